# Optimizing an MI355X kernel written in HIP

```python
import jax, jax.numpy as jnp
from jax import lax
import numpy as np

D_MODEL = 1024
BATCH = 1
SEQ = 16384
DEPTH = 1

N_META = 16
EPS = 1e-6
ROPE_THETA = 10000.0
GLA_HEADS = 4
GLA_DK = 64
GLA_DV = 128
GLA_LOWRANK = 16
GLA_GATE_NORM = 16.0
GLA_CHUNK = 64
DSA_HEADS = 8
DSA_HD = 64
IDX_HEADS = 8
IDX_HD = 64
TOPK_MAX = 256
Q_BLOCK = 128
D_FF = 2816

GLA_WIDTH = GLA_HEADS * GLA_DV
DSA_WIDTH = DSA_HEADS * DSA_HD
MIX_WIDTH = GLA_WIDTH + DSA_WIDTH
IN_SIZES = (GLA_HEADS * GLA_DK, GLA_HEADS * GLA_DK, GLA_WIDTH, GLA_WIDTH, GLA_LOWRANK,
            DSA_WIDTH, DSA_WIDTH, DSA_WIDTH, IDX_HEADS * IDX_HD, IDX_HD, IDX_HEADS)
IN_COLS = sum(IN_SIZES)

kernel_name = "hymba_gla_dsa_macaron"


def rmsnorm(x, g):
    x32 = x.astype(jnp.float32)
    y = x32 * lax.rsqrt(jnp.mean(x32 * x32, axis=-1, keepdims=True) + EPS)
    return (y * g.astype(jnp.float32)).astype(x.dtype)


def swiglu(h, w_gate, w_up, w_down):
    return (jax.nn.silu(h @ w_gate) * (h @ w_up)) @ w_down


def rope_tables(L, dim):
    pos = jnp.arange(L, dtype=jnp.float32)
    inv_freq = 1.0 / (ROPE_THETA ** (jnp.arange(0, dim, 2, dtype=jnp.float32) / dim))
    ang = pos[:, None] * inv_freq[None, :]
    ang = jnp.concatenate([ang, ang], axis=-1)
    return jnp.cos(ang), jnp.sin(ang)


def apply_rope(x, cos, sin):
    half = x.shape[-1] // 2
    rot = jnp.concatenate([-x[..., half:], x[..., :half]], axis=-1)
    c = cos[None, :, None, :].astype(x.dtype)
    s = sin[None, :, None, :].astype(x.dtype)
    return x * c + rot * s


def gla_mixer(q, k, v, r, a_low, w_a2, b_a, head_norm):
    B, L, _ = q.shape
    dt = q.dtype
    f32 = jnp.float32
    q = q.reshape(B, L, GLA_HEADS, GLA_DK).astype(f32) * (GLA_DK ** -0.5)
    k = k.reshape(B, L, GLA_HEADS, GLA_DK).astype(f32)
    v = v.reshape(B, L, GLA_HEADS, GLA_DV).astype(f32)
    g = jax.nn.log_sigmoid((a_low @ w_a2 + b_a).astype(f32)) / GLA_GATE_NORM
    g = g.reshape(B, L, GLA_HEADS, GLA_DK)
    pad = GLA_CHUNK - N_META

    def to_chunks(t):
        t = jnp.pad(t, ((0, 0), (pad, 0), (0, 0), (0, 0)))
        nc = t.shape[1] // GLA_CHUNK
        return t.reshape(B, nc, GLA_CHUNK, GLA_HEADS, t.shape[-1]).transpose(1, 0, 3, 2, 4)

    qc, kc, vc, gc = to_chunks(q), to_chunks(k), to_chunks(v), to_chunks(g)
    causal = jnp.tril(jnp.ones((GLA_CHUNK, GLA_CHUNK), dtype=bool))

    def step(S, inp):
        qb, kb, vb, gb = inp
        b = jnp.cumsum(gb, axis=2)
        o_inter = jnp.einsum('bhcd,bhde->bhce', qb * jnp.exp(b), S)
        diff = b[:, :, :, None, :] - b[:, :, None, :, :]
        decay = jnp.exp(jnp.where(causal[None, None, :, :, None], diff, -jnp.inf))
        A = jnp.einsum('bhid,bhjd,bhijd->bhij', qb, kb, decay)
        o_intra = jnp.einsum('bhij,bhje->bhie', A, vb)
        b_last = b[:, :, -1:, :]
        S_new = jnp.exp(b_last[:, :, 0, :])[..., None] * S + \
            jnp.einsum('bhjd,bhje->bhde', kb * jnp.exp(b_last - b), vb)
        return S_new, o_inter + o_intra

    S0 = jnp.zeros((B, GLA_HEADS, GLA_DK, GLA_DV), f32)
    _, oc = lax.scan(step, S0, (qc, kc, vc, gc))
    o = oc.transpose(1, 0, 3, 2, 4).reshape(B, -1, GLA_HEADS, GLA_DV)[:, pad:]
    o = rmsnorm(o, head_norm)
    o = o.reshape(B, L, GLA_WIDTH) * jax.nn.silu(r.astype(f32))
    return o.astype(dt)


def dsa_mixer(q, k, v, iq, ik, iw, cos, sin, k_sel):
    B, L, _ = q.shape
    f32 = jnp.float32
    q = apply_rope(q.reshape(B, L, DSA_HEADS, DSA_HD), cos, sin)
    k = apply_rope(k.reshape(B, L, DSA_HEADS, DSA_HD), cos, sin)
    v = v.reshape(B, L, DSA_HEADS, DSA_HD)
    iq = apply_rope(iq.reshape(B, L, IDX_HEADS, IDX_HD), cos, sin)
    ik = apply_rope(ik.reshape(B, L, 1, IDX_HD), cos, sin)[:, :, 0]
    iw = iw * (IDX_HEADS ** -0.5)
    n_blk = -(-L // Q_BLOCK)
    Lp = n_blk * Q_BLOCK

    def to_blocks(t):
        t = jnp.pad(t, ((0, 0), (0, Lp - L)) + ((0, 0),) * (t.ndim - 2))
        t = t.reshape((B, n_blk, Q_BLOCK) + t.shape[2:])
        return jnp.moveaxis(t, 1, 0)

    key_pos = jnp.arange(L)
    q_pos = jnp.arange(Lp).reshape(n_blk, Q_BLOCK)

    def block(args):
        qb, iqb, iwb, tq = args
        idx_logits = jnp.einsum('bqhd,bsd->bqhs', iqb, ik) * (IDX_HD ** -0.5)
        score = jnp.einsum('bqh,bqhs->bqs', iwb, jax.nn.relu(idx_logits)).astype(f32)
        visible = key_pos[None, :] <= tq[:, None]
        score = jnp.where(visible[None], score, -jnp.inf)
        _, idx = lax.top_k(score, k_sel)
        ks = jax.vmap(lambda kk, ii: kk[ii])(k, idx)
        vs = jax.vmap(lambda vv, ii: vv[ii])(v, idx)
        logits = jnp.einsum('bqhd,bqkhd->bhqk', qb, ks).astype(f32) * (DSA_HD ** -0.5)
        valid = idx <= tq[None, :, None]
        logits = jnp.where(valid[:, None], logits, -jnp.inf)
        p = jax.nn.softmax(logits, axis=-1).astype(vs.dtype)
        return jnp.einsum('bhqk,bqkhd->bqhd', p, vs)

    out = lax.map(block, (to_blocks(q), to_blocks(iq), to_blocks(iw), q_pos))
    out = jnp.moveaxis(out, 0, 1).reshape(B, Lp, DSA_WIDTH)[:, :L]
    return out


def token_mixing(hn, w_in, gla_w_a2, gla_b_a, gla_head_norm, w_out, cos, sin, k_sel):
    proj = hn @ w_in
    split_points = np.cumsum(IN_SIZES)[:-1].tolist()
    gq, gk, gv, gr, ga, dq, dk, dv, iq, ik, iw = jnp.split(proj, split_points, axis=-1)
    o_gla = gla_mixer(gq, gk, gv, gr, ga, gla_w_a2, gla_b_a, gla_head_norm)
    o_dsa = dsa_mixer(dq, dk, dv, iq, ik, iw, cos, sin, k_sel)
    return jnp.concatenate([o_gla, o_dsa], axis=-1) @ w_out


def setup_inputs(seed: int = 0) -> dict:
    key = jax.random.key(seed)
    ks = jax.random.split(key, 20)
    f32 = jnp.float32

    def w(k, shape, fan_in):
        return jax.random.normal(k, shape, f32) * (fan_in ** -0.5)

    def gain(k, shape):
        return 1.0 + 0.02 * jax.random.normal(k, shape, f32)

    return {
        "x": jax.random.normal(ks[0], (BATCH, SEQ, D_MODEL), f32),
        "meta_tokens": jax.random.normal(ks[1], (N_META, D_MODEL), f32),
        "ffn1_norm": gain(ks[2], (DEPTH, D_MODEL)),
        "ffn1_w_gate": w(ks[3], (DEPTH, D_MODEL, D_FF), D_MODEL),
        "ffn1_w_up": w(ks[4], (DEPTH, D_MODEL, D_FF), D_MODEL),
        "ffn1_w_down": w(ks[5], (DEPTH, D_FF, D_MODEL), D_FF),
        "mix_norm": gain(ks[6], (DEPTH, D_MODEL)),
        "w_in": w(ks[7], (DEPTH, D_MODEL, IN_COLS), D_MODEL),
        "gla_w_a2": w(ks[8], (DEPTH, GLA_LOWRANK, GLA_HEADS * GLA_DK), GLA_LOWRANK),
        "gla_b_a": 0.01 * jax.random.normal(ks[9], (DEPTH, GLA_HEADS * GLA_DK), f32),
        "gla_head_norm": gain(ks[10], (DEPTH, GLA_DV)),
        "w_out": w(ks[11], (DEPTH, MIX_WIDTH, D_MODEL), MIX_WIDTH),
        "ffn2_norm": gain(ks[12], (DEPTH, D_MODEL)),
        "ffn2_w_gate": w(ks[13], (DEPTH, D_MODEL, D_FF), D_MODEL),
        "ffn2_w_up": w(ks[14], (DEPTH, D_MODEL, D_FF), D_MODEL),
        "ffn2_w_down": w(ks[15], (DEPTH, D_FF, D_MODEL), D_FF),
        "final_norm": gain(ks[16], (D_MODEL,)),
    }


def reference(x, meta_tokens, ffn1_norm, ffn1_w_gate, ffn1_w_up, ffn1_w_down, mix_norm, w_in,
              gla_w_a2, gla_b_a, gla_head_norm, w_out, ffn2_norm, ffn2_w_gate, ffn2_w_up,
              ffn2_w_down, final_norm):
    B, S, _ = x.shape
    k_sel = min(TOPK_MAX, S // 4)
    meta = jnp.broadcast_to(meta_tokens[None].astype(x.dtype), (B, N_META, D_MODEL))
    h = jnp.concatenate([meta, x], axis=1)
    L = h.shape[1]
    cos, sin = rope_tables(L, DSA_HD)
    for layer in range(DEPTH):
        h = h + 0.5 * swiglu(rmsnorm(h, ffn1_norm[layer]), ffn1_w_gate[layer], ffn1_w_up[layer], ffn1_w_down[layer])
        h = h + token_mixing(rmsnorm(h, mix_norm[layer]), w_in[layer], gla_w_a2[layer], gla_b_a[layer],
                             gla_head_norm[layer], w_out[layer], cos, sin, k_sel)
        h = h + 0.5 * swiglu(rmsnorm(h, ffn2_norm[layer]), ffn2_w_gate[layer], ffn2_w_up[layer], ffn2_w_down[layer])
    h = rmsnorm(h, final_norm)
    return h[:, N_META:]
```

```cpp
#include <hip/hip_runtime.h>
#include <hip/hip_cooperative_groups.h>
#include <cstdio>
#include <cstdint>
namespace cg = cooperative_groups;

#ifndef MODE
#define MODE 1
#endif

#define LAS __attribute__((address_space(3)))
typedef _Float16 f16;
typedef _Float16 half8 __attribute__((ext_vector_type(8)));
typedef _Float16 half4 __attribute__((ext_vector_type(4)));
typedef float f32x2 __attribute__((ext_vector_type(2)));
typedef float f32x4 __attribute__((ext_vector_type(4)));
typedef float f32x16 __attribute__((ext_vector_type(16)));
typedef unsigned u32x2 __attribute__((ext_vector_type(2)));
typedef unsigned u32x4 __attribute__((ext_vector_type(4)));

constexpr int D = 1024, SEQ = 16384, NMETA = 16, L = SEQ + NMETA, DFF = 2816;
constexpr int MP = 16640;
constexpr int LP = 16512;
constexpr int NIN = 3840;
constexpr int NCH = 257;
constexpr float EPS = 1e-6f;
constexpr int NTHREADS = 512;
constexpr int LDS_BYTES = 131072 + 1024;
constexpr int NPHASE = 11;

constexpr size_t al256(size_t x) { return (x + 255) & ~(size_t)255; }
constexpr size_t WS_CTL = 0;
constexpr size_t WS_WGU1 = 4096;
constexpr size_t WS_WD1 = WS_WGU1 + (size_t)2 * DFF * D * 2;
constexpr size_t WS_WIN = WS_WD1 + (size_t)D * DFF * 2;
constexpr size_t WS_WOUT = WS_WIN + (size_t)NIN * D * 2;
constexpr size_t WS_WGU2 = WS_WOUT + (size_t)D * D * 2;
constexpr size_t WS_WD2 = WS_WGU2 + (size_t)2 * DFF * D * 2;
constexpr size_t WS_ACTA = WS_WD2 + (size_t)D * DFF * 2;
constexpr size_t WS_G = WS_ACTA + (size_t)MP * D * 2;
constexpr size_t WS_US = WS_G + (size_t)MP * DFF * 2;
constexpr size_t WS_DQ = WS_US + (size_t)NCH * 4 * 64 * 128 * 4;
constexpr size_t WS_IQ = WS_DQ + (size_t)LP * 512 * 2;
constexpr size_t WS_SEL = WS_IQ + (size_t)LP * 512 * 2;
constexpr size_t WS_ROPE = WS_SEL + (size_t)LP * 256 * 2;
constexpr size_t WS_IW = WS_ROPE + al256((size_t)L * 32 * 8);
constexpr size_t WS_GA = WS_IW + (size_t)LP * 8 * 4;
constexpr size_t WS_DECAY = WS_GA + (size_t)LP * 16 * 4;
constexpr size_t WS_SS0 = WS_DECAY + al256((size_t)NCH * 256 * 4);
constexpr size_t WS_SS1 = WS_SS0 + (size_t)MP * 4;
constexpr size_t WS_SS2 = WS_SS1 + (size_t)MP * 64;
constexpr size_t WS_SS3 = WS_SS2 + (size_t)MP * 64;
constexpr size_t WS_END = WS_SS3 + (size_t)MP * 64;
constexpr size_t WS_KV = WS_G;
constexpr size_t WS_GQ = WS_KV + (size_t)8 * LP * 128 * 2;
constexpr size_t WS_GK = WS_GQ + (size_t)LP * 256 * 2;
constexpr size_t WS_GV = WS_GK + (size_t)LP * 256 * 2;
constexpr size_t WS_GR = WS_GV + (size_t)LP * 512 * 2;
constexpr size_t WS_IK = WS_GR + (size_t)LP * 512 * 2;
constexpr size_t WS_ALIAS_END = WS_IK + (size_t)LP * 64 * 2;
static_assert(WS_ALIAS_END <= WS_US, "aliased buffers exceed G");
static_assert(WS_END <= (size_t)256 * 1024 * 1024, "workspace exceeds 256 MiB");
static_assert((size_t)SEQ * D * 2 <= (size_t)NCH * 4 * 64 * 128 * 4, "h2_16 alias");

struct Params {
    const float* x; const float* meta; const float* n1; const float* wg1; const float* wu1; const float* wd1;
    const float* nmix; const float* win; const float* wa2; const float* ba; const float* hn; const float* wout;
    const float* n2; const float* wg2; const float* wu2; const float* wd2; const float* nf;
    float* out; unsigned char* ws; int ph_lo, ph_hi;
};

namespace pg8 {
constexpr int BM = 256, BK = 64, HALF = 128, HTB = HALF * BK * 2, STAGE_BYTES = 8 * HTB, NXCD = 8, WGM = 8;
__host__ __device__ __forceinline__ int lds_byte(int r, int c) { const int st = (r >> 4) * 2 + (c >> 5), rr = r & 15, cc = c & 31, ob = rr * 64 + cc * 2; return st * 1024 + (ob ^ (((ob >> 9) & 1) << 5)); }
__host__ __device__ __forceinline__ void stage_rc(int b, int& R, int& C) { const int st = b / 1024, sb = b % 1024, swz = sb ^ (((sb >> 9) & 1) << 5); R = (st >> 1) * 16 + swz / 64; C = (st & 1) * 32 + (swz % 64) / 2; }
struct Unit { int pm, pn; };
struct Gemm { const f16* A; const f16* Bt; int M, N, K; };
struct StaticOrder {
    int nM, nN, nwg, G, c;
    __host__ __device__ void init(int M, int N, int G_, int c_) { nM = M / BM; nN = N / BM; nwg = nM * nN; G = G_; c = c_; }
    __host__ __device__ bool next(int i, Unit& u) const {
        const long Lx = (long)i * G + c; if (Lx >= nwg) return false;
        int wgid = (int)Lx; { const int q = nwg / NXCD, r = nwg % NXCD, xcd = wgid % NXCD, off = wgid / NXCD; wgid = (xcd < r ? xcd * (q + 1) : r * (q + 1) + (xcd - r) * q) + off; }
        const int nig = WGM * nN, gid = wgid / nig, fm = gid * WGM, gsz = (nM - fm) < WGM ? (nM - fm) : WGM;
        u.pm = fm + ((wgid % nig) % gsz); u.pn = (wgid % nig) / gsz; return true;
    }
};
template <class Epi>
__device__ __forceinline__ void gemm_phase(LAS unsigned char* lds, const Gemm g, const StaticOrder& S, const Epi& E) {
    const int tid = threadIdx.x, wid = __builtin_amdgcn_readfirstlane(tid >> 6), lane = tid & 63, wr = wid >> 2, wc = wid & 3, fr = lane & 15, fq = lane >> 4;
    const int K = g.K, nt = K / BK;
    unsigned voffA[2], voffB[2];
#pragma unroll
    for (int i = 0; i < 2; ++i) { int R, C; stage_rc(tid * 16 + i * 8192, R, C); voffA[i] = (unsigned)(R * K + C) * 2u; voffB[i] = (unsigned)(R * K + C) * 2u; }
    const size_t kstep = (size_t)(BK * 2);
    const size_t hstep = (size_t)HALF * K * 2;
    const size_t tstep = 2 * hstep;
    const unsigned ldsw = (unsigned)wid * 1024u;
    const int aoff = lds_byte(wr * 64 + fr, fq * 8), boff = lds_byte(wc * 32 + fr, fq * 8);
#define PG8_SA(b, h) (((b) * 2 + (h)) * HTB)
#define PG8_SB(b, h) ((4 + (b) * 2 + (h)) * HTB)
#define PG8_STAGE(bufoff, gbase, voff) do { _Pragma("unroll") for (int _i = 0; _i < 2; ++_i) \
        __builtin_amdgcn_global_load_lds((const unsigned*)((const char*)(gbase) + (voff)[_i]), (LAS unsigned*)(lds + (bufoff) + ldsw + _i * 8192), 16, 0, 0); } while (0)
#define PG8_LDA(dst, b, h) do { _Pragma("unroll") for (int m = 0; m < 4; ++m) _Pragma("unroll") for (int k = 0; k < 2; ++k) dst[m][k] = *(const LAS half8*)(lds + PG8_SA(b, h) + aoff + m * 2048 + k * 1024); } while (0)
#define PG8_LDB(dst, b, h) do { _Pragma("unroll") for (int n = 0; n < 2; ++n) _Pragma("unroll") for (int k = 0; k < 2; ++k) dst[n][k] = *(const LAS half8*)(lds + PG8_SB(b, h) + boff + n * 2048 + k * 1024); } while (0)
#define PG8_MMA(ai, bj, At, Bt) do { __builtin_amdgcn_s_setprio(1); _Pragma("unroll") for (int m = 0; m < 4; ++m) _Pragma("unroll") for (int n = 0; n < 2; ++n) _Pragma("unroll") for (int k = 0; k < 2; ++k) \
        acc[ai][bj][m][n] = __builtin_amdgcn_mfma_f32_16x16x32_f16(Bt[n][k], At[m][k], acc[ai][bj][m][n], 0, 0, 0); __builtin_amdgcn_s_setprio(0); } while (0)
#define PG8_WAIT_V(n) asm volatile("s_waitcnt vmcnt(" #n ")" ::: "memory")
#define PG8_WAIT_L(n) asm volatile("s_waitcnt lgkmcnt(" #n ")" ::: "memory")
#define PG8_BAR __builtin_amdgcn_s_barrier()
#define PG8_SCHED __builtin_amdgcn_sched_barrier(0)
    Unit cur, nxt; int ui = 0;
    if (!S.next(0, cur)) return;
    f32x4 acc[2][2][4][2];
#pragma unroll
    for (int a = 0; a < 2; ++a)
#pragma unroll
        for (int b = 0; b < 2; ++b)
#pragma unroll
            for (int m = 0; m < 4; ++m)
#pragma unroll
                for (int n = 0; n < 2; ++n) acc[a][b][m][n] = (f32x4){0.f, 0.f, 0.f, 0.f};
    half8 At[4][2], B0[2][2], B1[2][2];
    const char* cA = (const char*)g.A + (size_t)cur.pm * tstep; const char* cB = (const char*)g.Bt + (size_t)cur.pn * tstep;
    PG8_STAGE(PG8_SB(0, 0), cB, voffB); PG8_STAGE(PG8_SA(0, 0), cA, voffA); PG8_STAGE(PG8_SB(0, 1), cB + hstep, voffB); PG8_STAGE(PG8_SA(0, 1), cA + hstep, voffA);
    if (wr == 1) PG8_BAR;
    PG8_WAIT_V(4); PG8_BAR;
    PG8_STAGE(PG8_SB(1, 0), cB + kstep, voffB); PG8_STAGE(PG8_SA(1, 0), cA + kstep, voffA); PG8_STAGE(PG8_SB(1, 1), cB + hstep + kstep, voffB);
    PG8_WAIT_V(6); PG8_BAR;
    for (;;) {
        const bool has_next = S.next(ui + 1, nxt);
        const char* nA = has_next ? (const char*)g.A + (size_t)nxt.pm * tstep : cA; const char* nB = has_next ? (const char*)g.Bt + (size_t)nxt.pn * tstep : cB;
        for (int t = 0; t < nt; t += 2) {
            const bool last = (t == nt - 2);
            const char* a1 = cA + (size_t)(t + 1) * kstep;
            const char* a2 = last ? nA : cA + (size_t)(t + 2) * kstep; const char* b2 = last ? nB : cB + (size_t)(t + 2) * kstep;
            const char* a3 = a2 + kstep; const char* b3 = b2 + kstep;
            PG8_LDB(B0, 0, 0); PG8_SCHED; PG8_LDA(At, 0, 0); PG8_STAGE(PG8_SA(1, 1), a1 + hstep, voffA);
            PG8_WAIT_L(8); PG8_BAR; PG8_WAIT_L(0); PG8_MMA(0, 0, At, B0); PG8_BAR; PG8_SCHED;
            PG8_LDB(B1, 0, 1); PG8_STAGE(PG8_SB(0, 0), b2, voffB);
            PG8_BAR; PG8_WAIT_L(0); PG8_MMA(0, 1, At, B1); PG8_BAR;
            PG8_LDA(At, 0, 1); PG8_STAGE(PG8_SA(0, 0), a2, voffA);
            PG8_BAR; PG8_WAIT_L(0); PG8_MMA(1, 0, At, B0); PG8_BAR; PG8_SCHED;
            PG8_STAGE(PG8_SB(0, 1), b2 + hstep, voffB);
            PG8_WAIT_V(6); PG8_BAR; PG8_MMA(1, 1, At, B1); PG8_BAR;
            PG8_LDB(B0, 1, 0); PG8_SCHED; PG8_LDA(At, 1, 0); PG8_STAGE(PG8_SA(0, 1), a2 + hstep, voffA);
            PG8_WAIT_L(8); PG8_BAR; PG8_WAIT_L(0); PG8_MMA(0, 0, At, B0); PG8_BAR; PG8_SCHED;
            PG8_LDB(B1, 1, 1); PG8_STAGE(PG8_SB(1, 0), b3, voffB);
            PG8_BAR; PG8_WAIT_L(0); PG8_MMA(0, 1, At, B1); PG8_BAR;
            PG8_LDA(At, 1, 1); PG8_STAGE(PG8_SA(1, 0), a3, voffA);
            PG8_BAR; PG8_WAIT_L(0); PG8_MMA(1, 0, At, B0); PG8_BAR; PG8_SCHED;
            PG8_STAGE(PG8_SB(1, 1), b3 + hstep, voffB);
            PG8_WAIT_V(6); PG8_BAR; PG8_MMA(1, 1, At, B1); PG8_BAR;
        }
        E(acc, cur, wr, wc, fr, fq);
        if (!has_next) break;
#pragma unroll
        for (int a = 0; a < 2; ++a)
#pragma unroll
            for (int b = 0; b < 2; ++b)
#pragma unroll
                for (int m = 0; m < 4; ++m)
#pragma unroll
                    for (int n = 0; n < 2; ++n) acc[a][b][m][n] = (f32x4){0.f, 0.f, 0.f, 0.f};
        cur = nxt; cA = nA; cB = nB; ++ui;
    }
    PG8_WAIT_V(0);
    if (wr == 0) PG8_BAR;
    PG8_BAR;
#undef PG8_SA
#undef PG8_SB
#undef PG8_STAGE
#undef PG8_LDA
#undef PG8_LDB
#undef PG8_MMA
#undef PG8_WAIT_V
#undef PG8_WAIT_L
#undef PG8_BAR
#undef PG8_SCHED
}
}

__device__ __forceinline__ float silu_f(float v) { return v / (1.0f + __expf(-v)); }
__device__ __forceinline__ half4 to_half4(f32x4 v) { half4 h; h[0] = (f16)v[0]; h[1] = (f16)v[1]; h[2] = (f16)v[2]; h[3] = (f16)v[3]; return h; }

__device__ __forceinline__ float row_rstd(const float* ss, int np, int row) {
    float s;
    if (np == 1) s = ss[row];
    else { const f32x4* p = (const f32x4*)(ss + (size_t)row * 16); const f32x4 a = p[0], b = p[1], c = p[2], d = p[3];
        s = (((a[0] + a[1]) + (a[2] + a[3])) + ((b[0] + b[1]) + (b[2] + b[3]))) + (((c[0] + c[1]) + (c[2] + c[3])) + ((d[0] + d[1]) + (d[2] + d[3]))); }
    return rsqrtf(s * (1.0f / D) + EPS);
}
struct EpiSwiglu {
    f16* G; const float* ss; int np;
    __device__ __forceinline__ void operator()(const f32x4 (&acc)[2][2][4][2], const pg8::Unit& u, int wr, int wc, int fr, int fq) const {
#pragma unroll
        for (int ai = 0; ai < 2; ++ai)
#pragma unroll
            for (int m = 0; m < 4; ++m) {
                const int row = u.pm * 256 + ai * 128 + wr * 64 + m * 16 + fr;
                const float rs = row_rstd(ss, np, row);
#pragma unroll
                for (int n = 0; n < 2; ++n) {
                    const f32x4 gt = acc[ai][0][m][n] * rs, up = acc[ai][1][m][n] * rs; f32x4 o;
#pragma unroll
                    for (int j = 0; j < 4; ++j) o[j] = silu_f(gt[j]) * up[j];
                    *(half4*)(G + (size_t)row * DFF + u.pn * 128 + wc * 32 + n * 16 + 4 * fq) = to_half4(o);
                }
            }
    }
};
struct EpiResid {
    const float* src; float* out; f16* h16; float* ss; float alpha;
    __device__ __forceinline__ void operator()(const f32x4 (&acc)[2][2][4][2], const pg8::Unit& u, int wr, int wc, int fr, int fq) const {
#pragma unroll
        for (int ai = 0; ai < 2; ++ai)
#pragma unroll
            for (int m = 0; m < 4; ++m) {
                const int row = u.pm * 256 + ai * 128 + wr * 64 + m * 16 + fr; float part = 0.f;
#pragma unroll
                for (int bj = 0; bj < 2; ++bj)
#pragma unroll
                    for (int n = 0; n < 2; ++n) {
                        const size_t off = (size_t)row * D + u.pn * 256 + bj * 128 + wc * 32 + n * 16 + 4 * fq;
                        const f32x4 s = *(const f32x4*)(src + off); const f32x4 o = s + alpha * acc[ai][bj][m][n];
                        *(f32x4*)(out + off) = o; if (h16) *(half4*)(h16 + off) = to_half4(o);
                        part += (o[0] * o[0] + o[1] * o[1]) + (o[2] * o[2] + o[3] * o[3]);
                    }
                part += __shfl_xor(part, 16); part += __shfl_xor(part, 32);
                if (fq == 0) ss[(size_t)row * 16 + u.pn * 4 + wc] = part;
            }
    }
};
struct EpiInProj {
    const float* ss; const f32x2* rope; f16* GQ; f16* GK; f16* GV; f16* GR; f16* DQ; f16* KV; f16* IQ; f16* IK; float* GA; float* IW;
    __device__ __forceinline__ void operator()(const f32x4 (&acc)[2][2][4][2], const pg8::Unit& u, int wr, int wc, int fr, int fq) const {
        const int pn = u.pn;
#pragma unroll
        for (int ai = 0; ai < 2; ++ai)
#pragma unroll
            for (int m = 0; m < 4; ++m) {
                const int p = u.pm * 256 + ai * 128 + wr * 64 + m * 16 + fr;
                const int t = p < SEQ ? p + NMETA : p - SEQ;
                if (p >= L) continue;
                const float rs = row_rstd(ss, 16, p);
                const bool is_rope = (pn >= 6 && pn <= 9) || pn == 12 || pn == 13 || (pn == 14 && wc == 0);
                if (is_rope) {
                    const float sc = (pn == 8 || pn == 9 || pn == 14) ? rs : rs * 0.125f;
#pragma unroll
                    for (int n = 0; n < 2; ++n) {
                        const int dd = 16 * n + 4 * fq;
                        const f32x4 x1 = acc[ai][0][m][n], x2 = acc[ai][1][m][n]; f32x4 o1, o2;
                        const f32x4 cs0 = *(const f32x4*)(rope + (size_t)t * 32 + dd), cs1 = *(const f32x4*)(rope + (size_t)t * 32 + dd + 2);
                        const float c[4] = {cs0[0], cs0[2], cs1[0], cs1[2]}, s[4] = {cs0[1], cs0[3], cs1[1], cs1[3]};
#pragma unroll
                        for (int j = 0; j < 4; ++j) { o1[j] = (x1[j] * c[j] - x2[j] * s[j]) * sc; o2[j] = (x2[j] * c[j] + x1[j] * s[j]) * sc; }
                        f16* dst;
                        if (pn == 6 || pn == 7) dst = DQ + (size_t)t * 512 + (pn - 6) * 256 + wc * 64 + dd;
                        else if (pn == 8 || pn == 9) dst = KV + ((size_t)((pn - 8) * 4 + wc) * LP + t) * 128 + dd;
                        else if (pn == 12 || pn == 13) dst = IQ + (size_t)t * 512 + (pn - 12) * 256 + wc * 64 + dd;
                        else dst = IK + (size_t)t * 64 + dd;
                        *(half4*)dst = to_half4(o1); *(half4*)(dst + 32) = to_half4(o2);
                    }
                } else if (pn == 14) {
                    if (wc == 1) {
                        const f32x4 a0 = acc[ai][0][m][0] * rs; *(f32x4*)(GA + (size_t)t * 16 + 4 * fq) = a0;
                        if (fq < 2) { const f32x4 a1 = acc[ai][0][m][1] * (rs * 0.35355339059327373f); *(f32x4*)(IW + (size_t)t * 8 + 4 * fq) = a1; }
                    }
                } else {
#pragma unroll
                    for (int bj = 0; bj < 2; ++bj)
#pragma unroll
                        for (int n = 0; n < 2; ++n) {
                            const int c = bj * 128 + wc * 32 + n * 16 + 4 * fq; f16* dst;
                            if (pn == 0) dst = GQ + (size_t)t * 256 + c;
                            else if (pn == 1) dst = GK + (size_t)t * 256 + c;
                            else if (pn <= 3) dst = GV + (size_t)t * 512 + (pn - 2) * 256 + c;
                            else if (pn <= 5) dst = GR + (size_t)t * 512 + (pn - 4) * 256 + c;
                            else dst = KV + ((size_t)((pn - 10) * 4 + (c >> 6)) * LP + t) * 128 + 64 + (c & 63);
                            *(half4*)dst = to_half4(acc[ai][bj][m][n] * rs);
                        }
                }
            }
    }
};

__device__ __forceinline__ const float* w_src(const Params& P, int kind, int n, int& ld, const float*& gain) {
    switch (kind) {
    case 0: case 4: { const int pn = n >> 8, bj = (n >> 7) & 1, cc = n & 127; ld = DFF; gain = kind == 0 ? P.n1 : P.n2;
        const float* w = kind == 0 ? (bj ? P.wu1 : P.wg1) : (bj ? P.wu2 : P.wg2); return w + pn * 128 + cc; }
    case 1: ld = D; gain = nullptr; return P.wd1 + n;
    case 5: ld = D; gain = nullptr; return P.wd2 + n;
    case 3: ld = D; gain = nullptr; return P.wout + n;
    default: { ld = 3672; gain = P.nmix; const int pn = n >> 8, c = n & 255, bj = c >> 7, hh = (c >> 5) & 3, dd = c & 31; int j;
        if (pn == 0) j = c; else if (pn == 1) j = 256 + c; else if (pn <= 3) j = 512 + (pn - 2) * 256 + c; else if (pn <= 5) j = 1024 + (pn - 4) * 256 + c;
        else if (pn <= 7) j = 1552 + (pn - 6) * 256 + hh * 64 + bj * 32 + dd;
        else if (pn <= 9) j = 2064 + (pn - 8) * 256 + hh * 64 + bj * 32 + dd;
        else if (pn <= 11) j = 2576 + (pn - 10) * 256 + c;
        else if (pn <= 13) j = 3088 + (pn - 12) * 256 + hh * 64 + bj * 32 + dd;
        else { if (c < 32) j = 3600 + c; else if (c < 48) j = 1536 + (c - 32); else if (c < 56) j = 3664 + (c - 48); else if (c >= 128 && c < 160) j = 3600 + 32 + (c - 128); else j = -1; }
        return j < 0 ? nullptr : P.win + j; }
    }
}
__device__ __forceinline__ void prep_weight(const Params& P, const int kind, const int N, const int K, f16* dst, int& cursor, int& tbase, LAS f16* tl) {
    const int tid = threadIdx.x, G = gridDim.x, tn = N / 64, tk = K / 64, ntile = tn * tk;
#pragma unroll 1
    for (; cursor < tbase + ntile; cursor += G) {
        const int tI = cursor - tbase, n0 = (tI % tn) * 64, k0 = (tI / tn) * 64;
        { const int n = tid & 63, kk0 = tid >> 6; int ld; const float* gain; const float* col = w_src(P, kind, n0 + n, ld, gain);
#pragma unroll
          for (int i = 0; i < 8; ++i) { const int k = k0 + kk0 + 8 * i; float v = 0.f; if (col) { v = col[(size_t)k * ld]; if (gain) v *= gain[k]; } tl[n * 72 + kk0 + 8 * i] = (f16)v; } }
        __syncthreads();
        { const int n = tid >> 3, seg = tid & 7; *(half8*)(dst + (size_t)(n0 + n) * K + k0 + seg * 8) = *(const LAS half8*)(tl + n * 72 + seg * 8); }
        __syncthreads();
    }
    tbase += ntile;
}
__device__ __forceinline__ void p0_prologue(const Params& P, LAS unsigned char* lds) {
    const int tid = threadIdx.x, bid = blockIdx.x, G = gridDim.x, lane = tid & 63;
    unsigned char* ws = P.ws;
    int tbase = 0, cursor = bid;
    LAS f16* tl = (LAS f16*)lds;
    prep_weight(P, 0, 2 * DFF, D, (f16*)(ws + WS_WGU1), cursor, tbase, tl);
    prep_weight(P, 1, D, DFF, (f16*)(ws + WS_WD1), cursor, tbase, tl);
    prep_weight(P, 2, NIN, D, (f16*)(ws + WS_WIN), cursor, tbase, tl);
    prep_weight(P, 3, D, D, (f16*)(ws + WS_WOUT), cursor, tbase, tl);
    prep_weight(P, 4, 2 * DFF, D, (f16*)(ws + WS_WGU2), cursor, tbase, tl);
    prep_weight(P, 5, D, DFF, (f16*)(ws + WS_WD2), cursor, tbase, tl);
    float* ss0 = (float*)(ws + WS_SS0);
    f16* acta = (f16*)(ws + WS_ACTA);
    const int gw = bid * 8 + (tid >> 6), nw = G * 8;
    for (int p = gw; p < L; p += nw) {
        const float* src = p < SEQ ? P.x + (size_t)p * D : P.meta + (size_t)(p - SEQ) * D; float s = 0.f;
#pragma unroll
        for (int i = 0; i < 4; ++i) { const f32x4 v = *(const f32x4*)(src + lane * 4 + 256 * i); s += (v[0] * v[0] + v[1] * v[1]) + (v[2] * v[2] + v[3] * v[3]); *(half4*)(acta + (size_t)p * D + lane * 4 + 256 * i) = to_half4(v); }
#pragma unroll
        for (int o = 32; o >= 1; o >>= 1) s += __shfl_xor(s, o);
        if (lane == 0) ss0[p] = s;
    }
    const int gt = bid * NTHREADS + tid, ngt = G * NTHREADS;
    for (int i = gt; i < MP; i += ngt) { if (i >= L) ss0[i] = (float)D; }
    if (gt < 64) ((unsigned*)(ws + WS_CTL))[gt] = 0u;
    f32x2* rope = (f32x2*)(ws + WS_ROPE);
    for (int i = gt; i < L * 32; i += ngt) { const int t = i >> 5, f = i & 31; const double inv = exp(-(double)f * (9.210340371976184 / 32.0)); double sn, cs; sincos((double)t * inv, &sn, &cs); rope[i] = (f32x2){(float)cs, (float)sn}; }
}

__device__ __forceinline__ void meta_down(const Params& P, LAS unsigned char* lds) {
    const int tid = threadIdx.x, lane = tid & 63, wid = tid >> 6;
    const f16* Gm = (const f16*)(P.ws + WS_G) + (size_t)SEQ * DFF; const f16* Wt = (const f16*)(P.ws + WS_WD1);
    f16* acta = (f16*)(P.ws + WS_ACTA); float* ss1 = (float*)(P.ws + WS_SS1); LAS float* slot = (LAS float*)lds;
    for (int task = blockIdx.x; task < NMETA * 16; task += gridDim.x) {
        const int r = task >> 4, cg = task & 15; float part = 0.f;
#pragma unroll 1
        for (int q = 0; q < 2; ++q) {
            const int n0 = cg * 64 + (2 * wid + q) * 4; float a[4] = {0.f, 0.f, 0.f, 0.f};
            for (int kc = lane; kc < DFF / 8; kc += 64) {
                const half8 gv = *(const half8*)(Gm + (size_t)r * DFF + kc * 8);
#pragma unroll
                for (int j = 0; j < 4; ++j) { const half8 wv = *(const half8*)(Wt + (size_t)(n0 + j) * DFF + kc * 8);
#pragma unroll
                    for (int e = 0; e < 8; ++e) a[j] += (float)gv[e] * (float)wv[e]; }
            }
#pragma unroll
            for (int o = 32; o >= 1; o >>= 1) { a[0] += __shfl_xor(a[0], o); a[1] += __shfl_xor(a[1], o); a[2] += __shfl_xor(a[2], o); a[3] += __shfl_xor(a[3], o); }
            f32x4 o;
#pragma unroll
            for (int j = 0; j < 4; ++j) { o[j] = P.meta[r * D + n0 + j] + 0.5f * a[j]; part += o[j] * o[j]; }
            if (lane == 0) *(half4*)(acta + (size_t)(SEQ + r) * D + n0) = to_half4(o);
        }
        if (lane == 0) slot[wid] = part;
        __syncthreads();
        if (tid == 0) { float s = 0.f; for (int w = 0; w < 8; ++w) s += slot[w]; ss1[(size_t)(SEQ + r) * 16 + cg] = s; }
        __syncthreads();
    }
}

__device__ __forceinline__ float logsigmoid_f(float z) { return fminf(z, 0.f) - log1pf(expf(-fabsf(z))); }
__device__ __forceinline__ void gla_gates(const Params& P, int c, int h, LAS float* bl) {
    const int tid = threadIdx.x; const float* GA = (const float*)(P.ws + WS_GA);
    for (int e = tid; e < 4096; e += NTHREADS) {
        const int i = e >> 6, d = e & 63, t = 64 * c - 48 + i; float g = 0.f;
        if (t >= 0 && t < L) { float z = P.ba[64 * h + d]; const float* a = GA + (size_t)t * 16;
#pragma unroll
            for (int r = 0; r < 16; ++r) z += a[r] * P.wa2[r * 256 + 64 * h + d];
            g = logsigmoid_f(z) * (1.0f / 16.0f); }
        bl[i * 65 + d] = g;
    }
    __syncthreads();
    if (tid < 64) { float run = 0.f; for (int i = 0; i < 64; ++i) { run += bl[i * 65 + tid]; bl[i * 65 + tid] = run; } }
    __syncthreads();
}
__device__ __forceinline__ void gla_a_unit(const Params& P, int unit, LAS unsigned char* lds) {
    const int tid = threadIdx.x, lane = tid & 63, wid = tid >> 6, c = unit >> 2, h = unit & 3;
    LAS float* bl = (LAS float*)lds; LAS float* ks = bl + 4160; LAS float* vs = ks + 4096;
    const f16* GK = (const f16*)(P.ws + WS_GK); const f16* GV = (const f16*)(P.ws + WS_GV);
    float* U = (float*)(P.ws + WS_US); float* DEC = (float*)(P.ws + WS_DECAY);
    gla_gates(P, c, h, bl);
    for (int e = tid; e < 4096; e += NTHREADS) { const int j = e >> 6, d = e & 63, t = 64 * c - 48 + j; float v = 0.f;
        if (t >= 0 && t < L) v = (float)GK[(size_t)t * 256 + 64 * h + d] * __expf(bl[63 * 65 + d] - bl[j * 65 + d]); ks[j * 64 + d] = v; }
    for (int e = tid; e < 8192; e += NTHREADS) { const int j = e >> 7, x = e & 127, t = 64 * c - 48 + j; vs[j * 128 + x] = (t >= 0 && t < L) ? (float)GV[(size_t)t * 512 + 128 * h + x] : 0.f; }
    if (tid < 64) DEC[(size_t)c * 256 + h * 64 + tid] = __expf(bl[63 * 65 + tid]);
    __syncthreads();
    { const int d0 = (wid >> 2) * 32, e0 = (wid & 3) * 32, l31 = lane & 31, hf = lane >> 5; f32x16 acc;
#pragma unroll
      for (int i = 0; i < 16; ++i) acc[i] = 0.f;
#pragma unroll 8
      for (int s = 0; s < 32; ++s) acc = __builtin_amdgcn_mfma_f32_32x32x2f32(ks[(2 * s + hf) * 64 + d0 + l31], vs[(2 * s + hf) * 128 + e0 + l31], acc, 0, 0, 0);
      float* up = U + ((size_t)unit * 64) * 128;
#pragma unroll
      for (int r = 0; r < 16; ++r) { const int row = (r & 3) + 8 * (r >> 2) + 4 * hf; up[(size_t)(d0 + row) * 128 + e0 + l31] = acc[r]; } }
    __syncthreads();
}
__device__ __forceinline__ void gla_scan(const Params& P) {
    float* U = (float*)(P.ws + WS_US); const float* DEC = (const float*)(P.ws + WS_DECAY);
    const int idx = blockIdx.x * NTHREADS + threadIdx.x;
    if (idx >= 32768) return;
    float s = 0.f;
#pragma unroll 8
    for (int c = 0; c < NCH; ++c) { const float u = U[(size_t)c * 32768 + idx], dc = DEC[(size_t)c * 256 + (idx >> 7)]; U[(size_t)c * 32768 + idx] = s; s = dc * s + u; }
}
__device__ __forceinline__ void gla_c_unit(const Params& P, int unit, LAS unsigned char* lds) {
    const int tid = threadIdx.x, lane = tid & 63, wid = tid >> 6, c = unit >> 2, h = unit & 3, l31 = lane & 31, hf = lane >> 5;
    LAS float* bl = (LAS float*)lds; LAS float* kk = bl + 4160; LAS float* qs = kk + 4160; LAS float* As = qs + 4160; LAS float* vs = As + 4160; LAS float* os = bl;
    const f16* GQ = (const f16*)(P.ws + WS_GQ); const f16* GK = (const f16*)(P.ws + WS_GK); const f16* GV = (const f16*)(P.ws + WS_GV); const f16* GR = (const f16*)(P.ws + WS_GR);
    const float* Sg = (const float*)(P.ws + WS_US) + (size_t)unit * 8192; f16* mix = (f16*)(P.ws + WS_ACTA);
    gla_gates(P, c, h, bl);
    for (int e = tid; e < 4096; e += NTHREADS) { const int i = e >> 6, d = e & 63, t = 64 * c - 48 + i; float q = 0.f, k = 0.f;
        if (t >= 0 && t < L) { const float b = bl[i * 65 + d]; q = (float)GQ[(size_t)t * 256 + 64 * h + d] * 0.125f * __expf(b); k = (float)GK[(size_t)t * 256 + 64 * h + d] * __expf(-b); }
        qs[i * 65 + d] = q; kk[i * 65 + d] = k; }
    for (int e = tid; e < 8192; e += NTHREADS) { const int j = e >> 7, x = e & 127, t = 64 * c - 48 + j; vs[j * 128 + x] = (t >= 0 && t < L) ? (float)GV[(size_t)t * 512 + 128 * h + x] : 0.f; }
    __syncthreads();
    if (wid < 4) { const int i0 = (wid >> 1) * 32, j0 = (wid & 1) * 32; f32x16 acc;
#pragma unroll
        for (int i = 0; i < 16; ++i) acc[i] = 0.f;
#pragma unroll 8
        for (int s = 0; s < 32; ++s) acc = __builtin_amdgcn_mfma_f32_32x32x2f32(qs[(i0 + l31) * 65 + 2 * s + hf], kk[(j0 + l31) * 65 + 2 * s + hf], acc, 0, 0, 0);
#pragma unroll
        for (int r = 0; r < 16; ++r) { const int i = i0 + (r & 3) + 8 * (r >> 2) + 4 * hf, j = j0 + l31; As[i * 65 + j] = (j <= i) ? acc[r] : 0.f; } }
    __syncthreads();
    { const int i0 = (wid >> 2) * 32, e0 = (wid & 3) * 32; f32x16 acc;
#pragma unroll
      for (int i = 0; i < 16; ++i) acc[i] = 0.f;
#pragma unroll 8
      for (int s = 0; s < 32; ++s) acc = __builtin_amdgcn_mfma_f32_32x32x2f32(qs[(i0 + l31) * 65 + 2 * s + hf], Sg[(size_t)(2 * s + hf) * 128 + e0 + l31], acc, 0, 0, 0);
#pragma unroll 8
      for (int s = 0; s < 32; ++s) acc = __builtin_amdgcn_mfma_f32_32x32x2f32(As[(i0 + l31) * 65 + 2 * s + hf], vs[(2 * s + hf) * 128 + e0 + l31], acc, 0, 0, 0);
#pragma unroll
      for (int r = 0; r < 16; ++r) { const int i = i0 + (r & 3) + 8 * (r >> 2) + 4 * hf; os[i * 129 + e0 + l31] = acc[r]; } }
    __syncthreads();
    { const int i = tid >> 3, e0 = (tid & 7) * 16, t = 64 * c - 48 + i; float o[16], s = 0.f;
#pragma unroll
      for (int j = 0; j < 16; ++j) { o[j] = os[i * 129 + e0 + j]; s += o[j] * o[j]; }
      s += __shfl_xor(s, 1); s += __shfl_xor(s, 2); s += __shfl_xor(s, 4);
      const float rs = rsqrtf(s * (1.0f / 128.0f) + EPS);
      if (t >= NMETA && t < L) {
#pragma unroll
          for (int j4 = 0; j4 < 4; ++j4) { f32x4 v;
#pragma unroll
              for (int j = 0; j < 4; ++j) { const int e = e0 + 4 * j4 + j; v[j] = o[4 * j4 + j] * rs * P.hn[e] * silu_f((float)GR[(size_t)t * 512 + 128 * h + e]); }
              *(half4*)(mix + (size_t)(t - NMETA) * D + 128 * h + e0 + 4 * j4) = to_half4(v); } } }
    __syncthreads();
}

__device__ __forceinline__ unsigned mono_u(float f) { const unsigned u = __float_as_uint(f); return (u & 0x80000000u) ? ~u : (u | 0x80000000u); }
__device__ __forceinline__ float unmono_f(unsigned m) { return __uint_as_float((m & 0x80000000u) ? (m & 0x7fffffffu) : ~m); }
__device__ __forceinline__ int topk_compact(LAS float* cs, LAS unsigned short* ci, int n, bool exact, float& tau_out, int lane) {
    float sv[8]; unsigned iv[8], u[8];
#pragma unroll
    for (int i = 0; i < 8; ++i) { const int p = lane + 64 * i; const bool v = p < n; sv[i] = v ? cs[p] : 0.f; iv[i] = v ? (unsigned)ci[p] : 0xffffu; u[i] = v ? mono_u(sv[i]) : 0u; }
    unsigned T = 0u; bool full = true;
#pragma unroll 1
    for (int bit = 31; bit >= 0; --bit) {
        const unsigned cand = T | (1u << bit); int cgt = 0;
#pragma unroll
        for (int i = 0; i < 8; ++i) cgt += __popcll(__ballot(u[i] >= cand));
        if (cgt >= 256) { T = cand; if (!exact && cgt <= 320) { full = false; break; } }
    }
    bool keep[8];
    if (full) {
        int cgt = 0;
#pragma unroll
        for (int i = 0; i < 8; ++i) cgt += __popcll(__ballot(u[i] > T));
        const int need = 256 - cgt; unsigned I = 0u;
#pragma unroll 1
        for (int bit = 15; bit >= 0; --bit) { const unsigned cand = I | (1u << bit); int cl = 0;
#pragma unroll
            for (int i = 0; i < 8; ++i) cl += __popcll(__ballot(u[i] == T && iv[i] < cand));
            if (cl < need) I = cand; }
#pragma unroll
        for (int i = 0; i < 8; ++i) keep[i] = (u[i] > T) || (u[i] == T && iv[i] <= I);
    } else {
#pragma unroll
        for (int i = 0; i < 8; ++i) keep[i] = u[i] >= T;
    }
    int nn = 0;
#pragma unroll
    for (int i = 0; i < 8; ++i) { const unsigned long long m = __ballot(keep[i]); const int pre = __builtin_amdgcn_mbcnt_hi((unsigned)(m >> 32), __builtin_amdgcn_mbcnt_lo((unsigned)m, 0u));
        if (keep[i]) { cs[nn + pre] = sv[i]; ci[nn + pre] = (unsigned short)iv[i]; } nn += __popcll(m); }
    tau_out = unmono_f(T);
    return nn;
}
__device__ __forceinline__ void indexer_tile(const Params& P, int tile, LAS unsigned char* lds) {
    const int tid = threadIdx.x, lane = tid & 63, wid = __builtin_amdgcn_readfirstlane(tid >> 6), l31 = lane & 31, hf = lane >> 5;
    LAS float* candS = (LAS float*)lds;
    LAS unsigned short* candI = (LAS unsigned short*)(lds + 65536);
    LAS unsigned char* kbuf = lds + 98304;
    const f16* IQ = (const f16*)(P.ws + WS_IQ); const f16* IK = (const f16*)(P.ws + WS_IK); const float* IW = (const float*)(P.ws + WS_IW);
    unsigned short* SEL = (unsigned short*)(P.ws + WS_SEL);
    const int t0 = tile * 32, tw = t0 + wid * 4;
    half8 afr[4];
    { const int qi = 2 * (l31 >> 4) + ((l31 >> 2) & 1), hd = 4 * ((l31 >> 3) & 1) + (l31 & 3); int tq = tw + qi; if (tq > L - 1) tq = L - 1;
      const half8* ap = (const half8*)(IQ + (size_t)tq * 512 + hd * 64);
#pragma unroll
      for (int s = 0; s < 4; ++s) afr[s] = ap[2 * s + hf]; }
    float w0[8], w1[8];
    { int ta = tw + hf, tb = tw + 2 + hf; if (ta > L - 1) ta = L - 1; if (tb > L - 1) tb = L - 1;
#pragma unroll
      for (int h = 0; h < 8; ++h) { w0[h] = IW[(size_t)ta * 8 + h]; w1[h] = IW[(size_t)tb * 8 + h]; } }
    const int tq0 = (tw + hf < L) ? tw + hf : -1, tq1 = (tw + 2 + hf < L) ? tw + 2 + hf : -1;
    float tau0 = -__builtin_inff(), tau1 = -__builtin_inff();
    int cntv = 0;
    const int nkeys = (t0 + 32 < L) ? t0 + 32 : L, nst = (nkeys + 127) >> 7;
    u32x4 stg[2];
    const u32x4* IKv = (const u32x4*)IK;
#pragma unroll
    for (int i = 0; i < 2; ++i) stg[i] = IKv[(size_t)0 * 1024 + tid + 512 * i];
#pragma unroll
    for (int i = 0; i < 2; ++i) { const int ci = tid + 512 * i, row = ci >> 3, ch = ci & 7; *(LAS u32x4*)(kbuf + row * 128 + ((ch ^ ((row >> 1) & 7)) << 4)) = stg[i]; }
    __syncthreads();
#pragma unroll 1
    for (int st = 0; st < nst; ++st) {
        LAS unsigned char* kb = kbuf + (st & 1) * 16384;
        if (st + 1 < nst) {
#pragma unroll
            for (int i = 0; i < 2; ++i) stg[i] = IKv[(size_t)(st + 1) * 1024 + tid + 512 * i];
        }
#pragma unroll 1
        for (int sub = 0; sub < 4; ++sub) {
            const int kbase = st * 128 + sub * 32;
            if (kbase > tw + 3) break;
            const int row = sub * 32 + l31;
            f32x16 acc;
#pragma unroll
            for (int i = 0; i < 16; ++i) acc[i] = 0.f;
#pragma unroll
            for (int s = 0; s < 4; ++s) { const half8 bfr = *(const LAS half8*)(kb + row * 128 + (((2 * s + hf) ^ ((row >> 1) & 7)) << 4)); acc = __builtin_amdgcn_mfma_f32_32x32x16_f16(afr[s], bfr, acc, 0, 0, 0); }
            float s0 = 0.f, s1 = 0.f;
#pragma unroll
            for (int h = 0; h < 8; ++h) { s0 += w0[h] * fmaxf(acc[h], 0.f); s1 += w1[h] * fmaxf(acc[8 + h], 0.f); }
            const int key = kbase + l31;
#pragma unroll
            for (int g = 0; g < 2; ++g) {
                const float sc = g ? s1 : s0; const bool ok = g ? (key <= tq1 && sc > tau1) : (key <= tq0 && sc > tau0);
                const unsigned long long m = __ballot(ok);
                if (m) { const unsigned lo = (unsigned)m, hi = (unsigned)(m >> 32);
                    const int clo = __builtin_amdgcn_readlane(cntv, 2 * g), chi = __builtin_amdgcn_readlane(cntv, 2 * g + 1);
                    const int pre = hf ? __builtin_amdgcn_mbcnt_hi(hi, 0u) : __builtin_amdgcn_mbcnt_lo(lo, 0u);
                    const int pos = (hf ? chi : clo) + pre, qs = wid * 4 + 2 * g + hf;
                    if (ok) { candS[qs * 512 + pos] = sc; candI[qs * 512 + pos] = (unsigned short)key; }
                    cntv = (lane == 2 * g) ? clo + __popc(lo) : cntv; cntv = (lane == 2 * g + 1) ? chi + __popc(hi) : cntv; }
            }
            const int mx = max(max(__builtin_amdgcn_readlane(cntv, 0), __builtin_amdgcn_readlane(cntv, 1)), max(__builtin_amdgcn_readlane(cntv, 2), __builtin_amdgcn_readlane(cntv, 3)));
            if (mx > 480) {
#pragma unroll 1
                for (int qq = 0; qq < 4; ++qq) { const int n = __builtin_amdgcn_readlane(cntv, qq);
                    if (n > 480) { float nt; const int nn = topk_compact(candS + (wid * 4 + qq) * 512, candI + (wid * 4 + qq) * 512, n, false, nt, lane);
                        cntv = (lane == qq) ? nn : cntv;
                        if (hf == (qq & 1)) { if (qq < 2) tau0 = nt; else tau1 = nt; } } }
            }
        }
        if (st + 1 < nst) {
            LAS unsigned char* kn = kbuf + ((st + 1) & 1) * 16384;
#pragma unroll
            for (int i = 0; i < 2; ++i) { const int ci = tid + 512 * i, row = ci >> 3, ch = ci & 7; *(LAS u32x4*)(kn + row * 128 + ((ch ^ ((row >> 1) & 7)) << 4)) = stg[i]; }
        }
        __syncthreads();
    }
#pragma unroll 1
    for (int qq = 0; qq < 4; ++qq) {
        const int t = tw + qq; if (t >= L) break;
        int n = __builtin_amdgcn_readlane(cntv, qq); LAS float* cs = candS + (wid * 4 + qq) * 512; LAS unsigned short* ci = candI + (wid * 4 + qq) * 512;
        if (n > 256) { float nt; n = topk_compact(cs, ci, n, true, nt, lane); }
#pragma unroll
        for (int j = 0; j < 4; ++j) { const int p = lane + 64 * j; SEL[(size_t)t * 256 + p] = p < n ? ci[p] : (unsigned short)0xffffu; }
    }
    __syncthreads();
}

__device__ __forceinline__ void sparse_attn(const Params& P, LAS unsigned char* lds) {
    const int tid = threadIdx.x, lane = tid & 63, wid = tid >> 6, grp = lane >> 3, ch = lane & 7;
    const int head = blockIdx.x & 7, slot = (blockIdx.x >> 3) * 8 + wid, nslot = (gridDim.x >> 3) * 8;
    LAS unsigned short* widx = (LAS unsigned short*)(lds + wid * 512);
    const unsigned short* SEL = (const unsigned short*)(P.ws + WS_SEL); const f16* DQ = (const f16*)(P.ws + WS_DQ);
    const unsigned char* kvh = P.ws + WS_KV + (size_t)head * LP * 256; f16* mix = (f16*)(P.ws + WS_ACTA);
    for (int t = NMETA + slot; t < L; t += nslot) {
        *(LAS u32x2*)(widx + lane * 4) = *(const u32x2*)(SEL + (size_t)t * 256 + lane * 4);
        const half8 qv = *(const half8*)(DQ + (size_t)t * 512 + head * 64 + ch * 8);
        float qf[8];
#pragma unroll
        for (int e = 0; e < 8; ++e) qf[e] = (float)qv[e];
        float lg[32]; float mx = -__builtin_inff();
#pragma unroll
        for (int it = 0; it < 32; ++it) {
            const unsigned key = widx[8 * it + grp]; const bool valid = key != 0xffffu; const unsigned kk = valid ? key : 0u;
            const half8 kv = *(const half8*)(kvh + (size_t)kk * 256 + ch * 16); float part = 0.f;
#pragma unroll
            for (int e = 0; e < 8; ++e) part += qf[e] * (float)kv[e];
            part += __shfl_xor(part, 1); part += __shfl_xor(part, 2); part += __shfl_xor(part, 4);
            lg[it] = valid ? part : -__builtin_inff(); mx = fmaxf(mx, lg[it]);
        }
        mx = fmaxf(mx, __shfl_xor(mx, 8)); mx = fmaxf(mx, __shfl_xor(mx, 16)); mx = fmaxf(mx, __shfl_xor(mx, 32));
        float o[8] = {0.f, 0.f, 0.f, 0.f, 0.f, 0.f, 0.f, 0.f}; float lsum = 0.f;
#pragma unroll
        for (int it = 0; it < 32; ++it) {
            const unsigned key = widx[8 * it + grp]; const unsigned kk = key != 0xffffu ? key : 0u;
            const half8 vv = *(const half8*)(kvh + (size_t)kk * 256 + 128 + ch * 16);
            const float p = __expf(lg[it] - mx); lsum += p;
#pragma unroll
            for (int e = 0; e < 8; ++e) o[e] += p * (float)vv[e];
        }
        lsum += __shfl_xor(lsum, 8); lsum += __shfl_xor(lsum, 16); lsum += __shfl_xor(lsum, 32);
#pragma unroll
        for (int e = 0; e < 8; ++e) { o[e] += __shfl_xor(o[e], 8); o[e] += __shfl_xor(o[e], 16); o[e] += __shfl_xor(o[e], 32); }
        if (grp == 0) { const float inv = 1.0f / lsum; half8 ov;
#pragma unroll
            for (int e = 0; e < 8; ++e) ov[e] = (f16)(o[e] * inv);
            *(half8*)(mix + (size_t)(t - NMETA) * D + 512 + head * 64 + ch * 8) = ov; }
    }
}

__device__ __forceinline__ void final_norm(const Params& P) {
    const int tid = threadIdx.x, lane = tid & 63, gw = blockIdx.x * 8 + (tid >> 6), nw = gridDim.x * 8;
    const float* ss3 = (const float*)(P.ws + WS_SS3);
    for (int r = gw; r < SEQ; r += nw) { const float rs = row_rstd(ss3, 16, r);
#pragma unroll
        for (int i = 0; i < 4; ++i) { const int k = lane * 4 + 256 * i; const f32x4 v = *(const f32x4*)(P.out + (size_t)r * D + k), g = *(const f32x4*)(P.nf + k); *(f32x4*)(P.out + (size_t)r * D + k) = v * rs * g; } }
}

__global__ void __launch_bounds__(NTHREADS, 2) fwd_kernel(Params P) {
    __shared__ __attribute__((aligned(16))) unsigned char lds_raw[LDS_BYTES];
    LAS unsigned char* lds = (LAS unsigned char*)lds_raw;
    const int tid = threadIdx.x, bid = blockIdx.x, G = gridDim.x;
    unsigned char* ws = P.ws;
    const int lo = P.ph_lo, hi = P.ph_hi;
#define IN(k) (lo <= (k) && (k) < hi)
#define SEAM(k) do { if (IN(k) && IN((k) + 1)) { cg::this_grid().sync(); } } while (0)
    f16* acta = (f16*)(ws + WS_ACTA); f16* Gb = (f16*)(ws + WS_G);
    float* ss0 = (float*)(ws + WS_SS0); float* ss1 = (float*)(ws + WS_SS1); float* ss2 = (float*)(ws + WS_SS2); float* ss3 = (float*)(ws + WS_SS3);
    if (IN(0)) { p0_prologue(P, lds); }
    SEAM(0);
    if (IN(1)) {
        pg8::Gemm g{acta, (const f16*)(ws + WS_WGU1), MP, 2 * DFF, D}; pg8::StaticOrder S; S.init(MP, 2 * DFF, G, bid);
        EpiSwiglu E{Gb, ss0, 1}; pg8::gemm_phase(lds, g, S, E);
    }
    SEAM(1);
    if (IN(2)) {
        meta_down(P, lds);
        pg8::Gemm g{Gb, (const f16*)(ws + WS_WD1), SEQ, D, DFF}; pg8::StaticOrder S; S.init(SEQ, D, G, bid);
        EpiResid E{P.x, P.out, acta, ss1, 0.5f}; pg8::gemm_phase(lds, g, S, E);
    }
    SEAM(2);
    if (IN(3)) {
        pg8::Gemm g{acta, (const f16*)(ws + WS_WIN), MP, NIN, D}; pg8::StaticOrder S; S.init(MP, NIN, G, bid);
        EpiInProj E{ss1, (const f32x2*)(ws + WS_ROPE), (f16*)(ws + WS_GQ), (f16*)(ws + WS_GK), (f16*)(ws + WS_GV), (f16*)(ws + WS_GR), (f16*)(ws + WS_DQ), (f16*)(ws + WS_KV),
                    (f16*)(ws + WS_IQ), (f16*)(ws + WS_IK), (float*)(ws + WS_GA), (float*)(ws + WS_IW)};
        pg8::gemm_phase(lds, g, S, E);
    }
    SEAM(3);
    if (IN(4)) { for (int u = bid; u < NCH * 4; u += G) gla_a_unit(P, u, lds); }
    SEAM(4);
    if (IN(5)) {
        if (bid < 64) gla_scan(P);
        unsigned* ctr = (unsigned*)(ws + WS_CTL); LAS int* bc = (LAS int*)(lds + 131072);
        for (;;) {
            if (tid == 0) bc[0] = (int)atomicAdd(ctr, 1u);
            __syncthreads();
            const int k = bc[0];
            __syncthreads();
            if (k >= 513) break;
            indexer_tile(P, 512 - k, lds);
        }
    }
    SEAM(5);
    if (IN(6)) { for (int u = bid; u < NCH * 4; u += G) gla_c_unit(P, u, lds); sparse_attn(P, lds); }
    SEAM(6);
    if (IN(7)) {
        pg8::Gemm g{acta, (const f16*)(ws + WS_WOUT), SEQ, D, D}; pg8::StaticOrder S; S.init(SEQ, D, G, bid);
        EpiResid E{P.out, P.out, (f16*)(ws + WS_US), ss2, 1.0f}; pg8::gemm_phase(lds, g, S, E);
    }
    SEAM(7);
    if (IN(8)) {
        pg8::Gemm g{(const f16*)(ws + WS_US), (const f16*)(ws + WS_WGU2), SEQ, 2 * DFF, D}; pg8::StaticOrder S; S.init(SEQ, 2 * DFF, G, bid);
        EpiSwiglu E{Gb, ss2, 16}; pg8::gemm_phase(lds, g, S, E);
    }
    SEAM(8);
    if (IN(9)) {
        pg8::Gemm g{Gb, (const f16*)(ws + WS_WD2), SEQ, D, DFF}; pg8::StaticOrder S; S.init(SEQ, D, G, bid);
        EpiResid E{P.out, P.out, nullptr, ss3, 0.5f}; pg8::gemm_phase(lds, g, S, E);
    }
    SEAM(9);
    if (IN(10)) final_norm(P);
#ifdef DBG_CUT
    if (IN(11)) {
        const size_t n = (size_t)SEQ * D; const size_t i0 = (size_t)bid * NTHREADS + tid, st = (size_t)G * NTHREADS;
#if DBG_CUT == 6
        const f16* m = (const f16*)(ws + WS_ACTA); for (size_t i = i0; i < n; i += st) P.out[i] = (float)m[i];
#elif DBG_CUT == 5
        const unsigned short* m = (const unsigned short*)(ws + WS_SEL); for (size_t i = i0; i < n; i += st) P.out[i] = (float)m[i % ((size_t)L * 256)];
#elif DBG_CUT == 3
        const f16* a = (const f16*)(ws + WS_DQ); const f16* b = (const f16*)(ws + WS_IQ); const f16* c = (const f16*)(ws + WS_KV); const f16* d = (const f16*)(ws + WS_GQ);
        for (size_t i = i0; i < n; i += st) P.out[i] = (float)a[i % ((size_t)L * 512)] + (float)b[i % ((size_t)L * 512)] + (float)c[i] + (float)d[i % ((size_t)L * 1536)];
#elif DBG_CUT == 4
        const float* m = (const float*)(ws + WS_US); for (size_t i = i0; i < n; i += st) P.out[i] = m[i % ((size_t)NCH * 32768)];
#endif
    }
#endif
#undef IN
#undef SEAM
}

extern "C" void kernel_launch(void* const* d_in, const int* in_sizes, int n_in, void* d_out, int out_size, void* d_ws, size_t ws_size, hipStream_t stream) {
    static int grid = 0;
    if (grid == 0) {
        if (n_in != 17 || in_sizes[0] != SEQ * D || out_size != SEQ * D || ws_size < WS_END) { fprintf(stderr, "kernel_launch: unexpected shapes (n_in %d, in0 %d, out %d, ws %zu, need %zu)\n", n_in, n_in > 0 ? in_sizes[0] : -1, out_size, ws_size, (size_t)WS_END); grid = -1; return; }
        int dev = 0, cus = 0, per_cu = 0;
        (void)hipGetDevice(&dev); (void)hipDeviceGetAttribute(&cus, hipDeviceAttributeMultiprocessorCount, dev);
        if (hipOccupancyMaxActiveBlocksPerMultiprocessor(&per_cu, (const void*)fwd_kernel, NTHREADS, 0) != hipSuccess || per_cu < 1) { fprintf(stderr, "kernel_launch: occupancy query says %d blocks per CU\n", per_cu); per_cu = 1; }
        (void)hipGetLastError();
        grid = cus;
        if (grid % 8 != 0 || grid < 64) { fprintf(stderr, "kernel_launch: unexpected CU count %d\n", cus); }
    }
    if (grid < 0) return;
    Params p{};
    const float** pp = (const float**)&p;
    for (int i = 0; i < 17; ++i) pp[i] = (const float*)d_in[i];
    p.out = (float*)d_out; p.ws = (unsigned char*)d_ws;
#if MODE == 0
#ifdef DBG_CUT
    for (int ph = 0; ph <= DBG_CUT; ++ph) { p.ph_lo = ph; p.ph_hi = ph + 1; hipLaunchKernelGGL(fwd_kernel, dim3(grid), dim3(NTHREADS), 0, stream, p); }
    if (DBG_CUT != 2 && DBG_CUT != 7 && DBG_CUT != 9) { p.ph_lo = 11; p.ph_hi = 12; hipLaunchKernelGGL(fwd_kernel, dim3(grid), dim3(NTHREADS), 0, stream, p); }
#else
    for (int ph = 0; ph < NPHASE; ++ph) { p.ph_lo = ph; p.ph_hi = ph + 1; hipLaunchKernelGGL(fwd_kernel, dim3(grid), dim3(NTHREADS), 0, stream, p); }
#endif
#else
    p.ph_lo = 0; p.ph_hi = NPHASE;
    void* args[] = {&p};
    hipError_t e = hipLaunchCooperativeKernel((const void*)fwd_kernel, dim3(grid), dim3(NTHREADS), args, 0, stream);
    if (e != hipSuccess) fprintf(stderr, "cooperative launch failed: %s (grid %d)\n", hipGetErrorString(e), grid);
#endif
}
```

```cpp
#include <hip/hip_runtime.h>
#include <hip/hip_cooperative_groups.h>
#include <cstdio>
#include <cstdint>
namespace cg = cooperative_groups;

#ifndef MODE
#define MODE 1
#ifndef REPEAT_PH
#define REPEAT_PH -1
#endif
#ifndef EXTRA_SYNCS
#define EXTRA_SYNCS 0
#endif
#endif

#define LAS __attribute__((address_space(3)))
typedef _Float16 f16;
typedef _Float16 half8 __attribute__((ext_vector_type(8)));
typedef _Float16 half4 __attribute__((ext_vector_type(4)));
typedef float f32x2 __attribute__((ext_vector_type(2)));
typedef float f32x4 __attribute__((ext_vector_type(4)));
typedef float f32x16 __attribute__((ext_vector_type(16)));
typedef unsigned u32x2 __attribute__((ext_vector_type(2)));
typedef unsigned u32x4 __attribute__((ext_vector_type(4)));

constexpr int D = 1024, SEQ = 16384, NMETA = 16, L = SEQ + NMETA, DFF = 2816;
constexpr int MP = 16640;
constexpr int LP = 16512;
constexpr int NIN = 3840;
constexpr int NCH = 257;
constexpr float EPS = 1e-6f;
constexpr int NTHREADS = 512;
constexpr int LDS_BYTES = 131072 + 1024;
constexpr int NPHASE = 11;

constexpr size_t al256(size_t x) { return (x + 255) & ~(size_t)255; }
constexpr size_t WS_CTL = 0;
constexpr size_t CTL_BYTES = 32768;
constexpr size_t WS_BAR = 2048;
constexpr size_t WS_WGU1 = CTL_BYTES;
constexpr size_t WS_WD1 = WS_WGU1 + (size_t)2 * DFF * D * 2;
constexpr size_t WS_WIN = WS_WD1 + (size_t)D * DFF * 2;
constexpr size_t WS_WOUT = WS_WIN + (size_t)NIN * D * 2;
constexpr size_t WS_WGU2 = WS_WOUT + (size_t)D * D * 2;
constexpr size_t WS_WD2 = WS_WGU2 + (size_t)2 * DFF * D * 2;
constexpr size_t WS_ACTA = WS_WD2 + (size_t)D * DFF * 2;
constexpr size_t WS_G = WS_ACTA + (size_t)MP * D * 2;
constexpr size_t WS_US = WS_G + (size_t)MP * DFF * 2;
constexpr size_t WS_DQ = WS_US + (size_t)NCH * 4 * 64 * 128 * 4;
constexpr size_t WS_IQ = WS_DQ + (size_t)LP * 512 * 2;
constexpr size_t WS_SEL = WS_IQ + (size_t)LP * 512 * 2;
constexpr size_t WS_ROPE = WS_SEL + (size_t)LP * 256 * 2;
constexpr size_t WS_IW = WS_ROPE + al256((size_t)L * 32 * 8);
constexpr size_t WS_GA = WS_IW + (size_t)LP * 8 * 4;
constexpr size_t WS_DECAY = WS_GA + (size_t)LP * 16 * 4;
constexpr size_t WS_SS0 = WS_DECAY + al256((size_t)NCH * 256 * 4);
constexpr size_t WS_SS1 = WS_SS0 + (size_t)MP * 4;
constexpr size_t WS_SS2 = WS_SS1 + (size_t)MP * 64;
constexpr size_t WS_SS3 = WS_SS2 + (size_t)MP * 64;
constexpr size_t WS_END = WS_SS3 + (size_t)MP * 64;
constexpr size_t WS_KV = WS_G;
constexpr size_t WS_GQ = WS_KV + (size_t)8 * LP * 128 * 2;
constexpr size_t WS_GK = WS_GQ + (size_t)LP * 256 * 2;
constexpr size_t WS_GV = WS_GK + (size_t)LP * 256 * 2;
constexpr size_t WS_GR = WS_GV + (size_t)LP * 512 * 2;
constexpr size_t WS_IK = WS_GR + (size_t)LP * 512 * 2;
constexpr size_t WS_ALIAS_END = WS_IK + (size_t)LP * 64 * 2;
static_assert(WS_ALIAS_END <= WS_US, "aliased buffers exceed G");
static_assert(WS_END <= (size_t)256 * 1024 * 1024, "workspace exceeds 256 MiB");
static_assert((size_t)SEQ * D * 2 <= (size_t)NCH * 4 * 64 * 128 * 4, "h2_16 alias");

struct Params {
    const float* x; const float* meta; const float* n1; const float* wg1; const float* wu1; const float* wd1;
    const float* nmix; const float* win; const float* wa2; const float* ba; const float* hn; const float* wout;
    const float* n2; const float* wg2; const float* wu2; const float* wd2; const float* nf;
    float* out; unsigned char* ws; int ph_lo, ph_hi;
};

namespace pg8 {
constexpr int BM = 256, BK = 64, HALF = 128, HTB = HALF * BK * 2, STAGE_BYTES = 8 * HTB, NXCD = 8, WGM = 8;
__host__ __device__ __forceinline__ int lds_byte(int r, int c) { const int st = (r >> 4) * 2 + (c >> 5), rr = r & 15, cc = c & 31, ob = rr * 64 + cc * 2; return st * 1024 + (ob ^ (((ob >> 9) & 1) << 5)); }
__host__ __device__ __forceinline__ void stage_rc(int b, int& R, int& C) { const int st = b / 1024, sb = b % 1024, swz = sb ^ (((sb >> 9) & 1) << 5); R = (st >> 1) * 16 + swz / 64; C = (st & 1) * 32 + (swz % 64) / 2; }
struct Unit { int pm, pn; };
struct Gemm { const f16* A; const f16* Bt; int M, N, K; };
struct StaticOrder {
    int nM, nN, nwg, G, c;
    __host__ __device__ void init(int M, int N, int G_, int c_) { nM = M / BM; nN = N / BM; nwg = nM * nN; G = G_; c = c_; }
    __host__ __device__ bool next(int i, Unit& u) const {
        const long Lx = (long)i * G + c; if (Lx >= nwg) return false;
        int wgid = (int)Lx; { const int q = nwg / NXCD, r = nwg % NXCD, xcd = wgid % NXCD, off = wgid / NXCD; wgid = (xcd < r ? xcd * (q + 1) : r * (q + 1) + (xcd - r) * q) + off; }
        const int nig = WGM * nN, gid = wgid / nig, fm = gid * WGM, gsz = (nM - fm) < WGM ? (nM - fm) : WGM;
        u.pm = fm + ((wgid % nig) % gsz); u.pn = (wgid % nig) / gsz; return true;
    }
};
template <class Epi>
__device__ __forceinline__ void gemm_phase(LAS unsigned char* lds, const Gemm g, const StaticOrder& S, const Epi& E) {
    int tid_ = threadIdx.x; asm volatile("" : "+v"(tid_));
    const int tid = tid_, wid = __builtin_amdgcn_readfirstlane(tid >> 6), lane = tid & 63, wr = wid >> 2, wc = wid & 3, fr = lane & 15, fq = lane >> 4;
    const int K = g.K, nt = K / BK;
    unsigned voffA[2], voffB[2];
#pragma unroll
    for (int i = 0; i < 2; ++i) { int R, C; stage_rc(tid * 16 + i * 8192, R, C); voffA[i] = (unsigned)(R * K + C) * 2u; voffB[i] = (unsigned)(R * K + C) * 2u; }
    const size_t kstep = (size_t)(BK * 2);
    const size_t hstep = (size_t)HALF * K * 2;
    const size_t tstep = 2 * hstep;
    const unsigned ldsw = (unsigned)wid * 1024u;
    const int aoff = lds_byte(wr * 64 + fr, fq * 8), boff = lds_byte(wc * 32 + fr, fq * 8);
#define PG8_SA(b, h) (((b) * 2 + (h)) * HTB)
#define PG8_SB(b, h) ((4 + (b) * 2 + (h)) * HTB)
#define PG8_STAGE(bufoff, gbase, voff) do { _Pragma("unroll") for (int _i = 0; _i < 2; ++_i) \
        __builtin_amdgcn_global_load_lds((const unsigned*)((const char*)(gbase) + (voff)[_i]), (LAS unsigned*)(lds + (bufoff) + ldsw + _i * 8192), 16, 0, 0); } while (0)
#define PG8_LDA(dst, b, h) do { _Pragma("unroll") for (int m = 0; m < 4; ++m) _Pragma("unroll") for (int k = 0; k < 2; ++k) dst[m][k] = *(const LAS half8*)(lds + PG8_SA(b, h) + aoff + m * 2048 + k * 1024); } while (0)
#define PG8_LDB(dst, b, h) do { _Pragma("unroll") for (int n = 0; n < 2; ++n) _Pragma("unroll") for (int k = 0; k < 2; ++k) dst[n][k] = *(const LAS half8*)(lds + PG8_SB(b, h) + boff + n * 2048 + k * 1024); } while (0)
#define PG8_MMA(ai, bj, At, Bt) do { __builtin_amdgcn_s_setprio(1); _Pragma("unroll") for (int m = 0; m < 4; ++m) _Pragma("unroll") for (int n = 0; n < 2; ++n) _Pragma("unroll") for (int k = 0; k < 2; ++k) \
        acc[ai][bj][m][n] = __builtin_amdgcn_mfma_f32_16x16x32_f16(Bt[n][k], At[m][k], acc[ai][bj][m][n], 0, 0, 0); __builtin_amdgcn_s_setprio(0); } while (0)
#define PG8_WAIT_V(n) asm volatile("s_waitcnt vmcnt(" #n ")" ::: "memory")
#define PG8_WAIT_L(n) asm volatile("s_waitcnt lgkmcnt(" #n ")" ::: "memory")
#define PG8_BAR __builtin_amdgcn_s_barrier()
#define PG8_SCHED __builtin_amdgcn_sched_barrier(0)
    Unit cur, nxt; int ui = 0;
    if (!S.next(0, cur)) return;
    f32x4 acc[2][2][4][2];
#pragma unroll
    for (int a = 0; a < 2; ++a)
#pragma unroll
        for (int b = 0; b < 2; ++b)
#pragma unroll
            for (int m = 0; m < 4; ++m)
#pragma unroll
                for (int n = 0; n < 2; ++n) acc[a][b][m][n] = (f32x4){0.f, 0.f, 0.f, 0.f};
    half8 At[4][2], B0[2][2], B1[2][2];
    const char* cA = (const char*)g.A + (size_t)cur.pm * tstep; const char* cB = (const char*)g.Bt + (size_t)cur.pn * tstep;
    PG8_STAGE(PG8_SB(0, 0), cB, voffB); PG8_STAGE(PG8_SA(0, 0), cA, voffA); PG8_STAGE(PG8_SB(0, 1), cB + hstep, voffB); PG8_STAGE(PG8_SA(0, 1), cA + hstep, voffA);
    if (wr == 1) PG8_BAR;
    PG8_WAIT_V(4); PG8_BAR;
    PG8_STAGE(PG8_SB(1, 0), cB + kstep, voffB); PG8_STAGE(PG8_SA(1, 0), cA + kstep, voffA); PG8_STAGE(PG8_SB(1, 1), cB + hstep + kstep, voffB);
    PG8_WAIT_V(6); PG8_BAR;
    for (;;) {
        const bool has_next = S.next(ui + 1, nxt);
        const char* nA = has_next ? (const char*)g.A + (size_t)nxt.pm * tstep : cA; const char* nB = has_next ? (const char*)g.Bt + (size_t)nxt.pn * tstep : cB;
        for (int t = 0; t < nt; t += 2) {
            const bool last = (t == nt - 2);
            const char* a1 = cA + (size_t)(t + 1) * kstep;
            const char* a2 = last ? nA : cA + (size_t)(t + 2) * kstep; const char* b2 = last ? nB : cB + (size_t)(t + 2) * kstep;
            const char* a3 = a2 + kstep; const char* b3 = b2 + kstep;
            PG8_LDB(B0, 0, 0); PG8_SCHED; PG8_LDA(At, 0, 0); PG8_STAGE(PG8_SA(1, 1), a1 + hstep, voffA);
            PG8_WAIT_L(8); PG8_BAR; PG8_WAIT_L(0); PG8_MMA(0, 0, At, B0); PG8_BAR; PG8_SCHED;
            PG8_LDB(B1, 0, 1); PG8_STAGE(PG8_SB(0, 0), b2, voffB);
            PG8_BAR; PG8_WAIT_L(0); PG8_MMA(0, 1, At, B1); PG8_BAR;
            PG8_LDA(At, 0, 1); PG8_STAGE(PG8_SA(0, 0), a2, voffA);
            PG8_BAR; PG8_WAIT_L(0); PG8_MMA(1, 0, At, B0); PG8_BAR; PG8_SCHED;
            PG8_STAGE(PG8_SB(0, 1), b2 + hstep, voffB);
            PG8_WAIT_V(6); PG8_BAR; PG8_MMA(1, 1, At, B1); PG8_BAR;
            PG8_LDB(B0, 1, 0); PG8_SCHED; PG8_LDA(At, 1, 0); PG8_STAGE(PG8_SA(0, 1), a2 + hstep, voffA);
            PG8_WAIT_L(8); PG8_BAR; PG8_WAIT_L(0); PG8_MMA(0, 0, At, B0); PG8_BAR; PG8_SCHED;
            PG8_LDB(B1, 1, 1); PG8_STAGE(PG8_SB(1, 0), b3, voffB);
            PG8_BAR; PG8_WAIT_L(0); PG8_MMA(0, 1, At, B1); PG8_BAR;
            PG8_LDA(At, 1, 1); PG8_STAGE(PG8_SA(1, 0), a3, voffA);
            PG8_BAR; PG8_WAIT_L(0); PG8_MMA(1, 0, At, B0); PG8_BAR; PG8_SCHED;
            PG8_STAGE(PG8_SB(1, 1), b3 + hstep, voffB);
            PG8_WAIT_V(6); PG8_BAR; PG8_MMA(1, 1, At, B1); PG8_BAR;
        }
        E(acc, cur, wr, wc, fr, fq);
        if (!has_next) break;
#pragma unroll
        for (int a = 0; a < 2; ++a)
#pragma unroll
            for (int b = 0; b < 2; ++b)
#pragma unroll
                for (int m = 0; m < 4; ++m)
#pragma unroll
                    for (int n = 0; n < 2; ++n) acc[a][b][m][n] = (f32x4){0.f, 0.f, 0.f, 0.f};
        cur = nxt; cA = nA; cB = nB; ++ui;
    }
    PG8_WAIT_V(0);
    if (wr == 0) PG8_BAR;
    PG8_BAR;
#undef PG8_SA
#undef PG8_SB
#undef PG8_STAGE
#undef PG8_LDA
#undef PG8_LDB
#undef PG8_MMA
#undef PG8_WAIT_V
#undef PG8_WAIT_L
#undef PG8_BAR
#undef PG8_SCHED
}
}

__device__ __forceinline__ float silu_f(float v) { return v / (1.0f + __expf(-v)); }
__device__ __forceinline__ half4 to_half4(f32x4 v) { half4 h; h[0] = (f16)v[0]; h[1] = (f16)v[1]; h[2] = (f16)v[2]; h[3] = (f16)v[3]; return h; }

__device__ __forceinline__ float row_rstd(const float* ss, int np, int row) {
    float s;
    if (np == 1) s = ss[row];
    else { const f32x4* p = (const f32x4*)(ss + (size_t)row * 16); const f32x4 a = p[0], b = p[1], c = p[2], d = p[3];
        s = (((a[0] + a[1]) + (a[2] + a[3])) + ((b[0] + b[1]) + (b[2] + b[3]))) + (((c[0] + c[1]) + (c[2] + c[3])) + ((d[0] + d[1]) + (d[2] + d[3]))); }
    return rsqrtf(s * (1.0f / D) + EPS);
}
struct EpiSwiglu {
    f16* G; const float* ss; int np;
    __device__ __forceinline__ void operator()(const f32x4 (&acc)[2][2][4][2], const pg8::Unit& u, int wr, int wc, int fr, int fq) const {
#pragma unroll
        for (int ai = 0; ai < 2; ++ai)
#pragma unroll
            for (int m = 0; m < 4; ++m) {
                const int row = u.pm * 256 + ai * 128 + wr * 64 + m * 16 + fr;
                const float rs = row_rstd(ss, np, row);
#pragma unroll
                for (int n = 0; n < 2; ++n) {
                    const f32x4 gt = acc[ai][0][m][n] * rs, up = acc[ai][1][m][n] * rs; f32x4 o;
#pragma unroll
                    for (int j = 0; j < 4; ++j) o[j] = silu_f(gt[j]) * up[j];
                    *(half4*)(G + (size_t)row * DFF + u.pn * 128 + wc * 32 + n * 16 + 4 * fq) = to_half4(o);
                }
            }
    }
};
struct EpiResid {
    const float* src; float* out; f16* h16; float* ss; float alpha;
    __device__ __forceinline__ void operator()(const f32x4 (&acc)[2][2][4][2], const pg8::Unit& u, int wr, int wc, int fr, int fq) const {
#pragma unroll
        for (int ai = 0; ai < 2; ++ai)
#pragma unroll
            for (int m = 0; m < 4; ++m) {
                const int row = u.pm * 256 + ai * 128 + wr * 64 + m * 16 + fr; float part = 0.f;
#pragma unroll
                for (int bj = 0; bj < 2; ++bj)
#pragma unroll
                    for (int n = 0; n < 2; ++n) {
                        const size_t off = (size_t)row * D + u.pn * 256 + bj * 128 + wc * 32 + n * 16 + 4 * fq;
                        const f32x4 s = *(const f32x4*)(src + off); const f32x4 o = s + alpha * acc[ai][bj][m][n];
                        *(f32x4*)(out + off) = o; if (h16) *(half4*)(h16 + off) = to_half4(o);
                        part += (o[0] * o[0] + o[1] * o[1]) + (o[2] * o[2] + o[3] * o[3]);
                    }
                part += __shfl_xor(part, 16); part += __shfl_xor(part, 32);
                if (fq == 0) ss[(size_t)row * 16 + u.pn * 4 + wc] = part;
            }
    }
};
struct EpiInProj {
    const float* ss; const f32x2* rope; unsigned char* ws;
    __device__ __forceinline__ void operator()(const f32x4 (&acc)[2][2][4][2], const pg8::Unit& u, int wr, int wc, int fr, int fq) const {
        const int pn = u.pn;
        int mode = 0, stride = 256, bjs = 128; float scale = 1.0f; f16* lanebase;
        if (pn == 0) lanebase = (f16*)(ws + WS_GQ) + wc * 32 + 4 * fq;
        else if (pn == 1) lanebase = (f16*)(ws + WS_GK) + wc * 32 + 4 * fq;
        else if (pn <= 3) { lanebase = (f16*)(ws + WS_GV) + (pn - 2) * 256 + wc * 32 + 4 * fq; stride = 512; }
        else if (pn <= 5) { lanebase = (f16*)(ws + WS_GR) + (pn - 4) * 256 + wc * 32 + 4 * fq; stride = 512; }
        else if (pn <= 7) { lanebase = (f16*)(ws + WS_DQ) + (pn - 6) * 256 + wc * 64 + 4 * fq; stride = 512; mode = 1; scale = 0.125f; }
        else if (pn <= 9) { lanebase = (f16*)(ws + WS_KV) + (size_t)((pn - 8) * 4 + wc) * LP * 128 + 4 * fq; stride = 128; mode = 1; }
        else if (pn <= 11) { lanebase = (f16*)(ws + WS_KV) + (size_t)((pn - 10) * 4 + (wc >> 1)) * LP * 128 + 64 + (wc & 1) * 32 + 4 * fq; stride = 128; bjs = 2 * LP * 128; }
        else if (pn <= 13) { lanebase = (f16*)(ws + WS_IQ) + (pn - 12) * 256 + wc * 64 + 4 * fq; stride = 512; mode = 1; scale = 0.125f; }
        else { lanebase = (f16*)(ws + WS_IK) + 4 * fq; stride = 64; mode = wc == 0 ? 1 : (wc == 1 ? 2 : 3); }
#pragma unroll
        for (int ai = 0; ai < 2; ++ai)
#pragma unroll
            for (int m = 0; m < 4; ++m) {
                const int p = u.pm * 256 + ai * 128 + wr * 64 + m * 16 + fr;
                const int t = p < SEQ ? p + NMETA : p - SEQ;
                if (p < L && mode != 3) {
                    const float rs = row_rstd(ss, 16, p);
                    if (mode == 1) {
                        const float sc = rs * scale;
#pragma unroll
                        for (int n = 0; n < 2; ++n) {
                            const int dd = 16 * n + 4 * fq;
                            const f32x4 x1 = acc[ai][0][m][n], x2 = acc[ai][1][m][n]; f32x4 o1, o2;
                            const f32x4 cs0 = *(const f32x4*)(rope + (size_t)t * 32 + dd), cs1 = *(const f32x4*)(rope + (size_t)t * 32 + dd + 2);
                            o1[0] = (x1[0] * cs0[0] - x2[0] * cs0[1]) * sc; o2[0] = (x2[0] * cs0[0] + x1[0] * cs0[1]) * sc;
                            o1[1] = (x1[1] * cs0[2] - x2[1] * cs0[3]) * sc; o2[1] = (x2[1] * cs0[2] + x1[1] * cs0[3]) * sc;
                            o1[2] = (x1[2] * cs1[0] - x2[2] * cs1[1]) * sc; o2[2] = (x2[2] * cs1[0] + x1[2] * cs1[1]) * sc;
                            o1[3] = (x1[3] * cs1[2] - x2[3] * cs1[3]) * sc; o2[3] = (x2[3] * cs1[2] + x1[3] * cs1[3]) * sc;
                            f16* dst = lanebase + (size_t)t * stride + n * 16;
                            *(half4*)dst = to_half4(o1); *(half4*)(dst + 32) = to_half4(o2);
                        }
                    } else if (mode == 2) {
                        const f32x4 a0 = acc[ai][0][m][0] * rs; *(f32x4*)((float*)(ws + WS_GA) + (size_t)t * 16 + 4 * fq) = a0;
                        if (fq < 2) { const f32x4 a1 = acc[ai][0][m][1] * (rs * 0.35355339059327373f); *(f32x4*)((float*)(ws + WS_IW) + (size_t)t * 8 + 4 * fq) = a1; }
                    } else {
#pragma unroll
                        for (int bj = 0; bj < 2; ++bj)
#pragma unroll
                            for (int n = 0; n < 2; ++n) *(half4*)(lanebase + (size_t)t * stride + (size_t)bj * bjs + n * 16) = to_half4(acc[ai][bj][m][n] * rs);
                    }
                }
                asm volatile("" ::: "memory");
            }
    }
};

__device__ __forceinline__ const float* w_src(const Params& P, int kind, int n, int& ld, const float*& gain) {
    switch (kind) {
    case 0: case 4: { const int pn = n >> 8, bj = (n >> 7) & 1, cc = n & 127; ld = DFF; gain = kind == 0 ? P.n1 : P.n2;
        const float* w = kind == 0 ? (bj ? P.wu1 : P.wg1) : (bj ? P.wu2 : P.wg2); return w + pn * 128 + cc; }
    case 1: ld = D; gain = nullptr; return P.wd1 + n;
    case 5: ld = D; gain = nullptr; return P.wd2 + n;
    case 3: ld = D; gain = nullptr; return P.wout + n;
    default: { ld = 3672; gain = P.nmix; const int pn = n >> 8, c = n & 255, bj = c >> 7, hh = (c >> 5) & 3, dd = c & 31; int j;
        if (pn == 0) j = c; else if (pn == 1) j = 256 + c; else if (pn <= 3) j = 512 + (pn - 2) * 256 + c; else if (pn <= 5) j = 1024 + (pn - 4) * 256 + c;
        else if (pn <= 7) j = 1552 + (pn - 6) * 256 + hh * 64 + bj * 32 + dd;
        else if (pn <= 9) j = 2064 + (pn - 8) * 256 + hh * 64 + bj * 32 + dd;
        else if (pn <= 11) j = 2576 + (pn - 10) * 256 + c;
        else if (pn <= 13) j = 3088 + (pn - 12) * 256 + hh * 64 + bj * 32 + dd;
        else { if (c < 32) j = 3600 + c; else if (c < 48) j = 1536 + (c - 32); else if (c < 56) j = 3664 + (c - 48); else if (c >= 128 && c < 160) j = 3600 + 32 + (c - 128); else j = -1; }
        return j < 0 ? nullptr : P.win + j; }
    }
}
__device__ __forceinline__ void prep_weight(const Params& P, const int kind, const int N, const int K, f16* dst, int& cursor, int& tbase, LAS f16* tl) {
    const int tid = threadIdx.x, G = gridDim.x, tn = N / 64, tk = K / 64, ntile = tn * tk;
#pragma unroll 1
    for (; cursor < tbase + ntile; cursor += G) {
        const int tI = cursor - tbase, n0 = (tI % tn) * 64, k0 = (tI / tn) * 64;
        { const int n = tid & 63, kk0 = tid >> 6; int ld; const float* gain; const float* col = w_src(P, kind, n0 + n, ld, gain);
#pragma unroll
          for (int i = 0; i < 8; ++i) { const int k = k0 + kk0 + 8 * i; float v = 0.f; if (col) { v = col[(size_t)k * ld]; if (gain) v *= gain[k]; } tl[n * 72 + kk0 + 8 * i] = (f16)v; } }
        __syncthreads();
        { const int n = tid >> 3, seg = tid & 7; *(half8*)(dst + (size_t)(n0 + n) * K + k0 + seg * 8) = *(const LAS half8*)(tl + n * 72 + seg * 8); }
        __syncthreads();
    }
    tbase += ntile;
}
__device__ __forceinline__ void p0_prologue(const Params& P, LAS unsigned char* lds) {
    const int tid = threadIdx.x, bid = blockIdx.x, G = gridDim.x, lane = tid & 63;
    unsigned char* ws = P.ws;
    int tbase = 0, cursor = bid;
    LAS f16* tl = (LAS f16*)lds;
    prep_weight(P, 0, 2 * DFF, D, (f16*)(ws + WS_WGU1), cursor, tbase, tl);
    prep_weight(P, 1, D, DFF, (f16*)(ws + WS_WD1), cursor, tbase, tl);
    prep_weight(P, 2, NIN, D, (f16*)(ws + WS_WIN), cursor, tbase, tl);
    prep_weight(P, 3, D, D, (f16*)(ws + WS_WOUT), cursor, tbase, tl);
    prep_weight(P, 4, 2 * DFF, D, (f16*)(ws + WS_WGU2), cursor, tbase, tl);
    prep_weight(P, 5, D, DFF, (f16*)(ws + WS_WD2), cursor, tbase, tl);
    float* ss0 = (float*)(ws + WS_SS0);
    f16* acta = (f16*)(ws + WS_ACTA);
    const int gw = bid * 8 + (tid >> 6), nw = G * 8;
    for (int p = gw; p < L; p += nw) {
        const float* src = p < SEQ ? P.x + (size_t)p * D : P.meta + (size_t)(p - SEQ) * D; float s = 0.f;
#pragma unroll
        for (int i = 0; i < 4; ++i) { const f32x4 v = *(const f32x4*)(src + lane * 4 + 256 * i); s += (v[0] * v[0] + v[1] * v[1]) + (v[2] * v[2] + v[3] * v[3]); *(half4*)(acta + (size_t)p * D + lane * 4 + 256 * i) = to_half4(v); }
#pragma unroll
        for (int o = 32; o >= 1; o >>= 1) s += __shfl_xor(s, o);
        if (lane == 0) ss0[p] = s;
    }
    const int gt = bid * NTHREADS + tid, ngt = G * NTHREADS;
    for (int i = gt; i < MP; i += ngt) { if (i >= L) ss0[i] = (float)D; }
    f32x2* rope = (f32x2*)(ws + WS_ROPE);
    for (int i = gt; i < L * 32; i += ngt) { const int t = i >> 5, f = i & 31; const double inv = exp(-(double)f * (9.210340371976184 / 32.0)); double sn, cs; sincos((double)t * inv, &sn, &cs); rope[i] = (f32x2){(float)cs, (float)sn}; }
}

__device__ __forceinline__ void meta_down(const Params& P, LAS unsigned char* lds) {
    const int tid = threadIdx.x, lane = tid & 63, wid = tid >> 6;
    const f16* Gm = (const f16*)(P.ws + WS_G) + (size_t)SEQ * DFF; const f16* Wt = (const f16*)(P.ws + WS_WD1);
    f16* acta = (f16*)(P.ws + WS_ACTA); float* ss1 = (float*)(P.ws + WS_SS1); LAS float* slot = (LAS float*)lds;
    for (int task = blockIdx.x; task < NMETA * 16; task += gridDim.x) {
        const int r = task >> 4, cg = task & 15; float part = 0.f;
#pragma unroll 1
        for (int q = 0; q < 2; ++q) {
            const int n0 = cg * 64 + (2 * wid + q) * 4; float a[4] = {0.f, 0.f, 0.f, 0.f};
            for (int kc = lane; kc < DFF / 8; kc += 64) {
                const half8 gv = *(const half8*)(Gm + (size_t)r * DFF + kc * 8);
#pragma unroll
                for (int j = 0; j < 4; ++j) { const half8 wv = *(const half8*)(Wt + (size_t)(n0 + j) * DFF + kc * 8);
#pragma unroll
                    for (int e = 0; e < 8; ++e) a[j] += (float)gv[e] * (float)wv[e]; }
            }
#pragma unroll
            for (int o = 32; o >= 1; o >>= 1) { a[0] += __shfl_xor(a[0], o); a[1] += __shfl_xor(a[1], o); a[2] += __shfl_xor(a[2], o); a[3] += __shfl_xor(a[3], o); }
            f32x4 o;
#pragma unroll
            for (int j = 0; j < 4; ++j) { o[j] = P.meta[r * D + n0 + j] + 0.5f * a[j]; part += o[j] * o[j]; }
            if (lane == 0) *(half4*)(acta + (size_t)(SEQ + r) * D + n0) = to_half4(o);
        }
        if (lane == 0) slot[wid] = part;
        __syncthreads();
        if (tid == 0) { float s = 0.f; for (int w = 0; w < 8; ++w) s += slot[w]; ss1[(size_t)(SEQ + r) * 16 + cg] = s; }
        __syncthreads();
    }
}

__device__ __forceinline__ float logsigmoid_f(float z) { return fminf(z, 0.f) - log1pf(expf(-fabsf(z))); }
__device__ __forceinline__ void gla_gates(const Params& P, int c, int h, LAS float* bl) {
    const int tid = threadIdx.x; const float* GA = (const float*)(P.ws + WS_GA);
    for (int e = tid; e < 4096; e += NTHREADS) {
        const int i = e >> 6, d = e & 63, t = 64 * c - 48 + i; float g = 0.f;
        if (t >= 0 && t < L) { float z = P.ba[64 * h + d]; const float* a = GA + (size_t)t * 16;
#pragma unroll
            for (int r = 0; r < 16; ++r) z += a[r] * P.wa2[r * 256 + 64 * h + d];
            g = logsigmoid_f(z) * (1.0f / 16.0f); }
        bl[i * 65 + d] = g;
    }
    __syncthreads();
    if (tid < 64) { float run = 0.f; for (int i = 0; i < 64; ++i) { run += bl[i * 65 + tid]; bl[i * 65 + tid] = run; } }
    __syncthreads();
}
__device__ __forceinline__ void gla_a_unit(const Params& P, int unit, LAS unsigned char* lds) {
    int tid_ = threadIdx.x; asm volatile("" : "+v"(tid_));
    const int tid = tid_, lane = tid & 63, wid = tid >> 6, c = unit >> 2, h = unit & 3;
    LAS float* bl = (LAS float*)lds; LAS float* ks = bl + 4160; LAS float* vs = ks + 4096;
    const f16* GK = (const f16*)(P.ws + WS_GK); const f16* GV = (const f16*)(P.ws + WS_GV);
    float* U = (float*)(P.ws + WS_US); float* DEC = (float*)(P.ws + WS_DECAY);
    gla_gates(P, c, h, bl);
    for (int e = tid; e < 4096; e += NTHREADS) { const int j = e >> 6, d = e & 63, t = 64 * c - 48 + j; float v = 0.f;
        if (t >= 0 && t < L) v = (float)GK[(size_t)t * 256 + 64 * h + d] * __expf(bl[63 * 65 + d] - bl[j * 65 + d]); ks[j * 64 + d] = v; }
    for (int e = tid; e < 8192; e += NTHREADS) { const int j = e >> 7, x = e & 127, t = 64 * c - 48 + j; vs[j * 128 + x] = (t >= 0 && t < L) ? (float)GV[(size_t)t * 512 + 128 * h + x] : 0.f; }
    if (tid < 64) DEC[(size_t)c * 256 + h * 64 + tid] = __expf(bl[63 * 65 + tid]);
    __syncthreads();
    { const int d0 = (wid >> 2) * 32, e0 = (wid & 3) * 32, l31 = lane & 31, hf = lane >> 5; f32x16 acc;
#pragma unroll
      for (int i = 0; i < 16; ++i) acc[i] = 0.f;
#pragma unroll 8
      for (int s = 0; s < 32; ++s) acc = __builtin_amdgcn_mfma_f32_32x32x2f32(ks[(2 * s + hf) * 64 + d0 + l31], vs[(2 * s + hf) * 128 + e0 + l31], acc, 0, 0, 0);
      float* up = U + ((size_t)unit * 64) * 128;
#pragma unroll
      for (int r = 0; r < 16; ++r) { const int row = (r & 3) + 8 * (r >> 2) + 4 * hf; up[(size_t)(d0 + row) * 128 + e0 + l31] = acc[r]; } }
    __syncthreads();
}
__device__ __forceinline__ void gla_scan(const Params& P) {
    float* U = (float*)(P.ws + WS_US); const float* DEC = (const float*)(P.ws + WS_DECAY);
    const int idx = blockIdx.x * NTHREADS + threadIdx.x;
    if (idx >= 32768) return;
    float s = 0.f;
#pragma unroll 8
    for (int c = 0; c < NCH; ++c) { const float u = U[(size_t)c * 32768 + idx], dc = DEC[(size_t)c * 256 + (idx >> 7)]; U[(size_t)c * 32768 + idx] = s; s = dc * s + u; }
}
__device__ __forceinline__ void gla_c_unit(const Params& P, int unit, LAS unsigned char* lds) {
    int tid_ = threadIdx.x; asm volatile("" : "+v"(tid_));
    const int tid = tid_, lane = tid & 63, wid = tid >> 6, c = unit >> 2, h = unit & 3, l31 = lane & 31, hf = lane >> 5;
    LAS float* bl = (LAS float*)lds; LAS float* kk = bl + 4160; LAS float* qs = kk + 4160; LAS float* As = qs + 4160; LAS float* vs = As + 4160; LAS float* os = bl;
    const f16* GQ = (const f16*)(P.ws + WS_GQ); const f16* GK = (const f16*)(P.ws + WS_GK); const f16* GV = (const f16*)(P.ws + WS_GV); const f16* GR = (const f16*)(P.ws + WS_GR);
    const float* Sg = (const float*)(P.ws + WS_US) + (size_t)unit * 8192; f16* mix = (f16*)(P.ws + WS_ACTA);
    gla_gates(P, c, h, bl);
    for (int e = tid; e < 4096; e += NTHREADS) { const int i = e >> 6, d = e & 63, t = 64 * c - 48 + i; float q = 0.f, k = 0.f;
        if (t >= 0 && t < L) { const float b = bl[i * 65 + d]; q = (float)GQ[(size_t)t * 256 + 64 * h + d] * 0.125f * __expf(b); k = (float)GK[(size_t)t * 256 + 64 * h + d] * __expf(-b); }
        qs[i * 65 + d] = q; kk[i * 65 + d] = k; }
    for (int e = tid; e < 8192; e += NTHREADS) { const int j = e >> 7, x = e & 127, t = 64 * c - 48 + j; vs[j * 128 + x] = (t >= 0 && t < L) ? (float)GV[(size_t)t * 512 + 128 * h + x] : 0.f; }
    __syncthreads();
    if (wid < 4) { const int i0 = (wid >> 1) * 32, j0 = (wid & 1) * 32; f32x16 acc;
#pragma unroll
        for (int i = 0; i < 16; ++i) acc[i] = 0.f;
#pragma unroll 8
        for (int s = 0; s < 32; ++s) acc = __builtin_amdgcn_mfma_f32_32x32x2f32(qs[(i0 + l31) * 65 + 2 * s + hf], kk[(j0 + l31) * 65 + 2 * s + hf], acc, 0, 0, 0);
#pragma unroll
        for (int r = 0; r < 16; ++r) { const int i = i0 + (r & 3) + 8 * (r >> 2) + 4 * hf, j = j0 + l31; As[i * 65 + j] = (j <= i) ? acc[r] : 0.f; } }
    __syncthreads();
    { const int i0 = (wid >> 2) * 32, e0 = (wid & 3) * 32; f32x16 acc;
#pragma unroll
      for (int i = 0; i < 16; ++i) acc[i] = 0.f;
#pragma unroll 8
      for (int s = 0; s < 32; ++s) acc = __builtin_amdgcn_mfma_f32_32x32x2f32(qs[(i0 + l31) * 65 + 2 * s + hf], Sg[(size_t)(2 * s + hf) * 128 + e0 + l31], acc, 0, 0, 0);
#pragma unroll 8
      for (int s = 0; s < 32; ++s) acc = __builtin_amdgcn_mfma_f32_32x32x2f32(As[(i0 + l31) * 65 + 2 * s + hf], vs[(2 * s + hf) * 128 + e0 + l31], acc, 0, 0, 0);
#pragma unroll
      for (int r = 0; r < 16; ++r) { const int i = i0 + (r & 3) + 8 * (r >> 2) + 4 * hf; os[i * 129 + e0 + l31] = acc[r]; } }
    __syncthreads();
    { const int i = tid >> 3, e0 = (tid & 7) * 16, t = 64 * c - 48 + i; float o[16], s = 0.f;
#pragma unroll
      for (int j = 0; j < 16; ++j) { o[j] = os[i * 129 + e0 + j]; s += o[j] * o[j]; }
      s += __shfl_xor(s, 1); s += __shfl_xor(s, 2); s += __shfl_xor(s, 4);
      const float rs = rsqrtf(s * (1.0f / 128.0f) + EPS);
      if (t >= NMETA && t < L) {
#pragma unroll
          for (int j4 = 0; j4 < 4; ++j4) { f32x4 v;
#pragma unroll
              for (int j = 0; j < 4; ++j) { const int e = e0 + 4 * j4 + j; v[j] = o[4 * j4 + j] * rs * P.hn[e] * silu_f((float)GR[(size_t)t * 512 + 128 * h + e]); }
              *(half4*)(mix + (size_t)(t - NMETA) * D + 128 * h + e0 + 4 * j4) = to_half4(v); } } }
    __syncthreads();
}

__device__ __forceinline__ unsigned mono_u(float f) { const unsigned u = __float_as_uint(f); return (u & 0x80000000u) ? ~u : (u | 0x80000000u); }
__device__ __forceinline__ float unmono_f(unsigned m) { return __uint_as_float((m & 0x80000000u) ? (m & 0x7fffffffu) : ~m); }
__device__ __forceinline__ int topk_compact(LAS float* cs, LAS unsigned short* ci, int n, bool exact, float& tau_out, int lane) {
    float sv[8]; unsigned iv[8], u[8];
#pragma unroll
    for (int i = 0; i < 8; ++i) { const int p = lane + 64 * i; const bool v = p < n; sv[i] = v ? cs[p] : 0.f; iv[i] = v ? (unsigned)ci[p] : 0xffffu; u[i] = v ? mono_u(sv[i]) : 0u; }
    unsigned T = 0u; bool full = true;
#pragma unroll 1
    for (int bit = 31; bit >= 0; --bit) {
        const unsigned cand = T | (1u << bit); int cgt = 0;
#pragma unroll
        for (int i = 0; i < 8; ++i) cgt += __popcll(__ballot(u[i] >= cand));
        if (cgt >= 256) { T = cand; if (!exact && cgt <= 320) { full = false; break; } }
    }
    bool keep[8];
    if (full) {
        int cgt = 0;
#pragma unroll
        for (int i = 0; i < 8; ++i) cgt += __popcll(__ballot(u[i] > T));
        const int need = 256 - cgt; unsigned I = 0u;
#pragma unroll 1
        for (int bit = 15; bit >= 0; --bit) { const unsigned cand = I | (1u << bit); int cl = 0;
#pragma unroll
            for (int i = 0; i < 8; ++i) cl += __popcll(__ballot(u[i] == T && iv[i] < cand));
            if (cl < need) I = cand; }
#pragma unroll
        for (int i = 0; i < 8; ++i) keep[i] = (u[i] > T) || (u[i] == T && iv[i] <= I);
    } else {
#pragma unroll
        for (int i = 0; i < 8; ++i) keep[i] = u[i] >= T;
    }
    int nn = 0;
#pragma unroll
    for (int i = 0; i < 8; ++i) { const unsigned long long m = __ballot(keep[i]); const int pre = __builtin_amdgcn_mbcnt_hi((unsigned)(m >> 32), __builtin_amdgcn_mbcnt_lo((unsigned)m, 0u));
        if (keep[i]) { cs[nn + pre] = sv[i]; ci[nn + pre] = (unsigned short)iv[i]; } nn += __popcll(m); }
    tau_out = unmono_f(T);
    return nn;
}
__device__ __forceinline__ void indexer_tile(const Params& P, int tile, LAS unsigned char* lds) {
    int tid_ = threadIdx.x; asm volatile("" : "+v"(tid_));
    const int tid = tid_, lane = tid & 63, wid = __builtin_amdgcn_readfirstlane(tid >> 6), l31 = lane & 31, hf = lane >> 5;
    LAS float* candS = (LAS float*)lds;
    LAS unsigned short* candI = (LAS unsigned short*)(lds + 65536);
    LAS unsigned char* kbuf = lds + 98304;
    const f16* IQ = (const f16*)(P.ws + WS_IQ); const f16* IK = (const f16*)(P.ws + WS_IK); const float* IW = (const float*)(P.ws + WS_IW);
    unsigned short* SEL = (unsigned short*)(P.ws + WS_SEL);
    const int t0 = tile * 32, tw = t0 + wid * 4;
    half8 afr[4];
    { const int qi = 2 * (l31 >> 4) + ((l31 >> 2) & 1), hd = 4 * ((l31 >> 3) & 1) + (l31 & 3); int tq = tw + qi; if (tq > L - 1) tq = L - 1;
      const half8* ap = (const half8*)(IQ + (size_t)tq * 512 + hd * 64);
#pragma unroll
      for (int s = 0; s < 4; ++s) afr[s] = ap[2 * s + hf]; }
    float w0[8], w1[8];
    { int ta = tw + hf, tb = tw + 2 + hf; if (ta > L - 1) ta = L - 1; if (tb > L - 1) tb = L - 1;
#pragma unroll
      for (int h = 0; h < 8; ++h) { w0[h] = IW[(size_t)ta * 8 + h]; w1[h] = IW[(size_t)tb * 8 + h]; } }
    const int tq0 = (tw + hf < L) ? tw + hf : -1, tq1 = (tw + 2 + hf < L) ? tw + 2 + hf : -1;
    float tau0 = -__builtin_inff(), tau1 = -__builtin_inff();
    int cntv = 0;
    const int nkeys = (t0 + 32 < L) ? t0 + 32 : L, nst = (nkeys + 127) >> 7;
    u32x4 stg[2];
    const u32x4* IKv = (const u32x4*)IK;
#pragma unroll
    for (int i = 0; i < 2; ++i) stg[i] = IKv[(size_t)0 * 1024 + tid + 512 * i];
#pragma unroll
    for (int i = 0; i < 2; ++i) { const int ci = tid + 512 * i, row = ci >> 3, ch = ci & 7; *(LAS u32x4*)(kbuf + row * 128 + ((ch ^ ((row >> 1) & 7)) << 4)) = stg[i]; }
    __syncthreads();
#pragma unroll 1
    for (int st = 0; st < nst; ++st) {
        LAS unsigned char* kb = kbuf + (st & 1) * 16384;
        if (st + 1 < nst) {
#pragma unroll
            for (int i = 0; i < 2; ++i) stg[i] = IKv[(size_t)(st + 1) * 1024 + tid + 512 * i];
        }
#pragma unroll 1
        for (int sub = 0; sub < 4; ++sub) {
            const int kbase = st * 128 + sub * 32;
            if (kbase > tw + 3) break;
            const int row = sub * 32 + l31;
            f32x16 acc;
#pragma unroll
            for (int i = 0; i < 16; ++i) acc[i] = 0.f;
#pragma unroll
            for (int s = 0; s < 4; ++s) { const half8 bfr = *(const LAS half8*)(kb + row * 128 + (((2 * s + hf) ^ ((row >> 1) & 7)) << 4)); acc = __builtin_amdgcn_mfma_f32_32x32x16_f16(afr[s], bfr, acc, 0, 0, 0); }
            float s0 = 0.f, s1 = 0.f;
#pragma unroll
            for (int h = 0; h < 8; ++h) { s0 += w0[h] * fmaxf(acc[h], 0.f); s1 += w1[h] * fmaxf(acc[8 + h], 0.f); }
            const int key = kbase + l31;
#pragma unroll
            for (int g = 0; g < 2; ++g) {
                const float sc = g ? s1 : s0; const bool ok = g ? (key <= tq1 && sc > tau1) : (key <= tq0 && sc > tau0);
                const unsigned long long m = __ballot(ok);
                if (m) { const unsigned lo = (unsigned)m, hi = (unsigned)(m >> 32);
                    const int clo = __builtin_amdgcn_readlane(cntv, 2 * g), chi = __builtin_amdgcn_readlane(cntv, 2 * g + 1);
                    const int pre = hf ? __builtin_amdgcn_mbcnt_hi(hi, 0u) : __builtin_amdgcn_mbcnt_lo(lo, 0u);
                    const int pos = (hf ? chi : clo) + pre, qs = wid * 4 + 2 * g + hf;
                    if (ok) { candS[qs * 512 + pos] = sc; candI[qs * 512 + pos] = (unsigned short)key; }
                    cntv = (lane == 2 * g) ? clo + __popc(lo) : cntv; cntv = (lane == 2 * g + 1) ? chi + __popc(hi) : cntv; }
            }
            const int mx = max(max(__builtin_amdgcn_readlane(cntv, 0), __builtin_amdgcn_readlane(cntv, 1)), max(__builtin_amdgcn_readlane(cntv, 2), __builtin_amdgcn_readlane(cntv, 3)));
            if (mx > 480) {
#pragma unroll 1
                for (int qq = 0; qq < 4; ++qq) { const int n = __builtin_amdgcn_readlane(cntv, qq);
                    if (n > 480) { float nt; const int nn = topk_compact(candS + (wid * 4 + qq) * 512, candI + (wid * 4 + qq) * 512, n, false, nt, lane);
                        cntv = (lane == qq) ? nn : cntv;
                        if (hf == (qq & 1)) { if (qq < 2) tau0 = nt; else tau1 = nt; } } }
            }
        }
        if (st + 1 < nst) {
            LAS unsigned char* kn = kbuf + ((st + 1) & 1) * 16384;
#pragma unroll
            for (int i = 0; i < 2; ++i) { const int ci = tid + 512 * i, row = ci >> 3, ch = ci & 7; *(LAS u32x4*)(kn + row * 128 + ((ch ^ ((row >> 1) & 7)) << 4)) = stg[i]; }
        }
        __syncthreads();
    }
#pragma unroll 1
    for (int qq = 0; qq < 4; ++qq) {
        const int t = tw + qq; if (t >= L) break;
        int n = __builtin_amdgcn_readlane(cntv, qq); LAS float* cs = candS + (wid * 4 + qq) * 512; LAS unsigned short* ci = candI + (wid * 4 + qq) * 512;
        if (n > 256) { float nt; n = topk_compact(cs, ci, n, true, nt, lane); }
#pragma unroll
        for (int j = 0; j < 4; ++j) { const int p = lane + 64 * j; SEL[(size_t)t * 256 + p] = p < n ? ci[p] : (unsigned short)0xffffu; }
    }
    __syncthreads();
}

__device__ __forceinline__ void sparse_attn(const Params& P, LAS unsigned char* lds) {
    int tid_ = threadIdx.x; asm volatile("" : "+v"(tid_));
    const int tid = tid_, lane = tid & 63, wid = tid >> 6, grp = lane >> 3, ch = lane & 7;
    const int head = blockIdx.x & 7, slot = (blockIdx.x >> 3) * 8 + wid, nslot = (gridDim.x >> 3) * 8;
    LAS unsigned short* widx = (LAS unsigned short*)(lds + wid * 512);
    const unsigned short* SEL = (const unsigned short*)(P.ws + WS_SEL); const f16* DQ = (const f16*)(P.ws + WS_DQ);
    const unsigned char* kvh = P.ws + WS_KV + (size_t)head * LP * 256; f16* mix = (f16*)(P.ws + WS_ACTA);
    for (int t = NMETA + slot; t < L; t += nslot) {
        *(LAS u32x2*)(widx + lane * 4) = *(const u32x2*)(SEL + (size_t)t * 256 + lane * 4);
        const half8 qv = *(const half8*)(DQ + (size_t)t * 512 + head * 64 + ch * 8);
        float qf[8];
#pragma unroll
        for (int e = 0; e < 8; ++e) qf[e] = (float)qv[e];
        float lg[32]; float mx = -__builtin_inff();
#pragma unroll
        for (int it = 0; it < 32; ++it) {
            const unsigned key = widx[8 * it + grp]; const bool valid = key != 0xffffu; const unsigned kk = valid ? key : 0u;
            const half8 kv = *(const half8*)(kvh + (size_t)kk * 256 + ch * 16); float part = 0.f;
#pragma unroll
            for (int e = 0; e < 8; ++e) part += qf[e] * (float)kv[e];
            part += __shfl_xor(part, 1); part += __shfl_xor(part, 2); part += __shfl_xor(part, 4);
            lg[it] = valid ? part : -__builtin_inff(); mx = fmaxf(mx, lg[it]);
        }
        mx = fmaxf(mx, __shfl_xor(mx, 8)); mx = fmaxf(mx, __shfl_xor(mx, 16)); mx = fmaxf(mx, __shfl_xor(mx, 32));
        float o[8] = {0.f, 0.f, 0.f, 0.f, 0.f, 0.f, 0.f, 0.f}; float lsum = 0.f;
#pragma unroll
        for (int it = 0; it < 32; ++it) {
            const unsigned key = widx[8 * it + grp]; const unsigned kk = key != 0xffffu ? key : 0u;
            const half8 vv = *(const half8*)(kvh + (size_t)kk * 256 + 128 + ch * 16);
            const float p = __expf(lg[it] - mx); lsum += p;
#pragma unroll
            for (int e = 0; e < 8; ++e) o[e] += p * (float)vv[e];
        }
        lsum += __shfl_xor(lsum, 8); lsum += __shfl_xor(lsum, 16); lsum += __shfl_xor(lsum, 32);
#pragma unroll
        for (int e = 0; e < 8; ++e) { o[e] += __shfl_xor(o[e], 8); o[e] += __shfl_xor(o[e], 16); o[e] += __shfl_xor(o[e], 32); }
        if (grp == 0) { const float inv = 1.0f / lsum; half8 ov;
#pragma unroll
            for (int e = 0; e < 8; ++e) ov[e] = (f16)(o[e] * inv);
            *(half8*)(mix + (size_t)(t - NMETA) * D + 512 + head * 64 + ch * 8) = ov; }
    }
    __syncthreads();
}

__device__ __forceinline__ void final_norm(const Params& P) {
    const int tid = threadIdx.x, lane = tid & 63, gw = blockIdx.x * 8 + (tid >> 6), nw = gridDim.x * 8;
    const float* ss3 = (const float*)(P.ws + WS_SS3);
    for (int r = gw; r < SEQ; r += nw) { const float rs = row_rstd(ss3, 16, r);
#pragma unroll
        for (int i = 0; i < 4; ++i) { const int k = lane * 4 + 256 * i; const f32x4 v = *(const f32x4*)(P.out + (size_t)r * D + k), g = *(const f32x4*)(P.nf + k); *(f32x4*)(P.out + (size_t)r * D + k) = v * rs * g; } }
}

#define XB_TMO      128
#define XB_XCNT(j)  (256  + 64 * (j))
#define XB_XSUB(j)  (1280 + 64 * (j))
#define XB_XGEN(j)  (2304 + 64 * (j))
#define XB_TOP      3328
#define XB_TOPGEN   3392
#define XCD_BAR_WORDS 3456
#define XB_SPIN_CAP (1u << 22)
__device__ __forceinline__ unsigned xb_ld(unsigned* p)              { return __hip_atomic_load(p, __ATOMIC_RELAXED, __HIP_MEMORY_SCOPE_AGENT); }
__device__ __forceinline__ unsigned xb_add(unsigned* p, unsigned v) { return __hip_atomic_fetch_add(p, v, __ATOMIC_RELAXED, __HIP_MEMORY_SCOPE_AGENT); }
__device__ __forceinline__ unsigned xb_xcc_id() { return (unsigned)__builtin_amdgcn_s_getreg((3 << 11) | 20) & 0xFu; }
#define XB_SPIN(cond, bar) do { unsigned _sp = 0; while (cond) { __builtin_amdgcn_s_sleep(1); \
    if ((++_sp & 255u) == 0u) { if (xb_ld(&(bar)[XB_TMO])) break; if (_sp > XB_SPIN_CAP) { atomicAdd(&(bar)[XB_TMO], 1u); break; } } } } while (0)
struct XcdBarrier { unsigned* bar; unsigned x; volatile LAS unsigned* st; };
__device__ __forceinline__ XcdBarrier xcd_barrier_post(unsigned* bar, volatile LAS unsigned* st) {
    XcdBarrier b; b.bar = bar; b.x = xb_xcc_id(); b.st = st;
    if (threadIdx.x == 0) (void)xb_add(&bar[XB_XCNT(b.x)], 1u);
    return b;
}
__device__ __forceinline__ void xcd_barrier_complete(unsigned* bar, unsigned x, unsigned& nloc, unsigned& nx) {
    const unsigned G = gridDim.x * gridDim.y * gridDim.z;
    unsigned sum, cnt, mine, sp = 0u;
    for (;;) {
        sum = 0u; cnt = 0u; mine = 0u;
#pragma unroll
        for (unsigned j = 0; j < 16; ++j) { const unsigned c = xb_ld(&bar[XB_XCNT(j)]); sum += c; cnt += (c > 0u) ? 1u : 0u; mine = (j == x) ? c : mine; }
        if (sum == G) break;
        __builtin_amdgcn_s_sleep(1);
        if ((++sp & 255u) == 0u) { if (xb_ld(&bar[XB_TMO])) break; if (sp > XB_SPIN_CAP) { atomicAdd(&bar[XB_TMO], 1u); break; } }
    }
    nloc = mine > 0u ? mine : 1u; nx = cnt > 0u ? cnt : 1u;
}
__device__ __forceinline__ void xcd_barrier(const XcdBarrier& b) {
    asm volatile("s_waitcnt vmcnt(0)" ::: "memory");
    __syncthreads();
    if (threadIdx.x == 0) {
        unsigned* bar = b.bar;
        __builtin_amdgcn_s_waitcnt(0);
        unsigned nloc = b.st[0], nx = b.st[1];
        if (nloc == 0u) { xcd_barrier_complete(bar, b.x, nloc, nx); b.st[0] = nloc; b.st[1] = nx; }
        const unsigned old = xb_add(&bar[XB_XSUB(b.x)], 1u);
        const unsigned gen = old / nloc;
        if (old + 1u == (gen + 1u) * nloc) {
            __builtin_amdgcn_fence(__ATOMIC_RELEASE, "agent");
            asm volatile("s_waitcnt vmcnt(0)" ::: "memory");
            const unsigned og = xb_add(&bar[XB_TOP], 1u);
            const unsigned tg = og / nx;
            if (og + 1u == (tg + 1u) * nx) xb_add(&bar[XB_TOPGEN], 1u);
            else XB_SPIN(xb_ld(&bar[XB_TOPGEN]) == tg, bar);
            __builtin_amdgcn_fence(__ATOMIC_ACQUIRE, "agent");
            xb_add(&bar[XB_XGEN(b.x)], 1u);
            asm volatile("s_waitcnt vmcnt(0)" ::: "memory");
        } else {
            XB_SPIN(xb_ld(&bar[XB_XGEN(b.x)]) == gen, bar);
            __builtin_amdgcn_fence(__ATOMIC_ACQUIRE, "agent");
            asm volatile("s_waitcnt vmcnt(0)" ::: "memory");
        }
    }
    __syncthreads();
}

__global__ void __launch_bounds__(NTHREADS, 2) fwd_kernel(Params P) {
    __shared__ __attribute__((aligned(16))) unsigned char lds_raw[LDS_BYTES];
    LAS unsigned char* lds = (LAS unsigned char*)lds_raw;
    const int tid = threadIdx.x, bid = blockIdx.x, G = gridDim.x;
    unsigned char* ws = P.ws;
    const int lo = P.ph_lo, hi = P.ph_hi;
#ifndef ONLY_PHASE
#define ONLY_PHASE -1
#endif
#define IN(k) ((ONLY_PHASE < 0 || ONLY_PHASE == (k)) && lo <= (k) && (k) < hi)
#ifdef PROBE
#define STAMP(k) do { if (bid == 0 && tid == 0) ((unsigned long long*)(ws + WS_CTL + 1024))[(k)] = __builtin_amdgcn_s_memrealtime(); } while (0)
#else
#define STAMP(k) do { } while (0)
#endif
#define SEAM(k) do { if (IN(k) && IN((k) + 1)) { if ((k) == 0) cg::this_grid().sync(); else xcd_barrier(xbar); } STAMP((k) + 1); } while (0)
    XcdBarrier xbar; xbar.bar = (unsigned*)(ws + WS_BAR); xbar.x = 0; xbar.st = (volatile LAS unsigned*)(lds + 131072 + 16);
    if (hi - lo > 1) {
        if (tid == 0) { xbar.st[0] = 0u; xbar.st[1] = 0u; }
        __syncthreads();
        xbar = xcd_barrier_post((unsigned*)(ws + WS_BAR), (volatile LAS unsigned*)(lds + 131072 + 16));
    }
    f16* acta = (f16*)(ws + WS_ACTA); f16* Gb = (f16*)(ws + WS_G);
    float* ss0 = (float*)(ws + WS_SS0); float* ss1 = (float*)(ws + WS_SS1); float* ss2 = (float*)(ws + WS_SS2); float* ss3 = (float*)(ws + WS_SS3);
    STAMP(0);
    _Pragma("unroll 1") for (int rep = 0; rep < (REPEAT_PH == 0 ? 2 : 1); ++rep)
    if (IN(0)) { p0_prologue(P, lds); }
    SEAM(0);
    _Pragma("unroll 1") for (int rep = 0; rep < (REPEAT_PH == 1 ? 2 : 1); ++rep)
    if (IN(1)) {
        pg8::Gemm g{acta, (const f16*)(ws + WS_WGU1), MP, 2 * DFF, D}; pg8::StaticOrder S; S.init(MP, 2 * DFF, G, bid);
        EpiSwiglu E{Gb, ss0, 1}; pg8::gemm_phase(lds, g, S, E);
    }
    SEAM(1);
    if (IN(2)) {
        meta_down(P, lds);
        pg8::Gemm g{Gb, (const f16*)(ws + WS_WD1), SEQ, D, DFF}; pg8::StaticOrder S; S.init(SEQ, D, G, bid);
        EpiResid E{P.x, P.out, acta, ss1, 0.5f}; pg8::gemm_phase(lds, g, S, E);
    }
    SEAM(2);
    _Pragma("unroll 1") for (int rep = 0; rep < (REPEAT_PH == 3 ? 2 : 1); ++rep)
    if (IN(3)) {
        pg8::Gemm g{acta, (const f16*)(ws + WS_WIN), MP, NIN, D}; pg8::StaticOrder S; S.init(MP, NIN, G, bid);
        EpiInProj E{ss1, (const f32x2*)(ws + WS_ROPE), ws};
        pg8::gemm_phase(lds, g, S, E);
    }
    SEAM(3);
    _Pragma("unroll 1") for (int rep = 0; rep < (REPEAT_PH == 4 ? 2 : 1); ++rep)
    if (IN(4)) { for (int u = bid; u < NCH * 4; u += G) gla_a_unit(P, u, lds); }
    SEAM(4);
    _Pragma("unroll 1") for (int rep = 0; rep < (REPEAT_PH == 5 ? 2 : 1); ++rep)
    if (IN(5)) {
        if (bid < 64 && rep == 0) gla_scan(P);
        unsigned* ctr = (unsigned*)(ws + WS_CTL) + rep; LAS int* bc = (LAS int*)(lds + 131072);
        for (;;) {
            if (tid == 0) bc[0] = (int)atomicAdd(ctr, 1u);
            __syncthreads();
            const int k = bc[0];
            __syncthreads();
            if (k >= 513) break;
            indexer_tile(P, 512 - k, lds);
        }
    }
    SEAM(5);
    _Pragma("unroll 1") for (int rep = 0; rep < (REPEAT_PH == 6 ? 2 : 1); ++rep)
    if (IN(6)) { if (REPEAT_PH != 6 || rep == 0 || true) for (int u = bid; u < NCH * 4; u += G) gla_c_unit(P, u, lds); sparse_attn(P, lds); }
    for (int e = 0; e < EXTRA_SYNCS; ++e) cg::this_grid().sync();
    SEAM(6);
    if (IN(7)) {
        pg8::Gemm g{acta, (const f16*)(ws + WS_WOUT), SEQ, D, D}; pg8::StaticOrder S; S.init(SEQ, D, G, bid);
        EpiResid E{P.out, P.out, (f16*)(ws + WS_US), ss2, 1.0f}; pg8::gemm_phase(lds, g, S, E);
    }
    SEAM(7);
    _Pragma("unroll 1") for (int rep = 0; rep < (REPEAT_PH == 8 ? 2 : 1); ++rep)
    if (IN(8)) {
        pg8::Gemm g{(const f16*)(ws + WS_US), (const f16*)(ws + WS_WGU2), SEQ, 2 * DFF, D}; pg8::StaticOrder S; S.init(SEQ, 2 * DFF, G, bid);
        EpiSwiglu E{Gb, ss2, 16}; pg8::gemm_phase(lds, g, S, E);
    }
    SEAM(8);
    if (IN(9)) {
        pg8::Gemm g{Gb, (const f16*)(ws + WS_WD2), SEQ, D, DFF}; pg8::StaticOrder S; S.init(SEQ, D, G, bid);
        EpiResid E{P.out, P.out, nullptr, ss3, 0.5f}; pg8::gemm_phase(lds, g, S, E);
    }
    SEAM(9);
    if (IN(10)) final_norm(P);
#ifdef PROBE
    {
        STAMP(11);
        cg::this_grid().sync();
        const unsigned long long* tsv = (const unsigned long long*)(ws + WS_CTL + 1024);
        float tph[12]; float tg = 0.f;
#pragma unroll
        for (int k = 0; k < 11; ++k) { tph[k] = (float)(tsv[k + 1] - tsv[k]) * 0.01f; }
        tph[11] = (float)(tsv[11] - tsv[0]) * 0.01f;
        const float gsum = tph[1] + tph[2] + tph[3] + tph[7] + tph[8] + tph[9];
        const float va = (PROBE_A == 12) ? gsum : tph[PROBE_A < 12 ? PROBE_A : 0], vb = (PROBE_B == 12) ? gsum : tph[PROBE_B < 12 ? PROBE_B : 0];
        const size_t n = (size_t)SEQ * D;
        for (size_t i = (size_t)bid * NTHREADS + tid; i < n; i += (size_t)G * NTHREADS) P.out[i] = (i == 0) ? va : vb * 0.01f;
        (void)tg;
    }
#endif
#ifdef DBG_CUT
    if (IN(11)) {
        const size_t n = (size_t)SEQ * D; const size_t i0 = (size_t)bid * NTHREADS + tid, st = (size_t)G * NTHREADS;
#if DBG_CUT == 6
        const f16* m = (const f16*)(ws + WS_ACTA); for (size_t i = i0; i < n; i += st) P.out[i] = (float)m[i];
#elif DBG_CUT == 5
        const unsigned short* m = (const unsigned short*)(ws + WS_SEL); for (size_t i = i0; i < n; i += st) P.out[i] = (float)m[i % ((size_t)L * 256)];
#elif DBG_CUT == 3
        const f16* a = (const f16*)(ws + WS_DQ); const f16* b = (const f16*)(ws + WS_IQ); const f16* c = (const f16*)(ws + WS_KV); const f16* d = (const f16*)(ws + WS_GQ);
        for (size_t i = i0; i < n; i += st) P.out[i] = (float)a[i % ((size_t)L * 512)] + (float)b[i % ((size_t)L * 512)] + (float)c[i] + (float)d[i % ((size_t)L * 1536)];
#elif DBG_CUT == 4
        const float* m = (const float*)(ws + WS_US); for (size_t i = i0; i < n; i += st) P.out[i] = m[i % ((size_t)NCH * 32768)];
#endif
    }
#endif
#undef IN
#undef SEAM
}

extern "C" void kernel_launch(void* const* d_in, const int* in_sizes, int n_in, void* d_out, int out_size, void* d_ws, size_t ws_size, hipStream_t stream) {
    static int grid = 0;
    if (grid == 0) {
        if (n_in != 17 || in_sizes[0] != SEQ * D || out_size != SEQ * D || ws_size < WS_END) { fprintf(stderr, "kernel_launch: unexpected shapes (n_in %d, in0 %d, out %d, ws %zu, need %zu)\n", n_in, n_in > 0 ? in_sizes[0] : -1, out_size, ws_size, (size_t)WS_END); grid = -1; return; }
        int dev = 0, cus = 0, per_cu = 0;
        (void)hipGetDevice(&dev); (void)hipDeviceGetAttribute(&cus, hipDeviceAttributeMultiprocessorCount, dev);
        if (hipOccupancyMaxActiveBlocksPerMultiprocessor(&per_cu, (const void*)fwd_kernel, NTHREADS, 0) != hipSuccess || per_cu < 1) { fprintf(stderr, "kernel_launch: occupancy query says %d blocks per CU\n", per_cu); per_cu = 1; }
        (void)hipGetLastError();
        grid = cus;
        if (grid % 8 != 0 || grid < 64) { fprintf(stderr, "kernel_launch: unexpected CU count %d\n", cus); }
    }
    if (grid < 0) return;
    if (hipMemsetAsync((char*)d_ws + WS_CTL, 0, CTL_BYTES, stream) != hipSuccess) { fprintf(stderr, "kernel_launch: memset failed\n"); return; }
    Params p{};
    const float** pp = (const float**)&p;
    for (int i = 0; i < 17; ++i) pp[i] = (const float*)d_in[i];
    p.out = (float*)d_out; p.ws = (unsigned char*)d_ws;
#if MODE == 0
#ifdef DBG_CUT
    for (int ph = 0; ph <= DBG_CUT; ++ph) { p.ph_lo = ph; p.ph_hi = ph + 1; hipLaunchKernelGGL(fwd_kernel, dim3(grid), dim3(NTHREADS), 0, stream, p); }
    if (DBG_CUT != 2 && DBG_CUT != 7 && DBG_CUT != 9) { p.ph_lo = 11; p.ph_hi = 12; hipLaunchKernelGGL(fwd_kernel, dim3(grid), dim3(NTHREADS), 0, stream, p); }
#else
    for (int ph = 0; ph < NPHASE; ++ph) { p.ph_lo = ph; p.ph_hi = ph + 1; hipLaunchKernelGGL(fwd_kernel, dim3(grid), dim3(NTHREADS), 0, stream, p); }
#endif
#else
    p.ph_lo = 0; p.ph_hi = NPHASE;
    void* args[] = {&p};
    hipError_t e = hipLaunchCooperativeKernel((const void*)fwd_kernel, dim3(grid), dim3(NTHREADS), args, 0, stream);
    if (e != hipSuccess) fprintf(stderr, "cooperative launch failed: %s (grid %d)\n", hipGetErrorString(e), grid);
#endif
}
```

```cpp
#include <hip/hip_runtime.h>
#include <hip/hip_cooperative_groups.h>
#include <cstdio>
#include <cstdint>
namespace cg = cooperative_groups;

#ifndef MODE
#define MODE 1

#ifndef REPEAT_PH
#define REPEAT_PH -1
#endif
#ifndef EXTRA_SYNCS
#define EXTRA_SYNCS 0
#endif
#endif

#define LAS __attribute__((address_space(3)))
typedef _Float16 f16;
typedef _Float16 half8 __attribute__((ext_vector_type(8)));
typedef _Float16 half4 __attribute__((ext_vector_type(4)));
typedef float f32x2 __attribute__((ext_vector_type(2)));
typedef float f32x4 __attribute__((ext_vector_type(4)));
typedef float f32x16 __attribute__((ext_vector_type(16)));
typedef unsigned u32x2 __attribute__((ext_vector_type(2)));
typedef unsigned u32x4 __attribute__((ext_vector_type(4)));

constexpr int D = 1024, SEQ = 16384, NMETA = 16, L = SEQ + NMETA, DFF = 2816;
constexpr int MP = 16640;
constexpr int LP = 16512;
constexpr int NIN = 3840;
constexpr int NCH = 257;
constexpr float EPS = 1e-6f;
constexpr int NTHREADS = 512;
constexpr int LDS_BYTES = 155648 + 1024;
constexpr int NPHASE = 11;

constexpr size_t al256(size_t x) { return (x + 255) & ~(size_t)255; }
constexpr size_t WS_CTL = 0;
constexpr size_t CTL_BYTES = 32768;
constexpr size_t WS_BAR = 2048;
constexpr size_t WS_WGU1 = CTL_BYTES;
constexpr size_t WS_WD1 = WS_WGU1 + (size_t)2 * DFF * D * 2;
constexpr size_t WS_WIN = WS_WD1 + (size_t)D * DFF * 2;
constexpr size_t WS_WOUT = WS_WIN + (size_t)NIN * D * 2;
constexpr size_t WS_WGU2 = WS_WOUT + (size_t)D * D * 2;
constexpr size_t WS_WD2 = WS_WGU2 + (size_t)2 * DFF * D * 2;
constexpr size_t WS_ACTA = WS_WD2 + (size_t)D * DFF * 2;
constexpr size_t WS_G = WS_ACTA + (size_t)MP * D * 2;
constexpr size_t WS_US = WS_G + (size_t)MP * DFF * 2;
constexpr size_t WS_DQ = WS_US + (size_t)NCH * 4 * 64 * 128 * 4;
constexpr size_t WS_IQ = WS_DQ + (size_t)LP * 512 * 2;
constexpr size_t WS_SEL = WS_IQ + (size_t)LP * 512 * 2;
constexpr size_t WS_ROPE = WS_SEL + (size_t)LP * 256 * 2;
constexpr size_t WS_IW = WS_ROPE + al256((size_t)L * 32 * 8);
constexpr size_t WS_GA = WS_IW + (size_t)LP * 8 * 4;
constexpr size_t WS_DECAY = WS_GA + (size_t)LP * 16 * 4;
constexpr size_t WS_SS0 = WS_DECAY + al256((size_t)NCH * 256 * 4);
constexpr size_t WS_SS1 = WS_SS0 + (size_t)MP * 4;
constexpr size_t WS_SS2 = WS_SS1 + (size_t)MP * 64;
constexpr size_t WS_SS3 = WS_SS2 + (size_t)MP * 64;
constexpr size_t WS_END = WS_SS3 + (size_t)MP * 64;
constexpr size_t WS_KV = WS_G;
constexpr size_t WS_GQ = WS_KV + (size_t)8 * LP * 128 * 2;
constexpr size_t WS_GK = WS_GQ + (size_t)LP * 256 * 2;
constexpr size_t WS_GV = WS_GK + (size_t)LP * 256 * 2;
constexpr size_t WS_GR = WS_GV + (size_t)LP * 512 * 2;
constexpr size_t WS_IK = WS_GR + (size_t)LP * 512 * 2;
constexpr size_t WS_ALIAS_END = WS_IK + (size_t)LP * 64 * 2;
static_assert(WS_ALIAS_END <= WS_US, "aliased buffers exceed G");
static_assert(WS_END <= (size_t)256 * 1024 * 1024, "workspace exceeds 256 MiB");
static_assert((size_t)SEQ * D * 2 <= (size_t)NCH * 4 * 64 * 128 * 4, "h2_16 alias");

struct Params {
    const float* x; const float* meta; const float* n1; const float* wg1; const float* wu1; const float* wd1;
    const float* nmix; const float* win; const float* wa2; const float* ba; const float* hn; const float* wout;
    const float* n2; const float* wg2; const float* wu2; const float* wd2; const float* nf;
    float* out; unsigned char* ws; int ph_lo, ph_hi;
};

namespace pg8 {
constexpr int BM = 256, BK = 64, HALF = 128, HTB = HALF * BK * 2, STAGE_BYTES = 8 * HTB, NXCD = 8, WGM = 8;
__host__ __device__ __forceinline__ int lds_byte(int r, int c) { const int st = (r >> 4) * 2 + (c >> 5), rr = r & 15, cc = c & 31, ob = rr * 64 + cc * 2; return st * 1024 + (ob ^ (((ob >> 9) & 1) << 5)); }
__host__ __device__ __forceinline__ void stage_rc(int b, int& R, int& C) { const int st = b / 1024, sb = b % 1024, swz = sb ^ (((sb >> 9) & 1) << 5); R = (st >> 1) * 16 + swz / 64; C = (st & 1) * 32 + (swz % 64) / 2; }
struct Unit { int pm, pn; };
struct Gemm { const f16* A; const f16* Bt; int M, N, K; };
struct StaticOrder {
    int nM, nN, nwg, G, c;
    __host__ __device__ void init(int M, int N, int G_, int c_) { nM = M / BM; nN = N / BM; nwg = nM * nN; G = G_; c = c_; }
    __host__ __device__ bool next(int i, Unit& u) const {
        const long Lx = (long)i * G + c; if (Lx >= nwg) return false;
        int wgid = (int)Lx; { const int q = nwg / NXCD, r = nwg % NXCD, xcd = wgid % NXCD, off = wgid / NXCD; wgid = (xcd < r ? xcd * (q + 1) : r * (q + 1) + (xcd - r) * q) + off; }
        const int nig = WGM * nN, gid = wgid / nig, fm = gid * WGM, gsz = (nM - fm) < WGM ? (nM - fm) : WGM;
        u.pm = fm + ((wgid % nig) % gsz); u.pn = (wgid % nig) / gsz; return true;
    }
};
template <class Epi>
__device__ __forceinline__ void gemm_phase(LAS unsigned char* lds, const Gemm g, const StaticOrder& S, const Epi& E) {
    int tid_ = threadIdx.x; asm volatile("" : "+v"(tid_));
    const int tid = tid_, wid = __builtin_amdgcn_readfirstlane(tid >> 6), lane = tid & 63, wr = wid >> 2, wc = wid & 3, fr = lane & 15, fq = lane >> 4;
    const int K = g.K, nt = K / BK;
    unsigned voffA[2], voffB[2];
#pragma unroll
    for (int i = 0; i < 2; ++i) { int R, C; stage_rc(tid * 16 + i * 8192, R, C); voffA[i] = (unsigned)(R * K + C) * 2u; voffB[i] = (unsigned)(R * K + C) * 2u; }
    const size_t kstep = (size_t)(BK * 2);
    const size_t hstep = (size_t)HALF * K * 2;
    const size_t tstep = 2 * hstep;
    const unsigned ldsw = (unsigned)wid * 1024u;
    const int aoff = lds_byte(wr * 64 + fr, fq * 8), boff = lds_byte(wc * 32 + fr, fq * 8);
#define PG8_SA(b, h) (((b) * 2 + (h)) * HTB)
#define PG8_SB(b, h) ((4 + (b) * 2 + (h)) * HTB)
#define PG8_STAGE(bufoff, gbase, voff) do { _Pragma("unroll") for (int _i = 0; _i < 2; ++_i) \
        __builtin_amdgcn_global_load_lds((const unsigned*)((const char*)(gbase) + (voff)[_i]), (LAS unsigned*)(lds + (bufoff) + ldsw + _i * 8192), 16, 0, 0); } while (0)
#define PG8_LDA(dst, b, h) do { _Pragma("unroll") for (int m = 0; m < 4; ++m) _Pragma("unroll") for (int k = 0; k < 2; ++k) dst[m][k] = *(const LAS half8*)(lds + PG8_SA(b, h) + aoff + m * 2048 + k * 1024); } while (0)
#define PG8_LDB(dst, b, h) do { _Pragma("unroll") for (int n = 0; n < 2; ++n) _Pragma("unroll") for (int k = 0; k < 2; ++k) dst[n][k] = *(const LAS half8*)(lds + PG8_SB(b, h) + boff + n * 2048 + k * 1024); } while (0)
#define PG8_MMA(ai, bj, At, Bt) do { __builtin_amdgcn_s_setprio(1); _Pragma("unroll") for (int m = 0; m < 4; ++m) _Pragma("unroll") for (int n = 0; n < 2; ++n) _Pragma("unroll") for (int k = 0; k < 2; ++k) \
        acc[ai][bj][m][n] = __builtin_amdgcn_mfma_f32_16x16x32_f16(Bt[n][k], At[m][k], acc[ai][bj][m][n], 0, 0, 0); __builtin_amdgcn_s_setprio(0); } while (0)
#define PG8_WAIT_V(n) asm volatile("s_waitcnt vmcnt(" #n ")" ::: "memory")
#define PG8_WAIT_L(n) asm volatile("s_waitcnt lgkmcnt(" #n ")" ::: "memory")
#define PG8_BAR __builtin_amdgcn_s_barrier()
#define PG8_SCHED __builtin_amdgcn_sched_barrier(0)
    Unit cur, nxt; int ui = 0;
    if (!S.next(0, cur)) return;
    f32x4 acc[2][2][4][2];
#pragma unroll
    for (int a = 0; a < 2; ++a)
#pragma unroll
        for (int b = 0; b < 2; ++b)
#pragma unroll
            for (int m = 0; m < 4; ++m)
#pragma unroll
                for (int n = 0; n < 2; ++n) acc[a][b][m][n] = (f32x4){0.f, 0.f, 0.f, 0.f};
    half8 At[4][2], B0[2][2], B1[2][2];
    const char* cA = (const char*)g.A + (size_t)cur.pm * tstep; const char* cB = (const char*)g.Bt + (size_t)cur.pn * tstep;
    PG8_STAGE(PG8_SB(0, 0), cB, voffB); PG8_STAGE(PG8_SA(0, 0), cA, voffA); PG8_STAGE(PG8_SB(0, 1), cB + hstep, voffB); PG8_STAGE(PG8_SA(0, 1), cA + hstep, voffA);
    if (wr == 1) PG8_BAR;
    PG8_WAIT_V(4); PG8_BAR;
    PG8_STAGE(PG8_SB(1, 0), cB + kstep, voffB); PG8_STAGE(PG8_SA(1, 0), cA + kstep, voffA); PG8_STAGE(PG8_SB(1, 1), cB + hstep + kstep, voffB);
    PG8_WAIT_V(6); PG8_BAR;
    for (;;) {
        const bool has_next = S.next(ui + 1, nxt);
        const char* nA = has_next ? (const char*)g.A + (size_t)nxt.pm * tstep : cA; const char* nB = has_next ? (const char*)g.Bt + (size_t)nxt.pn * tstep : cB;
        for (int t = 0; t < nt; t += 2) {
            const bool last = (t == nt - 2);
            const char* a1 = cA + (size_t)(t + 1) * kstep;
            const char* a2 = last ? nA : cA + (size_t)(t + 2) * kstep; const char* b2 = last ? nB : cB + (size_t)(t + 2) * kstep;
            const char* a3 = a2 + kstep; const char* b3 = b2 + kstep;
            PG8_LDB(B0, 0, 0); PG8_SCHED; PG8_LDA(At, 0, 0); PG8_STAGE(PG8_SA(1, 1), a1 + hstep, voffA);
            PG8_WAIT_L(8); PG8_BAR; PG8_WAIT_L(0); PG8_MMA(0, 0, At, B0); PG8_BAR; PG8_SCHED;
            PG8_LDB(B1, 0, 1); PG8_STAGE(PG8_SB(0, 0), b2, voffB);
            PG8_BAR; PG8_WAIT_L(0); PG8_MMA(0, 1, At, B1); PG8_BAR;
            PG8_LDA(At, 0, 1); PG8_STAGE(PG8_SA(0, 0), a2, voffA);
            PG8_BAR; PG8_WAIT_L(0); PG8_MMA(1, 0, At, B0); PG8_BAR; PG8_SCHED;
            PG8_STAGE(PG8_SB(0, 1), b2 + hstep, voffB);
            PG8_WAIT_V(6); PG8_BAR; PG8_MMA(1, 1, At, B1); PG8_BAR;
            PG8_LDB(B0, 1, 0); PG8_SCHED; PG8_LDA(At, 1, 0); PG8_STAGE(PG8_SA(0, 1), a2 + hstep, voffA);
            PG8_WAIT_L(8); PG8_BAR; PG8_WAIT_L(0); PG8_MMA(0, 0, At, B0); PG8_BAR; PG8_SCHED;
            PG8_LDB(B1, 1, 1); PG8_STAGE(PG8_SB(1, 0), b3, voffB);
            PG8_BAR; PG8_WAIT_L(0); PG8_MMA(0, 1, At, B1); PG8_BAR;
            PG8_LDA(At, 1, 1); PG8_STAGE(PG8_SA(1, 0), a3, voffA);
            PG8_BAR; PG8_WAIT_L(0); PG8_MMA(1, 0, At, B0); PG8_BAR; PG8_SCHED;
            PG8_STAGE(PG8_SB(1, 1), b3 + hstep, voffB);
            PG8_WAIT_V(6); PG8_BAR; PG8_MMA(1, 1, At, B1); PG8_BAR;
        }
        E(acc, cur, wr, wc, fr, fq);
        if (!has_next) break;
#pragma unroll
        for (int a = 0; a < 2; ++a)
#pragma unroll
            for (int b = 0; b < 2; ++b)
#pragma unroll
                for (int m = 0; m < 4; ++m)
#pragma unroll
                    for (int n = 0; n < 2; ++n) acc[a][b][m][n] = (f32x4){0.f, 0.f, 0.f, 0.f};
        cur = nxt; cA = nA; cB = nB; ++ui;
    }
    PG8_WAIT_V(0);
    if (wr == 0) PG8_BAR;
    PG8_BAR;
#undef PG8_SA
#undef PG8_SB
#undef PG8_STAGE
#undef PG8_LDA
#undef PG8_LDB
#undef PG8_MMA
#undef PG8_WAIT_V
#undef PG8_WAIT_L
#undef PG8_BAR
#undef PG8_SCHED
}
}

__device__ __forceinline__ float silu_f(float v) { return v / (1.0f + __expf(-v)); }
__device__ __forceinline__ half4 to_half4(f32x4 v) { half4 h; h[0] = (f16)v[0]; h[1] = (f16)v[1]; h[2] = (f16)v[2]; h[3] = (f16)v[3]; return h; }

__device__ __forceinline__ float row_rstd(const float* ss, int np, int row) {
    float s;
    if (np == 1) s = ss[row];
    else { const f32x4* p = (const f32x4*)(ss + (size_t)row * 16); const f32x4 a = p[0], b = p[1], c = p[2], d = p[3];
        s = (((a[0] + a[1]) + (a[2] + a[3])) + ((b[0] + b[1]) + (b[2] + b[3]))) + (((c[0] + c[1]) + (c[2] + c[3])) + ((d[0] + d[1]) + (d[2] + d[3]))); }
    return rsqrtf(s * (1.0f / D) + EPS);
}
struct EpiSwiglu {
    f16* G; const float* ss; int np;
    __device__ __forceinline__ void operator()(const f32x4 (&acc)[2][2][4][2], const pg8::Unit& u, int wr, int wc, int fr, int fq) const {
        if (np < 0) { if (acc[0][0][0][0][0] == 1234.5f) G[0] = (f16)1.0f; return; }
#pragma unroll
        for (int ai = 0; ai < 2; ++ai)
#pragma unroll
            for (int m = 0; m < 4; ++m) {
                const int row = u.pm * 256 + ai * 128 + wr * 64 + m * 16 + fr;
                const float rs = row_rstd(ss, np, row);
#pragma unroll
                for (int n = 0; n < 2; ++n) {
                    const f32x4 gt = acc[ai][0][m][n] * rs, up = acc[ai][1][m][n] * rs; f32x4 o;
#pragma unroll
                    for (int j = 0; j < 4; ++j) o[j] = silu_f(gt[j]) * up[j];
                    *(half4*)(G + (size_t)row * DFF + u.pn * 128 + wc * 32 + n * 16 + 4 * fq) = to_half4(o);
                }
            }
    }
};
struct EpiResid {
    const float* src; float* out; f16* h16; float* ss; float alpha;
    __device__ __forceinline__ void operator()(const f32x4 (&acc)[2][2][4][2], const pg8::Unit& u, int wr, int wc, int fr, int fq) const {
#pragma unroll
        for (int ai = 0; ai < 2; ++ai)
#pragma unroll
            for (int m = 0; m < 4; ++m) {
                const int row = u.pm * 256 + ai * 128 + wr * 64 + m * 16 + fr; float part = 0.f;
#pragma unroll
                for (int bj = 0; bj < 2; ++bj)
#pragma unroll
                    for (int n = 0; n < 2; ++n) {
                        const size_t off = (size_t)row * D + u.pn * 256 + bj * 128 + wc * 32 + n * 16 + 4 * fq;
                        const f32x4 s = *(const f32x4*)(src + off); const f32x4 o = s + alpha * acc[ai][bj][m][n];
                        *(f32x4*)(out + off) = o; if (h16) *(half4*)(h16 + off) = to_half4(o);
                        part += (o[0] * o[0] + o[1] * o[1]) + (o[2] * o[2] + o[3] * o[3]);
                    }
                part += __shfl_xor(part, 16); part += __shfl_xor(part, 32);
                if (fq == 0) ss[(size_t)row * 16 + u.pn * 4 + wc] = part;
            }
    }
};
constexpr float KV_SCALE = 16.0f;
__device__ __forceinline__ unsigned pack_fp8x4(f32x4 v) {
#pragma unroll
    for (int j = 0; j < 4; ++j) v[j] = fminf(fmaxf(v[j], -448.f), 448.f);
    int w = __builtin_amdgcn_cvt_pk_fp8_f32(v[0], v[1], 0, false); w = __builtin_amdgcn_cvt_pk_fp8_f32(v[2], v[3], w, true); return (unsigned)w;
}
struct EpiInProj {
    const float* ss; const f32x2* rope; unsigned char* ws;
    __device__ __forceinline__ void operator()(const f32x4 (&acc)[2][2][4][2], const pg8::Unit& u, int wr, int wc, int fr, int fq) const {
        const int pn = u.pn;
        if (pn >= 8 && pn <= 11) {
            unsigned char* lb = (pn <= 9) ? ws + WS_KV + (size_t)((pn - 8) * 4 + wc) * LP * 128 + 4 * fq
                                          : ws + WS_KV + (size_t)((pn - 10) * 4 + (wc >> 1)) * LP * 128 + 64 + (wc & 1) * 32 + 4 * fq;
#pragma unroll
            for (int ai = 0; ai < 2; ++ai)
#pragma unroll
                for (int m = 0; m < 4; ++m) {
                    const int p = u.pm * 256 + ai * 128 + wr * 64 + m * 16 + fr;
                    const int t = p < SEQ ? p + NMETA : p - SEQ;
                    if (p < L) {
                        const float sc = row_rstd(ss, 16, p) * KV_SCALE;
                        if (pn <= 9) {
#pragma unroll
                            for (int n = 0; n < 2; ++n) {
                                const int dd = 16 * n + 4 * fq;
                                const f32x4 x1 = acc[ai][0][m][n], x2 = acc[ai][1][m][n]; f32x4 o1, o2;
                                const f32x4 cs0 = *(const f32x4*)(rope + (size_t)t * 32 + dd), cs1 = *(const f32x4*)(rope + (size_t)t * 32 + dd + 2);
                                o1[0] = (x1[0] * cs0[0] - x2[0] * cs0[1]) * sc; o2[0] = (x2[0] * cs0[0] + x1[0] * cs0[1]) * sc;
                                o1[1] = (x1[1] * cs0[2] - x2[1] * cs0[3]) * sc; o2[1] = (x2[1] * cs0[2] + x1[1] * cs0[3]) * sc;
                                o1[2] = (x1[2] * cs1[0] - x2[2] * cs1[1]) * sc; o2[2] = (x2[2] * cs1[0] + x1[2] * cs1[1]) * sc;
                                o1[3] = (x1[3] * cs1[2] - x2[3] * cs1[3]) * sc; o2[3] = (x2[3] * cs1[2] + x1[3] * cs1[3]) * sc;
                                unsigned char* d8 = lb + (size_t)t * 128 + n * 16; *(unsigned*)d8 = pack_fp8x4(o1); *(unsigned*)(d8 + 32) = pack_fp8x4(o2);
                            }
                        } else {
#pragma unroll
                            for (int bj = 0; bj < 2; ++bj)
#pragma unroll
                                for (int n = 0; n < 2; ++n) *(unsigned*)(lb + (size_t)t * 128 + (size_t)bj * 2 * LP * 128 + n * 16) = pack_fp8x4(acc[ai][bj][m][n] * sc);
                        }
                    }
                    asm volatile("" ::: "memory");
                }
            return;
        }
        int mode = 0, stride = 256; float scale = 1.0f; f16* lanebase;
        if (pn == 0) lanebase = (f16*)(ws + WS_GQ) + wc * 32 + 4 * fq;
        else if (pn == 1) lanebase = (f16*)(ws + WS_GK) + wc * 32 + 4 * fq;
        else if (pn <= 3) { lanebase = (f16*)(ws + WS_GV) + (pn - 2) * 256 + wc * 32 + 4 * fq; stride = 512; }
        else if (pn <= 5) { lanebase = (f16*)(ws + WS_GR) + (pn - 4) * 256 + wc * 32 + 4 * fq; stride = 512; }
        else if (pn <= 7) { lanebase = (f16*)(ws + WS_DQ) + (pn - 6) * 256 + wc * 64 + 4 * fq; stride = 512; mode = 1; scale = 0.125f; }
        else if (pn <= 13) { lanebase = (f16*)(ws + WS_IQ) + (pn - 12) * 256 + wc * 64 + 4 * fq; stride = 512; mode = 1; scale = 0.125f; }
        else { lanebase = (f16*)(ws + WS_IK) + 4 * fq; stride = 64; mode = wc == 0 ? 1 : (wc == 1 ? 2 : 3); }
#pragma unroll
        for (int ai = 0; ai < 2; ++ai)
#pragma unroll
            for (int m = 0; m < 4; ++m) {
                const int p = u.pm * 256 + ai * 128 + wr * 64 + m * 16 + fr;
                const int t = p < SEQ ? p + NMETA : p - SEQ;
                if (p < L && mode != 3) {
                    const float rs = row_rstd(ss, 16, p);
                    if (mode == 1) {
                        const float sc = rs * scale;
#pragma unroll
                        for (int n = 0; n < 2; ++n) {
                            const int dd = 16 * n + 4 * fq;
                            const f32x4 x1 = acc[ai][0][m][n], x2 = acc[ai][1][m][n]; f32x4 o1, o2;
                            const f32x4 cs0 = *(const f32x4*)(rope + (size_t)t * 32 + dd), cs1 = *(const f32x4*)(rope + (size_t)t * 32 + dd + 2);
                            o1[0] = (x1[0] * cs0[0] - x2[0] * cs0[1]) * sc; o2[0] = (x2[0] * cs0[0] + x1[0] * cs0[1]) * sc;
                            o1[1] = (x1[1] * cs0[2] - x2[1] * cs0[3]) * sc; o2[1] = (x2[1] * cs0[2] + x1[1] * cs0[3]) * sc;
                            o1[2] = (x1[2] * cs1[0] - x2[2] * cs1[1]) * sc; o2[2] = (x2[2] * cs1[0] + x1[2] * cs1[1]) * sc;
                            o1[3] = (x1[3] * cs1[2] - x2[3] * cs1[3]) * sc; o2[3] = (x2[3] * cs1[2] + x1[3] * cs1[3]) * sc;
                            f16* dst = lanebase + (size_t)t * stride + n * 16;
                            *(half4*)dst = to_half4(o1); *(half4*)(dst + 32) = to_half4(o2);
                        }
                    } else if (mode == 2) {
                        const f32x4 a0 = acc[ai][0][m][0] * rs; *(f32x4*)((float*)(ws + WS_GA) + (size_t)t * 16 + 4 * fq) = a0;
                        if (fq < 2) { const f32x4 a1 = acc[ai][0][m][1] * (rs * 0.35355339059327373f); *(f32x4*)((float*)(ws + WS_IW) + (size_t)t * 8 + 4 * fq) = a1; }
                    } else {
#pragma unroll
                        for (int bj = 0; bj < 2; ++bj)
#pragma unroll
                            for (int n = 0; n < 2; ++n) *(half4*)(lanebase + (size_t)t * stride + bj * 128 + n * 16) = to_half4(acc[ai][bj][m][n] * rs);
                    }
                }
                asm volatile("" ::: "memory");
            }
    }
};

__device__ __forceinline__ const float* w_src(const Params& P, int kind, int n, int& ld, const float*& gain) {
    switch (kind) {
    case 0: case 4: { const int pn = n >> 8, bj = (n >> 7) & 1, cc = n & 127; ld = DFF; gain = kind == 0 ? P.n1 : P.n2;
        const float* w = kind == 0 ? (bj ? P.wu1 : P.wg1) : (bj ? P.wu2 : P.wg2); return w + pn * 128 + cc; }
    case 1: ld = D; gain = nullptr; return P.wd1 + n;
    case 5: ld = D; gain = nullptr; return P.wd2 + n;
    case 3: ld = D; gain = nullptr; return P.wout + n;
    default: { ld = 3672; gain = P.nmix; const int pn = n >> 8, c = n & 255, bj = c >> 7, hh = (c >> 5) & 3, dd = c & 31; int j;
        if (pn == 0) j = c; else if (pn == 1) j = 256 + c; else if (pn <= 3) j = 512 + (pn - 2) * 256 + c; else if (pn <= 5) j = 1024 + (pn - 4) * 256 + c;
        else if (pn <= 7) j = 1552 + (pn - 6) * 256 + hh * 64 + bj * 32 + dd;
        else if (pn <= 9) j = 2064 + (pn - 8) * 256 + hh * 64 + bj * 32 + dd;
        else if (pn <= 11) j = 2576 + (pn - 10) * 256 + c;
        else if (pn <= 13) j = 3088 + (pn - 12) * 256 + hh * 64 + bj * 32 + dd;
        else { if (c < 32) j = 3600 + c; else if (c < 48) j = 1536 + (c - 32); else if (c < 56) j = 3664 + (c - 48); else if (c >= 128 && c < 160) j = 3600 + 32 + (c - 128); else j = -1; }
        return j < 0 ? nullptr : P.win + j; }
    }
}
__device__ __forceinline__ void prep_weight(const Params& P, const int kind, const int N, const int K, f16* dst, int& cursor, int& tbase, LAS f16* tl) {
    const int tid = threadIdx.x, G = gridDim.x, tn = N / 64, tk = K / 256, ntile = tn * tk;
#pragma unroll 1
    for (; cursor < tbase + ntile; cursor += G) {
        const int tI = cursor - tbase, n0 = (tI % tn) * 64, k0 = (tI / tn) * 256;
        { const int n = tid & 63, kk0 = tid >> 6; int ld; const float* gain; const float* col = w_src(P, kind, n0 + n, ld, gain);
          float v[32];
#pragma unroll
          for (int i = 0; i < 32; ++i) v[i] = col ? col[(size_t)(k0 + kk0 + 8 * i) * ld] : 0.f;
          if (gain) {
#pragma unroll
              for (int i = 0; i < 32; ++i) v[i] *= gain[k0 + kk0 + 8 * i];
          }
#pragma unroll
          for (int i = 0; i < 32; ++i) tl[n * 264 + kk0 + 8 * i] = (f16)v[i]; }
        __syncthreads();
        { const int n = tid >> 3, seg = tid & 7;
#pragma unroll
          for (int j = 0; j < 4; ++j) *(half8*)(dst + (size_t)(n0 + n) * K + k0 + (seg + 8 * j) * 8) = *(const LAS half8*)(tl + n * 264 + (seg + 8 * j) * 8); }
        __syncthreads();
    }
    tbase += ntile;
}
__device__ __forceinline__ void p0_prologue(const Params& P, LAS unsigned char* lds) {
    const int tid = threadIdx.x, bid = blockIdx.x, G = gridDim.x, lane = tid & 63;
    unsigned char* ws = P.ws;
    int tbase = 0, cursor = bid;
    LAS f16* tl = (LAS f16*)lds;
    prep_weight(P, 0, 2 * DFF, D, (f16*)(ws + WS_WGU1), cursor, tbase, tl);
    prep_weight(P, 1, D, DFF, (f16*)(ws + WS_WD1), cursor, tbase, tl);
    prep_weight(P, 2, NIN, D, (f16*)(ws + WS_WIN), cursor, tbase, tl);
    prep_weight(P, 3, D, D, (f16*)(ws + WS_WOUT), cursor, tbase, tl);
    prep_weight(P, 4, 2 * DFF, D, (f16*)(ws + WS_WGU2), cursor, tbase, tl);
    prep_weight(P, 5, D, DFF, (f16*)(ws + WS_WD2), cursor, tbase, tl);
    float* ss0 = (float*)(ws + WS_SS0);
    f16* acta = (f16*)(ws + WS_ACTA);
    const int gw = bid * 8 + (tid >> 6), nw = G * 8;
    for (int p = gw; p < L; p += nw) {
        const float* src = p < SEQ ? P.x + (size_t)p * D : P.meta + (size_t)(p - SEQ) * D; float s = 0.f;
#pragma unroll
        for (int i = 0; i < 4; ++i) { const f32x4 v = *(const f32x4*)(src + lane * 4 + 256 * i); s += (v[0] * v[0] + v[1] * v[1]) + (v[2] * v[2] + v[3] * v[3]); *(half4*)(acta + (size_t)p * D + lane * 4 + 256 * i) = to_half4(v); }
#pragma unroll
        for (int o = 32; o >= 1; o >>= 1) s += __shfl_xor(s, o);
        if (lane == 0) ss0[p] = s;
    }
    const int gt = bid * NTHREADS + tid, ngt = G * NTHREADS;
    for (int i = gt; i < MP; i += ngt) { if (i >= L) ss0[i] = (float)D; }
    f32x2* rope = (f32x2*)(ws + WS_ROPE);
    for (int i = gt; i < L * 32; i += ngt) { const int t = i >> 5, f = i & 31; const double inv = exp(-(double)f * (9.210340371976184 / 32.0)); double sn, cs; sincos((double)t * inv, &sn, &cs); rope[i] = (f32x2){(float)cs, (float)sn}; }
}

__device__ __forceinline__ void meta_down(const Params& P, LAS unsigned char* lds) {
    const int tid = threadIdx.x, lane = tid & 63, wid = tid >> 6;
    const f16* Gm = (const f16*)(P.ws + WS_G) + (size_t)SEQ * DFF; const f16* Wt = (const f16*)(P.ws + WS_WD1);
    f16* acta = (f16*)(P.ws + WS_ACTA); float* ss1 = (float*)(P.ws + WS_SS1); LAS float* slot = (LAS float*)lds;
    for (int task = blockIdx.x; task < NMETA * 16; task += gridDim.x) {
        const int r = task >> 4, cg = task & 15; float part = 0.f;
#pragma unroll 1
        for (int q = 0; q < 2; ++q) {
            const int n0 = cg * 64 + (2 * wid + q) * 4; float a[4] = {0.f, 0.f, 0.f, 0.f};
            for (int kc = lane; kc < DFF / 8; kc += 64) {
                const half8 gv = *(const half8*)(Gm + (size_t)r * DFF + kc * 8);
#pragma unroll
                for (int j = 0; j < 4; ++j) { const half8 wv = *(const half8*)(Wt + (size_t)(n0 + j) * DFF + kc * 8);
#pragma unroll
                    for (int e = 0; e < 8; ++e) a[j] += (float)gv[e] * (float)wv[e]; }
            }
#pragma unroll
            for (int o = 32; o >= 1; o >>= 1) { a[0] += __shfl_xor(a[0], o); a[1] += __shfl_xor(a[1], o); a[2] += __shfl_xor(a[2], o); a[3] += __shfl_xor(a[3], o); }
            f32x4 o;
#pragma unroll
            for (int j = 0; j < 4; ++j) { o[j] = P.meta[r * D + n0 + j] + 0.5f * a[j]; part += o[j] * o[j]; }
            if (lane == 0) *(half4*)(acta + (size_t)(SEQ + r) * D + n0) = to_half4(o);
        }
        if (lane == 0) slot[wid] = part;
        __syncthreads();
        if (tid == 0) { float s = 0.f; for (int w = 0; w < 8; ++w) s += slot[w]; ss1[(size_t)(SEQ + r) * 16 + cg] = s; }
        __syncthreads();
    }
}

__device__ __forceinline__ float logsigmoid_f(float z) { return fminf(z, 0.f) - log1pf(expf(-fabsf(z))); }
__device__ __forceinline__ void gla_gates(const Params& P, int c, int h, LAS float* bl) {
    const int tid = threadIdx.x; const float* GA = (const float*)(P.ws + WS_GA);
    for (int e = tid; e < 4096; e += NTHREADS) {
        const int i = e >> 6, d = e & 63, t = 64 * c - 48 + i; float g = 0.f;
        if (t >= 0 && t < L) { float z = P.ba[64 * h + d]; const float* a = GA + (size_t)t * 16;
#pragma unroll
            for (int r = 0; r < 16; ++r) z += a[r] * P.wa2[r * 256 + 64 * h + d];
            g = logsigmoid_f(z) * (1.0f / 16.0f); }
        bl[i * 65 + d] = g;
    }
    __syncthreads();
    if (tid < 64) { float run = 0.f; for (int i = 0; i < 64; ++i) { run += bl[i * 65 + tid]; bl[i * 65 + tid] = run; } }
    __syncthreads();
}
__device__ __forceinline__ void gla_a_unit(const Params& P, int unit, LAS unsigned char* lds) {
    int tid_ = threadIdx.x; asm volatile("" : "+v"(tid_));
    const int tid = tid_, lane = tid & 63, wid = tid >> 6, c = unit >> 2, h = unit & 3;
    LAS float* bl = (LAS float*)lds; LAS float* ks = bl + 4160; LAS float* vs = ks + 4096;
    const f16* GK = (const f16*)(P.ws + WS_GK); const f16* GV = (const f16*)(P.ws + WS_GV);
    float* U = (float*)(P.ws + WS_US); float* DEC = (float*)(P.ws + WS_DECAY);
    gla_gates(P, c, h, bl);
    for (int e = tid; e < 4096; e += NTHREADS) { const int j = e >> 6, d = e & 63, t = 64 * c - 48 + j; float v = 0.f;
        if (t >= 0 && t < L) v = (float)GK[(size_t)t * 256 + 64 * h + d] * __expf(bl[63 * 65 + d] - bl[j * 65 + d]); ks[j * 64 + d] = v; }
    for (int e = tid; e < 8192; e += NTHREADS) { const int j = e >> 7, x = e & 127, t = 64 * c - 48 + j; vs[j * 128 + x] = (t >= 0 && t < L) ? (float)GV[(size_t)t * 512 + 128 * h + x] : 0.f; }
    if (tid < 64) DEC[(size_t)c * 256 + h * 64 + tid] = __expf(bl[63 * 65 + tid]);
    __syncthreads();
    { const int d0 = (wid >> 2) * 32, e0 = (wid & 3) * 32, l31 = lane & 31, hf = lane >> 5; f32x16 acc;
#pragma unroll
      for (int i = 0; i < 16; ++i) acc[i] = 0.f;
#pragma unroll 8
      for (int s = 0; s < 32; ++s) acc = __builtin_amdgcn_mfma_f32_32x32x2f32(ks[(2 * s + hf) * 64 + d0 + l31], vs[(2 * s + hf) * 128 + e0 + l31], acc, 0, 0, 0);
      float* up = U + ((size_t)unit * 64) * 128;
#pragma unroll
      for (int r = 0; r < 16; ++r) { const int row = (r & 3) + 8 * (r >> 2) + 4 * hf; up[(size_t)(d0 + row) * 128 + e0 + l31] = acc[r]; } }
    __syncthreads();
}
__device__ __forceinline__ void gla_scan(const Params& P) {
    float* U = (float*)(P.ws + WS_US); const float* DEC = (const float*)(P.ws + WS_DECAY);
    const int idx = blockIdx.x * NTHREADS + threadIdx.x;
    if (idx >= 32768) return;
    float s = 0.f;
#pragma unroll 8
    for (int c = 0; c < NCH; ++c) { const float u = U[(size_t)c * 32768 + idx], dc = DEC[(size_t)c * 256 + (idx >> 7)]; U[(size_t)c * 32768 + idx] = s; s = dc * s + u; }
}
__device__ __forceinline__ void gla_c_unit(const Params& P, int unit, LAS unsigned char* lds) {
    int tid_ = threadIdx.x; asm volatile("" : "+v"(tid_));
    const int tid = tid_, lane = tid & 63, wid = tid >> 6, c = unit >> 2, h = unit & 3, l31 = lane & 31, hf = lane >> 5;
    LAS float* bl = (LAS float*)lds; LAS float* kk = bl + 4160; LAS float* qs = kk + 4160; LAS float* As = qs + 4160; LAS float* vs = As + 4160; LAS float* os = bl;
    const f16* GQ = (const f16*)(P.ws + WS_GQ); const f16* GK = (const f16*)(P.ws + WS_GK); const f16* GV = (const f16*)(P.ws + WS_GV); const f16* GR = (const f16*)(P.ws + WS_GR);
    const float* Sg = (const float*)(P.ws + WS_US) + (size_t)unit * 8192; f16* mix = (f16*)(P.ws + WS_ACTA);
    gla_gates(P, c, h, bl);
    for (int e = tid; e < 4096; e += NTHREADS) { const int i = e >> 6, d = e & 63, t = 64 * c - 48 + i; float q = 0.f, k = 0.f;
        if (t >= 0 && t < L) { const float b = bl[i * 65 + d]; q = (float)GQ[(size_t)t * 256 + 64 * h + d] * 0.125f * __expf(b); k = (float)GK[(size_t)t * 256 + 64 * h + d] * __expf(-b); }
        qs[i * 65 + d] = q; kk[i * 65 + d] = k; }
    for (int e = tid; e < 8192; e += NTHREADS) { const int j = e >> 7, x = e & 127, t = 64 * c - 48 + j; vs[j * 128 + x] = (t >= 0 && t < L) ? (float)GV[(size_t)t * 512 + 128 * h + x] : 0.f; }
    __syncthreads();
    if (wid < 4) { const int i0 = (wid >> 1) * 32, j0 = (wid & 1) * 32; f32x16 acc;
#pragma unroll
        for (int i = 0; i < 16; ++i) acc[i] = 0.f;
#pragma unroll 8
        for (int s = 0; s < 32; ++s) acc = __builtin_amdgcn_mfma_f32_32x32x2f32(qs[(i0 + l31) * 65 + 2 * s + hf], kk[(j0 + l31) * 65 + 2 * s + hf], acc, 0, 0, 0);
#pragma unroll
        for (int r = 0; r < 16; ++r) { const int i = i0 + (r & 3) + 8 * (r >> 2) + 4 * hf, j = j0 + l31; As[i * 65 + j] = (j <= i) ? acc[r] : 0.f; } }
    __syncthreads();
    { const int i0 = (wid >> 2) * 32, e0 = (wid & 3) * 32; f32x16 acc;
#pragma unroll
      for (int i = 0; i < 16; ++i) acc[i] = 0.f;
#pragma unroll 8
      for (int s = 0; s < 32; ++s) acc = __builtin_amdgcn_mfma_f32_32x32x2f32(qs[(i0 + l31) * 65 + 2 * s + hf], Sg[(size_t)(2 * s + hf) * 128 + e0 + l31], acc, 0, 0, 0);
#pragma unroll 8
      for (int s = 0; s < 32; ++s) acc = __builtin_amdgcn_mfma_f32_32x32x2f32(As[(i0 + l31) * 65 + 2 * s + hf], vs[(2 * s + hf) * 128 + e0 + l31], acc, 0, 0, 0);
#pragma unroll
      for (int r = 0; r < 16; ++r) { const int i = i0 + (r & 3) + 8 * (r >> 2) + 4 * hf; os[i * 129 + e0 + l31] = acc[r]; } }
    __syncthreads();
    { const int i = tid >> 3, e0 = (tid & 7) * 16, t = 64 * c - 48 + i; float o[16], s = 0.f;
#pragma unroll
      for (int j = 0; j < 16; ++j) { o[j] = os[i * 129 + e0 + j]; s += o[j] * o[j]; }
      s += __shfl_xor(s, 1); s += __shfl_xor(s, 2); s += __shfl_xor(s, 4);
      const float rs = rsqrtf(s * (1.0f / 128.0f) + EPS);
      if (t >= NMETA && t < L) {
#pragma unroll
          for (int j4 = 0; j4 < 4; ++j4) { f32x4 v;
#pragma unroll
              for (int j = 0; j < 4; ++j) { const int e = e0 + 4 * j4 + j; v[j] = o[4 * j4 + j] * rs * P.hn[e] * silu_f((float)GR[(size_t)t * 512 + 128 * h + e]); }
              *(half4*)(mix + (size_t)(t - NMETA) * D + 128 * h + e0 + 4 * j4) = to_half4(v); } } }
    __syncthreads();
}

__device__ __forceinline__ unsigned mono_u(float f) { const unsigned u = __float_as_uint(f); return (u & 0x80000000u) ? ~u : (u | 0x80000000u); }
__device__ __forceinline__ float unmono_f(unsigned m) { return __uint_as_float((m & 0x80000000u) ? (m & 0x7fffffffu) : ~m); }
constexpr int CAP = 640, NPL = CAP / 64;
__device__ __forceinline__ int topk_compact(LAS float* cs, LAS unsigned short* ci, int n, bool exact, float& tau_out, int lane) {
    float sv[NPL]; unsigned iv[NPL], u[NPL];
#pragma unroll
    for (int i = 0; i < NPL; ++i) { const int p = lane + 64 * i; const bool v = p < n; sv[i] = v ? cs[p] : 0.f; iv[i] = v ? (unsigned)ci[p] : 0xffffu; u[i] = v ? mono_u(sv[i]) : 0u; }
    unsigned T = 0u; bool full = true; int hb = 31;
    {
        unsigned umx = 0u, umn = 0xffffffffu;
#pragma unroll
        for (int i = 0; i < NPL; ++i) { umx = max(umx, u[i]); umn = min(umn, (lane + 64 * i < n) ? u[i] : 0xffffffffu); }
#pragma unroll
        for (int o = 32; o >= 1; o >>= 1) { umx = max(umx, (unsigned)__shfl_xor((int)umx, o)); umn = min(umn, (unsigned)__shfl_xor((int)umn, o)); }
        const unsigned df = umx ^ umn;
        if (df == 0u) { hb = -1; T = umx; } else { hb = 31 - __clz(df); T = (hb == 31) ? 0u : (umx & ~((2u << hb) - 1u)); }
    }
#pragma unroll 1
    for (int bit = hb; bit >= 0; --bit) {
        const unsigned cand = T | (1u << bit); int cgt = 0;
#pragma unroll
        for (int i = 0; i < NPL; ++i) cgt += __popcll(__ballot(u[i] >= cand));
        if (cgt >= 256) { T = cand; if (!exact && cgt <= 272) { full = false; break; } }
    }
    bool keep[NPL];
    if (full) {
        int cgt = 0;
#pragma unroll
        for (int i = 0; i < NPL; ++i) cgt += __popcll(__ballot(u[i] > T));
        const int need = 256 - cgt; unsigned I = 0u;
#pragma unroll 1
        for (int bit = 15; bit >= 0; --bit) { const unsigned cand = I | (1u << bit); int cl = 0;
#pragma unroll
            for (int i = 0; i < NPL; ++i) cl += __popcll(__ballot(u[i] == T && iv[i] < cand));
            if (cl < need) I = cand; }
#pragma unroll
        for (int i = 0; i < NPL; ++i) keep[i] = (u[i] > T) || (u[i] == T && iv[i] <= I);
    } else {
#pragma unroll
        for (int i = 0; i < NPL; ++i) keep[i] = u[i] >= T;
    }
    int nn = 0;
#pragma unroll
    for (int i = 0; i < NPL; ++i) { const unsigned long long m = __ballot(keep[i]); const int pre = __builtin_amdgcn_mbcnt_hi((unsigned)(m >> 32), __builtin_amdgcn_mbcnt_lo((unsigned)m, 0u));
        if (keep[i]) { cs[nn + pre] = sv[i]; ci[nn + pre] = (unsigned short)iv[i]; } nn += __popcll(m); }
    tau_out = unmono_f(T);
    return nn;
}
__device__ __forceinline__ float relu_asm(float x) { return __int_as_float(max(__float_as_int(x), 0)); }
__device__ __forceinline__ void indexer_tile(const Params& P, int tile, LAS unsigned char* lds) {
    int tid_ = threadIdx.x; asm volatile("" : "+v"(tid_));
    const int tid = tid_, lane = tid & 63, wid = __builtin_amdgcn_readfirstlane(tid >> 6), l31 = lane & 31, hf = lane >> 5;
    LAS float* candS = (LAS float*)lds;
    LAS unsigned short* candI = (LAS unsigned short*)(lds + 32 * CAP * 4);
    LAS unsigned char* kbuf = lds + 32 * CAP * 6;
    LAS int* lcnt = (LAS int*)(lds + LDS_BYTES - 1024 + 64);
    LAS int* lflag = (LAS int*)(lds + LDS_BYTES - 1024 + 192);
    const f16* IQ = (const f16*)(P.ws + WS_IQ); const f16* IK = (const f16*)(P.ws + WS_IK); const float* IW = (const float*)(P.ws + WS_IW);
    unsigned short* SEL = (unsigned short*)(P.ws + WS_SEL);
    const int t0 = tile * 32, tw = t0 + wid * 4;
    half8 afr[4];
    { const int qi = 2 * (l31 >> 4) + ((l31 >> 2) & 1), hd = 4 * ((l31 >> 3) & 1) + (l31 & 3); int tq = tw + qi; if (tq > L - 1) tq = L - 1;
      const half8* ap = (const half8*)(IQ + (size_t)tq * 512 + hd * 64);
#pragma unroll
      for (int s = 0; s < 4; ++s) afr[s] = ap[2 * s + hf]; }
    float w0[8], w1[8];
    { int ta = tw + hf, tb = tw + 2 + hf; if (ta > L - 1) ta = L - 1; if (tb > L - 1) tb = L - 1;
#pragma unroll
      for (int h = 0; h < 8; ++h) { w0[h] = IW[(size_t)ta * 8 + h]; w1[h] = IW[(size_t)tb * 8 + h]; } }
    asm volatile("" :: "v"(afr[0]), "v"(afr[1]), "v"(afr[2]), "v"(afr[3]));
    asm volatile("" :: "v"(w0[0]), "v"(w0[1]), "v"(w0[2]), "v"(w0[3]), "v"(w0[4]), "v"(w0[5]), "v"(w0[6]), "v"(w0[7]));
    asm volatile("" :: "v"(w1[0]), "v"(w1[1]), "v"(w1[2]), "v"(w1[3]), "v"(w1[4]), "v"(w1[5]), "v"(w1[6]), "v"(w1[7]));
    const int tq0 = (tw + hf < L) ? tw + hf : -1, tq1 = (tw + 2 + hf < L) ? tw + 2 + hf : -1;
    float tau0 = -__builtin_inff(), tau1 = -__builtin_inff();
    int cntv = 0;
    if (lane < 4) lcnt[wid * 4 + lane] = 0;
    if (tid < 3) lflag[tid] = 0;
    const int nkeys = (t0 + 32 < L) ? t0 + 32 : L, nst = (nkeys + 127) >> 7;
    u32x4 stg[2];
    const u32x4* IKv = (const u32x4*)IK;
#pragma unroll
    for (int i = 0; i < 2; ++i) stg[i] = IKv[(size_t)0 * 1024 + tid + 512 * i];
#pragma unroll
    for (int i = 0; i < 2; ++i) { const int ci = tid + 512 * i, row = ci >> 3, ch = ci & 7; *(LAS u32x4*)(kbuf + row * 128 + ((ch ^ ((row >> 1) & 7)) << 4)) = stg[i]; }
    __syncthreads();
#pragma unroll 1
    for (int st = 0; st < nst; ++st) {
        LAS unsigned char* kb = kbuf + (st & 1) * 16384;
        if (st + 1 < nst) {
#pragma unroll
            for (int i = 0; i < 2; ++i) stg[i] = IKv[(size_t)(st + 1) * 1024 + tid + 512 * i];
        }
#pragma unroll 1
        for (int sub = 0; sub < 4; ++sub) {
            const int kbase = st * 128 + sub * 32;
            if (kbase > tw + 3) break;
            const int row = sub * 32 + l31;
            f32x16 acc;
#pragma unroll
            for (int i = 0; i < 16; ++i) acc[i] = 0.f;
#pragma unroll
            for (int s = 0; s < 4; ++s) { const half8 bfr = *(const LAS half8*)(kb + row * 128 + (((2 * s + hf) ^ ((row >> 1) & 7)) << 4)); acc = __builtin_amdgcn_mfma_f32_32x32x16_f16(afr[s], bfr, acc, 0, 0, 0); }
            float s0 = 0.f, s1 = 0.f;
#pragma unroll
            for (int h = 0; h < 8; ++h) { s0 = __builtin_fmaf(w0[h], relu_asm(acc[h]), s0); s1 = __builtin_fmaf(w1[h], relu_asm(acc[8 + h]), s1); }
            const int key = kbase + l31;
            if (key <= tq0 && s0 > tau0) { const int qs = wid * 4 + hf; const int pos = (int)__hip_atomic_fetch_add(lcnt + qs, 1, __ATOMIC_RELAXED, __HIP_MEMORY_SCOPE_WORKGROUP); candS[qs * CAP + pos] = s0; candI[qs * CAP + pos] = (unsigned short)key; }
            if (key <= tq1 && s1 > tau1) { const int qs = wid * 4 + 2 + hf; const int pos = (int)__hip_atomic_fetch_add(lcnt + qs, 1, __ATOMIC_RELAXED, __HIP_MEMORY_SCOPE_WORKGROUP); candS[qs * CAP + pos] = s1; candI[qs * CAP + pos] = (unsigned short)key; }
        }
        if (st + 1 < nst) {
            LAS unsigned char* kn = kbuf + ((st + 1) & 1) * 16384;
#pragma unroll
            for (int i = 0; i < 2; ++i) { const int ci = tid + 512 * i, row = ci >> 3, ch = ci & 7; *(LAS u32x4*)(kn + row * 128 + ((ch ^ ((row >> 1) & 7)) << 4)) = stg[i]; }
        }
        cntv = lcnt[wid * 4 + (lane & 3)];
        const int mx = max(max(__builtin_amdgcn_readlane(cntv, 0), __builtin_amdgcn_readlane(cntv, 1)), max(__builtin_amdgcn_readlane(cntv, 2), __builtin_amdgcn_readlane(cntv, 3)));
        if (mx > CAP - 128 && lane == 0) lflag[st % 3] = 1;
        if (tid == 0) lflag[(st + 1) % 3] = 0;
        __syncthreads();
        const int any = lflag[st % 3];
        if (any) {
#pragma unroll 1
            for (int qq = 0; qq < 4; ++qq) { const int n = __builtin_amdgcn_readlane(cntv, qq);
                if (n > 288) { float nt; const int nn = topk_compact(candS + (wid * 4 + qq) * CAP, candI + (wid * 4 + qq) * CAP, n, false, nt, lane);
                    if (lane == 0) lcnt[wid * 4 + qq] = nn;
                    if (hf == (qq & 1)) { if (qq < 2) tau0 = nt; else tau1 = nt; } } }
        }
    }
#pragma unroll 1
    for (int qq = 0; qq < 4; ++qq) {
        const int t = tw + qq; if (t >= L) break;
        int n = lcnt[wid * 4 + qq]; LAS float* cs = candS + (wid * 4 + qq) * CAP; LAS unsigned short* ci = candI + (wid * 4 + qq) * CAP;
        if (n > 256) { float nt; n = topk_compact(cs, ci, n, true, nt, lane); }
#pragma unroll
        for (int j = 0; j < 4; ++j) { const int p = lane + 64 * j; SEL[(size_t)t * 256 + p] = p < n ? ci[p] : (unsigned short)0xffffu; }
    }
    __syncthreads();
}

#ifdef SCORE_ONLY_EXP
__device__ __forceinline__ void indexer_score_only(const Params& P, int tile, LAS unsigned char* lds) {
    int tid_ = threadIdx.x; asm volatile("" : "+v"(tid_));
    const int tid = tid_, lane = tid & 63, wid = __builtin_amdgcn_readfirstlane(tid >> 6), l31 = lane & 31, hf = lane >> 5;
    LAS float* candS = (LAS float*)lds;
    LAS unsigned short* candI = (LAS unsigned short*)(lds + 32 * CAP * 4);
    LAS unsigned char* kbuf = lds + 32 * CAP * 6;
    const f16* IQ = (const f16*)(P.ws + WS_IQ); const f16* IK = (const f16*)(P.ws + WS_IK); const float* IW = (const float*)(P.ws + WS_IW);
    unsigned short* SEL = (unsigned short*)(P.ws + WS_SEL);
    const int t0 = tile * 32, tw = t0 + wid * 4;
    half8 afr[4];
    { const int qi = 2 * (l31 >> 4) + ((l31 >> 2) & 1), hd = 4 * ((l31 >> 3) & 1) + (l31 & 3); int tq = tw + qi; if (tq > L - 1) tq = L - 1;
      const half8* ap = (const half8*)(IQ + (size_t)tq * 512 + hd * 64);
#pragma unroll
      for (int s = 0; s < 4; ++s) afr[s] = ap[2 * s + hf]; }
    float w0[8], w1[8];
    { int ta = tw + hf, tb = tw + 2 + hf; if (ta > L - 1) ta = L - 1; if (tb > L - 1) tb = L - 1;
#pragma unroll
      for (int h = 0; h < 8; ++h) { w0[h] = IW[(size_t)ta * 8 + h]; w1[h] = IW[(size_t)tb * 8 + h]; } }
    asm volatile("" :: "v"(afr[0]), "v"(afr[1]), "v"(afr[2]), "v"(afr[3]));
    asm volatile("" :: "v"(w0[0]), "v"(w0[1]), "v"(w0[2]), "v"(w0[3]), "v"(w0[4]), "v"(w0[5]), "v"(w0[6]), "v"(w0[7]));
    asm volatile("" :: "v"(w1[0]), "v"(w1[1]), "v"(w1[2]), "v"(w1[3]), "v"(w1[4]), "v"(w1[5]), "v"(w1[6]), "v"(w1[7]));
    const int tq0 = (tw + hf < L) ? tw + hf : -1, tq1 = (tw + 2 + hf < L) ? tw + 2 + hf : -1;
    float tau0 = -__builtin_inff(), tau1 = -__builtin_inff();
    int cntv = 0; float sink = 0.f;
    const int nkeys = (t0 + 32 < L) ? t0 + 32 : L, nst = (nkeys + 127) >> 7;
    u32x4 stg[2];
    const u32x4* IKv = (const u32x4*)IK;
#pragma unroll
    for (int i = 0; i < 2; ++i) stg[i] = IKv[(size_t)0 * 1024 + tid + 512 * i];
#pragma unroll
    for (int i = 0; i < 2; ++i) { const int ci = tid + 512 * i, row = ci >> 3, ch = ci & 7; *(LAS u32x4*)(kbuf + row * 128 + ((ch ^ ((row >> 1) & 7)) << 4)) = stg[i]; }
    __syncthreads();
#pragma unroll 1
    for (int st = 0; st < nst; ++st) {
        LAS unsigned char* kb = kbuf + (st & 1) * 16384;
        if (st + 1 < nst) {
#pragma unroll
            for (int i = 0; i < 2; ++i) stg[i] = IKv[(size_t)(st + 1) * 1024 + tid + 512 * i];
        }
#pragma unroll 1
        for (int sub = 0; sub < 4; ++sub) {
            const int kbase = st * 128 + sub * 32;
            if (kbase > tw + 3) break;
            const int row = sub * 32 + l31;
            f32x16 acc;
#pragma unroll
            for (int i = 0; i < 16; ++i) acc[i] = 0.f;
#pragma unroll
            for (int s = 0; s < 4; ++s) { const half8 bfr = *(const LAS half8*)(kb + row * 128 + (((2 * s + hf) ^ ((row >> 1) & 7)) << 4)); acc = __builtin_amdgcn_mfma_f32_32x32x16_f16(afr[s], bfr, acc, 0, 0, 0); }
            float s0 = 0.f, s1 = 0.f;
#pragma unroll
            for (int h = 0; h < 8; ++h) { s0 = __builtin_fmaf(w0[h], relu_asm(acc[h]), s0); s1 = __builtin_fmaf(w1[h], relu_asm(acc[8 + h]), s1); }
            const int key = kbase + l31;
            sink += (key <= tq0 && s0 > tau0) ? s0 : 0.f; sink += (key <= tq1 && s1 > tau1) ? s1 : 0.f;
        }
        if (st + 1 < nst) {
            LAS unsigned char* kn = kbuf + ((st + 1) & 1) * 16384;
#pragma unroll
            for (int i = 0; i < 2; ++i) { const int ci = tid + 512 * i, row = ci >> 3, ch = ci & 7; *(LAS u32x4*)(kn + row * 128 + ((ch ^ ((row >> 1) & 7)) << 4)) = stg[i]; }
        }
        __syncthreads();
    }
    if (sink == 12345.678f) ((float*)(P.ws + WS_CTL))[200 + (tid & 31)] = sink + (float)cntv;
    __syncthreads();
}

#endif
__device__ __forceinline__ void sparse_attn(const Params& P, LAS unsigned char* lds, int vbid) {
    int tid_ = threadIdx.x; asm volatile("" : "+v"(tid_));
    const int tid = tid_, lane = tid & 63, wid = tid >> 6, grp = lane >> 2, c4 = lane & 3;
    const int head = vbid & 7, slot = (vbid >> 3) * 8 + wid, nslot = (gridDim.x >> 3) * 8;
    LAS unsigned short* widx = (LAS unsigned short*)(lds + wid * 512);
    LAS float* red = (LAS float*)(lds + 4096 + wid * 4352);
    const unsigned short* SEL = (const unsigned short*)(P.ws + WS_SEL); const f16* DQ = (const f16*)(P.ws + WS_DQ);
    const unsigned char* kvh = P.ws + WS_KV + (size_t)head * LP * 128; f16* mix = (f16*)(P.ws + WS_ACTA);
    int t = NMETA + slot;
    u32x2 selr = {0u, 0u}; half8 qa, qb;
#pragma unroll
    for (int e = 0; e < 8; ++e) { qa[e] = (f16)0.f; qb[e] = (f16)0.f; }
    if (t < L) { selr = *(const u32x2*)(SEL + (size_t)t * 256 + lane * 4); qa = *(const half8*)(DQ + (size_t)t * 512 + head * 64 + c4 * 16); qb = *(const half8*)(DQ + (size_t)t * 512 + head * 64 + c4 * 16 + 8); }
#pragma unroll 1
    for (; t < L; t += nslot) {
        *(LAS u32x2*)(widx + lane * 4) = selr;
        unsigned keys[16]; u32x4 kreg[16], vreg[16];
#pragma unroll
        for (int it = 0; it < 16; ++it) keys[it] = widx[16 * it + grp];
#pragma unroll
        for (int it = 0; it < 16; ++it) { const unsigned kk = keys[it] != 0xffffu ? keys[it] : 0u; kreg[it] = *(const u32x4*)(kvh + (size_t)kk * 128 + c4 * 16); }
#pragma unroll
        for (int it = 0; it < 16; ++it) { const unsigned kk = keys[it] != 0xffffu ? keys[it] : 0u; vreg[it] = *(const u32x4*)(kvh + (size_t)kk * 128 + 64 + c4 * 16); }
        f32x2 q2[8];
#pragma unroll
        for (int e = 0; e < 4; ++e) { q2[e] = (f32x2){(float)qa[2 * e], (float)qa[2 * e + 1]} * (1.0f / KV_SCALE); q2[4 + e] = (f32x2){(float)qb[2 * e], (float)qb[2 * e + 1]} * (1.0f / KV_SCALE); }
        { const int tn = t + nslot;
          if (tn < L) { selr = *(const u32x2*)(SEL + (size_t)tn * 256 + lane * 4); qa = *(const half8*)(DQ + (size_t)tn * 512 + head * 64 + c4 * 16); qb = *(const half8*)(DQ + (size_t)tn * 512 + head * 64 + c4 * 16 + 8); } }
        float lg[16]; float mx = -__builtin_inff();
#pragma unroll
        for (int it = 0; it < 16; ++it) {
            f32x2 a2 = {0.f, 0.f};
#pragma unroll
            for (int w = 0; w < 4; ++w) { a2 += q2[2 * w] * __builtin_amdgcn_cvt_pk_f32_fp8((int)kreg[it][w], false); a2 += q2[2 * w + 1] * __builtin_amdgcn_cvt_pk_f32_fp8((int)kreg[it][w], true); }
            float part = a2[0] + a2[1];
            part += __shfl_xor(part, 1); part += __shfl_xor(part, 2);
            lg[it] = keys[it] != 0xffffu ? part : -__builtin_inff(); mx = fmaxf(mx, lg[it]);
        }
        mx = fmaxf(mx, __shfl_xor(mx, 4)); mx = fmaxf(mx, __shfl_xor(mx, 8)); mx = fmaxf(mx, __shfl_xor(mx, 16)); mx = fmaxf(mx, __shfl_xor(mx, 32));
        f32x2 o2[8]; float lsum = 0.f;
#pragma unroll
        for (int e = 0; e < 8; ++e) o2[e] = (f32x2){0.f, 0.f};
#pragma unroll
        for (int it = 0; it < 16; ++it) {
            const float p = __expf(lg[it] - mx); lsum += p; const f32x2 p2 = {p, p};
#pragma unroll
            for (int w = 0; w < 4; ++w) { o2[2 * w] += p2 * __builtin_amdgcn_cvt_pk_f32_fp8((int)vreg[it][w], false); o2[2 * w + 1] += p2 * __builtin_amdgcn_cvt_pk_f32_fp8((int)vreg[it][w], true); }
        }
        lsum += __shfl_xor(lsum, 4); lsum += __shfl_xor(lsum, 8); lsum += __shfl_xor(lsum, 16); lsum += __shfl_xor(lsum, 32);
#pragma unroll
        for (int e = 0; e < 8; ++e) { red[lane * 17 + 2 * e] = o2[e][0]; red[lane * 17 + 2 * e + 1] = o2[e][1]; }
        float acc = 0.f;
        { const int cc = lane >> 4, e = lane & 15;
#pragma unroll
          for (int g = 0; g < 16; ++g) acc += red[(g * 4 + cc) * 17 + e]; }
        mix[(size_t)(t - NMETA) * D + 512 + head * 64 + lane] = (f16)(acc * (1.0f / KV_SCALE) / lsum);
    }
    __syncthreads();
}

__device__ __forceinline__ void final_norm(const Params& P) {
    const int tid = threadIdx.x, lane = tid & 63, gw = blockIdx.x * 8 + (tid >> 6), nw = gridDim.x * 8;
    const float* ss3 = (const float*)(P.ws + WS_SS3);
    for (int r = gw; r < SEQ; r += nw) { const float rs = row_rstd(ss3, 16, r);
#pragma unroll
        for (int i = 0; i < 4; ++i) { const int k = lane * 4 + 256 * i; const f32x4 v = *(const f32x4*)(P.out + (size_t)r * D + k), g = *(const f32x4*)(P.nf + k); *(f32x4*)(P.out + (size_t)r * D + k) = v * rs * g; } }
}

#define XB_TMO      128
#define XB_XCNT(j)  (256  + 64 * (j))
#define XB_XSUB(j)  (1280 + 64 * (j))
#define XB_XGEN(j)  (2304 + 64 * (j))
#define XB_TOP      3328
#define XB_TOPGEN   3392
#define XCD_BAR_WORDS 3456
#define XB_SPIN_CAP (1u << 22)
__device__ __forceinline__ unsigned xb_ld(unsigned* p)              { return __hip_atomic_load(p, __ATOMIC_RELAXED, __HIP_MEMORY_SCOPE_AGENT); }
__device__ __forceinline__ unsigned xb_add(unsigned* p, unsigned v) { return __hip_atomic_fetch_add(p, v, __ATOMIC_RELAXED, __HIP_MEMORY_SCOPE_AGENT); }
__device__ __forceinline__ unsigned xb_xcc_id() { return (unsigned)__builtin_amdgcn_s_getreg((3 << 11) | 20) & 0xFu; }
#define XB_SPIN(cond, bar) do { unsigned _sp = 0; while (cond) { __builtin_amdgcn_s_sleep(1); \
    if ((++_sp & 255u) == 0u) { if (xb_ld(&(bar)[XB_TMO])) break; if (_sp > XB_SPIN_CAP) { atomicAdd(&(bar)[XB_TMO], 1u); break; } } } } while (0)
struct XcdBarrier { unsigned* bar; unsigned x; volatile LAS unsigned* st; };
__device__ __forceinline__ XcdBarrier xcd_barrier_post(unsigned* bar, volatile LAS unsigned* st) {
    XcdBarrier b; b.bar = bar; b.x = xb_xcc_id(); b.st = st;
    if (threadIdx.x == 0) (void)xb_add(&bar[XB_XCNT(b.x)], 1u);
    return b;
}
__device__ __forceinline__ void xcd_barrier_complete(unsigned* bar, unsigned x, unsigned& nloc, unsigned& nx) {
    const unsigned G = gridDim.x * gridDim.y * gridDim.z;
    unsigned sum, cnt, mine, sp = 0u;
    for (;;) {
        sum = 0u; cnt = 0u; mine = 0u;
#pragma unroll
        for (unsigned j = 0; j < 16; ++j) { const unsigned c = xb_ld(&bar[XB_XCNT(j)]); sum += c; cnt += (c > 0u) ? 1u : 0u; mine = (j == x) ? c : mine; }
        if (sum == G) break;
        __builtin_amdgcn_s_sleep(1);
        if ((++sp & 255u) == 0u) { if (xb_ld(&bar[XB_TMO])) break; if (sp > XB_SPIN_CAP) { atomicAdd(&bar[XB_TMO], 1u); break; } }
    }
    nloc = mine > 0u ? mine : 1u; nx = cnt > 0u ? cnt : 1u;
}
__device__ __forceinline__ void xcd_barrier(const XcdBarrier& b) {
    asm volatile("s_waitcnt vmcnt(0)" ::: "memory");
    __syncthreads();
    if (threadIdx.x == 0) {
        unsigned* bar = b.bar;
        __builtin_amdgcn_s_waitcnt(0);
        unsigned nloc = b.st[0], nx = b.st[1];
        if (nloc == 0u) { xcd_barrier_complete(bar, b.x, nloc, nx); b.st[0] = nloc; b.st[1] = nx; }
        const unsigned old = xb_add(&bar[XB_XSUB(b.x)], 1u);
        const unsigned gen = old / nloc;
        if (old + 1u == (gen + 1u) * nloc) {
            __builtin_amdgcn_fence(__ATOMIC_RELEASE, "agent");
            asm volatile("s_waitcnt vmcnt(0)" ::: "memory");
            const unsigned og = xb_add(&bar[XB_TOP], 1u);
            const unsigned tg = og / nx;
            if (og + 1u == (tg + 1u) * nx) xb_add(&bar[XB_TOPGEN], 1u);
            else XB_SPIN(xb_ld(&bar[XB_TOPGEN]) == tg, bar);
            __builtin_amdgcn_fence(__ATOMIC_ACQUIRE, "agent");
            xb_add(&bar[XB_XGEN(b.x)], 1u);
            asm volatile("s_waitcnt vmcnt(0)" ::: "memory");
        } else {
            XB_SPIN(xb_ld(&bar[XB_XGEN(b.x)]) == gen, bar);
            __builtin_amdgcn_fence(__ATOMIC_ACQUIRE, "agent");
            asm volatile("s_waitcnt vmcnt(0)" ::: "memory");
        }
    }
    __syncthreads();
}

__global__ void __launch_bounds__(NTHREADS, 2) fwd_kernel(Params P) {
    __shared__ __attribute__((aligned(16))) unsigned char lds_raw[LDS_BYTES];
    LAS unsigned char* lds = (LAS unsigned char*)lds_raw;
    const int tid = threadIdx.x, bid = blockIdx.x, G = gridDim.x;
    unsigned char* ws = P.ws;
    const int lo = P.ph_lo, hi = P.ph_hi;
#ifndef ONLY_PHASE
#define ONLY_PHASE -1
#endif
#define IN(k) ((ONLY_PHASE < 0 || ONLY_PHASE == (k)) && lo <= (k) && (k) < hi)
#ifdef PROBE
#define STAMP(k) do { if (bid == 0 && tid == 0) ((unsigned long long*)(ws + WS_CTL + 1024))[(k)] = __builtin_amdgcn_s_memrealtime(); } while (0)
#else
#define STAMP(k) do { } while (0)
#endif
#define SEAM(k) do { if (IN(k) && IN((k) + 1)) { if ((k) == 0) cg::this_grid().sync(); else xcd_barrier(xbar); } STAMP((k) + 1); } while (0)
    XcdBarrier xbar; xbar.bar = (unsigned*)(ws + WS_BAR); xbar.x = 0; xbar.st = (volatile LAS unsigned*)(lds + LDS_BYTES - 1024 + 16);
    if (hi - lo > 1) {
        if (tid == 0) { xbar.st[0] = 0u; xbar.st[1] = 0u; }
        __syncthreads();
        xbar = xcd_barrier_post((unsigned*)(ws + WS_BAR), (volatile LAS unsigned*)(lds + LDS_BYTES - 1024 + 16));
    }
    LAS int* misc = (LAS int*)(lds + LDS_BYTES - 1024);
    if (hi - lo > 1) {
        if (tid == 0) { const unsigned xcc = xb_xcc_id() & 7u; misc[8] = (int)xcc; misc[9] = (int)xb_add((unsigned*)(ws + WS_CTL) + 32 + 32 * xcc, 1u); }
    }
    int vbid = bid;
    f16* acta = (f16*)(ws + WS_ACTA); f16* Gb = (f16*)(ws + WS_G);
    float* ss0 = (float*)(ws + WS_SS0); float* ss1 = (float*)(ws + WS_SS1); float* ss2 = (float*)(ws + WS_SS2); float* ss3 = (float*)(ws + WS_SS3);
    STAMP(0);
    _Pragma("unroll 1") for (int rep = 0; rep < (REPEAT_PH == 0 ? 2 : 1); ++rep)
    if (IN(0)) { p0_prologue(P, lds); }
    SEAM(0);
    if (hi - lo > 1 && (G & 7) == 0) {
        if (tid == 0) { bool ok = true; for (int j = 0; j < 8; ++j) ok = ok && (xb_ld((unsigned*)(ws + WS_CTL) + 32 + 32 * j) == (unsigned)(G >> 3)); misc[10] = ok ? misc[9] * 8 + misc[8] : bid; }
        __syncthreads();
        vbid = misc[10];
        __syncthreads();
    }
    _Pragma("unroll 1") for (int rep = 0; rep < (REPEAT_PH == 1 ? 2 : 1); ++rep)
    if (IN(1)) {
        pg8::Gemm g{acta, (const f16*)(ws + WS_WGU1), MP, 2 * DFF, D}; pg8::StaticOrder S; S.init(MP, 2 * DFF, G, vbid);
        EpiSwiglu E{Gb, ss0, rep == 0 ? 1 : -1}; pg8::gemm_phase(lds, g, S, E);
    }
    SEAM(1);
    _Pragma("unroll 1") for (int rep = 0; rep < (REPEAT_PH == 2 ? 2 : 1); ++rep)
    if (IN(2)) {
        meta_down(P, lds);
        pg8::Gemm g{Gb, (const f16*)(ws + WS_WD1), SEQ, D, DFF}; pg8::StaticOrder S; S.init(SEQ, D, G, vbid);
        EpiResid E{P.x, P.out, acta, ss1, 0.5f}; pg8::gemm_phase(lds, g, S, E);
    }
    SEAM(2);
    _Pragma("unroll 1") for (int rep = 0; rep < (REPEAT_PH == 3 ? 2 : 1); ++rep)
    if (IN(3)) {
        pg8::Gemm g{acta, (const f16*)(ws + WS_WIN), MP, NIN, D}; pg8::StaticOrder S; S.init(MP, NIN, G, vbid);
        EpiInProj E{ss1, (const f32x2*)(ws + WS_ROPE), ws};
        pg8::gemm_phase(lds, g, S, E);
    }
    SEAM(3);
    _Pragma("unroll 1") for (int rep = 0; rep < (REPEAT_PH == 4 ? 2 : 1); ++rep)
    if (IN(4)) { for (int u = bid; u < NCH * 4; u += G) gla_a_unit(P, u, lds); }
    SEAM(4);
    _Pragma("unroll 1") for (int rep = 0; rep < (REPEAT_PH == 5 ? 2 : 1); ++rep)
    if (IN(5)) {
        if (bid < 64 && rep == 0) gla_scan(P);
        unsigned* ctr = (unsigned*)(ws + WS_CTL) + rep; LAS int* bc = (LAS int*)(lds + LDS_BYTES - 1024);
        for (;;) {
            if (tid == 0) bc[0] = (int)atomicAdd(ctr, 1u);
            __syncthreads();
            const int k = bc[0];
            __syncthreads();
            if (k >= 513) break;
            indexer_tile(P, 512 - k, lds);
        }
#ifdef SCORE_ONLY_EXP
        { unsigned* ctr2 = (unsigned*)(ws + WS_CTL) + 8;
          for (;;) {
            if (tid == 0) bc[0] = (int)atomicAdd(ctr2, 1u);
            __syncthreads();
            const int k = bc[0];
            __syncthreads();
            if (k >= 513) break;
            indexer_score_only(P, 512 - k, lds);
          } }
#endif
    }
    SEAM(5);
    _Pragma("unroll 1") for (int rep = 0; rep < (REPEAT_PH == 6 ? 2 : 1); ++rep)
    if (IN(6)) { if (REPEAT_PH != 6 || rep == 0 || true) for (int u = bid; u < NCH * 4; u += G) gla_c_unit(P, u, lds); sparse_attn(P, lds, vbid); }
    for (int e = 0; e < EXTRA_SYNCS; ++e) cg::this_grid().sync();
    SEAM(6);
    if (IN(7)) {
        pg8::Gemm g{acta, (const f16*)(ws + WS_WOUT), SEQ, D, D}; pg8::StaticOrder S; S.init(SEQ, D, G, vbid);
        EpiResid E{P.out, P.out, (f16*)(ws + WS_US), ss2, 1.0f}; pg8::gemm_phase(lds, g, S, E);
    }
    SEAM(7);
    _Pragma("unroll 1") for (int rep = 0; rep < (REPEAT_PH == 8 ? 2 : 1); ++rep)
    if (IN(8)) {
        pg8::Gemm g{(const f16*)(ws + WS_US), (const f16*)(ws + WS_WGU2), SEQ, 2 * DFF, D}; pg8::StaticOrder S; S.init(SEQ, 2 * DFF, G, vbid);
        EpiSwiglu E{Gb, ss2, 16}; pg8::gemm_phase(lds, g, S, E);
    }
    SEAM(8);
    if (IN(9)) {
        pg8::Gemm g{Gb, (const f16*)(ws + WS_WD2), SEQ, D, DFF}; pg8::StaticOrder S; S.init(SEQ, D, G, vbid);
        EpiResid E{P.out, P.out, nullptr, ss3, 0.5f}; pg8::gemm_phase(lds, g, S, E);
    }
    SEAM(9);
    if (IN(10)) final_norm(P);
#ifdef PROBE
    {
        STAMP(11);
        cg::this_grid().sync();
        const unsigned long long* tsv = (const unsigned long long*)(ws + WS_CTL + 1024);
        float tph[12]; float tg = 0.f;
#pragma unroll
        for (int k = 0; k < 11; ++k) { tph[k] = (float)(tsv[k + 1] - tsv[k]) * 0.01f; }
        tph[11] = (float)(tsv[11] - tsv[0]) * 0.01f;
        const float gsum = tph[1] + tph[2] + tph[3] + tph[7] + tph[8] + tph[9];
        const float va = (PROBE_A == 12) ? gsum : tph[PROBE_A < 12 ? PROBE_A : 0], vb = (PROBE_B == 12) ? gsum : tph[PROBE_B < 12 ? PROBE_B : 0];
        const size_t n = (size_t)SEQ * D;
        for (size_t i = (size_t)bid * NTHREADS + tid; i < n; i += (size_t)G * NTHREADS) P.out[i] = (i == 0) ? va : vb * 0.01f;
        (void)tg;
    }
#endif
#ifdef DBG_CUT
    if (IN(11)) {
        const size_t n = (size_t)SEQ * D; const size_t i0 = (size_t)bid * NTHREADS + tid, st = (size_t)G * NTHREADS;
#if DBG_CUT == 6
        const f16* m = (const f16*)(ws + WS_ACTA); for (size_t i = i0; i < n; i += st) P.out[i] = (float)m[i];
#elif DBG_CUT == 5
        const unsigned short* m = (const unsigned short*)(ws + WS_SEL); for (size_t i = i0; i < n; i += st) P.out[i] = (float)m[i % ((size_t)L * 256)];
#elif DBG_CUT == 3
        const f16* a = (const f16*)(ws + WS_DQ); const f16* b = (const f16*)(ws + WS_IQ); const f16* c = (const f16*)(ws + WS_KV); const f16* d = (const f16*)(ws + WS_GQ);
        for (size_t i = i0; i < n; i += st) P.out[i] = (float)a[i % ((size_t)L * 512)] + (float)b[i % ((size_t)L * 512)] + (float)c[i] + (float)d[i % ((size_t)L * 1536)];
#elif DBG_CUT == 4
        const float* m = (const float*)(ws + WS_US); for (size_t i = i0; i < n; i += st) P.out[i] = m[i % ((size_t)NCH * 32768)];
#endif
    }
#endif
#undef IN
#undef SEAM
}

extern "C" void kernel_launch(void* const* d_in, const int* in_sizes, int n_in, void* d_out, int out_size, void* d_ws, size_t ws_size, hipStream_t stream) {
    static int grid = 0;
    if (grid == 0) {
        if (n_in != 17 || in_sizes[0] != SEQ * D || out_size != SEQ * D || ws_size < WS_END) { fprintf(stderr, "kernel_launch: unexpected shapes (n_in %d, in0 %d, out %d, ws %zu, need %zu)\n", n_in, n_in > 0 ? in_sizes[0] : -1, out_size, ws_size, (size_t)WS_END); grid = -1; return; }
        int dev = 0, cus = 0, per_cu = 0;
        (void)hipGetDevice(&dev); (void)hipDeviceGetAttribute(&cus, hipDeviceAttributeMultiprocessorCount, dev);
        if (hipOccupancyMaxActiveBlocksPerMultiprocessor(&per_cu, (const void*)fwd_kernel, NTHREADS, 0) != hipSuccess || per_cu < 1) { fprintf(stderr, "kernel_launch: occupancy query says %d blocks per CU\n", per_cu); per_cu = 1; }
        (void)hipGetLastError();
        grid = cus;
        if (grid % 8 != 0 || grid < 64) { fprintf(stderr, "kernel_launch: unexpected CU count %d\n", cus); }
    }
    if (grid < 0) return;
    if (hipMemsetAsync((char*)d_ws + WS_CTL, 0, CTL_BYTES, stream) != hipSuccess) { fprintf(stderr, "kernel_launch: memset failed\n"); return; }
    Params p{};
    const float** pp = (const float**)&p;
    for (int i = 0; i < 17; ++i) pp[i] = (const float*)d_in[i];
    p.out = (float*)d_out; p.ws = (unsigned char*)d_ws;
#if MODE == 0
#ifdef DBG_CUT
    for (int ph = 0; ph <= DBG_CUT; ++ph) { p.ph_lo = ph; p.ph_hi = ph + 1; hipLaunchKernelGGL(fwd_kernel, dim3(grid), dim3(NTHREADS), 0, stream, p); }
    if (DBG_CUT != 2 && DBG_CUT != 7 && DBG_CUT != 9) { p.ph_lo = 11; p.ph_hi = 12; hipLaunchKernelGGL(fwd_kernel, dim3(grid), dim3(NTHREADS), 0, stream, p); }
#else
    for (int ph = 0; ph < NPHASE; ++ph) { p.ph_lo = ph; p.ph_hi = ph + 1; hipLaunchKernelGGL(fwd_kernel, dim3(grid), dim3(NTHREADS), 0, stream, p); }
#endif
#else
    p.ph_lo = 0; p.ph_hi = NPHASE;
    void* args[] = {&p};
    hipError_t e = hipLaunchCooperativeKernel((const void*)fwd_kernel, dim3(grid), dim3(NTHREADS), args, 0, stream);
    if (e != hipSuccess) fprintf(stderr, "cooperative launch failed: %s (grid %d)\n", hipGetErrorString(e), grid);
#endif
}
```

```cpp
#include <hip/hip_runtime.h>
#include <hip/hip_cooperative_groups.h>
#include <cstdio>
#include <cstdint>
namespace cg = cooperative_groups;

#ifndef MODE
#define MODE 1

#ifndef REPEAT_PH
#define REPEAT_PH -1
#endif
#ifndef EXTRA_SYNCS
#define EXTRA_SYNCS 0
#endif
#endif

#define LAS __attribute__((address_space(3)))
typedef _Float16 f16;
typedef _Float16 half8 __attribute__((ext_vector_type(8)));
typedef _Float16 half4 __attribute__((ext_vector_type(4)));
typedef float f32x2 __attribute__((ext_vector_type(2)));
typedef float f32x4 __attribute__((ext_vector_type(4)));
typedef float f32x16 __attribute__((ext_vector_type(16)));
typedef unsigned u32x2 __attribute__((ext_vector_type(2)));
typedef unsigned u32x4 __attribute__((ext_vector_type(4)));

constexpr int D = 1024, SEQ = 16384, NMETA = 16, L = SEQ + NMETA, DFF = 2816;
constexpr int MP = 16640;
constexpr int LP = 16512;
constexpr int NIN = 3840;
constexpr int NCH = 257;
constexpr float EPS = 1e-6f;
constexpr int NTHREADS = 512;
constexpr int LDS_BYTES = 155648 + 1024;
constexpr int NPHASE = 11;

constexpr size_t al256(size_t x) { return (x + 255) & ~(size_t)255; }
constexpr size_t WS_CTL = 0;
constexpr size_t CTL_BYTES = 32768;
constexpr size_t WS_BAR = 2048;
constexpr size_t WS_WGU1 = CTL_BYTES;
constexpr size_t WS_WD1 = WS_WGU1 + (size_t)2 * DFF * D * 2;
constexpr size_t WS_WIN = WS_WD1 + (size_t)D * DFF * 2;
constexpr size_t WS_WOUT = WS_WIN + (size_t)NIN * D * 2;
constexpr size_t WS_WGU2 = WS_WOUT + (size_t)D * D * 2;
constexpr size_t WS_WD2 = WS_WGU2 + (size_t)2 * DFF * D * 2;
constexpr size_t WS_ACTA = WS_WD2 + (size_t)D * DFF * 2;
constexpr size_t WS_G = WS_ACTA + (size_t)MP * D * 2;
constexpr size_t WS_US = WS_G + (size_t)MP * DFF * 2;
constexpr size_t WS_DQ = WS_US + (size_t)NCH * 4 * 64 * 128 * 4;
constexpr size_t WS_IQ = WS_DQ + (size_t)LP * 512 * 2;
constexpr size_t WS_SEL = WS_IQ + (size_t)LP * 512 * 2;
constexpr size_t WS_ROPE = WS_SEL + (size_t)LP * 256 * 2;
constexpr size_t WS_IW = WS_ROPE + al256((size_t)L * 32 * 8);
constexpr size_t WS_GA = WS_IW + (size_t)LP * 8 * 4;
constexpr size_t WS_DECAY = WS_GA + (size_t)LP * 16 * 4;
constexpr size_t WS_SS0 = WS_DECAY + al256((size_t)NCH * 256 * 4);
constexpr size_t WS_SS1 = WS_SS0 + (size_t)MP * 4;
constexpr size_t WS_SS2 = WS_SS1 + (size_t)MP * 64;
constexpr size_t WS_SS3 = WS_SS2 + (size_t)MP * 64;
constexpr size_t WS_END = WS_SS3 + (size_t)MP * 64;
constexpr size_t WS_KV = WS_G;
constexpr size_t WS_GQ = WS_KV + (size_t)8 * LP * 128 * 2;
constexpr size_t WS_GK = WS_GQ + (size_t)LP * 256 * 2;
constexpr size_t WS_GV = WS_GK + (size_t)LP * 256 * 2;
constexpr size_t WS_GR = WS_GV + (size_t)LP * 512 * 2;
constexpr size_t WS_IK = WS_GR + (size_t)LP * 512 * 2;
constexpr size_t WS_ALIAS_END = WS_IK + (size_t)LP * 64 * 2;
static_assert(WS_ALIAS_END <= WS_US, "aliased buffers exceed G");
static_assert(WS_END <= (size_t)256 * 1024 * 1024, "workspace exceeds 256 MiB");
static_assert((size_t)SEQ * D * 2 <= (size_t)NCH * 4 * 64 * 128 * 4, "h2_16 alias");

struct Params {
    const float* x; const float* meta; const float* n1; const float* wg1; const float* wu1; const float* wd1;
    const float* nmix; const float* win; const float* wa2; const float* ba; const float* hn; const float* wout;
    const float* n2; const float* wg2; const float* wu2; const float* wd2; const float* nf;
    float* out; unsigned char* ws; int ph_lo, ph_hi;
};

namespace pg8 {
constexpr int BM = 256, BK = 64, HALF = 128, HTB = HALF * BK * 2, STAGE_BYTES = 8 * HTB, NXCD = 8, WGM = 8;
__host__ __device__ __forceinline__ int lds_byte(int r, int c) { const int st = (r >> 4) * 2 + (c >> 5), rr = r & 15, cc = c & 31, ob = rr * 64 + cc * 2; return st * 1024 + (ob ^ (((ob >> 9) & 1) << 5)); }
__host__ __device__ __forceinline__ void stage_rc(int b, int& R, int& C) { const int st = b / 1024, sb = b % 1024, swz = sb ^ (((sb >> 9) & 1) << 5); R = (st >> 1) * 16 + swz / 64; C = (st & 1) * 32 + (swz % 64) / 2; }
struct Unit { int pm, pn; };
struct Gemm { const f16* A; const f16* Bt; int M, N, K; };
struct StaticOrder {
    int nM, nN, nwg, G, c;
    __host__ __device__ void init(int M, int N, int G_, int c_) { nM = M / BM; nN = N / BM; nwg = nM * nN; G = G_; c = c_; }
    __host__ __device__ bool next(int i, Unit& u) const {
        const long Lx = (long)i * G + c; if (Lx >= nwg) return false;
        int wgid = (int)Lx; { const int q = nwg / NXCD, r = nwg % NXCD, xcd = wgid % NXCD, off = wgid / NXCD; wgid = (xcd < r ? xcd * (q + 1) : r * (q + 1) + (xcd - r) * q) + off; }
        const int nig = WGM * nN, gid = wgid / nig, fm = gid * WGM, gsz = (nM - fm) < WGM ? (nM - fm) : WGM;
        u.pm = fm + ((wgid % nig) % gsz); u.pn = (wgid % nig) / gsz; return true;
    }
};
template <class Epi>
__device__ __forceinline__ void gemm_phase(LAS unsigned char* lds, const Gemm g, const StaticOrder& S, const Epi& E) {
    int tid_ = threadIdx.x; asm volatile("" : "+v"(tid_));
    const int tid = tid_, wid = __builtin_amdgcn_readfirstlane(tid >> 6), lane = tid & 63, wr = wid >> 2, wc = wid & 3, fr = lane & 15, fq = lane >> 4;
    const int K = g.K, nt = K / BK;
    unsigned voffA[2], voffB[2];
#pragma unroll
    for (int i = 0; i < 2; ++i) { int R, C; stage_rc(tid * 16 + i * 8192, R, C); voffA[i] = (unsigned)(R * K + C) * 2u; voffB[i] = (unsigned)(R * K + C) * 2u; }
    const size_t kstep = (size_t)(BK * 2);
    const size_t hstep = (size_t)HALF * K * 2;
    const size_t tstep = 2 * hstep;
    const unsigned ldsw = (unsigned)wid * 1024u;
    const int aoff = lds_byte(wr * 64 + fr, fq * 8), boff = lds_byte(wc * 32 + fr, fq * 8);
#define PG8_SA(b, h) (((b) * 2 + (h)) * HTB)
#define PG8_SB(b, h) ((4 + (b) * 2 + (h)) * HTB)
#define PG8_STAGE(bufoff, gbase, voff) do { _Pragma("unroll") for (int _i = 0; _i < 2; ++_i) \
        __builtin_amdgcn_global_load_lds((const unsigned*)((const char*)(gbase) + (voff)[_i]), (LAS unsigned*)(lds + (bufoff) + ldsw + _i * 8192), 16, 0, 0); } while (0)
#define PG8_LDA(dst, b, h) do { _Pragma("unroll") for (int m = 0; m < 4; ++m) _Pragma("unroll") for (int k = 0; k < 2; ++k) dst[m][k] = *(const LAS half8*)(lds + PG8_SA(b, h) + aoff + m * 2048 + k * 1024); } while (0)
#define PG8_LDB(dst, b, h) do { _Pragma("unroll") for (int n = 0; n < 2; ++n) _Pragma("unroll") for (int k = 0; k < 2; ++k) dst[n][k] = *(const LAS half8*)(lds + PG8_SB(b, h) + boff + n * 2048 + k * 1024); } while (0)
#define PG8_MMA(ai, bj, At, Bt) do { __builtin_amdgcn_s_setprio(1); _Pragma("unroll") for (int m = 0; m < 4; ++m) _Pragma("unroll") for (int n = 0; n < 2; ++n) _Pragma("unroll") for (int k = 0; k < 2; ++k) \
        acc[ai][bj][m][n] = __builtin_amdgcn_mfma_f32_16x16x32_f16(Bt[n][k], At[m][k], acc[ai][bj][m][n], 0, 0, 0); __builtin_amdgcn_s_setprio(0); } while (0)
#define PG8_WAIT_V(n) asm volatile("s_waitcnt vmcnt(" #n ")" ::: "memory")
#define PG8_WAIT_L(n) asm volatile("s_waitcnt lgkmcnt(" #n ")" ::: "memory")
#define PG8_BAR __builtin_amdgcn_s_barrier()
#define PG8_SCHED __builtin_amdgcn_sched_barrier(0)
    Unit cur, nxt; int ui = 0;
    if (!S.next(0, cur)) return;
    f32x4 acc[2][2][4][2];
#pragma unroll
    for (int a = 0; a < 2; ++a)
#pragma unroll
        for (int b = 0; b < 2; ++b)
#pragma unroll
            for (int m = 0; m < 4; ++m)
#pragma unroll
                for (int n = 0; n < 2; ++n) acc[a][b][m][n] = (f32x4){0.f, 0.f, 0.f, 0.f};
    half8 At[4][2], B0[2][2], B1[2][2];
    const char* cA = (const char*)g.A + (size_t)cur.pm * tstep; const char* cB = (const char*)g.Bt + (size_t)cur.pn * tstep;
    PG8_STAGE(PG8_SB(0, 0), cB, voffB); PG8_STAGE(PG8_SA(0, 0), cA, voffA); PG8_STAGE(PG8_SB(0, 1), cB + hstep, voffB); PG8_STAGE(PG8_SA(0, 1), cA + hstep, voffA);
    if (wr == 1) PG8_BAR;
    PG8_WAIT_V(4); PG8_BAR;
    PG8_STAGE(PG8_SB(1, 0), cB + kstep, voffB); PG8_STAGE(PG8_SA(1, 0), cA + kstep, voffA); PG8_STAGE(PG8_SB(1, 1), cB + hstep + kstep, voffB);
    PG8_WAIT_V(6); PG8_BAR;
    for (;;) {
        const bool has_next = S.next(ui + 1, nxt);
        const char* nA = has_next ? (const char*)g.A + (size_t)nxt.pm * tstep : cA; const char* nB = has_next ? (const char*)g.Bt + (size_t)nxt.pn * tstep : cB;
        for (int t = 0; t < nt; t += 2) {
            const bool last = (t == nt - 2);
            const char* a1 = cA + (size_t)(t + 1) * kstep;
            const char* a2 = last ? nA : cA + (size_t)(t + 2) * kstep; const char* b2 = last ? nB : cB + (size_t)(t + 2) * kstep;
            const char* a3 = a2 + kstep; const char* b3 = b2 + kstep;
            PG8_LDB(B0, 0, 0); PG8_SCHED; PG8_LDA(At, 0, 0); PG8_STAGE(PG8_SA(1, 1), a1 + hstep, voffA);
            PG8_WAIT_L(8); PG8_BAR; PG8_WAIT_L(0); PG8_MMA(0, 0, At, B0); PG8_BAR; PG8_SCHED;
            PG8_LDB(B1, 0, 1); PG8_STAGE(PG8_SB(0, 0), b2, voffB);
            PG8_BAR; PG8_WAIT_L(0); PG8_MMA(0, 1, At, B1); PG8_BAR;
            PG8_LDA(At, 0, 1); PG8_STAGE(PG8_SA(0, 0), a2, voffA);
            PG8_BAR; PG8_WAIT_L(0); PG8_MMA(1, 0, At, B0); PG8_BAR; PG8_SCHED;
            PG8_STAGE(PG8_SB(0, 1), b2 + hstep, voffB);
            PG8_WAIT_V(6); PG8_BAR; PG8_MMA(1, 1, At, B1); PG8_BAR;
            PG8_LDB(B0, 1, 0); PG8_SCHED; PG8_LDA(At, 1, 0); PG8_STAGE(PG8_SA(0, 1), a2 + hstep, voffA);
            PG8_WAIT_L(8); PG8_BAR; PG8_WAIT_L(0); PG8_MMA(0, 0, At, B0); PG8_BAR; PG8_SCHED;
            PG8_LDB(B1, 1, 1); PG8_STAGE(PG8_SB(1, 0), b3, voffB);
            PG8_BAR; PG8_WAIT_L(0); PG8_MMA(0, 1, At, B1); PG8_BAR;
            PG8_LDA(At, 1, 1); PG8_STAGE(PG8_SA(1, 0), a3, voffA);
            PG8_BAR; PG8_WAIT_L(0); PG8_MMA(1, 0, At, B0); PG8_BAR; PG8_SCHED;
            PG8_STAGE(PG8_SB(1, 1), b3 + hstep, voffB);
            PG8_WAIT_V(6); PG8_BAR; PG8_MMA(1, 1, At, B1); PG8_BAR;
        }
        E(acc, cur, wr, wc, fr, fq);
        if (!has_next) break;
#pragma unroll
        for (int a = 0; a < 2; ++a)
#pragma unroll
            for (int b = 0; b < 2; ++b)
#pragma unroll
                for (int m = 0; m < 4; ++m)
#pragma unroll
                    for (int n = 0; n < 2; ++n) acc[a][b][m][n] = (f32x4){0.f, 0.f, 0.f, 0.f};
        cur = nxt; cA = nA; cB = nB; ++ui;
    }
    PG8_WAIT_V(0);
    if (wr == 0) PG8_BAR;
    PG8_BAR;
#undef PG8_SA
#undef PG8_SB
#undef PG8_STAGE
#undef PG8_LDA
#undef PG8_LDB
#undef PG8_MMA
#undef PG8_WAIT_V
#undef PG8_WAIT_L
#undef PG8_BAR
#undef PG8_SCHED
}
}

__device__ __forceinline__ float silu_f(float v) { return v / (1.0f + __expf(-v)); }
__device__ __forceinline__ half4 to_half4(f32x4 v) { half4 h; h[0] = (f16)v[0]; h[1] = (f16)v[1]; h[2] = (f16)v[2]; h[3] = (f16)v[3]; return h; }

__device__ __forceinline__ float row_rstd(const float* ss, int np, int row) {
    float s;
    if (np == 1) s = ss[row];
    else { const f32x4* p = (const f32x4*)(ss + (size_t)row * 16); const f32x4 a = p[0], b = p[1], c = p[2], d = p[3];
        s = (((a[0] + a[1]) + (a[2] + a[3])) + ((b[0] + b[1]) + (b[2] + b[3]))) + (((c[0] + c[1]) + (c[2] + c[3])) + ((d[0] + d[1]) + (d[2] + d[3]))); }
    return rsqrtf(s * (1.0f / D) + EPS);
}
struct EpiSwiglu {
    f16* G; const float* ss; int np;
    __device__ __forceinline__ void operator()(const f32x4 (&acc)[2][2][4][2], const pg8::Unit& u, int wr, int wc, int fr, int fq) const {
        if (np < 0) { if (acc[0][0][0][0][0] == 1234.5f) G[0] = (f16)1.0f; return; }
#pragma unroll
        for (int ai = 0; ai < 2; ++ai)
#pragma unroll
            for (int m = 0; m < 4; ++m) {
                const int row = u.pm * 256 + ai * 128 + wr * 64 + m * 16 + fr;
                const float rs = row_rstd(ss, np, row);
#pragma unroll
                for (int n = 0; n < 2; ++n) {
                    const f32x4 gt = acc[ai][0][m][n] * rs, up = acc[ai][1][m][n] * rs; f32x4 o;
#pragma unroll
                    for (int j = 0; j < 4; ++j) o[j] = silu_f(gt[j]) * up[j];
                    *(half4*)(G + (size_t)row * DFF + u.pn * 128 + wc * 32 + n * 16 + 4 * fq) = to_half4(o);
                }
            }
    }
};
struct EpiResid {
    const float* src; float* out; f16* h16; float* ss; float alpha;
    __device__ __forceinline__ void operator()(const f32x4 (&acc)[2][2][4][2], const pg8::Unit& u, int wr, int wc, int fr, int fq) const {
#pragma unroll
        for (int ai = 0; ai < 2; ++ai)
#pragma unroll
            for (int m = 0; m < 4; ++m) {
                const int row = u.pm * 256 + ai * 128 + wr * 64 + m * 16 + fr; float part = 0.f;
#pragma unroll
                for (int bj = 0; bj < 2; ++bj)
#pragma unroll
                    for (int n = 0; n < 2; ++n) {
                        const size_t off = (size_t)row * D + u.pn * 256 + bj * 128 + wc * 32 + n * 16 + 4 * fq;
                        const f32x4 s = *(const f32x4*)(src + off); const f32x4 o = s + alpha * acc[ai][bj][m][n];
                        *(f32x4*)(out + off) = o; if (h16) *(half4*)(h16 + off) = to_half4(o);
                        part += (o[0] * o[0] + o[1] * o[1]) + (o[2] * o[2] + o[3] * o[3]);
                    }
                part += __shfl_xor(part, 16); part += __shfl_xor(part, 32);
                if (fq == 0) ss[(size_t)row * 16 + u.pn * 4 + wc] = part;
            }
    }
};
constexpr float KV_SCALE = 16.0f;
__device__ __forceinline__ unsigned pack_fp8x4(f32x4 v) {
#pragma unroll
    for (int j = 0; j < 4; ++j) v[j] = fminf(fmaxf(v[j], -448.f), 448.f);
    int w = __builtin_amdgcn_cvt_pk_fp8_f32(v[0], v[1], 0, false); w = __builtin_amdgcn_cvt_pk_fp8_f32(v[2], v[3], w, true); return (unsigned)w;
}
struct EpiInProj {
    const float* ss; const f32x2* rope; unsigned char* ws;
    __device__ __forceinline__ void operator()(const f32x4 (&acc)[2][2][4][2], const pg8::Unit& u, int wr, int wc, int fr, int fq) const {
        const int pn = u.pn;
        if (pn >= 8 && pn <= 11) {
            unsigned char* lb = (pn <= 9) ? ws + WS_KV + (size_t)((pn - 8) * 4 + wc) * LP * 128 + 4 * fq
                                          : ws + WS_KV + (size_t)((pn - 10) * 4 + (wc >> 1)) * LP * 128 + 64 + (wc & 1) * 32 + 4 * fq;
#pragma unroll
            for (int ai = 0; ai < 2; ++ai)
#pragma unroll
                for (int m = 0; m < 4; ++m) {
                    const int p = u.pm * 256 + ai * 128 + wr * 64 + m * 16 + fr;
                    const int t = p < SEQ ? p + NMETA : p - SEQ;
                    if (p < L) {
                        const float sc = row_rstd(ss, 16, p) * KV_SCALE;
                        if (pn <= 9) {
#pragma unroll
                            for (int n = 0; n < 2; ++n) {
                                const int dd = 16 * n + 4 * fq;
                                const f32x4 x1 = acc[ai][0][m][n], x2 = acc[ai][1][m][n]; f32x4 o1, o2;
                                const f32x4 cs0 = *(const f32x4*)(rope + (size_t)t * 32 + dd), cs1 = *(const f32x4*)(rope + (size_t)t * 32 + dd + 2);
                                o1[0] = (x1[0] * cs0[0] - x2[0] * cs0[1]) * sc; o2[0] = (x2[0] * cs0[0] + x1[0] * cs0[1]) * sc;
                                o1[1] = (x1[1] * cs0[2] - x2[1] * cs0[3]) * sc; o2[1] = (x2[1] * cs0[2] + x1[1] * cs0[3]) * sc;
                                o1[2] = (x1[2] * cs1[0] - x2[2] * cs1[1]) * sc; o2[2] = (x2[2] * cs1[0] + x1[2] * cs1[1]) * sc;
                                o1[3] = (x1[3] * cs1[2] - x2[3] * cs1[3]) * sc; o2[3] = (x2[3] * cs1[2] + x1[3] * cs1[3]) * sc;
                                unsigned char* d8 = lb + (size_t)t * 128 + n * 16; *(unsigned*)d8 = pack_fp8x4(o1); *(unsigned*)(d8 + 32) = pack_fp8x4(o2);
                            }
                        } else {
#pragma unroll
                            for (int bj = 0; bj < 2; ++bj)
#pragma unroll
                                for (int n = 0; n < 2; ++n) *(unsigned*)(lb + (size_t)t * 128 + (size_t)bj * 2 * LP * 128 + n * 16) = pack_fp8x4(acc[ai][bj][m][n] * sc);
                        }
                    }
                    asm volatile("" ::: "memory");
                }
            return;
        }
        int mode = 0, stride = 256; float scale = 1.0f; f16* lanebase;
        if (pn == 0) lanebase = (f16*)(ws + WS_GQ) + wc * 32 + 4 * fq;
        else if (pn == 1) lanebase = (f16*)(ws + WS_GK) + wc * 32 + 4 * fq;
        else if (pn <= 3) { lanebase = (f16*)(ws + WS_GV) + (pn - 2) * 256 + wc * 32 + 4 * fq; stride = 512; }
        else if (pn <= 5) { lanebase = (f16*)(ws + WS_GR) + (pn - 4) * 256 + wc * 32 + 4 * fq; stride = 512; }
        else if (pn <= 7) { lanebase = (f16*)(ws + WS_DQ) + (pn - 6) * 256 + wc * 64 + 4 * fq; stride = 512; mode = 1; scale = 0.125f; }
        else if (pn <= 13) { lanebase = (f16*)(ws + WS_IQ) + (pn - 12) * 256 + wc * 64 + 4 * fq; stride = 512; mode = 1; scale = 0.125f; }
        else { lanebase = (f16*)(ws + WS_IK) + 4 * fq; stride = 64; mode = wc == 0 ? 1 : (wc == 1 ? 2 : 3); }
#pragma unroll
        for (int ai = 0; ai < 2; ++ai)
#pragma unroll
            for (int m = 0; m < 4; ++m) {
                const int p = u.pm * 256 + ai * 128 + wr * 64 + m * 16 + fr;
                const int t = p < SEQ ? p + NMETA : p - SEQ;
                if (p < L && mode != 3) {
                    const float rs = row_rstd(ss, 16, p);
                    if (mode == 1) {
                        const float sc = rs * scale;
#pragma unroll
                        for (int n = 0; n < 2; ++n) {
                            const int dd = 16 * n + 4 * fq;
                            const f32x4 x1 = acc[ai][0][m][n], x2 = acc[ai][1][m][n]; f32x4 o1, o2;
                            const f32x4 cs0 = *(const f32x4*)(rope + (size_t)t * 32 + dd), cs1 = *(const f32x4*)(rope + (size_t)t * 32 + dd + 2);
                            o1[0] = (x1[0] * cs0[0] - x2[0] * cs0[1]) * sc; o2[0] = (x2[0] * cs0[0] + x1[0] * cs0[1]) * sc;
                            o1[1] = (x1[1] * cs0[2] - x2[1] * cs0[3]) * sc; o2[1] = (x2[1] * cs0[2] + x1[1] * cs0[3]) * sc;
                            o1[2] = (x1[2] * cs1[0] - x2[2] * cs1[1]) * sc; o2[2] = (x2[2] * cs1[0] + x1[2] * cs1[1]) * sc;
                            o1[3] = (x1[3] * cs1[2] - x2[3] * cs1[3]) * sc; o2[3] = (x2[3] * cs1[2] + x1[3] * cs1[3]) * sc;
                            f16* dst = lanebase + (size_t)t * stride + n * 16;
                            *(half4*)dst = to_half4(o1); *(half4*)(dst + 32) = to_half4(o2);
                        }
                    } else if (mode == 2) {
                        const f32x4 a0 = acc[ai][0][m][0] * rs; *(f32x4*)((float*)(ws + WS_GA) + (size_t)t * 16 + 4 * fq) = a0;
                        if (fq < 2) { const f32x4 a1 = acc[ai][0][m][1] * (rs * 0.35355339059327373f); *(f32x4*)((float*)(ws + WS_IW) + (size_t)t * 8 + 4 * fq) = a1; }
                    } else {
#pragma unroll
                        for (int bj = 0; bj < 2; ++bj)
#pragma unroll
                            for (int n = 0; n < 2; ++n) *(half4*)(lanebase + (size_t)t * stride + bj * 128 + n * 16) = to_half4(acc[ai][bj][m][n] * rs);
                    }
                }
                asm volatile("" ::: "memory");
            }
    }
};

__device__ __forceinline__ const float* w_src(const Params& P, int kind, int n, int& ld, const float*& gain) {
    switch (kind) {
    case 0: case 4: { const int pn = n >> 8, bj = (n >> 7) & 1, cc = n & 127; ld = DFF; gain = kind == 0 ? P.n1 : P.n2;
        const float* w = kind == 0 ? (bj ? P.wu1 : P.wg1) : (bj ? P.wu2 : P.wg2); return w + pn * 128 + cc; }
    case 1: ld = D; gain = nullptr; return P.wd1 + n;
    case 5: ld = D; gain = nullptr; return P.wd2 + n;
    case 3: ld = D; gain = nullptr; return P.wout + n;
    default: { ld = 3672; gain = P.nmix; const int pn = n >> 8, c = n & 255, bj = c >> 7, hh = (c >> 5) & 3, dd = c & 31; int j;
        if (pn == 0) j = c; else if (pn == 1) j = 256 + c; else if (pn <= 3) j = 512 + (pn - 2) * 256 + c; else if (pn <= 5) j = 1024 + (pn - 4) * 256 + c;
        else if (pn <= 7) j = 1552 + (pn - 6) * 256 + hh * 64 + bj * 32 + dd;
        else if (pn <= 9) j = 2064 + (pn - 8) * 256 + hh * 64 + bj * 32 + dd;
        else if (pn <= 11) j = 2576 + (pn - 10) * 256 + c;
        else if (pn <= 13) j = 3088 + (pn - 12) * 256 + hh * 64 + bj * 32 + dd;
        else { if (c < 32) j = 3600 + c; else if (c < 48) j = 1536 + (c - 32); else if (c < 56) j = 3664 + (c - 48); else if (c >= 128 && c < 160) j = 3600 + 32 + (c - 128); else j = -1; }
        return j < 0 ? nullptr : P.win + j; }
    }
}
__device__ __forceinline__ void prep_weight(const Params& P, const int kind, const int N, const int K, f16* dst, int& cursor, int& tbase, LAS f16* tl) {
    const int tid = threadIdx.x, G = gridDim.x, tn = N / 64, tk = K / 256, ntile = tn * tk;
#pragma unroll 1
    for (; cursor < tbase + ntile; cursor += G) {
        const int tI = cursor - tbase, n0 = (tI % tn) * 64, k0 = (tI / tn) * 256;
        { const int n = tid & 63, kk0 = tid >> 6; int ld; const float* gain; const float* col = w_src(P, kind, n0 + n, ld, gain);
          float v[32];
#pragma unroll
          for (int i = 0; i < 32; ++i) v[i] = col ? col[(size_t)(k0 + kk0 + 8 * i) * ld] : 0.f;
          if (gain) {
#pragma unroll
              for (int i = 0; i < 32; ++i) v[i] *= gain[k0 + kk0 + 8 * i];
          }
#pragma unroll
          for (int i = 0; i < 32; ++i) tl[n * 264 + kk0 + 8 * i] = (f16)v[i]; }
        __syncthreads();
        { const int n = tid >> 3, seg = tid & 7;
#pragma unroll
          for (int j = 0; j < 4; ++j) *(half8*)(dst + (size_t)(n0 + n) * K + k0 + (seg + 8 * j) * 8) = *(const LAS half8*)(tl + n * 264 + (seg + 8 * j) * 8); }
        __syncthreads();
    }
    tbase += ntile;
}
__device__ __forceinline__ void p0_prologue(const Params& P, LAS unsigned char* lds) {
    const int tid = threadIdx.x, bid = blockIdx.x, G = gridDim.x, lane = tid & 63;
    unsigned char* ws = P.ws;
    int tbase = 0, cursor = bid;
    LAS f16* tl = (LAS f16*)lds;
    prep_weight(P, 0, 2 * DFF, D, (f16*)(ws + WS_WGU1), cursor, tbase, tl);
    prep_weight(P, 1, D, DFF, (f16*)(ws + WS_WD1), cursor, tbase, tl);
    prep_weight(P, 2, NIN, D, (f16*)(ws + WS_WIN), cursor, tbase, tl);
    float* ss0 = (float*)(ws + WS_SS0);
    f16* acta = (f16*)(ws + WS_ACTA);
    const int gw = bid * 8 + (tid >> 6), nw = G * 8;
    for (int p = gw; p < L; p += nw) {
        const float* src = p < SEQ ? P.x + (size_t)p * D : P.meta + (size_t)(p - SEQ) * D; float s = 0.f;
#pragma unroll
        for (int i = 0; i < 4; ++i) { const f32x4 v = *(const f32x4*)(src + lane * 4 + 256 * i); s += (v[0] * v[0] + v[1] * v[1]) + (v[2] * v[2] + v[3] * v[3]); *(half4*)(acta + (size_t)p * D + lane * 4 + 256 * i) = to_half4(v); }
#pragma unroll
        for (int o = 32; o >= 1; o >>= 1) s += __shfl_xor(s, o);
        if (lane == 0) ss0[p] = s;
    }
    const int gt = bid * NTHREADS + tid, ngt = G * NTHREADS;
    for (int i = gt; i < MP; i += ngt) { if (i >= L) ss0[i] = (float)D; }
    f32x2* rope = (f32x2*)(ws + WS_ROPE);
    for (int i = gt; i < L * 32; i += ngt) { const int t = i >> 5, f = i & 31; const double inv = exp(-(double)f * (9.210340371976184 / 32.0)); double sn, cs; sincos((double)t * inv, &sn, &cs); rope[i] = (f32x2){(float)cs, (float)sn}; }
}

__device__ __forceinline__ void meta_down(const Params& P, LAS unsigned char* lds) {
    const int tid = threadIdx.x, lane = tid & 63, wid = tid >> 6;
    const f16* Gm = (const f16*)(P.ws + WS_G) + (size_t)SEQ * DFF; const f16* Wt = (const f16*)(P.ws + WS_WD1);
    f16* acta = (f16*)(P.ws + WS_ACTA); float* ss1 = (float*)(P.ws + WS_SS1); LAS float* slot = (LAS float*)lds;
    for (int task = blockIdx.x; task < NMETA * 16; task += gridDim.x) {
        const int r = task >> 4, cg = task & 15; float part = 0.f;
#pragma unroll 1
        for (int q = 0; q < 2; ++q) {
            const int n0 = cg * 64 + (2 * wid + q) * 4; float a[4] = {0.f, 0.f, 0.f, 0.f};
            for (int kc = lane; kc < DFF / 8; kc += 64) {
                const half8 gv = *(const half8*)(Gm + (size_t)r * DFF + kc * 8);
#pragma unroll
                for (int j = 0; j < 4; ++j) { const half8 wv = *(const half8*)(Wt + (size_t)(n0 + j) * DFF + kc * 8);
#pragma unroll
                    for (int e = 0; e < 8; ++e) a[j] += (float)gv[e] * (float)wv[e]; }
            }
#pragma unroll
            for (int o = 32; o >= 1; o >>= 1) { a[0] += __shfl_xor(a[0], o); a[1] += __shfl_xor(a[1], o); a[2] += __shfl_xor(a[2], o); a[3] += __shfl_xor(a[3], o); }
            f32x4 o;
#pragma unroll
            for (int j = 0; j < 4; ++j) { o[j] = P.meta[r * D + n0 + j] + 0.5f * a[j]; part += o[j] * o[j]; }
            if (lane == 0) *(half4*)(acta + (size_t)(SEQ + r) * D + n0) = to_half4(o);
        }
        if (lane == 0) slot[wid] = part;
        __syncthreads();
        if (tid == 0) { float s = 0.f; for (int w = 0; w < 8; ++w) s += slot[w]; ss1[(size_t)(SEQ + r) * 16 + cg] = s; }
        __syncthreads();
    }
}

__device__ __forceinline__ float logsigmoid_f(float z) { return fminf(z, 0.f) - log1pf(expf(-fabsf(z))); }
__device__ __forceinline__ void gla_gates(const Params& P, int c, int h, LAS float* bl) {
    const int tid = threadIdx.x; const float* GA = (const float*)(P.ws + WS_GA);
    for (int e = tid; e < 4096; e += NTHREADS) {
        const int i = e >> 6, d = e & 63, t = 64 * c - 48 + i; float g = 0.f;
        if (t >= 0 && t < L) { float z = P.ba[64 * h + d]; const float* a = GA + (size_t)t * 16;
#pragma unroll
            for (int r = 0; r < 16; ++r) z += a[r] * P.wa2[r * 256 + 64 * h + d];
            g = logsigmoid_f(z) * (1.0f / 16.0f); }
        bl[i * 65 + d] = g;
    }
    __syncthreads();
    if (tid < 64) { float run = 0.f; for (int i = 0; i < 64; ++i) { run += bl[i * 65 + tid]; bl[i * 65 + tid] = run; } }
    __syncthreads();
}
__device__ __forceinline__ void gla_a_unit(const Params& P, int unit, LAS unsigned char* lds) {
    int tid_ = threadIdx.x; asm volatile("" : "+v"(tid_));
    const int tid = tid_, lane = tid & 63, wid = tid >> 6, c = unit >> 2, h = unit & 3;
    LAS float* bl = (LAS float*)lds; LAS float* ks = bl + 4160; LAS float* vs = ks + 4096;
    const f16* GK = (const f16*)(P.ws + WS_GK); const f16* GV = (const f16*)(P.ws + WS_GV);
    float* U = (float*)(P.ws + WS_US); float* DEC = (float*)(P.ws + WS_DECAY);
    gla_gates(P, c, h, bl);
    for (int e = tid; e < 4096; e += NTHREADS) { const int j = e >> 6, d = e & 63, t = 64 * c - 48 + j; float v = 0.f;
        if (t >= 0 && t < L) v = (float)GK[(size_t)t * 256 + 64 * h + d] * __expf(bl[63 * 65 + d] - bl[j * 65 + d]); ks[j * 64 + d] = v; }
    for (int e = tid; e < 8192; e += NTHREADS) { const int j = e >> 7, x = e & 127, t = 64 * c - 48 + j; vs[j * 128 + x] = (t >= 0 && t < L) ? (float)GV[(size_t)t * 512 + 128 * h + x] : 0.f; }
    if (tid < 64) DEC[(size_t)c * 256 + h * 64 + tid] = __expf(bl[63 * 65 + tid]);
    __syncthreads();
    { const int d0 = (wid >> 2) * 32, e0 = (wid & 3) * 32, l31 = lane & 31, hf = lane >> 5; f32x16 acc;
#pragma unroll
      for (int i = 0; i < 16; ++i) acc[i] = 0.f;
#pragma unroll 8
      for (int s = 0; s < 32; ++s) acc = __builtin_amdgcn_mfma_f32_32x32x2f32(ks[(2 * s + hf) * 64 + d0 + l31], vs[(2 * s + hf) * 128 + e0 + l31], acc, 0, 0, 0);
      float* up = U + ((size_t)unit * 64) * 128;
#pragma unroll
      for (int r = 0; r < 16; ++r) { const int row = (r & 3) + 8 * (r >> 2) + 4 * hf; up[(size_t)(d0 + row) * 128 + e0 + l31] = acc[r]; } }
    __syncthreads();
}
__device__ __forceinline__ void gla_scan(const Params& P) {
    float* U = (float*)(P.ws + WS_US); const float* DEC = (const float*)(P.ws + WS_DECAY);
    const int idx = blockIdx.x * NTHREADS + threadIdx.x;
    if (idx >= 32768) return;
    float s = 0.f;
#pragma unroll 8
    for (int c = 0; c < NCH; ++c) { const float u = U[(size_t)c * 32768 + idx], dc = DEC[(size_t)c * 256 + (idx >> 7)]; U[(size_t)c * 32768 + idx] = s; s = dc * s + u; }
}
__device__ __forceinline__ void gla_c_unit(const Params& P, int unit, LAS unsigned char* lds) {
    int tid_ = threadIdx.x; asm volatile("" : "+v"(tid_));
    const int tid = tid_, lane = tid & 63, wid = tid >> 6, c = unit >> 2, h = unit & 3, l31 = lane & 31, hf = lane >> 5;
    LAS float* bl = (LAS float*)lds; LAS float* kk = bl + 4160; LAS float* qs = kk + 4160; LAS float* As = qs + 4160; LAS float* vs = As + 4160; LAS float* os = bl;
    const f16* GQ = (const f16*)(P.ws + WS_GQ); const f16* GK = (const f16*)(P.ws + WS_GK); const f16* GV = (const f16*)(P.ws + WS_GV); const f16* GR = (const f16*)(P.ws + WS_GR);
    const float* Sg = (const float*)(P.ws + WS_US) + (size_t)unit * 8192; f16* mix = (f16*)(P.ws + WS_ACTA);
    gla_gates(P, c, h, bl);
    for (int e = tid; e < 4096; e += NTHREADS) { const int i = e >> 6, d = e & 63, t = 64 * c - 48 + i; float q = 0.f, k = 0.f;
        if (t >= 0 && t < L) { const float b = bl[i * 65 + d]; q = (float)GQ[(size_t)t * 256 + 64 * h + d] * 0.125f * __expf(b); k = (float)GK[(size_t)t * 256 + 64 * h + d] * __expf(-b); }
        qs[i * 65 + d] = q; kk[i * 65 + d] = k; }
    for (int e = tid; e < 8192; e += NTHREADS) { const int j = e >> 7, x = e & 127, t = 64 * c - 48 + j; vs[j * 128 + x] = (t >= 0 && t < L) ? (float)GV[(size_t)t * 512 + 128 * h + x] : 0.f; }
    __syncthreads();
    if (wid < 4) { const int i0 = (wid >> 1) * 32, j0 = (wid & 1) * 32; f32x16 acc;
#pragma unroll
        for (int i = 0; i < 16; ++i) acc[i] = 0.f;
#pragma unroll 8
        for (int s = 0; s < 32; ++s) acc = __builtin_amdgcn_mfma_f32_32x32x2f32(qs[(i0 + l31) * 65 + 2 * s + hf], kk[(j0 + l31) * 65 + 2 * s + hf], acc, 0, 0, 0);
#pragma unroll
        for (int r = 0; r < 16; ++r) { const int i = i0 + (r & 3) + 8 * (r >> 2) + 4 * hf, j = j0 + l31; As[i * 65 + j] = (j <= i) ? acc[r] : 0.f; } }
    __syncthreads();
    { const int i0 = (wid >> 2) * 32, e0 = (wid & 3) * 32; f32x16 acc;
#pragma unroll
      for (int i = 0; i < 16; ++i) acc[i] = 0.f;
#pragma unroll 8
      for (int s = 0; s < 32; ++s) acc = __builtin_amdgcn_mfma_f32_32x32x2f32(qs[(i0 + l31) * 65 + 2 * s + hf], Sg[(size_t)(2 * s + hf) * 128 + e0 + l31], acc, 0, 0, 0);
#pragma unroll 8
      for (int s = 0; s < 32; ++s) acc = __builtin_amdgcn_mfma_f32_32x32x2f32(As[(i0 + l31) * 65 + 2 * s + hf], vs[(2 * s + hf) * 128 + e0 + l31], acc, 0, 0, 0);
#pragma unroll
      for (int r = 0; r < 16; ++r) { const int i = i0 + (r & 3) + 8 * (r >> 2) + 4 * hf; os[i * 129 + e0 + l31] = acc[r]; } }
    __syncthreads();
    { const int i = tid >> 3, e0 = (tid & 7) * 16, t = 64 * c - 48 + i; float o[16], s = 0.f;
#pragma unroll
      for (int j = 0; j < 16; ++j) { o[j] = os[i * 129 + e0 + j]; s += o[j] * o[j]; }
      s += __shfl_xor(s, 1); s += __shfl_xor(s, 2); s += __shfl_xor(s, 4);
      const float rs = rsqrtf(s * (1.0f / 128.0f) + EPS);
      if (t >= NMETA && t < L) {
#pragma unroll
          for (int j4 = 0; j4 < 4; ++j4) { f32x4 v;
#pragma unroll
              for (int j = 0; j < 4; ++j) { const int e = e0 + 4 * j4 + j; v[j] = o[4 * j4 + j] * rs * P.hn[e] * silu_f((float)GR[(size_t)t * 512 + 128 * h + e]); }
              *(half4*)(mix + (size_t)(t - NMETA) * D + 128 * h + e0 + 4 * j4) = to_half4(v); } } }
    __syncthreads();
}

__device__ __forceinline__ unsigned mono_u(float f) { const unsigned u = __float_as_uint(f); return (u & 0x80000000u) ? ~u : (u | 0x80000000u); }
__device__ __forceinline__ float unmono_f(unsigned m) { return __uint_as_float((m & 0x80000000u) ? (m & 0x7fffffffu) : ~m); }
__device__ __forceinline__ unsigned wave_umax(unsigned v) {
    v = max(v, (unsigned)__builtin_amdgcn_update_dpp(0, (int)v, 0x111, 0xf, 0xf, false));
    v = max(v, (unsigned)__builtin_amdgcn_update_dpp(0, (int)v, 0x112, 0xf, 0xf, false));
    v = max(v, (unsigned)__builtin_amdgcn_update_dpp(0, (int)v, 0x114, 0xf, 0xf, false));
    v = max(v, (unsigned)__builtin_amdgcn_update_dpp(0, (int)v, 0x118, 0xf, 0xf, false));
    v = max(v, (unsigned)__builtin_amdgcn_update_dpp(0, (int)v, 0x142, 0xa, 0xf, false));
    v = max(v, (unsigned)__builtin_amdgcn_update_dpp(0, (int)v, 0x143, 0xc, 0xf, false));
    return (unsigned)__builtin_amdgcn_readlane((int)v, 63);
}
constexpr int CAP = 640, NPL = CAP / 64;
__device__ __forceinline__ int topk_compact(LAS float* cs, LAS unsigned short* ci, int n, bool exact, float& tau_out, int lane) {
    float sv[NPL]; unsigned iv[NPL], u[NPL];
#pragma unroll
    for (int i = 0; i < NPL; ++i) { const int p = lane + 64 * i; const bool v = p < n; sv[i] = v ? cs[p] : 0.f; iv[i] = v ? (unsigned)ci[p] : 0xffffu; u[i] = v ? mono_u(sv[i]) : 0u; }
    unsigned T = 0u; bool full = true; int hb = 31;
    {
        unsigned umx = 0u, umn = 0xffffffffu;
#pragma unroll
        for (int i = 0; i < NPL; ++i) { umx = max(umx, u[i]); umn = min(umn, (lane + 64 * i < n) ? u[i] : 0xffffffffu); }
        umx = wave_umax(umx); umn = ~wave_umax(~umn);
        const unsigned df = umx ^ umn;
        if (df == 0u) { hb = -1; T = umx; } else { hb = 31 - __clz(df); T = (hb == 31) ? 0u : (umx & ~((2u << hb) - 1u)); }
    }
#pragma unroll 1
    for (int bit = hb; bit >= 0; --bit) {
        const unsigned cand = T | (1u << bit); int cgt = 0;
#pragma unroll
        for (int i = 0; i < NPL; ++i) cgt += __popcll(__ballot(u[i] >= cand));
        if (cgt >= 256) { T = cand; if (!exact && cgt <= 272) { full = false; break; } }
    }
    bool keep[NPL];
    if (full) {
        int cgt = 0;
#pragma unroll
        for (int i = 0; i < NPL; ++i) cgt += __popcll(__ballot(u[i] > T));
        const int need = 256 - cgt; unsigned I = 0xffffu; int nties = 0;
#pragma unroll
        for (int i = 0; i < NPL; ++i) nties += __popcll(__ballot(u[i] == T));
        if (nties != need) { I = 0u;
#pragma unroll 1
        for (int bit = 15; bit >= 0; --bit) { const unsigned cand = I | (1u << bit); int cl = 0;
#pragma unroll
            for (int i = 0; i < NPL; ++i) cl += __popcll(__ballot(u[i] == T && iv[i] < cand));
            if (cl < need) I = cand; } }
#pragma unroll
        for (int i = 0; i < NPL; ++i) keep[i] = (u[i] > T) || (u[i] == T && iv[i] <= I);
    } else {
#pragma unroll
        for (int i = 0; i < NPL; ++i) keep[i] = u[i] >= T;
    }
    int nn = 0;
#pragma unroll
    for (int i = 0; i < NPL; ++i) { const unsigned long long m = __ballot(keep[i]); const int pre = __builtin_amdgcn_mbcnt_hi((unsigned)(m >> 32), __builtin_amdgcn_mbcnt_lo((unsigned)m, 0u));
        if (keep[i]) { cs[nn + pre] = sv[i]; ci[nn + pre] = (unsigned short)iv[i]; } nn += __popcll(m); }
    tau_out = unmono_f(T);
    return nn;
}
__device__ __forceinline__ float relu_asm(float x) { return __int_as_float(max(__float_as_int(x), 0)); }
__device__ __forceinline__ void indexer_tile(const Params& P, int tile, LAS unsigned char* lds) {
    int tid_ = threadIdx.x; asm volatile("" : "+v"(tid_));
    const int tid = tid_, lane = tid & 63, wid = __builtin_amdgcn_readfirstlane(tid >> 6), l31 = lane & 31, hf = lane >> 5;
    LAS float* candS = (LAS float*)lds;
    LAS unsigned short* candI = (LAS unsigned short*)(lds + 32 * CAP * 4);
    LAS unsigned char* kbuf = lds + 32 * CAP * 6;
    LAS int* lcnt = (LAS int*)(lds + LDS_BYTES - 1024 + 64);
    LAS int* lflag = (LAS int*)(lds + LDS_BYTES - 1024 + 192);
    const f16* IQ = (const f16*)(P.ws + WS_IQ); const f16* IK = (const f16*)(P.ws + WS_IK); const float* IW = (const float*)(P.ws + WS_IW);
    unsigned short* SEL = (unsigned short*)(P.ws + WS_SEL);
    const int t0 = tile * 32, tw = t0 + wid * 4;
    half8 afr[4];
    { const int qi = 2 * (l31 >> 4) + ((l31 >> 2) & 1), hd = 4 * ((l31 >> 3) & 1) + (l31 & 3); int tq = tw + qi; if (tq > L - 1) tq = L - 1;
      const half8* ap = (const half8*)(IQ + (size_t)tq * 512 + hd * 64);
#pragma unroll
      for (int s = 0; s < 4; ++s) afr[s] = ap[2 * s + hf]; }
    float w0[8], w1[8];
    { int ta = tw + hf, tb = tw + 2 + hf; if (ta > L - 1) ta = L - 1; if (tb > L - 1) tb = L - 1;
#pragma unroll
      for (int h = 0; h < 8; ++h) { w0[h] = IW[(size_t)ta * 8 + h]; w1[h] = IW[(size_t)tb * 8 + h]; } }
    asm volatile("" :: "v"(afr[0]), "v"(afr[1]), "v"(afr[2]), "v"(afr[3]));
    asm volatile("" :: "v"(w0[0]), "v"(w0[1]), "v"(w0[2]), "v"(w0[3]), "v"(w0[4]), "v"(w0[5]), "v"(w0[6]), "v"(w0[7]));
    asm volatile("" :: "v"(w1[0]), "v"(w1[1]), "v"(w1[2]), "v"(w1[3]), "v"(w1[4]), "v"(w1[5]), "v"(w1[6]), "v"(w1[7]));
    const int tq0 = (tw + hf < L) ? tw + hf : -1, tq1 = (tw + 2 + hf < L) ? tw + 2 + hf : -1;
    float tau0 = -__builtin_inff(), tau1 = -__builtin_inff();
    int cntv = 0;
    if (lane < 4) lcnt[wid * 4 + lane] = 0;
    if (tid < 3) lflag[tid] = 0;
    const int nkeys = (t0 + 32 < L) ? t0 + 32 : L, nst = (nkeys + 127) >> 7;
    u32x4 stg[2];
    const u32x4* IKv = (const u32x4*)IK;
#pragma unroll
    for (int i = 0; i < 2; ++i) stg[i] = IKv[(size_t)0 * 1024 + tid + 512 * i];
#pragma unroll
    for (int i = 0; i < 2; ++i) { const int ci = tid + 512 * i, row = ci >> 3, ch = ci & 7; *(LAS u32x4*)(kbuf + row * 128 + ((ch ^ ((row >> 1) & 7)) << 4)) = stg[i]; }
    __syncthreads();
#pragma unroll 1
    for (int st = 0; st < nst; ++st) {
        LAS unsigned char* kb = kbuf + (st & 1) * 16384;
        if (st + 1 < nst) {
#pragma unroll
            for (int i = 0; i < 2; ++i) stg[i] = IKv[(size_t)(st + 1) * 1024 + tid + 512 * i];
        }
#pragma unroll 1
        for (int sub = 0; sub < 4; sub += 2) {
            const int kbase = st * 128 + sub * 32;
            if (kbase > tw + 3) break;
            const int rowa = sub * 32 + l31, rowb = rowa + 32;
            f32x16 acca, accb;
#pragma unroll
            for (int i = 0; i < 16; ++i) { acca[i] = 0.f; accb[i] = 0.f; }
            half8 bfa[4], bfb[4];
#pragma unroll
            for (int s = 0; s < 4; ++s) { bfa[s] = *(const LAS half8*)(kb + rowa * 128 + (((2 * s + hf) ^ ((rowa >> 1) & 7)) << 4)); bfb[s] = *(const LAS half8*)(kb + rowb * 128 + (((2 * s + hf) ^ ((rowb >> 1) & 7)) << 4)); }
#pragma unroll
            for (int s = 0; s < 4; ++s) { acca = __builtin_amdgcn_mfma_f32_32x32x16_f16(afr[s], bfa[s], acca, 0, 0, 0); accb = __builtin_amdgcn_mfma_f32_32x32x16_f16(afr[s], bfb[s], accb, 0, 0, 0); }
#pragma unroll
            for (int part = 0; part < 2; ++part) {
                const int key = kbase + part * 32 + l31;
                float s0 = 0.f, s1 = 0.f;
#pragma unroll
                for (int h = 0; h < 8; ++h) { s0 = __builtin_fmaf(w0[h], relu_asm(part ? accb[h] : acca[h]), s0); s1 = __builtin_fmaf(w1[h], relu_asm(part ? accb[8 + h] : acca[8 + h]), s1); }
                if (key <= tq0 && s0 > tau0) { const int qs = wid * 4 + hf; const int pos = (int)__hip_atomic_fetch_add(lcnt + qs, 1, __ATOMIC_RELAXED, __HIP_MEMORY_SCOPE_WORKGROUP); candS[qs * CAP + pos] = s0; candI[qs * CAP + pos] = (unsigned short)key; }
                if (key <= tq1 && s1 > tau1) { const int qs = wid * 4 + 2 + hf; const int pos = (int)__hip_atomic_fetch_add(lcnt + qs, 1, __ATOMIC_RELAXED, __HIP_MEMORY_SCOPE_WORKGROUP); candS[qs * CAP + pos] = s1; candI[qs * CAP + pos] = (unsigned short)key; }
            }
        }
        if (st + 1 < nst) {
            LAS unsigned char* kn = kbuf + ((st + 1) & 1) * 16384;
#pragma unroll
            for (int i = 0; i < 2; ++i) { const int ci = tid + 512 * i, row = ci >> 3, ch = ci & 7; *(LAS u32x4*)(kn + row * 128 + ((ch ^ ((row >> 1) & 7)) << 4)) = stg[i]; }
        }
        cntv = lcnt[wid * 4 + (lane & 3)];
        const int mx = max(max(__builtin_amdgcn_readlane(cntv, 0), __builtin_amdgcn_readlane(cntv, 1)), max(__builtin_amdgcn_readlane(cntv, 2), __builtin_amdgcn_readlane(cntv, 3)));
        if (mx > CAP - 128 && lane == 0) lflag[st % 3] = 1;
        if (tid == 0) lflag[(st + 1) % 3] = 0;
        __syncthreads();
        const int any = lflag[st % 3];
        if (any) {
#pragma unroll 1
            for (int qq = 0; qq < 4; ++qq) { const int n = __builtin_amdgcn_readlane(cntv, qq);
                if (n > 288) { float nt; const int nn = topk_compact(candS + (wid * 4 + qq) * CAP, candI + (wid * 4 + qq) * CAP, n, false, nt, lane);
                    if (lane == 0) lcnt[wid * 4 + qq] = nn;
                    if (hf == (qq & 1)) { if (qq < 2) tau0 = nt; else tau1 = nt; } } }
        }
    }
#pragma unroll 1
    for (int qq = 0; qq < 4; ++qq) {
        const int t = tw + qq; if (t >= L) break;
        int n = lcnt[wid * 4 + qq]; LAS float* cs = candS + (wid * 4 + qq) * CAP; LAS unsigned short* ci = candI + (wid * 4 + qq) * CAP;
        if (n > 256) { float nt; n = topk_compact(cs, ci, n, true, nt, lane); }
#pragma unroll
        for (int j = 0; j < 4; ++j) { const int p = lane + 64 * j; SEL[(size_t)t * 256 + p] = p < n ? ci[p] : (unsigned short)0xffffu; }
    }
    __syncthreads();
}

#ifdef SCORE_ONLY_EXP
__device__ __forceinline__ void indexer_score_only(const Params& P, int tile, LAS unsigned char* lds) {
    int tid_ = threadIdx.x; asm volatile("" : "+v"(tid_));
    const int tid = tid_, lane = tid & 63, wid = __builtin_amdgcn_readfirstlane(tid >> 6), l31 = lane & 31, hf = lane >> 5;
    LAS float* candS = (LAS float*)lds;
    LAS unsigned short* candI = (LAS unsigned short*)(lds + 32 * CAP * 4);
    LAS unsigned char* kbuf = lds + 32 * CAP * 6;
    const f16* IQ = (const f16*)(P.ws + WS_IQ); const f16* IK = (const f16*)(P.ws + WS_IK); const float* IW = (const float*)(P.ws + WS_IW);
    unsigned short* SEL = (unsigned short*)(P.ws + WS_SEL);
    const int t0 = tile * 32, tw = t0 + wid * 4;
    half8 afr[4];
    { const int qi = 2 * (l31 >> 4) + ((l31 >> 2) & 1), hd = 4 * ((l31 >> 3) & 1) + (l31 & 3); int tq = tw + qi; if (tq > L - 1) tq = L - 1;
      const half8* ap = (const half8*)(IQ + (size_t)tq * 512 + hd * 64);
#pragma unroll
      for (int s = 0; s < 4; ++s) afr[s] = ap[2 * s + hf]; }
    float w0[8], w1[8];
    { int ta = tw + hf, tb = tw + 2 + hf; if (ta > L - 1) ta = L - 1; if (tb > L - 1) tb = L - 1;
#pragma unroll
      for (int h = 0; h < 8; ++h) { w0[h] = IW[(size_t)ta * 8 + h]; w1[h] = IW[(size_t)tb * 8 + h]; } }
    asm volatile("" :: "v"(afr[0]), "v"(afr[1]), "v"(afr[2]), "v"(afr[3]));
    asm volatile("" :: "v"(w0[0]), "v"(w0[1]), "v"(w0[2]), "v"(w0[3]), "v"(w0[4]), "v"(w0[5]), "v"(w0[6]), "v"(w0[7]));
    asm volatile("" :: "v"(w1[0]), "v"(w1[1]), "v"(w1[2]), "v"(w1[3]), "v"(w1[4]), "v"(w1[5]), "v"(w1[6]), "v"(w1[7]));
    const int tq0 = (tw + hf < L) ? tw + hf : -1, tq1 = (tw + 2 + hf < L) ? tw + 2 + hf : -1;
    float tau0 = -__builtin_inff(), tau1 = -__builtin_inff();
    int cntv = 0; float sink = 0.f;
    const int nkeys = (t0 + 32 < L) ? t0 + 32 : L, nst = (nkeys + 127) >> 7;
    u32x4 stg[2];
    const u32x4* IKv = (const u32x4*)IK;
#pragma unroll
    for (int i = 0; i < 2; ++i) stg[i] = IKv[(size_t)0 * 1024 + tid + 512 * i];
#pragma unroll
    for (int i = 0; i < 2; ++i) { const int ci = tid + 512 * i, row = ci >> 3, ch = ci & 7; *(LAS u32x4*)(kbuf + row * 128 + ((ch ^ ((row >> 1) & 7)) << 4)) = stg[i]; }
    __syncthreads();
#pragma unroll 1
    for (int st = 0; st < nst; ++st) {
        LAS unsigned char* kb = kbuf + (st & 1) * 16384;
        if (st + 1 < nst) {
#pragma unroll
            for (int i = 0; i < 2; ++i) stg[i] = IKv[(size_t)(st + 1) * 1024 + tid + 512 * i];
        }
#pragma unroll 1
        for (int sub = 0; sub < 4; ++sub) {
            const int kbase = st * 128 + sub * 32;
            if (kbase > tw + 3) break;
            const int row = sub * 32 + l31;
            f32x16 acc;
#pragma unroll
            for (int i = 0; i < 16; ++i) acc[i] = 0.f;
#pragma unroll
            for (int s = 0; s < 4; ++s) { const half8 bfr = *(const LAS half8*)(kb + row * 128 + (((2 * s + hf) ^ ((row >> 1) & 7)) << 4)); acc = __builtin_amdgcn_mfma_f32_32x32x16_f16(afr[s], bfr, acc, 0, 0, 0); }
            float s0 = 0.f, s1 = 0.f;
#pragma unroll
            for (int h = 0; h < 8; ++h) { s0 = __builtin_fmaf(w0[h], relu_asm(acc[h]), s0); s1 = __builtin_fmaf(w1[h], relu_asm(acc[8 + h]), s1); }
            const int key = kbase + l31;
            sink += (key <= tq0 && s0 > tau0) ? s0 : 0.f; sink += (key <= tq1 && s1 > tau1) ? s1 : 0.f;
        }
        if (st + 1 < nst) {
            LAS unsigned char* kn = kbuf + ((st + 1) & 1) * 16384;
#pragma unroll
            for (int i = 0; i < 2; ++i) { const int ci = tid + 512 * i, row = ci >> 3, ch = ci & 7; *(LAS u32x4*)(kn + row * 128 + ((ch ^ ((row >> 1) & 7)) << 4)) = stg[i]; }
        }
        __syncthreads();
    }
    if (sink == 12345.678f) ((float*)(P.ws + WS_CTL))[200 + (tid & 31)] = sink + (float)cntv;
    __syncthreads();
}

#endif
__device__ __forceinline__ void sparse_attn(const Params& P, LAS unsigned char* lds, int vbid) {
    int tid_ = threadIdx.x; asm volatile("" : "+v"(tid_));
    const int tid = tid_, lane = tid & 63, wid = tid >> 6, grp = lane >> 2, c4 = lane & 3;
    const int head = vbid & 7, slot = (vbid >> 3) * 8 + wid, nslot = (gridDim.x >> 3) * 8;
    LAS unsigned short* widx = (LAS unsigned short*)(lds + wid * 512);
    LAS float* red = (LAS float*)(lds + 4096 + wid * 4352);
    const unsigned short* SEL = (const unsigned short*)(P.ws + WS_SEL); const f16* DQ = (const f16*)(P.ws + WS_DQ);
    const unsigned char* kvh = P.ws + WS_KV + (size_t)head * LP * 128; f16* mix = (f16*)(P.ws + WS_ACTA);
    int t = NMETA + slot;
    u32x2 selr = {0u, 0u}; half8 qa, qb;
#pragma unroll
    for (int e = 0; e < 8; ++e) { qa[e] = (f16)0.f; qb[e] = (f16)0.f; }
    if (t < L) { selr = *(const u32x2*)(SEL + (size_t)t * 256 + lane * 4); qa = *(const half8*)(DQ + (size_t)t * 512 + head * 64 + c4 * 16); qb = *(const half8*)(DQ + (size_t)t * 512 + head * 64 + c4 * 16 + 8); }
#pragma unroll 1
    for (; t < L; t += nslot) {
        *(LAS u32x2*)(widx + lane * 4) = selr;
        unsigned keys[16]; u32x4 kreg[16], vreg[16];
#pragma unroll
        for (int it = 0; it < 16; ++it) keys[it] = widx[16 * it + grp];
#pragma unroll
        for (int it = 0; it < 16; ++it) { const unsigned kk = keys[it] != 0xffffu ? keys[it] : 0u; kreg[it] = *(const u32x4*)(kvh + (size_t)kk * 128 + c4 * 16); }
#pragma unroll
        for (int it = 0; it < 16; ++it) { const unsigned kk = keys[it] != 0xffffu ? keys[it] : 0u; vreg[it] = *(const u32x4*)(kvh + (size_t)kk * 128 + 64 + c4 * 16); }
        f32x2 q2[8];
#pragma unroll
        for (int e = 0; e < 4; ++e) { q2[e] = (f32x2){(float)qa[2 * e], (float)qa[2 * e + 1]} * (1.0f / KV_SCALE); q2[4 + e] = (f32x2){(float)qb[2 * e], (float)qb[2 * e + 1]} * (1.0f / KV_SCALE); }
        { const int tn = t + nslot;
          if (tn < L) { selr = *(const u32x2*)(SEL + (size_t)tn * 256 + lane * 4); qa = *(const half8*)(DQ + (size_t)tn * 512 + head * 64 + c4 * 16); qb = *(const half8*)(DQ + (size_t)tn * 512 + head * 64 + c4 * 16 + 8); } }
        float lg[16]; float mx = -__builtin_inff();
#pragma unroll
        for (int it = 0; it < 16; ++it) {
            f32x2 a2 = {0.f, 0.f};
#pragma unroll
            for (int w = 0; w < 4; ++w) { a2 += q2[2 * w] * __builtin_amdgcn_cvt_pk_f32_fp8((int)kreg[it][w], false); a2 += q2[2 * w + 1] * __builtin_amdgcn_cvt_pk_f32_fp8((int)kreg[it][w], true); }
            float part = a2[0] + a2[1];
            part += __shfl_xor(part, 1); part += __shfl_xor(part, 2);
            lg[it] = keys[it] != 0xffffu ? part : -__builtin_inff(); mx = fmaxf(mx, lg[it]);
        }
        mx = fmaxf(mx, __shfl_xor(mx, 4)); mx = fmaxf(mx, __shfl_xor(mx, 8)); mx = fmaxf(mx, __shfl_xor(mx, 16)); mx = fmaxf(mx, __shfl_xor(mx, 32));
        f32x2 o2[8]; float lsum = 0.f;
#pragma unroll
        for (int e = 0; e < 8; ++e) o2[e] = (f32x2){0.f, 0.f};
#pragma unroll
        for (int it = 0; it < 16; ++it) {
            const float p = __expf(lg[it] - mx); lsum += p; const f32x2 p2 = {p, p};
#pragma unroll
            for (int w = 0; w < 4; ++w) { o2[2 * w] += p2 * __builtin_amdgcn_cvt_pk_f32_fp8((int)vreg[it][w], false); o2[2 * w + 1] += p2 * __builtin_amdgcn_cvt_pk_f32_fp8((int)vreg[it][w], true); }
        }
        lsum += __shfl_xor(lsum, 4); lsum += __shfl_xor(lsum, 8); lsum += __shfl_xor(lsum, 16); lsum += __shfl_xor(lsum, 32);
#pragma unroll
        for (int e = 0; e < 8; ++e) { red[lane * 17 + 2 * e] = o2[e][0]; red[lane * 17 + 2 * e + 1] = o2[e][1]; }
        float acc = 0.f;
        { const int cc = lane >> 4, e = lane & 15;
#pragma unroll
          for (int g = 0; g < 16; ++g) acc += red[(g * 4 + cc) * 17 + e]; }
        mix[(size_t)(t - NMETA) * D + 512 + head * 64 + lane] = (f16)(acc * (1.0f / KV_SCALE) / lsum);
    }
    __syncthreads();
}

__device__ __forceinline__ void final_norm(const Params& P) {
    const int tid = threadIdx.x, lane = tid & 63, gw = blockIdx.x * 8 + (tid >> 6), nw = gridDim.x * 8;
    const float* ss3 = (const float*)(P.ws + WS_SS3);
    for (int r = gw; r < SEQ; r += nw) { const float rs = row_rstd(ss3, 16, r);
#pragma unroll
        for (int i = 0; i < 4; ++i) { const int k = lane * 4 + 256 * i; const f32x4 v = *(const f32x4*)(P.out + (size_t)r * D + k), g = *(const f32x4*)(P.nf + k); *(f32x4*)(P.out + (size_t)r * D + k) = v * rs * g; } }
}

#define XB_TMO      128
#define XB_XCNT(j)  (256  + 64 * (j))
#define XB_XSUB(j)  (1280 + 64 * (j))
#define XB_XGEN(j)  (2304 + 64 * (j))
#define XB_TOP      3328
#define XB_TOPGEN   3392
#define XCD_BAR_WORDS 3456
#define XB_SPIN_CAP (1u << 22)
__device__ __forceinline__ unsigned xb_ld(unsigned* p)              { return __hip_atomic_load(p, __ATOMIC_RELAXED, __HIP_MEMORY_SCOPE_AGENT); }
__device__ __forceinline__ unsigned xb_add(unsigned* p, unsigned v) { return __hip_atomic_fetch_add(p, v, __ATOMIC_RELAXED, __HIP_MEMORY_SCOPE_AGENT); }
__device__ __forceinline__ unsigned xb_xcc_id() { return (unsigned)__builtin_amdgcn_s_getreg((3 << 11) | 20) & 0xFu; }
#define XB_SPIN(cond, bar) do { unsigned _sp = 0; while (cond) { __builtin_amdgcn_s_sleep(1); \
    if ((++_sp & 255u) == 0u) { if (xb_ld(&(bar)[XB_TMO])) break; if (_sp > XB_SPIN_CAP) { atomicAdd(&(bar)[XB_TMO], 1u); break; } } } } while (0)
struct XcdBarrier { unsigned* bar; unsigned x; volatile LAS unsigned* st; };
__device__ __forceinline__ XcdBarrier xcd_barrier_post(unsigned* bar, volatile LAS unsigned* st) {
    XcdBarrier b; b.bar = bar; b.x = xb_xcc_id(); b.st = st;
    if (threadIdx.x == 0) (void)xb_add(&bar[XB_XCNT(b.x)], 1u);
    return b;
}
__device__ __forceinline__ void xcd_barrier_complete(unsigned* bar, unsigned x, unsigned& nloc, unsigned& nx) {
    const unsigned G = gridDim.x * gridDim.y * gridDim.z;
    unsigned sum, cnt, mine, sp = 0u;
    for (;;) {
        sum = 0u; cnt = 0u; mine = 0u;
#pragma unroll
        for (unsigned j = 0; j < 16; ++j) { const unsigned c = xb_ld(&bar[XB_XCNT(j)]); sum += c; cnt += (c > 0u) ? 1u : 0u; mine = (j == x) ? c : mine; }
        if (sum == G) break;
        __builtin_amdgcn_s_sleep(1);
        if ((++sp & 255u) == 0u) { if (xb_ld(&bar[XB_TMO])) break; if (sp > XB_SPIN_CAP) { atomicAdd(&bar[XB_TMO], 1u); break; } }
    }
    nloc = mine > 0u ? mine : 1u; nx = cnt > 0u ? cnt : 1u;
}
__device__ __forceinline__ void xcd_barrier(const XcdBarrier& b) {
    asm volatile("s_waitcnt vmcnt(0)" ::: "memory");
    __syncthreads();
    if (threadIdx.x == 0) {
        unsigned* bar = b.bar;
        __builtin_amdgcn_s_waitcnt(0);
        unsigned nloc = b.st[0], nx = b.st[1];
        if (nloc == 0u) { xcd_barrier_complete(bar, b.x, nloc, nx); b.st[0] = nloc; b.st[1] = nx; }
        const unsigned old = xb_add(&bar[XB_XSUB(b.x)], 1u);
        const unsigned gen = old / nloc;
        if (old + 1u == (gen + 1u) * nloc) {
            __builtin_amdgcn_fence(__ATOMIC_RELEASE, "agent");
            asm volatile("s_waitcnt vmcnt(0)" ::: "memory");
            const unsigned og = xb_add(&bar[XB_TOP], 1u);
            const unsigned tg = og / nx;
            if (og + 1u == (tg + 1u) * nx) xb_add(&bar[XB_TOPGEN], 1u);
            else XB_SPIN(xb_ld(&bar[XB_TOPGEN]) == tg, bar);
            __builtin_amdgcn_fence(__ATOMIC_ACQUIRE, "agent");
            xb_add(&bar[XB_XGEN(b.x)], 1u);
            asm volatile("s_waitcnt vmcnt(0)" ::: "memory");
        } else {
            XB_SPIN(xb_ld(&bar[XB_XGEN(b.x)]) == gen, bar);
            __builtin_amdgcn_fence(__ATOMIC_ACQUIRE, "agent");
            asm volatile("s_waitcnt vmcnt(0)" ::: "memory");
        }
    }
    __syncthreads();
}

__global__ void __launch_bounds__(NTHREADS, 2) fwd_kernel(Params P) {
    __shared__ __attribute__((aligned(16))) unsigned char lds_raw[LDS_BYTES];
    LAS unsigned char* lds = (LAS unsigned char*)lds_raw;
    const int tid = threadIdx.x, bid = blockIdx.x, G = gridDim.x;
    unsigned char* ws = P.ws;
    const int lo = P.ph_lo, hi = P.ph_hi;
#ifndef ONLY_PHASE
#define ONLY_PHASE -1
#endif
#define IN(k) ((ONLY_PHASE < 0 || ONLY_PHASE == (k)) && lo <= (k) && (k) < hi)
#ifdef PROBE
#define STAMP(k) do { if (bid == 0 && tid == 0) ((unsigned long long*)(ws + WS_CTL + 1024))[(k)] = __builtin_amdgcn_s_memrealtime(); } while (0)
#else
#define STAMP(k) do { } while (0)
#endif
#define SEAM(k) do { if (IN(k) && IN((k) + 1)) { xcd_barrier(xbar); } STAMP((k) + 1); } while (0)
    XcdBarrier xbar; xbar.bar = (unsigned*)(ws + WS_BAR); xbar.x = 0; xbar.st = (volatile LAS unsigned*)(lds + LDS_BYTES - 1024 + 16);
    if (hi - lo > 1) {
        if (tid == 0) { xbar.st[0] = 0u; xbar.st[1] = 0u; }
        __syncthreads();
        xbar = xcd_barrier_post((unsigned*)(ws + WS_BAR), (volatile LAS unsigned*)(lds + LDS_BYTES - 1024 + 16));
    }
    LAS int* misc = (LAS int*)(lds + LDS_BYTES - 1024);
    if (hi - lo > 1) {
        if (tid == 0) { const unsigned xcc = xb_xcc_id() & 7u; misc[8] = (int)xcc; misc[9] = (int)xb_add((unsigned*)(ws + WS_CTL) + 32 + 32 * xcc, 1u); }
    }
    int vbid = bid;
    f16* acta = (f16*)(ws + WS_ACTA); f16* Gb = (f16*)(ws + WS_G);
    float* ss0 = (float*)(ws + WS_SS0); float* ss1 = (float*)(ws + WS_SS1); float* ss2 = (float*)(ws + WS_SS2); float* ss3 = (float*)(ws + WS_SS3);
    STAMP(0);
    _Pragma("unroll 1") for (int rep = 0; rep < (REPEAT_PH == 0 ? 2 : 1); ++rep)
    if (IN(0)) { p0_prologue(P, lds); }
    SEAM(0);
    if (hi - lo > 1 && (G & 7) == 0) {
        if (tid == 0) { bool ok = true; for (int j = 0; j < 8; ++j) ok = ok && (xb_ld((unsigned*)(ws + WS_CTL) + 32 + 32 * j) == (unsigned)(G >> 3)); misc[10] = ok ? misc[9] * 8 + misc[8] : bid; }
        __syncthreads();
        vbid = misc[10];
        __syncthreads();
    }
    _Pragma("unroll 1") for (int rep = 0; rep < (REPEAT_PH == 1 ? 2 : 1); ++rep)
    if (IN(1)) {
        pg8::Gemm g{acta, (const f16*)(ws + WS_WGU1), MP, 2 * DFF, D}; pg8::StaticOrder S; S.init(MP, 2 * DFF, G, vbid);
        EpiSwiglu E{Gb, ss0, rep == 0 ? 1 : -1}; pg8::gemm_phase(lds, g, S, E);
    }
    SEAM(1);
    _Pragma("unroll 1") for (int rep = 0; rep < (REPEAT_PH == 2 ? 2 : 1); ++rep)
    if (IN(2)) {
        meta_down(P, lds);
        pg8::Gemm g{Gb, (const f16*)(ws + WS_WD1), SEQ, D, DFF}; pg8::StaticOrder S; S.init(SEQ, D, G, vbid);
        EpiResid E{P.x, P.out, acta, ss1, 0.5f}; pg8::gemm_phase(lds, g, S, E);
    }
    SEAM(2);
    _Pragma("unroll 1") for (int rep = 0; rep < (REPEAT_PH == 3 ? 2 : 1); ++rep)
    if (IN(3)) {
        pg8::Gemm g{acta, (const f16*)(ws + WS_WIN), MP, NIN, D}; pg8::StaticOrder S; S.init(MP, NIN, G, vbid);
        EpiInProj E{ss1, (const f32x2*)(ws + WS_ROPE), ws};
        pg8::gemm_phase(lds, g, S, E);
    }
    SEAM(3);
    _Pragma("unroll 1") for (int rep = 0; rep < (REPEAT_PH == 4 ? 2 : 1); ++rep)
    if (IN(4)) {
        for (int u = bid; u < NCH * 4; u += G) gla_a_unit(P, u, lds);
        if (rep == 0) {
            int tbase = 0, cursor = bid; LAS f16* tl = (LAS f16*)lds;
            prep_weight(P, 3, D, D, (f16*)(ws + WS_WOUT), cursor, tbase, tl);
            prep_weight(P, 4, 2 * DFF, D, (f16*)(ws + WS_WGU2), cursor, tbase, tl);
            prep_weight(P, 5, D, DFF, (f16*)(ws + WS_WD2), cursor, tbase, tl);
        }
    }
    SEAM(4);
    _Pragma("unroll 1") for (int rep = 0; rep < (REPEAT_PH == 5 ? 2 : 1); ++rep)
    if (IN(5)) {
        if (bid < 64 && rep == 0) gla_scan(P);
        unsigned* ctr = (unsigned*)(ws + WS_CTL) + rep; LAS int* bc = (LAS int*)(lds + LDS_BYTES - 1024);
        for (;;) {
            if (tid == 0) bc[0] = (int)atomicAdd(ctr, 1u);
            __syncthreads();
            const int k = bc[0];
            __syncthreads();
            if (k >= 513) break;
            indexer_tile(P, 512 - k, lds);
        }
#ifdef SCORE_ONLY_EXP
        { unsigned* ctr2 = (unsigned*)(ws + WS_CTL) + 8;
          for (;;) {
            if (tid == 0) bc[0] = (int)atomicAdd(ctr2, 1u);
            __syncthreads();
            const int k = bc[0];
            __syncthreads();
            if (k >= 513) break;
            indexer_score_only(P, 512 - k, lds);
          } }
#endif
    }
    SEAM(5);
    _Pragma("unroll 1") for (int rep = 0; rep < (REPEAT_PH == 6 ? 2 : 1); ++rep)
    if (IN(6)) { if (REPEAT_PH != 6 || rep == 0 || true) for (int u = bid; u < NCH * 4; u += G) gla_c_unit(P, u, lds); sparse_attn(P, lds, vbid); }
    for (int e = 0; e < EXTRA_SYNCS; ++e) cg::this_grid().sync();
    SEAM(6);
    if (IN(7)) {
        pg8::Gemm g{acta, (const f16*)(ws + WS_WOUT), SEQ, D, D}; pg8::StaticOrder S; S.init(SEQ, D, G, vbid);
        EpiResid E{P.out, P.out, (f16*)(ws + WS_US), ss2, 1.0f}; pg8::gemm_phase(lds, g, S, E);
    }
    SEAM(7);
    _Pragma("unroll 1") for (int rep = 0; rep < (REPEAT_PH == 8 ? 2 : 1); ++rep)
    if (IN(8)) {
        pg8::Gemm g{(const f16*)(ws + WS_US), (const f16*)(ws + WS_WGU2), SEQ, 2 * DFF, D}; pg8::StaticOrder S; S.init(SEQ, 2 * DFF, G, vbid);
        EpiSwiglu E{Gb, ss2, 16}; pg8::gemm_phase(lds, g, S, E);
    }
    SEAM(8);
    if (IN(9)) {
        pg8::Gemm g{Gb, (const f16*)(ws + WS_WD2), SEQ, D, DFF}; pg8::StaticOrder S; S.init(SEQ, D, G, vbid);
        EpiResid E{P.out, P.out, nullptr, ss3, 0.5f}; pg8::gemm_phase(lds, g, S, E);
    }
    SEAM(9);
    if (IN(10)) final_norm(P);
#ifdef PROBE
    {
        STAMP(11);
        cg::this_grid().sync();
        const unsigned long long* tsv = (const unsigned long long*)(ws + WS_CTL + 1024);
        float tph[12]; float tg = 0.f;
#pragma unroll
        for (int k = 0; k < 11; ++k) { tph[k] = (float)(tsv[k + 1] - tsv[k]) * 0.01f; }
        tph[11] = (float)(tsv[11] - tsv[0]) * 0.01f;
        const float gsum = tph[1] + tph[2] + tph[3] + tph[7] + tph[8] + tph[9];
        const float va = (PROBE_A == 12) ? gsum : tph[PROBE_A < 12 ? PROBE_A : 0], vb = (PROBE_B == 12) ? gsum : tph[PROBE_B < 12 ? PROBE_B : 0];
        const size_t n = (size_t)SEQ * D;
        for (size_t i = (size_t)bid * NTHREADS + tid; i < n; i += (size_t)G * NTHREADS) P.out[i] = (i == 0) ? va : vb * 0.01f;
        (void)tg;
    }
#endif
#ifdef DBG_CUT
    if (IN(11)) {
        const size_t n = (size_t)SEQ * D; const size_t i0 = (size_t)bid * NTHREADS + tid, st = (size_t)G * NTHREADS;
#if DBG_CUT == 6
        const f16* m = (const f16*)(ws + WS_ACTA); for (size_t i = i0; i < n; i += st) P.out[i] = (float)m[i];
#elif DBG_CUT == 5
        const unsigned short* m = (const unsigned short*)(ws + WS_SEL); for (size_t i = i0; i < n; i += st) P.out[i] = (float)m[i % ((size_t)L * 256)];
#elif DBG_CUT == 3
        const f16* a = (const f16*)(ws + WS_DQ); const f16* b = (const f16*)(ws + WS_IQ); const f16* c = (const f16*)(ws + WS_KV); const f16* d = (const f16*)(ws + WS_GQ);
        for (size_t i = i0; i < n; i += st) P.out[i] = (float)a[i % ((size_t)L * 512)] + (float)b[i % ((size_t)L * 512)] + (float)c[i] + (float)d[i % ((size_t)L * 1536)];
#elif DBG_CUT == 4
        const float* m = (const float*)(ws + WS_US); for (size_t i = i0; i < n; i += st) P.out[i] = m[i % ((size_t)NCH * 32768)];
#endif
    }
#endif
#undef IN
#undef SEAM
}

extern "C" void kernel_launch(void* const* d_in, const int* in_sizes, int n_in, void* d_out, int out_size, void* d_ws, size_t ws_size, hipStream_t stream) {
    static int grid = 0;
    if (grid == 0) {
        if (n_in != 17 || in_sizes[0] != SEQ * D || out_size != SEQ * D || ws_size < WS_END) { fprintf(stderr, "kernel_launch: unexpected shapes (n_in %d, in0 %d, out %d, ws %zu, need %zu)\n", n_in, n_in > 0 ? in_sizes[0] : -1, out_size, ws_size, (size_t)WS_END); grid = -1; return; }
        int dev = 0, cus = 0, per_cu = 0;
        (void)hipGetDevice(&dev); (void)hipDeviceGetAttribute(&cus, hipDeviceAttributeMultiprocessorCount, dev);
        if (hipOccupancyMaxActiveBlocksPerMultiprocessor(&per_cu, (const void*)fwd_kernel, NTHREADS, 0) != hipSuccess || per_cu < 1) { fprintf(stderr, "kernel_launch: occupancy query says %d blocks per CU\n", per_cu); per_cu = 1; }
        (void)hipGetLastError();
        grid = cus;
        if (grid % 8 != 0 || grid < 64) { fprintf(stderr, "kernel_launch: unexpected CU count %d\n", cus); }
    }
    if (grid < 0) return;
    if (hipMemsetAsync((char*)d_ws + WS_CTL, 0, CTL_BYTES, stream) != hipSuccess) { fprintf(stderr, "kernel_launch: memset failed\n"); return; }
    Params p{};
    const float** pp = (const float**)&p;
    for (int i = 0; i < 17; ++i) pp[i] = (const float*)d_in[i];
    p.out = (float*)d_out; p.ws = (unsigned char*)d_ws;
#if MODE == 0
#ifdef DBG_CUT
    for (int ph = 0; ph <= DBG_CUT; ++ph) { p.ph_lo = ph; p.ph_hi = ph + 1; hipLaunchKernelGGL(fwd_kernel, dim3(grid), dim3(NTHREADS), 0, stream, p); }
    if (DBG_CUT != 2 && DBG_CUT != 7 && DBG_CUT != 9) { p.ph_lo = 11; p.ph_hi = 12; hipLaunchKernelGGL(fwd_kernel, dim3(grid), dim3(NTHREADS), 0, stream, p); }
#else
    for (int ph = 0; ph < NPHASE; ++ph) { p.ph_lo = ph; p.ph_hi = ph + 1; hipLaunchKernelGGL(fwd_kernel, dim3(grid), dim3(NTHREADS), 0, stream, p); }
#endif
#else
    p.ph_lo = 0; p.ph_hi = NPHASE;
    void* args[] = {&p};
    hipError_t e = hipLaunchCooperativeKernel((const void*)fwd_kernel, dim3(grid), dim3(NTHREADS), args, 0, stream);
    if (e != hipSuccess) fprintf(stderr, "cooperative launch failed: %s (grid %d)\n", hipGetErrorString(e), grid);
#endif
}
```

```cpp
#include <hip/hip_runtime.h>
#include <hip/hip_cooperative_groups.h>
#include <cstdio>
#include <cstdint>
namespace cg = cooperative_groups;

#ifndef MODE
#define MODE 1

#ifndef REPEAT_PH
#define REPEAT_PH -1
#endif
#define NREP(k) ((REPEAT_PH == (k) || REPEAT_PH == 99) ? 2 : 1)
#ifndef EXTRA_SYNCS
#define EXTRA_SYNCS 0
#endif
#endif

#define LAS __attribute__((address_space(3)))
typedef _Float16 f16;
typedef _Float16 half8 __attribute__((ext_vector_type(8)));
typedef _Float16 half4 __attribute__((ext_vector_type(4)));
typedef float f32x2 __attribute__((ext_vector_type(2)));
typedef float f32x4 __attribute__((ext_vector_type(4)));
typedef float f32x16 __attribute__((ext_vector_type(16)));
typedef unsigned u32x2 __attribute__((ext_vector_type(2)));
typedef unsigned u32x4 __attribute__((ext_vector_type(4)));

constexpr int D = 1024, SEQ = 16384, NMETA = 16, L = SEQ + NMETA, DFF = 2816;
constexpr int MP = 16640;
constexpr int LP = 16512;
constexpr int NIN = 3840;
constexpr int NCH = 257;
constexpr float EPS = 1e-6f;
constexpr int NTHREADS = 512;
constexpr int LDS_BYTES = 155648 + 1024;
constexpr int NPHASE = 11;

constexpr size_t al256(size_t x) { return (x + 255) & ~(size_t)255; }
constexpr size_t WS_CTL = 0;
constexpr size_t CTL_BYTES = 32768;
constexpr size_t WS_BAR = 2048;
constexpr size_t WS_WGU1 = CTL_BYTES;
constexpr size_t WS_WD1 = WS_WGU1 + (size_t)2 * DFF * D * 2;
constexpr size_t WS_WIN = WS_WD1 + (size_t)D * DFF * 2;
constexpr size_t WS_WOUT = WS_WIN + (size_t)NIN * D * 2;
constexpr size_t WS_WGU2 = WS_WOUT + (size_t)D * D * 2;
constexpr size_t WS_WD2 = WS_WGU2 + (size_t)2 * DFF * D * 2;
constexpr size_t WS_ACTA = WS_WD2 + (size_t)D * DFF * 2;
constexpr size_t WS_G = WS_ACTA + (size_t)MP * D * 2;
constexpr size_t WS_US = WS_G + (size_t)MP * DFF * 2;
constexpr size_t WS_DQ = WS_US + (size_t)NCH * 4 * 64 * 128 * 4;
constexpr size_t WS_IQ = WS_DQ + (size_t)LP * 512 * 2;
constexpr size_t WS_SEL = WS_IQ + (size_t)LP * 512 * 2;
constexpr size_t WS_ROPE = WS_SEL + (size_t)LP * 256 * 2;
constexpr size_t WS_IW = WS_ROPE + al256((size_t)L * 32 * 8);
constexpr size_t WS_GA = WS_IW + (size_t)LP * 8 * 4;
constexpr size_t WS_DECAY = WS_GA + (size_t)LP * 16 * 4;
constexpr size_t WS_SS0 = WS_DECAY + al256((size_t)NCH * 256 * 4);
constexpr size_t WS_SS1 = WS_SS0 + (size_t)MP * 4;
constexpr size_t WS_SS2 = WS_SS1 + (size_t)MP * 64;
constexpr size_t WS_SS3 = WS_SS2 + (size_t)MP * 64;
constexpr size_t WS_END = WS_SS3 + (size_t)MP * 64;
constexpr size_t WS_KV = WS_G;
constexpr size_t WS_GQ = WS_KV + (size_t)8 * LP * 128 * 2;
constexpr size_t WS_GK = WS_GQ + (size_t)LP * 256 * 2;
constexpr size_t WS_GV = WS_GK + (size_t)LP * 256 * 2;
constexpr size_t WS_GR = WS_GV + (size_t)LP * 512 * 2;
constexpr size_t WS_IK = WS_GR + (size_t)LP * 512 * 2;
constexpr size_t WS_ALIAS_END = WS_IK + (size_t)LP * 64 * 2;
static_assert(WS_ALIAS_END <= WS_US, "aliased buffers exceed G");
static_assert(WS_END <= (size_t)256 * 1024 * 1024, "workspace exceeds 256 MiB");
static_assert((size_t)SEQ * D * 2 <= (size_t)NCH * 4 * 64 * 128 * 4, "h2_16 alias");

struct Params {
    const float* x; const float* meta; const float* n1; const float* wg1; const float* wu1; const float* wd1;
    const float* nmix; const float* win; const float* wa2; const float* ba; const float* hn; const float* wout;
    const float* n2; const float* wg2; const float* wu2; const float* wd2; const float* nf;
    float* out; unsigned char* ws; int ph_lo, ph_hi;
};

namespace pg8 {
constexpr int BM = 256, BK = 64, HALF = 128, HTB = HALF * BK * 2, STAGE_BYTES = 8 * HTB, NXCD = 8, WGM = 8;
__host__ __device__ __forceinline__ int lds_byte(int r, int c) { const int st = (r >> 4) * 2 + (c >> 5), rr = r & 15, cc = c & 31, ob = rr * 64 + cc * 2; return st * 1024 + (ob ^ (((ob >> 9) & 1) << 5)); }
__host__ __device__ __forceinline__ int perm32(int rho) { const int n = rho >> 4, i = rho & 15; return 8 * (i >> 2) + 4 * n + (i & 3); }
__host__ __device__ __forceinline__ void stage_rc(int b, int& R, int& C) { const int st = b / 1024, sb = b % 1024, swz = sb ^ (((sb >> 9) & 1) << 5); R = (st >> 1) * 16 + swz / 64; C = (st & 1) * 32 + (swz % 64) / 2; }
struct Unit { int pm, pn; };
struct Gemm { const f16* A; const f16* Bt; int M, N, K; };
struct StaticOrder {
    int nM, nN, nwg, G, c;
    __host__ __device__ void init(int M, int N, int G_, int c_) { nM = M / BM; nN = N / BM; nwg = nM * nN; G = G_; c = c_; }
    __host__ __device__ bool next(int i, Unit& u) const {
        const long Lx = (long)i * G + c; if (Lx >= nwg) return false;
        int wgid = (int)Lx; { const int q = nwg / NXCD, r = nwg % NXCD, xcd = wgid % NXCD, off = wgid / NXCD; wgid = (xcd < r ? xcd * (q + 1) : r * (q + 1) + (xcd - r) * q) + off; }
        const int nig = WGM * nN, gid = wgid / nig, fm = gid * WGM, gsz = (nM - fm) < WGM ? (nM - fm) : WGM;
        u.pm = fm + ((wgid % nig) % gsz); u.pn = (wgid % nig) / gsz; return true;
    }
};
template <class Epi>
__device__ __forceinline__ void gemm_phase(LAS unsigned char* lds, const Gemm g, const StaticOrder& S, const Epi& E) {
    int tid_ = threadIdx.x; asm volatile("" : "+v"(tid_));
    const int tid = tid_, wid = __builtin_amdgcn_readfirstlane(tid >> 6), lane = tid & 63, wr = wid >> 2, wc = wid & 3, fr = lane & 15, fq = lane >> 4;
    const int K = g.K, nt = K / BK;
    unsigned voffA[2], voffB[2];
#pragma unroll
    for (int i = 0; i < 2; ++i) { int R, C; stage_rc(tid * 16 + i * 8192, R, C); const int Rb = (R & ~31) + perm32(R & 31); voffA[i] = (unsigned)(R * K + C) * 2u; voffB[i] = (unsigned)(Rb * K + C) * 2u; }
    const size_t kstep = (size_t)(BK * 2);
    const size_t hstep = (size_t)HALF * K * 2;
    const size_t tstep = 2 * hstep;
    const unsigned ldsw = (unsigned)wid * 1024u;
    const int aoff = lds_byte(wr * 64 + fr, fq * 8), boff = lds_byte(wc * 32 + fr, fq * 8);
#define PG8_SA(b, h) (((b) * 2 + (h)) * HTB)
#define PG8_SB(b, h) ((4 + (b) * 2 + (h)) * HTB)
#define PG8_STAGE(bufoff, gbase, voff) do { _Pragma("unroll") for (int _i = 0; _i < 2; ++_i) \
        __builtin_amdgcn_global_load_lds((const unsigned*)((const char*)(gbase) + (voff)[_i]), (LAS unsigned*)(lds + (bufoff) + ldsw + _i * 8192), 16, 0, 0); } while (0)
#define PG8_LDA(dst, b, h) do { _Pragma("unroll") for (int m = 0; m < 4; ++m) _Pragma("unroll") for (int k = 0; k < 2; ++k) dst[m][k] = *(const LAS half8*)(lds + PG8_SA(b, h) + aoff + m * 2048 + k * 1024); } while (0)
#define PG8_LDB(dst, b, h) do { _Pragma("unroll") for (int n = 0; n < 2; ++n) _Pragma("unroll") for (int k = 0; k < 2; ++k) dst[n][k] = *(const LAS half8*)(lds + PG8_SB(b, h) + boff + n * 2048 + k * 1024); } while (0)
#define PG8_MMA(ai, bj, At, Bt) do { __builtin_amdgcn_s_setprio(1); _Pragma("unroll") for (int m = 0; m < 4; ++m) _Pragma("unroll") for (int n = 0; n < 2; ++n) _Pragma("unroll") for (int k = 0; k < 2; ++k) \
        acc[ai][bj][m][n] = __builtin_amdgcn_mfma_f32_16x16x32_f16(Bt[n][k], At[m][k], acc[ai][bj][m][n], 0, 0, 0); __builtin_amdgcn_s_setprio(0); } while (0)
#define PG8_WAIT_V(n) asm volatile("s_waitcnt vmcnt(" #n ")" ::: "memory")
#define PG8_WAIT_L(n) asm volatile("s_waitcnt lgkmcnt(" #n ")" ::: "memory")
#define PG8_BAR __builtin_amdgcn_s_barrier()
#define PG8_SCHED __builtin_amdgcn_sched_barrier(0)
    Unit cur, nxt; int ui = 0;
    if (!S.next(0, cur)) return;
    f32x4 acc[2][2][4][2];
#pragma unroll
    for (int a = 0; a < 2; ++a)
#pragma unroll
        for (int b = 0; b < 2; ++b)
#pragma unroll
            for (int m = 0; m < 4; ++m)
#pragma unroll
                for (int n = 0; n < 2; ++n) acc[a][b][m][n] = (f32x4){0.f, 0.f, 0.f, 0.f};
    half8 At[4][2], B0[2][2], B1[2][2];
    const char* cA = (const char*)g.A + (size_t)cur.pm * tstep; const char* cB = (const char*)g.Bt + (size_t)cur.pn * tstep;
    PG8_STAGE(PG8_SB(0, 0), cB, voffB); PG8_STAGE(PG8_SA(0, 0), cA, voffA); PG8_STAGE(PG8_SB(0, 1), cB + hstep, voffB); PG8_STAGE(PG8_SA(0, 1), cA + hstep, voffA);
    if (wr == 1) PG8_BAR;
    PG8_WAIT_V(4); PG8_BAR;
    PG8_STAGE(PG8_SB(1, 0), cB + kstep, voffB); PG8_STAGE(PG8_SA(1, 0), cA + kstep, voffA); PG8_STAGE(PG8_SB(1, 1), cB + hstep + kstep, voffB);
    PG8_WAIT_V(6); PG8_BAR;
    for (;;) {
        const bool has_next = S.next(ui + 1, nxt);
        const char* nA = has_next ? (const char*)g.A + (size_t)nxt.pm * tstep : cA; const char* nB = has_next ? (const char*)g.Bt + (size_t)nxt.pn * tstep : cB;
        for (int t = 0; t < nt; t += 2) {
            const bool last = (t == nt - 2);
            const char* a1 = cA + (size_t)(t + 1) * kstep;
            const char* a2 = last ? nA : cA + (size_t)(t + 2) * kstep; const char* b2 = last ? nB : cB + (size_t)(t + 2) * kstep;
            const char* a3 = a2 + kstep; const char* b3 = b2 + kstep;
            PG8_LDB(B0, 0, 0); PG8_SCHED; PG8_LDA(At, 0, 0); PG8_STAGE(PG8_SA(1, 1), a1 + hstep, voffA);
            PG8_WAIT_L(8); PG8_BAR; PG8_WAIT_L(0); PG8_MMA(0, 0, At, B0); PG8_BAR; PG8_SCHED;
            PG8_LDB(B1, 0, 1); PG8_STAGE(PG8_SB(0, 0), b2, voffB);
            PG8_BAR; PG8_WAIT_L(0); PG8_MMA(0, 1, At, B1); PG8_BAR;
            PG8_LDA(At, 0, 1); PG8_STAGE(PG8_SA(0, 0), a2, voffA);
            PG8_BAR; PG8_WAIT_L(0); PG8_MMA(1, 0, At, B0); PG8_BAR; PG8_SCHED;
            PG8_STAGE(PG8_SB(0, 1), b2 + hstep, voffB);
            PG8_WAIT_V(6); PG8_BAR; PG8_MMA(1, 1, At, B1); PG8_BAR;
            PG8_LDB(B0, 1, 0); PG8_SCHED; PG8_LDA(At, 1, 0); PG8_STAGE(PG8_SA(0, 1), a2 + hstep, voffA);
            PG8_WAIT_L(8); PG8_BAR; PG8_WAIT_L(0); PG8_MMA(0, 0, At, B0); PG8_BAR; PG8_SCHED;
            PG8_LDB(B1, 1, 1); PG8_STAGE(PG8_SB(1, 0), b3, voffB);
            PG8_BAR; PG8_WAIT_L(0); PG8_MMA(0, 1, At, B1); PG8_BAR;
            PG8_LDA(At, 1, 1); PG8_STAGE(PG8_SA(1, 0), a3, voffA);
            PG8_BAR; PG8_WAIT_L(0); PG8_MMA(1, 0, At, B0); PG8_BAR; PG8_SCHED;
            PG8_STAGE(PG8_SB(1, 1), b3 + hstep, voffB);
            PG8_WAIT_V(6); PG8_BAR; PG8_MMA(1, 1, At, B1); PG8_BAR;
        }
        E(acc, cur, wr, wc, fr, fq);
        if (!has_next) break;
#pragma unroll
        for (int a = 0; a < 2; ++a)
#pragma unroll
            for (int b = 0; b < 2; ++b)
#pragma unroll
                for (int m = 0; m < 4; ++m)
#pragma unroll
                    for (int n = 0; n < 2; ++n) acc[a][b][m][n] = (f32x4){0.f, 0.f, 0.f, 0.f};
        cur = nxt; cA = nA; cB = nB; ++ui;
    }
    PG8_WAIT_V(0);
    if (wr == 0) PG8_BAR;
    PG8_BAR;
#undef PG8_SA
#undef PG8_SB
#undef PG8_STAGE
#undef PG8_LDA
#undef PG8_LDB
#undef PG8_MMA
#undef PG8_WAIT_V
#undef PG8_WAIT_L
#undef PG8_BAR
#undef PG8_SCHED
}
}

__device__ __forceinline__ float silu_f(float v) { return v / (1.0f + __expf(-v)); }
__device__ __forceinline__ half4 to_half4(f32x4 v) { half4 h; h[0] = (f16)v[0]; h[1] = (f16)v[1]; h[2] = (f16)v[2]; h[3] = (f16)v[3]; return h; }

__device__ __forceinline__ float row_rstd(const float* ss, int np, int row) {
    float s;
    if (np == 1) s = ss[row];
    else { const f32x4* p = (const f32x4*)(ss + (size_t)row * 16); const f32x4 a = p[0], b = p[1], c = p[2], d = p[3];
        s = (((a[0] + a[1]) + (a[2] + a[3])) + ((b[0] + b[1]) + (b[2] + b[3]))) + (((c[0] + c[1]) + (c[2] + c[3])) + ((d[0] + d[1]) + (d[2] + d[3]))); }
    return rsqrtf(s * (1.0f / D) + EPS);
}
struct EpiSwiglu {
    f16* G; const float* ss; int np;
    __device__ __forceinline__ void operator()(const f32x4 (&acc)[2][2][4][2], const pg8::Unit& u, int wr, int wc, int fr_, int fq_) const {
        int fr = fr_, fq = fq_; asm volatile("" : "+v"(fr), "+v"(fq));
#pragma unroll
        for (int ai = 0; ai < 2; ++ai)
#pragma unroll
            for (int m = 0; m < 4; ++m) {
                const int row = u.pm * 256 + ai * 128 + wr * 64 + m * 16 + fr;
                const float rs = row_rstd(ss, np, row); half8 o;
#pragma unroll
                for (int n = 0; n < 2; ++n) {
                    const f32x4 gt = acc[ai][0][m][n] * rs, up = acc[ai][1][m][n] * rs;
#pragma unroll
                    for (int j = 0; j < 4; ++j) o[4 * n + j] = (f16)(silu_f(gt[j]) * up[j]);
                }
                *(half8*)(G + (size_t)row * DFF + u.pn * 128 + wc * 32 + 8 * fq) = o;
            }
    }
};
struct EpiResid {
    const float* src; float* out; f16* h16; float* ss; float alpha;
    __device__ __forceinline__ void operator()(const f32x4 (&acc)[2][2][4][2], const pg8::Unit& u, int wr, int wc, int fr_, int fq_) const {
        int fr = fr_, fq = fq_; asm volatile("" : "+v"(fr), "+v"(fq));
#pragma unroll
        for (int ai = 0; ai < 2; ++ai)
#pragma unroll
            for (int m = 0; m < 4; ++m) {
                const int row = u.pm * 256 + ai * 128 + wr * 64 + m * 16 + fr; float part = 0.f;
#pragma unroll
                for (int bj = 0; bj < 2; ++bj) {
                    const size_t off = (size_t)row * D + u.pn * 256 + bj * 128 + wc * 32 + 8 * fq; half8 h;
#pragma unroll
                    for (int n = 0; n < 2; ++n) {
                        const f32x4 sv = *(const f32x4*)(src + off + 4 * n); const f32x4 o = sv + alpha * acc[ai][bj][m][n];
                        *(f32x4*)(out + off + 4 * n) = o;
#pragma unroll
                        for (int j = 0; j < 4; ++j) h[4 * n + j] = (f16)o[j];
                        part += (o[0] * o[0] + o[1] * o[1]) + (o[2] * o[2] + o[3] * o[3]);
                    }
                    if (h16) *(half8*)(h16 + off) = h;
                }
                part += __shfl_xor(part, 16); part += __shfl_xor(part, 32);
                if (fq == 0) ss[(size_t)row * 16 + u.pn * 4 + wc] = part;
            }
    }
};
constexpr float KV_SCALE = 16.0f;
__device__ __forceinline__ unsigned pack_fp8x4(f32x4 v) {
#pragma unroll
    for (int j = 0; j < 4; ++j) v[j] = fminf(fmaxf(v[j], -448.f), 448.f);
    int w = __builtin_amdgcn_cvt_pk_fp8_f32(v[0], v[1], 0, false); w = __builtin_amdgcn_cvt_pk_fp8_f32(v[2], v[3], w, true); return (unsigned)w;
}
__device__ __forceinline__ void rope8(const f32x4 (&x1)[2], const f32x4 (&x2)[2], const f32x2* rp, float sc, float (&o1)[8], float (&o2)[8]) {
#pragma unroll
    for (int n = 0; n < 2; ++n) {
        const f32x4 cs0 = *(const f32x4*)(rp + 4 * n), cs1 = *(const f32x4*)(rp + 4 * n + 2);
        o1[4 * n + 0] = (x1[n][0] * cs0[0] - x2[n][0] * cs0[1]) * sc; o2[4 * n + 0] = (x2[n][0] * cs0[0] + x1[n][0] * cs0[1]) * sc;
        o1[4 * n + 1] = (x1[n][1] * cs0[2] - x2[n][1] * cs0[3]) * sc; o2[4 * n + 1] = (x2[n][1] * cs0[2] + x1[n][1] * cs0[3]) * sc;
        o1[4 * n + 2] = (x1[n][2] * cs1[0] - x2[n][2] * cs1[1]) * sc; o2[4 * n + 2] = (x2[n][2] * cs1[0] + x1[n][2] * cs1[1]) * sc;
        o1[4 * n + 3] = (x1[n][3] * cs1[2] - x2[n][3] * cs1[3]) * sc; o2[4 * n + 3] = (x2[n][3] * cs1[2] + x1[n][3] * cs1[3]) * sc;
    }
}
__device__ __forceinline__ u32x2 pack_fp8x8(const float (&v)[8]) { u32x2 r; r[0] = pack_fp8x4((f32x4){v[0], v[1], v[2], v[3]}); r[1] = pack_fp8x4((f32x4){v[4], v[5], v[6], v[7]}); return r; }
struct EpiInProj {
    const float* ss; const f32x2* rope; unsigned char* ws;
    __device__ __forceinline__ void operator()(const f32x4 (&acc)[2][2][4][2], const pg8::Unit& u, int wr, int wc, int fr_, int fq_) const {
        int fr = fr_, fq = fq_; asm volatile("" : "+v"(fr), "+v"(fq));
        const int pn = u.pn;
        if (pn >= 8 && pn <= 11) {
            unsigned char* lb = (pn <= 9) ? ws + WS_KV + (size_t)((pn - 8) * 4 + wc) * LP * 128 + 8 * fq
                                          : ws + WS_KV + (size_t)((pn - 10) * 4 + (wc >> 1)) * LP * 128 + 64 + (wc & 1) * 32 + 8 * fq;
#pragma unroll
            for (int ai = 0; ai < 2; ++ai)
#pragma unroll
                for (int m = 0; m < 4; ++m) {
                    const int p = u.pm * 256 + ai * 128 + wr * 64 + m * 16 + fr;
                    const int t = p < SEQ ? p + NMETA : p - SEQ;
                    if (p < L) {
                        const float sc = row_rstd(ss, 16, p) * KV_SCALE;
                        if (pn <= 9) {
                            float o1[8], o2[8]; rope8(acc[ai][0][m], acc[ai][1][m], rope + (size_t)t * 32 + 8 * fq, sc, o1, o2);
                            unsigned char* d8 = lb + (size_t)t * 128; *(u32x2*)d8 = pack_fp8x8(o1); *(u32x2*)(d8 + 32) = pack_fp8x8(o2);
                        } else {
#pragma unroll
                            for (int bj = 0; bj < 2; ++bj) { float v[8];
#pragma unroll
                                for (int j = 0; j < 4; ++j) { v[j] = acc[ai][bj][m][0][j] * sc; v[4 + j] = acc[ai][bj][m][1][j] * sc; }
                                *(u32x2*)(lb + (size_t)t * 128 + (size_t)bj * 2 * LP * 128) = pack_fp8x8(v); }
                        }
                    }
                    asm volatile("" ::: "memory");
                }
            return;
        }
        int mode = 0, stride = 256; float scale = 1.0f; f16* lanebase;
        if (pn == 0) lanebase = (f16*)(ws + WS_GQ) + wc * 32 + 8 * fq;
        else if (pn == 1) lanebase = (f16*)(ws + WS_GK) + wc * 32 + 8 * fq;
        else if (pn <= 3) { lanebase = (f16*)(ws + WS_GV) + (pn - 2) * 256 + wc * 32 + 8 * fq; stride = 512; }
        else if (pn <= 5) { lanebase = (f16*)(ws + WS_GR) + (pn - 4) * 256 + wc * 32 + 8 * fq; stride = 512; }
        else if (pn <= 7) { lanebase = (f16*)(ws + WS_DQ) + (pn - 6) * 256 + wc * 64 + 8 * fq; stride = 512; mode = 1; scale = 0.125f; }
        else if (pn <= 13) { lanebase = (f16*)(ws + WS_IQ) + (pn - 12) * 256 + wc * 64 + 8 * fq; stride = 512; mode = 1; scale = 0.125f; }
        else { lanebase = (f16*)(ws + WS_IK) + 8 * fq; stride = 64; mode = wc == 0 ? 1 : (wc == 1 ? 2 : 3); }
#pragma unroll
        for (int ai = 0; ai < 2; ++ai)
#pragma unroll
            for (int m = 0; m < 4; ++m) {
                const int p = u.pm * 256 + ai * 128 + wr * 64 + m * 16 + fr;
                const int t = p < SEQ ? p + NMETA : p - SEQ;
                if (p < L && mode != 3) {
                    const float rs = row_rstd(ss, 16, p);
                    if (mode == 1) {
                        float o1[8], o2[8]; rope8(acc[ai][0][m], acc[ai][1][m], rope + (size_t)t * 32 + 8 * fq, rs * scale, o1, o2);
                        half8 h1, h2;
#pragma unroll
                        for (int j = 0; j < 8; ++j) { h1[j] = (f16)o1[j]; h2[j] = (f16)o2[j]; }
                        f16* dst = lanebase + (size_t)t * stride; *(half8*)dst = h1; *(half8*)(dst + 32) = h2;
                    } else if (mode == 2) {
                        if (fq < 2) { float* gp = (float*)(ws + WS_GA) + (size_t)t * 16 + 8 * fq; *(f32x4*)gp = acc[ai][0][m][0] * rs; *(f32x4*)(gp + 4) = acc[ai][0][m][1] * rs; }
                        else if (fq == 2) { float* ip = (float*)(ws + WS_IW) + (size_t)t * 8; const float r2 = rs * 0.35355339059327373f; *(f32x4*)ip = acc[ai][0][m][0] * r2; *(f32x4*)(ip + 4) = acc[ai][0][m][1] * r2; }
                    } else {
#pragma unroll
                        for (int bj = 0; bj < 2; ++bj) { half8 h;
#pragma unroll
                            for (int j = 0; j < 4; ++j) { h[j] = (f16)(acc[ai][bj][m][0][j] * rs); h[4 + j] = (f16)(acc[ai][bj][m][1][j] * rs); }
                            *(half8*)(lanebase + (size_t)t * stride + bj * 128) = h; }
                    }
                }
                asm volatile("" ::: "memory");
            }
    }
};

__device__ __forceinline__ const float* w_src(const Params& P, int kind, int n, int& ld, const float*& gain) {
    switch (kind) {
    case 0: case 4: { const int pn = n >> 8, bj = (n >> 7) & 1, cc = n & 127; ld = DFF; gain = kind == 0 ? P.n1 : P.n2;
        const float* w = kind == 0 ? (bj ? P.wu1 : P.wg1) : (bj ? P.wu2 : P.wg2); return w + pn * 128 + cc; }
    case 1: ld = D; gain = nullptr; return P.wd1 + n;
    case 5: ld = D; gain = nullptr; return P.wd2 + n;
    case 3: ld = D; gain = nullptr; return P.wout + n;
    default: { ld = 3672; gain = P.nmix; const int pn = n >> 8, c = n & 255, bj = c >> 7, hh = (c >> 5) & 3, dd = c & 31; int j;
        if (pn == 0) j = c; else if (pn == 1) j = 256 + c; else if (pn <= 3) j = 512 + (pn - 2) * 256 + c; else if (pn <= 5) j = 1024 + (pn - 4) * 256 + c;
        else if (pn <= 7) j = 1552 + (pn - 6) * 256 + hh * 64 + bj * 32 + dd;
        else if (pn <= 9) j = 2064 + (pn - 8) * 256 + hh * 64 + bj * 32 + dd;
        else if (pn <= 11) j = 2576 + (pn - 10) * 256 + c;
        else if (pn <= 13) j = 3088 + (pn - 12) * 256 + hh * 64 + bj * 32 + dd;
        else { if (c < 32) j = 3600 + c; else if (c < 48) j = 1536 + (c - 32); else if (c < 56) j = 3664 + (c - 48); else if (c >= 128 && c < 160) j = 3600 + 32 + (c - 128); else j = -1; }
        return j < 0 ? nullptr : P.win + j; }
    }
}
__device__ __forceinline__ void prep_weight(const Params& P, const int kind, const int N, const int K, f16* dst, int& cursor, int& tbase, LAS f16* tl) {
    const int tid = threadIdx.x, G = gridDim.x, tn = N / 64, tk = K / 256, ntile = tn * tk;
#pragma unroll 1
    for (; cursor < tbase + ntile; cursor += G) {
        const int tI = cursor - tbase, n0 = (tI % tn) * 64, k0 = (tI / tn) * 256;
        { const int n = tid & 63, kk0 = tid >> 6; int ld; const float* gain; const float* col = w_src(P, kind, n0 + n, ld, gain);
          float v[32];
#pragma unroll
          for (int i = 0; i < 32; ++i) v[i] = col ? col[(size_t)(k0 + kk0 + 8 * i) * ld] : 0.f;
          if (gain) {
#pragma unroll
              for (int i = 0; i < 32; ++i) v[i] *= gain[k0 + kk0 + 8 * i];
          }
#pragma unroll
          for (int i = 0; i < 32; ++i) tl[n * 264 + kk0 + 8 * i] = (f16)v[i]; }
        __syncthreads();
        { const int n = tid >> 3, seg = tid & 7;
#pragma unroll
          for (int j = 0; j < 4; ++j) *(half8*)(dst + (size_t)(n0 + n) * K + k0 + (seg + 8 * j) * 8) = *(const LAS half8*)(tl + n * 264 + (seg + 8 * j) * 8); }
        __syncthreads();
    }
    tbase += ntile;
}
__device__ __forceinline__ void p0_prologue(const Params& P, LAS unsigned char* lds) {
    const int tid = threadIdx.x, bid = blockIdx.x, G = gridDim.x, lane = tid & 63;
    unsigned char* ws = P.ws;
    int tbase = 0, cursor = bid;
    LAS f16* tl = (LAS f16*)lds;
    prep_weight(P, 0, 2 * DFF, D, (f16*)(ws + WS_WGU1), cursor, tbase, tl);
    prep_weight(P, 1, D, DFF, (f16*)(ws + WS_WD1), cursor, tbase, tl);
    prep_weight(P, 2, NIN, D, (f16*)(ws + WS_WIN), cursor, tbase, tl);
    float* ss0 = (float*)(ws + WS_SS0);
    f16* acta = (f16*)(ws + WS_ACTA);
    const int gw = bid * 8 + (tid >> 6), nw = G * 8;
    for (int p = gw; p < L; p += nw) {
        const float* src = p < SEQ ? P.x + (size_t)p * D : P.meta + (size_t)(p - SEQ) * D; float s = 0.f;
#pragma unroll
        for (int i = 0; i < 4; ++i) { const f32x4 v = *(const f32x4*)(src + lane * 4 + 256 * i); s += (v[0] * v[0] + v[1] * v[1]) + (v[2] * v[2] + v[3] * v[3]); *(half4*)(acta + (size_t)p * D + lane * 4 + 256 * i) = to_half4(v); }
#pragma unroll
        for (int o = 32; o >= 1; o >>= 1) s += __shfl_xor(s, o);
        if (lane == 0) ss0[p] = s;
    }
    const int gt = bid * NTHREADS + tid, ngt = G * NTHREADS;
    for (int i = gt; i < MP; i += ngt) { if (i >= L) ss0[i] = (float)D; }
    f32x2* rope = (f32x2*)(ws + WS_ROPE);
    for (int i = gt; i < L * 32; i += ngt) { const int t = i >> 5, f = i & 31; const double inv = exp(-(double)f * (9.210340371976184 / 32.0)); double sn, cs; sincos((double)t * inv, &sn, &cs); rope[i] = (f32x2){(float)cs, (float)sn}; }
}

__device__ __forceinline__ void meta_down(const Params& P, LAS unsigned char* lds) {
    const int tid = threadIdx.x, lane = tid & 63, wid = tid >> 6;
    const f16* Gm = (const f16*)(P.ws + WS_G) + (size_t)SEQ * DFF; const f16* Wt = (const f16*)(P.ws + WS_WD1);
    f16* acta = (f16*)(P.ws + WS_ACTA); float* ss1 = (float*)(P.ws + WS_SS1); LAS float* slot = (LAS float*)lds;
    for (int task = blockIdx.x; task < NMETA * 16; task += gridDim.x) {
        const int r = task >> 4, cg = task & 15; float part = 0.f;
#pragma unroll 1
        for (int q = 0; q < 2; ++q) {
            const int n0 = cg * 64 + (2 * wid + q) * 4; float a[4] = {0.f, 0.f, 0.f, 0.f};
            for (int kc = lane; kc < DFF / 8; kc += 64) {
                const half8 gv = *(const half8*)(Gm + (size_t)r * DFF + kc * 8);
#pragma unroll
                for (int j = 0; j < 4; ++j) { const half8 wv = *(const half8*)(Wt + (size_t)(n0 + j) * DFF + kc * 8);
#pragma unroll
                    for (int e = 0; e < 8; ++e) a[j] += (float)gv[e] * (float)wv[e]; }
            }
#pragma unroll
            for (int o = 32; o >= 1; o >>= 1) { a[0] += __shfl_xor(a[0], o); a[1] += __shfl_xor(a[1], o); a[2] += __shfl_xor(a[2], o); a[3] += __shfl_xor(a[3], o); }
            f32x4 o;
#pragma unroll
            for (int j = 0; j < 4; ++j) { o[j] = P.meta[r * D + n0 + j] + 0.5f * a[j]; part += o[j] * o[j]; }
            if (lane == 0) *(half4*)(acta + (size_t)(SEQ + r) * D + n0) = to_half4(o);
        }
        if (lane == 0) slot[wid] = part;
        __syncthreads();
        if (tid == 0) { float s = 0.f; for (int w = 0; w < 8; ++w) s += slot[w]; ss1[(size_t)(SEQ + r) * 16 + cg] = s; }
        __syncthreads();
    }
}

__device__ __forceinline__ float logsigmoid_f(float z) { return fminf(z, 0.f) - __logf(1.0f + __expf(-fabsf(z))); }
__device__ __forceinline__ void gla_gates(const Params& P, int c, int h, LAS float* bl) {
    const int tid = threadIdx.x, ti = tid >> 3, d0 = (tid & 7) * 8, tt = 64 * c - 48 + ti; const float* GA = (const float*)(P.ws + WS_GA);
    {
        float z[8];
        if (tt >= 0 && tt < L) {
            const f32x4 b0 = *(const f32x4*)(P.ba + 64 * h + d0), b1 = *(const f32x4*)(P.ba + 64 * h + d0 + 4);
#pragma unroll
            for (int m = 0; m < 4; ++m) { z[m] = b0[m]; z[4 + m] = b1[m]; }
            f32x4 a4[4];
#pragma unroll
            for (int q = 0; q < 4; ++q) a4[q] = *(const f32x4*)(GA + (size_t)tt * 16 + 4 * q);
#pragma unroll
            for (int r = 0; r < 16; ++r) { const float ar = a4[r >> 2][r & 3]; const f32x4 w0 = *(const f32x4*)(P.wa2 + r * 256 + 64 * h + d0), w1 = *(const f32x4*)(P.wa2 + r * 256 + 64 * h + d0 + 4);
#pragma unroll
                for (int m = 0; m < 4; ++m) { z[m] += ar * w0[m]; z[4 + m] += ar * w1[m]; } }
#pragma unroll
            for (int m = 0; m < 8; ++m) z[m] = logsigmoid_f(z[m]) * (1.0f / 16.0f);
        } else {
#pragma unroll
            for (int m = 0; m < 8; ++m) z[m] = 0.f;
        }
#pragma unroll
        for (int m = 0; m < 8; ++m) bl[ti * 65 + d0 + m] = z[m];
    }
    __syncthreads();
    {
        const int d = tid & 63, seg = tid >> 6; float v[8], run = 0.f;
#pragma unroll
        for (int i = 0; i < 8; ++i) { run += bl[(seg * 8 + i) * 65 + d]; v[i] = run; }
#pragma unroll
        for (int i = 0; i < 8; ++i) bl[(seg * 8 + i) * 65 + d] = v[i];
        __syncthreads();
        float off = 0.f;
#pragma unroll
        for (int sg = 0; sg < 7; ++sg) off += (sg < seg) ? bl[(sg * 8 + 7) * 65 + d] : 0.f;
        __syncthreads();
#pragma unroll
        for (int i = 0; i < 8; ++i) bl[(seg * 8 + i) * 65 + d] = v[i] + off;
    }
    __syncthreads();
}
__device__ __forceinline__ void gla_a_unit(const Params& P, int unit, LAS unsigned char* lds) {
    int tid_ = threadIdx.x; asm volatile("" : "+v"(tid_));
    const int tid = tid_, lane = tid & 63, wid = tid >> 6, c = unit >> 2, h = unit & 3;
    LAS float* bl = (LAS float*)lds; LAS float* ks = bl + 4160; LAS float* vs = ks + 4096;
    const f16* GK = (const f16*)(P.ws + WS_GK); const f16* GV = (const f16*)(P.ws + WS_GV);
    float* U = (float*)(P.ws + WS_US); float* DEC = (float*)(P.ws + WS_DECAY);
    const int ti = tid >> 3, d0 = (tid & 7) * 8, tt = 64 * c - 48 + ti; const bool tv = tt >= 0 && tt < L;
    half8 k8, v8[2];
#pragma unroll
    for (int m = 0; m < 8; ++m) { k8[m] = (f16)0.f; v8[0][m] = (f16)0.f; v8[1][m] = (f16)0.f; }
    if (tv) k8 = *(const half8*)(GK + (size_t)tt * 256 + 64 * h + d0);
#pragma unroll
    for (int q = 0; q < 2; ++q) { const int ch = tid + 512 * q, j = ch >> 4, t = 64 * c - 48 + j; if (t >= 0 && t < L) v8[q] = *(const half8*)(GV + (size_t)t * 512 + 128 * h + (ch & 15) * 8); }
    gla_gates(P, c, h, bl);
    { f32x4 o0, o1;
#pragma unroll
      for (int m = 0; m < 4; ++m) { o0[m] = (float)k8[m] * __expf(bl[63 * 65 + d0 + m] - bl[ti * 65 + d0 + m]); o1[m] = (float)k8[4 + m] * __expf(bl[63 * 65 + d0 + 4 + m] - bl[ti * 65 + d0 + 4 + m]); }
      *(LAS f32x4*)(ks + ti * 64 + d0) = o0; *(LAS f32x4*)(ks + ti * 64 + d0 + 4) = o1; }
#pragma unroll
    for (int q = 0; q < 2; ++q) { const int ch = tid + 512 * q, j = ch >> 4, e0 = (ch & 15) * 8; f32x4 o0, o1;
#pragma unroll
        for (int m = 0; m < 4; ++m) { o0[m] = (float)v8[q][m]; o1[m] = (float)v8[q][4 + m]; }
        *(LAS f32x4*)(vs + j * 128 + e0) = o0; *(LAS f32x4*)(vs + j * 128 + e0 + 4) = o1; }
    if (tid < 64) DEC[(size_t)c * 256 + h * 64 + tid] = __expf(bl[63 * 65 + tid]);
    __syncthreads();
    { const int dd0 = (wid >> 2) * 32, e0 = (wid & 3) * 32, l31 = lane & 31, hf = lane >> 5; f32x16 acc;
#pragma unroll
      for (int i = 0; i < 16; ++i) acc[i] = 0.f;
#pragma unroll 8
      for (int s = 0; s < 32; ++s) acc = __builtin_amdgcn_mfma_f32_32x32x2f32(ks[(2 * s + hf) * 64 + dd0 + l31], vs[(2 * s + hf) * 128 + e0 + l31], acc, 0, 0, 0);
      float* up = U + ((size_t)unit * 64) * 128;
#pragma unroll
      for (int r = 0; r < 16; ++r) { const int row = (r & 3) + 8 * (r >> 2) + 4 * hf; up[(size_t)(dd0 + row) * 128 + e0 + l31] = acc[r]; } }
    __syncthreads();
}
__device__ __forceinline__ void gla_scan(const Params& P) {
    float* U = (float*)(P.ws + WS_US); const float* DEC = (const float*)(P.ws + WS_DECAY);
    const int idx = blockIdx.x * NTHREADS + threadIdx.x;
    if (idx >= 32768) return;
    float s = 0.f;
#pragma unroll 8
    for (int c = 0; c < NCH; ++c) { const float u = U[(size_t)c * 32768 + idx], dc = DEC[(size_t)c * 256 + (idx >> 7)]; U[(size_t)c * 32768 + idx] = s; s = dc * s + u; }
}
__device__ __forceinline__ void gla_c_unit(const Params& P, int unit, LAS unsigned char* lds) {
    int tid_ = threadIdx.x; asm volatile("" : "+v"(tid_));
    const int tid = tid_, lane = tid & 63, wid = tid >> 6, c = unit >> 2, h = unit & 3, l31 = lane & 31, hf = lane >> 5;
    LAS float* bl = (LAS float*)lds; LAS float* kk = bl + 4160; LAS float* qs = kk + 4160; LAS float* As = qs + 4160; LAS float* vs = As + 4160; LAS float* Ss = vs + 8192; LAS float* os = bl;
    const f16* GQ = (const f16*)(P.ws + WS_GQ); const f16* GK = (const f16*)(P.ws + WS_GK); const f16* GV = (const f16*)(P.ws + WS_GV); const f16* GR = (const f16*)(P.ws + WS_GR);
    const float* Sg = (const float*)(P.ws + WS_US) + (size_t)unit * 8192; f16* mix = (f16*)(P.ws + WS_ACTA);
    const int ti = tid >> 3, d0 = (tid & 7) * 8, tt = 64 * c - 48 + ti; const bool tv = tt >= 0 && tt < L;
    half8 q8, k8, v8[2], r8[2]; f32x4 sreg[4];
#pragma unroll
    for (int m = 0; m < 8; ++m) { q8[m] = (f16)0.f; k8[m] = (f16)0.f; v8[0][m] = (f16)0.f; v8[1][m] = (f16)0.f; r8[0][m] = (f16)0.f; r8[1][m] = (f16)0.f; }
    if (tv) { q8 = *(const half8*)(GQ + (size_t)tt * 256 + 64 * h + d0); k8 = *(const half8*)(GK + (size_t)tt * 256 + 64 * h + d0);
        r8[0] = *(const half8*)(GR + (size_t)tt * 512 + 128 * h + (tid & 7) * 16); r8[1] = *(const half8*)(GR + (size_t)tt * 512 + 128 * h + (tid & 7) * 16 + 8); }
#pragma unroll
    for (int q = 0; q < 2; ++q) { const int ch = tid + 512 * q, j = ch >> 4, t = 64 * c - 48 + j; if (t >= 0 && t < L) v8[q] = *(const half8*)(GV + (size_t)t * 512 + 128 * h + (ch & 15) * 8); }
#pragma unroll
    for (int q = 0; q < 4; ++q) sreg[q] = *(const f32x4*)(Sg + (size_t)(tid + 512 * q) * 4);
    gla_gates(P, c, h, bl);
#pragma unroll
    for (int m = 0; m < 8; ++m) { const float bv = bl[ti * 65 + d0 + m]; qs[ti * 65 + d0 + m] = (float)q8[m] * 0.125f * __expf(bv); kk[ti * 65 + d0 + m] = (float)k8[m] * __expf(-bv); }
#pragma unroll
    for (int q = 0; q < 2; ++q) { const int ch = tid + 512 * q, j = ch >> 4, e0 = (ch & 15) * 8; f32x4 o0, o1;
#pragma unroll
        for (int m = 0; m < 4; ++m) { o0[m] = (float)v8[q][m]; o1[m] = (float)v8[q][4 + m]; }
        *(LAS f32x4*)(vs + j * 128 + e0) = o0; *(LAS f32x4*)(vs + j * 128 + e0 + 4) = o1; }
#pragma unroll
    for (int q = 0; q < 4; ++q) *(LAS f32x4*)(Ss + (tid + 512 * q) * 4) = sreg[q];
    __syncthreads();
    if (wid < 4) { const int i0 = (wid >> 1) * 32, j0 = (wid & 1) * 32; f32x16 acc;
#pragma unroll
        for (int i = 0; i < 16; ++i) acc[i] = 0.f;
#pragma unroll 8
        for (int s = 0; s < 32; ++s) acc = __builtin_amdgcn_mfma_f32_32x32x2f32(qs[(i0 + l31) * 65 + 2 * s + hf], kk[(j0 + l31) * 65 + 2 * s + hf], acc, 0, 0, 0);
#pragma unroll
        for (int r = 0; r < 16; ++r) { const int i = i0 + (r & 3) + 8 * (r >> 2) + 4 * hf, j = j0 + l31; As[i * 65 + j] = (j <= i) ? acc[r] : 0.f; } }
    __syncthreads();
    { const int i0 = (wid >> 2) * 32, e0 = (wid & 3) * 32; f32x16 acc;
#pragma unroll
      for (int i = 0; i < 16; ++i) acc[i] = 0.f;
#pragma unroll 8
      for (int s = 0; s < 32; ++s) acc = __builtin_amdgcn_mfma_f32_32x32x2f32(qs[(i0 + l31) * 65 + 2 * s + hf], Ss[(2 * s + hf) * 128 + e0 + l31], acc, 0, 0, 0);
#pragma unroll 8
      for (int s = 0; s < 32; ++s) acc = __builtin_amdgcn_mfma_f32_32x32x2f32(As[(i0 + l31) * 65 + 2 * s + hf], vs[(2 * s + hf) * 128 + e0 + l31], acc, 0, 0, 0);
#pragma unroll
      for (int r = 0; r < 16; ++r) { const int i = i0 + (r & 3) + 8 * (r >> 2) + 4 * hf; os[i * 129 + e0 + l31] = acc[r]; } }
    __syncthreads();
    { const int e0 = (tid & 7) * 16; float o[16], sq = 0.f;
#pragma unroll
      for (int j = 0; j < 16; ++j) { o[j] = os[ti * 129 + e0 + j]; sq += o[j] * o[j]; }
      sq += __shfl_xor(sq, 1); sq += __shfl_xor(sq, 2); sq += __shfl_xor(sq, 4);
      const float rs = rsqrtf(sq * (1.0f / 128.0f) + EPS);
      if (tt >= NMETA && tt < L) { half8 w0, w1;
#pragma unroll
          for (int j = 0; j < 8; ++j) { w0[j] = (f16)(o[j] * rs * P.hn[e0 + j] * silu_f((float)r8[0][j])); w1[j] = (f16)(o[8 + j] * rs * P.hn[e0 + 8 + j] * silu_f((float)r8[1][j])); }
          f16* dst = mix + (size_t)(tt - NMETA) * D + 128 * h + e0; *(half8*)dst = w0; *(half8*)(dst + 8) = w1; } }
    __syncthreads();
}

__device__ __forceinline__ unsigned mono_u(float f) { const unsigned u = __float_as_uint(f); return (u & 0x80000000u) ? ~u : (u | 0x80000000u); }
__device__ __forceinline__ float unmono_f(unsigned m) { return __uint_as_float((m & 0x80000000u) ? (m & 0x7fffffffu) : ~m); }
__device__ __forceinline__ unsigned wave_umax(unsigned v) {
    v = max(v, (unsigned)__builtin_amdgcn_update_dpp(0, (int)v, 0x111, 0xf, 0xf, false));
    v = max(v, (unsigned)__builtin_amdgcn_update_dpp(0, (int)v, 0x112, 0xf, 0xf, false));
    v = max(v, (unsigned)__builtin_amdgcn_update_dpp(0, (int)v, 0x114, 0xf, 0xf, false));
    v = max(v, (unsigned)__builtin_amdgcn_update_dpp(0, (int)v, 0x118, 0xf, 0xf, false));
    v = max(v, (unsigned)__builtin_amdgcn_update_dpp(0, (int)v, 0x142, 0xa, 0xf, false));
    v = max(v, (unsigned)__builtin_amdgcn_update_dpp(0, (int)v, 0x143, 0xc, 0xf, false));
    return (unsigned)__builtin_amdgcn_readlane((int)v, 63);
}
constexpr int CAP = 640, NPL = CAP / 64;
__device__ __forceinline__ int topk_compact(LAS float* cs, LAS unsigned short* ci, int n, bool exact, float& tau_out, int lane) {
    float sv[NPL]; unsigned iv[NPL], u[NPL];
#pragma unroll
    for (int i = 0; i < NPL; ++i) { const int p = lane + 64 * i; const bool v = p < n; sv[i] = v ? cs[p] : 0.f; iv[i] = v ? (unsigned)ci[p] : 0xffffu; u[i] = v ? mono_u(sv[i]) : 0u; }
    unsigned T = 0u; bool full = true; int hb = 31;
    {
        unsigned umx = 0u, umn = 0xffffffffu;
#pragma unroll
        for (int i = 0; i < NPL; ++i) { umx = max(umx, u[i]); umn = min(umn, (lane + 64 * i < n) ? u[i] : 0xffffffffu); }
        umx = wave_umax(umx); umn = ~wave_umax(~umn);
        const unsigned df = umx ^ umn;
        if (df == 0u) { hb = -1; T = umx; } else { hb = 31 - __clz(df); T = (hb == 31) ? 0u : (umx & ~((2u << hb) - 1u)); }
    }
#pragma unroll 1
    for (int bit = hb; bit >= 0; --bit) {
        const unsigned cand = T | (1u << bit); int cgt = 0;
#pragma unroll
        for (int i = 0; i < NPL; ++i) cgt += __popcll(__ballot(u[i] >= cand));
        if (cgt >= 256) { T = cand; if (!exact && cgt <= 272) { full = false; break; } }
    }
    bool keep[NPL];
    if (full) {
        int cgt = 0;
#pragma unroll
        for (int i = 0; i < NPL; ++i) cgt += __popcll(__ballot(u[i] > T));
        const int need = 256 - cgt; unsigned I = 0xffffu; int nties = 0;
#pragma unroll
        for (int i = 0; i < NPL; ++i) nties += __popcll(__ballot(u[i] == T));
        if (nties != need) { I = 0u;
#pragma unroll 1
        for (int bit = 15; bit >= 0; --bit) { const unsigned cand = I | (1u << bit); int cl = 0;
#pragma unroll
            for (int i = 0; i < NPL; ++i) cl += __popcll(__ballot(u[i] == T && iv[i] < cand));
            if (cl < need) I = cand; } }
#pragma unroll
        for (int i = 0; i < NPL; ++i) keep[i] = (u[i] > T) || (u[i] == T && iv[i] <= I);
    } else {
#pragma unroll
        for (int i = 0; i < NPL; ++i) keep[i] = u[i] >= T;
    }
    int nn = 0;
#pragma unroll
    for (int i = 0; i < NPL; ++i) { const unsigned long long m = __ballot(keep[i]); const int pre = __builtin_amdgcn_mbcnt_hi((unsigned)(m >> 32), __builtin_amdgcn_mbcnt_lo((unsigned)m, 0u));
        if (keep[i]) { cs[nn + pre] = sv[i]; ci[nn + pre] = (unsigned short)iv[i]; } nn += __popcll(m); }
    tau_out = unmono_f(T);
    return nn;
}
__device__ __forceinline__ float relu_asm(float x) { return __int_as_float(max(__float_as_int(x), 0)); }
__device__ __forceinline__ void indexer_tile(const Params& P, int tile, LAS unsigned char* lds) {
    int tid_ = threadIdx.x; asm volatile("" : "+v"(tid_));
    const int tid = tid_, lane = tid & 63, wid = __builtin_amdgcn_readfirstlane(tid >> 6), l31 = lane & 31, hf = lane >> 5;
    LAS float* candS = (LAS float*)lds;
    LAS unsigned short* candI = (LAS unsigned short*)(lds + 32 * CAP * 4);
    LAS unsigned char* kbuf = lds + 32 * CAP * 6;
    LAS int* lcnt = (LAS int*)(lds + LDS_BYTES - 1024 + 64);
    LAS int* lflag = (LAS int*)(lds + LDS_BYTES - 1024 + 192);
    const f16* IQ = (const f16*)(P.ws + WS_IQ); const f16* IK = (const f16*)(P.ws + WS_IK); const float* IW = (const float*)(P.ws + WS_IW);
    unsigned short* SEL = (unsigned short*)(P.ws + WS_SEL);
    const int t0 = tile * 32, tw = t0 + wid * 4;
    half8 afr[4];
    { const int qi = 2 * (l31 >> 4) + ((l31 >> 2) & 1), hd = 4 * ((l31 >> 3) & 1) + (l31 & 3); int tq = tw + qi; if (tq > L - 1) tq = L - 1;
      const half8* ap = (const half8*)(IQ + (size_t)tq * 512 + hd * 64);
#pragma unroll
      for (int s = 0; s < 4; ++s) afr[s] = ap[2 * s + hf]; }
    float w0[8], w1[8];
    { int ta = tw + hf, tb = tw + 2 + hf; if (ta > L - 1) ta = L - 1; if (tb > L - 1) tb = L - 1;
#pragma unroll
      for (int h = 0; h < 8; ++h) { w0[h] = IW[(size_t)ta * 8 + h]; w1[h] = IW[(size_t)tb * 8 + h]; } }
    asm volatile("" :: "v"(afr[0]), "v"(afr[1]), "v"(afr[2]), "v"(afr[3]));
    asm volatile("" :: "v"(w0[0]), "v"(w0[1]), "v"(w0[2]), "v"(w0[3]), "v"(w0[4]), "v"(w0[5]), "v"(w0[6]), "v"(w0[7]));
    asm volatile("" :: "v"(w1[0]), "v"(w1[1]), "v"(w1[2]), "v"(w1[3]), "v"(w1[4]), "v"(w1[5]), "v"(w1[6]), "v"(w1[7]));
    const int tq0 = (tw + hf < L) ? tw + hf : -1, tq1 = (tw + 2 + hf < L) ? tw + 2 + hf : -1;
    float tau0 = -__builtin_inff(), tau1 = -__builtin_inff();
    int cntv = 0;
    if (lane < 4) lcnt[wid * 4 + lane] = 0;
    if (tid < 3) lflag[tid] = 0;
    const int nkeys = (t0 + 32 < L) ? t0 + 32 : L, nst = (nkeys + 127) >> 7;
    u32x4 stg[2];
    const u32x4* IKv = (const u32x4*)IK;
#pragma unroll
    for (int i = 0; i < 2; ++i) stg[i] = IKv[(size_t)0 * 1024 + tid + 512 * i];
#pragma unroll
    for (int i = 0; i < 2; ++i) { const int ci = tid + 512 * i, row = ci >> 3, ch = ci & 7; *(LAS u32x4*)(kbuf + row * 128 + ((ch ^ ((row >> 1) & 7)) << 4)) = stg[i]; }
    __syncthreads();
#pragma unroll 1
    for (int st = 0; st < nst; ++st) {
        LAS unsigned char* kb = kbuf + (st & 1) * 16384;
        if (st + 1 < nst) {
#pragma unroll
            for (int i = 0; i < 2; ++i) stg[i] = IKv[(size_t)(st + 1) * 1024 + tid + 512 * i];
        }
#pragma unroll 1
        for (int sub = 0; sub < 4; sub += 2) {
            const int kbase = st * 128 + sub * 32;
            if (kbase > tw + 3) break;
            const int rowa = sub * 32 + l31, rowb = rowa + 32;
            f32x16 acca, accb;
#pragma unroll
            for (int i = 0; i < 16; ++i) { acca[i] = 0.f; accb[i] = 0.f; }
            half8 bfa[4], bfb[4];
#pragma unroll
            for (int s = 0; s < 4; ++s) { bfa[s] = *(const LAS half8*)(kb + rowa * 128 + (((2 * s + hf) ^ ((rowa >> 1) & 7)) << 4)); bfb[s] = *(const LAS half8*)(kb + rowb * 128 + (((2 * s + hf) ^ ((rowb >> 1) & 7)) << 4)); }
#pragma unroll
            for (int s = 0; s < 4; ++s) { acca = __builtin_amdgcn_mfma_f32_32x32x16_f16(afr[s], bfa[s], acca, 0, 0, 0); accb = __builtin_amdgcn_mfma_f32_32x32x16_f16(afr[s], bfb[s], accb, 0, 0, 0); }
#pragma unroll
            for (int part = 0; part < 2; ++part) {
                const int key = kbase + part * 32 + l31;
                float s0 = 0.f, s1 = 0.f;
#pragma unroll
                for (int h = 0; h < 8; ++h) { s0 = __builtin_fmaf(w0[h], relu_asm(part ? accb[h] : acca[h]), s0); s1 = __builtin_fmaf(w1[h], relu_asm(part ? accb[8 + h] : acca[8 + h]), s1); }
                if (key <= tq0 && s0 > tau0) { const int qs = wid * 4 + hf; const int pos = (int)__hip_atomic_fetch_add(lcnt + qs, 1, __ATOMIC_RELAXED, __HIP_MEMORY_SCOPE_WORKGROUP); candS[qs * CAP + pos] = s0; candI[qs * CAP + pos] = (unsigned short)key; }
                if (key <= tq1 && s1 > tau1) { const int qs = wid * 4 + 2 + hf; const int pos = (int)__hip_atomic_fetch_add(lcnt + qs, 1, __ATOMIC_RELAXED, __HIP_MEMORY_SCOPE_WORKGROUP); candS[qs * CAP + pos] = s1; candI[qs * CAP + pos] = (unsigned short)key; }
            }
        }
        if (st + 1 < nst) {
            LAS unsigned char* kn = kbuf + ((st + 1) & 1) * 16384;
#pragma unroll
            for (int i = 0; i < 2; ++i) { const int ci = tid + 512 * i, row = ci >> 3, ch = ci & 7; *(LAS u32x4*)(kn + row * 128 + ((ch ^ ((row >> 1) & 7)) << 4)) = stg[i]; }
        }
        cntv = lcnt[wid * 4 + (lane & 3)];
        const int mx = max(max(__builtin_amdgcn_readlane(cntv, 0), __builtin_amdgcn_readlane(cntv, 1)), max(__builtin_amdgcn_readlane(cntv, 2), __builtin_amdgcn_readlane(cntv, 3)));
        if (mx > CAP - 128 && lane == 0) lflag[st % 3] = 1;
        if (tid == 0) lflag[(st + 1) % 3] = 0;
        __syncthreads();
        const int any = lflag[st % 3];
        if (any) {
#pragma unroll 1
            for (int qq = 0; qq < 4; ++qq) { const int n = __builtin_amdgcn_readlane(cntv, qq);
                if (n > 288) { float nt; const int nn = topk_compact(candS + (wid * 4 + qq) * CAP, candI + (wid * 4 + qq) * CAP, n, false, nt, lane);
                    if (lane == 0) lcnt[wid * 4 + qq] = nn;
                    if (hf == (qq & 1)) { if (qq < 2) tau0 = nt; else tau1 = nt; } } }
        }
    }
#pragma unroll 1
    for (int qq = 0; qq < 4; ++qq) {
        const int t = tw + qq; if (t >= L) break;
        int n = lcnt[wid * 4 + qq]; LAS float* cs = candS + (wid * 4 + qq) * CAP; LAS unsigned short* ci = candI + (wid * 4 + qq) * CAP;
        if (n > 256) { float nt; n = topk_compact(cs, ci, n, true, nt, lane); }
#pragma unroll
        for (int j = 0; j < 4; ++j) { const int p = lane + 64 * j; SEL[(size_t)t * 256 + p] = p < n ? ci[p] : (unsigned short)0xffffu; }
    }
    __syncthreads();
}

#ifdef SCORE_ONLY_EXP
__device__ __forceinline__ void indexer_score_only(const Params& P, int tile, LAS unsigned char* lds) {
    int tid_ = threadIdx.x; asm volatile("" : "+v"(tid_));
    const int tid = tid_, lane = tid & 63, wid = __builtin_amdgcn_readfirstlane(tid >> 6), l31 = lane & 31, hf = lane >> 5;
    LAS float* candS = (LAS float*)lds;
    LAS unsigned short* candI = (LAS unsigned short*)(lds + 32 * CAP * 4);
    LAS unsigned char* kbuf = lds + 32 * CAP * 6;
    const f16* IQ = (const f16*)(P.ws + WS_IQ); const f16* IK = (const f16*)(P.ws + WS_IK); const float* IW = (const float*)(P.ws + WS_IW);
    unsigned short* SEL = (unsigned short*)(P.ws + WS_SEL);
    const int t0 = tile * 32, tw = t0 + wid * 4;
    half8 afr[4];
    { const int qi = 2 * (l31 >> 4) + ((l31 >> 2) & 1), hd = 4 * ((l31 >> 3) & 1) + (l31 & 3); int tq = tw + qi; if (tq > L - 1) tq = L - 1;
      const half8* ap = (const half8*)(IQ + (size_t)tq * 512 + hd * 64);
#pragma unroll
      for (int s = 0; s < 4; ++s) afr[s] = ap[2 * s + hf]; }
    float w0[8], w1[8];
    { int ta = tw + hf, tb = tw + 2 + hf; if (ta > L - 1) ta = L - 1; if (tb > L - 1) tb = L - 1;
#pragma unroll
      for (int h = 0; h < 8; ++h) { w0[h] = IW[(size_t)ta * 8 + h]; w1[h] = IW[(size_t)tb * 8 + h]; } }
    asm volatile("" :: "v"(afr[0]), "v"(afr[1]), "v"(afr[2]), "v"(afr[3]));
    asm volatile("" :: "v"(w0[0]), "v"(w0[1]), "v"(w0[2]), "v"(w0[3]), "v"(w0[4]), "v"(w0[5]), "v"(w0[6]), "v"(w0[7]));
    asm volatile("" :: "v"(w1[0]), "v"(w1[1]), "v"(w1[2]), "v"(w1[3]), "v"(w1[4]), "v"(w1[5]), "v"(w1[6]), "v"(w1[7]));
    const int tq0 = (tw + hf < L) ? tw + hf : -1, tq1 = (tw + 2 + hf < L) ? tw + 2 + hf : -1;
    float tau0 = -__builtin_inff(), tau1 = -__builtin_inff();
    int cntv = 0; float sink = 0.f;
    const int nkeys = (t0 + 32 < L) ? t0 + 32 : L, nst = (nkeys + 127) >> 7;
    u32x4 stg[2];
    const u32x4* IKv = (const u32x4*)IK;
#pragma unroll
    for (int i = 0; i < 2; ++i) stg[i] = IKv[(size_t)0 * 1024 + tid + 512 * i];
#pragma unroll
    for (int i = 0; i < 2; ++i) { const int ci = tid + 512 * i, row = ci >> 3, ch = ci & 7; *(LAS u32x4*)(kbuf + row * 128 + ((ch ^ ((row >> 1) & 7)) << 4)) = stg[i]; }
    __syncthreads();
#pragma unroll 1
    for (int st = 0; st < nst; ++st) {
        LAS unsigned char* kb = kbuf + (st & 1) * 16384;
        if (st + 1 < nst) {
#pragma unroll
            for (int i = 0; i < 2; ++i) stg[i] = IKv[(size_t)(st + 1) * 1024 + tid + 512 * i];
        }
#pragma unroll 1
        for (int sub = 0; sub < 4; ++sub) {
            const int kbase = st * 128 + sub * 32;
            if (kbase > tw + 3) break;
            const int row = sub * 32 + l31;
            f32x16 acc;
#pragma unroll
            for (int i = 0; i < 16; ++i) acc[i] = 0.f;
#pragma unroll
            for (int s = 0; s < 4; ++s) { const half8 bfr = *(const LAS half8*)(kb + row * 128 + (((2 * s + hf) ^ ((row >> 1) & 7)) << 4)); acc = __builtin_amdgcn_mfma_f32_32x32x16_f16(afr[s], bfr, acc, 0, 0, 0); }
            float s0 = 0.f, s1 = 0.f;
#pragma unroll
            for (int h = 0; h < 8; ++h) { s0 = __builtin_fmaf(w0[h], relu_asm(acc[h]), s0); s1 = __builtin_fmaf(w1[h], relu_asm(acc[8 + h]), s1); }
            const int key = kbase + l31;
            sink += (key <= tq0 && s0 > tau0) ? s0 : 0.f; sink += (key <= tq1 && s1 > tau1) ? s1 : 0.f;
        }
        if (st + 1 < nst) {
            LAS unsigned char* kn = kbuf + ((st + 1) & 1) * 16384;
#pragma unroll
            for (int i = 0; i < 2; ++i) { const int ci = tid + 512 * i, row = ci >> 3, ch = ci & 7; *(LAS u32x4*)(kn + row * 128 + ((ch ^ ((row >> 1) & 7)) << 4)) = stg[i]; }
        }
        __syncthreads();
    }
    if (sink == 12345.678f) ((float*)(P.ws + WS_CTL))[200 + (tid & 31)] = sink + (float)cntv;
    __syncthreads();
}

#endif
__device__ __forceinline__ void sparse_attn(const Params& P, LAS unsigned char* lds, int vbid) {
    int tid_ = threadIdx.x; asm volatile("" : "+v"(tid_));
    const int tid = tid_, lane = tid & 63, wid = tid >> 6, grp = lane >> 2, c4 = lane & 3;
    const int head = vbid & 7, slot = (vbid >> 3) * 8 + wid, nslot = (gridDim.x >> 3) * 8;
    LAS unsigned short* widx = (LAS unsigned short*)(lds + wid * 512);
    LAS float* red = (LAS float*)(lds + 4096 + wid * 4352);
    const unsigned short* SEL = (const unsigned short*)(P.ws + WS_SEL); const f16* DQ = (const f16*)(P.ws + WS_DQ);
    const unsigned char* kvh = P.ws + WS_KV + (size_t)head * LP * 128; f16* mix = (f16*)(P.ws + WS_ACTA);
    int t = NMETA + slot;
    u32x2 selr = {0u, 0u}; half8 qa, qb;
#pragma unroll
    for (int e = 0; e < 8; ++e) { qa[e] = (f16)0.f; qb[e] = (f16)0.f; }
    if (t < L) { selr = *(const u32x2*)(SEL + (size_t)t * 256 + lane * 4); qa = *(const half8*)(DQ + (size_t)t * 512 + head * 64 + c4 * 16); qb = *(const half8*)(DQ + (size_t)t * 512 + head * 64 + c4 * 16 + 8); }
#pragma unroll 1
    for (; t < L; t += nslot) {
        *(LAS u32x2*)(widx + lane * 4) = selr;
        unsigned keys[16]; u32x4 kreg[16], vreg[16];
#pragma unroll
        for (int it = 0; it < 16; ++it) keys[it] = widx[16 * it + grp];
#pragma unroll
        for (int it = 0; it < 16; ++it) { const unsigned kk = keys[it] != 0xffffu ? keys[it] : 0u; kreg[it] = *(const u32x4*)(kvh + (size_t)kk * 128 + c4 * 16); }
#pragma unroll
        for (int it = 0; it < 16; ++it) { const unsigned kk = keys[it] != 0xffffu ? keys[it] : 0u; vreg[it] = *(const u32x4*)(kvh + (size_t)kk * 128 + 64 + c4 * 16); }
        f32x2 q2[8];
#pragma unroll
        for (int e = 0; e < 4; ++e) { q2[e] = (f32x2){(float)qa[2 * e], (float)qa[2 * e + 1]} * (1.0f / KV_SCALE); q2[4 + e] = (f32x2){(float)qb[2 * e], (float)qb[2 * e + 1]} * (1.0f / KV_SCALE); }
        { const int tn = t + nslot;
          if (tn < L) { selr = *(const u32x2*)(SEL + (size_t)tn * 256 + lane * 4); qa = *(const half8*)(DQ + (size_t)tn * 512 + head * 64 + c4 * 16); qb = *(const half8*)(DQ + (size_t)tn * 512 + head * 64 + c4 * 16 + 8); } }
        float lg[16]; float mx = -__builtin_inff();
#pragma unroll
        for (int it = 0; it < 16; ++it) {
            f32x2 a2 = {0.f, 0.f};
#pragma unroll
            for (int w = 0; w < 4; ++w) { a2 += q2[2 * w] * __builtin_amdgcn_cvt_pk_f32_fp8((int)kreg[it][w], false); a2 += q2[2 * w + 1] * __builtin_amdgcn_cvt_pk_f32_fp8((int)kreg[it][w], true); }
            float part = a2[0] + a2[1];
            part += __shfl_xor(part, 1); part += __shfl_xor(part, 2);
            lg[it] = keys[it] != 0xffffu ? part : -__builtin_inff(); mx = fmaxf(mx, lg[it]);
        }
        mx = fmaxf(mx, __shfl_xor(mx, 4)); mx = fmaxf(mx, __shfl_xor(mx, 8)); mx = fmaxf(mx, __shfl_xor(mx, 16)); mx = fmaxf(mx, __shfl_xor(mx, 32));
        f32x2 o2[8]; float lsum = 0.f;
#pragma unroll
        for (int e = 0; e < 8; ++e) o2[e] = (f32x2){0.f, 0.f};
#pragma unroll
        for (int it = 0; it < 16; ++it) {
            const float p = __expf(lg[it] - mx); lsum += p; const f32x2 p2 = {p, p};
#pragma unroll
            for (int w = 0; w < 4; ++w) { o2[2 * w] += p2 * __builtin_amdgcn_cvt_pk_f32_fp8((int)vreg[it][w], false); o2[2 * w + 1] += p2 * __builtin_amdgcn_cvt_pk_f32_fp8((int)vreg[it][w], true); }
        }
        lsum += __shfl_xor(lsum, 4); lsum += __shfl_xor(lsum, 8); lsum += __shfl_xor(lsum, 16); lsum += __shfl_xor(lsum, 32);
#pragma unroll
        for (int e = 0; e < 8; ++e) { red[lane * 17 + 2 * e] = o2[e][0]; red[lane * 17 + 2 * e + 1] = o2[e][1]; }
        float acc = 0.f;
        { const int cc = lane >> 4, e = lane & 15;
#pragma unroll
          for (int g = 0; g < 16; ++g) acc += red[(g * 4 + cc) * 17 + e]; }
        mix[(size_t)(t - NMETA) * D + 512 + head * 64 + lane] = (f16)(acc * (1.0f / KV_SCALE) / lsum);
    }
    __syncthreads();
}

__device__ __forceinline__ void final_norm(const Params& P) {
    const int tid = threadIdx.x, lane = tid & 63, gw = blockIdx.x * 8 + (tid >> 6), nw = gridDim.x * 8;
    const float* ss3 = (const float*)(P.ws + WS_SS3);
    for (int r = gw; r < SEQ; r += nw) { const float rs = row_rstd(ss3, 16, r);
#pragma unroll
        for (int i = 0; i < 4; ++i) { const int k = lane * 4 + 256 * i; const f32x4 v = *(const f32x4*)(P.out + (size_t)r * D + k), g = *(const f32x4*)(P.nf + k); *(f32x4*)(P.out + (size_t)r * D + k) = v * rs * g; } }
}

#define XB_TMO      128
#define XB_XCNT(j)  (256  + 64 * (j))
#define XB_XSUB(j)  (1280 + 64 * (j))
#define XB_XGEN(j)  (2304 + 64 * (j))
#define XB_TOP      3328
#define XB_TOPGEN   3392
#define XCD_BAR_WORDS 3456
#define XB_SPIN_CAP (1u << 22)
__device__ __forceinline__ unsigned xb_ld(unsigned* p)              { return __hip_atomic_load(p, __ATOMIC_RELAXED, __HIP_MEMORY_SCOPE_AGENT); }
__device__ __forceinline__ unsigned xb_add(unsigned* p, unsigned v) { return __hip_atomic_fetch_add(p, v, __ATOMIC_RELAXED, __HIP_MEMORY_SCOPE_AGENT); }
__device__ __forceinline__ unsigned xb_xcc_id() { return (unsigned)__builtin_amdgcn_s_getreg((3 << 11) | 20) & 0xFu; }
#define XB_SPIN(cond, bar) do { unsigned _sp = 0; while (cond) { __builtin_amdgcn_s_sleep(1); \
    if ((++_sp & 255u) == 0u) { if (xb_ld(&(bar)[XB_TMO])) break; if (_sp > XB_SPIN_CAP) { atomicAdd(&(bar)[XB_TMO], 1u); break; } } } } while (0)
struct XcdBarrier { unsigned* bar; unsigned x; volatile LAS unsigned* st; };
__device__ __forceinline__ XcdBarrier xcd_barrier_post(unsigned* bar, volatile LAS unsigned* st) {
    XcdBarrier b; b.bar = bar; b.x = xb_xcc_id(); b.st = st;
    if (threadIdx.x == 0) (void)xb_add(&bar[XB_XCNT(b.x)], 1u);
    return b;
}
__device__ __forceinline__ void xcd_barrier_complete(unsigned* bar, unsigned x, unsigned& nloc, unsigned& nx) {
    const unsigned G = gridDim.x * gridDim.y * gridDim.z;
    unsigned sum, cnt, mine, sp = 0u;
    for (;;) {
        sum = 0u; cnt = 0u; mine = 0u;
#pragma unroll
        for (unsigned j = 0; j < 16; ++j) { const unsigned c = xb_ld(&bar[XB_XCNT(j)]); sum += c; cnt += (c > 0u) ? 1u : 0u; mine = (j == x) ? c : mine; }
        if (sum == G) break;
        __builtin_amdgcn_s_sleep(1);
        if ((++sp & 255u) == 0u) { if (xb_ld(&bar[XB_TMO])) break; if (sp > XB_SPIN_CAP) { atomicAdd(&bar[XB_TMO], 1u); break; } }
    }
    nloc = mine > 0u ? mine : 1u; nx = cnt > 0u ? cnt : 1u;
}
__device__ __forceinline__ void xcd_barrier(const XcdBarrier& b) {
    asm volatile("s_waitcnt vmcnt(0)" ::: "memory");
    __syncthreads();
    if (threadIdx.x == 0) {
        unsigned* bar = b.bar;
        __builtin_amdgcn_s_waitcnt(0);
        unsigned nloc = b.st[0], nx = b.st[1];
        if (nloc == 0u) { xcd_barrier_complete(bar, b.x, nloc, nx); b.st[0] = nloc; b.st[1] = nx; }
        const unsigned old = xb_add(&bar[XB_XSUB(b.x)], 1u);
        const unsigned gen = old / nloc;
        if (old + 1u == (gen + 1u) * nloc) {
            __builtin_amdgcn_fence(__ATOMIC_RELEASE, "agent");
            asm volatile("s_waitcnt vmcnt(0)" ::: "memory");
            const unsigned og = xb_add(&bar[XB_TOP], 1u);
            const unsigned tg = og / nx;
            if (og + 1u == (tg + 1u) * nx) xb_add(&bar[XB_TOPGEN], 1u);
            else XB_SPIN(xb_ld(&bar[XB_TOPGEN]) == tg, bar);
            __builtin_amdgcn_fence(__ATOMIC_ACQUIRE, "agent");
            xb_add(&bar[XB_XGEN(b.x)], 1u);
            asm volatile("s_waitcnt vmcnt(0)" ::: "memory");
        } else {
            XB_SPIN(xb_ld(&bar[XB_XGEN(b.x)]) == gen, bar);
            __builtin_amdgcn_fence(__ATOMIC_ACQUIRE, "agent");
            asm volatile("s_waitcnt vmcnt(0)" ::: "memory");
        }
    }
    __syncthreads();
}

__global__ void __launch_bounds__(NTHREADS, 2) fwd_kernel(Params P) {
    __shared__ __attribute__((aligned(16))) unsigned char lds_raw[LDS_BYTES];
    LAS unsigned char* lds = (LAS unsigned char*)lds_raw;
    const int tid = threadIdx.x, bid = blockIdx.x, G = gridDim.x;
    unsigned char* ws = P.ws;
    const int lo = P.ph_lo, hi = P.ph_hi;
#ifndef ONLY_PHASE
#define ONLY_PHASE -1
#endif
#define IN(k) ((ONLY_PHASE < 0 || ONLY_PHASE == (k)) && lo <= (k) && (k) < hi)
#ifdef PROBE
#define STAMP(k) do { if (bid == 0 && tid == 0) ((unsigned long long*)(ws + WS_CTL + 1024))[(k)] = __builtin_amdgcn_s_memrealtime(); } while (0)
#else
#define STAMP(k) do { } while (0)
#endif
#define SEAM(k) do { if (IN(k) && IN((k) + 1)) { xcd_barrier(xbar); } STAMP((k) + 1); } while (0)
    XcdBarrier xbar; xbar.bar = (unsigned*)(ws + WS_BAR); xbar.x = 0; xbar.st = (volatile LAS unsigned*)(lds + LDS_BYTES - 1024 + 16);
    if (hi - lo > 1) {
        if (tid == 0) { xbar.st[0] = 0u; xbar.st[1] = 0u; }
        __syncthreads();
        xbar = xcd_barrier_post((unsigned*)(ws + WS_BAR), (volatile LAS unsigned*)(lds + LDS_BYTES - 1024 + 16));
    }
    LAS int* misc = (LAS int*)(lds + LDS_BYTES - 1024);
    if (hi - lo > 1) {
        if (tid == 0) { const unsigned xcc = xb_xcc_id() & 7u; misc[8] = (int)xcc; misc[9] = (int)xb_add((unsigned*)(ws + WS_CTL) + 32 + 32 * xcc, 1u); }
    }
    int vbid = bid;
    f16* acta = (f16*)(ws + WS_ACTA); f16* Gb = (f16*)(ws + WS_G);
    float* ss0 = (float*)(ws + WS_SS0); float* ss1 = (float*)(ws + WS_SS1); float* ss2 = (float*)(ws + WS_SS2); float* ss3 = (float*)(ws + WS_SS3);
    STAMP(0);
    _Pragma("unroll 1") for (int rep = 0; rep < NREP(0); ++rep)
    if (IN(0)) { p0_prologue(P, lds); }
    SEAM(0);
    if (hi - lo > 1 && (G & 7) == 0) {
        if (tid == 0) { bool ok = true; for (int j = 0; j < 8; ++j) ok = ok && (xb_ld((unsigned*)(ws + WS_CTL) + 32 + 32 * j) == (unsigned)(G >> 3)); misc[10] = ok ? misc[9] * 8 + misc[8] : bid; }
        __syncthreads();
        vbid = __builtin_amdgcn_readfirstlane(misc[10]);
        __syncthreads();
    }
    _Pragma("unroll 1") for (int rep = 0; rep < NREP(1); ++rep)
    if (IN(1)) {
        pg8::Gemm g{acta, (const f16*)(ws + WS_WGU1), MP, 2 * DFF, D}; pg8::StaticOrder S; S.init(MP, 2 * DFF, G, vbid);
        EpiSwiglu E{Gb, ss0, 1}; pg8::gemm_phase(lds, g, S, E);
    }
    SEAM(1);
    _Pragma("unroll 1") for (int rep = 0; rep < NREP(2); ++rep)
    if (IN(2)) {
        meta_down(P, lds);
        pg8::Gemm g{Gb, (const f16*)(ws + WS_WD1), SEQ, D, DFF}; pg8::StaticOrder S; S.init(SEQ, D, G, vbid);
        EpiResid E{P.x, P.out, acta, ss1, 0.5f}; pg8::gemm_phase(lds, g, S, E);
    }
    SEAM(2);
    _Pragma("unroll 1") for (int rep = 0; rep < NREP(3); ++rep)
    if (IN(3)) {
        pg8::Gemm g{acta, (const f16*)(ws + WS_WIN), MP, NIN, D}; pg8::StaticOrder S; S.init(MP, NIN, G, vbid);
        EpiInProj E{ss1, (const f32x2*)(ws + WS_ROPE), ws};
        pg8::gemm_phase(lds, g, S, E);
    }
    SEAM(3);
    _Pragma("unroll 1") for (int rep = 0; rep < NREP(4); ++rep)
    if (IN(4)) {
        for (int u = bid; u < NCH * 4; u += G) gla_a_unit(P, u, lds);
        if (rep == 0) {
            int tbase = 0, cursor = bid; LAS f16* tl = (LAS f16*)lds;
            prep_weight(P, 3, D, D, (f16*)(ws + WS_WOUT), cursor, tbase, tl);
            prep_weight(P, 4, 2 * DFF, D, (f16*)(ws + WS_WGU2), cursor, tbase, tl);
            prep_weight(P, 5, D, DFF, (f16*)(ws + WS_WD2), cursor, tbase, tl);
        }
    }
    SEAM(4);
    _Pragma("unroll 1") for (int rep = 0; rep < NREP(5); ++rep)
    if (IN(5)) {
        if (bid < 64 && rep == 0) gla_scan(P);
        unsigned* ctr = (unsigned*)(ws + WS_CTL) + rep; LAS int* bc = (LAS int*)(lds + LDS_BYTES - 1024);
        for (;;) {
            if (tid == 0) bc[0] = (int)atomicAdd(ctr, 1u);
            __syncthreads();
            const int k = bc[0];
            __syncthreads();
            if (k >= 513) break;
            indexer_tile(P, 512 - k, lds);
        }
#ifdef SCORE_ONLY_EXP
        { unsigned* ctr2 = (unsigned*)(ws + WS_CTL) + 8;
          for (;;) {
            if (tid == 0) bc[0] = (int)atomicAdd(ctr2, 1u);
            __syncthreads();
            const int k = bc[0];
            __syncthreads();
            if (k >= 513) break;
            indexer_score_only(P, 512 - k, lds);
          } }
#endif
    }
    SEAM(5);
    _Pragma("unroll 1") for (int rep = 0; rep < NREP(6); ++rep)
    if (IN(6)) { if (REPEAT_PH != 6 || rep == 0 || true) for (int u = bid; u < NCH * 4; u += G) gla_c_unit(P, u, lds); sparse_attn(P, lds, vbid); }
    for (int e = 0; e < EXTRA_SYNCS; ++e) cg::this_grid().sync();
    SEAM(6);
    _Pragma("unroll 1") for (int rep = 0; rep < NREP(7); ++rep)
    if (IN(7)) {
        pg8::Gemm g{acta, (const f16*)(ws + WS_WOUT), SEQ, D, D}; pg8::StaticOrder S; S.init(SEQ, D, G, vbid);
        EpiResid E{P.out, P.out, (f16*)(ws + WS_US), ss2, rep == 0 ? 1.0f : 0.0f}; pg8::gemm_phase(lds, g, S, E);
    }
    SEAM(7);
    _Pragma("unroll 1") for (int rep = 0; rep < NREP(8); ++rep)
    if (IN(8)) {
        pg8::Gemm g{(const f16*)(ws + WS_US), (const f16*)(ws + WS_WGU2), SEQ, 2 * DFF, D}; pg8::StaticOrder S; S.init(SEQ, 2 * DFF, G, vbid);
        EpiSwiglu E{Gb, ss2, 16}; pg8::gemm_phase(lds, g, S, E);
    }
    SEAM(8);
    _Pragma("unroll 1") for (int rep = 0; rep < NREP(9); ++rep)
    if (IN(9)) {
        pg8::Gemm g{Gb, (const f16*)(ws + WS_WD2), SEQ, D, DFF}; pg8::StaticOrder S; S.init(SEQ, D, G, vbid);
        EpiResid E{P.out, P.out, nullptr, ss3, rep == 0 ? 0.5f : 0.0f}; pg8::gemm_phase(lds, g, S, E);
    }
    SEAM(9);
    if (IN(10)) final_norm(P);
#ifdef PROBE
    {
        STAMP(11);
        cg::this_grid().sync();
        const unsigned long long* tsv = (const unsigned long long*)(ws + WS_CTL + 1024);
        float tph[12]; float tg = 0.f;
#pragma unroll
        for (int k = 0; k < 11; ++k) { tph[k] = (float)(tsv[k + 1] - tsv[k]) * 0.01f; }
        tph[11] = (float)(tsv[11] - tsv[0]) * 0.01f;
        const float gsum = tph[1] + tph[2] + tph[3] + tph[7] + tph[8] + tph[9];
        const float va = (PROBE_A == 12) ? gsum : tph[PROBE_A < 12 ? PROBE_A : 0], vb = (PROBE_B == 12) ? gsum : tph[PROBE_B < 12 ? PROBE_B : 0];
        const size_t n = (size_t)SEQ * D;
        for (size_t i = (size_t)bid * NTHREADS + tid; i < n; i += (size_t)G * NTHREADS) P.out[i] = (i == 0) ? va : vb * 0.01f;
        (void)tg;
    }
#endif
#ifdef DBG_CUT
    if (IN(11)) {
        const size_t n = (size_t)SEQ * D; const size_t i0 = (size_t)bid * NTHREADS + tid, st = (size_t)G * NTHREADS;
#if DBG_CUT == 6
        const f16* m = (const f16*)(ws + WS_ACTA); for (size_t i = i0; i < n; i += st) P.out[i] = (float)m[i];
#elif DBG_CUT == 5
        const unsigned short* m = (const unsigned short*)(ws + WS_SEL); for (size_t i = i0; i < n; i += st) P.out[i] = (float)m[i % ((size_t)L * 256)];
#elif DBG_CUT == 3
        const f16* a = (const f16*)(ws + WS_DQ); const f16* b = (const f16*)(ws + WS_IQ); const f16* c = (const f16*)(ws + WS_KV); const f16* d = (const f16*)(ws + WS_GQ);
        for (size_t i = i0; i < n; i += st) P.out[i] = (float)a[i % ((size_t)L * 512)] + (float)b[i % ((size_t)L * 512)] + (float)c[i] + (float)d[i % ((size_t)L * 1536)];
#elif DBG_CUT == 4
        const float* m = (const float*)(ws + WS_US); for (size_t i = i0; i < n; i += st) P.out[i] = m[i % ((size_t)NCH * 32768)];
#endif
    }
#endif
#undef IN
#undef SEAM
}

extern "C" void kernel_launch(void* const* d_in, const int* in_sizes, int n_in, void* d_out, int out_size, void* d_ws, size_t ws_size, hipStream_t stream) {
    static int grid = 0;
    if (grid == 0) {
        if (n_in != 17 || in_sizes[0] != SEQ * D || out_size != SEQ * D || ws_size < WS_END) { fprintf(stderr, "kernel_launch: unexpected shapes (n_in %d, in0 %d, out %d, ws %zu, need %zu)\n", n_in, n_in > 0 ? in_sizes[0] : -1, out_size, ws_size, (size_t)WS_END); grid = -1; return; }
        int dev = 0, cus = 0, per_cu = 0;
        (void)hipGetDevice(&dev); (void)hipDeviceGetAttribute(&cus, hipDeviceAttributeMultiprocessorCount, dev);
        if (hipOccupancyMaxActiveBlocksPerMultiprocessor(&per_cu, (const void*)fwd_kernel, NTHREADS, 0) != hipSuccess || per_cu < 1) { fprintf(stderr, "kernel_launch: occupancy query says %d blocks per CU\n", per_cu); per_cu = 1; }
        (void)hipGetLastError();
        grid = cus;
        if (grid % 8 != 0 || grid < 64) { fprintf(stderr, "kernel_launch: unexpected CU count %d\n", cus); }
    }
    if (grid < 0) return;
    if (hipMemsetAsync((char*)d_ws + WS_CTL, 0, CTL_BYTES, stream) != hipSuccess) { fprintf(stderr, "kernel_launch: memset failed\n"); return; }
    Params p{};
    const float** pp = (const float**)&p;
    for (int i = 0; i < 17; ++i) pp[i] = (const float*)d_in[i];
    p.out = (float*)d_out; p.ws = (unsigned char*)d_ws;
#if MODE == 0
#ifdef DBG_CUT
    for (int ph = 0; ph <= DBG_CUT; ++ph) { p.ph_lo = ph; p.ph_hi = ph + 1; hipLaunchKernelGGL(fwd_kernel, dim3(grid), dim3(NTHREADS), 0, stream, p); }
    if (DBG_CUT != 2 && DBG_CUT != 7 && DBG_CUT != 9) { p.ph_lo = 11; p.ph_hi = 12; hipLaunchKernelGGL(fwd_kernel, dim3(grid), dim3(NTHREADS), 0, stream, p); }
#else
    for (int ph = 0; ph < NPHASE; ++ph) { p.ph_lo = ph; p.ph_hi = ph + 1; hipLaunchKernelGGL(fwd_kernel, dim3(grid), dim3(NTHREADS), 0, stream, p); }
#endif
#else
    p.ph_lo = 0; p.ph_hi = NPHASE;
    void* args[] = {&p};
    hipError_t e = hipLaunchCooperativeKernel((const void*)fwd_kernel, dim3(grid), dim3(NTHREADS), args, 0, stream);
    if (e != hipSuccess) fprintf(stderr, "cooperative launch failed: %s (grid %d)\n", hipGetErrorString(e), grid);
#endif
}
```

```cpp
#include <hip/hip_runtime.h>
#include <hip/hip_cooperative_groups.h>
#include <cstdio>
#include <cstdint>
namespace cg = cooperative_groups;

#ifndef MODE
#define MODE 1

#ifndef REPEAT_PH
#define REPEAT_PH -1
#endif
#define NREP(k) ((REPEAT_PH == (k) || REPEAT_PH == 99) ? 2 : 1)
#ifndef EXTRA_SYNCS
#define EXTRA_SYNCS 0
#endif
#endif

#define LAS __attribute__((address_space(3)))
typedef _Float16 f16;
typedef _Float16 half8 __attribute__((ext_vector_type(8)));
typedef _Float16 half4 __attribute__((ext_vector_type(4)));
typedef float f32x2 __attribute__((ext_vector_type(2)));
typedef float f32x4 __attribute__((ext_vector_type(4)));
typedef float f32x16 __attribute__((ext_vector_type(16)));
typedef unsigned u32x2 __attribute__((ext_vector_type(2)));
typedef unsigned u32x4 __attribute__((ext_vector_type(4)));

constexpr int D = 1024, SEQ = 16384, NMETA = 16, L = SEQ + NMETA, DFF = 2816;
constexpr int MP = 16640;
constexpr int LP = 16512;
constexpr int NIN = 3840;
constexpr int NCH = 257;
constexpr float EPS = 1e-6f;
constexpr int NTHREADS = 512;
constexpr int LDS_BYTES = 155648 + 1024;
constexpr int NPHASE = 11;

constexpr size_t al256(size_t x) { return (x + 255) & ~(size_t)255; }
constexpr size_t WS_CTL = 0;
constexpr size_t CTL_BYTES = 32768;
constexpr size_t WS_BAR = 2048;
constexpr size_t WS_WGU1 = CTL_BYTES;
constexpr size_t WS_WD1 = WS_WGU1 + (size_t)2 * DFF * D * 2;
constexpr size_t WS_WIN = WS_WD1 + (size_t)D * DFF * 2;
constexpr size_t WS_WOUT = WS_WIN + (size_t)NIN * D * 2;
constexpr size_t WS_WGU2 = WS_WOUT + (size_t)D * D * 2;
constexpr size_t WS_WD2 = WS_WGU2 + (size_t)2 * DFF * D * 2;
constexpr size_t WS_ACTA = WS_WD2 + (size_t)D * DFF * 2;
constexpr size_t WS_G = WS_ACTA + (size_t)MP * D * 2;
constexpr size_t WS_US = WS_G + (size_t)MP * DFF * 2;
constexpr size_t WS_DQ = WS_US + (size_t)NCH * 4 * 64 * 128 * 4;
constexpr size_t WS_IQ = WS_DQ + (size_t)LP * 512 * 2;
constexpr size_t WS_SEL = WS_IQ + (size_t)LP * 512 * 2;
constexpr size_t WS_ROPE = WS_SEL + (size_t)LP * 256 * 2;
constexpr size_t WS_IW = WS_ROPE + al256((size_t)L * 32 * 8);
constexpr size_t WS_GA = WS_IW + (size_t)LP * 8 * 4;
constexpr size_t WS_DECAY = WS_GA + (size_t)LP * 16 * 4;
constexpr size_t WS_SS0 = WS_DECAY + al256((size_t)NCH * 256 * 4);
constexpr size_t WS_SS1 = WS_SS0 + (size_t)MP * 4;
constexpr size_t WS_SS2 = WS_SS1 + (size_t)MP * 64;
constexpr size_t WS_SS3 = WS_SS2 + (size_t)MP * 64;
constexpr size_t WS_END = WS_SS3 + (size_t)MP * 64;
constexpr size_t WS_KV = WS_G;
constexpr size_t WS_GQ = WS_KV + (size_t)8 * LP * 128 * 2;
constexpr size_t WS_GK = WS_GQ + (size_t)LP * 256 * 2;
constexpr size_t WS_GV = WS_GK + (size_t)LP * 256 * 2;
constexpr size_t WS_GR = WS_GV + (size_t)LP * 512 * 2;
constexpr size_t WS_IK = WS_GR + (size_t)LP * 512 * 2;
constexpr size_t WS_ALIAS_END = WS_IK + (size_t)LP * 64 * 2;
static_assert(WS_ALIAS_END <= WS_US, "aliased buffers exceed G");
static_assert(WS_END <= (size_t)256 * 1024 * 1024, "workspace exceeds 256 MiB");
static_assert((size_t)SEQ * D * 2 <= (size_t)NCH * 4 * 64 * 128 * 4, "h2_16 alias");

struct Params {
    const float* x; const float* meta; const float* n1; const float* wg1; const float* wu1; const float* wd1;
    const float* nmix; const float* win; const float* wa2; const float* ba; const float* hn; const float* wout;
    const float* n2; const float* wg2; const float* wu2; const float* wd2; const float* nf;
    float* out; unsigned char* ws; int ph_lo, ph_hi;
};

namespace pg8 {
constexpr int BM = 256, BK = 64, HALF = 128, HTB = HALF * BK * 2, STAGE_BYTES = 8 * HTB, NXCD = 8, WGM = 8;
__host__ __device__ __forceinline__ int lds_byte(int r, int c) { const int st = (r >> 4) * 2 + (c >> 5), rr = r & 15, cc = c & 31, ob = rr * 64 + cc * 2; return st * 1024 + (ob ^ (((ob >> 9) & 1) << 5)); }
__host__ __device__ __forceinline__ int perm32(int rho) { const int n = rho >> 4, i = rho & 15; return 8 * (i >> 2) + 4 * n + (i & 3); }
__host__ __device__ __forceinline__ void stage_rc(int b, int& R, int& C) { const int st = b / 1024, sb = b % 1024, swz = sb ^ (((sb >> 9) & 1) << 5); R = (st >> 1) * 16 + swz / 64; C = (st & 1) * 32 + (swz % 64) / 2; }
struct Unit { int pm, pn; };
struct Gemm { const f16* A; const f16* Bt; int M, N, K; };
struct StaticOrder {
    int nM, nN, nwg, G, c;
    __host__ __device__ void init(int M, int N, int G_, int c_) { nM = M / BM; nN = N / BM; nwg = nM * nN; G = G_; c = c_; }
    __host__ __device__ bool next(int i, Unit& u) const {
        const long Lx = (long)i * G + c; if (Lx >= nwg) return false;
        int wgid = (int)Lx; { const int q = nwg / NXCD, r = nwg % NXCD, xcd = wgid % NXCD, off = wgid / NXCD; wgid = (xcd < r ? xcd * (q + 1) : r * (q + 1) + (xcd - r) * q) + off; }
        const int nig = WGM * nN, gid = wgid / nig, fm = gid * WGM, gsz = (nM - fm) < WGM ? (nM - fm) : WGM;
        u.pm = fm + ((wgid % nig) % gsz); u.pn = (wgid % nig) / gsz; return true;
    }
};
template <class Epi>
__device__ __forceinline__ void gemm_phase(LAS unsigned char* lds, const Gemm g, const StaticOrder& S, const Epi& E) {
    int tid_ = threadIdx.x; asm volatile("" : "+v"(tid_));
    const int tid = tid_, wid = __builtin_amdgcn_readfirstlane(tid >> 6), lane = tid & 63, wr = wid >> 2, wc = wid & 3, fr = lane & 15, fq = lane >> 4;
    const int K = g.K, nt = K / BK;
    unsigned voffA[2], voffB[2];
#pragma unroll
    for (int i = 0; i < 2; ++i) { int R, C; stage_rc(tid * 16 + i * 8192, R, C); const int Rb = (R & ~31) + perm32(R & 31); voffA[i] = (unsigned)(R * K + C) * 2u; voffB[i] = (unsigned)(Rb * K + C) * 2u; }
    const size_t kstep = (size_t)(BK * 2);
    const size_t hstep = (size_t)HALF * K * 2;
    const size_t tstep = 2 * hstep;
    const unsigned ldsw = (unsigned)wid * 1024u;
    const int aoff = lds_byte(wr * 64 + fr, fq * 8), boff = lds_byte(wc * 32 + fr, fq * 8);
#define PG8_SA(b, h) (((b) * 2 + (h)) * HTB)
#define PG8_SB(b, h) ((4 + (b) * 2 + (h)) * HTB)
#define PG8_STAGE(bufoff, gbase, voff) do { _Pragma("unroll") for (int _i = 0; _i < 2; ++_i) \
        __builtin_amdgcn_global_load_lds((const unsigned*)((const char*)(gbase) + (voff)[_i]), (LAS unsigned*)(lds + (bufoff) + ldsw + _i * 8192), 16, 0, 0); } while (0)
#define PG8_LDA(dst, b, h) do { _Pragma("unroll") for (int m = 0; m < 4; ++m) _Pragma("unroll") for (int k = 0; k < 2; ++k) dst[m][k] = *(const LAS half8*)(lds + PG8_SA(b, h) + aoff + m * 2048 + k * 1024); } while (0)
#define PG8_LDB(dst, b, h) do { _Pragma("unroll") for (int n = 0; n < 2; ++n) _Pragma("unroll") for (int k = 0; k < 2; ++k) dst[n][k] = *(const LAS half8*)(lds + PG8_SB(b, h) + boff + n * 2048 + k * 1024); } while (0)
#define PG8_MMA(ai, bj, At, Bt) do { __builtin_amdgcn_s_setprio(1); _Pragma("unroll") for (int m = 0; m < 4; ++m) _Pragma("unroll") for (int n = 0; n < 2; ++n) _Pragma("unroll") for (int k = 0; k < 2; ++k) \
        acc[ai][bj][m][n] = __builtin_amdgcn_mfma_f32_16x16x32_f16(Bt[n][k], At[m][k], acc[ai][bj][m][n], 0, 0, 0); __builtin_amdgcn_s_setprio(0); } while (0)
#define PG8_WAIT_V(n) asm volatile("s_waitcnt vmcnt(" #n ")" ::: "memory")
#define PG8_WAIT_L(n) asm volatile("s_waitcnt lgkmcnt(" #n ")" ::: "memory")
#define PG8_BAR __builtin_amdgcn_s_barrier()
#define PG8_SCHED __builtin_amdgcn_sched_barrier(0)
    Unit cur, nxt; int ui = 0;
    if (!S.next(0, cur)) return;
    f32x4 acc[2][2][4][2];
#pragma unroll
    for (int a = 0; a < 2; ++a)
#pragma unroll
        for (int b = 0; b < 2; ++b)
#pragma unroll
            for (int m = 0; m < 4; ++m)
#pragma unroll
                for (int n = 0; n < 2; ++n) acc[a][b][m][n] = (f32x4){0.f, 0.f, 0.f, 0.f};
    half8 At[4][2], B0[2][2], B1[2][2];
    const char* cA = (const char*)g.A + (size_t)cur.pm * tstep; const char* cB = (const char*)g.Bt + (size_t)cur.pn * tstep;
    PG8_STAGE(PG8_SB(0, 0), cB, voffB); PG8_STAGE(PG8_SA(0, 0), cA, voffA); PG8_STAGE(PG8_SB(0, 1), cB + hstep, voffB); PG8_STAGE(PG8_SA(0, 1), cA + hstep, voffA);
    if (wr == 1) PG8_BAR;
    PG8_WAIT_V(4); PG8_BAR;
    PG8_STAGE(PG8_SB(1, 0), cB + kstep, voffB); PG8_STAGE(PG8_SA(1, 0), cA + kstep, voffA); PG8_STAGE(PG8_SB(1, 1), cB + hstep + kstep, voffB);
    PG8_WAIT_V(6); PG8_BAR;
    for (;;) {
        const bool has_next = S.next(ui + 1, nxt);
        const char* nA = has_next ? (const char*)g.A + (size_t)nxt.pm * tstep : cA; const char* nB = has_next ? (const char*)g.Bt + (size_t)nxt.pn * tstep : cB;
        for (int t = 0; t < nt; t += 2) {
            const bool last = (t == nt - 2);
            const char* a1 = cA + (size_t)(t + 1) * kstep;
            const char* a2 = last ? nA : cA + (size_t)(t + 2) * kstep; const char* b2 = last ? nB : cB + (size_t)(t + 2) * kstep;
            const char* a3 = a2 + kstep; const char* b3 = b2 + kstep;
            PG8_LDB(B0, 0, 0); PG8_SCHED; PG8_LDA(At, 0, 0); PG8_STAGE(PG8_SA(1, 1), a1 + hstep, voffA);
            PG8_WAIT_L(8); PG8_BAR; PG8_WAIT_L(0); PG8_MMA(0, 0, At, B0); PG8_BAR; PG8_SCHED;
            PG8_LDB(B1, 0, 1); PG8_STAGE(PG8_SB(0, 0), b2, voffB);
            PG8_BAR; PG8_WAIT_L(0); PG8_MMA(0, 1, At, B1); PG8_BAR;
            PG8_LDA(At, 0, 1); PG8_STAGE(PG8_SA(0, 0), a2, voffA);
            PG8_BAR; PG8_WAIT_L(0); PG8_MMA(1, 0, At, B0); PG8_BAR; PG8_SCHED;
            PG8_STAGE(PG8_SB(0, 1), b2 + hstep, voffB);
            PG8_WAIT_V(6); PG8_BAR; PG8_MMA(1, 1, At, B1); PG8_BAR;
            PG8_LDB(B0, 1, 0); PG8_SCHED; PG8_LDA(At, 1, 0); PG8_STAGE(PG8_SA(0, 1), a2 + hstep, voffA);
            PG8_WAIT_L(8); PG8_BAR; PG8_WAIT_L(0); PG8_MMA(0, 0, At, B0); PG8_BAR; PG8_SCHED;
            PG8_LDB(B1, 1, 1); PG8_STAGE(PG8_SB(1, 0), b3, voffB);
            PG8_BAR; PG8_WAIT_L(0); PG8_MMA(0, 1, At, B1); PG8_BAR;
            PG8_LDA(At, 1, 1); PG8_STAGE(PG8_SA(1, 0), a3, voffA);
            PG8_BAR; PG8_WAIT_L(0); PG8_MMA(1, 0, At, B0); PG8_BAR; PG8_SCHED;
            PG8_STAGE(PG8_SB(1, 1), b3 + hstep, voffB);
            PG8_WAIT_V(6); PG8_BAR; PG8_MMA(1, 1, At, B1); PG8_BAR;
        }
        E(acc, cur, wr, wc, fr, fq);
        if (!has_next) break;
#pragma unroll
        for (int a = 0; a < 2; ++a)
#pragma unroll
            for (int b = 0; b < 2; ++b)
#pragma unroll
                for (int m = 0; m < 4; ++m)
#pragma unroll
                    for (int n = 0; n < 2; ++n) acc[a][b][m][n] = (f32x4){0.f, 0.f, 0.f, 0.f};
        cur = nxt; cA = nA; cB = nB; ++ui;
    }
    PG8_WAIT_V(0);
    if (wr == 0) PG8_BAR;
    PG8_BAR;
#undef PG8_SA
#undef PG8_SB
#undef PG8_STAGE
#undef PG8_LDA
#undef PG8_LDB
#undef PG8_MMA
#undef PG8_WAIT_V
#undef PG8_WAIT_L
#undef PG8_BAR
#undef PG8_SCHED
}
}

__device__ __forceinline__ float silu_f(float v) { return v * __builtin_amdgcn_rcpf(1.0f + __expf(-v)); }
__device__ __forceinline__ half4 to_half4(f32x4 v) { half4 h; h[0] = (f16)v[0]; h[1] = (f16)v[1]; h[2] = (f16)v[2]; h[3] = (f16)v[3]; return h; }

__device__ __forceinline__ float row_rstd(const float* ss, int np, int row) {
    float s;
    if (np == 1) s = ss[row];
    else { const f32x4* p = (const f32x4*)(ss + (size_t)row * 16); const f32x4 a = p[0], b = p[1], c = p[2], d = p[3];
        s = (((a[0] + a[1]) + (a[2] + a[3])) + ((b[0] + b[1]) + (b[2] + b[3]))) + (((c[0] + c[1]) + (c[2] + c[3])) + ((d[0] + d[1]) + (d[2] + d[3]))); }
    return rsqrtf(s * (1.0f / D) + EPS);
}
struct EpiSwiglu {
    f16* G; const float* ss; int np;
    __device__ __forceinline__ void operator()(const f32x4 (&acc)[2][2][4][2], const pg8::Unit& u, int wr, int wc, int fr_, int fq_) const {
        int fr = fr_, fq = fq_; asm volatile("" : "+v"(fr), "+v"(fq));
#pragma unroll
        for (int ai = 0; ai < 2; ++ai)
#pragma unroll
            for (int m = 0; m < 4; ++m) {
                const int row = u.pm * 256 + ai * 128 + wr * 64 + m * 16 + fr;
                const float rs = row_rstd(ss, np, row), ce = -1.4426950408889634f * rs, rs2 = rs * rs; half8 o;
#pragma unroll
                for (int n = 0; n < 2; ++n) {
                    const f32x4 g = acc[ai][0][m][n], u = acc[ai][1][m][n]; const f32x4 t = g * ce; f32x4 e, r;
#pragma unroll
                    for (int j = 0; j < 4; ++j) e[j] = __builtin_amdgcn_exp2f(t[j]);
                    const f32x4 d = e + 1.0f;
#pragma unroll
                    for (int j = 0; j < 4; ++j) r[j] = __builtin_amdgcn_rcpf(d[j]);
                    const f32x4 w = (g * u) * (r * rs2);
#pragma unroll
                    for (int j = 0; j < 4; ++j) o[4 * n + j] = (f16)w[j];
                }
                *(half8*)(G + (size_t)row * DFF + u.pn * 128 + wc * 32 + 8 * fq) = o;
            }
    }
};
struct EpiResid {
    const float* src; float* out; f16* h16; float* ss; float alpha;
    __device__ __forceinline__ void operator()(const f32x4 (&acc)[2][2][4][2], const pg8::Unit& u, int wr, int wc, int fr_, int fq_) const {
        int fr = fr_, fq = fq_; asm volatile("" : "+v"(fr), "+v"(fq));
#pragma unroll
        for (int ai = 0; ai < 2; ++ai)
#pragma unroll
            for (int m = 0; m < 4; ++m) {
                const int row = u.pm * 256 + ai * 128 + wr * 64 + m * 16 + fr; float part = 0.f;
#pragma unroll
                for (int bj = 0; bj < 2; ++bj) {
                    const size_t off = (size_t)row * D + u.pn * 256 + bj * 128 + wc * 32 + 8 * fq; half8 h;
#pragma unroll
                    for (int n = 0; n < 2; ++n) {
                        const f32x4 sv = *(const f32x4*)(src + off + 4 * n); const f32x4 o = sv + alpha * acc[ai][bj][m][n];
                        *(f32x4*)(out + off + 4 * n) = o;
#pragma unroll
                        for (int j = 0; j < 4; ++j) h[4 * n + j] = (f16)o[j];
                        part += (o[0] * o[0] + o[1] * o[1]) + (o[2] * o[2] + o[3] * o[3]);
                    }
                    if (h16) *(half8*)(h16 + off) = h;
                }
                part += __shfl_xor(part, 16); part += __shfl_xor(part, 32);
                if (fq == 0) ss[(size_t)row * 16 + u.pn * 4 + wc] = part;
            }
    }
};
constexpr float KV_SCALE = 16.0f;
constexpr float K_I8_SCALE = 127.0f / 8.0f;
__device__ __forceinline__ unsigned pack_fp8x4(f32x4 v) {
#pragma unroll
    for (int j = 0; j < 4; ++j) v[j] = fminf(fmaxf(v[j], -448.f), 448.f);
    int w = __builtin_amdgcn_cvt_pk_fp8_f32(v[0], v[1], 0, false); w = __builtin_amdgcn_cvt_pk_fp8_f32(v[2], v[3], w, true); return (unsigned)w;
}
__device__ __forceinline__ void rope8(const f32x4 (&x1)[2], const f32x4 (&x2)[2], const f32x2* rp, float sc, float (&o1)[8], float (&o2)[8]) {
#pragma unroll
    for (int n = 0; n < 2; ++n) {
        const f32x4 cs0 = *(const f32x4*)(rp + 4 * n), cs1 = *(const f32x4*)(rp + 4 * n + 2);
        o1[4 * n + 0] = (x1[n][0] * cs0[0] - x2[n][0] * cs0[1]) * sc; o2[4 * n + 0] = (x2[n][0] * cs0[0] + x1[n][0] * cs0[1]) * sc;
        o1[4 * n + 1] = (x1[n][1] * cs0[2] - x2[n][1] * cs0[3]) * sc; o2[4 * n + 1] = (x2[n][1] * cs0[2] + x1[n][1] * cs0[3]) * sc;
        o1[4 * n + 2] = (x1[n][2] * cs1[0] - x2[n][2] * cs1[1]) * sc; o2[4 * n + 2] = (x2[n][2] * cs1[0] + x1[n][2] * cs1[1]) * sc;
        o1[4 * n + 3] = (x1[n][3] * cs1[2] - x2[n][3] * cs1[3]) * sc; o2[4 * n + 3] = (x2[n][3] * cs1[2] + x1[n][3] * cs1[3]) * sc;
    }
}
__device__ __forceinline__ u32x2 pack_i8x8(const float (&v)[8]) {
    u32x2 r;
#pragma unroll
    for (int w = 0; w < 2; ++w) { unsigned word = 0u;
#pragma unroll
        for (int j = 0; j < 4; ++j) { const int q = (int)__builtin_rintf(fminf(fmaxf(v[4 * w + j] * K_I8_SCALE, -127.f), 127.f)); word |= ((unsigned)q & 0xffu) << (8 * j); }
        r[w] = word; }
    return r;
}
__device__ __forceinline__ u32x2 pack_bf8x8(const float (&v)[8]) {
    u32x2 r;
#pragma unroll
    for (int w = 0; w < 2; ++w) { int word = __builtin_amdgcn_cvt_pk_bf8_f32(v[4 * w], v[4 * w + 1], 0, false); word = __builtin_amdgcn_cvt_pk_bf8_f32(v[4 * w + 2], v[4 * w + 3], word, true); r[w] = (unsigned)word; }
    return r;
}
__device__ __forceinline__ u32x2 pack_fp8x8(const float (&v)[8]) { u32x2 r; r[0] = pack_fp8x4((f32x4){v[0], v[1], v[2], v[3]}); r[1] = pack_fp8x4((f32x4){v[4], v[5], v[6], v[7]}); return r; }
struct EpiInProj {
    const float* ss; const f32x2* rope; unsigned char* ws;
    __device__ __forceinline__ void operator()(const f32x4 (&acc)[2][2][4][2], const pg8::Unit& u, int wr, int wc, int fr_, int fq_) const {
        int fr = fr_, fq = fq_; asm volatile("" : "+v"(fr), "+v"(fq));
        const int pn = u.pn;
        if (pn >= 8 && pn <= 11) {
            unsigned char* lb = (pn <= 9) ? ws + WS_KV + (size_t)((pn - 8) * 4 + wc) * LP * 128 + 8 * fq
                                          : ws + WS_KV + (size_t)((pn - 10) * 4 + (wc >> 1)) * LP * 128 + 64 + (wc & 1) * 32 + 8 * fq;
#pragma unroll
            for (int ai = 0; ai < 2; ++ai)
#pragma unroll
                for (int m = 0; m < 4; ++m) {
                    const int p = u.pm * 256 + ai * 128 + wr * 64 + m * 16 + fr;
                    const int t = p < SEQ ? p + NMETA : p - SEQ;
                    if (p < L) {
                        const float sc = row_rstd(ss, 16, p);
                        if (pn <= 9) {
                            float o1[8], o2[8]; rope8(acc[ai][0][m], acc[ai][1][m], rope + (size_t)t * 32 + 8 * fq, sc, o1, o2);
                            unsigned char* d8 = lb + (size_t)t * 128; *(u32x2*)d8 = pack_i8x8(o1); *(u32x2*)(d8 + 32) = pack_i8x8(o2);
                        } else {
#pragma unroll
                            for (int bj = 0; bj < 2; ++bj) { float v[8];
#pragma unroll
                                for (int j = 0; j < 4; ++j) { v[j] = acc[ai][bj][m][0][j] * sc; v[4 + j] = acc[ai][bj][m][1][j] * sc; }
                                *(u32x2*)(lb + (size_t)t * 128 + (size_t)bj * 2 * LP * 128) = pack_bf8x8(v); }
                        }
                    }
                    asm volatile("" ::: "memory");
                }
            return;
        }
        int mode = 0, stride = 256; float scale = 1.0f; f16* lanebase;
        if (pn == 0) lanebase = (f16*)(ws + WS_GQ) + wc * 32 + 8 * fq;
        else if (pn == 1) lanebase = (f16*)(ws + WS_GK) + wc * 32 + 8 * fq;
        else if (pn <= 3) { lanebase = (f16*)(ws + WS_GV) + (pn - 2) * 256 + wc * 32 + 8 * fq; stride = 512; }
        else if (pn <= 5) { lanebase = (f16*)(ws + WS_GR) + (pn - 4) * 256 + wc * 32 + 8 * fq; stride = 512; }
        else if (pn <= 7) { lanebase = (f16*)(ws + WS_DQ) + (pn - 6) * 256 + wc * 64 + 8 * fq; stride = 512; mode = 1; scale = 0.125f; }
        else if (pn <= 13) { lanebase = (f16*)(ws + WS_IQ) + (pn - 12) * 256 + wc * 64 + 8 * fq; stride = 512; mode = 1; scale = 0.125f; }
        else { lanebase = (f16*)(ws + WS_IK) + 8 * fq; stride = 64; mode = wc == 0 ? 1 : (wc == 1 ? 2 : 3); }
#pragma unroll
        for (int ai = 0; ai < 2; ++ai)
#pragma unroll
            for (int m = 0; m < 4; ++m) {
                const int p = u.pm * 256 + ai * 128 + wr * 64 + m * 16 + fr;
                const int t = p < SEQ ? p + NMETA : p - SEQ;
                if (p < L && mode != 3) {
                    const float rs = row_rstd(ss, 16, p);
                    if (mode == 1) {
                        float o1[8], o2[8]; rope8(acc[ai][0][m], acc[ai][1][m], rope + (size_t)t * 32 + 8 * fq, rs * scale, o1, o2);
                        half8 h1, h2;
#pragma unroll
                        for (int j = 0; j < 8; ++j) { h1[j] = (f16)o1[j]; h2[j] = (f16)o2[j]; }
                        f16* dst = lanebase + (size_t)t * stride; *(half8*)dst = h1; *(half8*)(dst + 32) = h2;
                    } else if (mode == 2) {
                        if (fq < 2) { float* gp = (float*)(ws + WS_GA) + (size_t)t * 16 + 8 * fq; *(f32x4*)gp = acc[ai][0][m][0] * rs; *(f32x4*)(gp + 4) = acc[ai][0][m][1] * rs; }
                        else if (fq == 2) { float* ip = (float*)(ws + WS_IW) + (size_t)t * 8; const float r2 = rs * 0.35355339059327373f; *(f32x4*)ip = acc[ai][0][m][0] * r2; *(f32x4*)(ip + 4) = acc[ai][0][m][1] * r2; }
                    } else {
#pragma unroll
                        for (int bj = 0; bj < 2; ++bj) { half8 h;
#pragma unroll
                            for (int j = 0; j < 4; ++j) { h[j] = (f16)(acc[ai][bj][m][0][j] * rs); h[4 + j] = (f16)(acc[ai][bj][m][1][j] * rs); }
                            *(half8*)(lanebase + (size_t)t * stride + bj * 128) = h; }
                    }
                }
                asm volatile("" ::: "memory");
            }
    }
};

__device__ __forceinline__ const float* w_src(const Params& P, int kind, int n, int& ld, const float*& gain) {
    switch (kind) {
    case 0: case 4: { const int pn = n >> 8, bj = (n >> 7) & 1, cc = n & 127; ld = DFF; gain = kind == 0 ? P.n1 : P.n2;
        const float* w = kind == 0 ? (bj ? P.wu1 : P.wg1) : (bj ? P.wu2 : P.wg2); return w + pn * 128 + cc; }
    case 1: ld = D; gain = nullptr; return P.wd1 + n;
    case 5: ld = D; gain = nullptr; return P.wd2 + n;
    case 3: ld = D; gain = nullptr; return P.wout + n;
    default: { ld = 3672; gain = P.nmix; const int pn = n >> 8, c = n & 255, bj = c >> 7, hh = (c >> 5) & 3, dd = c & 31; int j;
        if (pn == 0) j = c; else if (pn == 1) j = 256 + c; else if (pn <= 3) j = 512 + (pn - 2) * 256 + c; else if (pn <= 5) j = 1024 + (pn - 4) * 256 + c;
        else if (pn <= 7) j = 1552 + (pn - 6) * 256 + hh * 64 + bj * 32 + dd;
        else if (pn <= 9) j = 2064 + (pn - 8) * 256 + hh * 64 + bj * 32 + dd;
        else if (pn <= 11) j = 2576 + (pn - 10) * 256 + c;
        else if (pn <= 13) j = 3088 + (pn - 12) * 256 + hh * 64 + bj * 32 + dd;
        else { if (c < 32) j = 3600 + c; else if (c < 48) j = 1536 + (c - 32); else if (c < 56) j = 3664 + (c - 48); else if (c >= 128 && c < 160) j = 3600 + 32 + (c - 128); else j = -1; }
        return j < 0 ? nullptr : P.win + j; }
    }
}
__device__ __forceinline__ void prep_weight(const Params& P, const int kind, const int N, const int K, f16* dst, int& cursor, int& tbase, LAS f16* tl) {
    const int tid = threadIdx.x, G = gridDim.x, tn = N / 64, tk = K / 256, ntile = tn * tk;
#pragma unroll 1
    for (; cursor < tbase + ntile; cursor += G) {
        const int tI = cursor - tbase, n0 = (tI % tn) * 64, k0 = (tI / tn) * 256;
        { const int n = tid & 63, kk0 = tid >> 6; int ld; const float* gain; const float* col = w_src(P, kind, n0 + n, ld, gain);
          float v[32];
#pragma unroll
          for (int i = 0; i < 32; ++i) v[i] = col ? col[(size_t)(k0 + kk0 + 8 * i) * ld] : 0.f;
          if (gain) {
#pragma unroll
              for (int i = 0; i < 32; ++i) v[i] *= gain[k0 + kk0 + 8 * i];
          }
#pragma unroll
          for (int i = 0; i < 32; ++i) tl[n * 264 + kk0 + 8 * i] = (f16)v[i]; }
        __syncthreads();
        { const int n = tid >> 3, seg = tid & 7;
#pragma unroll
          for (int j = 0; j < 4; ++j) *(half8*)(dst + (size_t)(n0 + n) * K + k0 + (seg + 8 * j) * 8) = *(const LAS half8*)(tl + n * 264 + (seg + 8 * j) * 8); }
        __syncthreads();
    }
    tbase += ntile;
}
__device__ __forceinline__ void p0_prologue(const Params& P, LAS unsigned char* lds) {
    const int tid = threadIdx.x, bid = blockIdx.x, G = gridDim.x, lane = tid & 63;
    unsigned char* ws = P.ws;
    int tbase = 0, cursor = bid;
    LAS f16* tl = (LAS f16*)lds;
    prep_weight(P, 0, 2 * DFF, D, (f16*)(ws + WS_WGU1), cursor, tbase, tl);
    prep_weight(P, 1, D, DFF, (f16*)(ws + WS_WD1), cursor, tbase, tl);
    prep_weight(P, 2, NIN, D, (f16*)(ws + WS_WIN), cursor, tbase, tl);
    float* ss0 = (float*)(ws + WS_SS0);
    f16* acta = (f16*)(ws + WS_ACTA);
    const int gw = bid * 8 + (tid >> 6), nw = G * 8;
    for (int p = gw; p < L; p += nw) {
        const float* src = p < SEQ ? P.x + (size_t)p * D : P.meta + (size_t)(p - SEQ) * D; float s = 0.f;
#pragma unroll
        for (int i = 0; i < 4; ++i) { const f32x4 v = *(const f32x4*)(src + lane * 4 + 256 * i); s += (v[0] * v[0] + v[1] * v[1]) + (v[2] * v[2] + v[3] * v[3]); *(half4*)(acta + (size_t)p * D + lane * 4 + 256 * i) = to_half4(v); }
#pragma unroll
        for (int o = 32; o >= 1; o >>= 1) s += __shfl_xor(s, o);
        if (lane == 0) ss0[p] = s;
    }
    const int gt = bid * NTHREADS + tid, ngt = G * NTHREADS;
    for (int i = gt; i < MP; i += ngt) { if (i >= L) ss0[i] = (float)D; }
    f32x2* rope = (f32x2*)(ws + WS_ROPE);
    for (int i = gt; i < L * 32; i += ngt) { const int t = i >> 5, f = i & 31; const double inv = exp(-(double)f * (9.210340371976184 / 32.0)); double sn, cs; sincos((double)t * inv, &sn, &cs); rope[i] = (f32x2){(float)cs, (float)sn}; }
}

__device__ __forceinline__ void meta_down(const Params& P, LAS unsigned char* lds) {
    const int tid = threadIdx.x, lane = tid & 63, wid = tid >> 6;
    const f16* Gm = (const f16*)(P.ws + WS_G) + (size_t)SEQ * DFF; const f16* Wt = (const f16*)(P.ws + WS_WD1);
    f16* acta = (f16*)(P.ws + WS_ACTA); float* ss1 = (float*)(P.ws + WS_SS1); LAS float* slot = (LAS float*)lds;
    for (int task = blockIdx.x; task < NMETA * 16; task += gridDim.x) {
        const int r = task >> 4, cg = task & 15; float part = 0.f;
#pragma unroll 1
        for (int q = 0; q < 2; ++q) {
            const int n0 = cg * 64 + (2 * wid + q) * 4; float a[4] = {0.f, 0.f, 0.f, 0.f};
            for (int kc = lane; kc < DFF / 8; kc += 64) {
                const half8 gv = *(const half8*)(Gm + (size_t)r * DFF + kc * 8);
#pragma unroll
                for (int j = 0; j < 4; ++j) { const half8 wv = *(const half8*)(Wt + (size_t)(n0 + j) * DFF + kc * 8);
#pragma unroll
                    for (int e = 0; e < 8; ++e) a[j] += (float)gv[e] * (float)wv[e]; }
            }
#pragma unroll
            for (int o = 32; o >= 1; o >>= 1) { a[0] += __shfl_xor(a[0], o); a[1] += __shfl_xor(a[1], o); a[2] += __shfl_xor(a[2], o); a[3] += __shfl_xor(a[3], o); }
            f32x4 o;
#pragma unroll
            for (int j = 0; j < 4; ++j) { o[j] = P.meta[r * D + n0 + j] + 0.5f * a[j]; part += o[j] * o[j]; }
            if (lane == 0) *(half4*)(acta + (size_t)(SEQ + r) * D + n0) = to_half4(o);
        }
        if (lane == 0) slot[wid] = part;
        __syncthreads();
        if (tid == 0) { float s = 0.f; for (int w = 0; w < 8; ++w) s += slot[w]; ss1[(size_t)(SEQ + r) * 16 + cg] = s; }
        __syncthreads();
    }
}

__device__ __forceinline__ float logsigmoid_f(float z) { return fminf(z, 0.f) - __logf(1.0f + __expf(-fabsf(z))); }
__device__ __forceinline__ void gla_gates(const Params& P, int c, int h, LAS float* bl) {
    const int tid = threadIdx.x, ti = tid >> 3, d0 = (tid & 7) * 8, tt = 64 * c - 48 + ti; const float* GA = (const float*)(P.ws + WS_GA);
    {
        float z[8];
        if (tt >= 0 && tt < L) {
            const f32x4 b0 = *(const f32x4*)(P.ba + 64 * h + d0), b1 = *(const f32x4*)(P.ba + 64 * h + d0 + 4);
#pragma unroll
            for (int m = 0; m < 4; ++m) { z[m] = b0[m]; z[4 + m] = b1[m]; }
            f32x4 a4[4];
#pragma unroll
            for (int q = 0; q < 4; ++q) a4[q] = *(const f32x4*)(GA + (size_t)tt * 16 + 4 * q);
#pragma unroll
            for (int r = 0; r < 16; ++r) { const float ar = a4[r >> 2][r & 3]; const f32x4 w0 = *(const f32x4*)(P.wa2 + r * 256 + 64 * h + d0), w1 = *(const f32x4*)(P.wa2 + r * 256 + 64 * h + d0 + 4);
#pragma unroll
                for (int m = 0; m < 4; ++m) { z[m] += ar * w0[m]; z[4 + m] += ar * w1[m]; } }
#pragma unroll
            for (int m = 0; m < 8; ++m) z[m] = logsigmoid_f(z[m]) * (1.0f / 16.0f);
        } else {
#pragma unroll
            for (int m = 0; m < 8; ++m) z[m] = 0.f;
        }
#pragma unroll
        for (int m = 0; m < 8; ++m) bl[ti * 65 + d0 + m] = z[m];
    }
    __syncthreads();
    {
        const int d = tid & 63, seg = tid >> 6; float v[8], run = 0.f;
#pragma unroll
        for (int i = 0; i < 8; ++i) { run += bl[(seg * 8 + i) * 65 + d]; v[i] = run; }
#pragma unroll
        for (int i = 0; i < 8; ++i) bl[(seg * 8 + i) * 65 + d] = v[i];
        __syncthreads();
        float off = 0.f;
#pragma unroll
        for (int sg = 0; sg < 7; ++sg) off += (sg < seg) ? bl[(sg * 8 + 7) * 65 + d] : 0.f;
        __syncthreads();
#pragma unroll
        for (int i = 0; i < 8; ++i) bl[(seg * 8 + i) * 65 + d] = v[i] + off;
    }
    __syncthreads();
}
__device__ __forceinline__ void gla_a_unit(const Params& P, int unit, LAS unsigned char* lds) {
    int tid_ = threadIdx.x; asm volatile("" : "+v"(tid_));
    const int tid = tid_, lane = tid & 63, wid = tid >> 6, c = unit >> 2, h = unit & 3;
    LAS float* bl = (LAS float*)lds; LAS float* ks = bl + 4160; LAS float* vs = ks + 4096;
    const f16* GK = (const f16*)(P.ws + WS_GK); const f16* GV = (const f16*)(P.ws + WS_GV);
    float* U = (float*)(P.ws + WS_US); float* DEC = (float*)(P.ws + WS_DECAY);
    const int ti = tid >> 3, d0 = (tid & 7) * 8, tt = 64 * c - 48 + ti; const bool tv = tt >= 0 && tt < L;
    half8 k8, v8[2];
#pragma unroll
    for (int m = 0; m < 8; ++m) { k8[m] = (f16)0.f; v8[0][m] = (f16)0.f; v8[1][m] = (f16)0.f; }
    if (tv) k8 = *(const half8*)(GK + (size_t)tt * 256 + 64 * h + d0);
#pragma unroll
    for (int q = 0; q < 2; ++q) { const int ch = tid + 512 * q, j = ch >> 4, t = 64 * c - 48 + j; if (t >= 0 && t < L) v8[q] = *(const half8*)(GV + (size_t)t * 512 + 128 * h + (ch & 15) * 8); }
    gla_gates(P, c, h, bl);
    { f32x4 o0, o1;
#pragma unroll
      for (int m = 0; m < 4; ++m) { o0[m] = (float)k8[m] * __expf(bl[63 * 65 + d0 + m] - bl[ti * 65 + d0 + m]); o1[m] = (float)k8[4 + m] * __expf(bl[63 * 65 + d0 + 4 + m] - bl[ti * 65 + d0 + 4 + m]); }
      *(LAS f32x4*)(ks + ti * 64 + d0) = o0; *(LAS f32x4*)(ks + ti * 64 + d0 + 4) = o1; }
#pragma unroll
    for (int q = 0; q < 2; ++q) { const int ch = tid + 512 * q, j = ch >> 4, e0 = (ch & 15) * 8; f32x4 o0, o1;
#pragma unroll
        for (int m = 0; m < 4; ++m) { o0[m] = (float)v8[q][m]; o1[m] = (float)v8[q][4 + m]; }
        *(LAS f32x4*)(vs + j * 128 + e0) = o0; *(LAS f32x4*)(vs + j * 128 + e0 + 4) = o1; }
    if (tid < 64) DEC[(size_t)c * 256 + h * 64 + tid] = __expf(bl[63 * 65 + tid]);
    __syncthreads();
    { const int dd0 = (wid >> 2) * 32, e0 = (wid & 3) * 32, l31 = lane & 31, hf = lane >> 5; f32x16 acc;
#pragma unroll
      for (int i = 0; i < 16; ++i) acc[i] = 0.f;
#pragma unroll 8
      for (int s = 0; s < 32; ++s) acc = __builtin_amdgcn_mfma_f32_32x32x2f32(ks[(2 * s + hf) * 64 + dd0 + l31], vs[(2 * s + hf) * 128 + e0 + l31], acc, 0, 0, 0);
      float* up = U + ((size_t)unit * 64) * 128;
#pragma unroll
      for (int r = 0; r < 16; ++r) { const int row = (r & 3) + 8 * (r >> 2) + 4 * hf; up[(size_t)(dd0 + row) * 128 + e0 + l31] = acc[r]; } }
    __syncthreads();
}
__device__ __forceinline__ void gla_scan(const Params& P) {
    float* U = (float*)(P.ws + WS_US); const float* DEC = (const float*)(P.ws + WS_DECAY);
    const int idx = blockIdx.x * NTHREADS + threadIdx.x;
    if (idx >= 32768) return;
    float s = 0.f;
#pragma unroll 8
    for (int c = 0; c < NCH; ++c) { const float u = U[(size_t)c * 32768 + idx], dc = DEC[(size_t)c * 256 + (idx >> 7)]; U[(size_t)c * 32768 + idx] = s; s = dc * s + u; }
}
__device__ __forceinline__ void gla_c_unit(const Params& P, int unit, LAS unsigned char* lds) {
    int tid_ = threadIdx.x; asm volatile("" : "+v"(tid_));
    const int tid = tid_, lane = tid & 63, wid = tid >> 6, c = unit >> 2, h = unit & 3, l31 = lane & 31, hf = lane >> 5;
    LAS float* bl = (LAS float*)lds; LAS float* kk = bl + 4160; LAS float* qs = kk + 4160; LAS float* As = qs + 4160; LAS float* vs = As + 4160; LAS float* Ss = vs + 8192; LAS float* os = bl;
    const f16* GQ = (const f16*)(P.ws + WS_GQ); const f16* GK = (const f16*)(P.ws + WS_GK); const f16* GV = (const f16*)(P.ws + WS_GV); const f16* GR = (const f16*)(P.ws + WS_GR);
    const float* Sg = (const float*)(P.ws + WS_US) + (size_t)unit * 8192; f16* mix = (f16*)(P.ws + WS_ACTA);
    const int ti = tid >> 3, d0 = (tid & 7) * 8, tt = 64 * c - 48 + ti; const bool tv = tt >= 0 && tt < L;
    half8 q8, k8, v8[2], r8[2]; f32x4 sreg[4];
#pragma unroll
    for (int m = 0; m < 8; ++m) { q8[m] = (f16)0.f; k8[m] = (f16)0.f; v8[0][m] = (f16)0.f; v8[1][m] = (f16)0.f; r8[0][m] = (f16)0.f; r8[1][m] = (f16)0.f; }
    if (tv) { q8 = *(const half8*)(GQ + (size_t)tt * 256 + 64 * h + d0); k8 = *(const half8*)(GK + (size_t)tt * 256 + 64 * h + d0);
        r8[0] = *(const half8*)(GR + (size_t)tt * 512 + 128 * h + (tid & 7) * 16); r8[1] = *(const half8*)(GR + (size_t)tt * 512 + 128 * h + (tid & 7) * 16 + 8); }
#pragma unroll
    for (int q = 0; q < 2; ++q) { const int ch = tid + 512 * q, j = ch >> 4, t = 64 * c - 48 + j; if (t >= 0 && t < L) v8[q] = *(const half8*)(GV + (size_t)t * 512 + 128 * h + (ch & 15) * 8); }
#pragma unroll
    for (int q = 0; q < 4; ++q) sreg[q] = *(const f32x4*)(Sg + (size_t)(tid + 512 * q) * 4);
    gla_gates(P, c, h, bl);
#pragma unroll
    for (int m = 0; m < 8; ++m) { const float bv = bl[ti * 65 + d0 + m]; qs[ti * 65 + d0 + m] = (float)q8[m] * 0.125f * __expf(bv); kk[ti * 65 + d0 + m] = (float)k8[m] * __expf(-bv); }
#pragma unroll
    for (int q = 0; q < 2; ++q) { const int ch = tid + 512 * q, j = ch >> 4, e0 = (ch & 15) * 8; f32x4 o0, o1;
#pragma unroll
        for (int m = 0; m < 4; ++m) { o0[m] = (float)v8[q][m]; o1[m] = (float)v8[q][4 + m]; }
        *(LAS f32x4*)(vs + j * 128 + e0) = o0; *(LAS f32x4*)(vs + j * 128 + e0 + 4) = o1; }
#pragma unroll
    for (int q = 0; q < 4; ++q) *(LAS f32x4*)(Ss + (tid + 512 * q) * 4) = sreg[q];
    __syncthreads();
    if (wid < 4) { const int i0 = (wid >> 1) * 32, j0 = (wid & 1) * 32; f32x16 acc;
#pragma unroll
        for (int i = 0; i < 16; ++i) acc[i] = 0.f;
#pragma unroll 8
        for (int s = 0; s < 32; ++s) acc = __builtin_amdgcn_mfma_f32_32x32x2f32(qs[(i0 + l31) * 65 + 2 * s + hf], kk[(j0 + l31) * 65 + 2 * s + hf], acc, 0, 0, 0);
#pragma unroll
        for (int r = 0; r < 16; ++r) { const int i = i0 + (r & 3) + 8 * (r >> 2) + 4 * hf, j = j0 + l31; As[i * 65 + j] = (j <= i) ? acc[r] : 0.f; } }
    __syncthreads();
    { const int i0 = (wid >> 2) * 32, e0 = (wid & 3) * 32; f32x16 acc;
#pragma unroll
      for (int i = 0; i < 16; ++i) acc[i] = 0.f;
#pragma unroll 8
      for (int s = 0; s < 32; ++s) acc = __builtin_amdgcn_mfma_f32_32x32x2f32(qs[(i0 + l31) * 65 + 2 * s + hf], Ss[(2 * s + hf) * 128 + e0 + l31], acc, 0, 0, 0);
#pragma unroll 8
      for (int s = 0; s < 32; ++s) acc = __builtin_amdgcn_mfma_f32_32x32x2f32(As[(i0 + l31) * 65 + 2 * s + hf], vs[(2 * s + hf) * 128 + e0 + l31], acc, 0, 0, 0);
#pragma unroll
      for (int r = 0; r < 16; ++r) { const int i = i0 + (r & 3) + 8 * (r >> 2) + 4 * hf; os[i * 129 + e0 + l31] = acc[r]; } }
    __syncthreads();
    { const int e0 = (tid & 7) * 16; float o[16], sq = 0.f;
#pragma unroll
      for (int j = 0; j < 16; ++j) { o[j] = os[ti * 129 + e0 + j]; sq += o[j] * o[j]; }
      sq += __shfl_xor(sq, 1); sq += __shfl_xor(sq, 2); sq += __shfl_xor(sq, 4);
      const float rs = rsqrtf(sq * (1.0f / 128.0f) + EPS);
      if (tt >= NMETA && tt < L) { half8 w0, w1;
#pragma unroll
          for (int j = 0; j < 8; ++j) { w0[j] = (f16)(o[j] * rs * P.hn[e0 + j] * silu_f((float)r8[0][j])); w1[j] = (f16)(o[8 + j] * rs * P.hn[e0 + 8 + j] * silu_f((float)r8[1][j])); }
          f16* dst = mix + (size_t)(tt - NMETA) * D + 128 * h + e0; *(half8*)dst = w0; *(half8*)(dst + 8) = w1; } }
    __syncthreads();
}

__device__ __forceinline__ unsigned mono_u(float f) { const unsigned u = __float_as_uint(f); return (u & 0x80000000u) ? ~u : (u | 0x80000000u); }
__device__ __forceinline__ float unmono_f(unsigned m) { return __uint_as_float((m & 0x80000000u) ? (m & 0x7fffffffu) : ~m); }
__device__ __forceinline__ unsigned wave_umax(unsigned v) {
    v = max(v, (unsigned)__builtin_amdgcn_update_dpp(0, (int)v, 0x111, 0xf, 0xf, false));
    v = max(v, (unsigned)__builtin_amdgcn_update_dpp(0, (int)v, 0x112, 0xf, 0xf, false));
    v = max(v, (unsigned)__builtin_amdgcn_update_dpp(0, (int)v, 0x114, 0xf, 0xf, false));
    v = max(v, (unsigned)__builtin_amdgcn_update_dpp(0, (int)v, 0x118, 0xf, 0xf, false));
    v = max(v, (unsigned)__builtin_amdgcn_update_dpp(0, (int)v, 0x142, 0xa, 0xf, false));
    v = max(v, (unsigned)__builtin_amdgcn_update_dpp(0, (int)v, 0x143, 0xc, 0xf, false));
    return (unsigned)__builtin_amdgcn_readlane((int)v, 63);
}
constexpr int CAP = 640, NPL = CAP / 64;
__device__ __forceinline__ int topk_compact(LAS float* cs, LAS unsigned short* ci, int n, bool exact, float& tau_out, int lane) {
    float sv[NPL]; unsigned iv[NPL], u[NPL];
#pragma unroll
    for (int i = 0; i < NPL; ++i) { const int p = lane + 64 * i; const bool v = p < n; sv[i] = v ? cs[p] : 0.f; iv[i] = v ? (unsigned)ci[p] : 0xffffu; u[i] = v ? mono_u(sv[i]) : 0u; }
    unsigned T = 0u; bool full = true; int hb = 31;
    {
        unsigned umx = 0u, umn = 0xffffffffu;
#pragma unroll
        for (int i = 0; i < NPL; ++i) { umx = max(umx, u[i]); umn = min(umn, (lane + 64 * i < n) ? u[i] : 0xffffffffu); }
        umx = wave_umax(umx); umn = ~wave_umax(~umn);
        const unsigned df = umx ^ umn;
        if (df == 0u) { hb = -1; T = umx; } else { hb = 31 - __clz(df); T = (hb == 31) ? 0u : (umx & ~((2u << hb) - 1u)); }
    }
#pragma unroll 1
    for (int bit = hb; bit >= 0; --bit) {
        const unsigned cand = T | (1u << bit); int cgt = 0;
#pragma unroll
        for (int i = 0; i < NPL; ++i) cgt += __popcll(__ballot(u[i] >= cand));
        if (cgt >= 256) { T = cand; if (!exact && cgt <= 272) { full = false; break; } }
    }
    bool keep[NPL];
    if (full) {
        int cgt = 0;
#pragma unroll
        for (int i = 0; i < NPL; ++i) cgt += __popcll(__ballot(u[i] > T));
        const int need = 256 - cgt; unsigned I = 0xffffu; int nties = 0;
#pragma unroll
        for (int i = 0; i < NPL; ++i) nties += __popcll(__ballot(u[i] == T));
        if (nties != need) { I = 0u;
#pragma unroll 1
        for (int bit = 15; bit >= 0; --bit) { const unsigned cand = I | (1u << bit); int cl = 0;
#pragma unroll
            for (int i = 0; i < NPL; ++i) cl += __popcll(__ballot(u[i] == T && iv[i] < cand));
            if (cl < need) I = cand; } }
#pragma unroll
        for (int i = 0; i < NPL; ++i) keep[i] = (u[i] > T) || (u[i] == T && iv[i] <= I);
    } else {
#pragma unroll
        for (int i = 0; i < NPL; ++i) keep[i] = u[i] >= T;
    }
    int nn = 0;
#pragma unroll
    for (int i = 0; i < NPL; ++i) { const unsigned long long m = __ballot(keep[i]); const int pre = __builtin_amdgcn_mbcnt_hi((unsigned)(m >> 32), __builtin_amdgcn_mbcnt_lo((unsigned)m, 0u));
        if (keep[i]) { cs[nn + pre] = sv[i]; ci[nn + pre] = (unsigned short)iv[i]; } nn += __popcll(m); }
    tau_out = unmono_f(T);
    return nn;
}
__device__ __forceinline__ float relu_asm(float x) { return __int_as_float(max(__float_as_int(x), 0)); }
__device__ __forceinline__ void indexer_tile(const Params& P, int tile, LAS unsigned char* lds) {
    int tid_ = threadIdx.x; asm volatile("" : "+v"(tid_));
    const int tid = tid_, lane = tid & 63, wid = __builtin_amdgcn_readfirstlane(tid >> 6), l31 = lane & 31, hf = lane >> 5;
    LAS float* candS = (LAS float*)lds;
    LAS unsigned short* candI = (LAS unsigned short*)(lds + 32 * CAP * 4);
    LAS unsigned char* kbuf = lds + 32 * CAP * 6;
    LAS int* lcnt = (LAS int*)(lds + LDS_BYTES - 1024 + 64);
    LAS int* lflag = (LAS int*)(lds + LDS_BYTES - 1024 + 192);
    const f16* IQ = (const f16*)(P.ws + WS_IQ); const f16* IK = (const f16*)(P.ws + WS_IK); const float* IW = (const float*)(P.ws + WS_IW);
    unsigned short* SEL = (unsigned short*)(P.ws + WS_SEL);
    const int t0 = tile * 32, tw = t0 + wid * 4;
    half8 afr[4];
    { const int qi = 2 * (l31 >> 4) + ((l31 >> 2) & 1), hd = 4 * ((l31 >> 3) & 1) + (l31 & 3); int tq = tw + qi; if (tq > L - 1) tq = L - 1;
      const half8* ap = (const half8*)(IQ + (size_t)tq * 512 + hd * 64);
#pragma unroll
      for (int s = 0; s < 4; ++s) afr[s] = ap[2 * s + hf]; }
    float w0[8], w1[8];
    { int ta = tw + hf, tb = tw + 2 + hf; if (ta > L - 1) ta = L - 1; if (tb > L - 1) tb = L - 1;
#pragma unroll
      for (int h = 0; h < 8; ++h) { w0[h] = IW[(size_t)ta * 8 + h]; w1[h] = IW[(size_t)tb * 8 + h]; } }
    asm volatile("" :: "v"(afr[0]), "v"(afr[1]), "v"(afr[2]), "v"(afr[3]));
    asm volatile("" :: "v"(w0[0]), "v"(w0[1]), "v"(w0[2]), "v"(w0[3]), "v"(w0[4]), "v"(w0[5]), "v"(w0[6]), "v"(w0[7]));
    asm volatile("" :: "v"(w1[0]), "v"(w1[1]), "v"(w1[2]), "v"(w1[3]), "v"(w1[4]), "v"(w1[5]), "v"(w1[6]), "v"(w1[7]));
    const int tq0 = (tw + hf < L) ? tw + hf : -1, tq1 = (tw + 2 + hf < L) ? tw + 2 + hf : -1;
    float tau0 = -__builtin_inff(), tau1 = -__builtin_inff();
    int cntv = 0;
    if (lane < 4) lcnt[wid * 4 + lane] = 0;
    if (tid < 3) lflag[tid] = 0;
    const int nkeys = (t0 + 32 < L) ? t0 + 32 : L, nst = (nkeys + 127) >> 7;
    u32x4 stg[2];
    const u32x4* IKv = (const u32x4*)IK;
#pragma unroll
    for (int i = 0; i < 2; ++i) stg[i] = IKv[(size_t)0 * 1024 + tid + 512 * i];
#pragma unroll
    for (int i = 0; i < 2; ++i) { const int ci = tid + 512 * i, row = ci >> 3, ch = ci & 7; *(LAS u32x4*)(kbuf + row * 128 + ((ch ^ ((row >> 1) & 7)) << 4)) = stg[i]; }
    __syncthreads();
#pragma unroll 1
    for (int st = 0; st < nst; ++st) {
        LAS unsigned char* kb = kbuf + (st & 1) * 16384;
        if (st + 1 < nst) {
#pragma unroll
            for (int i = 0; i < 2; ++i) stg[i] = IKv[(size_t)(st + 1) * 1024 + tid + 512 * i];
        }
#pragma unroll 1
        for (int sub = 0; sub < 4; sub += 2) {
            const int kbase = st * 128 + sub * 32;
            if (kbase > tw + 3) break;
            const int rowa = sub * 32 + l31, rowb = rowa + 32;
            f32x16 acca, accb;
#pragma unroll
            for (int i = 0; i < 16; ++i) { acca[i] = 0.f; accb[i] = 0.f; }
            half8 bfa[4], bfb[4];
#pragma unroll
            for (int s = 0; s < 4; ++s) { bfa[s] = *(const LAS half8*)(kb + rowa * 128 + (((2 * s + hf) ^ ((rowa >> 1) & 7)) << 4)); bfb[s] = *(const LAS half8*)(kb + rowb * 128 + (((2 * s + hf) ^ ((rowb >> 1) & 7)) << 4)); }
#pragma unroll
            for (int s = 0; s < 4; ++s) { acca = __builtin_amdgcn_mfma_f32_32x32x16_f16(afr[s], bfa[s], acca, 0, 0, 0); accb = __builtin_amdgcn_mfma_f32_32x32x16_f16(afr[s], bfb[s], accb, 0, 0, 0); }
#pragma unroll
            for (int part = 0; part < 2; ++part) {
                const int key = kbase + part * 32 + l31;
                float s0 = 0.f, s1 = 0.f;
#pragma unroll
                for (int h = 0; h < 8; ++h) { s0 = __builtin_fmaf(w0[h], relu_asm(part ? accb[h] : acca[h]), s0); s1 = __builtin_fmaf(w1[h], relu_asm(part ? accb[8 + h] : acca[8 + h]), s1); }
                if (key <= tq0 && s0 > tau0) { const int qs = wid * 4 + hf; const int pos = (int)__hip_atomic_fetch_add(lcnt + qs, 1, __ATOMIC_RELAXED, __HIP_MEMORY_SCOPE_WORKGROUP); candS[qs * CAP + pos] = s0; candI[qs * CAP + pos] = (unsigned short)key; }
                if (key <= tq1 && s1 > tau1) { const int qs = wid * 4 + 2 + hf; const int pos = (int)__hip_atomic_fetch_add(lcnt + qs, 1, __ATOMIC_RELAXED, __HIP_MEMORY_SCOPE_WORKGROUP); candS[qs * CAP + pos] = s1; candI[qs * CAP + pos] = (unsigned short)key; }
            }
        }
        if (st + 1 < nst) {
            LAS unsigned char* kn = kbuf + ((st + 1) & 1) * 16384;
#pragma unroll
            for (int i = 0; i < 2; ++i) { const int ci = tid + 512 * i, row = ci >> 3, ch = ci & 7; *(LAS u32x4*)(kn + row * 128 + ((ch ^ ((row >> 1) & 7)) << 4)) = stg[i]; }
        }
        cntv = lcnt[wid * 4 + (lane & 3)];
        const int mx = max(max(__builtin_amdgcn_readlane(cntv, 0), __builtin_amdgcn_readlane(cntv, 1)), max(__builtin_amdgcn_readlane(cntv, 2), __builtin_amdgcn_readlane(cntv, 3)));
        if (mx > CAP - 128 && lane == 0) lflag[st % 3] = 1;
        if (tid == 0) lflag[(st + 1) % 3] = 0;
        __syncthreads();
        const int any = lflag[st % 3];
        if (any) {
#pragma unroll 1
            for (int qq = 0; qq < 4; ++qq) { const int n = __builtin_amdgcn_readlane(cntv, qq);
                if (n > 288) { float nt; const int nn = topk_compact(candS + (wid * 4 + qq) * CAP, candI + (wid * 4 + qq) * CAP, n, false, nt, lane);
                    if (lane == 0) lcnt[wid * 4 + qq] = nn;
                    if (hf == (qq & 1)) { if (qq < 2) tau0 = nt; else tau1 = nt; } } }
        }
    }
#pragma unroll 1
    for (int qq = 0; qq < 4; ++qq) {
        const int t = tw + qq; if (t >= L) break;
        int n = lcnt[wid * 4 + qq]; LAS float* cs = candS + (wid * 4 + qq) * CAP; LAS unsigned short* ci = candI + (wid * 4 + qq) * CAP;
        if (n > 256) { float nt; n = topk_compact(cs, ci, n, true, nt, lane); }
#pragma unroll
        for (int j = 0; j < 4; ++j) { const int p = lane + 64 * j; SEL[(size_t)t * 256 + p] = p < n ? ci[p] : (unsigned short)0xffffu; }
    }
    __syncthreads();
}

#ifdef SCORE_ONLY_EXP
__device__ __forceinline__ void indexer_score_only(const Params& P, int tile, LAS unsigned char* lds) {
    int tid_ = threadIdx.x; asm volatile("" : "+v"(tid_));
    const int tid = tid_, lane = tid & 63, wid = __builtin_amdgcn_readfirstlane(tid >> 6), l31 = lane & 31, hf = lane >> 5;
    LAS float* candS = (LAS float*)lds;
    LAS unsigned short* candI = (LAS unsigned short*)(lds + 32 * CAP * 4);
    LAS unsigned char* kbuf = lds + 32 * CAP * 6;
    const f16* IQ = (const f16*)(P.ws + WS_IQ); const f16* IK = (const f16*)(P.ws + WS_IK); const float* IW = (const float*)(P.ws + WS_IW);
    unsigned short* SEL = (unsigned short*)(P.ws + WS_SEL);
    const int t0 = tile * 32, tw = t0 + wid * 4;
    half8 afr[4];
    { const int qi = 2 * (l31 >> 4) + ((l31 >> 2) & 1), hd = 4 * ((l31 >> 3) & 1) + (l31 & 3); int tq = tw + qi; if (tq > L - 1) tq = L - 1;
      const half8* ap = (const half8*)(IQ + (size_t)tq * 512 + hd * 64);
#pragma unroll
      for (int s = 0; s < 4; ++s) afr[s] = ap[2 * s + hf]; }
    float w0[8], w1[8];
    { int ta = tw + hf, tb = tw + 2 + hf; if (ta > L - 1) ta = L - 1; if (tb > L - 1) tb = L - 1;
#pragma unroll
      for (int h = 0; h < 8; ++h) { w0[h] = IW[(size_t)ta * 8 + h]; w1[h] = IW[(size_t)tb * 8 + h]; } }
    asm volatile("" :: "v"(afr[0]), "v"(afr[1]), "v"(afr[2]), "v"(afr[3]));
    asm volatile("" :: "v"(w0[0]), "v"(w0[1]), "v"(w0[2]), "v"(w0[3]), "v"(w0[4]), "v"(w0[5]), "v"(w0[6]), "v"(w0[7]));
    asm volatile("" :: "v"(w1[0]), "v"(w1[1]), "v"(w1[2]), "v"(w1[3]), "v"(w1[4]), "v"(w1[5]), "v"(w1[6]), "v"(w1[7]));
    const int tq0 = (tw + hf < L) ? tw + hf : -1, tq1 = (tw + 2 + hf < L) ? tw + 2 + hf : -1;
    float tau0 = -__builtin_inff(), tau1 = -__builtin_inff();
    int cntv = 0; float sink = 0.f;
    const int nkeys = (t0 + 32 < L) ? t0 + 32 : L, nst = (nkeys + 127) >> 7;
    u32x4 stg[2];
    const u32x4* IKv = (const u32x4*)IK;
#pragma unroll
    for (int i = 0; i < 2; ++i) stg[i] = IKv[(size_t)0 * 1024 + tid + 512 * i];
#pragma unroll
    for (int i = 0; i < 2; ++i) { const int ci = tid + 512 * i, row = ci >> 3, ch = ci & 7; *(LAS u32x4*)(kbuf + row * 128 + ((ch ^ ((row >> 1) & 7)) << 4)) = stg[i]; }
    __syncthreads();
#pragma unroll 1
    for (int st = 0; st < nst; ++st) {
        LAS unsigned char* kb = kbuf + (st & 1) * 16384;
        if (st + 1 < nst) {
#pragma unroll
            for (int i = 0; i < 2; ++i) stg[i] = IKv[(size_t)(st + 1) * 1024 + tid + 512 * i];
        }
#pragma unroll 1
        for (int sub = 0; sub < 4; ++sub) {
            const int kbase = st * 128 + sub * 32;
            if (kbase > tw + 3) break;
            const int row = sub * 32 + l31;
            f32x16 acc;
#pragma unroll
            for (int i = 0; i < 16; ++i) acc[i] = 0.f;
#pragma unroll
            for (int s = 0; s < 4; ++s) { const half8 bfr = *(const LAS half8*)(kb + row * 128 + (((2 * s + hf) ^ ((row >> 1) & 7)) << 4)); acc = __builtin_amdgcn_mfma_f32_32x32x16_f16(afr[s], bfr, acc, 0, 0, 0); }
            float s0 = 0.f, s1 = 0.f;
#pragma unroll
            for (int h = 0; h < 8; ++h) { s0 = __builtin_fmaf(w0[h], relu_asm(acc[h]), s0); s1 = __builtin_fmaf(w1[h], relu_asm(acc[8 + h]), s1); }
            const int key = kbase + l31;
            sink += (key <= tq0 && s0 > tau0) ? s0 : 0.f; sink += (key <= tq1 && s1 > tau1) ? s1 : 0.f;
        }
        if (st + 1 < nst) {
            LAS unsigned char* kn = kbuf + ((st + 1) & 1) * 16384;
#pragma unroll
            for (int i = 0; i < 2; ++i) { const int ci = tid + 512 * i, row = ci >> 3, ch = ci & 7; *(LAS u32x4*)(kn + row * 128 + ((ch ^ ((row >> 1) & 7)) << 4)) = stg[i]; }
        }
        __syncthreads();
    }
    if (sink == 12345.678f) ((float*)(P.ws + WS_CTL))[200 + (tid & 31)] = sink + (float)cntv;
    __syncthreads();
}

#endif
__device__ __forceinline__ void sparse_attn(const Params& P, LAS unsigned char* lds, int vbid) {
    int tid_ = threadIdx.x; asm volatile("" : "+v"(tid_));
    const int tid = tid_, lane = tid & 63, wid = tid >> 6, grp = lane >> 2, c4 = lane & 3;
    const int head = vbid & 7, slot = (vbid >> 3) * 8 + wid, nslot = (gridDim.x >> 3) * 8;
    typedef _Float16 half2v __attribute__((ext_vector_type(2)));
    LAS unsigned short* widx = (LAS unsigned short*)(lds + wid * 512);
    LAS float* red = (LAS float*)(lds + 4096 + wid * 4352);
    const unsigned short* SEL = (const unsigned short*)(P.ws + WS_SEL); const f16* DQ = (const f16*)(P.ws + WS_DQ);
    const unsigned char* kvh = P.ws + WS_KV + (size_t)head * LP * 128; f16* mix = (f16*)(P.ws + WS_ACTA);
    int t = NMETA + slot;
    u32x2 selr = {0u, 0u}; half8 qa, qb;
#pragma unroll
    for (int e = 0; e < 8; ++e) { qa[e] = (f16)0.f; qb[e] = (f16)0.f; }
    if (t < L) { selr = *(const u32x2*)(SEL + (size_t)t * 256 + lane * 4); qa = *(const half8*)(DQ + (size_t)t * 512 + head * 64 + c4 * 16); qb = *(const half8*)(DQ + (size_t)t * 512 + head * 64 + c4 * 16 + 8); }
#pragma unroll 1
    for (; t < L; t += nslot) {
        *(LAS u32x2*)(widx + lane * 4) = selr;
        unsigned keys[16]; u32x4 kreg[16], vreg[16];
#pragma unroll
        for (int it = 0; it < 16; ++it) keys[it] = widx[16 * it + grp];
#pragma unroll
        for (int it = 0; it < 16; ++it) { const unsigned kk = keys[it] != 0xffffu ? keys[it] : 0u; kreg[it] = *(const u32x4*)(kvh + (size_t)kk * 128 + c4 * 16); }
#pragma unroll
        for (int it = 0; it < 16; ++it) { const unsigned kk = keys[it] != 0xffffu ? keys[it] : 0u; vreg[it] = *(const u32x4*)(kvh + (size_t)kk * 128 + 64 + c4 * 16); }
        float qf[16], qmax = 1e-20f;
#pragma unroll
        for (int e = 0; e < 8; ++e) { qf[e] = (float)qa[e]; qf[8 + e] = (float)qb[e]; }
#pragma unroll
        for (int e = 0; e < 16; ++e) qmax = fmaxf(qmax, fabsf(qf[e]));
        qmax = fmaxf(qmax, __int_as_float(__builtin_amdgcn_update_dpp(0, __float_as_int(qmax), 0xB1, 0xf, 0xf, true)));
        qmax = fmaxf(qmax, __int_as_float(__builtin_amdgcn_update_dpp(0, __float_as_int(qmax), 0x4E, 0xf, 0xf, true)));
        const float qs = 127.0f * __builtin_amdgcn_rcpf(qmax), lscale = qmax * (1.0f / (127.0f * K_I8_SCALE));
        int q8[4];
#pragma unroll
        for (int w = 0; w < 4; ++w) { unsigned word = 0u;
#pragma unroll
            for (int j = 0; j < 4; ++j) { const int q = (int)__builtin_rintf(qf[4 * w + j] * qs); word |= ((unsigned)q & 0xffu) << (8 * j); }
            q8[w] = (int)word; }
        { const int tn = t + nslot;
          if (tn < L) { selr = *(const u32x2*)(SEL + (size_t)tn * 256 + lane * 4); qa = *(const half8*)(DQ + (size_t)tn * 512 + head * 64 + c4 * 16); qb = *(const half8*)(DQ + (size_t)tn * 512 + head * 64 + c4 * 16 + 8); } }
        float lg[16]; float mx = -__builtin_inff();
#pragma unroll
        for (int it = 0; it < 16; ++it) {
            int ai = 0;
#pragma unroll
            for (int w = 0; w < 4; ++w) ai = __builtin_amdgcn_sdot4((int)kreg[it][w], q8[w], ai, false);
            ai += __builtin_amdgcn_update_dpp(0, ai, 0xB1, 0xf, 0xf, true);
            ai += __builtin_amdgcn_update_dpp(0, ai, 0x4E, 0xf, 0xf, true);
            lg[it] = keys[it] != 0xffffu ? (float)ai * lscale : -__builtin_inff(); mx = fmaxf(mx, lg[it]);
        }
        mx = fmaxf(mx, __shfl_xor(mx, 4)); mx = fmaxf(mx, __shfl_xor(mx, 8)); mx = fmaxf(mx, __shfl_xor(mx, 16)); mx = fmaxf(mx, __shfl_xor(mx, 32));
        half2v o2[8]; float lsum = 0.f;
#pragma unroll
        for (int e = 0; e < 8; ++e) o2[e] = (half2v){(f16)0.f, (f16)0.f};
#pragma unroll
        for (int it = 0; it < 16; ++it) {
            const float p = __expf(lg[it] - mx); lsum += p; const f16 ph = (f16)p; const half2v p2 = {ph, ph};
#pragma unroll
            for (int w = 0; w < 4; ++w) {
                const half2v v01 = __builtin_bit_cast(half2v, __builtin_amdgcn_perm(0u, vreg[it][w], 0x010c000cu)), v23 = __builtin_bit_cast(half2v, __builtin_amdgcn_perm(0u, vreg[it][w], 0x030c020cu));
                o2[2 * w] = p2 * v01 + o2[2 * w]; o2[2 * w + 1] = p2 * v23 + o2[2 * w + 1]; }
        }
        lsum += __shfl_xor(lsum, 4); lsum += __shfl_xor(lsum, 8); lsum += __shfl_xor(lsum, 16); lsum += __shfl_xor(lsum, 32);
#pragma unroll
        for (int e = 0; e < 8; ++e) { red[lane * 17 + 2 * e] = (float)o2[e][0]; red[lane * 17 + 2 * e + 1] = (float)o2[e][1]; }
        float acc = 0.f;
        { const int cc = lane >> 4, e = lane & 15;
#pragma unroll
          for (int g = 0; g < 16; ++g) acc += red[(g * 4 + cc) * 17 + e]; }
        mix[(size_t)(t - NMETA) * D + 512 + head * 64 + lane] = (f16)(acc * __builtin_amdgcn_rcpf(lsum));
    }
    __syncthreads();
}

__device__ __forceinline__ void final_norm(const Params& P) {
    const int tid = threadIdx.x, lane = tid & 63, gw = blockIdx.x * 8 + (tid >> 6), nw = gridDim.x * 8;
    const float* ss3 = (const float*)(P.ws + WS_SS3);
    for (int r = gw; r < SEQ; r += nw) { const float rs = row_rstd(ss3, 16, r);
#pragma unroll
        for (int i = 0; i < 4; ++i) { const int k = lane * 4 + 256 * i; const f32x4 v = *(const f32x4*)(P.out + (size_t)r * D + k), g = *(const f32x4*)(P.nf + k); *(f32x4*)(P.out + (size_t)r * D + k) = v * rs * g; } }
}

#define XB_TMO      128
#define XB_XCNT(j)  (256  + 64 * (j))
#define XB_XSUB(j)  (1280 + 64 * (j))
#define XB_XGEN(j)  (2304 + 64 * (j))
#define XB_TOP      3328
#define XB_TOPGEN   3392
#define XCD_BAR_WORDS 3456
#define XB_SPIN_CAP (1u << 22)
__device__ __forceinline__ unsigned xb_ld(unsigned* p)              { return __hip_atomic_load(p, __ATOMIC_RELAXED, __HIP_MEMORY_SCOPE_AGENT); }
__device__ __forceinline__ unsigned xb_add(unsigned* p, unsigned v) { return __hip_atomic_fetch_add(p, v, __ATOMIC_RELAXED, __HIP_MEMORY_SCOPE_AGENT); }
__device__ __forceinline__ unsigned xb_xcc_id() { return (unsigned)__builtin_amdgcn_s_getreg((3 << 11) | 20) & 0xFu; }
#define XB_SPIN(cond, bar) do { unsigned _sp = 0; while (cond) { __builtin_amdgcn_s_sleep(1); \
    if ((++_sp & 255u) == 0u) { if (xb_ld(&(bar)[XB_TMO])) break; if (_sp > XB_SPIN_CAP) { atomicAdd(&(bar)[XB_TMO], 1u); break; } } } } while (0)
struct XcdBarrier { unsigned* bar; unsigned x; volatile LAS unsigned* st; };
__device__ __forceinline__ XcdBarrier xcd_barrier_post(unsigned* bar, volatile LAS unsigned* st) {
    XcdBarrier b; b.bar = bar; b.x = xb_xcc_id(); b.st = st;
    if (threadIdx.x == 0) (void)xb_add(&bar[XB_XCNT(b.x)], 1u);
    return b;
}
__device__ __forceinline__ void xcd_barrier_complete(unsigned* bar, unsigned x, unsigned& nloc, unsigned& nx) {
    const unsigned G = gridDim.x * gridDim.y * gridDim.z;
    unsigned sum, cnt, mine, sp = 0u;
    for (;;) {
        sum = 0u; cnt = 0u; mine = 0u;
#pragma unroll
        for (unsigned j = 0; j < 16; ++j) { const unsigned c = xb_ld(&bar[XB_XCNT(j)]); sum += c; cnt += (c > 0u) ? 1u : 0u; mine = (j == x) ? c : mine; }
        if (sum == G) break;
        __builtin_amdgcn_s_sleep(1);
        if ((++sp & 255u) == 0u) { if (xb_ld(&bar[XB_TMO])) break; if (sp > XB_SPIN_CAP) { atomicAdd(&bar[XB_TMO], 1u); break; } }
    }
    nloc = mine > 0u ? mine : 1u; nx = cnt > 0u ? cnt : 1u;
}
__device__ __forceinline__ void xcd_barrier(const XcdBarrier& b) {
    asm volatile("s_waitcnt vmcnt(0)" ::: "memory");
    __syncthreads();
    if (threadIdx.x == 0) {
        unsigned* bar = b.bar;
        __builtin_amdgcn_s_waitcnt(0);
        unsigned nloc = b.st[0], nx = b.st[1];
        if (nloc == 0u) { xcd_barrier_complete(bar, b.x, nloc, nx); b.st[0] = nloc; b.st[1] = nx; }
        const unsigned old = xb_add(&bar[XB_XSUB(b.x)], 1u);
        const unsigned gen = old / nloc;
        if (old + 1u == (gen + 1u) * nloc) {
            __builtin_amdgcn_fence(__ATOMIC_RELEASE, "agent");
            asm volatile("s_waitcnt vmcnt(0)" ::: "memory");
            const unsigned og = xb_add(&bar[XB_TOP], 1u);
            const unsigned tg = og / nx;
            if (og + 1u == (tg + 1u) * nx) xb_add(&bar[XB_TOPGEN], 1u);
            else XB_SPIN(xb_ld(&bar[XB_TOPGEN]) == tg, bar);
            __builtin_amdgcn_fence(__ATOMIC_ACQUIRE, "agent");
            xb_add(&bar[XB_XGEN(b.x)], 1u);
            asm volatile("s_waitcnt vmcnt(0)" ::: "memory");
        } else {
            XB_SPIN(xb_ld(&bar[XB_XGEN(b.x)]) == gen, bar);
            __builtin_amdgcn_fence(__ATOMIC_ACQUIRE, "agent");
            asm volatile("s_waitcnt vmcnt(0)" ::: "memory");
        }
    }
    __syncthreads();
}

__global__ void __launch_bounds__(NTHREADS, 2) fwd_kernel(Params P) {
    __shared__ __attribute__((aligned(16))) unsigned char lds_raw[LDS_BYTES];
    LAS unsigned char* lds = (LAS unsigned char*)lds_raw;
    const int tid = threadIdx.x, bid = blockIdx.x, G = gridDim.x;
    unsigned char* ws = P.ws;
    const int lo = P.ph_lo, hi = P.ph_hi;
#ifndef ONLY_PHASE
#define ONLY_PHASE -1
#endif
#define IN(k) ((ONLY_PHASE < 0 || ONLY_PHASE == (k)) && lo <= (k) && (k) < hi)
#ifdef PROBE
#define STAMP(k) do { if (bid == 0 && tid == 0) ((unsigned long long*)(ws + WS_CTL + 1024))[(k)] = __builtin_amdgcn_s_memrealtime(); } while (0)
#else
#define STAMP(k) do { } while (0)
#endif
#define SEAM(k) do { if (IN(k) && IN((k) + 1)) { xcd_barrier(xbar); } STAMP((k) + 1); } while (0)
    XcdBarrier xbar; xbar.bar = (unsigned*)(ws + WS_BAR); xbar.x = 0; xbar.st = (volatile LAS unsigned*)(lds + LDS_BYTES - 1024 + 16);
    if (hi - lo > 1) {
        if (tid == 0) { xbar.st[0] = 0u; xbar.st[1] = 0u; }
        __syncthreads();
        xbar = xcd_barrier_post((unsigned*)(ws + WS_BAR), (volatile LAS unsigned*)(lds + LDS_BYTES - 1024 + 16));
    }
    LAS int* misc = (LAS int*)(lds + LDS_BYTES - 1024);
    if (hi - lo > 1) {
        if (tid == 0) { const unsigned xcc = xb_xcc_id() & 7u; misc[8] = (int)xcc; misc[9] = (int)xb_add((unsigned*)(ws + WS_CTL) + 32 + 32 * xcc, 1u); }
    }
    int vbid = bid;
    f16* acta = (f16*)(ws + WS_ACTA); f16* Gb = (f16*)(ws + WS_G);
    float* ss0 = (float*)(ws + WS_SS0); float* ss1 = (float*)(ws + WS_SS1); float* ss2 = (float*)(ws + WS_SS2); float* ss3 = (float*)(ws + WS_SS3);
    STAMP(0);
    _Pragma("unroll 1") for (int rep = 0; rep < NREP(0); ++rep)
    if (IN(0)) { p0_prologue(P, lds); }
    SEAM(0);
    if (hi - lo > 1 && (G & 7) == 0) {
        if (tid == 0) { bool ok = true; for (int j = 0; j < 8; ++j) ok = ok && (xb_ld((unsigned*)(ws + WS_CTL) + 32 + 32 * j) == (unsigned)(G >> 3)); misc[10] = ok ? misc[9] * 8 + misc[8] : bid; }
        __syncthreads();
        vbid = __builtin_amdgcn_readfirstlane(misc[10]);
        __syncthreads();
    }
    _Pragma("unroll 1") for (int rep = 0; rep < NREP(1); ++rep)
    if (IN(1)) {
        pg8::Gemm g{acta, (const f16*)(ws + WS_WGU1), MP, 2 * DFF, D}; pg8::StaticOrder S; S.init(MP, 2 * DFF, G, vbid);
        EpiSwiglu E{Gb, ss0, 1}; pg8::gemm_phase(lds, g, S, E);
    }
    SEAM(1);
    _Pragma("unroll 1") for (int rep = 0; rep < NREP(2); ++rep)
    if (IN(2)) {
        meta_down(P, lds);
        pg8::Gemm g{Gb, (const f16*)(ws + WS_WD1), SEQ, D, DFF}; pg8::StaticOrder S; S.init(SEQ, D, G, vbid);
        EpiResid E{P.x, P.out, acta, ss1, 0.5f}; pg8::gemm_phase(lds, g, S, E);
    }
    SEAM(2);
    _Pragma("unroll 1") for (int rep = 0; rep < NREP(3); ++rep)
    if (IN(3)) {
        pg8::Gemm g{acta, (const f16*)(ws + WS_WIN), MP, NIN, D}; pg8::StaticOrder S; S.init(MP, NIN, G, vbid);
        EpiInProj E{ss1, (const f32x2*)(ws + WS_ROPE), ws};
        pg8::gemm_phase(lds, g, S, E);
    }
    SEAM(3);
    _Pragma("unroll 1") for (int rep = 0; rep < NREP(4); ++rep)
    if (IN(4)) {
        for (int u = bid; u < NCH * 4; u += G) gla_a_unit(P, u, lds);
        if (rep == 0) {
            int tbase = 0, cursor = bid; LAS f16* tl = (LAS f16*)lds;
            prep_weight(P, 3, D, D, (f16*)(ws + WS_WOUT), cursor, tbase, tl);
            prep_weight(P, 4, 2 * DFF, D, (f16*)(ws + WS_WGU2), cursor, tbase, tl);
            prep_weight(P, 5, D, DFF, (f16*)(ws + WS_WD2), cursor, tbase, tl);
        }
    }
    SEAM(4);
    _Pragma("unroll 1") for (int rep = 0; rep < NREP(5); ++rep)
    if (IN(5)) {
        if (bid < 64 && rep == 0) gla_scan(P);
        unsigned* ctr = (unsigned*)(ws + WS_CTL) + rep; LAS int* bc = (LAS int*)(lds + LDS_BYTES - 1024);
        for (;;) {
            if (tid == 0) bc[0] = (int)atomicAdd(ctr, 1u);
            __syncthreads();
            const int k = bc[0];
            __syncthreads();
            if (k >= 513) break;
            indexer_tile(P, 512 - k, lds);
        }
#ifdef SCORE_ONLY_EXP
        { unsigned* ctr2 = (unsigned*)(ws + WS_CTL) + 8;
          for (;;) {
            if (tid == 0) bc[0] = (int)atomicAdd(ctr2, 1u);
            __syncthreads();
            const int k = bc[0];
            __syncthreads();
            if (k >= 513) break;
            indexer_score_only(P, 512 - k, lds);
          } }
#endif
    }
    SEAM(5);
    _Pragma("unroll 1") for (int rep = 0; rep < NREP(6); ++rep)
    if (IN(6)) { if (REPEAT_PH != 6 || rep == 0 || true) for (int u = bid; u < NCH * 4; u += G) gla_c_unit(P, u, lds); sparse_attn(P, lds, vbid); }
    for (int e = 0; e < EXTRA_SYNCS; ++e) cg::this_grid().sync();
    SEAM(6);
    _Pragma("unroll 1") for (int rep = 0; rep < NREP(7); ++rep)
    if (IN(7)) {
        pg8::Gemm g{acta, (const f16*)(ws + WS_WOUT), SEQ, D, D}; pg8::StaticOrder S; S.init(SEQ, D, G, vbid);
        EpiResid E{P.out, P.out, (f16*)(ws + WS_US), ss2, rep == 0 ? 1.0f : 0.0f}; pg8::gemm_phase(lds, g, S, E);
    }
    SEAM(7);
    _Pragma("unroll 1") for (int rep = 0; rep < NREP(8); ++rep)
    if (IN(8)) {
        pg8::Gemm g{(const f16*)(ws + WS_US), (const f16*)(ws + WS_WGU2), SEQ, 2 * DFF, D}; pg8::StaticOrder S; S.init(SEQ, 2 * DFF, G, vbid);
        EpiSwiglu E{Gb, ss2, 16}; pg8::gemm_phase(lds, g, S, E);
    }
    SEAM(8);
    _Pragma("unroll 1") for (int rep = 0; rep < NREP(9); ++rep)
    if (IN(9)) {
        pg8::Gemm g{Gb, (const f16*)(ws + WS_WD2), SEQ, D, DFF}; pg8::StaticOrder S; S.init(SEQ, D, G, vbid);
        EpiResid E{P.out, P.out, nullptr, ss3, rep == 0 ? 0.5f : 0.0f}; pg8::gemm_phase(lds, g, S, E);
    }
    SEAM(9);
    if (IN(10)) final_norm(P);
#ifdef PROBE
    {
        STAMP(11);
        cg::this_grid().sync();
        const unsigned long long* tsv = (const unsigned long long*)(ws + WS_CTL + 1024);
        float tph[12]; float tg = 0.f;
#pragma unroll
        for (int k = 0; k < 11; ++k) { tph[k] = (float)(tsv[k + 1] - tsv[k]) * 0.01f; }
        tph[11] = (float)(tsv[11] - tsv[0]) * 0.01f;
        const float gsum = tph[1] + tph[2] + tph[3] + tph[7] + tph[8] + tph[9];
        const float va = (PROBE_A == 12) ? gsum : tph[PROBE_A < 12 ? PROBE_A : 0], vb = (PROBE_B == 12) ? gsum : tph[PROBE_B < 12 ? PROBE_B : 0];
        const size_t n = (size_t)SEQ * D;
        for (size_t i = (size_t)bid * NTHREADS + tid; i < n; i += (size_t)G * NTHREADS) P.out[i] = (i == 0) ? va : vb * 0.01f;
        (void)tg;
    }
#endif
#ifdef DBG_CUT
    if (IN(11)) {
        const size_t n = (size_t)SEQ * D; const size_t i0 = (size_t)bid * NTHREADS + tid, st = (size_t)G * NTHREADS;
#if DBG_CUT == 6
        const f16* m = (const f16*)(ws + WS_ACTA); for (size_t i = i0; i < n; i += st) P.out[i] = (float)m[i];
#elif DBG_CUT == 5
        const unsigned short* m = (const unsigned short*)(ws + WS_SEL); for (size_t i = i0; i < n; i += st) P.out[i] = (float)m[i % ((size_t)L * 256)];
#elif DBG_CUT == 3
        const f16* a = (const f16*)(ws + WS_DQ); const f16* b = (const f16*)(ws + WS_IQ); const f16* c = (const f16*)(ws + WS_KV); const f16* d = (const f16*)(ws + WS_GQ);
        for (size_t i = i0; i < n; i += st) P.out[i] = (float)a[i % ((size_t)L * 512)] + (float)b[i % ((size_t)L * 512)] + (float)c[i] + (float)d[i % ((size_t)L * 1536)];
#elif DBG_CUT == 4
        const float* m = (const float*)(ws + WS_US); for (size_t i = i0; i < n; i += st) P.out[i] = m[i % ((size_t)NCH * 32768)];
#endif
    }
#endif
#undef IN
#undef SEAM
}

extern "C" void kernel_launch(void* const* d_in, const int* in_sizes, int n_in, void* d_out, int out_size, void* d_ws, size_t ws_size, hipStream_t stream) {
    static int grid = 0;
    if (grid == 0) {
        if (n_in != 17 || in_sizes[0] != SEQ * D || out_size != SEQ * D || ws_size < WS_END) { fprintf(stderr, "kernel_launch: unexpected shapes (n_in %d, in0 %d, out %d, ws %zu, need %zu)\n", n_in, n_in > 0 ? in_sizes[0] : -1, out_size, ws_size, (size_t)WS_END); grid = -1; return; }
        int dev = 0, cus = 0, per_cu = 0;
        (void)hipGetDevice(&dev); (void)hipDeviceGetAttribute(&cus, hipDeviceAttributeMultiprocessorCount, dev);
        if (hipOccupancyMaxActiveBlocksPerMultiprocessor(&per_cu, (const void*)fwd_kernel, NTHREADS, 0) != hipSuccess || per_cu < 1) { fprintf(stderr, "kernel_launch: occupancy query says %d blocks per CU\n", per_cu); per_cu = 1; }
        (void)hipGetLastError();
        grid = cus;
        if (grid % 8 != 0 || grid < 64) { fprintf(stderr, "kernel_launch: unexpected CU count %d\n", cus); }
    }
    if (grid < 0) return;
    if (hipMemsetAsync((char*)d_ws + WS_CTL, 0, CTL_BYTES, stream) != hipSuccess) { fprintf(stderr, "kernel_launch: memset failed\n"); return; }
    Params p{};
    const float** pp = (const float**)&p;
    for (int i = 0; i < 17; ++i) pp[i] = (const float*)d_in[i];
    p.out = (float*)d_out; p.ws = (unsigned char*)d_ws;
#if MODE == 0
#ifdef DBG_CUT
    for (int ph = 0; ph <= DBG_CUT; ++ph) { p.ph_lo = ph; p.ph_hi = ph + 1; hipLaunchKernelGGL(fwd_kernel, dim3(grid), dim3(NTHREADS), 0, stream, p); }
    if (DBG_CUT != 2 && DBG_CUT != 7 && DBG_CUT != 9) { p.ph_lo = 11; p.ph_hi = 12; hipLaunchKernelGGL(fwd_kernel, dim3(grid), dim3(NTHREADS), 0, stream, p); }
#else
    for (int ph = 0; ph < NPHASE; ++ph) { p.ph_lo = ph; p.ph_hi = ph + 1; hipLaunchKernelGGL(fwd_kernel, dim3(grid), dim3(NTHREADS), 0, stream, p); }
#endif
#else
    p.ph_lo = 0; p.ph_hi = NPHASE;
    void* args[] = {&p};
    hipError_t e = hipLaunchCooperativeKernel((const void*)fwd_kernel, dim3(grid), dim3(NTHREADS), args, 0, stream);
    if (e != hipSuccess) fprintf(stderr, "cooperative launch failed: %s (grid %d)\n", hipGetErrorString(e), grid);
#endif
}
```

```cpp
#include <hip/hip_runtime.h>
#include <hip/hip_cooperative_groups.h>
#include <cstdio>
#include <cstdint>
namespace cg = cooperative_groups;

#ifndef MODE
#define MODE 1

#ifndef REPEAT_PH
#define REPEAT_PH -1
#endif
#define NREP(k) ((REPEAT_PH == (k) && (k) != 7 && (k) != 9) ? 2 : 1)
#ifndef EXTRA_SYNCS
#define EXTRA_SYNCS 0
#endif
#endif

#define LAS __attribute__((address_space(3)))
typedef _Float16 f16;
typedef _Float16 half8 __attribute__((ext_vector_type(8)));
typedef _Float16 half4 __attribute__((ext_vector_type(4)));
typedef float f32x2 __attribute__((ext_vector_type(2)));
typedef float f32x4 __attribute__((ext_vector_type(4)));
typedef float f32x16 __attribute__((ext_vector_type(16)));
typedef unsigned u32x2 __attribute__((ext_vector_type(2)));
typedef unsigned u32x4 __attribute__((ext_vector_type(4)));

constexpr int D = 1024, SEQ = 16384, NMETA = 16, L = SEQ + NMETA, DFF = 2816;
constexpr int MP = 16640;
constexpr int LP = 16512;
constexpr int NIN = 3840;
constexpr int NCH = 257;
constexpr float EPS = 1e-6f;
constexpr int NTHREADS = 512;
constexpr int LDS_BYTES = 155648 + 1024;
constexpr int NPHASE = 11;

constexpr size_t al256(size_t x) { return (x + 255) & ~(size_t)255; }
constexpr size_t WS_CTL = 0;
constexpr size_t CTL_BYTES = 32768;
constexpr size_t WS_BAR = 2048;
constexpr size_t WS_WGU1 = CTL_BYTES;
constexpr size_t WS_WD1 = WS_WGU1 + (size_t)2 * DFF * D * 2;
constexpr size_t WS_WIN = WS_WD1 + (size_t)D * DFF * 2;
constexpr size_t WS_WOUT = WS_WIN + (size_t)NIN * D * 2;
constexpr size_t WS_WGU2 = WS_WOUT + (size_t)D * D * 2;
constexpr size_t WS_WD2 = WS_WGU2 + (size_t)2 * DFF * D * 2;
constexpr size_t WS_ACTA = WS_WD2 + (size_t)D * DFF * 2;
constexpr size_t WS_G = WS_ACTA + (size_t)MP * D * 2;
constexpr size_t WS_US = WS_G + (size_t)MP * DFF * 2;
constexpr size_t WS_DQ = WS_US + (size_t)NCH * 4 * 64 * 128 * 4;
constexpr size_t WS_IQ = WS_DQ + (size_t)LP * 512 * 2;
constexpr size_t WS_SEL = WS_IQ + (size_t)LP * 512 * 2;
constexpr size_t WS_ROPE = WS_SEL + (size_t)LP * 256 * 2;
constexpr size_t WS_IW = WS_ROPE + al256((size_t)L * 32 * 8);
constexpr size_t WS_GA = WS_IW + (size_t)LP * 8 * 4;
constexpr size_t WS_DECAY = WS_GA + (size_t)LP * 16 * 4;
constexpr size_t WS_SS0 = WS_DECAY + al256((size_t)NCH * 256 * 4);
constexpr size_t WS_SS1 = WS_SS0 + (size_t)MP * 4;
constexpr size_t WS_SS2 = WS_SS1 + (size_t)MP * 64;
constexpr size_t WS_SS3 = WS_SS2 + (size_t)MP * 64;
constexpr size_t WS_END = WS_SS3 + (size_t)MP * 64;
constexpr size_t WS_KV = WS_G;
constexpr size_t WS_GQ = WS_KV + (size_t)8 * LP * 128 * 2;
constexpr size_t WS_GK = WS_GQ + (size_t)LP * 256 * 2;
constexpr size_t WS_GV = WS_GK + (size_t)LP * 256 * 2;
constexpr size_t WS_GR = WS_GV + (size_t)LP * 512 * 2;
constexpr size_t WS_IK = WS_GR + (size_t)LP * 512 * 2;
constexpr size_t WS_ALIAS_END = WS_IK + (size_t)LP * 64 * 2;
static_assert(WS_ALIAS_END <= WS_US, "aliased buffers exceed G");
static_assert(WS_END <= (size_t)256 * 1024 * 1024, "workspace exceeds 256 MiB");
static_assert((size_t)SEQ * D * 2 <= (size_t)NCH * 4 * 64 * 128 * 4, "h2_16 alias");

struct Params {
    const float* x; const float* meta; const float* n1; const float* wg1; const float* wu1; const float* wd1;
    const float* nmix; const float* win; const float* wa2; const float* ba; const float* hn; const float* wout;
    const float* n2; const float* wg2; const float* wu2; const float* wd2; const float* nf;
    float* out; unsigned char* ws; int ph_lo, ph_hi;
};

namespace pg8 {
constexpr int BM = 256, BK = 64, HALF = 128, HTB = HALF * BK * 2, STAGE_BYTES = 8 * HTB, NXCD = 8, WGM = 8;
__host__ __device__ __forceinline__ int lds_byte(int r, int c) { const int st = (r >> 4) * 2 + (c >> 5), rr = r & 15, cc = c & 31, ob = rr * 64 + cc * 2; return st * 1024 + (ob ^ (((ob >> 9) & 1) << 5)); }
__host__ __device__ __forceinline__ int perm32(int rho) { const int n = rho >> 4, i = rho & 15; return 8 * (i >> 2) + 4 * n + (i & 3); }
__host__ __device__ __forceinline__ void stage_rc(int b, int& R, int& C) { const int st = b / 1024, sb = b % 1024, swz = sb ^ (((sb >> 9) & 1) << 5); R = (st >> 1) * 16 + swz / 64; C = (st & 1) * 32 + (swz % 64) / 2; }
struct Unit { int pm, pn; };
struct Gemm { const f16* A; const f16* Bt; int M, N, K; };
struct StaticOrder {
    int nM, nN, nwg, G, c;
    __host__ __device__ void init(int M, int N, int G_, int c_) { nM = M / BM; nN = N / BM; nwg = nM * nN; G = G_; c = c_; }
    __host__ __device__ bool next(int i, Unit& u) const {
        const long Lx = (long)i * G + c; if (Lx >= nwg) return false;
        int wgid = (int)Lx; { const int q = nwg / NXCD, r = nwg % NXCD, xcd = wgid % NXCD, off = wgid / NXCD; wgid = (xcd < r ? xcd * (q + 1) : r * (q + 1) + (xcd - r) * q) + off; }
        const int nig = WGM * nN, gid = wgid / nig, fm = gid * WGM, gsz = (nM - fm) < WGM ? (nM - fm) : WGM;
        u.pm = fm + ((wgid % nig) % gsz); u.pn = (wgid % nig) / gsz; return true;
    }
};
template <class Epi>
__device__ __forceinline__ void gemm_phase(LAS unsigned char* lds, const Gemm g, const StaticOrder& S, const Epi& E) {
    int tid_ = threadIdx.x; asm volatile("" : "+v"(tid_));
    const int tid = tid_, wid = __builtin_amdgcn_readfirstlane(tid >> 6), lane = tid & 63, wr = wid >> 2, wc = wid & 3, fr = lane & 15, fq = lane >> 4;
    const int K = g.K, nt = K / BK;
    unsigned voffA[2], voffB[2];
#pragma unroll
    for (int i = 0; i < 2; ++i) { int R, C; stage_rc(tid * 16 + i * 8192, R, C); const int Rb = (R & ~31) + perm32(R & 31); voffA[i] = (unsigned)(R * K + C) * 2u; voffB[i] = (unsigned)(Rb * K + C) * 2u; }
    const size_t kstep = (size_t)(BK * 2);
    const size_t hstep = (size_t)HALF * K * 2;
    const size_t tstep = 2 * hstep;
    const unsigned ldsw = (unsigned)wid * 1024u;
    const int aoff = lds_byte(wr * 64 + fr, fq * 8), boff = lds_byte(wc * 32 + fr, fq * 8);
#define PG8_SA(b, h) (((b) * 2 + (h)) * HTB)
#define PG8_SB(b, h) ((4 + (b) * 2 + (h)) * HTB)
#define PG8_STAGE(bufoff, gbase, voff) do { _Pragma("unroll") for (int _i = 0; _i < 2; ++_i) \
        __builtin_amdgcn_global_load_lds((const unsigned*)((const char*)(gbase) + (voff)[_i]), (LAS unsigned*)(lds + (bufoff) + ldsw + _i * 8192), 16, 0, 0); } while (0)
#define PG8_LDA(dst, b, h) do { _Pragma("unroll") for (int m = 0; m < 4; ++m) _Pragma("unroll") for (int k = 0; k < 2; ++k) dst[m][k] = *(const LAS half8*)(lds + PG8_SA(b, h) + aoff + m * 2048 + k * 1024); } while (0)
#define PG8_LDB(dst, b, h) do { _Pragma("unroll") for (int n = 0; n < 2; ++n) _Pragma("unroll") for (int k = 0; k < 2; ++k) dst[n][k] = *(const LAS half8*)(lds + PG8_SB(b, h) + boff + n * 2048 + k * 1024); } while (0)
#define PG8_MMA(ai, bj, At, Bt) do { __builtin_amdgcn_s_setprio(1); _Pragma("unroll") for (int m = 0; m < 4; ++m) _Pragma("unroll") for (int n = 0; n < 2; ++n) _Pragma("unroll") for (int k = 0; k < 2; ++k) \
        acc[ai][bj][m][n] = __builtin_amdgcn_mfma_f32_16x16x32_f16(Bt[n][k], At[m][k], acc[ai][bj][m][n], 0, 0, 0); __builtin_amdgcn_s_setprio(0); } while (0)
#define PG8_WAIT_V(n) asm volatile("s_waitcnt vmcnt(" #n ")" ::: "memory")
#define PG8_WAIT_L(n) asm volatile("s_waitcnt lgkmcnt(" #n ")" ::: "memory")
#define PG8_BAR __builtin_amdgcn_s_barrier()
#define PG8_SCHED __builtin_amdgcn_sched_barrier(0)
    Unit cur, nxt; int ui = 0;
    if (!S.next(0, cur)) return;
    f32x4 acc[2][2][4][2];
#pragma unroll
    for (int a = 0; a < 2; ++a)
#pragma unroll
        for (int b = 0; b < 2; ++b)
#pragma unroll
            for (int m = 0; m < 4; ++m)
#pragma unroll
                for (int n = 0; n < 2; ++n) acc[a][b][m][n] = (f32x4){0.f, 0.f, 0.f, 0.f};
    half8 At[4][2], B0[2][2], B1[2][2];
    const char* cA = (const char*)g.A + (size_t)cur.pm * tstep; const char* cB = (const char*)g.Bt + (size_t)cur.pn * tstep;
    PG8_STAGE(PG8_SB(0, 0), cB, voffB); PG8_STAGE(PG8_SA(0, 0), cA, voffA); PG8_STAGE(PG8_SB(0, 1), cB + hstep, voffB); PG8_STAGE(PG8_SA(0, 1), cA + hstep, voffA);
    if (wr == 1) PG8_BAR;
    PG8_WAIT_V(4); PG8_BAR;
    PG8_STAGE(PG8_SB(1, 0), cB + kstep, voffB); PG8_STAGE(PG8_SA(1, 0), cA + kstep, voffA); PG8_STAGE(PG8_SB(1, 1), cB + hstep + kstep, voffB);
    PG8_WAIT_V(6); PG8_BAR;
    for (;;) {
        const bool has_next = S.next(ui + 1, nxt);
        const char* nA = has_next ? (const char*)g.A + (size_t)nxt.pm * tstep : cA; const char* nB = has_next ? (const char*)g.Bt + (size_t)nxt.pn * tstep : cB;
        for (int t = 0; t < nt; t += 2) {
            const bool last = (t == nt - 2);
            const char* a1 = cA + (size_t)(t + 1) * kstep;
            const char* a2 = last ? nA : cA + (size_t)(t + 2) * kstep; const char* b2 = last ? nB : cB + (size_t)(t + 2) * kstep;
            const char* a3 = a2 + kstep; const char* b3 = b2 + kstep;
            PG8_LDB(B0, 0, 0); PG8_SCHED; PG8_LDA(At, 0, 0); PG8_STAGE(PG8_SA(1, 1), a1 + hstep, voffA);
            PG8_WAIT_L(8); PG8_BAR; PG8_WAIT_L(0); PG8_MMA(0, 0, At, B0); PG8_BAR; PG8_SCHED;
            PG8_LDB(B1, 0, 1); PG8_STAGE(PG8_SB(0, 0), b2, voffB);
            PG8_BAR; PG8_WAIT_L(0); PG8_MMA(0, 1, At, B1); PG8_BAR;
            PG8_LDA(At, 0, 1); PG8_STAGE(PG8_SA(0, 0), a2, voffA);
            PG8_BAR; PG8_WAIT_L(0); PG8_MMA(1, 0, At, B0); PG8_BAR; PG8_SCHED;
            PG8_STAGE(PG8_SB(0, 1), b2 + hstep, voffB);
            PG8_WAIT_V(6); PG8_BAR; PG8_MMA(1, 1, At, B1); PG8_BAR;
            PG8_LDB(B0, 1, 0); PG8_SCHED; PG8_LDA(At, 1, 0); PG8_STAGE(PG8_SA(0, 1), a2 + hstep, voffA);
            PG8_WAIT_L(8); PG8_BAR; PG8_WAIT_L(0); PG8_MMA(0, 0, At, B0); PG8_BAR; PG8_SCHED;
            PG8_LDB(B1, 1, 1); PG8_STAGE(PG8_SB(1, 0), b3, voffB);
            PG8_BAR; PG8_WAIT_L(0); PG8_MMA(0, 1, At, B1); PG8_BAR;
            PG8_LDA(At, 1, 1); PG8_STAGE(PG8_SA(1, 0), a3, voffA);
            PG8_BAR; PG8_WAIT_L(0); PG8_MMA(1, 0, At, B0); PG8_BAR; PG8_SCHED;
            PG8_STAGE(PG8_SB(1, 1), b3 + hstep, voffB);
            PG8_WAIT_V(6); PG8_BAR; PG8_MMA(1, 1, At, B1); PG8_BAR;
        }
        E(acc, cur, wr, wc, fr, fq);
        if (!has_next) break;
#pragma unroll
        for (int a = 0; a < 2; ++a)
#pragma unroll
            for (int b = 0; b < 2; ++b)
#pragma unroll
                for (int m = 0; m < 4; ++m)
#pragma unroll
                    for (int n = 0; n < 2; ++n) acc[a][b][m][n] = (f32x4){0.f, 0.f, 0.f, 0.f};
        cur = nxt; cA = nA; cB = nB; ++ui;
    }
    PG8_WAIT_V(0);
    if (wr == 0) PG8_BAR;
    PG8_BAR;
#undef PG8_SA
#undef PG8_SB
#undef PG8_STAGE
#undef PG8_LDA
#undef PG8_LDB
#undef PG8_MMA
#undef PG8_WAIT_V
#undef PG8_WAIT_L
#undef PG8_BAR
#undef PG8_SCHED
}
}

__device__ __forceinline__ float silu_f(float v) { return v * __builtin_amdgcn_rcpf(1.0f + __expf(-v)); }
__device__ __forceinline__ half4 to_half4(f32x4 v) { half4 h; h[0] = (f16)v[0]; h[1] = (f16)v[1]; h[2] = (f16)v[2]; h[3] = (f16)v[3]; return h; }

__device__ __forceinline__ float row_rstd(const float* ss, int np, int row) {
    float s;
    if (np == 1) s = ss[row];
    else { const f32x4* p = (const f32x4*)(ss + (size_t)row * 16); const f32x4 a = p[0], b = p[1], c = p[2], d = p[3];
        s = (((a[0] + a[1]) + (a[2] + a[3])) + ((b[0] + b[1]) + (b[2] + b[3]))) + (((c[0] + c[1]) + (c[2] + c[3])) + ((d[0] + d[1]) + (d[2] + d[3]))); }
    return rsqrtf(s * (1.0f / D) + EPS);
}
struct EpiSwiglu {
    f16* G; const float* ss; int np;
    __device__ __forceinline__ void operator()(const f32x4 (&acc)[2][2][4][2], const pg8::Unit& u, int wr, int wc, int fr_, int fq_) const {
        int fr = fr_, fq = fq_; asm volatile("" : "+v"(fr), "+v"(fq));
#pragma unroll
        for (int ai = 0; ai < 2; ++ai)
#pragma unroll
            for (int m = 0; m < 4; ++m) {
                const int row = u.pm * 256 + ai * 128 + wr * 64 + m * 16 + fr;
                const float rs = row_rstd(ss, np, row), ce = -1.4426950408889634f * rs, rs2 = rs * rs; half8 o;
#pragma unroll
                for (int n = 0; n < 2; ++n) {
                    const f32x4 g = acc[ai][0][m][n], u = acc[ai][1][m][n]; const f32x4 t = g * ce; f32x4 e, r;
#pragma unroll
                    for (int j = 0; j < 4; ++j) e[j] = __builtin_amdgcn_exp2f(t[j]);
                    const f32x4 d = e + 1.0f;
#pragma unroll
                    for (int j = 0; j < 4; ++j) r[j] = __builtin_amdgcn_rcpf(d[j]);
                    const f32x4 w = (g * u) * (r * rs2);
#pragma unroll
                    for (int j = 0; j < 4; ++j) o[4 * n + j] = (f16)w[j];
                }
                *(half8*)(G + (size_t)row * DFF + u.pn * 128 + wc * 32 + 8 * fq) = o;
            }
    }
};
template <bool SRC16> struct EpiResid {
    const void* src; f16* h16; float* ss; float alpha;
    __device__ __forceinline__ void operator()(const f32x4 (&acc)[2][2][4][2], const pg8::Unit& u, int wr, int wc, int fr_, int fq_) const {
        int fr = fr_, fq = fq_; asm volatile("" : "+v"(fr), "+v"(fq));
#pragma unroll
        for (int ai = 0; ai < 2; ++ai)
#pragma unroll
            for (int m = 0; m < 4; ++m) {
                const int row = u.pm * 256 + ai * 128 + wr * 64 + m * 16 + fr; float part = 0.f;
#pragma unroll
                for (int bj = 0; bj < 2; ++bj) {
                    const size_t off = (size_t)row * D + u.pn * 256 + bj * 128 + wc * 32 + 8 * fq; half8 h; f32x4 sv[2];
                    if (SRC16) { const half8 s8 = *(const half8*)((const f16*)src + off);
#pragma unroll
                        for (int j = 0; j < 4; ++j) { sv[0][j] = (float)s8[j]; sv[1][j] = (float)s8[4 + j]; } }
                    else { sv[0] = *(const f32x4*)((const float*)src + off); sv[1] = *(const f32x4*)((const float*)src + off + 4); }
#pragma unroll
                    for (int n = 0; n < 2; ++n) {
                        const f32x4 o = sv[n] + alpha * acc[ai][bj][m][n];
#pragma unroll
                        for (int j = 0; j < 4; ++j) h[4 * n + j] = (f16)o[j];
                        part += (o[0] * o[0] + o[1] * o[1]) + (o[2] * o[2] + o[3] * o[3]);
                    }
                    *(half8*)(h16 + off) = h;
                }
                part += __shfl_xor(part, 16); part += __shfl_xor(part, 32);
                if (fq == 0) ss[(size_t)row * 16 + u.pn * 4 + wc] = part;
            }
    }
};
constexpr float KV_SCALE = 16.0f;
constexpr float K_I8_SCALE = 127.0f / 8.0f;
__device__ __forceinline__ unsigned pack_fp8x4(f32x4 v) {
#pragma unroll
    for (int j = 0; j < 4; ++j) v[j] = fminf(fmaxf(v[j], -448.f), 448.f);
    int w = __builtin_amdgcn_cvt_pk_fp8_f32(v[0], v[1], 0, false); w = __builtin_amdgcn_cvt_pk_fp8_f32(v[2], v[3], w, true); return (unsigned)w;
}
__device__ __forceinline__ void rope8(const f32x4 (&x1)[2], const f32x4 (&x2)[2], const f32x2* rp, float sc, float (&o1)[8], float (&o2)[8]) {
#pragma unroll
    for (int n = 0; n < 2; ++n) {
        const f32x4 cs0 = *(const f32x4*)(rp + 4 * n), cs1 = *(const f32x4*)(rp + 4 * n + 2);
        o1[4 * n + 0] = (x1[n][0] * cs0[0] - x2[n][0] * cs0[1]) * sc; o2[4 * n + 0] = (x2[n][0] * cs0[0] + x1[n][0] * cs0[1]) * sc;
        o1[4 * n + 1] = (x1[n][1] * cs0[2] - x2[n][1] * cs0[3]) * sc; o2[4 * n + 1] = (x2[n][1] * cs0[2] + x1[n][1] * cs0[3]) * sc;
        o1[4 * n + 2] = (x1[n][2] * cs1[0] - x2[n][2] * cs1[1]) * sc; o2[4 * n + 2] = (x2[n][2] * cs1[0] + x1[n][2] * cs1[1]) * sc;
        o1[4 * n + 3] = (x1[n][3] * cs1[2] - x2[n][3] * cs1[3]) * sc; o2[4 * n + 3] = (x2[n][3] * cs1[2] + x1[n][3] * cs1[3]) * sc;
    }
}
__device__ __forceinline__ u32x2 pack_i8x8(const float (&v)[8]) {
    u32x2 r;
#pragma unroll
    for (int w = 0; w < 2; ++w) { unsigned word = 0u;
#pragma unroll
        for (int j = 0; j < 4; ++j) { const int q = (int)__builtin_rintf(fminf(fmaxf(v[4 * w + j] * K_I8_SCALE, -127.f), 127.f)); word |= ((unsigned)q & 0xffu) << (8 * j); }
        r[w] = word; }
    return r;
}
__device__ __forceinline__ u32x2 pack_bf8x8(const float (&v)[8]) {
    u32x2 r;
#pragma unroll
    for (int w = 0; w < 2; ++w) { int word = __builtin_amdgcn_cvt_pk_bf8_f32(v[4 * w], v[4 * w + 1], 0, false); word = __builtin_amdgcn_cvt_pk_bf8_f32(v[4 * w + 2], v[4 * w + 3], word, true); r[w] = (unsigned)word; }
    return r;
}
__device__ __forceinline__ u32x2 pack_fp8x8(const float (&v)[8]) { u32x2 r; r[0] = pack_fp8x4((f32x4){v[0], v[1], v[2], v[3]}); r[1] = pack_fp8x4((f32x4){v[4], v[5], v[6], v[7]}); return r; }
struct EpiInProj {
    const float* ss; const f32x2* rope; unsigned char* ws;
    __device__ __forceinline__ void operator()(const f32x4 (&acc)[2][2][4][2], const pg8::Unit& u, int wr, int wc, int fr_, int fq_) const {
        int fr = fr_, fq = fq_; asm volatile("" : "+v"(fr), "+v"(fq));
        const int pn = u.pn;
        if (pn >= 8 && pn <= 11) {
            unsigned char* lb = (pn <= 9) ? ws + WS_KV + (size_t)((pn - 8) * 4 + wc) * LP * 128 + 8 * fq
                                          : ws + WS_KV + (size_t)((pn - 10) * 4 + (wc >> 1)) * LP * 128 + 64 + (wc & 1) * 32 + 8 * fq;
#pragma unroll
            for (int ai = 0; ai < 2; ++ai)
#pragma unroll
                for (int m = 0; m < 4; ++m) {
                    const int p = u.pm * 256 + ai * 128 + wr * 64 + m * 16 + fr;
                    const int t = p < SEQ ? p + NMETA : p - SEQ;
                    if (p < L) {
                        const float sc = row_rstd(ss, 16, p);
                        if (pn <= 9) {
                            float o1[8], o2[8]; rope8(acc[ai][0][m], acc[ai][1][m], rope + (size_t)t * 32 + 8 * fq, sc, o1, o2);
                            unsigned char* d8 = lb + (size_t)t * 128; *(u32x2*)d8 = pack_i8x8(o1); *(u32x2*)(d8 + 32) = pack_i8x8(o2);
                        } else {
#pragma unroll
                            for (int bj = 0; bj < 2; ++bj) { float v[8];
#pragma unroll
                                for (int j = 0; j < 4; ++j) { v[j] = acc[ai][bj][m][0][j] * sc; v[4 + j] = acc[ai][bj][m][1][j] * sc; }
                                *(u32x2*)(lb + (size_t)t * 128 + (size_t)bj * 2 * LP * 128) = pack_bf8x8(v); }
                        }
                    }
                    asm volatile("" ::: "memory");
                }
            return;
        }
        int mode = 0, stride = 256; float scale = 1.0f; f16* lanebase;
        if (pn == 0) lanebase = (f16*)(ws + WS_GQ) + wc * 32 + 8 * fq;
        else if (pn == 1) lanebase = (f16*)(ws + WS_GK) + wc * 32 + 8 * fq;
        else if (pn <= 3) { lanebase = (f16*)(ws + WS_GV) + (pn - 2) * 256 + wc * 32 + 8 * fq; stride = 512; }
        else if (pn <= 5) { lanebase = (f16*)(ws + WS_GR) + (pn - 4) * 256 + wc * 32 + 8 * fq; stride = 512; }
        else if (pn <= 7) { lanebase = (f16*)(ws + WS_DQ) + (pn - 6) * 256 + wc * 64 + 8 * fq; stride = 512; mode = 1; scale = 0.125f; }
        else if (pn <= 13) { lanebase = (f16*)(ws + WS_IQ) + (pn - 12) * 256 + wc * 64 + 8 * fq; stride = 512; mode = 1; scale = 0.125f; }
        else { lanebase = (f16*)(ws + WS_IK) + 8 * fq; stride = 64; mode = wc == 0 ? 1 : (wc == 1 ? 2 : 3); }
#pragma unroll
        for (int ai = 0; ai < 2; ++ai)
#pragma unroll
            for (int m = 0; m < 4; ++m) {
                const int p = u.pm * 256 + ai * 128 + wr * 64 + m * 16 + fr;
                const int t = p < SEQ ? p + NMETA : p - SEQ;
                if (p < L && mode != 3) {
                    const float rs = row_rstd(ss, 16, p);
                    if (mode == 1) {
                        float o1[8], o2[8]; rope8(acc[ai][0][m], acc[ai][1][m], rope + (size_t)t * 32 + 8 * fq, rs * scale, o1, o2);
                        half8 h1, h2;
#pragma unroll
                        for (int j = 0; j < 8; ++j) { h1[j] = (f16)o1[j]; h2[j] = (f16)o2[j]; }
                        f16* dst = lanebase + (size_t)t * stride; *(half8*)dst = h1; *(half8*)(dst + 32) = h2;
                    } else if (mode == 2) {
                        if (fq < 2) { float* gp = (float*)(ws + WS_GA) + (size_t)t * 16 + 8 * fq; *(f32x4*)gp = acc[ai][0][m][0] * rs; *(f32x4*)(gp + 4) = acc[ai][0][m][1] * rs; }
                        else if (fq == 2) { float* ip = (float*)(ws + WS_IW) + (size_t)t * 8; const float r2 = rs * 0.35355339059327373f; *(f32x4*)ip = acc[ai][0][m][0] * r2; *(f32x4*)(ip + 4) = acc[ai][0][m][1] * r2; }
                    } else {
#pragma unroll
                        for (int bj = 0; bj < 2; ++bj) { half8 h;
#pragma unroll
                            for (int j = 0; j < 4; ++j) { h[j] = (f16)(acc[ai][bj][m][0][j] * rs); h[4 + j] = (f16)(acc[ai][bj][m][1][j] * rs); }
                            *(half8*)(lanebase + (size_t)t * stride + bj * 128) = h; }
                    }
                }
                asm volatile("" ::: "memory");
            }
    }
};

__device__ __forceinline__ const float* w_src(const Params& P, int kind, int n, int& ld, const float*& gain) {
    switch (kind) {
    case 0: case 4: { const int pn = n >> 8, bj = (n >> 7) & 1, cc = n & 127; ld = DFF; gain = kind == 0 ? P.n1 : P.n2;
        const float* w = kind == 0 ? (bj ? P.wu1 : P.wg1) : (bj ? P.wu2 : P.wg2); return w + pn * 128 + cc; }
    case 1: ld = D; gain = nullptr; return P.wd1 + n;
    case 5: ld = D; gain = nullptr; return P.wd2 + n;
    case 3: ld = D; gain = nullptr; return P.wout + n;
    default: { ld = 3672; gain = P.nmix; const int pn = n >> 8, c = n & 255, bj = c >> 7, hh = (c >> 5) & 3, dd = c & 31; int j;
        if (pn == 0) j = c; else if (pn == 1) j = 256 + c; else if (pn <= 3) j = 512 + (pn - 2) * 256 + c; else if (pn <= 5) j = 1024 + (pn - 4) * 256 + c;
        else if (pn <= 7) j = 1552 + (pn - 6) * 256 + hh * 64 + bj * 32 + dd;
        else if (pn <= 9) j = 2064 + (pn - 8) * 256 + hh * 64 + bj * 32 + dd;
        else if (pn <= 11) j = 2576 + (pn - 10) * 256 + c;
        else if (pn <= 13) j = 3088 + (pn - 12) * 256 + hh * 64 + bj * 32 + dd;
        else { if (c < 32) j = 3600 + c; else if (c < 48) j = 1536 + (c - 32); else if (c < 56) j = 3664 + (c - 48); else if (c >= 128 && c < 160) j = 3600 + 32 + (c - 128); else j = -1; }
        return j < 0 ? nullptr : P.win + j; }
    }
}
__device__ __forceinline__ void prep_weight(const Params& P, const int kind, const int N, const int K, f16* dst, int& cursor, int& tbase, LAS f16* tl) {
    const int tid = threadIdx.x, G = gridDim.x, tn = N / 64, tk = K / 256, ntile = tn * tk;
#pragma unroll 1
    for (; cursor < tbase + ntile; cursor += G) {
        const int tI = cursor - tbase, n0 = (tI % tn) * 64, k0 = (tI / tn) * 256;
        { const int n = tid & 63, kk0 = tid >> 6; int ld; const float* gain; const float* col = w_src(P, kind, n0 + n, ld, gain);
          float v[32];
#pragma unroll
          for (int i = 0; i < 32; ++i) v[i] = col ? col[(size_t)(k0 + kk0 + 8 * i) * ld] : 0.f;
          if (gain) {
#pragma unroll
              for (int i = 0; i < 32; ++i) v[i] *= gain[k0 + kk0 + 8 * i];
          }
#pragma unroll
          for (int i = 0; i < 32; ++i) tl[n * 264 + kk0 + 8 * i] = (f16)v[i]; }
        __syncthreads();
        { const int n = tid >> 3, seg = tid & 7;
#pragma unroll
          for (int j = 0; j < 4; ++j) *(half8*)(dst + (size_t)(n0 + n) * K + k0 + (seg + 8 * j) * 8) = *(const LAS half8*)(tl + n * 264 + (seg + 8 * j) * 8); }
        __syncthreads();
    }
    tbase += ntile;
}
__device__ __forceinline__ void p0_prologue(const Params& P, LAS unsigned char* lds) {
    const int tid = threadIdx.x, bid = blockIdx.x, G = gridDim.x, lane = tid & 63;
    unsigned char* ws = P.ws;
    int tbase = 0, cursor = bid;
    LAS f16* tl = (LAS f16*)lds;
    prep_weight(P, 0, 2 * DFF, D, (f16*)(ws + WS_WGU1), cursor, tbase, tl);
    prep_weight(P, 1, D, DFF, (f16*)(ws + WS_WD1), cursor, tbase, tl);
    prep_weight(P, 2, NIN, D, (f16*)(ws + WS_WIN), cursor, tbase, tl);
    float* ss0 = (float*)(ws + WS_SS0);
    f16* acta = (f16*)(ws + WS_ACTA);
    const int gw = bid * 8 + (tid >> 6), nw = G * 8;
    for (int p = gw; p < L; p += nw) {
        const float* src = p < SEQ ? P.x + (size_t)p * D : P.meta + (size_t)(p - SEQ) * D; float s = 0.f;
#pragma unroll
        for (int i = 0; i < 4; ++i) { const f32x4 v = *(const f32x4*)(src + lane * 4 + 256 * i); s += (v[0] * v[0] + v[1] * v[1]) + (v[2] * v[2] + v[3] * v[3]); *(half4*)(acta + (size_t)p * D + lane * 4 + 256 * i) = to_half4(v); }
#pragma unroll
        for (int o = 32; o >= 1; o >>= 1) s += __shfl_xor(s, o);
        if (lane == 0) ss0[p] = s;
    }
    const int gt = bid * NTHREADS + tid, ngt = G * NTHREADS;
    for (int i = gt; i < MP; i += ngt) { if (i >= L) ss0[i] = (float)D; }
    f32x2* rope = (f32x2*)(ws + WS_ROPE);
    for (int i = gt; i < L * 32; i += ngt) { const int t = i >> 5, f = i & 31; const double inv = exp(-(double)f * (9.210340371976184 / 32.0)); double sn, cs; sincos((double)t * inv, &sn, &cs); rope[i] = (f32x2){(float)cs, (float)sn}; }
}

__device__ __forceinline__ void meta_down(const Params& P, LAS unsigned char* lds) {
    const int tid = threadIdx.x, lane = tid & 63, wid = tid >> 6;
    const f16* Gm = (const f16*)(P.ws + WS_G) + (size_t)SEQ * DFF; const f16* Wt = (const f16*)(P.ws + WS_WD1);
    f16* acta = (f16*)P.out; float* ss1 = (float*)(P.ws + WS_SS1); LAS float* slot = (LAS float*)lds;
    for (int task = blockIdx.x; task < NMETA * 16; task += gridDim.x) {
        const int r = task >> 4, cg = task & 15; float part = 0.f;
#pragma unroll 1
        for (int q = 0; q < 2; ++q) {
            const int n0 = cg * 64 + (2 * wid + q) * 4; float a[4] = {0.f, 0.f, 0.f, 0.f};
            for (int kc = lane; kc < DFF / 8; kc += 64) {
                const half8 gv = *(const half8*)(Gm + (size_t)r * DFF + kc * 8);
#pragma unroll
                for (int j = 0; j < 4; ++j) { const half8 wv = *(const half8*)(Wt + (size_t)(n0 + j) * DFF + kc * 8);
#pragma unroll
                    for (int e = 0; e < 8; ++e) a[j] += (float)gv[e] * (float)wv[e]; }
            }
#pragma unroll
            for (int o = 32; o >= 1; o >>= 1) { a[0] += __shfl_xor(a[0], o); a[1] += __shfl_xor(a[1], o); a[2] += __shfl_xor(a[2], o); a[3] += __shfl_xor(a[3], o); }
            f32x4 o;
#pragma unroll
            for (int j = 0; j < 4; ++j) { o[j] = P.meta[r * D + n0 + j] + 0.5f * a[j]; part += o[j] * o[j]; }
            if (lane == 0) *(half4*)(acta + (size_t)(SEQ + r) * D + n0) = to_half4(o);
        }
        if (lane == 0) slot[wid] = part;
        __syncthreads();
        if (tid == 0) { float s = 0.f; for (int w = 0; w < 8; ++w) s += slot[w]; ss1[(size_t)(SEQ + r) * 16 + cg] = s; }
        __syncthreads();
    }
}

__device__ __forceinline__ float logsigmoid_f(float z) { return fminf(z, 0.f) - __logf(1.0f + __expf(-fabsf(z))); }
__device__ __forceinline__ void gla_gates(const Params& P, int c, int h, LAS float* bl) {
    const int tid = threadIdx.x, ti = tid >> 3, d0 = (tid & 7) * 8, tt = 64 * c - 48 + ti; const float* GA = (const float*)(P.ws + WS_GA);
    {
        float z[8];
        if (tt >= 0 && tt < L) {
            const f32x4 b0 = *(const f32x4*)(P.ba + 64 * h + d0), b1 = *(const f32x4*)(P.ba + 64 * h + d0 + 4);
#pragma unroll
            for (int m = 0; m < 4; ++m) { z[m] = b0[m]; z[4 + m] = b1[m]; }
            f32x4 a4[4];
#pragma unroll
            for (int q = 0; q < 4; ++q) a4[q] = *(const f32x4*)(GA + (size_t)tt * 16 + 4 * q);
#pragma unroll
            for (int r = 0; r < 16; ++r) { const float ar = a4[r >> 2][r & 3]; const f32x4 w0 = *(const f32x4*)(P.wa2 + r * 256 + 64 * h + d0), w1 = *(const f32x4*)(P.wa2 + r * 256 + 64 * h + d0 + 4);
#pragma unroll
                for (int m = 0; m < 4; ++m) { z[m] += ar * w0[m]; z[4 + m] += ar * w1[m]; } }
#pragma unroll
            for (int m = 0; m < 8; ++m) z[m] = logsigmoid_f(z[m]) * (1.0f / 16.0f);
        } else {
#pragma unroll
            for (int m = 0; m < 8; ++m) z[m] = 0.f;
        }
#pragma unroll
        for (int m = 0; m < 8; ++m) bl[ti * 65 + d0 + m] = z[m];
    }
    __syncthreads();
    {
        const int d = tid & 63, seg = tid >> 6; float v[8], run = 0.f;
#pragma unroll
        for (int i = 0; i < 8; ++i) { run += bl[(seg * 8 + i) * 65 + d]; v[i] = run; }
#pragma unroll
        for (int i = 0; i < 8; ++i) bl[(seg * 8 + i) * 65 + d] = v[i];
        __syncthreads();
        float off = 0.f;
#pragma unroll
        for (int sg = 0; sg < 7; ++sg) off += (sg < seg) ? bl[(sg * 8 + 7) * 65 + d] : 0.f;
        __syncthreads();
#pragma unroll
        for (int i = 0; i < 8; ++i) bl[(seg * 8 + i) * 65 + d] = v[i] + off;
    }
    __syncthreads();
}
__device__ __forceinline__ void gla_a_unit(const Params& P, int unit, LAS unsigned char* lds) {
    int tid_ = threadIdx.x; asm volatile("" : "+v"(tid_));
    const int tid = tid_, lane = tid & 63, wid = tid >> 6, c = unit >> 2, h = unit & 3;
    LAS float* bl = (LAS float*)lds; LAS float* ks = bl + 4160; LAS float* vs = ks + 4096;
    const f16* GK = (const f16*)(P.ws + WS_GK); const f16* GV = (const f16*)(P.ws + WS_GV);
    float* U = (float*)(P.ws + WS_US); float* DEC = (float*)(P.ws + WS_DECAY);
    const int ti = tid >> 3, d0 = (tid & 7) * 8, tt = 64 * c - 48 + ti; const bool tv = tt >= 0 && tt < L;
    half8 k8, v8[2];
#pragma unroll
    for (int m = 0; m < 8; ++m) { k8[m] = (f16)0.f; v8[0][m] = (f16)0.f; v8[1][m] = (f16)0.f; }
    if (tv) k8 = *(const half8*)(GK + (size_t)tt * 256 + 64 * h + d0);
#pragma unroll
    for (int q = 0; q < 2; ++q) { const int ch = tid + 512 * q, j = ch >> 4, t = 64 * c - 48 + j; if (t >= 0 && t < L) v8[q] = *(const half8*)(GV + (size_t)t * 512 + 128 * h + (ch & 15) * 8); }
    gla_gates(P, c, h, bl);
    { f32x4 o0, o1;
#pragma unroll
      for (int m = 0; m < 4; ++m) { o0[m] = (float)k8[m] * __expf(bl[63 * 65 + d0 + m] - bl[ti * 65 + d0 + m]); o1[m] = (float)k8[4 + m] * __expf(bl[63 * 65 + d0 + 4 + m] - bl[ti * 65 + d0 + 4 + m]); }
      *(LAS f32x4*)(ks + ti * 64 + d0) = o0; *(LAS f32x4*)(ks + ti * 64 + d0 + 4) = o1; }
#pragma unroll
    for (int q = 0; q < 2; ++q) { const int ch = tid + 512 * q, j = ch >> 4, e0 = (ch & 15) * 8; f32x4 o0, o1;
#pragma unroll
        for (int m = 0; m < 4; ++m) { o0[m] = (float)v8[q][m]; o1[m] = (float)v8[q][4 + m]; }
        *(LAS f32x4*)(vs + j * 128 + e0) = o0; *(LAS f32x4*)(vs + j * 128 + e0 + 4) = o1; }
    if (tid < 64) DEC[(size_t)c * 256 + h * 64 + tid] = __expf(bl[63 * 65 + tid]);
    __syncthreads();
    { const int dd0 = (wid >> 2) * 32, e0 = (wid & 3) * 32, l31 = lane & 31, hf = lane >> 5; f32x16 acc;
#pragma unroll
      for (int i = 0; i < 16; ++i) acc[i] = 0.f;
#pragma unroll 8
      for (int s = 0; s < 32; ++s) acc = __builtin_amdgcn_mfma_f32_32x32x2f32(ks[(2 * s + hf) * 64 + dd0 + l31], vs[(2 * s + hf) * 128 + e0 + l31], acc, 0, 0, 0);
      float* up = U + ((size_t)unit * 64) * 128;
#pragma unroll
      for (int r = 0; r < 16; ++r) { const int row = (r & 3) + 8 * (r >> 2) + 4 * hf; up[(size_t)(dd0 + row) * 128 + e0 + l31] = acc[r]; } }
    __syncthreads();
}
__device__ __forceinline__ void gla_scan(const Params& P) {
    float* U = (float*)(P.ws + WS_US); const float* DEC = (const float*)(P.ws + WS_DECAY);
    const int idx = blockIdx.x * NTHREADS + threadIdx.x;
    if (idx >= 32768) return;
    float s = 0.f;
#pragma unroll 8
    for (int c = 0; c < NCH; ++c) { const float u = U[(size_t)c * 32768 + idx], dc = DEC[(size_t)c * 256 + (idx >> 7)]; U[(size_t)c * 32768 + idx] = s; s = dc * s + u; }
}
__device__ __forceinline__ void gla_c_unit(const Params& P, int unit, LAS unsigned char* lds) {
    int tid_ = threadIdx.x; asm volatile("" : "+v"(tid_));
    const int tid = tid_, lane = tid & 63, wid = tid >> 6, c = unit >> 2, h = unit & 3, l31 = lane & 31, hf = lane >> 5;
    LAS float* bl = (LAS float*)lds; LAS float* kk = bl + 4160; LAS float* qs = kk + 4160; LAS float* As = qs + 4160; LAS float* vs = As + 4160; LAS float* Ss = vs + 8192; LAS float* os = bl;
    const f16* GQ = (const f16*)(P.ws + WS_GQ); const f16* GK = (const f16*)(P.ws + WS_GK); const f16* GV = (const f16*)(P.ws + WS_GV); const f16* GR = (const f16*)(P.ws + WS_GR);
    const float* Sg = (const float*)(P.ws + WS_US) + (size_t)unit * 8192; f16* mix = (f16*)(P.ws + WS_ACTA);
    const int ti = tid >> 3, d0 = (tid & 7) * 8, tt = 64 * c - 48 + ti; const bool tv = tt >= 0 && tt < L;
    half8 q8, k8, v8[2], r8[2]; f32x4 sreg[4];
#pragma unroll
    for (int m = 0; m < 8; ++m) { q8[m] = (f16)0.f; k8[m] = (f16)0.f; v8[0][m] = (f16)0.f; v8[1][m] = (f16)0.f; r8[0][m] = (f16)0.f; r8[1][m] = (f16)0.f; }
    if (tv) { q8 = *(const half8*)(GQ + (size_t)tt * 256 + 64 * h + d0); k8 = *(const half8*)(GK + (size_t)tt * 256 + 64 * h + d0);
        r8[0] = *(const half8*)(GR + (size_t)tt * 512 + 128 * h + (tid & 7) * 16); r8[1] = *(const half8*)(GR + (size_t)tt * 512 + 128 * h + (tid & 7) * 16 + 8); }
#pragma unroll
    for (int q = 0; q < 2; ++q) { const int ch = tid + 512 * q, j = ch >> 4, t = 64 * c - 48 + j; if (t >= 0 && t < L) v8[q] = *(const half8*)(GV + (size_t)t * 512 + 128 * h + (ch & 15) * 8); }
#pragma unroll
    for (int q = 0; q < 4; ++q) sreg[q] = *(const f32x4*)(Sg + (size_t)(tid + 512 * q) * 4);
    gla_gates(P, c, h, bl);
#pragma unroll
    for (int m = 0; m < 8; ++m) { const float bv = bl[ti * 65 + d0 + m]; qs[ti * 65 + d0 + m] = (float)q8[m] * 0.125f * __expf(bv); kk[ti * 65 + d0 + m] = (float)k8[m] * __expf(-bv); }
#pragma unroll
    for (int q = 0; q < 2; ++q) { const int ch = tid + 512 * q, j = ch >> 4, e0 = (ch & 15) * 8; f32x4 o0, o1;
#pragma unroll
        for (int m = 0; m < 4; ++m) { o0[m] = (float)v8[q][m]; o1[m] = (float)v8[q][4 + m]; }
        *(LAS f32x4*)(vs + j * 128 + e0) = o0; *(LAS f32x4*)(vs + j * 128 + e0 + 4) = o1; }
#pragma unroll
    for (int q = 0; q < 4; ++q) *(LAS f32x4*)(Ss + (tid + 512 * q) * 4) = sreg[q];
    __syncthreads();
    if (wid < 4) { const int i0 = (wid >> 1) * 32, j0 = (wid & 1) * 32; f32x16 acc;
#pragma unroll
        for (int i = 0; i < 16; ++i) acc[i] = 0.f;
#pragma unroll 8
        for (int s = 0; s < 32; ++s) acc = __builtin_amdgcn_mfma_f32_32x32x2f32(qs[(i0 + l31) * 65 + 2 * s + hf], kk[(j0 + l31) * 65 + 2 * s + hf], acc, 0, 0, 0);
#pragma unroll
        for (int r = 0; r < 16; ++r) { const int i = i0 + (r & 3) + 8 * (r >> 2) + 4 * hf, j = j0 + l31; As[i * 65 + j] = (j <= i) ? acc[r] : 0.f; } }
    __syncthreads();
    { const int i0 = (wid >> 2) * 32, e0 = (wid & 3) * 32; f32x16 acc;
#pragma unroll
      for (int i = 0; i < 16; ++i) acc[i] = 0.f;
#pragma unroll 8
      for (int s = 0; s < 32; ++s) acc = __builtin_amdgcn_mfma_f32_32x32x2f32(qs[(i0 + l31) * 65 + 2 * s + hf], Ss[(2 * s + hf) * 128 + e0 + l31], acc, 0, 0, 0);
#pragma unroll 8
      for (int s = 0; s < 32; ++s) acc = __builtin_amdgcn_mfma_f32_32x32x2f32(As[(i0 + l31) * 65 + 2 * s + hf], vs[(2 * s + hf) * 128 + e0 + l31], acc, 0, 0, 0);
#pragma unroll
      for (int r = 0; r < 16; ++r) { const int i = i0 + (r & 3) + 8 * (r >> 2) + 4 * hf; os[i * 129 + e0 + l31] = acc[r]; } }
    __syncthreads();
    { const int e0 = (tid & 7) * 16; float o[16], sq = 0.f;
#pragma unroll
      for (int j = 0; j < 16; ++j) { o[j] = os[ti * 129 + e0 + j]; sq += o[j] * o[j]; }
      sq += __shfl_xor(sq, 1); sq += __shfl_xor(sq, 2); sq += __shfl_xor(sq, 4);
      const float rs = rsqrtf(sq * (1.0f / 128.0f) + EPS);
      if (tt >= NMETA && tt < L) { half8 w0, w1;
#pragma unroll
          for (int j = 0; j < 8; ++j) { w0[j] = (f16)(o[j] * rs * P.hn[e0 + j] * silu_f((float)r8[0][j])); w1[j] = (f16)(o[8 + j] * rs * P.hn[e0 + 8 + j] * silu_f((float)r8[1][j])); }
          f16* dst = mix + (size_t)(tt - NMETA) * D + 128 * h + e0; *(half8*)dst = w0; *(half8*)(dst + 8) = w1; } }
    __syncthreads();
}

__device__ __forceinline__ unsigned mono_u(float f) { const unsigned u = __float_as_uint(f); return (u & 0x80000000u) ? ~u : (u | 0x80000000u); }
__device__ __forceinline__ float unmono_f(unsigned m) { return __uint_as_float((m & 0x80000000u) ? (m & 0x7fffffffu) : ~m); }
__device__ __forceinline__ unsigned wave_umax(unsigned v) {
    v = max(v, (unsigned)__builtin_amdgcn_update_dpp(0, (int)v, 0x111, 0xf, 0xf, false));
    v = max(v, (unsigned)__builtin_amdgcn_update_dpp(0, (int)v, 0x112, 0xf, 0xf, false));
    v = max(v, (unsigned)__builtin_amdgcn_update_dpp(0, (int)v, 0x114, 0xf, 0xf, false));
    v = max(v, (unsigned)__builtin_amdgcn_update_dpp(0, (int)v, 0x118, 0xf, 0xf, false));
    v = max(v, (unsigned)__builtin_amdgcn_update_dpp(0, (int)v, 0x142, 0xa, 0xf, false));
    v = max(v, (unsigned)__builtin_amdgcn_update_dpp(0, (int)v, 0x143, 0xc, 0xf, false));
    return (unsigned)__builtin_amdgcn_readlane((int)v, 63);
}
constexpr int CAP = 640, NPL = CAP / 64;
__device__ __forceinline__ int topk_compact(LAS float* cs, LAS unsigned short* ci, int n, bool exact, float& tau_out, int lane) {
    float sv[NPL]; unsigned iv[NPL], u[NPL];
#pragma unroll
    for (int i = 0; i < NPL; ++i) { const int p = lane + 64 * i; const bool v = p < n; sv[i] = v ? cs[p] : 0.f; iv[i] = v ? (unsigned)ci[p] : 0xffffu; u[i] = v ? mono_u(sv[i]) : 0u; }
    unsigned T = 0u; bool full = true; int hb = 31;
    {
        unsigned umx = 0u, umn = 0xffffffffu;
#pragma unroll
        for (int i = 0; i < NPL; ++i) { umx = max(umx, u[i]); umn = min(umn, (lane + 64 * i < n) ? u[i] : 0xffffffffu); }
        umx = wave_umax(umx); umn = ~wave_umax(~umn);
        const unsigned df = umx ^ umn;
        if (df == 0u) { hb = -1; T = umx; } else { hb = 31 - __clz(df); T = (hb == 31) ? 0u : (umx & ~((2u << hb) - 1u)); }
    }
#pragma unroll 1
    for (int bit = hb; bit >= 0; --bit) {
        const unsigned cand = T | (1u << bit); int cgt = 0;
#pragma unroll
        for (int i = 0; i < NPL; ++i) cgt += __popcll(__ballot(u[i] >= cand));
        if (cgt >= 256) { T = cand; if (!exact && cgt <= 272) { full = false; break; } }
    }
    bool keep[NPL];
    if (full) {
        int cgt = 0;
#pragma unroll
        for (int i = 0; i < NPL; ++i) cgt += __popcll(__ballot(u[i] > T));
        const int need = 256 - cgt; unsigned I = 0xffffu; int nties = 0;
#pragma unroll
        for (int i = 0; i < NPL; ++i) nties += __popcll(__ballot(u[i] == T));
        if (nties != need) { I = 0u;
#pragma unroll 1
        for (int bit = 15; bit >= 0; --bit) { const unsigned cand = I | (1u << bit); int cl = 0;
#pragma unroll
            for (int i = 0; i < NPL; ++i) cl += __popcll(__ballot(u[i] == T && iv[i] < cand));
            if (cl < need) I = cand; } }
#pragma unroll
        for (int i = 0; i < NPL; ++i) keep[i] = (u[i] > T) || (u[i] == T && iv[i] <= I);
    } else {
#pragma unroll
        for (int i = 0; i < NPL; ++i) keep[i] = u[i] >= T;
    }
    int nn = 0;
#pragma unroll
    for (int i = 0; i < NPL; ++i) { const unsigned long long m = __ballot(keep[i]); const int pre = __builtin_amdgcn_mbcnt_hi((unsigned)(m >> 32), __builtin_amdgcn_mbcnt_lo((unsigned)m, 0u));
        if (keep[i]) { cs[nn + pre] = sv[i]; ci[nn + pre] = (unsigned short)iv[i]; } nn += __popcll(m); }
    tau_out = unmono_f(T);
    return nn;
}
__device__ __forceinline__ float relu_asm(float x) { return __int_as_float(max(__float_as_int(x), 0)); }
__device__ __forceinline__ void indexer_tile(const Params& P, int tile, LAS unsigned char* lds) {
    int tid_ = threadIdx.x; asm volatile("" : "+v"(tid_));
    const int tid = tid_, lane = tid & 63, wid = __builtin_amdgcn_readfirstlane(tid >> 6), l31 = lane & 31, hf = lane >> 5;
    LAS float* candS = (LAS float*)lds;
    LAS unsigned short* candI = (LAS unsigned short*)(lds + 32 * CAP * 4);
    LAS unsigned char* kbuf = lds + 32 * CAP * 6;
    LAS int* lcnt = (LAS int*)(lds + LDS_BYTES - 1024 + 64);
    LAS int* lflag = (LAS int*)(lds + LDS_BYTES - 1024 + 192);
    const f16* IQ = (const f16*)(P.ws + WS_IQ); const f16* IK = (const f16*)(P.ws + WS_IK); const float* IW = (const float*)(P.ws + WS_IW);
    unsigned short* SEL = (unsigned short*)(P.ws + WS_SEL);
    const int t0 = tile * 32, tw = t0 + wid * 4;
    half8 afr[4];
    { const int qi = 2 * (l31 >> 4) + ((l31 >> 2) & 1), hd = 4 * ((l31 >> 3) & 1) + (l31 & 3); int tq = tw + qi; if (tq > L - 1) tq = L - 1;
      const half8* ap = (const half8*)(IQ + (size_t)tq * 512 + hd * 64);
#pragma unroll
      for (int s = 0; s < 4; ++s) afr[s] = ap[2 * s + hf]; }
    float w0[8], w1[8];
    { int ta = tw + hf, tb = tw + 2 + hf; if (ta > L - 1) ta = L - 1; if (tb > L - 1) tb = L - 1;
#pragma unroll
      for (int h = 0; h < 8; ++h) { w0[h] = IW[(size_t)ta * 8 + h]; w1[h] = IW[(size_t)tb * 8 + h]; } }
    asm volatile("" :: "v"(afr[0]), "v"(afr[1]), "v"(afr[2]), "v"(afr[3]));
    asm volatile("" :: "v"(w0[0]), "v"(w0[1]), "v"(w0[2]), "v"(w0[3]), "v"(w0[4]), "v"(w0[5]), "v"(w0[6]), "v"(w0[7]));
    asm volatile("" :: "v"(w1[0]), "v"(w1[1]), "v"(w1[2]), "v"(w1[3]), "v"(w1[4]), "v"(w1[5]), "v"(w1[6]), "v"(w1[7]));
    const int tq0 = (tw + hf < L) ? tw + hf : -1, tq1 = (tw + 2 + hf < L) ? tw + 2 + hf : -1;
    float tau0 = -__builtin_inff(), tau1 = -__builtin_inff();
    int cntv = 0;
    if (lane < 4) lcnt[wid * 4 + lane] = 0;
    if (tid < 3) lflag[tid] = 0;
    const int nkeys = (t0 + 32 < L) ? t0 + 32 : L, nst = (nkeys + 127) >> 7;
    u32x4 stg[2];
    const u32x4* IKv = (const u32x4*)IK;
#pragma unroll
    for (int i = 0; i < 2; ++i) stg[i] = IKv[(size_t)0 * 1024 + tid + 512 * i];
#pragma unroll
    for (int i = 0; i < 2; ++i) { const int ci = tid + 512 * i, row = ci >> 3, ch = ci & 7; *(LAS u32x4*)(kbuf + row * 128 + ((ch ^ ((row >> 1) & 7)) << 4)) = stg[i]; }
    __syncthreads();
#pragma unroll 1
    for (int st = 0; st < nst; ++st) {
        LAS unsigned char* kb = kbuf + (st & 1) * 16384;
        if (st + 1 < nst) {
#pragma unroll
            for (int i = 0; i < 2; ++i) stg[i] = IKv[(size_t)(st + 1) * 1024 + tid + 512 * i];
        }
#pragma unroll 1
        for (int sub = 0; sub < 4; sub += 2) {
            const int kbase = st * 128 + sub * 32;
            if (kbase > tw + 3) break;
            const int rowa = sub * 32 + l31, rowb = rowa + 32;
            f32x16 acca, accb;
#pragma unroll
            for (int i = 0; i < 16; ++i) { acca[i] = 0.f; accb[i] = 0.f; }
            half8 bfa[4], bfb[4];
#pragma unroll
            for (int s = 0; s < 4; ++s) { bfa[s] = *(const LAS half8*)(kb + rowa * 128 + (((2 * s + hf) ^ ((rowa >> 1) & 7)) << 4)); bfb[s] = *(const LAS half8*)(kb + rowb * 128 + (((2 * s + hf) ^ ((rowb >> 1) & 7)) << 4)); }
#pragma unroll
            for (int s = 0; s < 4; ++s) { acca = __builtin_amdgcn_mfma_f32_32x32x16_f16(afr[s], bfa[s], acca, 0, 0, 0); accb = __builtin_amdgcn_mfma_f32_32x32x16_f16(afr[s], bfb[s], accb, 0, 0, 0); }
#pragma unroll
            for (int part = 0; part < 2; ++part) {
                const int key = kbase + part * 32 + l31;
                float s0 = 0.f, s1 = 0.f;
#pragma unroll
                for (int h = 0; h < 8; ++h) { s0 = __builtin_fmaf(w0[h], relu_asm(part ? accb[h] : acca[h]), s0); s1 = __builtin_fmaf(w1[h], relu_asm(part ? accb[8 + h] : acca[8 + h]), s1); }
                if (key <= tq0 && s0 > tau0) { const int qs = wid * 4 + hf; const int pos = (int)__hip_atomic_fetch_add(lcnt + qs, 1, __ATOMIC_RELAXED, __HIP_MEMORY_SCOPE_WORKGROUP); candS[qs * CAP + pos] = s0; candI[qs * CAP + pos] = (unsigned short)key; }
                if (key <= tq1 && s1 > tau1) { const int qs = wid * 4 + 2 + hf; const int pos = (int)__hip_atomic_fetch_add(lcnt + qs, 1, __ATOMIC_RELAXED, __HIP_MEMORY_SCOPE_WORKGROUP); candS[qs * CAP + pos] = s1; candI[qs * CAP + pos] = (unsigned short)key; }
            }
        }
        if (st + 1 < nst) {
            LAS unsigned char* kn = kbuf + ((st + 1) & 1) * 16384;
#pragma unroll
            for (int i = 0; i < 2; ++i) { const int ci = tid + 512 * i, row = ci >> 3, ch = ci & 7; *(LAS u32x4*)(kn + row * 128 + ((ch ^ ((row >> 1) & 7)) << 4)) = stg[i]; }
        }
        cntv = lcnt[wid * 4 + (lane & 3)];
        const int mx = max(max(__builtin_amdgcn_readlane(cntv, 0), __builtin_amdgcn_readlane(cntv, 1)), max(__builtin_amdgcn_readlane(cntv, 2), __builtin_amdgcn_readlane(cntv, 3)));
        if (mx > CAP - 128 && lane == 0) lflag[st % 3] = 1;
        if (tid == 0) lflag[(st + 1) % 3] = 0;
        __syncthreads();
        const int any = lflag[st % 3];
        if (any) {
#pragma unroll 1
            for (int qq = 0; qq < 4; ++qq) { const int n = __builtin_amdgcn_readlane(cntv, qq);
                if (n > 288) { float nt; const int nn = topk_compact(candS + (wid * 4 + qq) * CAP, candI + (wid * 4 + qq) * CAP, n, false, nt, lane);
                    if (lane == 0) lcnt[wid * 4 + qq] = nn;
                    if (hf == (qq & 1)) { if (qq < 2) tau0 = nt; else tau1 = nt; } } }
        }
    }
#pragma unroll 1
    for (int qq = 0; qq < 4; ++qq) {
        const int t = tw + qq; if (t >= L) break;
        int n = lcnt[wid * 4 + qq]; LAS float* cs = candS + (wid * 4 + qq) * CAP; LAS unsigned short* ci = candI + (wid * 4 + qq) * CAP;
        if (n > 256) { float nt; n = topk_compact(cs, ci, n, true, nt, lane); }
#pragma unroll
        for (int j = 0; j < 4; ++j) { const int p = lane + 64 * j; SEL[(size_t)t * 256 + p] = p < n ? ci[p] : (unsigned short)0xffffu; }
    }
    __syncthreads();
}

#ifdef SCORE_ONLY_EXP
__device__ __forceinline__ void indexer_score_only(const Params& P, int tile, LAS unsigned char* lds) {
    int tid_ = threadIdx.x; asm volatile("" : "+v"(tid_));
    const int tid = tid_, lane = tid & 63, wid = __builtin_amdgcn_readfirstlane(tid >> 6), l31 = lane & 31, hf = lane >> 5;
    LAS float* candS = (LAS float*)lds;
    LAS unsigned short* candI = (LAS unsigned short*)(lds + 32 * CAP * 4);
    LAS unsigned char* kbuf = lds + 32 * CAP * 6;
    const f16* IQ = (const f16*)(P.ws + WS_IQ); const f16* IK = (const f16*)(P.ws + WS_IK); const float* IW = (const float*)(P.ws + WS_IW);
    unsigned short* SEL = (unsigned short*)(P.ws + WS_SEL);
    const int t0 = tile * 32, tw = t0 + wid * 4;
    half8 afr[4];
    { const int qi = 2 * (l31 >> 4) + ((l31 >> 2) & 1), hd = 4 * ((l31 >> 3) & 1) + (l31 & 3); int tq = tw + qi; if (tq > L - 1) tq = L - 1;
      const half8* ap = (const half8*)(IQ + (size_t)tq * 512 + hd * 64);
#pragma unroll
      for (int s = 0; s < 4; ++s) afr[s] = ap[2 * s + hf]; }
    float w0[8], w1[8];
    { int ta = tw + hf, tb = tw + 2 + hf; if (ta > L - 1) ta = L - 1; if (tb > L - 1) tb = L - 1;
#pragma unroll
      for (int h = 0; h < 8; ++h) { w0[h] = IW[(size_t)ta * 8 + h]; w1[h] = IW[(size_t)tb * 8 + h]; } }
    asm volatile("" :: "v"(afr[0]), "v"(afr[1]), "v"(afr[2]), "v"(afr[3]));
    asm volatile("" :: "v"(w0[0]), "v"(w0[1]), "v"(w0[2]), "v"(w0[3]), "v"(w0[4]), "v"(w0[5]), "v"(w0[6]), "v"(w0[7]));
    asm volatile("" :: "v"(w1[0]), "v"(w1[1]), "v"(w1[2]), "v"(w1[3]), "v"(w1[4]), "v"(w1[5]), "v"(w1[6]), "v"(w1[7]));
    const int tq0 = (tw + hf < L) ? tw + hf : -1, tq1 = (tw + 2 + hf < L) ? tw + 2 + hf : -1;
    float tau0 = -__builtin_inff(), tau1 = -__builtin_inff();
    int cntv = 0; float sink = 0.f;
    const int nkeys = (t0 + 32 < L) ? t0 + 32 : L, nst = (nkeys + 127) >> 7;
    u32x4 stg[2];
    const u32x4* IKv = (const u32x4*)IK;
#pragma unroll
    for (int i = 0; i < 2; ++i) stg[i] = IKv[(size_t)0 * 1024 + tid + 512 * i];
#pragma unroll
    for (int i = 0; i < 2; ++i) { const int ci = tid + 512 * i, row = ci >> 3, ch = ci & 7; *(LAS u32x4*)(kbuf + row * 128 + ((ch ^ ((row >> 1) & 7)) << 4)) = stg[i]; }
    __syncthreads();
#pragma unroll 1
    for (int st = 0; st < nst; ++st) {
        LAS unsigned char* kb = kbuf + (st & 1) * 16384;
        if (st + 1 < nst) {
#pragma unroll
            for (int i = 0; i < 2; ++i) stg[i] = IKv[(size_t)(st + 1) * 1024 + tid + 512 * i];
        }
#pragma unroll 1
        for (int sub = 0; sub < 4; ++sub) {
            const int kbase = st * 128 + sub * 32;
            if (kbase > tw + 3) break;
            const int row = sub * 32 + l31;
            f32x16 acc;
#pragma unroll
            for (int i = 0; i < 16; ++i) acc[i] = 0.f;
#pragma unroll
            for (int s = 0; s < 4; ++s) { const half8 bfr = *(const LAS half8*)(kb + row * 128 + (((2 * s + hf) ^ ((row >> 1) & 7)) << 4)); acc = __builtin_amdgcn_mfma_f32_32x32x16_f16(afr[s], bfr, acc, 0, 0, 0); }
            float s0 = 0.f, s1 = 0.f;
#pragma unroll
            for (int h = 0; h < 8; ++h) { s0 = __builtin_fmaf(w0[h], relu_asm(acc[h]), s0); s1 = __builtin_fmaf(w1[h], relu_asm(acc[8 + h]), s1); }
            const int key = kbase + l31;
            sink += (key <= tq0 && s0 > tau0) ? s0 : 0.f; sink += (key <= tq1 && s1 > tau1) ? s1 : 0.f;
        }
        if (st + 1 < nst) {
            LAS unsigned char* kn = kbuf + ((st + 1) & 1) * 16384;
#pragma unroll
            for (int i = 0; i < 2; ++i) { const int ci = tid + 512 * i, row = ci >> 3, ch = ci & 7; *(LAS u32x4*)(kn + row * 128 + ((ch ^ ((row >> 1) & 7)) << 4)) = stg[i]; }
        }
        __syncthreads();
    }
    if (sink == 12345.678f) ((float*)(P.ws + WS_CTL))[200 + (tid & 31)] = sink + (float)cntv;
    __syncthreads();
}

#endif
__device__ __forceinline__ void sparse_attn(const Params& P, LAS unsigned char* lds, int vbid) {
    int tid_ = threadIdx.x; asm volatile("" : "+v"(tid_));
    const int tid = tid_, lane = tid & 63, wid = tid >> 6, grp = lane >> 2, c4 = lane & 3;
    const int head = vbid & 7, slot = (vbid >> 3) * 8 + wid, nslot = (gridDim.x >> 3) * 8;
    typedef _Float16 half2v __attribute__((ext_vector_type(2)));
    LAS unsigned short* widx = (LAS unsigned short*)(lds + wid * 512);
    LAS float* red = (LAS float*)(lds + 4096 + wid * 4352);
    const unsigned short* SEL = (const unsigned short*)(P.ws + WS_SEL); const f16* DQ = (const f16*)(P.ws + WS_DQ);
    const unsigned char* kvh = P.ws + WS_KV + (size_t)head * LP * 128; f16* mix = (f16*)(P.ws + WS_ACTA);
    int t = NMETA + slot;
    u32x2 selr = {0u, 0u}; half8 qa, qb;
#pragma unroll
    for (int e = 0; e < 8; ++e) { qa[e] = (f16)0.f; qb[e] = (f16)0.f; }
    if (t < L) { selr = *(const u32x2*)(SEL + (size_t)t * 256 + lane * 4); qa = *(const half8*)(DQ + (size_t)t * 512 + head * 64 + c4 * 16); qb = *(const half8*)(DQ + (size_t)t * 512 + head * 64 + c4 * 16 + 8); }
#pragma unroll 1
    for (; t < L; t += nslot) {
        *(LAS u32x2*)(widx + lane * 4) = selr;
        unsigned keys[16]; u32x4 kreg[16], vreg[16];
#pragma unroll
        for (int it = 0; it < 16; ++it) keys[it] = widx[16 * it + grp];
#pragma unroll
        for (int it = 0; it < 16; ++it) { const unsigned kk = keys[it] != 0xffffu ? keys[it] : 0u; kreg[it] = *(const u32x4*)(kvh + (size_t)kk * 128 + c4 * 16); }
#pragma unroll
        for (int it = 0; it < 16; ++it) { const unsigned kk = keys[it] != 0xffffu ? keys[it] : 0u; vreg[it] = *(const u32x4*)(kvh + (size_t)kk * 128 + 64 + c4 * 16); }
        float qf[16], qmax = 1e-20f;
#pragma unroll
        for (int e = 0; e < 8; ++e) { qf[e] = (float)qa[e]; qf[8 + e] = (float)qb[e]; }
#pragma unroll
        for (int e = 0; e < 16; ++e) qmax = fmaxf(qmax, fabsf(qf[e]));
        qmax = fmaxf(qmax, __int_as_float(__builtin_amdgcn_update_dpp(0, __float_as_int(qmax), 0xB1, 0xf, 0xf, true)));
        qmax = fmaxf(qmax, __int_as_float(__builtin_amdgcn_update_dpp(0, __float_as_int(qmax), 0x4E, 0xf, 0xf, true)));
        const float qs = 127.0f * __builtin_amdgcn_rcpf(qmax), lscale = qmax * (1.0f / (127.0f * K_I8_SCALE));
        int q8[4];
#pragma unroll
        for (int w = 0; w < 4; ++w) { unsigned word = 0u;
#pragma unroll
            for (int j = 0; j < 4; ++j) { const int q = (int)__builtin_rintf(qf[4 * w + j] * qs); word |= ((unsigned)q & 0xffu) << (8 * j); }
            q8[w] = (int)word; }
        { const int tn = t + nslot;
          if (tn < L) { selr = *(const u32x2*)(SEL + (size_t)tn * 256 + lane * 4); qa = *(const half8*)(DQ + (size_t)tn * 512 + head * 64 + c4 * 16); qb = *(const half8*)(DQ + (size_t)tn * 512 + head * 64 + c4 * 16 + 8); } }
        float lg[16]; float mx = -__builtin_inff();
#pragma unroll
        for (int it = 0; it < 16; ++it) {
            int ai = 0;
#pragma unroll
            for (int w = 0; w < 4; ++w) ai = __builtin_amdgcn_sdot4((int)kreg[it][w], q8[w], ai, false);
            ai += __builtin_amdgcn_update_dpp(0, ai, 0xB1, 0xf, 0xf, true);
            ai += __builtin_amdgcn_update_dpp(0, ai, 0x4E, 0xf, 0xf, true);
            lg[it] = keys[it] != 0xffffu ? (float)ai * lscale : -__builtin_inff(); mx = fmaxf(mx, lg[it]);
        }
        mx = fmaxf(mx, __shfl_xor(mx, 4)); mx = fmaxf(mx, __shfl_xor(mx, 8)); mx = fmaxf(mx, __shfl_xor(mx, 16)); mx = fmaxf(mx, __shfl_xor(mx, 32));
        half2v o2[8]; float lsum = 0.f;
#pragma unroll
        for (int e = 0; e < 8; ++e) o2[e] = (half2v){(f16)0.f, (f16)0.f};
#pragma unroll
        for (int it = 0; it < 16; ++it) {
            const float p = __expf(lg[it] - mx); lsum += p; const f16 ph = (f16)p; const half2v p2 = {ph, ph};
#pragma unroll
            for (int w = 0; w < 4; ++w) {
                const half2v v01 = __builtin_bit_cast(half2v, __builtin_amdgcn_perm(0u, vreg[it][w], 0x010c000cu)), v23 = __builtin_bit_cast(half2v, __builtin_amdgcn_perm(0u, vreg[it][w], 0x030c020cu));
                o2[2 * w] = p2 * v01 + o2[2 * w]; o2[2 * w + 1] = p2 * v23 + o2[2 * w + 1]; }
        }
        lsum += __shfl_xor(lsum, 4); lsum += __shfl_xor(lsum, 8); lsum += __shfl_xor(lsum, 16); lsum += __shfl_xor(lsum, 32);
#pragma unroll
        for (int e = 0; e < 8; ++e) { red[lane * 17 + 2 * e] = (float)o2[e][0]; red[lane * 17 + 2 * e + 1] = (float)o2[e][1]; }
        float acc = 0.f;
        { const int cc = lane >> 4, e = lane & 15;
#pragma unroll
          for (int g = 0; g < 16; ++g) acc += red[(g * 4 + cc) * 17 + e]; }
        mix[(size_t)(t - NMETA) * D + 512 + head * 64 + lane] = (f16)(acc * __builtin_amdgcn_rcpf(lsum));
    }
    __syncthreads();
}

__device__ __forceinline__ void final_norm(const Params& P) {
    const int tid = threadIdx.x, lane = tid & 63, gw = blockIdx.x * 8 + (tid >> 6), nw = gridDim.x * 8;
    const float* ss3 = (const float*)(P.ws + WS_SS3); const f16* h3 = (const f16*)(P.ws + WS_ACTA);
    for (int r = gw; r < SEQ; r += nw) { const float rs = row_rstd(ss3, 16, r);
#pragma unroll
        for (int i = 0; i < 2; ++i) { const int k = lane * 8 + 512 * i; const half8 v = *(const half8*)(h3 + (size_t)r * D + k); const f32x4 g0 = *(const f32x4*)(P.nf + k), g1 = *(const f32x4*)(P.nf + k + 4); f32x4 o0, o1;
#pragma unroll
            for (int j = 0; j < 4; ++j) { o0[j] = (float)v[j] * rs * g0[j]; o1[j] = (float)v[4 + j] * rs * g1[j]; }
            *(f32x4*)(P.out + (size_t)r * D + k) = o0; *(f32x4*)(P.out + (size_t)r * D + k + 4) = o1; } }
}

#define XB_TMO      128
#define XB_XCNT(j)  (256  + 64 * (j))
#define XB_XSUB(j)  (1280 + 64 * (j))
#define XB_XGEN(j)  (2304 + 64 * (j))
#define XB_TOP      3328
#define XB_TOPGEN   3392
#define XCD_BAR_WORDS 3456
#define XB_SPIN_CAP (1u << 22)
__device__ __forceinline__ unsigned xb_ld(unsigned* p)              { return __hip_atomic_load(p, __ATOMIC_RELAXED, __HIP_MEMORY_SCOPE_AGENT); }
__device__ __forceinline__ unsigned xb_add(unsigned* p, unsigned v) { return __hip_atomic_fetch_add(p, v, __ATOMIC_RELAXED, __HIP_MEMORY_SCOPE_AGENT); }
__device__ __forceinline__ unsigned xb_xcc_id() { return (unsigned)__builtin_amdgcn_s_getreg((3 << 11) | 20) & 0xFu; }
#define XB_SPIN(cond, bar) do { unsigned _sp = 0; while (cond) { __builtin_amdgcn_s_sleep(1); \
    if ((++_sp & 255u) == 0u) { if (xb_ld(&(bar)[XB_TMO])) break; if (_sp > XB_SPIN_CAP) { atomicAdd(&(bar)[XB_TMO], 1u); break; } } } } while (0)
struct XcdBarrier { unsigned* bar; unsigned x; volatile LAS unsigned* st; };
__device__ __forceinline__ XcdBarrier xcd_barrier_post(unsigned* bar, volatile LAS unsigned* st) {
    XcdBarrier b; b.bar = bar; b.x = xb_xcc_id(); b.st = st;
    if (threadIdx.x == 0) (void)xb_add(&bar[XB_XCNT(b.x)], 1u);
    return b;
}
__device__ __forceinline__ void xcd_barrier_complete(unsigned* bar, unsigned x, unsigned& nloc, unsigned& nx) {
    const unsigned G = gridDim.x * gridDim.y * gridDim.z;
    unsigned sum, cnt, mine, sp = 0u;
    for (;;) {
        sum = 0u; cnt = 0u; mine = 0u;
#pragma unroll
        for (unsigned j = 0; j < 16; ++j) { const unsigned c = xb_ld(&bar[XB_XCNT(j)]); sum += c; cnt += (c > 0u) ? 1u : 0u; mine = (j == x) ? c : mine; }
        if (sum == G) break;
        __builtin_amdgcn_s_sleep(1);
        if ((++sp & 255u) == 0u) { if (xb_ld(&bar[XB_TMO])) break; if (sp > XB_SPIN_CAP) { atomicAdd(&bar[XB_TMO], 1u); break; } }
    }
    nloc = mine > 0u ? mine : 1u; nx = cnt > 0u ? cnt : 1u;
}
__device__ __forceinline__ void xcd_barrier(const XcdBarrier& b) {
    asm volatile("s_waitcnt vmcnt(0)" ::: "memory");
    __syncthreads();
    if (threadIdx.x == 0) {
        unsigned* bar = b.bar;
        __builtin_amdgcn_s_waitcnt(0);
        unsigned nloc = b.st[0], nx = b.st[1];
        if (nloc == 0u) { xcd_barrier_complete(bar, b.x, nloc, nx); b.st[0] = nloc; b.st[1] = nx; }
        const unsigned old = xb_add(&bar[XB_XSUB(b.x)], 1u);
        const unsigned gen = old / nloc;
        if (old + 1u == (gen + 1u) * nloc) {
            __builtin_amdgcn_fence(__ATOMIC_RELEASE, "agent");
            asm volatile("s_waitcnt vmcnt(0)" ::: "memory");
            const unsigned og = xb_add(&bar[XB_TOP], 1u);
            const unsigned tg = og / nx;
            if (og + 1u == (tg + 1u) * nx) xb_add(&bar[XB_TOPGEN], 1u);
            else XB_SPIN(xb_ld(&bar[XB_TOPGEN]) == tg, bar);
            __builtin_amdgcn_fence(__ATOMIC_ACQUIRE, "agent");
            xb_add(&bar[XB_XGEN(b.x)], 1u);
            asm volatile("s_waitcnt vmcnt(0)" ::: "memory");
        } else {
            XB_SPIN(xb_ld(&bar[XB_XGEN(b.x)]) == gen, bar);
            __builtin_amdgcn_fence(__ATOMIC_ACQUIRE, "agent");
            asm volatile("s_waitcnt vmcnt(0)" ::: "memory");
        }
    }
    __syncthreads();
}

__global__ void __launch_bounds__(NTHREADS, 2) fwd_kernel(Params P) {
    __shared__ __attribute__((aligned(16))) unsigned char lds_raw[LDS_BYTES];
    LAS unsigned char* lds = (LAS unsigned char*)lds_raw;
    const int tid = threadIdx.x, bid = blockIdx.x, G = gridDim.x;
    unsigned char* ws = P.ws;
    const int lo = P.ph_lo, hi = P.ph_hi;
#ifndef ONLY_PHASE
#define ONLY_PHASE -1
#endif
#define IN(k) ((ONLY_PHASE < 0 || ONLY_PHASE == (k)) && lo <= (k) && (k) < hi)
#ifdef PROBE
#define STAMP(k) do { if (bid == 0 && tid == 0) ((unsigned long long*)(ws + WS_CTL + 1024))[(k)] = __builtin_amdgcn_s_memrealtime(); } while (0)
#else
#define STAMP(k) do { } while (0)
#endif
#define SEAM(k) do { if (IN(k) && IN((k) + 1)) { xcd_barrier(xbar); } STAMP((k) + 1); } while (0)
    XcdBarrier xbar; xbar.bar = (unsigned*)(ws + WS_BAR); xbar.x = 0; xbar.st = (volatile LAS unsigned*)(lds + LDS_BYTES - 1024 + 16);
    if (hi - lo > 1) {
        if (tid == 0) { xbar.st[0] = 0u; xbar.st[1] = 0u; }
        __syncthreads();
        xbar = xcd_barrier_post((unsigned*)(ws + WS_BAR), (volatile LAS unsigned*)(lds + LDS_BYTES - 1024 + 16));
    }
    LAS int* misc = (LAS int*)(lds + LDS_BYTES - 1024);
    if (hi - lo > 1) {
        if (tid == 0) { const unsigned xcc = xb_xcc_id() & 7u; misc[8] = (int)xcc; misc[9] = (int)xb_add((unsigned*)(ws + WS_CTL) + 32 + 32 * xcc, 1u); }
    }
    int vbid = bid;
    f16* acta = (f16*)(ws + WS_ACTA); f16* Gb = (f16*)(ws + WS_G);
    float* ss0 = (float*)(ws + WS_SS0); float* ss1 = (float*)(ws + WS_SS1); float* ss2 = (float*)(ws + WS_SS2); float* ss3 = (float*)(ws + WS_SS3);
    STAMP(0);
    _Pragma("unroll 1") for (int rep = 0; rep < NREP(0); ++rep)
    if (IN(0)) { p0_prologue(P, lds); }
    SEAM(0);
    if (hi - lo > 1 && (G & 7) == 0) {
        if (tid == 0) { bool ok = true; for (int j = 0; j < 8; ++j) ok = ok && (xb_ld((unsigned*)(ws + WS_CTL) + 32 + 32 * j) == (unsigned)(G >> 3)); misc[10] = ok ? misc[9] * 8 + misc[8] : bid; }
        __syncthreads();
        vbid = __builtin_amdgcn_readfirstlane(misc[10]);
        __syncthreads();
    }
    _Pragma("unroll 1") for (int rep = 0; rep < NREP(1); ++rep)
    if (IN(1)) {
        pg8::Gemm g{acta, (const f16*)(ws + WS_WGU1), MP, 2 * DFF, D}; pg8::StaticOrder S; S.init(MP, 2 * DFF, G, vbid);
        EpiSwiglu E{Gb, ss0, 1}; pg8::gemm_phase(lds, g, S, E);
    }
    SEAM(1);
    _Pragma("unroll 1") for (int rep = 0; rep < NREP(2); ++rep)
    if (IN(2)) {
        meta_down(P, lds);
        pg8::Gemm g{Gb, (const f16*)(ws + WS_WD1), SEQ, D, DFF}; pg8::StaticOrder S; S.init(SEQ, D, G, vbid);
        EpiResid<true> E{acta, (f16*)P.out, ss1, 0.5f}; pg8::gemm_phase(lds, g, S, E);
    }
    SEAM(2);
    _Pragma("unroll 1") for (int rep = 0; rep < NREP(3); ++rep)
    if (IN(3)) {
        pg8::Gemm g{(const f16*)P.out, (const f16*)(ws + WS_WIN), MP, NIN, D}; pg8::StaticOrder S; S.init(MP, NIN, G, vbid);
        EpiInProj E{ss1, (const f32x2*)(ws + WS_ROPE), ws};
        pg8::gemm_phase(lds, g, S, E);
    }
    SEAM(3);
    _Pragma("unroll 1") for (int rep = 0; rep < NREP(4); ++rep)
    if (IN(4)) {
        for (int u = bid; u < NCH * 4; u += G) gla_a_unit(P, u, lds);
        if (rep == 0) {
            int tbase = 0, cursor = bid; LAS f16* tl = (LAS f16*)lds;
            prep_weight(P, 3, D, D, (f16*)(ws + WS_WOUT), cursor, tbase, tl);
            prep_weight(P, 4, 2 * DFF, D, (f16*)(ws + WS_WGU2), cursor, tbase, tl);
            prep_weight(P, 5, D, DFF, (f16*)(ws + WS_WD2), cursor, tbase, tl);
        }
    }
    SEAM(4);
    _Pragma("unroll 1") for (int rep = 0; rep < NREP(5); ++rep)
    if (IN(5)) {
        if (bid < 64 && rep == 0) gla_scan(P);
        unsigned* ctr = (unsigned*)(ws + WS_CTL) + rep; LAS int* bc = (LAS int*)(lds + LDS_BYTES - 1024);
        for (;;) {
            if (tid == 0) bc[0] = (int)atomicAdd(ctr, 1u);
            __syncthreads();
            const int k = bc[0];
            __syncthreads();
            if (k >= 513) break;
            indexer_tile(P, 512 - k, lds);
        }
#ifdef SCORE_ONLY_EXP
        { unsigned* ctr2 = (unsigned*)(ws + WS_CTL) + 8;
          for (;;) {
            if (tid == 0) bc[0] = (int)atomicAdd(ctr2, 1u);
            __syncthreads();
            const int k = bc[0];
            __syncthreads();
            if (k >= 513) break;
            indexer_score_only(P, 512 - k, lds);
          } }
#endif
    }
    SEAM(5);
    _Pragma("unroll 1") for (int rep = 0; rep < NREP(6); ++rep)
    if (IN(6)) { if (REPEAT_PH != 6 || rep == 0 || true) for (int u = bid; u < NCH * 4; u += G) gla_c_unit(P, u, lds); sparse_attn(P, lds, vbid); }
    for (int e = 0; e < EXTRA_SYNCS; ++e) cg::this_grid().sync();
    SEAM(6);
    _Pragma("unroll 1") for (int rep = 0; rep < NREP(7); ++rep)
    if (IN(7)) {
        pg8::Gemm g{acta, (const f16*)(ws + WS_WOUT), SEQ, D, D}; pg8::StaticOrder S; S.init(SEQ, D, G, vbid);
        EpiResid<true> E{P.out, (f16*)(ws + WS_US), ss2, 1.0f}; pg8::gemm_phase(lds, g, S, E);
    }
    SEAM(7);
    _Pragma("unroll 1") for (int rep = 0; rep < NREP(8); ++rep)
    if (IN(8)) {
        pg8::Gemm g{(const f16*)(ws + WS_US), (const f16*)(ws + WS_WGU2), SEQ, 2 * DFF, D}; pg8::StaticOrder S; S.init(SEQ, 2 * DFF, G, vbid);
        EpiSwiglu E{Gb, ss2, 16}; pg8::gemm_phase(lds, g, S, E);
    }
    SEAM(8);
    _Pragma("unroll 1") for (int rep = 0; rep < NREP(9); ++rep)
    if (IN(9)) {
        pg8::Gemm g{Gb, (const f16*)(ws + WS_WD2), SEQ, D, DFF}; pg8::StaticOrder S; S.init(SEQ, D, G, vbid);
        EpiResid<true> E{ws + WS_US, acta, ss3, 0.5f}; pg8::gemm_phase(lds, g, S, E);
    }
    SEAM(9);
    if (IN(10)) final_norm(P);
#ifdef PROBE
    {
        STAMP(11);
        cg::this_grid().sync();
        const unsigned long long* tsv = (const unsigned long long*)(ws + WS_CTL + 1024);
        float tph[12]; float tg = 0.f;
#pragma unroll
        for (int k = 0; k < 11; ++k) { tph[k] = (float)(tsv[k + 1] - tsv[k]) * 0.01f; }
        tph[11] = (float)(tsv[11] - tsv[0]) * 0.01f;
        const float gsum = tph[1] + tph[2] + tph[3] + tph[7] + tph[8] + tph[9];
        const float va = (PROBE_A == 12) ? gsum : tph[PROBE_A < 12 ? PROBE_A : 0], vb = (PROBE_B == 12) ? gsum : tph[PROBE_B < 12 ? PROBE_B : 0];
        const size_t n = (size_t)SEQ * D;
        for (size_t i = (size_t)bid * NTHREADS + tid; i < n; i += (size_t)G * NTHREADS) P.out[i] = (i == 0) ? va : vb * 0.01f;
        (void)tg;
    }
#endif
#ifdef DBG_CUT
    if (IN(11)) {
        const size_t n = (size_t)SEQ * D; const size_t i0 = (size_t)bid * NTHREADS + tid, st = (size_t)G * NTHREADS;
#if DBG_CUT == 6
        const f16* m = (const f16*)(ws + WS_ACTA); for (size_t i = i0; i < n; i += st) P.out[i] = (float)m[i];
#elif DBG_CUT == 5
        const unsigned short* m = (const unsigned short*)(ws + WS_SEL); for (size_t i = i0; i < n; i += st) P.out[i] = (float)m[i % ((size_t)L * 256)];
#elif DBG_CUT == 3
        const f16* a = (const f16*)(ws + WS_DQ); const f16* b = (const f16*)(ws + WS_IQ); const f16* c = (const f16*)(ws + WS_KV); const f16* d = (const f16*)(ws + WS_GQ);
        for (size_t i = i0; i < n; i += st) P.out[i] = (float)a[i % ((size_t)L * 512)] + (float)b[i % ((size_t)L * 512)] + (float)c[i] + (float)d[i % ((size_t)L * 1536)];
#elif DBG_CUT == 4
        const float* m = (const float*)(ws + WS_US); for (size_t i = i0; i < n; i += st) P.out[i] = m[i % ((size_t)NCH * 32768)];
#endif
    }
#endif
#undef IN
#undef SEAM
}

extern "C" void kernel_launch(void* const* d_in, const int* in_sizes, int n_in, void* d_out, int out_size, void* d_ws, size_t ws_size, hipStream_t stream) {
    static int grid = 0;
    if (grid == 0) {
        if (n_in != 17 || in_sizes[0] != SEQ * D || out_size != SEQ * D || ws_size < WS_END) { fprintf(stderr, "kernel_launch: unexpected shapes (n_in %d, in0 %d, out %d, ws %zu, need %zu)\n", n_in, n_in > 0 ? in_sizes[0] : -1, out_size, ws_size, (size_t)WS_END); grid = -1; return; }
        int dev = 0, cus = 0, per_cu = 0;
        (void)hipGetDevice(&dev); (void)hipDeviceGetAttribute(&cus, hipDeviceAttributeMultiprocessorCount, dev);
        if (hipOccupancyMaxActiveBlocksPerMultiprocessor(&per_cu, (const void*)fwd_kernel, NTHREADS, 0) != hipSuccess || per_cu < 1) { fprintf(stderr, "kernel_launch: occupancy query says %d blocks per CU\n", per_cu); per_cu = 1; }
        (void)hipGetLastError();
        grid = cus;
        if (grid % 8 != 0 || grid < 64) { fprintf(stderr, "kernel_launch: unexpected CU count %d\n", cus); }
    }
    if (grid < 0) return;
    if (hipMemsetAsync((char*)d_ws + WS_CTL, 0, CTL_BYTES, stream) != hipSuccess) { fprintf(stderr, "kernel_launch: memset failed\n"); return; }
    Params p{};
    const float** pp = (const float**)&p;
    for (int i = 0; i < 17; ++i) pp[i] = (const float*)d_in[i];
    p.out = (float*)d_out; p.ws = (unsigned char*)d_ws;
#if MODE == 0
#ifdef DBG_CUT
    for (int ph = 0; ph <= DBG_CUT; ++ph) { p.ph_lo = ph; p.ph_hi = ph + 1; hipLaunchKernelGGL(fwd_kernel, dim3(grid), dim3(NTHREADS), 0, stream, p); }
    if (DBG_CUT != 2 && DBG_CUT != 7 && DBG_CUT != 9) { p.ph_lo = 11; p.ph_hi = 12; hipLaunchKernelGGL(fwd_kernel, dim3(grid), dim3(NTHREADS), 0, stream, p); }
#else
    for (int ph = 0; ph < NPHASE; ++ph) { p.ph_lo = ph; p.ph_hi = ph + 1; hipLaunchKernelGGL(fwd_kernel, dim3(grid), dim3(NTHREADS), 0, stream, p); }
#endif
#else
    p.ph_lo = 0; p.ph_hi = NPHASE;
    void* args[] = {&p};
    hipError_t e = hipLaunchCooperativeKernel((const void*)fwd_kernel, dim3(grid), dim3(NTHREADS), args, 0, stream);
    if (e != hipSuccess) fprintf(stderr, "cooperative launch failed: %s (grid %d)\n", hipGetErrorString(e), grid);
#endif
}
```

```cpp
#include <hip/hip_runtime.h>
#include <cstdio>
#include <cstdint>

#ifndef MODE
#define MODE 1
#endif

#define LAS __attribute__((address_space(3)))
typedef _Float16 f16;
typedef _Float16 half8 __attribute__((ext_vector_type(8)));
typedef _Float16 half4 __attribute__((ext_vector_type(4)));
typedef float f32x2 __attribute__((ext_vector_type(2)));
typedef float f32x4 __attribute__((ext_vector_type(4)));
typedef float f32x16 __attribute__((ext_vector_type(16)));
typedef unsigned u32x2 __attribute__((ext_vector_type(2)));
typedef unsigned u32x4 __attribute__((ext_vector_type(4)));

constexpr int D = 1024, SEQ = 16384, NMETA = 16, L = SEQ + NMETA, DFF = 2816;
constexpr int MP = 16640;
constexpr int LP = 16512;
constexpr int NIN = 3840;
constexpr int NCH = 257;
constexpr float EPS = 1e-6f;
constexpr int NTHREADS = 512;
constexpr int LDS_BYTES = 155648 + 1024;
constexpr int NPHASE = 11;

constexpr size_t al256(size_t x) { return (x + 255) & ~(size_t)255; }
constexpr size_t WS_CTL = 0;
constexpr size_t CTL_BYTES = 32768;
constexpr size_t WS_BAR = 2048;
constexpr size_t WS_WGU1 = CTL_BYTES;
constexpr size_t WS_WD1 = WS_WGU1 + (size_t)2 * DFF * D * 2;
constexpr size_t WS_WIN = WS_WD1 + (size_t)D * DFF * 2;
constexpr size_t WS_WOUT = WS_WIN + (size_t)NIN * D * 2;
constexpr size_t WS_WGU2 = WS_WOUT + (size_t)D * D * 2;
constexpr size_t WS_WD2 = WS_WGU2 + (size_t)2 * DFF * D * 2;
constexpr size_t WS_ACTA = WS_WD2 + (size_t)D * DFF * 2;
constexpr size_t WS_G = WS_ACTA + (size_t)MP * D * 2;
constexpr size_t WS_US = WS_G + (size_t)MP * DFF * 2;
constexpr size_t WS_DQ = WS_US + (size_t)NCH * 4 * 64 * 128 * 4;
constexpr size_t WS_IQ = WS_DQ + (size_t)LP * 512 * 2;
constexpr size_t WS_SEL = WS_IQ + (size_t)LP * 512 * 2;
constexpr size_t WS_ROPE = WS_SEL + (size_t)LP * 256 * 2;
constexpr size_t WS_IW = WS_ROPE + al256((size_t)L * 32 * 8);
constexpr size_t WS_GA = WS_IW + (size_t)LP * 8 * 4;
constexpr size_t WS_DECAY = WS_GA + (size_t)LP * 16 * 4;
constexpr size_t WS_SS0 = WS_DECAY + al256((size_t)NCH * 256 * 4);
constexpr size_t WS_SS1 = WS_SS0 + (size_t)MP * 4;
constexpr size_t WS_SS2 = WS_SS1 + (size_t)MP * 64;
constexpr size_t WS_SS3 = WS_SS2 + (size_t)MP * 64;
constexpr size_t WS_END = WS_SS3 + (size_t)MP * 64;
constexpr size_t WS_KV = WS_G;
constexpr size_t WS_GQ = WS_KV + (size_t)8 * LP * 128 * 2;
constexpr size_t WS_GK = WS_GQ + (size_t)LP * 256 * 2;
constexpr size_t WS_GV = WS_GK + (size_t)LP * 256 * 2;
constexpr size_t WS_GR = WS_GV + (size_t)LP * 512 * 2;
constexpr size_t WS_IK = WS_GR + (size_t)LP * 512 * 2;
constexpr size_t WS_ALIAS_END = WS_IK + (size_t)LP * 64 * 2;
static_assert(WS_ALIAS_END <= WS_US, "aliased buffers exceed G");
static_assert(WS_END <= (size_t)256 * 1024 * 1024, "workspace exceeds 256 MiB");
static_assert((size_t)SEQ * D * 2 <= (size_t)NCH * 4 * 64 * 128 * 4, "h2_16 alias");

struct Params {
    const float* x; const float* meta; const float* n1; const float* wg1; const float* wu1; const float* wd1;
    const float* nmix; const float* win; const float* wa2; const float* ba; const float* hn; const float* wout;
    const float* n2; const float* wg2; const float* wu2; const float* wd2; const float* nf;
    float* out; unsigned char* ws; int ph_lo, ph_hi;
};

namespace pg8 {
constexpr int BM = 256, BK = 64, HALF = 128, HTB = HALF * BK * 2, STAGE_BYTES = 8 * HTB, NXCD = 8, WGM = 8;
__host__ __device__ __forceinline__ int lds_byte(int r, int c) { const int st = (r >> 4) * 2 + (c >> 5), rr = r & 15, cc = c & 31, ob = rr * 64 + cc * 2; return st * 1024 + (ob ^ (((ob >> 9) & 1) << 5)); }
__host__ __device__ __forceinline__ int perm32(int rho) { const int n = rho >> 4, i = rho & 15; return 8 * (i >> 2) + 4 * n + (i & 3); }
__host__ __device__ __forceinline__ void stage_rc(int b, int& R, int& C) { const int st = b / 1024, sb = b % 1024, swz = sb ^ (((sb >> 9) & 1) << 5); R = (st >> 1) * 16 + swz / 64; C = (st & 1) * 32 + (swz % 64) / 2; }
struct Unit { int pm, pn; };
struct Gemm { const f16* A; const f16* Bt; int M, N, K; };
struct StaticOrder {
    int nM, nN, nwg, G, c;
    __host__ __device__ void init(int M, int N, int G_, int c_) { nM = M / BM; nN = N / BM; nwg = nM * nN; G = G_; c = c_; }
    __host__ __device__ bool next(int i, Unit& u) const {
        const long Lx = (long)i * G + c; if (Lx >= nwg) return false;
        int wgid = (int)Lx; { const int q = nwg / NXCD, r = nwg % NXCD, xcd = wgid % NXCD, off = wgid / NXCD; wgid = (xcd < r ? xcd * (q + 1) : r * (q + 1) + (xcd - r) * q) + off; }
        const int nig = WGM * nN, gid = wgid / nig, fm = gid * WGM, gsz = (nM - fm) < WGM ? (nM - fm) : WGM;
        u.pm = fm + ((wgid % nig) % gsz); u.pn = (wgid % nig) / gsz; return true;
    }
};
template <class Epi>
__device__ __forceinline__ void gemm_phase(LAS unsigned char* lds, const Gemm g, const StaticOrder& S, const Epi& E) {
    int tid_ = threadIdx.x; asm volatile("" : "+v"(tid_));
    const int tid = tid_, wid = __builtin_amdgcn_readfirstlane(tid >> 6), lane = tid & 63, wr = wid >> 2, wc = wid & 3, fr = lane & 15, fq = lane >> 4;
    const int K = g.K, nt = K / BK;
    unsigned voffA[2], voffB[2];
#pragma unroll
    for (int i = 0; i < 2; ++i) { int R, C; stage_rc(tid * 16 + i * 8192, R, C); const int Rb = (R & ~31) + perm32(R & 31); voffA[i] = (unsigned)(R * K + C) * 2u; voffB[i] = (unsigned)(Rb * K + C) * 2u; }
    const size_t kstep = (size_t)(BK * 2);
    const size_t hstep = (size_t)HALF * K * 2;
    const size_t tstep = 2 * hstep;
    const unsigned ldsw = (unsigned)wid * 1024u;
    const int aoff = lds_byte(wr * 64 + fr, fq * 8), boff = lds_byte(wc * 32 + fr, fq * 8);
#define PG8_SA(b, h) (((b) * 2 + (h)) * HTB)
#define PG8_SB(b, h) ((4 + (b) * 2 + (h)) * HTB)
#define PG8_STAGE(bufoff, gbase, voff) do { _Pragma("unroll") for (int _i = 0; _i < 2; ++_i) \
        __builtin_amdgcn_global_load_lds((const unsigned*)((const char*)(gbase) + (voff)[_i]), (LAS unsigned*)(lds + (bufoff) + ldsw + _i * 8192), 16, 0, 0); } while (0)
#define PG8_LDA(dst, b, h) do { _Pragma("unroll") for (int m = 0; m < 4; ++m) _Pragma("unroll") for (int k = 0; k < 2; ++k) dst[m][k] = *(const LAS half8*)(lds + PG8_SA(b, h) + aoff + m * 2048 + k * 1024); } while (0)
#define PG8_LDB(dst, b, h) do { _Pragma("unroll") for (int n = 0; n < 2; ++n) _Pragma("unroll") for (int k = 0; k < 2; ++k) dst[n][k] = *(const LAS half8*)(lds + PG8_SB(b, h) + boff + n * 2048 + k * 1024); } while (0)
#define PG8_MMA(ai, bj, At, Bt) do { __builtin_amdgcn_s_setprio(1); _Pragma("unroll") for (int m = 0; m < 4; ++m) _Pragma("unroll") for (int n = 0; n < 2; ++n) _Pragma("unroll") for (int k = 0; k < 2; ++k) \
        acc[ai][bj][m][n] = __builtin_amdgcn_mfma_f32_16x16x32_f16(Bt[n][k], At[m][k], acc[ai][bj][m][n], 0, 0, 0); __builtin_amdgcn_s_setprio(0); } while (0)
#define PG8_WAIT_V(n) asm volatile("s_waitcnt vmcnt(" #n ")" ::: "memory")
#define PG8_WAIT_L(n) asm volatile("s_waitcnt lgkmcnt(" #n ")" ::: "memory")
#define PG8_BAR __builtin_amdgcn_s_barrier()
#define PG8_SCHED __builtin_amdgcn_sched_barrier(0)
    Unit cur, nxt; int ui = 0;
    if (!S.next(0, cur)) return;
    f32x4 acc[2][2][4][2];
#pragma unroll
    for (int a = 0; a < 2; ++a)
#pragma unroll
        for (int b = 0; b < 2; ++b)
#pragma unroll
            for (int m = 0; m < 4; ++m)
#pragma unroll
                for (int n = 0; n < 2; ++n) acc[a][b][m][n] = (f32x4){0.f, 0.f, 0.f, 0.f};
    half8 At[4][2], B0[2][2], B1[2][2];
    const char* cA = (const char*)g.A + (size_t)cur.pm * tstep; const char* cB = (const char*)g.Bt + (size_t)cur.pn * tstep;
    PG8_STAGE(PG8_SB(0, 0), cB, voffB); PG8_STAGE(PG8_SA(0, 0), cA, voffA); PG8_STAGE(PG8_SB(0, 1), cB + hstep, voffB); PG8_STAGE(PG8_SA(0, 1), cA + hstep, voffA);
    if (wr == 1) PG8_BAR;
    PG8_WAIT_V(4); PG8_BAR;
    PG8_STAGE(PG8_SB(1, 0), cB + kstep, voffB); PG8_STAGE(PG8_SA(1, 0), cA + kstep, voffA); PG8_STAGE(PG8_SB(1, 1), cB + hstep + kstep, voffB);
    PG8_WAIT_V(6); PG8_BAR;
    for (;;) {
        const bool has_next = S.next(ui + 1, nxt);
        const char* nA = has_next ? (const char*)g.A + (size_t)nxt.pm * tstep : cA; const char* nB = has_next ? (const char*)g.Bt + (size_t)nxt.pn * tstep : cB;
        for (int t = 0; t < nt; t += 2) {
            const bool last = (t == nt - 2);
            const char* a1 = cA + (size_t)(t + 1) * kstep;
            const char* a2 = last ? nA : cA + (size_t)(t + 2) * kstep; const char* b2 = last ? nB : cB + (size_t)(t + 2) * kstep;
            const char* a3 = a2 + kstep; const char* b3 = b2 + kstep;
            PG8_LDB(B0, 0, 0); PG8_SCHED; PG8_LDA(At, 0, 0); PG8_STAGE(PG8_SA(1, 1), a1 + hstep, voffA);
            PG8_WAIT_L(8); PG8_BAR; PG8_WAIT_L(0); PG8_MMA(0, 0, At, B0); PG8_BAR; PG8_SCHED;
            PG8_LDB(B1, 0, 1); PG8_STAGE(PG8_SB(0, 0), b2, voffB);
            PG8_BAR; PG8_WAIT_L(0); PG8_MMA(0, 1, At, B1); PG8_BAR;
            PG8_LDA(At, 0, 1); PG8_STAGE(PG8_SA(0, 0), a2, voffA);
            PG8_BAR; PG8_WAIT_L(0); PG8_MMA(1, 0, At, B0); PG8_BAR; PG8_SCHED;
            PG8_STAGE(PG8_SB(0, 1), b2 + hstep, voffB);
            PG8_WAIT_V(6); PG8_BAR; PG8_MMA(1, 1, At, B1); PG8_BAR;
            PG8_LDB(B0, 1, 0); PG8_SCHED; PG8_LDA(At, 1, 0); PG8_STAGE(PG8_SA(0, 1), a2 + hstep, voffA);
            PG8_WAIT_L(8); PG8_BAR; PG8_WAIT_L(0); PG8_MMA(0, 0, At, B0); PG8_BAR; PG8_SCHED;
            PG8_LDB(B1, 1, 1); PG8_STAGE(PG8_SB(1, 0), b3, voffB);
            PG8_BAR; PG8_WAIT_L(0); PG8_MMA(0, 1, At, B1); PG8_BAR;
            PG8_LDA(At, 1, 1); PG8_STAGE(PG8_SA(1, 0), a3, voffA);
            PG8_BAR; PG8_WAIT_L(0); PG8_MMA(1, 0, At, B0); PG8_BAR; PG8_SCHED;
            PG8_STAGE(PG8_SB(1, 1), b3 + hstep, voffB);
            PG8_WAIT_V(6); PG8_BAR; PG8_MMA(1, 1, At, B1); PG8_BAR;
        }
        E(acc, cur, wr, wc, fr, fq);
        if (!has_next) break;
#pragma unroll
        for (int a = 0; a < 2; ++a)
#pragma unroll
            for (int b = 0; b < 2; ++b)
#pragma unroll
                for (int m = 0; m < 4; ++m)
#pragma unroll
                    for (int n = 0; n < 2; ++n) acc[a][b][m][n] = (f32x4){0.f, 0.f, 0.f, 0.f};
        cur = nxt; cA = nA; cB = nB; ++ui;
    }
    PG8_WAIT_V(0);
    if (wr == 0) PG8_BAR;
    PG8_BAR;
#undef PG8_SA
#undef PG8_SB
#undef PG8_STAGE
#undef PG8_LDA
#undef PG8_LDB
#undef PG8_MMA
#undef PG8_WAIT_V
#undef PG8_WAIT_L
#undef PG8_BAR
#undef PG8_SCHED
}
}

__device__ __forceinline__ float silu_f(float v) { return v * __builtin_amdgcn_rcpf(1.0f + __expf(-v)); }
__device__ __forceinline__ half4 to_half4(f32x4 v) { half4 h; h[0] = (f16)v[0]; h[1] = (f16)v[1]; h[2] = (f16)v[2]; h[3] = (f16)v[3]; return h; }

__device__ __forceinline__ float row_rstd(const float* ss, int np, int row) {
    float s;
    if (np == 1) s = ss[row];
    else { const f32x4* p = (const f32x4*)(ss + (size_t)row * 16); const f32x4 a = p[0], b = p[1], c = p[2], d = p[3];
        s = (((a[0] + a[1]) + (a[2] + a[3])) + ((b[0] + b[1]) + (b[2] + b[3]))) + (((c[0] + c[1]) + (c[2] + c[3])) + ((d[0] + d[1]) + (d[2] + d[3]))); }
    return rsqrtf(s * (1.0f / D) + EPS);
}
struct EpiSwiglu {
    f16* G; const float* ss; int np;
    __device__ __forceinline__ void operator()(const f32x4 (&acc)[2][2][4][2], const pg8::Unit& u, int wr, int wc, int fr_, int fq_) const {
        int fr = fr_, fq = fq_; asm volatile("" : "+v"(fr), "+v"(fq));
#pragma unroll
        for (int ai = 0; ai < 2; ++ai)
#pragma unroll
            for (int m = 0; m < 4; ++m) {
                const int row = u.pm * 256 + ai * 128 + wr * 64 + m * 16 + fr;
                const float rs = row_rstd(ss, np, row), ce = -1.4426950408889634f * rs, rs2 = rs * rs; half8 o;
#pragma unroll
                for (int n = 0; n < 2; ++n) {
                    const f32x4 g = acc[ai][0][m][n], u = acc[ai][1][m][n]; const f32x4 t = g * ce; f32x4 e, r;
#pragma unroll
                    for (int j = 0; j < 4; ++j) e[j] = __builtin_amdgcn_exp2f(t[j]);
                    const f32x4 d = e + 1.0f;
#pragma unroll
                    for (int j = 0; j < 4; ++j) r[j] = __builtin_amdgcn_rcpf(d[j]);
                    const f32x4 w = (g * u) * (r * rs2);
#pragma unroll
                    for (int j = 0; j < 4; ++j) o[4 * n + j] = (f16)w[j];
                }
                *(half8*)(G + (size_t)row * DFF + u.pn * 128 + wc * 32 + 8 * fq) = o;
            }
    }
};
template <bool SRC16> struct EpiResid {
    const void* src; f16* h16; float* ss; float alpha;
    __device__ __forceinline__ void operator()(const f32x4 (&acc)[2][2][4][2], const pg8::Unit& u, int wr, int wc, int fr_, int fq_) const {
        int fr = fr_, fq = fq_; asm volatile("" : "+v"(fr), "+v"(fq));
#pragma unroll
        for (int ai = 0; ai < 2; ++ai)
#pragma unroll
            for (int m = 0; m < 4; ++m) {
                const int row = u.pm * 256 + ai * 128 + wr * 64 + m * 16 + fr; float part = 0.f;
#pragma unroll
                for (int bj = 0; bj < 2; ++bj) {
                    const size_t off = (size_t)row * D + u.pn * 256 + bj * 128 + wc * 32 + 8 * fq; half8 h; f32x4 sv[2];
                    if (SRC16) { const half8 s8 = *(const half8*)((const f16*)src + off);
#pragma unroll
                        for (int j = 0; j < 4; ++j) { sv[0][j] = (float)s8[j]; sv[1][j] = (float)s8[4 + j]; } }
                    else { sv[0] = *(const f32x4*)((const float*)src + off); sv[1] = *(const f32x4*)((const float*)src + off + 4); }
#pragma unroll
                    for (int n = 0; n < 2; ++n) {
                        const f32x4 o = sv[n] + alpha * acc[ai][bj][m][n];
#pragma unroll
                        for (int j = 0; j < 4; ++j) h[4 * n + j] = (f16)o[j];
                        part += (o[0] * o[0] + o[1] * o[1]) + (o[2] * o[2] + o[3] * o[3]);
                    }
                    *(half8*)(h16 + off) = h;
                }
                part += __shfl_xor(part, 16); part += __shfl_xor(part, 32);
                if (fq == 0) ss[(size_t)row * 16 + u.pn * 4 + wc] = part;
            }
    }
};
constexpr float KV_SCALE = 16.0f;
constexpr float K_I8_SCALE = 127.0f / 8.0f;
__device__ __forceinline__ unsigned pack_fp8x4(f32x4 v) {
#pragma unroll
    for (int j = 0; j < 4; ++j) v[j] = fminf(fmaxf(v[j], -448.f), 448.f);
    int w = __builtin_amdgcn_cvt_pk_fp8_f32(v[0], v[1], 0, false); w = __builtin_amdgcn_cvt_pk_fp8_f32(v[2], v[3], w, true); return (unsigned)w;
}
__device__ __forceinline__ void rope8(const f32x4 (&x1)[2], const f32x4 (&x2)[2], const f32x2* rp, float sc, float (&o1)[8], float (&o2)[8]) {
#pragma unroll
    for (int n = 0; n < 2; ++n) {
        const f32x4 cs0 = *(const f32x4*)(rp + 4 * n), cs1 = *(const f32x4*)(rp + 4 * n + 2);
        o1[4 * n + 0] = (x1[n][0] * cs0[0] - x2[n][0] * cs0[1]) * sc; o2[4 * n + 0] = (x2[n][0] * cs0[0] + x1[n][0] * cs0[1]) * sc;
        o1[4 * n + 1] = (x1[n][1] * cs0[2] - x2[n][1] * cs0[3]) * sc; o2[4 * n + 1] = (x2[n][1] * cs0[2] + x1[n][1] * cs0[3]) * sc;
        o1[4 * n + 2] = (x1[n][2] * cs1[0] - x2[n][2] * cs1[1]) * sc; o2[4 * n + 2] = (x2[n][2] * cs1[0] + x1[n][2] * cs1[1]) * sc;
        o1[4 * n + 3] = (x1[n][3] * cs1[2] - x2[n][3] * cs1[3]) * sc; o2[4 * n + 3] = (x2[n][3] * cs1[2] + x1[n][3] * cs1[3]) * sc;
    }
}
__device__ __forceinline__ u32x2 pack_i8x8(const float (&v)[8]) {
    u32x2 r;
#pragma unroll
    for (int w = 0; w < 2; ++w) { unsigned word = 0u;
#pragma unroll
        for (int j = 0; j < 4; ++j) { const int q = (int)__builtin_rintf(fminf(fmaxf(v[4 * w + j] * K_I8_SCALE, -127.f), 127.f)); word |= ((unsigned)q & 0xffu) << (8 * j); }
        r[w] = word; }
    return r;
}
__device__ __forceinline__ u32x2 pack_bf8x8(const float (&v)[8]) {
    u32x2 r;
#pragma unroll
    for (int w = 0; w < 2; ++w) { int word = __builtin_amdgcn_cvt_pk_bf8_f32(v[4 * w], v[4 * w + 1], 0, false); word = __builtin_amdgcn_cvt_pk_bf8_f32(v[4 * w + 2], v[4 * w + 3], word, true); r[w] = (unsigned)word; }
    return r;
}
__device__ __forceinline__ u32x2 pack_fp8x8(const float (&v)[8]) { u32x2 r; r[0] = pack_fp8x4((f32x4){v[0], v[1], v[2], v[3]}); r[1] = pack_fp8x4((f32x4){v[4], v[5], v[6], v[7]}); return r; }
struct EpiInProj {
    const float* ss; const f32x2* rope; unsigned char* ws;
    __device__ __forceinline__ void operator()(const f32x4 (&acc)[2][2][4][2], const pg8::Unit& u, int wr, int wc, int fr_, int fq_) const {
        int fr = fr_, fq = fq_; asm volatile("" : "+v"(fr), "+v"(fq));
        const int pn = u.pn;
        if (pn >= 8 && pn <= 11) {
            unsigned char* lb = (pn <= 9) ? ws + WS_KV + (size_t)((pn - 8) * 4 + wc) * LP * 128 + 8 * fq
                                          : ws + WS_KV + (size_t)((pn - 10) * 4 + (wc >> 1)) * LP * 128 + 64 + (wc & 1) * 32 + 8 * fq;
#pragma unroll
            for (int ai = 0; ai < 2; ++ai)
#pragma unroll
                for (int m = 0; m < 4; ++m) {
                    const int p = u.pm * 256 + ai * 128 + wr * 64 + m * 16 + fr;
                    const int t = p < SEQ ? p + NMETA : p - SEQ;
                    if (p < L) {
                        const float sc = row_rstd(ss, 16, p);
                        if (pn <= 9) {
                            float o1[8], o2[8]; rope8(acc[ai][0][m], acc[ai][1][m], rope + (size_t)t * 32 + 8 * fq, sc, o1, o2);
                            unsigned char* d8 = lb + (size_t)t * 128; *(u32x2*)d8 = pack_i8x8(o1); *(u32x2*)(d8 + 32) = pack_i8x8(o2);
                        } else {
#pragma unroll
                            for (int bj = 0; bj < 2; ++bj) { float v[8];
#pragma unroll
                                for (int j = 0; j < 4; ++j) { v[j] = acc[ai][bj][m][0][j] * sc; v[4 + j] = acc[ai][bj][m][1][j] * sc; }
                                *(u32x2*)(lb + (size_t)t * 128 + (size_t)bj * 2 * LP * 128) = pack_bf8x8(v); }
                        }
                    }
                    asm volatile("" ::: "memory");
                }
            return;
        }
        int mode = 0, stride = 256; float scale = 1.0f; f16* lanebase;
        if (pn == 0) lanebase = (f16*)(ws + WS_GQ) + wc * 32 + 8 * fq;
        else if (pn == 1) lanebase = (f16*)(ws + WS_GK) + wc * 32 + 8 * fq;
        else if (pn <= 3) { lanebase = (f16*)(ws + WS_GV) + (pn - 2) * 256 + wc * 32 + 8 * fq; stride = 512; }
        else if (pn <= 5) { lanebase = (f16*)(ws + WS_GR) + (pn - 4) * 256 + wc * 32 + 8 * fq; stride = 512; }
        else if (pn <= 7) { lanebase = (f16*)(ws + WS_DQ) + (pn - 6) * 256 + wc * 64 + 8 * fq; stride = 512; mode = 1; scale = 0.125f; }
        else if (pn <= 13) { lanebase = (f16*)(ws + WS_IQ) + (pn - 12) * 256 + wc * 64 + 8 * fq; stride = 512; mode = 1; scale = 0.125f; }
        else { lanebase = (f16*)(ws + WS_IK) + 8 * fq; stride = 64; mode = wc == 0 ? 1 : (wc == 1 ? 2 : 3); }
#pragma unroll
        for (int ai = 0; ai < 2; ++ai)
#pragma unroll
            for (int m = 0; m < 4; ++m) {
                const int p = u.pm * 256 + ai * 128 + wr * 64 + m * 16 + fr;
                const int t = p < SEQ ? p + NMETA : p - SEQ;
                if (p < L && mode != 3) {
                    const float rs = row_rstd(ss, 16, p);
                    if (mode == 1) {
                        float o1[8], o2[8]; rope8(acc[ai][0][m], acc[ai][1][m], rope + (size_t)t * 32 + 8 * fq, rs * scale, o1, o2);
                        half8 h1, h2;
#pragma unroll
                        for (int j = 0; j < 8; ++j) { h1[j] = (f16)o1[j]; h2[j] = (f16)o2[j]; }
                        f16* dst = lanebase + (size_t)t * stride; *(half8*)dst = h1; *(half8*)(dst + 32) = h2;
                    } else if (mode == 2) {
                        if (fq < 2) { float* gp = (float*)(ws + WS_GA) + (size_t)t * 16 + 8 * fq; *(f32x4*)gp = acc[ai][0][m][0] * rs; *(f32x4*)(gp + 4) = acc[ai][0][m][1] * rs; }
                        else if (fq == 2) { float* ip = (float*)(ws + WS_IW) + (size_t)t * 8; const float r2 = rs * 0.35355339059327373f; *(f32x4*)ip = acc[ai][0][m][0] * r2; *(f32x4*)(ip + 4) = acc[ai][0][m][1] * r2; }
                    } else {
#pragma unroll
                        for (int bj = 0; bj < 2; ++bj) { half8 h;
#pragma unroll
                            for (int j = 0; j < 4; ++j) { h[j] = (f16)(acc[ai][bj][m][0][j] * rs); h[4 + j] = (f16)(acc[ai][bj][m][1][j] * rs); }
                            *(half8*)(lanebase + (size_t)t * stride + bj * 128) = h; }
                    }
                }
                asm volatile("" ::: "memory");
            }
    }
};

__device__ __forceinline__ const float* w_src(const Params& P, int kind, int n, int& ld, const float*& gain) {
    switch (kind) {
    case 0: case 4: { const int pn = n >> 8, bj = (n >> 7) & 1, cc = n & 127; ld = DFF; gain = kind == 0 ? P.n1 : P.n2;
        const float* w = kind == 0 ? (bj ? P.wu1 : P.wg1) : (bj ? P.wu2 : P.wg2); return w + pn * 128 + cc; }
    case 1: ld = D; gain = nullptr; return P.wd1 + n;
    case 5: ld = D; gain = nullptr; return P.wd2 + n;
    case 3: ld = D; gain = nullptr; return P.wout + n;
    default: { ld = 3672; gain = P.nmix; const int pn = n >> 8, c = n & 255, bj = c >> 7, hh = (c >> 5) & 3, dd = c & 31; int j;
        if (pn == 0) j = c; else if (pn == 1) j = 256 + c; else if (pn <= 3) j = 512 + (pn - 2) * 256 + c; else if (pn <= 5) j = 1024 + (pn - 4) * 256 + c;
        else if (pn <= 7) j = 1552 + (pn - 6) * 256 + hh * 64 + bj * 32 + dd;
        else if (pn <= 9) j = 2064 + (pn - 8) * 256 + hh * 64 + bj * 32 + dd;
        else if (pn <= 11) j = 2576 + (pn - 10) * 256 + c;
        else if (pn <= 13) j = 3088 + (pn - 12) * 256 + hh * 64 + bj * 32 + dd;
        else { if (c < 32) j = 3600 + c; else if (c < 48) j = 1536 + (c - 32); else if (c < 56) j = 3664 + (c - 48); else if (c >= 128 && c < 160) j = 3600 + 32 + (c - 128); else j = -1; }
        return j < 0 ? nullptr : P.win + j; }
    }
}
__device__ __forceinline__ void prep_weight(const Params& P, const int kind, const int N, const int K, f16* dst, int& cursor, int& tbase, LAS f16* tl) {
    const int tid = threadIdx.x, G = gridDim.x, tn = N / 64, tk = K / 256, ntile = tn * tk;
#pragma unroll 1
    for (; cursor < tbase + ntile; cursor += G) {
        const int tI = cursor - tbase, n0 = (tI % tn) * 64, k0 = (tI / tn) * 256;
        { const int n = tid & 63, kk0 = tid >> 6; int ld; const float* gain; const float* col = w_src(P, kind, n0 + n, ld, gain);
          float v[32];
#pragma unroll
          for (int i = 0; i < 32; ++i) v[i] = col ? col[(size_t)(k0 + kk0 + 8 * i) * ld] : 0.f;
          if (gain) {
#pragma unroll
              for (int i = 0; i < 32; ++i) v[i] *= gain[k0 + kk0 + 8 * i];
          }
#pragma unroll
          for (int i = 0; i < 32; ++i) tl[n * 264 + kk0 + 8 * i] = (f16)v[i]; }
        __syncthreads();
        { const int n = tid >> 3, seg = tid & 7;
#pragma unroll
          for (int j = 0; j < 4; ++j) *(half8*)(dst + (size_t)(n0 + n) * K + k0 + (seg + 8 * j) * 8) = *(const LAS half8*)(tl + n * 264 + (seg + 8 * j) * 8); }
        __syncthreads();
    }
    tbase += ntile;
}
__device__ __forceinline__ void p0_prologue(const Params& P, LAS unsigned char* lds) {
    const int tid = threadIdx.x, bid = blockIdx.x, G = gridDim.x, lane = tid & 63;
    unsigned char* ws = P.ws;
    int tbase = 0, cursor = bid;
    LAS f16* tl = (LAS f16*)lds;
    prep_weight(P, 0, 2 * DFF, D, (f16*)(ws + WS_WGU1), cursor, tbase, tl);
    prep_weight(P, 1, D, DFF, (f16*)(ws + WS_WD1), cursor, tbase, tl);
    prep_weight(P, 2, NIN, D, (f16*)(ws + WS_WIN), cursor, tbase, tl);
    float* ss0 = (float*)(ws + WS_SS0);
    f16* acta = (f16*)(ws + WS_ACTA);
    const int gw = bid * 8 + (tid >> 6), nw = G * 8;
    for (int p = gw; p < L; p += nw) {
        const float* src = p < SEQ ? P.x + (size_t)p * D : P.meta + (size_t)(p - SEQ) * D; float s = 0.f;
#pragma unroll
        for (int i = 0; i < 4; ++i) { const f32x4 v = *(const f32x4*)(src + lane * 4 + 256 * i); s += (v[0] * v[0] + v[1] * v[1]) + (v[2] * v[2] + v[3] * v[3]); *(half4*)(acta + (size_t)p * D + lane * 4 + 256 * i) = to_half4(v); }
#pragma unroll
        for (int o = 32; o >= 1; o >>= 1) s += __shfl_xor(s, o);
        if (lane == 0) ss0[p] = s;
    }
    const int gt = bid * NTHREADS + tid, ngt = G * NTHREADS;
    for (int i = gt; i < MP; i += ngt) { if (i >= L) ss0[i] = (float)D; }
    f32x2* rope = (f32x2*)(ws + WS_ROPE);
    for (int i = gt; i < L * 32; i += ngt) { const int t = i >> 5, f = i & 31; const double inv = exp(-(double)f * (9.210340371976184 / 32.0)); double sn, cs; sincos((double)t * inv, &sn, &cs); rope[i] = (f32x2){(float)cs, (float)sn}; }
}

__device__ __forceinline__ void meta_down(const Params& P, LAS unsigned char* lds) {
    const int tid = threadIdx.x, lane = tid & 63, wid = tid >> 6;
    const f16* Gm = (const f16*)(P.ws + WS_G) + (size_t)SEQ * DFF; const f16* Wt = (const f16*)(P.ws + WS_WD1);
    f16* acta = (f16*)P.out; float* ss1 = (float*)(P.ws + WS_SS1); LAS float* slot = (LAS float*)lds;
    for (int task = blockIdx.x; task < NMETA * 16; task += gridDim.x) {
        const int r = task >> 4, cg = task & 15; float part = 0.f;
#pragma unroll 1
        for (int q = 0; q < 2; ++q) {
            const int n0 = cg * 64 + (2 * wid + q) * 4; float a[4] = {0.f, 0.f, 0.f, 0.f};
            for (int kc = lane; kc < DFF / 8; kc += 64) {
                const half8 gv = *(const half8*)(Gm + (size_t)r * DFF + kc * 8);
#pragma unroll
                for (int j = 0; j < 4; ++j) { const half8 wv = *(const half8*)(Wt + (size_t)(n0 + j) * DFF + kc * 8);
#pragma unroll
                    for (int e = 0; e < 8; ++e) a[j] += (float)gv[e] * (float)wv[e]; }
            }
#pragma unroll
            for (int o = 32; o >= 1; o >>= 1) { a[0] += __shfl_xor(a[0], o); a[1] += __shfl_xor(a[1], o); a[2] += __shfl_xor(a[2], o); a[3] += __shfl_xor(a[3], o); }
            f32x4 o;
#pragma unroll
            for (int j = 0; j < 4; ++j) { o[j] = P.meta[r * D + n0 + j] + 0.5f * a[j]; part += o[j] * o[j]; }
            if (lane == 0) *(half4*)(acta + (size_t)(SEQ + r) * D + n0) = to_half4(o);
        }
        if (lane == 0) slot[wid] = part;
        __syncthreads();
        if (tid == 0) { float s = 0.f; for (int w = 0; w < 8; ++w) s += slot[w]; ss1[(size_t)(SEQ + r) * 16 + cg] = s; }
        __syncthreads();
    }
}

__device__ __forceinline__ float logsigmoid_f(float z) { return fminf(z, 0.f) - __logf(1.0f + __expf(-fabsf(z))); }
__device__ __forceinline__ void gla_gates(const Params& P, int c, int h, LAS float* bl) {
    const int tid = threadIdx.x, ti = tid >> 3, d0 = (tid & 7) * 8, tt = 64 * c - 48 + ti; const float* GA = (const float*)(P.ws + WS_GA);
    {
        float z[8];
        if (tt >= 0 && tt < L) {
            const f32x4 b0 = *(const f32x4*)(P.ba + 64 * h + d0), b1 = *(const f32x4*)(P.ba + 64 * h + d0 + 4);
#pragma unroll
            for (int m = 0; m < 4; ++m) { z[m] = b0[m]; z[4 + m] = b1[m]; }
            f32x4 a4[4];
#pragma unroll
            for (int q = 0; q < 4; ++q) a4[q] = *(const f32x4*)(GA + (size_t)tt * 16 + 4 * q);
#pragma unroll
            for (int r = 0; r < 16; ++r) { const float ar = a4[r >> 2][r & 3]; const f32x4 w0 = *(const f32x4*)(P.wa2 + r * 256 + 64 * h + d0), w1 = *(const f32x4*)(P.wa2 + r * 256 + 64 * h + d0 + 4);
#pragma unroll
                for (int m = 0; m < 4; ++m) { z[m] += ar * w0[m]; z[4 + m] += ar * w1[m]; } }
#pragma unroll
            for (int m = 0; m < 8; ++m) z[m] = logsigmoid_f(z[m]) * (1.0f / 16.0f);
        } else {
#pragma unroll
            for (int m = 0; m < 8; ++m) z[m] = 0.f;
        }
#pragma unroll
        for (int m = 0; m < 8; ++m) bl[ti * 65 + d0 + m] = z[m];
    }
    __syncthreads();
    {
        const int d = tid & 63, seg = tid >> 6; float v[8], run = 0.f;
#pragma unroll
        for (int i = 0; i < 8; ++i) { run += bl[(seg * 8 + i) * 65 + d]; v[i] = run; }
#pragma unroll
        for (int i = 0; i < 8; ++i) bl[(seg * 8 + i) * 65 + d] = v[i];
        __syncthreads();
        float off = 0.f;
#pragma unroll
        for (int sg = 0; sg < 7; ++sg) off += (sg < seg) ? bl[(sg * 8 + 7) * 65 + d] : 0.f;
        __syncthreads();
#pragma unroll
        for (int i = 0; i < 8; ++i) bl[(seg * 8 + i) * 65 + d] = v[i] + off;
    }
    __syncthreads();
}
__device__ __forceinline__ void gla_a_unit(const Params& P, int unit, LAS unsigned char* lds) {
    int tid_ = threadIdx.x; asm volatile("" : "+v"(tid_));
    const int tid = tid_, lane = tid & 63, wid = tid >> 6, c = unit >> 2, h = unit & 3;
    LAS float* bl = (LAS float*)lds; LAS float* ks = bl + 4160; LAS float* vs = ks + 4096;
    const f16* GK = (const f16*)(P.ws + WS_GK); const f16* GV = (const f16*)(P.ws + WS_GV);
    float* U = (float*)(P.ws + WS_US); float* DEC = (float*)(P.ws + WS_DECAY);
    const int ti = tid >> 3, d0 = (tid & 7) * 8, tt = 64 * c - 48 + ti; const bool tv = tt >= 0 && tt < L;
    half8 k8, v8[2];
#pragma unroll
    for (int m = 0; m < 8; ++m) { k8[m] = (f16)0.f; v8[0][m] = (f16)0.f; v8[1][m] = (f16)0.f; }
    if (tv) k8 = *(const half8*)(GK + (size_t)tt * 256 + 64 * h + d0);
#pragma unroll
    for (int q = 0; q < 2; ++q) { const int ch = tid + 512 * q, j = ch >> 4, t = 64 * c - 48 + j; if (t >= 0 && t < L) v8[q] = *(const half8*)(GV + (size_t)t * 512 + 128 * h + (ch & 15) * 8); }
    gla_gates(P, c, h, bl);
    { f32x4 o0, o1;
#pragma unroll
      for (int m = 0; m < 4; ++m) { o0[m] = (float)k8[m] * __expf(bl[63 * 65 + d0 + m] - bl[ti * 65 + d0 + m]); o1[m] = (float)k8[4 + m] * __expf(bl[63 * 65 + d0 + 4 + m] - bl[ti * 65 + d0 + 4 + m]); }
      *(LAS f32x4*)(ks + ti * 64 + d0) = o0; *(LAS f32x4*)(ks + ti * 64 + d0 + 4) = o1; }
#pragma unroll
    for (int q = 0; q < 2; ++q) { const int ch = tid + 512 * q, j = ch >> 4, e0 = (ch & 15) * 8; f32x4 o0, o1;
#pragma unroll
        for (int m = 0; m < 4; ++m) { o0[m] = (float)v8[q][m]; o1[m] = (float)v8[q][4 + m]; }
        *(LAS f32x4*)(vs + j * 128 + e0) = o0; *(LAS f32x4*)(vs + j * 128 + e0 + 4) = o1; }
    if (tid < 64) DEC[(size_t)c * 256 + h * 64 + tid] = __expf(bl[63 * 65 + tid]);
    __syncthreads();
    { const int dd0 = (wid >> 2) * 32, e0 = (wid & 3) * 32, l31 = lane & 31, hf = lane >> 5; f32x16 acc;
#pragma unroll
      for (int i = 0; i < 16; ++i) acc[i] = 0.f;
#pragma unroll 8
      for (int s = 0; s < 32; ++s) acc = __builtin_amdgcn_mfma_f32_32x32x2f32(ks[(2 * s + hf) * 64 + dd0 + l31], vs[(2 * s + hf) * 128 + e0 + l31], acc, 0, 0, 0);
      float* up = U + ((size_t)unit * 64) * 128;
#pragma unroll
      for (int r = 0; r < 16; ++r) { const int row = (r & 3) + 8 * (r >> 2) + 4 * hf; up[(size_t)(dd0 + row) * 128 + e0 + l31] = acc[r]; } }
    __syncthreads();
}
__device__ __forceinline__ void gla_scan(const Params& P) {
    float* U = (float*)(P.ws + WS_US); const float* DEC = (const float*)(P.ws + WS_DECAY);
    const int idx = blockIdx.x * NTHREADS + threadIdx.x;
    if (idx >= 32768) return;
    float s = 0.f;
#pragma unroll 8
    for (int c = 0; c < NCH; ++c) { const float u = U[(size_t)c * 32768 + idx], dc = DEC[(size_t)c * 256 + (idx >> 7)]; U[(size_t)c * 32768 + idx] = s; s = dc * s + u; }
}
__device__ __forceinline__ void gla_c_unit(const Params& P, int unit, LAS unsigned char* lds) {
    int tid_ = threadIdx.x; asm volatile("" : "+v"(tid_));
    const int tid = tid_, lane = tid & 63, wid = tid >> 6, c = unit >> 2, h = unit & 3, l31 = lane & 31, hf = lane >> 5;
    LAS float* bl = (LAS float*)lds; LAS float* kk = bl + 4160; LAS float* qs = kk + 4160; LAS float* As = qs + 4160; LAS float* vs = As + 4160; LAS float* Ss = vs + 8192; LAS float* os = bl;
    const f16* GQ = (const f16*)(P.ws + WS_GQ); const f16* GK = (const f16*)(P.ws + WS_GK); const f16* GV = (const f16*)(P.ws + WS_GV); const f16* GR = (const f16*)(P.ws + WS_GR);
    const float* Sg = (const float*)(P.ws + WS_US) + (size_t)unit * 8192; f16* mix = (f16*)(P.ws + WS_ACTA);
    const int ti = tid >> 3, d0 = (tid & 7) * 8, tt = 64 * c - 48 + ti; const bool tv = tt >= 0 && tt < L;
    half8 q8, k8, v8[2], r8[2]; f32x4 sreg[4];
#pragma unroll
    for (int m = 0; m < 8; ++m) { q8[m] = (f16)0.f; k8[m] = (f16)0.f; v8[0][m] = (f16)0.f; v8[1][m] = (f16)0.f; r8[0][m] = (f16)0.f; r8[1][m] = (f16)0.f; }
    if (tv) { q8 = *(const half8*)(GQ + (size_t)tt * 256 + 64 * h + d0); k8 = *(const half8*)(GK + (size_t)tt * 256 + 64 * h + d0);
        r8[0] = *(const half8*)(GR + (size_t)tt * 512 + 128 * h + (tid & 7) * 16); r8[1] = *(const half8*)(GR + (size_t)tt * 512 + 128 * h + (tid & 7) * 16 + 8); }
#pragma unroll
    for (int q = 0; q < 2; ++q) { const int ch = tid + 512 * q, j = ch >> 4, t = 64 * c - 48 + j; if (t >= 0 && t < L) v8[q] = *(const half8*)(GV + (size_t)t * 512 + 128 * h + (ch & 15) * 8); }
#pragma unroll
    for (int q = 0; q < 4; ++q) sreg[q] = *(const f32x4*)(Sg + (size_t)(tid + 512 * q) * 4);
    gla_gates(P, c, h, bl);
#pragma unroll
    for (int m = 0; m < 8; ++m) { const float bv = bl[ti * 65 + d0 + m]; qs[ti * 65 + d0 + m] = (float)q8[m] * 0.125f * __expf(bv); kk[ti * 65 + d0 + m] = (float)k8[m] * __expf(-bv); }
#pragma unroll
    for (int q = 0; q < 2; ++q) { const int ch = tid + 512 * q, j = ch >> 4, e0 = (ch & 15) * 8; f32x4 o0, o1;
#pragma unroll
        for (int m = 0; m < 4; ++m) { o0[m] = (float)v8[q][m]; o1[m] = (float)v8[q][4 + m]; }
        *(LAS f32x4*)(vs + j * 128 + e0) = o0; *(LAS f32x4*)(vs + j * 128 + e0 + 4) = o1; }
#pragma unroll
    for (int q = 0; q < 4; ++q) *(LAS f32x4*)(Ss + (tid + 512 * q) * 4) = sreg[q];
    __syncthreads();
    if (wid < 4) { const int i0 = (wid >> 1) * 32, j0 = (wid & 1) * 32; f32x16 acc;
#pragma unroll
        for (int i = 0; i < 16; ++i) acc[i] = 0.f;
#pragma unroll 8
        for (int s = 0; s < 32; ++s) acc = __builtin_amdgcn_mfma_f32_32x32x2f32(qs[(i0 + l31) * 65 + 2 * s + hf], kk[(j0 + l31) * 65 + 2 * s + hf], acc, 0, 0, 0);
#pragma unroll
        for (int r = 0; r < 16; ++r) { const int i = i0 + (r & 3) + 8 * (r >> 2) + 4 * hf, j = j0 + l31; As[i * 65 + j] = (j <= i) ? acc[r] : 0.f; } }
    __syncthreads();
    { const int i0 = (wid >> 2) * 32, e0 = (wid & 3) * 32; f32x16 acc;
#pragma unroll
      for (int i = 0; i < 16; ++i) acc[i] = 0.f;
#pragma unroll 8
      for (int s = 0; s < 32; ++s) acc = __builtin_amdgcn_mfma_f32_32x32x2f32(qs[(i0 + l31) * 65 + 2 * s + hf], Ss[(2 * s + hf) * 128 + e0 + l31], acc, 0, 0, 0);
#pragma unroll 8
      for (int s = 0; s < 32; ++s) acc = __builtin_amdgcn_mfma_f32_32x32x2f32(As[(i0 + l31) * 65 + 2 * s + hf], vs[(2 * s + hf) * 128 + e0 + l31], acc, 0, 0, 0);
#pragma unroll
      for (int r = 0; r < 16; ++r) { const int i = i0 + (r & 3) + 8 * (r >> 2) + 4 * hf; os[i * 129 + e0 + l31] = acc[r]; } }
    __syncthreads();
    { const int e0 = (tid & 7) * 16; float o[16], sq = 0.f;
#pragma unroll
      for (int j = 0; j < 16; ++j) { o[j] = os[ti * 129 + e0 + j]; sq += o[j] * o[j]; }
      sq += __shfl_xor(sq, 1); sq += __shfl_xor(sq, 2); sq += __shfl_xor(sq, 4);
      const float rs = rsqrtf(sq * (1.0f / 128.0f) + EPS);
      if (tt >= NMETA && tt < L) { half8 w0, w1;
#pragma unroll
          for (int j = 0; j < 8; ++j) { w0[j] = (f16)(o[j] * rs * P.hn[e0 + j] * silu_f((float)r8[0][j])); w1[j] = (f16)(o[8 + j] * rs * P.hn[e0 + 8 + j] * silu_f((float)r8[1][j])); }
          f16* dst = mix + (size_t)(tt - NMETA) * D + 128 * h + e0; *(half8*)dst = w0; *(half8*)(dst + 8) = w1; } }
    __syncthreads();
}

__device__ __forceinline__ unsigned mono_u(float f) { const unsigned u = __float_as_uint(f); return (u & 0x80000000u) ? ~u : (u | 0x80000000u); }
__device__ __forceinline__ float unmono_f(unsigned m) { return __uint_as_float((m & 0x80000000u) ? (m & 0x7fffffffu) : ~m); }
__device__ __forceinline__ unsigned wave_umax(unsigned v) {
    v = max(v, (unsigned)__builtin_amdgcn_update_dpp(0, (int)v, 0x111, 0xf, 0xf, false));
    v = max(v, (unsigned)__builtin_amdgcn_update_dpp(0, (int)v, 0x112, 0xf, 0xf, false));
    v = max(v, (unsigned)__builtin_amdgcn_update_dpp(0, (int)v, 0x114, 0xf, 0xf, false));
    v = max(v, (unsigned)__builtin_amdgcn_update_dpp(0, (int)v, 0x118, 0xf, 0xf, false));
    v = max(v, (unsigned)__builtin_amdgcn_update_dpp(0, (int)v, 0x142, 0xa, 0xf, false));
    v = max(v, (unsigned)__builtin_amdgcn_update_dpp(0, (int)v, 0x143, 0xc, 0xf, false));
    return (unsigned)__builtin_amdgcn_readlane((int)v, 63);
}
constexpr int CAP = 640, NPL = CAP / 64;
__device__ __forceinline__ int topk_compact(LAS float* cs, LAS unsigned short* ci, int n, bool exact, float& tau_out, int lane) {
    float sv[NPL]; unsigned iv[NPL], u[NPL];
#pragma unroll
    for (int i = 0; i < NPL; ++i) { const int p = lane + 64 * i; const bool v = p < n; sv[i] = v ? cs[p] : 0.f; iv[i] = v ? (unsigned)ci[p] : 0xffffu; u[i] = v ? mono_u(sv[i]) : 0u; }
    unsigned T = 0u; bool full = true; int hb = 31;
    {
        unsigned umx = 0u, umn = 0xffffffffu;
#pragma unroll
        for (int i = 0; i < NPL; ++i) { umx = max(umx, u[i]); umn = min(umn, (lane + 64 * i < n) ? u[i] : 0xffffffffu); }
        umx = wave_umax(umx); umn = ~wave_umax(~umn);
        const unsigned df = umx ^ umn;
        if (df == 0u) { hb = -1; T = umx; } else { hb = 31 - __clz(df); T = (hb == 31) ? 0u : (umx & ~((2u << hb) - 1u)); }
    }
#pragma unroll 1
    for (int bit = hb; bit >= 0; --bit) {
        const unsigned cand = T | (1u << bit); int cgt = 0;
#pragma unroll
        for (int i = 0; i < NPL; ++i) cgt += __popcll(__ballot(u[i] >= cand));
        if (cgt >= 256) { T = cand; if (!exact && cgt <= 272) { full = false; break; } }
    }
    bool keep[NPL];
    if (full) {
        int cgt = 0;
#pragma unroll
        for (int i = 0; i < NPL; ++i) cgt += __popcll(__ballot(u[i] > T));
        const int need = 256 - cgt; unsigned I = 0xffffu; int nties = 0;
#pragma unroll
        for (int i = 0; i < NPL; ++i) nties += __popcll(__ballot(u[i] == T));
        if (nties != need) { I = 0u;
#pragma unroll 1
        for (int bit = 15; bit >= 0; --bit) { const unsigned cand = I | (1u << bit); int cl = 0;
#pragma unroll
            for (int i = 0; i < NPL; ++i) cl += __popcll(__ballot(u[i] == T && iv[i] < cand));
            if (cl < need) I = cand; } }
#pragma unroll
        for (int i = 0; i < NPL; ++i) keep[i] = (u[i] > T) || (u[i] == T && iv[i] <= I);
    } else {
#pragma unroll
        for (int i = 0; i < NPL; ++i) keep[i] = u[i] >= T;
    }
    int nn = 0;
#pragma unroll
    for (int i = 0; i < NPL; ++i) { const unsigned long long m = __ballot(keep[i]); const int pre = __builtin_amdgcn_mbcnt_hi((unsigned)(m >> 32), __builtin_amdgcn_mbcnt_lo((unsigned)m, 0u));
        if (keep[i]) { cs[nn + pre] = sv[i]; ci[nn + pre] = (unsigned short)iv[i]; } nn += __popcll(m); }
    tau_out = unmono_f(T);
    return nn;
}
__device__ __forceinline__ float relu_asm(float x) { return __int_as_float(max(__float_as_int(x), 0)); }
__device__ __forceinline__ void indexer_tile(const Params& P, int tile, LAS unsigned char* lds) {
    int tid_ = threadIdx.x; asm volatile("" : "+v"(tid_));
    const int tid = tid_, lane = tid & 63, wid = __builtin_amdgcn_readfirstlane(tid >> 6), l31 = lane & 31, hf = lane >> 5;
    LAS float* candS = (LAS float*)lds;
    LAS unsigned short* candI = (LAS unsigned short*)(lds + 32 * CAP * 4);
    LAS unsigned char* kbuf = lds + 32 * CAP * 6;
    LAS int* lcnt = (LAS int*)(lds + LDS_BYTES - 1024 + 64);
    LAS int* lflag = (LAS int*)(lds + LDS_BYTES - 1024 + 192);
    const f16* IQ = (const f16*)(P.ws + WS_IQ); const f16* IK = (const f16*)(P.ws + WS_IK); const float* IW = (const float*)(P.ws + WS_IW);
    unsigned short* SEL = (unsigned short*)(P.ws + WS_SEL);
    const int t0 = tile * 32, tw = t0 + wid * 4;
    half8 afr[4];
    { const int qi = 2 * (l31 >> 4) + ((l31 >> 2) & 1), hd = 4 * ((l31 >> 3) & 1) + (l31 & 3); int tq = tw + qi; if (tq > L - 1) tq = L - 1;
      const half8* ap = (const half8*)(IQ + (size_t)tq * 512 + hd * 64);
#pragma unroll
      for (int s = 0; s < 4; ++s) afr[s] = ap[2 * s + hf]; }
    float w0[8], w1[8];
    { int ta = tw + hf, tb = tw + 2 + hf; if (ta > L - 1) ta = L - 1; if (tb > L - 1) tb = L - 1;
#pragma unroll
      for (int h = 0; h < 8; ++h) { w0[h] = IW[(size_t)ta * 8 + h]; w1[h] = IW[(size_t)tb * 8 + h]; } }
    asm volatile("" :: "v"(afr[0]), "v"(afr[1]), "v"(afr[2]), "v"(afr[3]));
    asm volatile("" :: "v"(w0[0]), "v"(w0[1]), "v"(w0[2]), "v"(w0[3]), "v"(w0[4]), "v"(w0[5]), "v"(w0[6]), "v"(w0[7]));
    asm volatile("" :: "v"(w1[0]), "v"(w1[1]), "v"(w1[2]), "v"(w1[3]), "v"(w1[4]), "v"(w1[5]), "v"(w1[6]), "v"(w1[7]));
    const int tq0 = (tw + hf < L) ? tw + hf : -1, tq1 = (tw + 2 + hf < L) ? tw + 2 + hf : -1;
    float tau0 = -__builtin_inff(), tau1 = -__builtin_inff();
    int cntv = 0;
    if (lane < 4) lcnt[wid * 4 + lane] = 0;
    if (tid < 3) lflag[tid] = 0;
    const int nkeys = (t0 + 32 < L) ? t0 + 32 : L, nst = (nkeys + 127) >> 7;
    u32x4 stg[2];
    const u32x4* IKv = (const u32x4*)IK;
#pragma unroll
    for (int i = 0; i < 2; ++i) stg[i] = IKv[(size_t)0 * 1024 + tid + 512 * i];
#pragma unroll
    for (int i = 0; i < 2; ++i) { const int ci = tid + 512 * i, row = ci >> 3, ch = ci & 7; *(LAS u32x4*)(kbuf + row * 128 + ((ch ^ ((row >> 1) & 7)) << 4)) = stg[i]; }
    __syncthreads();
#pragma unroll 1
    for (int st = 0; st < nst; ++st) {
        LAS unsigned char* kb = kbuf + (st & 1) * 16384;
        if (st + 1 < nst) {
#pragma unroll
            for (int i = 0; i < 2; ++i) stg[i] = IKv[(size_t)(st + 1) * 1024 + tid + 512 * i];
        }
#pragma unroll 1
        for (int sub = 0; sub < 4; sub += 2) {
            const int kbase = st * 128 + sub * 32;
            if (kbase > tw + 3) break;
            const int rowa = sub * 32 + l31, rowb = rowa + 32;
            f32x16 acca, accb;
#pragma unroll
            for (int i = 0; i < 16; ++i) { acca[i] = 0.f; accb[i] = 0.f; }
            half8 bfa[4], bfb[4];
#pragma unroll
            for (int s = 0; s < 4; ++s) { bfa[s] = *(const LAS half8*)(kb + rowa * 128 + (((2 * s + hf) ^ ((rowa >> 1) & 7)) << 4)); bfb[s] = *(const LAS half8*)(kb + rowb * 128 + (((2 * s + hf) ^ ((rowb >> 1) & 7)) << 4)); }
#pragma unroll
            for (int s = 0; s < 4; ++s) { acca = __builtin_amdgcn_mfma_f32_32x32x16_f16(afr[s], bfa[s], acca, 0, 0, 0); accb = __builtin_amdgcn_mfma_f32_32x32x16_f16(afr[s], bfb[s], accb, 0, 0, 0); }
#pragma unroll
            for (int part = 0; part < 2; ++part) {
                const int key = kbase + part * 32 + l31;
                float s0 = 0.f, s1 = 0.f;
#pragma unroll
                for (int h = 0; h < 8; ++h) { s0 = __builtin_fmaf(w0[h], relu_asm(part ? accb[h] : acca[h]), s0); s1 = __builtin_fmaf(w1[h], relu_asm(part ? accb[8 + h] : acca[8 + h]), s1); }
                if (key <= tq0 && s0 > tau0) { const int qs = wid * 4 + hf; const int pos = (int)__hip_atomic_fetch_add(lcnt + qs, 1, __ATOMIC_RELAXED, __HIP_MEMORY_SCOPE_WORKGROUP); candS[qs * CAP + pos] = s0; candI[qs * CAP + pos] = (unsigned short)key; }
                if (key <= tq1 && s1 > tau1) { const int qs = wid * 4 + 2 + hf; const int pos = (int)__hip_atomic_fetch_add(lcnt + qs, 1, __ATOMIC_RELAXED, __HIP_MEMORY_SCOPE_WORKGROUP); candS[qs * CAP + pos] = s1; candI[qs * CAP + pos] = (unsigned short)key; }
            }
        }
        if (st + 1 < nst) {
            LAS unsigned char* kn = kbuf + ((st + 1) & 1) * 16384;
#pragma unroll
            for (int i = 0; i < 2; ++i) { const int ci = tid + 512 * i, row = ci >> 3, ch = ci & 7; *(LAS u32x4*)(kn + row * 128 + ((ch ^ ((row >> 1) & 7)) << 4)) = stg[i]; }
        }
        cntv = lcnt[wid * 4 + (lane & 3)];
        const int mx = max(max(__builtin_amdgcn_readlane(cntv, 0), __builtin_amdgcn_readlane(cntv, 1)), max(__builtin_amdgcn_readlane(cntv, 2), __builtin_amdgcn_readlane(cntv, 3)));
        if (mx > CAP - 128 && lane == 0) lflag[st % 3] = 1;
        if (tid == 0) lflag[(st + 1) % 3] = 0;
        __syncthreads();
        const int any = lflag[st % 3];
        if (any) {
#pragma unroll 1
            for (int qq = 0; qq < 4; ++qq) { const int n = __builtin_amdgcn_readlane(cntv, qq);
                if (n > 288) { float nt; const int nn = topk_compact(candS + (wid * 4 + qq) * CAP, candI + (wid * 4 + qq) * CAP, n, false, nt, lane);
                    if (lane == 0) lcnt[wid * 4 + qq] = nn;
                    if (hf == (qq & 1)) { if (qq < 2) tau0 = nt; else tau1 = nt; } } }
        }
    }
#pragma unroll 1
    for (int qq = 0; qq < 4; ++qq) {
        const int t = tw + qq; if (t >= L) break;
        int n = lcnt[wid * 4 + qq]; LAS float* cs = candS + (wid * 4 + qq) * CAP; LAS unsigned short* ci = candI + (wid * 4 + qq) * CAP;
        if (n > 256) { float nt; n = topk_compact(cs, ci, n, true, nt, lane); }
#pragma unroll
        for (int j = 0; j < 4; ++j) { const int p = lane + 64 * j; SEL[(size_t)t * 256 + p] = p < n ? ci[p] : (unsigned short)0xffffu; }
    }
    __syncthreads();
}

__device__ __forceinline__ void sparse_attn(const Params& P, LAS unsigned char* lds, int vbid) {
    int tid_ = threadIdx.x; asm volatile("" : "+v"(tid_));
    const int tid = tid_, lane = tid & 63, wid = tid >> 6, grp = lane >> 2, c4 = lane & 3;
    const int head = vbid & 7, slot = (vbid >> 3) * 8 + wid, nslot = (gridDim.x >> 3) * 8;
    typedef _Float16 half2v __attribute__((ext_vector_type(2)));
    LAS unsigned short* widx = (LAS unsigned short*)(lds + wid * 512);
    LAS float* red = (LAS float*)(lds + 4096 + wid * 4352);
    const unsigned short* SEL = (const unsigned short*)(P.ws + WS_SEL); const f16* DQ = (const f16*)(P.ws + WS_DQ);
    const unsigned char* kvh = P.ws + WS_KV + (size_t)head * LP * 128; f16* mix = (f16*)(P.ws + WS_ACTA);
    int t = NMETA + slot;
    u32x2 selr = {0u, 0u}; half8 qa, qb;
#pragma unroll
    for (int e = 0; e < 8; ++e) { qa[e] = (f16)0.f; qb[e] = (f16)0.f; }
    if (t < L) { selr = *(const u32x2*)(SEL + (size_t)t * 256 + lane * 4); qa = *(const half8*)(DQ + (size_t)t * 512 + head * 64 + c4 * 16); qb = *(const half8*)(DQ + (size_t)t * 512 + head * 64 + c4 * 16 + 8); }
#pragma unroll 1
    for (; t < L; t += nslot) {
        *(LAS u32x2*)(widx + lane * 4) = selr;
        unsigned keys[16]; u32x4 kreg[16], vreg[16];
#pragma unroll
        for (int it = 0; it < 16; ++it) keys[it] = widx[16 * it + grp];
#pragma unroll
        for (int it = 0; it < 16; ++it) { const unsigned kk = keys[it] != 0xffffu ? keys[it] : 0u; kreg[it] = *(const u32x4*)(kvh + (size_t)kk * 128 + c4 * 16); }
#pragma unroll
        for (int it = 0; it < 16; ++it) { const unsigned kk = keys[it] != 0xffffu ? keys[it] : 0u; vreg[it] = *(const u32x4*)(kvh + (size_t)kk * 128 + 64 + c4 * 16); }
        float qf[16], qmax = 1e-20f;
#pragma unroll
        for (int e = 0; e < 8; ++e) { qf[e] = (float)qa[e]; qf[8 + e] = (float)qb[e]; }
#pragma unroll
        for (int e = 0; e < 16; ++e) qmax = fmaxf(qmax, fabsf(qf[e]));
        qmax = fmaxf(qmax, __int_as_float(__builtin_amdgcn_update_dpp(0, __float_as_int(qmax), 0xB1, 0xf, 0xf, true)));
        qmax = fmaxf(qmax, __int_as_float(__builtin_amdgcn_update_dpp(0, __float_as_int(qmax), 0x4E, 0xf, 0xf, true)));
        const float qs = 127.0f * __builtin_amdgcn_rcpf(qmax), lscale = qmax * (1.0f / (127.0f * K_I8_SCALE));
        int q8[4];
#pragma unroll
        for (int w = 0; w < 4; ++w) { unsigned word = 0u;
#pragma unroll
            for (int j = 0; j < 4; ++j) { const int q = (int)__builtin_rintf(qf[4 * w + j] * qs); word |= ((unsigned)q & 0xffu) << (8 * j); }
            q8[w] = (int)word; }
        { const int tn = t + nslot;
          if (tn < L) { selr = *(const u32x2*)(SEL + (size_t)tn * 256 + lane * 4); qa = *(const half8*)(DQ + (size_t)tn * 512 + head * 64 + c4 * 16); qb = *(const half8*)(DQ + (size_t)tn * 512 + head * 64 + c4 * 16 + 8); } }
        float lg[16]; float mx = -__builtin_inff();
#pragma unroll
        for (int it = 0; it < 16; ++it) {
            int ai = 0;
#pragma unroll
            for (int w = 0; w < 4; ++w) ai = __builtin_amdgcn_sdot4((int)kreg[it][w], q8[w], ai, false);
            ai += __builtin_amdgcn_update_dpp(0, ai, 0xB1, 0xf, 0xf, true);
            ai += __builtin_amdgcn_update_dpp(0, ai, 0x4E, 0xf, 0xf, true);
            lg[it] = keys[it] != 0xffffu ? (float)ai * lscale : -__builtin_inff(); mx = fmaxf(mx, lg[it]);
        }
        mx = fmaxf(mx, __shfl_xor(mx, 4)); mx = fmaxf(mx, __shfl_xor(mx, 8)); mx = fmaxf(mx, __shfl_xor(mx, 16)); mx = fmaxf(mx, __shfl_xor(mx, 32));
        half2v o2[8]; float lsum = 0.f;
#pragma unroll
        for (int e = 0; e < 8; ++e) o2[e] = (half2v){(f16)0.f, (f16)0.f};
#pragma unroll
        for (int it = 0; it < 16; ++it) {
            const float p = __expf(lg[it] - mx); lsum += p; const f16 ph = (f16)p; const half2v p2 = {ph, ph};
#pragma unroll
            for (int w = 0; w < 4; ++w) {
                const half2v v01 = __builtin_bit_cast(half2v, __builtin_amdgcn_perm(0u, vreg[it][w], 0x010c000cu)), v23 = __builtin_bit_cast(half2v, __builtin_amdgcn_perm(0u, vreg[it][w], 0x030c020cu));
                o2[2 * w] = p2 * v01 + o2[2 * w]; o2[2 * w + 1] = p2 * v23 + o2[2 * w + 1]; }
        }
        lsum += __shfl_xor(lsum, 4); lsum += __shfl_xor(lsum, 8); lsum += __shfl_xor(lsum, 16); lsum += __shfl_xor(lsum, 32);
#pragma unroll
        for (int e = 0; e < 8; ++e) { red[lane * 17 + 2 * e] = (float)o2[e][0]; red[lane * 17 + 2 * e + 1] = (float)o2[e][1]; }
        float acc = 0.f;
        { const int cc = lane >> 4, e = lane & 15;
#pragma unroll
          for (int g = 0; g < 16; ++g) acc += red[(g * 4 + cc) * 17 + e]; }
        mix[(size_t)(t - NMETA) * D + 512 + head * 64 + lane] = (f16)(acc * __builtin_amdgcn_rcpf(lsum));
    }
    __syncthreads();
}

__device__ __forceinline__ void final_norm(const Params& P) {
    const int tid = threadIdx.x, lane = tid & 63, gw = blockIdx.x * 8 + (tid >> 6), nw = gridDim.x * 8;
    const float* ss3 = (const float*)(P.ws + WS_SS3); const f16* h3 = (const f16*)(P.ws + WS_ACTA);
    for (int r = gw; r < SEQ; r += nw) { const float rs = row_rstd(ss3, 16, r);
#pragma unroll
        for (int i = 0; i < 2; ++i) { const int k = lane * 8 + 512 * i; const half8 v = *(const half8*)(h3 + (size_t)r * D + k); const f32x4 g0 = *(const f32x4*)(P.nf + k), g1 = *(const f32x4*)(P.nf + k + 4); f32x4 o0, o1;
#pragma unroll
            for (int j = 0; j < 4; ++j) { o0[j] = (float)v[j] * rs * g0[j]; o1[j] = (float)v[4 + j] * rs * g1[j]; }
            *(f32x4*)(P.out + (size_t)r * D + k) = o0; *(f32x4*)(P.out + (size_t)r * D + k + 4) = o1; } }
}

#define XB_TMO      128
#define XB_XCNT(j)  (256  + 64 * (j))
#define XB_XSUB(j)  (1280 + 64 * (j))
#define XB_XGEN(j)  (2304 + 64 * (j))
#define XB_TOP      3328
#define XB_TOPGEN   3392
#define XCD_BAR_WORDS 3456
#define XB_SPIN_CAP (1u << 22)
__device__ __forceinline__ unsigned xb_ld(unsigned* p)              { return __hip_atomic_load(p, __ATOMIC_RELAXED, __HIP_MEMORY_SCOPE_AGENT); }
__device__ __forceinline__ unsigned xb_add(unsigned* p, unsigned v) { return __hip_atomic_fetch_add(p, v, __ATOMIC_RELAXED, __HIP_MEMORY_SCOPE_AGENT); }
__device__ __forceinline__ unsigned xb_xcc_id() { return (unsigned)__builtin_amdgcn_s_getreg((3 << 11) | 20) & 0xFu; }
#define XB_SPIN(cond, bar) do { unsigned _sp = 0; while (cond) { __builtin_amdgcn_s_sleep(1); \
    if ((++_sp & 255u) == 0u) { if (xb_ld(&(bar)[XB_TMO])) break; if (_sp > XB_SPIN_CAP) { atomicAdd(&(bar)[XB_TMO], 1u); break; } } } } while (0)
struct XcdBarrier { unsigned* bar; unsigned x; volatile LAS unsigned* st; };
__device__ __forceinline__ XcdBarrier xcd_barrier_post(unsigned* bar, volatile LAS unsigned* st) {
    XcdBarrier b; b.bar = bar; b.x = xb_xcc_id(); b.st = st;
    if (threadIdx.x == 0) (void)xb_add(&bar[XB_XCNT(b.x)], 1u);
    return b;
}
__device__ __forceinline__ void xcd_barrier_complete(unsigned* bar, unsigned x, unsigned& nloc, unsigned& nx) {
    const unsigned G = gridDim.x * gridDim.y * gridDim.z;
    unsigned sum, cnt, mine, sp = 0u;
    for (;;) {
        sum = 0u; cnt = 0u; mine = 0u;
#pragma unroll
        for (unsigned j = 0; j < 16; ++j) { const unsigned c = xb_ld(&bar[XB_XCNT(j)]); sum += c; cnt += (c > 0u) ? 1u : 0u; mine = (j == x) ? c : mine; }
        if (sum == G) break;
        __builtin_amdgcn_s_sleep(1);
        if ((++sp & 255u) == 0u) { if (xb_ld(&bar[XB_TMO])) break; if (sp > XB_SPIN_CAP) { atomicAdd(&bar[XB_TMO], 1u); break; } }
    }
    nloc = mine > 0u ? mine : 1u; nx = cnt > 0u ? cnt : 1u;
}
__device__ __forceinline__ void xcd_barrier(const XcdBarrier& b) {
    asm volatile("s_waitcnt vmcnt(0)" ::: "memory");
    __syncthreads();
    if (threadIdx.x == 0) {
        unsigned* bar = b.bar;
        __builtin_amdgcn_s_waitcnt(0);
        unsigned nloc = b.st[0], nx = b.st[1];
        if (nloc == 0u) { xcd_barrier_complete(bar, b.x, nloc, nx); b.st[0] = nloc; b.st[1] = nx; }
        const unsigned old = xb_add(&bar[XB_XSUB(b.x)], 1u);
        const unsigned gen = old / nloc;
        if (old + 1u == (gen + 1u) * nloc) {
            __builtin_amdgcn_fence(__ATOMIC_RELEASE, "agent");
            asm volatile("s_waitcnt vmcnt(0)" ::: "memory");
            const unsigned og = xb_add(&bar[XB_TOP], 1u);
            const unsigned tg = og / nx;
            if (og + 1u == (tg + 1u) * nx) xb_add(&bar[XB_TOPGEN], 1u);
            else XB_SPIN(xb_ld(&bar[XB_TOPGEN]) == tg, bar);
            __builtin_amdgcn_fence(__ATOMIC_ACQUIRE, "agent");
            xb_add(&bar[XB_XGEN(b.x)], 1u);
            asm volatile("s_waitcnt vmcnt(0)" ::: "memory");
        } else {
            XB_SPIN(xb_ld(&bar[XB_XGEN(b.x)]) == gen, bar);
            __builtin_amdgcn_fence(__ATOMIC_ACQUIRE, "agent");
            asm volatile("s_waitcnt vmcnt(0)" ::: "memory");
        }
    }
    __syncthreads();
}

__global__ void __launch_bounds__(NTHREADS, 2) fwd_kernel(Params P) {
    __shared__ __attribute__((aligned(16))) unsigned char lds_raw[LDS_BYTES];
    LAS unsigned char* lds = (LAS unsigned char*)lds_raw;
    const int tid = threadIdx.x, bid = blockIdx.x, G = gridDim.x;
    unsigned char* ws = P.ws;
    const int lo = P.ph_lo, hi = P.ph_hi;
#ifndef ONLY_PHASE
#define ONLY_PHASE -1
#endif
#define IN(k) ((ONLY_PHASE < 0 || ONLY_PHASE == (k)) && lo <= (k) && (k) < hi)
#define SEAM(k) do { if (IN(k) && IN((k) + 1)) { xcd_barrier(xbar); } } while (0)
    XcdBarrier xbar; xbar.bar = (unsigned*)(ws + WS_BAR); xbar.x = 0; xbar.st = (volatile LAS unsigned*)(lds + LDS_BYTES - 1024 + 16);
    if (hi - lo > 1) {
        if (tid == 0) { xbar.st[0] = 0u; xbar.st[1] = 0u; }
        __syncthreads();
        xbar = xcd_barrier_post((unsigned*)(ws + WS_BAR), (volatile LAS unsigned*)(lds + LDS_BYTES - 1024 + 16));
    }
    LAS int* misc = (LAS int*)(lds + LDS_BYTES - 1024);
    if (hi - lo > 1) {
        if (tid == 0) { const unsigned xcc = xb_xcc_id() & 7u; misc[8] = (int)xcc; misc[9] = (int)xb_add((unsigned*)(ws + WS_CTL) + 32 + 32 * xcc, 1u); }
    }
    int vbid = bid;
    f16* acta = (f16*)(ws + WS_ACTA); f16* Gb = (f16*)(ws + WS_G);
    float* ss0 = (float*)(ws + WS_SS0); float* ss1 = (float*)(ws + WS_SS1); float* ss2 = (float*)(ws + WS_SS2); float* ss3 = (float*)(ws + WS_SS3);
    if (IN(0)) { p0_prologue(P, lds); }
    SEAM(0);
    if (hi - lo > 1 && (G & 7) == 0) {
        if (tid == 0) { bool ok = true; for (int j = 0; j < 8; ++j) ok = ok && (xb_ld((unsigned*)(ws + WS_CTL) + 32 + 32 * j) == (unsigned)(G >> 3)); misc[10] = ok ? misc[9] * 8 + misc[8] : bid; }
        __syncthreads();
        vbid = __builtin_amdgcn_readfirstlane(misc[10]);
        __syncthreads();
    }
    if (IN(1)) {
        pg8::Gemm g{acta, (const f16*)(ws + WS_WGU1), MP, 2 * DFF, D}; pg8::StaticOrder S; S.init(MP, 2 * DFF, G, vbid);
        EpiSwiglu E{Gb, ss0, 1}; pg8::gemm_phase(lds, g, S, E);
    }
    SEAM(1);
    if (IN(2)) {
        meta_down(P, lds);
        pg8::Gemm g{Gb, (const f16*)(ws + WS_WD1), SEQ, D, DFF}; pg8::StaticOrder S; S.init(SEQ, D, G, vbid);
        EpiResid<true> E{acta, (f16*)P.out, ss1, 0.5f}; pg8::gemm_phase(lds, g, S, E);
    }
    SEAM(2);
    if (IN(3)) {
        pg8::Gemm g{(const f16*)P.out, (const f16*)(ws + WS_WIN), MP, NIN, D}; pg8::StaticOrder S; S.init(MP, NIN, G, vbid);
        EpiInProj E{ss1, (const f32x2*)(ws + WS_ROPE), ws};
        pg8::gemm_phase(lds, g, S, E);
    }
    SEAM(3);
    if (IN(4)) {
        for (int u = bid; u < NCH * 4; u += G) gla_a_unit(P, u, lds);
        {
            int tbase = 0, cursor = bid; LAS f16* tl = (LAS f16*)lds;
            prep_weight(P, 3, D, D, (f16*)(ws + WS_WOUT), cursor, tbase, tl);
            prep_weight(P, 4, 2 * DFF, D, (f16*)(ws + WS_WGU2), cursor, tbase, tl);
            prep_weight(P, 5, D, DFF, (f16*)(ws + WS_WD2), cursor, tbase, tl);
        }
    }
    SEAM(4);
    if (IN(5)) {
        if (bid < 64) gla_scan(P);
        unsigned* ctr = (unsigned*)(ws + WS_CTL); LAS int* bc = (LAS int*)(lds + LDS_BYTES - 1024);
        for (;;) {
            if (tid == 0) bc[0] = (int)atomicAdd(ctr, 1u);
            __syncthreads();
            const int k = bc[0];
            __syncthreads();
            if (k >= 513) break;
            indexer_tile(P, 512 - k, lds);
        }
    }
    SEAM(5);
    if (IN(6)) { for (int u = bid; u < NCH * 4; u += G) gla_c_unit(P, u, lds); sparse_attn(P, lds, vbid); }
    SEAM(6);
    if (IN(7)) {
        pg8::Gemm g{acta, (const f16*)(ws + WS_WOUT), SEQ, D, D}; pg8::StaticOrder S; S.init(SEQ, D, G, vbid);
        EpiResid<true> E{P.out, (f16*)(ws + WS_US), ss2, 1.0f}; pg8::gemm_phase(lds, g, S, E);
    }
    SEAM(7);
    if (IN(8)) {
        pg8::Gemm g{(const f16*)(ws + WS_US), (const f16*)(ws + WS_WGU2), SEQ, 2 * DFF, D}; pg8::StaticOrder S; S.init(SEQ, 2 * DFF, G, vbid);
        EpiSwiglu E{Gb, ss2, 16}; pg8::gemm_phase(lds, g, S, E);
    }
    SEAM(8);
    if (IN(9)) {
        pg8::Gemm g{Gb, (const f16*)(ws + WS_WD2), SEQ, D, DFF}; pg8::StaticOrder S; S.init(SEQ, D, G, vbid);
        EpiResid<true> E{ws + WS_US, acta, ss3, 0.5f}; pg8::gemm_phase(lds, g, S, E);
    }
    SEAM(9);
    if (IN(10)) final_norm(P);
#undef IN
#undef SEAM
}

extern "C" void kernel_launch(void* const* d_in, const int* in_sizes, int n_in, void* d_out, int out_size, void* d_ws, size_t ws_size, hipStream_t stream) {
    static int grid = 0;
    if (grid == 0) {
        if (n_in != 17 || in_sizes[0] != SEQ * D || out_size != SEQ * D || ws_size < WS_END) { fprintf(stderr, "kernel_launch: unexpected shapes (n_in %d, in0 %d, out %d, ws %zu, need %zu)\n", n_in, n_in > 0 ? in_sizes[0] : -1, out_size, ws_size, (size_t)WS_END); grid = -1; return; }
        int dev = 0, cus = 0, per_cu = 0;
        (void)hipGetDevice(&dev); (void)hipDeviceGetAttribute(&cus, hipDeviceAttributeMultiprocessorCount, dev);
        if (hipOccupancyMaxActiveBlocksPerMultiprocessor(&per_cu, (const void*)fwd_kernel, NTHREADS, 0) != hipSuccess || per_cu < 1) { fprintf(stderr, "kernel_launch: occupancy query says %d blocks per CU\n", per_cu); per_cu = 1; }
        (void)hipGetLastError();
        grid = cus;
        if (grid % 8 != 0 || grid < 64) { fprintf(stderr, "kernel_launch: unexpected CU count %d\n", cus); }
    }
    if (grid < 0) return;
    if (hipMemsetAsync((char*)d_ws + WS_CTL, 0, CTL_BYTES, stream) != hipSuccess) { fprintf(stderr, "kernel_launch: memset failed\n"); return; }
    Params p{};
    const float** pp = (const float**)&p;
    for (int i = 0; i < 17; ++i) pp[i] = (const float*)d_in[i];
    p.out = (float*)d_out; p.ws = (unsigned char*)d_ws;
#if MODE == 0
    for (int ph = 0; ph < NPHASE; ++ph) { p.ph_lo = ph; p.ph_hi = ph + 1; hipLaunchKernelGGL(fwd_kernel, dim3(grid), dim3(NTHREADS), 0, stream, p); }
#else
    p.ph_lo = 0; p.ph_hi = NPHASE;
    void* args[] = {&p};
    hipError_t e = hipLaunchCooperativeKernel((const void*)fwd_kernel, dim3(grid), dim3(NTHREADS), args, 0, stream);
    if (e != hipSuccess) fprintf(stderr, "cooperative launch failed: %s (grid %d)\n", hipGetErrorString(e), grid);
#endif
}
```

```cpp
#include <hip/hip_runtime.h>
#include <cstdio>
#include <cstdint>

#ifndef MODE
#define MODE 1
#endif

#define LAS __attribute__((address_space(3)))
typedef _Float16 f16;
typedef _Float16 half8 __attribute__((ext_vector_type(8)));
typedef _Float16 half4 __attribute__((ext_vector_type(4)));
typedef float f32x2 __attribute__((ext_vector_type(2)));
typedef float f32x4 __attribute__((ext_vector_type(4)));
typedef float f32x16 __attribute__((ext_vector_type(16)));
typedef unsigned u32x2 __attribute__((ext_vector_type(2)));
typedef unsigned u32x4 __attribute__((ext_vector_type(4)));

constexpr int D = 1024, SEQ = 16384, NMETA = 16, L = SEQ + NMETA, DFF = 2816;
constexpr int MP = 16640;
constexpr int LP = 16512;
constexpr int NIN = 3840;
constexpr int NCH = 257;
constexpr float EPS = 1e-6f;
constexpr int NTHREADS = 512;
constexpr int LDS_BYTES = 155648 + 1024;
constexpr int NPHASE = 11;

constexpr size_t al256(size_t x) { return (x + 255) & ~(size_t)255; }
constexpr size_t WS_CTL = 0;
constexpr size_t CTL_BYTES = 32768;
constexpr size_t WS_BAR = 2048;
constexpr size_t WS_WGU1 = CTL_BYTES;
constexpr size_t WS_WD1 = WS_WGU1 + (size_t)2 * DFF * D * 2;
constexpr size_t WS_WIN = WS_WD1 + (size_t)D * DFF * 2;
constexpr size_t WS_WOUT = WS_WIN + (size_t)NIN * D * 2;
constexpr size_t WS_WGU2 = WS_WOUT + (size_t)D * D * 2;
constexpr size_t WS_WD2 = WS_WGU2 + (size_t)2 * DFF * D * 2;
constexpr size_t WS_ACTA = WS_WD2 + (size_t)D * DFF * 2;
constexpr size_t WS_G = WS_ACTA + (size_t)MP * D * 2;
constexpr size_t WS_US = WS_G + (size_t)MP * DFF * 2;
constexpr size_t WS_DQ = WS_US + (size_t)NCH * 4 * 64 * 128 * 4;
constexpr size_t WS_IQ = WS_DQ + (size_t)LP * 512 * 2;
constexpr size_t WS_SEL = WS_IQ + (size_t)LP * 512 * 2;
constexpr size_t WS_ROPE = WS_SEL + (size_t)LP * 256 * 2;
constexpr size_t WS_IW = WS_ROPE + al256((size_t)L * 32 * 8);
constexpr size_t WS_GA = WS_IW + (size_t)LP * 8 * 4;
constexpr size_t WS_DECAY = WS_GA + (size_t)LP * 16 * 4;
constexpr size_t WS_SS0 = WS_DECAY + al256((size_t)NCH * 256 * 4);
constexpr size_t WS_SS1 = WS_SS0 + (size_t)MP * 4;
constexpr size_t WS_SS2 = WS_SS1 + (size_t)MP * 64;
constexpr size_t WS_SS3 = WS_SS2 + (size_t)MP * 64;
constexpr size_t WS_END = WS_SS3 + (size_t)MP * 64;
constexpr size_t WS_KV = WS_G;
constexpr size_t WS_GQ = WS_KV + (size_t)8 * LP * 128 * 2;
constexpr size_t WS_GK = WS_GQ + (size_t)LP * 256 * 2;
constexpr size_t WS_GV = WS_GK + (size_t)LP * 256 * 2;
constexpr size_t WS_GR = WS_GV + (size_t)LP * 512 * 2;
constexpr size_t WS_IK = WS_GR + (size_t)LP * 512 * 2;
constexpr size_t WS_ALIAS_END = WS_IK + (size_t)LP * 64 * 2;
static_assert(WS_ALIAS_END <= WS_US, "aliased buffers exceed G");
static_assert(WS_END <= (size_t)256 * 1024 * 1024, "workspace exceeds 256 MiB");
static_assert((size_t)SEQ * D * 2 <= (size_t)NCH * 4 * 64 * 128 * 4, "h2_16 alias");

struct Params {
    const float* x; const float* meta; const float* n1; const float* wg1; const float* wu1; const float* wd1;
    const float* nmix; const float* win; const float* wa2; const float* ba; const float* hn; const float* wout;
    const float* n2; const float* wg2; const float* wu2; const float* wd2; const float* nf;
    float* out; unsigned char* ws; int ph_lo, ph_hi;
};

namespace pg8 {
constexpr int BM = 256, BK = 64, HALF = 128, HTB = HALF * BK * 2, STAGE_BYTES = 8 * HTB, NXCD = 8, WGM = 8;
__host__ __device__ __forceinline__ int lds_byte(int r, int c) { const int st = (r >> 4) * 2 + (c >> 5), rr = r & 15, cc = c & 31, ob = rr * 64 + cc * 2; return st * 1024 + (ob ^ (((ob >> 9) & 1) << 5)); }
__host__ __device__ __forceinline__ int perm32(int rho) { const int n = rho >> 4, i = rho & 15; return 8 * (i >> 2) + 4 * n + (i & 3); }
__host__ __device__ __forceinline__ void stage_rc(int b, int& R, int& C) { const int st = b / 1024, sb = b % 1024, swz = sb ^ (((sb >> 9) & 1) << 5); R = (st >> 1) * 16 + swz / 64; C = (st & 1) * 32 + (swz % 64) / 2; }
struct Unit { int pm, pn; };
struct Gemm { const f16* A; const f16* Bt; int M, N, K; };
struct StaticOrder {
    int nM, nN, nwg, G, c;
    __host__ __device__ void init(int M, int N, int G_, int c_) { nM = M / BM; nN = N / BM; nwg = nM * nN; G = G_; c = c_; }
    __host__ __device__ bool next(int i, Unit& u) const {
        const long Lx = (long)i * G + c; if (Lx >= nwg) return false;
        int wgid = (int)Lx; { const int q = nwg / NXCD, r = nwg % NXCD, xcd = wgid % NXCD, off = wgid / NXCD; wgid = (xcd < r ? xcd * (q + 1) : r * (q + 1) + (xcd - r) * q) + off; }
        const int nig = WGM * nN, gid = wgid / nig, fm = gid * WGM, gsz = (nM - fm) < WGM ? (nM - fm) : WGM;
        u.pm = fm + ((wgid % nig) % gsz); u.pn = (wgid % nig) / gsz; return true;
    }
};
template <class Epi>
__device__ __forceinline__ void gemm_phase(LAS unsigned char* lds, const Gemm g, const StaticOrder& S, const Epi& E) {
    int tid_ = threadIdx.x; asm volatile("" : "+v"(tid_));
    const int tid = tid_, wid = __builtin_amdgcn_readfirstlane(tid >> 6), lane = tid & 63, wr = wid >> 2, wc = wid & 3, fr = lane & 15, fq = lane >> 4;
    const int K = g.K, nt = K / BK;
    unsigned voffA[2], voffB[2];
#pragma unroll
    for (int i = 0; i < 2; ++i) { int R, C; stage_rc(tid * 16 + i * 8192, R, C); const int Rb = (R & ~31) + perm32(R & 31); voffA[i] = (unsigned)(R * K + C) * 2u; voffB[i] = (unsigned)(Rb * K + C) * 2u; }
    const size_t kstep = (size_t)(BK * 2);
    const size_t hstep = (size_t)HALF * K * 2;
    const size_t tstep = 2 * hstep;
    const unsigned ldsw = (unsigned)wid * 1024u;
    const int aoff = lds_byte(wr * 64 + fr, fq * 8), boff = lds_byte(wc * 32 + fr, fq * 8);
#define PG8_SA(b, h) (((b) * 2 + (h)) * HTB)
#define PG8_SB(b, h) ((4 + (b) * 2 + (h)) * HTB)
#define PG8_STAGE(bufoff, gbase, voff) do { _Pragma("unroll") for (int _i = 0; _i < 2; ++_i) \
        __builtin_amdgcn_global_load_lds((const unsigned*)((const char*)(gbase) + (voff)[_i]), (LAS unsigned*)(lds + (bufoff) + ldsw + _i * 8192), 16, 0, 0); } while (0)
#define PG8_LDA(dst, b, h) do { _Pragma("unroll") for (int m = 0; m < 4; ++m) _Pragma("unroll") for (int k = 0; k < 2; ++k) dst[m][k] = *(const LAS half8*)(lds + PG8_SA(b, h) + aoff + m * 2048 + k * 1024); } while (0)
#define PG8_LDB(dst, b, h) do { _Pragma("unroll") for (int n = 0; n < 2; ++n) _Pragma("unroll") for (int k = 0; k < 2; ++k) dst[n][k] = *(const LAS half8*)(lds + PG8_SB(b, h) + boff + n * 2048 + k * 1024); } while (0)
#define PG8_MMA(ai, bj, At, Bt) do { __builtin_amdgcn_s_setprio(1); _Pragma("unroll") for (int m = 0; m < 4; ++m) _Pragma("unroll") for (int n = 0; n < 2; ++n) _Pragma("unroll") for (int k = 0; k < 2; ++k) \
        acc[ai][bj][m][n] = __builtin_amdgcn_mfma_f32_16x16x32_f16(Bt[n][k], At[m][k], acc[ai][bj][m][n], 0, 0, 0); __builtin_amdgcn_s_setprio(0); } while (0)
#define PG8_WAIT_V(n) asm volatile("s_waitcnt vmcnt(" #n ")" ::: "memory")
#define PG8_WAIT_L(n) asm volatile("s_waitcnt lgkmcnt(" #n ")" ::: "memory")
#define PG8_BAR __builtin_amdgcn_s_barrier()
#define PG8_SCHED __builtin_amdgcn_sched_barrier(0)
    Unit cur, nxt; int ui = 0;
    if (!S.next(0, cur)) return;
    f32x4 acc[2][2][4][2];
#pragma unroll
    for (int a = 0; a < 2; ++a)
#pragma unroll
        for (int b = 0; b < 2; ++b)
#pragma unroll
            for (int m = 0; m < 4; ++m)
#pragma unroll
                for (int n = 0; n < 2; ++n) acc[a][b][m][n] = (f32x4){0.f, 0.f, 0.f, 0.f};
    half8 At[4][2], B0[2][2], B1[2][2];
    const char* cA = (const char*)g.A + (size_t)cur.pm * tstep; const char* cB = (const char*)g.Bt + (size_t)cur.pn * tstep;
    PG8_STAGE(PG8_SB(0, 0), cB, voffB); PG8_STAGE(PG8_SA(0, 0), cA, voffA); PG8_STAGE(PG8_SB(0, 1), cB + hstep, voffB); PG8_STAGE(PG8_SA(0, 1), cA + hstep, voffA);
    if (wr == 1) PG8_BAR;
    PG8_WAIT_V(4); PG8_BAR;
    PG8_STAGE(PG8_SB(1, 0), cB + kstep, voffB); PG8_STAGE(PG8_SA(1, 0), cA + kstep, voffA); PG8_STAGE(PG8_SB(1, 1), cB + hstep + kstep, voffB);
    PG8_WAIT_V(6); PG8_BAR;
    for (;;) {
        const bool has_next = S.next(ui + 1, nxt);
        const char* nA = has_next ? (const char*)g.A + (size_t)nxt.pm * tstep : cA; const char* nB = has_next ? (const char*)g.Bt + (size_t)nxt.pn * tstep : cB;
        for (int t = 0; t < nt; t += 2) {
            const bool last = (t == nt - 2);
            const char* a1 = cA + (size_t)(t + 1) * kstep;
            const char* a2 = last ? nA : cA + (size_t)(t + 2) * kstep; const char* b2 = last ? nB : cB + (size_t)(t + 2) * kstep;
            const char* a3 = a2 + kstep; const char* b3 = b2 + kstep;
            PG8_LDB(B0, 0, 0); PG8_SCHED; PG8_LDA(At, 0, 0); PG8_STAGE(PG8_SA(1, 1), a1 + hstep, voffA);
            PG8_WAIT_L(8); PG8_BAR; PG8_WAIT_L(0); PG8_MMA(0, 0, At, B0); PG8_BAR; PG8_SCHED;
            PG8_LDB(B1, 0, 1); PG8_STAGE(PG8_SB(0, 0), b2, voffB);
            PG8_BAR; PG8_WAIT_L(0); PG8_MMA(0, 1, At, B1); PG8_BAR;
            PG8_LDA(At, 0, 1); PG8_STAGE(PG8_SA(0, 0), a2, voffA);
            PG8_BAR; PG8_WAIT_L(0); PG8_MMA(1, 0, At, B0); PG8_BAR; PG8_SCHED;
            PG8_STAGE(PG8_SB(0, 1), b2 + hstep, voffB);
            PG8_WAIT_V(6); PG8_BAR; PG8_MMA(1, 1, At, B1); PG8_BAR;
            PG8_LDB(B0, 1, 0); PG8_SCHED; PG8_LDA(At, 1, 0); PG8_STAGE(PG8_SA(0, 1), a2 + hstep, voffA);
            PG8_WAIT_L(8); PG8_BAR; PG8_WAIT_L(0); PG8_MMA(0, 0, At, B0); PG8_BAR; PG8_SCHED;
            PG8_LDB(B1, 1, 1); PG8_STAGE(PG8_SB(1, 0), b3, voffB);
            PG8_BAR; PG8_WAIT_L(0); PG8_MMA(0, 1, At, B1); PG8_BAR;
            PG8_LDA(At, 1, 1); PG8_STAGE(PG8_SA(1, 0), a3, voffA);
            PG8_BAR; PG8_WAIT_L(0); PG8_MMA(1, 0, At, B0); PG8_BAR; PG8_SCHED;
            PG8_STAGE(PG8_SB(1, 1), b3 + hstep, voffB);
            PG8_WAIT_V(6); PG8_BAR; PG8_MMA(1, 1, At, B1); PG8_BAR;
        }
        E(acc, cur, wr, wc, fr, fq);
        if (!has_next) break;
#pragma unroll
        for (int a = 0; a < 2; ++a)
#pragma unroll
            for (int b = 0; b < 2; ++b)
#pragma unroll
                for (int m = 0; m < 4; ++m)
#pragma unroll
                    for (int n = 0; n < 2; ++n) acc[a][b][m][n] = (f32x4){0.f, 0.f, 0.f, 0.f};
        cur = nxt; cA = nA; cB = nB; ++ui;
    }
    PG8_WAIT_V(0);
    if (wr == 0) PG8_BAR;
    PG8_BAR;
#undef PG8_SA
#undef PG8_SB
#undef PG8_STAGE
#undef PG8_LDA
#undef PG8_LDB
#undef PG8_MMA
#undef PG8_WAIT_V
#undef PG8_WAIT_L
#undef PG8_BAR
#undef PG8_SCHED
}
}

__device__ __forceinline__ float silu_f(float v) { return v * __builtin_amdgcn_rcpf(1.0f + __expf(-v)); }
__device__ __forceinline__ half4 to_half4(f32x4 v) { half4 h; h[0] = (f16)v[0]; h[1] = (f16)v[1]; h[2] = (f16)v[2]; h[3] = (f16)v[3]; return h; }

__device__ __forceinline__ float row_rstd(const float* ss, int np, int row) {
    float s;
    if (np == 1) s = ss[row];
    else { const f32x4* p = (const f32x4*)(ss + (size_t)row * 16); const f32x4 a = p[0], b = p[1], c = p[2], d = p[3];
        s = (((a[0] + a[1]) + (a[2] + a[3])) + ((b[0] + b[1]) + (b[2] + b[3]))) + (((c[0] + c[1]) + (c[2] + c[3])) + ((d[0] + d[1]) + (d[2] + d[3]))); }
    return rsqrtf(s * (1.0f / D) + EPS);
}
struct EpiSwiglu {
    f16* G; const float* ss; int np;
    __device__ __forceinline__ void operator()(const f32x4 (&acc)[2][2][4][2], const pg8::Unit& u, int wr, int wc, int fr_, int fq_) const {
        int fr = fr_, fq = fq_; asm volatile("" : "+v"(fr), "+v"(fq));
#pragma unroll
        for (int ai = 0; ai < 2; ++ai)
#pragma unroll
            for (int m = 0; m < 4; ++m) {
                const int row = u.pm * 256 + ai * 128 + wr * 64 + m * 16 + fr;
                const float rs = row_rstd(ss, np, row), ce = -1.4426950408889634f * rs, rs2 = rs * rs; half8 o;
#pragma unroll
                for (int n = 0; n < 2; ++n) {
                    const f32x4 g = acc[ai][0][m][n], u = acc[ai][1][m][n]; const f32x4 t = g * ce; f32x4 e, r;
#pragma unroll
                    for (int j = 0; j < 4; ++j) e[j] = __builtin_amdgcn_exp2f(t[j]);
                    const f32x4 d = e + 1.0f;
#pragma unroll
                    for (int j = 0; j < 4; ++j) r[j] = __builtin_amdgcn_rcpf(d[j]);
                    const f32x4 w = (g * u) * (r * rs2);
#pragma unroll
                    for (int j = 0; j < 4; ++j) o[4 * n + j] = (f16)w[j];
                }
                *(half8*)(G + (size_t)row * DFF + u.pn * 128 + wc * 32 + 8 * fq) = o;
            }
    }
};
template <bool SRC16> struct EpiResid {
    const void* src; f16* h16; float* ss; float alpha;
    __device__ __forceinline__ void operator()(const f32x4 (&acc)[2][2][4][2], const pg8::Unit& u, int wr, int wc, int fr_, int fq_) const {
        int fr = fr_, fq = fq_; asm volatile("" : "+v"(fr), "+v"(fq));
#pragma unroll
        for (int ai = 0; ai < 2; ++ai)
#pragma unroll
            for (int m = 0; m < 4; ++m) {
                const int row = u.pm * 256 + ai * 128 + wr * 64 + m * 16 + fr; float part = 0.f;
#pragma unroll
                for (int bj = 0; bj < 2; ++bj) {
                    const size_t off = (size_t)row * D + u.pn * 256 + bj * 128 + wc * 32 + 8 * fq; half8 h; f32x4 sv[2];
                    if (SRC16) { const half8 s8 = *(const half8*)((const f16*)src + off);
#pragma unroll
                        for (int j = 0; j < 4; ++j) { sv[0][j] = (float)s8[j]; sv[1][j] = (float)s8[4 + j]; } }
                    else { sv[0] = *(const f32x4*)((const float*)src + off); sv[1] = *(const f32x4*)((const float*)src + off + 4); }
#pragma unroll
                    for (int n = 0; n < 2; ++n) {
                        const f32x4 o = sv[n] + alpha * acc[ai][bj][m][n];
#pragma unroll
                        for (int j = 0; j < 4; ++j) h[4 * n + j] = (f16)o[j];
                        part += (o[0] * o[0] + o[1] * o[1]) + (o[2] * o[2] + o[3] * o[3]);
                    }
                    *(half8*)(h16 + off) = h;
                }
                part += __shfl_xor(part, 16); part += __shfl_xor(part, 32);
                if (fq == 0) ss[(size_t)row * 16 + u.pn * 4 + wc] = part;
            }
    }
};
constexpr float KV_SCALE = 16.0f;
constexpr float K_I8_SCALE = 127.0f / 8.0f;
__device__ __forceinline__ unsigned pack_fp8x4(f32x4 v) {
#pragma unroll
    for (int j = 0; j < 4; ++j) v[j] = fminf(fmaxf(v[j], -448.f), 448.f);
    int w = __builtin_amdgcn_cvt_pk_fp8_f32(v[0], v[1], 0, false); w = __builtin_amdgcn_cvt_pk_fp8_f32(v[2], v[3], w, true); return (unsigned)w;
}
__device__ __forceinline__ void rope8(const f32x4 (&x1)[2], const f32x4 (&x2)[2], const f32x2* rp, float sc, float (&o1)[8], float (&o2)[8]) {
#pragma unroll
    for (int n = 0; n < 2; ++n) {
        const f32x4 cs0 = *(const f32x4*)(rp + 4 * n), cs1 = *(const f32x4*)(rp + 4 * n + 2);
        o1[4 * n + 0] = (x1[n][0] * cs0[0] - x2[n][0] * cs0[1]) * sc; o2[4 * n + 0] = (x2[n][0] * cs0[0] + x1[n][0] * cs0[1]) * sc;
        o1[4 * n + 1] = (x1[n][1] * cs0[2] - x2[n][1] * cs0[3]) * sc; o2[4 * n + 1] = (x2[n][1] * cs0[2] + x1[n][1] * cs0[3]) * sc;
        o1[4 * n + 2] = (x1[n][2] * cs1[0] - x2[n][2] * cs1[1]) * sc; o2[4 * n + 2] = (x2[n][2] * cs1[0] + x1[n][2] * cs1[1]) * sc;
        o1[4 * n + 3] = (x1[n][3] * cs1[2] - x2[n][3] * cs1[3]) * sc; o2[4 * n + 3] = (x2[n][3] * cs1[2] + x1[n][3] * cs1[3]) * sc;
    }
}
__device__ __forceinline__ u32x2 pack_i8x8(const float (&v)[8]) {
    u32x2 r;
#pragma unroll
    for (int w = 0; w < 2; ++w) { unsigned word = 0u;
#pragma unroll
        for (int j = 0; j < 4; ++j) { const int q = (int)__builtin_rintf(fminf(fmaxf(v[4 * w + j] * K_I8_SCALE, -127.f), 127.f)); word |= ((unsigned)q & 0xffu) << (8 * j); }
        r[w] = word; }
    return r;
}
__device__ __forceinline__ u32x2 pack_bf8x8(const float (&v)[8]) {
    u32x2 r;
#pragma unroll
    for (int w = 0; w < 2; ++w) { int word = __builtin_amdgcn_cvt_pk_bf8_f32(v[4 * w], v[4 * w + 1], 0, false); word = __builtin_amdgcn_cvt_pk_bf8_f32(v[4 * w + 2], v[4 * w + 3], word, true); r[w] = (unsigned)word; }
    return r;
}
__device__ __forceinline__ u32x2 pack_fp8x8(const float (&v)[8]) { u32x2 r; r[0] = pack_fp8x4((f32x4){v[0], v[1], v[2], v[3]}); r[1] = pack_fp8x4((f32x4){v[4], v[5], v[6], v[7]}); return r; }
struct EpiInProj {
    const float* ss; const f32x2* rope; unsigned char* ws;
    __device__ __forceinline__ void operator()(const f32x4 (&acc)[2][2][4][2], const pg8::Unit& u, int wr, int wc, int fr_, int fq_) const {
        int fr = fr_, fq = fq_; asm volatile("" : "+v"(fr), "+v"(fq));
        const int pn = u.pn;
        if (pn >= 8 && pn <= 11) {
            unsigned char* lb = (pn <= 9) ? ws + WS_KV + (size_t)((pn - 8) * 4 + wc) * LP * 128 + 8 * fq
                                          : ws + WS_KV + (size_t)((pn - 10) * 4 + (wc >> 1)) * LP * 128 + 64 + (wc & 1) * 32 + 8 * fq;
#pragma unroll
            for (int ai = 0; ai < 2; ++ai)
#pragma unroll
                for (int m = 0; m < 4; ++m) {
                    const int p = u.pm * 256 + ai * 128 + wr * 64 + m * 16 + fr;
                    const int t = p < SEQ ? p + NMETA : p - SEQ;
                    if (p < L) {
                        const float sc = row_rstd(ss, 16, p);
                        if (pn <= 9) {
                            float o1[8], o2[8]; rope8(acc[ai][0][m], acc[ai][1][m], rope + (size_t)t * 32 + 8 * fq, sc, o1, o2);
                            unsigned char* d8 = lb + (size_t)t * 128; *(u32x2*)d8 = pack_i8x8(o1); *(u32x2*)(d8 + 32) = pack_i8x8(o2);
                        } else {
#pragma unroll
                            for (int bj = 0; bj < 2; ++bj) { float v[8];
#pragma unroll
                                for (int j = 0; j < 4; ++j) { v[j] = acc[ai][bj][m][0][j] * sc; v[4 + j] = acc[ai][bj][m][1][j] * sc; }
                                *(u32x2*)(lb + (size_t)t * 128 + (size_t)bj * 2 * LP * 128) = pack_bf8x8(v); }
                        }
                    }
                    asm volatile("" ::: "memory");
                }
            return;
        }
        int mode = 0, stride = 256; float scale = 1.0f; f16* lanebase;
        if (pn == 0) lanebase = (f16*)(ws + WS_GQ) + wc * 32 + 8 * fq;
        else if (pn == 1) lanebase = (f16*)(ws + WS_GK) + wc * 32 + 8 * fq;
        else if (pn <= 3) { lanebase = (f16*)(ws + WS_GV) + (pn - 2) * 256 + wc * 32 + 8 * fq; stride = 512; }
        else if (pn <= 5) { lanebase = (f16*)(ws + WS_GR) + (pn - 4) * 256 + wc * 32 + 8 * fq; stride = 512; }
        else if (pn <= 7) { lanebase = (f16*)(ws + WS_DQ) + (pn - 6) * 256 + wc * 64 + 8 * fq; stride = 512; mode = 1; scale = 0.125f; }
        else if (pn <= 13) { lanebase = (f16*)(ws + WS_IQ) + (pn - 12) * 256 + wc * 64 + 8 * fq; stride = 512; mode = 1; scale = 0.125f; }
        else { lanebase = (f16*)(ws + WS_IK) + 8 * fq; stride = 64; mode = wc == 0 ? 1 : (wc == 1 ? 2 : 3); }
#pragma unroll
        for (int ai = 0; ai < 2; ++ai)
#pragma unroll
            for (int m = 0; m < 4; ++m) {
                const int p = u.pm * 256 + ai * 128 + wr * 64 + m * 16 + fr;
                const int t = p < SEQ ? p + NMETA : p - SEQ;
                if (p < L && mode != 3) {
                    const float rs = row_rstd(ss, 16, p);
                    if (mode == 1) {
                        float o1[8], o2[8]; rope8(acc[ai][0][m], acc[ai][1][m], rope + (size_t)t * 32 + 8 * fq, rs * scale, o1, o2);
                        half8 h1, h2;
#pragma unroll
                        for (int j = 0; j < 8; ++j) { h1[j] = (f16)o1[j]; h2[j] = (f16)o2[j]; }
                        f16* dst = lanebase + (size_t)t * stride; *(half8*)dst = h1; *(half8*)(dst + 32) = h2;
                    } else if (mode == 2) {
                        if (fq < 2) { float* gp = (float*)(ws + WS_GA) + (size_t)t * 16 + 8 * fq; *(f32x4*)gp = acc[ai][0][m][0] * rs; *(f32x4*)(gp + 4) = acc[ai][0][m][1] * rs; }
                        else if (fq == 2) { float* ip = (float*)(ws + WS_IW) + (size_t)t * 8; const float r2 = rs * 0.35355339059327373f; *(f32x4*)ip = acc[ai][0][m][0] * r2; *(f32x4*)(ip + 4) = acc[ai][0][m][1] * r2; }
                    } else {
#pragma unroll
                        for (int bj = 0; bj < 2; ++bj) { half8 h;
#pragma unroll
                            for (int j = 0; j < 4; ++j) { h[j] = (f16)(acc[ai][bj][m][0][j] * rs); h[4 + j] = (f16)(acc[ai][bj][m][1][j] * rs); }
                            *(half8*)(lanebase + (size_t)t * stride + bj * 128) = h; }
                    }
                }
                asm volatile("" ::: "memory");
            }
    }
};

__device__ __forceinline__ const float* w_src(const Params& P, int kind, int n, int& ld, const float*& gain) {
    switch (kind) {
    case 0: case 4: { const int pn = n >> 8, bj = (n >> 7) & 1, cc = n & 127; ld = DFF; gain = kind == 0 ? P.n1 : P.n2;
        const float* w = kind == 0 ? (bj ? P.wu1 : P.wg1) : (bj ? P.wu2 : P.wg2); return w + pn * 128 + cc; }
    case 1: ld = D; gain = nullptr; return P.wd1 + n;
    case 5: ld = D; gain = nullptr; return P.wd2 + n;
    case 3: ld = D; gain = nullptr; return P.wout + n;
    default: { ld = 3672; gain = P.nmix; const int pn = n >> 8, c = n & 255, bj = c >> 7, hh = (c >> 5) & 3, dd = c & 31; int j;
        if (pn == 0) j = c; else if (pn == 1) j = 256 + c; else if (pn <= 3) j = 512 + (pn - 2) * 256 + c; else if (pn <= 5) j = 1024 + (pn - 4) * 256 + c;
        else if (pn <= 7) j = 1552 + (pn - 6) * 256 + hh * 64 + bj * 32 + dd;
        else if (pn <= 9) j = 2064 + (pn - 8) * 256 + hh * 64 + bj * 32 + dd;
        else if (pn <= 11) j = 2576 + (pn - 10) * 256 + c;
        else if (pn <= 13) j = 3088 + (pn - 12) * 256 + hh * 64 + bj * 32 + dd;
        else { if (c < 32) j = 3600 + c; else if (c < 48) j = 1536 + (c - 32); else if (c < 56) j = 3664 + (c - 48); else if (c >= 128 && c < 160) j = 3600 + 32 + (c - 128); else j = -1; }
        return j < 0 ? nullptr : P.win + j; }
    }
}
__device__ __forceinline__ void prep_weight(const Params& P, const int kind, const int N, const int K, f16* dst, int& cursor, int& tbase, LAS f16* tl) {
    const int tid = threadIdx.x, G = gridDim.x, tn = N / 64, tk = K / 256, ntile = tn * tk;
#pragma unroll 1
    for (; cursor < tbase + ntile; cursor += G) {
        const int tI = cursor - tbase, n0 = (tI % tn) * 64, k0 = (tI / tn) * 256;
        { const int n = tid & 63, kk0 = tid >> 6; int ld; const float* gain; const float* col = w_src(P, kind, n0 + n, ld, gain);
          float v[32];
#pragma unroll
          for (int i = 0; i < 32; ++i) v[i] = col ? col[(size_t)(k0 + kk0 + 8 * i) * ld] : 0.f;
          if (gain) {
#pragma unroll
              for (int i = 0; i < 32; ++i) v[i] *= gain[k0 + kk0 + 8 * i];
          }
#pragma unroll
          for (int i = 0; i < 32; ++i) tl[n * 264 + kk0 + 8 * i] = (f16)v[i]; }
        __syncthreads();
        { const int n = tid >> 3, seg = tid & 7;
#pragma unroll
          for (int j = 0; j < 4; ++j) *(half8*)(dst + (size_t)(n0 + n) * K + k0 + (seg + 8 * j) * 8) = *(const LAS half8*)(tl + n * 264 + (seg + 8 * j) * 8); }
        __syncthreads();
    }
    tbase += ntile;
}
__device__ __forceinline__ void p0_prologue(const Params& P, LAS unsigned char* lds) {
    const int tid = threadIdx.x, bid = blockIdx.x, G = gridDim.x, lane = tid & 63;
    unsigned char* ws = P.ws;
    int tbase = 0, cursor = bid;
    LAS f16* tl = (LAS f16*)lds;
    prep_weight(P, 0, 2 * DFF, D, (f16*)(ws + WS_WGU1), cursor, tbase, tl);
    prep_weight(P, 1, D, DFF, (f16*)(ws + WS_WD1), cursor, tbase, tl);
    prep_weight(P, 2, NIN, D, (f16*)(ws + WS_WIN), cursor, tbase, tl);
    float* ss0 = (float*)(ws + WS_SS0);
    f16* acta = (f16*)(ws + WS_ACTA);
    const int gw = bid * 8 + (tid >> 6), nw = G * 8;
    for (int p = gw; p < L; p += nw) {
        const float* src = p < SEQ ? P.x + (size_t)p * D : P.meta + (size_t)(p - SEQ) * D; float s = 0.f;
#pragma unroll
        for (int i = 0; i < 4; ++i) { const f32x4 v = *(const f32x4*)(src + lane * 4 + 256 * i); s += (v[0] * v[0] + v[1] * v[1]) + (v[2] * v[2] + v[3] * v[3]); *(half4*)(acta + (size_t)p * D + lane * 4 + 256 * i) = to_half4(v); }
#pragma unroll
        for (int o = 32; o >= 1; o >>= 1) s += __shfl_xor(s, o);
        if (lane == 0) ss0[p] = s;
    }
    const int gt = bid * NTHREADS + tid, ngt = G * NTHREADS;
    for (int i = gt; i < MP; i += ngt) { if (i >= L) ss0[i] = (float)D; }
    f32x2* rope = (f32x2*)(ws + WS_ROPE);
    for (int i = gt; i < L * 32; i += ngt) { const int t = i >> 5, f = i & 31; const double inv = exp(-(double)f * (9.210340371976184 / 32.0)); double sn, cs; sincos((double)t * inv, &sn, &cs); rope[i] = (f32x2){(float)cs, (float)sn}; }
}

__device__ __forceinline__ void meta_down(const Params& P, LAS unsigned char* lds) {
    const int tid = threadIdx.x, lane = tid & 63, wid = tid >> 6;
    const f16* Gm = (const f16*)(P.ws + WS_G) + (size_t)SEQ * DFF; const f16* Wt = (const f16*)(P.ws + WS_WD1);
    f16* acta = (f16*)P.out; float* ss1 = (float*)(P.ws + WS_SS1); LAS float* slot = (LAS float*)lds;
    for (int task = blockIdx.x; task < NMETA * 16; task += gridDim.x) {
        const int r = task >> 4, cg = task & 15; float part = 0.f;
#pragma unroll 1
        for (int q = 0; q < 2; ++q) {
            const int n0 = cg * 64 + (2 * wid + q) * 4; float a[4] = {0.f, 0.f, 0.f, 0.f};
            for (int kc = lane; kc < DFF / 8; kc += 64) {
                const half8 gv = *(const half8*)(Gm + (size_t)r * DFF + kc * 8);
#pragma unroll
                for (int j = 0; j < 4; ++j) { const half8 wv = *(const half8*)(Wt + (size_t)(n0 + j) * DFF + kc * 8);
#pragma unroll
                    for (int e = 0; e < 8; ++e) a[j] += (float)gv[e] * (float)wv[e]; }
            }
#pragma unroll
            for (int o = 32; o >= 1; o >>= 1) { a[0] += __shfl_xor(a[0], o); a[1] += __shfl_xor(a[1], o); a[2] += __shfl_xor(a[2], o); a[3] += __shfl_xor(a[3], o); }
            f32x4 o;
#pragma unroll
            for (int j = 0; j < 4; ++j) { o[j] = P.meta[r * D + n0 + j] + 0.5f * a[j]; part += o[j] * o[j]; }
            if (lane == 0) *(half4*)(acta + (size_t)(SEQ + r) * D + n0) = to_half4(o);
        }
        if (lane == 0) slot[wid] = part;
        __syncthreads();
        if (tid == 0) { float s = 0.f; for (int w = 0; w < 8; ++w) s += slot[w]; ss1[(size_t)(SEQ + r) * 16 + cg] = s; }
        __syncthreads();
    }
}

__device__ __forceinline__ float logsigmoid_f(float z) { return fminf(z, 0.f) - __logf(1.0f + __expf(-fabsf(z))); }
__device__ __forceinline__ void gla_gates(const Params& P, int c, int h, LAS float* bl) {
    const int tid = threadIdx.x, ti = tid >> 3, d0 = (tid & 7) * 8, tt = 64 * c - 48 + ti; const float* GA = (const float*)(P.ws + WS_GA);
    {
        float z[8];
        if (tt >= 0 && tt < L) {
            const f32x4 b0 = *(const f32x4*)(P.ba + 64 * h + d0), b1 = *(const f32x4*)(P.ba + 64 * h + d0 + 4);
#pragma unroll
            for (int m = 0; m < 4; ++m) { z[m] = b0[m]; z[4 + m] = b1[m]; }
            f32x4 a4[4];
#pragma unroll
            for (int q = 0; q < 4; ++q) a4[q] = *(const f32x4*)(GA + (size_t)tt * 16 + 4 * q);
#pragma unroll
            for (int r = 0; r < 16; ++r) { const float ar = a4[r >> 2][r & 3]; const f32x4 w0 = *(const f32x4*)(P.wa2 + r * 256 + 64 * h + d0), w1 = *(const f32x4*)(P.wa2 + r * 256 + 64 * h + d0 + 4);
#pragma unroll
                for (int m = 0; m < 4; ++m) { z[m] += ar * w0[m]; z[4 + m] += ar * w1[m]; } }
#pragma unroll
            for (int m = 0; m < 8; ++m) z[m] = logsigmoid_f(z[m]) * (1.0f / 16.0f);
        } else {
#pragma unroll
            for (int m = 0; m < 8; ++m) z[m] = 0.f;
        }
#pragma unroll
        for (int m = 0; m < 8; ++m) bl[ti * 65 + d0 + m] = z[m];
    }
    __syncthreads();
    {
        const int d = tid & 63, seg = tid >> 6; float v[8], run = 0.f;
#pragma unroll
        for (int i = 0; i < 8; ++i) { run += bl[(seg * 8 + i) * 65 + d]; v[i] = run; }
#pragma unroll
        for (int i = 0; i < 8; ++i) bl[(seg * 8 + i) * 65 + d] = v[i];
        __syncthreads();
        float off = 0.f;
#pragma unroll
        for (int sg = 0; sg < 7; ++sg) off += (sg < seg) ? bl[(sg * 8 + 7) * 65 + d] : 0.f;
        __syncthreads();
#pragma unroll
        for (int i = 0; i < 8; ++i) bl[(seg * 8 + i) * 65 + d] = v[i] + off;
    }
    __syncthreads();
}
__device__ __forceinline__ void gla_a_unit(const Params& P, int unit, LAS unsigned char* lds) {
    int tid_ = threadIdx.x; asm volatile("" : "+v"(tid_));
    const int tid = tid_, lane = tid & 63, wid = tid >> 6, c = unit >> 2, h = unit & 3;
    LAS float* bl = (LAS float*)lds; LAS float* ks = bl + 4160; LAS float* vs = ks + 4096;
    const f16* GK = (const f16*)(P.ws + WS_GK); const f16* GV = (const f16*)(P.ws + WS_GV);
    float* U = (float*)(P.ws + WS_US); float* DEC = (float*)(P.ws + WS_DECAY);
    const int ti = tid >> 3, d0 = (tid & 7) * 8, tt = 64 * c - 48 + ti; const bool tv = tt >= 0 && tt < L;
    half8 k8, v8[2];
#pragma unroll
    for (int m = 0; m < 8; ++m) { k8[m] = (f16)0.f; v8[0][m] = (f16)0.f; v8[1][m] = (f16)0.f; }
    if (tv) k8 = *(const half8*)(GK + (size_t)tt * 256 + 64 * h + d0);
#pragma unroll
    for (int q = 0; q < 2; ++q) { const int ch = tid + 512 * q, j = ch >> 4, t = 64 * c - 48 + j; if (t >= 0 && t < L) v8[q] = *(const half8*)(GV + (size_t)t * 512 + 128 * h + (ch & 15) * 8); }
    gla_gates(P, c, h, bl);
    { f32x4 o0, o1;
#pragma unroll
      for (int m = 0; m < 4; ++m) { o0[m] = (float)k8[m] * __expf(bl[63 * 65 + d0 + m] - bl[ti * 65 + d0 + m]); o1[m] = (float)k8[4 + m] * __expf(bl[63 * 65 + d0 + 4 + m] - bl[ti * 65 + d0 + 4 + m]); }
      *(LAS f32x4*)(ks + ti * 64 + d0) = o0; *(LAS f32x4*)(ks + ti * 64 + d0 + 4) = o1; }
#pragma unroll
    for (int q = 0; q < 2; ++q) { const int ch = tid + 512 * q, j = ch >> 4, e0 = (ch & 15) * 8; f32x4 o0, o1;
#pragma unroll
        for (int m = 0; m < 4; ++m) { o0[m] = (float)v8[q][m]; o1[m] = (float)v8[q][4 + m]; }
        *(LAS f32x4*)(vs + j * 128 + e0) = o0; *(LAS f32x4*)(vs + j * 128 + e0 + 4) = o1; }
    if (tid < 64) DEC[(size_t)c * 256 + h * 64 + tid] = __expf(bl[63 * 65 + tid]);
    __syncthreads();
    { const int dd0 = (wid >> 2) * 32, e0 = (wid & 3) * 32, l31 = lane & 31, hf = lane >> 5; f32x16 acc;
#pragma unroll
      for (int i = 0; i < 16; ++i) acc[i] = 0.f;
#pragma unroll 8
      for (int s = 0; s < 32; ++s) acc = __builtin_amdgcn_mfma_f32_32x32x2f32(ks[(2 * s + hf) * 64 + dd0 + l31], vs[(2 * s + hf) * 128 + e0 + l31], acc, 0, 0, 0);
      float* up = U + ((size_t)unit * 64) * 128;
#pragma unroll
      for (int r = 0; r < 16; ++r) { const int row = (r & 3) + 8 * (r >> 2) + 4 * hf; up[(size_t)(dd0 + row) * 128 + e0 + l31] = acc[r]; } }
    __syncthreads();
}
__device__ __forceinline__ void gla_scan(const Params& P) {
    float* U = (float*)(P.ws + WS_US); const float* DEC = (const float*)(P.ws + WS_DECAY);
    const int idx = blockIdx.x * NTHREADS + threadIdx.x;
    if (idx >= 32768) return;
    float s = 0.f;
#pragma unroll 8
    for (int c = 0; c < NCH; ++c) { const float u = U[(size_t)c * 32768 + idx], dc = DEC[(size_t)c * 256 + (idx >> 7)]; U[(size_t)c * 32768 + idx] = s; s = dc * s + u; }
}
__device__ __forceinline__ void gla_c_unit(const Params& P, int unit, LAS unsigned char* lds) {
    int tid_ = threadIdx.x; asm volatile("" : "+v"(tid_));
    const int tid = tid_, lane = tid & 63, wid = tid >> 6, c = unit >> 2, h = unit & 3, l31 = lane & 31, hf = lane >> 5;
    LAS float* bl = (LAS float*)lds; LAS float* kk = bl + 4160; LAS float* qs = kk + 4160; LAS float* As = qs + 4160; LAS float* vs = As + 4160; LAS float* Ss = vs + 8192; LAS float* os = bl;
    const f16* GQ = (const f16*)(P.ws + WS_GQ); const f16* GK = (const f16*)(P.ws + WS_GK); const f16* GV = (const f16*)(P.ws + WS_GV); const f16* GR = (const f16*)(P.ws + WS_GR);
    const float* Sg = (const float*)(P.ws + WS_US) + (size_t)unit * 8192; f16* mix = (f16*)(P.ws + WS_ACTA);
    const int ti = tid >> 3, d0 = (tid & 7) * 8, tt = 64 * c - 48 + ti; const bool tv = tt >= 0 && tt < L;
    half8 q8, k8, v8[2], r8[2]; f32x4 sreg[4];
#pragma unroll
    for (int m = 0; m < 8; ++m) { q8[m] = (f16)0.f; k8[m] = (f16)0.f; v8[0][m] = (f16)0.f; v8[1][m] = (f16)0.f; r8[0][m] = (f16)0.f; r8[1][m] = (f16)0.f; }
    if (tv) { q8 = *(const half8*)(GQ + (size_t)tt * 256 + 64 * h + d0); k8 = *(const half8*)(GK + (size_t)tt * 256 + 64 * h + d0);
        r8[0] = *(const half8*)(GR + (size_t)tt * 512 + 128 * h + (tid & 7) * 16); r8[1] = *(const half8*)(GR + (size_t)tt * 512 + 128 * h + (tid & 7) * 16 + 8); }
#pragma unroll
    for (int q = 0; q < 2; ++q) { const int ch = tid + 512 * q, j = ch >> 4, t = 64 * c - 48 + j; if (t >= 0 && t < L) v8[q] = *(const half8*)(GV + (size_t)t * 512 + 128 * h + (ch & 15) * 8); }
#pragma unroll
    for (int q = 0; q < 4; ++q) sreg[q] = *(const f32x4*)(Sg + (size_t)(tid + 512 * q) * 4);
    gla_gates(P, c, h, bl);
#pragma unroll
    for (int m = 0; m < 8; ++m) { const float bv = bl[ti * 65 + d0 + m]; qs[ti * 65 + d0 + m] = (float)q8[m] * 0.125f * __expf(bv); kk[ti * 65 + d0 + m] = (float)k8[m] * __expf(-bv); }
#pragma unroll
    for (int q = 0; q < 2; ++q) { const int ch = tid + 512 * q, j = ch >> 4, e0 = (ch & 15) * 8; f32x4 o0, o1;
#pragma unroll
        for (int m = 0; m < 4; ++m) { o0[m] = (float)v8[q][m]; o1[m] = (float)v8[q][4 + m]; }
        *(LAS f32x4*)(vs + j * 128 + e0) = o0; *(LAS f32x4*)(vs + j * 128 + e0 + 4) = o1; }
#pragma unroll
    for (int q = 0; q < 4; ++q) *(LAS f32x4*)(Ss + (tid + 512 * q) * 4) = sreg[q];
    __syncthreads();
    if (wid < 4) { const int i0 = (wid >> 1) * 32, j0 = (wid & 1) * 32; f32x16 acc;
#pragma unroll
        for (int i = 0; i < 16; ++i) acc[i] = 0.f;
#pragma unroll 8
        for (int s = 0; s < 32; ++s) acc = __builtin_amdgcn_mfma_f32_32x32x2f32(qs[(i0 + l31) * 65 + 2 * s + hf], kk[(j0 + l31) * 65 + 2 * s + hf], acc, 0, 0, 0);
#pragma unroll
        for (int r = 0; r < 16; ++r) { const int i = i0 + (r & 3) + 8 * (r >> 2) + 4 * hf, j = j0 + l31; As[i * 65 + j] = (j <= i) ? acc[r] : 0.f; } }
    __syncthreads();
    { const int i0 = (wid >> 2) * 32, e0 = (wid & 3) * 32; f32x16 acc;
#pragma unroll
      for (int i = 0; i < 16; ++i) acc[i] = 0.f;
#pragma unroll 8
      for (int s = 0; s < 32; ++s) acc = __builtin_amdgcn_mfma_f32_32x32x2f32(qs[(i0 + l31) * 65 + 2 * s + hf], Ss[(2 * s + hf) * 128 + e0 + l31], acc, 0, 0, 0);
#pragma unroll 8
      for (int s = 0; s < 32; ++s) acc = __builtin_amdgcn_mfma_f32_32x32x2f32(As[(i0 + l31) * 65 + 2 * s + hf], vs[(2 * s + hf) * 128 + e0 + l31], acc, 0, 0, 0);
#pragma unroll
      for (int r = 0; r < 16; ++r) { const int i = i0 + (r & 3) + 8 * (r >> 2) + 4 * hf; os[i * 129 + e0 + l31] = acc[r]; } }
    __syncthreads();
    { const int e0 = (tid & 7) * 16; float o[16], sq = 0.f;
#pragma unroll
      for (int j = 0; j < 16; ++j) { o[j] = os[ti * 129 + e0 + j]; sq += o[j] * o[j]; }
      sq += __shfl_xor(sq, 1); sq += __shfl_xor(sq, 2); sq += __shfl_xor(sq, 4);
      const float rs = rsqrtf(sq * (1.0f / 128.0f) + EPS);
      if (tt >= NMETA && tt < L) { half8 w0, w1;
#pragma unroll
          for (int j = 0; j < 8; ++j) { w0[j] = (f16)(o[j] * rs * P.hn[e0 + j] * silu_f((float)r8[0][j])); w1[j] = (f16)(o[8 + j] * rs * P.hn[e0 + 8 + j] * silu_f((float)r8[1][j])); }
          f16* dst = mix + (size_t)(tt - NMETA) * D + 128 * h + e0; *(half8*)dst = w0; *(half8*)(dst + 8) = w1; } }
    __syncthreads();
}

__device__ __forceinline__ unsigned mono_u(float f) { const unsigned u = __float_as_uint(f); return (u & 0x80000000u) ? ~u : (u | 0x80000000u); }
__device__ __forceinline__ float unmono_f(unsigned m) { return __uint_as_float((m & 0x80000000u) ? (m & 0x7fffffffu) : ~m); }
__device__ __forceinline__ unsigned wave_umax(unsigned v) {
    v = max(v, (unsigned)__builtin_amdgcn_update_dpp(0, (int)v, 0x111, 0xf, 0xf, false));
    v = max(v, (unsigned)__builtin_amdgcn_update_dpp(0, (int)v, 0x112, 0xf, 0xf, false));
    v = max(v, (unsigned)__builtin_amdgcn_update_dpp(0, (int)v, 0x114, 0xf, 0xf, false));
    v = max(v, (unsigned)__builtin_amdgcn_update_dpp(0, (int)v, 0x118, 0xf, 0xf, false));
    v = max(v, (unsigned)__builtin_amdgcn_update_dpp(0, (int)v, 0x142, 0xa, 0xf, false));
    v = max(v, (unsigned)__builtin_amdgcn_update_dpp(0, (int)v, 0x143, 0xc, 0xf, false));
    return (unsigned)__builtin_amdgcn_readlane((int)v, 63);
}
__device__ __forceinline__ int half_scan_incl(int v) {
    v += __builtin_amdgcn_update_dpp(0, v, 0x111, 0xf, 0xf, true);
    v += __builtin_amdgcn_update_dpp(0, v, 0x112, 0xf, 0xf, true);
    v += __builtin_amdgcn_update_dpp(0, v, 0x114, 0xf, 0xf, true);
    v += __builtin_amdgcn_update_dpp(0, v, 0x118, 0xf, 0xf, true);
    v += __builtin_amdgcn_update_dpp(0, v, 0x142, 0xa, 0xf, true);
    return v;
}
constexpr int CAP = 640, NPL = CAP / 64;
__device__ __forceinline__ int topk_compact(LAS float* cs, LAS unsigned short* ci, int n, bool exact, float& tau_out, int lane) {
    float sv[NPL]; unsigned iv[NPL], u[NPL];
#pragma unroll
    for (int i = 0; i < NPL; ++i) { const int p = lane + 64 * i; const bool v = p < n; sv[i] = v ? cs[p] : 0.f; iv[i] = v ? (unsigned)ci[p] : 0xffffu; u[i] = v ? mono_u(sv[i]) : 0u; }
    unsigned T = 0u; bool full = true; int hb = 31;
    {
        unsigned umx = 0u, umn = 0xffffffffu;
#pragma unroll
        for (int i = 0; i < NPL; ++i) { umx = max(umx, u[i]); umn = min(umn, (lane + 64 * i < n) ? u[i] : 0xffffffffu); }
        umx = wave_umax(umx); umn = ~wave_umax(~umn);
        const unsigned df = umx ^ umn;
        if (df == 0u) { hb = -1; T = umx; } else { hb = 31 - __clz(df); T = (hb == 31) ? 0u : (umx & ~((2u << hb) - 1u)); }
    }
#pragma unroll 1
    for (int bit = hb; bit >= 0; --bit) {
        const unsigned cand = T | (1u << bit); int cgt = 0;
#pragma unroll
        for (int i = 0; i < NPL; ++i) cgt += __popcll(__ballot(u[i] >= cand));
        if (cgt >= 256) { T = cand; if (!exact && cgt <= 272) { full = false; break; } }
    }
    bool keep[NPL];
    if (full) {
        int cgt = 0;
#pragma unroll
        for (int i = 0; i < NPL; ++i) cgt += __popcll(__ballot(u[i] > T));
        const int need = 256 - cgt; unsigned I = 0xffffu; int nties = 0;
#pragma unroll
        for (int i = 0; i < NPL; ++i) nties += __popcll(__ballot(u[i] == T));
        if (nties != need) { I = 0u;
#pragma unroll 1
        for (int bit = 15; bit >= 0; --bit) { const unsigned cand = I | (1u << bit); int cl = 0;
#pragma unroll
            for (int i = 0; i < NPL; ++i) cl += __popcll(__ballot(u[i] == T && iv[i] < cand));
            if (cl < need) I = cand; } }
#pragma unroll
        for (int i = 0; i < NPL; ++i) keep[i] = (u[i] > T) || (u[i] == T && iv[i] <= I);
    } else {
#pragma unroll
        for (int i = 0; i < NPL; ++i) keep[i] = u[i] >= T;
    }
    int nn = 0;
#pragma unroll
    for (int i = 0; i < NPL; ++i) { const unsigned long long m = __ballot(keep[i]); const int pre = __builtin_amdgcn_mbcnt_hi((unsigned)(m >> 32), __builtin_amdgcn_mbcnt_lo((unsigned)m, 0u));
        if (keep[i]) { cs[nn + pre] = sv[i]; ci[nn + pre] = (unsigned short)iv[i]; } nn += __popcll(m); }
    tau_out = unmono_f(T);
    return nn;
}
__device__ __forceinline__ float relu_asm(float x) { return __int_as_float(max(__float_as_int(x), 0)); }
__device__ __forceinline__ void indexer_tile(const Params& P, int tile, LAS unsigned char* lds) {
    int tid_ = threadIdx.x; asm volatile("" : "+v"(tid_));
    const int tid = tid_, lane = tid & 63, wid = __builtin_amdgcn_readfirstlane(tid >> 6), l31 = lane & 31, hf = lane >> 5;
    LAS float* candS = (LAS float*)lds;
    LAS unsigned short* candI = (LAS unsigned short*)(lds + 32 * CAP * 4);
    LAS unsigned char* kbuf = lds + 32 * CAP * 6;
    LAS int* lcnt = (LAS int*)(lds + LDS_BYTES - 1024 + 64);
    LAS int* lflag = (LAS int*)(lds + LDS_BYTES - 1024 + 192);
    const f16* IQ = (const f16*)(P.ws + WS_IQ); const f16* IK = (const f16*)(P.ws + WS_IK); const float* IW = (const float*)(P.ws + WS_IW);
    unsigned short* SEL = (unsigned short*)(P.ws + WS_SEL);
    const int t0 = tile * 32, tw = t0 + wid * 4;
    half8 afr[4];
    { const int qi = 2 * (l31 >> 4) + ((l31 >> 2) & 1), hd = 4 * ((l31 >> 3) & 1) + (l31 & 3); int tq = tw + qi; if (tq > L - 1) tq = L - 1;
      const half8* ap = (const half8*)(IQ + (size_t)tq * 512 + hd * 64);
#pragma unroll
      for (int s = 0; s < 4; ++s) afr[s] = ap[2 * s + hf]; }
    float w0[8], w1[8];
    { int ta = tw + hf, tb = tw + 2 + hf; if (ta > L - 1) ta = L - 1; if (tb > L - 1) tb = L - 1;
#pragma unroll
      for (int h = 0; h < 8; ++h) { w0[h] = IW[(size_t)ta * 8 + h]; w1[h] = IW[(size_t)tb * 8 + h]; } }
    asm volatile("" :: "v"(afr[0]), "v"(afr[1]), "v"(afr[2]), "v"(afr[3]));
    asm volatile("" :: "v"(w0[0]), "v"(w0[1]), "v"(w0[2]), "v"(w0[3]), "v"(w0[4]), "v"(w0[5]), "v"(w0[6]), "v"(w0[7]));
    asm volatile("" :: "v"(w1[0]), "v"(w1[1]), "v"(w1[2]), "v"(w1[3]), "v"(w1[4]), "v"(w1[5]), "v"(w1[6]), "v"(w1[7]));
    const int tq0 = (tw + hf < L) ? tw + hf : -1, tq1 = (tw + 2 + hf < L) ? tw + 2 + hf : -1;
    float tau0 = -__builtin_inff(), tau1 = -__builtin_inff();
    int cq0 = 0, cq1 = 0, cq2 = 0, cq3 = 0;
    if (tid < 3) lflag[tid] = 0;
    const int nkeys = (t0 + 32 < L) ? t0 + 32 : L, nst = (nkeys + 127) >> 7;
    u32x4 stg[2];
    const u32x4* IKv = (const u32x4*)IK;
#pragma unroll
    for (int i = 0; i < 2; ++i) stg[i] = IKv[(size_t)0 * 1024 + tid + 512 * i];
#pragma unroll
    for (int i = 0; i < 2; ++i) { const int ci = tid + 512 * i, row = ci >> 3, ch = ci & 7; *(LAS u32x4*)(kbuf + row * 128 + ((ch ^ ((row >> 1) & 7)) << 4)) = stg[i]; }
    __syncthreads();
#pragma unroll 1
    for (int st = 0; st < nst; ++st) {
        LAS unsigned char* kb = kbuf + (st & 1) * 16384;
        if (st + 1 < nst) {
#pragma unroll
            for (int i = 0; i < 2; ++i) stg[i] = IKv[(size_t)(st + 1) * 1024 + tid + 512 * i];
        }
        if (st * 128 <= tw + 3) {
            f32x16 acc[4];
#pragma unroll
            for (int c = 0; c < 4; ++c) {
#pragma unroll
                for (int i = 0; i < 16; ++i) acc[c][i] = 0.f;
            }
#pragma unroll
            for (int s = 0; s < 4; ++s) {
#pragma unroll
                for (int c = 0; c < 4; ++c) { const int row = c * 32 + l31; const half8 bf = *(const LAS half8*)(kb + row * 128 + (((2 * s + hf) ^ ((row >> 1) & 7)) << 4)); acc[c] = __builtin_amdgcn_mfma_f32_32x32x16_f16(afr[s], bf, acc[c], 0, 0, 0); }
            }
            float sc[8]; bool ok[8]; int na = 0, nb = 0;
#pragma unroll
            for (int c = 0; c < 4; ++c) {
                float s0 = 0.f, s1 = 0.f;
#pragma unroll
                for (int h = 0; h < 8; ++h) { s0 = __builtin_fmaf(w0[h], relu_asm(acc[c][h]), s0); s1 = __builtin_fmaf(w1[h], relu_asm(acc[c][8 + h]), s1); }
                const int key = st * 128 + c * 32 + l31;
                sc[2 * c] = s0; sc[2 * c + 1] = s1; ok[2 * c] = key <= tq0 && s0 > tau0; ok[2 * c + 1] = key <= tq1 && s1 > tau1;
                na += ok[2 * c] ? 1 : 0; nb += ok[2 * c + 1] ? 1 : 0;
            }
            const int ia = half_scan_incl(na), ib = half_scan_incl(nb);
            const int ta0 = __builtin_amdgcn_readlane(ia, 31), ta1 = __builtin_amdgcn_readlane(ia, 63), tb0 = __builtin_amdgcn_readlane(ib, 31), tb1 = __builtin_amdgcn_readlane(ib, 63);
            int pa = (hf ? cq1 : cq0) + ia - na, pb = (hf ? cq3 : cq2) + ib - nb;
            cq0 += ta0; cq1 += ta1; cq2 += tb0; cq3 += tb1;
            pa += (wid * 4 + hf) * CAP; pb += (wid * 4 + 2 + hf) * CAP;
            const int dmy = 32 * CAP * 6 / 4 + 2 * 16384 / 4 + 64 + lane;
#pragma unroll
            for (int c = 0; c < 4; ++c) {
                const unsigned short key = (unsigned short)(st * 128 + c * 32 + l31);
                { const bool k0 = ok[2 * c]; LAS float* ps = k0 ? candS + pa : candS + dmy; LAS unsigned short* pi = k0 ? candI + pa : (LAS unsigned short*)(candS + dmy + 64); *ps = sc[2 * c]; *pi = key; pa += k0 ? 1 : 0; }
                { const bool k1 = ok[2 * c + 1]; LAS float* ps = k1 ? candS + pb : candS + dmy; LAS unsigned short* pi = k1 ? candI + pb : (LAS unsigned short*)(candS + dmy + 64); *ps = sc[2 * c + 1]; *pi = key; pb += k1 ? 1 : 0; }
            }
        }
        if (st + 1 < nst) {
            LAS unsigned char* kn = kbuf + ((st + 1) & 1) * 16384;
#pragma unroll
            for (int i = 0; i < 2; ++i) { const int ci = tid + 512 * i, row = ci >> 3, ch = ci & 7; *(LAS u32x4*)(kn + row * 128 + ((ch ^ ((row >> 1) & 7)) << 4)) = stg[i]; }
        }
        const int mx = max(max(cq0, cq1), max(cq2, cq3));
        if (mx > CAP - 128 && lane == 0) lflag[st % 3] = 1;
        if (tid == 0) lflag[(st + 1) % 3] = 0;
        __syncthreads();
        const int any = lflag[st % 3];
        if (any) {
#pragma unroll 1
            for (int qq = 0; qq < 4; ++qq) { const int n = qq == 0 ? cq0 : (qq == 1 ? cq1 : (qq == 2 ? cq2 : cq3));
                if (n > 288) { float nt; const int nn = topk_compact(candS + (wid * 4 + qq) * CAP, candI + (wid * 4 + qq) * CAP, n, false, nt, lane);
                    if (qq == 0) cq0 = nn; else if (qq == 1) cq1 = nn; else if (qq == 2) cq2 = nn; else cq3 = nn;
                    if (hf == (qq & 1)) { if (qq < 2) tau0 = nt; else tau1 = nt; } } }
        }
    }
#pragma unroll 1
    for (int qq = 0; qq < 4; ++qq) {
        const int t = tw + qq; if (t >= L) break;
        int n = qq == 0 ? cq0 : (qq == 1 ? cq1 : (qq == 2 ? cq2 : cq3)); LAS float* cs = candS + (wid * 4 + qq) * CAP; LAS unsigned short* ci = candI + (wid * 4 + qq) * CAP;
        if (n > 256) { float nt; n = topk_compact(cs, ci, n, true, nt, lane); }
#pragma unroll
        for (int j = 0; j < 4; ++j) { const int p = lane + 64 * j; SEL[(size_t)t * 256 + p] = p < n ? ci[p] : (unsigned short)0xffffu; }
    }
    __syncthreads();
}

__device__ __forceinline__ void sparse_attn(const Params& P, LAS unsigned char* lds, int vbid) {
    int tid_ = threadIdx.x; asm volatile("" : "+v"(tid_));
    const int tid = tid_, lane = tid & 63, wid = tid >> 6, grp = lane >> 2, c4 = lane & 3;
    const int head = vbid & 7, slot = (vbid >> 3) * 8 + wid, nslot = (gridDim.x >> 3) * 8;
    typedef _Float16 half2v __attribute__((ext_vector_type(2)));
    LAS unsigned short* widx = (LAS unsigned short*)(lds + wid * 512);
    LAS float* red = (LAS float*)(lds + 4096 + wid * 4352);
    const unsigned short* SEL = (const unsigned short*)(P.ws + WS_SEL); const f16* DQ = (const f16*)(P.ws + WS_DQ);
    const unsigned char* kvh = P.ws + WS_KV + (size_t)head * LP * 128; f16* mix = (f16*)(P.ws + WS_ACTA);
    int t = NMETA + slot;
    u32x2 selr = {0u, 0u}; half8 qa, qb;
#pragma unroll
    for (int e = 0; e < 8; ++e) { qa[e] = (f16)0.f; qb[e] = (f16)0.f; }
    if (t < L) { selr = *(const u32x2*)(SEL + (size_t)t * 256 + lane * 4); qa = *(const half8*)(DQ + (size_t)t * 512 + head * 64 + c4 * 16); qb = *(const half8*)(DQ + (size_t)t * 512 + head * 64 + c4 * 16 + 8); }
#pragma unroll 1
    for (; t < L; t += nslot) {
        *(LAS u32x2*)(widx + lane * 4) = selr;
        unsigned keys[16]; u32x4 kreg[16], vreg[16];
#pragma unroll
        for (int it = 0; it < 16; ++it) keys[it] = widx[16 * it + grp];
#pragma unroll
        for (int it = 0; it < 16; ++it) { const unsigned kk = keys[it] != 0xffffu ? keys[it] : 0u; kreg[it] = *(const u32x4*)(kvh + (size_t)kk * 128 + c4 * 16); }
#pragma unroll
        for (int it = 0; it < 16; ++it) { const unsigned kk = keys[it] != 0xffffu ? keys[it] : 0u; vreg[it] = *(const u32x4*)(kvh + (size_t)kk * 128 + 64 + c4 * 16); }
        float qf[16], qmax = 1e-20f;
#pragma unroll
        for (int e = 0; e < 8; ++e) { qf[e] = (float)qa[e]; qf[8 + e] = (float)qb[e]; }
#pragma unroll
        for (int e = 0; e < 16; ++e) qmax = fmaxf(qmax, fabsf(qf[e]));
        qmax = fmaxf(qmax, __int_as_float(__builtin_amdgcn_update_dpp(0, __float_as_int(qmax), 0xB1, 0xf, 0xf, true)));
        qmax = fmaxf(qmax, __int_as_float(__builtin_amdgcn_update_dpp(0, __float_as_int(qmax), 0x4E, 0xf, 0xf, true)));
        const float qs = 127.0f * __builtin_amdgcn_rcpf(qmax), lscale = qmax * (1.0f / (127.0f * K_I8_SCALE));
        int q8[4];
#pragma unroll
        for (int w = 0; w < 4; ++w) { unsigned word = 0u;
#pragma unroll
            for (int j = 0; j < 4; ++j) { const int q = (int)__builtin_rintf(qf[4 * w + j] * qs); word |= ((unsigned)q & 0xffu) << (8 * j); }
            q8[w] = (int)word; }
        { const int tn = t + nslot;
          if (tn < L) { selr = *(const u32x2*)(SEL + (size_t)tn * 256 + lane * 4); qa = *(const half8*)(DQ + (size_t)tn * 512 + head * 64 + c4 * 16); qb = *(const half8*)(DQ + (size_t)tn * 512 + head * 64 + c4 * 16 + 8); } }
        float lg[16]; float mx = -__builtin_inff();
#pragma unroll
        for (int it = 0; it < 16; ++it) {
            int ai = 0;
#pragma unroll
            for (int w = 0; w < 4; ++w) ai = __builtin_amdgcn_sdot4((int)kreg[it][w], q8[w], ai, false);
            ai += __builtin_amdgcn_update_dpp(0, ai, 0xB1, 0xf, 0xf, true);
            ai += __builtin_amdgcn_update_dpp(0, ai, 0x4E, 0xf, 0xf, true);
            lg[it] = keys[it] != 0xffffu ? (float)ai * lscale : -__builtin_inff(); mx = fmaxf(mx, lg[it]);
        }
        mx = fmaxf(mx, __shfl_xor(mx, 4)); mx = fmaxf(mx, __shfl_xor(mx, 8)); mx = fmaxf(mx, __shfl_xor(mx, 16)); mx = fmaxf(mx, __shfl_xor(mx, 32));
        half2v o2[8]; float lsum = 0.f;
#pragma unroll
        for (int e = 0; e < 8; ++e) o2[e] = (half2v){(f16)0.f, (f16)0.f};
#pragma unroll
        for (int it = 0; it < 16; ++it) {
            const float p = __expf(lg[it] - mx); lsum += p; const f16 ph = (f16)p; const half2v p2 = {ph, ph};
#pragma unroll
            for (int w = 0; w < 4; ++w) {
                const half2v v01 = __builtin_bit_cast(half2v, __builtin_amdgcn_perm(0u, vreg[it][w], 0x010c000cu)), v23 = __builtin_bit_cast(half2v, __builtin_amdgcn_perm(0u, vreg[it][w], 0x030c020cu));
                o2[2 * w] = p2 * v01 + o2[2 * w]; o2[2 * w + 1] = p2 * v23 + o2[2 * w + 1]; }
        }
        lsum += __shfl_xor(lsum, 4); lsum += __shfl_xor(lsum, 8); lsum += __shfl_xor(lsum, 16); lsum += __shfl_xor(lsum, 32);
#pragma unroll
        for (int e = 0; e < 8; ++e) { red[lane * 17 + 2 * e] = (float)o2[e][0]; red[lane * 17 + 2 * e + 1] = (float)o2[e][1]; }
        float acc = 0.f;
        { const int cc = lane >> 4, e = lane & 15;
#pragma unroll
          for (int g = 0; g < 16; ++g) acc += red[(g * 4 + cc) * 17 + e]; }
        mix[(size_t)(t - NMETA) * D + 512 + head * 64 + lane] = (f16)(acc * __builtin_amdgcn_rcpf(lsum));
    }
    __syncthreads();
}

__device__ __forceinline__ void final_norm(const Params& P) {
    const int tid = threadIdx.x, lane = tid & 63, gw = blockIdx.x * 8 + (tid >> 6), nw = gridDim.x * 8;
    const float* ss3 = (const float*)(P.ws + WS_SS3); const f16* h3 = (const f16*)(P.ws + WS_ACTA);
    for (int r = gw; r < SEQ; r += nw) { const float rs = row_rstd(ss3, 16, r);
#pragma unroll
        for (int i = 0; i < 2; ++i) { const int k = lane * 8 + 512 * i; const half8 v = *(const half8*)(h3 + (size_t)r * D + k); const f32x4 g0 = *(const f32x4*)(P.nf + k), g1 = *(const f32x4*)(P.nf + k + 4); f32x4 o0, o1;
#pragma unroll
            for (int j = 0; j < 4; ++j) { o0[j] = (float)v[j] * rs * g0[j]; o1[j] = (float)v[4 + j] * rs * g1[j]; }
            *(f32x4*)(P.out + (size_t)r * D + k) = o0; *(f32x4*)(P.out + (size_t)r * D + k + 4) = o1; } }
}

#define XB_TMO      128
#define XB_XCNT(j)  (256  + 64 * (j))
#define XB_XSUB(j)  (1280 + 64 * (j))
#define XB_XGEN(j)  (2304 + 64 * (j))
#define XB_TOP      3328
#define XB_TOPGEN   3392
#define XCD_BAR_WORDS 3456
#define XB_SPIN_CAP (1u << 22)
__device__ __forceinline__ unsigned xb_ld(unsigned* p)              { return __hip_atomic_load(p, __ATOMIC_RELAXED, __HIP_MEMORY_SCOPE_AGENT); }
__device__ __forceinline__ unsigned xb_add(unsigned* p, unsigned v) { return __hip_atomic_fetch_add(p, v, __ATOMIC_RELAXED, __HIP_MEMORY_SCOPE_AGENT); }
__device__ __forceinline__ unsigned xb_xcc_id() { return (unsigned)__builtin_amdgcn_s_getreg((3 << 11) | 20) & 0xFu; }
#define XB_SPIN(cond, bar) do { unsigned _sp = 0; while (cond) { __builtin_amdgcn_s_sleep(1); \
    if ((++_sp & 255u) == 0u) { if (xb_ld(&(bar)[XB_TMO])) break; if (_sp > XB_SPIN_CAP) { atomicAdd(&(bar)[XB_TMO], 1u); break; } } } } while (0)
struct XcdBarrier { unsigned* bar; unsigned x; volatile LAS unsigned* st; };
__device__ __forceinline__ XcdBarrier xcd_barrier_post(unsigned* bar, volatile LAS unsigned* st) {
    XcdBarrier b; b.bar = bar; b.x = xb_xcc_id(); b.st = st;
    if (threadIdx.x == 0) (void)xb_add(&bar[XB_XCNT(b.x)], 1u);
    return b;
}
__device__ __forceinline__ void xcd_barrier_complete(unsigned* bar, unsigned x, unsigned& nloc, unsigned& nx) {
    const unsigned G = gridDim.x * gridDim.y * gridDim.z;
    unsigned sum, cnt, mine, sp = 0u;
    for (;;) {
        sum = 0u; cnt = 0u; mine = 0u;
#pragma unroll
        for (unsigned j = 0; j < 16; ++j) { const unsigned c = xb_ld(&bar[XB_XCNT(j)]); sum += c; cnt += (c > 0u) ? 1u : 0u; mine = (j == x) ? c : mine; }
        if (sum == G) break;
        __builtin_amdgcn_s_sleep(1);
        if ((++sp & 255u) == 0u) { if (xb_ld(&bar[XB_TMO])) break; if (sp > XB_SPIN_CAP) { atomicAdd(&bar[XB_TMO], 1u); break; } }
    }
    nloc = mine > 0u ? mine : 1u; nx = cnt > 0u ? cnt : 1u;
}
__device__ __forceinline__ void xcd_barrier(const XcdBarrier& b) {
    asm volatile("s_waitcnt vmcnt(0)" ::: "memory");
    __syncthreads();
    if (threadIdx.x == 0) {
        unsigned* bar = b.bar;
        __builtin_amdgcn_s_waitcnt(0);
        unsigned nloc = b.st[0], nx = b.st[1];
        if (nloc == 0u) { xcd_barrier_complete(bar, b.x, nloc, nx); b.st[0] = nloc; b.st[1] = nx; }
        const unsigned old = xb_add(&bar[XB_XSUB(b.x)], 1u);
        const unsigned gen = old / nloc;
        if (old + 1u == (gen + 1u) * nloc) {
            __builtin_amdgcn_fence(__ATOMIC_RELEASE, "agent");
            asm volatile("s_waitcnt vmcnt(0)" ::: "memory");
            const unsigned og = xb_add(&bar[XB_TOP], 1u);
            const unsigned tg = og / nx;
            if (og + 1u == (tg + 1u) * nx) xb_add(&bar[XB_TOPGEN], 1u);
            else XB_SPIN(xb_ld(&bar[XB_TOPGEN]) == tg, bar);
            __builtin_amdgcn_fence(__ATOMIC_ACQUIRE, "agent");
            xb_add(&bar[XB_XGEN(b.x)], 1u);
            asm volatile("s_waitcnt vmcnt(0)" ::: "memory");
        } else {
            XB_SPIN(xb_ld(&bar[XB_XGEN(b.x)]) == gen, bar);
            __builtin_amdgcn_fence(__ATOMIC_ACQUIRE, "agent");
            asm volatile("s_waitcnt vmcnt(0)" ::: "memory");
        }
    }
    __syncthreads();
}

__global__ void __launch_bounds__(NTHREADS, 2) fwd_kernel(Params P) {
    __shared__ __attribute__((aligned(16))) unsigned char lds_raw[LDS_BYTES];
    LAS unsigned char* lds = (LAS unsigned char*)lds_raw;
    const int tid = threadIdx.x, bid = blockIdx.x, G = gridDim.x;
    unsigned char* ws = P.ws;
    const int lo = P.ph_lo, hi = P.ph_hi;
#ifndef ONLY_PHASE
#define ONLY_PHASE -1
#endif
#define IN(k) ((ONLY_PHASE < 0 || ONLY_PHASE == (k)) && lo <= (k) && (k) < hi)
#define SEAM(k) do { if (IN(k) && IN((k) + 1)) { xcd_barrier(xbar); } } while (0)
    XcdBarrier xbar; xbar.bar = (unsigned*)(ws + WS_BAR); xbar.x = 0; xbar.st = (volatile LAS unsigned*)(lds + LDS_BYTES - 1024 + 16);
    if (hi - lo > 1) {
        if (tid == 0) { xbar.st[0] = 0u; xbar.st[1] = 0u; }
        __syncthreads();
        xbar = xcd_barrier_post((unsigned*)(ws + WS_BAR), (volatile LAS unsigned*)(lds + LDS_BYTES - 1024 + 16));
    }
    LAS int* misc = (LAS int*)(lds + LDS_BYTES - 1024);
    if (hi - lo > 1) {
        if (tid == 0) { const unsigned xcc = xb_xcc_id() & 7u; misc[8] = (int)xcc; misc[9] = (int)xb_add((unsigned*)(ws + WS_CTL) + 32 + 32 * xcc, 1u); }
    }
    int vbid = bid;
    f16* acta = (f16*)(ws + WS_ACTA); f16* Gb = (f16*)(ws + WS_G);
    float* ss0 = (float*)(ws + WS_SS0); float* ss1 = (float*)(ws + WS_SS1); float* ss2 = (float*)(ws + WS_SS2); float* ss3 = (float*)(ws + WS_SS3);
    if (IN(0)) { p0_prologue(P, lds); }
    SEAM(0);
    if (hi - lo > 1 && (G & 7) == 0) {
        if (tid == 0) { bool ok = true; for (int j = 0; j < 8; ++j) ok = ok && (xb_ld((unsigned*)(ws + WS_CTL) + 32 + 32 * j) == (unsigned)(G >> 3)); misc[10] = ok ? misc[9] * 8 + misc[8] : bid; }
        __syncthreads();
        vbid = __builtin_amdgcn_readfirstlane(misc[10]);
        __syncthreads();
    }
    if (IN(1)) {
        pg8::Gemm g{acta, (const f16*)(ws + WS_WGU1), MP, 2 * DFF, D}; pg8::StaticOrder S; S.init(MP, 2 * DFF, G, vbid);
        EpiSwiglu E{Gb, ss0, 1}; pg8::gemm_phase(lds, g, S, E);
    }
    SEAM(1);
    if (IN(2)) {
        meta_down(P, lds);
        pg8::Gemm g{Gb, (const f16*)(ws + WS_WD1), SEQ, D, DFF}; pg8::StaticOrder S; S.init(SEQ, D, G, vbid);
        EpiResid<true> E{acta, (f16*)P.out, ss1, 0.5f}; pg8::gemm_phase(lds, g, S, E);
    }
    SEAM(2);
    if (IN(3)) {
        pg8::Gemm g{(const f16*)P.out, (const f16*)(ws + WS_WIN), MP, NIN, D}; pg8::StaticOrder S; S.init(MP, NIN, G, vbid);
        EpiInProj E{ss1, (const f32x2*)(ws + WS_ROPE), ws};
        pg8::gemm_phase(lds, g, S, E);
    }
    SEAM(3);
    if (IN(4)) {
        for (int u = bid; u < NCH * 4; u += G) gla_a_unit(P, u, lds);
        {
            int tbase = 0, cursor = bid; LAS f16* tl = (LAS f16*)lds;
            prep_weight(P, 3, D, D, (f16*)(ws + WS_WOUT), cursor, tbase, tl);
            prep_weight(P, 4, 2 * DFF, D, (f16*)(ws + WS_WGU2), cursor, tbase, tl);
            prep_weight(P, 5, D, DFF, (f16*)(ws + WS_WD2), cursor, tbase, tl);
        }
    }
    SEAM(4);
    if (IN(5)) {
        if (bid < 64) gla_scan(P);
        unsigned* ctr = (unsigned*)(ws + WS_CTL); LAS int* bc = (LAS int*)(lds + LDS_BYTES - 1024);
        for (;;) {
            if (tid == 0) bc[0] = (int)atomicAdd(ctr, 1u);
            __syncthreads();
            const int k = bc[0];
            __syncthreads();
            if (k >= 513) break;
            indexer_tile(P, 512 - k, lds);
        }
    }
    SEAM(5);
    if (IN(6)) { for (int u = bid; u < NCH * 4; u += G) gla_c_unit(P, u, lds); sparse_attn(P, lds, vbid); }
    SEAM(6);
    if (IN(7)) {
        pg8::Gemm g{acta, (const f16*)(ws + WS_WOUT), SEQ, D, D}; pg8::StaticOrder S; S.init(SEQ, D, G, vbid);
        EpiResid<true> E{P.out, (f16*)(ws + WS_US), ss2, 1.0f}; pg8::gemm_phase(lds, g, S, E);
    }
    SEAM(7);
    if (IN(8)) {
        pg8::Gemm g{(const f16*)(ws + WS_US), (const f16*)(ws + WS_WGU2), SEQ, 2 * DFF, D}; pg8::StaticOrder S; S.init(SEQ, 2 * DFF, G, vbid);
        EpiSwiglu E{Gb, ss2, 16}; pg8::gemm_phase(lds, g, S, E);
    }
    SEAM(8);
    if (IN(9)) {
        pg8::Gemm g{Gb, (const f16*)(ws + WS_WD2), SEQ, D, DFF}; pg8::StaticOrder S; S.init(SEQ, D, G, vbid);
        EpiResid<true> E{ws + WS_US, acta, ss3, 0.5f}; pg8::gemm_phase(lds, g, S, E);
    }
    SEAM(9);
    if (IN(10)) final_norm(P);
#undef IN
#undef SEAM
}

extern "C" void kernel_launch(void* const* d_in, const int* in_sizes, int n_in, void* d_out, int out_size, void* d_ws, size_t ws_size, hipStream_t stream) {
    static int grid = 0;
    if (grid == 0) {
        if (n_in != 17 || in_sizes[0] != SEQ * D || out_size != SEQ * D || ws_size < WS_END) { fprintf(stderr, "kernel_launch: unexpected shapes (n_in %d, in0 %d, out %d, ws %zu, need %zu)\n", n_in, n_in > 0 ? in_sizes[0] : -1, out_size, ws_size, (size_t)WS_END); grid = -1; return; }
        int dev = 0, cus = 0, per_cu = 0;
        (void)hipGetDevice(&dev); (void)hipDeviceGetAttribute(&cus, hipDeviceAttributeMultiprocessorCount, dev);
        if (hipOccupancyMaxActiveBlocksPerMultiprocessor(&per_cu, (const void*)fwd_kernel, NTHREADS, 0) != hipSuccess || per_cu < 1) { fprintf(stderr, "kernel_launch: occupancy query says %d blocks per CU\n", per_cu); per_cu = 1; }
        (void)hipGetLastError();
        grid = cus;
        if (grid % 8 != 0 || grid < 64) { fprintf(stderr, "kernel_launch: unexpected CU count %d\n", cus); }
    }
    if (grid < 0) return;
    if (hipMemsetAsync((char*)d_ws + WS_CTL, 0, CTL_BYTES, stream) != hipSuccess) { fprintf(stderr, "kernel_launch: memset failed\n"); return; }
    Params p{};
    const float** pp = (const float**)&p;
    for (int i = 0; i < 17; ++i) pp[i] = (const float*)d_in[i];
    p.out = (float*)d_out; p.ws = (unsigned char*)d_ws;
#if MODE == 0
    for (int ph = 0; ph < NPHASE; ++ph) { p.ph_lo = ph; p.ph_hi = ph + 1; hipLaunchKernelGGL(fwd_kernel, dim3(grid), dim3(NTHREADS), 0, stream, p); }
#else
    p.ph_lo = 0; p.ph_hi = NPHASE;
    void* args[] = {&p};
    hipError_t e = hipLaunchCooperativeKernel((const void*)fwd_kernel, dim3(grid), dim3(NTHREADS), args, 0, stream);
    if (e != hipSuccess) fprintf(stderr, "cooperative launch failed: %s (grid %d)\n", hipGetErrorString(e), grid);
#endif
}
```

```cpp
#include <hip/hip_runtime.h>
#include <cstdio>
#include <cstdint>

#ifndef MODE
#define MODE 1
#endif

#define LAS __attribute__((address_space(3)))
typedef _Float16 f16;
typedef _Float16 half8 __attribute__((ext_vector_type(8)));
typedef _Float16 half4 __attribute__((ext_vector_type(4)));
typedef float f32x2 __attribute__((ext_vector_type(2)));
typedef float f32x4 __attribute__((ext_vector_type(4)));
typedef float f32x16 __attribute__((ext_vector_type(16)));
typedef unsigned u32x2 __attribute__((ext_vector_type(2)));
typedef unsigned u32x4 __attribute__((ext_vector_type(4)));

constexpr int D = 1024, SEQ = 16384, NMETA = 16, L = SEQ + NMETA, DFF = 2816;
constexpr int MP = 16640;
constexpr int LP = 16512;
constexpr int NIN = 3840;
constexpr int NCH = 257;
constexpr float EPS = 1e-6f;
constexpr int NTHREADS = 512;
constexpr int LDS_BYTES = 155648 + 1024;
constexpr int NPHASE = 11;

constexpr size_t al256(size_t x) { return (x + 255) & ~(size_t)255; }
constexpr size_t WS_CTL = 0;
constexpr size_t CTL_BYTES = 32768;
constexpr size_t WS_BAR = 2048;
constexpr size_t WS_WGU1 = CTL_BYTES;
constexpr size_t WS_WD1 = WS_WGU1 + (size_t)2 * DFF * D * 2;
constexpr size_t WS_WIN = WS_WD1 + (size_t)D * DFF * 2;
constexpr size_t WS_WOUT = WS_WIN + (size_t)NIN * D * 2;
constexpr size_t WS_WGU2 = WS_WOUT + (size_t)D * D * 2;
constexpr size_t WS_WD2 = WS_WGU2 + (size_t)2 * DFF * D * 2;
constexpr size_t WS_ACTA = WS_WD2 + (size_t)D * DFF * 2;
constexpr size_t WS_G = WS_ACTA + (size_t)MP * D * 2;
constexpr size_t WS_US = WS_G + (size_t)MP * DFF * 2;
constexpr size_t WS_DQ = WS_US + (size_t)NCH * 4 * 64 * 128 * 4;
constexpr size_t WS_IQ = WS_DQ + (size_t)LP * 512 * 2;
constexpr size_t WS_SEL = WS_IQ + (size_t)LP * 512 * 2;
constexpr size_t WS_ROPE = WS_SEL + (size_t)LP * 256 * 2;
constexpr size_t WS_IW = WS_ROPE + al256((size_t)L * 32 * 8);
constexpr size_t WS_GA = WS_IW + (size_t)LP * 8 * 4;
constexpr size_t WS_DECAY = WS_GA + (size_t)LP * 16 * 4;
constexpr size_t WS_SS0 = WS_DECAY + al256((size_t)NCH * 256 * 4);
constexpr size_t WS_SS1 = WS_SS0 + (size_t)MP * 4;
constexpr size_t WS_SS2 = WS_SS1 + (size_t)MP * 64;
constexpr size_t WS_SS3 = WS_SS2 + (size_t)MP * 64;
constexpr size_t WS_END = WS_SS3 + (size_t)MP * 64;
constexpr size_t WS_KV = WS_G;
constexpr size_t WS_GQ = WS_KV + (size_t)8 * LP * 128 * 2;
constexpr size_t WS_GK = WS_GQ + (size_t)LP * 256 * 2;
constexpr size_t WS_GV = WS_GK + (size_t)LP * 256 * 2;
constexpr size_t WS_GR = WS_GV + (size_t)LP * 512 * 2;
constexpr size_t WS_IK = WS_GR + (size_t)LP * 512 * 2;
constexpr size_t WS_ALIAS_END = WS_IK + (size_t)LP * 64 * 2;
static_assert(WS_ALIAS_END <= WS_US, "aliased buffers exceed G");
static_assert(WS_END <= (size_t)256 * 1024 * 1024, "workspace exceeds 256 MiB");
static_assert((size_t)SEQ * D * 2 <= (size_t)NCH * 4 * 64 * 128 * 4, "h2_16 alias");

struct Params {
    const float* x; const float* meta; const float* n1; const float* wg1; const float* wu1; const float* wd1;
    const float* nmix; const float* win; const float* wa2; const float* ba; const float* hn; const float* wout;
    const float* n2; const float* wg2; const float* wu2; const float* wd2; const float* nf;
    float* out; unsigned char* ws; int ph_lo, ph_hi;
};

namespace pg8 {
constexpr int BM = 256, BK = 64, HALF = 128, HTB = HALF * BK * 2, STAGE_BYTES = 8 * HTB, NXCD = 8, WGM = 8;
__host__ __device__ __forceinline__ int lds_byte(int r, int c) { const int st = (r >> 4) * 2 + (c >> 5), rr = r & 15, cc = c & 31, ob = rr * 64 + cc * 2; return st * 1024 + (ob ^ (((ob >> 9) & 1) << 5)); }
__host__ __device__ __forceinline__ int perm32(int rho) { const int n = rho >> 4, i = rho & 15; return 8 * (i >> 2) + 4 * n + (i & 3); }
__host__ __device__ __forceinline__ void stage_rc(int b, int& R, int& C) { const int st = b / 1024, sb = b % 1024, swz = sb ^ (((sb >> 9) & 1) << 5); R = (st >> 1) * 16 + swz / 64; C = (st & 1) * 32 + (swz % 64) / 2; }
struct Unit { int pm, pn; };
struct Gemm { const f16* A; const f16* Bt; int M, N, K; };
struct StaticOrder {
    int nM, nN, nwg, G, c;
    __host__ __device__ void init(int M, int N, int G_, int c_) { nM = M / BM; nN = N / BM; nwg = nM * nN; G = G_; c = c_; }
    __host__ __device__ bool next(int i, Unit& u) const {
        const long Lx = (long)i * G + c; if (Lx >= nwg) return false;
        int wgid = (int)Lx; { const int q = nwg / NXCD, r = nwg % NXCD, xcd = wgid % NXCD, off = wgid / NXCD; wgid = (xcd < r ? xcd * (q + 1) : r * (q + 1) + (xcd - r) * q) + off; }
        const int nig = WGM * nN, gid = wgid / nig, fm = gid * WGM, gsz = (nM - fm) < WGM ? (nM - fm) : WGM;
        u.pm = fm + ((wgid % nig) % gsz); u.pn = (wgid % nig) / gsz; return true;
    }
};
template <class Epi>
__device__ __forceinline__ void gemm_phase(LAS unsigned char* lds, const Gemm g, const StaticOrder& S, const Epi& E) {
    int tid_ = threadIdx.x; asm volatile("" : "+v"(tid_));
    const int tid = tid_, wid = __builtin_amdgcn_readfirstlane(tid >> 6), lane = tid & 63, wr = wid >> 2, wc = wid & 3, fr = lane & 15, fq = lane >> 4;
    const int K = g.K, nt = K / BK;
    unsigned voffA[2], voffB[2];
#pragma unroll
    for (int i = 0; i < 2; ++i) { int R, C; stage_rc(tid * 16 + i * 8192, R, C); const int Rb = (R & ~31) + perm32(R & 31); voffA[i] = (unsigned)(R * K + C) * 2u; voffB[i] = (unsigned)(Rb * K + C) * 2u; }
    const size_t kstep = (size_t)(BK * 2);
    const size_t hstep = (size_t)HALF * K * 2;
    const size_t tstep = 2 * hstep;
    const unsigned ldsw = (unsigned)wid * 1024u;
    const int aoff = lds_byte(wr * 64 + fr, fq * 8), boff = lds_byte(wc * 32 + fr, fq * 8);
#define PG8_SA(b, h) (((b) * 2 + (h)) * HTB)
#define PG8_SB(b, h) ((4 + (b) * 2 + (h)) * HTB)
#define PG8_STAGE(bufoff, gbase, voff) do { _Pragma("unroll") for (int _i = 0; _i < 2; ++_i) \
        __builtin_amdgcn_global_load_lds((const unsigned*)((const char*)(gbase) + (voff)[_i]), (LAS unsigned*)(lds + (bufoff) + ldsw + _i * 8192), 16, 0, 0); } while (0)
#define PG8_LDA(dst, b, h) do { _Pragma("unroll") for (int m = 0; m < 4; ++m) _Pragma("unroll") for (int k = 0; k < 2; ++k) dst[m][k] = *(const LAS half8*)(lds + PG8_SA(b, h) + aoff + m * 2048 + k * 1024); } while (0)
#define PG8_LDB(dst, b, h) do { _Pragma("unroll") for (int n = 0; n < 2; ++n) _Pragma("unroll") for (int k = 0; k < 2; ++k) dst[n][k] = *(const LAS half8*)(lds + PG8_SB(b, h) + boff + n * 2048 + k * 1024); } while (0)
#define PG8_MMA(ai, bj, At, Bt) do { __builtin_amdgcn_s_setprio(1); _Pragma("unroll") for (int m = 0; m < 4; ++m) _Pragma("unroll") for (int n = 0; n < 2; ++n) _Pragma("unroll") for (int k = 0; k < 2; ++k) \
        acc[ai][bj][m][n] = __builtin_amdgcn_mfma_f32_16x16x32_f16(Bt[n][k], At[m][k], acc[ai][bj][m][n], 0, 0, 0); __builtin_amdgcn_s_setprio(0); } while (0)
#define PG8_WAIT_V(n) asm volatile("s_waitcnt vmcnt(" #n ")" ::: "memory")
#define PG8_WAIT_L(n) asm volatile("s_waitcnt lgkmcnt(" #n ")" ::: "memory")
#define PG8_BAR __builtin_amdgcn_s_barrier()
#define PG8_SCHED __builtin_amdgcn_sched_barrier(0)
    Unit cur, nxt; int ui = 0;
    if (!S.next(0, cur)) return;
    f32x4 acc[2][2][4][2];
#pragma unroll
    for (int a = 0; a < 2; ++a)
#pragma unroll
        for (int b = 0; b < 2; ++b)
#pragma unroll
            for (int m = 0; m < 4; ++m)
#pragma unroll
                for (int n = 0; n < 2; ++n) acc[a][b][m][n] = (f32x4){0.f, 0.f, 0.f, 0.f};
    half8 At[4][2], B0[2][2], B1[2][2];
    const char* cA = (const char*)g.A + (size_t)cur.pm * tstep; const char* cB = (const char*)g.Bt + (size_t)cur.pn * tstep;
    PG8_STAGE(PG8_SB(0, 0), cB, voffB); PG8_STAGE(PG8_SA(0, 0), cA, voffA); PG8_STAGE(PG8_SB(0, 1), cB + hstep, voffB); PG8_STAGE(PG8_SA(0, 1), cA + hstep, voffA);
    if (wr == 1) PG8_BAR;
    PG8_WAIT_V(4); PG8_BAR;
    PG8_STAGE(PG8_SB(1, 0), cB + kstep, voffB); PG8_STAGE(PG8_SA(1, 0), cA + kstep, voffA); PG8_STAGE(PG8_SB(1, 1), cB + hstep + kstep, voffB);
    PG8_WAIT_V(6); PG8_BAR;
    for (;;) {
        const bool has_next = S.next(ui + 1, nxt);
        const char* nA = has_next ? (const char*)g.A + (size_t)nxt.pm * tstep : cA; const char* nB = has_next ? (const char*)g.Bt + (size_t)nxt.pn * tstep : cB;
        for (int t = 0; t < nt; t += 2) {
            const bool last = (t == nt - 2);
            const char* a1 = cA + (size_t)(t + 1) * kstep;
            const char* a2 = last ? nA : cA + (size_t)(t + 2) * kstep; const char* b2 = last ? nB : cB + (size_t)(t + 2) * kstep;
            const char* a3 = a2 + kstep; const char* b3 = b2 + kstep;
            PG8_LDB(B0, 0, 0); PG8_SCHED; PG8_LDA(At, 0, 0); PG8_STAGE(PG8_SA(1, 1), a1 + hstep, voffA);
            PG8_WAIT_L(8); PG8_BAR; PG8_WAIT_L(0); PG8_MMA(0, 0, At, B0); PG8_BAR; PG8_SCHED;
            PG8_LDB(B1, 0, 1); PG8_STAGE(PG8_SB(0, 0), b2, voffB);
            PG8_BAR; PG8_WAIT_L(0); PG8_MMA(0, 1, At, B1); PG8_BAR;
            PG8_LDA(At, 0, 1); PG8_STAGE(PG8_SA(0, 0), a2, voffA);
            PG8_BAR; PG8_WAIT_L(0); PG8_MMA(1, 0, At, B0); PG8_BAR; PG8_SCHED;
            PG8_STAGE(PG8_SB(0, 1), b2 + hstep, voffB);
            PG8_WAIT_V(6); PG8_BAR; PG8_MMA(1, 1, At, B1); PG8_BAR;
            PG8_LDB(B0, 1, 0); PG8_SCHED; PG8_LDA(At, 1, 0); PG8_STAGE(PG8_SA(0, 1), a2 + hstep, voffA);
            PG8_WAIT_L(8); PG8_BAR; PG8_WAIT_L(0); PG8_MMA(0, 0, At, B0); PG8_BAR; PG8_SCHED;
            PG8_LDB(B1, 1, 1); PG8_STAGE(PG8_SB(1, 0), b3, voffB);
            PG8_BAR; PG8_WAIT_L(0); PG8_MMA(0, 1, At, B1); PG8_BAR;
            PG8_LDA(At, 1, 1); PG8_STAGE(PG8_SA(1, 0), a3, voffA);
            PG8_BAR; PG8_WAIT_L(0); PG8_MMA(1, 0, At, B0); PG8_BAR; PG8_SCHED;
            PG8_STAGE(PG8_SB(1, 1), b3 + hstep, voffB);
            PG8_WAIT_V(6); PG8_BAR; PG8_MMA(1, 1, At, B1); PG8_BAR;
        }
        E(acc, cur, wr, wc, fr, fq);
        if (!has_next) break;
#pragma unroll
        for (int a = 0; a < 2; ++a)
#pragma unroll
            for (int b = 0; b < 2; ++b)
#pragma unroll
                for (int m = 0; m < 4; ++m)
#pragma unroll
                    for (int n = 0; n < 2; ++n) acc[a][b][m][n] = (f32x4){0.f, 0.f, 0.f, 0.f};
        cur = nxt; cA = nA; cB = nB; ++ui;
    }
    PG8_WAIT_V(0);
    if (wr == 0) PG8_BAR;
    PG8_BAR;
#undef PG8_SA
#undef PG8_SB
#undef PG8_STAGE
#undef PG8_LDA
#undef PG8_LDB
#undef PG8_MMA
#undef PG8_WAIT_V
#undef PG8_WAIT_L
#undef PG8_BAR
#undef PG8_SCHED
}
}

__device__ __forceinline__ float silu_f(float v) { return v * __builtin_amdgcn_rcpf(1.0f + __expf(-v)); }
__device__ __forceinline__ half4 to_half4(f32x4 v) { half4 h; h[0] = (f16)v[0]; h[1] = (f16)v[1]; h[2] = (f16)v[2]; h[3] = (f16)v[3]; return h; }

__device__ __forceinline__ float row_rstd(const float* ss, int np, int row) {
    float s;
    if (np == 1) s = ss[row];
    else { const f32x4* p = (const f32x4*)(ss + (size_t)row * 16); const f32x4 a = p[0], b = p[1], c = p[2], d = p[3];
        s = (((a[0] + a[1]) + (a[2] + a[3])) + ((b[0] + b[1]) + (b[2] + b[3]))) + (((c[0] + c[1]) + (c[2] + c[3])) + ((d[0] + d[1]) + (d[2] + d[3]))); }
    return rsqrtf(s * (1.0f / D) + EPS);
}
struct EpiSwiglu {
    f16* G; const float* ss; int np;
    __device__ __forceinline__ void operator()(const f32x4 (&acc)[2][2][4][2], const pg8::Unit& u, int wr, int wc, int fr_, int fq_) const {
        int fr = fr_, fq = fq_; asm volatile("" : "+v"(fr), "+v"(fq));
#pragma unroll
        for (int ai = 0; ai < 2; ++ai)
#pragma unroll
            for (int m = 0; m < 4; ++m) {
                const int row = u.pm * 256 + ai * 128 + wr * 64 + m * 16 + fr;
                const float rs = row_rstd(ss, np, row), ce = -1.4426950408889634f * rs, rs2 = rs * rs; half8 o;
#pragma unroll
                for (int n = 0; n < 2; ++n) {
                    const f32x4 g = acc[ai][0][m][n], u = acc[ai][1][m][n]; const f32x4 t = g * ce; f32x4 e, r;
#pragma unroll
                    for (int j = 0; j < 4; ++j) e[j] = __builtin_amdgcn_exp2f(t[j]);
                    const f32x4 d = e + 1.0f;
#pragma unroll
                    for (int j = 0; j < 4; ++j) r[j] = __builtin_amdgcn_rcpf(d[j]);
                    const f32x4 w = (g * u) * (r * rs2);
#pragma unroll
                    for (int j = 0; j < 4; ++j) o[4 * n + j] = (f16)w[j];
                }
                *(half8*)(G + (size_t)row * DFF + u.pn * 128 + wc * 32 + 8 * fq) = o;
            }
    }
};
template <bool SRC16> struct EpiResid {
    const void* src; f16* h16; float* ss; float alpha;
    __device__ __forceinline__ void operator()(const f32x4 (&acc)[2][2][4][2], const pg8::Unit& u, int wr, int wc, int fr_, int fq_) const {
        int fr = fr_, fq = fq_; asm volatile("" : "+v"(fr), "+v"(fq));
#pragma unroll
        for (int ai = 0; ai < 2; ++ai)
#pragma unroll
            for (int m = 0; m < 4; ++m) {
                const int row = u.pm * 256 + ai * 128 + wr * 64 + m * 16 + fr; float part = 0.f;
#pragma unroll
                for (int bj = 0; bj < 2; ++bj) {
                    const size_t off = (size_t)row * D + u.pn * 256 + bj * 128 + wc * 32 + 8 * fq; half8 h; f32x4 sv[2];
                    if (SRC16) { const half8 s8 = *(const half8*)((const f16*)src + off);
#pragma unroll
                        for (int j = 0; j < 4; ++j) { sv[0][j] = (float)s8[j]; sv[1][j] = (float)s8[4 + j]; } }
                    else { sv[0] = *(const f32x4*)((const float*)src + off); sv[1] = *(const f32x4*)((const float*)src + off + 4); }
#pragma unroll
                    for (int n = 0; n < 2; ++n) {
                        const f32x4 o = sv[n] + alpha * acc[ai][bj][m][n];
#pragma unroll
                        for (int j = 0; j < 4; ++j) h[4 * n + j] = (f16)o[j];
                        part += (o[0] * o[0] + o[1] * o[1]) + (o[2] * o[2] + o[3] * o[3]);
                    }
                    *(half8*)(h16 + off) = h;
                }
                part += __shfl_xor(part, 16); part += __shfl_xor(part, 32);
                if (fq == 0) ss[(size_t)row * 16 + u.pn * 4 + wc] = part;
            }
    }
};
constexpr float KV_SCALE = 16.0f;
constexpr float K_I8_SCALE = 127.0f / 8.0f;
__device__ __forceinline__ unsigned pack_fp8x4(f32x4 v) {
#pragma unroll
    for (int j = 0; j < 4; ++j) v[j] = fminf(fmaxf(v[j], -448.f), 448.f);
    int w = __builtin_amdgcn_cvt_pk_fp8_f32(v[0], v[1], 0, false); w = __builtin_amdgcn_cvt_pk_fp8_f32(v[2], v[3], w, true); return (unsigned)w;
}
__device__ __forceinline__ void rope8(const f32x4 (&x1)[2], const f32x4 (&x2)[2], const f32x2* rp, float sc, float (&o1)[8], float (&o2)[8]) {
#pragma unroll
    for (int n = 0; n < 2; ++n) {
        const f32x4 cs0 = *(const f32x4*)(rp + 4 * n), cs1 = *(const f32x4*)(rp + 4 * n + 2);
        o1[4 * n + 0] = (x1[n][0] * cs0[0] - x2[n][0] * cs0[1]) * sc; o2[4 * n + 0] = (x2[n][0] * cs0[0] + x1[n][0] * cs0[1]) * sc;
        o1[4 * n + 1] = (x1[n][1] * cs0[2] - x2[n][1] * cs0[3]) * sc; o2[4 * n + 1] = (x2[n][1] * cs0[2] + x1[n][1] * cs0[3]) * sc;
        o1[4 * n + 2] = (x1[n][2] * cs1[0] - x2[n][2] * cs1[1]) * sc; o2[4 * n + 2] = (x2[n][2] * cs1[0] + x1[n][2] * cs1[1]) * sc;
        o1[4 * n + 3] = (x1[n][3] * cs1[2] - x2[n][3] * cs1[3]) * sc; o2[4 * n + 3] = (x2[n][3] * cs1[2] + x1[n][3] * cs1[3]) * sc;
    }
}
__device__ __forceinline__ u32x2 pack_i8x8(const float (&v)[8]) {
    u32x2 r;
#pragma unroll
    for (int w = 0; w < 2; ++w) { unsigned word = 0u;
#pragma unroll
        for (int j = 0; j < 4; ++j) { const int q = (int)__builtin_rintf(fminf(fmaxf(v[4 * w + j] * K_I8_SCALE, -127.f), 127.f)); word |= ((unsigned)q & 0xffu) << (8 * j); }
        r[w] = word; }
    return r;
}
__device__ __forceinline__ u32x2 pack_bf8x8(const float (&v)[8]) {
    u32x2 r;
#pragma unroll
    for (int w = 0; w < 2; ++w) { int word = __builtin_amdgcn_cvt_pk_bf8_f32(v[4 * w], v[4 * w + 1], 0, false); word = __builtin_amdgcn_cvt_pk_bf8_f32(v[4 * w + 2], v[4 * w + 3], word, true); r[w] = (unsigned)word; }
    return r;
}
__device__ __forceinline__ u32x2 pack_fp8x8(const float (&v)[8]) { u32x2 r; r[0] = pack_fp8x4((f32x4){v[0], v[1], v[2], v[3]}); r[1] = pack_fp8x4((f32x4){v[4], v[5], v[6], v[7]}); return r; }
struct EpiInProj {
    const float* ss; const f32x2* rope; unsigned char* ws;
    __device__ __forceinline__ void operator()(const f32x4 (&acc)[2][2][4][2], const pg8::Unit& u, int wr, int wc, int fr_, int fq_) const {
        int fr = fr_, fq = fq_; asm volatile("" : "+v"(fr), "+v"(fq));
        const int pn = u.pn;
        if (pn >= 8 && pn <= 11) {
            unsigned char* lb = (pn <= 9) ? ws + WS_KV + (size_t)((pn - 8) * 4 + wc) * LP * 128 + 8 * fq
                                          : ws + WS_KV + (size_t)((pn - 10) * 4 + (wc >> 1)) * LP * 128 + 64 + (wc & 1) * 32 + 8 * fq;
#pragma unroll
            for (int ai = 0; ai < 2; ++ai)
#pragma unroll
                for (int m = 0; m < 4; ++m) {
                    const int p = u.pm * 256 + ai * 128 + wr * 64 + m * 16 + fr;
                    const int t = p < SEQ ? p + NMETA : p - SEQ;
                    if (p < L) {
                        const float sc = row_rstd(ss, 16, p);
                        if (pn <= 9) {
                            float o1[8], o2[8]; rope8(acc[ai][0][m], acc[ai][1][m], rope + (size_t)t * 32 + 8 * fq, sc, o1, o2);
                            unsigned char* d8 = lb + (size_t)t * 128; *(u32x2*)d8 = pack_i8x8(o1); *(u32x2*)(d8 + 32) = pack_i8x8(o2);
                        } else {
#pragma unroll
                            for (int bj = 0; bj < 2; ++bj) { float v[8];
#pragma unroll
                                for (int j = 0; j < 4; ++j) { v[j] = acc[ai][bj][m][0][j] * sc; v[4 + j] = acc[ai][bj][m][1][j] * sc; }
                                *(u32x2*)(lb + (size_t)t * 128 + (size_t)bj * 2 * LP * 128) = pack_bf8x8(v); }
                        }
                    }
                    asm volatile("" ::: "memory");
                }
            return;
        }
        int mode = 0, stride = 256; float scale = 1.0f; f16* lanebase;
        if (pn == 0) lanebase = (f16*)(ws + WS_GQ) + wc * 32 + 8 * fq;
        else if (pn == 1) lanebase = (f16*)(ws + WS_GK) + wc * 32 + 8 * fq;
        else if (pn <= 3) { lanebase = (f16*)(ws + WS_GV) + (pn - 2) * 256 + wc * 32 + 8 * fq; stride = 512; }
        else if (pn <= 5) { lanebase = (f16*)(ws + WS_GR) + (pn - 4) * 256 + wc * 32 + 8 * fq; stride = 512; }
        else if (pn <= 7) { lanebase = (f16*)(ws + WS_DQ); mode = 6; scale = 0.125f; }
        else if (pn <= 13) { lanebase = (f16*)(ws + WS_IQ) + (pn - 12) * 256 + wc * 64 + 8 * fq; stride = 512; mode = 1; scale = 0.125f; }
        else { lanebase = (f16*)(ws + WS_IK) + 8 * fq; stride = 64; mode = wc == 0 ? 1 : (wc == 1 ? 2 : 3); }
#pragma unroll
        for (int ai = 0; ai < 2; ++ai)
#pragma unroll
            for (int m = 0; m < 4; ++m) {
                const int p = u.pm * 256 + ai * 128 + wr * 64 + m * 16 + fr;
                const int t = p < SEQ ? p + NMETA : p - SEQ;
                if (p < L && mode != 3) {
                    const float rs = row_rstd(ss, 16, p);
                    if (mode == 6) {
                        float o1[8], o2[8]; rope8(acc[ai][0][m], acc[ai][1][m], rope + (size_t)t * 32 + 8 * fq, rs * scale, o1, o2);
                        float qm = 1e-20f;
#pragma unroll
                        for (int j = 0; j < 8; ++j) qm = fmaxf(qm, fmaxf(fabsf(o1[j]), fabsf(o2[j])));
                        qm = fmaxf(qm, __shfl_xor(qm, 16)); qm = fmaxf(qm, __shfl_xor(qm, 32));
                        const float qsc = 127.0f * __builtin_amdgcn_rcpf(qm); u32x2 w1, w2;
#pragma unroll
                        for (int w = 0; w < 2; ++w) { unsigned a = 0u, b = 0u;
#pragma unroll
                            for (int j = 0; j < 4; ++j) { a |= ((unsigned)(int)__builtin_rintf(o1[4 * w + j] * qsc) & 0xffu) << (8 * j); b |= ((unsigned)(int)__builtin_rintf(o2[4 * w + j] * qsc) & 0xffu) << (8 * j); }
                            w1[w] = a; w2[w] = b; }
                        const int head = (pn - 6) * 4 + wc; unsigned char* qrow = ws + WS_DQ + (size_t)t * 512 + head * 64 + 8 * fq;
                        *(u32x2*)qrow = w1; *(u32x2*)(qrow + 32) = w2;
                        if (fq == 0) ((float*)(ws + WS_DQ + (size_t)LP * 512))[(size_t)t * 8 + head] = qm * (1.0f / (127.0f * K_I8_SCALE));
                    } else if (mode == 1) {
                        float o1[8], o2[8]; rope8(acc[ai][0][m], acc[ai][1][m], rope + (size_t)t * 32 + 8 * fq, rs * scale, o1, o2);
                        half8 h1, h2;
#pragma unroll
                        for (int j = 0; j < 8; ++j) { h1[j] = (f16)o1[j]; h2[j] = (f16)o2[j]; }
                        f16* dst = lanebase + (size_t)t * stride; *(half8*)dst = h1; *(half8*)(dst + 32) = h2;
                    } else if (mode == 2) {
                        if (fq < 2) { float* gp = (float*)(ws + WS_GA) + (size_t)t * 16 + 8 * fq; *(f32x4*)gp = acc[ai][0][m][0] * rs; *(f32x4*)(gp + 4) = acc[ai][0][m][1] * rs; }
                        else if (fq == 2) { float* ip = (float*)(ws + WS_IW) + (size_t)t * 8; const float r2 = rs * 0.35355339059327373f; *(f32x4*)ip = acc[ai][0][m][0] * r2; *(f32x4*)(ip + 4) = acc[ai][0][m][1] * r2; }
                    } else {
#pragma unroll
                        for (int bj = 0; bj < 2; ++bj) { half8 h;
#pragma unroll
                            for (int j = 0; j < 4; ++j) { h[j] = (f16)(acc[ai][bj][m][0][j] * rs); h[4 + j] = (f16)(acc[ai][bj][m][1][j] * rs); }
                            *(half8*)(lanebase + (size_t)t * stride + bj * 128) = h; }
                    }
                }
                asm volatile("" ::: "memory");
            }
    }
};

__device__ __forceinline__ const float* w_src(const Params& P, int kind, int n, int& ld, const float*& gain) {
    switch (kind) {
    case 0: case 4: { const int pn = n >> 8, bj = (n >> 7) & 1, cc = n & 127; ld = DFF; gain = kind == 0 ? P.n1 : P.n2;
        const float* w = kind == 0 ? (bj ? P.wu1 : P.wg1) : (bj ? P.wu2 : P.wg2); return w + pn * 128 + cc; }
    case 1: ld = D; gain = nullptr; return P.wd1 + n;
    case 5: ld = D; gain = nullptr; return P.wd2 + n;
    case 3: ld = D; gain = nullptr; return P.wout + n;
    default: { ld = 3672; gain = P.nmix; const int pn = n >> 8, c = n & 255, bj = c >> 7, hh = (c >> 5) & 3, dd = c & 31; int j;
        if (pn == 0) j = c; else if (pn == 1) j = 256 + c; else if (pn <= 3) j = 512 + (pn - 2) * 256 + c; else if (pn <= 5) j = 1024 + (pn - 4) * 256 + c;
        else if (pn <= 7) j = 1552 + (pn - 6) * 256 + hh * 64 + bj * 32 + dd;
        else if (pn <= 9) j = 2064 + (pn - 8) * 256 + hh * 64 + bj * 32 + dd;
        else if (pn <= 11) j = 2576 + (pn - 10) * 256 + c;
        else if (pn <= 13) j = 3088 + (pn - 12) * 256 + hh * 64 + bj * 32 + dd;
        else { if (c < 32) j = 3600 + c; else if (c < 48) j = 1536 + (c - 32); else if (c < 56) j = 3664 + (c - 48); else if (c >= 128 && c < 160) j = 3600 + 32 + (c - 128); else j = -1; }
        return j < 0 ? nullptr : P.win + j; }
    }
}
__device__ __forceinline__ void prep_weight(const Params& P, const int kind, const int N, const int K, f16* dst, int& cursor, int& tbase, LAS f16* tl) {
    const int tid = threadIdx.x, G = gridDim.x, tn = N / 64, tk = K / 256, ntile = tn * tk;
#pragma unroll 1
    for (; cursor < tbase + ntile; cursor += G) {
        const int tI = cursor - tbase, n0 = (tI % tn) * 64, k0 = (tI / tn) * 256;
        { const int n = tid & 63, kk0 = tid >> 6; int ld; const float* gain; const float* col = w_src(P, kind, n0 + n, ld, gain);
          float v[32];
#pragma unroll
          for (int i = 0; i < 32; ++i) v[i] = col ? col[(size_t)(k0 + kk0 + 8 * i) * ld] : 0.f;
          if (gain) {
#pragma unroll
              for (int i = 0; i < 32; ++i) v[i] *= gain[k0 + kk0 + 8 * i];
          }
#pragma unroll
          for (int i = 0; i < 32; ++i) tl[n * 264 + kk0 + 8 * i] = (f16)v[i]; }
        __syncthreads();
        { const int n = tid >> 3, seg = tid & 7;
#pragma unroll
          for (int j = 0; j < 4; ++j) *(half8*)(dst + (size_t)(n0 + n) * K + k0 + (seg + 8 * j) * 8) = *(const LAS half8*)(tl + n * 264 + (seg + 8 * j) * 8); }
        __syncthreads();
    }
    tbase += ntile;
}
__device__ __forceinline__ void p0_prologue(const Params& P, LAS unsigned char* lds) {
    const int tid = threadIdx.x, bid = blockIdx.x, G = gridDim.x, lane = tid & 63;
    unsigned char* ws = P.ws;
    int tbase = 0, cursor = bid;
    LAS f16* tl = (LAS f16*)lds;
    prep_weight(P, 0, 2 * DFF, D, (f16*)(ws + WS_WGU1), cursor, tbase, tl);
    prep_weight(P, 1, D, DFF, (f16*)(ws + WS_WD1), cursor, tbase, tl);
    prep_weight(P, 2, NIN, D, (f16*)(ws + WS_WIN), cursor, tbase, tl);
    float* ss0 = (float*)(ws + WS_SS0);
    f16* acta = (f16*)(ws + WS_ACTA);
    const int gw = bid * 8 + (tid >> 6), nw = G * 8;
    for (int p = gw; p < L; p += nw) {
        const float* src = p < SEQ ? P.x + (size_t)p * D : P.meta + (size_t)(p - SEQ) * D; float s = 0.f;
#pragma unroll
        for (int i = 0; i < 4; ++i) { const f32x4 v = *(const f32x4*)(src + lane * 4 + 256 * i); s += (v[0] * v[0] + v[1] * v[1]) + (v[2] * v[2] + v[3] * v[3]); *(half4*)(acta + (size_t)p * D + lane * 4 + 256 * i) = to_half4(v); }
#pragma unroll
        for (int o = 32; o >= 1; o >>= 1) s += __shfl_xor(s, o);
        if (lane == 0) ss0[p] = s;
    }
    const int gt = bid * NTHREADS + tid, ngt = G * NTHREADS;
    for (int i = gt; i < MP; i += ngt) { if (i >= L) ss0[i] = (float)D; }
    f32x2* rope = (f32x2*)(ws + WS_ROPE);
    for (int i = gt; i < L * 32; i += ngt) { const int t = i >> 5, f = i & 31; const double inv = exp(-(double)f * (9.210340371976184 / 32.0)); double sn, cs; sincos((double)t * inv, &sn, &cs); rope[i] = (f32x2){(float)cs, (float)sn}; }
}

__device__ __forceinline__ void meta_down(const Params& P, LAS unsigned char* lds) {
    const int tid = threadIdx.x, lane = tid & 63, wid = tid >> 6;
    const f16* Gm = (const f16*)(P.ws + WS_G) + (size_t)SEQ * DFF; const f16* Wt = (const f16*)(P.ws + WS_WD1);
    f16* acta = (f16*)P.out; float* ss1 = (float*)(P.ws + WS_SS1); LAS float* slot = (LAS float*)lds;
    for (int task = blockIdx.x; task < NMETA * 16; task += gridDim.x) {
        const int r = task >> 4, cg = task & 15; float part = 0.f;
#pragma unroll 1
        for (int q = 0; q < 2; ++q) {
            const int n0 = cg * 64 + (2 * wid + q) * 4; float a[4] = {0.f, 0.f, 0.f, 0.f};
            for (int kc = lane; kc < DFF / 8; kc += 64) {
                const half8 gv = *(const half8*)(Gm + (size_t)r * DFF + kc * 8);
#pragma unroll
                for (int j = 0; j < 4; ++j) { const half8 wv = *(const half8*)(Wt + (size_t)(n0 + j) * DFF + kc * 8);
#pragma unroll
                    for (int e = 0; e < 8; ++e) a[j] += (float)gv[e] * (float)wv[e]; }
            }
#pragma unroll
            for (int o = 32; o >= 1; o >>= 1) { a[0] += __shfl_xor(a[0], o); a[1] += __shfl_xor(a[1], o); a[2] += __shfl_xor(a[2], o); a[3] += __shfl_xor(a[3], o); }
            f32x4 o;
#pragma unroll
            for (int j = 0; j < 4; ++j) { o[j] = P.meta[r * D + n0 + j] + 0.5f * a[j]; part += o[j] * o[j]; }
            if (lane == 0) *(half4*)(acta + (size_t)(SEQ + r) * D + n0) = to_half4(o);
        }
        if (lane == 0) slot[wid] = part;
        __syncthreads();
        if (tid == 0) { float s = 0.f; for (int w = 0; w < 8; ++w) s += slot[w]; ss1[(size_t)(SEQ + r) * 16 + cg] = s; }
        __syncthreads();
    }
}

__device__ __forceinline__ float logsigmoid_f(float z) { return fminf(z, 0.f) - __logf(1.0f + __expf(-fabsf(z))); }
__device__ __forceinline__ void gla_gates(const Params& P, int c, int h, LAS float* bl) {
    const int tid = threadIdx.x, ti = tid >> 3, d0 = (tid & 7) * 8, tt = 64 * c - 48 + ti; const float* GA = (const float*)(P.ws + WS_GA);
    {
        float z[8];
        if (tt >= 0 && tt < L) {
            const f32x4 b0 = *(const f32x4*)(P.ba + 64 * h + d0), b1 = *(const f32x4*)(P.ba + 64 * h + d0 + 4);
#pragma unroll
            for (int m = 0; m < 4; ++m) { z[m] = b0[m]; z[4 + m] = b1[m]; }
            f32x4 a4[4];
#pragma unroll
            for (int q = 0; q < 4; ++q) a4[q] = *(const f32x4*)(GA + (size_t)tt * 16 + 4 * q);
#pragma unroll
            for (int r = 0; r < 16; ++r) { const float ar = a4[r >> 2][r & 3]; const f32x4 w0 = *(const f32x4*)(P.wa2 + r * 256 + 64 * h + d0), w1 = *(const f32x4*)(P.wa2 + r * 256 + 64 * h + d0 + 4);
#pragma unroll
                for (int m = 0; m < 4; ++m) { z[m] += ar * w0[m]; z[4 + m] += ar * w1[m]; } }
#pragma unroll
            for (int m = 0; m < 8; ++m) z[m] = logsigmoid_f(z[m]) * (1.0f / 16.0f);
        } else {
#pragma unroll
            for (int m = 0; m < 8; ++m) z[m] = 0.f;
        }
#pragma unroll
        for (int m = 0; m < 8; ++m) bl[ti * 65 + d0 + m] = z[m];
    }
    __syncthreads();
    {
        const int d = tid & 63, seg = tid >> 6; float v[8], run = 0.f;
#pragma unroll
        for (int i = 0; i < 8; ++i) { run += bl[(seg * 8 + i) * 65 + d]; v[i] = run; }
#pragma unroll
        for (int i = 0; i < 8; ++i) bl[(seg * 8 + i) * 65 + d] = v[i];
        __syncthreads();
        float off = 0.f;
#pragma unroll
        for (int sg = 0; sg < 7; ++sg) off += (sg < seg) ? bl[(sg * 8 + 7) * 65 + d] : 0.f;
        __syncthreads();
#pragma unroll
        for (int i = 0; i < 8; ++i) bl[(seg * 8 + i) * 65 + d] = v[i] + off;
    }
    __syncthreads();
}
__device__ __forceinline__ void gla_a_unit(const Params& P, int unit, LAS unsigned char* lds) {
    int tid_ = threadIdx.x; asm volatile("" : "+v"(tid_));
    const int tid = tid_, lane = tid & 63, wid = tid >> 6, c = unit >> 2, h = unit & 3;
    LAS float* bl = (LAS float*)lds; LAS float* ks = bl + 4160; LAS float* vs = ks + 4096;
    const f16* GK = (const f16*)(P.ws + WS_GK); const f16* GV = (const f16*)(P.ws + WS_GV);
    float* U = (float*)(P.ws + WS_US); float* DEC = (float*)(P.ws + WS_DECAY);
    const int ti = tid >> 3, d0 = (tid & 7) * 8, tt = 64 * c - 48 + ti; const bool tv = tt >= 0 && tt < L;
    half8 k8, v8[2];
#pragma unroll
    for (int m = 0; m < 8; ++m) { k8[m] = (f16)0.f; v8[0][m] = (f16)0.f; v8[1][m] = (f16)0.f; }
    if (tv) k8 = *(const half8*)(GK + (size_t)tt * 256 + 64 * h + d0);
#pragma unroll
    for (int q = 0; q < 2; ++q) { const int ch = tid + 512 * q, j = ch >> 4, t = 64 * c - 48 + j; if (t >= 0 && t < L) v8[q] = *(const half8*)(GV + (size_t)t * 512 + 128 * h + (ch & 15) * 8); }
    gla_gates(P, c, h, bl);
    { f32x4 o0, o1;
#pragma unroll
      for (int m = 0; m < 4; ++m) { o0[m] = (float)k8[m] * __expf(bl[63 * 65 + d0 + m] - bl[ti * 65 + d0 + m]); o1[m] = (float)k8[4 + m] * __expf(bl[63 * 65 + d0 + 4 + m] - bl[ti * 65 + d0 + 4 + m]); }
      *(LAS f32x4*)(ks + ti * 64 + d0) = o0; *(LAS f32x4*)(ks + ti * 64 + d0 + 4) = o1; }
#pragma unroll
    for (int q = 0; q < 2; ++q) { const int ch = tid + 512 * q, j = ch >> 4, e0 = (ch & 15) * 8; f32x4 o0, o1;
#pragma unroll
        for (int m = 0; m < 4; ++m) { o0[m] = (float)v8[q][m]; o1[m] = (float)v8[q][4 + m]; }
        *(LAS f32x4*)(vs + j * 128 + e0) = o0; *(LAS f32x4*)(vs + j * 128 + e0 + 4) = o1; }
    if (tid < 64) DEC[(size_t)c * 256 + h * 64 + tid] = __expf(bl[63 * 65 + tid]);
    __syncthreads();
    { const int dd0 = (wid >> 2) * 32, e0 = (wid & 3) * 32, l31 = lane & 31, hf = lane >> 5; f32x16 acc;
#pragma unroll
      for (int i = 0; i < 16; ++i) acc[i] = 0.f;
#pragma unroll 8
      for (int s = 0; s < 32; ++s) acc = __builtin_amdgcn_mfma_f32_32x32x2f32(ks[(2 * s + hf) * 64 + dd0 + l31], vs[(2 * s + hf) * 128 + e0 + l31], acc, 0, 0, 0);
      float* up = U + ((size_t)unit * 64) * 128;
#pragma unroll
      for (int r = 0; r < 16; ++r) { const int row = (r & 3) + 8 * (r >> 2) + 4 * hf; up[(size_t)(dd0 + row) * 128 + e0 + l31] = acc[r]; } }
    __syncthreads();
}
__device__ __forceinline__ void gla_scan(const Params& P) {
    float* U = (float*)(P.ws + WS_US); const float* DEC = (const float*)(P.ws + WS_DECAY);
    const int idx = blockIdx.x * NTHREADS + threadIdx.x;
    if (idx >= 32768) return;
    float s = 0.f;
#pragma unroll 8
    for (int c = 0; c < NCH; ++c) { const float u = U[(size_t)c * 32768 + idx], dc = DEC[(size_t)c * 256 + (idx >> 7)]; U[(size_t)c * 32768 + idx] = s; s = dc * s + u; }
}
__device__ __forceinline__ void gla_c_unit(const Params& P, int unit, LAS unsigned char* lds) {
    int tid_ = threadIdx.x; asm volatile("" : "+v"(tid_));
    const int tid = tid_, lane = tid & 63, wid = tid >> 6, c = unit >> 2, h = unit & 3, l31 = lane & 31, hf = lane >> 5;
    LAS float* bl = (LAS float*)lds; LAS float* kk = bl + 4160; LAS float* qs = kk + 4160; LAS float* As = qs + 4160; LAS float* vs = As + 4160; LAS float* Ss = vs + 8192; LAS float* os = bl;
    const f16* GQ = (const f16*)(P.ws + WS_GQ); const f16* GK = (const f16*)(P.ws + WS_GK); const f16* GV = (const f16*)(P.ws + WS_GV); const f16* GR = (const f16*)(P.ws + WS_GR);
    const float* Sg = (const float*)(P.ws + WS_US) + (size_t)unit * 8192; f16* mix = (f16*)(P.ws + WS_ACTA);
    const int ti = tid >> 3, d0 = (tid & 7) * 8, tt = 64 * c - 48 + ti; const bool tv = tt >= 0 && tt < L;
    half8 q8, k8, v8[2], r8[2]; f32x4 sreg[4];
#pragma unroll
    for (int m = 0; m < 8; ++m) { q8[m] = (f16)0.f; k8[m] = (f16)0.f; v8[0][m] = (f16)0.f; v8[1][m] = (f16)0.f; r8[0][m] = (f16)0.f; r8[1][m] = (f16)0.f; }
    if (tv) { q8 = *(const half8*)(GQ + (size_t)tt * 256 + 64 * h + d0); k8 = *(const half8*)(GK + (size_t)tt * 256 + 64 * h + d0);
        r8[0] = *(const half8*)(GR + (size_t)tt * 512 + 128 * h + (tid & 7) * 16); r8[1] = *(const half8*)(GR + (size_t)tt * 512 + 128 * h + (tid & 7) * 16 + 8); }
#pragma unroll
    for (int q = 0; q < 2; ++q) { const int ch = tid + 512 * q, j = ch >> 4, t = 64 * c - 48 + j; if (t >= 0 && t < L) v8[q] = *(const half8*)(GV + (size_t)t * 512 + 128 * h + (ch & 15) * 8); }
#pragma unroll
    for (int q = 0; q < 4; ++q) sreg[q] = *(const f32x4*)(Sg + (size_t)(tid + 512 * q) * 4);
    gla_gates(P, c, h, bl);
#pragma unroll
    for (int m = 0; m < 8; ++m) { const float bv = bl[ti * 65 + d0 + m]; qs[ti * 65 + d0 + m] = (float)q8[m] * 0.125f * __expf(bv); kk[ti * 65 + d0 + m] = (float)k8[m] * __expf(-bv); }
#pragma unroll
    for (int q = 0; q < 2; ++q) { const int ch = tid + 512 * q, j = ch >> 4, e0 = (ch & 15) * 8; f32x4 o0, o1;
#pragma unroll
        for (int m = 0; m < 4; ++m) { o0[m] = (float)v8[q][m]; o1[m] = (float)v8[q][4 + m]; }
        *(LAS f32x4*)(vs + j * 128 + e0) = o0; *(LAS f32x4*)(vs + j * 128 + e0 + 4) = o1; }
#pragma unroll
    for (int q = 0; q < 4; ++q) *(LAS f32x4*)(Ss + (tid + 512 * q) * 4) = sreg[q];
    __syncthreads();
    if (wid < 4) { const int i0 = (wid >> 1) * 32, j0 = (wid & 1) * 32; f32x16 acc;
#pragma unroll
        for (int i = 0; i < 16; ++i) acc[i] = 0.f;
#pragma unroll 8
        for (int s = 0; s < 32; ++s) acc = __builtin_amdgcn_mfma_f32_32x32x2f32(qs[(i0 + l31) * 65 + 2 * s + hf], kk[(j0 + l31) * 65 + 2 * s + hf], acc, 0, 0, 0);
#pragma unroll
        for (int r = 0; r < 16; ++r) { const int i = i0 + (r & 3) + 8 * (r >> 2) + 4 * hf, j = j0 + l31; As[i * 65 + j] = (j <= i) ? acc[r] : 0.f; } }
    __syncthreads();
    { const int i0 = (wid >> 2) * 32, e0 = (wid & 3) * 32; f32x16 acc;
#pragma unroll
      for (int i = 0; i < 16; ++i) acc[i] = 0.f;
#pragma unroll 8
      for (int s = 0; s < 32; ++s) acc = __builtin_amdgcn_mfma_f32_32x32x2f32(qs[(i0 + l31) * 65 + 2 * s + hf], Ss[(2 * s + hf) * 128 + e0 + l31], acc, 0, 0, 0);
#pragma unroll 8
      for (int s = 0; s < 32; ++s) acc = __builtin_amdgcn_mfma_f32_32x32x2f32(As[(i0 + l31) * 65 + 2 * s + hf], vs[(2 * s + hf) * 128 + e0 + l31], acc, 0, 0, 0);
#pragma unroll
      for (int r = 0; r < 16; ++r) { const int i = i0 + (r & 3) + 8 * (r >> 2) + 4 * hf; os[i * 129 + e0 + l31] = acc[r]; } }
    __syncthreads();
    { const int e0 = (tid & 7) * 16; float o[16], sq = 0.f;
#pragma unroll
      for (int j = 0; j < 16; ++j) { o[j] = os[ti * 129 + e0 + j]; sq += o[j] * o[j]; }
      sq += __shfl_xor(sq, 1); sq += __shfl_xor(sq, 2); sq += __shfl_xor(sq, 4);
      const float rs = rsqrtf(sq * (1.0f / 128.0f) + EPS);
      if (tt >= NMETA && tt < L) { half8 w0, w1;
#pragma unroll
          for (int j = 0; j < 8; ++j) { w0[j] = (f16)(o[j] * rs * P.hn[e0 + j] * silu_f((float)r8[0][j])); w1[j] = (f16)(o[8 + j] * rs * P.hn[e0 + 8 + j] * silu_f((float)r8[1][j])); }
          f16* dst = mix + (size_t)(tt - NMETA) * D + 128 * h + e0; *(half8*)dst = w0; *(half8*)(dst + 8) = w1; } }
    __syncthreads();
}

__device__ __forceinline__ unsigned mono_u(float f) { const unsigned u = __float_as_uint(f); return (u & 0x80000000u) ? ~u : (u | 0x80000000u); }
__device__ __forceinline__ float unmono_f(unsigned m) { return __uint_as_float((m & 0x80000000u) ? (m & 0x7fffffffu) : ~m); }
__device__ __forceinline__ unsigned wave_umax(unsigned v) {
    v = max(v, (unsigned)__builtin_amdgcn_update_dpp(0, (int)v, 0x111, 0xf, 0xf, false));
    v = max(v, (unsigned)__builtin_amdgcn_update_dpp(0, (int)v, 0x112, 0xf, 0xf, false));
    v = max(v, (unsigned)__builtin_amdgcn_update_dpp(0, (int)v, 0x114, 0xf, 0xf, false));
    v = max(v, (unsigned)__builtin_amdgcn_update_dpp(0, (int)v, 0x118, 0xf, 0xf, false));
    v = max(v, (unsigned)__builtin_amdgcn_update_dpp(0, (int)v, 0x142, 0xa, 0xf, false));
    v = max(v, (unsigned)__builtin_amdgcn_update_dpp(0, (int)v, 0x143, 0xc, 0xf, false));
    return (unsigned)__builtin_amdgcn_readlane((int)v, 63);
}
__device__ __forceinline__ int half_scan_incl(int v) {
    v += __builtin_amdgcn_update_dpp(0, v, 0x111, 0xf, 0xf, true);
    v += __builtin_amdgcn_update_dpp(0, v, 0x112, 0xf, 0xf, true);
    v += __builtin_amdgcn_update_dpp(0, v, 0x114, 0xf, 0xf, true);
    v += __builtin_amdgcn_update_dpp(0, v, 0x118, 0xf, 0xf, true);
    v += __builtin_amdgcn_update_dpp(0, v, 0x142, 0xa, 0xf, true);
    return v;
}
constexpr int CAP = 640, NPL = CAP / 64;
__device__ __forceinline__ int topk_compact(LAS float* cs, LAS unsigned short* ci, int n, bool exact, float& tau_out, int lane) {
    float sv[NPL]; unsigned iv[NPL], u[NPL];
#pragma unroll
    for (int i = 0; i < NPL; ++i) { const int p = lane + 64 * i; const bool v = p < n; sv[i] = v ? cs[p] : 0.f; iv[i] = v ? (unsigned)ci[p] : 0xffffu; u[i] = v ? mono_u(sv[i]) : 0u; }
    unsigned T = 0u; bool full = true; int hb = 31;
    {
        unsigned umx = 0u, umn = 0xffffffffu;
#pragma unroll
        for (int i = 0; i < NPL; ++i) { umx = max(umx, u[i]); umn = min(umn, (lane + 64 * i < n) ? u[i] : 0xffffffffu); }
        umx = wave_umax(umx); umn = ~wave_umax(~umn);
        const unsigned df = umx ^ umn;
        if (df == 0u) { hb = -1; T = umx; } else { hb = 31 - __clz(df); T = (hb == 31) ? 0u : (umx & ~((2u << hb) - 1u)); }
    }
#pragma unroll 1
    for (int bit = hb; bit >= 0; --bit) {
        const unsigned cand = T | (1u << bit); int cgt = 0;
#pragma unroll
        for (int i = 0; i < NPL; ++i) cgt += __popcll(__ballot(u[i] >= cand));
        if (cgt >= 256) { T = cand; if (!exact && cgt <= 272) { full = false; break; } }
    }
    bool keep[NPL];
    if (full) {
        int cgt = 0;
#pragma unroll
        for (int i = 0; i < NPL; ++i) cgt += __popcll(__ballot(u[i] > T));
        const int need = 256 - cgt; unsigned I = 0xffffu; int nties = 0;
#pragma unroll
        for (int i = 0; i < NPL; ++i) nties += __popcll(__ballot(u[i] == T));
        if (nties != need) { I = 0u;
#pragma unroll 1
        for (int bit = 15; bit >= 0; --bit) { const unsigned cand = I | (1u << bit); int cl = 0;
#pragma unroll
            for (int i = 0; i < NPL; ++i) cl += __popcll(__ballot(u[i] == T && iv[i] < cand));
            if (cl < need) I = cand; } }
#pragma unroll
        for (int i = 0; i < NPL; ++i) keep[i] = (u[i] > T) || (u[i] == T && iv[i] <= I);
    } else {
#pragma unroll
        for (int i = 0; i < NPL; ++i) keep[i] = u[i] >= T;
    }
    int nn = 0;
#pragma unroll
    for (int i = 0; i < NPL; ++i) { const unsigned long long m = __ballot(keep[i]); const int pre = __builtin_amdgcn_mbcnt_hi((unsigned)(m >> 32), __builtin_amdgcn_mbcnt_lo((unsigned)m, 0u));
        if (keep[i]) { cs[nn + pre] = sv[i]; ci[nn + pre] = (unsigned short)iv[i]; } nn += __popcll(m); }
    tau_out = unmono_f(T);
    return nn;
}
__device__ __forceinline__ float relu_asm(float x) { return __int_as_float(max(__float_as_int(x), 0)); }
__device__ __forceinline__ void indexer_tile(const Params& P, int tile, LAS unsigned char* lds) {
    int tid_ = threadIdx.x; asm volatile("" : "+v"(tid_));
    const int tid = tid_, lane = tid & 63, wid = __builtin_amdgcn_readfirstlane(tid >> 6), l31 = lane & 31, hf = lane >> 5;
    LAS float* candS = (LAS float*)lds;
    LAS unsigned short* candI = (LAS unsigned short*)(lds + 32 * CAP * 4);
    LAS unsigned char* kbuf = lds + 32 * CAP * 6;
    LAS int* lcnt = (LAS int*)(lds + LDS_BYTES - 1024 + 64);
    LAS int* lflag = (LAS int*)(lds + LDS_BYTES - 1024 + 192);
    const f16* IQ = (const f16*)(P.ws + WS_IQ); const f16* IK = (const f16*)(P.ws + WS_IK); const float* IW = (const float*)(P.ws + WS_IW);
    unsigned short* SEL = (unsigned short*)(P.ws + WS_SEL);
    const int t0 = tile * 32, tw = t0 + wid * 4;
    half8 afr[4];
    { const int qi = 2 * (l31 >> 4) + ((l31 >> 2) & 1), hd = 4 * ((l31 >> 3) & 1) + (l31 & 3); int tq = tw + qi; if (tq > L - 1) tq = L - 1;
      const half8* ap = (const half8*)(IQ + (size_t)tq * 512 + hd * 64);
#pragma unroll
      for (int s = 0; s < 4; ++s) afr[s] = ap[2 * s + hf]; }
    float w0[8], w1[8];
    { int ta = tw + hf, tb = tw + 2 + hf; if (ta > L - 1) ta = L - 1; if (tb > L - 1) tb = L - 1;
#pragma unroll
      for (int h = 0; h < 8; ++h) { w0[h] = IW[(size_t)ta * 8 + h]; w1[h] = IW[(size_t)tb * 8 + h]; } }
    asm volatile("" :: "v"(afr[0]), "v"(afr[1]), "v"(afr[2]), "v"(afr[3]));
    asm volatile("" :: "v"(w0[0]), "v"(w0[1]), "v"(w0[2]), "v"(w0[3]), "v"(w0[4]), "v"(w0[5]), "v"(w0[6]), "v"(w0[7]));
    asm volatile("" :: "v"(w1[0]), "v"(w1[1]), "v"(w1[2]), "v"(w1[3]), "v"(w1[4]), "v"(w1[5]), "v"(w1[6]), "v"(w1[7]));
    const int tq0 = (tw + hf < L) ? tw + hf : -1, tq1 = (tw + 2 + hf < L) ? tw + 2 + hf : -1;
    float tau0 = -__builtin_inff(), tau1 = -__builtin_inff();
    int cq0 = 0, cq1 = 0, cq2 = 0, cq3 = 0;
    if (tid < 3) lflag[tid] = 0;
    const int nkeys = (t0 + 32 < L) ? t0 + 32 : L, nst = (nkeys + 127) >> 7;
    u32x4 stg[2];
    const u32x4* IKv = (const u32x4*)IK;
#pragma unroll
    for (int i = 0; i < 2; ++i) stg[i] = IKv[(size_t)0 * 1024 + tid + 512 * i];
#pragma unroll
    for (int i = 0; i < 2; ++i) { const int ci = tid + 512 * i, row = ci >> 3, ch = ci & 7; *(LAS u32x4*)(kbuf + row * 128 + ((ch ^ ((row >> 1) & 7)) << 4)) = stg[i]; }
    __syncthreads();
#pragma unroll 1
    for (int st = 0; st < nst; ++st) {
        LAS unsigned char* kb = kbuf + (st & 1) * 16384;
        if (st + 1 < nst) {
#pragma unroll
            for (int i = 0; i < 2; ++i) stg[i] = IKv[(size_t)(st + 1) * 1024 + tid + 512 * i];
        }
        if (st * 128 <= tw + 3) {
            f32x16 acc[4];
#pragma unroll
            for (int c = 0; c < 4; ++c) {
#pragma unroll
                for (int i = 0; i < 16; ++i) acc[c][i] = 0.f;
            }
#pragma unroll
            for (int s = 0; s < 4; ++s) {
#pragma unroll
                for (int c = 0; c < 4; ++c) { const int row = c * 32 + l31; const half8 bf = *(const LAS half8*)(kb + row * 128 + (((2 * s + hf) ^ ((row >> 1) & 7)) << 4)); acc[c] = __builtin_amdgcn_mfma_f32_32x32x16_f16(afr[s], bf, acc[c], 0, 0, 0); }
            }
            float sc[8]; bool ok[8]; int na = 0, nb = 0;
#pragma unroll
            for (int c = 0; c < 4; ++c) {
                float s0 = 0.f, s1 = 0.f;
#pragma unroll
                for (int h = 0; h < 8; ++h) { s0 = __builtin_fmaf(w0[h], relu_asm(acc[c][h]), s0); s1 = __builtin_fmaf(w1[h], relu_asm(acc[c][8 + h]), s1); }
                const int key = st * 128 + c * 32 + l31;
                sc[2 * c] = s0; sc[2 * c + 1] = s1; ok[2 * c] = key <= tq0 && s0 > tau0; ok[2 * c + 1] = key <= tq1 && s1 > tau1;
                na += ok[2 * c] ? 1 : 0; nb += ok[2 * c + 1] ? 1 : 0;
            }
            const int ia = half_scan_incl(na), ib = half_scan_incl(nb);
            const int ta0 = __builtin_amdgcn_readlane(ia, 31), ta1 = __builtin_amdgcn_readlane(ia, 63), tb0 = __builtin_amdgcn_readlane(ib, 31), tb1 = __builtin_amdgcn_readlane(ib, 63);
            int pa = (hf ? cq1 : cq0) + ia - na, pb = (hf ? cq3 : cq2) + ib - nb;
            cq0 += ta0; cq1 += ta1; cq2 += tb0; cq3 += tb1;
            pa += (wid * 4 + hf) * CAP; pb += (wid * 4 + 2 + hf) * CAP;
            const int dmy = 32 * CAP * 6 / 4 + 2 * 16384 / 4 + 64 + lane;
#pragma unroll
            for (int c = 0; c < 4; ++c) {
                const unsigned short key = (unsigned short)(st * 128 + c * 32 + l31);
                { const bool k0 = ok[2 * c]; LAS float* ps = k0 ? candS + pa : candS + dmy; LAS unsigned short* pi = k0 ? candI + pa : (LAS unsigned short*)(candS + dmy + 64); *ps = sc[2 * c]; *pi = key; pa += k0 ? 1 : 0; }
                { const bool k1 = ok[2 * c + 1]; LAS float* ps = k1 ? candS + pb : candS + dmy; LAS unsigned short* pi = k1 ? candI + pb : (LAS unsigned short*)(candS + dmy + 64); *ps = sc[2 * c + 1]; *pi = key; pb += k1 ? 1 : 0; }
            }
        }
        if (st + 1 < nst) {
            LAS unsigned char* kn = kbuf + ((st + 1) & 1) * 16384;
#pragma unroll
            for (int i = 0; i < 2; ++i) { const int ci = tid + 512 * i, row = ci >> 3, ch = ci & 7; *(LAS u32x4*)(kn + row * 128 + ((ch ^ ((row >> 1) & 7)) << 4)) = stg[i]; }
        }
        const int mx = max(max(cq0, cq1), max(cq2, cq3));
        if (mx > CAP - 128 && lane == 0) lflag[st % 3] = 1;
        if (tid == 0) lflag[(st + 1) % 3] = 0;
        __syncthreads();
        const int any = lflag[st % 3];
        if (any) {
#pragma unroll 1
            for (int qq = 0; qq < 4; ++qq) { const int n = qq == 0 ? cq0 : (qq == 1 ? cq1 : (qq == 2 ? cq2 : cq3));
                if (n > 288) { float nt; const int nn = topk_compact(candS + (wid * 4 + qq) * CAP, candI + (wid * 4 + qq) * CAP, n, false, nt, lane);
                    if (qq == 0) cq0 = nn; else if (qq == 1) cq1 = nn; else if (qq == 2) cq2 = nn; else cq3 = nn;
                    if (hf == (qq & 1)) { if (qq < 2) tau0 = nt; else tau1 = nt; } } }
        }
    }
#pragma unroll 1
    for (int qq = 0; qq < 4; ++qq) {
        const int t = tw + qq; if (t >= L) break;
        int n = qq == 0 ? cq0 : (qq == 1 ? cq1 : (qq == 2 ? cq2 : cq3)); LAS float* cs = candS + (wid * 4 + qq) * CAP; LAS unsigned short* ci = candI + (wid * 4 + qq) * CAP;
        if (n > 256) { float nt; n = topk_compact(cs, ci, n, true, nt, lane); }
#pragma unroll
        for (int j = 0; j < 4; ++j) { const int p = lane + 64 * j; SEL[(size_t)t * 256 + (p & 15) * 16 + (p >> 4)] = p < n ? ci[p] : (unsigned short)0xffffu; }
    }
    __syncthreads();
}

__device__ __forceinline__ void sparse_attn(const Params& P, LAS unsigned char* lds, int vbid) {
    int tid_ = threadIdx.x; asm volatile("" : "+v"(tid_));
    const int tid = tid_, lane = tid & 63, wid = tid >> 6, grp = lane >> 2, c4 = lane & 3;
    const int head = vbid & 7, slot = (vbid >> 3) * 8 + wid, nslot = (gridDim.x >> 3) * 8;
    typedef _Float16 half2v __attribute__((ext_vector_type(2)));
    LAS float* red = (LAS float*)(lds + 4096 + wid * 4352);
    const unsigned short* SEL = (const unsigned short*)(P.ws + WS_SEL);
    const unsigned char* Q8 = P.ws + WS_DQ + head * 64 + c4 * 16; const float* QS = (const float*)(P.ws + WS_DQ + (size_t)LP * 512) + head;
    const unsigned char* kvh = P.ws + WS_KV + (size_t)head * LP * 128; f16* mix = (f16*)(P.ws + WS_ACTA);
    int t = NMETA + slot;
    u32x4 sela = {0u, 0u, 0u, 0u}, selb = {0u, 0u, 0u, 0u}, q8 = {0u, 0u, 0u, 0u}; float lscale = 0.f;
    if (t < L) { sela = *(const u32x4*)(SEL + (size_t)t * 256 + grp * 16); selb = *(const u32x4*)(SEL + (size_t)t * 256 + grp * 16 + 8); q8 = *(const u32x4*)(Q8 + (size_t)t * 512); lscale = QS[(size_t)t * 8]; }
#define ATTN_ITEM(ALLV) do { \
        unsigned keys[16]; u32x4 kreg[16], vreg[16]; \
        _Pragma("unroll") for (int it = 0; it < 16; ++it) { const unsigned w = it < 8 ? sela[it >> 1] : selb[(it - 8) >> 1]; keys[it] = (it & 1) ? (w >> 16) : (w & 0xffffu); } \
        _Pragma("unroll") for (int it = 0; it < 16; ++it) { const unsigned kk = (ALLV || keys[it] != 0xffffu) ? keys[it] : 0u; kreg[it] = *(const u32x4*)(kvh + (size_t)kk * 128 + c4 * 16); } \
        _Pragma("unroll") for (int it = 0; it < 16; ++it) { const unsigned kk = (ALLV || keys[it] != 0xffffu) ? keys[it] : 0u; vreg[it] = *(const u32x4*)(kvh + (size_t)kk * 128 + 64 + c4 * 16); } \
        const u32x4 qc = q8; const float ls = lscale; \
        { const int tn = t + nslot;     \
          if (tn < L) { sela = *(const u32x4*)(SEL + (size_t)tn * 256 + grp * 16); selb = *(const u32x4*)(SEL + (size_t)tn * 256 + grp * 16 + 8); q8 = *(const u32x4*)(Q8 + (size_t)tn * 512); lscale = QS[(size_t)tn * 8]; } } \
        float lg[16]; float mx = -__builtin_inff(); \
        _Pragma("unroll") for (int it = 0; it < 16; ++it) { \
            int ai = 0; \
            _Pragma("unroll") for (int w = 0; w < 4; ++w) ai = __builtin_amdgcn_sdot4((int)kreg[it][w], (int)qc[w], ai, false); \
            ai += __builtin_amdgcn_update_dpp(0, ai, 0xB1, 0xf, 0xf, true);     \
            ai += __builtin_amdgcn_update_dpp(0, ai, 0x4E, 0xf, 0xf, true);     \
            lg[it] = (ALLV || keys[it] != 0xffffu) ? (float)ai * ls : -__builtin_inff(); mx = fmaxf(mx, lg[it]); } \
        mx = fmaxf(mx, __shfl_xor(mx, 4)); mx = fmaxf(mx, __shfl_xor(mx, 8)); mx = fmaxf(mx, __shfl_xor(mx, 16)); mx = fmaxf(mx, __shfl_xor(mx, 32)); \
        half2v o2[8]; float lsum = 0.f; \
        _Pragma("unroll") for (int e = 0; e < 8; ++e) o2[e] = (half2v){(f16)0.f, (f16)0.f}; \
        _Pragma("unroll") for (int it = 0; it < 16; ++it) { \
            const float p = __expf(lg[it] - mx); lsum += p; const f16 ph = (f16)p; const half2v p2 = {ph, ph}; \
            _Pragma("unroll") for (int w = 0; w < 4; ++w) {     \
                const half2v v01 = __builtin_bit_cast(half2v, __builtin_amdgcn_perm(0u, vreg[it][w], 0x010c000cu)), v23 = __builtin_bit_cast(half2v, __builtin_amdgcn_perm(0u, vreg[it][w], 0x030c020cu)); \
                o2[2 * w] = p2 * v01 + o2[2 * w]; o2[2 * w + 1] = p2 * v23 + o2[2 * w + 1]; } } \
        lsum += __shfl_xor(lsum, 4); lsum += __shfl_xor(lsum, 8); lsum += __shfl_xor(lsum, 16); lsum += __shfl_xor(lsum, 32); \
          \
        _Pragma("unroll") for (int e = 0; e < 8; ++e) { red[lane * 17 + 2 * e] = (float)o2[e][0]; red[lane * 17 + 2 * e + 1] = (float)o2[e][1]; } \
        float acc = 0.f; \
        { const int cc = lane >> 4, e = lane & 15; \
          _Pragma("unroll") for (int g = 0; g < 16; ++g) acc += red[(g * 4 + cc) * 17 + e]; } \
        mix[(size_t)(t - NMETA) * D + 512 + head * 64 + lane] = (f16)(acc * __builtin_amdgcn_rcpf(lsum)); \
    } while (0)
#pragma unroll 1
    for (; t < L; t += nslot) {
        if (t >= 255) ATTN_ITEM(true);
        else ATTN_ITEM(false);
    }
#undef ATTN_ITEM
    __syncthreads();
}

__device__ __forceinline__ void final_norm(const Params& P) {
    const int tid = threadIdx.x, lane = tid & 63, gw = blockIdx.x * 8 + (tid >> 6), nw = gridDim.x * 8;
    const float* ss3 = (const float*)(P.ws + WS_SS3); const f16* h3 = (const f16*)(P.ws + WS_ACTA);
    for (int r = gw; r < SEQ; r += nw) { const float rs = row_rstd(ss3, 16, r);
#pragma unroll
        for (int i = 0; i < 2; ++i) { const int k = lane * 8 + 512 * i; const half8 v = *(const half8*)(h3 + (size_t)r * D + k); const f32x4 g0 = *(const f32x4*)(P.nf + k), g1 = *(const f32x4*)(P.nf + k + 4); f32x4 o0, o1;
#pragma unroll
            for (int j = 0; j < 4; ++j) { o0[j] = (float)v[j] * rs * g0[j]; o1[j] = (float)v[4 + j] * rs * g1[j]; }
            *(f32x4*)(P.out + (size_t)r * D + k) = o0; *(f32x4*)(P.out + (size_t)r * D + k + 4) = o1; } }
}

#define XB_TMO      128
#define XB_XCNT(j)  (256  + 64 * (j))
#define XB_XSUB(j)  (1280 + 64 * (j))
#define XB_XGEN(j)  (2304 + 64 * (j))
#define XB_TOP      3328
#define XB_TOPGEN   3392
#define XCD_BAR_WORDS 3456
#define XB_SPIN_CAP (1u << 22)
__device__ __forceinline__ unsigned xb_ld(unsigned* p)              { return __hip_atomic_load(p, __ATOMIC_RELAXED, __HIP_MEMORY_SCOPE_AGENT); }
__device__ __forceinline__ unsigned xb_add(unsigned* p, unsigned v) { return __hip_atomic_fetch_add(p, v, __ATOMIC_RELAXED, __HIP_MEMORY_SCOPE_AGENT); }
__device__ __forceinline__ unsigned xb_xcc_id() { return (unsigned)__builtin_amdgcn_s_getreg((3 << 11) | 20) & 0xFu; }
#define XB_SPIN(cond, bar) do { unsigned _sp = 0; while (cond) { __builtin_amdgcn_s_sleep(1); \
    if ((++_sp & 255u) == 0u) { if (xb_ld(&(bar)[XB_TMO])) break; if (_sp > XB_SPIN_CAP) { atomicAdd(&(bar)[XB_TMO], 1u); break; } } } } while (0)
struct XcdBarrier { unsigned* bar; unsigned x; volatile LAS unsigned* st; };
__device__ __forceinline__ XcdBarrier xcd_barrier_post(unsigned* bar, volatile LAS unsigned* st) {
    XcdBarrier b; b.bar = bar; b.x = xb_xcc_id(); b.st = st;
    if (threadIdx.x == 0) (void)xb_add(&bar[XB_XCNT(b.x)], 1u);
    return b;
}
__device__ __forceinline__ void xcd_barrier_complete(unsigned* bar, unsigned x, unsigned& nloc, unsigned& nx) {
    const unsigned G = gridDim.x * gridDim.y * gridDim.z;
    unsigned sum, cnt, mine, sp = 0u;
    for (;;) {
        sum = 0u; cnt = 0u; mine = 0u;
#pragma unroll
        for (unsigned j = 0; j < 16; ++j) { const unsigned c = xb_ld(&bar[XB_XCNT(j)]); sum += c; cnt += (c > 0u) ? 1u : 0u; mine = (j == x) ? c : mine; }
        if (sum == G) break;
        __builtin_amdgcn_s_sleep(1);
        if ((++sp & 255u) == 0u) { if (xb_ld(&bar[XB_TMO])) break; if (sp > XB_SPIN_CAP) { atomicAdd(&bar[XB_TMO], 1u); break; } }
    }
    nloc = mine > 0u ? mine : 1u; nx = cnt > 0u ? cnt : 1u;
}
__device__ __forceinline__ void xcd_barrier(const XcdBarrier& b) {
    asm volatile("s_waitcnt vmcnt(0)" ::: "memory");
    __syncthreads();
    if (threadIdx.x == 0) {
        unsigned* bar = b.bar;
        __builtin_amdgcn_s_waitcnt(0);
        unsigned nloc = b.st[0], nx = b.st[1];
        if (nloc == 0u) { xcd_barrier_complete(bar, b.x, nloc, nx); b.st[0] = nloc; b.st[1] = nx; }
        const unsigned old = xb_add(&bar[XB_XSUB(b.x)], 1u);
        const unsigned gen = old / nloc;
        if (old + 1u == (gen + 1u) * nloc) {
            __builtin_amdgcn_fence(__ATOMIC_RELEASE, "agent");
            asm volatile("s_waitcnt vmcnt(0)" ::: "memory");
            const unsigned og = xb_add(&bar[XB_TOP], 1u);
            const unsigned tg = og / nx;
            if (og + 1u == (tg + 1u) * nx) xb_add(&bar[XB_TOPGEN], 1u);
            else XB_SPIN(xb_ld(&bar[XB_TOPGEN]) == tg, bar);
            __builtin_amdgcn_fence(__ATOMIC_ACQUIRE, "agent");
            xb_add(&bar[XB_XGEN(b.x)], 1u);
            asm volatile("s_waitcnt vmcnt(0)" ::: "memory");
        } else {
            XB_SPIN(xb_ld(&bar[XB_XGEN(b.x)]) == gen, bar);
            __builtin_amdgcn_fence(__ATOMIC_ACQUIRE, "agent");
            asm volatile("s_waitcnt vmcnt(0)" ::: "memory");
        }
    }
    __syncthreads();
}

__global__ void __launch_bounds__(NTHREADS, 2) fwd_kernel(Params P) {
    __shared__ __attribute__((aligned(16))) unsigned char lds_raw[LDS_BYTES];
    LAS unsigned char* lds = (LAS unsigned char*)lds_raw;
    const int tid = threadIdx.x, bid = blockIdx.x, G = gridDim.x;
    unsigned char* ws = P.ws;
    const int lo = P.ph_lo, hi = P.ph_hi;
#ifndef ONLY_PHASE
#define ONLY_PHASE -1
#endif
#define IN(k) ((ONLY_PHASE < 0 || ONLY_PHASE == (k)) && lo <= (k) && (k) < hi)
#define SEAM(k) do { if (IN(k) && IN((k) + 1)) { xcd_barrier(xbar); } } while (0)
    XcdBarrier xbar; xbar.bar = (unsigned*)(ws + WS_BAR); xbar.x = 0; xbar.st = (volatile LAS unsigned*)(lds + LDS_BYTES - 1024 + 16);
    if (hi - lo > 1) {
        if (tid == 0) { xbar.st[0] = 0u; xbar.st[1] = 0u; }
        __syncthreads();
        xbar = xcd_barrier_post((unsigned*)(ws + WS_BAR), (volatile LAS unsigned*)(lds + LDS_BYTES - 1024 + 16));
    }
    LAS int* misc = (LAS int*)(lds + LDS_BYTES - 1024);
    if (hi - lo > 1) {
        if (tid == 0) { const unsigned xcc = xb_xcc_id() & 7u; misc[8] = (int)xcc; misc[9] = (int)xb_add((unsigned*)(ws + WS_CTL) + 32 + 32 * xcc, 1u); }
    }
    int vbid = bid;
    f16* acta = (f16*)(ws + WS_ACTA); f16* Gb = (f16*)(ws + WS_G);
    float* ss0 = (float*)(ws + WS_SS0); float* ss1 = (float*)(ws + WS_SS1); float* ss2 = (float*)(ws + WS_SS2); float* ss3 = (float*)(ws + WS_SS3);
    if (IN(0)) { p0_prologue(P, lds); }
    SEAM(0);
    if (hi - lo > 1 && (G & 7) == 0) {
        if (tid == 0) { bool ok = true; for (int j = 0; j < 8; ++j) ok = ok && (xb_ld((unsigned*)(ws + WS_CTL) + 32 + 32 * j) == (unsigned)(G >> 3)); misc[10] = ok ? misc[9] * 8 + misc[8] : bid; }
        __syncthreads();
        vbid = __builtin_amdgcn_readfirstlane(misc[10]);
        __syncthreads();
    }
    if (IN(1)) {
        pg8::Gemm g{acta, (const f16*)(ws + WS_WGU1), MP, 2 * DFF, D}; pg8::StaticOrder S; S.init(MP, 2 * DFF, G, vbid);
        EpiSwiglu E{Gb, ss0, 1}; pg8::gemm_phase(lds, g, S, E);
    }
    SEAM(1);
    if (IN(2)) {
        meta_down(P, lds);
        pg8::Gemm g{Gb, (const f16*)(ws + WS_WD1), SEQ, D, DFF}; pg8::StaticOrder S; S.init(SEQ, D, G, vbid);
        EpiResid<true> E{acta, (f16*)P.out, ss1, 0.5f}; pg8::gemm_phase(lds, g, S, E);
    }
    SEAM(2);
    if (IN(3)) {
        pg8::Gemm g{(const f16*)P.out, (const f16*)(ws + WS_WIN), MP, NIN, D}; pg8::StaticOrder S; S.init(MP, NIN, G, vbid);
        EpiInProj E{ss1, (const f32x2*)(ws + WS_ROPE), ws};
        pg8::gemm_phase(lds, g, S, E);
    }
    SEAM(3);
    if (IN(4)) {
        for (int u = bid; u < NCH * 4; u += G) gla_a_unit(P, u, lds);
        {
            int tbase = 0, cursor = bid; LAS f16* tl = (LAS f16*)lds;
            prep_weight(P, 3, D, D, (f16*)(ws + WS_WOUT), cursor, tbase, tl);
            prep_weight(P, 4, 2 * DFF, D, (f16*)(ws + WS_WGU2), cursor, tbase, tl);
            prep_weight(P, 5, D, DFF, (f16*)(ws + WS_WD2), cursor, tbase, tl);
        }
    }
    SEAM(4);
    if (IN(5)) {
        if (bid < 64) gla_scan(P);
        unsigned* ctr = (unsigned*)(ws + WS_CTL); LAS int* bc = (LAS int*)(lds + LDS_BYTES - 1024);
        for (;;) {
            if (tid == 0) bc[0] = (int)atomicAdd(ctr, 1u);
            __syncthreads();
            const int k = bc[0];
            __syncthreads();
            if (k >= 513) break;
            indexer_tile(P, 512 - k, lds);
        }
    }
    SEAM(5);
    if (IN(6)) { for (int u = bid; u < NCH * 4; u += G) gla_c_unit(P, u, lds); sparse_attn(P, lds, vbid); }
    SEAM(6);
    if (IN(7)) {
        pg8::Gemm g{acta, (const f16*)(ws + WS_WOUT), SEQ, D, D}; pg8::StaticOrder S; S.init(SEQ, D, G, vbid);
        EpiResid<true> E{P.out, (f16*)(ws + WS_US), ss2, 1.0f}; pg8::gemm_phase(lds, g, S, E);
    }
    SEAM(7);
    if (IN(8)) {
        pg8::Gemm g{(const f16*)(ws + WS_US), (const f16*)(ws + WS_WGU2), SEQ, 2 * DFF, D}; pg8::StaticOrder S; S.init(SEQ, 2 * DFF, G, vbid);
        EpiSwiglu E{Gb, ss2, 16}; pg8::gemm_phase(lds, g, S, E);
    }
    SEAM(8);
    if (IN(9)) {
        pg8::Gemm g{Gb, (const f16*)(ws + WS_WD2), SEQ, D, DFF}; pg8::StaticOrder S; S.init(SEQ, D, G, vbid);
        EpiResid<true> E{ws + WS_US, acta, ss3, 0.5f}; pg8::gemm_phase(lds, g, S, E);
    }
    SEAM(9);
    if (IN(10)) final_norm(P);
#undef IN
#undef SEAM
}

extern "C" void kernel_launch(void* const* d_in, const int* in_sizes, int n_in, void* d_out, int out_size, void* d_ws, size_t ws_size, hipStream_t stream) {
    static int grid = 0;
    if (grid == 0) {
        if (n_in != 17 || in_sizes[0] != SEQ * D || out_size != SEQ * D || ws_size < WS_END) { fprintf(stderr, "kernel_launch: unexpected shapes (n_in %d, in0 %d, out %d, ws %zu, need %zu)\n", n_in, n_in > 0 ? in_sizes[0] : -1, out_size, ws_size, (size_t)WS_END); grid = -1; return; }
        int dev = 0, cus = 0, per_cu = 0;
        (void)hipGetDevice(&dev); (void)hipDeviceGetAttribute(&cus, hipDeviceAttributeMultiprocessorCount, dev);
        if (hipOccupancyMaxActiveBlocksPerMultiprocessor(&per_cu, (const void*)fwd_kernel, NTHREADS, 0) != hipSuccess || per_cu < 1) { fprintf(stderr, "kernel_launch: occupancy query says %d blocks per CU\n", per_cu); per_cu = 1; }
        (void)hipGetLastError();
        grid = cus;
        if (grid % 8 != 0 || grid < 64) { fprintf(stderr, "kernel_launch: unexpected CU count %d\n", cus); }
    }
    if (grid < 0) return;
    if (hipMemsetAsync((char*)d_ws + WS_CTL, 0, CTL_BYTES, stream) != hipSuccess) { fprintf(stderr, "kernel_launch: memset failed\n"); return; }
    Params p{};
    const float** pp = (const float**)&p;
    for (int i = 0; i < 17; ++i) pp[i] = (const float*)d_in[i];
    p.out = (float*)d_out; p.ws = (unsigned char*)d_ws;
#if MODE == 0
    for (int ph = 0; ph < NPHASE; ++ph) { p.ph_lo = ph; p.ph_hi = ph + 1; hipLaunchKernelGGL(fwd_kernel, dim3(grid), dim3(NTHREADS), 0, stream, p); }
#else
    p.ph_lo = 0; p.ph_hi = NPHASE;
    void* args[] = {&p};
    hipError_t e = hipLaunchCooperativeKernel((const void*)fwd_kernel, dim3(grid), dim3(NTHREADS), args, 0, stream);
    if (e != hipSuccess) fprintf(stderr, "cooperative launch failed: %s (grid %d)\n", hipGetErrorString(e), grid);
#endif
}
```

```cpp
#include <hip/hip_runtime.h>
#include <cstdio>
#include <cstdint>

#ifndef MODE
#define MODE 1
#endif

#define LAS __attribute__((address_space(3)))
typedef _Float16 f16;
typedef _Float16 half8 __attribute__((ext_vector_type(8)));
typedef _Float16 half4 __attribute__((ext_vector_type(4)));
typedef float f32x2 __attribute__((ext_vector_type(2)));
typedef float f32x4 __attribute__((ext_vector_type(4)));
typedef float f32x16 __attribute__((ext_vector_type(16)));
typedef unsigned u32x2 __attribute__((ext_vector_type(2)));
typedef unsigned u32x4 __attribute__((ext_vector_type(4)));

constexpr int D = 1024, SEQ = 16384, NMETA = 16, L = SEQ + NMETA, DFF = 2816;
constexpr int MP = 16640;
constexpr int LP = 16512;
constexpr int NIN = 3840;
constexpr int NCH = 257;
constexpr float EPS = 1e-6f;
constexpr int NTHREADS = 512;
constexpr int LDS_BYTES = 155648 + 1024;
constexpr int NPHASE = 11;

constexpr size_t al256(size_t x) { return (x + 255) & ~(size_t)255; }
constexpr size_t WS_CTL = 0;
constexpr size_t CTL_BYTES = 32768;
constexpr size_t WS_BAR = 2048;
constexpr size_t WS_WGU1 = CTL_BYTES;
constexpr size_t WS_WD1 = WS_WGU1 + (size_t)2 * DFF * D * 2;
constexpr size_t WS_WIN = WS_WD1 + (size_t)D * DFF * 2;
constexpr size_t WS_WOUT = WS_WIN + (size_t)NIN * D * 2;
constexpr size_t WS_WGU2 = WS_WOUT + (size_t)D * D * 2;
constexpr size_t WS_WD2 = WS_WGU2 + (size_t)2 * DFF * D * 2;
constexpr size_t WS_ACTA = WS_WD2 + (size_t)D * DFF * 2;
constexpr size_t WS_G = WS_ACTA + (size_t)MP * D * 2;
constexpr size_t WS_US = WS_G + (size_t)MP * DFF * 2;
constexpr size_t WS_DQ = WS_US + (size_t)NCH * 4 * 64 * 128 * 4;
constexpr size_t WS_IQ = WS_DQ + (size_t)LP * 512 * 2;
constexpr size_t WS_SEL = WS_IQ + (size_t)LP * 512 * 2;
constexpr size_t WS_ROPE = WS_SEL + (size_t)LP * 256 * 2;
constexpr size_t WS_IW = WS_ROPE + al256((size_t)L * 32 * 8);
constexpr size_t WS_GA = WS_IW + (size_t)LP * 8 * 4;
constexpr size_t WS_DECAY = WS_GA + (size_t)LP * 16 * 4;
constexpr size_t WS_SS0 = WS_DECAY + al256((size_t)NCH * 256 * 4);
constexpr size_t WS_SS1 = WS_SS0 + (size_t)MP * 4;
constexpr size_t WS_SS2 = WS_SS1 + (size_t)MP * 64;
constexpr size_t WS_SS3 = WS_SS2 + (size_t)MP * 64;
constexpr size_t WS_END = WS_SS3 + (size_t)MP * 64;
constexpr size_t WS_KV = WS_G;
constexpr size_t WS_GQ = WS_KV + (size_t)8 * LP * 128 * 2;
constexpr size_t WS_GK = WS_GQ + (size_t)LP * 256 * 2;
constexpr size_t WS_GV = WS_GK + (size_t)LP * 256 * 2;
constexpr size_t WS_GR = WS_GV + (size_t)LP * 512 * 2;
constexpr size_t WS_IK = WS_GR + (size_t)LP * 512 * 2;
constexpr size_t WS_ALIAS_END = WS_IK + (size_t)LP * 64 * 2;
static_assert(WS_ALIAS_END <= WS_US, "aliased buffers exceed G");
static_assert(WS_END <= (size_t)256 * 1024 * 1024, "workspace exceeds 256 MiB");
static_assert((size_t)SEQ * D * 2 <= (size_t)NCH * 4 * 64 * 128 * 4, "h2_16 alias");

struct Params {
    const float* x; const float* meta; const float* n1; const float* wg1; const float* wu1; const float* wd1;
    const float* nmix; const float* win; const float* wa2; const float* ba; const float* hn; const float* wout;
    const float* n2; const float* wg2; const float* wu2; const float* wd2; const float* nf;
    float* out; unsigned char* ws; int ph_lo, ph_hi;
};

namespace pg8 {
constexpr int BM = 256, BK = 64, HALF = 128, HTB = HALF * BK * 2, STAGE_BYTES = 8 * HTB, NXCD = 8, WGM = 8;
__host__ __device__ __forceinline__ int lds_byte(int r, int c) { const int st = (r >> 4) * 2 + (c >> 5), rr = r & 15, cc = c & 31, ob = rr * 64 + cc * 2; return st * 1024 + (ob ^ (((ob >> 9) & 1) << 5)); }
__host__ __device__ __forceinline__ int perm32(int rho) { const int n = rho >> 4, i = rho & 15; return 8 * (i >> 2) + 4 * n + (i & 3); }
__host__ __device__ __forceinline__ void stage_rc(int b, int& R, int& C) { const int st = b / 1024, sb = b % 1024, swz = sb ^ (((sb >> 9) & 1) << 5); R = (st >> 1) * 16 + swz / 64; C = (st & 1) * 32 + (swz % 64) / 2; }
struct Unit { int pm, pn; };
struct Gemm { const f16* A; const f16* Bt; int M, N, K; };
struct StaticOrder {
    int nM, nN, nwg, G, c;
    __host__ __device__ void init(int M, int N, int G_, int c_) { nM = M / BM; nN = N / BM; nwg = nM * nN; G = G_; c = c_; }
    __host__ __device__ bool next(int i, Unit& u) const {
        const long Lx = (long)i * G + c; if (Lx >= nwg) return false;
        int wgid = (int)Lx; { const int q = nwg / NXCD, r = nwg % NXCD, xcd = wgid % NXCD, off = wgid / NXCD; wgid = (xcd < r ? xcd * (q + 1) : r * (q + 1) + (xcd - r) * q) + off; }
        const int nig = WGM * nN, gid = wgid / nig, fm = gid * WGM, gsz = (nM - fm) < WGM ? (nM - fm) : WGM;
        u.pm = fm + ((wgid % nig) % gsz); u.pn = (wgid % nig) / gsz; return true;
    }
};
template <class Epi>
__device__ __forceinline__ void gemm_phase(LAS unsigned char* lds, const Gemm g, const StaticOrder& S, const Epi& E) {
    int tid_ = threadIdx.x; asm volatile("" : "+v"(tid_));
    const int tid = tid_, wid = __builtin_amdgcn_readfirstlane(tid >> 6), lane = tid & 63, wr = wid >> 2, wc = wid & 3, fr = lane & 15, fq = lane >> 4;
    const int K = g.K, nt = K / BK;
    unsigned voffA[2], voffB[2];
#pragma unroll
    for (int i = 0; i < 2; ++i) { int R, C; stage_rc(tid * 16 + i * 8192, R, C); const int Rb = (R & ~31) + perm32(R & 31); voffA[i] = (unsigned)(R * K + C) * 2u; voffB[i] = (unsigned)(Rb * K + C) * 2u; }
    const size_t kstep = (size_t)(BK * 2);
    const size_t hstep = (size_t)HALF * K * 2;
    const size_t tstep = 2 * hstep;
    const unsigned ldsw = (unsigned)wid * 1024u;
    const int aoff = lds_byte(wr * 64 + fr, fq * 8), boff = lds_byte(wc * 32 + fr, fq * 8);
#define PG8_SA(b, h) (((b) * 2 + (h)) * HTB)
#define PG8_SB(b, h) ((4 + (b) * 2 + (h)) * HTB)
#define PG8_STAGE(bufoff, gbase, voff) do { _Pragma("unroll") for (int _i = 0; _i < 2; ++_i) \
        __builtin_amdgcn_global_load_lds((const unsigned*)((const char*)(gbase) + (voff)[_i]), (LAS unsigned*)(lds + (bufoff) + ldsw + _i * 8192), 16, 0, 0); } while (0)
#define PG8_LDA(dst, b, h) do { _Pragma("unroll") for (int m = 0; m < 4; ++m) _Pragma("unroll") for (int k = 0; k < 2; ++k) dst[m][k] = *(const LAS half8*)(lds + PG8_SA(b, h) + aoff + m * 2048 + k * 1024); } while (0)
#define PG8_LDB(dst, b, h) do { _Pragma("unroll") for (int n = 0; n < 2; ++n) _Pragma("unroll") for (int k = 0; k < 2; ++k) dst[n][k] = *(const LAS half8*)(lds + PG8_SB(b, h) + boff + n * 2048 + k * 1024); } while (0)
#define PG8_MMA(ai, bj, At, Bt) do { __builtin_amdgcn_s_setprio(1); _Pragma("unroll") for (int m = 0; m < 4; ++m) _Pragma("unroll") for (int n = 0; n < 2; ++n) _Pragma("unroll") for (int k = 0; k < 2; ++k) \
        acc[ai][bj][m][n] = __builtin_amdgcn_mfma_f32_16x16x32_f16(Bt[n][k], At[m][k], acc[ai][bj][m][n], 0, 0, 0); __builtin_amdgcn_s_setprio(0); } while (0)
#define PG8_WAIT_V(n) asm volatile("s_waitcnt vmcnt(" #n ")" ::: "memory")
#define PG8_WAIT_L(n) asm volatile("s_waitcnt lgkmcnt(" #n ")" ::: "memory")
#define PG8_BAR __builtin_amdgcn_s_barrier()
#define PG8_SCHED __builtin_amdgcn_sched_barrier(0)
    Unit cur, nxt; int ui = 0;
    if (!S.next(0, cur)) return;
    f32x4 acc[2][2][4][2];
#pragma unroll
    for (int a = 0; a < 2; ++a)
#pragma unroll
        for (int b = 0; b < 2; ++b)
#pragma unroll
            for (int m = 0; m < 4; ++m)
#pragma unroll
                for (int n = 0; n < 2; ++n) acc[a][b][m][n] = (f32x4){0.f, 0.f, 0.f, 0.f};
    half8 At[4][2], B0[2][2], B1[2][2];
    const char* cA = (const char*)g.A + (size_t)cur.pm * tstep; const char* cB = (const char*)g.Bt + (size_t)cur.pn * tstep;
    PG8_STAGE(PG8_SB(0, 0), cB, voffB); PG8_STAGE(PG8_SA(0, 0), cA, voffA); PG8_STAGE(PG8_SB(0, 1), cB + hstep, voffB); PG8_STAGE(PG8_SA(0, 1), cA + hstep, voffA);
    if (wr == 1) PG8_BAR;
    PG8_WAIT_V(4); PG8_BAR;
    PG8_STAGE(PG8_SB(1, 0), cB + kstep, voffB); PG8_STAGE(PG8_SA(1, 0), cA + kstep, voffA); PG8_STAGE(PG8_SB(1, 1), cB + hstep + kstep, voffB);
    PG8_WAIT_V(6); PG8_BAR;
    for (;;) {
        const bool has_next = S.next(ui + 1, nxt);
        const char* nA = has_next ? (const char*)g.A + (size_t)nxt.pm * tstep : cA; const char* nB = has_next ? (const char*)g.Bt + (size_t)nxt.pn * tstep : cB;
        for (int t = 0; t < nt; t += 2) {
            const bool last = (t == nt - 2);
            const char* a1 = cA + (size_t)(t + 1) * kstep;
            const char* a2 = last ? nA : cA + (size_t)(t + 2) * kstep; const char* b2 = last ? nB : cB + (size_t)(t + 2) * kstep;
            const char* a3 = a2 + kstep; const char* b3 = b2 + kstep;
            PG8_LDB(B0, 0, 0); PG8_SCHED; PG8_LDA(At, 0, 0); PG8_STAGE(PG8_SA(1, 1), a1 + hstep, voffA);
            PG8_WAIT_L(8); PG8_BAR; PG8_WAIT_L(0); PG8_MMA(0, 0, At, B0); PG8_BAR; PG8_SCHED;
            PG8_LDB(B1, 0, 1); PG8_STAGE(PG8_SB(0, 0), b2, voffB);
            PG8_BAR; PG8_WAIT_L(0); PG8_MMA(0, 1, At, B1); PG8_BAR;
            PG8_LDA(At, 0, 1); PG8_STAGE(PG8_SA(0, 0), a2, voffA);
            PG8_BAR; PG8_WAIT_L(0); PG8_MMA(1, 0, At, B0); PG8_BAR; PG8_SCHED;
            PG8_STAGE(PG8_SB(0, 1), b2 + hstep, voffB);
            PG8_WAIT_V(6); PG8_BAR; PG8_MMA(1, 1, At, B1); PG8_BAR;
            PG8_LDB(B0, 1, 0); PG8_SCHED; PG8_LDA(At, 1, 0); PG8_STAGE(PG8_SA(0, 1), a2 + hstep, voffA);
            PG8_WAIT_L(8); PG8_BAR; PG8_WAIT_L(0); PG8_MMA(0, 0, At, B0); PG8_BAR; PG8_SCHED;
            PG8_LDB(B1, 1, 1); PG8_STAGE(PG8_SB(1, 0), b3, voffB);
            PG8_BAR; PG8_WAIT_L(0); PG8_MMA(0, 1, At, B1); PG8_BAR;
            PG8_LDA(At, 1, 1); PG8_STAGE(PG8_SA(1, 0), a3, voffA);
            PG8_BAR; PG8_WAIT_L(0); PG8_MMA(1, 0, At, B0); PG8_BAR; PG8_SCHED;
            PG8_STAGE(PG8_SB(1, 1), b3 + hstep, voffB);
            PG8_WAIT_V(6); PG8_BAR; PG8_MMA(1, 1, At, B1); PG8_BAR;
        }
        E(acc, cur, wr, wc, fr, fq);
        if (!has_next) break;
#pragma unroll
        for (int a = 0; a < 2; ++a)
#pragma unroll
            for (int b = 0; b < 2; ++b)
#pragma unroll
                for (int m = 0; m < 4; ++m)
#pragma unroll
                    for (int n = 0; n < 2; ++n) acc[a][b][m][n] = (f32x4){0.f, 0.f, 0.f, 0.f};
        cur = nxt; cA = nA; cB = nB; ++ui;
    }
    PG8_WAIT_V(0);
    if (wr == 0) PG8_BAR;
    PG8_BAR;
#undef PG8_SA
#undef PG8_SB
#undef PG8_STAGE
#undef PG8_LDA
#undef PG8_LDB
#undef PG8_MMA
#undef PG8_WAIT_V
#undef PG8_WAIT_L
#undef PG8_BAR
#undef PG8_SCHED
}
}

__device__ __forceinline__ float silu_f(float v) { return v * __builtin_amdgcn_rcpf(1.0f + __expf(-v)); }
__device__ __forceinline__ half4 to_half4(f32x4 v) { half4 h; h[0] = (f16)v[0]; h[1] = (f16)v[1]; h[2] = (f16)v[2]; h[3] = (f16)v[3]; return h; }

__device__ __forceinline__ float row_rstd(const float* ss, int np, int row) {
    float s;
    if (np == 1) s = ss[row];
    else { const f32x4* p = (const f32x4*)(ss + (size_t)row * 16); const f32x4 a = p[0], b = p[1], c = p[2], d = p[3];
        s = (((a[0] + a[1]) + (a[2] + a[3])) + ((b[0] + b[1]) + (b[2] + b[3]))) + (((c[0] + c[1]) + (c[2] + c[3])) + ((d[0] + d[1]) + (d[2] + d[3]))); }
    return rsqrtf(s * (1.0f / D) + EPS);
}
struct EpiSwiglu {
    f16* G; const float* ss; int np;
    __device__ __forceinline__ void operator()(const f32x4 (&acc)[2][2][4][2], const pg8::Unit& u, int wr, int wc, int fr_, int fq_) const {
        int fr = fr_, fq = fq_; asm volatile("" : "+v"(fr), "+v"(fq));
#pragma unroll
        for (int ai = 0; ai < 2; ++ai)
#pragma unroll
            for (int m = 0; m < 4; ++m) {
                const int row = u.pm * 256 + ai * 128 + wr * 64 + m * 16 + fr;
                const float rs = row_rstd(ss, np, row), ce = -1.4426950408889634f * rs, rs2 = rs * rs; half8 o;
#pragma unroll
                for (int n = 0; n < 2; ++n) {
                    const f32x4 g = acc[ai][0][m][n], u = acc[ai][1][m][n]; const f32x4 t = g * ce; f32x4 e, r;
#pragma unroll
                    for (int j = 0; j < 4; ++j) e[j] = __builtin_amdgcn_exp2f(t[j]);
                    const f32x4 d = e + 1.0f;
#pragma unroll
                    for (int j = 0; j < 4; ++j) r[j] = __builtin_amdgcn_rcpf(d[j]);
                    const f32x4 w = (g * u) * (r * rs2);
#pragma unroll
                    for (int j = 0; j < 4; ++j) o[4 * n + j] = (f16)w[j];
                }
                *(half8*)(G + (size_t)row * DFF + u.pn * 128 + wc * 32 + 8 * fq) = o;
            }
    }
};
template <bool SRC16> struct EpiResid {
    const void* src; f16* h16; float* ss; float alpha;
    __device__ __forceinline__ void operator()(const f32x4 (&acc)[2][2][4][2], const pg8::Unit& u, int wr, int wc, int fr_, int fq_) const {
        int fr = fr_, fq = fq_; asm volatile("" : "+v"(fr), "+v"(fq));
#pragma unroll
        for (int ai = 0; ai < 2; ++ai)
#pragma unroll
            for (int m = 0; m < 4; ++m) {
                const int row = u.pm * 256 + ai * 128 + wr * 64 + m * 16 + fr; float part = 0.f;
#pragma unroll
                for (int bj = 0; bj < 2; ++bj) {
                    const size_t off = (size_t)row * D + u.pn * 256 + bj * 128 + wc * 32 + 8 * fq; half8 h; f32x4 sv[2];
                    if (SRC16) { const half8 s8 = *(const half8*)((const f16*)src + off);
#pragma unroll
                        for (int j = 0; j < 4; ++j) { sv[0][j] = (float)s8[j]; sv[1][j] = (float)s8[4 + j]; } }
                    else { sv[0] = *(const f32x4*)((const float*)src + off); sv[1] = *(const f32x4*)((const float*)src + off + 4); }
#pragma unroll
                    for (int n = 0; n < 2; ++n) {
                        const f32x4 o = sv[n] + alpha * acc[ai][bj][m][n];
#pragma unroll
                        for (int j = 0; j < 4; ++j) h[4 * n + j] = (f16)o[j];
                        part += (o[0] * o[0] + o[1] * o[1]) + (o[2] * o[2] + o[3] * o[3]);
                    }
                    *(half8*)(h16 + off) = h;
                }
                part += __shfl_xor(part, 16); part += __shfl_xor(part, 32);
                if (fq == 0) ss[(size_t)row * 16 + u.pn * 4 + wc] = part;
            }
    }
};
constexpr float KV_SCALE = 16.0f;
constexpr float K_I8_SCALE = 127.0f / 8.0f;
__device__ __forceinline__ unsigned pack_fp8x4(f32x4 v) {
#pragma unroll
    for (int j = 0; j < 4; ++j) v[j] = fminf(fmaxf(v[j], -448.f), 448.f);
    int w = __builtin_amdgcn_cvt_pk_fp8_f32(v[0], v[1], 0, false); w = __builtin_amdgcn_cvt_pk_fp8_f32(v[2], v[3], w, true); return (unsigned)w;
}
__device__ __forceinline__ void rope8(const f32x4 (&x1)[2], const f32x4 (&x2)[2], const f32x2* rp, float sc, float (&o1)[8], float (&o2)[8]) {
#pragma unroll
    for (int n = 0; n < 2; ++n) {
        const f32x4 cs0 = *(const f32x4*)(rp + 4 * n), cs1 = *(const f32x4*)(rp + 4 * n + 2);
        o1[4 * n + 0] = (x1[n][0] * cs0[0] - x2[n][0] * cs0[1]) * sc; o2[4 * n + 0] = (x2[n][0] * cs0[0] + x1[n][0] * cs0[1]) * sc;
        o1[4 * n + 1] = (x1[n][1] * cs0[2] - x2[n][1] * cs0[3]) * sc; o2[4 * n + 1] = (x2[n][1] * cs0[2] + x1[n][1] * cs0[3]) * sc;
        o1[4 * n + 2] = (x1[n][2] * cs1[0] - x2[n][2] * cs1[1]) * sc; o2[4 * n + 2] = (x2[n][2] * cs1[0] + x1[n][2] * cs1[1]) * sc;
        o1[4 * n + 3] = (x1[n][3] * cs1[2] - x2[n][3] * cs1[3]) * sc; o2[4 * n + 3] = (x2[n][3] * cs1[2] + x1[n][3] * cs1[3]) * sc;
    }
}
__device__ __forceinline__ u32x2 pack_i8x8(const float (&v)[8]) {
    u32x2 r;
#pragma unroll
    for (int w = 0; w < 2; ++w) { unsigned word = 0u;
#pragma unroll
        for (int j = 0; j < 4; ++j) { const int q = (int)__builtin_rintf(fminf(fmaxf(v[4 * w + j] * K_I8_SCALE, -127.f), 127.f)); word |= ((unsigned)q & 0xffu) << (8 * j); }
        r[w] = word; }
    return r;
}
__device__ __forceinline__ u32x2 pack_bf8x8(const float (&v)[8]) {
    u32x2 r;
#pragma unroll
    for (int w = 0; w < 2; ++w) { int word = __builtin_amdgcn_cvt_pk_bf8_f32(v[4 * w], v[4 * w + 1], 0, false); word = __builtin_amdgcn_cvt_pk_bf8_f32(v[4 * w + 2], v[4 * w + 3], word, true); r[w] = (unsigned)word; }
    return r;
}
__device__ __forceinline__ u32x2 pack_fp8x8(const float (&v)[8]) { u32x2 r; r[0] = pack_fp8x4((f32x4){v[0], v[1], v[2], v[3]}); r[1] = pack_fp8x4((f32x4){v[4], v[5], v[6], v[7]}); return r; }
struct EpiInProj {
    const float* ss; const f32x2* rope; unsigned char* ws;
    __device__ __forceinline__ void operator()(const f32x4 (&acc)[2][2][4][2], const pg8::Unit& u, int wr, int wc, int fr_, int fq_) const {
        int fr = fr_, fq = fq_; asm volatile("" : "+v"(fr), "+v"(fq));
        const int pn = u.pn;
        if (pn >= 8 && pn <= 11) {
            unsigned char* lb = (pn <= 9) ? ws + WS_KV + (size_t)((pn - 8) * 4 + wc) * LP * 128 + 8 * fq
                                          : ws + WS_KV + (size_t)((pn - 10) * 4 + (wc >> 1)) * LP * 128 + 64 + (wc & 1) * 32 + 8 * fq;
#pragma unroll
            for (int ai = 0; ai < 2; ++ai)
#pragma unroll
                for (int m = 0; m < 4; ++m) {
                    const int p = u.pm * 256 + ai * 128 + wr * 64 + m * 16 + fr;
                    const int t = p < SEQ ? p + NMETA : p - SEQ;
                    if (p < L) {
                        const float sc = row_rstd(ss, 16, p);
                        if (pn <= 9) {
                            float o1[8], o2[8]; rope8(acc[ai][0][m], acc[ai][1][m], rope + (size_t)t * 32 + 8 * fq, sc, o1, o2);
                            unsigned char* d8 = lb + (size_t)t * 128; *(u32x2*)d8 = pack_i8x8(o1); *(u32x2*)(d8 + 32) = pack_i8x8(o2);
                        } else {
#pragma unroll
                            for (int bj = 0; bj < 2; ++bj) { float v[8];
#pragma unroll
                                for (int j = 0; j < 4; ++j) { v[j] = acc[ai][bj][m][0][j] * sc; v[4 + j] = acc[ai][bj][m][1][j] * sc; }
                                *(u32x2*)(lb + (size_t)t * 128 + (size_t)bj * 2 * LP * 128) = pack_bf8x8(v); }
                        }
                    }
                    asm volatile("" ::: "memory");
                }
            return;
        }
        int mode = 0, stride = 256; float scale = 1.0f; f16* lanebase;
        if (pn == 0) lanebase = (f16*)(ws + WS_GQ) + wc * 32 + 8 * fq;
        else if (pn == 1) lanebase = (f16*)(ws + WS_GK) + wc * 32 + 8 * fq;
        else if (pn <= 3) { lanebase = (f16*)(ws + WS_GV) + (pn - 2) * 256 + wc * 32 + 8 * fq; stride = 512; }
        else if (pn <= 5) { lanebase = (f16*)(ws + WS_GR) + (pn - 4) * 256 + wc * 32 + 8 * fq; stride = 512; }
        else if (pn <= 7) { lanebase = (f16*)(ws + WS_DQ); mode = 6; scale = 0.125f; }
        else if (pn <= 13) { lanebase = (f16*)(ws + WS_IQ) + (pn - 12) * 256 + wc * 64 + 8 * fq; stride = 512; mode = 1; scale = 0.125f; }
        else { lanebase = (f16*)(ws + WS_IK) + 8 * fq; stride = 64; mode = wc == 0 ? 1 : (wc == 1 ? 2 : 3); }
#pragma unroll
        for (int ai = 0; ai < 2; ++ai)
#pragma unroll
            for (int m = 0; m < 4; ++m) {
                const int p = u.pm * 256 + ai * 128 + wr * 64 + m * 16 + fr;
                const int t = p < SEQ ? p + NMETA : p - SEQ;
                if (p < L && mode != 3) {
                    const float rs = row_rstd(ss, 16, p);
                    if (mode == 6) {
                        float o1[8], o2[8]; rope8(acc[ai][0][m], acc[ai][1][m], rope + (size_t)t * 32 + 8 * fq, rs * scale, o1, o2);
                        float qm = 1e-20f;
#pragma unroll
                        for (int j = 0; j < 8; ++j) qm = fmaxf(qm, fmaxf(fabsf(o1[j]), fabsf(o2[j])));
                        qm = fmaxf(qm, __shfl_xor(qm, 16)); qm = fmaxf(qm, __shfl_xor(qm, 32));
                        const float qsc = 127.0f * __builtin_amdgcn_rcpf(qm); u32x2 w1, w2;
#pragma unroll
                        for (int w = 0; w < 2; ++w) { unsigned a = 0u, b = 0u;
#pragma unroll
                            for (int j = 0; j < 4; ++j) { a |= ((unsigned)(int)__builtin_rintf(o1[4 * w + j] * qsc) & 0xffu) << (8 * j); b |= ((unsigned)(int)__builtin_rintf(o2[4 * w + j] * qsc) & 0xffu) << (8 * j); }
                            w1[w] = a; w2[w] = b; }
                        const int head = (pn - 6) * 4 + wc; unsigned char* qrow = ws + WS_DQ + (size_t)t * 512 + head * 64 + 8 * fq;
                        *(u32x2*)qrow = w1; *(u32x2*)(qrow + 32) = w2;
                        if (fq == 0) ((float*)(ws + WS_DQ + (size_t)LP * 512))[(size_t)t * 8 + head] = qm * (1.0f / (127.0f * K_I8_SCALE));
                    } else if (mode == 1) {
                        float o1[8], o2[8]; rope8(acc[ai][0][m], acc[ai][1][m], rope + (size_t)t * 32 + 8 * fq, rs * scale, o1, o2);
                        half8 h1, h2;
#pragma unroll
                        for (int j = 0; j < 8; ++j) { h1[j] = (f16)o1[j]; h2[j] = (f16)o2[j]; }
                        f16* dst = lanebase + (size_t)t * stride; *(half8*)dst = h1; *(half8*)(dst + 32) = h2;
                    } else if (mode == 2) {
                        if (fq < 2) { float* gp = (float*)(ws + WS_GA) + (size_t)t * 16 + 8 * fq; *(f32x4*)gp = acc[ai][0][m][0] * rs; *(f32x4*)(gp + 4) = acc[ai][0][m][1] * rs; }
                        else if (fq == 2) { float* ip = (float*)(ws + WS_IW) + (size_t)t * 8; const float r2 = rs * 0.35355339059327373f; *(f32x4*)ip = acc[ai][0][m][0] * r2; *(f32x4*)(ip + 4) = acc[ai][0][m][1] * r2; }
                    } else {
#pragma unroll
                        for (int bj = 0; bj < 2; ++bj) { half8 h;
#pragma unroll
                            for (int j = 0; j < 4; ++j) { h[j] = (f16)(acc[ai][bj][m][0][j] * rs); h[4 + j] = (f16)(acc[ai][bj][m][1][j] * rs); }
                            *(half8*)(lanebase + (size_t)t * stride + bj * 128) = h; }
                    }
                }
                asm volatile("" ::: "memory");
            }
    }
};

__device__ __forceinline__ const float* w_src(const Params& P, int kind, int n, int& ld, const float*& gain) {
    switch (kind) {
    case 0: case 4: { const int pn = n >> 8, bj = (n >> 7) & 1, cc = n & 127; ld = DFF; gain = kind == 0 ? P.n1 : P.n2;
        const float* w = kind == 0 ? (bj ? P.wu1 : P.wg1) : (bj ? P.wu2 : P.wg2); return w + pn * 128 + cc; }
    case 1: ld = D; gain = nullptr; return P.wd1 + n;
    case 5: ld = D; gain = nullptr; return P.wd2 + n;
    case 3: ld = D; gain = nullptr; return P.wout + n;
    default: { ld = 3672; gain = P.nmix; const int pn = n >> 8, c = n & 255, bj = c >> 7, hh = (c >> 5) & 3, dd = c & 31; int j;
        if (pn == 0) j = c; else if (pn == 1) j = 256 + c; else if (pn <= 3) j = 512 + (pn - 2) * 256 + c; else if (pn <= 5) j = 1024 + (pn - 4) * 256 + c;
        else if (pn <= 7) j = 1552 + (pn - 6) * 256 + hh * 64 + bj * 32 + dd;
        else if (pn <= 9) j = 2064 + (pn - 8) * 256 + hh * 64 + bj * 32 + dd;
        else if (pn <= 11) j = 2576 + (pn - 10) * 256 + c;
        else if (pn <= 13) j = 3088 + (pn - 12) * 256 + hh * 64 + bj * 32 + dd;
        else { if (c < 32) j = 3600 + c; else if (c < 48) j = 1536 + (c - 32); else if (c < 56) j = 3664 + (c - 48); else if (c >= 128 && c < 160) j = 3600 + 32 + (c - 128); else j = -1; }
        return j < 0 ? nullptr : P.win + j; }
    }
}
__device__ __forceinline__ void prep_weight(const Params& P, const int kind, const int N, const int K, f16* dst, int& cursor, int& tbase, LAS f16* tl) {
    const int tid = threadIdx.x, G = gridDim.x, tn = N / 64, tk = K / 256, ntile = tn * tk;
    const int n = tid & 63, kk0 = tid >> 6;
    float v[32], vn[32];
#define PREP_LOAD(dstv, tI) do { const int n0_ = ((tI) % tn) * 64, k0_ = ((tI) / tn) * 256; int ld; const float* gain; const float* col = w_src(P, kind, n0_ + n, ld, gain); \
        _Pragma("unroll") for (int i = 0; i < 32; ++i) dstv[i] = col ? col[(size_t)(k0_ + kk0 + 8 * i) * ld] : 0.f; \
        if (gain) { _Pragma("unroll") for (int i = 0; i < 32; ++i) dstv[i] *= gain[k0_ + kk0 + 8 * i]; } } while (0)
    if (cursor < tbase + ntile) PREP_LOAD(v, cursor - tbase);
#pragma unroll 1
    for (; cursor < tbase + ntile; cursor += G) {
        const int tI = cursor - tbase, n0 = (tI % tn) * 64, k0 = (tI / tn) * 256;
        const bool more = cursor + G < tbase + ntile;
        if (more) PREP_LOAD(vn, tI + G);
#pragma unroll
        for (int i = 0; i < 32; ++i) tl[n * 264 + kk0 + 8 * i] = (f16)v[i];
        __syncthreads();
        { const int nr = tid >> 3, seg = tid & 7;
#pragma unroll
          for (int j = 0; j < 4; ++j) *(half8*)(dst + (size_t)(n0 + nr) * K + k0 + (seg + 8 * j) * 8) = *(const LAS half8*)(tl + nr * 264 + (seg + 8 * j) * 8); }
        __syncthreads();
        if (more) {
#pragma unroll
            for (int i = 0; i < 32; ++i) v[i] = vn[i];
        }
    }
#undef PREP_LOAD
    tbase += ntile;
}
__device__ __forceinline__ void p0_prologue(const Params& P, LAS unsigned char* lds) {
    const int tid = threadIdx.x, bid = blockIdx.x, G = gridDim.x, lane = tid & 63;
    unsigned char* ws = P.ws;
    int tbase = 0, cursor = bid;
    LAS f16* tl = (LAS f16*)lds;
    prep_weight(P, 0, 2 * DFF, D, (f16*)(ws + WS_WGU1), cursor, tbase, tl);
    prep_weight(P, 1, D, DFF, (f16*)(ws + WS_WD1), cursor, tbase, tl);
    prep_weight(P, 2, NIN, D, (f16*)(ws + WS_WIN), cursor, tbase, tl);
    float* ss0 = (float*)(ws + WS_SS0);
    f16* acta = (f16*)(ws + WS_ACTA);
    const int gw = bid * 8 + (tid >> 6), nw = G * 8;
    for (int p = gw; p < L; p += nw) {
        const float* src = p < SEQ ? P.x + (size_t)p * D : P.meta + (size_t)(p - SEQ) * D; float s = 0.f;
#pragma unroll
        for (int i = 0; i < 4; ++i) { const f32x4 v = *(const f32x4*)(src + lane * 4 + 256 * i); s += (v[0] * v[0] + v[1] * v[1]) + (v[2] * v[2] + v[3] * v[3]); *(half4*)(acta + (size_t)p * D + lane * 4 + 256 * i) = to_half4(v); }
#pragma unroll
        for (int o = 32; o >= 1; o >>= 1) s += __shfl_xor(s, o);
        if (lane == 0) ss0[p] = s;
    }
    const int gt = bid * NTHREADS + tid, ngt = G * NTHREADS;
    for (int i = gt; i < MP; i += ngt) { if (i >= L) ss0[i] = (float)D; }
    f32x2* rope = (f32x2*)(ws + WS_ROPE);
    for (int i = gt; i < L * 32; i += ngt) { const int t = i >> 5, f = i & 31; const double inv = exp(-(double)f * (9.210340371976184 / 32.0)); double sn, cs; sincos((double)t * inv, &sn, &cs); rope[i] = (f32x2){(float)cs, (float)sn}; }
}

__device__ __forceinline__ void meta_down(const Params& P, LAS unsigned char* lds) {
    const int tid = threadIdx.x, lane = tid & 63, wid = tid >> 6;
    const f16* Gm = (const f16*)(P.ws + WS_G) + (size_t)SEQ * DFF; const f16* Wt = (const f16*)(P.ws + WS_WD1);
    f16* acta = (f16*)P.out; float* ss1 = (float*)(P.ws + WS_SS1); LAS float* slot = (LAS float*)lds;
    for (int task = blockIdx.x; task < NMETA * 16; task += gridDim.x) {
        const int r = task >> 4, cg = task & 15; float part = 0.f;
#pragma unroll 1
        for (int q = 0; q < 2; ++q) {
            const int n0 = cg * 64 + (2 * wid + q) * 4; float a[4] = {0.f, 0.f, 0.f, 0.f};
            for (int kc = lane; kc < DFF / 8; kc += 64) {
                const half8 gv = *(const half8*)(Gm + (size_t)r * DFF + kc * 8);
#pragma unroll
                for (int j = 0; j < 4; ++j) { const half8 wv = *(const half8*)(Wt + (size_t)(n0 + j) * DFF + kc * 8);
#pragma unroll
                    for (int e = 0; e < 8; ++e) a[j] += (float)gv[e] * (float)wv[e]; }
            }
#pragma unroll
            for (int o = 32; o >= 1; o >>= 1) { a[0] += __shfl_xor(a[0], o); a[1] += __shfl_xor(a[1], o); a[2] += __shfl_xor(a[2], o); a[3] += __shfl_xor(a[3], o); }
            f32x4 o;
#pragma unroll
            for (int j = 0; j < 4; ++j) { o[j] = P.meta[r * D + n0 + j] + 0.5f * a[j]; part += o[j] * o[j]; }
            if (lane == 0) *(half4*)(acta + (size_t)(SEQ + r) * D + n0) = to_half4(o);
        }
        if (lane == 0) slot[wid] = part;
        __syncthreads();
        if (tid == 0) { float s = 0.f; for (int w = 0; w < 8; ++w) s += slot[w]; ss1[(size_t)(SEQ + r) * 16 + cg] = s; }
        __syncthreads();
    }
}

__device__ __forceinline__ float logsigmoid_f(float z) { return fminf(z, 0.f) - __logf(1.0f + __expf(-fabsf(z))); }
__device__ __forceinline__ void gla_gates(const Params& P, int c, int h, LAS float* bl) {
    const int tid = threadIdx.x, ti = tid >> 3, d0 = (tid & 7) * 8, tt = 64 * c - 48 + ti; const float* GA = (const float*)(P.ws + WS_GA);
    {
        float z[8];
        if (tt >= 0 && tt < L) {
            const f32x4 b0 = *(const f32x4*)(P.ba + 64 * h + d0), b1 = *(const f32x4*)(P.ba + 64 * h + d0 + 4);
#pragma unroll
            for (int m = 0; m < 4; ++m) { z[m] = b0[m]; z[4 + m] = b1[m]; }
            f32x4 a4[4];
#pragma unroll
            for (int q = 0; q < 4; ++q) a4[q] = *(const f32x4*)(GA + (size_t)tt * 16 + 4 * q);
#pragma unroll
            for (int r = 0; r < 16; ++r) { const float ar = a4[r >> 2][r & 3]; const f32x4 w0 = *(const f32x4*)(P.wa2 + r * 256 + 64 * h + d0), w1 = *(const f32x4*)(P.wa2 + r * 256 + 64 * h + d0 + 4);
#pragma unroll
                for (int m = 0; m < 4; ++m) { z[m] += ar * w0[m]; z[4 + m] += ar * w1[m]; } }
#pragma unroll
            for (int m = 0; m < 8; ++m) z[m] = logsigmoid_f(z[m]) * (1.0f / 16.0f);
        } else {
#pragma unroll
            for (int m = 0; m < 8; ++m) z[m] = 0.f;
        }
#pragma unroll
        for (int m = 0; m < 8; ++m) bl[ti * 65 + d0 + m] = z[m];
    }
    __syncthreads();
    {
        const int d = tid & 63, seg = tid >> 6; float v[8], run = 0.f;
#pragma unroll
        for (int i = 0; i < 8; ++i) { run += bl[(seg * 8 + i) * 65 + d]; v[i] = run; }
#pragma unroll
        for (int i = 0; i < 8; ++i) bl[(seg * 8 + i) * 65 + d] = v[i];
        __syncthreads();
        float off = 0.f;
#pragma unroll
        for (int sg = 0; sg < 7; ++sg) off += (sg < seg) ? bl[(sg * 8 + 7) * 65 + d] : 0.f;
        __syncthreads();
#pragma unroll
        for (int i = 0; i < 8; ++i) bl[(seg * 8 + i) * 65 + d] = v[i] + off;
    }
    __syncthreads();
}
__device__ __forceinline__ void gla_a_unit(const Params& P, int unit, LAS unsigned char* lds) {
    int tid_ = threadIdx.x; asm volatile("" : "+v"(tid_));
    const int tid = tid_, lane = tid & 63, wid = tid >> 6, c = unit >> 2, h = unit & 3;
    LAS float* bl = (LAS float*)lds; LAS float* ks = bl + 4160; LAS float* vs = ks + 4096;
    const f16* GK = (const f16*)(P.ws + WS_GK); const f16* GV = (const f16*)(P.ws + WS_GV);
    float* U = (float*)(P.ws + WS_US); float* DEC = (float*)(P.ws + WS_DECAY);
    const int ti = tid >> 3, d0 = (tid & 7) * 8, tt = 64 * c - 48 + ti; const bool tv = tt >= 0 && tt < L;
    half8 k8, v8[2];
#pragma unroll
    for (int m = 0; m < 8; ++m) { k8[m] = (f16)0.f; v8[0][m] = (f16)0.f; v8[1][m] = (f16)0.f; }
    if (tv) k8 = *(const half8*)(GK + (size_t)tt * 256 + 64 * h + d0);
#pragma unroll
    for (int q = 0; q < 2; ++q) { const int ch = tid + 512 * q, j = ch >> 4, t = 64 * c - 48 + j; if (t >= 0 && t < L) v8[q] = *(const half8*)(GV + (size_t)t * 512 + 128 * h + (ch & 15) * 8); }
    gla_gates(P, c, h, bl);
    { f32x4 o0, o1;
#pragma unroll
      for (int m = 0; m < 4; ++m) { o0[m] = (float)k8[m] * __expf(bl[63 * 65 + d0 + m] - bl[ti * 65 + d0 + m]); o1[m] = (float)k8[4 + m] * __expf(bl[63 * 65 + d0 + 4 + m] - bl[ti * 65 + d0 + 4 + m]); }
      *(LAS f32x4*)(ks + ti * 64 + d0) = o0; *(LAS f32x4*)(ks + ti * 64 + d0 + 4) = o1; }
#pragma unroll
    for (int q = 0; q < 2; ++q) { const int ch = tid + 512 * q, j = ch >> 4, e0 = (ch & 15) * 8; f32x4 o0, o1;
#pragma unroll
        for (int m = 0; m < 4; ++m) { o0[m] = (float)v8[q][m]; o1[m] = (float)v8[q][4 + m]; }
        *(LAS f32x4*)(vs + j * 128 + e0) = o0; *(LAS f32x4*)(vs + j * 128 + e0 + 4) = o1; }
    if (tid < 64) DEC[(size_t)c * 256 + h * 64 + tid] = __expf(bl[63 * 65 + tid]);
    __syncthreads();
    { const int dd0 = (wid >> 2) * 32, e0 = (wid & 3) * 32, l31 = lane & 31, hf = lane >> 5; f32x16 acc;
#pragma unroll
      for (int i = 0; i < 16; ++i) acc[i] = 0.f;
#pragma unroll 8
      for (int s = 0; s < 32; ++s) acc = __builtin_amdgcn_mfma_f32_32x32x2f32(ks[(2 * s + hf) * 64 + dd0 + l31], vs[(2 * s + hf) * 128 + e0 + l31], acc, 0, 0, 0);
      float* up = U + ((size_t)unit * 64) * 128;
#pragma unroll
      for (int r = 0; r < 16; ++r) { const int row = (r & 3) + 8 * (r >> 2) + 4 * hf; up[(size_t)(dd0 + row) * 128 + e0 + l31] = acc[r]; } }
    __syncthreads();
}
__device__ __forceinline__ void gla_scan(const Params& P) {
    float* U = (float*)(P.ws + WS_US); const float* DEC = (const float*)(P.ws + WS_DECAY);
    const int idx = blockIdx.x * NTHREADS + threadIdx.x;
    if (idx >= 32768) return;
    float s = 0.f;
#pragma unroll 8
    for (int c = 0; c < NCH; ++c) { const float u = U[(size_t)c * 32768 + idx], dc = DEC[(size_t)c * 256 + (idx >> 7)]; U[(size_t)c * 32768 + idx] = s; s = dc * s + u; }
}
__device__ __forceinline__ void gla_c_unit(const Params& P, int unit, LAS unsigned char* lds) {
    int tid_ = threadIdx.x; asm volatile("" : "+v"(tid_));
    const int tid = tid_, lane = tid & 63, wid = tid >> 6, c = unit >> 2, h = unit & 3, l31 = lane & 31, hf = lane >> 5;
    LAS float* bl = (LAS float*)lds; LAS float* kk = bl + 4160; LAS float* qs = kk + 4160; LAS float* As = qs + 4160; LAS float* vs = As + 4160; LAS float* Ss = vs + 8192; LAS float* os = bl;
    const f16* GQ = (const f16*)(P.ws + WS_GQ); const f16* GK = (const f16*)(P.ws + WS_GK); const f16* GV = (const f16*)(P.ws + WS_GV); const f16* GR = (const f16*)(P.ws + WS_GR);
    const float* Sg = (const float*)(P.ws + WS_US) + (size_t)unit * 8192; f16* mix = (f16*)(P.ws + WS_ACTA);
    const int ti = tid >> 3, d0 = (tid & 7) * 8, tt = 64 * c - 48 + ti; const bool tv = tt >= 0 && tt < L;
    half8 q8, k8, v8[2], r8[2]; f32x4 sreg[4];
#pragma unroll
    for (int m = 0; m < 8; ++m) { q8[m] = (f16)0.f; k8[m] = (f16)0.f; v8[0][m] = (f16)0.f; v8[1][m] = (f16)0.f; r8[0][m] = (f16)0.f; r8[1][m] = (f16)0.f; }
    if (tv) { q8 = *(const half8*)(GQ + (size_t)tt * 256 + 64 * h + d0); k8 = *(const half8*)(GK + (size_t)tt * 256 + 64 * h + d0);
        r8[0] = *(const half8*)(GR + (size_t)tt * 512 + 128 * h + (tid & 7) * 16); r8[1] = *(const half8*)(GR + (size_t)tt * 512 + 128 * h + (tid & 7) * 16 + 8); }
#pragma unroll
    for (int q = 0; q < 2; ++q) { const int ch = tid + 512 * q, j = ch >> 4, t = 64 * c - 48 + j; if (t >= 0 && t < L) v8[q] = *(const half8*)(GV + (size_t)t * 512 + 128 * h + (ch & 15) * 8); }
#pragma unroll
    for (int q = 0; q < 4; ++q) sreg[q] = *(const f32x4*)(Sg + (size_t)(tid + 512 * q) * 4);
    gla_gates(P, c, h, bl);
#pragma unroll
    for (int m = 0; m < 8; ++m) { const float bv = bl[ti * 65 + d0 + m]; qs[ti * 65 + d0 + m] = (float)q8[m] * 0.125f * __expf(bv); kk[ti * 65 + d0 + m] = (float)k8[m] * __expf(-bv); }
#pragma unroll
    for (int q = 0; q < 2; ++q) { const int ch = tid + 512 * q, j = ch >> 4, e0 = (ch & 15) * 8; f32x4 o0, o1;
#pragma unroll
        for (int m = 0; m < 4; ++m) { o0[m] = (float)v8[q][m]; o1[m] = (float)v8[q][4 + m]; }
        *(LAS f32x4*)(vs + j * 128 + e0) = o0; *(LAS f32x4*)(vs + j * 128 + e0 + 4) = o1; }
#pragma unroll
    for (int q = 0; q < 4; ++q) *(LAS f32x4*)(Ss + (tid + 512 * q) * 4) = sreg[q];
    __syncthreads();
    if (wid < 4) { const int i0 = (wid >> 1) * 32, j0 = (wid & 1) * 32; f32x16 acc;
#pragma unroll
        for (int i = 0; i < 16; ++i) acc[i] = 0.f;
#pragma unroll 8
        for (int s = 0; s < 32; ++s) acc = __builtin_amdgcn_mfma_f32_32x32x2f32(qs[(i0 + l31) * 65 + 2 * s + hf], kk[(j0 + l31) * 65 + 2 * s + hf], acc, 0, 0, 0);
#pragma unroll
        for (int r = 0; r < 16; ++r) { const int i = i0 + (r & 3) + 8 * (r >> 2) + 4 * hf, j = j0 + l31; As[i * 65 + j] = (j <= i) ? acc[r] : 0.f; } }
    __syncthreads();
    { const int i0 = (wid >> 2) * 32, e0 = (wid & 3) * 32; f32x16 acc;
#pragma unroll
      for (int i = 0; i < 16; ++i) acc[i] = 0.f;
#pragma unroll 8
      for (int s = 0; s < 32; ++s) acc = __builtin_amdgcn_mfma_f32_32x32x2f32(qs[(i0 + l31) * 65 + 2 * s + hf], Ss[(2 * s + hf) * 128 + e0 + l31], acc, 0, 0, 0);
#pragma unroll 8
      for (int s = 0; s < 32; ++s) acc = __builtin_amdgcn_mfma_f32_32x32x2f32(As[(i0 + l31) * 65 + 2 * s + hf], vs[(2 * s + hf) * 128 + e0 + l31], acc, 0, 0, 0);
#pragma unroll
      for (int r = 0; r < 16; ++r) { const int i = i0 + (r & 3) + 8 * (r >> 2) + 4 * hf; os[i * 129 + e0 + l31] = acc[r]; } }
    __syncthreads();
    { const int e0 = (tid & 7) * 16; float o[16], sq = 0.f;
#pragma unroll
      for (int j = 0; j < 16; ++j) { o[j] = os[ti * 129 + e0 + j]; sq += o[j] * o[j]; }
      sq += __shfl_xor(sq, 1); sq += __shfl_xor(sq, 2); sq += __shfl_xor(sq, 4);
      const float rs = rsqrtf(sq * (1.0f / 128.0f) + EPS);
      if (tt >= NMETA && tt < L) { half8 w0, w1;
#pragma unroll
          for (int j = 0; j < 8; ++j) { w0[j] = (f16)(o[j] * rs * P.hn[e0 + j] * silu_f((float)r8[0][j])); w1[j] = (f16)(o[8 + j] * rs * P.hn[e0 + 8 + j] * silu_f((float)r8[1][j])); }
          f16* dst = mix + (size_t)(tt - NMETA) * D + 128 * h + e0; *(half8*)dst = w0; *(half8*)(dst + 8) = w1; } }
    __syncthreads();
}

__device__ __forceinline__ unsigned mono_u(float f) { const unsigned u = __float_as_uint(f); return (u & 0x80000000u) ? ~u : (u | 0x80000000u); }
__device__ __forceinline__ float unmono_f(unsigned m) { return __uint_as_float((m & 0x80000000u) ? (m & 0x7fffffffu) : ~m); }
__device__ __forceinline__ unsigned wave_umax(unsigned v) {
    v = max(v, (unsigned)__builtin_amdgcn_update_dpp(0, (int)v, 0x111, 0xf, 0xf, false));
    v = max(v, (unsigned)__builtin_amdgcn_update_dpp(0, (int)v, 0x112, 0xf, 0xf, false));
    v = max(v, (unsigned)__builtin_amdgcn_update_dpp(0, (int)v, 0x114, 0xf, 0xf, false));
    v = max(v, (unsigned)__builtin_amdgcn_update_dpp(0, (int)v, 0x118, 0xf, 0xf, false));
    v = max(v, (unsigned)__builtin_amdgcn_update_dpp(0, (int)v, 0x142, 0xa, 0xf, false));
    v = max(v, (unsigned)__builtin_amdgcn_update_dpp(0, (int)v, 0x143, 0xc, 0xf, false));
    return (unsigned)__builtin_amdgcn_readlane((int)v, 63);
}
__device__ __forceinline__ int half_scan_incl(int v) {
    v += __builtin_amdgcn_update_dpp(0, v, 0x111, 0xf, 0xf, true);
    v += __builtin_amdgcn_update_dpp(0, v, 0x112, 0xf, 0xf, true);
    v += __builtin_amdgcn_update_dpp(0, v, 0x114, 0xf, 0xf, true);
    v += __builtin_amdgcn_update_dpp(0, v, 0x118, 0xf, 0xf, true);
    v += __builtin_amdgcn_update_dpp(0, v, 0x142, 0xa, 0xf, true);
    return v;
}
constexpr int CAP = 640, NPL = CAP / 64;
__device__ __forceinline__ int topk_compact(LAS float* cs, LAS unsigned short* ci, int n, bool exact, float& tau_out, int lane) {
    float sv[NPL]; unsigned iv[NPL], u[NPL];
#pragma unroll
    for (int i = 0; i < NPL; ++i) { const int p = lane + 64 * i; const bool v = p < n; sv[i] = v ? cs[p] : 0.f; iv[i] = v ? (unsigned)ci[p] : 0xffffu; u[i] = v ? mono_u(sv[i]) : 0u; }
    unsigned T = 0u; bool full = true; int hb = 31;
    {
        unsigned umx = 0u, umn = 0xffffffffu;
#pragma unroll
        for (int i = 0; i < NPL; ++i) { umx = max(umx, u[i]); umn = min(umn, (lane + 64 * i < n) ? u[i] : 0xffffffffu); }
        umx = wave_umax(umx); umn = ~wave_umax(~umn);
        const unsigned df = umx ^ umn;
        if (df == 0u) { hb = -1; T = umx; } else { hb = 31 - __clz(df); T = (hb == 31) ? 0u : (umx & ~((2u << hb) - 1u)); }
    }
#pragma unroll 1
    for (int bit = hb; bit >= 0; --bit) {
        const unsigned cand = T | (1u << bit); int cgt = 0;
#pragma unroll
        for (int i = 0; i < NPL; ++i) cgt += __popcll(__ballot(u[i] >= cand));
        if (cgt >= 256) { T = cand; if (!exact && cgt <= 272) { full = false; break; } }
    }
    bool keep[NPL];
    if (full) {
        int cgt = 0;
#pragma unroll
        for (int i = 0; i < NPL; ++i) cgt += __popcll(__ballot(u[i] > T));
        const int need = 256 - cgt; unsigned I = 0xffffu; int nties = 0;
#pragma unroll
        for (int i = 0; i < NPL; ++i) nties += __popcll(__ballot(u[i] == T));
        if (nties != need) { I = 0u;
#pragma unroll 1
        for (int bit = 15; bit >= 0; --bit) { const unsigned cand = I | (1u << bit); int cl = 0;
#pragma unroll
            for (int i = 0; i < NPL; ++i) cl += __popcll(__ballot(u[i] == T && iv[i] < cand));
            if (cl < need) I = cand; } }
#pragma unroll
        for (int i = 0; i < NPL; ++i) keep[i] = (u[i] > T) || (u[i] == T && iv[i] <= I);
    } else {
#pragma unroll
        for (int i = 0; i < NPL; ++i) keep[i] = u[i] >= T;
    }
    int nn = 0;
#pragma unroll
    for (int i = 0; i < NPL; ++i) { const unsigned long long m = __ballot(keep[i]); const int pre = __builtin_amdgcn_mbcnt_hi((unsigned)(m >> 32), __builtin_amdgcn_mbcnt_lo((unsigned)m, 0u));
        if (keep[i]) { cs[nn + pre] = sv[i]; ci[nn + pre] = (unsigned short)iv[i]; } nn += __popcll(m); }
    tau_out = unmono_f(T);
    return nn;
}
__device__ __forceinline__ float relu_asm(float x) { return __int_as_float(max(__float_as_int(x), 0)); }
__device__ __forceinline__ void indexer_tile(const Params& P, int tile, LAS unsigned char* lds) {
    int tid_ = threadIdx.x; asm volatile("" : "+v"(tid_));
    const int tid = tid_, lane = tid & 63, wid = __builtin_amdgcn_readfirstlane(tid >> 6), l31 = lane & 31, hf = lane >> 5;
    LAS float* candS = (LAS float*)lds;
    LAS unsigned short* candI = (LAS unsigned short*)(lds + 32 * CAP * 4);
    LAS unsigned char* kbuf = lds + 32 * CAP * 6;
    LAS int* lcnt = (LAS int*)(lds + LDS_BYTES - 1024 + 64);
    LAS int* lflag = (LAS int*)(lds + LDS_BYTES - 1024 + 192);
    const f16* IQ = (const f16*)(P.ws + WS_IQ); const f16* IK = (const f16*)(P.ws + WS_IK); const float* IW = (const float*)(P.ws + WS_IW);
    unsigned short* SEL = (unsigned short*)(P.ws + WS_SEL);
    const int t0 = tile * 32, tw = t0 + wid * 4;
    half8 afr[4];
    { const int qi = 2 * (l31 >> 4) + ((l31 >> 2) & 1), hd = 4 * ((l31 >> 3) & 1) + (l31 & 3); int tq = tw + qi; if (tq > L - 1) tq = L - 1;
      const half8* ap = (const half8*)(IQ + (size_t)tq * 512 + hd * 64);
#pragma unroll
      for (int s = 0; s < 4; ++s) afr[s] = ap[2 * s + hf]; }
    float w0[8], w1[8];
    { int ta = tw + hf, tb = tw + 2 + hf; if (ta > L - 1) ta = L - 1; if (tb > L - 1) tb = L - 1;
#pragma unroll
      for (int h = 0; h < 8; ++h) { w0[h] = IW[(size_t)ta * 8 + h]; w1[h] = IW[(size_t)tb * 8 + h]; } }
    asm volatile("" :: "v"(afr[0]), "v"(afr[1]), "v"(afr[2]), "v"(afr[3]));
    asm volatile("" :: "v"(w0[0]), "v"(w0[1]), "v"(w0[2]), "v"(w0[3]), "v"(w0[4]), "v"(w0[5]), "v"(w0[6]), "v"(w0[7]));
    asm volatile("" :: "v"(w1[0]), "v"(w1[1]), "v"(w1[2]), "v"(w1[3]), "v"(w1[4]), "v"(w1[5]), "v"(w1[6]), "v"(w1[7]));
    const int tq0 = (tw + hf < L) ? tw + hf : -1, tq1 = (tw + 2 + hf < L) ? tw + 2 + hf : -1;
    float tau0 = -__builtin_inff(), tau1 = -__builtin_inff();
    int cq0 = 0, cq1 = 0, cq2 = 0, cq3 = 0;
    if (tid < 3) lflag[tid] = 0;
    const int nkeys = (t0 + 32 < L) ? t0 + 32 : L, nst = (nkeys + 127) >> 7;
    u32x4 stg[2];
    const u32x4* IKv = (const u32x4*)IK;
#pragma unroll
    for (int i = 0; i < 2; ++i) stg[i] = IKv[(size_t)0 * 1024 + tid + 512 * i];
#pragma unroll
    for (int i = 0; i < 2; ++i) { const int ci = tid + 512 * i, row = ci >> 3, ch = ci & 7; *(LAS u32x4*)(kbuf + row * 128 + ((ch ^ ((row >> 1) & 7)) << 4)) = stg[i]; }
    __syncthreads();
#pragma unroll 1
    for (int st = 0; st < nst; ++st) {
        LAS unsigned char* kb = kbuf + (st & 1) * 16384;
        if (st + 1 < nst) {
#pragma unroll
            for (int i = 0; i < 2; ++i) stg[i] = IKv[(size_t)(st + 1) * 1024 + tid + 512 * i];
        }
        if (st * 128 <= tw + 3) {
            f32x16 acc[4];
#pragma unroll
            for (int c = 0; c < 4; ++c) {
#pragma unroll
                for (int i = 0; i < 16; ++i) acc[c][i] = 0.f;
            }
#pragma unroll
            for (int s = 0; s < 4; ++s) {
#pragma unroll
                for (int c = 0; c < 4; ++c) { const int row = c * 32 + l31; const half8 bf = *(const LAS half8*)(kb + row * 128 + (((2 * s + hf) ^ ((row >> 1) & 7)) << 4)); acc[c] = __builtin_amdgcn_mfma_f32_32x32x16_f16(afr[s], bf, acc[c], 0, 0, 0); }
            }
            float sc[8]; bool ok[8]; int na = 0, nb = 0;
#pragma unroll
            for (int c = 0; c < 4; ++c) {
                float s0 = 0.f, s1 = 0.f;
#pragma unroll
                for (int h = 0; h < 8; ++h) { s0 = __builtin_fmaf(w0[h], relu_asm(acc[c][h]), s0); s1 = __builtin_fmaf(w1[h], relu_asm(acc[c][8 + h]), s1); }
                const int key = st * 128 + c * 32 + l31;
                sc[2 * c] = s0; sc[2 * c + 1] = s1; ok[2 * c] = key <= tq0 && s0 > tau0; ok[2 * c + 1] = key <= tq1 && s1 > tau1;
                na += ok[2 * c] ? 1 : 0; nb += ok[2 * c + 1] ? 1 : 0;
            }
            const int ia = half_scan_incl(na), ib = half_scan_incl(nb);
            const int ta0 = __builtin_amdgcn_readlane(ia, 31), ta1 = __builtin_amdgcn_readlane(ia, 63), tb0 = __builtin_amdgcn_readlane(ib, 31), tb1 = __builtin_amdgcn_readlane(ib, 63);
            int pa = (hf ? cq1 : cq0) + ia - na, pb = (hf ? cq3 : cq2) + ib - nb;
            cq0 += ta0; cq1 += ta1; cq2 += tb0; cq3 += tb1;
            pa += (wid * 4 + hf) * CAP; pb += (wid * 4 + 2 + hf) * CAP;
            const int dmy = 32 * CAP * 6 / 4 + 2 * 16384 / 4 + 64 + lane;
#pragma unroll
            for (int c = 0; c < 4; ++c) {
                const unsigned short key = (unsigned short)(st * 128 + c * 32 + l31);
                { const bool k0 = ok[2 * c]; LAS float* ps = k0 ? candS + pa : candS + dmy; LAS unsigned short* pi = k0 ? candI + pa : (LAS unsigned short*)(candS + dmy + 64); *ps = sc[2 * c]; *pi = key; pa += k0 ? 1 : 0; }
                { const bool k1 = ok[2 * c + 1]; LAS float* ps = k1 ? candS + pb : candS + dmy; LAS unsigned short* pi = k1 ? candI + pb : (LAS unsigned short*)(candS + dmy + 64); *ps = sc[2 * c + 1]; *pi = key; pb += k1 ? 1 : 0; }
            }
        }
        if (st + 1 < nst) {
            LAS unsigned char* kn = kbuf + ((st + 1) & 1) * 16384;
#pragma unroll
            for (int i = 0; i < 2; ++i) { const int ci = tid + 512 * i, row = ci >> 3, ch = ci & 7; *(LAS u32x4*)(kn + row * 128 + ((ch ^ ((row >> 1) & 7)) << 4)) = stg[i]; }
        }
        const int mx = max(max(cq0, cq1), max(cq2, cq3));
        if (mx > CAP - 128 && lane == 0) lflag[st % 3] = 1;
        if (tid == 0) lflag[(st + 1) % 3] = 0;
        __syncthreads();
        const int any = lflag[st % 3];
        if (any) {
#pragma unroll 1
            for (int qq = 0; qq < 4; ++qq) { const int n = qq == 0 ? cq0 : (qq == 1 ? cq1 : (qq == 2 ? cq2 : cq3));
                if (n > 288) { float nt; const int nn = topk_compact(candS + (wid * 4 + qq) * CAP, candI + (wid * 4 + qq) * CAP, n, false, nt, lane);
                    if (qq == 0) cq0 = nn; else if (qq == 1) cq1 = nn; else if (qq == 2) cq2 = nn; else cq3 = nn;
                    if (hf == (qq & 1)) { if (qq < 2) tau0 = nt; else tau1 = nt; } } }
        }
    }
#pragma unroll 1
    for (int qq = 0; qq < 4; ++qq) {
        const int t = tw + qq; if (t >= L) break;
        int n = qq == 0 ? cq0 : (qq == 1 ? cq1 : (qq == 2 ? cq2 : cq3)); LAS float* cs = candS + (wid * 4 + qq) * CAP; LAS unsigned short* ci = candI + (wid * 4 + qq) * CAP;
        if (n > 256) { float nt; n = topk_compact(cs, ci, n, true, nt, lane); }
#pragma unroll
        for (int j = 0; j < 4; ++j) { const int p = lane + 64 * j; SEL[(size_t)t * 256 + (p & 15) * 16 + (p >> 4)] = p < n ? ci[p] : (unsigned short)0xffffu; }
    }
    __syncthreads();
}

__device__ __forceinline__ void sparse_attn(const Params& P, LAS unsigned char* lds, int vbid) {
    int tid_ = threadIdx.x; asm volatile("" : "+v"(tid_));
    const int tid = tid_, lane = tid & 63, wid = tid >> 6, grp = lane >> 2, c4 = lane & 3;
    const int head = vbid & 7, slot = (vbid >> 3) * 8 + wid, nslot = (gridDim.x >> 3) * 8;
    typedef _Float16 half2v __attribute__((ext_vector_type(2)));
    LAS float* red = (LAS float*)(lds + 4096 + wid * 4352);
    const unsigned short* SEL = (const unsigned short*)(P.ws + WS_SEL);
    const unsigned char* Q8 = P.ws + WS_DQ + head * 64 + c4 * 16; const float* QS = (const float*)(P.ws + WS_DQ + (size_t)LP * 512) + head;
    const unsigned char* kvh = P.ws + WS_KV + (size_t)head * LP * 128; f16* mix = (f16*)(P.ws + WS_ACTA);
    int t = NMETA + slot;
    u32x4 sela = {0u, 0u, 0u, 0u}, selb = {0u, 0u, 0u, 0u}, q8 = {0u, 0u, 0u, 0u}; float lscale = 0.f;
    if (t < L) { sela = *(const u32x4*)(SEL + (size_t)t * 256 + grp * 16); selb = *(const u32x4*)(SEL + (size_t)t * 256 + grp * 16 + 8); q8 = *(const u32x4*)(Q8 + (size_t)t * 512); lscale = QS[(size_t)t * 8]; }
#define ATTN_ITEM(ALLV) do { \
        unsigned keys[16]; u32x4 kreg[16], vreg[16]; \
        _Pragma("unroll") for (int it = 0; it < 16; ++it) { const unsigned w = it < 8 ? sela[it >> 1] : selb[(it - 8) >> 1]; keys[it] = (it & 1) ? (w >> 16) : (w & 0xffffu); } \
        _Pragma("unroll") for (int it = 0; it < 16; ++it) { const unsigned kk = (ALLV || keys[it] != 0xffffu) ? keys[it] : 0u; kreg[it] = *(const u32x4*)(kvh + (size_t)kk * 128 + c4 * 16); } \
        _Pragma("unroll") for (int it = 0; it < 16; ++it) { const unsigned kk = (ALLV || keys[it] != 0xffffu) ? keys[it] : 0u; vreg[it] = *(const u32x4*)(kvh + (size_t)kk * 128 + 64 + c4 * 16); } \
        const u32x4 qc = q8; const float ls = lscale; \
        { const int tn = t + nslot;     \
          if (tn < L) { sela = *(const u32x4*)(SEL + (size_t)tn * 256 + grp * 16); selb = *(const u32x4*)(SEL + (size_t)tn * 256 + grp * 16 + 8); q8 = *(const u32x4*)(Q8 + (size_t)tn * 512); lscale = QS[(size_t)tn * 8]; } } \
        float lg[16]; float mx = -__builtin_inff(); \
        _Pragma("unroll") for (int it = 0; it < 16; ++it) { \
            int ai = 0; \
            _Pragma("unroll") for (int w = 0; w < 4; ++w) ai = __builtin_amdgcn_sdot4((int)kreg[it][w], (int)qc[w], ai, false); \
            ai += __builtin_amdgcn_update_dpp(0, ai, 0xB1, 0xf, 0xf, true);     \
            ai += __builtin_amdgcn_update_dpp(0, ai, 0x4E, 0xf, 0xf, true);     \
            lg[it] = (ALLV || keys[it] != 0xffffu) ? (float)ai * ls : -__builtin_inff(); mx = fmaxf(mx, lg[it]); } \
        mx = fmaxf(mx, __shfl_xor(mx, 4)); mx = fmaxf(mx, __shfl_xor(mx, 8)); mx = fmaxf(mx, __shfl_xor(mx, 16)); mx = fmaxf(mx, __shfl_xor(mx, 32)); \
        half2v o2[8]; float lsum = 0.f; \
        _Pragma("unroll") for (int e = 0; e < 8; ++e) o2[e] = (half2v){(f16)0.f, (f16)0.f}; \
        _Pragma("unroll") for (int it = 0; it < 16; ++it) { \
            const float p = __expf(lg[it] - mx); lsum += p; const f16 ph = (f16)p; const half2v p2 = {ph, ph}; \
            _Pragma("unroll") for (int w = 0; w < 4; ++w) {     \
                const half2v v01 = __builtin_bit_cast(half2v, __builtin_amdgcn_perm(0u, vreg[it][w], 0x010c000cu)), v23 = __builtin_bit_cast(half2v, __builtin_amdgcn_perm(0u, vreg[it][w], 0x030c020cu)); \
                o2[2 * w] = p2 * v01 + o2[2 * w]; o2[2 * w + 1] = p2 * v23 + o2[2 * w + 1]; } } \
        lsum += __shfl_xor(lsum, 4); lsum += __shfl_xor(lsum, 8); lsum += __shfl_xor(lsum, 16); lsum += __shfl_xor(lsum, 32); \
          \
        _Pragma("unroll") for (int e = 0; e < 8; ++e) { red[lane * 17 + 2 * e] = (float)o2[e][0]; red[lane * 17 + 2 * e + 1] = (float)o2[e][1]; } \
        float acc = 0.f; \
        { const int cc = lane >> 4, e = lane & 15; \
          _Pragma("unroll") for (int g = 0; g < 16; ++g) acc += red[(g * 4 + cc) * 17 + e]; } \
        mix[(size_t)(t - NMETA) * D + 512 + head * 64 + lane] = (f16)(acc * __builtin_amdgcn_rcpf(lsum)); \
    } while (0)
#pragma unroll 1
    for (; t < L; t += nslot) {
        if (t >= 255) ATTN_ITEM(true);
        else ATTN_ITEM(false);
    }
#undef ATTN_ITEM
    __syncthreads();
}

__device__ __forceinline__ void final_norm(const Params& P) {
    const int tid = threadIdx.x, lane = tid & 63, gw = blockIdx.x * 8 + (tid >> 6), nw = gridDim.x * 8;
    const float* ss3 = (const float*)(P.ws + WS_SS3); const f16* h3 = (const f16*)(P.ws + WS_ACTA);
    for (int r = gw; r < SEQ; r += nw) { const float rs = row_rstd(ss3, 16, r);
#pragma unroll
        for (int i = 0; i < 2; ++i) { const int k = lane * 8 + 512 * i; const half8 v = *(const half8*)(h3 + (size_t)r * D + k); const f32x4 g0 = *(const f32x4*)(P.nf + k), g1 = *(const f32x4*)(P.nf + k + 4); f32x4 o0, o1;
#pragma unroll
            for (int j = 0; j < 4; ++j) { o0[j] = (float)v[j] * rs * g0[j]; o1[j] = (float)v[4 + j] * rs * g1[j]; }
            *(f32x4*)(P.out + (size_t)r * D + k) = o0; *(f32x4*)(P.out + (size_t)r * D + k + 4) = o1; } }
}

#define XB_TMO      128
#define XB_XCNT(j)  (256  + 64 * (j))
#define XB_XSUB(j)  (1280 + 64 * (j))
#define XB_XGEN(j)  (2304 + 64 * (j))
#define XB_TOP      3328
#define XB_TOPGEN   3392
#define XCD_BAR_WORDS 3456
#define XB_SPIN_CAP (1u << 22)
__device__ __forceinline__ unsigned xb_ld(unsigned* p)              { return __hip_atomic_load(p, __ATOMIC_RELAXED, __HIP_MEMORY_SCOPE_AGENT); }
__device__ __forceinline__ unsigned xb_add(unsigned* p, unsigned v) { return __hip_atomic_fetch_add(p, v, __ATOMIC_RELAXED, __HIP_MEMORY_SCOPE_AGENT); }
__device__ __forceinline__ unsigned xb_xcc_id() { return (unsigned)__builtin_amdgcn_s_getreg((3 << 11) | 20) & 0xFu; }
#define XB_SPIN(cond, bar) do { unsigned _sp = 0; while (cond) { __builtin_amdgcn_s_sleep(1); \
    if ((++_sp & 255u) == 0u) { if (xb_ld(&(bar)[XB_TMO])) break; if (_sp > XB_SPIN_CAP) { atomicAdd(&(bar)[XB_TMO], 1u); break; } } } } while (0)
struct XcdBarrier { unsigned* bar; unsigned x; volatile LAS unsigned* st; };
__device__ __forceinline__ XcdBarrier xcd_barrier_post(unsigned* bar, volatile LAS unsigned* st) {
    XcdBarrier b; b.bar = bar; b.x = xb_xcc_id(); b.st = st;
    if (threadIdx.x == 0) (void)xb_add(&bar[XB_XCNT(b.x)], 1u);
    return b;
}
__device__ __forceinline__ void xcd_barrier_complete(unsigned* bar, unsigned x, unsigned& nloc, unsigned& nx) {
    const unsigned G = gridDim.x * gridDim.y * gridDim.z;
    unsigned sum, cnt, mine, sp = 0u;
    for (;;) {
        sum = 0u; cnt = 0u; mine = 0u;
#pragma unroll
        for (unsigned j = 0; j < 16; ++j) { const unsigned c = xb_ld(&bar[XB_XCNT(j)]); sum += c; cnt += (c > 0u) ? 1u : 0u; mine = (j == x) ? c : mine; }
        if (sum == G) break;
        __builtin_amdgcn_s_sleep(1);
        if ((++sp & 255u) == 0u) { if (xb_ld(&bar[XB_TMO])) break; if (sp > XB_SPIN_CAP) { atomicAdd(&bar[XB_TMO], 1u); break; } }
    }
    nloc = mine > 0u ? mine : 1u; nx = cnt > 0u ? cnt : 1u;
}
__device__ __forceinline__ void xcd_barrier(const XcdBarrier& b) {
    asm volatile("s_waitcnt vmcnt(0)" ::: "memory");
    __syncthreads();
    if (threadIdx.x == 0) {
        unsigned* bar = b.bar;
        __builtin_amdgcn_s_waitcnt(0);
        unsigned nloc = b.st[0], nx = b.st[1];
        if (nloc == 0u) { xcd_barrier_complete(bar, b.x, nloc, nx); b.st[0] = nloc; b.st[1] = nx; }
        const unsigned old = xb_add(&bar[XB_XSUB(b.x)], 1u);
        const unsigned gen = old / nloc;
        if (old + 1u == (gen + 1u) * nloc) {
            __builtin_amdgcn_fence(__ATOMIC_RELEASE, "agent");
            asm volatile("s_waitcnt vmcnt(0)" ::: "memory");
            const unsigned og = xb_add(&bar[XB_TOP], 1u);
            const unsigned tg = og / nx;
            if (og + 1u == (tg + 1u) * nx) xb_add(&bar[XB_TOPGEN], 1u);
            else XB_SPIN(xb_ld(&bar[XB_TOPGEN]) == tg, bar);
            __builtin_amdgcn_fence(__ATOMIC_ACQUIRE, "agent");
            xb_add(&bar[XB_XGEN(b.x)], 1u);
            asm volatile("s_waitcnt vmcnt(0)" ::: "memory");
        } else {
            XB_SPIN(xb_ld(&bar[XB_XGEN(b.x)]) == gen, bar);
            __builtin_amdgcn_fence(__ATOMIC_ACQUIRE, "agent");
            asm volatile("s_waitcnt vmcnt(0)" ::: "memory");
        }
    }
    __syncthreads();
}

__global__ void __launch_bounds__(NTHREADS, 2) fwd_kernel(Params P) {
    __shared__ __attribute__((aligned(16))) unsigned char lds_raw[LDS_BYTES];
    LAS unsigned char* lds = (LAS unsigned char*)lds_raw;
    const int tid = threadIdx.x, bid = blockIdx.x, G = gridDim.x;
    unsigned char* ws = P.ws;
    const int lo = P.ph_lo, hi = P.ph_hi;
#ifndef ONLY_PHASE
#define ONLY_PHASE -1
#endif
#define IN(k) ((ONLY_PHASE < 0 || ONLY_PHASE == (k)) && lo <= (k) && (k) < hi)
#define SEAM(k) do { if (IN(k) && IN((k) + 1)) { xcd_barrier(xbar); } } while (0)
    XcdBarrier xbar; xbar.bar = (unsigned*)(ws + WS_BAR); xbar.x = 0; xbar.st = (volatile LAS unsigned*)(lds + LDS_BYTES - 1024 + 16);
    if (hi - lo > 1) {
        if (tid == 0) { xbar.st[0] = 0u; xbar.st[1] = 0u; }
        __syncthreads();
        xbar = xcd_barrier_post((unsigned*)(ws + WS_BAR), (volatile LAS unsigned*)(lds + LDS_BYTES - 1024 + 16));
    }
    LAS int* misc = (LAS int*)(lds + LDS_BYTES - 1024);
    if (hi - lo > 1) {
        if (tid == 0) { const unsigned xcc = xb_xcc_id() & 7u; misc[8] = (int)xcc; misc[9] = (int)xb_add((unsigned*)(ws + WS_CTL) + 32 + 32 * xcc, 1u); }
    }
    int vbid = bid;
    f16* acta = (f16*)(ws + WS_ACTA); f16* Gb = (f16*)(ws + WS_G);
    float* ss0 = (float*)(ws + WS_SS0); float* ss1 = (float*)(ws + WS_SS1); float* ss2 = (float*)(ws + WS_SS2); float* ss3 = (float*)(ws + WS_SS3);
    if (IN(0)) { p0_prologue(P, lds); }
    SEAM(0);
    if (hi - lo > 1 && (G & 7) == 0) {
        if (tid == 0) { bool ok = true; for (int j = 0; j < 8; ++j) ok = ok && (xb_ld((unsigned*)(ws + WS_CTL) + 32 + 32 * j) == (unsigned)(G >> 3)); misc[10] = ok ? misc[9] * 8 + misc[8] : bid; }
        __syncthreads();
        vbid = __builtin_amdgcn_readfirstlane(misc[10]);
        __syncthreads();
    }
    if (IN(1)) {
        pg8::Gemm g{acta, (const f16*)(ws + WS_WGU1), MP, 2 * DFF, D}; pg8::StaticOrder S; S.init(MP, 2 * DFF, G, vbid);
        EpiSwiglu E{Gb, ss0, 1}; pg8::gemm_phase(lds, g, S, E);
    }
    SEAM(1);
    if (IN(2)) {
        meta_down(P, lds);
        pg8::Gemm g{Gb, (const f16*)(ws + WS_WD1), SEQ, D, DFF}; pg8::StaticOrder S; S.init(SEQ, D, G, vbid);
        EpiResid<true> E{acta, (f16*)P.out, ss1, 0.5f}; pg8::gemm_phase(lds, g, S, E);
    }
    SEAM(2);
    if (IN(3)) {
        pg8::Gemm g{(const f16*)P.out, (const f16*)(ws + WS_WIN), MP, NIN, D}; pg8::StaticOrder S; S.init(MP, NIN, G, vbid);
        EpiInProj E{ss1, (const f32x2*)(ws + WS_ROPE), ws};
        pg8::gemm_phase(lds, g, S, E);
    }
    SEAM(3);
    if (IN(4)) {
        for (int u = bid; u < NCH * 4; u += G) gla_a_unit(P, u, lds);
        {
            int tbase = 0, cursor = bid; LAS f16* tl = (LAS f16*)lds;
            prep_weight(P, 3, D, D, (f16*)(ws + WS_WOUT), cursor, tbase, tl);
            prep_weight(P, 4, 2 * DFF, D, (f16*)(ws + WS_WGU2), cursor, tbase, tl);
            prep_weight(P, 5, D, DFF, (f16*)(ws + WS_WD2), cursor, tbase, tl);
        }
    }
    SEAM(4);
    if (IN(5)) {
        if (bid < 64) gla_scan(P);
        unsigned* ctr = (unsigned*)(ws + WS_CTL); LAS int* bc = (LAS int*)(lds + LDS_BYTES - 1024);
        for (;;) {
            if (tid == 0) bc[0] = (int)atomicAdd(ctr, 1u);
            __syncthreads();
            const int k = bc[0];
            __syncthreads();
            if (k >= 513) break;
            indexer_tile(P, 512 - k, lds);
        }
    }
    SEAM(5);
    if (IN(6)) { for (int u = bid; u < NCH * 4; u += G) gla_c_unit(P, u, lds); sparse_attn(P, lds, vbid); }
    SEAM(6);
    if (IN(7)) {
        pg8::Gemm g{acta, (const f16*)(ws + WS_WOUT), SEQ, D, D}; pg8::StaticOrder S; S.init(SEQ, D, G, vbid);
        EpiResid<true> E{P.out, (f16*)(ws + WS_US), ss2, 1.0f}; pg8::gemm_phase(lds, g, S, E);
    }
    SEAM(7);
    if (IN(8)) {
        pg8::Gemm g{(const f16*)(ws + WS_US), (const f16*)(ws + WS_WGU2), SEQ, 2 * DFF, D}; pg8::StaticOrder S; S.init(SEQ, 2 * DFF, G, vbid);
        EpiSwiglu E{Gb, ss2, 16}; pg8::gemm_phase(lds, g, S, E);
    }
    SEAM(8);
    if (IN(9)) {
        pg8::Gemm g{Gb, (const f16*)(ws + WS_WD2), SEQ, D, DFF}; pg8::StaticOrder S; S.init(SEQ, D, G, vbid);
        EpiResid<true> E{ws + WS_US, acta, ss3, 0.5f}; pg8::gemm_phase(lds, g, S, E);
    }
    SEAM(9);
    if (IN(10)) final_norm(P);
#undef IN
#undef SEAM
}

extern "C" void kernel_launch(void* const* d_in, const int* in_sizes, int n_in, void* d_out, int out_size, void* d_ws, size_t ws_size, hipStream_t stream) {
    static int grid = 0;
    if (grid == 0) {
        if (n_in != 17 || in_sizes[0] != SEQ * D || out_size != SEQ * D || ws_size < WS_END) { fprintf(stderr, "kernel_launch: unexpected shapes (n_in %d, in0 %d, out %d, ws %zu, need %zu)\n", n_in, n_in > 0 ? in_sizes[0] : -1, out_size, ws_size, (size_t)WS_END); grid = -1; return; }
        int dev = 0, cus = 0, per_cu = 0;
        (void)hipGetDevice(&dev); (void)hipDeviceGetAttribute(&cus, hipDeviceAttributeMultiprocessorCount, dev);
        if (hipOccupancyMaxActiveBlocksPerMultiprocessor(&per_cu, (const void*)fwd_kernel, NTHREADS, 0) != hipSuccess || per_cu < 1) { fprintf(stderr, "kernel_launch: occupancy query says %d blocks per CU\n", per_cu); per_cu = 1; }
        (void)hipGetLastError();
        grid = cus;
        if (grid % 8 != 0 || grid < 64) { fprintf(stderr, "kernel_launch: unexpected CU count %d\n", cus); }
    }
    if (grid < 0) return;
    if (hipMemsetAsync((char*)d_ws + WS_CTL, 0, CTL_BYTES, stream) != hipSuccess) { fprintf(stderr, "kernel_launch: memset failed\n"); return; }
    Params p{};
    const float** pp = (const float**)&p;
    for (int i = 0; i < 17; ++i) pp[i] = (const float*)d_in[i];
    p.out = (float*)d_out; p.ws = (unsigned char*)d_ws;
#if MODE == 0
    for (int ph = 0; ph < NPHASE; ++ph) { p.ph_lo = ph; p.ph_hi = ph + 1; hipLaunchKernelGGL(fwd_kernel, dim3(grid), dim3(NTHREADS), 0, stream, p); }
#else
    p.ph_lo = 0; p.ph_hi = NPHASE;
    void* args[] = {&p};
    hipError_t e = hipLaunchCooperativeKernel((const void*)fwd_kernel, dim3(grid), dim3(NTHREADS), args, 0, stream);
    if (e != hipSuccess) fprintf(stderr, "cooperative launch failed: %s (grid %d)\n", hipGetErrorString(e), grid);
#endif
}
```

```cpp
#include <hip/hip_runtime.h>
#include <cstdio>
#include <cstdint>

#ifndef MODE
#define MODE 1
#endif

#define LAS __attribute__((address_space(3)))
typedef _Float16 f16;
typedef _Float16 half8 __attribute__((ext_vector_type(8)));
typedef _Float16 half4 __attribute__((ext_vector_type(4)));
typedef float f32x2 __attribute__((ext_vector_type(2)));
typedef float f32x4 __attribute__((ext_vector_type(4)));
typedef float f32x16 __attribute__((ext_vector_type(16)));
typedef unsigned u32x2 __attribute__((ext_vector_type(2)));
typedef unsigned u32x4 __attribute__((ext_vector_type(4)));

constexpr int D = 1024, SEQ = 16384, NMETA = 16, L = SEQ + NMETA, DFF = 2816;
constexpr int MP = 16640;
constexpr int LP = 16512;
constexpr int NIN = 3840;
constexpr int NCH = 257;
constexpr float EPS = 1e-6f;
constexpr int NTHREADS = 512;
constexpr int LDS_BYTES = 155648 + 1024;
constexpr int NPHASE = 11;

constexpr size_t al256(size_t x) { return (x + 255) & ~(size_t)255; }
constexpr size_t WS_CTL = 0;
constexpr size_t CTL_BYTES = 32768;
constexpr size_t WS_BAR = 2048;
constexpr size_t WS_WGU1 = CTL_BYTES;
constexpr size_t WS_WD1 = WS_WGU1 + (size_t)2 * DFF * D * 2;
constexpr size_t WS_WIN = WS_WD1 + (size_t)D * DFF * 2;
constexpr size_t WS_WOUT = WS_WIN + (size_t)NIN * D * 2;
constexpr size_t WS_WGU2 = WS_WOUT + (size_t)D * D * 2;
constexpr size_t WS_WD2 = WS_WGU2 + (size_t)2 * DFF * D * 2;
constexpr size_t WS_ACTA = WS_WD2 + (size_t)D * DFF * 2;
constexpr size_t WS_G = WS_ACTA + (size_t)MP * D * 2;
constexpr size_t WS_US = WS_G + (size_t)MP * DFF * 2;
constexpr size_t WS_DQ = WS_US + (size_t)NCH * 4 * 64 * 128 * 4;
constexpr size_t WS_IQ = WS_DQ + (size_t)LP * 512 * 2;
constexpr size_t WS_SEL = WS_IQ + (size_t)LP * 512 * 2;
constexpr size_t WS_ROPE = WS_SEL + (size_t)LP * 256 * 2;
constexpr size_t WS_IW = WS_ROPE + al256((size_t)L * 32 * 8);
constexpr size_t WS_GA = WS_IW + (size_t)LP * 8 * 4;
constexpr size_t WS_DECAY = WS_GA + (size_t)LP * 16 * 4;
constexpr size_t WS_SS0 = WS_DECAY + al256((size_t)NCH * 256 * 4);
constexpr size_t WS_SS1 = WS_SS0 + (size_t)MP * 4;
constexpr size_t WS_SS2 = WS_SS1 + (size_t)MP * 64;
constexpr size_t WS_SS3 = WS_SS2 + (size_t)MP * 64;
constexpr size_t WS_END = WS_SS3 + (size_t)MP * 64;
constexpr size_t WS_KV = WS_G;
constexpr size_t WS_GQ = WS_KV + (size_t)8 * LP * 128 * 2;
constexpr size_t WS_GK = WS_GQ + (size_t)LP * 256 * 2;
constexpr size_t WS_GV = WS_GK + (size_t)LP * 256 * 2;
constexpr size_t WS_GR = WS_GV + (size_t)LP * 512 * 2;
constexpr size_t WS_IK = WS_GR + (size_t)LP * 512 * 2;
constexpr size_t WS_ALIAS_END = WS_IK + (size_t)LP * 64 * 2;
static_assert(WS_ALIAS_END <= WS_US, "aliased buffers exceed G");
static_assert(WS_END <= (size_t)256 * 1024 * 1024, "workspace exceeds 256 MiB");
static_assert((size_t)SEQ * D * 2 <= (size_t)NCH * 4 * 64 * 128 * 4, "h2_16 alias");

struct Params {
    const float* x; const float* meta; const float* n1; const float* wg1; const float* wu1; const float* wd1;
    const float* nmix; const float* win; const float* wa2; const float* ba; const float* hn; const float* wout;
    const float* n2; const float* wg2; const float* wu2; const float* wd2; const float* nf;
    float* out; unsigned char* ws; int ph_lo, ph_hi;
};

namespace pg8 {
constexpr int BM = 256, BK = 64, HALF = 128, HTB = HALF * BK * 2, STAGE_BYTES = 8 * HTB, NXCD = 8, WGM = 8;
__host__ __device__ __forceinline__ int lds_byte(int r, int c) { const int st = (r >> 4) * 2 + (c >> 5), rr = r & 15, cc = c & 31, ob = rr * 64 + cc * 2; return st * 1024 + (ob ^ (((ob >> 9) & 1) << 5)); }
__host__ __device__ __forceinline__ int perm32(int rho) { const int n = rho >> 4, i = rho & 15; return 8 * (i >> 2) + 4 * n + (i & 3); }
__host__ __device__ __forceinline__ void stage_rc(int b, int& R, int& C) { const int st = b / 1024, sb = b % 1024, swz = sb ^ (((sb >> 9) & 1) << 5); R = (st >> 1) * 16 + swz / 64; C = (st & 1) * 32 + (swz % 64) / 2; }
struct Unit { int pm, pn; };
struct Gemm { const f16* A; const f16* Bt; int M, N, K; };
struct StaticOrder {
    int nM, nN, nwg, G, c;
    __host__ __device__ void init(int M, int N, int G_, int c_) { nM = M / BM; nN = N / BM; nwg = nM * nN; G = G_; c = c_; }
    __host__ __device__ bool next(int i, Unit& u) const {
        const long Lx = (long)i * G + c; if (Lx >= nwg) return false;
        int wgid = (int)Lx; { const int q = nwg / NXCD, r = nwg % NXCD, xcd = wgid % NXCD, off = wgid / NXCD; wgid = (xcd < r ? xcd * (q + 1) : r * (q + 1) + (xcd - r) * q) + off; }
        const int nig = WGM * nN, gid = wgid / nig, fm = gid * WGM, gsz = (nM - fm) < WGM ? (nM - fm) : WGM;
        u.pm = fm + ((wgid % nig) % gsz); u.pn = (wgid % nig) / gsz; return true;
    }
};
template <class Epi>
__device__ __forceinline__ void gemm_phase(LAS unsigned char* lds, const Gemm g, const StaticOrder& S, const Epi& E) {
    int tid_ = threadIdx.x; asm volatile("" : "+v"(tid_));
    const int tid = tid_, wid = __builtin_amdgcn_readfirstlane(tid >> 6), lane = tid & 63, wr = wid >> 2, wc = wid & 3, fr = lane & 15, fq = lane >> 4;
    const int K = g.K, nt = K / BK;
    unsigned voffA[2], voffB[2];
#pragma unroll
    for (int i = 0; i < 2; ++i) { int R, C; stage_rc(tid * 16 + i * 8192, R, C); const int Rb = (R & ~31) + perm32(R & 31); voffA[i] = (unsigned)(R * K + C) * 2u; voffB[i] = (unsigned)(Rb * K + C) * 2u; }
    const size_t kstep = (size_t)(BK * 2);
    const size_t hstep = (size_t)HALF * K * 2;
    const size_t tstep = 2 * hstep;
    const unsigned ldsw = (unsigned)wid * 1024u;
    const int aoff = lds_byte(wr * 64 + fr, fq * 8), boff = lds_byte(wc * 32 + fr, fq * 8);
#define PG8_SA(b, h) (((b) * 2 + (h)) * HTB)
#define PG8_SB(b, h) ((4 + (b) * 2 + (h)) * HTB)
#define PG8_STAGE(bufoff, gbase, voff) do { _Pragma("unroll") for (int _i = 0; _i < 2; ++_i) \
        __builtin_amdgcn_global_load_lds((const unsigned*)((const char*)(gbase) + (voff)[_i]), (LAS unsigned*)(lds + (bufoff) + ldsw + _i * 8192), 16, 0, 0); } while (0)
#define PG8_LDA(dst, b, h) do { _Pragma("unroll") for (int m = 0; m < 4; ++m) _Pragma("unroll") for (int k = 0; k < 2; ++k) dst[m][k] = *(const LAS half8*)(lds + PG8_SA(b, h) + aoff + m * 2048 + k * 1024); } while (0)
#define PG8_LDB(dst, b, h) do { _Pragma("unroll") for (int n = 0; n < 2; ++n) _Pragma("unroll") for (int k = 0; k < 2; ++k) dst[n][k] = *(const LAS half8*)(lds + PG8_SB(b, h) + boff + n * 2048 + k * 1024); } while (0)
#define PG8_MMA(ai, bj, At, Bt) do { __builtin_amdgcn_s_setprio(1); _Pragma("unroll") for (int m = 0; m < 4; ++m) _Pragma("unroll") for (int n = 0; n < 2; ++n) _Pragma("unroll") for (int k = 0; k < 2; ++k) \
        acc[ai][bj][m][n] = __builtin_amdgcn_mfma_f32_16x16x32_f16(Bt[n][k], At[m][k], acc[ai][bj][m][n], 0, 0, 0); __builtin_amdgcn_s_setprio(0); } while (0)
#define PG8_WAIT_V(n) asm volatile("s_waitcnt vmcnt(" #n ")" ::: "memory")
#define PG8_WAIT_L(n) asm volatile("s_waitcnt lgkmcnt(" #n ")" ::: "memory")
#define PG8_BAR __builtin_amdgcn_s_barrier()
#define PG8_SCHED __builtin_amdgcn_sched_barrier(0)
    Unit cur, nxt; int ui = 0;
    if (!S.next(0, cur)) return;
    f32x4 acc[2][2][4][2];
#pragma unroll
    for (int a = 0; a < 2; ++a)
#pragma unroll
        for (int b = 0; b < 2; ++b)
#pragma unroll
            for (int m = 0; m < 4; ++m)
#pragma unroll
                for (int n = 0; n < 2; ++n) acc[a][b][m][n] = (f32x4){0.f, 0.f, 0.f, 0.f};
    half8 At[4][2], B0[2][2], B1[2][2];
    const char* cA = (const char*)g.A + (size_t)cur.pm * tstep; const char* cB = (const char*)g.Bt + (size_t)cur.pn * tstep;
    PG8_STAGE(PG8_SB(0, 0), cB, voffB); PG8_STAGE(PG8_SA(0, 0), cA, voffA); PG8_STAGE(PG8_SB(0, 1), cB + hstep, voffB); PG8_STAGE(PG8_SA(0, 1), cA + hstep, voffA);
    if (wr == 1) PG8_BAR;
    PG8_WAIT_V(4); PG8_BAR;
    PG8_STAGE(PG8_SB(1, 0), cB + kstep, voffB); PG8_STAGE(PG8_SA(1, 0), cA + kstep, voffA); PG8_STAGE(PG8_SB(1, 1), cB + hstep + kstep, voffB);
    PG8_WAIT_V(6); PG8_BAR;
    for (;;) {
        const bool has_next = S.next(ui + 1, nxt);
        const char* nA = has_next ? (const char*)g.A + (size_t)nxt.pm * tstep : cA; const char* nB = has_next ? (const char*)g.Bt + (size_t)nxt.pn * tstep : cB;
        for (int t = 0; t < nt; t += 2) {
            const bool last = (t == nt - 2);
            const char* a1 = cA + (size_t)(t + 1) * kstep;
            const char* a2 = last ? nA : cA + (size_t)(t + 2) * kstep; const char* b2 = last ? nB : cB + (size_t)(t + 2) * kstep;
            const char* a3 = a2 + kstep; const char* b3 = b2 + kstep;
            PG8_LDB(B0, 0, 0); PG8_SCHED; PG8_LDA(At, 0, 0); PG8_STAGE(PG8_SA(1, 1), a1 + hstep, voffA);
            PG8_WAIT_L(8); PG8_BAR; PG8_WAIT_L(0); PG8_MMA(0, 0, At, B0); PG8_BAR; PG8_SCHED;
            PG8_LDB(B1, 0, 1); PG8_STAGE(PG8_SB(0, 0), b2, voffB);
            PG8_BAR; PG8_WAIT_L(0); PG8_MMA(0, 1, At, B1); PG8_BAR;
            PG8_LDA(At, 0, 1); PG8_STAGE(PG8_SA(0, 0), a2, voffA);
            PG8_BAR; PG8_WAIT_L(0); PG8_MMA(1, 0, At, B0); PG8_BAR; PG8_SCHED;
            PG8_STAGE(PG8_SB(0, 1), b2 + hstep, voffB);
            PG8_WAIT_V(6); PG8_BAR; PG8_MMA(1, 1, At, B1); PG8_BAR;
            PG8_LDB(B0, 1, 0); PG8_SCHED; PG8_LDA(At, 1, 0); PG8_STAGE(PG8_SA(0, 1), a2 + hstep, voffA);
            PG8_WAIT_L(8); PG8_BAR; PG8_WAIT_L(0); PG8_MMA(0, 0, At, B0); PG8_BAR; PG8_SCHED;
            PG8_LDB(B1, 1, 1); PG8_STAGE(PG8_SB(1, 0), b3, voffB);
            PG8_BAR; PG8_WAIT_L(0); PG8_MMA(0, 1, At, B1); PG8_BAR;
            PG8_LDA(At, 1, 1); PG8_STAGE(PG8_SA(1, 0), a3, voffA);
            PG8_BAR; PG8_WAIT_L(0); PG8_MMA(1, 0, At, B0); PG8_BAR; PG8_SCHED;
            PG8_STAGE(PG8_SB(1, 1), b3 + hstep, voffB);
            PG8_WAIT_V(6); PG8_BAR; PG8_MMA(1, 1, At, B1); PG8_BAR;
        }
        E(acc, cur, wr, wc, fr, fq);
        if (!has_next) break;
#pragma unroll
        for (int a = 0; a < 2; ++a)
#pragma unroll
            for (int b = 0; b < 2; ++b)
#pragma unroll
                for (int m = 0; m < 4; ++m)
#pragma unroll
                    for (int n = 0; n < 2; ++n) acc[a][b][m][n] = (f32x4){0.f, 0.f, 0.f, 0.f};
        cur = nxt; cA = nA; cB = nB; ++ui;
    }
    PG8_WAIT_V(0);
    if (wr == 0) PG8_BAR;
    PG8_BAR;
#undef PG8_SA
#undef PG8_SB
#undef PG8_STAGE
#undef PG8_LDA
#undef PG8_LDB
#undef PG8_MMA
#undef PG8_WAIT_V
#undef PG8_WAIT_L
#undef PG8_BAR
#undef PG8_SCHED
}
}

__device__ __forceinline__ float silu_f(float v) { return v * __builtin_amdgcn_rcpf(1.0f + __expf(-v)); }
__device__ __forceinline__ half4 to_half4(f32x4 v) { half4 h; h[0] = (f16)v[0]; h[1] = (f16)v[1]; h[2] = (f16)v[2]; h[3] = (f16)v[3]; return h; }

__device__ __forceinline__ float row_rstd(const float* ss, int np, int row) {
    float s;
    if (np == 1) s = ss[row];
    else { const f32x4* p = (const f32x4*)(ss + (size_t)row * 16); const f32x4 a = p[0], b = p[1], c = p[2], d = p[3];
        s = (((a[0] + a[1]) + (a[2] + a[3])) + ((b[0] + b[1]) + (b[2] + b[3]))) + (((c[0] + c[1]) + (c[2] + c[3])) + ((d[0] + d[1]) + (d[2] + d[3]))); }
    return rsqrtf(s * (1.0f / D) + EPS);
}
struct EpiSwiglu {
    f16* G; const float* ss; int np;
    __device__ __forceinline__ void operator()(const f32x4 (&acc)[2][2][4][2], const pg8::Unit& u, int wr, int wc, int fr_, int fq_) const {
        int fr = fr_, fq = fq_; asm volatile("" : "+v"(fr), "+v"(fq));
#pragma unroll
        for (int ai = 0; ai < 2; ++ai)
#pragma unroll
            for (int m = 0; m < 4; ++m) {
                const int row = u.pm * 256 + ai * 128 + wr * 64 + m * 16 + fr;
                const float rs = row_rstd(ss, np, row), ce = -1.4426950408889634f * rs, rs2 = rs * rs; half8 o;
#pragma unroll
                for (int n = 0; n < 2; ++n) {
                    const f32x4 g = acc[ai][0][m][n], u = acc[ai][1][m][n]; const f32x4 t = g * ce; f32x4 e, r;
#pragma unroll
                    for (int j = 0; j < 4; ++j) e[j] = __builtin_amdgcn_exp2f(t[j]);
                    const f32x4 d = e + 1.0f;
#pragma unroll
                    for (int j = 0; j < 4; ++j) r[j] = __builtin_amdgcn_rcpf(d[j]);
                    const f32x4 w = (g * u) * (r * rs2);
#pragma unroll
                    for (int j = 0; j < 4; ++j) o[4 * n + j] = (f16)w[j];
                }
                *(half8*)(G + (size_t)row * DFF + u.pn * 128 + wc * 32 + 8 * fq) = o;
            }
    }
};
template <bool SRC16> struct EpiResid {
    const void* src; f16* h16; float* ss; float alpha;
    __device__ __forceinline__ void operator()(const f32x4 (&acc)[2][2][4][2], const pg8::Unit& u, int wr, int wc, int fr_, int fq_) const {
        int fr = fr_, fq = fq_; asm volatile("" : "+v"(fr), "+v"(fq));
#pragma unroll
        for (int ai = 0; ai < 2; ++ai)
#pragma unroll
            for (int m = 0; m < 4; ++m) {
                const int row = u.pm * 256 + ai * 128 + wr * 64 + m * 16 + fr; float part = 0.f;
#pragma unroll
                for (int bj = 0; bj < 2; ++bj) {
                    const size_t off = (size_t)row * D + u.pn * 256 + bj * 128 + wc * 32 + 8 * fq; half8 h; f32x4 sv[2];
                    if (SRC16) { const half8 s8 = *(const half8*)((const f16*)src + off);
#pragma unroll
                        for (int j = 0; j < 4; ++j) { sv[0][j] = (float)s8[j]; sv[1][j] = (float)s8[4 + j]; } }
                    else { sv[0] = *(const f32x4*)((const float*)src + off); sv[1] = *(const f32x4*)((const float*)src + off + 4); }
#pragma unroll
                    for (int n = 0; n < 2; ++n) {
                        const f32x4 o = sv[n] + alpha * acc[ai][bj][m][n];
#pragma unroll
                        for (int j = 0; j < 4; ++j) h[4 * n + j] = (f16)o[j];
                        part += (o[0] * o[0] + o[1] * o[1]) + (o[2] * o[2] + o[3] * o[3]);
                    }
                    *(half8*)(h16 + off) = h;
                }
                part += __shfl_xor(part, 16); part += __shfl_xor(part, 32);
                if (fq == 0) ss[(size_t)row * 16 + u.pn * 4 + wc] = part;
            }
    }
};
constexpr float K_I8_SCALE = 127.0f / 8.0f;
__device__ __forceinline__ void rope8(const f32x4 (&x1)[2], const f32x4 (&x2)[2], const f32x2* rp, float sc, float (&o1)[8], float (&o2)[8]) {
#pragma unroll
    for (int n = 0; n < 2; ++n) {
        const f32x4 cs0 = *(const f32x4*)(rp + 4 * n), cs1 = *(const f32x4*)(rp + 4 * n + 2);
        o1[4 * n + 0] = (x1[n][0] * cs0[0] - x2[n][0] * cs0[1]) * sc; o2[4 * n + 0] = (x2[n][0] * cs0[0] + x1[n][0] * cs0[1]) * sc;
        o1[4 * n + 1] = (x1[n][1] * cs0[2] - x2[n][1] * cs0[3]) * sc; o2[4 * n + 1] = (x2[n][1] * cs0[2] + x1[n][1] * cs0[3]) * sc;
        o1[4 * n + 2] = (x1[n][2] * cs1[0] - x2[n][2] * cs1[1]) * sc; o2[4 * n + 2] = (x2[n][2] * cs1[0] + x1[n][2] * cs1[1]) * sc;
        o1[4 * n + 3] = (x1[n][3] * cs1[2] - x2[n][3] * cs1[3]) * sc; o2[4 * n + 3] = (x2[n][3] * cs1[2] + x1[n][3] * cs1[3]) * sc;
    }
}
__device__ __forceinline__ u32x2 pack_i8x8(const float (&v)[8]) {
    u32x2 r;
#pragma unroll
    for (int w = 0; w < 2; ++w) { unsigned word = 0u;
#pragma unroll
        for (int j = 0; j < 4; ++j) { const int q = (int)__builtin_rintf(fminf(fmaxf(v[4 * w + j] * K_I8_SCALE, -127.f), 127.f)); word |= ((unsigned)q & 0xffu) << (8 * j); }
        r[w] = word; }
    return r;
}
__device__ __forceinline__ u32x2 pack_bf8x8(const float (&v)[8]) {
    u32x2 r;
#pragma unroll
    for (int w = 0; w < 2; ++w) { int word = __builtin_amdgcn_cvt_pk_bf8_f32(v[4 * w], v[4 * w + 1], 0, false); word = __builtin_amdgcn_cvt_pk_bf8_f32(v[4 * w + 2], v[4 * w + 3], word, true); r[w] = (unsigned)word; }
    return r;
}
struct EpiInProj {
    const float* ss; const f32x2* rope; unsigned char* ws;
    __device__ __forceinline__ void operator()(const f32x4 (&acc)[2][2][4][2], const pg8::Unit& u, int wr, int wc, int fr_, int fq_) const {
        int fr = fr_, fq = fq_; asm volatile("" : "+v"(fr), "+v"(fq));
        const int pn = u.pn;
        if (pn >= 8 && pn <= 11) {
            unsigned char* lb = (pn <= 9) ? ws + WS_KV + (size_t)((pn - 8) * 4 + wc) * LP * 128 + 8 * fq
                                          : ws + WS_KV + (size_t)((pn - 10) * 4 + (wc >> 1)) * LP * 128 + 64 + (wc & 1) * 32 + 8 * fq;
#pragma unroll
            for (int ai = 0; ai < 2; ++ai)
#pragma unroll
                for (int m = 0; m < 4; ++m) {
                    const int p = u.pm * 256 + ai * 128 + wr * 64 + m * 16 + fr;
                    const int t = p < SEQ ? p + NMETA : p - SEQ;
                    if (p < L) {
                        const float sc = row_rstd(ss, 16, p);
                        if (pn <= 9) {
                            float o1[8], o2[8]; rope8(acc[ai][0][m], acc[ai][1][m], rope + (size_t)t * 32 + 8 * fq, sc, o1, o2);
                            unsigned char* d8 = lb + (size_t)t * 128; *(u32x2*)d8 = pack_i8x8(o1); *(u32x2*)(d8 + 32) = pack_i8x8(o2);
                        } else {
#pragma unroll
                            for (int bj = 0; bj < 2; ++bj) { float v[8];
#pragma unroll
                                for (int j = 0; j < 4; ++j) { v[j] = acc[ai][bj][m][0][j] * sc; v[4 + j] = acc[ai][bj][m][1][j] * sc; }
                                *(u32x2*)(lb + (size_t)t * 128 + (size_t)bj * 2 * LP * 128) = pack_bf8x8(v); }
                        }
                    }
                    asm volatile("" ::: "memory");
                }
            return;
        }
        int mode = 0, stride = 256; float scale = 1.0f; f16* lanebase;
        if (pn == 0) lanebase = (f16*)(ws + WS_GQ) + wc * 32 + 8 * fq;
        else if (pn == 1) lanebase = (f16*)(ws + WS_GK) + wc * 32 + 8 * fq;
        else if (pn <= 3) { lanebase = (f16*)(ws + WS_GV) + (pn - 2) * 256 + wc * 32 + 8 * fq; stride = 512; }
        else if (pn <= 5) { lanebase = (f16*)(ws + WS_GR) + (pn - 4) * 256 + wc * 32 + 8 * fq; stride = 512; }
        else if (pn <= 7) { lanebase = (f16*)(ws + WS_DQ); mode = 6; scale = 0.125f; }
        else if (pn <= 13) { lanebase = (f16*)(ws + WS_IQ) + (pn - 12) * 256 + wc * 64 + 8 * fq; stride = 512; mode = 1; scale = 0.125f; }
        else { lanebase = (f16*)(ws + WS_IK) + 8 * fq; stride = 64; mode = wc == 0 ? 1 : (wc == 1 ? 2 : 3); }
#pragma unroll
        for (int ai = 0; ai < 2; ++ai)
#pragma unroll
            for (int m = 0; m < 4; ++m) {
                const int p = u.pm * 256 + ai * 128 + wr * 64 + m * 16 + fr;
                const int t = p < SEQ ? p + NMETA : p - SEQ;
                if (p < L && mode != 3) {
                    const float rs = row_rstd(ss, 16, p);
                    if (mode == 6) {
                        float o1[8], o2[8]; rope8(acc[ai][0][m], acc[ai][1][m], rope + (size_t)t * 32 + 8 * fq, rs * scale, o1, o2);
                        float qm = 1e-20f;
#pragma unroll
                        for (int j = 0; j < 8; ++j) qm = fmaxf(qm, fmaxf(fabsf(o1[j]), fabsf(o2[j])));
                        qm = fmaxf(qm, __shfl_xor(qm, 16)); qm = fmaxf(qm, __shfl_xor(qm, 32));
                        const float qsc = 127.0f * __builtin_amdgcn_rcpf(qm); u32x2 w1, w2;
#pragma unroll
                        for (int w = 0; w < 2; ++w) { unsigned a = 0u, b = 0u;
#pragma unroll
                            for (int j = 0; j < 4; ++j) { a |= ((unsigned)(int)__builtin_rintf(o1[4 * w + j] * qsc) & 0xffu) << (8 * j); b |= ((unsigned)(int)__builtin_rintf(o2[4 * w + j] * qsc) & 0xffu) << (8 * j); }
                            w1[w] = a; w2[w] = b; }
                        const int head = (pn - 6) * 4 + wc; unsigned char* qrow = ws + WS_DQ + (size_t)t * 512 + head * 64 + 8 * fq;
                        *(u32x2*)qrow = w1; *(u32x2*)(qrow + 32) = w2;
                        if (fq == 0) ((float*)(ws + WS_DQ + (size_t)LP * 512))[(size_t)t * 8 + head] = qm * (1.0f / (127.0f * K_I8_SCALE));
                    } else if (mode == 1) {
                        float o1[8], o2[8]; rope8(acc[ai][0][m], acc[ai][1][m], rope + (size_t)t * 32 + 8 * fq, rs * scale, o1, o2);
                        half8 h1, h2;
#pragma unroll
                        for (int j = 0; j < 8; ++j) { h1[j] = (f16)o1[j]; h2[j] = (f16)o2[j]; }
                        f16* dst = lanebase + (size_t)t * stride; *(half8*)dst = h1; *(half8*)(dst + 32) = h2;
                    } else if (mode == 2) {
                        if (fq < 2) { float* gp = (float*)(ws + WS_GA) + (size_t)t * 16 + 8 * fq; *(f32x4*)gp = acc[ai][0][m][0] * rs; *(f32x4*)(gp + 4) = acc[ai][0][m][1] * rs; }
                        else if (fq == 2) { float* ip = (float*)(ws + WS_IW) + (size_t)t * 8; const float r2 = rs * 0.35355339059327373f; *(f32x4*)ip = acc[ai][0][m][0] * r2; *(f32x4*)(ip + 4) = acc[ai][0][m][1] * r2; }
                    } else {
#pragma unroll
                        for (int bj = 0; bj < 2; ++bj) { half8 h;
#pragma unroll
                            for (int j = 0; j < 4; ++j) { h[j] = (f16)(acc[ai][bj][m][0][j] * rs); h[4 + j] = (f16)(acc[ai][bj][m][1][j] * rs); }
                            *(half8*)(lanebase + (size_t)t * stride + bj * 128) = h; }
                    }
                }
                asm volatile("" ::: "memory");
            }
    }
};

__device__ __forceinline__ const float* w_src(const Params& P, int kind, int n, int& ld, const float*& gain) {
    switch (kind) {
    case 0: case 4: { const int pn = n >> 8, bj = (n >> 7) & 1, cc = n & 127; ld = DFF; gain = kind == 0 ? P.n1 : P.n2;
        const float* w = kind == 0 ? (bj ? P.wu1 : P.wg1) : (bj ? P.wu2 : P.wg2); return w + pn * 128 + cc; }
    case 1: ld = D; gain = nullptr; return P.wd1 + n;
    case 5: ld = D; gain = nullptr; return P.wd2 + n;
    case 3: ld = D; gain = nullptr; return P.wout + n;
    default: { ld = 3672; gain = P.nmix; const int pn = n >> 8, c = n & 255, bj = c >> 7, hh = (c >> 5) & 3, dd = c & 31; int j;
        if (pn == 0) j = c; else if (pn == 1) j = 256 + c; else if (pn <= 3) j = 512 + (pn - 2) * 256 + c; else if (pn <= 5) j = 1024 + (pn - 4) * 256 + c;
        else if (pn <= 7) j = 1552 + (pn - 6) * 256 + hh * 64 + bj * 32 + dd;
        else if (pn <= 9) j = 2064 + (pn - 8) * 256 + hh * 64 + bj * 32 + dd;
        else if (pn <= 11) j = 2576 + (pn - 10) * 256 + c;
        else if (pn <= 13) j = 3088 + (pn - 12) * 256 + hh * 64 + bj * 32 + dd;
        else { if (c < 32) j = 3600 + c; else if (c < 48) j = 1536 + (c - 32); else if (c < 56) j = 3664 + (c - 48); else if (c >= 128 && c < 160) j = 3600 + 32 + (c - 128); else j = -1; }
        return j < 0 ? nullptr : P.win + j; }
    }
}
__device__ __forceinline__ void prep_weight(const Params& P, const int kind, const int N, const int K, f16* dst, int& cursor, int& tbase, LAS f16* tl) {
    const int tid = threadIdx.x, G = gridDim.x, tn = N / 64, tk = K / 256, ntile = tn * tk;
    const int n = tid & 63, kk0 = tid >> 6;
    float v[32], vn[32];
#define PREP_LOAD(dstv, tI) do { const int n0_ = ((tI) % tn) * 64, k0_ = ((tI) / tn) * 256; int ld; const float* gain; const float* col = w_src(P, kind, n0_ + n, ld, gain); \
        _Pragma("unroll") for (int i = 0; i < 32; ++i) dstv[i] = col ? col[(size_t)(k0_ + kk0 + 8 * i) * ld] : 0.f; \
        if (gain) { _Pragma("unroll") for (int i = 0; i < 32; ++i) dstv[i] *= gain[k0_ + kk0 + 8 * i]; } } while (0)
    if (cursor < tbase + ntile) PREP_LOAD(v, cursor - tbase);
#pragma unroll 1
    for (; cursor < tbase + ntile; cursor += G) {
        const int tI = cursor - tbase, n0 = (tI % tn) * 64, k0 = (tI / tn) * 256;
        const bool more = cursor + G < tbase + ntile;
        if (more) PREP_LOAD(vn, tI + G);
#pragma unroll
        for (int i = 0; i < 32; ++i) tl[n * 264 + kk0 + 8 * i] = (f16)v[i];
        __syncthreads();
        { const int nr = tid >> 3, seg = tid & 7;
#pragma unroll
          for (int j = 0; j < 4; ++j) *(half8*)(dst + (size_t)(n0 + nr) * K + k0 + (seg + 8 * j) * 8) = *(const LAS half8*)(tl + nr * 264 + (seg + 8 * j) * 8); }
        __syncthreads();
        if (more) {
#pragma unroll
            for (int i = 0; i < 32; ++i) v[i] = vn[i];
        }
    }
#undef PREP_LOAD
    tbase += ntile;
}
__device__ __forceinline__ void p0_prologue(const Params& P, LAS unsigned char* lds) {
    const int tid = threadIdx.x, bid = blockIdx.x, G = gridDim.x, lane = tid & 63;
    unsigned char* ws = P.ws;
    int tbase = 0, cursor = bid;
    LAS f16* tl = (LAS f16*)lds;
    prep_weight(P, 0, 2 * DFF, D, (f16*)(ws + WS_WGU1), cursor, tbase, tl);
    prep_weight(P, 1, D, DFF, (f16*)(ws + WS_WD1), cursor, tbase, tl);
    prep_weight(P, 2, NIN, D, (f16*)(ws + WS_WIN), cursor, tbase, tl);
    float* ss0 = (float*)(ws + WS_SS0);
    f16* acta = (f16*)(ws + WS_ACTA);
    const int gw = bid * 8 + (tid >> 6), nw = G * 8;
    for (int p = gw; p < L; p += nw) {
        const float* src = p < SEQ ? P.x + (size_t)p * D : P.meta + (size_t)(p - SEQ) * D; float s = 0.f;
#pragma unroll
        for (int i = 0; i < 4; ++i) { const f32x4 v = *(const f32x4*)(src + lane * 4 + 256 * i); s += (v[0] * v[0] + v[1] * v[1]) + (v[2] * v[2] + v[3] * v[3]); *(half4*)(acta + (size_t)p * D + lane * 4 + 256 * i) = to_half4(v); }
#pragma unroll
        for (int o = 32; o >= 1; o >>= 1) s += __shfl_xor(s, o);
        if (lane == 0) ss0[p] = s;
    }
    const int gt = bid * NTHREADS + tid, ngt = G * NTHREADS;
    for (int i = gt; i < MP; i += ngt) { if (i >= L) ss0[i] = (float)D; }
    f32x2* rope = (f32x2*)(ws + WS_ROPE);
    for (int i = gt; i < L * 32; i += ngt) { const int t = i >> 5, f = i & 31; const double inv = exp(-(double)f * (9.210340371976184 / 32.0)); double sn, cs; sincos((double)t * inv, &sn, &cs); rope[i] = (f32x2){(float)cs, (float)sn}; }
}

__device__ __forceinline__ void meta_down(const Params& P, LAS unsigned char* lds) {
    const int tid = threadIdx.x, lane = tid & 63, wid = tid >> 6;
    const f16* Gm = (const f16*)(P.ws + WS_G) + (size_t)SEQ * DFF; const f16* Wt = (const f16*)(P.ws + WS_WD1);
    f16* acta = (f16*)P.out; float* ss1 = (float*)(P.ws + WS_SS1); LAS float* slot = (LAS float*)lds;
    for (int task = blockIdx.x; task < NMETA * 16; task += gridDim.x) {
        const int r = task >> 4, cg = task & 15; float part = 0.f;
#pragma unroll 1
        for (int q = 0; q < 2; ++q) {
            const int n0 = cg * 64 + (2 * wid + q) * 4; float a[4] = {0.f, 0.f, 0.f, 0.f};
            for (int kc = lane; kc < DFF / 8; kc += 64) {
                const half8 gv = *(const half8*)(Gm + (size_t)r * DFF + kc * 8);
#pragma unroll
                for (int j = 0; j < 4; ++j) { const half8 wv = *(const half8*)(Wt + (size_t)(n0 + j) * DFF + kc * 8);
#pragma unroll
                    for (int e = 0; e < 8; ++e) a[j] += (float)gv[e] * (float)wv[e]; }
            }
#pragma unroll
            for (int o = 32; o >= 1; o >>= 1) { a[0] += __shfl_xor(a[0], o); a[1] += __shfl_xor(a[1], o); a[2] += __shfl_xor(a[2], o); a[3] += __shfl_xor(a[3], o); }
            f32x4 o;
#pragma unroll
            for (int j = 0; j < 4; ++j) { o[j] = P.meta[r * D + n0 + j] + 0.5f * a[j]; part += o[j] * o[j]; }
            if (lane == 0) *(half4*)(acta + (size_t)(SEQ + r) * D + n0) = to_half4(o);
        }
        if (lane == 0) slot[wid] = part;
        __syncthreads();
        if (tid == 0) { float s = 0.f; for (int w = 0; w < 8; ++w) s += slot[w]; ss1[(size_t)(SEQ + r) * 16 + cg] = s; }
        __syncthreads();
    }
}

__device__ __forceinline__ float logsigmoid_f(float z) { return fminf(z, 0.f) - __logf(1.0f + __expf(-fabsf(z))); }
__device__ __forceinline__ void gla_gates(const Params& P, int c, int h, LAS float* bl) {
    const int tid = threadIdx.x, ti = tid >> 3, d0 = (tid & 7) * 8, tt = 64 * c - 48 + ti; const float* GA = (const float*)(P.ws + WS_GA);
    {
        float z[8];
        if (tt >= 0 && tt < L) {
            const f32x4 b0 = *(const f32x4*)(P.ba + 64 * h + d0), b1 = *(const f32x4*)(P.ba + 64 * h + d0 + 4);
#pragma unroll
            for (int m = 0; m < 4; ++m) { z[m] = b0[m]; z[4 + m] = b1[m]; }
            f32x4 a4[4];
#pragma unroll
            for (int q = 0; q < 4; ++q) a4[q] = *(const f32x4*)(GA + (size_t)tt * 16 + 4 * q);
#pragma unroll
            for (int r = 0; r < 16; ++r) { const float ar = a4[r >> 2][r & 3]; const f32x4 w0 = *(const f32x4*)(P.wa2 + r * 256 + 64 * h + d0), w1 = *(const f32x4*)(P.wa2 + r * 256 + 64 * h + d0 + 4);
#pragma unroll
                for (int m = 0; m < 4; ++m) { z[m] += ar * w0[m]; z[4 + m] += ar * w1[m]; } }
#pragma unroll
            for (int m = 0; m < 8; ++m) z[m] = logsigmoid_f(z[m]) * (1.0f / 16.0f);
        } else {
#pragma unroll
            for (int m = 0; m < 8; ++m) z[m] = 0.f;
        }
#pragma unroll
        for (int m = 0; m < 8; ++m) bl[ti * 65 + d0 + m] = z[m];
    }
    __syncthreads();
    {
        const int d = tid & 63, seg = tid >> 6; float v[8], run = 0.f;
#pragma unroll
        for (int i = 0; i < 8; ++i) { run += bl[(seg * 8 + i) * 65 + d]; v[i] = run; }
#pragma unroll
        for (int i = 0; i < 8; ++i) bl[(seg * 8 + i) * 65 + d] = v[i];
        __syncthreads();
        float off = 0.f;
#pragma unroll
        for (int sg = 0; sg < 7; ++sg) off += (sg < seg) ? bl[(sg * 8 + 7) * 65 + d] : 0.f;
        __syncthreads();
#pragma unroll
        for (int i = 0; i < 8; ++i) bl[(seg * 8 + i) * 65 + d] = v[i] + off;
    }
    __syncthreads();
}
__device__ __forceinline__ void gla_a_unit(const Params& P, int unit, LAS unsigned char* lds) {
    int tid_ = threadIdx.x; asm volatile("" : "+v"(tid_));
    const int tid = tid_, lane = tid & 63, wid = tid >> 6, c = unit >> 2, h = unit & 3;
    LAS float* bl = (LAS float*)lds; LAS float* ks = bl + 4160; LAS float* vs = ks + 4096;
    const f16* GK = (const f16*)(P.ws + WS_GK); const f16* GV = (const f16*)(P.ws + WS_GV);
    float* U = (float*)(P.ws + WS_US); float* DEC = (float*)(P.ws + WS_DECAY);
    const int ti = tid >> 3, d0 = (tid & 7) * 8, tt = 64 * c - 48 + ti; const bool tv = tt >= 0 && tt < L;
    half8 k8, v8[2];
#pragma unroll
    for (int m = 0; m < 8; ++m) { k8[m] = (f16)0.f; v8[0][m] = (f16)0.f; v8[1][m] = (f16)0.f; }
    if (tv) k8 = *(const half8*)(GK + (size_t)tt * 256 + 64 * h + d0);
#pragma unroll
    for (int q = 0; q < 2; ++q) { const int ch = tid + 512 * q, j = ch >> 4, t = 64 * c - 48 + j; if (t >= 0 && t < L) v8[q] = *(const half8*)(GV + (size_t)t * 512 + 128 * h + (ch & 15) * 8); }
    gla_gates(P, c, h, bl);
    { f32x4 o0, o1;
#pragma unroll
      for (int m = 0; m < 4; ++m) { o0[m] = (float)k8[m] * __expf(bl[63 * 65 + d0 + m] - bl[ti * 65 + d0 + m]); o1[m] = (float)k8[4 + m] * __expf(bl[63 * 65 + d0 + 4 + m] - bl[ti * 65 + d0 + 4 + m]); }
      *(LAS f32x4*)(ks + ti * 64 + d0) = o0; *(LAS f32x4*)(ks + ti * 64 + d0 + 4) = o1; }
#pragma unroll
    for (int q = 0; q < 2; ++q) { const int ch = tid + 512 * q, j = ch >> 4, e0 = (ch & 15) * 8; f32x4 o0, o1;
#pragma unroll
        for (int m = 0; m < 4; ++m) { o0[m] = (float)v8[q][m]; o1[m] = (float)v8[q][4 + m]; }
        *(LAS f32x4*)(vs + j * 128 + e0) = o0; *(LAS f32x4*)(vs + j * 128 + e0 + 4) = o1; }
    if (tid < 64) DEC[(size_t)c * 256 + h * 64 + tid] = __expf(bl[63 * 65 + tid]);
    __syncthreads();
    { const int dd0 = (wid >> 2) * 32, e0 = (wid & 3) * 32, l31 = lane & 31, hf = lane >> 5; f32x16 acc;
#pragma unroll
      for (int i = 0; i < 16; ++i) acc[i] = 0.f;
#pragma unroll 8
      for (int s = 0; s < 32; ++s) acc = __builtin_amdgcn_mfma_f32_32x32x2f32(ks[(2 * s + hf) * 64 + dd0 + l31], vs[(2 * s + hf) * 128 + e0 + l31], acc, 0, 0, 0);
      float* up = U + ((size_t)unit * 64) * 128;
#pragma unroll
      for (int r = 0; r < 16; ++r) { const int row = (r & 3) + 8 * (r >> 2) + 4 * hf; up[(size_t)(dd0 + row) * 128 + e0 + l31] = acc[r]; } }
    __syncthreads();
}
__device__ __forceinline__ void gla_scan(const Params& P) {
    float* U = (float*)(P.ws + WS_US); const float* DEC = (const float*)(P.ws + WS_DECAY);
    const int idx = blockIdx.x * NTHREADS + threadIdx.x;
    if (idx >= 32768) return;
    float s = 0.f;
#pragma unroll 8
    for (int c = 0; c < NCH; ++c) { const float u = U[(size_t)c * 32768 + idx], dc = DEC[(size_t)c * 256 + (idx >> 7)]; U[(size_t)c * 32768 + idx] = s; s = dc * s + u; }
}
__device__ __forceinline__ void gla_c_unit(const Params& P, int unit, LAS unsigned char* lds) {
    int tid_ = threadIdx.x; asm volatile("" : "+v"(tid_));
    const int tid = tid_, lane = tid & 63, wid = tid >> 6, c = unit >> 2, h = unit & 3, l31 = lane & 31, hf = lane >> 5;
    LAS float* bl = (LAS float*)lds; LAS float* kk = bl + 4160; LAS float* qs = kk + 4160; LAS float* As = qs + 4160; LAS float* vs = As + 4160; LAS float* Ss = vs + 8192; LAS float* os = bl;
    const f16* GQ = (const f16*)(P.ws + WS_GQ); const f16* GK = (const f16*)(P.ws + WS_GK); const f16* GV = (const f16*)(P.ws + WS_GV); const f16* GR = (const f16*)(P.ws + WS_GR);
    const float* Sg = (const float*)(P.ws + WS_US) + (size_t)unit * 8192; f16* mix = (f16*)(P.ws + WS_ACTA);
    const int ti = tid >> 3, d0 = (tid & 7) * 8, tt = 64 * c - 48 + ti; const bool tv = tt >= 0 && tt < L;
    half8 q8, k8, v8[2], r8[2]; f32x4 sreg[4];
#pragma unroll
    for (int m = 0; m < 8; ++m) { q8[m] = (f16)0.f; k8[m] = (f16)0.f; v8[0][m] = (f16)0.f; v8[1][m] = (f16)0.f; r8[0][m] = (f16)0.f; r8[1][m] = (f16)0.f; }
    if (tv) { q8 = *(const half8*)(GQ + (size_t)tt * 256 + 64 * h + d0); k8 = *(const half8*)(GK + (size_t)tt * 256 + 64 * h + d0);
        r8[0] = *(const half8*)(GR + (size_t)tt * 512 + 128 * h + (tid & 7) * 16); r8[1] = *(const half8*)(GR + (size_t)tt * 512 + 128 * h + (tid & 7) * 16 + 8); }
#pragma unroll
    for (int q = 0; q < 2; ++q) { const int ch = tid + 512 * q, j = ch >> 4, t = 64 * c - 48 + j; if (t >= 0 && t < L) v8[q] = *(const half8*)(GV + (size_t)t * 512 + 128 * h + (ch & 15) * 8); }
#pragma unroll
    for (int q = 0; q < 4; ++q) sreg[q] = *(const f32x4*)(Sg + (size_t)(tid + 512 * q) * 4);
    gla_gates(P, c, h, bl);
#pragma unroll
    for (int m = 0; m < 8; ++m) { const float bv = bl[ti * 65 + d0 + m]; qs[ti * 65 + d0 + m] = (float)q8[m] * 0.125f * __expf(bv); kk[ti * 65 + d0 + m] = (float)k8[m] * __expf(-bv); }
#pragma unroll
    for (int q = 0; q < 2; ++q) { const int ch = tid + 512 * q, j = ch >> 4, e0 = (ch & 15) * 8; f32x4 o0, o1;
#pragma unroll
        for (int m = 0; m < 4; ++m) { o0[m] = (float)v8[q][m]; o1[m] = (float)v8[q][4 + m]; }
        *(LAS f32x4*)(vs + j * 128 + e0) = o0; *(LAS f32x4*)(vs + j * 128 + e0 + 4) = o1; }
#pragma unroll
    for (int q = 0; q < 4; ++q) *(LAS f32x4*)(Ss + (tid + 512 * q) * 4) = sreg[q];
    __syncthreads();
    if (wid < 4) { const int i0 = (wid >> 1) * 32, j0 = (wid & 1) * 32; f32x16 acc;
#pragma unroll
        for (int i = 0; i < 16; ++i) acc[i] = 0.f;
#pragma unroll 8
        for (int s = 0; s < 32; ++s) acc = __builtin_amdgcn_mfma_f32_32x32x2f32(qs[(i0 + l31) * 65 + 2 * s + hf], kk[(j0 + l31) * 65 + 2 * s + hf], acc, 0, 0, 0);
#pragma unroll
        for (int r = 0; r < 16; ++r) { const int i = i0 + (r & 3) + 8 * (r >> 2) + 4 * hf, j = j0 + l31; As[i * 65 + j] = (j <= i) ? acc[r] : 0.f; } }
    __syncthreads();
    { const int i0 = (wid >> 2) * 32, e0 = (wid & 3) * 32; f32x16 acc;
#pragma unroll
      for (int i = 0; i < 16; ++i) acc[i] = 0.f;
#pragma unroll 8
      for (int s = 0; s < 32; ++s) acc = __builtin_amdgcn_mfma_f32_32x32x2f32(qs[(i0 + l31) * 65 + 2 * s + hf], Ss[(2 * s + hf) * 128 + e0 + l31], acc, 0, 0, 0);
#pragma unroll 8
      for (int s = 0; s < 32; ++s) acc = __builtin_amdgcn_mfma_f32_32x32x2f32(As[(i0 + l31) * 65 + 2 * s + hf], vs[(2 * s + hf) * 128 + e0 + l31], acc, 0, 0, 0);
#pragma unroll
      for (int r = 0; r < 16; ++r) { const int i = i0 + (r & 3) + 8 * (r >> 2) + 4 * hf; os[i * 129 + e0 + l31] = acc[r]; } }
    __syncthreads();
    { const int e0 = (tid & 7) * 16; float o[16], sq = 0.f;
#pragma unroll
      for (int j = 0; j < 16; ++j) { o[j] = os[ti * 129 + e0 + j]; sq += o[j] * o[j]; }
      sq += __shfl_xor(sq, 1); sq += __shfl_xor(sq, 2); sq += __shfl_xor(sq, 4);
      const float rs = rsqrtf(sq * (1.0f / 128.0f) + EPS);
      if (tt >= NMETA && tt < L) { half8 w0, w1;
#pragma unroll
          for (int j = 0; j < 8; ++j) { w0[j] = (f16)(o[j] * rs * P.hn[e0 + j] * silu_f((float)r8[0][j])); w1[j] = (f16)(o[8 + j] * rs * P.hn[e0 + 8 + j] * silu_f((float)r8[1][j])); }
          f16* dst = mix + (size_t)(tt - NMETA) * D + 128 * h + e0; *(half8*)dst = w0; *(half8*)(dst + 8) = w1; } }
    __syncthreads();
}

__device__ __forceinline__ unsigned mono_u(float f) { const unsigned u = __float_as_uint(f); return (u & 0x80000000u) ? ~u : (u | 0x80000000u); }
__device__ __forceinline__ float unmono_f(unsigned m) { return __uint_as_float((m & 0x80000000u) ? (m & 0x7fffffffu) : ~m); }
__device__ __forceinline__ unsigned wave_umax(unsigned v) {
    v = max(v, (unsigned)__builtin_amdgcn_update_dpp(0, (int)v, 0x111, 0xf, 0xf, false));
    v = max(v, (unsigned)__builtin_amdgcn_update_dpp(0, (int)v, 0x112, 0xf, 0xf, false));
    v = max(v, (unsigned)__builtin_amdgcn_update_dpp(0, (int)v, 0x114, 0xf, 0xf, false));
    v = max(v, (unsigned)__builtin_amdgcn_update_dpp(0, (int)v, 0x118, 0xf, 0xf, false));
    v = max(v, (unsigned)__builtin_amdgcn_update_dpp(0, (int)v, 0x142, 0xa, 0xf, false));
    v = max(v, (unsigned)__builtin_amdgcn_update_dpp(0, (int)v, 0x143, 0xc, 0xf, false));
    return (unsigned)__builtin_amdgcn_readlane((int)v, 63);
}
__device__ __forceinline__ int half_scan_incl(int v) {
    v += __builtin_amdgcn_update_dpp(0, v, 0x111, 0xf, 0xf, true);
    v += __builtin_amdgcn_update_dpp(0, v, 0x112, 0xf, 0xf, true);
    v += __builtin_amdgcn_update_dpp(0, v, 0x114, 0xf, 0xf, true);
    v += __builtin_amdgcn_update_dpp(0, v, 0x118, 0xf, 0xf, true);
    v += __builtin_amdgcn_update_dpp(0, v, 0x142, 0xa, 0xf, true);
    return v;
}
constexpr int CAP = 640, NPL = CAP / 64;
__device__ __forceinline__ int topk_compact(LAS float* cs, LAS unsigned short* ci, int n, bool exact, float& tau_out, int lane) {
    float sv[NPL]; unsigned iv[NPL], u[NPL];
#pragma unroll
    for (int i = 0; i < NPL; ++i) { const int p = lane + 64 * i; const bool v = p < n; sv[i] = v ? cs[p] : 0.f; iv[i] = v ? (unsigned)ci[p] : 0xffffu; u[i] = v ? mono_u(sv[i]) : 0u; }
    unsigned T = 0u; bool full = true; int hb = 31;
    {
        unsigned umx = 0u, umn = 0xffffffffu;
#pragma unroll
        for (int i = 0; i < NPL; ++i) { umx = max(umx, u[i]); umn = min(umn, (lane + 64 * i < n) ? u[i] : 0xffffffffu); }
        umx = wave_umax(umx); umn = ~wave_umax(~umn);
        const unsigned df = umx ^ umn;
        if (df == 0u) { hb = -1; T = umx; } else { hb = 31 - __clz(df); T = (hb == 31) ? 0u : (umx & ~((2u << hb) - 1u)); }
    }
#pragma unroll 1
    for (int bit = hb; bit >= 0; --bit) {
        const unsigned cand = T | (1u << bit); int cgt = 0;
#pragma unroll
        for (int i = 0; i < NPL; ++i) cgt += __popcll(__ballot(u[i] >= cand));
        if (cgt >= 256) { T = cand; if (!exact && cgt <= 272) { full = false; break; } }
    }
    bool keep[NPL];
    if (full) {
        int cgt = 0;
#pragma unroll
        for (int i = 0; i < NPL; ++i) cgt += __popcll(__ballot(u[i] > T));
        const int need = 256 - cgt; unsigned I = 0xffffu; int nties = 0;
#pragma unroll
        for (int i = 0; i < NPL; ++i) nties += __popcll(__ballot(u[i] == T));
        if (nties != need) { I = 0u;
#pragma unroll 1
        for (int bit = 15; bit >= 0; --bit) { const unsigned cand = I | (1u << bit); int cl = 0;
#pragma unroll
            for (int i = 0; i < NPL; ++i) cl += __popcll(__ballot(u[i] == T && iv[i] < cand));
            if (cl < need) I = cand; } }
#pragma unroll
        for (int i = 0; i < NPL; ++i) keep[i] = (u[i] > T) || (u[i] == T && iv[i] <= I);
    } else {
#pragma unroll
        for (int i = 0; i < NPL; ++i) keep[i] = u[i] >= T;
    }
    int nn = 0;
#pragma unroll
    for (int i = 0; i < NPL; ++i) { const unsigned long long m = __ballot(keep[i]); const int pre = __builtin_amdgcn_mbcnt_hi((unsigned)(m >> 32), __builtin_amdgcn_mbcnt_lo((unsigned)m, 0u));
        if (keep[i]) { cs[nn + pre] = sv[i]; ci[nn + pre] = (unsigned short)iv[i]; } nn += __popcll(m); }
    tau_out = unmono_f(T);
    return nn;
}
__device__ __forceinline__ float relu_asm(float x) { return __int_as_float(max(__float_as_int(x), 0)); }
__device__ __forceinline__ void indexer_tile(const Params& P, int tile, LAS unsigned char* lds) {
    int tid_ = threadIdx.x; asm volatile("" : "+v"(tid_));
    const int tid = tid_, lane = tid & 63, wid = __builtin_amdgcn_readfirstlane(tid >> 6), l31 = lane & 31, hf = lane >> 5;
    LAS float* candS = (LAS float*)lds;
    LAS unsigned short* candI = (LAS unsigned short*)(lds + 32 * CAP * 4);
    LAS unsigned char* kbuf = lds + 32 * CAP * 6;
    LAS int* lflag = (LAS int*)(lds + LDS_BYTES - 1024 + 192);
    const f16* IQ = (const f16*)(P.ws + WS_IQ); const f16* IK = (const f16*)(P.ws + WS_IK); const float* IW = (const float*)(P.ws + WS_IW);
    unsigned short* SEL = (unsigned short*)(P.ws + WS_SEL);
    const int t0 = tile * 32, tw = t0 + wid * 4;
    half8 afr[4];
    { const int qi = 2 * (l31 >> 4) + ((l31 >> 2) & 1), hd = 4 * ((l31 >> 3) & 1) + (l31 & 3); int tq = tw + qi; if (tq > L - 1) tq = L - 1;
      const half8* ap = (const half8*)(IQ + (size_t)tq * 512 + hd * 64);
#pragma unroll
      for (int s = 0; s < 4; ++s) afr[s] = ap[2 * s + hf]; }
    float w0[8], w1[8];
    { int ta = tw + hf, tb = tw + 2 + hf; if (ta > L - 1) ta = L - 1; if (tb > L - 1) tb = L - 1;
#pragma unroll
      for (int h = 0; h < 8; ++h) { w0[h] = IW[(size_t)ta * 8 + h]; w1[h] = IW[(size_t)tb * 8 + h]; } }
    asm volatile("" :: "v"(afr[0]), "v"(afr[1]), "v"(afr[2]), "v"(afr[3]));
    asm volatile("" :: "v"(w0[0]), "v"(w0[1]), "v"(w0[2]), "v"(w0[3]), "v"(w0[4]), "v"(w0[5]), "v"(w0[6]), "v"(w0[7]));
    asm volatile("" :: "v"(w1[0]), "v"(w1[1]), "v"(w1[2]), "v"(w1[3]), "v"(w1[4]), "v"(w1[5]), "v"(w1[6]), "v"(w1[7]));
    const int tq0 = (tw + hf < L) ? tw + hf : -1, tq1 = (tw + 2 + hf < L) ? tw + 2 + hf : -1;
    float tau0 = -__builtin_inff(), tau1 = -__builtin_inff();
    int cq0 = 0, cq1 = 0, cq2 = 0, cq3 = 0;
    if (tid < 3) lflag[tid] = 0;
    const int nkeys = (t0 + 32 < L) ? t0 + 32 : L, nst = (nkeys + 127) >> 7;
    u32x4 stg[2];
    const u32x4* IKv = (const u32x4*)IK;
#pragma unroll
    for (int i = 0; i < 2; ++i) stg[i] = IKv[(size_t)0 * 1024 + tid + 512 * i];
#pragma unroll
    for (int i = 0; i < 2; ++i) { const int ci = tid + 512 * i, row = ci >> 3, ch = ci & 7; *(LAS u32x4*)(kbuf + row * 128 + ((ch ^ ((row >> 1) & 7)) << 4)) = stg[i]; }
    __syncthreads();
#pragma unroll 1
    for (int st = 0; st < nst; ++st) {
        LAS unsigned char* kb = kbuf + (st & 1) * 16384;
        if (st + 1 < nst) {
#pragma unroll
            for (int i = 0; i < 2; ++i) stg[i] = IKv[(size_t)(st + 1) * 1024 + tid + 512 * i];
        }
        if (st * 128 <= tw + 3) {
            f32x16 acc[4];
#pragma unroll
            for (int c = 0; c < 4; ++c) {
#pragma unroll
                for (int i = 0; i < 16; ++i) acc[c][i] = 0.f;
            }
#pragma unroll
            for (int s = 0; s < 4; ++s) {
#pragma unroll
                for (int c = 0; c < 4; ++c) { const int row = c * 32 + l31; const half8 bf = *(const LAS half8*)(kb + row * 128 + (((2 * s + hf) ^ ((row >> 1) & 7)) << 4)); acc[c] = __builtin_amdgcn_mfma_f32_32x32x16_f16(afr[s], bf, acc[c], 0, 0, 0); }
            }
            float sc[8]; bool ok[8]; int na = 0, nb = 0;
#pragma unroll
            for (int c = 0; c < 4; ++c) {
                float s0 = 0.f, s1 = 0.f;
#pragma unroll
                for (int h = 0; h < 8; ++h) { s0 = __builtin_fmaf(w0[h], relu_asm(acc[c][h]), s0); s1 = __builtin_fmaf(w1[h], relu_asm(acc[c][8 + h]), s1); }
                const int key = st * 128 + c * 32 + l31;
                sc[2 * c] = s0; sc[2 * c + 1] = s1; ok[2 * c] = key <= tq0 && s0 > tau0; ok[2 * c + 1] = key <= tq1 && s1 > tau1;
                na += ok[2 * c] ? 1 : 0; nb += ok[2 * c + 1] ? 1 : 0;
            }
            const int ia = half_scan_incl(na), ib = half_scan_incl(nb);
            const int ta0 = __builtin_amdgcn_readlane(ia, 31), ta1 = __builtin_amdgcn_readlane(ia, 63), tb0 = __builtin_amdgcn_readlane(ib, 31), tb1 = __builtin_amdgcn_readlane(ib, 63);
            int pa = (hf ? cq1 : cq0) + ia - na, pb = (hf ? cq3 : cq2) + ib - nb;
            cq0 += ta0; cq1 += ta1; cq2 += tb0; cq3 += tb1;
            pa += (wid * 4 + hf) * CAP; pb += (wid * 4 + 2 + hf) * CAP;
            const int dmy = 32 * CAP * 6 / 4 + 2 * 16384 / 4 + 64 + lane;
#pragma unroll
            for (int c = 0; c < 4; ++c) {
                const unsigned short key = (unsigned short)(st * 128 + c * 32 + l31);
                { const bool k0 = ok[2 * c]; LAS float* ps = k0 ? candS + pa : candS + dmy; LAS unsigned short* pi = k0 ? candI + pa : (LAS unsigned short*)(candS + dmy + 64); *ps = sc[2 * c]; *pi = key; pa += k0 ? 1 : 0; }
                { const bool k1 = ok[2 * c + 1]; LAS float* ps = k1 ? candS + pb : candS + dmy; LAS unsigned short* pi = k1 ? candI + pb : (LAS unsigned short*)(candS + dmy + 64); *ps = sc[2 * c + 1]; *pi = key; pb += k1 ? 1 : 0; }
            }
        }
        if (st + 1 < nst) {
            LAS unsigned char* kn = kbuf + ((st + 1) & 1) * 16384;
#pragma unroll
            for (int i = 0; i < 2; ++i) { const int ci = tid + 512 * i, row = ci >> 3, ch = ci & 7; *(LAS u32x4*)(kn + row * 128 + ((ch ^ ((row >> 1) & 7)) << 4)) = stg[i]; }
        }
        const int mx = max(max(cq0, cq1), max(cq2, cq3));
        if (mx > CAP - 128 && lane == 0) lflag[st % 3] = 1;
        if (tid == 0) lflag[(st + 1) % 3] = 0;
        __syncthreads();
        const int any = lflag[st % 3];
        if (any) {
#pragma unroll 1
            for (int qq = 0; qq < 4; ++qq) { const int n = qq == 0 ? cq0 : (qq == 1 ? cq1 : (qq == 2 ? cq2 : cq3));
                if (n > 288) { float nt; const int nn = topk_compact(candS + (wid * 4 + qq) * CAP, candI + (wid * 4 + qq) * CAP, n, false, nt, lane);
                    if (qq == 0) cq0 = nn; else if (qq == 1) cq1 = nn; else if (qq == 2) cq2 = nn; else cq3 = nn;
                    if (hf == (qq & 1)) { if (qq < 2) tau0 = nt; else tau1 = nt; } } }
        }
    }
#pragma unroll 1
    for (int qq = 0; qq < 4; ++qq) {
        const int t = tw + qq; if (t >= L) break;
        int n = qq == 0 ? cq0 : (qq == 1 ? cq1 : (qq == 2 ? cq2 : cq3)); LAS float* cs = candS + (wid * 4 + qq) * CAP; LAS unsigned short* ci = candI + (wid * 4 + qq) * CAP;
        if (n > 256) { float nt; n = topk_compact(cs, ci, n, true, nt, lane); }
#pragma unroll
        for (int j = 0; j < 4; ++j) { const int p = lane + 64 * j; SEL[(size_t)t * 256 + (p & 15) * 16 + (p >> 4)] = p < n ? ci[p] : (unsigned short)0xffffu; }
    }
    __syncthreads();
}

__device__ __forceinline__ void sparse_attn(const Params& P, LAS unsigned char* lds, int vbid) {
    int tid_ = threadIdx.x; asm volatile("" : "+v"(tid_));
    const int tid = tid_, lane = tid & 63, wid = tid >> 6, grp = lane >> 2, c4 = lane & 3;
    const int head = vbid & 7, slot = (vbid >> 3) * 8 + wid, nslot = (gridDim.x >> 3) * 8;
    typedef _Float16 half2v __attribute__((ext_vector_type(2)));
    LAS float* red = (LAS float*)(lds + 4096 + wid * 4352);
    const unsigned short* SEL = (const unsigned short*)(P.ws + WS_SEL);
    const unsigned char* Q8 = P.ws + WS_DQ + head * 64 + c4 * 16; const float* QS = (const float*)(P.ws + WS_DQ + (size_t)LP * 512) + head;
    const unsigned char* kvh = P.ws + WS_KV + (size_t)head * LP * 128; f16* mix = (f16*)(P.ws + WS_ACTA);
    int t = NMETA + slot;
    u32x4 sela = {0u, 0u, 0u, 0u}, selb = {0u, 0u, 0u, 0u}, q8 = {0u, 0u, 0u, 0u}; float lscale = 0.f;
    if (t < L) { sela = *(const u32x4*)(SEL + (size_t)t * 256 + grp * 16); selb = *(const u32x4*)(SEL + (size_t)t * 256 + grp * 16 + 8); q8 = *(const u32x4*)(Q8 + (size_t)t * 512); lscale = QS[(size_t)t * 8]; }
#define ATTN_ITEM(ALLV) do { \
        unsigned keys[16]; u32x4 kreg[16], vreg[16]; \
        _Pragma("unroll") for (int it = 0; it < 16; ++it) { const unsigned w = it < 8 ? sela[it >> 1] : selb[(it - 8) >> 1]; keys[it] = (it & 1) ? (w >> 16) : (w & 0xffffu); } \
        _Pragma("unroll") for (int it = 0; it < 16; ++it) { const unsigned kk = (ALLV || keys[it] != 0xffffu) ? keys[it] : 0u; kreg[it] = *(const u32x4*)(kvh + (size_t)kk * 128 + c4 * 16); } \
        _Pragma("unroll") for (int it = 0; it < 16; ++it) { const unsigned kk = (ALLV || keys[it] != 0xffffu) ? keys[it] : 0u; vreg[it] = *(const u32x4*)(kvh + (size_t)kk * 128 + 64 + c4 * 16); } \
        const u32x4 qc = q8; const float ls = lscale; \
        { const int tn = t + nslot;     \
          if (tn < L) { sela = *(const u32x4*)(SEL + (size_t)tn * 256 + grp * 16); selb = *(const u32x4*)(SEL + (size_t)tn * 256 + grp * 16 + 8); q8 = *(const u32x4*)(Q8 + (size_t)tn * 512); lscale = QS[(size_t)tn * 8]; } } \
        float lg[16]; float mx = -__builtin_inff(); \
        _Pragma("unroll") for (int it = 0; it < 16; ++it) { \
            int ai = 0; \
            _Pragma("unroll") for (int w = 0; w < 4; ++w) ai = __builtin_amdgcn_sdot4((int)kreg[it][w], (int)qc[w], ai, false); \
            ai += __builtin_amdgcn_update_dpp(0, ai, 0xB1, 0xf, 0xf, true);     \
            ai += __builtin_amdgcn_update_dpp(0, ai, 0x4E, 0xf, 0xf, true);     \
            lg[it] = (ALLV || keys[it] != 0xffffu) ? (float)ai * ls : -__builtin_inff(); mx = fmaxf(mx, lg[it]); } \
        mx = fmaxf(mx, __shfl_xor(mx, 4)); mx = fmaxf(mx, __shfl_xor(mx, 8)); mx = fmaxf(mx, __shfl_xor(mx, 16)); mx = fmaxf(mx, __shfl_xor(mx, 32)); \
        half2v o2[8]; float lsum = 0.f; \
        _Pragma("unroll") for (int e = 0; e < 8; ++e) o2[e] = (half2v){(f16)0.f, (f16)0.f}; \
        _Pragma("unroll") for (int it = 0; it < 16; ++it) { \
            const float p = __expf(lg[it] - mx); lsum += p; const f16 ph = (f16)p; const half2v p2 = {ph, ph}; \
            _Pragma("unroll") for (int w = 0; w < 4; ++w) {     \
                const half2v v01 = __builtin_bit_cast(half2v, __builtin_amdgcn_perm(0u, vreg[it][w], 0x010c000cu)), v23 = __builtin_bit_cast(half2v, __builtin_amdgcn_perm(0u, vreg[it][w], 0x030c020cu)); \
                o2[2 * w] = p2 * v01 + o2[2 * w]; o2[2 * w + 1] = p2 * v23 + o2[2 * w + 1]; } } \
        lsum += __shfl_xor(lsum, 4); lsum += __shfl_xor(lsum, 8); lsum += __shfl_xor(lsum, 16); lsum += __shfl_xor(lsum, 32); \
          \
        _Pragma("unroll") for (int e = 0; e < 8; ++e) { red[lane * 17 + 2 * e] = (float)o2[e][0]; red[lane * 17 + 2 * e + 1] = (float)o2[e][1]; } \
        float acc = 0.f; \
        { const int cc = lane >> 4, e = lane & 15; \
          _Pragma("unroll") for (int g = 0; g < 16; ++g) acc += red[(g * 4 + cc) * 17 + e]; } \
        mix[(size_t)(t - NMETA) * D + 512 + head * 64 + lane] = (f16)(acc * __builtin_amdgcn_rcpf(lsum)); \
    } while (0)
#pragma unroll 1
    for (; t < L; t += nslot) {
        if (t >= 255) ATTN_ITEM(true);
        else ATTN_ITEM(false);
    }
#undef ATTN_ITEM
    __syncthreads();
}

__device__ __forceinline__ void final_norm(const Params& P) {
    const int tid = threadIdx.x, lane = tid & 63, gw = blockIdx.x * 8 + (tid >> 6), nw = gridDim.x * 8;
    const float* ss3 = (const float*)(P.ws + WS_SS3); const f16* h3 = (const f16*)(P.ws + WS_ACTA);
    for (int r = gw; r < SEQ; r += nw) { const float rs = row_rstd(ss3, 16, r);
#pragma unroll
        for (int i = 0; i < 2; ++i) { const int k = lane * 8 + 512 * i; const half8 v = *(const half8*)(h3 + (size_t)r * D + k); const f32x4 g0 = *(const f32x4*)(P.nf + k), g1 = *(const f32x4*)(P.nf + k + 4); f32x4 o0, o1;
#pragma unroll
            for (int j = 0; j < 4; ++j) { o0[j] = (float)v[j] * rs * g0[j]; o1[j] = (float)v[4 + j] * rs * g1[j]; }
            *(f32x4*)(P.out + (size_t)r * D + k) = o0; *(f32x4*)(P.out + (size_t)r * D + k + 4) = o1; } }
}

#define XB_TMO      128
#define XB_XCNT(j)  (256  + 64 * (j))
#define XB_XSUB(j)  (1280 + 64 * (j))
#define XB_XGEN(j)  (2304 + 64 * (j))
#define XB_TOP      3328
#define XB_TOPGEN   3392
#define XCD_BAR_WORDS 3456
#define XB_SPIN_CAP (1u << 22)
__device__ __forceinline__ unsigned xb_ld(unsigned* p)              { return __hip_atomic_load(p, __ATOMIC_RELAXED, __HIP_MEMORY_SCOPE_AGENT); }
__device__ __forceinline__ unsigned xb_add(unsigned* p, unsigned v) { return __hip_atomic_fetch_add(p, v, __ATOMIC_RELAXED, __HIP_MEMORY_SCOPE_AGENT); }
__device__ __forceinline__ unsigned xb_xcc_id() { return (unsigned)__builtin_amdgcn_s_getreg((3 << 11) | 20) & 0xFu; }
#define XB_SPIN(cond, bar) do { unsigned _sp = 0; while (cond) { __builtin_amdgcn_s_sleep(1); \
    if ((++_sp & 255u) == 0u) { if (xb_ld(&(bar)[XB_TMO])) break; if (_sp > XB_SPIN_CAP) { atomicAdd(&(bar)[XB_TMO], 1u); break; } } } } while (0)
struct XcdBarrier { unsigned* bar; unsigned x; volatile LAS unsigned* st; };
__device__ __forceinline__ XcdBarrier xcd_barrier_post(unsigned* bar, volatile LAS unsigned* st) {
    XcdBarrier b; b.bar = bar; b.x = xb_xcc_id(); b.st = st;
    if (threadIdx.x == 0) (void)xb_add(&bar[XB_XCNT(b.x)], 1u);
    return b;
}
__device__ __forceinline__ void xcd_barrier_complete(unsigned* bar, unsigned x, unsigned& nloc, unsigned& nx) {
    const unsigned G = gridDim.x * gridDim.y * gridDim.z;
    unsigned sum, cnt, mine, sp = 0u;
    for (;;) {
        sum = 0u; cnt = 0u; mine = 0u;
#pragma unroll
        for (unsigned j = 0; j < 16; ++j) { const unsigned c = xb_ld(&bar[XB_XCNT(j)]); sum += c; cnt += (c > 0u) ? 1u : 0u; mine = (j == x) ? c : mine; }
        if (sum == G) break;
        __builtin_amdgcn_s_sleep(1);
        if ((++sp & 255u) == 0u) { if (xb_ld(&bar[XB_TMO])) break; if (sp > XB_SPIN_CAP) { atomicAdd(&bar[XB_TMO], 1u); break; } }
    }
    nloc = mine > 0u ? mine : 1u; nx = cnt > 0u ? cnt : 1u;
}
__device__ __forceinline__ void xcd_barrier(const XcdBarrier& b) {
    asm volatile("s_waitcnt vmcnt(0)" ::: "memory");
    __syncthreads();
    if (threadIdx.x == 0) {
        unsigned* bar = b.bar;
        __builtin_amdgcn_s_waitcnt(0);
        unsigned nloc = b.st[0], nx = b.st[1];
        if (nloc == 0u) { xcd_barrier_complete(bar, b.x, nloc, nx); b.st[0] = nloc; b.st[1] = nx; }
        const unsigned old = xb_add(&bar[XB_XSUB(b.x)], 1u);
        const unsigned gen = old / nloc;
        if (old + 1u == (gen + 1u) * nloc) {
            __builtin_amdgcn_fence(__ATOMIC_RELEASE, "agent");
            asm volatile("s_waitcnt vmcnt(0)" ::: "memory");
            const unsigned og = xb_add(&bar[XB_TOP], 1u);
            const unsigned tg = og / nx;
            if (og + 1u == (tg + 1u) * nx) xb_add(&bar[XB_TOPGEN], 1u);
            else XB_SPIN(xb_ld(&bar[XB_TOPGEN]) == tg, bar);
            __builtin_amdgcn_fence(__ATOMIC_ACQUIRE, "agent");
            xb_add(&bar[XB_XGEN(b.x)], 1u);
            asm volatile("s_waitcnt vmcnt(0)" ::: "memory");
        } else {
            XB_SPIN(xb_ld(&bar[XB_XGEN(b.x)]) == gen, bar);
            __builtin_amdgcn_fence(__ATOMIC_ACQUIRE, "agent");
            asm volatile("s_waitcnt vmcnt(0)" ::: "memory");
        }
    }
    __syncthreads();
}

__global__ void __launch_bounds__(NTHREADS, 2) fwd_kernel(Params P) {
    __shared__ __attribute__((aligned(16))) unsigned char lds_raw[LDS_BYTES];
    LAS unsigned char* lds = (LAS unsigned char*)lds_raw;
    const int tid = threadIdx.x, bid = blockIdx.x, G = gridDim.x;
    unsigned char* ws = P.ws;
    const int lo = P.ph_lo, hi = P.ph_hi;
#ifndef ONLY_PHASE
#define ONLY_PHASE -1
#endif
#define IN(k) ((ONLY_PHASE < 0 || ONLY_PHASE == (k)) && lo <= (k) && (k) < hi)
#define SEAM(k) do { if (IN(k) && IN((k) + 1)) { xcd_barrier(xbar); } } while (0)
    XcdBarrier xbar; xbar.bar = (unsigned*)(ws + WS_BAR); xbar.x = 0; xbar.st = (volatile LAS unsigned*)(lds + LDS_BYTES - 1024 + 16);
    if (hi - lo > 1) {
        if (tid == 0) { xbar.st[0] = 0u; xbar.st[1] = 0u; }
        __syncthreads();
        xbar = xcd_barrier_post((unsigned*)(ws + WS_BAR), (volatile LAS unsigned*)(lds + LDS_BYTES - 1024 + 16));
    }
    LAS int* misc = (LAS int*)(lds + LDS_BYTES - 1024);
    if (hi - lo > 1) {
        if (tid == 0) { const unsigned xcc = xb_xcc_id() & 7u; misc[8] = (int)xcc; misc[9] = (int)xb_add((unsigned*)(ws + WS_CTL) + 32 + 32 * xcc, 1u); }
    }
    int vbid = bid;
    f16* acta = (f16*)(ws + WS_ACTA); f16* Gb = (f16*)(ws + WS_G);
    float* ss0 = (float*)(ws + WS_SS0); float* ss1 = (float*)(ws + WS_SS1); float* ss2 = (float*)(ws + WS_SS2); float* ss3 = (float*)(ws + WS_SS3);
    if (IN(0)) { p0_prologue(P, lds); }
    SEAM(0);
    if (hi - lo > 1 && (G & 7) == 0) {
        if (tid == 0) { bool ok = true; for (int j = 0; j < 8; ++j) ok = ok && (xb_ld((unsigned*)(ws + WS_CTL) + 32 + 32 * j) == (unsigned)(G >> 3)); misc[10] = ok ? misc[9] * 8 + misc[8] : bid; }
        __syncthreads();
        vbid = __builtin_amdgcn_readfirstlane(misc[10]);
        __syncthreads();
    }
    if (IN(1)) {
        pg8::Gemm g{acta, (const f16*)(ws + WS_WGU1), MP, 2 * DFF, D}; pg8::StaticOrder S; S.init(MP, 2 * DFF, G, vbid);
        EpiSwiglu E{Gb, ss0, 1}; pg8::gemm_phase(lds, g, S, E);
    }
    SEAM(1);
    if (IN(2)) {
        meta_down(P, lds);
        pg8::Gemm g{Gb, (const f16*)(ws + WS_WD1), SEQ, D, DFF}; pg8::StaticOrder S; S.init(SEQ, D, G, vbid);
        EpiResid<true> E{acta, (f16*)P.out, ss1, 0.5f}; pg8::gemm_phase(lds, g, S, E);
    }
    SEAM(2);
    if (IN(3)) {
        pg8::Gemm g{(const f16*)P.out, (const f16*)(ws + WS_WIN), MP, NIN, D}; pg8::StaticOrder S; S.init(MP, NIN, G, vbid);
        EpiInProj E{ss1, (const f32x2*)(ws + WS_ROPE), ws};
        pg8::gemm_phase(lds, g, S, E);
    }
    SEAM(3);
    if (IN(4)) {
        for (int u = bid; u < NCH * 4; u += G) gla_a_unit(P, u, lds);
        {
            int tbase = 0, cursor = bid; LAS f16* tl = (LAS f16*)lds;
            prep_weight(P, 3, D, D, (f16*)(ws + WS_WOUT), cursor, tbase, tl);
            prep_weight(P, 4, 2 * DFF, D, (f16*)(ws + WS_WGU2), cursor, tbase, tl);
            prep_weight(P, 5, D, DFF, (f16*)(ws + WS_WD2), cursor, tbase, tl);
        }
    }
    SEAM(4);
    if (IN(5)) {
        if (bid < 64) gla_scan(P);
        unsigned* ctr = (unsigned*)(ws + WS_CTL); LAS int* bc = (LAS int*)(lds + LDS_BYTES - 1024);
        for (;;) {
            if (tid == 0) bc[0] = (int)atomicAdd(ctr, 1u);
            __syncthreads();
            const int k = bc[0];
            __syncthreads();
            if (k >= 513) break;
            indexer_tile(P, 512 - k, lds);
        }
    }
    SEAM(5);
    if (IN(6)) { for (int u = bid; u < NCH * 4; u += G) gla_c_unit(P, u, lds); sparse_attn(P, lds, vbid); }
    SEAM(6);
    if (IN(7)) {
        pg8::Gemm g{acta, (const f16*)(ws + WS_WOUT), SEQ, D, D}; pg8::StaticOrder S; S.init(SEQ, D, G, vbid);
        EpiResid<true> E{P.out, (f16*)(ws + WS_US), ss2, 1.0f}; pg8::gemm_phase(lds, g, S, E);
    }
    SEAM(7);
    if (IN(8)) {
        pg8::Gemm g{(const f16*)(ws + WS_US), (const f16*)(ws + WS_WGU2), SEQ, 2 * DFF, D}; pg8::StaticOrder S; S.init(SEQ, 2 * DFF, G, vbid);
        EpiSwiglu E{Gb, ss2, 16}; pg8::gemm_phase(lds, g, S, E);
    }
    SEAM(8);
    if (IN(9)) {
        pg8::Gemm g{Gb, (const f16*)(ws + WS_WD2), SEQ, D, DFF}; pg8::StaticOrder S; S.init(SEQ, D, G, vbid);
        EpiResid<true> E{ws + WS_US, acta, ss3, 0.5f}; pg8::gemm_phase(lds, g, S, E);
    }
    SEAM(9);
    if (IN(10)) final_norm(P);
#undef IN
#undef SEAM
}

extern "C" void kernel_launch(void* const* d_in, const int* in_sizes, int n_in, void* d_out, int out_size, void* d_ws, size_t ws_size, hipStream_t stream) {
    static int grid = 0;
    if (grid == 0) {
        if (n_in != 17 || in_sizes[0] != SEQ * D || out_size != SEQ * D || ws_size < WS_END) { fprintf(stderr, "kernel_launch: unexpected shapes (n_in %d, in0 %d, out %d, ws %zu, need %zu)\n", n_in, n_in > 0 ? in_sizes[0] : -1, out_size, ws_size, (size_t)WS_END); grid = -1; return; }
        int dev = 0, cus = 0, per_cu = 0;
        (void)hipGetDevice(&dev); (void)hipDeviceGetAttribute(&cus, hipDeviceAttributeMultiprocessorCount, dev);
        if (hipOccupancyMaxActiveBlocksPerMultiprocessor(&per_cu, (const void*)fwd_kernel, NTHREADS, 0) != hipSuccess || per_cu < 1) { fprintf(stderr, "kernel_launch: occupancy query says %d blocks per CU\n", per_cu); per_cu = 1; }
        (void)hipGetLastError();
        grid = cus;
        if (grid % 8 != 0 || grid < 64) { fprintf(stderr, "kernel_launch: unexpected CU count %d\n", cus); }
    }
    if (grid < 0) return;
    if (hipMemsetAsync((char*)d_ws + WS_CTL, 0, CTL_BYTES, stream) != hipSuccess) { fprintf(stderr, "kernel_launch: memset failed\n"); return; }
    Params p{};
    const float** pp = (const float**)&p;
    for (int i = 0; i < 17; ++i) pp[i] = (const float*)d_in[i];
    p.out = (float*)d_out; p.ws = (unsigned char*)d_ws;
#if MODE == 0
    for (int ph = 0; ph < NPHASE; ++ph) { p.ph_lo = ph; p.ph_hi = ph + 1; hipLaunchKernelGGL(fwd_kernel, dim3(grid), dim3(NTHREADS), 0, stream, p); }
#else
    p.ph_lo = 0; p.ph_hi = NPHASE;
    void* args[] = {&p};
    hipError_t e = hipLaunchCooperativeKernel((const void*)fwd_kernel, dim3(grid), dim3(NTHREADS), args, 0, stream);
    if (e != hipSuccess) fprintf(stderr, "cooperative launch failed: %s (grid %d)\n", hipGetErrorString(e), grid);
#endif
}
```

```cpp
#include <hip/hip_runtime.h>
#include <cstdio>
#include <cstdint>

#ifndef MODE
#define MODE 1
#endif

#define LAS __attribute__((address_space(3)))
typedef _Float16 f16;
typedef _Float16 half8 __attribute__((ext_vector_type(8)));
typedef _Float16 half4 __attribute__((ext_vector_type(4)));
typedef float f32x2 __attribute__((ext_vector_type(2)));
typedef float f32x4 __attribute__((ext_vector_type(4)));
typedef float f32x16 __attribute__((ext_vector_type(16)));
typedef unsigned u32x2 __attribute__((ext_vector_type(2)));
typedef unsigned u32x4 __attribute__((ext_vector_type(4)));
typedef int i32x4 __attribute__((ext_vector_type(4)));

constexpr int D = 1024, SEQ = 16384, NMETA = 16, L = SEQ + NMETA, DFF = 2816;
constexpr int MP = 16640;
constexpr int LP = 16512;
constexpr int NIN = 3840;
constexpr int NCH = 257;
constexpr float EPS = 1e-6f;
constexpr int NTHREADS = 512;
constexpr int LDS_BYTES = 155648 + 1024;
constexpr int NPHASE = 12;

constexpr size_t al256(size_t x) { return (x + 255) & ~(size_t)255; }
constexpr size_t WS_CTL = 0;
constexpr size_t CTL_BYTES = 32768;
constexpr size_t WS_BAR = 2048;
constexpr size_t WS_WGU1 = CTL_BYTES;
constexpr size_t WS_WD1 = WS_WGU1 + (size_t)2 * DFF * D * 2;
constexpr size_t WS_WIN = WS_WD1 + (size_t)D * DFF * 2;
constexpr size_t WS_WOUT = WS_WIN + (size_t)NIN * D * 2;
constexpr size_t WS_WGU2 = WS_WOUT + (size_t)D * D * 2;
constexpr size_t WS_WD2 = WS_WGU2 + (size_t)2 * DFF * D * 2;
constexpr size_t WS_ACTA = WS_WD2 + (size_t)D * DFF * 2;
constexpr size_t WS_G = WS_ACTA + (size_t)MP * D * 2;
constexpr size_t WS_US = WS_G + (size_t)MP * DFF * 2;
constexpr size_t WS_DQ = WS_US + (size_t)NCH * 4 * 64 * 128 * 4;
constexpr size_t WS_IQ = WS_DQ + (size_t)LP * 512 * 2;
constexpr size_t WS_SEL = WS_IQ + (size_t)LP * 512 * 2;
constexpr size_t WS_ROPE = WS_SEL + (size_t)LP * 256 * 2;
constexpr size_t WS_IW = WS_ROPE + al256((size_t)L * 32 * 8);
constexpr size_t WS_GA = WS_IW + (size_t)LP * 8 * 4;
constexpr size_t WS_DECAY = WS_GA + (size_t)LP * 16 * 4;
constexpr size_t WS_SS0 = WS_DECAY + al256((size_t)NCH * 256 * 4);
constexpr size_t WS_SS1 = WS_SS0 + (size_t)MP * 4;
constexpr size_t WS_SS2 = WS_SS1 + (size_t)MP * 64;
constexpr size_t WS_SS3 = WS_SS2 + (size_t)MP * 64;
constexpr size_t WS_END = WS_SS3 + (size_t)MP * 64;
constexpr size_t WS_KV = WS_G;
constexpr size_t WS_GQ = WS_KV + (size_t)8 * LP * 128 * 2;
constexpr size_t WS_GK = WS_GQ + (size_t)LP * 256 * 2;
constexpr size_t WS_GV = WS_GK + (size_t)LP * 256 * 2;
constexpr size_t WS_GR = WS_GV + (size_t)LP * 512 * 2;
constexpr size_t WS_IK = WS_GR + (size_t)LP * 512 * 2;
constexpr size_t WS_ALIAS_END = WS_IK + (size_t)LP * 64 * 2;
static_assert(WS_ALIAS_END <= WS_US, "aliased buffers exceed G");
static_assert(WS_END <= (size_t)256 * 1024 * 1024, "workspace exceeds 256 MiB");
static_assert((size_t)SEQ * D * 2 <= (size_t)NCH * 4 * 64 * 128 * 4, "h2_16 alias");

struct Params {
    const float* x; const float* meta; const float* n1; const float* wg1; const float* wu1; const float* wd1;
    const float* nmix; const float* win; const float* wa2; const float* ba; const float* hn; const float* wout;
    const float* n2; const float* wg2; const float* wu2; const float* wd2; const float* nf;
    float* out; unsigned char* ws; int ph_lo, ph_hi;
};

namespace pg8 {
constexpr int BM = 256, BK = 64, HALF = 128, HTB = HALF * BK * 2, STAGE_BYTES = 8 * HTB, NXCD = 8, WGM = 8;
__host__ __device__ __forceinline__ int lds_byte(int r, int c) { const int st = (r >> 4) * 2 + (c >> 5), rr = r & 15, cc = c & 31, ob = rr * 64 + cc * 2; return st * 1024 + (ob ^ (((ob >> 9) & 1) << 5)); }
__host__ __device__ __forceinline__ int perm32(int rho) { const int n = rho >> 4, i = rho & 15; return 8 * (i >> 2) + 4 * n + (i & 3); }
__host__ __device__ __forceinline__ void stage_rc(int b, int& R, int& C) { const int st = b / 1024, sb = b % 1024, swz = sb ^ (((sb >> 9) & 1) << 5); R = (st >> 1) * 16 + swz / 64; C = (st & 1) * 32 + (swz % 64) / 2; }
struct Unit { int pm, pn; };
struct Gemm { const f16* A; const f16* Bt; int M, N, K; };
struct StaticOrder {
    int nM, nN, nwg, G, c;
    __host__ __device__ void init(int M, int N, int G_, int c_) { nM = M / BM; nN = N / BM; nwg = nM * nN; G = G_; c = c_; }
    __host__ __device__ bool next(int i, Unit& u) const {
        const long Lx = (long)i * G + c; if (Lx >= nwg) return false;
        int wgid = (int)Lx; { const int q = nwg / NXCD, r = nwg % NXCD, xcd = wgid % NXCD, off = wgid / NXCD; wgid = (xcd < r ? xcd * (q + 1) : r * (q + 1) + (xcd - r) * q) + off; }
        const int nig = WGM * nN, gid = wgid / nig, fm = gid * WGM, gsz = (nM - fm) < WGM ? (nM - fm) : WGM;
        u.pm = fm + ((wgid % nig) % gsz); u.pn = (wgid % nig) / gsz; return true;
    }
};
template <class Epi>
__device__ __forceinline__ void gemm_phase(LAS unsigned char* lds, const Gemm g, const StaticOrder& S, const Epi& E) {
    int tid_ = threadIdx.x; asm volatile("" : "+v"(tid_));
    const int tid = tid_, wid = __builtin_amdgcn_readfirstlane(tid >> 6), lane = tid & 63, wr = wid >> 2, wc = wid & 3, fr = lane & 15, fq = lane >> 4;
    const int K = g.K, nt = K / BK;
    unsigned voffA[2], voffB[2];
#pragma unroll
    for (int i = 0; i < 2; ++i) { int R, C; stage_rc(tid * 16 + i * 8192, R, C); const int Rb = (R & ~31) + perm32(R & 31); voffA[i] = (unsigned)(R * K + C) * 2u; voffB[i] = (unsigned)(Rb * K + C) * 2u; }
    const size_t kstep = (size_t)(BK * 2);
    const size_t hstep = (size_t)HALF * K * 2;
    const size_t tstep = 2 * hstep;
    const unsigned ldsw = (unsigned)wid * 1024u;
    const int aoff = lds_byte(wr * 64 + fr, fq * 8), boff = lds_byte(wc * 32 + fr, fq * 8);
#define PG8_SA(b, h) (((b) * 2 + (h)) * HTB)
#define PG8_SB(b, h) ((4 + (b) * 2 + (h)) * HTB)
#define PG8_STAGE(bufoff, gbase, voff) do { _Pragma("unroll") for (int _i = 0; _i < 2; ++_i) \
        __builtin_amdgcn_global_load_lds((const unsigned*)((const char*)(gbase) + (voff)[_i]), (LAS unsigned*)(lds + (bufoff) + ldsw + _i * 8192), 16, 0, 0); } while (0)
#define PG8_LDA(dst, b, h) do { _Pragma("unroll") for (int m = 0; m < 4; ++m) _Pragma("unroll") for (int k = 0; k < 2; ++k) dst[m][k] = *(const LAS half8*)(lds + PG8_SA(b, h) + aoff + m * 2048 + k * 1024); } while (0)
#define PG8_LDB(dst, b, h) do { _Pragma("unroll") for (int n = 0; n < 2; ++n) _Pragma("unroll") for (int k = 0; k < 2; ++k) dst[n][k] = *(const LAS half8*)(lds + PG8_SB(b, h) + boff + n * 2048 + k * 1024); } while (0)
#define PG8_MMA(ai, bj, At, Bt) do { __builtin_amdgcn_s_setprio(1); _Pragma("unroll") for (int m = 0; m < 4; ++m) _Pragma("unroll") for (int n = 0; n < 2; ++n) _Pragma("unroll") for (int k = 0; k < 2; ++k) { \
        if constexpr (Epi::I8) acc[ai][bj][m][n] = __builtin_bit_cast(f32x4, __builtin_amdgcn_mfma_i32_16x16x64_i8(__builtin_bit_cast(i32x4, Bt[n][k]), __builtin_bit_cast(i32x4, At[m][k]), __builtin_bit_cast(i32x4, acc[ai][bj][m][n]), 0, 0, 0)); \
        else acc[ai][bj][m][n] = __builtin_amdgcn_mfma_f32_16x16x32_f16(Bt[n][k], At[m][k], acc[ai][bj][m][n], 0, 0, 0); } __builtin_amdgcn_s_setprio(0); } while (0)
#define PG8_WAIT_V(n) asm volatile("s_waitcnt vmcnt(" #n ")" ::: "memory")
#define PG8_WAIT_L(n) asm volatile("s_waitcnt lgkmcnt(" #n ")" ::: "memory")
#define PG8_BAR __builtin_amdgcn_s_barrier()
#define PG8_SCHED __builtin_amdgcn_sched_barrier(0)
    Unit cur, nxt; int ui = 0;
    if (!S.next(0, cur)) return;
    f32x4 acc[2][2][4][2];
#pragma unroll
    for (int a = 0; a < 2; ++a)
#pragma unroll
        for (int b = 0; b < 2; ++b)
#pragma unroll
            for (int m = 0; m < 4; ++m)
#pragma unroll
                for (int n = 0; n < 2; ++n) acc[a][b][m][n] = (f32x4){0.f, 0.f, 0.f, 0.f};
    half8 At[4][2], B0[2][2], B1[2][2];
    const char* cA = (const char*)g.A + (size_t)cur.pm * tstep; const char* cB = (const char*)g.Bt + (size_t)cur.pn * tstep;
    PG8_STAGE(PG8_SB(0, 0), cB, voffB); PG8_STAGE(PG8_SA(0, 0), cA, voffA); PG8_STAGE(PG8_SB(0, 1), cB + hstep, voffB); PG8_STAGE(PG8_SA(0, 1), cA + hstep, voffA);
    if (wr == 1) PG8_BAR;
    PG8_WAIT_V(4); PG8_BAR;
    PG8_STAGE(PG8_SB(1, 0), cB + kstep, voffB); PG8_STAGE(PG8_SA(1, 0), cA + kstep, voffA); PG8_STAGE(PG8_SB(1, 1), cB + hstep + kstep, voffB);
    PG8_WAIT_V(6); PG8_BAR;
    for (;;) {
        const bool has_next = S.next(ui + 1, nxt);
        const char* nA = has_next ? (const char*)g.A + (size_t)nxt.pm * tstep : cA; const char* nB = has_next ? (const char*)g.Bt + (size_t)nxt.pn * tstep : cB;
        for (int t = 0; t < nt; t += 2) {
            const bool last = (t == nt - 2);
            const char* a1 = cA + (size_t)(t + 1) * kstep;
            const char* a2 = last ? nA : cA + (size_t)(t + 2) * kstep; const char* b2 = last ? nB : cB + (size_t)(t + 2) * kstep;
            const char* a3 = a2 + kstep; const char* b3 = b2 + kstep;
            PG8_LDB(B0, 0, 0); PG8_SCHED; PG8_LDA(At, 0, 0); PG8_STAGE(PG8_SA(1, 1), a1 + hstep, voffA);
            PG8_WAIT_L(8); PG8_BAR; PG8_WAIT_L(0); PG8_MMA(0, 0, At, B0); PG8_BAR; PG8_SCHED;
            PG8_LDB(B1, 0, 1); PG8_STAGE(PG8_SB(0, 0), b2, voffB);
            PG8_BAR; PG8_WAIT_L(0); PG8_MMA(0, 1, At, B1); PG8_BAR;
            PG8_LDA(At, 0, 1); PG8_STAGE(PG8_SA(0, 0), a2, voffA);
            PG8_BAR; PG8_WAIT_L(0); PG8_MMA(1, 0, At, B0); PG8_BAR; PG8_SCHED;
            PG8_STAGE(PG8_SB(0, 1), b2 + hstep, voffB);
            PG8_WAIT_V(6); PG8_BAR; PG8_MMA(1, 1, At, B1); PG8_BAR;
            PG8_LDB(B0, 1, 0); PG8_SCHED; PG8_LDA(At, 1, 0); PG8_STAGE(PG8_SA(0, 1), a2 + hstep, voffA);
            PG8_WAIT_L(8); PG8_BAR; PG8_WAIT_L(0); PG8_MMA(0, 0, At, B0); PG8_BAR; PG8_SCHED;
            PG8_LDB(B1, 1, 1); PG8_STAGE(PG8_SB(1, 0), b3, voffB);
            PG8_BAR; PG8_WAIT_L(0); PG8_MMA(0, 1, At, B1); PG8_BAR;
            PG8_LDA(At, 1, 1); PG8_STAGE(PG8_SA(1, 0), a3, voffA);
            PG8_BAR; PG8_WAIT_L(0); PG8_MMA(1, 0, At, B0); PG8_BAR; PG8_SCHED;
            PG8_STAGE(PG8_SB(1, 1), b3 + hstep, voffB);
            PG8_WAIT_V(6); PG8_BAR; PG8_MMA(1, 1, At, B1); PG8_BAR;
        }
        if constexpr (Epi::I8) {
#pragma unroll
            for (int a = 0; a < 2; ++a)
#pragma unroll
                for (int b = 0; b < 2; ++b)
#pragma unroll
                    for (int m = 0; m < 4; ++m)
#pragma unroll
                        for (int n = 0; n < 2; ++n) { const i32x4 v = __builtin_bit_cast(i32x4, acc[a][b][m][n]); acc[a][b][m][n] = (f32x4){(float)v[0], (float)v[1], (float)v[2], (float)v[3]}; }
        }
        E(acc, cur, wr, wc, fr, fq);
        if (!has_next) break;
#pragma unroll
        for (int a = 0; a < 2; ++a)
#pragma unroll
            for (int b = 0; b < 2; ++b)
#pragma unroll
                for (int m = 0; m < 4; ++m)
#pragma unroll
                    for (int n = 0; n < 2; ++n) acc[a][b][m][n] = (f32x4){0.f, 0.f, 0.f, 0.f};
        cur = nxt; cA = nA; cB = nB; ++ui;
    }
    PG8_WAIT_V(0);
    if (wr == 0) PG8_BAR;
    PG8_BAR;
#undef PG8_SA
#undef PG8_SB
#undef PG8_STAGE
#undef PG8_LDA
#undef PG8_LDB
#undef PG8_MMA
#undef PG8_WAIT_V
#undef PG8_WAIT_L
#undef PG8_BAR
#undef PG8_SCHED
}
}

__device__ __forceinline__ float silu_f(float v) { return v * __builtin_amdgcn_rcpf(1.0f + __expf(-v)); }
__device__ __forceinline__ half4 to_half4(f32x4 v) { half4 h; h[0] = (f16)v[0]; h[1] = (f16)v[1]; h[2] = (f16)v[2]; h[3] = (f16)v[3]; return h; }

__device__ __forceinline__ float row_rstd(const float* ss, int np, int row) {
    float s;
    if (np == 1) s = ss[row];
    else { const f32x4* p = (const f32x4*)(ss + (size_t)row * 16); const f32x4 a = p[0], b = p[1], c = p[2], d = p[3];
        s = (((a[0] + a[1]) + (a[2] + a[3])) + ((b[0] + b[1]) + (b[2] + b[3]))) + (((c[0] + c[1]) + (c[2] + c[3])) + ((d[0] + d[1]) + (d[2] + d[3]))); }
    return rsqrtf(s * (1.0f / D) + EPS);
}
template <bool I8_> struct EpiSwiglu {
    static constexpr bool I8 = I8_;
    f16* G; const float* ss; int np; const float* sa; const float* sw;
    __device__ __forceinline__ void operator()(const f32x4 (&acc)[2][2][4][2], const pg8::Unit& u, int wr, int wc, int fr_, int fq_) const {
        int fr = fr_, fq = fq_; asm volatile("" : "+v"(fr), "+v"(fq));
        f32x4 swg[2], swu[2];
        if constexpr (I8) {
#pragma unroll
            for (int n = 0; n < 2; ++n) { swg[n] = *(const f32x4*)(sw + u.pn * 256 + wc * 32 + 8 * fq + 4 * n); swu[n] = *(const f32x4*)(sw + u.pn * 256 + 128 + wc * 32 + 8 * fq + 4 * n); }
        }
#pragma unroll
        for (int ai = 0; ai < 2; ++ai)
#pragma unroll
            for (int m = 0; m < 4; ++m) {
                const int row = u.pm * 256 + ai * 128 + wr * 64 + m * 16 + fr;
                float rs = row_rstd(ss, np, row); if constexpr (I8) rs *= sa[row];
                const float ce = -1.4426950408889634f * rs, rs2 = rs * rs; half8 o;
#pragma unroll
                for (int n = 0; n < 2; ++n) {
                    f32x4 g = acc[ai][0][m][n], u = acc[ai][1][m][n];
                    if constexpr (I8) { g = g * swg[n]; u = u * swu[n]; }
                    const f32x4 t = g * ce; f32x4 e, r;
#pragma unroll
                    for (int j = 0; j < 4; ++j) e[j] = __builtin_amdgcn_exp2f(t[j]);
                    const f32x4 d = e + 1.0f;
#pragma unroll
                    for (int j = 0; j < 4; ++j) r[j] = __builtin_amdgcn_rcpf(d[j]);
                    const f32x4 w = (g * u) * (r * rs2);
#pragma unroll
                    for (int j = 0; j < 4; ++j) o[4 * n + j] = (f16)w[j];
                }
                *(half8*)(G + (size_t)row * DFF + u.pn * 128 + wc * 32 + 8 * fq) = o;
            }
    }
};
template <bool SRC16> struct EpiResid {
    static constexpr bool I8 = false;
    const void* src; f16* h16; float* ss; float alpha;
    __device__ __forceinline__ void operator()(const f32x4 (&acc)[2][2][4][2], const pg8::Unit& u, int wr, int wc, int fr_, int fq_) const {
        int fr = fr_, fq = fq_; asm volatile("" : "+v"(fr), "+v"(fq));
#pragma unroll
        for (int ai = 0; ai < 2; ++ai)
#pragma unroll
            for (int m = 0; m < 4; ++m) {
                const int row = u.pm * 256 + ai * 128 + wr * 64 + m * 16 + fr; float part = 0.f;
#pragma unroll
                for (int bj = 0; bj < 2; ++bj) {
                    const size_t off = (size_t)row * D + u.pn * 256 + bj * 128 + wc * 32 + 8 * fq; half8 h; f32x4 sv[2];
                    if (SRC16) { const half8 s8 = *(const half8*)((const f16*)src + off);
#pragma unroll
                        for (int j = 0; j < 4; ++j) { sv[0][j] = (float)s8[j]; sv[1][j] = (float)s8[4 + j]; } }
                    else { sv[0] = *(const f32x4*)((const float*)src + off); sv[1] = *(const f32x4*)((const float*)src + off + 4); }
#pragma unroll
                    for (int n = 0; n < 2; ++n) {
                        const f32x4 o = sv[n] + alpha * acc[ai][bj][m][n];
#pragma unroll
                        for (int j = 0; j < 4; ++j) h[4 * n + j] = (f16)o[j];
                        part += (o[0] * o[0] + o[1] * o[1]) + (o[2] * o[2] + o[3] * o[3]);
                    }
                    *(half8*)(h16 + off) = h;
                }
                part += __shfl_xor(part, 16); part += __shfl_xor(part, 32);
                if (fq == 0) ss[(size_t)row * 16 + u.pn * 4 + wc] = part;
            }
    }
};
constexpr float K_I8_SCALE = 127.0f / 8.0f;
__device__ __forceinline__ void rope8(const f32x4 (&x1)[2], const f32x4 (&x2)[2], const f32x2* rp, float sc, float (&o1)[8], float (&o2)[8]) {
#pragma unroll
    for (int n = 0; n < 2; ++n) {
        const f32x4 cs0 = *(const f32x4*)(rp + 4 * n), cs1 = *(const f32x4*)(rp + 4 * n + 2);
        o1[4 * n + 0] = (x1[n][0] * cs0[0] - x2[n][0] * cs0[1]) * sc; o2[4 * n + 0] = (x2[n][0] * cs0[0] + x1[n][0] * cs0[1]) * sc;
        o1[4 * n + 1] = (x1[n][1] * cs0[2] - x2[n][1] * cs0[3]) * sc; o2[4 * n + 1] = (x2[n][1] * cs0[2] + x1[n][1] * cs0[3]) * sc;
        o1[4 * n + 2] = (x1[n][2] * cs1[0] - x2[n][2] * cs1[1]) * sc; o2[4 * n + 2] = (x2[n][2] * cs1[0] + x1[n][2] * cs1[1]) * sc;
        o1[4 * n + 3] = (x1[n][3] * cs1[2] - x2[n][3] * cs1[3]) * sc; o2[4 * n + 3] = (x2[n][3] * cs1[2] + x1[n][3] * cs1[3]) * sc;
    }
}
__device__ __forceinline__ u32x2 pack_i8x8(const float (&v)[8]) {
    u32x2 r;
#pragma unroll
    for (int w = 0; w < 2; ++w) { unsigned word = 0u;
#pragma unroll
        for (int j = 0; j < 4; ++j) { const int q = (int)__builtin_rintf(fminf(fmaxf(v[4 * w + j] * K_I8_SCALE, -127.f), 127.f)); word |= ((unsigned)q & 0xffu) << (8 * j); }
        r[w] = word; }
    return r;
}
__device__ __forceinline__ u32x2 pack_bf8x8(const float (&v)[8]) {
    u32x2 r;
#pragma unroll
    for (int w = 0; w < 2; ++w) { int word = __builtin_amdgcn_cvt_pk_bf8_f32(v[4 * w], v[4 * w + 1], 0, false); word = __builtin_amdgcn_cvt_pk_bf8_f32(v[4 * w + 2], v[4 * w + 3], word, true); r[w] = (unsigned)word; }
    return r;
}
struct EpiInProj {
    static constexpr bool I8 = false;
    const float* ss; const f32x2* rope; unsigned char* ws;
    __device__ __forceinline__ void operator()(const f32x4 (&acc)[2][2][4][2], const pg8::Unit& u, int wr, int wc, int fr_, int fq_) const {
        int fr = fr_, fq = fq_; asm volatile("" : "+v"(fr), "+v"(fq));
        const int pn = u.pn;
        if (pn >= 8 && pn <= 11) {
            unsigned char* lb = (pn <= 9) ? ws + WS_KV + (size_t)((pn - 8) * 4 + wc) * LP * 128 + 8 * fq
                                          : ws + WS_KV + (size_t)((pn - 10) * 4 + (wc >> 1)) * LP * 128 + 64 + (wc & 1) * 32 + 8 * fq;
#pragma unroll
            for (int ai = 0; ai < 2; ++ai)
#pragma unroll
                for (int m = 0; m < 4; ++m) {
                    const int p = u.pm * 256 + ai * 128 + wr * 64 + m * 16 + fr;
                    const int t = p < SEQ ? p + NMETA : p - SEQ;
                    if (p < L) {
                        const float sc = row_rstd(ss, 16, p);
                        if (pn <= 9) {
                            float o1[8], o2[8]; rope8(acc[ai][0][m], acc[ai][1][m], rope + (size_t)t * 32 + 8 * fq, sc, o1, o2);
                            unsigned char* d8 = lb + (size_t)t * 128; *(u32x2*)d8 = pack_i8x8(o1); *(u32x2*)(d8 + 32) = pack_i8x8(o2);
                        } else {
#pragma unroll
                            for (int bj = 0; bj < 2; ++bj) { float v[8];
#pragma unroll
                                for (int j = 0; j < 4; ++j) { v[j] = acc[ai][bj][m][0][j] * sc; v[4 + j] = acc[ai][bj][m][1][j] * sc; }
                                *(u32x2*)(lb + (size_t)t * 128 + (size_t)bj * 2 * LP * 128) = pack_bf8x8(v); }
                        }
                    }
                    asm volatile("" ::: "memory");
                }
            return;
        }
        int mode = 0, stride = 256; float scale = 1.0f; f16* lanebase;
        if (pn == 0) lanebase = (f16*)(ws + WS_GQ) + wc * 32 + 8 * fq;
        else if (pn == 1) lanebase = (f16*)(ws + WS_GK) + wc * 32 + 8 * fq;
        else if (pn <= 3) { lanebase = (f16*)(ws + WS_GV) + (pn - 2) * 256 + wc * 32 + 8 * fq; stride = 512; }
        else if (pn <= 5) { lanebase = (f16*)(ws + WS_GR) + (pn - 4) * 256 + wc * 32 + 8 * fq; stride = 512; }
        else if (pn <= 7) { lanebase = (f16*)(ws + WS_DQ); mode = 6; scale = 0.125f; }
        else if (pn <= 13) { lanebase = (f16*)(ws + WS_IQ) + (pn - 12) * 256 + wc * 64 + 8 * fq; stride = 512; mode = 1; scale = 0.125f; }
        else { lanebase = (f16*)(ws + WS_IK) + 8 * fq; stride = 64; mode = wc == 0 ? 1 : (wc == 1 ? 2 : 3); }
#pragma unroll
        for (int ai = 0; ai < 2; ++ai)
#pragma unroll
            for (int m = 0; m < 4; ++m) {
                const int p = u.pm * 256 + ai * 128 + wr * 64 + m * 16 + fr;
                const int t = p < SEQ ? p + NMETA : p - SEQ;
                if (p < L && mode != 3) {
                    const float rs = row_rstd(ss, 16, p);
                    if (mode == 6) {
                        float o1[8], o2[8]; rope8(acc[ai][0][m], acc[ai][1][m], rope + (size_t)t * 32 + 8 * fq, rs * scale, o1, o2);
                        float qm = 1e-20f;
#pragma unroll
                        for (int j = 0; j < 8; ++j) qm = fmaxf(qm, fmaxf(fabsf(o1[j]), fabsf(o2[j])));
                        qm = fmaxf(qm, __shfl_xor(qm, 16)); qm = fmaxf(qm, __shfl_xor(qm, 32));
                        const float qsc = 127.0f * __builtin_amdgcn_rcpf(qm); u32x2 w1, w2;
#pragma unroll
                        for (int w = 0; w < 2; ++w) { unsigned a = 0u, b = 0u;
#pragma unroll
                            for (int j = 0; j < 4; ++j) { a |= ((unsigned)(int)__builtin_rintf(o1[4 * w + j] * qsc) & 0xffu) << (8 * j); b |= ((unsigned)(int)__builtin_rintf(o2[4 * w + j] * qsc) & 0xffu) << (8 * j); }
                            w1[w] = a; w2[w] = b; }
                        const int head = (pn - 6) * 4 + wc; unsigned char* qrow = ws + WS_DQ + (size_t)t * 512 + head * 64 + 8 * fq;
                        *(u32x2*)qrow = w1; *(u32x2*)(qrow + 32) = w2;
                        if (fq == 0) ((float*)(ws + WS_DQ + (size_t)LP * 512))[(size_t)t * 8 + head] = qm * (1.0f / (127.0f * K_I8_SCALE));
                    } else if (mode == 1) {
                        float o1[8], o2[8]; rope8(acc[ai][0][m], acc[ai][1][m], rope + (size_t)t * 32 + 8 * fq, rs * scale, o1, o2);
                        half8 h1, h2;
#pragma unroll
                        for (int j = 0; j < 8; ++j) { h1[j] = (f16)o1[j]; h2[j] = (f16)o2[j]; }
                        f16* dst = lanebase + (size_t)t * stride; *(half8*)dst = h1; *(half8*)(dst + 32) = h2;
                    } else if (mode == 2) {
                        if (fq < 2) { float* gp = (float*)(ws + WS_GA) + (size_t)t * 16 + 8 * fq; *(f32x4*)gp = acc[ai][0][m][0] * rs; *(f32x4*)(gp + 4) = acc[ai][0][m][1] * rs; }
                        else if (fq == 2) { float* ip = (float*)(ws + WS_IW) + (size_t)t * 8; const float r2 = rs * 0.35355339059327373f; *(f32x4*)ip = acc[ai][0][m][0] * r2; *(f32x4*)(ip + 4) = acc[ai][0][m][1] * r2; }
                    } else {
#pragma unroll
                        for (int bj = 0; bj < 2; ++bj) { half8 h;
#pragma unroll
                            for (int j = 0; j < 4; ++j) { h[j] = (f16)(acc[ai][bj][m][0][j] * rs); h[4 + j] = (f16)(acc[ai][bj][m][1][j] * rs); }
                            *(half8*)(lanebase + (size_t)t * stride + bj * 128) = h; }
                    }
                }
                asm volatile("" ::: "memory");
            }
    }
};

__device__ __forceinline__ const float* w_src(const Params& P, int kind, int n, int& ld, const float*& gain) {
    switch (kind) {
    case 0: case 4: { const int pn = n >> 8, bj = (n >> 7) & 1, cc = n & 127; ld = DFF; gain = kind == 0 ? P.n1 : P.n2;
        const float* w = kind == 0 ? (bj ? P.wu1 : P.wg1) : (bj ? P.wu2 : P.wg2); return w + pn * 128 + cc; }
    case 1: ld = D; gain = nullptr; return P.wd1 + n;
    case 5: ld = D; gain = nullptr; return P.wd2 + n;
    case 3: ld = D; gain = nullptr; return P.wout + n;
    default: { ld = 3672; gain = P.nmix; const int pn = n >> 8, c = n & 255, bj = c >> 7, hh = (c >> 5) & 3, dd = c & 31; int j;
        if (pn == 0) j = c; else if (pn == 1) j = 256 + c; else if (pn <= 3) j = 512 + (pn - 2) * 256 + c; else if (pn <= 5) j = 1024 + (pn - 4) * 256 + c;
        else if (pn <= 7) j = 1552 + (pn - 6) * 256 + hh * 64 + bj * 32 + dd;
        else if (pn <= 9) j = 2064 + (pn - 8) * 256 + hh * 64 + bj * 32 + dd;
        else if (pn <= 11) j = 2576 + (pn - 10) * 256 + c;
        else if (pn <= 13) j = 3088 + (pn - 12) * 256 + hh * 64 + bj * 32 + dd;
        else { if (c < 32) j = 3600 + c; else if (c < 48) j = 1536 + (c - 32); else if (c < 56) j = 3664 + (c - 48); else if (c >= 128 && c < 160) j = 3600 + 32 + (c - 128); else j = -1; }
        return j < 0 ? nullptr : P.win + j; }
    }
}
__device__ __forceinline__ void prep_weight(const Params& P, const int kind, const int N, const int K, f16* dst, int& cursor, int& tbase, LAS f16* tl) {
    const int tid = threadIdx.x, G = gridDim.x, tn = N / 64, tk = K / 256, ntile = tn * tk;
    const int n = tid & 63, kk0 = tid >> 6;
    float v[32], vn[32];
#define PREP_LOAD(dstv, tI) do { const int n0_ = ((tI) % tn) * 64, k0_ = ((tI) / tn) * 256; int ld; const float* gain; const float* col = w_src(P, kind, n0_ + n, ld, gain); \
        _Pragma("unroll") for (int i = 0; i < 32; ++i) dstv[i] = col ? col[(size_t)(k0_ + kk0 + 8 * i) * ld] : 0.f; \
        if (gain) { _Pragma("unroll") for (int i = 0; i < 32; ++i) dstv[i] *= gain[k0_ + kk0 + 8 * i]; } } while (0)
    if (cursor < tbase + ntile) PREP_LOAD(v, cursor - tbase);
#pragma unroll 1
    for (; cursor < tbase + ntile; cursor += G) {
        const int tI = cursor - tbase, n0 = (tI % tn) * 64, k0 = (tI / tn) * 256;
        const bool more = cursor + G < tbase + ntile;
        if (more) PREP_LOAD(vn, tI + G);
#pragma unroll
        for (int i = 0; i < 32; ++i) tl[n * 264 + kk0 + 8 * i] = (f16)v[i];
        __syncthreads();
        { const int nr = tid >> 3, seg = tid & 7;
#pragma unroll
          for (int j = 0; j < 4; ++j) *(half8*)(dst + (size_t)(n0 + nr) * K + k0 + (seg + 8 * j) * 8) = *(const LAS half8*)(tl + nr * 264 + (seg + 8 * j) * 8); }
        __syncthreads();
        if (more) {
#pragma unroll
            for (int i = 0; i < 32; ++i) v[i] = vn[i];
        }
    }
#undef PREP_LOAD
    tbase += ntile;
}
__device__ __forceinline__ void prep_weight_i8(const Params& P, const int kind, const int N, unsigned char* dst, float* sw, int first, int step, LAS unsigned char* lds) {
    const int tid = threadIdx.x, n = tid & 63, kk0 = tid >> 6;
    LAS float* pmax = (LAS float*)lds; LAS unsigned* img = (LAS unsigned*)(lds + 2048);
#pragma unroll 1
    for (int task = first; task < N / 64; task += step) {
        const int n0 = task * 64; int ld; const float* gain; const float* col = w_src(P, kind, n0 + n, ld, gain);
        float v[128]; float mx = 0.f;
#pragma unroll
        for (int i = 0; i < 128; ++i) v[i] = col ? col[(size_t)(kk0 * 128 + i) * ld] : 0.f;
        if (gain) {
#pragma unroll
            for (int i = 0; i < 128; ++i) v[i] *= gain[kk0 * 128 + i];
        }
#pragma unroll
        for (int i = 0; i < 128; ++i) mx = fmaxf(mx, fabsf(v[i]));
        pmax[kk0 * 64 + n] = mx;
        __syncthreads();
#pragma unroll
        for (int q = 0; q < 8; ++q) mx = fmaxf(mx, pmax[q * 64 + n]);
        const float sc = mx > 0.f ? 127.0f / mx : 0.f;
        if (kk0 == 0) sw[n0 + n] = mx * (1.0f / 127.0f);
#pragma unroll
        for (int w = 0; w < 32; ++w) { unsigned word = 0u;
#pragma unroll
            for (int j = 0; j < 4; ++j) word |= ((unsigned)(int)__builtin_rintf(v[4 * w + j] * sc) & 0xffu) << (8 * j);
            img[n * 260 + kk0 * 32 + w] = word; }
        __syncthreads();
        { const int nr = tid >> 3, seg = tid & 7;
#pragma unroll
          for (int j = 0; j < 8; ++j) *(u32x4*)(dst + (size_t)(n0 + nr) * D + (seg + 8 * j) * 16) = *(const LAS u32x4*)(img + nr * 260 + (seg + 8 * j) * 4); }
        __syncthreads();
    }
}
__device__ __forceinline__ void quant_rows_i8(const f16* src, unsigned char* dst, float* sa, int rows) {
    const int tid = threadIdx.x, lane = tid & 63, gw = blockIdx.x * 8 + (tid >> 6), nw = gridDim.x * 8;
    for (int r = gw; r < rows; r += nw) {
        const half8 a = *(const half8*)(src + (size_t)r * D + lane * 16), b = *(const half8*)(src + (size_t)r * D + lane * 16 + 8);
        float v[16], mx = 0.f;
#pragma unroll
        for (int j = 0; j < 8; ++j) { v[j] = (float)a[j]; v[8 + j] = (float)b[j]; }
#pragma unroll
        for (int j = 0; j < 16; ++j) mx = fmaxf(mx, fabsf(v[j]));
#pragma unroll
        for (int o = 32; o >= 1; o >>= 1) mx = fmaxf(mx, __shfl_xor(mx, o));
        const float sc = mx > 0.f ? 127.0f / mx : 0.f; u32x4 w;
#pragma unroll
        for (int q = 0; q < 4; ++q) { unsigned word = 0u;
#pragma unroll
            for (int j = 0; j < 4; ++j) word |= ((unsigned)(int)__builtin_rintf(v[4 * q + j] * sc) & 0xffu) << (8 * j);
            w[q] = word; }
        *(u32x4*)(dst + (size_t)r * D + lane * 16) = w;
        if (lane == 0) sa[r] = mx * (1.0f / 127.0f);
    }
}
__device__ __forceinline__ void p0_prologue(const Params& P, LAS unsigned char* lds) {
    const int tid = threadIdx.x, bid = blockIdx.x, G = gridDim.x, lane = tid & 63;
    unsigned char* ws = P.ws;
    int tbase = 0, cursor = bid;
    LAS f16* tl = (LAS f16*)lds;
    prep_weight(P, 0, 2 * DFF, D, (f16*)(ws + WS_WGU1), cursor, tbase, tl);
    prep_weight(P, 1, D, DFF, (f16*)(ws + WS_WD1), cursor, tbase, tl);
    prep_weight(P, 2, NIN, D, (f16*)(ws + WS_WIN), cursor, tbase, tl);
    float* ss0 = (float*)(ws + WS_SS0);
    f16* acta = (f16*)(ws + WS_ACTA);
    const int gw = bid * 8 + (tid >> 6), nw = G * 8;
    for (int p = gw; p < L; p += nw) {
        const float* src = p < SEQ ? P.x + (size_t)p * D : P.meta + (size_t)(p - SEQ) * D; float s = 0.f;
#pragma unroll
        for (int i = 0; i < 4; ++i) { const f32x4 v = *(const f32x4*)(src + lane * 4 + 256 * i); s += (v[0] * v[0] + v[1] * v[1]) + (v[2] * v[2] + v[3] * v[3]); *(half4*)(acta + (size_t)p * D + lane * 4 + 256 * i) = to_half4(v); }
#pragma unroll
        for (int o = 32; o >= 1; o >>= 1) s += __shfl_xor(s, o);
        if (lane == 0) ss0[p] = s;
    }
    const int gt = bid * NTHREADS + tid, ngt = G * NTHREADS;
    for (int i = gt; i < MP; i += ngt) { if (i >= L) ss0[i] = (float)D; }
    f32x2* rope = (f32x2*)(ws + WS_ROPE);
    for (int i = gt; i < L * 32; i += ngt) { const int t = i >> 5, f = i & 31; const double inv = exp(-(double)f * (9.210340371976184 / 32.0)); double sn, cs; sincos((double)t * inv, &sn, &cs); rope[i] = (f32x2){(float)cs, (float)sn}; }
}

__device__ __forceinline__ void meta_down(const Params& P, LAS unsigned char* lds) {
    const int tid = threadIdx.x, lane = tid & 63, wid = tid >> 6;
    const f16* Gm = (const f16*)(P.ws + WS_G) + (size_t)SEQ * DFF; const f16* Wt = (const f16*)(P.ws + WS_WD1);
    f16* acta = (f16*)P.out; float* ss1 = (float*)(P.ws + WS_SS1); LAS float* slot = (LAS float*)lds;
    for (int task = blockIdx.x; task < NMETA * 16; task += gridDim.x) {
        const int r = task >> 4, cg = task & 15; float part = 0.f;
#pragma unroll 1
        for (int q = 0; q < 2; ++q) {
            const int n0 = cg * 64 + (2 * wid + q) * 4; float a[4] = {0.f, 0.f, 0.f, 0.f};
            for (int kc = lane; kc < DFF / 8; kc += 64) {
                const half8 gv = *(const half8*)(Gm + (size_t)r * DFF + kc * 8);
#pragma unroll
                for (int j = 0; j < 4; ++j) { const half8 wv = *(const half8*)(Wt + (size_t)(n0 + j) * DFF + kc * 8);
#pragma unroll
                    for (int e = 0; e < 8; ++e) a[j] += (float)gv[e] * (float)wv[e]; }
            }
#pragma unroll
            for (int o = 32; o >= 1; o >>= 1) { a[0] += __shfl_xor(a[0], o); a[1] += __shfl_xor(a[1], o); a[2] += __shfl_xor(a[2], o); a[3] += __shfl_xor(a[3], o); }
            f32x4 o;
#pragma unroll
            for (int j = 0; j < 4; ++j) { o[j] = P.meta[r * D + n0 + j] + 0.5f * a[j]; part += o[j] * o[j]; }
            if (lane == 0) *(half4*)(acta + (size_t)(SEQ + r) * D + n0) = to_half4(o);
        }
        if (lane == 0) slot[wid] = part;
        __syncthreads();
        if (tid == 0) { float s = 0.f; for (int w = 0; w < 8; ++w) s += slot[w]; ss1[(size_t)(SEQ + r) * 16 + cg] = s; }
        __syncthreads();
    }
}

__device__ __forceinline__ float logsigmoid_f(float z) { return fminf(z, 0.f) - __logf(1.0f + __expf(-fabsf(z))); }
__device__ __forceinline__ void gla_gates(const Params& P, int c, int h, LAS float* bl) {
    const int tid = threadIdx.x, ti = tid >> 3, d0 = (tid & 7) * 8, tt = 64 * c - 48 + ti; const float* GA = (const float*)(P.ws + WS_GA);
    {
        float z[8];
        if (tt >= 0 && tt < L) {
            const f32x4 b0 = *(const f32x4*)(P.ba + 64 * h + d0), b1 = *(const f32x4*)(P.ba + 64 * h + d0 + 4);
#pragma unroll
            for (int m = 0; m < 4; ++m) { z[m] = b0[m]; z[4 + m] = b1[m]; }
            f32x4 a4[4];
#pragma unroll
            for (int q = 0; q < 4; ++q) a4[q] = *(const f32x4*)(GA + (size_t)tt * 16 + 4 * q);
#pragma unroll
            for (int r = 0; r < 16; ++r) { const float ar = a4[r >> 2][r & 3]; const f32x4 w0 = *(const f32x4*)(P.wa2 + r * 256 + 64 * h + d0), w1 = *(const f32x4*)(P.wa2 + r * 256 + 64 * h + d0 + 4);
#pragma unroll
                for (int m = 0; m < 4; ++m) { z[m] += ar * w0[m]; z[4 + m] += ar * w1[m]; } }
#pragma unroll
            for (int m = 0; m < 8; ++m) z[m] = logsigmoid_f(z[m]) * (1.0f / 16.0f);
        } else {
#pragma unroll
            for (int m = 0; m < 8; ++m) z[m] = 0.f;
        }
#pragma unroll
        for (int m = 0; m < 8; ++m) bl[ti * 65 + d0 + m] = z[m];
    }
    __syncthreads();
    {
        const int d = tid & 63, seg = tid >> 6; float v[8], run = 0.f;
#pragma unroll
        for (int i = 0; i < 8; ++i) { run += bl[(seg * 8 + i) * 65 + d]; v[i] = run; }
#pragma unroll
        for (int i = 0; i < 8; ++i) bl[(seg * 8 + i) * 65 + d] = v[i];
        __syncthreads();
        float off = 0.f;
#pragma unroll
        for (int sg = 0; sg < 7; ++sg) off += (sg < seg) ? bl[(sg * 8 + 7) * 65 + d] : 0.f;
        __syncthreads();
#pragma unroll
        for (int i = 0; i < 8; ++i) bl[(seg * 8 + i) * 65 + d] = v[i] + off;
    }
    __syncthreads();
}
__device__ __forceinline__ void gla_a_unit(const Params& P, int unit, LAS unsigned char* lds) {
    int tid_ = threadIdx.x; asm volatile("" : "+v"(tid_));
    const int tid = tid_, lane = tid & 63, wid = tid >> 6, c = unit >> 2, h = unit & 3;
    LAS float* bl = (LAS float*)lds; LAS float* ks = bl + 4160; LAS float* vs = ks + 4096;
    const f16* GK = (const f16*)(P.ws + WS_GK); const f16* GV = (const f16*)(P.ws + WS_GV);
    float* U = (float*)(P.ws + WS_US); float* DEC = (float*)(P.ws + WS_DECAY);
    const int ti = tid >> 3, d0 = (tid & 7) * 8, tt = 64 * c - 48 + ti; const bool tv = tt >= 0 && tt < L;
    half8 k8, v8[2];
#pragma unroll
    for (int m = 0; m < 8; ++m) { k8[m] = (f16)0.f; v8[0][m] = (f16)0.f; v8[1][m] = (f16)0.f; }
    if (tv) k8 = *(const half8*)(GK + (size_t)tt * 256 + 64 * h + d0);
#pragma unroll
    for (int q = 0; q < 2; ++q) { const int ch = tid + 512 * q, j = ch >> 4, t = 64 * c - 48 + j; if (t >= 0 && t < L) v8[q] = *(const half8*)(GV + (size_t)t * 512 + 128 * h + (ch & 15) * 8); }
    gla_gates(P, c, h, bl);
    { f32x4 o0, o1;
#pragma unroll
      for (int m = 0; m < 4; ++m) { o0[m] = (float)k8[m] * __expf(bl[63 * 65 + d0 + m] - bl[ti * 65 + d0 + m]); o1[m] = (float)k8[4 + m] * __expf(bl[63 * 65 + d0 + 4 + m] - bl[ti * 65 + d0 + 4 + m]); }
      *(LAS f32x4*)(ks + ti * 64 + d0) = o0; *(LAS f32x4*)(ks + ti * 64 + d0 + 4) = o1; }
#pragma unroll
    for (int q = 0; q < 2; ++q) { const int ch = tid + 512 * q, j = ch >> 4, e0 = (ch & 15) * 8; f32x4 o0, o1;
#pragma unroll
        for (int m = 0; m < 4; ++m) { o0[m] = (float)v8[q][m]; o1[m] = (float)v8[q][4 + m]; }
        *(LAS f32x4*)(vs + j * 128 + e0) = o0; *(LAS f32x4*)(vs + j * 128 + e0 + 4) = o1; }
    if (tid < 64) DEC[(size_t)c * 256 + h * 64 + tid] = __expf(bl[63 * 65 + tid]);
    __syncthreads();
    { const int dd0 = (wid >> 2) * 32, e0 = (wid & 3) * 32, l31 = lane & 31, hf = lane >> 5; f32x16 acc;
#pragma unroll
      for (int i = 0; i < 16; ++i) acc[i] = 0.f;
#pragma unroll 8
      for (int s = 0; s < 32; ++s) acc = __builtin_amdgcn_mfma_f32_32x32x2f32(ks[(2 * s + hf) * 64 + dd0 + l31], vs[(2 * s + hf) * 128 + e0 + l31], acc, 0, 0, 0);
      float* up = U + ((size_t)unit * 64) * 128;
#pragma unroll
      for (int r = 0; r < 16; ++r) { const int row = (r & 3) + 8 * (r >> 2) + 4 * hf; up[(size_t)(dd0 + row) * 128 + e0 + l31] = acc[r]; } }
    __syncthreads();
}
__device__ __forceinline__ void gla_scan(const Params& P) {
    float* U = (float*)(P.ws + WS_US); const float* DEC = (const float*)(P.ws + WS_DECAY);
    const int idx = blockIdx.x * NTHREADS + threadIdx.x;
    if (idx >= 32768) return;
    float s = 0.f;
#pragma unroll 8
    for (int c = 0; c < NCH; ++c) { const float u = U[(size_t)c * 32768 + idx], dc = DEC[(size_t)c * 256 + (idx >> 7)]; U[(size_t)c * 32768 + idx] = s; s = dc * s + u; }
}
__device__ __forceinline__ void gla_c_unit(const Params& P, int unit, LAS unsigned char* lds) {
    int tid_ = threadIdx.x; asm volatile("" : "+v"(tid_));
    const int tid = tid_, lane = tid & 63, wid = tid >> 6, c = unit >> 2, h = unit & 3, l31 = lane & 31, hf = lane >> 5;
    LAS float* bl = (LAS float*)lds; LAS float* kk = bl + 4160; LAS float* qs = kk + 4160; LAS float* As = qs + 4160; LAS float* vs = As + 4160; LAS float* Ss = vs + 8192; LAS float* os = bl;
    const f16* GQ = (const f16*)(P.ws + WS_GQ); const f16* GK = (const f16*)(P.ws + WS_GK); const f16* GV = (const f16*)(P.ws + WS_GV); const f16* GR = (const f16*)(P.ws + WS_GR);
    const float* Sg = (const float*)(P.ws + WS_US) + (size_t)unit * 8192; f16* mix = (f16*)(P.ws + WS_ACTA);
    const int ti = tid >> 3, d0 = (tid & 7) * 8, tt = 64 * c - 48 + ti; const bool tv = tt >= 0 && tt < L;
    half8 q8, k8, v8[2], r8[2]; f32x4 sreg[4];
#pragma unroll
    for (int m = 0; m < 8; ++m) { q8[m] = (f16)0.f; k8[m] = (f16)0.f; v8[0][m] = (f16)0.f; v8[1][m] = (f16)0.f; r8[0][m] = (f16)0.f; r8[1][m] = (f16)0.f; }
    if (tv) { q8 = *(const half8*)(GQ + (size_t)tt * 256 + 64 * h + d0); k8 = *(const half8*)(GK + (size_t)tt * 256 + 64 * h + d0);
        r8[0] = *(const half8*)(GR + (size_t)tt * 512 + 128 * h + (tid & 7) * 16); r8[1] = *(const half8*)(GR + (size_t)tt * 512 + 128 * h + (tid & 7) * 16 + 8); }
#pragma unroll
    for (int q = 0; q < 2; ++q) { const int ch = tid + 512 * q, j = ch >> 4, t = 64 * c - 48 + j; if (t >= 0 && t < L) v8[q] = *(const half8*)(GV + (size_t)t * 512 + 128 * h + (ch & 15) * 8); }
#pragma unroll
    for (int q = 0; q < 4; ++q) sreg[q] = *(const f32x4*)(Sg + (size_t)(tid + 512 * q) * 4);
    gla_gates(P, c, h, bl);
#pragma unroll
    for (int m = 0; m < 8; ++m) { const float bv = bl[ti * 65 + d0 + m]; qs[ti * 65 + d0 + m] = (float)q8[m] * 0.125f * __expf(bv); kk[ti * 65 + d0 + m] = (float)k8[m] * __expf(-bv); }
#pragma unroll
    for (int q = 0; q < 2; ++q) { const int ch = tid + 512 * q, j = ch >> 4, e0 = (ch & 15) * 8; f32x4 o0, o1;
#pragma unroll
        for (int m = 0; m < 4; ++m) { o0[m] = (float)v8[q][m]; o1[m] = (float)v8[q][4 + m]; }
        *(LAS f32x4*)(vs + j * 128 + e0) = o0; *(LAS f32x4*)(vs + j * 128 + e0 + 4) = o1; }
#pragma unroll
    for (int q = 0; q < 4; ++q) *(LAS f32x4*)(Ss + (tid + 512 * q) * 4) = sreg[q];
    __syncthreads();
    if (wid < 4) { const int i0 = (wid >> 1) * 32, j0 = (wid & 1) * 32; f32x16 acc;
#pragma unroll
        for (int i = 0; i < 16; ++i) acc[i] = 0.f;
#pragma unroll 8
        for (int s = 0; s < 32; ++s) acc = __builtin_amdgcn_mfma_f32_32x32x2f32(qs[(i0 + l31) * 65 + 2 * s + hf], kk[(j0 + l31) * 65 + 2 * s + hf], acc, 0, 0, 0);
#pragma unroll
        for (int r = 0; r < 16; ++r) { const int i = i0 + (r & 3) + 8 * (r >> 2) + 4 * hf, j = j0 + l31; As[i * 65 + j] = (j <= i) ? acc[r] : 0.f; } }
    __syncthreads();
    { const int i0 = (wid >> 2) * 32, e0 = (wid & 3) * 32; f32x16 acc;
#pragma unroll
      for (int i = 0; i < 16; ++i) acc[i] = 0.f;
#pragma unroll 8
      for (int s = 0; s < 32; ++s) acc = __builtin_amdgcn_mfma_f32_32x32x2f32(qs[(i0 + l31) * 65 + 2 * s + hf], Ss[(2 * s + hf) * 128 + e0 + l31], acc, 0, 0, 0);
#pragma unroll 8
      for (int s = 0; s < 32; ++s) acc = __builtin_amdgcn_mfma_f32_32x32x2f32(As[(i0 + l31) * 65 + 2 * s + hf], vs[(2 * s + hf) * 128 + e0 + l31], acc, 0, 0, 0);
#pragma unroll
      for (int r = 0; r < 16; ++r) { const int i = i0 + (r & 3) + 8 * (r >> 2) + 4 * hf; os[i * 129 + e0 + l31] = acc[r]; } }
    __syncthreads();
    { const int e0 = (tid & 7) * 16; float o[16], sq = 0.f;
#pragma unroll
      for (int j = 0; j < 16; ++j) { o[j] = os[ti * 129 + e0 + j]; sq += o[j] * o[j]; }
      sq += __shfl_xor(sq, 1); sq += __shfl_xor(sq, 2); sq += __shfl_xor(sq, 4);
      const float rs = rsqrtf(sq * (1.0f / 128.0f) + EPS);
      if (tt >= NMETA && tt < L) { half8 w0, w1;
#pragma unroll
          for (int j = 0; j < 8; ++j) { w0[j] = (f16)(o[j] * rs * P.hn[e0 + j] * silu_f((float)r8[0][j])); w1[j] = (f16)(o[8 + j] * rs * P.hn[e0 + 8 + j] * silu_f((float)r8[1][j])); }
          f16* dst = mix + (size_t)(tt - NMETA) * D + 128 * h + e0; *(half8*)dst = w0; *(half8*)(dst + 8) = w1; } }
    __syncthreads();
}

__device__ __forceinline__ unsigned mono_u(float f) { const unsigned u = __float_as_uint(f); return (u & 0x80000000u) ? ~u : (u | 0x80000000u); }
__device__ __forceinline__ float unmono_f(unsigned m) { return __uint_as_float((m & 0x80000000u) ? (m & 0x7fffffffu) : ~m); }
__device__ __forceinline__ unsigned wave_umax(unsigned v) {
    v = max(v, (unsigned)__builtin_amdgcn_update_dpp(0, (int)v, 0x111, 0xf, 0xf, false));
    v = max(v, (unsigned)__builtin_amdgcn_update_dpp(0, (int)v, 0x112, 0xf, 0xf, false));
    v = max(v, (unsigned)__builtin_amdgcn_update_dpp(0, (int)v, 0x114, 0xf, 0xf, false));
    v = max(v, (unsigned)__builtin_amdgcn_update_dpp(0, (int)v, 0x118, 0xf, 0xf, false));
    v = max(v, (unsigned)__builtin_amdgcn_update_dpp(0, (int)v, 0x142, 0xa, 0xf, false));
    v = max(v, (unsigned)__builtin_amdgcn_update_dpp(0, (int)v, 0x143, 0xc, 0xf, false));
    return (unsigned)__builtin_amdgcn_readlane((int)v, 63);
}
__device__ __forceinline__ int half_scan_incl(int v) {
    v += __builtin_amdgcn_update_dpp(0, v, 0x111, 0xf, 0xf, true);
    v += __builtin_amdgcn_update_dpp(0, v, 0x112, 0xf, 0xf, true);
    v += __builtin_amdgcn_update_dpp(0, v, 0x114, 0xf, 0xf, true);
    v += __builtin_amdgcn_update_dpp(0, v, 0x118, 0xf, 0xf, true);
    v += __builtin_amdgcn_update_dpp(0, v, 0x142, 0xa, 0xf, true);
    return v;
}
constexpr int CAP = 640, NPL = CAP / 64;
__device__ __forceinline__ int topk_compact(LAS float* cs, LAS unsigned short* ci, int n, bool exact, float& tau_out, int lane) {
    float sv[NPL]; unsigned iv[NPL], u[NPL];
#pragma unroll
    for (int i = 0; i < NPL; ++i) { const int p = lane + 64 * i; const bool v = p < n; sv[i] = v ? cs[p] : 0.f; iv[i] = v ? (unsigned)ci[p] : 0xffffu; u[i] = v ? mono_u(sv[i]) : 0u; }
    unsigned T = 0u; bool full = true; int hb = 31;
    {
        unsigned umx = 0u, umn = 0xffffffffu;
#pragma unroll
        for (int i = 0; i < NPL; ++i) { umx = max(umx, u[i]); umn = min(umn, (lane + 64 * i < n) ? u[i] : 0xffffffffu); }
        umx = wave_umax(umx); umn = ~wave_umax(~umn);
        const unsigned df = umx ^ umn;
        if (df == 0u) { hb = -1; T = umx; } else { hb = 31 - __clz(df); T = (hb == 31) ? 0u : (umx & ~((2u << hb) - 1u)); }
    }
#pragma unroll 1
    for (int bit = hb; bit >= 0; --bit) {
        const unsigned cand = T | (1u << bit); int cgt = 0;
#pragma unroll
        for (int i = 0; i < NPL; ++i) cgt += __popcll(__ballot(u[i] >= cand));
        if (cgt >= 256) { T = cand; if (!exact && cgt <= 272) { full = false; break; } }
    }
    bool keep[NPL];
    if (full) {
        int cgt = 0;
#pragma unroll
        for (int i = 0; i < NPL; ++i) cgt += __popcll(__ballot(u[i] > T));
        const int need = 256 - cgt; unsigned I = 0xffffu; int nties = 0;
#pragma unroll
        for (int i = 0; i < NPL; ++i) nties += __popcll(__ballot(u[i] == T));
        if (nties != need) { I = 0u;
#pragma unroll 1
        for (int bit = 15; bit >= 0; --bit) { const unsigned cand = I | (1u << bit); int cl = 0;
#pragma unroll
            for (int i = 0; i < NPL; ++i) cl += __popcll(__ballot(u[i] == T && iv[i] < cand));
            if (cl < need) I = cand; } }
#pragma unroll
        for (int i = 0; i < NPL; ++i) keep[i] = (u[i] > T) || (u[i] == T && iv[i] <= I);
    } else {
#pragma unroll
        for (int i = 0; i < NPL; ++i) keep[i] = u[i] >= T;
    }
    int nn = 0;
#pragma unroll
    for (int i = 0; i < NPL; ++i) { const unsigned long long m = __ballot(keep[i]); const int pre = __builtin_amdgcn_mbcnt_hi((unsigned)(m >> 32), __builtin_amdgcn_mbcnt_lo((unsigned)m, 0u));
        if (keep[i]) { cs[nn + pre] = sv[i]; ci[nn + pre] = (unsigned short)iv[i]; } nn += __popcll(m); }
    tau_out = unmono_f(T);
    return nn;
}
__device__ __forceinline__ float relu_asm(float x) { return __int_as_float(max(__float_as_int(x), 0)); }
__device__ __forceinline__ void indexer_tile(const Params& P, int tile, LAS unsigned char* lds) {
    int tid_ = threadIdx.x; asm volatile("" : "+v"(tid_));
    const int tid = tid_, lane = tid & 63, wid = __builtin_amdgcn_readfirstlane(tid >> 6), l31 = lane & 31, hf = lane >> 5;
    LAS float* candS = (LAS float*)lds;
    LAS unsigned short* candI = (LAS unsigned short*)(lds + 32 * CAP * 4);
    LAS unsigned char* kbuf = lds + 32 * CAP * 6;
    LAS int* lflag = (LAS int*)(lds + LDS_BYTES - 1024 + 192);
    const f16* IQ = (const f16*)(P.ws + WS_IQ); const f16* IK = (const f16*)(P.ws + WS_IK); const float* IW = (const float*)(P.ws + WS_IW);
    unsigned short* SEL = (unsigned short*)(P.ws + WS_SEL);
    const int t0 = tile * 32, tw = t0 + wid * 4;
    half8 afr[4];
    { const int qi = 2 * (l31 >> 4) + ((l31 >> 2) & 1), hd = 4 * ((l31 >> 3) & 1) + (l31 & 3); int tq = tw + qi; if (tq > L - 1) tq = L - 1;
      const half8* ap = (const half8*)(IQ + (size_t)tq * 512 + hd * 64);
#pragma unroll
      for (int s = 0; s < 4; ++s) afr[s] = ap[2 * s + hf]; }
    float w0[8], w1[8];
    { int ta = tw + hf, tb = tw + 2 + hf; if (ta > L - 1) ta = L - 1; if (tb > L - 1) tb = L - 1;
#pragma unroll
      for (int h = 0; h < 8; ++h) { w0[h] = IW[(size_t)ta * 8 + h]; w1[h] = IW[(size_t)tb * 8 + h]; } }
    asm volatile("" :: "v"(afr[0]), "v"(afr[1]), "v"(afr[2]), "v"(afr[3]));
    asm volatile("" :: "v"(w0[0]), "v"(w0[1]), "v"(w0[2]), "v"(w0[3]), "v"(w0[4]), "v"(w0[5]), "v"(w0[6]), "v"(w0[7]));
    asm volatile("" :: "v"(w1[0]), "v"(w1[1]), "v"(w1[2]), "v"(w1[3]), "v"(w1[4]), "v"(w1[5]), "v"(w1[6]), "v"(w1[7]));
    const int tq0 = (tw + hf < L) ? tw + hf : -1, tq1 = (tw + 2 + hf < L) ? tw + 2 + hf : -1;
    float tau0 = -__builtin_inff(), tau1 = -__builtin_inff();
    int cq0 = 0, cq1 = 0, cq2 = 0, cq3 = 0;
    if (tid < 3) lflag[tid] = 0;
    const int nkeys = (t0 + 32 < L) ? t0 + 32 : L, nst = (nkeys + 127) >> 7;
    u32x4 stg[2];
    const u32x4* IKv = (const u32x4*)IK;
#pragma unroll
    for (int i = 0; i < 2; ++i) stg[i] = IKv[(size_t)0 * 1024 + tid + 512 * i];
#pragma unroll
    for (int i = 0; i < 2; ++i) { const int ci = tid + 512 * i, row = ci >> 3, ch = ci & 7; *(LAS u32x4*)(kbuf + row * 128 + ((ch ^ ((row >> 1) & 7)) << 4)) = stg[i]; }
    __syncthreads();
#pragma unroll 1
    for (int st = 0; st < nst; ++st) {
        LAS unsigned char* kb = kbuf + (st & 1) * 16384;
        if (st + 1 < nst) {
#pragma unroll
            for (int i = 0; i < 2; ++i) stg[i] = IKv[(size_t)(st + 1) * 1024 + tid + 512 * i];
        }
        if (st * 128 <= tw + 3) {
            f32x16 acc[4];
#pragma unroll
            for (int c = 0; c < 4; ++c) {
#pragma unroll
                for (int i = 0; i < 16; ++i) acc[c][i] = 0.f;
            }
#pragma unroll
            for (int s = 0; s < 4; ++s) {
#pragma unroll
                for (int c = 0; c < 4; ++c) { const int row = c * 32 + l31; const half8 bf = *(const LAS half8*)(kb + row * 128 + (((2 * s + hf) ^ ((row >> 1) & 7)) << 4)); acc[c] = __builtin_amdgcn_mfma_f32_32x32x16_f16(afr[s], bf, acc[c], 0, 0, 0); }
            }
            float sc[8]; bool ok[8]; int na = 0, nb = 0;
#pragma unroll
            for (int c = 0; c < 4; ++c) {
                float s0 = 0.f, s1 = 0.f;
#pragma unroll
                for (int h = 0; h < 8; ++h) { s0 = __builtin_fmaf(w0[h], relu_asm(acc[c][h]), s0); s1 = __builtin_fmaf(w1[h], relu_asm(acc[c][8 + h]), s1); }
                const int key = st * 128 + c * 32 + l31;
                sc[2 * c] = s0; sc[2 * c + 1] = s1; ok[2 * c] = key <= tq0 && s0 > tau0; ok[2 * c + 1] = key <= tq1 && s1 > tau1;
                na += ok[2 * c] ? 1 : 0; nb += ok[2 * c + 1] ? 1 : 0;
            }
            const int ia = half_scan_incl(na), ib = half_scan_incl(nb);
            const int ta0 = __builtin_amdgcn_readlane(ia, 31), ta1 = __builtin_amdgcn_readlane(ia, 63), tb0 = __builtin_amdgcn_readlane(ib, 31), tb1 = __builtin_amdgcn_readlane(ib, 63);
            int pa = (hf ? cq1 : cq0) + ia - na, pb = (hf ? cq3 : cq2) + ib - nb;
            cq0 += ta0; cq1 += ta1; cq2 += tb0; cq3 += tb1;
            pa += (wid * 4 + hf) * CAP; pb += (wid * 4 + 2 + hf) * CAP;
            const int dmy = 32 * CAP * 6 / 4 + 2 * 16384 / 4 + 64 + lane;
#pragma unroll
            for (int c = 0; c < 4; ++c) {
                const unsigned short key = (unsigned short)(st * 128 + c * 32 + l31);
                { const bool k0 = ok[2 * c]; LAS float* ps = k0 ? candS + pa : candS + dmy; LAS unsigned short* pi = k0 ? candI + pa : (LAS unsigned short*)(candS + dmy + 64); *ps = sc[2 * c]; *pi = key; pa += k0 ? 1 : 0; }
                { const bool k1 = ok[2 * c + 1]; LAS float* ps = k1 ? candS + pb : candS + dmy; LAS unsigned short* pi = k1 ? candI + pb : (LAS unsigned short*)(candS + dmy + 64); *ps = sc[2 * c + 1]; *pi = key; pb += k1 ? 1 : 0; }
            }
        }
        if (st + 1 < nst) {
            LAS unsigned char* kn = kbuf + ((st + 1) & 1) * 16384;
#pragma unroll
            for (int i = 0; i < 2; ++i) { const int ci = tid + 512 * i, row = ci >> 3, ch = ci & 7; *(LAS u32x4*)(kn + row * 128 + ((ch ^ ((row >> 1) & 7)) << 4)) = stg[i]; }
        }
        const int mx = max(max(cq0, cq1), max(cq2, cq3));
        if (mx > CAP - 128 && lane == 0) lflag[st % 3] = 1;
        if (tid == 0) lflag[(st + 1) % 3] = 0;
        __syncthreads();
        const int any = lflag[st % 3];
        if (any) {
#pragma unroll 1
            for (int qq = 0; qq < 4; ++qq) { const int n = qq == 0 ? cq0 : (qq == 1 ? cq1 : (qq == 2 ? cq2 : cq3));
                if (n > 288) { float nt; const int nn = topk_compact(candS + (wid * 4 + qq) * CAP, candI + (wid * 4 + qq) * CAP, n, false, nt, lane);
                    if (qq == 0) cq0 = nn; else if (qq == 1) cq1 = nn; else if (qq == 2) cq2 = nn; else cq3 = nn;
                    if (hf == (qq & 1)) { if (qq < 2) tau0 = nt; else tau1 = nt; } } }
        }
    }
#pragma unroll 1
    for (int qq = 0; qq < 4; ++qq) {
        const int t = tw + qq; if (t >= L) break;
        int n = qq == 0 ? cq0 : (qq == 1 ? cq1 : (qq == 2 ? cq2 : cq3)); LAS float* cs = candS + (wid * 4 + qq) * CAP; LAS unsigned short* ci = candI + (wid * 4 + qq) * CAP;
        if (n > 256) { float nt; n = topk_compact(cs, ci, n, true, nt, lane); }
#pragma unroll
        for (int j = 0; j < 4; ++j) { const int p = lane + 64 * j; SEL[(size_t)t * 256 + (p & 15) * 16 + (p >> 4)] = p < n ? ci[p] : (unsigned short)0xffffu; }
    }
    __syncthreads();
}

__device__ __forceinline__ void sparse_attn(const Params& P, LAS unsigned char* lds, int vbid) {
    int tid_ = threadIdx.x; asm volatile("" : "+v"(tid_));
    const int tid = tid_, lane = tid & 63, wid = tid >> 6, grp = lane >> 2, c4 = lane & 3;
    const int head = vbid & 7, slot = (vbid >> 3) * 8 + wid, nslot = (gridDim.x >> 3) * 8;
    typedef _Float16 half2v __attribute__((ext_vector_type(2)));
    LAS float* red = (LAS float*)(lds + 4096 + wid * 4352);
    const unsigned short* SEL = (const unsigned short*)(P.ws + WS_SEL);
    const unsigned char* Q8 = P.ws + WS_DQ + head * 64 + c4 * 16; const float* QS = (const float*)(P.ws + WS_DQ + (size_t)LP * 512) + head;
    const unsigned char* kvh = P.ws + WS_KV + (size_t)head * LP * 128; f16* mix = (f16*)(P.ws + WS_ACTA);
    int t = NMETA + slot;
    u32x4 sela = {0u, 0u, 0u, 0u}, selb = {0u, 0u, 0u, 0u}, q8 = {0u, 0u, 0u, 0u}; float lscale = 0.f;
    if (t < L) { sela = *(const u32x4*)(SEL + (size_t)t * 256 + grp * 16); selb = *(const u32x4*)(SEL + (size_t)t * 256 + grp * 16 + 8); q8 = *(const u32x4*)(Q8 + (size_t)t * 512); lscale = QS[(size_t)t * 8]; }
#define ATTN_ITEM(ALLV) do { \
        unsigned keys[16]; u32x4 kreg[16], vreg[16]; \
        _Pragma("unroll") for (int it = 0; it < 16; ++it) { const unsigned w = it < 8 ? sela[it >> 1] : selb[(it - 8) >> 1]; keys[it] = (it & 1) ? (w >> 16) : (w & 0xffffu); } \
        _Pragma("unroll") for (int it = 0; it < 16; ++it) { const unsigned kk = (ALLV || keys[it] != 0xffffu) ? keys[it] : 0u; kreg[it] = *(const u32x4*)(kvh + (size_t)kk * 128 + c4 * 16); } \
        _Pragma("unroll") for (int it = 0; it < 16; ++it) { const unsigned kk = (ALLV || keys[it] != 0xffffu) ? keys[it] : 0u; vreg[it] = *(const u32x4*)(kvh + (size_t)kk * 128 + 64 + c4 * 16); } \
        const u32x4 qc = q8; const float ls = lscale; \
        { const int tn = t + nslot;     \
          if (tn < L) { sela = *(const u32x4*)(SEL + (size_t)tn * 256 + grp * 16); selb = *(const u32x4*)(SEL + (size_t)tn * 256 + grp * 16 + 8); q8 = *(const u32x4*)(Q8 + (size_t)tn * 512); lscale = QS[(size_t)tn * 8]; } } \
        float lg[16]; float mx = -__builtin_inff(); \
        _Pragma("unroll") for (int it = 0; it < 16; ++it) { \
            int ai = 0; \
            _Pragma("unroll") for (int w = 0; w < 4; ++w) ai = __builtin_amdgcn_sdot4((int)kreg[it][w], (int)qc[w], ai, false); \
            ai += __builtin_amdgcn_update_dpp(0, ai, 0xB1, 0xf, 0xf, true);     \
            ai += __builtin_amdgcn_update_dpp(0, ai, 0x4E, 0xf, 0xf, true);     \
            lg[it] = (ALLV || keys[it] != 0xffffu) ? (float)ai * ls : -__builtin_inff(); mx = fmaxf(mx, lg[it]); } \
        mx = fmaxf(mx, __shfl_xor(mx, 4)); mx = fmaxf(mx, __shfl_xor(mx, 8)); mx = fmaxf(mx, __shfl_xor(mx, 16)); mx = fmaxf(mx, __shfl_xor(mx, 32)); \
        half2v o2[8]; float lsum = 0.f; \
        _Pragma("unroll") for (int e = 0; e < 8; ++e) o2[e] = (half2v){(f16)0.f, (f16)0.f}; \
        _Pragma("unroll") for (int it = 0; it < 16; ++it) { \
            const float p = __expf(lg[it] - mx); lsum += p; const f16 ph = (f16)p; const half2v p2 = {ph, ph}; \
            _Pragma("unroll") for (int w = 0; w < 4; ++w) {     \
                const half2v v01 = __builtin_bit_cast(half2v, __builtin_amdgcn_perm(0u, vreg[it][w], 0x010c000cu)), v23 = __builtin_bit_cast(half2v, __builtin_amdgcn_perm(0u, vreg[it][w], 0x030c020cu)); \
                o2[2 * w] = p2 * v01 + o2[2 * w]; o2[2 * w + 1] = p2 * v23 + o2[2 * w + 1]; } } \
        lsum += __shfl_xor(lsum, 4); lsum += __shfl_xor(lsum, 8); lsum += __shfl_xor(lsum, 16); lsum += __shfl_xor(lsum, 32); \
          \
        _Pragma("unroll") for (int e = 0; e < 8; ++e) { red[lane * 17 + 2 * e] = (float)o2[e][0]; red[lane * 17 + 2 * e + 1] = (float)o2[e][1]; } \
        float acc = 0.f; \
        { const int cc = lane >> 4, e = lane & 15; \
          _Pragma("unroll") for (int g = 0; g < 16; ++g) acc += red[(g * 4 + cc) * 17 + e]; } \
        mix[(size_t)(t - NMETA) * D + 512 + head * 64 + lane] = (f16)(acc * __builtin_amdgcn_rcpf(lsum)); \
    } while (0)
#pragma unroll 1
    for (; t < L; t += nslot) {
        if (t >= 255) ATTN_ITEM(true);
        else ATTN_ITEM(false);
    }
#undef ATTN_ITEM
    __syncthreads();
}

__device__ __forceinline__ void final_norm(const Params& P) {
    const int tid = threadIdx.x, lane = tid & 63, gw = blockIdx.x * 8 + (tid >> 6), nw = gridDim.x * 8;
    const float* ss3 = (const float*)(P.ws + WS_SS3); const f16* h3 = (const f16*)(P.ws + WS_ACTA);
    for (int r = gw; r < SEQ; r += nw) { const float rs = row_rstd(ss3, 16, r);
#pragma unroll
        for (int i = 0; i < 2; ++i) { const int k = lane * 8 + 512 * i; const half8 v = *(const half8*)(h3 + (size_t)r * D + k); const f32x4 g0 = *(const f32x4*)(P.nf + k), g1 = *(const f32x4*)(P.nf + k + 4); f32x4 o0, o1;
#pragma unroll
            for (int j = 0; j < 4; ++j) { o0[j] = (float)v[j] * rs * g0[j]; o1[j] = (float)v[4 + j] * rs * g1[j]; }
            *(f32x4*)(P.out + (size_t)r * D + k) = o0; *(f32x4*)(P.out + (size_t)r * D + k + 4) = o1; } }
}

#define XB_TMO      128
#define XB_XCNT(j)  (256  + 64 * (j))
#define XB_XSUB(j)  (1280 + 64 * (j))
#define XB_XGEN(j)  (2304 + 64 * (j))
#define XB_TOP      3328
#define XB_TOPGEN   3392
#define XCD_BAR_WORDS 3456
#define XB_SPIN_CAP (1u << 22)
__device__ __forceinline__ unsigned xb_ld(unsigned* p)              { return __hip_atomic_load(p, __ATOMIC_RELAXED, __HIP_MEMORY_SCOPE_AGENT); }
__device__ __forceinline__ unsigned xb_add(unsigned* p, unsigned v) { return __hip_atomic_fetch_add(p, v, __ATOMIC_RELAXED, __HIP_MEMORY_SCOPE_AGENT); }
__device__ __forceinline__ unsigned xb_xcc_id() { return (unsigned)__builtin_amdgcn_s_getreg((3 << 11) | 20) & 0xFu; }
#define XB_SPIN(cond, bar) do { unsigned _sp = 0; while (cond) { __builtin_amdgcn_s_sleep(1); \
    if ((++_sp & 255u) == 0u) { if (xb_ld(&(bar)[XB_TMO])) break; if (_sp > XB_SPIN_CAP) { atomicAdd(&(bar)[XB_TMO], 1u); break; } } } } while (0)
struct XcdBarrier { unsigned* bar; unsigned x; volatile LAS unsigned* st; };
__device__ __forceinline__ XcdBarrier xcd_barrier_post(unsigned* bar, volatile LAS unsigned* st) {
    XcdBarrier b; b.bar = bar; b.x = xb_xcc_id(); b.st = st;
    if (threadIdx.x == 0) (void)xb_add(&bar[XB_XCNT(b.x)], 1u);
    return b;
}
__device__ __forceinline__ void xcd_barrier_complete(unsigned* bar, unsigned x, unsigned& nloc, unsigned& nx) {
    const unsigned G = gridDim.x * gridDim.y * gridDim.z;
    unsigned sum, cnt, mine, sp = 0u;
    for (;;) {
        sum = 0u; cnt = 0u; mine = 0u;
#pragma unroll
        for (unsigned j = 0; j < 16; ++j) { const unsigned c = xb_ld(&bar[XB_XCNT(j)]); sum += c; cnt += (c > 0u) ? 1u : 0u; mine = (j == x) ? c : mine; }
        if (sum == G) break;
        __builtin_amdgcn_s_sleep(1);
        if ((++sp & 255u) == 0u) { if (xb_ld(&bar[XB_TMO])) break; if (sp > XB_SPIN_CAP) { atomicAdd(&bar[XB_TMO], 1u); break; } }
    }
    nloc = mine > 0u ? mine : 1u; nx = cnt > 0u ? cnt : 1u;
}
__device__ __forceinline__ void xcd_barrier(const XcdBarrier& b) {
    asm volatile("s_waitcnt vmcnt(0)" ::: "memory");
    __syncthreads();
    if (threadIdx.x == 0) {
        unsigned* bar = b.bar;
        __builtin_amdgcn_s_waitcnt(0);
        unsigned nloc = b.st[0], nx = b.st[1];
        if (nloc == 0u) { xcd_barrier_complete(bar, b.x, nloc, nx); b.st[0] = nloc; b.st[1] = nx; }
        const unsigned old = xb_add(&bar[XB_XSUB(b.x)], 1u);
        const unsigned gen = old / nloc;
        if (old + 1u == (gen + 1u) * nloc) {
            __builtin_amdgcn_fence(__ATOMIC_RELEASE, "agent");
            asm volatile("s_waitcnt vmcnt(0)" ::: "memory");
            const unsigned og = xb_add(&bar[XB_TOP], 1u);
            const unsigned tg = og / nx;
            if (og + 1u == (tg + 1u) * nx) xb_add(&bar[XB_TOPGEN], 1u);
            else XB_SPIN(xb_ld(&bar[XB_TOPGEN]) == tg, bar);
            __builtin_amdgcn_fence(__ATOMIC_ACQUIRE, "agent");
            xb_add(&bar[XB_XGEN(b.x)], 1u);
            asm volatile("s_waitcnt vmcnt(0)" ::: "memory");
        } else {
            XB_SPIN(xb_ld(&bar[XB_XGEN(b.x)]) == gen, bar);
            __builtin_amdgcn_fence(__ATOMIC_ACQUIRE, "agent");
            asm volatile("s_waitcnt vmcnt(0)" ::: "memory");
        }
    }
    __syncthreads();
}

__global__ void __launch_bounds__(NTHREADS, 2) fwd_kernel(Params P) {
    __shared__ __attribute__((aligned(16))) unsigned char lds_raw[LDS_BYTES];
    LAS unsigned char* lds = (LAS unsigned char*)lds_raw;
    const int tid = threadIdx.x, bid = blockIdx.x, G = gridDim.x;
    unsigned char* ws = P.ws;
    const int lo = P.ph_lo, hi = P.ph_hi;
#ifndef ONLY_PHASE
#define ONLY_PHASE -1
#endif
#define IN(k) ((ONLY_PHASE < 0 || ONLY_PHASE == (k)) && lo <= (k) && (k) < hi)
#define SEAM(k) do { if (IN(k) && IN((k) + 1)) { xcd_barrier(xbar); } } while (0)
    XcdBarrier xbar; xbar.bar = (unsigned*)(ws + WS_BAR); xbar.x = 0; xbar.st = (volatile LAS unsigned*)(lds + LDS_BYTES - 1024 + 16);
    if (hi - lo > 1) {
        if (tid == 0) { xbar.st[0] = 0u; xbar.st[1] = 0u; }
        __syncthreads();
        xbar = xcd_barrier_post((unsigned*)(ws + WS_BAR), (volatile LAS unsigned*)(lds + LDS_BYTES - 1024 + 16));
    }
    LAS int* misc = (LAS int*)(lds + LDS_BYTES - 1024);
    if (hi - lo > 1) {
        if (tid == 0) { const unsigned xcc = xb_xcc_id() & 7u; misc[8] = (int)xcc; misc[9] = (int)xb_add((unsigned*)(ws + WS_CTL) + 32 + 32 * xcc, 1u); }
    }
    int vbid = bid;
    f16* acta = (f16*)(ws + WS_ACTA); f16* Gb = (f16*)(ws + WS_G);
    float* ss0 = (float*)(ws + WS_SS0); float* ss1 = (float*)(ws + WS_SS1); float* ss2 = (float*)(ws + WS_SS2); float* ss3 = (float*)(ws + WS_SS3);
    if (IN(0)) { p0_prologue(P, lds); }
    SEAM(0);
    if (hi - lo > 1 && (G & 7) == 0) {
        if (tid == 0) { bool ok = true; for (int j = 0; j < 8; ++j) ok = ok && (xb_ld((unsigned*)(ws + WS_CTL) + 32 + 32 * j) == (unsigned)(G >> 3)); misc[10] = ok ? misc[9] * 8 + misc[8] : bid; }
        __syncthreads();
        vbid = __builtin_amdgcn_readfirstlane(misc[10]);
        __syncthreads();
    }
    if (IN(1)) {
        pg8::Gemm g{acta, (const f16*)(ws + WS_WGU1), MP, 2 * DFF, D}; pg8::StaticOrder S; S.init(MP, 2 * DFF, G, vbid);
        EpiSwiglu<false> E{Gb, ss0, 1, nullptr, nullptr}; pg8::gemm_phase(lds, g, S, E);
    }
    SEAM(1);
    if (IN(2)) {
        meta_down(P, lds);
        pg8::Gemm g{Gb, (const f16*)(ws + WS_WD1), SEQ, D, DFF}; pg8::StaticOrder S; S.init(SEQ, D, G, vbid);
        EpiResid<true> E{acta, (f16*)P.out, ss1, 0.5f}; pg8::gemm_phase(lds, g, S, E);
    }
    SEAM(2);
    if (IN(3)) {
        pg8::Gemm g{(const f16*)P.out, (const f16*)(ws + WS_WIN), MP, NIN, D}; pg8::StaticOrder S; S.init(MP, NIN, G, vbid);
        EpiInProj E{ss1, (const f32x2*)(ws + WS_ROPE), ws};
        pg8::gemm_phase(lds, g, S, E);
    }
    SEAM(3);
    if (IN(4)) {
        for (int u = bid; u < NCH * 4; u += G) gla_a_unit(P, u, lds);
        {
            int tbase = 0, cursor = bid; LAS f16* tl = (LAS f16*)lds;
            prep_weight(P, 3, D, D, (f16*)(ws + WS_WOUT), cursor, tbase, tl);
            prep_weight(P, 5, D, DFF, (f16*)(ws + WS_WD2), cursor, tbase, tl);
            __syncthreads();
            prep_weight_i8(P, 4, 2 * DFF, ws + WS_WGU2, (float*)(ws + WS_WGU2 + (size_t)2 * DFF * D), bid, G, lds);
        }
    }
    SEAM(4);
    if (IN(5)) {
        if (bid < 64) gla_scan(P);
        unsigned* ctr = (unsigned*)(ws + WS_CTL); LAS int* bc = (LAS int*)(lds + LDS_BYTES - 1024);
        for (;;) {
            if (tid == 0) bc[0] = (int)atomicAdd(ctr, 1u);
            __syncthreads();
            const int k = bc[0];
            __syncthreads();
            if (k >= 513) break;
            indexer_tile(P, 512 - k, lds);
        }
    }
    SEAM(5);
    if (IN(6)) { for (int u = bid; u < NCH * 4; u += G) gla_c_unit(P, u, lds); sparse_attn(P, lds, vbid); }
    SEAM(6);
    if (IN(7)) {
        pg8::Gemm g{acta, (const f16*)(ws + WS_WOUT), SEQ, D, D}; pg8::StaticOrder S; S.init(SEQ, D, G, vbid);
        EpiResid<true> E{P.out, (f16*)(ws + WS_US), ss2, 1.0f}; pg8::gemm_phase(lds, g, S, E);
    }
    SEAM(7);
    if (IN(8)) quant_rows_i8((const f16*)(ws + WS_US), ws + WS_DQ, (float*)(ws + WS_IQ), SEQ);
    SEAM(8);
    if (IN(9)) {
        pg8::Gemm g{(const f16*)(ws + WS_DQ), (const f16*)(ws + WS_WGU2), SEQ, 2 * DFF, D / 2}; pg8::StaticOrder S; S.init(SEQ, 2 * DFF, G, vbid);
        EpiSwiglu<true> E{Gb, ss2, 16, (const float*)(ws + WS_IQ), (const float*)(ws + WS_WGU2 + (size_t)2 * DFF * D)}; pg8::gemm_phase(lds, g, S, E);
    }
    SEAM(9);
    if (IN(10)) {
        pg8::Gemm g{Gb, (const f16*)(ws + WS_WD2), SEQ, D, DFF}; pg8::StaticOrder S; S.init(SEQ, D, G, vbid);
        EpiResid<true> E{ws + WS_US, acta, ss3, 0.5f}; pg8::gemm_phase(lds, g, S, E);
    }
    SEAM(10);
    if (IN(11)) final_norm(P);
#undef IN
#undef SEAM
}

extern "C" void kernel_launch(void* const* d_in, const int* in_sizes, int n_in, void* d_out, int out_size, void* d_ws, size_t ws_size, hipStream_t stream) {
    static int grid = 0;
    if (grid == 0) {
        if (n_in != 17 || in_sizes[0] != SEQ * D || out_size != SEQ * D || ws_size < WS_END) { fprintf(stderr, "kernel_launch: unexpected shapes (n_in %d, in0 %d, out %d, ws %zu, need %zu)\n", n_in, n_in > 0 ? in_sizes[0] : -1, out_size, ws_size, (size_t)WS_END); grid = -1; return; }
        int dev = 0, cus = 0, per_cu = 0;
        (void)hipGetDevice(&dev); (void)hipDeviceGetAttribute(&cus, hipDeviceAttributeMultiprocessorCount, dev);
        if (hipOccupancyMaxActiveBlocksPerMultiprocessor(&per_cu, (const void*)fwd_kernel, NTHREADS, 0) != hipSuccess || per_cu < 1) { fprintf(stderr, "kernel_launch: occupancy query says %d blocks per CU\n", per_cu); per_cu = 1; }
        (void)hipGetLastError();
        grid = cus;
        if (grid % 8 != 0 || grid < 64) { fprintf(stderr, "kernel_launch: unexpected CU count %d\n", cus); }
    }
    if (grid < 0) return;
    if (hipMemsetAsync((char*)d_ws + WS_CTL, 0, CTL_BYTES, stream) != hipSuccess) { fprintf(stderr, "kernel_launch: memset failed\n"); return; }
    Params p{};
    const float** pp = (const float**)&p;
    for (int i = 0; i < 17; ++i) pp[i] = (const float*)d_in[i];
    p.out = (float*)d_out; p.ws = (unsigned char*)d_ws;
#if MODE == 0
    for (int ph = 0; ph < NPHASE; ++ph) { p.ph_lo = ph; p.ph_hi = ph + 1; hipLaunchKernelGGL(fwd_kernel, dim3(grid), dim3(NTHREADS), 0, stream, p); }
#else
    p.ph_lo = 0; p.ph_hi = NPHASE;
    void* args[] = {&p};
    hipError_t e = hipLaunchCooperativeKernel((const void*)fwd_kernel, dim3(grid), dim3(NTHREADS), args, 0, stream);
    if (e != hipSuccess) fprintf(stderr, "cooperative launch failed: %s (grid %d)\n", hipGetErrorString(e), grid);
#endif
}
```

```cpp
#include <hip/hip_runtime.h>
#include <cstdio>
#include <cstdint>

#ifndef MODE
#define MODE 1
#endif

#define LAS __attribute__((address_space(3)))
typedef _Float16 f16;
typedef _Float16 half8 __attribute__((ext_vector_type(8)));
typedef _Float16 half4 __attribute__((ext_vector_type(4)));
typedef float f32x2 __attribute__((ext_vector_type(2)));
typedef float f32x4 __attribute__((ext_vector_type(4)));
typedef float f32x16 __attribute__((ext_vector_type(16)));
typedef unsigned u32x2 __attribute__((ext_vector_type(2)));
typedef unsigned u32x4 __attribute__((ext_vector_type(4)));
typedef int i32x4 __attribute__((ext_vector_type(4)));

constexpr int D = 1024, SEQ = 16384, NMETA = 16, L = SEQ + NMETA, DFF = 2816;
constexpr int MP = 16640;
constexpr int LP = 16512;
constexpr int NIN = 3840;
constexpr int NCH = 257;
constexpr float EPS = 1e-6f;
constexpr int NTHREADS = 512;
constexpr int LDS_BYTES = 155648 + 1024;
constexpr int NPHASE = 12;

constexpr size_t al256(size_t x) { return (x + 255) & ~(size_t)255; }
constexpr size_t WS_CTL = 0;
constexpr size_t CTL_BYTES = 32768;
constexpr size_t WS_BAR = 2048;
constexpr size_t WS_WGU1 = CTL_BYTES;
constexpr size_t WS_WD1 = WS_WGU1 + (size_t)2 * DFF * D * 2;
constexpr size_t WS_WIN = WS_WD1 + (size_t)D * DFF * 2;
constexpr size_t WS_WOUT = WS_WIN + (size_t)NIN * D * 2;
constexpr size_t WS_WGU2 = WS_WOUT + (size_t)D * D * 2;
constexpr size_t WS_WD2 = WS_WGU2 + (size_t)2 * DFF * D * 2;
constexpr size_t WS_ACTA = WS_WD2 + (size_t)D * DFF * 2;
constexpr size_t WS_G = WS_ACTA + (size_t)MP * D * 2;
constexpr size_t WS_US = WS_G + (size_t)MP * DFF * 2;
constexpr size_t WS_DQ = WS_US + (size_t)NCH * 4 * 64 * 128 * 4;
constexpr size_t WS_IQ = WS_DQ + (size_t)LP * 512 * 2;
constexpr size_t WS_SEL = WS_IQ + (size_t)LP * 512 * 2;
constexpr size_t WS_ROPE = WS_SEL + (size_t)LP * 256 * 2;
constexpr size_t WS_IW = WS_ROPE + al256((size_t)L * 32 * 8);
constexpr size_t WS_GA = WS_IW + (size_t)LP * 8 * 4;
constexpr size_t WS_DECAY = WS_GA + (size_t)LP * 16 * 4;
constexpr size_t WS_SS0 = WS_DECAY + al256((size_t)NCH * 256 * 4);
constexpr size_t WS_SS1 = WS_SS0 + (size_t)MP * 4;
constexpr size_t WS_SS2 = WS_SS1 + (size_t)MP * 64;
constexpr size_t WS_SS3 = WS_SS2 + (size_t)MP * 64;
constexpr size_t WS_END = WS_SS3 + (size_t)MP * 64;
constexpr size_t WS_KV = WS_G;
constexpr size_t WS_GQ = WS_KV + (size_t)8 * LP * 128 * 2;
constexpr size_t WS_GK = WS_GQ + (size_t)LP * 256 * 2;
constexpr size_t WS_GV = WS_GK + (size_t)LP * 256 * 2;
constexpr size_t WS_GR = WS_GV + (size_t)LP * 512 * 2;
constexpr size_t WS_IK = WS_GR + (size_t)LP * 512 * 2;
constexpr size_t WS_ALIAS_END = WS_IK + (size_t)LP * 64 * 2;
static_assert(WS_ALIAS_END <= WS_US, "aliased buffers exceed G");
static_assert(WS_END <= (size_t)256 * 1024 * 1024, "workspace exceeds 256 MiB");
static_assert((size_t)SEQ * D * 2 <= (size_t)NCH * 4 * 64 * 128 * 4, "h2_16 alias");

struct Params {
    const float* x; const float* meta; const float* n1; const float* wg1; const float* wu1; const float* wd1;
    const float* nmix; const float* win; const float* wa2; const float* ba; const float* hn; const float* wout;
    const float* n2; const float* wg2; const float* wu2; const float* wd2; const float* nf;
    float* out; unsigned char* ws; int ph_lo, ph_hi;
};

namespace pg8 {
constexpr int BM = 256, BK = 64, HALF = 128, HTB = HALF * BK * 2, STAGE_BYTES = 8 * HTB, NXCD = 8, WGM = 8;
__host__ __device__ __forceinline__ int lds_byte(int r, int c) { const int st = (r >> 4) * 2 + (c >> 5), rr = r & 15, cc = c & 31, ob = rr * 64 + cc * 2; return st * 1024 + (ob ^ (((ob >> 9) & 1) << 5)); }
__host__ __device__ __forceinline__ int perm32(int rho) { const int n = rho >> 4, i = rho & 15; return 8 * (i >> 2) + 4 * n + (i & 3); }
__host__ __device__ __forceinline__ void stage_rc(int b, int& R, int& C) { const int st = b / 1024, sb = b % 1024, swz = sb ^ (((sb >> 9) & 1) << 5); R = (st >> 1) * 16 + swz / 64; C = (st & 1) * 32 + (swz % 64) / 2; }
struct Unit { int pm, pn; };
struct Gemm { const f16* A; const f16* Bt; int M, N, K; };
struct StaticOrder {
    int nM, nN, nwg, G, c;
    __host__ __device__ void init(int M, int N, int G_, int c_) { nM = M / BM; nN = N / BM; nwg = nM * nN; G = G_; c = c_; }
    __host__ __device__ bool next(int i, Unit& u) const {
        const long Lx = (long)i * G + c; if (Lx >= nwg) return false;
        int wgid = (int)Lx; { const int q = nwg / NXCD, r = nwg % NXCD, xcd = wgid % NXCD, off = wgid / NXCD; wgid = (xcd < r ? xcd * (q + 1) : r * (q + 1) + (xcd - r) * q) + off; }
        const int nig = WGM * nN, gid = wgid / nig, fm = gid * WGM, gsz = (nM - fm) < WGM ? (nM - fm) : WGM;
        u.pm = fm + ((wgid % nig) % gsz); u.pn = (wgid % nig) / gsz; return true;
    }
};
template <class Epi>
__device__ __forceinline__ void gemm_phase(LAS unsigned char* lds, const Gemm g, const StaticOrder& S, const Epi& E) {
    int tid_ = threadIdx.x; asm volatile("" : "+v"(tid_));
    const int tid = tid_, wid = __builtin_amdgcn_readfirstlane(tid >> 6), lane = tid & 63, wr = wid >> 2, wc = wid & 3, fr = lane & 15, fq = lane >> 4;
    const int K = g.K, nt = K / BK;
    unsigned voffA[2], voffB[2];
#pragma unroll
    for (int i = 0; i < 2; ++i) { int R, C; stage_rc(tid * 16 + i * 8192, R, C); const int Rb = (R & ~31) + perm32(R & 31); voffA[i] = (unsigned)(R * K + C) * 2u; voffB[i] = (unsigned)(Rb * K + C) * 2u; }
    const size_t kstep = (size_t)(BK * 2);
    const size_t hstep = (size_t)HALF * K * 2;
    const size_t tstep = 2 * hstep;
    const unsigned ldsw = (unsigned)wid * 1024u;
    const int aoff = lds_byte(wr * 64 + fr, fq * 8), boff = lds_byte(wc * 32 + fr, fq * 8);
#define PG8_SA(b, h) (((b) * 2 + (h)) * HTB)
#define PG8_SB(b, h) ((4 + (b) * 2 + (h)) * HTB)
#define PG8_STAGE(bufoff, gbase, voff) do { _Pragma("unroll") for (int _i = 0; _i < 2; ++_i) \
        __builtin_amdgcn_global_load_lds((const unsigned*)((const char*)(gbase) + (voff)[_i]), (LAS unsigned*)(lds + (bufoff) + ldsw + _i * 8192), 16, 0, 0); } while (0)
#define PG8_LDA(dst, b, h) do { _Pragma("unroll") for (int m = 0; m < 4; ++m) _Pragma("unroll") for (int k = 0; k < 2; ++k) dst[m][k] = *(const LAS half8*)(lds + PG8_SA(b, h) + aoff + m * 2048 + k * 1024); } while (0)
#define PG8_LDB(dst, b, h) do { _Pragma("unroll") for (int n = 0; n < 2; ++n) _Pragma("unroll") for (int k = 0; k < 2; ++k) dst[n][k] = *(const LAS half8*)(lds + PG8_SB(b, h) + boff + n * 2048 + k * 1024); } while (0)
#define PG8_MMA(ai, bj, At, Bt) do { __builtin_amdgcn_s_setprio(1); _Pragma("unroll") for (int m = 0; m < 4; ++m) _Pragma("unroll") for (int n = 0; n < 2; ++n) _Pragma("unroll") for (int k = 0; k < 2; ++k) { \
        if constexpr (Epi::I8) acc[ai][bj][m][n] = __builtin_bit_cast(f32x4, __builtin_amdgcn_mfma_i32_16x16x64_i8(__builtin_bit_cast(i32x4, Bt[n][k]), __builtin_bit_cast(i32x4, At[m][k]), __builtin_bit_cast(i32x4, acc[ai][bj][m][n]), 0, 0, 0)); \
        else acc[ai][bj][m][n] = __builtin_amdgcn_mfma_f32_16x16x32_f16(Bt[n][k], At[m][k], acc[ai][bj][m][n], 0, 0, 0); } __builtin_amdgcn_s_setprio(0); } while (0)
#define PG8_WAIT_V(n) asm volatile("s_waitcnt vmcnt(" #n ")" ::: "memory")
#define PG8_WAIT_L(n) asm volatile("s_waitcnt lgkmcnt(" #n ")" ::: "memory")
#define PG8_BAR __builtin_amdgcn_s_barrier()
#define PG8_SCHED __builtin_amdgcn_sched_barrier(0)
    Unit cur, nxt; int ui = 0;
    if (!S.next(0, cur)) return;
    f32x4 acc[2][2][4][2];
#pragma unroll
    for (int a = 0; a < 2; ++a)
#pragma unroll
        for (int b = 0; b < 2; ++b)
#pragma unroll
            for (int m = 0; m < 4; ++m)
#pragma unroll
                for (int n = 0; n < 2; ++n) acc[a][b][m][n] = (f32x4){0.f, 0.f, 0.f, 0.f};
    half8 At[4][2], B0[2][2], B1[2][2];
    const char* cA = (const char*)g.A + (size_t)cur.pm * tstep; const char* cB = (const char*)g.Bt + (size_t)cur.pn * tstep;
    PG8_STAGE(PG8_SB(0, 0), cB, voffB); PG8_STAGE(PG8_SA(0, 0), cA, voffA); PG8_STAGE(PG8_SB(0, 1), cB + hstep, voffB); PG8_STAGE(PG8_SA(0, 1), cA + hstep, voffA);
    if (wr == 1) PG8_BAR;
    PG8_WAIT_V(4); PG8_BAR;
    PG8_STAGE(PG8_SB(1, 0), cB + kstep, voffB); PG8_STAGE(PG8_SA(1, 0), cA + kstep, voffA); PG8_STAGE(PG8_SB(1, 1), cB + hstep + kstep, voffB);
    PG8_WAIT_V(6); PG8_BAR;
    for (;;) {
        const bool has_next = S.next(ui + 1, nxt);
        const char* nA = has_next ? (const char*)g.A + (size_t)nxt.pm * tstep : cA; const char* nB = has_next ? (const char*)g.Bt + (size_t)nxt.pn * tstep : cB;
        for (int t = 0; t < nt; t += 2) {
            const bool last = (t == nt - 2);
            const char* a1 = cA + (size_t)(t + 1) * kstep;
            const char* a2 = last ? nA : cA + (size_t)(t + 2) * kstep; const char* b2 = last ? nB : cB + (size_t)(t + 2) * kstep;
            const char* a3 = a2 + kstep; const char* b3 = b2 + kstep;
            PG8_LDB(B0, 0, 0); PG8_SCHED; PG8_LDA(At, 0, 0); PG8_STAGE(PG8_SA(1, 1), a1 + hstep, voffA);
            PG8_WAIT_L(8); PG8_BAR; PG8_WAIT_L(0); PG8_MMA(0, 0, At, B0); PG8_BAR; PG8_SCHED;
            PG8_LDB(B1, 0, 1); PG8_STAGE(PG8_SB(0, 0), b2, voffB);
            PG8_BAR; PG8_WAIT_L(0); PG8_MMA(0, 1, At, B1); PG8_BAR;
            PG8_LDA(At, 0, 1); PG8_STAGE(PG8_SA(0, 0), a2, voffA);
            PG8_BAR; PG8_WAIT_L(0); PG8_MMA(1, 0, At, B0); PG8_BAR; PG8_SCHED;
            PG8_STAGE(PG8_SB(0, 1), b2 + hstep, voffB);
            PG8_WAIT_V(6); PG8_BAR; PG8_MMA(1, 1, At, B1); PG8_BAR;
            PG8_LDB(B0, 1, 0); PG8_SCHED; PG8_LDA(At, 1, 0); PG8_STAGE(PG8_SA(0, 1), a2 + hstep, voffA);
            PG8_WAIT_L(8); PG8_BAR; PG8_WAIT_L(0); PG8_MMA(0, 0, At, B0); PG8_BAR; PG8_SCHED;
            PG8_LDB(B1, 1, 1); PG8_STAGE(PG8_SB(1, 0), b3, voffB);
            PG8_BAR; PG8_WAIT_L(0); PG8_MMA(0, 1, At, B1); PG8_BAR;
            PG8_LDA(At, 1, 1); PG8_STAGE(PG8_SA(1, 0), a3, voffA);
            PG8_BAR; PG8_WAIT_L(0); PG8_MMA(1, 0, At, B0); PG8_BAR; PG8_SCHED;
            PG8_STAGE(PG8_SB(1, 1), b3 + hstep, voffB);
            PG8_WAIT_V(6); PG8_BAR; PG8_MMA(1, 1, At, B1); PG8_BAR;
        }
        if constexpr (Epi::I8) {
#pragma unroll
            for (int a = 0; a < 2; ++a)
#pragma unroll
                for (int b = 0; b < 2; ++b)
#pragma unroll
                    for (int m = 0; m < 4; ++m)
#pragma unroll
                        for (int n = 0; n < 2; ++n) { const i32x4 v = __builtin_bit_cast(i32x4, acc[a][b][m][n]); acc[a][b][m][n] = (f32x4){(float)v[0], (float)v[1], (float)v[2], (float)v[3]}; }
        }
        E(acc, cur, wr, wc, fr, fq);
        if (!has_next) break;
#pragma unroll
        for (int a = 0; a < 2; ++a)
#pragma unroll
            for (int b = 0; b < 2; ++b)
#pragma unroll
                for (int m = 0; m < 4; ++m)
#pragma unroll
                    for (int n = 0; n < 2; ++n) acc[a][b][m][n] = (f32x4){0.f, 0.f, 0.f, 0.f};
        cur = nxt; cA = nA; cB = nB; ++ui;
    }
    PG8_WAIT_V(0);
    if (wr == 0) PG8_BAR;
    PG8_BAR;
#undef PG8_SA
#undef PG8_SB
#undef PG8_STAGE
#undef PG8_LDA
#undef PG8_LDB
#undef PG8_MMA
#undef PG8_WAIT_V
#undef PG8_WAIT_L
#undef PG8_BAR
#undef PG8_SCHED
}
}

__device__ __forceinline__ float silu_f(float v) { return v * __builtin_amdgcn_rcpf(1.0f + __expf(-v)); }
__device__ __forceinline__ half4 to_half4(f32x4 v) { half4 h; h[0] = (f16)v[0]; h[1] = (f16)v[1]; h[2] = (f16)v[2]; h[3] = (f16)v[3]; return h; }

__device__ __forceinline__ float row_rstd(const float* ss, int np, int row) {
    float s;
    if (np == 1) s = ss[row];
    else { const f32x4* p = (const f32x4*)(ss + (size_t)row * 16); const f32x4 a = p[0], b = p[1], c = p[2], d = p[3];
        s = (((a[0] + a[1]) + (a[2] + a[3])) + ((b[0] + b[1]) + (b[2] + b[3]))) + (((c[0] + c[1]) + (c[2] + c[3])) + ((d[0] + d[1]) + (d[2] + d[3]))); }
    return rsqrtf(s * (1.0f / D) + EPS);
}
template <bool I8_> struct EpiSwiglu {
    static constexpr bool I8 = I8_;
    f16* G; const float* ss; int np; const float* sa; const float* sw;
    __device__ __forceinline__ void operator()(const f32x4 (&acc)[2][2][4][2], const pg8::Unit& u, int wr, int wc, int fr_, int fq_) const {
        int fr = fr_, fq = fq_; asm volatile("" : "+v"(fr), "+v"(fq));
        f32x4 swg[2], swu[2];
        if constexpr (I8) {
#pragma unroll
            for (int n = 0; n < 2; ++n) { swg[n] = *(const f32x4*)(sw + u.pn * 256 + wc * 32 + 8 * fq + 4 * n); swu[n] = *(const f32x4*)(sw + u.pn * 256 + 128 + wc * 32 + 8 * fq + 4 * n); }
        }
#pragma unroll
        for (int ai = 0; ai < 2; ++ai)
#pragma unroll
            for (int m = 0; m < 4; ++m) {
                const int row = u.pm * 256 + ai * 128 + wr * 64 + m * 16 + fr;
                float rs = row_rstd(ss, np, row); if constexpr (I8) rs *= sa[row];
                const float ce = -1.4426950408889634f * rs, rs2 = rs * rs; half8 o;
#pragma unroll
                for (int n = 0; n < 2; ++n) {
                    f32x4 g = acc[ai][0][m][n], u = acc[ai][1][m][n];
                    if constexpr (I8) { g = g * swg[n]; u = u * swu[n]; }
                    const f32x4 t = g * ce; f32x4 e, r;
#pragma unroll
                    for (int j = 0; j < 4; ++j) e[j] = __builtin_amdgcn_exp2f(t[j]);
                    const f32x4 d = e + 1.0f;
#pragma unroll
                    for (int j = 0; j < 4; ++j) r[j] = __builtin_amdgcn_rcpf(d[j]);
                    const f32x4 w = (g * u) * (r * rs2);
#pragma unroll
                    for (int j = 0; j < 4; ++j) o[4 * n + j] = (f16)w[j];
                }
                *(half8*)(G + (size_t)row * DFF + u.pn * 128 + wc * 32 + 8 * fq) = o;
            }
    }
};
template <bool SRC16> struct EpiResid {
    static constexpr bool I8 = false;
    const void* src; f16* h16; float* ss; float alpha;
    __device__ __forceinline__ void operator()(const f32x4 (&acc)[2][2][4][2], const pg8::Unit& u, int wr, int wc, int fr_, int fq_) const {
        int fr = fr_, fq = fq_; asm volatile("" : "+v"(fr), "+v"(fq));
#pragma unroll
        for (int ai = 0; ai < 2; ++ai)
#pragma unroll
            for (int m = 0; m < 4; ++m) {
                const int row = u.pm * 256 + ai * 128 + wr * 64 + m * 16 + fr; float part = 0.f;
#pragma unroll
                for (int bj = 0; bj < 2; ++bj) {
                    const size_t off = (size_t)row * D + u.pn * 256 + bj * 128 + wc * 32 + 8 * fq; half8 h; f32x4 sv[2];
                    if (SRC16) { const half8 s8 = *(const half8*)((const f16*)src + off);
#pragma unroll
                        for (int j = 0; j < 4; ++j) { sv[0][j] = (float)s8[j]; sv[1][j] = (float)s8[4 + j]; } }
                    else { sv[0] = *(const f32x4*)((const float*)src + off); sv[1] = *(const f32x4*)((const float*)src + off + 4); }
#pragma unroll
                    for (int n = 0; n < 2; ++n) {
                        const f32x4 o = sv[n] + alpha * acc[ai][bj][m][n];
#pragma unroll
                        for (int j = 0; j < 4; ++j) h[4 * n + j] = (f16)o[j];
                        part += (o[0] * o[0] + o[1] * o[1]) + (o[2] * o[2] + o[3] * o[3]);
                    }
                    *(half8*)(h16 + off) = h;
                }
                part += __shfl_xor(part, 16); part += __shfl_xor(part, 32);
                if (fq == 0) ss[(size_t)row * 16 + u.pn * 4 + wc] = part;
            }
    }
};
constexpr float K_I8_SCALE = 127.0f / 8.0f;
__device__ __forceinline__ void rope8(const f32x4 (&x1)[2], const f32x4 (&x2)[2], const f32x2* rp, float sc, float (&o1)[8], float (&o2)[8]) {
#pragma unroll
    for (int n = 0; n < 2; ++n) {
        const f32x4 cs0 = *(const f32x4*)(rp + 4 * n), cs1 = *(const f32x4*)(rp + 4 * n + 2);
        o1[4 * n + 0] = (x1[n][0] * cs0[0] - x2[n][0] * cs0[1]) * sc; o2[4 * n + 0] = (x2[n][0] * cs0[0] + x1[n][0] * cs0[1]) * sc;
        o1[4 * n + 1] = (x1[n][1] * cs0[2] - x2[n][1] * cs0[3]) * sc; o2[4 * n + 1] = (x2[n][1] * cs0[2] + x1[n][1] * cs0[3]) * sc;
        o1[4 * n + 2] = (x1[n][2] * cs1[0] - x2[n][2] * cs1[1]) * sc; o2[4 * n + 2] = (x2[n][2] * cs1[0] + x1[n][2] * cs1[1]) * sc;
        o1[4 * n + 3] = (x1[n][3] * cs1[2] - x2[n][3] * cs1[3]) * sc; o2[4 * n + 3] = (x2[n][3] * cs1[2] + x1[n][3] * cs1[3]) * sc;
    }
}
__device__ __forceinline__ u32x2 pack_i8x8(const float (&v)[8]) {
    u32x2 r;
#pragma unroll
    for (int w = 0; w < 2; ++w) { unsigned word = 0u;
#pragma unroll
        for (int j = 0; j < 4; ++j) { const int q = (int)__builtin_rintf(fminf(fmaxf(v[4 * w + j] * K_I8_SCALE, -127.f), 127.f)); word |= ((unsigned)q & 0xffu) << (8 * j); }
        r[w] = word; }
    return r;
}
__device__ __forceinline__ u32x2 pack_bf8x8(const float (&v)[8]) {
    u32x2 r;
#pragma unroll
    for (int w = 0; w < 2; ++w) { int word = __builtin_amdgcn_cvt_pk_bf8_f32(v[4 * w], v[4 * w + 1], 0, false); word = __builtin_amdgcn_cvt_pk_bf8_f32(v[4 * w + 2], v[4 * w + 3], word, true); r[w] = (unsigned)word; }
    return r;
}
struct EpiInProj {
    static constexpr bool I8 = false;
    const float* ss; const f32x2* rope; unsigned char* ws;
    __device__ __forceinline__ void operator()(const f32x4 (&acc)[2][2][4][2], const pg8::Unit& u, int wr, int wc, int fr_, int fq_) const {
        int fr = fr_, fq = fq_; asm volatile("" : "+v"(fr), "+v"(fq));
        const int pn = u.pn;
        if (pn >= 8 && pn <= 11) {
            unsigned char* lb = (pn <= 9) ? ws + WS_KV + (size_t)((pn - 8) * 4 + wc) * LP * 128 + 8 * fq
                                          : ws + WS_KV + (size_t)((pn - 10) * 4 + (wc >> 1)) * LP * 128 + 64 + (wc & 1) * 32 + 8 * fq;
#pragma unroll
            for (int ai = 0; ai < 2; ++ai)
#pragma unroll
                for (int m = 0; m < 4; ++m) {
                    const int p = u.pm * 256 + ai * 128 + wr * 64 + m * 16 + fr;
                    const int t = p < SEQ ? p + NMETA : p - SEQ;
                    if (p < L) {
                        const float sc = row_rstd(ss, 16, p);
                        if (pn <= 9) {
                            float o1[8], o2[8]; rope8(acc[ai][0][m], acc[ai][1][m], rope + (size_t)t * 32 + 8 * fq, sc, o1, o2);
                            unsigned char* d8 = lb + (size_t)t * 128; *(u32x2*)d8 = pack_i8x8(o1); *(u32x2*)(d8 + 32) = pack_i8x8(o2);
                        } else {
#pragma unroll
                            for (int bj = 0; bj < 2; ++bj) { float v[8];
#pragma unroll
                                for (int j = 0; j < 4; ++j) { v[j] = acc[ai][bj][m][0][j] * sc; v[4 + j] = acc[ai][bj][m][1][j] * sc; }
                                *(u32x2*)(lb + (size_t)t * 128 + (size_t)bj * 2 * LP * 128) = pack_bf8x8(v); }
                        }
                    }
                    asm volatile("" ::: "memory");
                }
            return;
        }
        int mode = 0, stride = 256; float scale = 1.0f; f16* lanebase;
        if (pn == 0) lanebase = (f16*)(ws + WS_GQ) + wc * 32 + 8 * fq;
        else if (pn == 1) lanebase = (f16*)(ws + WS_GK) + wc * 32 + 8 * fq;
        else if (pn <= 3) { lanebase = (f16*)(ws + WS_GV) + (pn - 2) * 256 + wc * 32 + 8 * fq; stride = 512; }
        else if (pn <= 5) { lanebase = (f16*)(ws + WS_GR) + (pn - 4) * 256 + wc * 32 + 8 * fq; stride = 512; }
        else if (pn <= 7) { lanebase = (f16*)(ws + WS_DQ); mode = 6; scale = 0.125f; }
        else if (pn <= 13) { lanebase = (f16*)(ws + WS_IQ) + (pn - 12) * 256 + wc * 64 + 8 * fq; stride = 512; mode = 1; scale = 0.125f; }
        else { lanebase = (f16*)(ws + WS_IK) + 8 * fq; stride = 64; mode = wc == 0 ? 1 : (wc == 1 ? 2 : 3); }
#pragma unroll
        for (int ai = 0; ai < 2; ++ai)
#pragma unroll
            for (int m = 0; m < 4; ++m) {
                const int p = u.pm * 256 + ai * 128 + wr * 64 + m * 16 + fr;
                const int t = p < SEQ ? p + NMETA : p - SEQ;
                if (p < L && mode != 3) {
                    const float rs = row_rstd(ss, 16, p);
                    if (mode == 6) {
                        float o1[8], o2[8]; rope8(acc[ai][0][m], acc[ai][1][m], rope + (size_t)t * 32 + 8 * fq, rs * scale, o1, o2);
                        float qm = 1e-20f;
#pragma unroll
                        for (int j = 0; j < 8; ++j) qm = fmaxf(qm, fmaxf(fabsf(o1[j]), fabsf(o2[j])));
                        qm = fmaxf(qm, __shfl_xor(qm, 16)); qm = fmaxf(qm, __shfl_xor(qm, 32));
                        const float qsc = 127.0f * __builtin_amdgcn_rcpf(qm); u32x2 w1, w2;
#pragma unroll
                        for (int w = 0; w < 2; ++w) { unsigned a = 0u, b = 0u;
#pragma unroll
                            for (int j = 0; j < 4; ++j) { a |= ((unsigned)(int)__builtin_rintf(o1[4 * w + j] * qsc) & 0xffu) << (8 * j); b |= ((unsigned)(int)__builtin_rintf(o2[4 * w + j] * qsc) & 0xffu) << (8 * j); }
                            w1[w] = a; w2[w] = b; }
                        const int head = (pn - 6) * 4 + wc; unsigned char* qrow = ws + WS_DQ + (size_t)t * 512 + head * 64 + 8 * fq;
                        *(u32x2*)qrow = w1; *(u32x2*)(qrow + 32) = w2;
                        if (fq == 0) ((float*)(ws + WS_DQ + (size_t)LP * 512))[(size_t)t * 8 + head] = qm * (1.0f / (127.0f * K_I8_SCALE));
                    } else if (mode == 1) {
                        float o1[8], o2[8]; rope8(acc[ai][0][m], acc[ai][1][m], rope + (size_t)t * 32 + 8 * fq, rs * scale, o1, o2);
                        half8 h1, h2;
#pragma unroll
                        for (int j = 0; j < 8; ++j) { h1[j] = (f16)o1[j]; h2[j] = (f16)o2[j]; }
                        f16* dst = lanebase + (size_t)t * stride; *(half8*)dst = h1; *(half8*)(dst + 32) = h2;
                    } else if (mode == 2) {
                        if (fq < 2) { float* gp = (float*)(ws + WS_GA) + (size_t)t * 16 + 8 * fq; *(f32x4*)gp = acc[ai][0][m][0] * rs; *(f32x4*)(gp + 4) = acc[ai][0][m][1] * rs; }
                        else if (fq == 2) { float* ip = (float*)(ws + WS_IW) + (size_t)t * 8; const float r2 = rs * 0.35355339059327373f; *(f32x4*)ip = acc[ai][0][m][0] * r2; *(f32x4*)(ip + 4) = acc[ai][0][m][1] * r2; }
                    } else {
#pragma unroll
                        for (int bj = 0; bj < 2; ++bj) { half8 h;
#pragma unroll
                            for (int j = 0; j < 4; ++j) { h[j] = (f16)(acc[ai][bj][m][0][j] * rs); h[4 + j] = (f16)(acc[ai][bj][m][1][j] * rs); }
                            *(half8*)(lanebase + (size_t)t * stride + bj * 128) = h; }
                    }
                }
                asm volatile("" ::: "memory");
            }
    }
};

__device__ __forceinline__ const float* w_src(const Params& P, int kind, int n, int& ld, const float*& gain) {
    switch (kind) {
    case 0: case 4: { const int pn = n >> 8, bj = (n >> 7) & 1, cc = n & 127; ld = DFF; gain = kind == 0 ? P.n1 : P.n2;
        const float* w = kind == 0 ? (bj ? P.wu1 : P.wg1) : (bj ? P.wu2 : P.wg2); return w + pn * 128 + cc; }
    case 1: ld = D; gain = nullptr; return P.wd1 + n;
    case 5: ld = D; gain = nullptr; return P.wd2 + n;
    case 3: ld = D; gain = nullptr; return P.wout + n;
    default: { ld = 3672; gain = P.nmix; const int pn = n >> 8, c = n & 255, bj = c >> 7, hh = (c >> 5) & 3, dd = c & 31; int j;
        if (pn == 0) j = c; else if (pn == 1) j = 256 + c; else if (pn <= 3) j = 512 + (pn - 2) * 256 + c; else if (pn <= 5) j = 1024 + (pn - 4) * 256 + c;
        else if (pn <= 7) j = 1552 + (pn - 6) * 256 + hh * 64 + bj * 32 + dd;
        else if (pn <= 9) j = 2064 + (pn - 8) * 256 + hh * 64 + bj * 32 + dd;
        else if (pn <= 11) j = 2576 + (pn - 10) * 256 + c;
        else if (pn <= 13) j = 3088 + (pn - 12) * 256 + hh * 64 + bj * 32 + dd;
        else { if (c < 32) j = 3600 + c; else if (c < 48) j = 1536 + (c - 32); else if (c < 56) j = 3664 + (c - 48); else if (c >= 128 && c < 160) j = 3600 + 32 + (c - 128); else j = -1; }
        return j < 0 ? nullptr : P.win + j; }
    }
}
__device__ __forceinline__ void prep_weight(const Params& P, const int kind, const int N, const int K, f16* dst, int& cursor, int& tbase, LAS f16* tl, const int G) {
    const int tid = threadIdx.x, tn = N / 64, tk = K / 256, ntile = tn * tk;
    const int n = tid & 63, kk0 = tid >> 6;
    float v[32], vn[32];
#define PREP_LOAD(dstv, tI) do { const int n0_ = ((tI) % tn) * 64, k0_ = ((tI) / tn) * 256; int ld; const float* gain; const float* col = w_src(P, kind, n0_ + n, ld, gain); \
        _Pragma("unroll") for (int i = 0; i < 32; ++i) dstv[i] = col ? col[(size_t)(k0_ + kk0 + 8 * i) * ld] : 0.f; \
        if (gain) { _Pragma("unroll") for (int i = 0; i < 32; ++i) dstv[i] *= gain[k0_ + kk0 + 8 * i]; } } while (0)
    if (cursor < tbase + ntile) PREP_LOAD(v, cursor - tbase);
#pragma unroll 1
    for (; cursor < tbase + ntile; cursor += G) {
        const int tI = cursor - tbase, n0 = (tI % tn) * 64, k0 = (tI / tn) * 256;
        const bool more = cursor + G < tbase + ntile;
        if (more) PREP_LOAD(vn, tI + G);
#pragma unroll
        for (int i = 0; i < 32; ++i) tl[n * 264 + kk0 + 8 * i] = (f16)v[i];
        __syncthreads();
        { const int nr = tid >> 3, seg = tid & 7;
#pragma unroll
          for (int j = 0; j < 4; ++j) *(half8*)(dst + (size_t)(n0 + nr) * K + k0 + (seg + 8 * j) * 8) = *(const LAS half8*)(tl + nr * 264 + (seg + 8 * j) * 8); }
        __syncthreads();
        if (more) {
#pragma unroll
            for (int i = 0; i < 32; ++i) v[i] = vn[i];
        }
    }
#undef PREP_LOAD
    tbase += ntile;
}
__device__ __forceinline__ void prep_weight_i8(const Params& P, const int kind, const int N, unsigned char* dst, float* sw, int first, int step, LAS unsigned char* lds) {
    const int tid = threadIdx.x, n = tid & 63, kk0 = tid >> 6;
    LAS float* pmax = (LAS float*)lds; LAS unsigned* img = (LAS unsigned*)(lds + 2048);
#pragma unroll 1
    for (int task = first; task < N / 64; task += step) {
        const int n0 = task * 64; int ld; const float* gain; const float* col = w_src(P, kind, n0 + n, ld, gain);
        float v[128]; float mx = 0.f;
#pragma unroll
        for (int i = 0; i < 128; ++i) v[i] = col ? col[(size_t)(kk0 * 128 + i) * ld] : 0.f;
        if (gain) {
#pragma unroll
            for (int i = 0; i < 128; ++i) v[i] *= gain[kk0 * 128 + i];
        }
#pragma unroll
        for (int i = 0; i < 128; ++i) mx = fmaxf(mx, fabsf(v[i]));
        pmax[kk0 * 64 + n] = mx;
        __syncthreads();
#pragma unroll
        for (int q = 0; q < 8; ++q) mx = fmaxf(mx, pmax[q * 64 + n]);
        const float sc = mx > 0.f ? 127.0f / mx : 0.f;
        if (kk0 == 0) sw[n0 + n] = mx * (1.0f / 127.0f);
#pragma unroll
        for (int w = 0; w < 32; ++w) { unsigned word = 0u;
#pragma unroll
            for (int j = 0; j < 4; ++j) word |= ((unsigned)(int)__builtin_rintf(v[4 * w + j] * sc) & 0xffu) << (8 * j);
            img[n * 260 + kk0 * 32 + w] = word; }
        __syncthreads();
        { const int nr = tid >> 3, seg = tid & 7;
#pragma unroll
          for (int j = 0; j < 8; ++j) *(u32x4*)(dst + (size_t)(n0 + nr) * D + (seg + 8 * j) * 16) = *(const LAS u32x4*)(img + nr * 260 + (seg + 8 * j) * 4); }
        __syncthreads();
    }
}
__device__ __forceinline__ void quant_rows_i8(const f16* src, unsigned char* dst, float* sa, int rows) {
    const int tid = threadIdx.x, lane = tid & 63, gw = blockIdx.x * 8 + (tid >> 6), nw = gridDim.x * 8;
    for (int r = gw; r < rows; r += nw) {
        const half8 a = *(const half8*)(src + (size_t)r * D + lane * 16), b = *(const half8*)(src + (size_t)r * D + lane * 16 + 8);
        float v[16], mx = 0.f;
#pragma unroll
        for (int j = 0; j < 8; ++j) { v[j] = (float)a[j]; v[8 + j] = (float)b[j]; }
#pragma unroll
        for (int j = 0; j < 16; ++j) mx = fmaxf(mx, fabsf(v[j]));
#pragma unroll
        for (int o = 32; o >= 1; o >>= 1) mx = fmaxf(mx, __shfl_xor(mx, o));
        const float sc = mx > 0.f ? 127.0f / mx : 0.f; u32x4 w;
#pragma unroll
        for (int q = 0; q < 4; ++q) { unsigned word = 0u;
#pragma unroll
            for (int j = 0; j < 4; ++j) word |= ((unsigned)(int)__builtin_rintf(v[4 * q + j] * sc) & 0xffu) << (8 * j);
            w[q] = word; }
        *(u32x4*)(dst + (size_t)r * D + lane * 16) = w;
        if (lane == 0) sa[r] = mx * (1.0f / 127.0f);
    }
}
__device__ __forceinline__ void p0_prologue(const Params& P, LAS unsigned char* lds) {
    const int tid = threadIdx.x, bid = blockIdx.x, G = gridDim.x, lane = tid & 63;
    unsigned char* ws = P.ws;
    LAS f16* tl = (LAS f16*)lds;
    {
        constexpr int NI8 = 2 * DFF / 64; const int nI = G > 2 * NI8 ? NI8 : 0;
        if (bid >= G - nI || nI == 0) prep_weight_i8(P, 0, 2 * DFF, ws + WS_WGU1, (float*)(ws + WS_WGU1 + (size_t)2 * DFF * D), nI ? bid - (G - nI) : bid, nI ? nI : G, lds);
        if (bid < G - nI) { int tbase = 0, cursor = bid; __syncthreads();
            prep_weight(P, 1, D, DFF, (f16*)(ws + WS_WD1), cursor, tbase, tl, G - nI);
            prep_weight(P, 2, NIN, D, (f16*)(ws + WS_WIN), cursor, tbase, tl, G - nI); }
    }
    float* ss0 = (float*)(ws + WS_SS0);
    f16* acta = (f16*)(ws + WS_ACTA);
    const int gw = bid * 8 + (tid >> 6), nw = G * 8;
    unsigned char* x8 = ws + WS_US; float* sa0 = (float*)(ws + WS_IQ);
    for (int p = gw; p < L; p += nw) {
        const float* src = p < SEQ ? P.x + (size_t)p * D : P.meta + (size_t)(p - SEQ) * D; float s = 0.f, mx = 0.f; f32x4 v[4];
#pragma unroll
        for (int i = 0; i < 4; ++i) { v[i] = *(const f32x4*)(src + lane * 4 + 256 * i); s += (v[i][0] * v[i][0] + v[i][1] * v[i][1]) + (v[i][2] * v[i][2] + v[i][3] * v[i][3]);
            mx = fmaxf(fmaxf(mx, fmaxf(fabsf(v[i][0]), fabsf(v[i][1]))), fmaxf(fabsf(v[i][2]), fabsf(v[i][3]))); *(half4*)(acta + (size_t)p * D + lane * 4 + 256 * i) = to_half4(v[i]); }
#pragma unroll
        for (int o = 32; o >= 1; o >>= 1) { s += __shfl_xor(s, o); mx = fmaxf(mx, __shfl_xor(mx, o)); }
        const float sc = mx > 0.f ? 127.0f / mx : 0.f;
#pragma unroll
        for (int i = 0; i < 4; ++i) { unsigned word = 0u;
#pragma unroll
            for (int j = 0; j < 4; ++j) word |= ((unsigned)(int)__builtin_rintf(v[i][j] * sc) & 0xffu) << (8 * j);
            *(unsigned*)(x8 + (size_t)p * D + lane * 4 + 256 * i) = word; }
        if (lane == 0) { ss0[p] = s; sa0[p] = mx * (1.0f / 127.0f); }
    }
    const int gt = bid * NTHREADS + tid, ngt = G * NTHREADS;
    for (int i = gt; i < MP; i += ngt) { if (i >= L) { ss0[i] = (float)D; sa0[i] = 0.f; } }
    f32x2* rope = (f32x2*)(ws + WS_ROPE);
    for (int i = gt; i < L * 32; i += ngt) { const int t = i >> 5, f = i & 31; const double inv = exp(-(double)f * (9.210340371976184 / 32.0)); double sn, cs; sincos((double)t * inv, &sn, &cs); rope[i] = (f32x2){(float)cs, (float)sn}; }
}

__device__ __forceinline__ void meta_down(const Params& P, LAS unsigned char* lds) {
    const int tid = threadIdx.x, lane = tid & 63, wid = tid >> 6;
    const f16* Gm = (const f16*)(P.ws + WS_G) + (size_t)SEQ * DFF; const f16* Wt = (const f16*)(P.ws + WS_WD1);
    f16* acta = (f16*)P.out; float* ss1 = (float*)(P.ws + WS_SS1); LAS float* slot = (LAS float*)lds;
    for (int task = blockIdx.x; task < NMETA * 16; task += gridDim.x) {
        const int r = task >> 4, cg = task & 15; float part = 0.f;
#pragma unroll 1
        for (int q = 0; q < 2; ++q) {
            const int n0 = cg * 64 + (2 * wid + q) * 4; float a[4] = {0.f, 0.f, 0.f, 0.f};
            for (int kc = lane; kc < DFF / 8; kc += 64) {
                const half8 gv = *(const half8*)(Gm + (size_t)r * DFF + kc * 8);
#pragma unroll
                for (int j = 0; j < 4; ++j) { const half8 wv = *(const half8*)(Wt + (size_t)(n0 + j) * DFF + kc * 8);
#pragma unroll
                    for (int e = 0; e < 8; ++e) a[j] += (float)gv[e] * (float)wv[e]; }
            }
#pragma unroll
            for (int o = 32; o >= 1; o >>= 1) { a[0] += __shfl_xor(a[0], o); a[1] += __shfl_xor(a[1], o); a[2] += __shfl_xor(a[2], o); a[3] += __shfl_xor(a[3], o); }
            f32x4 o;
#pragma unroll
            for (int j = 0; j < 4; ++j) { o[j] = P.meta[r * D + n0 + j] + 0.5f * a[j]; part += o[j] * o[j]; }
            if (lane == 0) *(half4*)(acta + (size_t)(SEQ + r) * D + n0) = to_half4(o);
        }
        if (lane == 0) slot[wid] = part;
        __syncthreads();
        if (tid == 0) { float s = 0.f; for (int w = 0; w < 8; ++w) s += slot[w]; ss1[(size_t)(SEQ + r) * 16 + cg] = s; }
        __syncthreads();
    }
}

__device__ __forceinline__ float logsigmoid_f(float z) { return fminf(z, 0.f) - __logf(1.0f + __expf(-fabsf(z))); }
__device__ __forceinline__ void gla_gates(const Params& P, int c, int h, LAS float* bl) {
    const int tid = threadIdx.x, ti = tid >> 3, d0 = (tid & 7) * 8, tt = 64 * c - 48 + ti; const float* GA = (const float*)(P.ws + WS_GA);
    {
        float z[8];
        if (tt >= 0 && tt < L) {
            const f32x4 b0 = *(const f32x4*)(P.ba + 64 * h + d0), b1 = *(const f32x4*)(P.ba + 64 * h + d0 + 4);
#pragma unroll
            for (int m = 0; m < 4; ++m) { z[m] = b0[m]; z[4 + m] = b1[m]; }
            f32x4 a4[4];
#pragma unroll
            for (int q = 0; q < 4; ++q) a4[q] = *(const f32x4*)(GA + (size_t)tt * 16 + 4 * q);
#pragma unroll
            for (int r = 0; r < 16; ++r) { const float ar = a4[r >> 2][r & 3]; const f32x4 w0 = *(const f32x4*)(P.wa2 + r * 256 + 64 * h + d0), w1 = *(const f32x4*)(P.wa2 + r * 256 + 64 * h + d0 + 4);
#pragma unroll
                for (int m = 0; m < 4; ++m) { z[m] += ar * w0[m]; z[4 + m] += ar * w1[m]; } }
#pragma unroll
            for (int m = 0; m < 8; ++m) z[m] = logsigmoid_f(z[m]) * (1.0f / 16.0f);
        } else {
#pragma unroll
            for (int m = 0; m < 8; ++m) z[m] = 0.f;
        }
#pragma unroll
        for (int m = 0; m < 8; ++m) bl[ti * 65 + d0 + m] = z[m];
    }
    __syncthreads();
    {
        const int d = tid & 63, seg = tid >> 6; float v[8], run = 0.f;
#pragma unroll
        for (int i = 0; i < 8; ++i) { run += bl[(seg * 8 + i) * 65 + d]; v[i] = run; }
#pragma unroll
        for (int i = 0; i < 8; ++i) bl[(seg * 8 + i) * 65 + d] = v[i];
        __syncthreads();
        float off = 0.f;
#pragma unroll
        for (int sg = 0; sg < 7; ++sg) off += (sg < seg) ? bl[(sg * 8 + 7) * 65 + d] : 0.f;
        __syncthreads();
#pragma unroll
        for (int i = 0; i < 8; ++i) bl[(seg * 8 + i) * 65 + d] = v[i] + off;
    }
    __syncthreads();
}
__device__ __forceinline__ void gla_a_unit(const Params& P, int unit, LAS unsigned char* lds) {
    int tid_ = threadIdx.x; asm volatile("" : "+v"(tid_));
    const int tid = tid_, lane = tid & 63, wid = tid >> 6, c = unit >> 2, h = unit & 3;
    LAS float* bl = (LAS float*)lds; LAS float* ks = bl + 4160; LAS float* vs = ks + 4096;
    const f16* GK = (const f16*)(P.ws + WS_GK); const f16* GV = (const f16*)(P.ws + WS_GV);
    float* U = (float*)(P.ws + WS_US); float* DEC = (float*)(P.ws + WS_DECAY);
    const int ti = tid >> 3, d0 = (tid & 7) * 8, tt = 64 * c - 48 + ti; const bool tv = tt >= 0 && tt < L;
    half8 k8, v8[2];
#pragma unroll
    for (int m = 0; m < 8; ++m) { k8[m] = (f16)0.f; v8[0][m] = (f16)0.f; v8[1][m] = (f16)0.f; }
    if (tv) k8 = *(const half8*)(GK + (size_t)tt * 256 + 64 * h + d0);
#pragma unroll
    for (int q = 0; q < 2; ++q) { const int ch = tid + 512 * q, j = ch >> 4, t = 64 * c - 48 + j; if (t >= 0 && t < L) v8[q] = *(const half8*)(GV + (size_t)t * 512 + 128 * h + (ch & 15) * 8); }
    gla_gates(P, c, h, bl);
    { f32x4 o0, o1;
#pragma unroll
      for (int m = 0; m < 4; ++m) { o0[m] = (float)k8[m] * __expf(bl[63 * 65 + d0 + m] - bl[ti * 65 + d0 + m]); o1[m] = (float)k8[4 + m] * __expf(bl[63 * 65 + d0 + 4 + m] - bl[ti * 65 + d0 + 4 + m]); }
      *(LAS f32x4*)(ks + ti * 64 + d0) = o0; *(LAS f32x4*)(ks + ti * 64 + d0 + 4) = o1; }
#pragma unroll
    for (int q = 0; q < 2; ++q) { const int ch = tid + 512 * q, j = ch >> 4, e0 = (ch & 15) * 8; f32x4 o0, o1;
#pragma unroll
        for (int m = 0; m < 4; ++m) { o0[m] = (float)v8[q][m]; o1[m] = (float)v8[q][4 + m]; }
        *(LAS f32x4*)(vs + j * 128 + e0) = o0; *(LAS f32x4*)(vs + j * 128 + e0 + 4) = o1; }
    if (tid < 64) DEC[(size_t)c * 256 + h * 64 + tid] = __expf(bl[63 * 65 + tid]);
    __syncthreads();
    { const int dd0 = (wid >> 2) * 32, e0 = (wid & 3) * 32, l31 = lane & 31, hf = lane >> 5; f32x16 acc;
#pragma unroll
      for (int i = 0; i < 16; ++i) acc[i] = 0.f;
#pragma unroll 8
      for (int s = 0; s < 32; ++s) acc = __builtin_amdgcn_mfma_f32_32x32x2f32(ks[(2 * s + hf) * 64 + dd0 + l31], vs[(2 * s + hf) * 128 + e0 + l31], acc, 0, 0, 0);
      float* up = U + ((size_t)unit * 64) * 128;
#pragma unroll
      for (int r = 0; r < 16; ++r) { const int row = (r & 3) + 8 * (r >> 2) + 4 * hf; up[(size_t)(dd0 + row) * 128 + e0 + l31] = acc[r]; } }
    __syncthreads();
}
__device__ __forceinline__ void gla_scan(const Params& P) {
    float* U = (float*)(P.ws + WS_US); const float* DEC = (const float*)(P.ws + WS_DECAY);
    const int idx = blockIdx.x * NTHREADS + threadIdx.x;
    if (idx >= 32768) return;
    float s = 0.f;
#pragma unroll 8
    for (int c = 0; c < NCH; ++c) { const float u = U[(size_t)c * 32768 + idx], dc = DEC[(size_t)c * 256 + (idx >> 7)]; U[(size_t)c * 32768 + idx] = s; s = dc * s + u; }
}
__device__ __forceinline__ void gla_c_unit(const Params& P, int unit, LAS unsigned char* lds) {
    int tid_ = threadIdx.x; asm volatile("" : "+v"(tid_));
    const int tid = tid_, lane = tid & 63, wid = tid >> 6, c = unit >> 2, h = unit & 3, l31 = lane & 31, hf = lane >> 5;
    LAS float* bl = (LAS float*)lds; LAS float* kk = bl + 4160; LAS float* qs = kk + 4160; LAS float* As = qs + 4160; LAS float* vs = As + 4160; LAS float* Ss = vs + 8192; LAS float* os = bl;
    const f16* GQ = (const f16*)(P.ws + WS_GQ); const f16* GK = (const f16*)(P.ws + WS_GK); const f16* GV = (const f16*)(P.ws + WS_GV); const f16* GR = (const f16*)(P.ws + WS_GR);
    const float* Sg = (const float*)(P.ws + WS_US) + (size_t)unit * 8192; f16* mix = (f16*)(P.ws + WS_ACTA);
    const int ti = tid >> 3, d0 = (tid & 7) * 8, tt = 64 * c - 48 + ti; const bool tv = tt >= 0 && tt < L;
    half8 q8, k8, v8[2], r8[2]; f32x4 sreg[4];
#pragma unroll
    for (int m = 0; m < 8; ++m) { q8[m] = (f16)0.f; k8[m] = (f16)0.f; v8[0][m] = (f16)0.f; v8[1][m] = (f16)0.f; r8[0][m] = (f16)0.f; r8[1][m] = (f16)0.f; }
    if (tv) { q8 = *(const half8*)(GQ + (size_t)tt * 256 + 64 * h + d0); k8 = *(const half8*)(GK + (size_t)tt * 256 + 64 * h + d0);
        r8[0] = *(const half8*)(GR + (size_t)tt * 512 + 128 * h + (tid & 7) * 16); r8[1] = *(const half8*)(GR + (size_t)tt * 512 + 128 * h + (tid & 7) * 16 + 8); }
#pragma unroll
    for (int q = 0; q < 2; ++q) { const int ch = tid + 512 * q, j = ch >> 4, t = 64 * c - 48 + j; if (t >= 0 && t < L) v8[q] = *(const half8*)(GV + (size_t)t * 512 + 128 * h + (ch & 15) * 8); }
#pragma unroll
    for (int q = 0; q < 4; ++q) sreg[q] = *(const f32x4*)(Sg + (size_t)(tid + 512 * q) * 4);
    gla_gates(P, c, h, bl);
#pragma unroll
    for (int m = 0; m < 8; ++m) { const float bv = bl[ti * 65 + d0 + m]; qs[ti * 65 + d0 + m] = (float)q8[m] * 0.125f * __expf(bv); kk[ti * 65 + d0 + m] = (float)k8[m] * __expf(-bv); }
#pragma unroll
    for (int q = 0; q < 2; ++q) { const int ch = tid + 512 * q, j = ch >> 4, e0 = (ch & 15) * 8; f32x4 o0, o1;
#pragma unroll
        for (int m = 0; m < 4; ++m) { o0[m] = (float)v8[q][m]; o1[m] = (float)v8[q][4 + m]; }
        *(LAS f32x4*)(vs + j * 128 + e0) = o0; *(LAS f32x4*)(vs + j * 128 + e0 + 4) = o1; }
#pragma unroll
    for (int q = 0; q < 4; ++q) *(LAS f32x4*)(Ss + (tid + 512 * q) * 4) = sreg[q];
    __syncthreads();
    if (wid < 4) { const int i0 = (wid >> 1) * 32, j0 = (wid & 1) * 32; f32x16 acc;
#pragma unroll
        for (int i = 0; i < 16; ++i) acc[i] = 0.f;
#pragma unroll 8
        for (int s = 0; s < 32; ++s) acc = __builtin_amdgcn_mfma_f32_32x32x2f32(qs[(i0 + l31) * 65 + 2 * s + hf], kk[(j0 + l31) * 65 + 2 * s + hf], acc, 0, 0, 0);
#pragma unroll
        for (int r = 0; r < 16; ++r) { const int i = i0 + (r & 3) + 8 * (r >> 2) + 4 * hf, j = j0 + l31; As[i * 65 + j] = (j <= i) ? acc[r] : 0.f; } }
    __syncthreads();
    { const int i0 = (wid >> 2) * 32, e0 = (wid & 3) * 32; f32x16 acc;
#pragma unroll
      for (int i = 0; i < 16; ++i) acc[i] = 0.f;
#pragma unroll 8
      for (int s = 0; s < 32; ++s) acc = __builtin_amdgcn_mfma_f32_32x32x2f32(qs[(i0 + l31) * 65 + 2 * s + hf], Ss[(2 * s + hf) * 128 + e0 + l31], acc, 0, 0, 0);
#pragma unroll 8
      for (int s = 0; s < 32; ++s) acc = __builtin_amdgcn_mfma_f32_32x32x2f32(As[(i0 + l31) * 65 + 2 * s + hf], vs[(2 * s + hf) * 128 + e0 + l31], acc, 0, 0, 0);
#pragma unroll
      for (int r = 0; r < 16; ++r) { const int i = i0 + (r & 3) + 8 * (r >> 2) + 4 * hf; os[i * 129 + e0 + l31] = acc[r]; } }
    __syncthreads();
    { const int e0 = (tid & 7) * 16; float o[16], sq = 0.f;
#pragma unroll
      for (int j = 0; j < 16; ++j) { o[j] = os[ti * 129 + e0 + j]; sq += o[j] * o[j]; }
      sq += __shfl_xor(sq, 1); sq += __shfl_xor(sq, 2); sq += __shfl_xor(sq, 4);
      const float rs = rsqrtf(sq * (1.0f / 128.0f) + EPS);
      if (tt >= NMETA && tt < L) { half8 w0, w1;
#pragma unroll
          for (int j = 0; j < 8; ++j) { w0[j] = (f16)(o[j] * rs * P.hn[e0 + j] * silu_f((float)r8[0][j])); w1[j] = (f16)(o[8 + j] * rs * P.hn[e0 + 8 + j] * silu_f((float)r8[1][j])); }
          f16* dst = mix + (size_t)(tt - NMETA) * D + 128 * h + e0; *(half8*)dst = w0; *(half8*)(dst + 8) = w1; } }
    __syncthreads();
}

__device__ __forceinline__ unsigned mono_u(float f) { const unsigned u = __float_as_uint(f); return (u & 0x80000000u) ? ~u : (u | 0x80000000u); }
__device__ __forceinline__ float unmono_f(unsigned m) { return __uint_as_float((m & 0x80000000u) ? (m & 0x7fffffffu) : ~m); }
__device__ __forceinline__ unsigned wave_umax(unsigned v) {
    v = max(v, (unsigned)__builtin_amdgcn_update_dpp(0, (int)v, 0x111, 0xf, 0xf, false));
    v = max(v, (unsigned)__builtin_amdgcn_update_dpp(0, (int)v, 0x112, 0xf, 0xf, false));
    v = max(v, (unsigned)__builtin_amdgcn_update_dpp(0, (int)v, 0x114, 0xf, 0xf, false));
    v = max(v, (unsigned)__builtin_amdgcn_update_dpp(0, (int)v, 0x118, 0xf, 0xf, false));
    v = max(v, (unsigned)__builtin_amdgcn_update_dpp(0, (int)v, 0x142, 0xa, 0xf, false));
    v = max(v, (unsigned)__builtin_amdgcn_update_dpp(0, (int)v, 0x143, 0xc, 0xf, false));
    return (unsigned)__builtin_amdgcn_readlane((int)v, 63);
}
__device__ __forceinline__ int half_scan_incl(int v) {
    v += __builtin_amdgcn_update_dpp(0, v, 0x111, 0xf, 0xf, true);
    v += __builtin_amdgcn_update_dpp(0, v, 0x112, 0xf, 0xf, true);
    v += __builtin_amdgcn_update_dpp(0, v, 0x114, 0xf, 0xf, true);
    v += __builtin_amdgcn_update_dpp(0, v, 0x118, 0xf, 0xf, true);
    v += __builtin_amdgcn_update_dpp(0, v, 0x142, 0xa, 0xf, true);
    return v;
}
constexpr int CAP = 640, NPL = CAP / 64;
__device__ __forceinline__ int topk_compact(LAS float* cs, LAS unsigned short* ci, int n, bool exact, float& tau_out, int lane) {
    float sv[NPL]; unsigned iv[NPL], u[NPL];
#pragma unroll
    for (int i = 0; i < NPL; ++i) { const int p = lane + 64 * i; const bool v = p < n; sv[i] = v ? cs[p] : 0.f; iv[i] = v ? (unsigned)ci[p] : 0xffffu; u[i] = v ? mono_u(sv[i]) : 0u; }
    unsigned T = 0u; bool full = true; int hb = 31;
    {
        unsigned umx = 0u, umn = 0xffffffffu;
#pragma unroll
        for (int i = 0; i < NPL; ++i) { umx = max(umx, u[i]); umn = min(umn, (lane + 64 * i < n) ? u[i] : 0xffffffffu); }
        umx = wave_umax(umx); umn = ~wave_umax(~umn);
        const unsigned df = umx ^ umn;
        if (df == 0u) { hb = -1; T = umx; } else { hb = 31 - __clz(df); T = (hb == 31) ? 0u : (umx & ~((2u << hb) - 1u)); }
    }
#pragma unroll 1
    for (int bit = hb; bit >= 0; --bit) {
        const unsigned cand = T | (1u << bit); int cgt = 0;
#pragma unroll
        for (int i = 0; i < NPL; ++i) cgt += __popcll(__ballot(u[i] >= cand));
        if (cgt >= 256) { T = cand; if (!exact && cgt <= 272) { full = false; break; } }
    }
    bool keep[NPL];
    if (full) {
        int cgt = 0;
#pragma unroll
        for (int i = 0; i < NPL; ++i) cgt += __popcll(__ballot(u[i] > T));
        const int need = 256 - cgt; unsigned I = 0xffffu; int nties = 0;
#pragma unroll
        for (int i = 0; i < NPL; ++i) nties += __popcll(__ballot(u[i] == T));
        if (nties != need) { I = 0u;
#pragma unroll 1
        for (int bit = 15; bit >= 0; --bit) { const unsigned cand = I | (1u << bit); int cl = 0;
#pragma unroll
            for (int i = 0; i < NPL; ++i) cl += __popcll(__ballot(u[i] == T && iv[i] < cand));
            if (cl < need) I = cand; } }
#pragma unroll
        for (int i = 0; i < NPL; ++i) keep[i] = (u[i] > T) || (u[i] == T && iv[i] <= I);
    } else {
#pragma unroll
        for (int i = 0; i < NPL; ++i) keep[i] = u[i] >= T;
    }
    int nn = 0;
#pragma unroll
    for (int i = 0; i < NPL; ++i) { const unsigned long long m = __ballot(keep[i]); const int pre = __builtin_amdgcn_mbcnt_hi((unsigned)(m >> 32), __builtin_amdgcn_mbcnt_lo((unsigned)m, 0u));
        if (keep[i]) { cs[nn + pre] = sv[i]; ci[nn + pre] = (unsigned short)iv[i]; } nn += __popcll(m); }
    tau_out = unmono_f(T);
    return nn;
}
__device__ __forceinline__ float relu_asm(float x) { return __int_as_float(max(__float_as_int(x), 0)); }
__device__ __forceinline__ void indexer_tile(const Params& P, int tile, LAS unsigned char* lds) {
    int tid_ = threadIdx.x; asm volatile("" : "+v"(tid_));
    const int tid = tid_, lane = tid & 63, wid = __builtin_amdgcn_readfirstlane(tid >> 6), l31 = lane & 31, hf = lane >> 5;
    LAS float* candS = (LAS float*)lds;
    LAS unsigned short* candI = (LAS unsigned short*)(lds + 32 * CAP * 4);
    LAS unsigned char* kbuf = lds + 32 * CAP * 6;
    LAS int* lflag = (LAS int*)(lds + LDS_BYTES - 1024 + 192);
    const f16* IQ = (const f16*)(P.ws + WS_IQ); const f16* IK = (const f16*)(P.ws + WS_IK); const float* IW = (const float*)(P.ws + WS_IW);
    unsigned short* SEL = (unsigned short*)(P.ws + WS_SEL);
    const int t0 = tile * 32, tw = t0 + wid * 4;
    half8 afr[4];
    { const int qi = 2 * (l31 >> 4) + ((l31 >> 2) & 1), hd = 4 * ((l31 >> 3) & 1) + (l31 & 3); int tq = tw + qi; if (tq > L - 1) tq = L - 1;
      const half8* ap = (const half8*)(IQ + (size_t)tq * 512 + hd * 64);
#pragma unroll
      for (int s = 0; s < 4; ++s) afr[s] = ap[2 * s + hf]; }
    float w0[8], w1[8];
    { int ta = tw + hf, tb = tw + 2 + hf; if (ta > L - 1) ta = L - 1; if (tb > L - 1) tb = L - 1;
#pragma unroll
      for (int h = 0; h < 8; ++h) { w0[h] = IW[(size_t)ta * 8 + h]; w1[h] = IW[(size_t)tb * 8 + h]; } }
    asm volatile("" :: "v"(afr[0]), "v"(afr[1]), "v"(afr[2]), "v"(afr[3]));
    asm volatile("" :: "v"(w0[0]), "v"(w0[1]), "v"(w0[2]), "v"(w0[3]), "v"(w0[4]), "v"(w0[5]), "v"(w0[6]), "v"(w0[7]));
    asm volatile("" :: "v"(w1[0]), "v"(w1[1]), "v"(w1[2]), "v"(w1[3]), "v"(w1[4]), "v"(w1[5]), "v"(w1[6]), "v"(w1[7]));
    const int tq0 = (tw + hf < L) ? tw + hf : -1, tq1 = (tw + 2 + hf < L) ? tw + 2 + hf : -1;
    float tau0 = -__builtin_inff(), tau1 = -__builtin_inff();
    int cq0 = 0, cq1 = 0, cq2 = 0, cq3 = 0;
    if (tid < 3) lflag[tid] = 0;
    const int nkeys = (t0 + 32 < L) ? t0 + 32 : L, nst = (nkeys + 127) >> 7;
    u32x4 stg[2];
    const u32x4* IKv = (const u32x4*)IK;
#pragma unroll
    for (int i = 0; i < 2; ++i) stg[i] = IKv[(size_t)0 * 1024 + tid + 512 * i];
#pragma unroll
    for (int i = 0; i < 2; ++i) { const int ci = tid + 512 * i, row = ci >> 3, ch = ci & 7; *(LAS u32x4*)(kbuf + row * 128 + ((ch ^ ((row >> 1) & 7)) << 4)) = stg[i]; }
    __syncthreads();
#pragma unroll 1
    for (int st = 0; st < nst; ++st) {
        LAS unsigned char* kb = kbuf + (st & 1) * 16384;
        if (st + 1 < nst) {
#pragma unroll
            for (int i = 0; i < 2; ++i) stg[i] = IKv[(size_t)(st + 1) * 1024 + tid + 512 * i];
        }
        if (st * 128 <= tw + 3) {
            f32x16 acc[4];
#pragma unroll
            for (int c = 0; c < 4; ++c) {
#pragma unroll
                for (int i = 0; i < 16; ++i) acc[c][i] = 0.f;
            }
#pragma unroll
            for (int s = 0; s < 4; ++s) {
#pragma unroll
                for (int c = 0; c < 4; ++c) { const int row = c * 32 + l31; const half8 bf = *(const LAS half8*)(kb + row * 128 + (((2 * s + hf) ^ ((row >> 1) & 7)) << 4)); acc[c] = __builtin_amdgcn_mfma_f32_32x32x16_f16(afr[s], bf, acc[c], 0, 0, 0); }
            }
            float sc[8]; bool ok[8]; int na = 0, nb = 0;
#pragma unroll
            for (int c = 0; c < 4; ++c) {
                float s0 = 0.f, s1 = 0.f;
#pragma unroll
                for (int h = 0; h < 8; ++h) { s0 = __builtin_fmaf(w0[h], relu_asm(acc[c][h]), s0); s1 = __builtin_fmaf(w1[h], relu_asm(acc[c][8 + h]), s1); }
                const int key = st * 128 + c * 32 + l31;
                sc[2 * c] = s0; sc[2 * c + 1] = s1; ok[2 * c] = key <= tq0 && s0 > tau0; ok[2 * c + 1] = key <= tq1 && s1 > tau1;
                na += ok[2 * c] ? 1 : 0; nb += ok[2 * c + 1] ? 1 : 0;
            }
            const int ia = half_scan_incl(na), ib = half_scan_incl(nb);
            const int ta0 = __builtin_amdgcn_readlane(ia, 31), ta1 = __builtin_amdgcn_readlane(ia, 63), tb0 = __builtin_amdgcn_readlane(ib, 31), tb1 = __builtin_amdgcn_readlane(ib, 63);
            int pa = (hf ? cq1 : cq0) + ia - na, pb = (hf ? cq3 : cq2) + ib - nb;
            cq0 += ta0; cq1 += ta1; cq2 += tb0; cq3 += tb1;
            pa += (wid * 4 + hf) * CAP; pb += (wid * 4 + 2 + hf) * CAP;
            const int dmy = 32 * CAP * 6 / 4 + 2 * 16384 / 4 + 64 + lane;
#pragma unroll
            for (int c = 0; c < 4; ++c) {
                const unsigned short key = (unsigned short)(st * 128 + c * 32 + l31);
                { const bool k0 = ok[2 * c]; LAS float* ps = k0 ? candS + pa : candS + dmy; LAS unsigned short* pi = k0 ? candI + pa : (LAS unsigned short*)(candS + dmy + 64); *ps = sc[2 * c]; *pi = key; pa += k0 ? 1 : 0; }
                { const bool k1 = ok[2 * c + 1]; LAS float* ps = k1 ? candS + pb : candS + dmy; LAS unsigned short* pi = k1 ? candI + pb : (LAS unsigned short*)(candS + dmy + 64); *ps = sc[2 * c + 1]; *pi = key; pb += k1 ? 1 : 0; }
            }
        }
        if (st + 1 < nst) {
            LAS unsigned char* kn = kbuf + ((st + 1) & 1) * 16384;
#pragma unroll
            for (int i = 0; i < 2; ++i) { const int ci = tid + 512 * i, row = ci >> 3, ch = ci & 7; *(LAS u32x4*)(kn + row * 128 + ((ch ^ ((row >> 1) & 7)) << 4)) = stg[i]; }
        }
        const int mx = max(max(cq0, cq1), max(cq2, cq3));
        if (mx > CAP - 128 && lane == 0) lflag[st % 3] = 1;
        if (tid == 0) lflag[(st + 1) % 3] = 0;
        __syncthreads();
        const int any = lflag[st % 3];
        if (any) {
#pragma unroll 1
            for (int qq = 0; qq < 4; ++qq) { const int n = qq == 0 ? cq0 : (qq == 1 ? cq1 : (qq == 2 ? cq2 : cq3));
                if (n > 288) { float nt; const int nn = topk_compact(candS + (wid * 4 + qq) * CAP, candI + (wid * 4 + qq) * CAP, n, false, nt, lane);
                    if (qq == 0) cq0 = nn; else if (qq == 1) cq1 = nn; else if (qq == 2) cq2 = nn; else cq3 = nn;
                    if (hf == (qq & 1)) { if (qq < 2) tau0 = nt; else tau1 = nt; } } }
        }
    }
#pragma unroll 1
    for (int qq = 0; qq < 4; ++qq) {
        const int t = tw + qq; if (t >= L) break;
        int n = qq == 0 ? cq0 : (qq == 1 ? cq1 : (qq == 2 ? cq2 : cq3)); LAS float* cs = candS + (wid * 4 + qq) * CAP; LAS unsigned short* ci = candI + (wid * 4 + qq) * CAP;
        if (n > 256) { float nt; n = topk_compact(cs, ci, n, true, nt, lane); }
#pragma unroll
        for (int j = 0; j < 4; ++j) { const int p = lane + 64 * j; SEL[(size_t)t * 256 + (p & 15) * 16 + (p >> 4)] = p < n ? ci[p] : (unsigned short)0xffffu; }
    }
    __syncthreads();
}

__device__ __forceinline__ void sparse_attn(const Params& P, LAS unsigned char* lds, int vbid) {
    int tid_ = threadIdx.x; asm volatile("" : "+v"(tid_));
    const int tid = tid_, lane = tid & 63, wid = tid >> 6, grp = lane >> 2, c4 = lane & 3;
    const int head = vbid & 7, slot = (vbid >> 3) * 8 + wid, nslot = (gridDim.x >> 3) * 8;
    typedef _Float16 half2v __attribute__((ext_vector_type(2)));
    LAS float* red = (LAS float*)(lds + 4096 + wid * 4352);
    const unsigned short* SEL = (const unsigned short*)(P.ws + WS_SEL);
    const unsigned char* Q8 = P.ws + WS_DQ + head * 64 + c4 * 16; const float* QS = (const float*)(P.ws + WS_DQ + (size_t)LP * 512) + head;
    const unsigned char* kvh = P.ws + WS_KV + (size_t)head * LP * 128; f16* mix = (f16*)(P.ws + WS_ACTA);
    int t = NMETA + slot;
    u32x4 sela = {0u, 0u, 0u, 0u}, selb = {0u, 0u, 0u, 0u}, q8 = {0u, 0u, 0u, 0u}; float lscale = 0.f;
    if (t < L) { sela = *(const u32x4*)(SEL + (size_t)t * 256 + grp * 16); selb = *(const u32x4*)(SEL + (size_t)t * 256 + grp * 16 + 8); q8 = *(const u32x4*)(Q8 + (size_t)t * 512); lscale = QS[(size_t)t * 8]; }
#define ATTN_ITEM(ALLV) do { \
        unsigned keys[16]; u32x4 kreg[16], vreg[16]; \
        _Pragma("unroll") for (int it = 0; it < 16; ++it) { const unsigned w = it < 8 ? sela[it >> 1] : selb[(it - 8) >> 1]; keys[it] = (it & 1) ? (w >> 16) : (w & 0xffffu); } \
        _Pragma("unroll") for (int it = 0; it < 16; ++it) { const unsigned kk = (ALLV || keys[it] != 0xffffu) ? keys[it] : 0u; kreg[it] = *(const u32x4*)(kvh + (size_t)kk * 128 + c4 * 16); } \
        _Pragma("unroll") for (int it = 0; it < 16; ++it) { const unsigned kk = (ALLV || keys[it] != 0xffffu) ? keys[it] : 0u; vreg[it] = *(const u32x4*)(kvh + (size_t)kk * 128 + 64 + c4 * 16); } \
        const u32x4 qc = q8; const float ls = lscale; \
        { const int tn = t + nslot;     \
          if (tn < L) { sela = *(const u32x4*)(SEL + (size_t)tn * 256 + grp * 16); selb = *(const u32x4*)(SEL + (size_t)tn * 256 + grp * 16 + 8); q8 = *(const u32x4*)(Q8 + (size_t)tn * 512); lscale = QS[(size_t)tn * 8]; } } \
        float lg[16]; float mx = -__builtin_inff(); \
        _Pragma("unroll") for (int it = 0; it < 16; ++it) { \
            int ai = 0; \
            _Pragma("unroll") for (int w = 0; w < 4; ++w) ai = __builtin_amdgcn_sdot4((int)kreg[it][w], (int)qc[w], ai, false); \
            ai += __builtin_amdgcn_update_dpp(0, ai, 0xB1, 0xf, 0xf, true);     \
            ai += __builtin_amdgcn_update_dpp(0, ai, 0x4E, 0xf, 0xf, true);     \
            lg[it] = (ALLV || keys[it] != 0xffffu) ? (float)ai * ls : -__builtin_inff(); mx = fmaxf(mx, lg[it]); } \
        mx = fmaxf(mx, __shfl_xor(mx, 4)); mx = fmaxf(mx, __shfl_xor(mx, 8)); mx = fmaxf(mx, __shfl_xor(mx, 16)); mx = fmaxf(mx, __shfl_xor(mx, 32)); \
        half2v o2[8]; float lsum = 0.f; \
        _Pragma("unroll") for (int e = 0; e < 8; ++e) o2[e] = (half2v){(f16)0.f, (f16)0.f}; \
        _Pragma("unroll") for (int it = 0; it < 16; ++it) { \
            const float p = __expf(lg[it] - mx); lsum += p; const f16 ph = (f16)p; const half2v p2 = {ph, ph}; \
            _Pragma("unroll") for (int w = 0; w < 4; ++w) {     \
                const half2v v01 = __builtin_bit_cast(half2v, __builtin_amdgcn_perm(0u, vreg[it][w], 0x010c000cu)), v23 = __builtin_bit_cast(half2v, __builtin_amdgcn_perm(0u, vreg[it][w], 0x030c020cu)); \
                o2[2 * w] = p2 * v01 + o2[2 * w]; o2[2 * w + 1] = p2 * v23 + o2[2 * w + 1]; } } \
        lsum += __shfl_xor(lsum, 4); lsum += __shfl_xor(lsum, 8); lsum += __shfl_xor(lsum, 16); lsum += __shfl_xor(lsum, 32); \
          \
        _Pragma("unroll") for (int e = 0; e < 8; ++e) { red[lane * 17 + 2 * e] = (float)o2[e][0]; red[lane * 17 + 2 * e + 1] = (float)o2[e][1]; } \
        float acc = 0.f; \
        { const int cc = lane >> 4, e = lane & 15; \
          _Pragma("unroll") for (int g = 0; g < 16; ++g) acc += red[(g * 4 + cc) * 17 + e]; } \
        mix[(size_t)(t - NMETA) * D + 512 + head * 64 + lane] = (f16)(acc * __builtin_amdgcn_rcpf(lsum)); \
    } while (0)
#pragma unroll 1
    for (; t < L; t += nslot) {
        if (t >= 255) ATTN_ITEM(true);
        else ATTN_ITEM(false);
    }
#undef ATTN_ITEM
    __syncthreads();
}

__device__ __forceinline__ void final_norm(const Params& P) {
    const int tid = threadIdx.x, lane = tid & 63, gw = blockIdx.x * 8 + (tid >> 6), nw = gridDim.x * 8;
    const float* ss3 = (const float*)(P.ws + WS_SS3); const f16* h3 = (const f16*)(P.ws + WS_ACTA);
    for (int r = gw; r < SEQ; r += nw) { const float rs = row_rstd(ss3, 16, r);
#pragma unroll
        for (int i = 0; i < 2; ++i) { const int k = lane * 8 + 512 * i; const half8 v = *(const half8*)(h3 + (size_t)r * D + k); const f32x4 g0 = *(const f32x4*)(P.nf + k), g1 = *(const f32x4*)(P.nf + k + 4); f32x4 o0, o1;
#pragma unroll
            for (int j = 0; j < 4; ++j) { o0[j] = (float)v[j] * rs * g0[j]; o1[j] = (float)v[4 + j] * rs * g1[j]; }
            *(f32x4*)(P.out + (size_t)r * D + k) = o0; *(f32x4*)(P.out + (size_t)r * D + k + 4) = o1; } }
}

#define XB_TMO      128
#define XB_XCNT(j)  (256  + 64 * (j))
#define XB_XSUB(j)  (1280 + 64 * (j))
#define XB_XGEN(j)  (2304 + 64 * (j))
#define XB_TOP      3328
#define XB_TOPGEN   3392
#define XCD_BAR_WORDS 3456
#define XB_SPIN_CAP (1u << 22)
__device__ __forceinline__ unsigned xb_ld(unsigned* p)              { return __hip_atomic_load(p, __ATOMIC_RELAXED, __HIP_MEMORY_SCOPE_AGENT); }
__device__ __forceinline__ unsigned xb_add(unsigned* p, unsigned v) { return __hip_atomic_fetch_add(p, v, __ATOMIC_RELAXED, __HIP_MEMORY_SCOPE_AGENT); }
__device__ __forceinline__ unsigned xb_xcc_id() { return (unsigned)__builtin_amdgcn_s_getreg((3 << 11) | 20) & 0xFu; }
#define XB_SPIN(cond, bar) do { unsigned _sp = 0; while (cond) { __builtin_amdgcn_s_sleep(1); \
    if ((++_sp & 255u) == 0u) { if (xb_ld(&(bar)[XB_TMO])) break; if (_sp > XB_SPIN_CAP) { atomicAdd(&(bar)[XB_TMO], 1u); break; } } } } while (0)
struct XcdBarrier { unsigned* bar; unsigned x; volatile LAS unsigned* st; };
__device__ __forceinline__ XcdBarrier xcd_barrier_post(unsigned* bar, volatile LAS unsigned* st) {
    XcdBarrier b; b.bar = bar; b.x = xb_xcc_id(); b.st = st;
    if (threadIdx.x == 0) (void)xb_add(&bar[XB_XCNT(b.x)], 1u);
    return b;
}
__device__ __forceinline__ void xcd_barrier_complete(unsigned* bar, unsigned x, unsigned& nloc, unsigned& nx) {
    const unsigned G = gridDim.x * gridDim.y * gridDim.z;
    unsigned sum, cnt, mine, sp = 0u;
    for (;;) {
        sum = 0u; cnt = 0u; mine = 0u;
#pragma unroll
        for (unsigned j = 0; j < 16; ++j) { const unsigned c = xb_ld(&bar[XB_XCNT(j)]); sum += c; cnt += (c > 0u) ? 1u : 0u; mine = (j == x) ? c : mine; }
        if (sum == G) break;
        __builtin_amdgcn_s_sleep(1);
        if ((++sp & 255u) == 0u) { if (xb_ld(&bar[XB_TMO])) break; if (sp > XB_SPIN_CAP) { atomicAdd(&bar[XB_TMO], 1u); break; } }
    }
    nloc = mine > 0u ? mine : 1u; nx = cnt > 0u ? cnt : 1u;
}
__device__ __forceinline__ void xcd_barrier(const XcdBarrier& b) {
    asm volatile("s_waitcnt vmcnt(0)" ::: "memory");
    __syncthreads();
    if (threadIdx.x == 0) {
        unsigned* bar = b.bar;
        __builtin_amdgcn_s_waitcnt(0);
        unsigned nloc = b.st[0], nx = b.st[1];
        if (nloc == 0u) { xcd_barrier_complete(bar, b.x, nloc, nx); b.st[0] = nloc; b.st[1] = nx; }
        const unsigned old = xb_add(&bar[XB_XSUB(b.x)], 1u);
        const unsigned gen = old / nloc;
        if (old + 1u == (gen + 1u) * nloc) {
            __builtin_amdgcn_fence(__ATOMIC_RELEASE, "agent");
            asm volatile("s_waitcnt vmcnt(0)" ::: "memory");
            const unsigned og = xb_add(&bar[XB_TOP], 1u);
            const unsigned tg = og / nx;
            if (og + 1u == (tg + 1u) * nx) xb_add(&bar[XB_TOPGEN], 1u);
            else XB_SPIN(xb_ld(&bar[XB_TOPGEN]) == tg, bar);
            __builtin_amdgcn_fence(__ATOMIC_ACQUIRE, "agent");
            xb_add(&bar[XB_XGEN(b.x)], 1u);
            asm volatile("s_waitcnt vmcnt(0)" ::: "memory");
        } else {
            XB_SPIN(xb_ld(&bar[XB_XGEN(b.x)]) == gen, bar);
            __builtin_amdgcn_fence(__ATOMIC_ACQUIRE, "agent");
            asm volatile("s_waitcnt vmcnt(0)" ::: "memory");
        }
    }
    __syncthreads();
}

__global__ void __launch_bounds__(NTHREADS, 2) fwd_kernel(Params P) {
    __shared__ __attribute__((aligned(16))) unsigned char lds_raw[LDS_BYTES];
    LAS unsigned char* lds = (LAS unsigned char*)lds_raw;
    const int tid = threadIdx.x, bid = blockIdx.x, G = gridDim.x;
    unsigned char* ws = P.ws;
    const int lo = P.ph_lo, hi = P.ph_hi;
#ifndef ONLY_PHASE
#define ONLY_PHASE -1
#endif
#define IN(k) ((ONLY_PHASE < 0 || ONLY_PHASE == (k)) && lo <= (k) && (k) < hi)
#define SEAM(k) do { if (IN(k) && IN((k) + 1)) { xcd_barrier(xbar); } } while (0)
    XcdBarrier xbar; xbar.bar = (unsigned*)(ws + WS_BAR); xbar.x = 0; xbar.st = (volatile LAS unsigned*)(lds + LDS_BYTES - 1024 + 16);
    if (hi - lo > 1) {
        if (tid == 0) { xbar.st[0] = 0u; xbar.st[1] = 0u; }
        __syncthreads();
        xbar = xcd_barrier_post((unsigned*)(ws + WS_BAR), (volatile LAS unsigned*)(lds + LDS_BYTES - 1024 + 16));
    }
    LAS int* misc = (LAS int*)(lds + LDS_BYTES - 1024);
    if (hi - lo > 1) {
        if (tid == 0) { const unsigned xcc = xb_xcc_id() & 7u; misc[8] = (int)xcc; misc[9] = (int)xb_add((unsigned*)(ws + WS_CTL) + 32 + 32 * xcc, 1u); }
    }
    int vbid = bid;
    f16* acta = (f16*)(ws + WS_ACTA); f16* Gb = (f16*)(ws + WS_G);
    float* ss0 = (float*)(ws + WS_SS0); float* ss1 = (float*)(ws + WS_SS1); float* ss2 = (float*)(ws + WS_SS2); float* ss3 = (float*)(ws + WS_SS3);
    if (IN(0)) { p0_prologue(P, lds); }
    SEAM(0);
    if (hi - lo > 1 && (G & 7) == 0) {
        if (tid == 0) { bool ok = true; for (int j = 0; j < 8; ++j) ok = ok && (xb_ld((unsigned*)(ws + WS_CTL) + 32 + 32 * j) == (unsigned)(G >> 3)); misc[10] = ok ? misc[9] * 8 + misc[8] : bid; }
        __syncthreads();
        vbid = __builtin_amdgcn_readfirstlane(misc[10]);
        __syncthreads();
    }
    if (IN(1)) {
        pg8::Gemm g{(const f16*)(ws + WS_US), (const f16*)(ws + WS_WGU1), MP, 2 * DFF, D / 2}; pg8::StaticOrder S; S.init(MP, 2 * DFF, G, vbid);
        EpiSwiglu<true> E{Gb, ss0, 1, (const float*)(ws + WS_IQ), (const float*)(ws + WS_WGU1 + (size_t)2 * DFF * D)}; pg8::gemm_phase(lds, g, S, E);
    }
    SEAM(1);
    if (IN(2)) {
        meta_down(P, lds);
        pg8::Gemm g{Gb, (const f16*)(ws + WS_WD1), SEQ, D, DFF}; pg8::StaticOrder S; S.init(SEQ, D, G, vbid);
        EpiResid<true> E{acta, (f16*)P.out, ss1, 0.5f}; pg8::gemm_phase(lds, g, S, E);
    }
    SEAM(2);
    if (IN(3)) {
        pg8::Gemm g{(const f16*)P.out, (const f16*)(ws + WS_WIN), MP, NIN, D}; pg8::StaticOrder S; S.init(MP, NIN, G, vbid);
        EpiInProj E{ss1, (const f32x2*)(ws + WS_ROPE), ws};
        pg8::gemm_phase(lds, g, S, E);
    }
    SEAM(3);
    if (IN(4)) {
        for (int u = bid; u < NCH * 4; u += G) gla_a_unit(P, u, lds);
        {
            int tbase = 0, cursor = bid; LAS f16* tl = (LAS f16*)lds;
            prep_weight(P, 3, D, D, (f16*)(ws + WS_WOUT), cursor, tbase, tl, G);
            prep_weight(P, 5, D, DFF, (f16*)(ws + WS_WD2), cursor, tbase, tl, G);
            __syncthreads();
            prep_weight_i8(P, 4, 2 * DFF, ws + WS_WGU2, (float*)(ws + WS_WGU2 + (size_t)2 * DFF * D), bid, G, lds);
        }
    }
    SEAM(4);
    if (IN(5)) {
        if (bid < 64) gla_scan(P);
        unsigned* ctr = (unsigned*)(ws + WS_CTL); LAS int* bc = (LAS int*)(lds + LDS_BYTES - 1024);
        for (;;) {
            if (tid == 0) bc[0] = (int)atomicAdd(ctr, 1u);
            __syncthreads();
            const int k = bc[0];
            __syncthreads();
            if (k >= 513) break;
            indexer_tile(P, 512 - k, lds);
        }
    }
    SEAM(5);
    if (IN(6)) { for (int u = bid; u < NCH * 4; u += G) gla_c_unit(P, u, lds); sparse_attn(P, lds, vbid); }
    SEAM(6);
    if (IN(7)) {
        pg8::Gemm g{acta, (const f16*)(ws + WS_WOUT), SEQ, D, D}; pg8::StaticOrder S; S.init(SEQ, D, G, vbid);
        EpiResid<true> E{P.out, (f16*)(ws + WS_US), ss2, 1.0f}; pg8::gemm_phase(lds, g, S, E);
    }
    SEAM(7);
    if (IN(8)) quant_rows_i8((const f16*)(ws + WS_US), ws + WS_DQ, (float*)(ws + WS_IQ), SEQ);
    SEAM(8);
    if (IN(9)) {
        pg8::Gemm g{(const f16*)(ws + WS_DQ), (const f16*)(ws + WS_WGU2), SEQ, 2 * DFF, D / 2}; pg8::StaticOrder S; S.init(SEQ, 2 * DFF, G, vbid);
        EpiSwiglu<true> E{Gb, ss2, 16, (const float*)(ws + WS_IQ), (const float*)(ws + WS_WGU2 + (size_t)2 * DFF * D)}; pg8::gemm_phase(lds, g, S, E);
    }
    SEAM(9);
    if (IN(10)) {
        pg8::Gemm g{Gb, (const f16*)(ws + WS_WD2), SEQ, D, DFF}; pg8::StaticOrder S; S.init(SEQ, D, G, vbid);
        EpiResid<true> E{ws + WS_US, acta, ss3, 0.5f}; pg8::gemm_phase(lds, g, S, E);
    }
    SEAM(10);
    if (IN(11)) final_norm(P);
#undef IN
#undef SEAM
}

extern "C" void kernel_launch(void* const* d_in, const int* in_sizes, int n_in, void* d_out, int out_size, void* d_ws, size_t ws_size, hipStream_t stream) {
    static int grid = 0;
    if (grid == 0) {
        if (n_in != 17 || in_sizes[0] != SEQ * D || out_size != SEQ * D || ws_size < WS_END) { fprintf(stderr, "kernel_launch: unexpected shapes (n_in %d, in0 %d, out %d, ws %zu, need %zu)\n", n_in, n_in > 0 ? in_sizes[0] : -1, out_size, ws_size, (size_t)WS_END); grid = -1; return; }
        int dev = 0, cus = 0, per_cu = 0;
        (void)hipGetDevice(&dev); (void)hipDeviceGetAttribute(&cus, hipDeviceAttributeMultiprocessorCount, dev);
        if (hipOccupancyMaxActiveBlocksPerMultiprocessor(&per_cu, (const void*)fwd_kernel, NTHREADS, 0) != hipSuccess || per_cu < 1) { fprintf(stderr, "kernel_launch: occupancy query says %d blocks per CU\n", per_cu); per_cu = 1; }
        (void)hipGetLastError();
        grid = cus;
        if (grid % 8 != 0 || grid < 64) { fprintf(stderr, "kernel_launch: unexpected CU count %d\n", cus); }
    }
    if (grid < 0) return;
    if (hipMemsetAsync((char*)d_ws + WS_CTL, 0, CTL_BYTES, stream) != hipSuccess) { fprintf(stderr, "kernel_launch: memset failed\n"); return; }
    Params p{};
    const float** pp = (const float**)&p;
    for (int i = 0; i < 17; ++i) pp[i] = (const float*)d_in[i];
    p.out = (float*)d_out; p.ws = (unsigned char*)d_ws;
#if MODE == 0
    for (int ph = 0; ph < NPHASE; ++ph) { p.ph_lo = ph; p.ph_hi = ph + 1; hipLaunchKernelGGL(fwd_kernel, dim3(grid), dim3(NTHREADS), 0, stream, p); }
#else
    p.ph_lo = 0; p.ph_hi = NPHASE;
    void* args[] = {&p};
    hipError_t e = hipLaunchCooperativeKernel((const void*)fwd_kernel, dim3(grid), dim3(NTHREADS), args, 0, stream);
    if (e != hipSuccess) fprintf(stderr, "cooperative launch failed: %s (grid %d)\n", hipGetErrorString(e), grid);
#endif
}
```

```cpp
#include <hip/hip_runtime.h>
#include <cstdio>
#include <cstdint>

#ifndef MODE
#define MODE 1
#endif

#define LAS __attribute__((address_space(3)))
typedef _Float16 f16;
typedef _Float16 half8 __attribute__((ext_vector_type(8)));
typedef _Float16 half4 __attribute__((ext_vector_type(4)));
typedef float f32x2 __attribute__((ext_vector_type(2)));
typedef float f32x4 __attribute__((ext_vector_type(4)));
typedef float f32x16 __attribute__((ext_vector_type(16)));
typedef unsigned u32x2 __attribute__((ext_vector_type(2)));
typedef unsigned u32x4 __attribute__((ext_vector_type(4)));
typedef int i32x4 __attribute__((ext_vector_type(4)));

constexpr int D = 1024, SEQ = 16384, NMETA = 16, L = SEQ + NMETA, DFF = 2816;
constexpr int MP = 16640;
constexpr int LP = 16512;
constexpr int NIN = 3840;
constexpr int NCH = 257;
constexpr float EPS = 1e-6f;
constexpr int NTHREADS = 512;
constexpr int LDS_BYTES = 155648 + 1024;
constexpr int NPHASE = 12;

constexpr size_t al256(size_t x) { return (x + 255) & ~(size_t)255; }
constexpr size_t WS_CTL = 0;
constexpr size_t CTL_BYTES = 32768;
constexpr size_t WS_BAR = 2048;
constexpr size_t WS_WGU1 = CTL_BYTES;
constexpr size_t WS_WD1 = WS_WGU1 + (size_t)2 * DFF * D * 2;
constexpr size_t WS_WIN = WS_WD1 + (size_t)D * DFF * 2;
constexpr size_t WS_WOUT = WS_WIN + (size_t)NIN * D * 2;
constexpr size_t WS_WGU2 = WS_WOUT + (size_t)D * D * 2;
constexpr size_t WS_WD2 = WS_WGU2 + (size_t)2 * DFF * D * 2;
constexpr size_t WS_ACTA = WS_WD2 + (size_t)D * DFF * 2;
constexpr size_t WS_G = WS_ACTA + (size_t)MP * D * 2;
constexpr size_t WS_US = WS_G + (size_t)MP * DFF * 2;
constexpr size_t WS_DQ = WS_US + (size_t)NCH * 4 * 64 * 128 * 4;
constexpr size_t WS_IQ = WS_DQ + (size_t)LP * 512 * 2;
constexpr size_t WS_SEL = WS_IQ + (size_t)LP * 512 * 2;
constexpr size_t WS_ROPE = WS_SEL + (size_t)LP * 256 * 2;
constexpr size_t WS_IW = WS_ROPE + al256((size_t)L * 32 * 8);
constexpr size_t WS_GA = WS_IW + (size_t)LP * 8 * 4;
constexpr size_t WS_DECAY = WS_GA + (size_t)LP * 16 * 4;
constexpr size_t WS_SS0 = WS_DECAY + al256((size_t)NCH * 256 * 4);
constexpr size_t WS_SS1 = WS_SS0 + (size_t)MP * 4;
constexpr size_t WS_SS2 = WS_SS1 + (size_t)MP * 64;
constexpr size_t WS_SS3 = WS_SS2 + (size_t)MP * 64;
constexpr size_t WS_END = WS_SS3 + (size_t)MP * 64;
constexpr size_t WS_KV = WS_G;
constexpr size_t WS_GQ = WS_KV + (size_t)8 * LP * 128 * 2;
constexpr size_t WS_GK = WS_GQ + (size_t)LP * 256 * 2;
constexpr size_t WS_GV = WS_GK + (size_t)LP * 256 * 2;
constexpr size_t WS_GR = WS_GV + (size_t)LP * 512 * 2;
constexpr size_t WS_IK = WS_GR + (size_t)LP * 512 * 2;
constexpr size_t WS_ALIAS_END = WS_IK + (size_t)LP * 64 * 2;
static_assert(WS_ALIAS_END <= WS_US, "aliased buffers exceed G");
static_assert(WS_END <= (size_t)256 * 1024 * 1024, "workspace exceeds 256 MiB");
static_assert((size_t)SEQ * D * 2 <= (size_t)NCH * 4 * 64 * 128 * 4, "h2_16 alias");

struct Params {
    const float* x; const float* meta; const float* n1; const float* wg1; const float* wu1; const float* wd1;
    const float* nmix; const float* win; const float* wa2; const float* ba; const float* hn; const float* wout;
    const float* n2; const float* wg2; const float* wu2; const float* wd2; const float* nf;
    float* out; unsigned char* ws; int ph_lo, ph_hi;
};

namespace pg8 {
constexpr int BM = 256, BK = 64, HALF = 128, HTB = HALF * BK * 2, STAGE_BYTES = 8 * HTB, NXCD = 8, WGM = 8;
__host__ __device__ __forceinline__ int lds_byte(int r, int c) { const int st = (r >> 4) * 2 + (c >> 5), rr = r & 15, cc = c & 31, ob = rr * 64 + cc * 2; return st * 1024 + (ob ^ (((ob >> 9) & 1) << 5)); }
__host__ __device__ __forceinline__ int perm32(int rho) { const int n = rho >> 4, i = rho & 15; return 8 * (i >> 2) + 4 * n + (i & 3); }
__host__ __device__ __forceinline__ void stage_rc(int b, int& R, int& C) { const int st = b / 1024, sb = b % 1024, swz = sb ^ (((sb >> 9) & 1) << 5); R = (st >> 1) * 16 + swz / 64; C = (st & 1) * 32 + (swz % 64) / 2; }
struct Unit { int pm, pn; };
struct Gemm { const f16* A; const f16* Bt; int M, N, K; };
struct StaticOrder {
    int nM, nN, nwg, G, c;
    __host__ __device__ void init(int M, int N, int G_, int c_) { nM = M / BM; nN = N / BM; nwg = nM * nN; G = G_; c = c_; }
    __host__ __device__ bool next(int i, Unit& u) const {
        const long Lx = (long)i * G + c; if (Lx >= nwg) return false;
        int wgid = (int)Lx; { const int q = nwg / NXCD, r = nwg % NXCD, xcd = wgid % NXCD, off = wgid / NXCD; wgid = (xcd < r ? xcd * (q + 1) : r * (q + 1) + (xcd - r) * q) + off; }
        const int nig = WGM * nN, gid = wgid / nig, fm = gid * WGM, gsz = (nM - fm) < WGM ? (nM - fm) : WGM;
        u.pm = fm + ((wgid % nig) % gsz); u.pn = (wgid % nig) / gsz; return true;
    }
};
template <class Epi>
__device__ __forceinline__ void gemm_phase(LAS unsigned char* lds, const Gemm g, const StaticOrder& S, const Epi& E) {
    int tid_ = threadIdx.x; asm volatile("" : "+v"(tid_));
    const int tid = tid_, wid = __builtin_amdgcn_readfirstlane(tid >> 6), lane = tid & 63, wr = wid >> 2, wc = wid & 3, fr = lane & 15, fq = lane >> 4;
    const int K = g.K, nt = K / BK;
    unsigned voffA[2], voffB[2];
#pragma unroll
    for (int i = 0; i < 2; ++i) { int R, C; stage_rc(tid * 16 + i * 8192, R, C); const int Rb = (R & ~31) + perm32(R & 31); voffA[i] = (unsigned)(R * K + C) * 2u; voffB[i] = (unsigned)(Rb * K + C) * 2u; }
    const size_t kstep = (size_t)(BK * 2);
    const size_t hstep = (size_t)HALF * K * 2;
    const size_t tstep = 2 * hstep;
    const unsigned ldsw = (unsigned)wid * 1024u;
    const int aoff = lds_byte(wr * 64 + fr, fq * 8), boff = lds_byte(wc * 32 + fr, fq * 8);
#define PG8_SA(b, h) (((b) * 2 + (h)) * HTB)
#define PG8_SB(b, h) ((4 + (b) * 2 + (h)) * HTB)
#define PG8_STAGE(bufoff, gbase, voff) do { _Pragma("unroll") for (int _i = 0; _i < 2; ++_i) \
        __builtin_amdgcn_global_load_lds((const unsigned*)((const char*)(gbase) + (voff)[_i]), (LAS unsigned*)(lds + (bufoff) + ldsw + _i * 8192), 16, 0, 0); } while (0)
#define PG8_LDA(dst, b, h) do { _Pragma("unroll") for (int m = 0; m < 4; ++m) _Pragma("unroll") for (int k = 0; k < 2; ++k) dst[m][k] = *(const LAS half8*)(lds + PG8_SA(b, h) + aoff + m * 2048 + k * 1024); } while (0)
#define PG8_LDB(dst, b, h) do { _Pragma("unroll") for (int n = 0; n < 2; ++n) _Pragma("unroll") for (int k = 0; k < 2; ++k) dst[n][k] = *(const LAS half8*)(lds + PG8_SB(b, h) + boff + n * 2048 + k * 1024); } while (0)
#define PG8_MMA(ai, bj, At, Bt) do { __builtin_amdgcn_s_setprio(1); _Pragma("unroll") for (int m = 0; m < 4; ++m) _Pragma("unroll") for (int n = 0; n < 2; ++n) _Pragma("unroll") for (int k = 0; k < 2; ++k) { \
        if constexpr (Epi::I8) acc[ai][bj][m][n] = __builtin_bit_cast(f32x4, __builtin_amdgcn_mfma_i32_16x16x64_i8(__builtin_bit_cast(i32x4, Bt[n][k]), __builtin_bit_cast(i32x4, At[m][k]), __builtin_bit_cast(i32x4, acc[ai][bj][m][n]), 0, 0, 0)); \
        else acc[ai][bj][m][n] = __builtin_amdgcn_mfma_f32_16x16x32_f16(Bt[n][k], At[m][k], acc[ai][bj][m][n], 0, 0, 0); } __builtin_amdgcn_s_setprio(0); } while (0)
#define PG8_WAIT_V(n) asm volatile("s_waitcnt vmcnt(" #n ")" ::: "memory")
#define PG8_WAIT_L(n) asm volatile("s_waitcnt lgkmcnt(" #n ")" ::: "memory")
#define PG8_BAR __builtin_amdgcn_s_barrier()
#define PG8_SCHED __builtin_amdgcn_sched_barrier(0)
    Unit cur, nxt; int ui = 0;
    if (!S.next(0, cur)) return;
    f32x4 acc[2][2][4][2];
#pragma unroll
    for (int a = 0; a < 2; ++a)
#pragma unroll
        for (int b = 0; b < 2; ++b)
#pragma unroll
            for (int m = 0; m < 4; ++m)
#pragma unroll
                for (int n = 0; n < 2; ++n) acc[a][b][m][n] = (f32x4){0.f, 0.f, 0.f, 0.f};
    half8 At[4][2], B0[2][2], B1[2][2];
    const char* cA = (const char*)g.A + (size_t)cur.pm * tstep; const char* cB = (const char*)g.Bt + (size_t)cur.pn * tstep;
    PG8_STAGE(PG8_SB(0, 0), cB, voffB); PG8_STAGE(PG8_SA(0, 0), cA, voffA); PG8_STAGE(PG8_SB(0, 1), cB + hstep, voffB); PG8_STAGE(PG8_SA(0, 1), cA + hstep, voffA);
    if (wr == 1) PG8_BAR;
    PG8_WAIT_V(4); PG8_BAR;
    PG8_STAGE(PG8_SB(1, 0), cB + kstep, voffB); PG8_STAGE(PG8_SA(1, 0), cA + kstep, voffA); PG8_STAGE(PG8_SB(1, 1), cB + hstep + kstep, voffB);
    PG8_WAIT_V(6); PG8_BAR;
    for (;;) {
        const bool has_next = S.next(ui + 1, nxt);
        const char* nA = has_next ? (const char*)g.A + (size_t)nxt.pm * tstep : cA; const char* nB = has_next ? (const char*)g.Bt + (size_t)nxt.pn * tstep : cB;
        for (int t = 0; t < nt; t += 2) {
            const bool last = (t == nt - 2);
            const char* a1 = cA + (size_t)(t + 1) * kstep;
            const char* a2 = last ? nA : cA + (size_t)(t + 2) * kstep; const char* b2 = last ? nB : cB + (size_t)(t + 2) * kstep;
            const char* a3 = a2 + kstep; const char* b3 = b2 + kstep;
            PG8_LDB(B0, 0, 0); PG8_SCHED; PG8_LDA(At, 0, 0); PG8_STAGE(PG8_SA(1, 1), a1 + hstep, voffA);
            PG8_WAIT_L(8); PG8_BAR; PG8_WAIT_L(0); PG8_MMA(0, 0, At, B0); PG8_BAR; PG8_SCHED;
            PG8_LDB(B1, 0, 1); PG8_STAGE(PG8_SB(0, 0), b2, voffB);
            PG8_BAR; PG8_WAIT_L(0); PG8_MMA(0, 1, At, B1); PG8_BAR;
            PG8_LDA(At, 0, 1); PG8_STAGE(PG8_SA(0, 0), a2, voffA);
            PG8_BAR; PG8_WAIT_L(0); PG8_MMA(1, 0, At, B0); PG8_BAR; PG8_SCHED;
            PG8_STAGE(PG8_SB(0, 1), b2 + hstep, voffB);
            PG8_WAIT_V(6); PG8_BAR; PG8_MMA(1, 1, At, B1); PG8_BAR;
            PG8_LDB(B0, 1, 0); PG8_SCHED; PG8_LDA(At, 1, 0); PG8_STAGE(PG8_SA(0, 1), a2 + hstep, voffA);
            PG8_WAIT_L(8); PG8_BAR; PG8_WAIT_L(0); PG8_MMA(0, 0, At, B0); PG8_BAR; PG8_SCHED;
            PG8_LDB(B1, 1, 1); PG8_STAGE(PG8_SB(1, 0), b3, voffB);
            PG8_BAR; PG8_WAIT_L(0); PG8_MMA(0, 1, At, B1); PG8_BAR;
            PG8_LDA(At, 1, 1); PG8_STAGE(PG8_SA(1, 0), a3, voffA);
            PG8_BAR; PG8_WAIT_L(0); PG8_MMA(1, 0, At, B0); PG8_BAR; PG8_SCHED;
            PG8_STAGE(PG8_SB(1, 1), b3 + hstep, voffB);
            PG8_WAIT_V(6); PG8_BAR; PG8_MMA(1, 1, At, B1); PG8_BAR;
        }
        if constexpr (Epi::I8) {
#pragma unroll
            for (int a = 0; a < 2; ++a)
#pragma unroll
                for (int b = 0; b < 2; ++b)
#pragma unroll
                    for (int m = 0; m < 4; ++m)
#pragma unroll
                        for (int n = 0; n < 2; ++n) { const i32x4 v = __builtin_bit_cast(i32x4, acc[a][b][m][n]); acc[a][b][m][n] = (f32x4){(float)v[0], (float)v[1], (float)v[2], (float)v[3]}; }
        }
        E(acc, cur, wr, wc, fr, fq);
        if (!has_next) break;
#pragma unroll
        for (int a = 0; a < 2; ++a)
#pragma unroll
            for (int b = 0; b < 2; ++b)
#pragma unroll
                for (int m = 0; m < 4; ++m)
#pragma unroll
                    for (int n = 0; n < 2; ++n) acc[a][b][m][n] = (f32x4){0.f, 0.f, 0.f, 0.f};
        cur = nxt; cA = nA; cB = nB; ++ui;
    }
    PG8_WAIT_V(0);
    if (wr == 0) PG8_BAR;
    PG8_BAR;
#undef PG8_SA
#undef PG8_SB
#undef PG8_STAGE
#undef PG8_LDA
#undef PG8_LDB
#undef PG8_MMA
#undef PG8_WAIT_V
#undef PG8_WAIT_L
#undef PG8_BAR
#undef PG8_SCHED
}
}

__device__ __forceinline__ float silu_f(float v) { return v * __builtin_amdgcn_rcpf(1.0f + __expf(-v)); }
__device__ __forceinline__ half4 to_half4(f32x4 v) { half4 h; h[0] = (f16)v[0]; h[1] = (f16)v[1]; h[2] = (f16)v[2]; h[3] = (f16)v[3]; return h; }

__device__ __forceinline__ float row_rstd(const float* ss, int np, int row) {
    float s;
    if (np == 1) s = ss[row];
    else { const f32x4* p = (const f32x4*)(ss + (size_t)row * 16); const f32x4 a = p[0], b = p[1], c = p[2], d = p[3];
        s = (((a[0] + a[1]) + (a[2] + a[3])) + ((b[0] + b[1]) + (b[2] + b[3]))) + (((c[0] + c[1]) + (c[2] + c[3])) + ((d[0] + d[1]) + (d[2] + d[3]))); }
    return rsqrtf(s * (1.0f / D) + EPS);
}
template <bool I8_> struct EpiSwiglu {
    static constexpr bool I8 = I8_;
    f16* G; const float* ss; int np; const float* sa; const float* sw;
    __device__ __forceinline__ void operator()(const f32x4 (&acc)[2][2][4][2], const pg8::Unit& u, int wr, int wc, int fr_, int fq_) const {
        int fr = fr_, fq = fq_; asm volatile("" : "+v"(fr), "+v"(fq));
        f32x4 swg[2], swu[2];
        if constexpr (I8) {
#pragma unroll
            for (int n = 0; n < 2; ++n) { swg[n] = *(const f32x4*)(sw + u.pn * 256 + wc * 32 + 8 * fq + 4 * n); swu[n] = *(const f32x4*)(sw + u.pn * 256 + 128 + wc * 32 + 8 * fq + 4 * n); }
        }
#pragma unroll
        for (int ai = 0; ai < 2; ++ai)
#pragma unroll
            for (int m = 0; m < 4; ++m) {
                const int row = u.pm * 256 + ai * 128 + wr * 64 + m * 16 + fr;
                float rs = row_rstd(ss, np, row); if constexpr (I8) rs *= sa[row];
                const float ce = -1.4426950408889634f * rs, rs2 = rs * rs; half8 o;
#pragma unroll
                for (int n = 0; n < 2; ++n) {
                    f32x4 g = acc[ai][0][m][n], u = acc[ai][1][m][n];
                    if constexpr (I8) { g = g * swg[n]; u = u * swu[n]; }
                    const f32x4 t = g * ce; f32x4 e, r;
#pragma unroll
                    for (int j = 0; j < 4; ++j) e[j] = __builtin_amdgcn_exp2f(t[j]);
                    const f32x4 d = e + 1.0f;
#pragma unroll
                    for (int j = 0; j < 4; ++j) r[j] = __builtin_amdgcn_rcpf(d[j]);
                    const f32x4 w = (g * u) * (r * rs2);
#pragma unroll
                    for (int j = 0; j < 4; ++j) o[4 * n + j] = (f16)w[j];
                }
                *(half8*)(G + (size_t)row * DFF + u.pn * 128 + wc * 32 + 8 * fq) = o;
            }
    }
};
template <bool SRC16> struct EpiResid {
    static constexpr bool I8 = false;
    const void* src; f16* h16; float* ss; float alpha;
    __device__ __forceinline__ void operator()(const f32x4 (&acc)[2][2][4][2], const pg8::Unit& u, int wr, int wc, int fr_, int fq_) const {
        int fr = fr_, fq = fq_; asm volatile("" : "+v"(fr), "+v"(fq));
#pragma unroll
        for (int ai = 0; ai < 2; ++ai)
#pragma unroll
            for (int m = 0; m < 4; ++m) {
                const int row = u.pm * 256 + ai * 128 + wr * 64 + m * 16 + fr; float part = 0.f;
#pragma unroll
                for (int bj = 0; bj < 2; ++bj) {
                    const size_t off = (size_t)row * D + u.pn * 256 + bj * 128 + wc * 32 + 8 * fq; half8 h; f32x4 sv[2];
                    if (SRC16) { const half8 s8 = *(const half8*)((const f16*)src + off);
#pragma unroll
                        for (int j = 0; j < 4; ++j) { sv[0][j] = (float)s8[j]; sv[1][j] = (float)s8[4 + j]; } }
                    else { sv[0] = *(const f32x4*)((const float*)src + off); sv[1] = *(const f32x4*)((const float*)src + off + 4); }
#pragma unroll
                    for (int n = 0; n < 2; ++n) {
                        const f32x4 o = sv[n] + alpha * acc[ai][bj][m][n];
#pragma unroll
                        for (int j = 0; j < 4; ++j) h[4 * n + j] = (f16)o[j];
                        part += (o[0] * o[0] + o[1] * o[1]) + (o[2] * o[2] + o[3] * o[3]);
                    }
                    *(half8*)(h16 + off) = h;
                }
                part += __shfl_xor(part, 16); part += __shfl_xor(part, 32);
                if (fq == 0) ss[(size_t)row * 16 + u.pn * 4 + wc] = part;
            }
    }
};
constexpr float K_I8_SCALE = 127.0f / 8.0f;
__device__ __forceinline__ void rope8(const f32x4 (&x1)[2], const f32x4 (&x2)[2], const f32x2* rp, float sc, float (&o1)[8], float (&o2)[8]) {
#pragma unroll
    for (int n = 0; n < 2; ++n) {
        const f32x4 cs0 = *(const f32x4*)(rp + 4 * n), cs1 = *(const f32x4*)(rp + 4 * n + 2);
        o1[4 * n + 0] = (x1[n][0] * cs0[0] - x2[n][0] * cs0[1]) * sc; o2[4 * n + 0] = (x2[n][0] * cs0[0] + x1[n][0] * cs0[1]) * sc;
        o1[4 * n + 1] = (x1[n][1] * cs0[2] - x2[n][1] * cs0[3]) * sc; o2[4 * n + 1] = (x2[n][1] * cs0[2] + x1[n][1] * cs0[3]) * sc;
        o1[4 * n + 2] = (x1[n][2] * cs1[0] - x2[n][2] * cs1[1]) * sc; o2[4 * n + 2] = (x2[n][2] * cs1[0] + x1[n][2] * cs1[1]) * sc;
        o1[4 * n + 3] = (x1[n][3] * cs1[2] - x2[n][3] * cs1[3]) * sc; o2[4 * n + 3] = (x2[n][3] * cs1[2] + x1[n][3] * cs1[3]) * sc;
    }
}
__device__ __forceinline__ u32x2 pack_i8x8(const float (&v)[8]) {
    u32x2 r;
#pragma unroll
    for (int w = 0; w < 2; ++w) { unsigned word = 0u;
#pragma unroll
        for (int j = 0; j < 4; ++j) { const int q = (int)__builtin_rintf(fminf(fmaxf(v[4 * w + j] * K_I8_SCALE, -127.f), 127.f)); word |= ((unsigned)q & 0xffu) << (8 * j); }
        r[w] = word; }
    return r;
}
__device__ __forceinline__ u32x2 pack_bf8x8(const float (&v)[8]) {
    u32x2 r;
#pragma unroll
    for (int w = 0; w < 2; ++w) { int word = __builtin_amdgcn_cvt_pk_bf8_f32(v[4 * w], v[4 * w + 1], 0, false); word = __builtin_amdgcn_cvt_pk_bf8_f32(v[4 * w + 2], v[4 * w + 3], word, true); r[w] = (unsigned)word; }
    return r;
}
struct EpiInProj {
    static constexpr bool I8 = false;
    const float* ss; const f32x2* rope; unsigned char* ws;
    __device__ __forceinline__ void operator()(const f32x4 (&acc)[2][2][4][2], const pg8::Unit& u, int wr, int wc, int fr_, int fq_) const {
        int fr = fr_, fq = fq_; asm volatile("" : "+v"(fr), "+v"(fq));
        const int pn = u.pn;
        if (pn >= 8 && pn <= 11) {
            unsigned char* lb = (pn <= 9) ? ws + WS_KV + (size_t)((pn - 8) * 4 + wc) * LP * 128 + 8 * fq
                                          : ws + WS_KV + (size_t)((pn - 10) * 4 + (wc >> 1)) * LP * 128 + 64 + (wc & 1) * 32 + 8 * fq;
#pragma unroll
            for (int ai = 0; ai < 2; ++ai)
#pragma unroll
                for (int m = 0; m < 4; ++m) {
                    const int p = u.pm * 256 + ai * 128 + wr * 64 + m * 16 + fr;
                    const int t = p < SEQ ? p + NMETA : p - SEQ;
                    if (p < L) {
                        const float sc = row_rstd(ss, 16, p);
                        if (pn <= 9) {
                            float o1[8], o2[8]; rope8(acc[ai][0][m], acc[ai][1][m], rope + (size_t)t * 32 + 8 * fq, sc, o1, o2);
                            unsigned char* d8 = lb + (size_t)t * 128; *(u32x2*)d8 = pack_i8x8(o1); *(u32x2*)(d8 + 32) = pack_i8x8(o2);
                        } else {
#pragma unroll
                            for (int bj = 0; bj < 2; ++bj) { float v[8];
#pragma unroll
                                for (int j = 0; j < 4; ++j) { v[j] = acc[ai][bj][m][0][j] * sc; v[4 + j] = acc[ai][bj][m][1][j] * sc; }
                                *(u32x2*)(lb + (size_t)t * 128 + (size_t)bj * 2 * LP * 128) = pack_bf8x8(v); }
                        }
                    }
                    asm volatile("" ::: "memory");
                }
            return;
        }
        int mode = 0, stride = 256; float scale = 1.0f; f16* lanebase;
        if (pn == 0) lanebase = (f16*)(ws + WS_GQ) + wc * 32 + 8 * fq;
        else if (pn == 1) lanebase = (f16*)(ws + WS_GK) + wc * 32 + 8 * fq;
        else if (pn <= 3) { lanebase = (f16*)(ws + WS_GV) + (pn - 2) * 256 + wc * 32 + 8 * fq; stride = 512; }
        else if (pn <= 5) { lanebase = (f16*)(ws + WS_GR) + (pn - 4) * 256 + wc * 32 + 8 * fq; stride = 512; }
        else if (pn <= 7) { lanebase = (f16*)(ws + WS_DQ); mode = 6; scale = 0.125f; }
        else if (pn <= 13) { lanebase = (f16*)(ws + WS_IQ) + (pn - 12) * 256 + wc * 64 + 8 * fq; stride = 512; mode = 1; scale = 0.125f; }
        else { lanebase = (f16*)(ws + WS_IK) + 8 * fq; stride = 64; mode = wc == 0 ? 1 : (wc == 1 ? 2 : 3); }
#pragma unroll
        for (int ai = 0; ai < 2; ++ai)
#pragma unroll
            for (int m = 0; m < 4; ++m) {
                const int p = u.pm * 256 + ai * 128 + wr * 64 + m * 16 + fr;
                const int t = p < SEQ ? p + NMETA : p - SEQ;
                if (p < L && mode != 3) {
                    const float rs = row_rstd(ss, 16, p);
                    if (mode == 6) {
                        float o1[8], o2[8]; rope8(acc[ai][0][m], acc[ai][1][m], rope + (size_t)t * 32 + 8 * fq, rs * scale, o1, o2);
                        float qm = 1e-20f;
#pragma unroll
                        for (int j = 0; j < 8; ++j) qm = fmaxf(qm, fmaxf(fabsf(o1[j]), fabsf(o2[j])));
                        qm = fmaxf(qm, __shfl_xor(qm, 16)); qm = fmaxf(qm, __shfl_xor(qm, 32));
                        const float qsc = 127.0f * __builtin_amdgcn_rcpf(qm); u32x2 w1, w2;
#pragma unroll
                        for (int w = 0; w < 2; ++w) { unsigned a = 0u, b = 0u;
#pragma unroll
                            for (int j = 0; j < 4; ++j) { a |= ((unsigned)(int)__builtin_rintf(o1[4 * w + j] * qsc) & 0xffu) << (8 * j); b |= ((unsigned)(int)__builtin_rintf(o2[4 * w + j] * qsc) & 0xffu) << (8 * j); }
                            w1[w] = a; w2[w] = b; }
                        const int head = (pn - 6) * 4 + wc; unsigned char* qrow = ws + WS_DQ + (size_t)t * 512 + head * 64 + 8 * fq;
                        *(u32x2*)qrow = w1; *(u32x2*)(qrow + 32) = w2;
                        if (fq == 0) ((float*)(ws + WS_DQ + (size_t)LP * 512))[(size_t)t * 8 + head] = qm * (1.0f / (127.0f * K_I8_SCALE));
                    } else if (mode == 1) {
                        float o1[8], o2[8]; rope8(acc[ai][0][m], acc[ai][1][m], rope + (size_t)t * 32 + 8 * fq, rs * scale, o1, o2);
                        half8 h1, h2;
#pragma unroll
                        for (int j = 0; j < 8; ++j) { h1[j] = (f16)o1[j]; h2[j] = (f16)o2[j]; }
                        f16* dst = lanebase + (size_t)t * stride; *(half8*)dst = h1; *(half8*)(dst + 32) = h2;
                    } else if (mode == 2) {
                        if (fq < 2) { float* gp = (float*)(ws + WS_GA) + (size_t)t * 16 + 8 * fq; *(f32x4*)gp = acc[ai][0][m][0] * rs; *(f32x4*)(gp + 4) = acc[ai][0][m][1] * rs; }
                        else if (fq == 2) { float* ip = (float*)(ws + WS_IW) + (size_t)t * 8; const float r2 = rs * 0.35355339059327373f; *(f32x4*)ip = acc[ai][0][m][0] * r2; *(f32x4*)(ip + 4) = acc[ai][0][m][1] * r2; }
                    } else {
#pragma unroll
                        for (int bj = 0; bj < 2; ++bj) { half8 h;
#pragma unroll
                            for (int j = 0; j < 4; ++j) { h[j] = (f16)(acc[ai][bj][m][0][j] * rs); h[4 + j] = (f16)(acc[ai][bj][m][1][j] * rs); }
                            *(half8*)(lanebase + (size_t)t * stride + bj * 128) = h; }
                    }
                }
                asm volatile("" ::: "memory");
            }
    }
};

__device__ __forceinline__ const float* w_src(const Params& P, int kind, int n, int& ld, const float*& gain) {
    switch (kind) {
    case 0: case 4: { const int pn = n >> 8, bj = (n >> 7) & 1, cc = n & 127; ld = DFF; gain = kind == 0 ? P.n1 : P.n2;
        const float* w = kind == 0 ? (bj ? P.wu1 : P.wg1) : (bj ? P.wu2 : P.wg2); return w + pn * 128 + cc; }
    case 1: ld = D; gain = nullptr; return P.wd1 + n;
    case 5: ld = D; gain = nullptr; return P.wd2 + n;
    case 3: ld = D; gain = nullptr; return P.wout + n;
    default: { ld = 3672; gain = P.nmix; const int pn = n >> 8, c = n & 255, bj = c >> 7, hh = (c >> 5) & 3, dd = c & 31; int j;
        if (pn == 0) j = c; else if (pn == 1) j = 256 + c; else if (pn <= 3) j = 512 + (pn - 2) * 256 + c; else if (pn <= 5) j = 1024 + (pn - 4) * 256 + c;
        else if (pn <= 7) j = 1552 + (pn - 6) * 256 + hh * 64 + bj * 32 + dd;
        else if (pn <= 9) j = 2064 + (pn - 8) * 256 + hh * 64 + bj * 32 + dd;
        else if (pn <= 11) j = 2576 + (pn - 10) * 256 + c;
        else if (pn <= 13) j = 3088 + (pn - 12) * 256 + hh * 64 + bj * 32 + dd;
        else { if (c < 32) j = 3600 + c; else if (c < 48) j = 1536 + (c - 32); else if (c < 56) j = 3664 + (c - 48); else if (c >= 128 && c < 160) j = 3600 + 32 + (c - 128); else j = -1; }
        return j < 0 ? nullptr : P.win + j; }
    }
}
__device__ __forceinline__ void prep_weight(const Params& P, const int kind, const int N, const int K, f16* dst, int& cursor, int& tbase, LAS f16* tl, const int G) {
    const int tid = threadIdx.x, tn = N / 64, tk = K / 256, ntile = tn * tk;
    const int n = tid & 63, kk0 = tid >> 6;
    float v[32], vn[32];
#define PREP_LOAD(dstv, tI) do { const int n0_ = ((tI) % tn) * 64, k0_ = ((tI) / tn) * 256; int ld; const float* gain; const float* col = w_src(P, kind, n0_ + n, ld, gain); \
        _Pragma("unroll") for (int i = 0; i < 32; ++i) dstv[i] = col ? col[(size_t)(k0_ + kk0 + 8 * i) * ld] : 0.f; \
        if (gain) { _Pragma("unroll") for (int i = 0; i < 32; ++i) dstv[i] *= gain[k0_ + kk0 + 8 * i]; } } while (0)
    if (cursor < tbase + ntile) PREP_LOAD(v, cursor - tbase);
#pragma unroll 1
    for (; cursor < tbase + ntile; cursor += G) {
        const int tI = cursor - tbase, n0 = (tI % tn) * 64, k0 = (tI / tn) * 256;
        const bool more = cursor + G < tbase + ntile;
        if (more) PREP_LOAD(vn, tI + G);
#pragma unroll
        for (int i = 0; i < 32; ++i) tl[n * 264 + kk0 + 8 * i] = (f16)v[i];
        __syncthreads();
        { const int nr = tid >> 3, seg = tid & 7;
#pragma unroll
          for (int j = 0; j < 4; ++j) *(half8*)(dst + (size_t)(n0 + nr) * K + k0 + (seg + 8 * j) * 8) = *(const LAS half8*)(tl + nr * 264 + (seg + 8 * j) * 8); }
        __syncthreads();
        if (more) {
#pragma unroll
            for (int i = 0; i < 32; ++i) v[i] = vn[i];
        }
    }
#undef PREP_LOAD
    tbase += ntile;
}
__device__ __forceinline__ void prep_weight_i8(const Params& P, const int kind, const int N, unsigned char* dst, float* sw, int first, int step, LAS unsigned char* lds) {
    const int tid = threadIdx.x, n = tid & 63, kk0 = tid >> 6;
    LAS float* pmax = (LAS float*)lds; LAS unsigned* img = (LAS unsigned*)(lds + 2048);
#pragma unroll 1
    for (int task = first; task < N / 64; task += step) {
        const int n0 = task * 64; int ld; const float* gain; const float* col = w_src(P, kind, n0 + n, ld, gain);
        float v[128]; float mx = 0.f;
#pragma unroll
        for (int i = 0; i < 128; ++i) v[i] = col ? col[(size_t)(kk0 * 128 + i) * ld] : 0.f;
        if (gain) {
#pragma unroll
            for (int i = 0; i < 128; ++i) v[i] *= gain[kk0 * 128 + i];
        }
#pragma unroll
        for (int i = 0; i < 128; ++i) mx = fmaxf(mx, fabsf(v[i]));
        pmax[kk0 * 64 + n] = mx;
        __syncthreads();
#pragma unroll
        for (int q = 0; q < 8; ++q) mx = fmaxf(mx, pmax[q * 64 + n]);
        const float sc = mx > 0.f ? 127.0f / mx : 0.f;
        if (kk0 == 0) sw[n0 + n] = mx * (1.0f / 127.0f);
#pragma unroll
        for (int w = 0; w < 32; ++w) { unsigned word = 0u;
#pragma unroll
            for (int j = 0; j < 4; ++j) word |= ((unsigned)(int)__builtin_rintf(v[4 * w + j] * sc) & 0xffu) << (8 * j);
            img[n * 260 + kk0 * 32 + w] = word; }
        __syncthreads();
        { const int nr = tid >> 3, seg = tid & 7;
#pragma unroll
          for (int j = 0; j < 8; ++j) *(u32x4*)(dst + (size_t)(n0 + nr) * D + (seg + 8 * j) * 16) = *(const LAS u32x4*)(img + nr * 260 + (seg + 8 * j) * 4); }
        __syncthreads();
    }
}
__device__ __forceinline__ void quant_rows_i8(const f16* src, unsigned char* dst, float* sa, int rows) {
    const int tid = threadIdx.x, lane = tid & 63, gw = blockIdx.x * 8 + (tid >> 6), nw = gridDim.x * 8;
    for (int r = gw; r < rows; r += nw) {
        const half8 a = *(const half8*)(src + (size_t)r * D + lane * 16), b = *(const half8*)(src + (size_t)r * D + lane * 16 + 8);
        float v[16], mx = 0.f;
#pragma unroll
        for (int j = 0; j < 8; ++j) { v[j] = (float)a[j]; v[8 + j] = (float)b[j]; }
#pragma unroll
        for (int j = 0; j < 16; ++j) mx = fmaxf(mx, fabsf(v[j]));
#pragma unroll
        for (int o = 32; o >= 1; o >>= 1) mx = fmaxf(mx, __shfl_xor(mx, o));
        const float sc = mx > 0.f ? 127.0f / mx : 0.f; u32x4 w;
#pragma unroll
        for (int q = 0; q < 4; ++q) { unsigned word = 0u;
#pragma unroll
            for (int j = 0; j < 4; ++j) word |= ((unsigned)(int)__builtin_rintf(v[4 * q + j] * sc) & 0xffu) << (8 * j);
            w[q] = word; }
        *(u32x4*)(dst + (size_t)r * D + lane * 16) = w;
        if (lane == 0) sa[r] = mx * (1.0f / 127.0f);
    }
}
__device__ __forceinline__ void p0_prologue(const Params& P, LAS unsigned char* lds) {
    const int tid = threadIdx.x, bid = blockIdx.x, G = gridDim.x, lane = tid & 63;
    unsigned char* ws = P.ws;
    LAS f16* tl = (LAS f16*)lds;
    {
        constexpr int NI8 = 2 * DFF / 64; const int nI = G > 2 * NI8 ? NI8 : 0;
        if (bid >= G - nI || nI == 0) prep_weight_i8(P, 0, 2 * DFF, ws + WS_WGU1, (float*)(ws + WS_WGU1 + (size_t)2 * DFF * D), nI ? bid - (G - nI) : bid, nI ? nI : G, lds);
        if (bid < G - nI) { int tbase = 0, cursor = bid; __syncthreads();
            prep_weight(P, 1, D, DFF, (f16*)(ws + WS_WD1), cursor, tbase, tl, G - nI);
            prep_weight(P, 2, NIN, D, (f16*)(ws + WS_WIN), cursor, tbase, tl, G - nI); }
    }
    float* ss0 = (float*)(ws + WS_SS0);
    f16* acta = (f16*)(ws + WS_ACTA);
    const int gw = bid * 8 + (tid >> 6), nw = G * 8;
    unsigned char* x8 = ws + WS_US; float* sa0 = (float*)(ws + WS_IQ);
    for (int p = gw; p < L; p += nw) {
        const float* src = p < SEQ ? P.x + (size_t)p * D : P.meta + (size_t)(p - SEQ) * D; float s = 0.f, mx = 0.f; f32x4 v[4];
#pragma unroll
        for (int i = 0; i < 4; ++i) { v[i] = *(const f32x4*)(src + lane * 4 + 256 * i); s += (v[i][0] * v[i][0] + v[i][1] * v[i][1]) + (v[i][2] * v[i][2] + v[i][3] * v[i][3]);
            mx = fmaxf(fmaxf(mx, fmaxf(fabsf(v[i][0]), fabsf(v[i][1]))), fmaxf(fabsf(v[i][2]), fabsf(v[i][3]))); *(half4*)(acta + (size_t)p * D + lane * 4 + 256 * i) = to_half4(v[i]); }
#pragma unroll
        for (int o = 32; o >= 1; o >>= 1) { s += __shfl_xor(s, o); mx = fmaxf(mx, __shfl_xor(mx, o)); }
        const float sc = mx > 0.f ? 127.0f / mx : 0.f;
#pragma unroll
        for (int i = 0; i < 4; ++i) { unsigned word = 0u;
#pragma unroll
            for (int j = 0; j < 4; ++j) word |= ((unsigned)(int)__builtin_rintf(v[i][j] * sc) & 0xffu) << (8 * j);
            *(unsigned*)(x8 + (size_t)p * D + lane * 4 + 256 * i) = word; }
        if (lane == 0) { ss0[p] = s; sa0[p] = mx * (1.0f / 127.0f); }
    }
    const int gt = bid * NTHREADS + tid, ngt = G * NTHREADS;
    for (int i = gt; i < MP; i += ngt) { if (i >= L) { ss0[i] = (float)D; sa0[i] = 0.f; } }
    f32x2* rope = (f32x2*)(ws + WS_ROPE);
    for (int i = gt; i < L * 32; i += ngt) { const int t = i >> 5, f = i & 31; const double inv = exp(-(double)f * (9.210340371976184 / 32.0)); double sn, cs; sincos((double)t * inv, &sn, &cs); rope[i] = (f32x2){(float)cs, (float)sn}; }
}

__device__ __forceinline__ void meta_down(const Params& P, LAS unsigned char* lds) {
    const int tid = threadIdx.x, lane = tid & 63, wid = tid >> 6;
    const f16* Gm = (const f16*)(P.ws + WS_G) + (size_t)SEQ * DFF; const f16* Wt = (const f16*)(P.ws + WS_WD1);
    f16* acta = (f16*)P.out; float* ss1 = (float*)(P.ws + WS_SS1); LAS float* slot = (LAS float*)lds;
    for (int task = blockIdx.x; task < NMETA * 16; task += gridDim.x) {
        const int r = task >> 4, cg = task & 15; float part = 0.f;
#pragma unroll 1
        for (int q = 0; q < 2; ++q) {
            const int n0 = cg * 64 + (2 * wid + q) * 4; float a[4] = {0.f, 0.f, 0.f, 0.f};
            for (int kc = lane; kc < DFF / 8; kc += 64) {
                const half8 gv = *(const half8*)(Gm + (size_t)r * DFF + kc * 8);
#pragma unroll
                for (int j = 0; j < 4; ++j) { const half8 wv = *(const half8*)(Wt + (size_t)(n0 + j) * DFF + kc * 8);
#pragma unroll
                    for (int e = 0; e < 8; ++e) a[j] += (float)gv[e] * (float)wv[e]; }
            }
#pragma unroll
            for (int o = 32; o >= 1; o >>= 1) { a[0] += __shfl_xor(a[0], o); a[1] += __shfl_xor(a[1], o); a[2] += __shfl_xor(a[2], o); a[3] += __shfl_xor(a[3], o); }
            f32x4 o;
#pragma unroll
            for (int j = 0; j < 4; ++j) { o[j] = P.meta[r * D + n0 + j] + 0.5f * a[j]; part += o[j] * o[j]; }
            if (lane == 0) *(half4*)(acta + (size_t)(SEQ + r) * D + n0) = to_half4(o);
        }
        if (lane == 0) slot[wid] = part;
        __syncthreads();
        if (tid == 0) { float s = 0.f; for (int w = 0; w < 8; ++w) s += slot[w]; ss1[(size_t)(SEQ + r) * 16 + cg] = s; }
        __syncthreads();
    }
}

__device__ __forceinline__ float logsigmoid_f(float z) { return fminf(z, 0.f) - __logf(1.0f + __expf(-fabsf(z))); }
__device__ __forceinline__ void gla_gates(const Params& P, int c, int h, LAS float* bl) {
    const int tid = threadIdx.x, ti = tid >> 3, d0 = (tid & 7) * 8, tt = 64 * c - 48 + ti; const float* GA = (const float*)(P.ws + WS_GA);
    {
        float z[8];
        if (tt >= 0 && tt < L) {
            const f32x4 b0 = *(const f32x4*)(P.ba + 64 * h + d0), b1 = *(const f32x4*)(P.ba + 64 * h + d0 + 4);
#pragma unroll
            for (int m = 0; m < 4; ++m) { z[m] = b0[m]; z[4 + m] = b1[m]; }
            f32x4 a4[4];
#pragma unroll
            for (int q = 0; q < 4; ++q) a4[q] = *(const f32x4*)(GA + (size_t)tt * 16 + 4 * q);
#pragma unroll
            for (int r = 0; r < 16; ++r) { const float ar = a4[r >> 2][r & 3]; const f32x4 w0 = *(const f32x4*)(P.wa2 + r * 256 + 64 * h + d0), w1 = *(const f32x4*)(P.wa2 + r * 256 + 64 * h + d0 + 4);
#pragma unroll
                for (int m = 0; m < 4; ++m) { z[m] += ar * w0[m]; z[4 + m] += ar * w1[m]; } }
#pragma unroll
            for (int m = 0; m < 8; ++m) z[m] = logsigmoid_f(z[m]) * (1.0f / 16.0f);
        } else {
#pragma unroll
            for (int m = 0; m < 8; ++m) z[m] = 0.f;
        }
#pragma unroll
        for (int m = 0; m < 8; ++m) bl[ti * 65 + d0 + m] = z[m];
    }
    __syncthreads();
    {
        const int d = tid & 63, seg = tid >> 6; float v[8], run = 0.f;
#pragma unroll
        for (int i = 0; i < 8; ++i) { run += bl[(seg * 8 + i) * 65 + d]; v[i] = run; }
#pragma unroll
        for (int i = 0; i < 8; ++i) bl[(seg * 8 + i) * 65 + d] = v[i];
        __syncthreads();
        float off = 0.f;
#pragma unroll
        for (int sg = 0; sg < 7; ++sg) off += (sg < seg) ? bl[(sg * 8 + 7) * 65 + d] : 0.f;
        __syncthreads();
#pragma unroll
        for (int i = 0; i < 8; ++i) bl[(seg * 8 + i) * 65 + d] = v[i] + off;
    }
    __syncthreads();
}
__device__ __forceinline__ void gla_a_unit(const Params& P, int unit, LAS unsigned char* lds) {
    int tid_ = threadIdx.x; asm volatile("" : "+v"(tid_));
    const int tid = tid_, lane = tid & 63, wid = tid >> 6, c = unit >> 2, h = unit & 3;
    LAS float* bl = (LAS float*)lds; LAS float* ks = bl + 4160; LAS float* vs = ks + 4096;
    const f16* GK = (const f16*)(P.ws + WS_GK); const f16* GV = (const f16*)(P.ws + WS_GV);
    float* U = (float*)(P.ws + WS_US); float* DEC = (float*)(P.ws + WS_DECAY);
    const int ti = tid >> 3, d0 = (tid & 7) * 8, tt = 64 * c - 48 + ti; const bool tv = tt >= 0 && tt < L;
    half8 k8, v8[2];
#pragma unroll
    for (int m = 0; m < 8; ++m) { k8[m] = (f16)0.f; v8[0][m] = (f16)0.f; v8[1][m] = (f16)0.f; }
    if (tv) k8 = *(const half8*)(GK + (size_t)tt * 256 + 64 * h + d0);
#pragma unroll
    for (int q = 0; q < 2; ++q) { const int ch = tid + 512 * q, j = ch >> 4, t = 64 * c - 48 + j; if (t >= 0 && t < L) v8[q] = *(const half8*)(GV + (size_t)t * 512 + 128 * h + (ch & 15) * 8); }
    gla_gates(P, c, h, bl);
    { f32x4 o0, o1;
#pragma unroll
      for (int m = 0; m < 4; ++m) { o0[m] = (float)k8[m] * __expf(bl[63 * 65 + d0 + m] - bl[ti * 65 + d0 + m]); o1[m] = (float)k8[4 + m] * __expf(bl[63 * 65 + d0 + 4 + m] - bl[ti * 65 + d0 + 4 + m]); }
      *(LAS f32x4*)(ks + ti * 64 + d0) = o0; *(LAS f32x4*)(ks + ti * 64 + d0 + 4) = o1; }
#pragma unroll
    for (int q = 0; q < 2; ++q) { const int ch = tid + 512 * q, j = ch >> 4, e0 = (ch & 15) * 8; f32x4 o0, o1;
#pragma unroll
        for (int m = 0; m < 4; ++m) { o0[m] = (float)v8[q][m]; o1[m] = (float)v8[q][4 + m]; }
        *(LAS f32x4*)(vs + j * 128 + e0) = o0; *(LAS f32x4*)(vs + j * 128 + e0 + 4) = o1; }
    if (tid < 64) DEC[(size_t)c * 256 + h * 64 + tid] = __expf(bl[63 * 65 + tid]);
    __syncthreads();
    { const int dd0 = (wid >> 2) * 32, e0 = (wid & 3) * 32, l31 = lane & 31, hf = lane >> 5; f32x16 acc;
#pragma unroll
      for (int i = 0; i < 16; ++i) acc[i] = 0.f;
#pragma unroll 8
      for (int s = 0; s < 32; ++s) acc = __builtin_amdgcn_mfma_f32_32x32x2f32(ks[(2 * s + hf) * 64 + dd0 + l31], vs[(2 * s + hf) * 128 + e0 + l31], acc, 0, 0, 0);
      float* up = U + ((size_t)unit * 64) * 128;
#pragma unroll
      for (int r = 0; r < 16; ++r) { const int row = (r & 3) + 8 * (r >> 2) + 4 * hf; up[(size_t)(dd0 + row) * 128 + e0 + l31] = acc[r]; } }
    __syncthreads();
}
__device__ __forceinline__ void gla_scan(const Params& P) {
    float* U = (float*)(P.ws + WS_US); const float* DEC = (const float*)(P.ws + WS_DECAY);
    const int idx = blockIdx.x * NTHREADS + threadIdx.x;
    if (idx >= 32768) return;
    float s = 0.f;
#pragma unroll 8
    for (int c = 0; c < NCH; ++c) { const float u = U[(size_t)c * 32768 + idx], dc = DEC[(size_t)c * 256 + (idx >> 7)]; U[(size_t)c * 32768 + idx] = s; s = dc * s + u; }
}
__device__ __forceinline__ void gla_c_unit(const Params& P, int unit, LAS unsigned char* lds) {
    int tid_ = threadIdx.x; asm volatile("" : "+v"(tid_));
    const int tid = tid_, lane = tid & 63, wid = tid >> 6, c = unit >> 2, h = unit & 3, l31 = lane & 31, hf = lane >> 5;
    LAS float* bl = (LAS float*)lds; LAS float* kk = bl + 4160; LAS float* qs = kk + 4160; LAS float* As = qs + 4160; LAS float* vs = As + 4160; LAS float* Ss = vs + 8192; LAS float* os = bl;
    const f16* GQ = (const f16*)(P.ws + WS_GQ); const f16* GK = (const f16*)(P.ws + WS_GK); const f16* GV = (const f16*)(P.ws + WS_GV); const f16* GR = (const f16*)(P.ws + WS_GR);
    const float* Sg = (const float*)(P.ws + WS_US) + (size_t)unit * 8192; f16* mix = (f16*)(P.ws + WS_ACTA);
    const int ti = tid >> 3, d0 = (tid & 7) * 8, tt = 64 * c - 48 + ti; const bool tv = tt >= 0 && tt < L;
    half8 q8, k8, v8[2], r8[2]; f32x4 sreg[4];
#pragma unroll
    for (int m = 0; m < 8; ++m) { q8[m] = (f16)0.f; k8[m] = (f16)0.f; v8[0][m] = (f16)0.f; v8[1][m] = (f16)0.f; r8[0][m] = (f16)0.f; r8[1][m] = (f16)0.f; }
    if (tv) { q8 = *(const half8*)(GQ + (size_t)tt * 256 + 64 * h + d0); k8 = *(const half8*)(GK + (size_t)tt * 256 + 64 * h + d0);
        r8[0] = *(const half8*)(GR + (size_t)tt * 512 + 128 * h + (tid & 7) * 16); r8[1] = *(const half8*)(GR + (size_t)tt * 512 + 128 * h + (tid & 7) * 16 + 8); }
#pragma unroll
    for (int q = 0; q < 2; ++q) { const int ch = tid + 512 * q, j = ch >> 4, t = 64 * c - 48 + j; if (t >= 0 && t < L) v8[q] = *(const half8*)(GV + (size_t)t * 512 + 128 * h + (ch & 15) * 8); }
#pragma unroll
    for (int q = 0; q < 4; ++q) sreg[q] = *(const f32x4*)(Sg + (size_t)(tid + 512 * q) * 4);
    gla_gates(P, c, h, bl);
#pragma unroll
    for (int m = 0; m < 8; ++m) { const float bv = bl[ti * 65 + d0 + m]; qs[ti * 65 + d0 + m] = (float)q8[m] * 0.125f * __expf(bv); kk[ti * 65 + d0 + m] = (float)k8[m] * __expf(-bv); }
#pragma unroll
    for (int q = 0; q < 2; ++q) { const int ch = tid + 512 * q, j = ch >> 4, e0 = (ch & 15) * 8; f32x4 o0, o1;
#pragma unroll
        for (int m = 0; m < 4; ++m) { o0[m] = (float)v8[q][m]; o1[m] = (float)v8[q][4 + m]; }
        *(LAS f32x4*)(vs + j * 128 + e0) = o0; *(LAS f32x4*)(vs + j * 128 + e0 + 4) = o1; }
#pragma unroll
    for (int q = 0; q < 4; ++q) *(LAS f32x4*)(Ss + (tid + 512 * q) * 4) = sreg[q];
    __syncthreads();
    if (wid < 4) { const int i0 = (wid >> 1) * 32, j0 = (wid & 1) * 32; f32x16 acc;
#pragma unroll
        for (int i = 0; i < 16; ++i) acc[i] = 0.f;
#pragma unroll 8
        for (int s = 0; s < 32; ++s) acc = __builtin_amdgcn_mfma_f32_32x32x2f32(qs[(i0 + l31) * 65 + 2 * s + hf], kk[(j0 + l31) * 65 + 2 * s + hf], acc, 0, 0, 0);
#pragma unroll
        for (int r = 0; r < 16; ++r) { const int i = i0 + (r & 3) + 8 * (r >> 2) + 4 * hf, j = j0 + l31; As[i * 65 + j] = (j <= i) ? acc[r] : 0.f; } }
    __syncthreads();
    { const int i0 = (wid >> 2) * 32, e0 = (wid & 3) * 32; f32x16 acc;
#pragma unroll
      for (int i = 0; i < 16; ++i) acc[i] = 0.f;
#pragma unroll 8
      for (int s = 0; s < 32; ++s) acc = __builtin_amdgcn_mfma_f32_32x32x2f32(qs[(i0 + l31) * 65 + 2 * s + hf], Ss[(2 * s + hf) * 128 + e0 + l31], acc, 0, 0, 0);
#pragma unroll 8
      for (int s = 0; s < 32; ++s) acc = __builtin_amdgcn_mfma_f32_32x32x2f32(As[(i0 + l31) * 65 + 2 * s + hf], vs[(2 * s + hf) * 128 + e0 + l31], acc, 0, 0, 0);
#pragma unroll
      for (int r = 0; r < 16; ++r) { const int i = i0 + (r & 3) + 8 * (r >> 2) + 4 * hf; os[i * 129 + e0 + l31] = acc[r]; } }
    __syncthreads();
    { const int e0 = (tid & 7) * 16; float o[16], sq = 0.f;
#pragma unroll
      for (int j = 0; j < 16; ++j) { o[j] = os[ti * 129 + e0 + j]; sq += o[j] * o[j]; }
      sq += __shfl_xor(sq, 1); sq += __shfl_xor(sq, 2); sq += __shfl_xor(sq, 4);
      const float rs = rsqrtf(sq * (1.0f / 128.0f) + EPS);
      if (tt >= NMETA && tt < L) { half8 w0, w1;
#pragma unroll
          for (int j = 0; j < 8; ++j) { w0[j] = (f16)(o[j] * rs * P.hn[e0 + j] * silu_f((float)r8[0][j])); w1[j] = (f16)(o[8 + j] * rs * P.hn[e0 + 8 + j] * silu_f((float)r8[1][j])); }
          f16* dst = mix + (size_t)(tt - NMETA) * D + 128 * h + e0; *(half8*)dst = w0; *(half8*)(dst + 8) = w1; } }
    __syncthreads();
}

__device__ __forceinline__ unsigned mono_u(float f) { const unsigned u = __float_as_uint(f); return (u & 0x80000000u) ? ~u : (u | 0x80000000u); }
__device__ __forceinline__ float unmono_f(unsigned m) { return __uint_as_float((m & 0x80000000u) ? (m & 0x7fffffffu) : ~m); }
__device__ __forceinline__ unsigned wave_umax(unsigned v) {
    v = max(v, (unsigned)__builtin_amdgcn_update_dpp(0, (int)v, 0x111, 0xf, 0xf, false));
    v = max(v, (unsigned)__builtin_amdgcn_update_dpp(0, (int)v, 0x112, 0xf, 0xf, false));
    v = max(v, (unsigned)__builtin_amdgcn_update_dpp(0, (int)v, 0x114, 0xf, 0xf, false));
    v = max(v, (unsigned)__builtin_amdgcn_update_dpp(0, (int)v, 0x118, 0xf, 0xf, false));
    v = max(v, (unsigned)__builtin_amdgcn_update_dpp(0, (int)v, 0x142, 0xa, 0xf, false));
    v = max(v, (unsigned)__builtin_amdgcn_update_dpp(0, (int)v, 0x143, 0xc, 0xf, false));
    return (unsigned)__builtin_amdgcn_readlane((int)v, 63);
}
__device__ __forceinline__ int half_scan_incl(int v) {
    v += __builtin_amdgcn_update_dpp(0, v, 0x111, 0xf, 0xf, true);
    v += __builtin_amdgcn_update_dpp(0, v, 0x112, 0xf, 0xf, true);
    v += __builtin_amdgcn_update_dpp(0, v, 0x114, 0xf, 0xf, true);
    v += __builtin_amdgcn_update_dpp(0, v, 0x118, 0xf, 0xf, true);
    v += __builtin_amdgcn_update_dpp(0, v, 0x142, 0xa, 0xf, true);
    return v;
}
constexpr int CAP = 640, NPL = CAP / 64;
__device__ __forceinline__ int topk_compact(LAS float* cs, LAS unsigned short* ci, int n, bool exact, float& tau_out, int lane) {
    float sv[NPL]; unsigned iv[NPL], u[NPL];
#pragma unroll
    for (int i = 0; i < NPL; ++i) { const int p = lane + 64 * i; const bool v = p < n; sv[i] = v ? cs[p] : 0.f; iv[i] = v ? (unsigned)ci[p] : 0xffffu; u[i] = v ? mono_u(sv[i]) : 0u; }
    unsigned T = 0u; bool full = true; int hb = 31;
    {
        unsigned umx = 0u, umn = 0xffffffffu;
#pragma unroll
        for (int i = 0; i < NPL; ++i) { umx = max(umx, u[i]); umn = min(umn, (lane + 64 * i < n) ? u[i] : 0xffffffffu); }
        umx = wave_umax(umx); umn = ~wave_umax(~umn);
        const unsigned df = umx ^ umn;
        if (df == 0u) { hb = -1; T = umx; } else { hb = 31 - __clz(df); T = (hb == 31) ? 0u : (umx & ~((2u << hb) - 1u)); }
    }
#pragma unroll 1
    for (int bit = hb; bit >= 0; --bit) {
        const unsigned cand = T | (1u << bit); int cgt = 0;
#pragma unroll
        for (int i = 0; i < NPL; ++i) cgt += __popcll(__ballot(u[i] >= cand));
        if (cgt >= 256) { T = cand; if (cgt <= (exact ? 256 : 272)) { full = false; break; } }
    }
    bool keep[NPL];
    if (full) {
        int cgt = 0;
#pragma unroll
        for (int i = 0; i < NPL; ++i) cgt += __popcll(__ballot(u[i] > T));
        const int need = 256 - cgt; unsigned I = 0xffffu; int nties = 0;
#pragma unroll
        for (int i = 0; i < NPL; ++i) nties += __popcll(__ballot(u[i] == T));
        if (nties != need) { I = 0u;
#pragma unroll 1
        for (int bit = 15; bit >= 0; --bit) { const unsigned cand = I | (1u << bit); int cl = 0;
#pragma unroll
            for (int i = 0; i < NPL; ++i) cl += __popcll(__ballot(u[i] == T && iv[i] < cand));
            if (cl < need) I = cand; } }
#pragma unroll
        for (int i = 0; i < NPL; ++i) keep[i] = (u[i] > T) || (u[i] == T && iv[i] <= I);
    } else {
#pragma unroll
        for (int i = 0; i < NPL; ++i) keep[i] = u[i] >= T;
    }
    int nn = 0;
#pragma unroll
    for (int i = 0; i < NPL; ++i) { const unsigned long long m = __ballot(keep[i]); const int pre = __builtin_amdgcn_mbcnt_hi((unsigned)(m >> 32), __builtin_amdgcn_mbcnt_lo((unsigned)m, 0u));
        if (keep[i]) { cs[nn + pre] = sv[i]; ci[nn + pre] = (unsigned short)iv[i]; } nn += __popcll(m); }
    tau_out = unmono_f(T);
    return nn;
}
__device__ __forceinline__ float relu_asm(float x) { return __int_as_float(max(__float_as_int(x), 0)); }
__device__ __forceinline__ void indexer_tile(const Params& P, int tile, LAS unsigned char* lds) {
    int tid_ = threadIdx.x; asm volatile("" : "+v"(tid_));
    const int tid = tid_, lane = tid & 63, wid = __builtin_amdgcn_readfirstlane(tid >> 6), l31 = lane & 31, hf = lane >> 5;
    LAS float* candS = (LAS float*)lds;
    LAS unsigned short* candI = (LAS unsigned short*)(lds + 32 * CAP * 4);
    LAS unsigned char* kbuf = lds + 32 * CAP * 6;
    LAS int* lflag = (LAS int*)(lds + LDS_BYTES - 1024 + 192);
    const f16* IQ = (const f16*)(P.ws + WS_IQ); const f16* IK = (const f16*)(P.ws + WS_IK); const float* IW = (const float*)(P.ws + WS_IW);
    unsigned short* SEL = (unsigned short*)(P.ws + WS_SEL);
    const int t0 = tile * 32, tw = t0 + wid * 4;
    half8 afr[4];
    { const int qi = 2 * (l31 >> 4) + ((l31 >> 2) & 1), hd = 4 * ((l31 >> 3) & 1) + (l31 & 3); int tq = tw + qi; if (tq > L - 1) tq = L - 1;
      const half8* ap = (const half8*)(IQ + (size_t)tq * 512 + hd * 64);
#pragma unroll
      for (int s = 0; s < 4; ++s) afr[s] = ap[2 * s + hf]; }
    float w0[8], w1[8];
    { int ta = tw + hf, tb = tw + 2 + hf; if (ta > L - 1) ta = L - 1; if (tb > L - 1) tb = L - 1;
#pragma unroll
      for (int h = 0; h < 8; ++h) { w0[h] = IW[(size_t)ta * 8 + h]; w1[h] = IW[(size_t)tb * 8 + h]; } }
    asm volatile("" :: "v"(afr[0]), "v"(afr[1]), "v"(afr[2]), "v"(afr[3]));
    asm volatile("" :: "v"(w0[0]), "v"(w0[1]), "v"(w0[2]), "v"(w0[3]), "v"(w0[4]), "v"(w0[5]), "v"(w0[6]), "v"(w0[7]));
    asm volatile("" :: "v"(w1[0]), "v"(w1[1]), "v"(w1[2]), "v"(w1[3]), "v"(w1[4]), "v"(w1[5]), "v"(w1[6]), "v"(w1[7]));
    const int tq0 = (tw + hf < L) ? tw + hf : -1, tq1 = (tw + 2 + hf < L) ? tw + 2 + hf : -1;
    float tau0 = -__builtin_inff(), tau1 = -__builtin_inff();
    int cq0 = 0, cq1 = 0, cq2 = 0, cq3 = 0;
    if (tid < 3) lflag[tid] = 0;
    const int nkeys = (t0 + 32 < L) ? t0 + 32 : L, nst = (nkeys + 127) >> 7;
    u32x4 stg[2];
    const u32x4* IKv = (const u32x4*)IK;
#pragma unroll
    for (int i = 0; i < 2; ++i) stg[i] = IKv[(size_t)0 * 1024 + tid + 512 * i];
#pragma unroll
    for (int i = 0; i < 2; ++i) { const int ci = tid + 512 * i, row = ci >> 3, ch = ci & 7; *(LAS u32x4*)(kbuf + row * 128 + ((ch ^ ((row >> 1) & 7)) << 4)) = stg[i]; }
    __syncthreads();
#pragma unroll 1
    for (int st = 0; st < nst; ++st) {
        LAS unsigned char* kb = kbuf + (st & 1) * 16384;
        if (st + 1 < nst) {
#pragma unroll
            for (int i = 0; i < 2; ++i) stg[i] = IKv[(size_t)(st + 1) * 1024 + tid + 512 * i];
        }
        if (st * 128 <= tw + 3) {
            f32x16 acc[4];
#pragma unroll
            for (int c = 0; c < 4; ++c) {
#pragma unroll
                for (int i = 0; i < 16; ++i) acc[c][i] = 0.f;
            }
#pragma unroll
            for (int s = 0; s < 4; ++s) {
#pragma unroll
                for (int c = 0; c < 4; ++c) { const int row = c * 32 + l31; const half8 bf = *(const LAS half8*)(kb + row * 128 + (((2 * s + hf) ^ ((row >> 1) & 7)) << 4)); acc[c] = __builtin_amdgcn_mfma_f32_32x32x16_f16(afr[s], bf, acc[c], 0, 0, 0); }
            }
            float sc[8]; bool ok[8]; int na = 0, nb = 0;
#pragma unroll
            for (int c = 0; c < 4; ++c) {
                float s0 = 0.f, s1 = 0.f;
#pragma unroll
                for (int h = 0; h < 8; ++h) { const float r0 = relu_asm(acc[c][h]), r1 = relu_asm(acc[c][8 + h]);
                    asm("v_fmac_f32 %0, %1, %2" : "+v"(s0) : "v"(w0[h]), "v"(r0)); asm("v_fmac_f32 %0, %1, %2" : "+v"(s1) : "v"(w1[h]), "v"(r1)); }
                const int key = st * 128 + c * 32 + l31;
                sc[2 * c] = s0; sc[2 * c + 1] = s1; ok[2 * c] = key <= tq0 && s0 > tau0; ok[2 * c + 1] = key <= tq1 && s1 > tau1;
                na += ok[2 * c] ? 1 : 0; nb += ok[2 * c + 1] ? 1 : 0;
            }
            const int ia = half_scan_incl(na), ib = half_scan_incl(nb);
            const int ta0 = __builtin_amdgcn_readlane(ia, 31), ta1 = __builtin_amdgcn_readlane(ia, 63), tb0 = __builtin_amdgcn_readlane(ib, 31), tb1 = __builtin_amdgcn_readlane(ib, 63);
            int pa = (hf ? cq1 : cq0) + ia - na, pb = (hf ? cq3 : cq2) + ib - nb;
            cq0 += ta0; cq1 += ta1; cq2 += tb0; cq3 += tb1;
            pa += (wid * 4 + hf) * CAP; pb += (wid * 4 + 2 + hf) * CAP;
            const int dmy = 32 * CAP * 6 / 4 + 2 * 16384 / 4 + 64 + lane;
#pragma unroll
            for (int c = 0; c < 4; ++c) {
                const unsigned short key = (unsigned short)(st * 128 + c * 32 + l31);
                { const bool k0 = ok[2 * c]; LAS float* ps = k0 ? candS + pa : candS + dmy; LAS unsigned short* pi = k0 ? candI + pa : (LAS unsigned short*)(candS + dmy + 64); *ps = sc[2 * c]; *pi = key; pa += k0 ? 1 : 0; }
                { const bool k1 = ok[2 * c + 1]; LAS float* ps = k1 ? candS + pb : candS + dmy; LAS unsigned short* pi = k1 ? candI + pb : (LAS unsigned short*)(candS + dmy + 64); *ps = sc[2 * c + 1]; *pi = key; pb += k1 ? 1 : 0; }
            }
        }
        if (st + 1 < nst) {
            LAS unsigned char* kn = kbuf + ((st + 1) & 1) * 16384;
#pragma unroll
            for (int i = 0; i < 2; ++i) { const int ci = tid + 512 * i, row = ci >> 3, ch = ci & 7; *(LAS u32x4*)(kn + row * 128 + ((ch ^ ((row >> 1) & 7)) << 4)) = stg[i]; }
        }
        const int mx = max(max(cq0, cq1), max(cq2, cq3));
        if (mx > CAP - 128 && lane == 0) lflag[st % 3] = 1;
        if (tid == 0) lflag[(st + 1) % 3] = 0;
        __syncthreads();
        const int any = lflag[st % 3];
        if (any) {
#pragma unroll 1
            for (int qq = 0; qq < 4; ++qq) { const int n = qq == 0 ? cq0 : (qq == 1 ? cq1 : (qq == 2 ? cq2 : cq3));
                if (n > 288) { float nt; const int nn = topk_compact(candS + (wid * 4 + qq) * CAP, candI + (wid * 4 + qq) * CAP, n, false, nt, lane);
                    if (qq == 0) cq0 = nn; else if (qq == 1) cq1 = nn; else if (qq == 2) cq2 = nn; else cq3 = nn;
                    if (hf == (qq & 1)) { if (qq < 2) tau0 = nt; else tau1 = nt; } } }
        }
    }
#pragma unroll 1
    for (int qq = 0; qq < 4; ++qq) {
        const int t = tw + qq; if (t >= L) break;
        int n = qq == 0 ? cq0 : (qq == 1 ? cq1 : (qq == 2 ? cq2 : cq3)); LAS float* cs = candS + (wid * 4 + qq) * CAP; LAS unsigned short* ci = candI + (wid * 4 + qq) * CAP;
        if (n > 256) { float nt; n = topk_compact(cs, ci, n, true, nt, lane); }
#pragma unroll
        for (int j = 0; j < 4; ++j) { const int p = lane + 64 * j; SEL[(size_t)t * 256 + (p & 15) * 16 + (p >> 4)] = p < n ? ci[p] : (unsigned short)0xffffu; }
    }
    __syncthreads();
}

__device__ __forceinline__ void sparse_attn(const Params& P, LAS unsigned char* lds, int vbid) {
    int tid_ = threadIdx.x; asm volatile("" : "+v"(tid_));
    const int tid = tid_, lane = tid & 63, wid = tid >> 6, grp = lane >> 2, c4 = lane & 3;
    const int head = vbid & 7, slot = (vbid >> 3) * 8 + wid, nslot = (gridDim.x >> 3) * 8;
    typedef _Float16 half2v __attribute__((ext_vector_type(2)));
    LAS float* red = (LAS float*)(lds + 4096 + wid * 4352);
    const unsigned short* SEL = (const unsigned short*)(P.ws + WS_SEL);
    const unsigned char* Q8 = P.ws + WS_DQ + head * 64 + c4 * 16; const float* QS = (const float*)(P.ws + WS_DQ + (size_t)LP * 512) + head;
    const unsigned char* kvh = P.ws + WS_KV + (size_t)head * LP * 128; f16* mix = (f16*)(P.ws + WS_ACTA);
    int t = NMETA + slot;
    u32x4 sela = {0u, 0u, 0u, 0u}, selb = {0u, 0u, 0u, 0u}, q8 = {0u, 0u, 0u, 0u}; float lscale = 0.f;
    if (t < L) { sela = *(const u32x4*)(SEL + (size_t)t * 256 + grp * 16); selb = *(const u32x4*)(SEL + (size_t)t * 256 + grp * 16 + 8); q8 = *(const u32x4*)(Q8 + (size_t)t * 512); lscale = QS[(size_t)t * 8]; }
#define ATTN_ITEM(ALLV) do { \
        unsigned keys[16]; u32x4 kreg[16], vreg[16]; \
        _Pragma("unroll") for (int it = 0; it < 16; ++it) { const unsigned w = it < 8 ? sela[it >> 1] : selb[(it - 8) >> 1]; keys[it] = (it & 1) ? (w >> 16) : (w & 0xffffu); } \
        _Pragma("unroll") for (int it = 0; it < 16; ++it) { const unsigned kk = (ALLV || keys[it] != 0xffffu) ? keys[it] : 0u; kreg[it] = *(const u32x4*)(kvh + (size_t)kk * 128 + c4 * 16); } \
        _Pragma("unroll") for (int it = 0; it < 16; ++it) { const unsigned kk = (ALLV || keys[it] != 0xffffu) ? keys[it] : 0u; vreg[it] = *(const u32x4*)(kvh + (size_t)kk * 128 + 64 + c4 * 16); } \
        const u32x4 qc = q8; const float ls = lscale; \
        { const int tn = t + nslot;     \
          if (tn < L) { sela = *(const u32x4*)(SEL + (size_t)tn * 256 + grp * 16); selb = *(const u32x4*)(SEL + (size_t)tn * 256 + grp * 16 + 8); q8 = *(const u32x4*)(Q8 + (size_t)tn * 512); lscale = QS[(size_t)tn * 8]; } } \
        float lg[16]; float mx = -__builtin_inff(); \
        _Pragma("unroll") for (int it = 0; it < 16; ++it) { \
            int ai = 0; \
            _Pragma("unroll") for (int w = 0; w < 4; ++w) ai = __builtin_amdgcn_sdot4((int)kreg[it][w], (int)qc[w], ai, false); \
            ai += __builtin_amdgcn_update_dpp(0, ai, 0xB1, 0xf, 0xf, true);     \
            ai += __builtin_amdgcn_update_dpp(0, ai, 0x4E, 0xf, 0xf, true);     \
            lg[it] = (ALLV || keys[it] != 0xffffu) ? (float)ai * ls : -__builtin_inff(); mx = fmaxf(mx, lg[it]); } \
        mx = fmaxf(mx, __shfl_xor(mx, 4)); mx = fmaxf(mx, __shfl_xor(mx, 8)); mx = fmaxf(mx, __shfl_xor(mx, 16)); mx = fmaxf(mx, __shfl_xor(mx, 32)); \
        half2v o2[8]; float lsum = 0.f; \
        _Pragma("unroll") for (int e = 0; e < 8; ++e) o2[e] = (half2v){(f16)0.f, (f16)0.f}; \
        _Pragma("unroll") for (int it = 0; it < 16; ++it) { \
            const float p = __expf(lg[it] - mx); lsum += p; const f16 ph = (f16)p; const half2v p2 = {ph, ph}; \
            _Pragma("unroll") for (int w = 0; w < 4; ++w) {     \
                const half2v v01 = __builtin_bit_cast(half2v, __builtin_amdgcn_perm(0u, vreg[it][w], 0x010c000cu)), v23 = __builtin_bit_cast(half2v, __builtin_amdgcn_perm(0u, vreg[it][w], 0x030c020cu)); \
                o2[2 * w] = p2 * v01 + o2[2 * w]; o2[2 * w + 1] = p2 * v23 + o2[2 * w + 1]; } } \
        lsum += __shfl_xor(lsum, 4); lsum += __shfl_xor(lsum, 8); lsum += __shfl_xor(lsum, 16); lsum += __shfl_xor(lsum, 32); \
          \
        _Pragma("unroll") for (int e = 0; e < 8; ++e) { red[lane * 17 + 2 * e] = (float)o2[e][0]; red[lane * 17 + 2 * e + 1] = (float)o2[e][1]; } \
        float acc = 0.f; \
        { const int cc = lane >> 4, e = lane & 15; \
          _Pragma("unroll") for (int g = 0; g < 16; ++g) acc += red[(g * 4 + cc) * 17 + e]; } \
        mix[(size_t)(t - NMETA) * D + 512 + head * 64 + lane] = (f16)(acc * __builtin_amdgcn_rcpf(lsum)); \
    } while (0)
#pragma unroll 1
    for (; t < L; t += nslot) {
        if (t >= 255) ATTN_ITEM(true);
        else ATTN_ITEM(false);
    }
#undef ATTN_ITEM
    __syncthreads();
}

__device__ __forceinline__ void final_norm(const Params& P) {
    const int tid = threadIdx.x, lane = tid & 63, gw = blockIdx.x * 8 + (tid >> 6), nw = gridDim.x * 8;
    const float* ss3 = (const float*)(P.ws + WS_SS3); const f16* h3 = (const f16*)(P.ws + WS_ACTA);
    for (int r = gw; r < SEQ; r += nw) { const float rs = row_rstd(ss3, 16, r);
#pragma unroll
        for (int i = 0; i < 2; ++i) { const int k = lane * 8 + 512 * i; const half8 v = *(const half8*)(h3 + (size_t)r * D + k); const f32x4 g0 = *(const f32x4*)(P.nf + k), g1 = *(const f32x4*)(P.nf + k + 4); f32x4 o0, o1;
#pragma unroll
            for (int j = 0; j < 4; ++j) { o0[j] = (float)v[j] * rs * g0[j]; o1[j] = (float)v[4 + j] * rs * g1[j]; }
            *(f32x4*)(P.out + (size_t)r * D + k) = o0; *(f32x4*)(P.out + (size_t)r * D + k + 4) = o1; } }
}

#define XB_TMO      128
#define XB_XCNT(j)  (256  + 64 * (j))
#define XB_XSUB(j)  (1280 + 64 * (j))
#define XB_XGEN(j)  (2304 + 64 * (j))
#define XB_TOP      3328
#define XB_TOPGEN   3392
#define XCD_BAR_WORDS 3456
#define XB_SPIN_CAP (1u << 22)
__device__ __forceinline__ unsigned xb_ld(unsigned* p)              { return __hip_atomic_load(p, __ATOMIC_RELAXED, __HIP_MEMORY_SCOPE_AGENT); }
__device__ __forceinline__ unsigned xb_add(unsigned* p, unsigned v) { return __hip_atomic_fetch_add(p, v, __ATOMIC_RELAXED, __HIP_MEMORY_SCOPE_AGENT); }
__device__ __forceinline__ unsigned xb_xcc_id() { return (unsigned)__builtin_amdgcn_s_getreg((3 << 11) | 20) & 0xFu; }
#define XB_SPIN(cond, bar) do { unsigned _sp = 0; while (cond) { __builtin_amdgcn_s_sleep(1); \
    if ((++_sp & 255u) == 0u) { if (xb_ld(&(bar)[XB_TMO])) break; if (_sp > XB_SPIN_CAP) { atomicAdd(&(bar)[XB_TMO], 1u); break; } } } } while (0)
struct XcdBarrier { unsigned* bar; unsigned x; volatile LAS unsigned* st; };
__device__ __forceinline__ XcdBarrier xcd_barrier_post(unsigned* bar, volatile LAS unsigned* st) {
    XcdBarrier b; b.bar = bar; b.x = xb_xcc_id(); b.st = st;
    if (threadIdx.x == 0) (void)xb_add(&bar[XB_XCNT(b.x)], 1u);
    return b;
}
__device__ __forceinline__ void xcd_barrier_complete(unsigned* bar, unsigned x, unsigned& nloc, unsigned& nx) {
    const unsigned G = gridDim.x * gridDim.y * gridDim.z;
    unsigned sum, cnt, mine, sp = 0u;
    for (;;) {
        sum = 0u; cnt = 0u; mine = 0u;
#pragma unroll
        for (unsigned j = 0; j < 16; ++j) { const unsigned c = xb_ld(&bar[XB_XCNT(j)]); sum += c; cnt += (c > 0u) ? 1u : 0u; mine = (j == x) ? c : mine; }
        if (sum == G) break;
        __builtin_amdgcn_s_sleep(1);
        if ((++sp & 255u) == 0u) { if (xb_ld(&bar[XB_TMO])) break; if (sp > XB_SPIN_CAP) { atomicAdd(&bar[XB_TMO], 1u); break; } }
    }
    nloc = mine > 0u ? mine : 1u; nx = cnt > 0u ? cnt : 1u;
}
__device__ __forceinline__ void xcd_barrier(const XcdBarrier& b) {
    asm volatile("s_waitcnt vmcnt(0)" ::: "memory");
    __syncthreads();
    if (threadIdx.x == 0) {
        unsigned* bar = b.bar;
        __builtin_amdgcn_s_waitcnt(0);
        unsigned nloc = b.st[0], nx = b.st[1];
        if (nloc == 0u) { xcd_barrier_complete(bar, b.x, nloc, nx); b.st[0] = nloc; b.st[1] = nx; }
        const unsigned old = xb_add(&bar[XB_XSUB(b.x)], 1u);
        const unsigned gen = old / nloc;
        if (old + 1u == (gen + 1u) * nloc) {
            __builtin_amdgcn_fence(__ATOMIC_RELEASE, "agent");
            asm volatile("s_waitcnt vmcnt(0)" ::: "memory");
            const unsigned og = xb_add(&bar[XB_TOP], 1u);
            const unsigned tg = og / nx;
            if (og + 1u == (tg + 1u) * nx) xb_add(&bar[XB_TOPGEN], 1u);
            else XB_SPIN(xb_ld(&bar[XB_TOPGEN]) == tg, bar);
            __builtin_amdgcn_fence(__ATOMIC_ACQUIRE, "agent");
            xb_add(&bar[XB_XGEN(b.x)], 1u);
            asm volatile("s_waitcnt vmcnt(0)" ::: "memory");
        } else {
            XB_SPIN(xb_ld(&bar[XB_XGEN(b.x)]) == gen, bar);
            __builtin_amdgcn_fence(__ATOMIC_ACQUIRE, "agent");
            asm volatile("s_waitcnt vmcnt(0)" ::: "memory");
        }
    }
    __syncthreads();
}

__global__ void __launch_bounds__(NTHREADS, 2) fwd_kernel(Params P) {
    __shared__ __attribute__((aligned(16))) unsigned char lds_raw[LDS_BYTES];
    LAS unsigned char* lds = (LAS unsigned char*)lds_raw;
    const int tid = threadIdx.x, bid = blockIdx.x, G = gridDim.x;
    unsigned char* ws = P.ws;
    const int lo = P.ph_lo, hi = P.ph_hi;
#ifndef ONLY_PHASE
#define ONLY_PHASE -1
#endif
#define IN(k) ((ONLY_PHASE < 0 || ONLY_PHASE == (k)) && lo <= (k) && (k) < hi)
#define SEAM(k) do { if (IN(k) && IN((k) + 1)) { xcd_barrier(xbar); } } while (0)
    XcdBarrier xbar; xbar.bar = (unsigned*)(ws + WS_BAR); xbar.x = 0; xbar.st = (volatile LAS unsigned*)(lds + LDS_BYTES - 1024 + 16);
    if (hi - lo > 1) {
        if (tid == 0) { xbar.st[0] = 0u; xbar.st[1] = 0u; }
        __syncthreads();
        xbar = xcd_barrier_post((unsigned*)(ws + WS_BAR), (volatile LAS unsigned*)(lds + LDS_BYTES - 1024 + 16));
    }
    LAS int* misc = (LAS int*)(lds + LDS_BYTES - 1024);
    if (hi - lo > 1) {
        if (tid == 0) { const unsigned xcc = xb_xcc_id() & 7u; misc[8] = (int)xcc; misc[9] = (int)xb_add((unsigned*)(ws + WS_CTL) + 32 + 32 * xcc, 1u); }
    }
    int vbid = bid;
    f16* acta = (f16*)(ws + WS_ACTA); f16* Gb = (f16*)(ws + WS_G);
    float* ss0 = (float*)(ws + WS_SS0); float* ss1 = (float*)(ws + WS_SS1); float* ss2 = (float*)(ws + WS_SS2); float* ss3 = (float*)(ws + WS_SS3);
    if (IN(0)) { p0_prologue(P, lds); }
    SEAM(0);
    if (hi - lo > 1 && (G & 7) == 0) {
        if (tid == 0) { bool ok = true; for (int j = 0; j < 8; ++j) ok = ok && (xb_ld((unsigned*)(ws + WS_CTL) + 32 + 32 * j) == (unsigned)(G >> 3)); misc[10] = ok ? misc[9] * 8 + misc[8] : bid; }
        __syncthreads();
        vbid = __builtin_amdgcn_readfirstlane(misc[10]);
        __syncthreads();
    }
    if (IN(1)) {
        pg8::Gemm g{(const f16*)(ws + WS_US), (const f16*)(ws + WS_WGU1), MP, 2 * DFF, D / 2}; pg8::StaticOrder S; S.init(MP, 2 * DFF, G, vbid);
        EpiSwiglu<true> E{Gb, ss0, 1, (const float*)(ws + WS_IQ), (const float*)(ws + WS_WGU1 + (size_t)2 * DFF * D)}; pg8::gemm_phase(lds, g, S, E);
    }
    SEAM(1);
    if (IN(2)) {
        meta_down(P, lds);
        pg8::Gemm g{Gb, (const f16*)(ws + WS_WD1), SEQ, D, DFF}; pg8::StaticOrder S; S.init(SEQ, D, G, vbid);
        EpiResid<true> E{acta, (f16*)P.out, ss1, 0.5f}; pg8::gemm_phase(lds, g, S, E);
    }
    SEAM(2);
    if (IN(3)) {
        pg8::Gemm g{(const f16*)P.out, (const f16*)(ws + WS_WIN), MP, NIN, D}; pg8::StaticOrder S; S.init(MP, NIN, G, vbid);
        EpiInProj E{ss1, (const f32x2*)(ws + WS_ROPE), ws};
        pg8::gemm_phase(lds, g, S, E);
    }
    SEAM(3);
    if (IN(4)) {
        for (int u = bid; u < NCH * 4; u += G) gla_a_unit(P, u, lds);
        {
            int tbase = 0, cursor = bid; LAS f16* tl = (LAS f16*)lds;
            prep_weight(P, 3, D, D, (f16*)(ws + WS_WOUT), cursor, tbase, tl, G);
            prep_weight(P, 5, D, DFF, (f16*)(ws + WS_WD2), cursor, tbase, tl, G);
            __syncthreads();
            prep_weight_i8(P, 4, 2 * DFF, ws + WS_WGU2, (float*)(ws + WS_WGU2 + (size_t)2 * DFF * D), bid, G, lds);
        }
    }
    SEAM(4);
    if (IN(5)) {
        if (bid < 64) gla_scan(P);
        unsigned* ctr = (unsigned*)(ws + WS_CTL); LAS int* bc = (LAS int*)(lds + LDS_BYTES - 1024);
        for (;;) {
            if (tid == 0) bc[0] = (int)atomicAdd(ctr, 1u);
            __syncthreads();
            const int k = bc[0];
            __syncthreads();
            if (k >= 513) break;
            indexer_tile(P, 512 - k, lds);
        }
    }
    SEAM(5);
    if (IN(6)) { for (int u = bid; u < NCH * 4; u += G) gla_c_unit(P, u, lds); sparse_attn(P, lds, vbid); }
    SEAM(6);
    if (IN(7)) {
        pg8::Gemm g{acta, (const f16*)(ws + WS_WOUT), SEQ, D, D}; pg8::StaticOrder S; S.init(SEQ, D, G, vbid);
        EpiResid<true> E{P.out, (f16*)(ws + WS_US), ss2, 1.0f}; pg8::gemm_phase(lds, g, S, E);
    }
    SEAM(7);
    if (IN(8)) quant_rows_i8((const f16*)(ws + WS_US), ws + WS_DQ, (float*)(ws + WS_IQ), SEQ);
    SEAM(8);
    if (IN(9)) {
        pg8::Gemm g{(const f16*)(ws + WS_DQ), (const f16*)(ws + WS_WGU2), SEQ, 2 * DFF, D / 2}; pg8::StaticOrder S; S.init(SEQ, 2 * DFF, G, vbid);
        EpiSwiglu<true> E{Gb, ss2, 16, (const float*)(ws + WS_IQ), (const float*)(ws + WS_WGU2 + (size_t)2 * DFF * D)}; pg8::gemm_phase(lds, g, S, E);
    }
    SEAM(9);
    if (IN(10)) {
        pg8::Gemm g{Gb, (const f16*)(ws + WS_WD2), SEQ, D, DFF}; pg8::StaticOrder S; S.init(SEQ, D, G, vbid);
        EpiResid<true> E{ws + WS_US, acta, ss3, 0.5f}; pg8::gemm_phase(lds, g, S, E);
    }
    SEAM(10);
    if (IN(11)) final_norm(P);
#undef IN
#undef SEAM
}

extern "C" void kernel_launch(void* const* d_in, const int* in_sizes, int n_in, void* d_out, int out_size, void* d_ws, size_t ws_size, hipStream_t stream) {
    static int grid = 0;
    if (grid == 0) {
        if (n_in != 17 || in_sizes[0] != SEQ * D || out_size != SEQ * D || ws_size < WS_END) { fprintf(stderr, "kernel_launch: unexpected shapes (n_in %d, in0 %d, out %d, ws %zu, need %zu)\n", n_in, n_in > 0 ? in_sizes[0] : -1, out_size, ws_size, (size_t)WS_END); grid = -1; return; }
        int dev = 0, cus = 0, per_cu = 0;
        (void)hipGetDevice(&dev); (void)hipDeviceGetAttribute(&cus, hipDeviceAttributeMultiprocessorCount, dev);
        if (hipOccupancyMaxActiveBlocksPerMultiprocessor(&per_cu, (const void*)fwd_kernel, NTHREADS, 0) != hipSuccess || per_cu < 1) { fprintf(stderr, "kernel_launch: occupancy query says %d blocks per CU\n", per_cu); per_cu = 1; }
        (void)hipGetLastError();
        grid = cus;
        if (grid % 8 != 0 || grid < 64) { fprintf(stderr, "kernel_launch: unexpected CU count %d\n", cus); }
    }
    if (grid < 0) return;
    if (hipMemsetAsync((char*)d_ws + WS_CTL, 0, CTL_BYTES, stream) != hipSuccess) { fprintf(stderr, "kernel_launch: memset failed\n"); return; }
    Params p{};
    const float** pp = (const float**)&p;
    for (int i = 0; i < 17; ++i) pp[i] = (const float*)d_in[i];
    p.out = (float*)d_out; p.ws = (unsigned char*)d_ws;
#if MODE == 0
    for (int ph = 0; ph < NPHASE; ++ph) { p.ph_lo = ph; p.ph_hi = ph + 1; hipLaunchKernelGGL(fwd_kernel, dim3(grid), dim3(NTHREADS), 0, stream, p); }
#else
    p.ph_lo = 0; p.ph_hi = NPHASE;
    void* args[] = {&p};
    hipError_t e = hipLaunchCooperativeKernel((const void*)fwd_kernel, dim3(grid), dim3(NTHREADS), args, 0, stream);
    if (e != hipSuccess) fprintf(stderr, "cooperative launch failed: %s (grid %d)\n", hipGetErrorString(e), grid);
#endif
}
```

```cpp
#include <hip/hip_runtime.h>
#include <cstdio>
#include <cstdint>

#ifndef MODE
#define MODE 1
#endif

#define LAS __attribute__((address_space(3)))
typedef _Float16 f16;
typedef _Float16 half8 __attribute__((ext_vector_type(8)));
typedef _Float16 half4 __attribute__((ext_vector_type(4)));
typedef float f32x2 __attribute__((ext_vector_type(2)));
typedef float f32x4 __attribute__((ext_vector_type(4)));
typedef float f32x16 __attribute__((ext_vector_type(16)));
typedef unsigned u32x2 __attribute__((ext_vector_type(2)));
typedef unsigned u32x4 __attribute__((ext_vector_type(4)));
typedef int i32x4 __attribute__((ext_vector_type(4)));

constexpr int D = 1024, SEQ = 16384, NMETA = 16, L = SEQ + NMETA, DFF = 2816;
constexpr int MP = 16640;
constexpr int LP = 16512;
constexpr int NIN = 3840;
constexpr int NCH = 257;
constexpr float EPS = 1e-6f;
constexpr int NTHREADS = 512;
constexpr int LDS_BYTES = 155648 + 1024;
constexpr int NPHASE = 12;

constexpr size_t al256(size_t x) { return (x + 255) & ~(size_t)255; }
constexpr size_t WS_CTL = 0;
constexpr size_t CTL_BYTES = 32768;
constexpr size_t WS_BAR = 2048;
constexpr size_t WS_WGU1 = CTL_BYTES;
constexpr size_t WS_WD1 = WS_WGU1 + (size_t)2 * DFF * D * 2;
constexpr size_t WS_WIN = WS_WD1 + (size_t)D * DFF * 2;
constexpr size_t WS_WOUT = WS_WIN + (size_t)NIN * D * 2;
constexpr size_t WS_WGU2 = WS_WOUT + (size_t)D * D * 2;
constexpr size_t WS_WD2 = WS_WGU2 + (size_t)2 * DFF * D * 2;
constexpr size_t WS_ACTA = WS_WD2 + (size_t)D * DFF * 2;
constexpr size_t WS_G = WS_ACTA + (size_t)MP * D * 2;
constexpr size_t WS_US = WS_G + (size_t)MP * DFF * 2;
constexpr size_t WS_DQ = WS_US + (size_t)NCH * 4 * 64 * 128 * 4;
constexpr size_t WS_IQ = WS_DQ + (size_t)LP * 512 * 2;
constexpr size_t WS_SEL = WS_IQ + (size_t)LP * 512 * 2;
constexpr size_t WS_ROPE = WS_SEL + (size_t)LP * 256 * 2;
constexpr size_t WS_IW = WS_ROPE + al256((size_t)L * 32 * 8);
constexpr size_t WS_GA = WS_IW + (size_t)LP * 8 * 4;
constexpr size_t WS_DECAY = WS_GA + (size_t)LP * 16 * 4;
constexpr size_t WS_SS0 = WS_DECAY + al256((size_t)NCH * 256 * 4);
constexpr size_t WS_SS1 = WS_SS0 + (size_t)MP * 4;
constexpr size_t WS_SS2 = WS_SS1 + (size_t)MP * 64;
constexpr size_t WS_SS3 = WS_SS2 + (size_t)MP * 64;
constexpr size_t WS_END = WS_SS3 + (size_t)MP * 64;
constexpr size_t WS_KV = WS_G;
constexpr size_t WS_GQ = WS_KV + (size_t)8 * LP * 128 * 2;
constexpr size_t WS_GK = WS_GQ + (size_t)LP * 256 * 2;
constexpr size_t WS_GV = WS_GK + (size_t)LP * 256 * 2;
constexpr size_t WS_GR = WS_GV + (size_t)LP * 512 * 2;
constexpr size_t WS_IK = WS_GR + (size_t)LP * 512 * 2;
constexpr size_t WS_ALIAS_END = WS_IK + (size_t)LP * 64 * 2;
static_assert(WS_ALIAS_END <= WS_US, "aliased buffers exceed G");
static_assert(WS_END <= (size_t)256 * 1024 * 1024, "workspace exceeds 256 MiB");
static_assert((size_t)SEQ * D * 2 <= (size_t)NCH * 4 * 64 * 128 * 4, "h2_16 alias");

struct Params {
    const float* x; const float* meta; const float* n1; const float* wg1; const float* wu1; const float* wd1;
    const float* nmix; const float* win; const float* wa2; const float* ba; const float* hn; const float* wout;
    const float* n2; const float* wg2; const float* wu2; const float* wd2; const float* nf;
    float* out; unsigned char* ws; int ph_lo, ph_hi;
};

namespace pg8 {
constexpr int BM = 256, BK = 64, HALF = 128, HTB = HALF * BK * 2, STAGE_BYTES = 8 * HTB, NXCD = 8, WGM = 8;
__host__ __device__ __forceinline__ int lds_byte(int r, int c) { const int st = (r >> 4) * 2 + (c >> 5), rr = r & 15, cc = c & 31, ob = rr * 64 + cc * 2; return st * 1024 + (ob ^ (((ob >> 9) & 1) << 5)); }
__host__ __device__ __forceinline__ int perm32(int rho) { const int n = rho >> 4, i = rho & 15; return 8 * (i >> 2) + 4 * n + (i & 3); }
__host__ __device__ __forceinline__ void stage_rc(int b, int& R, int& C) { const int st = b / 1024, sb = b % 1024, swz = sb ^ (((sb >> 9) & 1) << 5); R = (st >> 1) * 16 + swz / 64; C = (st & 1) * 32 + (swz % 64) / 2; }
struct Unit { int pm, pn; };
struct Gemm { const f16* A; const f16* Bt; int M, N, K; };
struct StaticOrder {
    int nM, nN, nwg, G, c;
    __host__ __device__ void init(int M, int N, int G_, int c_) { nM = M / BM; nN = N / BM; nwg = nM * nN; G = G_; c = c_; }
    __host__ __device__ bool next(int i, Unit& u) const {
        const long Lx = (long)i * G + c; if (Lx >= nwg) return false;
        int wgid = (int)Lx; { const int q = nwg / NXCD, r = nwg % NXCD, xcd = wgid % NXCD, off = wgid / NXCD; wgid = (xcd < r ? xcd * (q + 1) : r * (q + 1) + (xcd - r) * q) + off; }
        const int nig = WGM * nN, gid = wgid / nig, fm = gid * WGM, gsz = (nM - fm) < WGM ? (nM - fm) : WGM;
        u.pm = fm + ((wgid % nig) % gsz); u.pn = (wgid % nig) / gsz; return true;
    }
};
template <class Epi>
__device__ __forceinline__ void gemm_phase(LAS unsigned char* lds, const Gemm g, const StaticOrder& S, const Epi& E) {
    int tid_ = threadIdx.x; asm volatile("" : "+v"(tid_));
    const int tid = tid_, wid = __builtin_amdgcn_readfirstlane(tid >> 6), lane = tid & 63, wr = wid >> 2, wc = wid & 3, fr = lane & 15, fq = lane >> 4;
    const int K = g.K, nt = K / BK;
    unsigned voffA[2], voffB[2];
#pragma unroll
    for (int i = 0; i < 2; ++i) { int R, C; stage_rc(tid * 16 + i * 8192, R, C); const int Rb = (R & ~31) + perm32(R & 31); voffA[i] = (unsigned)(R * K + C) * 2u; voffB[i] = (unsigned)(Rb * K + C) * 2u; }
    const size_t kstep = (size_t)(BK * 2);
    const size_t hstep = (size_t)HALF * K * 2;
    const size_t tstep = 2 * hstep;
    const unsigned ldsw = (unsigned)wid * 1024u;
    const int aoff = lds_byte(wr * 64 + fr, fq * 8), boff = lds_byte(wc * 32 + fr, fq * 8);
#define PG8_SA(b, h) (((b) * 2 + (h)) * HTB)
#define PG8_SB(b, h) ((4 + (b) * 2 + (h)) * HTB)
#define PG8_STAGE(bufoff, gbase, voff) do { _Pragma("unroll") for (int _i = 0; _i < 2; ++_i) \
        __builtin_amdgcn_global_load_lds((const unsigned*)((const char*)(gbase) + (voff)[_i]), (LAS unsigned*)(lds + (bufoff) + ldsw + _i * 8192), 16, 0, 0); } while (0)
#define PG8_LDA(dst, b, h) do { _Pragma("unroll") for (int m = 0; m < 4; ++m) _Pragma("unroll") for (int k = 0; k < 2; ++k) dst[m][k] = *(const LAS half8*)(lds + PG8_SA(b, h) + aoff + m * 2048 + k * 1024); } while (0)
#define PG8_LDB(dst, b, h) do { _Pragma("unroll") for (int n = 0; n < 2; ++n) _Pragma("unroll") for (int k = 0; k < 2; ++k) dst[n][k] = *(const LAS half8*)(lds + PG8_SB(b, h) + boff + n * 2048 + k * 1024); } while (0)
#define PG8_MMA(ai, bj, At, Bt) do { __builtin_amdgcn_s_setprio(1); _Pragma("unroll") for (int m = 0; m < 4; ++m) _Pragma("unroll") for (int n = 0; n < 2; ++n) _Pragma("unroll") for (int k = 0; k < 2; ++k) { \
        if constexpr (Epi::I8) acc[ai][bj][m][n] = __builtin_bit_cast(f32x4, __builtin_amdgcn_mfma_i32_16x16x64_i8(__builtin_bit_cast(i32x4, Bt[n][k]), __builtin_bit_cast(i32x4, At[m][k]), __builtin_bit_cast(i32x4, acc[ai][bj][m][n]), 0, 0, 0)); \
        else acc[ai][bj][m][n] = __builtin_amdgcn_mfma_f32_16x16x32_f16(Bt[n][k], At[m][k], acc[ai][bj][m][n], 0, 0, 0); } __builtin_amdgcn_s_setprio(0); } while (0)
#define PG8_WAIT_V(n) asm volatile("s_waitcnt vmcnt(" #n ")" ::: "memory")
#define PG8_WAIT_L(n) asm volatile("s_waitcnt lgkmcnt(" #n ")" ::: "memory")
#define PG8_BAR __builtin_amdgcn_s_barrier()
#define PG8_SCHED __builtin_amdgcn_sched_barrier(0)
    Unit cur, nxt; int ui = 0;
    if (!S.next(0, cur)) return;
    f32x4 acc[2][2][4][2];
#pragma unroll
    for (int a = 0; a < 2; ++a)
#pragma unroll
        for (int b = 0; b < 2; ++b)
#pragma unroll
            for (int m = 0; m < 4; ++m)
#pragma unroll
                for (int n = 0; n < 2; ++n) acc[a][b][m][n] = (f32x4){0.f, 0.f, 0.f, 0.f};
    half8 At[4][2], B0[2][2], B1[2][2];
    const char* cA = (const char*)g.A + (size_t)cur.pm * tstep; const char* cB = (const char*)g.Bt + (size_t)cur.pn * tstep;
    PG8_STAGE(PG8_SB(0, 0), cB, voffB); PG8_STAGE(PG8_SA(0, 0), cA, voffA); PG8_STAGE(PG8_SB(0, 1), cB + hstep, voffB); PG8_STAGE(PG8_SA(0, 1), cA + hstep, voffA);
    if (wr == 1) PG8_BAR;
    PG8_WAIT_V(4); PG8_BAR;
    PG8_STAGE(PG8_SB(1, 0), cB + kstep, voffB); PG8_STAGE(PG8_SA(1, 0), cA + kstep, voffA); PG8_STAGE(PG8_SB(1, 1), cB + hstep + kstep, voffB);
    PG8_WAIT_V(6); PG8_BAR;
    for (;;) {
        const bool has_next = S.next(ui + 1, nxt);
        const char* nA = has_next ? (const char*)g.A + (size_t)nxt.pm * tstep : cA; const char* nB = has_next ? (const char*)g.Bt + (size_t)nxt.pn * tstep : cB;
        for (int t = 0; t < nt; t += 2) {
            const bool last = (t == nt - 2);
            const char* a1 = cA + (size_t)(t + 1) * kstep;
            const char* a2 = last ? nA : cA + (size_t)(t + 2) * kstep; const char* b2 = last ? nB : cB + (size_t)(t + 2) * kstep;
            const char* a3 = a2 + kstep; const char* b3 = b2 + kstep;
            PG8_LDB(B0, 0, 0); PG8_SCHED; PG8_LDA(At, 0, 0); PG8_STAGE(PG8_SA(1, 1), a1 + hstep, voffA);
            PG8_WAIT_L(8); PG8_BAR; PG8_WAIT_L(0); PG8_MMA(0, 0, At, B0); PG8_BAR; PG8_SCHED;
            PG8_LDB(B1, 0, 1); PG8_STAGE(PG8_SB(0, 0), b2, voffB);
            PG8_BAR; PG8_WAIT_L(0); PG8_MMA(0, 1, At, B1); PG8_BAR;
            PG8_LDA(At, 0, 1); PG8_STAGE(PG8_SA(0, 0), a2, voffA);
            PG8_BAR; PG8_WAIT_L(0); PG8_MMA(1, 0, At, B0); PG8_BAR; PG8_SCHED;
            PG8_STAGE(PG8_SB(0, 1), b2 + hstep, voffB);
            PG8_WAIT_V(6); PG8_BAR; PG8_MMA(1, 1, At, B1); PG8_BAR;
            PG8_LDB(B0, 1, 0); PG8_SCHED; PG8_LDA(At, 1, 0); PG8_STAGE(PG8_SA(0, 1), a2 + hstep, voffA);
            PG8_WAIT_L(8); PG8_BAR; PG8_WAIT_L(0); PG8_MMA(0, 0, At, B0); PG8_BAR; PG8_SCHED;
            PG8_LDB(B1, 1, 1); PG8_STAGE(PG8_SB(1, 0), b3, voffB);
            PG8_BAR; PG8_WAIT_L(0); PG8_MMA(0, 1, At, B1); PG8_BAR;
            PG8_LDA(At, 1, 1); PG8_STAGE(PG8_SA(1, 0), a3, voffA);
            PG8_BAR; PG8_WAIT_L(0); PG8_MMA(1, 0, At, B0); PG8_BAR; PG8_SCHED;
            PG8_STAGE(PG8_SB(1, 1), b3 + hstep, voffB);
            PG8_WAIT_V(6); PG8_BAR; PG8_MMA(1, 1, At, B1); PG8_BAR;
        }
        if constexpr (Epi::I8) {
#pragma unroll
            for (int a = 0; a < 2; ++a)
#pragma unroll
                for (int b = 0; b < 2; ++b)
#pragma unroll
                    for (int m = 0; m < 4; ++m)
#pragma unroll
                        for (int n = 0; n < 2; ++n) { const i32x4 v = __builtin_bit_cast(i32x4, acc[a][b][m][n]); acc[a][b][m][n] = (f32x4){(float)v[0], (float)v[1], (float)v[2], (float)v[3]}; }
        }
        E(acc, cur, wr, wc, fr, fq);
        if (!has_next) break;
#pragma unroll
        for (int a = 0; a < 2; ++a)
#pragma unroll
            for (int b = 0; b < 2; ++b)
#pragma unroll
                for (int m = 0; m < 4; ++m)
#pragma unroll
                    for (int n = 0; n < 2; ++n) acc[a][b][m][n] = (f32x4){0.f, 0.f, 0.f, 0.f};
        cur = nxt; cA = nA; cB = nB; ++ui;
    }
    PG8_WAIT_V(0);
    if (wr == 0) PG8_BAR;
    PG8_BAR;
#undef PG8_SA
#undef PG8_SB
#undef PG8_STAGE
#undef PG8_LDA
#undef PG8_LDB
#undef PG8_MMA
#undef PG8_WAIT_V
#undef PG8_WAIT_L
#undef PG8_BAR
#undef PG8_SCHED
}
}

__device__ __forceinline__ float silu_f(float v) { return v * __builtin_amdgcn_rcpf(1.0f + __expf(-v)); }
__device__ __forceinline__ half4 to_half4(f32x4 v) { half4 h; h[0] = (f16)v[0]; h[1] = (f16)v[1]; h[2] = (f16)v[2]; h[3] = (f16)v[3]; return h; }

__device__ __forceinline__ float row_rstd(const float* ss, int np, int row) {
    float s;
    if (np == 1) s = ss[row];
    else { const f32x4* p = (const f32x4*)(ss + (size_t)row * 16); const f32x4 a = p[0], b = p[1], c = p[2], d = p[3];
        s = (((a[0] + a[1]) + (a[2] + a[3])) + ((b[0] + b[1]) + (b[2] + b[3]))) + (((c[0] + c[1]) + (c[2] + c[3])) + ((d[0] + d[1]) + (d[2] + d[3]))); }
    return rsqrtf(s * (1.0f / D) + EPS);
}
template <bool I8_> struct EpiSwiglu {
    static constexpr bool I8 = I8_;
    f16* G; const float* ss; int np; const float* sa; const float* sw;
    __device__ __forceinline__ void operator()(const f32x4 (&acc)[2][2][4][2], const pg8::Unit& u, int wr, int wc, int fr_, int fq_) const {
        int fr = fr_, fq = fq_; asm volatile("" : "+v"(fr), "+v"(fq));
        f32x4 swg[2], swu[2];
        if constexpr (I8) {
#pragma unroll
            for (int n = 0; n < 2; ++n) { swg[n] = *(const f32x4*)(sw + u.pn * 256 + wc * 32 + 8 * fq + 4 * n); swu[n] = *(const f32x4*)(sw + u.pn * 256 + 128 + wc * 32 + 8 * fq + 4 * n); }
        }
#pragma unroll
        for (int ai = 0; ai < 2; ++ai)
#pragma unroll
            for (int m = 0; m < 4; ++m) {
                const int row = u.pm * 256 + ai * 128 + wr * 64 + m * 16 + fr;
                float rs = row_rstd(ss, np, row); if constexpr (I8) rs *= sa[row];
                const float ce = -1.4426950408889634f * rs, rs2 = rs * rs; half8 o;
#pragma unroll
                for (int n = 0; n < 2; ++n) {
                    f32x4 g = acc[ai][0][m][n], u = acc[ai][1][m][n];
                    if constexpr (I8) { g = g * swg[n]; u = u * swu[n]; }
                    const f32x4 t = g * ce; f32x4 e, r;
#pragma unroll
                    for (int j = 0; j < 4; ++j) e[j] = __builtin_amdgcn_exp2f(t[j]);
                    const f32x4 d = e + 1.0f;
#pragma unroll
                    for (int j = 0; j < 4; ++j) r[j] = __builtin_amdgcn_rcpf(d[j]);
                    const f32x4 w = (g * u) * (r * rs2);
#pragma unroll
                    for (int j = 0; j < 4; ++j) o[4 * n + j] = (f16)w[j];
                }
                *(half8*)(G + (size_t)row * DFF + u.pn * 128 + wc * 32 + 8 * fq) = o;
            }
    }
};
template <bool SRC16> struct EpiResid {
    static constexpr bool I8 = false;
    const void* src; f16* h16; float* ss; float alpha;
    __device__ __forceinline__ void operator()(const f32x4 (&acc)[2][2][4][2], const pg8::Unit& u, int wr, int wc, int fr_, int fq_) const {
        int fr = fr_, fq = fq_; asm volatile("" : "+v"(fr), "+v"(fq));
#pragma unroll
        for (int ai = 0; ai < 2; ++ai)
#pragma unroll
            for (int m = 0; m < 4; ++m) {
                const int row = u.pm * 256 + ai * 128 + wr * 64 + m * 16 + fr; float part = 0.f;
#pragma unroll
                for (int bj = 0; bj < 2; ++bj) {
                    const size_t off = (size_t)row * D + u.pn * 256 + bj * 128 + wc * 32 + 8 * fq; half8 h; f32x4 sv[2];
                    if (SRC16) { const half8 s8 = *(const half8*)((const f16*)src + off);
#pragma unroll
                        for (int j = 0; j < 4; ++j) { sv[0][j] = (float)s8[j]; sv[1][j] = (float)s8[4 + j]; } }
                    else { sv[0] = *(const f32x4*)((const float*)src + off); sv[1] = *(const f32x4*)((const float*)src + off + 4); }
#pragma unroll
                    for (int n = 0; n < 2; ++n) {
                        const f32x4 o = sv[n] + alpha * acc[ai][bj][m][n];
#pragma unroll
                        for (int j = 0; j < 4; ++j) h[4 * n + j] = (f16)o[j];
                        part += (o[0] * o[0] + o[1] * o[1]) + (o[2] * o[2] + o[3] * o[3]);
                    }
                    *(half8*)(h16 + off) = h;
                }
                part += __shfl_xor(part, 16); part += __shfl_xor(part, 32);
                if (fq == 0) ss[(size_t)row * 16 + u.pn * 4 + wc] = part;
            }
    }
};
constexpr float K_I8_SCALE = 127.0f / 8.0f;
__device__ __forceinline__ void rope8(const f32x4 (&x1)[2], const f32x4 (&x2)[2], const f32x2* rp, float sc, float (&o1)[8], float (&o2)[8]) {
#pragma unroll
    for (int n = 0; n < 2; ++n) {
        const f32x4 cs0 = *(const f32x4*)(rp + 4 * n), cs1 = *(const f32x4*)(rp + 4 * n + 2);
        o1[4 * n + 0] = (x1[n][0] * cs0[0] - x2[n][0] * cs0[1]) * sc; o2[4 * n + 0] = (x2[n][0] * cs0[0] + x1[n][0] * cs0[1]) * sc;
        o1[4 * n + 1] = (x1[n][1] * cs0[2] - x2[n][1] * cs0[3]) * sc; o2[4 * n + 1] = (x2[n][1] * cs0[2] + x1[n][1] * cs0[3]) * sc;
        o1[4 * n + 2] = (x1[n][2] * cs1[0] - x2[n][2] * cs1[1]) * sc; o2[4 * n + 2] = (x2[n][2] * cs1[0] + x1[n][2] * cs1[1]) * sc;
        o1[4 * n + 3] = (x1[n][3] * cs1[2] - x2[n][3] * cs1[3]) * sc; o2[4 * n + 3] = (x2[n][3] * cs1[2] + x1[n][3] * cs1[3]) * sc;
    }
}
__device__ __forceinline__ u32x2 pack_i8x8(const float (&v)[8]) {
    u32x2 r;
#pragma unroll
    for (int w = 0; w < 2; ++w) { unsigned word = 0u;
#pragma unroll
        for (int j = 0; j < 4; ++j) { const int q = (int)__builtin_rintf(fminf(fmaxf(v[4 * w + j] * K_I8_SCALE, -127.f), 127.f)); word |= ((unsigned)q & 0xffu) << (8 * j); }
        r[w] = word; }
    return r;
}
__device__ __forceinline__ u32x2 pack_bf8x8(const float (&v)[8]) {
    u32x2 r;
#pragma unroll
    for (int w = 0; w < 2; ++w) { int word = __builtin_amdgcn_cvt_pk_bf8_f32(v[4 * w], v[4 * w + 1], 0, false); word = __builtin_amdgcn_cvt_pk_bf8_f32(v[4 * w + 2], v[4 * w + 3], word, true); r[w] = (unsigned)word; }
    return r;
}
struct EpiInProj {
    static constexpr bool I8 = false;
    const float* ss; const f32x2* rope; unsigned char* ws;
    __device__ __forceinline__ void operator()(const f32x4 (&acc)[2][2][4][2], const pg8::Unit& u, int wr, int wc, int fr_, int fq_) const {
        int fr = fr_, fq = fq_; asm volatile("" : "+v"(fr), "+v"(fq));
        const int pn = u.pn;
        if (pn >= 8 && pn <= 11) {
            unsigned char* lb = (pn <= 9) ? ws + WS_KV + (size_t)((pn - 8) * 4 + wc) * LP * 128 + 8 * fq
                                          : ws + WS_KV + (size_t)((pn - 10) * 4 + (wc >> 1)) * LP * 128 + 64 + (wc & 1) * 32 + 8 * fq;
#pragma unroll
            for (int ai = 0; ai < 2; ++ai)
#pragma unroll
                for (int m = 0; m < 4; ++m) {
                    const int p = u.pm * 256 + ai * 128 + wr * 64 + m * 16 + fr;
                    const int t = p < SEQ ? p + NMETA : p - SEQ;
                    if (p < L) {
                        const float sc = row_rstd(ss, 16, p);
                        if (pn <= 9) {
                            float o1[8], o2[8]; rope8(acc[ai][0][m], acc[ai][1][m], rope + (size_t)t * 32 + 8 * fq, sc, o1, o2);
                            unsigned char* d8 = lb + (size_t)t * 128; *(u32x2*)d8 = pack_i8x8(o1); *(u32x2*)(d8 + 32) = pack_i8x8(o2);
                        } else {
#pragma unroll
                            for (int bj = 0; bj < 2; ++bj) { float v[8];
#pragma unroll
                                for (int j = 0; j < 4; ++j) { v[j] = acc[ai][bj][m][0][j] * sc; v[4 + j] = acc[ai][bj][m][1][j] * sc; }
                                *(u32x2*)(lb + (size_t)t * 128 + (size_t)bj * 2 * LP * 128) = pack_bf8x8(v); }
                        }
                    }
                    asm volatile("" ::: "memory");
                }
            return;
        }
        int mode = 0, stride = 256; float scale = 1.0f; f16* lanebase;
        if (pn == 0) lanebase = (f16*)(ws + WS_GQ) + wc * 32 + 8 * fq;
        else if (pn == 1) lanebase = (f16*)(ws + WS_GK) + wc * 32 + 8 * fq;
        else if (pn <= 3) { lanebase = (f16*)(ws + WS_GV) + (pn - 2) * 256 + wc * 32 + 8 * fq; stride = 512; }
        else if (pn <= 5) { lanebase = (f16*)(ws + WS_GR) + (pn - 4) * 256 + wc * 32 + 8 * fq; stride = 512; }
        else if (pn <= 7) { lanebase = (f16*)(ws + WS_DQ); mode = 6; scale = 0.125f; }
        else if (pn <= 13) { lanebase = (f16*)(ws + WS_IQ) + (pn - 12) * 256 + wc * 64 + 8 * fq; stride = 512; mode = 1; scale = 0.125f; }
        else { lanebase = (f16*)(ws + WS_IK) + 8 * fq; stride = 64; mode = wc == 0 ? 1 : (wc == 1 ? 2 : 3); }
#pragma unroll
        for (int ai = 0; ai < 2; ++ai)
#pragma unroll
            for (int m = 0; m < 4; ++m) {
                const int p = u.pm * 256 + ai * 128 + wr * 64 + m * 16 + fr;
                const int t = p < SEQ ? p + NMETA : p - SEQ;
                if (p < L && mode != 3) {
                    const float rs = row_rstd(ss, 16, p);
                    if (mode == 6) {
                        float o1[8], o2[8]; rope8(acc[ai][0][m], acc[ai][1][m], rope + (size_t)t * 32 + 8 * fq, rs * scale, o1, o2);
                        float qm = 1e-20f;
#pragma unroll
                        for (int j = 0; j < 8; ++j) qm = fmaxf(qm, fmaxf(fabsf(o1[j]), fabsf(o2[j])));
                        qm = fmaxf(qm, __shfl_xor(qm, 16)); qm = fmaxf(qm, __shfl_xor(qm, 32));
                        const float qsc = 127.0f * __builtin_amdgcn_rcpf(qm); u32x2 w1, w2;
#pragma unroll
                        for (int w = 0; w < 2; ++w) { unsigned a = 0u, b = 0u;
#pragma unroll
                            for (int j = 0; j < 4; ++j) { a |= ((unsigned)(int)__builtin_rintf(o1[4 * w + j] * qsc) & 0xffu) << (8 * j); b |= ((unsigned)(int)__builtin_rintf(o2[4 * w + j] * qsc) & 0xffu) << (8 * j); }
                            w1[w] = a; w2[w] = b; }
                        const int head = (pn - 6) * 4 + wc; unsigned char* qrow = ws + WS_DQ + (size_t)t * 512 + head * 64 + 8 * fq;
                        *(u32x2*)qrow = w1; *(u32x2*)(qrow + 32) = w2;
                        if (fq == 0) ((float*)(ws + WS_DQ + (size_t)LP * 512))[(size_t)t * 8 + head] = qm * (1.0f / (127.0f * K_I8_SCALE));
                    } else if (mode == 1) {
                        float o1[8], o2[8]; rope8(acc[ai][0][m], acc[ai][1][m], rope + (size_t)t * 32 + 8 * fq, rs * scale, o1, o2);
                        half8 h1, h2;
#pragma unroll
                        for (int j = 0; j < 8; ++j) { h1[j] = (f16)o1[j]; h2[j] = (f16)o2[j]; }
                        f16* dst = lanebase + (size_t)t * stride; *(half8*)dst = h1; *(half8*)(dst + 32) = h2;
                    } else if (mode == 2) {
                        if (fq < 2) { float* gp = (float*)(ws + WS_GA) + (size_t)t * 16 + 8 * fq; *(f32x4*)gp = acc[ai][0][m][0] * rs; *(f32x4*)(gp + 4) = acc[ai][0][m][1] * rs; }
                        else if (fq == 2) { float* ip = (float*)(ws + WS_IW) + (size_t)t * 8; const float r2 = rs * 0.35355339059327373f; *(f32x4*)ip = acc[ai][0][m][0] * r2; *(f32x4*)(ip + 4) = acc[ai][0][m][1] * r2; }
                    } else {
#pragma unroll
                        for (int bj = 0; bj < 2; ++bj) { half8 h;
#pragma unroll
                            for (int j = 0; j < 4; ++j) { h[j] = (f16)(acc[ai][bj][m][0][j] * rs); h[4 + j] = (f16)(acc[ai][bj][m][1][j] * rs); }
                            *(half8*)(lanebase + (size_t)t * stride + bj * 128) = h; }
                    }
                }
                asm volatile("" ::: "memory");
            }
    }
};

__device__ __forceinline__ const float* w_src(const Params& P, int kind, int n, int& ld, const float*& gain) {
    switch (kind) {
    case 0: case 4: { const int pn = n >> 8, bj = (n >> 7) & 1, cc = n & 127; ld = DFF; gain = kind == 0 ? P.n1 : P.n2;
        const float* w = kind == 0 ? (bj ? P.wu1 : P.wg1) : (bj ? P.wu2 : P.wg2); return w + pn * 128 + cc; }
    case 1: ld = D; gain = nullptr; return P.wd1 + n;
    case 5: ld = D; gain = nullptr; return P.wd2 + n;
    case 3: ld = D; gain = nullptr; return P.wout + n;
    default: { ld = 3672; gain = P.nmix; const int pn = n >> 8, c = n & 255, bj = c >> 7, hh = (c >> 5) & 3, dd = c & 31; int j;
        if (pn == 0) j = c; else if (pn == 1) j = 256 + c; else if (pn <= 3) j = 512 + (pn - 2) * 256 + c; else if (pn <= 5) j = 1024 + (pn - 4) * 256 + c;
        else if (pn <= 7) j = 1552 + (pn - 6) * 256 + hh * 64 + bj * 32 + dd;
        else if (pn <= 9) j = 2064 + (pn - 8) * 256 + hh * 64 + bj * 32 + dd;
        else if (pn <= 11) j = 2576 + (pn - 10) * 256 + c;
        else if (pn <= 13) j = 3088 + (pn - 12) * 256 + hh * 64 + bj * 32 + dd;
        else { if (c < 32) j = 3600 + c; else if (c < 48) j = 1536 + (c - 32); else if (c < 56) j = 3664 + (c - 48); else if (c >= 128 && c < 160) j = 3600 + 32 + (c - 128); else j = -1; }
        return j < 0 ? nullptr : P.win + j; }
    }
}
__device__ __forceinline__ void prep_weight(const Params& P, const int kind, const int N, const int K, f16* dst, int& cursor, int& tbase, LAS f16* tl, const int G) {
    const int tid = threadIdx.x, tn = N / 64, tk = K / 256, ntile = tn * tk;
    const int n = tid & 63, kk0 = tid >> 6;
    float v[32], vn[32];
#define PREP_LOAD(dstv, tI) do { const int n0_ = ((tI) % tn) * 64, k0_ = ((tI) / tn) * 256; int ld; const float* gain; const float* col = w_src(P, kind, n0_ + n, ld, gain); \
        _Pragma("unroll") for (int i = 0; i < 32; ++i) dstv[i] = col ? col[(size_t)(k0_ + kk0 + 8 * i) * ld] : 0.f; \
        if (gain) { _Pragma("unroll") for (int i = 0; i < 32; ++i) dstv[i] *= gain[k0_ + kk0 + 8 * i]; } } while (0)
    if (cursor < tbase + ntile) PREP_LOAD(v, cursor - tbase);
#pragma unroll 1
    for (; cursor < tbase + ntile; cursor += G) {
        const int tI = cursor - tbase, n0 = (tI % tn) * 64, k0 = (tI / tn) * 256;
        const bool more = cursor + G < tbase + ntile;
        if (more) PREP_LOAD(vn, tI + G);
#pragma unroll
        for (int i = 0; i < 32; ++i) tl[n * 264 + kk0 + 8 * i] = (f16)v[i];
        __syncthreads();
        { const int nr = tid >> 3, seg = tid & 7;
#pragma unroll
          for (int j = 0; j < 4; ++j) *(half8*)(dst + (size_t)(n0 + nr) * K + k0 + (seg + 8 * j) * 8) = *(const LAS half8*)(tl + nr * 264 + (seg + 8 * j) * 8); }
        __syncthreads();
        if (more) {
#pragma unroll
            for (int i = 0; i < 32; ++i) v[i] = vn[i];
        }
    }
#undef PREP_LOAD
    tbase += ntile;
}
__device__ __forceinline__ void prep_weight_i8(const Params& P, const int kind, const int N, unsigned char* dst, float* sw, int first, int step, LAS unsigned char* lds) {
    const int tid = threadIdx.x, n = tid & 63, kk0 = tid >> 6;
    LAS float* pmax = (LAS float*)lds; LAS unsigned* img = (LAS unsigned*)(lds + 2048);
#pragma unroll 1
    for (int task = first; task < N / 64; task += step) {
        const int n0 = task * 64; int ld; const float* gain; const float* col = w_src(P, kind, n0 + n, ld, gain);
        float v[128]; float mx = 0.f;
#pragma unroll
        for (int i = 0; i < 128; ++i) v[i] = col ? col[(size_t)(kk0 * 128 + i) * ld] : 0.f;
        if (gain) {
#pragma unroll
            for (int i = 0; i < 128; ++i) v[i] *= gain[kk0 * 128 + i];
        }
#pragma unroll
        for (int i = 0; i < 128; ++i) mx = fmaxf(mx, fabsf(v[i]));
        pmax[kk0 * 64 + n] = mx;
        __syncthreads();
#pragma unroll
        for (int q = 0; q < 8; ++q) mx = fmaxf(mx, pmax[q * 64 + n]);
        const float sc = mx > 0.f ? 127.0f / mx : 0.f;
        if (kk0 == 0) sw[n0 + n] = mx * (1.0f / 127.0f);
#pragma unroll
        for (int w = 0; w < 32; ++w) { unsigned word = 0u;
#pragma unroll
            for (int j = 0; j < 4; ++j) word |= ((unsigned)(int)__builtin_rintf(v[4 * w + j] * sc) & 0xffu) << (8 * j);
            img[n * 260 + kk0 * 32 + w] = word; }
        __syncthreads();
        { const int nr = tid >> 3, seg = tid & 7;
#pragma unroll
          for (int j = 0; j < 8; ++j) *(u32x4*)(dst + (size_t)(n0 + nr) * D + (seg + 8 * j) * 16) = *(const LAS u32x4*)(img + nr * 260 + (seg + 8 * j) * 4); }
        __syncthreads();
    }
}
__device__ __forceinline__ void quant_rows_i8(const f16* src, unsigned char* dst, float* sa, int rows) {
    const int tid = threadIdx.x, lane = tid & 63, gw = blockIdx.x * 8 + (tid >> 6), nw = gridDim.x * 8;
    for (int r = gw; r < rows; r += nw) {
        const half8 a = *(const half8*)(src + (size_t)r * D + lane * 16), b = *(const half8*)(src + (size_t)r * D + lane * 16 + 8);
        float v[16], mx = 0.f;
#pragma unroll
        for (int j = 0; j < 8; ++j) { v[j] = (float)a[j]; v[8 + j] = (float)b[j]; }
#pragma unroll
        for (int j = 0; j < 16; ++j) mx = fmaxf(mx, fabsf(v[j]));
#pragma unroll
        for (int o = 32; o >= 1; o >>= 1) mx = fmaxf(mx, __shfl_xor(mx, o));
        const float sc = mx > 0.f ? 127.0f / mx : 0.f; u32x4 w;
#pragma unroll
        for (int q = 0; q < 4; ++q) { unsigned word = 0u;
#pragma unroll
            for (int j = 0; j < 4; ++j) word |= ((unsigned)(int)__builtin_rintf(v[4 * q + j] * sc) & 0xffu) << (8 * j);
            w[q] = word; }
        *(u32x4*)(dst + (size_t)r * D + lane * 16) = w;
        if (lane == 0) sa[r] = mx * (1.0f / 127.0f);
    }
}
__device__ __forceinline__ void p0_prologue(const Params& P, LAS unsigned char* lds) {
    const int tid = threadIdx.x, bid = blockIdx.x, G = gridDim.x, lane = tid & 63;
    unsigned char* ws = P.ws;
    LAS f16* tl = (LAS f16*)lds;
    {
        constexpr int NI8 = 2 * DFF / 64; const int nI = G > 2 * NI8 ? NI8 : 0;
        if (bid >= G - nI || nI == 0) prep_weight_i8(P, 0, 2 * DFF, ws + WS_WGU1, (float*)(ws + WS_WGU1 + (size_t)2 * DFF * D), nI ? bid - (G - nI) : bid, nI ? nI : G, lds);
        if (bid < G - nI) { int tbase = 0, cursor = bid; __syncthreads();
            prep_weight(P, 1, D, DFF, (f16*)(ws + WS_WD1), cursor, tbase, tl, G - nI);
            prep_weight(P, 2, NIN, D, (f16*)(ws + WS_WIN), cursor, tbase, tl, G - nI); }
    }
    float* ss0 = (float*)(ws + WS_SS0);
    f16* acta = (f16*)(ws + WS_ACTA);
    const int gw = bid * 8 + (tid >> 6), nw = G * 8;
    unsigned char* x8 = ws + WS_US; float* sa0 = (float*)(ws + WS_IQ);
    for (int p = gw; p < L; p += nw) {
        const float* src = p < SEQ ? P.x + (size_t)p * D : P.meta + (size_t)(p - SEQ) * D; float s = 0.f, mx = 0.f; f32x4 v[4];
#pragma unroll
        for (int i = 0; i < 4; ++i) { v[i] = *(const f32x4*)(src + lane * 4 + 256 * i); s += (v[i][0] * v[i][0] + v[i][1] * v[i][1]) + (v[i][2] * v[i][2] + v[i][3] * v[i][3]);
            mx = fmaxf(fmaxf(mx, fmaxf(fabsf(v[i][0]), fabsf(v[i][1]))), fmaxf(fabsf(v[i][2]), fabsf(v[i][3]))); *(half4*)(acta + (size_t)p * D + lane * 4 + 256 * i) = to_half4(v[i]); }
#pragma unroll
        for (int o = 32; o >= 1; o >>= 1) { s += __shfl_xor(s, o); mx = fmaxf(mx, __shfl_xor(mx, o)); }
        const float sc = mx > 0.f ? 127.0f / mx : 0.f;
#pragma unroll
        for (int i = 0; i < 4; ++i) { unsigned word = 0u;
#pragma unroll
            for (int j = 0; j < 4; ++j) word |= ((unsigned)(int)__builtin_rintf(v[i][j] * sc) & 0xffu) << (8 * j);
            *(unsigned*)(x8 + (size_t)p * D + lane * 4 + 256 * i) = word; }
        if (lane == 0) { ss0[p] = s; sa0[p] = mx * (1.0f / 127.0f); }
    }
    const int gt = bid * NTHREADS + tid, ngt = G * NTHREADS;
    for (int i = gt; i < MP; i += ngt) { if (i >= L) { ss0[i] = (float)D; sa0[i] = 0.f; } }
    f32x2* rope = (f32x2*)(ws + WS_ROPE);
    for (int i = gt; i < L * 32; i += ngt) { const int t = i >> 5, f = i & 31; const double inv = exp(-(double)f * (9.210340371976184 / 32.0)); double sn, cs; sincos((double)t * inv, &sn, &cs); rope[i] = (f32x2){(float)cs, (float)sn}; }
}

__device__ __forceinline__ void meta_down(const Params& P, LAS unsigned char* lds) {
    const int tid = threadIdx.x, lane = tid & 63, wid = tid >> 6;
    const f16* Gm = (const f16*)(P.ws + WS_G) + (size_t)SEQ * DFF; const f16* Wt = (const f16*)(P.ws + WS_WD1);
    f16* acta = (f16*)P.out; float* ss1 = (float*)(P.ws + WS_SS1); LAS float* slot = (LAS float*)lds;
    for (int task = blockIdx.x; task < NMETA * 16; task += gridDim.x) {
        const int r = task >> 4, cg = task & 15; float part = 0.f;
#pragma unroll 1
        for (int q = 0; q < 2; ++q) {
            const int n0 = cg * 64 + (2 * wid + q) * 4; float a[4] = {0.f, 0.f, 0.f, 0.f};
            for (int kc = lane; kc < DFF / 8; kc += 64) {
                const half8 gv = *(const half8*)(Gm + (size_t)r * DFF + kc * 8);
#pragma unroll
                for (int j = 0; j < 4; ++j) { const half8 wv = *(const half8*)(Wt + (size_t)(n0 + j) * DFF + kc * 8);
#pragma unroll
                    for (int e = 0; e < 8; ++e) a[j] += (float)gv[e] * (float)wv[e]; }
            }
#pragma unroll
            for (int o = 32; o >= 1; o >>= 1) { a[0] += __shfl_xor(a[0], o); a[1] += __shfl_xor(a[1], o); a[2] += __shfl_xor(a[2], o); a[3] += __shfl_xor(a[3], o); }
            f32x4 o;
#pragma unroll
            for (int j = 0; j < 4; ++j) { o[j] = P.meta[r * D + n0 + j] + 0.5f * a[j]; part += o[j] * o[j]; }
            if (lane == 0) *(half4*)(acta + (size_t)(SEQ + r) * D + n0) = to_half4(o);
        }
        if (lane == 0) slot[wid] = part;
        __syncthreads();
        if (tid == 0) { float s = 0.f; for (int w = 0; w < 8; ++w) s += slot[w]; ss1[(size_t)(SEQ + r) * 16 + cg] = s; }
        __syncthreads();
    }
}

__device__ __forceinline__ float logsigmoid_f(float z) { return fminf(z, 0.f) - __logf(1.0f + __expf(-fabsf(z))); }
__device__ __forceinline__ void gla_gates(const Params& P, int c, int h, LAS float* bl) {
    const int tid = threadIdx.x, ti = tid >> 3, d0 = (tid & 7) * 8, tt = 64 * c - 48 + ti; const float* GA = (const float*)(P.ws + WS_GA);
    {
        float z[8];
        if (tt >= 0 && tt < L) {
            const f32x4 b0 = *(const f32x4*)(P.ba + 64 * h + d0), b1 = *(const f32x4*)(P.ba + 64 * h + d0 + 4);
#pragma unroll
            for (int m = 0; m < 4; ++m) { z[m] = b0[m]; z[4 + m] = b1[m]; }
            f32x4 a4[4];
#pragma unroll
            for (int q = 0; q < 4; ++q) a4[q] = *(const f32x4*)(GA + (size_t)tt * 16 + 4 * q);
#pragma unroll
            for (int r = 0; r < 16; ++r) { const float ar = a4[r >> 2][r & 3]; const f32x4 w0 = *(const f32x4*)(P.wa2 + r * 256 + 64 * h + d0), w1 = *(const f32x4*)(P.wa2 + r * 256 + 64 * h + d0 + 4);
#pragma unroll
                for (int m = 0; m < 4; ++m) { z[m] += ar * w0[m]; z[4 + m] += ar * w1[m]; } }
#pragma unroll
            for (int m = 0; m < 8; ++m) z[m] = logsigmoid_f(z[m]) * (1.0f / 16.0f);
        } else {
#pragma unroll
            for (int m = 0; m < 8; ++m) z[m] = 0.f;
        }
#pragma unroll
        for (int m = 0; m < 8; ++m) bl[ti * 65 + d0 + m] = z[m];
    }
    __syncthreads();
    {
        const int d = tid & 63, seg = tid >> 6; float v[8], run = 0.f;
#pragma unroll
        for (int i = 0; i < 8; ++i) { run += bl[(seg * 8 + i) * 65 + d]; v[i] = run; }
#pragma unroll
        for (int i = 0; i < 8; ++i) bl[(seg * 8 + i) * 65 + d] = v[i];
        __syncthreads();
        float off = 0.f;
#pragma unroll
        for (int sg = 0; sg < 7; ++sg) off += (sg < seg) ? bl[(sg * 8 + 7) * 65 + d] : 0.f;
        __syncthreads();
#pragma unroll
        for (int i = 0; i < 8; ++i) bl[(seg * 8 + i) * 65 + d] = v[i] + off;
    }
    __syncthreads();
}
__device__ __forceinline__ void gla_a_unit(const Params& P, int unit, LAS unsigned char* lds) {
    int tid_ = threadIdx.x; asm volatile("" : "+v"(tid_));
    const int tid = tid_, lane = tid & 63, wid = tid >> 6, c = unit >> 2, h = unit & 3;
    LAS float* bl = (LAS float*)lds; LAS float* ks = bl + 4160; LAS float* vs = ks + 4096;
    const f16* GK = (const f16*)(P.ws + WS_GK); const f16* GV = (const f16*)(P.ws + WS_GV);
    float* U = (float*)(P.ws + WS_US); float* DEC = (float*)(P.ws + WS_DECAY);
    const int ti = tid >> 3, d0 = (tid & 7) * 8, tt = 64 * c - 48 + ti; const bool tv = tt >= 0 && tt < L;
    half8 k8, v8[2];
#pragma unroll
    for (int m = 0; m < 8; ++m) { k8[m] = (f16)0.f; v8[0][m] = (f16)0.f; v8[1][m] = (f16)0.f; }
    if (tv) k8 = *(const half8*)(GK + (size_t)tt * 256 + 64 * h + d0);
#pragma unroll
    for (int q = 0; q < 2; ++q) { const int ch = tid + 512 * q, j = ch >> 4, t = 64 * c - 48 + j; if (t >= 0 && t < L) v8[q] = *(const half8*)(GV + (size_t)t * 512 + 128 * h + (ch & 15) * 8); }
    gla_gates(P, c, h, bl);
    { f32x4 o0, o1;
#pragma unroll
      for (int m = 0; m < 4; ++m) { o0[m] = (float)k8[m] * __expf(bl[63 * 65 + d0 + m] - bl[ti * 65 + d0 + m]); o1[m] = (float)k8[4 + m] * __expf(bl[63 * 65 + d0 + 4 + m] - bl[ti * 65 + d0 + 4 + m]); }
      *(LAS f32x4*)(ks + ti * 64 + d0) = o0; *(LAS f32x4*)(ks + ti * 64 + d0 + 4) = o1; }
#pragma unroll
    for (int q = 0; q < 2; ++q) { const int ch = tid + 512 * q, j = ch >> 4, e0 = (ch & 15) * 8; f32x4 o0, o1;
#pragma unroll
        for (int m = 0; m < 4; ++m) { o0[m] = (float)v8[q][m]; o1[m] = (float)v8[q][4 + m]; }
        *(LAS f32x4*)(vs + j * 128 + e0) = o0; *(LAS f32x4*)(vs + j * 128 + e0 + 4) = o1; }
    if (tid < 64) DEC[(size_t)c * 256 + h * 64 + tid] = __expf(bl[63 * 65 + tid]);
    __syncthreads();
    { const int dd0 = (wid >> 2) * 32, e0 = (wid & 3) * 32, l31 = lane & 31, hf = lane >> 5; f32x16 acc;
#pragma unroll
      for (int i = 0; i < 16; ++i) acc[i] = 0.f;
#pragma unroll 8
      for (int s = 0; s < 32; ++s) acc = __builtin_amdgcn_mfma_f32_32x32x2f32(ks[(2 * s + hf) * 64 + dd0 + l31], vs[(2 * s + hf) * 128 + e0 + l31], acc, 0, 0, 0);
      float* up = U + ((size_t)unit * 64) * 128;
#pragma unroll
      for (int r = 0; r < 16; ++r) { const int row = (r & 3) + 8 * (r >> 2) + 4 * hf; up[(size_t)(dd0 + row) * 128 + e0 + l31] = acc[r]; } }
    __syncthreads();
}
__device__ __forceinline__ void gla_scan(const Params& P) {
    float* U = (float*)(P.ws + WS_US); const float* DEC = (const float*)(P.ws + WS_DECAY);
    const int idx = blockIdx.x * NTHREADS + threadIdx.x;
    if (idx >= 32768) return;
    float s = 0.f;
#pragma unroll 8
    for (int c = 0; c < NCH; ++c) { const float u = U[(size_t)c * 32768 + idx], dc = DEC[(size_t)c * 256 + (idx >> 7)]; U[(size_t)c * 32768 + idx] = s; s = dc * s + u; }
}
__device__ __forceinline__ void gla_c_unit(const Params& P, int unit, LAS unsigned char* lds) {
    int tid_ = threadIdx.x; asm volatile("" : "+v"(tid_));
    const int tid = tid_, lane = tid & 63, wid = tid >> 6, c = unit >> 2, h = unit & 3, l31 = lane & 31, hf = lane >> 5;
    LAS float* bl = (LAS float*)lds; LAS float* kk = bl + 4160; LAS float* qs = kk + 4160; LAS float* As = qs + 4160; LAS float* vs = As + 4160; LAS float* Ss = vs + 8192; LAS float* os = bl;
    const f16* GQ = (const f16*)(P.ws + WS_GQ); const f16* GK = (const f16*)(P.ws + WS_GK); const f16* GV = (const f16*)(P.ws + WS_GV); const f16* GR = (const f16*)(P.ws + WS_GR);
    const float* Sg = (const float*)(P.ws + WS_US) + (size_t)unit * 8192; f16* mix = (f16*)(P.ws + WS_ACTA);
    const int ti = tid >> 3, d0 = (tid & 7) * 8, tt = 64 * c - 48 + ti; const bool tv = tt >= 0 && tt < L;
    half8 q8, k8, v8[2], r8[2]; f32x4 sreg[4];
#pragma unroll
    for (int m = 0; m < 8; ++m) { q8[m] = (f16)0.f; k8[m] = (f16)0.f; v8[0][m] = (f16)0.f; v8[1][m] = (f16)0.f; r8[0][m] = (f16)0.f; r8[1][m] = (f16)0.f; }
    if (tv) { q8 = *(const half8*)(GQ + (size_t)tt * 256 + 64 * h + d0); k8 = *(const half8*)(GK + (size_t)tt * 256 + 64 * h + d0);
        r8[0] = *(const half8*)(GR + (size_t)tt * 512 + 128 * h + (tid & 7) * 16); r8[1] = *(const half8*)(GR + (size_t)tt * 512 + 128 * h + (tid & 7) * 16 + 8); }
#pragma unroll
    for (int q = 0; q < 2; ++q) { const int ch = tid + 512 * q, j = ch >> 4, t = 64 * c - 48 + j; if (t >= 0 && t < L) v8[q] = *(const half8*)(GV + (size_t)t * 512 + 128 * h + (ch & 15) * 8); }
#pragma unroll
    for (int q = 0; q < 4; ++q) sreg[q] = *(const f32x4*)(Sg + (size_t)(tid + 512 * q) * 4);
    gla_gates(P, c, h, bl);
#pragma unroll
    for (int m = 0; m < 8; ++m) { const float bv = bl[ti * 65 + d0 + m]; qs[ti * 65 + d0 + m] = (float)q8[m] * 0.125f * __expf(bv); kk[ti * 65 + d0 + m] = (float)k8[m] * __expf(-bv); }
#pragma unroll
    for (int q = 0; q < 2; ++q) { const int ch = tid + 512 * q, j = ch >> 4, e0 = (ch & 15) * 8; f32x4 o0, o1;
#pragma unroll
        for (int m = 0; m < 4; ++m) { o0[m] = (float)v8[q][m]; o1[m] = (float)v8[q][4 + m]; }
        *(LAS f32x4*)(vs + j * 128 + e0) = o0; *(LAS f32x4*)(vs + j * 128 + e0 + 4) = o1; }
#pragma unroll
    for (int q = 0; q < 4; ++q) *(LAS f32x4*)(Ss + (tid + 512 * q) * 4) = sreg[q];
    __syncthreads();
    if (wid < 4) { const int i0 = (wid >> 1) * 32, j0 = (wid & 1) * 32; f32x16 acc;
#pragma unroll
        for (int i = 0; i < 16; ++i) acc[i] = 0.f;
#pragma unroll 8
        for (int s = 0; s < 32; ++s) acc = __builtin_amdgcn_mfma_f32_32x32x2f32(qs[(i0 + l31) * 65 + 2 * s + hf], kk[(j0 + l31) * 65 + 2 * s + hf], acc, 0, 0, 0);
#pragma unroll
        for (int r = 0; r < 16; ++r) { const int i = i0 + (r & 3) + 8 * (r >> 2) + 4 * hf, j = j0 + l31; As[i * 65 + j] = (j <= i) ? acc[r] : 0.f; } }
    __syncthreads();
    { const int i0 = (wid >> 2) * 32, e0 = (wid & 3) * 32; f32x16 acc;
#pragma unroll
      for (int i = 0; i < 16; ++i) acc[i] = 0.f;
#pragma unroll 8
      for (int s = 0; s < 32; ++s) acc = __builtin_amdgcn_mfma_f32_32x32x2f32(qs[(i0 + l31) * 65 + 2 * s + hf], Ss[(2 * s + hf) * 128 + e0 + l31], acc, 0, 0, 0);
#pragma unroll 8
      for (int s = 0; s < 32; ++s) acc = __builtin_amdgcn_mfma_f32_32x32x2f32(As[(i0 + l31) * 65 + 2 * s + hf], vs[(2 * s + hf) * 128 + e0 + l31], acc, 0, 0, 0);
#pragma unroll
      for (int r = 0; r < 16; ++r) { const int i = i0 + (r & 3) + 8 * (r >> 2) + 4 * hf; os[i * 129 + e0 + l31] = acc[r]; } }
    __syncthreads();
    { const int e0 = (tid & 7) * 16; float o[16], sq = 0.f;
#pragma unroll
      for (int j = 0; j < 16; ++j) { o[j] = os[ti * 129 + e0 + j]; sq += o[j] * o[j]; }
      sq += __shfl_xor(sq, 1); sq += __shfl_xor(sq, 2); sq += __shfl_xor(sq, 4);
      const float rs = rsqrtf(sq * (1.0f / 128.0f) + EPS);
      if (tt >= NMETA && tt < L) { half8 w0, w1;
#pragma unroll
          for (int j = 0; j < 8; ++j) { w0[j] = (f16)(o[j] * rs * P.hn[e0 + j] * silu_f((float)r8[0][j])); w1[j] = (f16)(o[8 + j] * rs * P.hn[e0 + 8 + j] * silu_f((float)r8[1][j])); }
          f16* dst = mix + (size_t)(tt - NMETA) * D + 128 * h + e0; *(half8*)dst = w0; *(half8*)(dst + 8) = w1; } }
    __syncthreads();
}

__device__ __forceinline__ unsigned mono_u(float f) { const unsigned u = __float_as_uint(f); return (u & 0x80000000u) ? ~u : (u | 0x80000000u); }
__device__ __forceinline__ float unmono_f(unsigned m) { return __uint_as_float((m & 0x80000000u) ? (m & 0x7fffffffu) : ~m); }
__device__ __forceinline__ unsigned wave_umax(unsigned v) {
    v = max(v, (unsigned)__builtin_amdgcn_update_dpp(0, (int)v, 0x111, 0xf, 0xf, false));
    v = max(v, (unsigned)__builtin_amdgcn_update_dpp(0, (int)v, 0x112, 0xf, 0xf, false));
    v = max(v, (unsigned)__builtin_amdgcn_update_dpp(0, (int)v, 0x114, 0xf, 0xf, false));
    v = max(v, (unsigned)__builtin_amdgcn_update_dpp(0, (int)v, 0x118, 0xf, 0xf, false));
    v = max(v, (unsigned)__builtin_amdgcn_update_dpp(0, (int)v, 0x142, 0xa, 0xf, false));
    v = max(v, (unsigned)__builtin_amdgcn_update_dpp(0, (int)v, 0x143, 0xc, 0xf, false));
    return (unsigned)__builtin_amdgcn_readlane((int)v, 63);
}
__device__ __forceinline__ int half_scan_incl(int v) {
    v += __builtin_amdgcn_update_dpp(0, v, 0x111, 0xf, 0xf, true);
    v += __builtin_amdgcn_update_dpp(0, v, 0x112, 0xf, 0xf, true);
    v += __builtin_amdgcn_update_dpp(0, v, 0x114, 0xf, 0xf, true);
    v += __builtin_amdgcn_update_dpp(0, v, 0x118, 0xf, 0xf, true);
    v += __builtin_amdgcn_update_dpp(0, v, 0x142, 0xa, 0xf, true);
    return v;
}
constexpr int CAP = 640, NPL = CAP / 64;
__device__ __forceinline__ int topk_compact(LAS float* cs, LAS unsigned short* ci, int n, bool exact, float& tau_out, int lane) {
    float sv[NPL]; unsigned iv[NPL], u[NPL];
#pragma unroll
    for (int i = 0; i < NPL; ++i) { const int p = lane + 64 * i; const bool v = p < n; sv[i] = v ? cs[p] : 0.f; iv[i] = v ? (unsigned)ci[p] : 0xffffu; u[i] = v ? mono_u(sv[i]) : 0u; }
    unsigned T = 0u; bool full = true; int hb = 31;
    {
        unsigned umx = 0u, umn = 0xffffffffu;
#pragma unroll
        for (int i = 0; i < NPL; ++i) { umx = max(umx, u[i]); umn = min(umn, (lane + 64 * i < n) ? u[i] : 0xffffffffu); }
        umx = wave_umax(umx); umn = ~wave_umax(~umn);
        const unsigned df = umx ^ umn;
        if (df == 0u) { hb = -1; T = umx; } else { hb = 31 - __clz(df); T = (hb == 31) ? 0u : (umx & ~((2u << hb) - 1u)); }
    }
#pragma unroll 1
    for (int bit = hb; bit >= 0; --bit) {
        const unsigned cand = T | (1u << bit); int cgt = 0;
#pragma unroll
        for (int i = 0; i < NPL; ++i) cgt += __popcll(__ballot(u[i] >= cand));
        if (cgt >= 256) { T = cand; if (cgt <= (exact ? 256 : 272)) { full = false; break; } }
    }
    bool keep[NPL];
    if (full) {
        int cgt = 0;
#pragma unroll
        for (int i = 0; i < NPL; ++i) cgt += __popcll(__ballot(u[i] > T));
        const int need = 256 - cgt; unsigned I = 0xffffu; int nties = 0;
#pragma unroll
        for (int i = 0; i < NPL; ++i) nties += __popcll(__ballot(u[i] == T));
        if (nties != need) { I = 0u;
#pragma unroll 1
        for (int bit = 15; bit >= 0; --bit) { const unsigned cand = I | (1u << bit); int cl = 0;
#pragma unroll
            for (int i = 0; i < NPL; ++i) cl += __popcll(__ballot(u[i] == T && iv[i] < cand));
            if (cl < need) I = cand; } }
#pragma unroll
        for (int i = 0; i < NPL; ++i) keep[i] = (u[i] > T) || (u[i] == T && iv[i] <= I);
    } else {
#pragma unroll
        for (int i = 0; i < NPL; ++i) keep[i] = u[i] >= T;
    }
    int nn = 0;
#pragma unroll
    for (int i = 0; i < NPL; ++i) { const unsigned long long m = __ballot(keep[i]); const int pre = __builtin_amdgcn_mbcnt_hi((unsigned)(m >> 32), __builtin_amdgcn_mbcnt_lo((unsigned)m, 0u));
        if (keep[i]) { cs[nn + pre] = sv[i]; ci[nn + pre] = (unsigned short)iv[i]; } nn += __popcll(m); }
    tau_out = unmono_f(T);
    return nn;
}
__device__ __forceinline__ float relu_asm(float x) { return __int_as_float(max(__float_as_int(x), 0)); }
__device__ __forceinline__ void indexer_tile(const Params& P, int tile, LAS unsigned char* lds) {
    int tid_ = threadIdx.x; asm volatile("" : "+v"(tid_));
    const int tid = tid_, lane = tid & 63, wid = __builtin_amdgcn_readfirstlane(tid >> 6), l31 = lane & 31, hf = lane >> 5;
    LAS float* candS = (LAS float*)lds;
    LAS unsigned short* candI = (LAS unsigned short*)(lds + 32 * CAP * 4);
    LAS unsigned char* kbuf = lds + 32 * CAP * 6;
    LAS int* lflag = (LAS int*)(lds + LDS_BYTES - 1024 + 192);
    const f16* IQ = (const f16*)(P.ws + WS_IQ); const f16* IK = (const f16*)(P.ws + WS_IK); const float* IW = (const float*)(P.ws + WS_IW);
    unsigned short* SEL = (unsigned short*)(P.ws + WS_SEL);
    const int t0 = tile * 32, tw = t0 + wid * 4;
    half8 afr[4];
    { const int qi = 2 * (l31 >> 4) + ((l31 >> 2) & 1), hd = 4 * ((l31 >> 3) & 1) + (l31 & 3); int tq = tw + qi; if (tq > L - 1) tq = L - 1;
      const half8* ap = (const half8*)(IQ + (size_t)tq * 512 + hd * 64);
#pragma unroll
      for (int s = 0; s < 4; ++s) afr[s] = ap[2 * s + hf]; }
    float w0[8], w1[8];
    { int ta = tw + hf, tb = tw + 2 + hf; if (ta > L - 1) ta = L - 1; if (tb > L - 1) tb = L - 1;
#pragma unroll
      for (int h = 0; h < 8; ++h) { w0[h] = IW[(size_t)ta * 8 + h]; w1[h] = IW[(size_t)tb * 8 + h]; } }
    asm volatile("" :: "v"(afr[0]), "v"(afr[1]), "v"(afr[2]), "v"(afr[3]));
    asm volatile("" :: "v"(w0[0]), "v"(w0[1]), "v"(w0[2]), "v"(w0[3]), "v"(w0[4]), "v"(w0[5]), "v"(w0[6]), "v"(w0[7]));
    asm volatile("" :: "v"(w1[0]), "v"(w1[1]), "v"(w1[2]), "v"(w1[3]), "v"(w1[4]), "v"(w1[5]), "v"(w1[6]), "v"(w1[7]));
    const int tq0 = (tw + hf < L) ? tw + hf : -1, tq1 = (tw + 2 + hf < L) ? tw + 2 + hf : -1;
    float tau0 = -__builtin_inff(), tau1 = -__builtin_inff();
    int cq0 = 0, cq1 = 0, cq2 = 0, cq3 = 0;
    if (tid < 3) lflag[tid] = 0;
    const int nkeys = (t0 + 32 < L) ? t0 + 32 : L, nst = (nkeys + 127) >> 7;
    u32x4 stg[2];
    const u32x4* IKv = (const u32x4*)IK;
#pragma unroll
    for (int i = 0; i < 2; ++i) stg[i] = IKv[(size_t)0 * 1024 + tid + 512 * i];
#pragma unroll
    for (int i = 0; i < 2; ++i) { const int ci = tid + 512 * i, row = ci >> 3, ch = ci & 7; *(LAS u32x4*)(kbuf + row * 128 + ((ch ^ ((row >> 1) & 7)) << 4)) = stg[i]; }
    __syncthreads();
#pragma unroll 1
    for (int st = 0; st < nst; ++st) {
        LAS unsigned char* kb = kbuf + (st & 1) * 16384;
        if (st + 1 < nst) {
#pragma unroll
            for (int i = 0; i < 2; ++i) stg[i] = IKv[(size_t)(st + 1) * 1024 + tid + 512 * i];
        }
        if (st * 128 <= tw + 3) {
            f32x16 acc[4];
#pragma unroll
            for (int c = 0; c < 4; ++c) {
#pragma unroll
                for (int i = 0; i < 16; ++i) acc[c][i] = 0.f;
            }
#pragma unroll
            for (int s = 0; s < 4; ++s) {
#pragma unroll
                for (int c = 0; c < 4; ++c) { const int row = c * 32 + l31; const half8 bf = *(const LAS half8*)(kb + row * 128 + (((2 * s + hf) ^ ((row >> 1) & 7)) << 4)); acc[c] = __builtin_amdgcn_mfma_f32_32x32x16_f16(afr[s], bf, acc[c], 0, 0, 0); }
            }
            float sc[8]; bool ok[8]; int na = 0, nb = 0;
#pragma unroll
            for (int c = 0; c < 4; ++c) {
                float s0 = 0.f, s1 = 0.f;
#pragma unroll
                for (int h = 0; h < 8; ++h) { const float r0 = relu_asm(acc[c][h]), r1 = relu_asm(acc[c][8 + h]);
                    asm("v_fmac_f32 %0, %1, %2" : "+v"(s0) : "v"(w0[h]), "v"(r0)); asm("v_fmac_f32 %0, %1, %2" : "+v"(s1) : "v"(w1[h]), "v"(r1)); }
                const int key = st * 128 + c * 32 + l31;
                sc[2 * c] = s0; sc[2 * c + 1] = s1; ok[2 * c] = key <= tq0 && s0 > tau0; ok[2 * c + 1] = key <= tq1 && s1 > tau1;
                na += ok[2 * c] ? 1 : 0; nb += ok[2 * c + 1] ? 1 : 0;
            }
            const int ia = half_scan_incl(na), ib = half_scan_incl(nb);
            const int ta0 = __builtin_amdgcn_readlane(ia, 31), ta1 = __builtin_amdgcn_readlane(ia, 63), tb0 = __builtin_amdgcn_readlane(ib, 31), tb1 = __builtin_amdgcn_readlane(ib, 63);
            int pa = (hf ? cq1 : cq0) + ia - na, pb = (hf ? cq3 : cq2) + ib - nb;
            cq0 += ta0; cq1 += ta1; cq2 += tb0; cq3 += tb1;
            pa += (wid * 4 + hf) * CAP; pb += (wid * 4 + 2 + hf) * CAP;
            const int dmy = 32 * CAP * 6 / 4 + 2 * 16384 / 4 + 64 + lane;
#pragma unroll
            for (int c = 0; c < 4; ++c) {
                const unsigned short key = (unsigned short)(st * 128 + c * 32 + l31);
                { const bool k0 = ok[2 * c]; LAS float* ps = k0 ? candS + pa : candS + dmy; LAS unsigned short* pi = k0 ? candI + pa : (LAS unsigned short*)(candS + dmy + 64); *ps = sc[2 * c]; *pi = key; pa += k0 ? 1 : 0; }
                { const bool k1 = ok[2 * c + 1]; LAS float* ps = k1 ? candS + pb : candS + dmy; LAS unsigned short* pi = k1 ? candI + pb : (LAS unsigned short*)(candS + dmy + 64); *ps = sc[2 * c + 1]; *pi = key; pb += k1 ? 1 : 0; }
            }
        }
        if (st + 1 < nst) {
            LAS unsigned char* kn = kbuf + ((st + 1) & 1) * 16384;
#pragma unroll
            for (int i = 0; i < 2; ++i) { const int ci = tid + 512 * i, row = ci >> 3, ch = ci & 7; *(LAS u32x4*)(kn + row * 128 + ((ch ^ ((row >> 1) & 7)) << 4)) = stg[i]; }
        }
        const int mx = max(max(cq0, cq1), max(cq2, cq3));
        if (mx > CAP - 128 && lane == 0) lflag[st % 3] = 1;
        if (tid == 0) lflag[(st + 1) % 3] = 0;
        __syncthreads();
        const int any = lflag[st % 3];
        if (any) {
#pragma unroll 1
            for (int qq = 0; qq < 4; ++qq) { const int n = qq == 0 ? cq0 : (qq == 1 ? cq1 : (qq == 2 ? cq2 : cq3));
                if (n > 288) { float nt; const int nn = topk_compact(candS + (wid * 4 + qq) * CAP, candI + (wid * 4 + qq) * CAP, n, false, nt, lane);
                    if (qq == 0) cq0 = nn; else if (qq == 1) cq1 = nn; else if (qq == 2) cq2 = nn; else cq3 = nn;
                    if (hf == (qq & 1)) { if (qq < 2) tau0 = nt; else tau1 = nt; } } }
        }
    }
#pragma unroll 1
    for (int qq = 0; qq < 4; ++qq) {
        const int t = tw + qq; if (t >= L) break;
        int n = qq == 0 ? cq0 : (qq == 1 ? cq1 : (qq == 2 ? cq2 : cq3)); LAS float* cs = candS + (wid * 4 + qq) * CAP; LAS unsigned short* ci = candI + (wid * 4 + qq) * CAP;
        if (n > 256) { float nt; n = topk_compact(cs, ci, n, true, nt, lane); }
#pragma unroll
        for (int j = 0; j < 4; ++j) { const int p = lane + 64 * j; SEL[(size_t)t * 256 + (p & 15) * 16 + (p >> 4)] = p < n ? ci[p] : (unsigned short)0xffffu; }
    }
    __syncthreads();
}

__device__ __forceinline__ void sparse_attn(const Params& P, LAS unsigned char* lds, int vbid) {
    int tid_ = threadIdx.x; asm volatile("" : "+v"(tid_));
    const int tid = tid_, lane = tid & 63, wid = tid >> 6, grp = lane >> 2, c4 = lane & 3;
    const int head = vbid & 7, slot = (vbid >> 3) * 8 + wid, nslot = (gridDim.x >> 3) * 8;
    typedef _Float16 half2v __attribute__((ext_vector_type(2)));
    LAS float* red = (LAS float*)(lds + 4096 + wid * 4352);
    const unsigned short* SEL = (const unsigned short*)(P.ws + WS_SEL);
    const unsigned char* Q8 = P.ws + WS_DQ + head * 64 + c4 * 16; const float* QS = (const float*)(P.ws + WS_DQ + (size_t)LP * 512) + head;
    const unsigned char* kvh = P.ws + WS_KV + (size_t)head * LP * 128; f16* mix = (f16*)(P.ws + WS_ACTA);
    int t = NMETA + slot;
    int tlim = L, textra = -1;
    if (gridDim.x == 256 && head < 4) { if (slot < 8) tlim = NMETA + 256 * 60; else if (slot < 40) textra = NMETA + ((slot - 8) & 7) + 256 * (60 + ((slot - 8) >> 3)); }
#define NEXT_T(tc) ((tc) == textra ? -1 : ((tc) + nslot < tlim ? (tc) + nslot : textra))
    u32x4 sela = {0u, 0u, 0u, 0u}, selb = {0u, 0u, 0u, 0u}, q8 = {0u, 0u, 0u, 0u}; float lscale = 0.f;
    if (t < L) { sela = *(const u32x4*)(SEL + (size_t)t * 256 + grp * 16); selb = *(const u32x4*)(SEL + (size_t)t * 256 + grp * 16 + 8); q8 = *(const u32x4*)(Q8 + (size_t)t * 512); lscale = QS[(size_t)t * 8]; }
#define ATTN_ITEM(ALLV) do { \
        unsigned keys[16]; u32x4 kreg[16], vreg[16]; \
        _Pragma("unroll") for (int it = 0; it < 16; ++it) { const unsigned w = it < 8 ? sela[it >> 1] : selb[(it - 8) >> 1]; keys[it] = (it & 1) ? (w >> 16) : (w & 0xffffu); } \
        _Pragma("unroll") for (int it = 0; it < 16; ++it) { const unsigned kk = (ALLV || keys[it] != 0xffffu) ? keys[it] : 0u; kreg[it] = *(const u32x4*)(kvh + (size_t)kk * 128 + c4 * 16); } \
        _Pragma("unroll") for (int it = 0; it < 16; ++it) { const unsigned kk = (ALLV || keys[it] != 0xffffu) ? keys[it] : 0u; vreg[it] = *(const u32x4*)(kvh + (size_t)kk * 128 + 64 + c4 * 16); } \
        const u32x4 qc = q8; const float ls = lscale; \
        { const int tn = NEXT_T(t);     \
          if (tn >= 0) { sela = *(const u32x4*)(SEL + (size_t)tn * 256 + grp * 16); selb = *(const u32x4*)(SEL + (size_t)tn * 256 + grp * 16 + 8); q8 = *(const u32x4*)(Q8 + (size_t)tn * 512); lscale = QS[(size_t)tn * 8]; } } \
        float lg[16]; float mx = -__builtin_inff(); \
        _Pragma("unroll") for (int it = 0; it < 16; ++it) { \
            int ai = 0; \
            _Pragma("unroll") for (int w = 0; w < 4; ++w) ai = __builtin_amdgcn_sdot4((int)kreg[it][w], (int)qc[w], ai, false); \
            ai += __builtin_amdgcn_update_dpp(0, ai, 0xB1, 0xf, 0xf, true);     \
            ai += __builtin_amdgcn_update_dpp(0, ai, 0x4E, 0xf, 0xf, true);     \
            lg[it] = (ALLV || keys[it] != 0xffffu) ? (float)ai * ls : -__builtin_inff(); mx = fmaxf(mx, lg[it]); } \
        mx = fmaxf(mx, __shfl_xor(mx, 4)); mx = fmaxf(mx, __shfl_xor(mx, 8)); mx = fmaxf(mx, __shfl_xor(mx, 16)); mx = fmaxf(mx, __shfl_xor(mx, 32)); \
        half2v o2[8]; float lsum = 0.f; \
        _Pragma("unroll") for (int e = 0; e < 8; ++e) o2[e] = (half2v){(f16)0.f, (f16)0.f}; \
        _Pragma("unroll") for (int it = 0; it < 16; ++it) { \
            const float p = __expf(lg[it] - mx); lsum += p; const f16 ph = (f16)p; const half2v p2 = {ph, ph}; \
            _Pragma("unroll") for (int w = 0; w < 4; ++w) {     \
                const half2v v01 = __builtin_bit_cast(half2v, __builtin_amdgcn_perm(0u, vreg[it][w], 0x010c000cu)), v23 = __builtin_bit_cast(half2v, __builtin_amdgcn_perm(0u, vreg[it][w], 0x030c020cu)); \
                o2[2 * w] = p2 * v01 + o2[2 * w]; o2[2 * w + 1] = p2 * v23 + o2[2 * w + 1]; } } \
        lsum += __shfl_xor(lsum, 4); lsum += __shfl_xor(lsum, 8); lsum += __shfl_xor(lsum, 16); lsum += __shfl_xor(lsum, 32); \
          \
        _Pragma("unroll") for (int e = 0; e < 8; ++e) { red[lane * 17 + 2 * e] = (float)o2[e][0]; red[lane * 17 + 2 * e + 1] = (float)o2[e][1]; } \
        float acc = 0.f; \
        { const int cc = lane >> 4, e = lane & 15; \
          _Pragma("unroll") for (int g = 0; g < 16; ++g) acc += red[(g * 4 + cc) * 17 + e]; } \
        mix[(size_t)(t - NMETA) * D + 512 + head * 64 + lane] = (f16)(acc * __builtin_amdgcn_rcpf(lsum)); \
    } while (0)
#pragma unroll 1
    for (; t >= 0 && t < L; t = NEXT_T(t)) {
        if (t >= 255) ATTN_ITEM(true);
        else ATTN_ITEM(false);
    }
#undef ATTN_ITEM
#undef NEXT_T
    __syncthreads();
}

__device__ __forceinline__ void final_norm(const Params& P) {
    const int tid = threadIdx.x, lane = tid & 63, gw = blockIdx.x * 8 + (tid >> 6), nw = gridDim.x * 8;
    const float* ss3 = (const float*)(P.ws + WS_SS3); const f16* h3 = (const f16*)(P.ws + WS_ACTA);
    for (int r = gw; r < SEQ; r += nw) { const float rs = row_rstd(ss3, 16, r);
#pragma unroll
        for (int i = 0; i < 2; ++i) { const int k = lane * 8 + 512 * i; const half8 v = *(const half8*)(h3 + (size_t)r * D + k); const f32x4 g0 = *(const f32x4*)(P.nf + k), g1 = *(const f32x4*)(P.nf + k + 4); f32x4 o0, o1;
#pragma unroll
            for (int j = 0; j < 4; ++j) { o0[j] = (float)v[j] * rs * g0[j]; o1[j] = (float)v[4 + j] * rs * g1[j]; }
            *(f32x4*)(P.out + (size_t)r * D + k) = o0; *(f32x4*)(P.out + (size_t)r * D + k + 4) = o1; } }
}

#define XB_TMO      128
#define XB_XCNT(j)  (256  + 64 * (j))
#define XB_XSUB(j)  (1280 + 64 * (j))
#define XB_XGEN(j)  (2304 + 64 * (j))
#define XB_TOP      3328
#define XB_TOPGEN   3392
#define XCD_BAR_WORDS 3456
#define XB_SPIN_CAP (1u << 22)
__device__ __forceinline__ unsigned xb_ld(unsigned* p)              { return __hip_atomic_load(p, __ATOMIC_RELAXED, __HIP_MEMORY_SCOPE_AGENT); }
__device__ __forceinline__ unsigned xb_add(unsigned* p, unsigned v) { return __hip_atomic_fetch_add(p, v, __ATOMIC_RELAXED, __HIP_MEMORY_SCOPE_AGENT); }
__device__ __forceinline__ unsigned xb_xcc_id() { return (unsigned)__builtin_amdgcn_s_getreg((3 << 11) | 20) & 0xFu; }
#define XB_SPIN(cond, bar) do { unsigned _sp = 0; while (cond) { __builtin_amdgcn_s_sleep(1); \
    if ((++_sp & 255u) == 0u) { if (xb_ld(&(bar)[XB_TMO])) break; if (_sp > XB_SPIN_CAP) { atomicAdd(&(bar)[XB_TMO], 1u); break; } } } } while (0)
struct XcdBarrier { unsigned* bar; unsigned x; volatile LAS unsigned* st; };
__device__ __forceinline__ XcdBarrier xcd_barrier_post(unsigned* bar, volatile LAS unsigned* st) {
    XcdBarrier b; b.bar = bar; b.x = xb_xcc_id(); b.st = st;
    if (threadIdx.x == 0) (void)xb_add(&bar[XB_XCNT(b.x)], 1u);
    return b;
}
__device__ __forceinline__ void xcd_barrier_complete(unsigned* bar, unsigned x, unsigned& nloc, unsigned& nx) {
    const unsigned G = gridDim.x * gridDim.y * gridDim.z;
    unsigned sum, cnt, mine, sp = 0u;
    for (;;) {
        sum = 0u; cnt = 0u; mine = 0u;
#pragma unroll
        for (unsigned j = 0; j < 16; ++j) { const unsigned c = xb_ld(&bar[XB_XCNT(j)]); sum += c; cnt += (c > 0u) ? 1u : 0u; mine = (j == x) ? c : mine; }
        if (sum == G) break;
        __builtin_amdgcn_s_sleep(1);
        if ((++sp & 255u) == 0u) { if (xb_ld(&bar[XB_TMO])) break; if (sp > XB_SPIN_CAP) { atomicAdd(&bar[XB_TMO], 1u); break; } }
    }
    nloc = mine > 0u ? mine : 1u; nx = cnt > 0u ? cnt : 1u;
}
__device__ __forceinline__ void xcd_barrier(const XcdBarrier& b) {
    asm volatile("s_waitcnt vmcnt(0)" ::: "memory");
    __syncthreads();
    if (threadIdx.x == 0) {
        unsigned* bar = b.bar;
        __builtin_amdgcn_s_waitcnt(0);
        unsigned nloc = b.st[0], nx = b.st[1];
        if (nloc == 0u) { xcd_barrier_complete(bar, b.x, nloc, nx); b.st[0] = nloc; b.st[1] = nx; }
        const unsigned old = xb_add(&bar[XB_XSUB(b.x)], 1u);
        const unsigned gen = old / nloc;
        if (old + 1u == (gen + 1u) * nloc) {
            __builtin_amdgcn_fence(__ATOMIC_RELEASE, "agent");
            asm volatile("s_waitcnt vmcnt(0)" ::: "memory");
            const unsigned og = xb_add(&bar[XB_TOP], 1u);
            const unsigned tg = og / nx;
            if (og + 1u == (tg + 1u) * nx) xb_add(&bar[XB_TOPGEN], 1u);
            else XB_SPIN(xb_ld(&bar[XB_TOPGEN]) == tg, bar);
            __builtin_amdgcn_fence(__ATOMIC_ACQUIRE, "agent");
            xb_add(&bar[XB_XGEN(b.x)], 1u);
            asm volatile("s_waitcnt vmcnt(0)" ::: "memory");
        } else {
            XB_SPIN(xb_ld(&bar[XB_XGEN(b.x)]) == gen, bar);
            __builtin_amdgcn_fence(__ATOMIC_ACQUIRE, "agent");
            asm volatile("s_waitcnt vmcnt(0)" ::: "memory");
        }
    }
    __syncthreads();
}

__global__ void __launch_bounds__(NTHREADS, 2) fwd_kernel(Params P) {
    __shared__ __attribute__((aligned(16))) unsigned char lds_raw[LDS_BYTES];
    LAS unsigned char* lds = (LAS unsigned char*)lds_raw;
    const int tid = threadIdx.x, bid = blockIdx.x, G = gridDim.x;
    unsigned char* ws = P.ws;
    const int lo = P.ph_lo, hi = P.ph_hi;
#ifndef ONLY_PHASE
#define ONLY_PHASE -1
#endif
#define IN(k) ((ONLY_PHASE < 0 || ONLY_PHASE == (k)) && lo <= (k) && (k) < hi)
#define SEAM(k) do { if (IN(k) && IN((k) + 1)) { xcd_barrier(xbar); } } while (0)
    XcdBarrier xbar; xbar.bar = (unsigned*)(ws + WS_BAR); xbar.x = 0; xbar.st = (volatile LAS unsigned*)(lds + LDS_BYTES - 1024 + 16);
    if (hi - lo > 1) {
        if (tid == 0) { xbar.st[0] = 0u; xbar.st[1] = 0u; }
        __syncthreads();
        xbar = xcd_barrier_post((unsigned*)(ws + WS_BAR), (volatile LAS unsigned*)(lds + LDS_BYTES - 1024 + 16));
    }
    LAS int* misc = (LAS int*)(lds + LDS_BYTES - 1024);
    if (hi - lo > 1) {
        if (tid == 0) { const unsigned xcc = xb_xcc_id() & 7u; misc[8] = (int)xcc; misc[9] = (int)xb_add((unsigned*)(ws + WS_CTL) + 32 + 32 * xcc, 1u); }
    }
    int vbid = bid;
    f16* acta = (f16*)(ws + WS_ACTA); f16* Gb = (f16*)(ws + WS_G);
    float* ss0 = (float*)(ws + WS_SS0); float* ss1 = (float*)(ws + WS_SS1); float* ss2 = (float*)(ws + WS_SS2); float* ss3 = (float*)(ws + WS_SS3);
    if (IN(0)) { p0_prologue(P, lds); }
    SEAM(0);
    if (hi - lo > 1 && (G & 7) == 0) {
        if (tid == 0) { bool ok = true; for (int j = 0; j < 8; ++j) ok = ok && (xb_ld((unsigned*)(ws + WS_CTL) + 32 + 32 * j) == (unsigned)(G >> 3)); misc[10] = ok ? misc[9] * 8 + misc[8] : bid; }
        __syncthreads();
        vbid = __builtin_amdgcn_readfirstlane(misc[10]);
        __syncthreads();
    }
    if (IN(1)) {
        pg8::Gemm g{(const f16*)(ws + WS_US), (const f16*)(ws + WS_WGU1), MP, 2 * DFF, D / 2}; pg8::StaticOrder S; S.init(MP, 2 * DFF, G, vbid);
        EpiSwiglu<true> E{Gb, ss0, 1, (const float*)(ws + WS_IQ), (const float*)(ws + WS_WGU1 + (size_t)2 * DFF * D)}; pg8::gemm_phase(lds, g, S, E);
    }
    SEAM(1);
    if (IN(2)) {
        meta_down(P, lds);
        pg8::Gemm g{Gb, (const f16*)(ws + WS_WD1), SEQ, D, DFF}; pg8::StaticOrder S; S.init(SEQ, D, G, vbid);
        EpiResid<true> E{acta, (f16*)P.out, ss1, 0.5f}; pg8::gemm_phase(lds, g, S, E);
    }
    SEAM(2);
    if (IN(3)) {
        pg8::Gemm g{(const f16*)P.out, (const f16*)(ws + WS_WIN), MP, NIN, D}; pg8::StaticOrder S; S.init(MP, NIN, G, vbid);
        EpiInProj E{ss1, (const f32x2*)(ws + WS_ROPE), ws};
        pg8::gemm_phase(lds, g, S, E);
    }
    SEAM(3);
    if (IN(4)) {
        for (int u = bid; u < NCH * 4; u += G) gla_a_unit(P, u, lds);
        {
            constexpr int NI8 = 2 * DFF / 64; LAS f16* tl = (LAS f16*)lds;
            if (G > NI8 + 64) {
                if (bid >= G - NI8) prep_weight_i8(P, 4, 2 * DFF, ws + WS_WGU2, (float*)(ws + WS_WGU2 + (size_t)2 * DFF * D), bid - (G - NI8), NI8, lds);
                else if (bid >= 4) { int tbase = 0, cursor = bid - 4;
                    prep_weight(P, 3, D, D, (f16*)(ws + WS_WOUT), cursor, tbase, tl, G - NI8 - 4);
                    prep_weight(P, 5, D, DFF, (f16*)(ws + WS_WD2), cursor, tbase, tl, G - NI8 - 4); }
            } else { int tbase = 0, cursor = bid;
                prep_weight(P, 3, D, D, (f16*)(ws + WS_WOUT), cursor, tbase, tl, G);
                prep_weight(P, 5, D, DFF, (f16*)(ws + WS_WD2), cursor, tbase, tl, G);
                __syncthreads();
                prep_weight_i8(P, 4, 2 * DFF, ws + WS_WGU2, (float*)(ws + WS_WGU2 + (size_t)2 * DFF * D), bid, G, lds); }
        }
    }
    SEAM(4);
    if (IN(5)) {
        if (bid < 64) gla_scan(P);
        unsigned* ctr = (unsigned*)(ws + WS_CTL); LAS int* bc = (LAS int*)(lds + LDS_BYTES - 1024);
        for (;;) {
            if (tid == 0) bc[0] = (int)atomicAdd(ctr, 1u);
            __syncthreads();
            const int k = bc[0];
            __syncthreads();
            if (k >= 513) break;
            indexer_tile(P, 512 - k, lds);
        }
    }
    SEAM(5);
    if (IN(6)) { for (int u = vbid; u < NCH * 4; u += G) gla_c_unit(P, u, lds); sparse_attn(P, lds, vbid); }
    SEAM(6);
    if (IN(7)) {
        pg8::Gemm g{acta, (const f16*)(ws + WS_WOUT), SEQ, D, D}; pg8::StaticOrder S; S.init(SEQ, D, G, vbid);
        EpiResid<true> E{P.out, (f16*)(ws + WS_US), ss2, 1.0f}; pg8::gemm_phase(lds, g, S, E);
    }
    SEAM(7);
    if (IN(8)) quant_rows_i8((const f16*)(ws + WS_US), ws + WS_DQ, (float*)(ws + WS_IQ), SEQ);
    SEAM(8);
    if (IN(9)) {
        pg8::Gemm g{(const f16*)(ws + WS_DQ), (const f16*)(ws + WS_WGU2), SEQ, 2 * DFF, D / 2}; pg8::StaticOrder S; S.init(SEQ, 2 * DFF, G, vbid);
        EpiSwiglu<true> E{Gb, ss2, 16, (const float*)(ws + WS_IQ), (const float*)(ws + WS_WGU2 + (size_t)2 * DFF * D)}; pg8::gemm_phase(lds, g, S, E);
    }
    SEAM(9);
    if (IN(10)) {
        pg8::Gemm g{Gb, (const f16*)(ws + WS_WD2), SEQ, D, DFF}; pg8::StaticOrder S; S.init(SEQ, D, G, vbid);
        EpiResid<true> E{ws + WS_US, acta, ss3, 0.5f}; pg8::gemm_phase(lds, g, S, E);
    }
    SEAM(10);
    if (IN(11)) final_norm(P);
#undef IN
#undef SEAM
}

extern "C" void kernel_launch(void* const* d_in, const int* in_sizes, int n_in, void* d_out, int out_size, void* d_ws, size_t ws_size, hipStream_t stream) {
    static int grid = 0;
    if (grid == 0) {
        if (n_in != 17 || in_sizes[0] != SEQ * D || out_size != SEQ * D || ws_size < WS_END) { fprintf(stderr, "kernel_launch: unexpected shapes (n_in %d, in0 %d, out %d, ws %zu, need %zu)\n", n_in, n_in > 0 ? in_sizes[0] : -1, out_size, ws_size, (size_t)WS_END); grid = -1; return; }
        int dev = 0, cus = 0, per_cu = 0;
        (void)hipGetDevice(&dev); (void)hipDeviceGetAttribute(&cus, hipDeviceAttributeMultiprocessorCount, dev);
        if (hipOccupancyMaxActiveBlocksPerMultiprocessor(&per_cu, (const void*)fwd_kernel, NTHREADS, 0) != hipSuccess || per_cu < 1) { fprintf(stderr, "kernel_launch: occupancy query says %d blocks per CU\n", per_cu); per_cu = 1; }
        (void)hipGetLastError();
        grid = cus;
        if (grid % 8 != 0 || grid < 64) { fprintf(stderr, "kernel_launch: unexpected CU count %d\n", cus); }
    }
    if (grid < 0) return;
    if (hipMemsetAsync((char*)d_ws + WS_CTL, 0, CTL_BYTES, stream) != hipSuccess) { fprintf(stderr, "kernel_launch: memset failed\n"); return; }
    Params p{};
    const float** pp = (const float**)&p;
    for (int i = 0; i < 17; ++i) pp[i] = (const float*)d_in[i];
    p.out = (float*)d_out; p.ws = (unsigned char*)d_ws;
#if MODE == 0
    for (int ph = 0; ph < NPHASE; ++ph) { p.ph_lo = ph; p.ph_hi = ph + 1; hipLaunchKernelGGL(fwd_kernel, dim3(grid), dim3(NTHREADS), 0, stream, p); }
#else
    p.ph_lo = 0; p.ph_hi = NPHASE;
    void* args[] = {&p};
    hipError_t e = hipLaunchCooperativeKernel((const void*)fwd_kernel, dim3(grid), dim3(NTHREADS), args, 0, stream);
    if (e != hipSuccess) fprintf(stderr, "cooperative launch failed: %s (grid %d)\n", hipGetErrorString(e), grid);
#endif
}
```

```cpp
#include <hip/hip_runtime.h>
#include <cstdio>
#include <cstdint>

#ifndef MODE
#define MODE 1
#endif

#define LAS __attribute__((address_space(3)))
typedef _Float16 f16;
typedef _Float16 half8 __attribute__((ext_vector_type(8)));
typedef _Float16 half4 __attribute__((ext_vector_type(4)));
typedef float f32x2 __attribute__((ext_vector_type(2)));
typedef float f32x4 __attribute__((ext_vector_type(4)));
typedef float f32x16 __attribute__((ext_vector_type(16)));
typedef unsigned u32x2 __attribute__((ext_vector_type(2)));
typedef unsigned u32x4 __attribute__((ext_vector_type(4)));
typedef int i32x4 __attribute__((ext_vector_type(4)));

constexpr int D = 1024, SEQ = 16384, NMETA = 16, L = SEQ + NMETA, DFF = 2816;
constexpr int MP = 16640;
constexpr int LP = 16512;
constexpr int NIN = 3840;
constexpr int NCH = 257;
constexpr float EPS = 1e-6f;
constexpr int NTHREADS = 512;
constexpr int LDS_BYTES = 155648 + 1024;
constexpr int NPHASE = 12;

constexpr size_t al256(size_t x) { return (x + 255) & ~(size_t)255; }
constexpr size_t WS_CTL = 0;
constexpr size_t CTL_BYTES = 32768;
constexpr size_t WS_BAR = 2048;
constexpr size_t WS_WGU1 = CTL_BYTES;
constexpr size_t WS_WD1 = WS_WGU1 + (size_t)2 * DFF * D * 2;
constexpr size_t WS_WIN = WS_WD1 + (size_t)D * DFF * 2;
constexpr size_t WS_WOUT = WS_WIN + (size_t)NIN * D * 2;
constexpr size_t WS_WGU2 = WS_WOUT + (size_t)D * D * 2;
constexpr size_t WS_WD2 = WS_WGU2 + (size_t)2 * DFF * D * 2;
constexpr size_t WS_ACTA = WS_WD2 + (size_t)D * DFF * 2;
constexpr size_t WS_G = WS_ACTA + (size_t)MP * D * 2;
constexpr size_t WS_US = WS_G + (size_t)MP * DFF * 2;
constexpr size_t WS_DQ = WS_US + (size_t)NCH * 4 * 64 * 128 * 4;
constexpr size_t WS_IQ = WS_DQ + (size_t)LP * 512 * 2;
constexpr size_t WS_SEL = WS_IQ + (size_t)LP * 512 * 2;
constexpr size_t WS_ROPE = WS_SEL + (size_t)LP * 256 * 2;
constexpr size_t WS_IW = WS_ROPE + al256((size_t)L * 32 * 8);
constexpr size_t WS_GA = WS_IW + (size_t)LP * 8 * 4;
constexpr size_t WS_DECAY = WS_GA + (size_t)LP * 16 * 4;
constexpr size_t WS_SS0 = WS_DECAY + al256((size_t)NCH * 256 * 4);
constexpr size_t WS_SS1 = WS_SS0 + (size_t)MP * 4;
constexpr size_t WS_SS2 = WS_SS1 + (size_t)MP * 64;
constexpr size_t WS_SS3 = WS_SS2 + (size_t)MP * 64;
constexpr size_t WS_END = WS_SS3 + (size_t)MP * 64;
constexpr size_t WS_KV = WS_G;
constexpr size_t WS_GQ = WS_KV + (size_t)8 * LP * 128 * 2;
constexpr size_t WS_GK = WS_GQ + (size_t)LP * 256 * 2;
constexpr size_t WS_GV = WS_GK + (size_t)LP * 256 * 2;
constexpr size_t WS_GR = WS_GV + (size_t)LP * 512 * 2;
constexpr size_t WS_IK = WS_GR + (size_t)LP * 512 * 2;
constexpr size_t WS_ALIAS_END = WS_IK + (size_t)LP * 64 * 2;
static_assert(WS_ALIAS_END <= WS_US, "aliased buffers exceed G");
static_assert(WS_END <= (size_t)256 * 1024 * 1024, "workspace exceeds 256 MiB");
static_assert((size_t)SEQ * D * 2 <= (size_t)NCH * 4 * 64 * 128 * 4, "h2_16 alias");

struct Params {
    const float* x; const float* meta; const float* n1; const float* wg1; const float* wu1; const float* wd1;
    const float* nmix; const float* win; const float* wa2; const float* ba; const float* hn; const float* wout;
    const float* n2; const float* wg2; const float* wu2; const float* wd2; const float* nf;
    float* out; unsigned char* ws; int ph_lo, ph_hi;
};

namespace pg8 {
constexpr int BM = 256, BK = 64, HALF = 128, HTB = HALF * BK * 2, STAGE_BYTES = 8 * HTB, NXCD = 8, WGM = 8;
__host__ __device__ __forceinline__ int lds_byte(int r, int c) { const int st = (r >> 4) * 2 + (c >> 5), rr = r & 15, cc = c & 31, ob = rr * 64 + cc * 2; return st * 1024 + (ob ^ (((ob >> 9) & 1) << 5)); }
__host__ __device__ __forceinline__ int perm32(int rho) { const int n = rho >> 4, i = rho & 15; return 8 * (i >> 2) + 4 * n + (i & 3); }
__host__ __device__ __forceinline__ void stage_rc(int b, int& R, int& C) { const int st = b / 1024, sb = b % 1024, swz = sb ^ (((sb >> 9) & 1) << 5); R = (st >> 1) * 16 + swz / 64; C = (st & 1) * 32 + (swz % 64) / 2; }
struct Unit { int pm, pn; };
struct Gemm { const f16* A; const f16* Bt; int M, N, K; };
struct StaticOrder {
    int nM, nN, nwg, G, c;
    __host__ __device__ void init(int M, int N, int G_, int c_) { nM = M / BM; nN = N / BM; nwg = nM * nN; G = G_; c = c_; }
    __host__ __device__ bool next(int i, Unit& u) const {
        const long Lx = (long)i * G + c; if (Lx >= nwg) return false;
        int wgid = (int)Lx; { const int q = nwg / NXCD, r = nwg % NXCD, xcd = wgid % NXCD, off = wgid / NXCD; wgid = (xcd < r ? xcd * (q + 1) : r * (q + 1) + (xcd - r) * q) + off; }
        const int nig = WGM * nN, gid = wgid / nig, fm = gid * WGM, gsz = (nM - fm) < WGM ? (nM - fm) : WGM;
        u.pm = fm + ((wgid % nig) % gsz); u.pn = (wgid % nig) / gsz; return true;
    }
};
template <class Epi>
__device__ __forceinline__ void gemm_phase(LAS unsigned char* lds, const Gemm g, const StaticOrder& S, const Epi& E) {
    int tid_ = threadIdx.x; asm volatile("" : "+v"(tid_));
    const int tid = tid_, wid = __builtin_amdgcn_readfirstlane(tid >> 6), lane = tid & 63, wr = wid >> 2, wc = wid & 3, fr = lane & 15, fq = lane >> 4;
    const int K = g.K, nt = K / BK;
    unsigned voffA[2], voffB[2];
#pragma unroll
    for (int i = 0; i < 2; ++i) { int R, C; stage_rc(tid * 16 + i * 8192, R, C); const int Rb = (R & ~31) + perm32(R & 31); voffA[i] = (unsigned)(R * K + C) * 2u; voffB[i] = (unsigned)(Rb * K + C) * 2u; }
    const size_t kstep = (size_t)(BK * 2);
    const size_t hstep = (size_t)HALF * K * 2;
    const size_t tstep = 2 * hstep;
    const unsigned ldsw = (unsigned)wid * 1024u;
    const int aoff = lds_byte(wr * 64 + fr, fq * 8), boff = lds_byte(wc * 32 + fr, fq * 8);
#define PG8_SA(b, h) (((b) * 2 + (h)) * HTB)
#define PG8_SB(b, h) ((4 + (b) * 2 + (h)) * HTB)
#define PG8_STAGE(bufoff, gbase, voff) do { _Pragma("unroll") for (int _i = 0; _i < 2; ++_i) \
        __builtin_amdgcn_global_load_lds((const unsigned*)((const char*)(gbase) + (voff)[_i]), (LAS unsigned*)(lds + (bufoff) + ldsw + _i * 8192), 16, 0, 0); } while (0)
#define PG8_LDA(dst, b, h) do { _Pragma("unroll") for (int m = 0; m < 4; ++m) _Pragma("unroll") for (int k = 0; k < 2; ++k) dst[m][k] = *(const LAS half8*)(lds + PG8_SA(b, h) + aoff + m * 2048 + k * 1024); } while (0)
#define PG8_LDB(dst, b, h) do { _Pragma("unroll") for (int n = 0; n < 2; ++n) _Pragma("unroll") for (int k = 0; k < 2; ++k) dst[n][k] = *(const LAS half8*)(lds + PG8_SB(b, h) + boff + n * 2048 + k * 1024); } while (0)
#define PG8_MMA(ai, bj, At, Bt) do { __builtin_amdgcn_s_setprio(1); _Pragma("unroll") for (int m = 0; m < 4; ++m) _Pragma("unroll") for (int n = 0; n < 2; ++n) _Pragma("unroll") for (int k = 0; k < 2; ++k) { \
        if constexpr (Epi::I8) acc[ai][bj][m][n] = __builtin_bit_cast(f32x4, __builtin_amdgcn_mfma_i32_16x16x64_i8(__builtin_bit_cast(i32x4, Bt[n][k]), __builtin_bit_cast(i32x4, At[m][k]), __builtin_bit_cast(i32x4, acc[ai][bj][m][n]), 0, 0, 0)); \
        else acc[ai][bj][m][n] = __builtin_amdgcn_mfma_f32_16x16x32_f16(Bt[n][k], At[m][k], acc[ai][bj][m][n], 0, 0, 0); } __builtin_amdgcn_s_setprio(0); } while (0)
#define PG8_WAIT_V(n) asm volatile("s_waitcnt vmcnt(" #n ")" ::: "memory")
#define PG8_WAIT_L(n) asm volatile("s_waitcnt lgkmcnt(" #n ")" ::: "memory")
#define PG8_BAR __builtin_amdgcn_s_barrier()
#define PG8_SCHED __builtin_amdgcn_sched_barrier(0)
    Unit cur, nxt; int ui = 0;
    if (!S.next(0, cur)) return;
    f32x4 acc[2][2][4][2];
#pragma unroll
    for (int a = 0; a < 2; ++a)
#pragma unroll
        for (int b = 0; b < 2; ++b)
#pragma unroll
            for (int m = 0; m < 4; ++m)
#pragma unroll
                for (int n = 0; n < 2; ++n) acc[a][b][m][n] = (f32x4){0.f, 0.f, 0.f, 0.f};
    half8 At[4][2], B0[2][2], B1[2][2];
    const char* cA = (const char*)g.A + (size_t)cur.pm * tstep; const char* cB = (const char*)g.Bt + (size_t)cur.pn * tstep;
    PG8_STAGE(PG8_SB(0, 0), cB, voffB); PG8_STAGE(PG8_SA(0, 0), cA, voffA); PG8_STAGE(PG8_SB(0, 1), cB + hstep, voffB); PG8_STAGE(PG8_SA(0, 1), cA + hstep, voffA);
    if (wr == 1) PG8_BAR;
    PG8_WAIT_V(4); PG8_BAR;
    PG8_STAGE(PG8_SB(1, 0), cB + kstep, voffB); PG8_STAGE(PG8_SA(1, 0), cA + kstep, voffA); PG8_STAGE(PG8_SB(1, 1), cB + hstep + kstep, voffB);
    PG8_WAIT_V(6); PG8_BAR;
    for (;;) {
        const bool has_next = S.next(ui + 1, nxt);
        const char* nA = has_next ? (const char*)g.A + (size_t)nxt.pm * tstep : cA; const char* nB = has_next ? (const char*)g.Bt + (size_t)nxt.pn * tstep : cB;
        for (int t = 0; t < nt; t += 2) {
            const bool last = (t == nt - 2);
            const char* a1 = cA + (size_t)(t + 1) * kstep;
            const char* a2 = last ? nA : cA + (size_t)(t + 2) * kstep; const char* b2 = last ? nB : cB + (size_t)(t + 2) * kstep;
            const char* a3 = a2 + kstep; const char* b3 = b2 + kstep;
            PG8_LDB(B0, 0, 0); PG8_SCHED; PG8_LDA(At, 0, 0); PG8_STAGE(PG8_SA(1, 1), a1 + hstep, voffA);
            PG8_WAIT_L(8); PG8_BAR; PG8_WAIT_L(0); PG8_MMA(0, 0, At, B0); PG8_BAR; PG8_SCHED;
            PG8_LDB(B1, 0, 1); PG8_STAGE(PG8_SB(0, 0), b2, voffB);
            PG8_BAR; PG8_WAIT_L(0); PG8_MMA(0, 1, At, B1); PG8_BAR;
            PG8_LDA(At, 0, 1); PG8_STAGE(PG8_SA(0, 0), a2, voffA);
            PG8_BAR; PG8_WAIT_L(0); PG8_MMA(1, 0, At, B0); PG8_BAR; PG8_SCHED;
            PG8_STAGE(PG8_SB(0, 1), b2 + hstep, voffB);
            PG8_WAIT_V(6); PG8_BAR; PG8_MMA(1, 1, At, B1); PG8_BAR;
            PG8_LDB(B0, 1, 0); PG8_SCHED; PG8_LDA(At, 1, 0); PG8_STAGE(PG8_SA(0, 1), a2 + hstep, voffA);
            PG8_WAIT_L(8); PG8_BAR; PG8_WAIT_L(0); PG8_MMA(0, 0, At, B0); PG8_BAR; PG8_SCHED;
            PG8_LDB(B1, 1, 1); PG8_STAGE(PG8_SB(1, 0), b3, voffB);
            PG8_BAR; PG8_WAIT_L(0); PG8_MMA(0, 1, At, B1); PG8_BAR;
            PG8_LDA(At, 1, 1); PG8_STAGE(PG8_SA(1, 0), a3, voffA);
            PG8_BAR; PG8_WAIT_L(0); PG8_MMA(1, 0, At, B0); PG8_BAR; PG8_SCHED;
            PG8_STAGE(PG8_SB(1, 1), b3 + hstep, voffB);
            PG8_WAIT_V(6); PG8_BAR; PG8_MMA(1, 1, At, B1); PG8_BAR;
        }
        if constexpr (Epi::I8) {
#pragma unroll
            for (int a = 0; a < 2; ++a)
#pragma unroll
                for (int b = 0; b < 2; ++b)
#pragma unroll
                    for (int m = 0; m < 4; ++m)
#pragma unroll
                        for (int n = 0; n < 2; ++n) { const i32x4 v = __builtin_bit_cast(i32x4, acc[a][b][m][n]); acc[a][b][m][n] = (f32x4){(float)v[0], (float)v[1], (float)v[2], (float)v[3]}; }
        }
        E(acc, cur, wr, wc, fr, fq);
        if (!has_next) break;
#pragma unroll
        for (int a = 0; a < 2; ++a)
#pragma unroll
            for (int b = 0; b < 2; ++b)
#pragma unroll
                for (int m = 0; m < 4; ++m)
#pragma unroll
                    for (int n = 0; n < 2; ++n) acc[a][b][m][n] = (f32x4){0.f, 0.f, 0.f, 0.f};
        cur = nxt; cA = nA; cB = nB; ++ui;
    }
    PG8_WAIT_V(0);
    if (wr == 0) PG8_BAR;
    PG8_BAR;
#undef PG8_SA
#undef PG8_SB
#undef PG8_STAGE
#undef PG8_LDA
#undef PG8_LDB
#undef PG8_MMA
#undef PG8_WAIT_V
#undef PG8_WAIT_L
#undef PG8_BAR
#undef PG8_SCHED
}
}

__device__ __forceinline__ float silu_f(float v) { return v * __builtin_amdgcn_rcpf(1.0f + __expf(-v)); }
__device__ __forceinline__ half4 to_half4(f32x4 v) { half4 h; h[0] = (f16)v[0]; h[1] = (f16)v[1]; h[2] = (f16)v[2]; h[3] = (f16)v[3]; return h; }

__device__ __forceinline__ float row_rstd(const float* ss, int np, int row) {
    float s;
    if (np == 1) s = ss[row];
    else { const f32x4* p = (const f32x4*)(ss + (size_t)row * 16); const f32x4 a = p[0], b = p[1], c = p[2], d = p[3];
        s = (((a[0] + a[1]) + (a[2] + a[3])) + ((b[0] + b[1]) + (b[2] + b[3]))) + (((c[0] + c[1]) + (c[2] + c[3])) + ((d[0] + d[1]) + (d[2] + d[3]))); }
    return rsqrtf(s * (1.0f / D) + EPS);
}
template <bool I8_> struct EpiSwiglu {
    static constexpr bool I8 = I8_;
    f16* G; const float* ss; int np; const float* sa; const float* sw;
    __device__ __forceinline__ void operator()(const f32x4 (&acc)[2][2][4][2], const pg8::Unit& u, int wr, int wc, int fr_, int fq_) const {
        int fr = fr_, fq = fq_; asm volatile("" : "+v"(fr), "+v"(fq));
        f32x4 swg[2], swu[2];
        if constexpr (I8) {
#pragma unroll
            for (int n = 0; n < 2; ++n) { swg[n] = *(const f32x4*)(sw + u.pn * 256 + wc * 32 + 8 * fq + 4 * n); swu[n] = *(const f32x4*)(sw + u.pn * 256 + 128 + wc * 32 + 8 * fq + 4 * n); }
        }
#pragma unroll
        for (int ai = 0; ai < 2; ++ai)
#pragma unroll
            for (int m = 0; m < 4; ++m) {
                const int row = u.pm * 256 + ai * 128 + wr * 64 + m * 16 + fr;
                float rs = row_rstd(ss, np, row); if constexpr (I8) rs *= sa[row];
                const float ce = -1.4426950408889634f * rs, rs2 = rs * rs; half8 o;
#pragma unroll
                for (int n = 0; n < 2; ++n) {
                    f32x4 g = acc[ai][0][m][n], u = acc[ai][1][m][n];
                    if constexpr (I8) { g = g * swg[n]; u = u * swu[n]; }
                    const f32x4 t = g * ce; f32x4 e, r;
#pragma unroll
                    for (int j = 0; j < 4; ++j) e[j] = __builtin_amdgcn_exp2f(t[j]);
                    const f32x4 d = e + 1.0f;
#pragma unroll
                    for (int j = 0; j < 4; ++j) r[j] = __builtin_amdgcn_rcpf(d[j]);
                    const f32x4 w = (g * u) * (r * rs2);
#pragma unroll
                    for (int j = 0; j < 4; ++j) o[4 * n + j] = (f16)w[j];
                }
                *(half8*)(G + (size_t)row * DFF + u.pn * 128 + wc * 32 + 8 * fq) = o;
            }
    }
};
template <bool SRC16> struct EpiResid {
    static constexpr bool I8 = false;
    const void* src; f16* h16; float* ss; float alpha;
    __device__ __forceinline__ void operator()(const f32x4 (&acc)[2][2][4][2], const pg8::Unit& u, int wr, int wc, int fr_, int fq_) const {
        int fr = fr_, fq = fq_; asm volatile("" : "+v"(fr), "+v"(fq));
#pragma unroll
        for (int ai = 0; ai < 2; ++ai)
#pragma unroll
            for (int m = 0; m < 4; ++m) {
                const int row = u.pm * 256 + ai * 128 + wr * 64 + m * 16 + fr; float part = 0.f;
#pragma unroll
                for (int bj = 0; bj < 2; ++bj) {
                    const size_t off = (size_t)row * D + u.pn * 256 + bj * 128 + wc * 32 + 8 * fq; half8 h; f32x4 sv[2];
                    if (SRC16) { const half8 s8 = *(const half8*)((const f16*)src + off);
#pragma unroll
                        for (int j = 0; j < 4; ++j) { sv[0][j] = (float)s8[j]; sv[1][j] = (float)s8[4 + j]; } }
                    else { sv[0] = *(const f32x4*)((const float*)src + off); sv[1] = *(const f32x4*)((const float*)src + off + 4); }
#pragma unroll
                    for (int n = 0; n < 2; ++n) {
                        const f32x4 o = sv[n] + alpha * acc[ai][bj][m][n];
#pragma unroll
                        for (int j = 0; j < 4; ++j) h[4 * n + j] = (f16)o[j];
                        part += (o[0] * o[0] + o[1] * o[1]) + (o[2] * o[2] + o[3] * o[3]);
                    }
                    *(half8*)(h16 + off) = h;
                }
                part += __shfl_xor(part, 16); part += __shfl_xor(part, 32);
                if (fq == 0) ss[(size_t)row * 16 + u.pn * 4 + wc] = part;
            }
    }
};
constexpr float K_I8_SCALE = 127.0f / 8.0f;
__device__ __forceinline__ void rope8(const f32x4 (&x1)[2], const f32x4 (&x2)[2], const f32x2* rp, float sc, float (&o1)[8], float (&o2)[8]) {
#pragma unroll
    for (int n = 0; n < 2; ++n) {
        const f32x4 cs0 = *(const f32x4*)(rp + 4 * n), cs1 = *(const f32x4*)(rp + 4 * n + 2);
        o1[4 * n + 0] = (x1[n][0] * cs0[0] - x2[n][0] * cs0[1]) * sc; o2[4 * n + 0] = (x2[n][0] * cs0[0] + x1[n][0] * cs0[1]) * sc;
        o1[4 * n + 1] = (x1[n][1] * cs0[2] - x2[n][1] * cs0[3]) * sc; o2[4 * n + 1] = (x2[n][1] * cs0[2] + x1[n][1] * cs0[3]) * sc;
        o1[4 * n + 2] = (x1[n][2] * cs1[0] - x2[n][2] * cs1[1]) * sc; o2[4 * n + 2] = (x2[n][2] * cs1[0] + x1[n][2] * cs1[1]) * sc;
        o1[4 * n + 3] = (x1[n][3] * cs1[2] - x2[n][3] * cs1[3]) * sc; o2[4 * n + 3] = (x2[n][3] * cs1[2] + x1[n][3] * cs1[3]) * sc;
    }
}
__device__ __forceinline__ u32x2 pack_i8x8(const float (&v)[8]) {
    u32x2 r;
#pragma unroll
    for (int w = 0; w < 2; ++w) { unsigned word = 0u;
#pragma unroll
        for (int j = 0; j < 4; ++j) { const int q = (int)__builtin_rintf(fminf(fmaxf(v[4 * w + j] * K_I8_SCALE, -127.f), 127.f)); word |= ((unsigned)q & 0xffu) << (8 * j); }
        r[w] = word; }
    return r;
}
__device__ __forceinline__ u32x2 pack_bf8x8(const float (&v)[8]) {
    u32x2 r;
#pragma unroll
    for (int w = 0; w < 2; ++w) { int word = __builtin_amdgcn_cvt_pk_bf8_f32(v[4 * w], v[4 * w + 1], 0, false); word = __builtin_amdgcn_cvt_pk_bf8_f32(v[4 * w + 2], v[4 * w + 3], word, true); r[w] = (unsigned)word; }
    return r;
}
struct EpiInProj {
    static constexpr bool I8 = false;
    const float* ss; const f32x2* rope; unsigned char* ws;
    __device__ __forceinline__ void operator()(const f32x4 (&acc)[2][2][4][2], const pg8::Unit& u, int wr, int wc, int fr_, int fq_) const {
        int fr = fr_, fq = fq_; asm volatile("" : "+v"(fr), "+v"(fq));
        const int pn = u.pn;
        if (pn >= 8 && pn <= 11) {
            unsigned char* lb = (pn <= 9) ? ws + WS_KV + (size_t)((pn - 8) * 4 + wc) * LP * 128 + 8 * fq
                                          : ws + WS_KV + (size_t)((pn - 10) * 4 + (wc >> 1)) * LP * 128 + 64 + (wc & 1) * 32 + 8 * fq;
#pragma unroll
            for (int ai = 0; ai < 2; ++ai)
#pragma unroll
                for (int m = 0; m < 4; ++m) {
                    const int p = u.pm * 256 + ai * 128 + wr * 64 + m * 16 + fr;
                    const int t = p < SEQ ? p + NMETA : p - SEQ;
                    if (p < L) {
                        const float sc = row_rstd(ss, 16, p);
                        if (pn <= 9) {
                            float o1[8], o2[8]; rope8(acc[ai][0][m], acc[ai][1][m], rope + (size_t)t * 32 + 8 * fq, sc, o1, o2);
                            unsigned char* d8 = lb + (size_t)t * 128; *(u32x2*)d8 = pack_i8x8(o1); *(u32x2*)(d8 + 32) = pack_i8x8(o2);
                        } else {
#pragma unroll
                            for (int bj = 0; bj < 2; ++bj) { float v[8];
#pragma unroll
                                for (int j = 0; j < 4; ++j) { v[j] = acc[ai][bj][m][0][j] * sc; v[4 + j] = acc[ai][bj][m][1][j] * sc; }
                                *(u32x2*)(lb + (size_t)t * 128 + (size_t)bj * 2 * LP * 128) = pack_bf8x8(v); }
                        }
                    }
                    asm volatile("" ::: "memory");
                }
            return;
        }
        int mode = 0, stride = 256; float scale = 1.0f; f16* lanebase;
        if (pn == 0) lanebase = (f16*)(ws + WS_GQ) + wc * 32 + 8 * fq;
        else if (pn == 1) lanebase = (f16*)(ws + WS_GK) + wc * 32 + 8 * fq;
        else if (pn <= 3) { lanebase = (f16*)(ws + WS_GV) + (pn - 2) * 256 + wc * 32 + 8 * fq; stride = 512; }
        else if (pn <= 5) { lanebase = (f16*)(ws + WS_GR) + (pn - 4) * 256 + wc * 32 + 8 * fq; stride = 512; }
        else if (pn <= 7) { lanebase = (f16*)(ws + WS_DQ); mode = 6; scale = 0.125f; }
        else if (pn <= 13) { lanebase = (f16*)(ws + WS_IQ) + (pn - 12) * 256 + wc * 64 + 8 * fq; stride = 512; mode = 1; scale = 0.125f; }
        else { lanebase = (f16*)(ws + WS_IK) + 8 * fq; stride = 64; mode = wc == 0 ? 1 : (wc == 1 ? 2 : 3); }
#pragma unroll
        for (int ai = 0; ai < 2; ++ai)
#pragma unroll
            for (int m = 0; m < 4; ++m) {
                const int p = u.pm * 256 + ai * 128 + wr * 64 + m * 16 + fr;
                const int t = p < SEQ ? p + NMETA : p - SEQ;
                if (p < L && mode != 3) {
                    const float rs = row_rstd(ss, 16, p);
                    if (mode == 6) {
                        float o1[8], o2[8]; rope8(acc[ai][0][m], acc[ai][1][m], rope + (size_t)t * 32 + 8 * fq, rs * scale, o1, o2);
                        float qm = 1e-20f;
#pragma unroll
                        for (int j = 0; j < 8; ++j) qm = fmaxf(qm, fmaxf(fabsf(o1[j]), fabsf(o2[j])));
                        qm = fmaxf(qm, __shfl_xor(qm, 16)); qm = fmaxf(qm, __shfl_xor(qm, 32));
                        const float qsc = 127.0f * __builtin_amdgcn_rcpf(qm); u32x2 w1, w2;
#pragma unroll
                        for (int w = 0; w < 2; ++w) { unsigned a = 0u, b = 0u;
#pragma unroll
                            for (int j = 0; j < 4; ++j) { a |= ((unsigned)(int)__builtin_rintf(o1[4 * w + j] * qsc) & 0xffu) << (8 * j); b |= ((unsigned)(int)__builtin_rintf(o2[4 * w + j] * qsc) & 0xffu) << (8 * j); }
                            w1[w] = a; w2[w] = b; }
                        const int head = (pn - 6) * 4 + wc; unsigned char* qrow = ws + WS_DQ + (size_t)t * 512 + head * 64 + 8 * fq;
                        *(u32x2*)qrow = w1; *(u32x2*)(qrow + 32) = w2;
                        if (fq == 0) ((float*)(ws + WS_DQ + (size_t)LP * 512))[(size_t)t * 8 + head] = qm * (1.0f / (127.0f * K_I8_SCALE));
                    } else if (mode == 1) {
                        float o1[8], o2[8]; rope8(acc[ai][0][m], acc[ai][1][m], rope + (size_t)t * 32 + 8 * fq, rs * scale, o1, o2);
                        half8 h1, h2;
#pragma unroll
                        for (int j = 0; j < 8; ++j) { h1[j] = (f16)o1[j]; h2[j] = (f16)o2[j]; }
                        f16* dst = lanebase + (size_t)t * stride; *(half8*)dst = h1; *(half8*)(dst + 32) = h2;
                    } else if (mode == 2) {
                        if (fq < 2) { float* gp = (float*)(ws + WS_GA) + (size_t)t * 16 + 8 * fq; *(f32x4*)gp = acc[ai][0][m][0] * rs; *(f32x4*)(gp + 4) = acc[ai][0][m][1] * rs; }
                        else if (fq == 2) { float* ip = (float*)(ws + WS_IW) + (size_t)t * 8; const float r2 = rs * 0.35355339059327373f; *(f32x4*)ip = acc[ai][0][m][0] * r2; *(f32x4*)(ip + 4) = acc[ai][0][m][1] * r2; }
                    } else {
#pragma unroll
                        for (int bj = 0; bj < 2; ++bj) { half8 h;
#pragma unroll
                            for (int j = 0; j < 4; ++j) { h[j] = (f16)(acc[ai][bj][m][0][j] * rs); h[4 + j] = (f16)(acc[ai][bj][m][1][j] * rs); }
                            *(half8*)(lanebase + (size_t)t * stride + bj * 128) = h; }
                    }
                }
                asm volatile("" ::: "memory");
            }
    }
};

__device__ __forceinline__ const float* w_src(const Params& P, int kind, int n, int& ld, const float*& gain) {
    switch (kind) {
    case 0: case 4: { const int pn = n >> 8, bj = (n >> 7) & 1, cc = n & 127; ld = DFF; gain = kind == 0 ? P.n1 : P.n2;
        const float* w = kind == 0 ? (bj ? P.wu1 : P.wg1) : (bj ? P.wu2 : P.wg2); return w + pn * 128 + cc; }
    case 1: ld = D; gain = nullptr; return P.wd1 + n;
    case 5: ld = D; gain = nullptr; return P.wd2 + n;
    case 3: ld = D; gain = nullptr; return P.wout + n;
    default: { ld = 3672; gain = P.nmix; const int pn = n >> 8, c = n & 255, bj = c >> 7, hh = (c >> 5) & 3, dd = c & 31; int j;
        if (pn == 0) j = c; else if (pn == 1) j = 256 + c; else if (pn <= 3) j = 512 + (pn - 2) * 256 + c; else if (pn <= 5) j = 1024 + (pn - 4) * 256 + c;
        else if (pn <= 7) j = 1552 + (pn - 6) * 256 + hh * 64 + bj * 32 + dd;
        else if (pn <= 9) j = 2064 + (pn - 8) * 256 + hh * 64 + bj * 32 + dd;
        else if (pn <= 11) j = 2576 + (pn - 10) * 256 + c;
        else if (pn <= 13) j = 3088 + (pn - 12) * 256 + hh * 64 + bj * 32 + dd;
        else { if (c < 32) j = 3600 + c; else if (c < 48) j = 1536 + (c - 32); else if (c < 56) j = 3664 + (c - 48); else if (c >= 128 && c < 160) j = 3600 + 32 + (c - 128); else j = -1; }
        return j < 0 ? nullptr : P.win + j; }
    }
}
__device__ __forceinline__ void prep_weight(const Params& P, const int kind, const int N, const int K, f16* dst, int& cursor, int& tbase, LAS f16* tl, const int G) {
    const int tid = threadIdx.x, tn = N / 64, tk = K / 256, ntile = tn * tk;
    const int n = tid & 63, kk0 = tid >> 6;
    float v[32], vn[32];
#define PREP_LOAD(dstv, tI) do { const int n0_ = ((tI) % tn) * 64, k0_ = ((tI) / tn) * 256; int ld; const float* gain; const float* col = w_src(P, kind, n0_ + n, ld, gain); \
        _Pragma("unroll") for (int i = 0; i < 32; ++i) dstv[i] = col ? col[(size_t)(k0_ + kk0 + 8 * i) * ld] : 0.f; \
        if (gain) { _Pragma("unroll") for (int i = 0; i < 32; ++i) dstv[i] *= gain[k0_ + kk0 + 8 * i]; } } while (0)
    if (cursor < tbase + ntile) PREP_LOAD(v, cursor - tbase);
#pragma unroll 1
    for (; cursor < tbase + ntile; cursor += G) {
        const int tI = cursor - tbase, n0 = (tI % tn) * 64, k0 = (tI / tn) * 256;
        const bool more = cursor + G < tbase + ntile;
        if (more) PREP_LOAD(vn, tI + G);
#pragma unroll
        for (int i = 0; i < 32; ++i) tl[n * 264 + kk0 + 8 * i] = (f16)v[i];
        __syncthreads();
        { const int nr = tid >> 3, seg = tid & 7;
#pragma unroll
          for (int j = 0; j < 4; ++j) *(half8*)(dst + (size_t)(n0 + nr) * K + k0 + (seg + 8 * j) * 8) = *(const LAS half8*)(tl + nr * 264 + (seg + 8 * j) * 8); }
        __syncthreads();
        if (more) {
#pragma unroll
            for (int i = 0; i < 32; ++i) v[i] = vn[i];
        }
    }
#undef PREP_LOAD
    tbase += ntile;
}
__device__ __forceinline__ void prep_weight_i8(const Params& P, const int kind, const int N, unsigned char* dst, float* sw, int first, int step, LAS unsigned char* lds) {
    const int tid = threadIdx.x, n = tid & 63, kk0 = tid >> 6;
    LAS float* pmax = (LAS float*)lds; LAS unsigned* img = (LAS unsigned*)(lds + 2048);
#pragma unroll 1
    for (int task = first; task < N / 64; task += step) {
        const int n0 = task * 64; int ld; const float* gain; const float* col = w_src(P, kind, n0 + n, ld, gain);
        float v[128]; float mx = 0.f;
#pragma unroll
        for (int i = 0; i < 128; ++i) v[i] = col ? col[(size_t)(kk0 * 128 + i) * ld] : 0.f;
        if (gain) {
#pragma unroll
            for (int i = 0; i < 128; ++i) v[i] *= gain[kk0 * 128 + i];
        }
#pragma unroll
        for (int i = 0; i < 128; ++i) mx = fmaxf(mx, fabsf(v[i]));
        pmax[kk0 * 64 + n] = mx;
        __syncthreads();
#pragma unroll
        for (int q = 0; q < 8; ++q) mx = fmaxf(mx, pmax[q * 64 + n]);
        const float sc = mx > 0.f ? 127.0f / mx : 0.f;
        if (kk0 == 0) sw[n0 + n] = mx * (1.0f / 127.0f);
#pragma unroll
        for (int w = 0; w < 32; ++w) { unsigned word = 0u;
#pragma unroll
            for (int j = 0; j < 4; ++j) word |= ((unsigned)(int)__builtin_rintf(v[4 * w + j] * sc) & 0xffu) << (8 * j);
            img[n * 260 + kk0 * 32 + w] = word; }
        __syncthreads();
        { const int nr = tid >> 3, seg = tid & 7;
#pragma unroll
          for (int j = 0; j < 8; ++j) *(u32x4*)(dst + (size_t)(n0 + nr) * D + (seg + 8 * j) * 16) = *(const LAS u32x4*)(img + nr * 260 + (seg + 8 * j) * 4); }
        __syncthreads();
    }
}
__device__ __forceinline__ void quant_rows_i8(const f16* src, unsigned char* dst, float* sa, int rows) {
    const int tid = threadIdx.x, lane = tid & 63, gw = blockIdx.x * 8 + (tid >> 6), nw = gridDim.x * 8;
    for (int r = gw; r < rows; r += nw) {
        const half8 a = *(const half8*)(src + (size_t)r * D + lane * 16), b = *(const half8*)(src + (size_t)r * D + lane * 16 + 8);
        float v[16], mx = 0.f;
#pragma unroll
        for (int j = 0; j < 8; ++j) { v[j] = (float)a[j]; v[8 + j] = (float)b[j]; }
#pragma unroll
        for (int j = 0; j < 16; ++j) mx = fmaxf(mx, fabsf(v[j]));
#pragma unroll
        for (int o = 32; o >= 1; o >>= 1) mx = fmaxf(mx, __shfl_xor(mx, o));
        const float sc = mx > 0.f ? 127.0f / mx : 0.f; u32x4 w;
#pragma unroll
        for (int q = 0; q < 4; ++q) { unsigned word = 0u;
#pragma unroll
            for (int j = 0; j < 4; ++j) word |= ((unsigned)(int)__builtin_rintf(v[4 * q + j] * sc) & 0xffu) << (8 * j);
            w[q] = word; }
        *(u32x4*)(dst + (size_t)r * D + lane * 16) = w;
        if (lane == 0) sa[r] = mx * (1.0f / 127.0f);
    }
}
__device__ __forceinline__ void p0_prologue(const Params& P, LAS unsigned char* lds) {
    const int tid = threadIdx.x, bid = blockIdx.x, G = gridDim.x, lane = tid & 63;
    unsigned char* ws = P.ws;
    LAS f16* tl = (LAS f16*)lds;
    {
        constexpr int NI8 = 2 * DFF / 64; const int nI = G > 2 * NI8 ? NI8 : 0;
        if (bid >= G - nI || nI == 0) prep_weight_i8(P, 0, 2 * DFF, ws + WS_WGU1, (float*)(ws + WS_WGU1 + (size_t)2 * DFF * D), nI ? bid - (G - nI) : bid, nI ? nI : G, lds);
        if (bid < G - nI) { int tbase = 0, cursor = bid; __syncthreads();
            prep_weight(P, 1, D, DFF, (f16*)(ws + WS_WD1), cursor, tbase, tl, G - nI);
            prep_weight(P, 2, NIN, D, (f16*)(ws + WS_WIN), cursor, tbase, tl, G - nI); }
    }
    float* ss0 = (float*)(ws + WS_SS0);
    f16* acta = (f16*)(ws + WS_ACTA);
    const int gw = bid * 8 + (tid >> 6), nw = G * 8;
    unsigned char* x8 = ws + WS_US; float* sa0 = (float*)(ws + WS_IQ);
    for (int p = gw; p < L; p += nw) {
        const float* src = p < SEQ ? P.x + (size_t)p * D : P.meta + (size_t)(p - SEQ) * D; float s = 0.f, mx = 0.f; f32x4 v[4];
#pragma unroll
        for (int i = 0; i < 4; ++i) { v[i] = *(const f32x4*)(src + lane * 4 + 256 * i); s += (v[i][0] * v[i][0] + v[i][1] * v[i][1]) + (v[i][2] * v[i][2] + v[i][3] * v[i][3]);
            mx = fmaxf(fmaxf(mx, fmaxf(fabsf(v[i][0]), fabsf(v[i][1]))), fmaxf(fabsf(v[i][2]), fabsf(v[i][3]))); *(half4*)(acta + (size_t)p * D + lane * 4 + 256 * i) = to_half4(v[i]); }
#pragma unroll
        for (int o = 32; o >= 1; o >>= 1) { s += __shfl_xor(s, o); mx = fmaxf(mx, __shfl_xor(mx, o)); }
        const float sc = mx > 0.f ? 127.0f / mx : 0.f;
#pragma unroll
        for (int i = 0; i < 4; ++i) { unsigned word = 0u;
#pragma unroll
            for (int j = 0; j < 4; ++j) word |= ((unsigned)(int)__builtin_rintf(v[i][j] * sc) & 0xffu) << (8 * j);
            *(unsigned*)(x8 + (size_t)p * D + lane * 4 + 256 * i) = word; }
        if (lane == 0) { ss0[p] = s; sa0[p] = mx * (1.0f / 127.0f); }
    }
    const int gt = bid * NTHREADS + tid, ngt = G * NTHREADS;
    for (int i = gt; i < MP; i += ngt) { if (i >= L) { ss0[i] = (float)D; sa0[i] = 0.f; } }
    f32x2* rope = (f32x2*)(ws + WS_ROPE);
    for (int i = gt; i < L * 32; i += ngt) { const int t = i >> 5, f = i & 31; const double inv = exp(-(double)f * (9.210340371976184 / 32.0)); double sn, cs; sincos((double)t * inv, &sn, &cs); rope[i] = (f32x2){(float)cs, (float)sn}; }
}

__device__ __forceinline__ void meta_down(const Params& P, LAS unsigned char* lds) {
    const int tid = threadIdx.x, lane = tid & 63, wid = tid >> 6;
    const f16* Gm = (const f16*)(P.ws + WS_G) + (size_t)SEQ * DFF; const f16* Wt = (const f16*)(P.ws + WS_WD1);
    f16* acta = (f16*)P.out; float* ss1 = (float*)(P.ws + WS_SS1); LAS float* slot = (LAS float*)lds;
    for (int task = blockIdx.x; task < NMETA * 16; task += gridDim.x) {
        const int r = task >> 4, cg = task & 15; float part = 0.f;
#pragma unroll 1
        for (int q = 0; q < 2; ++q) {
            const int n0 = cg * 64 + (2 * wid + q) * 4; float a[4] = {0.f, 0.f, 0.f, 0.f};
            for (int kc = lane; kc < DFF / 8; kc += 64) {
                const half8 gv = *(const half8*)(Gm + (size_t)r * DFF + kc * 8);
#pragma unroll
                for (int j = 0; j < 4; ++j) { const half8 wv = *(const half8*)(Wt + (size_t)(n0 + j) * DFF + kc * 8);
#pragma unroll
                    for (int e = 0; e < 8; ++e) a[j] += (float)gv[e] * (float)wv[e]; }
            }
#pragma unroll
            for (int o = 32; o >= 1; o >>= 1) { a[0] += __shfl_xor(a[0], o); a[1] += __shfl_xor(a[1], o); a[2] += __shfl_xor(a[2], o); a[3] += __shfl_xor(a[3], o); }
            f32x4 o;
#pragma unroll
            for (int j = 0; j < 4; ++j) { o[j] = P.meta[r * D + n0 + j] + 0.5f * a[j]; part += o[j] * o[j]; }
            if (lane == 0) *(half4*)(acta + (size_t)(SEQ + r) * D + n0) = to_half4(o);
        }
        if (lane == 0) slot[wid] = part;
        __syncthreads();
        if (tid == 0) { float s = 0.f; for (int w = 0; w < 8; ++w) s += slot[w]; ss1[(size_t)(SEQ + r) * 16 + cg] = s; }
        __syncthreads();
    }
}

__device__ __forceinline__ float logsigmoid_f(float z) { return fminf(z, 0.f) - __logf(1.0f + __expf(-fabsf(z))); }
__device__ __forceinline__ void gla_gates(const Params& P, int c, int h, LAS float* bl) {
    const int tid = threadIdx.x, ti = tid >> 3, d0 = (tid & 7) * 8, tt = 64 * c - 48 + ti; const float* GA = (const float*)(P.ws + WS_GA);
    {
        float z[8];
        if (tt >= 0 && tt < L) {
            const f32x4 b0 = *(const f32x4*)(P.ba + 64 * h + d0), b1 = *(const f32x4*)(P.ba + 64 * h + d0 + 4);
#pragma unroll
            for (int m = 0; m < 4; ++m) { z[m] = b0[m]; z[4 + m] = b1[m]; }
            f32x4 a4[4];
#pragma unroll
            for (int q = 0; q < 4; ++q) a4[q] = *(const f32x4*)(GA + (size_t)tt * 16 + 4 * q);
#pragma unroll
            for (int r = 0; r < 16; ++r) { const float ar = a4[r >> 2][r & 3]; const f32x4 w0 = *(const f32x4*)(P.wa2 + r * 256 + 64 * h + d0), w1 = *(const f32x4*)(P.wa2 + r * 256 + 64 * h + d0 + 4);
#pragma unroll
                for (int m = 0; m < 4; ++m) { z[m] += ar * w0[m]; z[4 + m] += ar * w1[m]; } }
#pragma unroll
            for (int m = 0; m < 8; ++m) z[m] = logsigmoid_f(z[m]) * (1.0f / 16.0f);
        } else {
#pragma unroll
            for (int m = 0; m < 8; ++m) z[m] = 0.f;
        }
#pragma unroll
        for (int m = 0; m < 8; ++m) bl[ti * 65 + d0 + m] = z[m];
    }
    __syncthreads();
    {
        const int d = tid & 63, seg = tid >> 6; float v[8], run = 0.f;
#pragma unroll
        for (int i = 0; i < 8; ++i) { run += bl[(seg * 8 + i) * 65 + d]; v[i] = run; }
#pragma unroll
        for (int i = 0; i < 8; ++i) bl[(seg * 8 + i) * 65 + d] = v[i];
        __syncthreads();
        float off = 0.f;
#pragma unroll
        for (int sg = 0; sg < 7; ++sg) off += (sg < seg) ? bl[(sg * 8 + 7) * 65 + d] : 0.f;
        __syncthreads();
#pragma unroll
        for (int i = 0; i < 8; ++i) bl[(seg * 8 + i) * 65 + d] = v[i] + off;
    }
    __syncthreads();
}
__device__ __forceinline__ void gla_a_unit(const Params& P, int unit, LAS unsigned char* lds) {
    int tid_ = threadIdx.x; asm volatile("" : "+v"(tid_));
    const int tid = tid_, lane = tid & 63, wid = tid >> 6, c = unit >> 2, h = unit & 3;
    LAS float* bl = (LAS float*)lds; LAS float* ks = bl + 4160; LAS float* vs = ks + 4096;
    const f16* GK = (const f16*)(P.ws + WS_GK); const f16* GV = (const f16*)(P.ws + WS_GV);
    float* U = (float*)(P.ws + WS_US); float* DEC = (float*)(P.ws + WS_DECAY);
    const int ti = tid >> 3, d0 = (tid & 7) * 8, tt = 64 * c - 48 + ti; const bool tv = tt >= 0 && tt < L;
    half8 k8, v8[2];
#pragma unroll
    for (int m = 0; m < 8; ++m) { k8[m] = (f16)0.f; v8[0][m] = (f16)0.f; v8[1][m] = (f16)0.f; }
    if (tv) k8 = *(const half8*)(GK + (size_t)tt * 256 + 64 * h + d0);
#pragma unroll
    for (int q = 0; q < 2; ++q) { const int ch = tid + 512 * q, j = ch >> 4, t = 64 * c - 48 + j; if (t >= 0 && t < L) v8[q] = *(const half8*)(GV + (size_t)t * 512 + 128 * h + (ch & 15) * 8); }
    gla_gates(P, c, h, bl);
    { f32x4 o0, o1;
#pragma unroll
      for (int m = 0; m < 4; ++m) { o0[m] = (float)k8[m] * __expf(bl[63 * 65 + d0 + m] - bl[ti * 65 + d0 + m]); o1[m] = (float)k8[4 + m] * __expf(bl[63 * 65 + d0 + 4 + m] - bl[ti * 65 + d0 + 4 + m]); }
      *(LAS f32x4*)(ks + ti * 64 + d0) = o0; *(LAS f32x4*)(ks + ti * 64 + d0 + 4) = o1; }
#pragma unroll
    for (int q = 0; q < 2; ++q) { const int ch = tid + 512 * q, j = ch >> 4, e0 = (ch & 15) * 8; f32x4 o0, o1;
#pragma unroll
        for (int m = 0; m < 4; ++m) { o0[m] = (float)v8[q][m]; o1[m] = (float)v8[q][4 + m]; }
        *(LAS f32x4*)(vs + j * 128 + e0) = o0; *(LAS f32x4*)(vs + j * 128 + e0 + 4) = o1; }
    if (tid < 64) DEC[(size_t)c * 256 + h * 64 + tid] = __expf(bl[63 * 65 + tid]);
    __syncthreads();
    { const int dd0 = (wid >> 2) * 32, e0 = (wid & 3) * 32, l31 = lane & 31, hf = lane >> 5; f32x16 acc;
#pragma unroll
      for (int i = 0; i < 16; ++i) acc[i] = 0.f;
#pragma unroll 8
      for (int s = 0; s < 32; ++s) acc = __builtin_amdgcn_mfma_f32_32x32x2f32(ks[(2 * s + hf) * 64 + dd0 + l31], vs[(2 * s + hf) * 128 + e0 + l31], acc, 0, 0, 0);
      float* up = U + ((size_t)unit * 64) * 128;
#pragma unroll
      for (int r = 0; r < 16; ++r) { const int row = (r & 3) + 8 * (r >> 2) + 4 * hf; up[(size_t)(dd0 + row) * 128 + e0 + l31] = acc[r]; } }
    __syncthreads();
}
__device__ __forceinline__ void gla_scan(const Params& P) {
    float* U = (float*)(P.ws + WS_US); const float* DEC = (const float*)(P.ws + WS_DECAY);
    const int idx = blockIdx.x * NTHREADS + threadIdx.x;
    if (idx >= 32768) return;
    float s = 0.f;
#pragma unroll 8
    for (int c = 0; c < NCH - 1; ++c) { const float u = U[(size_t)c * 32768 + idx], dc = DEC[(size_t)c * 256 + (idx >> 7)]; U[(size_t)c * 32768 + idx] = s; s = dc * s + u; }
    U[(size_t)(NCH - 1) * 32768 + idx] = s;
}
__device__ __forceinline__ void gla_c_unit(const Params& P, int unit, LAS unsigned char* lds) {
    int tid_ = threadIdx.x; asm volatile("" : "+v"(tid_));
    const int tid = tid_, lane = tid & 63, wid = tid >> 6, c = unit >> 2, h = unit & 3, l31 = lane & 31, hf = lane >> 5;
    LAS float* bl = (LAS float*)lds; LAS float* kk = bl + 4160; LAS float* qs = kk + 4160; LAS float* As = qs + 4160; LAS float* vs = As + 4160; LAS float* Ss = vs + 8192; LAS float* os = bl;
    const f16* GQ = (const f16*)(P.ws + WS_GQ); const f16* GK = (const f16*)(P.ws + WS_GK); const f16* GV = (const f16*)(P.ws + WS_GV); const f16* GR = (const f16*)(P.ws + WS_GR);
    const float* Sg = (const float*)(P.ws + WS_US) + (size_t)unit * 8192; f16* mix = (f16*)(P.ws + WS_ACTA);
    const int ti = tid >> 3, d0 = (tid & 7) * 8, tt = 64 * c - 48 + ti; const bool tv = tt >= 0 && tt < L;
    half8 q8, k8, v8[2], r8[2]; f32x4 sreg[4];
#pragma unroll
    for (int m = 0; m < 8; ++m) { q8[m] = (f16)0.f; k8[m] = (f16)0.f; v8[0][m] = (f16)0.f; v8[1][m] = (f16)0.f; r8[0][m] = (f16)0.f; r8[1][m] = (f16)0.f; }
    if (tv) { q8 = *(const half8*)(GQ + (size_t)tt * 256 + 64 * h + d0); k8 = *(const half8*)(GK + (size_t)tt * 256 + 64 * h + d0);
        r8[0] = *(const half8*)(GR + (size_t)tt * 512 + 128 * h + (tid & 7) * 16); r8[1] = *(const half8*)(GR + (size_t)tt * 512 + 128 * h + (tid & 7) * 16 + 8); }
#pragma unroll
    for (int q = 0; q < 2; ++q) { const int ch = tid + 512 * q, j = ch >> 4, t = 64 * c - 48 + j; if (t >= 0 && t < L) v8[q] = *(const half8*)(GV + (size_t)t * 512 + 128 * h + (ch & 15) * 8); }
#pragma unroll
    for (int q = 0; q < 4; ++q) sreg[q] = *(const f32x4*)(Sg + (size_t)(tid + 512 * q) * 4);
    gla_gates(P, c, h, bl);
#pragma unroll
    for (int m = 0; m < 8; ++m) { const float bv = bl[ti * 65 + d0 + m]; qs[ti * 65 + d0 + m] = (float)q8[m] * 0.125f * __expf(bv); kk[ti * 65 + d0 + m] = (float)k8[m] * __expf(-bv); }
#pragma unroll
    for (int q = 0; q < 2; ++q) { const int ch = tid + 512 * q, j = ch >> 4, e0 = (ch & 15) * 8; f32x4 o0, o1;
#pragma unroll
        for (int m = 0; m < 4; ++m) { o0[m] = (float)v8[q][m]; o1[m] = (float)v8[q][4 + m]; }
        *(LAS f32x4*)(vs + j * 128 + e0) = o0; *(LAS f32x4*)(vs + j * 128 + e0 + 4) = o1; }
#pragma unroll
    for (int q = 0; q < 4; ++q) *(LAS f32x4*)(Ss + (tid + 512 * q) * 4) = sreg[q];
    __syncthreads();
    if (wid < 4) { const int i0 = (wid >> 1) * 32, j0 = (wid & 1) * 32; f32x16 acc;
#pragma unroll
        for (int i = 0; i < 16; ++i) acc[i] = 0.f;
#pragma unroll 8
        for (int s = 0; s < 32; ++s) acc = __builtin_amdgcn_mfma_f32_32x32x2f32(qs[(i0 + l31) * 65 + 2 * s + hf], kk[(j0 + l31) * 65 + 2 * s + hf], acc, 0, 0, 0);
#pragma unroll
        for (int r = 0; r < 16; ++r) { const int i = i0 + (r & 3) + 8 * (r >> 2) + 4 * hf, j = j0 + l31; As[i * 65 + j] = (j <= i) ? acc[r] : 0.f; } }
    __syncthreads();
    { const int i0 = (wid >> 2) * 32, e0 = (wid & 3) * 32; f32x16 acc;
#pragma unroll
      for (int i = 0; i < 16; ++i) acc[i] = 0.f;
#pragma unroll 8
      for (int s = 0; s < 32; ++s) acc = __builtin_amdgcn_mfma_f32_32x32x2f32(qs[(i0 + l31) * 65 + 2 * s + hf], Ss[(2 * s + hf) * 128 + e0 + l31], acc, 0, 0, 0);
#pragma unroll 8
      for (int s = 0; s < 32; ++s) acc = __builtin_amdgcn_mfma_f32_32x32x2f32(As[(i0 + l31) * 65 + 2 * s + hf], vs[(2 * s + hf) * 128 + e0 + l31], acc, 0, 0, 0);
#pragma unroll
      for (int r = 0; r < 16; ++r) { const int i = i0 + (r & 3) + 8 * (r >> 2) + 4 * hf; os[i * 129 + e0 + l31] = acc[r]; } }
    __syncthreads();
    { const int e0 = (tid & 7) * 16; float o[16], sq = 0.f;
#pragma unroll
      for (int j = 0; j < 16; ++j) { o[j] = os[ti * 129 + e0 + j]; sq += o[j] * o[j]; }
      sq += __shfl_xor(sq, 1); sq += __shfl_xor(sq, 2); sq += __shfl_xor(sq, 4);
      const float rs = rsqrtf(sq * (1.0f / 128.0f) + EPS);
      if (tt >= NMETA && tt < L) { half8 w0, w1;
#pragma unroll
          for (int j = 0; j < 8; ++j) { w0[j] = (f16)(o[j] * rs * P.hn[e0 + j] * silu_f((float)r8[0][j])); w1[j] = (f16)(o[8 + j] * rs * P.hn[e0 + 8 + j] * silu_f((float)r8[1][j])); }
          f16* dst = mix + (size_t)(tt - NMETA) * D + 128 * h + e0; *(half8*)dst = w0; *(half8*)(dst + 8) = w1; } }
    __syncthreads();
}

__device__ __forceinline__ unsigned mono_u(float f) { const unsigned u = __float_as_uint(f); return (u & 0x80000000u) ? ~u : (u | 0x80000000u); }
__device__ __forceinline__ float unmono_f(unsigned m) { return __uint_as_float((m & 0x80000000u) ? (m & 0x7fffffffu) : ~m); }
__device__ __forceinline__ unsigned wave_umax(unsigned v) {
    v = max(v, (unsigned)__builtin_amdgcn_update_dpp(0, (int)v, 0x111, 0xf, 0xf, false));
    v = max(v, (unsigned)__builtin_amdgcn_update_dpp(0, (int)v, 0x112, 0xf, 0xf, false));
    v = max(v, (unsigned)__builtin_amdgcn_update_dpp(0, (int)v, 0x114, 0xf, 0xf, false));
    v = max(v, (unsigned)__builtin_amdgcn_update_dpp(0, (int)v, 0x118, 0xf, 0xf, false));
    v = max(v, (unsigned)__builtin_amdgcn_update_dpp(0, (int)v, 0x142, 0xa, 0xf, false));
    v = max(v, (unsigned)__builtin_amdgcn_update_dpp(0, (int)v, 0x143, 0xc, 0xf, false));
    return (unsigned)__builtin_amdgcn_readlane((int)v, 63);
}
__device__ __forceinline__ int half_scan_incl(int v) {
    v += __builtin_amdgcn_update_dpp(0, v, 0x111, 0xf, 0xf, true);
    v += __builtin_amdgcn_update_dpp(0, v, 0x112, 0xf, 0xf, true);
    v += __builtin_amdgcn_update_dpp(0, v, 0x114, 0xf, 0xf, true);
    v += __builtin_amdgcn_update_dpp(0, v, 0x118, 0xf, 0xf, true);
    v += __builtin_amdgcn_update_dpp(0, v, 0x142, 0xa, 0xf, true);
    return v;
}
constexpr int CAP = 640, NPL = CAP / 64;
__device__ __forceinline__ int topk_compact(LAS float* cs, LAS unsigned short* ci, int n, bool exact, float& tau_out, int lane) {
    float sv[NPL]; unsigned iv[NPL], u[NPL];
#pragma unroll
    for (int i = 0; i < NPL; ++i) { const int p = lane + 64 * i; const bool v = p < n; sv[i] = v ? cs[p] : 0.f; iv[i] = v ? (unsigned)ci[p] : 0xffffu; u[i] = v ? mono_u(sv[i]) : 0u; }
    unsigned T = 0u; bool full = true; int hb = 31;
    {
        unsigned umx = 0u, umn = 0xffffffffu;
#pragma unroll
        for (int i = 0; i < NPL; ++i) { umx = max(umx, u[i]); umn = min(umn, (lane + 64 * i < n) ? u[i] : 0xffffffffu); }
        umx = wave_umax(umx); umn = ~wave_umax(~umn);
        const unsigned df = umx ^ umn;
        if (df == 0u) { hb = -1; T = umx; } else { hb = 31 - __clz(df); T = (hb == 31) ? 0u : (umx & ~((2u << hb) - 1u)); }
    }
#pragma unroll 1
    for (int bit = hb; bit >= 0; --bit) {
        const unsigned cand = T | (1u << bit); int cgt = 0;
#pragma unroll
        for (int i = 0; i < NPL; ++i) cgt += __popcll(__ballot(u[i] >= cand));
        if (cgt >= 256) { T = cand; if (cgt <= (exact ? 256 : 272)) { full = false; break; } }
    }
    bool keep[NPL];
    if (full) {
        int cgt = 0;
#pragma unroll
        for (int i = 0; i < NPL; ++i) cgt += __popcll(__ballot(u[i] > T));
        const int need = 256 - cgt; unsigned I = 0xffffu; int nties = 0;
#pragma unroll
        for (int i = 0; i < NPL; ++i) nties += __popcll(__ballot(u[i] == T));
        if (nties != need) { I = 0u;
#pragma unroll 1
        for (int bit = 15; bit >= 0; --bit) { const unsigned cand = I | (1u << bit); int cl = 0;
#pragma unroll
            for (int i = 0; i < NPL; ++i) cl += __popcll(__ballot(u[i] == T && iv[i] < cand));
            if (cl < need) I = cand; } }
#pragma unroll
        for (int i = 0; i < NPL; ++i) keep[i] = (u[i] > T) || (u[i] == T && iv[i] <= I);
    } else {
#pragma unroll
        for (int i = 0; i < NPL; ++i) keep[i] = u[i] >= T;
    }
    int nn = 0;
#pragma unroll
    for (int i = 0; i < NPL; ++i) { const unsigned long long m = __ballot(keep[i]); const int pre = __builtin_amdgcn_mbcnt_hi((unsigned)(m >> 32), __builtin_amdgcn_mbcnt_lo((unsigned)m, 0u));
        if (keep[i]) { cs[nn + pre] = sv[i]; ci[nn + pre] = (unsigned short)iv[i]; } nn += __popcll(m); }
    tau_out = unmono_f(T);
    return nn;
}
__device__ __forceinline__ float relu_asm(float x) { return __int_as_float(max(__float_as_int(x), 0)); }
__device__ __forceinline__ void indexer_tile(const Params& P, int tile, LAS unsigned char* lds) {
    int tid_ = threadIdx.x; asm volatile("" : "+v"(tid_));
    const int tid = tid_, lane = tid & 63, wid = __builtin_amdgcn_readfirstlane(tid >> 6), l31 = lane & 31, hf = lane >> 5;
    LAS float* candS = (LAS float*)lds;
    LAS unsigned short* candI = (LAS unsigned short*)(lds + 32 * CAP * 4);
    LAS unsigned char* kbuf = lds + 32 * CAP * 6;
    LAS int* lflag = (LAS int*)(lds + LDS_BYTES - 1024 + 192);
    const f16* IQ = (const f16*)(P.ws + WS_IQ); const f16* IK = (const f16*)(P.ws + WS_IK); const float* IW = (const float*)(P.ws + WS_IW);
    unsigned short* SEL = (unsigned short*)(P.ws + WS_SEL);
    const int t0 = tile * 32, tw = t0 + wid * 4;
    half8 afr[4];
    { const int qi = 2 * (l31 >> 4) + ((l31 >> 2) & 1), hd = 4 * ((l31 >> 3) & 1) + (l31 & 3); int tq = tw + qi; if (tq > L - 1) tq = L - 1;
      const half8* ap = (const half8*)(IQ + (size_t)tq * 512 + hd * 64);
#pragma unroll
      for (int s = 0; s < 4; ++s) afr[s] = ap[2 * s + hf]; }
    float w0[8], w1[8];
    { int ta = tw + hf, tb = tw + 2 + hf; if (ta > L - 1) ta = L - 1; if (tb > L - 1) tb = L - 1;
#pragma unroll
      for (int h = 0; h < 8; ++h) { w0[h] = IW[(size_t)ta * 8 + h]; w1[h] = IW[(size_t)tb * 8 + h]; } }
    asm volatile("" :: "v"(afr[0]), "v"(afr[1]), "v"(afr[2]), "v"(afr[3]));
    asm volatile("" :: "v"(w0[0]), "v"(w0[1]), "v"(w0[2]), "v"(w0[3]), "v"(w0[4]), "v"(w0[5]), "v"(w0[6]), "v"(w0[7]));
    asm volatile("" :: "v"(w1[0]), "v"(w1[1]), "v"(w1[2]), "v"(w1[3]), "v"(w1[4]), "v"(w1[5]), "v"(w1[6]), "v"(w1[7]));
    const int tq0 = (tw + hf < L) ? tw + hf : -1, tq1 = (tw + 2 + hf < L) ? tw + 2 + hf : -1;
    float tau0 = -__builtin_inff(), tau1 = -__builtin_inff();
    int cq0 = 0, cq1 = 0, cq2 = 0, cq3 = 0;
    if (tid < 3) lflag[tid] = 0;
    const int nkeys = (t0 + 32 < L) ? t0 + 32 : L, nst = (nkeys + 127) >> 7;
    u32x4 stg[2];
    const u32x4* IKv = (const u32x4*)IK;
#pragma unroll
    for (int i = 0; i < 2; ++i) stg[i] = IKv[(size_t)0 * 1024 + tid + 512 * i];
#pragma unroll
    for (int i = 0; i < 2; ++i) { const int ci = tid + 512 * i, row = ci >> 3, ch = ci & 7; *(LAS u32x4*)(kbuf + row * 128 + ((ch ^ ((row >> 1) & 7)) << 4)) = stg[i]; }
    __syncthreads();
#pragma unroll 1
    for (int st = 0; st < nst; ++st) {
        LAS unsigned char* kb = kbuf + (st & 1) * 16384;
        if (st + 1 < nst) {
#pragma unroll
            for (int i = 0; i < 2; ++i) stg[i] = IKv[(size_t)(st + 1) * 1024 + tid + 512 * i];
        }
        if (st * 128 <= tw + 3) {
            f32x16 acc[4];
#pragma unroll
            for (int c = 0; c < 4; ++c) {
#pragma unroll
                for (int i = 0; i < 16; ++i) acc[c][i] = 0.f;
            }
#pragma unroll
            for (int s = 0; s < 4; ++s) {
#pragma unroll
                for (int c = 0; c < 4; ++c) { const int row = c * 32 + l31; const half8 bf = *(const LAS half8*)(kb + row * 128 + (((2 * s + hf) ^ ((row >> 1) & 7)) << 4)); acc[c] = __builtin_amdgcn_mfma_f32_32x32x16_f16(afr[s], bf, acc[c], 0, 0, 0); }
            }
            float sc[8]; bool ok[8]; int na = 0, nb = 0;
#pragma unroll
            for (int c = 0; c < 4; ++c) {
                float s0 = 0.f, s1 = 0.f;
#pragma unroll
                for (int h = 0; h < 8; ++h) { const float r0 = relu_asm(acc[c][h]), r1 = relu_asm(acc[c][8 + h]);
                    asm("v_fmac_f32 %0, %1, %2" : "+v"(s0) : "v"(w0[h]), "v"(r0)); asm("v_fmac_f32 %0, %1, %2" : "+v"(s1) : "v"(w1[h]), "v"(r1)); }
                const int key = st * 128 + c * 32 + l31;
                sc[2 * c] = s0; sc[2 * c + 1] = s1; ok[2 * c] = key <= tq0 && s0 > tau0; ok[2 * c + 1] = key <= tq1 && s1 > tau1;
                na += ok[2 * c] ? 1 : 0; nb += ok[2 * c + 1] ? 1 : 0;
            }
            const int ia = half_scan_incl(na), ib = half_scan_incl(nb);
            const int ta0 = __builtin_amdgcn_readlane(ia, 31), ta1 = __builtin_amdgcn_readlane(ia, 63), tb0 = __builtin_amdgcn_readlane(ib, 31), tb1 = __builtin_amdgcn_readlane(ib, 63);
            int pa = (hf ? cq1 : cq0) + ia - na, pb = (hf ? cq3 : cq2) + ib - nb;
            cq0 += ta0; cq1 += ta1; cq2 += tb0; cq3 += tb1;
            pa += (wid * 4 + hf) * CAP; pb += (wid * 4 + 2 + hf) * CAP;
            const int dmy = 32 * CAP * 6 / 4 + 2 * 16384 / 4 + 64 + lane;
#pragma unroll
            for (int c = 0; c < 4; ++c) {
                const unsigned short key = (unsigned short)(st * 128 + c * 32 + l31);
                { const bool k0 = ok[2 * c]; LAS float* ps = k0 ? candS + pa : candS + dmy; LAS unsigned short* pi = k0 ? candI + pa : (LAS unsigned short*)(candS + dmy + 64); *ps = sc[2 * c]; *pi = key; pa += k0 ? 1 : 0; }
                { const bool k1 = ok[2 * c + 1]; LAS float* ps = k1 ? candS + pb : candS + dmy; LAS unsigned short* pi = k1 ? candI + pb : (LAS unsigned short*)(candS + dmy + 64); *ps = sc[2 * c + 1]; *pi = key; pb += k1 ? 1 : 0; }
            }
        }
        if (st + 1 < nst) {
            LAS unsigned char* kn = kbuf + ((st + 1) & 1) * 16384;
#pragma unroll
            for (int i = 0; i < 2; ++i) { const int ci = tid + 512 * i, row = ci >> 3, ch = ci & 7; *(LAS u32x4*)(kn + row * 128 + ((ch ^ ((row >> 1) & 7)) << 4)) = stg[i]; }
        }
        const int mx = max(max(cq0, cq1), max(cq2, cq3));
        if (mx > CAP - 128 && lane == 0) lflag[st % 3] = 1;
        if (tid == 0) lflag[(st + 1) % 3] = 0;
        __syncthreads();
        const int any = lflag[st % 3];
        if (any) {
#pragma unroll 1
            for (int qq = 0; qq < 4; ++qq) { const int n = qq == 0 ? cq0 : (qq == 1 ? cq1 : (qq == 2 ? cq2 : cq3));
                if (n > 288) { float nt; const int nn = topk_compact(candS + (wid * 4 + qq) * CAP, candI + (wid * 4 + qq) * CAP, n, false, nt, lane);
                    if (qq == 0) cq0 = nn; else if (qq == 1) cq1 = nn; else if (qq == 2) cq2 = nn; else cq3 = nn;
                    if (hf == (qq & 1)) { if (qq < 2) tau0 = nt; else tau1 = nt; } } }
        }
    }
#pragma unroll 1
    for (int qq = 0; qq < 4; ++qq) {
        const int t = tw + qq; if (t >= L) break;
        int n = qq == 0 ? cq0 : (qq == 1 ? cq1 : (qq == 2 ? cq2 : cq3)); LAS float* cs = candS + (wid * 4 + qq) * CAP; LAS unsigned short* ci = candI + (wid * 4 + qq) * CAP;
        if (n > 256) { float nt; n = topk_compact(cs, ci, n, true, nt, lane); }
#pragma unroll
        for (int j = 0; j < 4; ++j) { const int p = lane + 64 * j; SEL[(size_t)t * 256 + (p & 15) * 16 + (p >> 4)] = p < n ? ci[p] : (unsigned short)0xffffu; }
    }
    __syncthreads();
}

__device__ __forceinline__ void sparse_attn(const Params& P, LAS unsigned char* lds, int vbid) {
    int tid_ = threadIdx.x; asm volatile("" : "+v"(tid_));
    const int tid = tid_, lane = tid & 63, wid = tid >> 6, grp = lane >> 2, c4 = lane & 3;
    const int head = vbid & 7, slot = (vbid >> 3) * 8 + wid, nslot = (gridDim.x >> 3) * 8;
    typedef _Float16 half2v __attribute__((ext_vector_type(2)));
    LAS float* red = (LAS float*)(lds + 4096 + wid * 4352);
    const unsigned short* SEL = (const unsigned short*)(P.ws + WS_SEL);
    const unsigned char* Q8 = P.ws + WS_DQ + head * 64 + c4 * 16; const float* QS = (const float*)(P.ws + WS_DQ + (size_t)LP * 512) + head;
    const unsigned char* kvh = P.ws + WS_KV + (size_t)head * LP * 128; f16* mix = (f16*)(P.ws + WS_ACTA);
    int t = NMETA + slot;
    int tlim = L, textra = -1;
    if (gridDim.x == 256 && head < 4) { if (slot < 8) tlim = NMETA + 256 * 60; else if (slot < 40) textra = NMETA + ((slot - 8) & 7) + 256 * (60 + ((slot - 8) >> 3)); }
#define NEXT_T(tc) ((tc) == textra ? -1 : ((tc) + nslot < tlim ? (tc) + nslot : textra))
    u32x4 sela = {0u, 0u, 0u, 0u}, selb = {0u, 0u, 0u, 0u}, q8 = {0u, 0u, 0u, 0u}; float lscale = 0.f;
    if (t < L) { sela = *(const u32x4*)(SEL + (size_t)t * 256 + grp * 16); selb = *(const u32x4*)(SEL + (size_t)t * 256 + grp * 16 + 8); q8 = *(const u32x4*)(Q8 + (size_t)t * 512); lscale = QS[(size_t)t * 8]; }
#define ATTN_ITEM(ALLV) do { \
        unsigned keys[16]; u32x4 kreg[16], vreg[16]; \
        _Pragma("unroll") for (int it = 0; it < 16; ++it) { const unsigned w = it < 8 ? sela[it >> 1] : selb[(it - 8) >> 1]; keys[it] = (it & 1) ? (w >> 16) : (w & 0xffffu); } \
        _Pragma("unroll") for (int it = 0; it < 16; ++it) { const unsigned kk = (ALLV || keys[it] != 0xffffu) ? keys[it] : 0u; kreg[it] = *(const u32x4*)(kvh + (size_t)kk * 128 + c4 * 16); } \
        _Pragma("unroll") for (int it = 0; it < 16; ++it) { const unsigned kk = (ALLV || keys[it] != 0xffffu) ? keys[it] : 0u; vreg[it] = *(const u32x4*)(kvh + (size_t)kk * 128 + 64 + c4 * 16); } \
        const u32x4 qc = q8; const float ls = lscale; \
        { const int tn = NEXT_T(t);     \
          if (tn >= 0) { sela = *(const u32x4*)(SEL + (size_t)tn * 256 + grp * 16); selb = *(const u32x4*)(SEL + (size_t)tn * 256 + grp * 16 + 8); q8 = *(const u32x4*)(Q8 + (size_t)tn * 512); lscale = QS[(size_t)tn * 8]; } } \
        float lg[16]; float mx = -__builtin_inff(); \
        _Pragma("unroll") for (int it = 0; it < 16; ++it) { \
            int ai = 0; \
            _Pragma("unroll") for (int w = 0; w < 4; ++w) ai = __builtin_amdgcn_sdot4((int)kreg[it][w], (int)qc[w], ai, false); \
            ai += __builtin_amdgcn_update_dpp(0, ai, 0xB1, 0xf, 0xf, true);     \
            ai += __builtin_amdgcn_update_dpp(0, ai, 0x4E, 0xf, 0xf, true);     \
            lg[it] = (ALLV || keys[it] != 0xffffu) ? (float)ai * ls : -__builtin_inff(); mx = fmaxf(mx, lg[it]); } \
        mx = fmaxf(mx, __shfl_xor(mx, 4)); mx = fmaxf(mx, __shfl_xor(mx, 8)); mx = fmaxf(mx, __shfl_xor(mx, 16)); mx = fmaxf(mx, __shfl_xor(mx, 32)); \
        half2v o2[8]; float lsum = 0.f; \
        _Pragma("unroll") for (int e = 0; e < 8; ++e) o2[e] = (half2v){(f16)0.f, (f16)0.f}; \
        _Pragma("unroll") for (int it = 0; it < 16; ++it) { \
            const float p = __expf(lg[it] - mx); lsum += p; const f16 ph = (f16)p; const half2v p2 = {ph, ph}; \
            _Pragma("unroll") for (int w = 0; w < 4; ++w) {     \
                const half2v v01 = __builtin_bit_cast(half2v, __builtin_amdgcn_perm(0u, vreg[it][w], 0x010c000cu)), v23 = __builtin_bit_cast(half2v, __builtin_amdgcn_perm(0u, vreg[it][w], 0x030c020cu)); \
                o2[2 * w] = p2 * v01 + o2[2 * w]; o2[2 * w + 1] = p2 * v23 + o2[2 * w + 1]; } } \
        lsum += __shfl_xor(lsum, 4); lsum += __shfl_xor(lsum, 8); lsum += __shfl_xor(lsum, 16); lsum += __shfl_xor(lsum, 32); \
          \
        _Pragma("unroll") for (int e = 0; e < 8; ++e) { red[lane * 17 + 2 * e] = (float)o2[e][0]; red[lane * 17 + 2 * e + 1] = (float)o2[e][1]; } \
        float acc = 0.f; \
        { const int cc = lane >> 4, e = lane & 15; \
          _Pragma("unroll") for (int g = 0; g < 16; ++g) acc += red[(g * 4 + cc) * 17 + e]; } \
        mix[(size_t)(t - NMETA) * D + 512 + head * 64 + lane] = (f16)(acc * __builtin_amdgcn_rcpf(lsum)); \
    } while (0)
#pragma unroll 1
    for (; t >= 0 && t < L; t = NEXT_T(t)) {
        if (t >= 255) ATTN_ITEM(true);
        else ATTN_ITEM(false);
    }
#undef ATTN_ITEM
#undef NEXT_T
    __syncthreads();
}

__device__ __forceinline__ void final_norm(const Params& P) {
    const int tid = threadIdx.x, lane = tid & 63, gw = blockIdx.x * 8 + (tid >> 6), nw = gridDim.x * 8;
    const float* ss3 = (const float*)(P.ws + WS_SS3); const f16* h3 = (const f16*)(P.ws + WS_ACTA);
    for (int r = gw; r < SEQ; r += nw) { const float rs = row_rstd(ss3, 16, r);
#pragma unroll
        for (int i = 0; i < 2; ++i) { const int k = lane * 8 + 512 * i; const half8 v = *(const half8*)(h3 + (size_t)r * D + k); const f32x4 g0 = *(const f32x4*)(P.nf + k), g1 = *(const f32x4*)(P.nf + k + 4); f32x4 o0, o1;
#pragma unroll
            for (int j = 0; j < 4; ++j) { o0[j] = (float)v[j] * rs * g0[j]; o1[j] = (float)v[4 + j] * rs * g1[j]; }
            *(f32x4*)(P.out + (size_t)r * D + k) = o0; *(f32x4*)(P.out + (size_t)r * D + k + 4) = o1; } }
}

#define XB_TMO      128
#define XB_XCNT(j)  (256  + 64 * (j))
#define XB_XSUB(j)  (1280 + 64 * (j))
#define XB_XGEN(j)  (2304 + 64 * (j))
#define XB_TOP      3328
#define XB_TOPGEN   3392
#define XCD_BAR_WORDS 3456
#define XB_SPIN_CAP (1u << 22)
__device__ __forceinline__ unsigned xb_ld(unsigned* p)              { return __hip_atomic_load(p, __ATOMIC_RELAXED, __HIP_MEMORY_SCOPE_AGENT); }
__device__ __forceinline__ unsigned xb_add(unsigned* p, unsigned v) { return __hip_atomic_fetch_add(p, v, __ATOMIC_RELAXED, __HIP_MEMORY_SCOPE_AGENT); }
__device__ __forceinline__ unsigned xb_xcc_id() { return (unsigned)__builtin_amdgcn_s_getreg((3 << 11) | 20) & 0xFu; }
#define XB_SPIN(cond, bar) do { unsigned _sp = 0; while (cond) { __builtin_amdgcn_s_sleep(1); \
    if ((++_sp & 255u) == 0u) { if (xb_ld(&(bar)[XB_TMO])) break; if (_sp > XB_SPIN_CAP) { atomicAdd(&(bar)[XB_TMO], 1u); break; } } } } while (0)
struct XcdBarrier { unsigned* bar; unsigned x; volatile LAS unsigned* st; };
__device__ __forceinline__ XcdBarrier xcd_barrier_post(unsigned* bar, volatile LAS unsigned* st) {
    XcdBarrier b; b.bar = bar; b.x = xb_xcc_id(); b.st = st;
    if (threadIdx.x == 0) (void)xb_add(&bar[XB_XCNT(b.x)], 1u);
    return b;
}
__device__ __forceinline__ void xcd_barrier_complete(unsigned* bar, unsigned x, unsigned& nloc, unsigned& nx) {
    const unsigned G = gridDim.x * gridDim.y * gridDim.z;
    unsigned sum, cnt, mine, sp = 0u;
    for (;;) {
        sum = 0u; cnt = 0u; mine = 0u;
#pragma unroll
        for (unsigned j = 0; j < 16; ++j) { const unsigned c = xb_ld(&bar[XB_XCNT(j)]); sum += c; cnt += (c > 0u) ? 1u : 0u; mine = (j == x) ? c : mine; }
        if (sum == G) break;
        __builtin_amdgcn_s_sleep(1);
        if ((++sp & 255u) == 0u) { if (xb_ld(&bar[XB_TMO])) break; if (sp > XB_SPIN_CAP) { atomicAdd(&bar[XB_TMO], 1u); break; } }
    }
    nloc = mine > 0u ? mine : 1u; nx = cnt > 0u ? cnt : 1u;
}
__device__ __forceinline__ void xcd_barrier(const XcdBarrier& b) {
    asm volatile("s_waitcnt vmcnt(0)" ::: "memory");
    __syncthreads();
    if (threadIdx.x == 0) {
        unsigned* bar = b.bar;
        __builtin_amdgcn_s_waitcnt(0);
        unsigned nloc = b.st[0], nx = b.st[1];
        if (nloc == 0u) { xcd_barrier_complete(bar, b.x, nloc, nx); b.st[0] = nloc; b.st[1] = nx; }
        const unsigned old = xb_add(&bar[XB_XSUB(b.x)], 1u);
        const unsigned gen = old / nloc;
        if (old + 1u == (gen + 1u) * nloc) {
            __builtin_amdgcn_fence(__ATOMIC_RELEASE, "agent");
            asm volatile("s_waitcnt vmcnt(0)" ::: "memory");
            const unsigned og = xb_add(&bar[XB_TOP], 1u);
            const unsigned tg = og / nx;
            if (og + 1u == (tg + 1u) * nx) xb_add(&bar[XB_TOPGEN], 1u);
            else XB_SPIN(xb_ld(&bar[XB_TOPGEN]) == tg, bar);
            __builtin_amdgcn_fence(__ATOMIC_ACQUIRE, "agent");
            xb_add(&bar[XB_XGEN(b.x)], 1u);
            asm volatile("s_waitcnt vmcnt(0)" ::: "memory");
        } else {
            XB_SPIN(xb_ld(&bar[XB_XGEN(b.x)]) == gen, bar);
            __builtin_amdgcn_fence(__ATOMIC_ACQUIRE, "agent");
            asm volatile("s_waitcnt vmcnt(0)" ::: "memory");
        }
    }
    __syncthreads();
}

__global__ void __launch_bounds__(NTHREADS, 2) fwd_kernel(Params P) {
    __shared__ __attribute__((aligned(16))) unsigned char lds_raw[LDS_BYTES];
    LAS unsigned char* lds = (LAS unsigned char*)lds_raw;
    const int tid = threadIdx.x, bid = blockIdx.x, G = gridDim.x;
    unsigned char* ws = P.ws;
    const int lo = P.ph_lo, hi = P.ph_hi;
#ifndef ONLY_PHASE
#define ONLY_PHASE -1
#endif
#define IN(k) ((ONLY_PHASE < 0 || ONLY_PHASE == (k)) && lo <= (k) && (k) < hi)
#define SEAM(k) do { if (IN(k) && IN((k) + 1)) { xcd_barrier(xbar); } } while (0)
    XcdBarrier xbar; xbar.bar = (unsigned*)(ws + WS_BAR); xbar.x = 0; xbar.st = (volatile LAS unsigned*)(lds + LDS_BYTES - 1024 + 16);
    if (hi - lo > 1) {
        if (tid == 0) { xbar.st[0] = 0u; xbar.st[1] = 0u; }
        __syncthreads();
        xbar = xcd_barrier_post((unsigned*)(ws + WS_BAR), (volatile LAS unsigned*)(lds + LDS_BYTES - 1024 + 16));
    }
    LAS int* misc = (LAS int*)(lds + LDS_BYTES - 1024);
    if (hi - lo > 1) {
        if (tid == 0) { const unsigned xcc = xb_xcc_id() & 7u; misc[8] = (int)xcc; misc[9] = (int)xb_add((unsigned*)(ws + WS_CTL) + 32 + 32 * xcc, 1u); }
    }
    int vbid = bid;
    f16* acta = (f16*)(ws + WS_ACTA); f16* Gb = (f16*)(ws + WS_G);
    float* ss0 = (float*)(ws + WS_SS0); float* ss1 = (float*)(ws + WS_SS1); float* ss2 = (float*)(ws + WS_SS2); float* ss3 = (float*)(ws + WS_SS3);
    if (IN(0)) { p0_prologue(P, lds); }
    SEAM(0);
    if (hi - lo > 1 && (G & 7) == 0) {
        if (tid == 0) { bool ok = true; for (int j = 0; j < 8; ++j) ok = ok && (xb_ld((unsigned*)(ws + WS_CTL) + 32 + 32 * j) == (unsigned)(G >> 3)); misc[10] = ok ? misc[9] * 8 + misc[8] : bid; }
        __syncthreads();
        vbid = __builtin_amdgcn_readfirstlane(misc[10]);
        __syncthreads();
    }
    if (IN(1)) {
        pg8::Gemm g{(const f16*)(ws + WS_US), (const f16*)(ws + WS_WGU1), MP, 2 * DFF, D / 2}; pg8::StaticOrder S; S.init(MP, 2 * DFF, G, vbid);
        EpiSwiglu<true> E{Gb, ss0, 1, (const float*)(ws + WS_IQ), (const float*)(ws + WS_WGU1 + (size_t)2 * DFF * D)}; pg8::gemm_phase(lds, g, S, E);
    }
    SEAM(1);
    if (IN(2)) {
        meta_down(P, lds);
        pg8::Gemm g{Gb, (const f16*)(ws + WS_WD1), SEQ, D, DFF}; pg8::StaticOrder S; S.init(SEQ, D, G, vbid);
        EpiResid<true> E{acta, (f16*)P.out, ss1, 0.5f}; pg8::gemm_phase(lds, g, S, E);
    }
    SEAM(2);
    if (IN(3)) {
        pg8::Gemm g{(const f16*)P.out, (const f16*)(ws + WS_WIN), MP, NIN, D}; pg8::StaticOrder S; S.init(MP, NIN, G, vbid);
        EpiInProj E{ss1, (const f32x2*)(ws + WS_ROPE), ws};
        pg8::gemm_phase(lds, g, S, E);
    }
    SEAM(3);
    if (IN(4)) {
        for (int u = bid; u < (NCH - 1) * 4; u += G) gla_a_unit(P, u, lds);
        {
            constexpr int NI8 = 2 * DFF / 64; LAS f16* tl = (LAS f16*)lds;
            if (G > NI8 + 64) {
                if (bid >= G - NI8) prep_weight_i8(P, 4, 2 * DFF, ws + WS_WGU2, (float*)(ws + WS_WGU2 + (size_t)2 * DFF * D), bid - (G - NI8), NI8, lds);
                else { int tbase = 0, cursor = bid;
                    prep_weight(P, 3, D, D, (f16*)(ws + WS_WOUT), cursor, tbase, tl, G - NI8);
                    prep_weight(P, 5, D, DFF, (f16*)(ws + WS_WD2), cursor, tbase, tl, G - NI8); }
            } else { int tbase = 0, cursor = bid;
                prep_weight(P, 3, D, D, (f16*)(ws + WS_WOUT), cursor, tbase, tl, G);
                prep_weight(P, 5, D, DFF, (f16*)(ws + WS_WD2), cursor, tbase, tl, G);
                __syncthreads();
                prep_weight_i8(P, 4, 2 * DFF, ws + WS_WGU2, (float*)(ws + WS_WGU2 + (size_t)2 * DFF * D), bid, G, lds); }
        }
    }
    SEAM(4);
    if (IN(5)) {
        if (bid < 64) gla_scan(P);
        unsigned* ctr = (unsigned*)(ws + WS_CTL); LAS int* bc = (LAS int*)(lds + LDS_BYTES - 1024);
        for (;;) {
            if (tid == 0) bc[0] = (int)atomicAdd(ctr, 1u);
            __syncthreads();
            const int k = bc[0];
            __syncthreads();
            if (k >= 513) break;
            indexer_tile(P, 512 - k, lds);
        }
    }
    SEAM(5);
    if (IN(6)) { for (int u = vbid; u < NCH * 4; u += G) gla_c_unit(P, u, lds); sparse_attn(P, lds, vbid); }
    SEAM(6);
    if (IN(7)) {
        pg8::Gemm g{acta, (const f16*)(ws + WS_WOUT), SEQ, D, D}; pg8::StaticOrder S; S.init(SEQ, D, G, vbid);
        EpiResid<true> E{P.out, (f16*)(ws + WS_US), ss2, 1.0f}; pg8::gemm_phase(lds, g, S, E);
    }
    SEAM(7);
    if (IN(8)) quant_rows_i8((const f16*)(ws + WS_US), ws + WS_DQ, (float*)(ws + WS_IQ), SEQ);
    SEAM(8);
    if (IN(9)) {
        pg8::Gemm g{(const f16*)(ws + WS_DQ), (const f16*)(ws + WS_WGU2), SEQ, 2 * DFF, D / 2}; pg8::StaticOrder S; S.init(SEQ, 2 * DFF, G, vbid);
        EpiSwiglu<true> E{Gb, ss2, 16, (const float*)(ws + WS_IQ), (const float*)(ws + WS_WGU2 + (size_t)2 * DFF * D)}; pg8::gemm_phase(lds, g, S, E);
    }
    SEAM(9);
    if (IN(10)) {
        pg8::Gemm g{Gb, (const f16*)(ws + WS_WD2), SEQ, D, DFF}; pg8::StaticOrder S; S.init(SEQ, D, G, vbid);
        EpiResid<true> E{ws + WS_US, acta, ss3, 0.5f}; pg8::gemm_phase(lds, g, S, E);
    }
    SEAM(10);
    if (IN(11)) final_norm(P);
#undef IN
#undef SEAM
}

extern "C" void kernel_launch(void* const* d_in, const int* in_sizes, int n_in, void* d_out, int out_size, void* d_ws, size_t ws_size, hipStream_t stream) {
    static int grid = 0;
    if (grid == 0) {
        if (n_in != 17 || in_sizes[0] != SEQ * D || out_size != SEQ * D || ws_size < WS_END) { fprintf(stderr, "kernel_launch: unexpected shapes (n_in %d, in0 %d, out %d, ws %zu, need %zu)\n", n_in, n_in > 0 ? in_sizes[0] : -1, out_size, ws_size, (size_t)WS_END); grid = -1; return; }
        int dev = 0, cus = 0, per_cu = 0;
        (void)hipGetDevice(&dev); (void)hipDeviceGetAttribute(&cus, hipDeviceAttributeMultiprocessorCount, dev);
        if (hipOccupancyMaxActiveBlocksPerMultiprocessor(&per_cu, (const void*)fwd_kernel, NTHREADS, 0) != hipSuccess || per_cu < 1) { fprintf(stderr, "kernel_launch: occupancy query says %d blocks per CU\n", per_cu); per_cu = 1; }
        (void)hipGetLastError();
        grid = cus;
        if (grid % 8 != 0 || grid < 64) { fprintf(stderr, "kernel_launch: unexpected CU count %d\n", cus); }
    }
    if (grid < 0) return;
    if (hipMemsetAsync((char*)d_ws + WS_CTL, 0, CTL_BYTES, stream) != hipSuccess) { fprintf(stderr, "kernel_launch: memset failed\n"); return; }
    Params p{};
    const float** pp = (const float**)&p;
    for (int i = 0; i < 17; ++i) pp[i] = (const float*)d_in[i];
    p.out = (float*)d_out; p.ws = (unsigned char*)d_ws;
#if MODE == 0
    for (int ph = 0; ph < NPHASE; ++ph) { p.ph_lo = ph; p.ph_hi = ph + 1; hipLaunchKernelGGL(fwd_kernel, dim3(grid), dim3(NTHREADS), 0, stream, p); }
#else
    p.ph_lo = 0; p.ph_hi = NPHASE;
    void* args[] = {&p};
    hipError_t e = hipLaunchCooperativeKernel((const void*)fwd_kernel, dim3(grid), dim3(NTHREADS), args, 0, stream);
    if (e != hipSuccess) fprintf(stderr, "cooperative launch failed: %s (grid %d)\n", hipGetErrorString(e), grid);
#endif
}
```

```cpp
#include <hip/hip_runtime.h>
#include <cstdio>
#include <cstdint>

#ifndef MODE
#define MODE 1
#endif

#define LAS __attribute__((address_space(3)))
typedef _Float16 f16;
typedef _Float16 half8 __attribute__((ext_vector_type(8)));
typedef _Float16 half4 __attribute__((ext_vector_type(4)));
typedef float f32x2 __attribute__((ext_vector_type(2)));
typedef float f32x4 __attribute__((ext_vector_type(4)));
typedef float f32x16 __attribute__((ext_vector_type(16)));
typedef unsigned u32x2 __attribute__((ext_vector_type(2)));
typedef unsigned u32x4 __attribute__((ext_vector_type(4)));
typedef int i32x4 __attribute__((ext_vector_type(4)));

constexpr int D = 1024, SEQ = 16384, NMETA = 16, L = SEQ + NMETA, DFF = 2816;
constexpr int MP = 16640;
constexpr int LP = 16512;
constexpr int NIN = 3840;
constexpr int NCH = 257;
constexpr float EPS = 1e-6f;
constexpr int NTHREADS = 512;
constexpr int LDS_BYTES = 155648 + 1024;
constexpr int NPHASE = 12;

constexpr size_t al256(size_t x) { return (x + 255) & ~(size_t)255; }
constexpr size_t WS_CTL = 0;
constexpr size_t CTL_BYTES = 32768;
constexpr size_t WS_BAR = 2048;
constexpr size_t WS_WGU1 = CTL_BYTES;
constexpr size_t WS_WD1 = WS_WGU1 + (size_t)2 * DFF * D * 2;
constexpr size_t WS_WIN = WS_WD1 + (size_t)D * DFF * 2;
constexpr size_t WS_WOUT = WS_WIN + (size_t)NIN * D * 2;
constexpr size_t WS_WGU2 = WS_WOUT + (size_t)D * D * 2;
constexpr size_t WS_WD2 = WS_WGU2 + (size_t)2 * DFF * D * 2;
constexpr size_t WS_ACTA = WS_WD2 + (size_t)D * DFF * 2;
constexpr size_t WS_G = WS_ACTA + (size_t)MP * D * 2;
constexpr size_t WS_US = WS_G + (size_t)MP * DFF * 2;
constexpr size_t WS_DQ = WS_US + (size_t)NCH * 4 * 64 * 128 * 4;
constexpr size_t WS_IQ = WS_DQ + (size_t)LP * 512 * 2;
constexpr size_t WS_SEL = WS_IQ + (size_t)LP * 512 * 2;
constexpr size_t WS_ROPE = WS_SEL + (size_t)LP * 256 * 2;
constexpr size_t WS_IW = WS_ROPE + al256((size_t)L * 32 * 8);
constexpr size_t WS_GA = WS_IW + (size_t)LP * 8 * 4;
constexpr size_t WS_DECAY = WS_GA + (size_t)LP * 16 * 4;
constexpr size_t WS_SS0 = WS_DECAY + al256((size_t)NCH * 256 * 4);
constexpr size_t WS_SS1 = WS_SS0 + (size_t)MP * 4;
constexpr size_t WS_SS2 = WS_SS1 + (size_t)MP * 64;
constexpr size_t WS_SS3 = WS_SS2 + (size_t)MP * 64;
constexpr size_t WS_END = WS_SS3 + (size_t)MP * 64;
constexpr size_t WS_KV = WS_G;
constexpr size_t WS_GQ = WS_KV + (size_t)8 * LP * 128 * 2;
constexpr size_t WS_GK = WS_GQ + (size_t)LP * 256 * 2;
constexpr size_t WS_GV = WS_GK + (size_t)LP * 256 * 2;
constexpr size_t WS_GR = WS_GV + (size_t)LP * 512 * 2;
constexpr size_t WS_IK = WS_GR + (size_t)LP * 512 * 2;
constexpr size_t WS_ALIAS_END = WS_IK + (size_t)LP * 64 * 2;
static_assert(WS_ALIAS_END <= WS_US, "aliased buffers exceed G");
static_assert(WS_END <= (size_t)256 * 1024 * 1024, "workspace exceeds 256 MiB");
static_assert((size_t)SEQ * D * 2 <= (size_t)NCH * 4 * 64 * 128 * 4, "h2_16 alias");

struct Params {
    const float* x; const float* meta; const float* n1; const float* wg1; const float* wu1; const float* wd1;
    const float* nmix; const float* win; const float* wa2; const float* ba; const float* hn; const float* wout;
    const float* n2; const float* wg2; const float* wu2; const float* wd2; const float* nf;
    float* out; unsigned char* ws; int ph_lo, ph_hi;
};

namespace pg8 {
constexpr int BM = 256, BK = 64, HALF = 128, HTB = HALF * BK * 2, STAGE_BYTES = 8 * HTB, NXCD = 8, WGM = 8;
__host__ __device__ __forceinline__ int lds_byte(int r, int c) { const int st = (r >> 4) * 2 + (c >> 5), rr = r & 15, cc = c & 31, ob = rr * 64 + cc * 2; return st * 1024 + (ob ^ (((ob >> 9) & 1) << 5)); }
__host__ __device__ __forceinline__ int perm32(int rho) { const int n = rho >> 4, i = rho & 15; return 8 * (i >> 2) + 4 * n + (i & 3); }
__host__ __device__ __forceinline__ void stage_rc(int b, int& R, int& C) { const int st = b / 1024, sb = b % 1024, swz = sb ^ (((sb >> 9) & 1) << 5); R = (st >> 1) * 16 + swz / 64; C = (st & 1) * 32 + (swz % 64) / 2; }
struct Unit { int pm, pn; };
struct Gemm { const f16* A; const f16* Bt; int M, N, K; };
struct StaticOrder {
    int nM, nN, nwg, G, c;
    __host__ __device__ void init(int M, int N, int G_, int c_) { nM = M / BM; nN = N / BM; nwg = nM * nN; G = G_; c = c_; }
    __host__ __device__ bool next(int i, Unit& u) const {
        const long Lx = (long)i * G + c; if (Lx >= nwg) return false;
        int wgid = (int)Lx; { const int q = nwg / NXCD, r = nwg % NXCD, xcd = wgid % NXCD, off = wgid / NXCD; wgid = (xcd < r ? xcd * (q + 1) : r * (q + 1) + (xcd - r) * q) + off; }
        const int nig = WGM * nN, gid = wgid / nig, fm = gid * WGM, gsz = (nM - fm) < WGM ? (nM - fm) : WGM;
        u.pm = fm + ((wgid % nig) % gsz); u.pn = (wgid % nig) / gsz; return true;
    }
};
template <class Epi>
__device__ __forceinline__ void gemm_phase(LAS unsigned char* lds, const Gemm g, const StaticOrder& S, const Epi& E) {
    int tid_ = threadIdx.x; asm volatile("" : "+v"(tid_));
    const int tid = tid_, wid = __builtin_amdgcn_readfirstlane(tid >> 6), lane = tid & 63, wr = wid >> 2, wc = wid & 3, fr = lane & 15, fq = lane >> 4;
    const int K = g.K, nt = K / BK;
    unsigned voffA[2], voffB[2];
#pragma unroll
    for (int i = 0; i < 2; ++i) { int R, C; stage_rc(tid * 16 + i * 8192, R, C); const int Rb = (R & ~31) + perm32(R & 31); voffA[i] = (unsigned)(R * K + C) * 2u; voffB[i] = (unsigned)(Rb * K + C) * 2u; }
    const size_t kstep = (size_t)(BK * 2);
    const size_t hstep = (size_t)HALF * K * 2;
    const size_t tstep = 2 * hstep;
    const unsigned ldsw = (unsigned)wid * 1024u;
    const int aoff = lds_byte(wr * 64 + fr, fq * 8), boff = lds_byte(wc * 32 + fr, fq * 8);
#define PG8_SA(b, h) (((b) * 2 + (h)) * HTB)
#define PG8_SB(b, h) ((4 + (b) * 2 + (h)) * HTB)
#define PG8_STAGE(bufoff, gbase, voff) do { _Pragma("unroll") for (int _i = 0; _i < 2; ++_i) \
        __builtin_amdgcn_global_load_lds((const unsigned*)((const char*)(gbase) + (voff)[_i]), (LAS unsigned*)(lds + (bufoff) + ldsw + _i * 8192), 16, 0, 0); } while (0)
#define PG8_LDA(dst, b, h) do { _Pragma("unroll") for (int m = 0; m < 4; ++m) _Pragma("unroll") for (int k = 0; k < 2; ++k) dst[m][k] = *(const LAS half8*)(lds + PG8_SA(b, h) + aoff + m * 2048 + k * 1024); } while (0)
#define PG8_LDB(dst, b, h) do { _Pragma("unroll") for (int n = 0; n < 2; ++n) _Pragma("unroll") for (int k = 0; k < 2; ++k) dst[n][k] = *(const LAS half8*)(lds + PG8_SB(b, h) + boff + n * 2048 + k * 1024); } while (0)
#define PG8_MMA(ai, bj, At, Bt) do { __builtin_amdgcn_s_setprio(1); _Pragma("unroll") for (int m = 0; m < 4; ++m) _Pragma("unroll") for (int n = 0; n < 2; ++n) _Pragma("unroll") for (int k = 0; k < 2; ++k) { \
        if constexpr (Epi::I8) acc[ai][bj][m][n] = __builtin_bit_cast(f32x4, __builtin_amdgcn_mfma_i32_16x16x64_i8(__builtin_bit_cast(i32x4, Bt[n][k]), __builtin_bit_cast(i32x4, At[m][k]), __builtin_bit_cast(i32x4, acc[ai][bj][m][n]), 0, 0, 0)); \
        else acc[ai][bj][m][n] = __builtin_amdgcn_mfma_f32_16x16x32_f16(Bt[n][k], At[m][k], acc[ai][bj][m][n], 0, 0, 0); } __builtin_amdgcn_s_setprio(0); } while (0)
#define PG8_WAIT_V(n) asm volatile("s_waitcnt vmcnt(" #n ")" ::: "memory")
#define PG8_WAIT_L(n) asm volatile("s_waitcnt lgkmcnt(" #n ")" ::: "memory")
#define PG8_BAR __builtin_amdgcn_s_barrier()
#define PG8_SCHED __builtin_amdgcn_sched_barrier(0)
    Unit cur, nxt; int ui = 0;
    if (!S.next(0, cur)) return;
    f32x4 acc[2][2][4][2];
#pragma unroll
    for (int a = 0; a < 2; ++a)
#pragma unroll
        for (int b = 0; b < 2; ++b)
#pragma unroll
            for (int m = 0; m < 4; ++m)
#pragma unroll
                for (int n = 0; n < 2; ++n) acc[a][b][m][n] = (f32x4){0.f, 0.f, 0.f, 0.f};
    half8 At[4][2], B0[2][2], B1[2][2];
    const char* cA = (const char*)g.A + (size_t)cur.pm * tstep; const char* cB = (const char*)g.Bt + (size_t)cur.pn * tstep;
    PG8_STAGE(PG8_SB(0, 0), cB, voffB); PG8_STAGE(PG8_SA(0, 0), cA, voffA); PG8_STAGE(PG8_SB(0, 1), cB + hstep, voffB); PG8_STAGE(PG8_SA(0, 1), cA + hstep, voffA);
    if (wr == 1) PG8_BAR;
    PG8_WAIT_V(4); PG8_BAR;
    PG8_STAGE(PG8_SB(1, 0), cB + kstep, voffB); PG8_STAGE(PG8_SA(1, 0), cA + kstep, voffA); PG8_STAGE(PG8_SB(1, 1), cB + hstep + kstep, voffB);
    PG8_WAIT_V(6); PG8_BAR;
    for (;;) {
        const bool has_next = S.next(ui + 1, nxt);
        const char* nA = has_next ? (const char*)g.A + (size_t)nxt.pm * tstep : cA; const char* nB = has_next ? (const char*)g.Bt + (size_t)nxt.pn * tstep : cB;
        for (int t = 0; t < nt; t += 2) {
            const bool last = (t == nt - 2);
            const char* a1 = cA + (size_t)(t + 1) * kstep;
            const char* a2 = last ? nA : cA + (size_t)(t + 2) * kstep; const char* b2 = last ? nB : cB + (size_t)(t + 2) * kstep;
            const char* a3 = a2 + kstep; const char* b3 = b2 + kstep;
            PG8_LDB(B0, 0, 0); PG8_SCHED; PG8_LDA(At, 0, 0); PG8_STAGE(PG8_SA(1, 1), a1 + hstep, voffA);
            PG8_WAIT_L(8); PG8_BAR; PG8_WAIT_L(0); PG8_MMA(0, 0, At, B0); PG8_BAR; PG8_SCHED;
            PG8_LDB(B1, 0, 1); PG8_STAGE(PG8_SB(0, 0), b2, voffB);
            PG8_BAR; PG8_WAIT_L(0); PG8_MMA(0, 1, At, B1); PG8_BAR;
            PG8_LDA(At, 0, 1); PG8_STAGE(PG8_SA(0, 0), a2, voffA);
            PG8_BAR; PG8_WAIT_L(0); PG8_MMA(1, 0, At, B0); PG8_BAR; PG8_SCHED;
            PG8_STAGE(PG8_SB(0, 1), b2 + hstep, voffB);
            PG8_WAIT_V(6); PG8_BAR; PG8_MMA(1, 1, At, B1); PG8_BAR;
            PG8_LDB(B0, 1, 0); PG8_SCHED; PG8_LDA(At, 1, 0); PG8_STAGE(PG8_SA(0, 1), a2 + hstep, voffA);
            PG8_WAIT_L(8); PG8_BAR; PG8_WAIT_L(0); PG8_MMA(0, 0, At, B0); PG8_BAR; PG8_SCHED;
            PG8_LDB(B1, 1, 1); PG8_STAGE(PG8_SB(1, 0), b3, voffB);
            PG8_BAR; PG8_WAIT_L(0); PG8_MMA(0, 1, At, B1); PG8_BAR;
            PG8_LDA(At, 1, 1); PG8_STAGE(PG8_SA(1, 0), a3, voffA);
            PG8_BAR; PG8_WAIT_L(0); PG8_MMA(1, 0, At, B0); PG8_BAR; PG8_SCHED;
            PG8_STAGE(PG8_SB(1, 1), b3 + hstep, voffB);
            PG8_WAIT_V(6); PG8_BAR; PG8_MMA(1, 1, At, B1); PG8_BAR;
        }
        if constexpr (Epi::I8) {
#pragma unroll
            for (int a = 0; a < 2; ++a)
#pragma unroll
                for (int b = 0; b < 2; ++b)
#pragma unroll
                    for (int m = 0; m < 4; ++m)
#pragma unroll
                        for (int n = 0; n < 2; ++n) { const i32x4 v = __builtin_bit_cast(i32x4, acc[a][b][m][n]); acc[a][b][m][n] = (f32x4){(float)v[0], (float)v[1], (float)v[2], (float)v[3]}; }
        }
        E(acc, cur, wr, wc, fr, fq);
        if (!has_next) break;
#pragma unroll
        for (int a = 0; a < 2; ++a)
#pragma unroll
            for (int b = 0; b < 2; ++b)
#pragma unroll
                for (int m = 0; m < 4; ++m)
#pragma unroll
                    for (int n = 0; n < 2; ++n) acc[a][b][m][n] = (f32x4){0.f, 0.f, 0.f, 0.f};
        cur = nxt; cA = nA; cB = nB; ++ui;
    }
    PG8_WAIT_V(0);
    if (wr == 0) PG8_BAR;
    PG8_BAR;
#undef PG8_SA
#undef PG8_SB
#undef PG8_STAGE
#undef PG8_LDA
#undef PG8_LDB
#undef PG8_MMA
#undef PG8_WAIT_V
#undef PG8_WAIT_L
#undef PG8_BAR
#undef PG8_SCHED
}
}

__device__ __forceinline__ float silu_f(float v) { return v * __builtin_amdgcn_rcpf(1.0f + __expf(-v)); }
__device__ __forceinline__ half4 to_half4(f32x4 v) { half4 h; h[0] = (f16)v[0]; h[1] = (f16)v[1]; h[2] = (f16)v[2]; h[3] = (f16)v[3]; return h; }

__device__ __forceinline__ float row_rstd(const float* ss, int np, int row) {
    float s;
    if (np == 1) s = ss[row];
    else { const f32x4* p = (const f32x4*)(ss + (size_t)row * 16); const f32x4 a = p[0], b = p[1], c = p[2], d = p[3];
        s = (((a[0] + a[1]) + (a[2] + a[3])) + ((b[0] + b[1]) + (b[2] + b[3]))) + (((c[0] + c[1]) + (c[2] + c[3])) + ((d[0] + d[1]) + (d[2] + d[3]))); }
    return rsqrtf(s * (1.0f / D) + EPS);
}
template <bool I8_> struct EpiSwiglu {
    static constexpr bool I8 = I8_;
    f16* G; const float* ss; int np; const float* sa; const float* sw;
    __device__ __forceinline__ void operator()(const f32x4 (&acc)[2][2][4][2], const pg8::Unit& u, int wr, int wc, int fr_, int fq_) const {
        int fr = fr_, fq = fq_; asm volatile("" : "+v"(fr), "+v"(fq));
        f32x4 swg[2], swu[2];
        if constexpr (I8) {
#pragma unroll
            for (int n = 0; n < 2; ++n) { swg[n] = *(const f32x4*)(sw + u.pn * 256 + wc * 32 + 8 * fq + 4 * n); swu[n] = *(const f32x4*)(sw + u.pn * 256 + 128 + wc * 32 + 8 * fq + 4 * n); }
        }
#pragma unroll
        for (int ai = 0; ai < 2; ++ai)
#pragma unroll
            for (int m = 0; m < 4; ++m) {
                const int row = u.pm * 256 + ai * 128 + wr * 64 + m * 16 + fr;
                float rs = row_rstd(ss, np, row); if constexpr (I8) rs *= sa[row];
                const float ce = -1.4426950408889634f * rs, rs2 = rs * rs; half8 o;
#pragma unroll
                for (int n = 0; n < 2; ++n) {
                    f32x4 g = acc[ai][0][m][n], u = acc[ai][1][m][n];
                    if constexpr (I8) { g = g * swg[n]; u = u * swu[n]; }
                    const f32x4 t = g * ce; f32x4 e, r;
#pragma unroll
                    for (int j = 0; j < 4; ++j) e[j] = __builtin_amdgcn_exp2f(t[j]);
                    const f32x4 d = e + 1.0f;
#pragma unroll
                    for (int j = 0; j < 4; ++j) r[j] = __builtin_amdgcn_rcpf(d[j]);
                    const f32x4 w = (g * u) * (r * rs2);
#pragma unroll
                    for (int j = 0; j < 4; ++j) o[4 * n + j] = (f16)w[j];
                }
                *(half8*)(G + (size_t)row * DFF + u.pn * 128 + wc * 32 + 8 * fq) = o;
            }
    }
};
template <bool SRC16> struct EpiResid {
    static constexpr bool I8 = false;
    const void* src; f16* h16; float* ss; float alpha;
    __device__ __forceinline__ void operator()(const f32x4 (&acc)[2][2][4][2], const pg8::Unit& u, int wr, int wc, int fr_, int fq_) const {
        int fr = fr_, fq = fq_; asm volatile("" : "+v"(fr), "+v"(fq));
#pragma unroll
        for (int ai = 0; ai < 2; ++ai)
#pragma unroll
            for (int m = 0; m < 4; ++m) {
                const int row = u.pm * 256 + ai * 128 + wr * 64 + m * 16 + fr; float part = 0.f;
#pragma unroll
                for (int bj = 0; bj < 2; ++bj) {
                    const size_t off = (size_t)row * D + u.pn * 256 + bj * 128 + wc * 32 + 8 * fq; half8 h; f32x4 sv[2];
                    if (SRC16) { const half8 s8 = *(const half8*)((const f16*)src + off);
#pragma unroll
                        for (int j = 0; j < 4; ++j) { sv[0][j] = (float)s8[j]; sv[1][j] = (float)s8[4 + j]; } }
                    else { sv[0] = *(const f32x4*)((const float*)src + off); sv[1] = *(const f32x4*)((const float*)src + off + 4); }
#pragma unroll
                    for (int n = 0; n < 2; ++n) {
                        const f32x4 o = sv[n] + alpha * acc[ai][bj][m][n];
#pragma unroll
                        for (int j = 0; j < 4; ++j) h[4 * n + j] = (f16)o[j];
                        part += (o[0] * o[0] + o[1] * o[1]) + (o[2] * o[2] + o[3] * o[3]);
                    }
                    *(half8*)(h16 + off) = h;
                }
                part += __shfl_xor(part, 16); part += __shfl_xor(part, 32);
                if (fq == 0) ss[(size_t)row * 16 + u.pn * 4 + wc] = part;
            }
    }
};
constexpr float K_I8_SCALE = 127.0f / 8.0f;
__device__ __forceinline__ void rope8(const f32x4 (&x1)[2], const f32x4 (&x2)[2], const f32x2* rp, float sc, float (&o1)[8], float (&o2)[8]) {
#pragma unroll
    for (int n = 0; n < 2; ++n) {
        const f32x4 cs0 = *(const f32x4*)(rp + 4 * n), cs1 = *(const f32x4*)(rp + 4 * n + 2);
        o1[4 * n + 0] = (x1[n][0] * cs0[0] - x2[n][0] * cs0[1]) * sc; o2[4 * n + 0] = (x2[n][0] * cs0[0] + x1[n][0] * cs0[1]) * sc;
        o1[4 * n + 1] = (x1[n][1] * cs0[2] - x2[n][1] * cs0[3]) * sc; o2[4 * n + 1] = (x2[n][1] * cs0[2] + x1[n][1] * cs0[3]) * sc;
        o1[4 * n + 2] = (x1[n][2] * cs1[0] - x2[n][2] * cs1[1]) * sc; o2[4 * n + 2] = (x2[n][2] * cs1[0] + x1[n][2] * cs1[1]) * sc;
        o1[4 * n + 3] = (x1[n][3] * cs1[2] - x2[n][3] * cs1[3]) * sc; o2[4 * n + 3] = (x2[n][3] * cs1[2] + x1[n][3] * cs1[3]) * sc;
    }
}
__device__ __forceinline__ u32x2 pack_i8x8(const float (&v)[8]) {
    u32x2 r;
#pragma unroll
    for (int w = 0; w < 2; ++w) { unsigned word = 0u;
#pragma unroll
        for (int j = 0; j < 4; ++j) { const int q = (int)__builtin_rintf(fminf(fmaxf(v[4 * w + j] * K_I8_SCALE, -127.f), 127.f)); word |= ((unsigned)q & 0xffu) << (8 * j); }
        r[w] = word; }
    return r;
}
__device__ __forceinline__ u32x2 pack_bf8x8(const float (&v)[8]) {
    u32x2 r;
#pragma unroll
    for (int w = 0; w < 2; ++w) { int word = __builtin_amdgcn_cvt_pk_bf8_f32(v[4 * w], v[4 * w + 1], 0, false); word = __builtin_amdgcn_cvt_pk_bf8_f32(v[4 * w + 2], v[4 * w + 3], word, true); r[w] = (unsigned)word; }
    return r;
}
struct EpiInProj {
    static constexpr bool I8 = false;
    const float* ss; const f32x2* rope; unsigned char* ws;
    __device__ __forceinline__ void operator()(const f32x4 (&acc)[2][2][4][2], const pg8::Unit& u, int wr, int wc, int fr_, int fq_) const {
        int fr = fr_, fq = fq_; asm volatile("" : "+v"(fr), "+v"(fq));
        const int pn = u.pn;
        if (pn >= 8 && pn <= 11) {
            unsigned char* lb = (pn <= 9) ? ws + WS_KV + (size_t)((pn - 8) * 4 + wc) * LP * 128 + 8 * fq
                                          : ws + WS_KV + (size_t)((pn - 10) * 4 + (wc >> 1)) * LP * 128 + 64 + (wc & 1) * 32 + 8 * fq;
#pragma unroll
            for (int ai = 0; ai < 2; ++ai)
#pragma unroll
                for (int m = 0; m < 4; ++m) {
                    const int p = u.pm * 256 + ai * 128 + wr * 64 + m * 16 + fr;
                    const int t = p < SEQ ? p + NMETA : p - SEQ;
                    if (p < L) {
                        const float sc = row_rstd(ss, 16, p);
                        if (pn <= 9) {
                            float o1[8], o2[8]; rope8(acc[ai][0][m], acc[ai][1][m], rope + (size_t)t * 32 + 8 * fq, sc, o1, o2);
                            unsigned char* d8 = lb + (size_t)t * 128; *(u32x2*)d8 = pack_i8x8(o1); *(u32x2*)(d8 + 32) = pack_i8x8(o2);
                        } else {
#pragma unroll
                            for (int bj = 0; bj < 2; ++bj) { float v[8];
#pragma unroll
                                for (int j = 0; j < 4; ++j) { v[j] = acc[ai][bj][m][0][j] * sc; v[4 + j] = acc[ai][bj][m][1][j] * sc; }
                                *(u32x2*)(lb + (size_t)t * 128 + (size_t)bj * 2 * LP * 128) = pack_bf8x8(v); }
                        }
                    }
                    asm volatile("" ::: "memory");
                }
            return;
        }
        int mode = 0, stride = 256; float scale = 1.0f; f16* lanebase;
        if (pn == 0) lanebase = (f16*)(ws + WS_GQ) + wc * 32 + 8 * fq;
        else if (pn == 1) lanebase = (f16*)(ws + WS_GK) + wc * 32 + 8 * fq;
        else if (pn <= 3) { lanebase = (f16*)(ws + WS_GV) + (pn - 2) * 256 + wc * 32 + 8 * fq; stride = 512; }
        else if (pn <= 5) { lanebase = (f16*)(ws + WS_GR) + (pn - 4) * 256 + wc * 32 + 8 * fq; stride = 512; }
        else if (pn <= 7) { lanebase = (f16*)(ws + WS_DQ); mode = 6; scale = 0.125f; }
        else if (pn <= 13) { lanebase = (f16*)(ws + WS_IQ) + (pn - 12) * 256 + wc * 64 + 8 * fq; stride = 512; mode = 1; scale = 0.125f; }
        else { lanebase = (f16*)(ws + WS_IK) + 8 * fq; stride = 64; mode = wc == 0 ? 1 : (wc == 1 ? 2 : 3); }
#pragma unroll
        for (int ai = 0; ai < 2; ++ai)
#pragma unroll
            for (int m = 0; m < 4; ++m) {
                const int p = u.pm * 256 + ai * 128 + wr * 64 + m * 16 + fr;
                const int t = p < SEQ ? p + NMETA : p - SEQ;
                if (p < L && mode != 3) {
                    const float rs = row_rstd(ss, 16, p);
                    if (mode == 6) {
                        float o1[8], o2[8]; rope8(acc[ai][0][m], acc[ai][1][m], rope + (size_t)t * 32 + 8 * fq, rs * scale, o1, o2);
                        float qm = 1e-20f;
#pragma unroll
                        for (int j = 0; j < 8; ++j) qm = fmaxf(qm, fmaxf(fabsf(o1[j]), fabsf(o2[j])));
                        qm = fmaxf(qm, __shfl_xor(qm, 16)); qm = fmaxf(qm, __shfl_xor(qm, 32));
                        const float qsc = 127.0f * __builtin_amdgcn_rcpf(qm); u32x2 w1, w2;
#pragma unroll
                        for (int w = 0; w < 2; ++w) { unsigned a = 0u, b = 0u;
#pragma unroll
                            for (int j = 0; j < 4; ++j) { a |= ((unsigned)(int)__builtin_rintf(o1[4 * w + j] * qsc) & 0xffu) << (8 * j); b |= ((unsigned)(int)__builtin_rintf(o2[4 * w + j] * qsc) & 0xffu) << (8 * j); }
                            w1[w] = a; w2[w] = b; }
                        const int head = (pn - 6) * 4 + wc; unsigned char* qrow = ws + WS_DQ + (size_t)t * 512 + head * 64 + 8 * fq;
                        *(u32x2*)qrow = w1; *(u32x2*)(qrow + 32) = w2;
                        if (fq == 0) ((float*)(ws + WS_DQ + (size_t)LP * 512))[(size_t)t * 8 + head] = qm * (1.0f / (127.0f * K_I8_SCALE));
                    } else if (mode == 1) {
                        float o1[8], o2[8]; rope8(acc[ai][0][m], acc[ai][1][m], rope + (size_t)t * 32 + 8 * fq, rs * scale, o1, o2);
                        half8 h1, h2;
#pragma unroll
                        for (int j = 0; j < 8; ++j) { h1[j] = (f16)o1[j]; h2[j] = (f16)o2[j]; }
                        f16* dst = lanebase + (size_t)t * stride; *(half8*)dst = h1; *(half8*)(dst + 32) = h2;
                    } else if (mode == 2) {
                        if (fq < 2) { float* gp = (float*)(ws + WS_GA) + (size_t)t * 16 + 8 * fq; *(f32x4*)gp = acc[ai][0][m][0] * rs; *(f32x4*)(gp + 4) = acc[ai][0][m][1] * rs; }
                        else if (fq == 2) { float* ip = (float*)(ws + WS_IW) + (size_t)t * 8; const float r2 = rs * 0.35355339059327373f; *(f32x4*)ip = acc[ai][0][m][0] * r2; *(f32x4*)(ip + 4) = acc[ai][0][m][1] * r2; }
                    } else {
#pragma unroll
                        for (int bj = 0; bj < 2; ++bj) { half8 h;
#pragma unroll
                            for (int j = 0; j < 4; ++j) { h[j] = (f16)(acc[ai][bj][m][0][j] * rs); h[4 + j] = (f16)(acc[ai][bj][m][1][j] * rs); }
                            *(half8*)(lanebase + (size_t)t * stride + bj * 128) = h; }
                    }
                }
                asm volatile("" ::: "memory");
            }
    }
};

__device__ __forceinline__ const float* w_src(const Params& P, int kind, int n, int& ld, const float*& gain) {
    switch (kind) {
    case 0: case 4: { const int pn = n >> 8, bj = (n >> 7) & 1, cc = n & 127; ld = DFF; gain = kind == 0 ? P.n1 : P.n2;
        const float* w = kind == 0 ? (bj ? P.wu1 : P.wg1) : (bj ? P.wu2 : P.wg2); return w + pn * 128 + cc; }
    case 1: ld = D; gain = nullptr; return P.wd1 + n;
    case 5: ld = D; gain = nullptr; return P.wd2 + n;
    case 3: ld = D; gain = nullptr; return P.wout + n;
    default: { ld = 3672; gain = P.nmix; const int pn = n >> 8, c = n & 255, bj = c >> 7, hh = (c >> 5) & 3, dd = c & 31; int j;
        if (pn == 0) j = c; else if (pn == 1) j = 256 + c; else if (pn <= 3) j = 512 + (pn - 2) * 256 + c; else if (pn <= 5) j = 1024 + (pn - 4) * 256 + c;
        else if (pn <= 7) j = 1552 + (pn - 6) * 256 + hh * 64 + bj * 32 + dd;
        else if (pn <= 9) j = 2064 + (pn - 8) * 256 + hh * 64 + bj * 32 + dd;
        else if (pn <= 11) j = 2576 + (pn - 10) * 256 + c;
        else if (pn <= 13) j = 3088 + (pn - 12) * 256 + hh * 64 + bj * 32 + dd;
        else { if (c < 32) j = 3600 + c; else if (c < 48) j = 1536 + (c - 32); else if (c < 56) j = 3664 + (c - 48); else if (c >= 128 && c < 160) j = 3600 + 32 + (c - 128); else j = -1; }
        return j < 0 ? nullptr : P.win + j; }
    }
}
__device__ __forceinline__ void prep_weight(const Params& P, const int kind, const int N, const int K, f16* dst, int& cursor, int& tbase, LAS f16* tl, const int G) {
    const int tid = threadIdx.x, tn = N / 64, tk = K / 256, ntile = tn * tk;
    const int n = tid & 63, kk0 = tid >> 6;
    float v[32], vn[32];
#define PREP_LOAD(dstv, tI) do { const int n0_ = ((tI) % tn) * 64, k0_ = ((tI) / tn) * 256; int ld; const float* gain; const float* col = w_src(P, kind, n0_ + n, ld, gain); \
        _Pragma("unroll") for (int i = 0; i < 32; ++i) dstv[i] = col ? col[(size_t)(k0_ + kk0 + 8 * i) * ld] : 0.f; \
        if (gain) { _Pragma("unroll") for (int i = 0; i < 32; ++i) dstv[i] *= gain[k0_ + kk0 + 8 * i]; } } while (0)
    if (cursor < tbase + ntile) PREP_LOAD(v, cursor - tbase);
#pragma unroll 1
    for (; cursor < tbase + ntile; cursor += G) {
        const int tI = cursor - tbase, n0 = (tI % tn) * 64, k0 = (tI / tn) * 256;
        const bool more = cursor + G < tbase + ntile;
        if (more) PREP_LOAD(vn, tI + G);
#pragma unroll
        for (int i = 0; i < 32; ++i) tl[n * 264 + kk0 + 8 * i] = (f16)v[i];
        __syncthreads();
        { const int nr = tid >> 3, seg = tid & 7;
#pragma unroll
          for (int j = 0; j < 4; ++j) *(half8*)(dst + (size_t)(n0 + nr) * K + k0 + (seg + 8 * j) * 8) = *(const LAS half8*)(tl + nr * 264 + (seg + 8 * j) * 8); }
        __syncthreads();
        if (more) {
#pragma unroll
            for (int i = 0; i < 32; ++i) v[i] = vn[i];
        }
    }
#undef PREP_LOAD
    tbase += ntile;
}
__device__ __forceinline__ void prep_weight_i8(const Params& P, const int kind, const int N, unsigned char* dst, float* sw, int first, int step, LAS unsigned char* lds) {
    const int tid = threadIdx.x, n = tid & 63, kk0 = tid >> 6;
    LAS float* pmax = (LAS float*)lds; LAS unsigned* img = (LAS unsigned*)(lds + 2048);
#pragma unroll 1
    for (int task = first; task < N / 64; task += step) {
        const int n0 = task * 64; int ld; const float* gain; const float* col = w_src(P, kind, n0 + n, ld, gain);
        float v[128]; float mx = 0.f;
#pragma unroll
        for (int i = 0; i < 128; ++i) v[i] = col ? col[(size_t)(kk0 * 128 + i) * ld] : 0.f;
        if (gain) {
#pragma unroll
            for (int i = 0; i < 128; ++i) v[i] *= gain[kk0 * 128 + i];
        }
#pragma unroll
        for (int i = 0; i < 128; ++i) mx = fmaxf(mx, fabsf(v[i]));
        pmax[kk0 * 64 + n] = mx;
        __syncthreads();
#pragma unroll
        for (int q = 0; q < 8; ++q) mx = fmaxf(mx, pmax[q * 64 + n]);
        const float sc = mx > 0.f ? 127.0f / mx : 0.f;
        if (kk0 == 0) sw[n0 + n] = mx * (1.0f / 127.0f);
#pragma unroll
        for (int w = 0; w < 32; ++w) { unsigned word = 0u;
#pragma unroll
            for (int j = 0; j < 4; ++j) word |= ((unsigned)(int)__builtin_rintf(v[4 * w + j] * sc) & 0xffu) << (8 * j);
            img[n * 260 + kk0 * 32 + w] = word; }
        __syncthreads();
        { const int nr = tid >> 3, seg = tid & 7;
#pragma unroll
          for (int j = 0; j < 8; ++j) *(u32x4*)(dst + (size_t)(n0 + nr) * D + (seg + 8 * j) * 16) = *(const LAS u32x4*)(img + nr * 260 + (seg + 8 * j) * 4); }
        __syncthreads();
    }
}
__device__ __forceinline__ void quant_rows_i8(const f16* src, unsigned char* dst, float* sa, int rows) {
    const int tid = threadIdx.x, lane = tid & 63, gw = blockIdx.x * 8 + (tid >> 6), nw = gridDim.x * 8;
    for (int r = gw; r < rows; r += nw) {
        const half8 a = *(const half8*)(src + (size_t)r * D + lane * 16), b = *(const half8*)(src + (size_t)r * D + lane * 16 + 8);
        float v[16], mx = 0.f;
#pragma unroll
        for (int j = 0; j < 8; ++j) { v[j] = (float)a[j]; v[8 + j] = (float)b[j]; }
#pragma unroll
        for (int j = 0; j < 16; ++j) mx = fmaxf(mx, fabsf(v[j]));
#pragma unroll
        for (int o = 32; o >= 1; o >>= 1) mx = fmaxf(mx, __shfl_xor(mx, o));
        const float sc = mx > 0.f ? 127.0f / mx : 0.f; u32x4 w;
#pragma unroll
        for (int q = 0; q < 4; ++q) { unsigned word = 0u;
#pragma unroll
            for (int j = 0; j < 4; ++j) word |= ((unsigned)(int)__builtin_rintf(v[4 * q + j] * sc) & 0xffu) << (8 * j);
            w[q] = word; }
        *(u32x4*)(dst + (size_t)r * D + lane * 16) = w;
        if (lane == 0) sa[r] = mx * (1.0f / 127.0f);
    }
}
__device__ __forceinline__ void p0_prologue(const Params& P, LAS unsigned char* lds) {
    const int tid = threadIdx.x, bid = blockIdx.x, G = gridDim.x, lane = tid & 63;
    unsigned char* ws = P.ws;
    LAS f16* tl = (LAS f16*)lds;
    {
        constexpr int NI8 = 2 * DFF / 64; const int nI = G > 2 * NI8 ? NI8 : 0;
        if (bid >= G - nI || nI == 0) prep_weight_i8(P, 0, 2 * DFF, ws + WS_WGU1, (float*)(ws + WS_WGU1 + (size_t)2 * DFF * D), nI ? bid - (G - nI) : bid, nI ? nI : G, lds);
        if (bid < G - nI) { int tbase = 0, cursor = bid; __syncthreads();
            prep_weight(P, 1, D, DFF, (f16*)(ws + WS_WD1), cursor, tbase, tl, G - nI);
            prep_weight(P, 2, NIN, D, (f16*)(ws + WS_WIN), cursor, tbase, tl, G - nI); }
    }
    float* ss0 = (float*)(ws + WS_SS0);
    f16* acta = (f16*)(ws + WS_ACTA);
    const int gw = bid * 8 + (tid >> 6), nw = G * 8;
    unsigned char* x8 = ws + WS_US; float* sa0 = (float*)(ws + WS_IQ);
    for (int p = gw; p < L; p += nw) {
        const float* src = p < SEQ ? P.x + (size_t)p * D : P.meta + (size_t)(p - SEQ) * D; float s = 0.f, mx = 0.f; f32x4 v[4];
#pragma unroll
        for (int i = 0; i < 4; ++i) { v[i] = *(const f32x4*)(src + lane * 4 + 256 * i); s += (v[i][0] * v[i][0] + v[i][1] * v[i][1]) + (v[i][2] * v[i][2] + v[i][3] * v[i][3]);
            mx = fmaxf(fmaxf(mx, fmaxf(fabsf(v[i][0]), fabsf(v[i][1]))), fmaxf(fabsf(v[i][2]), fabsf(v[i][3]))); *(half4*)(acta + (size_t)p * D + lane * 4 + 256 * i) = to_half4(v[i]); }
#pragma unroll
        for (int o = 32; o >= 1; o >>= 1) { s += __shfl_xor(s, o); mx = fmaxf(mx, __shfl_xor(mx, o)); }
        const float sc = mx > 0.f ? 127.0f / mx : 0.f;
#pragma unroll
        for (int i = 0; i < 4; ++i) { unsigned word = 0u;
#pragma unroll
            for (int j = 0; j < 4; ++j) word |= ((unsigned)(int)__builtin_rintf(v[i][j] * sc) & 0xffu) << (8 * j);
            *(unsigned*)(x8 + (size_t)p * D + lane * 4 + 256 * i) = word; }
        if (lane == 0) { ss0[p] = s; sa0[p] = mx * (1.0f / 127.0f); }
    }
    const int gt = bid * NTHREADS + tid, ngt = G * NTHREADS;
    for (int i = gt; i < MP; i += ngt) { if (i >= L) { ss0[i] = (float)D; sa0[i] = 0.f; } }
    f32x2* rope = (f32x2*)(ws + WS_ROPE);
    for (int i = gt; i < L * 32; i += ngt) { const int t = i >> 5, f = i & 31; const double inv = exp(-(double)f * (9.210340371976184 / 32.0)); double sn, cs; sincos((double)t * inv, &sn, &cs); rope[i] = (f32x2){(float)cs, (float)sn}; }
}

__device__ __forceinline__ void meta_down(const Params& P, LAS unsigned char* lds) {
    const int tid = threadIdx.x, lane = tid & 63, wid = tid >> 6;
    const f16* Gm = (const f16*)(P.ws + WS_G) + (size_t)SEQ * DFF; const f16* Wt = (const f16*)(P.ws + WS_WD1);
    f16* acta = (f16*)P.out; float* ss1 = (float*)(P.ws + WS_SS1); LAS float* slot = (LAS float*)lds;
    for (int task = blockIdx.x; task < NMETA * 16; task += gridDim.x) {
        const int r = task >> 4, cg = task & 15; float part = 0.f;
#pragma unroll 1
        for (int q = 0; q < 2; ++q) {
            const int n0 = cg * 64 + (2 * wid + q) * 4; float a[4] = {0.f, 0.f, 0.f, 0.f};
            for (int kc = lane; kc < DFF / 8; kc += 64) {
                const half8 gv = *(const half8*)(Gm + (size_t)r * DFF + kc * 8);
#pragma unroll
                for (int j = 0; j < 4; ++j) { const half8 wv = *(const half8*)(Wt + (size_t)(n0 + j) * DFF + kc * 8);
#pragma unroll
                    for (int e = 0; e < 8; ++e) a[j] += (float)gv[e] * (float)wv[e]; }
            }
#pragma unroll
            for (int o = 32; o >= 1; o >>= 1) { a[0] += __shfl_xor(a[0], o); a[1] += __shfl_xor(a[1], o); a[2] += __shfl_xor(a[2], o); a[3] += __shfl_xor(a[3], o); }
            f32x4 o;
#pragma unroll
            for (int j = 0; j < 4; ++j) { o[j] = P.meta[r * D + n0 + j] + 0.5f * a[j]; part += o[j] * o[j]; }
            if (lane == 0) *(half4*)(acta + (size_t)(SEQ + r) * D + n0) = to_half4(o);
        }
        if (lane == 0) slot[wid] = part;
        __syncthreads();
        if (tid == 0) { float s = 0.f; for (int w = 0; w < 8; ++w) s += slot[w]; ss1[(size_t)(SEQ + r) * 16 + cg] = s; }
        __syncthreads();
    }
}

__device__ __forceinline__ float logsigmoid_f(float z) { return fminf(z, 0.f) - __logf(1.0f + __expf(-fabsf(z))); }
__device__ __forceinline__ void gla_gates(const Params& P, int c, int h, LAS float* bl) {
    const int tid = threadIdx.x, ti = tid >> 3, d0 = (tid & 7) * 8, tt = 64 * c - 48 + ti; const float* GA = (const float*)(P.ws + WS_GA);
    {
        float z[8];
        if (tt >= 0 && tt < L) {
            const f32x4 b0 = *(const f32x4*)(P.ba + 64 * h + d0), b1 = *(const f32x4*)(P.ba + 64 * h + d0 + 4);
#pragma unroll
            for (int m = 0; m < 4; ++m) { z[m] = b0[m]; z[4 + m] = b1[m]; }
            f32x4 a4[4];
#pragma unroll
            for (int q = 0; q < 4; ++q) a4[q] = *(const f32x4*)(GA + (size_t)tt * 16 + 4 * q);
#pragma unroll
            for (int r = 0; r < 16; ++r) { const float ar = a4[r >> 2][r & 3]; const f32x4 w0 = *(const f32x4*)(P.wa2 + r * 256 + 64 * h + d0), w1 = *(const f32x4*)(P.wa2 + r * 256 + 64 * h + d0 + 4);
#pragma unroll
                for (int m = 0; m < 4; ++m) { z[m] += ar * w0[m]; z[4 + m] += ar * w1[m]; } }
#pragma unroll
            for (int m = 0; m < 8; ++m) z[m] = logsigmoid_f(z[m]) * (1.0f / 16.0f);
        } else {
#pragma unroll
            for (int m = 0; m < 8; ++m) z[m] = 0.f;
        }
#pragma unroll
        for (int m = 0; m < 8; ++m) bl[ti * 65 + d0 + m] = z[m];
    }
    __syncthreads();
    {
        const int d = tid & 63, seg = tid >> 6; float v[8], run = 0.f;
#pragma unroll
        for (int i = 0; i < 8; ++i) { run += bl[(seg * 8 + i) * 65 + d]; v[i] = run; }
#pragma unroll
        for (int i = 0; i < 8; ++i) bl[(seg * 8 + i) * 65 + d] = v[i];
        __syncthreads();
        float off = 0.f;
#pragma unroll
        for (int sg = 0; sg < 7; ++sg) off += (sg < seg) ? bl[(sg * 8 + 7) * 65 + d] : 0.f;
        __syncthreads();
#pragma unroll
        for (int i = 0; i < 8; ++i) bl[(seg * 8 + i) * 65 + d] = v[i] + off;
    }
    __syncthreads();
}
__device__ __forceinline__ void gla_a_unit(const Params& P, int unit, LAS unsigned char* lds) {
    int tid_ = threadIdx.x; asm volatile("" : "+v"(tid_));
    const int tid = tid_, lane = tid & 63, wid = tid >> 6, c = unit >> 2, h = unit & 3;
    LAS float* bl = (LAS float*)lds; LAS float* ks = bl + 4160; LAS float* vs = ks + 4096;
    const f16* GK = (const f16*)(P.ws + WS_GK); const f16* GV = (const f16*)(P.ws + WS_GV);
    float* U = (float*)(P.ws + WS_US); float* DEC = (float*)(P.ws + WS_DECAY);
    const int ti = tid >> 3, d0 = (tid & 7) * 8, tt = 64 * c - 48 + ti; const bool tv = tt >= 0 && tt < L;
    half8 k8, v8[2];
#pragma unroll
    for (int m = 0; m < 8; ++m) { k8[m] = (f16)0.f; v8[0][m] = (f16)0.f; v8[1][m] = (f16)0.f; }
    if (tv) k8 = *(const half8*)(GK + (size_t)tt * 256 + 64 * h + d0);
#pragma unroll
    for (int q = 0; q < 2; ++q) { const int ch = tid + 512 * q, j = ch >> 4, t = 64 * c - 48 + j; if (t >= 0 && t < L) v8[q] = *(const half8*)(GV + (size_t)t * 512 + 128 * h + (ch & 15) * 8); }
    gla_gates(P, c, h, bl);
    { f32x4 o0, o1;
#pragma unroll
      for (int m = 0; m < 4; ++m) { o0[m] = (float)k8[m] * __expf(bl[63 * 65 + d0 + m] - bl[ti * 65 + d0 + m]); o1[m] = (float)k8[4 + m] * __expf(bl[63 * 65 + d0 + 4 + m] - bl[ti * 65 + d0 + 4 + m]); }
      *(LAS f32x4*)(ks + ti * 64 + d0) = o0; *(LAS f32x4*)(ks + ti * 64 + d0 + 4) = o1; }
#pragma unroll
    for (int q = 0; q < 2; ++q) { const int ch = tid + 512 * q, j = ch >> 4, e0 = (ch & 15) * 8; f32x4 o0, o1;
#pragma unroll
        for (int m = 0; m < 4; ++m) { o0[m] = (float)v8[q][m]; o1[m] = (float)v8[q][4 + m]; }
        *(LAS f32x4*)(vs + j * 128 + e0) = o0; *(LAS f32x4*)(vs + j * 128 + e0 + 4) = o1; }
    if (tid < 64) DEC[(size_t)c * 256 + h * 64 + tid] = __expf(bl[63 * 65 + tid]);
    __syncthreads();
    { const int dd0 = (wid >> 2) * 32, e0 = (wid & 3) * 32, l31 = lane & 31, hf = lane >> 5; f32x16 acc;
#pragma unroll
      for (int i = 0; i < 16; ++i) acc[i] = 0.f;
#pragma unroll 8
      for (int s = 0; s < 32; ++s) acc = __builtin_amdgcn_mfma_f32_32x32x2f32(ks[(2 * s + hf) * 64 + dd0 + l31], vs[(2 * s + hf) * 128 + e0 + l31], acc, 0, 0, 0);
      float* up = U + ((size_t)unit * 64) * 128;
#pragma unroll
      for (int r = 0; r < 16; ++r) { const int row = (r & 3) + 8 * (r >> 2) + 4 * hf; up[(size_t)(dd0 + row) * 128 + e0 + l31] = acc[r]; } }
    __syncthreads();
}
__device__ __forceinline__ void gla_scan(const Params& P) {
    float* U = (float*)(P.ws + WS_US); const float* DEC = (const float*)(P.ws + WS_DECAY);
    const int idx = blockIdx.x * NTHREADS + threadIdx.x;
    if (idx >= 32768) return;
    float s = 0.f;
#pragma unroll 8
    for (int c = 0; c < NCH - 1; ++c) { const float u = U[(size_t)c * 32768 + idx], dc = DEC[(size_t)c * 256 + (idx >> 7)]; U[(size_t)c * 32768 + idx] = s; s = dc * s + u; }
    U[(size_t)(NCH - 1) * 32768 + idx] = s;
}
__device__ __forceinline__ void gla_c_unit(const Params& P, int unit, LAS unsigned char* lds) {
    int tid_ = threadIdx.x; asm volatile("" : "+v"(tid_));
    const int tid = tid_, lane = tid & 63, wid = tid >> 6, c = unit >> 2, h = unit & 3, l31 = lane & 31, hf = lane >> 5;
    LAS float* bl = (LAS float*)lds; LAS float* kk = bl + 4160; LAS float* qs = kk + 4160; LAS float* As = qs + 4160; LAS float* vs = As + 4160; LAS float* Ss = vs + 8192; LAS float* os = bl;
    const f16* GQ = (const f16*)(P.ws + WS_GQ); const f16* GK = (const f16*)(P.ws + WS_GK); const f16* GV = (const f16*)(P.ws + WS_GV); const f16* GR = (const f16*)(P.ws + WS_GR);
    const float* Sg = (const float*)(P.ws + WS_US) + (size_t)unit * 8192; f16* mix = (f16*)(P.ws + WS_ACTA);
    const int ti = tid >> 3, d0 = (tid & 7) * 8, tt = 64 * c - 48 + ti; const bool tv = tt >= 0 && tt < L;
    half8 q8, k8, v8[2], r8[2]; f32x4 sreg[4];
#pragma unroll
    for (int m = 0; m < 8; ++m) { q8[m] = (f16)0.f; k8[m] = (f16)0.f; v8[0][m] = (f16)0.f; v8[1][m] = (f16)0.f; r8[0][m] = (f16)0.f; r8[1][m] = (f16)0.f; }
    if (tv) { q8 = *(const half8*)(GQ + (size_t)tt * 256 + 64 * h + d0); k8 = *(const half8*)(GK + (size_t)tt * 256 + 64 * h + d0);
        r8[0] = *(const half8*)(GR + (size_t)tt * 512 + 128 * h + (tid & 7) * 16); r8[1] = *(const half8*)(GR + (size_t)tt * 512 + 128 * h + (tid & 7) * 16 + 8); }
#pragma unroll
    for (int q = 0; q < 2; ++q) { const int ch = tid + 512 * q, j = ch >> 4, t = 64 * c - 48 + j; if (t >= 0 && t < L) v8[q] = *(const half8*)(GV + (size_t)t * 512 + 128 * h + (ch & 15) * 8); }
#pragma unroll
    for (int q = 0; q < 4; ++q) sreg[q] = *(const f32x4*)(Sg + (size_t)(tid + 512 * q) * 4);
    gla_gates(P, c, h, bl);
#pragma unroll
    for (int m = 0; m < 8; ++m) { const float bv = bl[ti * 65 + d0 + m]; qs[ti * 65 + d0 + m] = (float)q8[m] * 0.125f * __expf(bv); kk[ti * 65 + d0 + m] = (float)k8[m] * __expf(-bv); }
#pragma unroll
    for (int q = 0; q < 2; ++q) { const int ch = tid + 512 * q, j = ch >> 4, e0 = (ch & 15) * 8; f32x4 o0, o1;
#pragma unroll
        for (int m = 0; m < 4; ++m) { o0[m] = (float)v8[q][m]; o1[m] = (float)v8[q][4 + m]; }
        *(LAS f32x4*)(vs + j * 128 + e0) = o0; *(LAS f32x4*)(vs + j * 128 + e0 + 4) = o1; }
#pragma unroll
    for (int q = 0; q < 4; ++q) *(LAS f32x4*)(Ss + (tid + 512 * q) * 4) = sreg[q];
    __syncthreads();
    if (wid < 4) { const int i0 = (wid >> 1) * 32, j0 = (wid & 1) * 32; f32x16 acc;
#pragma unroll
        for (int i = 0; i < 16; ++i) acc[i] = 0.f;
#pragma unroll 8
        for (int s = 0; s < 32; ++s) acc = __builtin_amdgcn_mfma_f32_32x32x2f32(qs[(i0 + l31) * 65 + 2 * s + hf], kk[(j0 + l31) * 65 + 2 * s + hf], acc, 0, 0, 0);
#pragma unroll
        for (int r = 0; r < 16; ++r) { const int i = i0 + (r & 3) + 8 * (r >> 2) + 4 * hf, j = j0 + l31; As[i * 65 + j] = (j <= i) ? acc[r] : 0.f; } }
    __syncthreads();
    { const int i0 = (wid >> 2) * 32, e0 = (wid & 3) * 32; f32x16 acc;
#pragma unroll
      for (int i = 0; i < 16; ++i) acc[i] = 0.f;
#pragma unroll 8
      for (int s = 0; s < 32; ++s) acc = __builtin_amdgcn_mfma_f32_32x32x2f32(qs[(i0 + l31) * 65 + 2 * s + hf], Ss[(2 * s + hf) * 128 + e0 + l31], acc, 0, 0, 0);
#pragma unroll 8
      for (int s = 0; s < 32; ++s) acc = __builtin_amdgcn_mfma_f32_32x32x2f32(As[(i0 + l31) * 65 + 2 * s + hf], vs[(2 * s + hf) * 128 + e0 + l31], acc, 0, 0, 0);
#pragma unroll
      for (int r = 0; r < 16; ++r) { const int i = i0 + (r & 3) + 8 * (r >> 2) + 4 * hf; os[i * 129 + e0 + l31] = acc[r]; } }
    __syncthreads();
    { const int e0 = (tid & 7) * 16; float o[16], sq = 0.f;
#pragma unroll
      for (int j = 0; j < 16; ++j) { o[j] = os[ti * 129 + e0 + j]; sq += o[j] * o[j]; }
      sq += __shfl_xor(sq, 1); sq += __shfl_xor(sq, 2); sq += __shfl_xor(sq, 4);
      const float rs = rsqrtf(sq * (1.0f / 128.0f) + EPS);
      if (tt >= NMETA && tt < L) { half8 w0, w1;
#pragma unroll
          for (int j = 0; j < 8; ++j) { w0[j] = (f16)(o[j] * rs * P.hn[e0 + j] * silu_f((float)r8[0][j])); w1[j] = (f16)(o[8 + j] * rs * P.hn[e0 + 8 + j] * silu_f((float)r8[1][j])); }
          f16* dst = mix + (size_t)(tt - NMETA) * D + 128 * h + e0; *(half8*)dst = w0; *(half8*)(dst + 8) = w1; } }
    __syncthreads();
}

__device__ __forceinline__ unsigned mono_u(float f) { const unsigned u = __float_as_uint(f); return (u & 0x80000000u) ? ~u : (u | 0x80000000u); }
__device__ __forceinline__ float unmono_f(unsigned m) { return __uint_as_float((m & 0x80000000u) ? (m & 0x7fffffffu) : ~m); }
__device__ __forceinline__ unsigned wave_umax(unsigned v) {
    v = max(v, (unsigned)__builtin_amdgcn_update_dpp(0, (int)v, 0x111, 0xf, 0xf, false));
    v = max(v, (unsigned)__builtin_amdgcn_update_dpp(0, (int)v, 0x112, 0xf, 0xf, false));
    v = max(v, (unsigned)__builtin_amdgcn_update_dpp(0, (int)v, 0x114, 0xf, 0xf, false));
    v = max(v, (unsigned)__builtin_amdgcn_update_dpp(0, (int)v, 0x118, 0xf, 0xf, false));
    v = max(v, (unsigned)__builtin_amdgcn_update_dpp(0, (int)v, 0x142, 0xa, 0xf, false));
    v = max(v, (unsigned)__builtin_amdgcn_update_dpp(0, (int)v, 0x143, 0xc, 0xf, false));
    return (unsigned)__builtin_amdgcn_readlane((int)v, 63);
}
__device__ __forceinline__ int half_scan_incl(int v) {
    v += __builtin_amdgcn_update_dpp(0, v, 0x111, 0xf, 0xf, true);
    v += __builtin_amdgcn_update_dpp(0, v, 0x112, 0xf, 0xf, true);
    v += __builtin_amdgcn_update_dpp(0, v, 0x114, 0xf, 0xf, true);
    v += __builtin_amdgcn_update_dpp(0, v, 0x118, 0xf, 0xf, true);
    v += __builtin_amdgcn_update_dpp(0, v, 0x142, 0xa, 0xf, true);
    return v;
}
constexpr int CAP = 640, NPL = CAP / 64;
__device__ __forceinline__ int topk_compact(LAS float* cs, LAS unsigned short* ci, int n, bool exact, float& tau_out, int lane) {
    float sv[NPL]; unsigned iv[NPL], u[NPL];
#pragma unroll
    for (int i = 0; i < NPL; ++i) { const int p = lane + 64 * i; const bool v = p < n; sv[i] = v ? cs[p] : 0.f; iv[i] = v ? (unsigned)ci[p] : 0xffffu; u[i] = v ? mono_u(sv[i]) : 0u; }
    unsigned T = 0u; bool full = true; int hb = 31;
    {
        unsigned umx = 0u, umn = 0xffffffffu;
#pragma unroll
        for (int i = 0; i < NPL; ++i) { umx = max(umx, u[i]); umn = min(umn, (lane + 64 * i < n) ? u[i] : 0xffffffffu); }
        umx = wave_umax(umx); umn = ~wave_umax(~umn);
        const unsigned df = umx ^ umn;
        if (df == 0u) { hb = -1; T = umx; } else { hb = 31 - __clz(df); T = (hb == 31) ? 0u : (umx & ~((2u << hb) - 1u)); }
    }
#pragma unroll 1
    for (int bit = hb; bit >= 0; --bit) {
        const unsigned cand = T | (1u << bit); int cgt = 0;
#pragma unroll
        for (int i = 0; i < NPL; ++i) cgt += __popcll(__ballot(u[i] >= cand));
        if (cgt >= 256) { T = cand; if (cgt <= (exact ? 256 : 272)) { full = false; break; } }
    }
    bool keep[NPL];
    if (full) {
        int cgt = 0;
#pragma unroll
        for (int i = 0; i < NPL; ++i) cgt += __popcll(__ballot(u[i] > T));
        const int need = 256 - cgt; unsigned I = 0xffffu; int nties = 0;
#pragma unroll
        for (int i = 0; i < NPL; ++i) nties += __popcll(__ballot(u[i] == T));
        if (nties != need) { I = 0u;
#pragma unroll 1
        for (int bit = 15; bit >= 0; --bit) { const unsigned cand = I | (1u << bit); int cl = 0;
#pragma unroll
            for (int i = 0; i < NPL; ++i) cl += __popcll(__ballot(u[i] == T && iv[i] < cand));
            if (cl < need) I = cand; } }
#pragma unroll
        for (int i = 0; i < NPL; ++i) keep[i] = (u[i] > T) || (u[i] == T && iv[i] <= I);
    } else {
#pragma unroll
        for (int i = 0; i < NPL; ++i) keep[i] = u[i] >= T;
    }
    int nn = 0;
#pragma unroll
    for (int i = 0; i < NPL; ++i) { const unsigned long long m = __ballot(keep[i]); const int pre = __builtin_amdgcn_mbcnt_hi((unsigned)(m >> 32), __builtin_amdgcn_mbcnt_lo((unsigned)m, 0u));
        if (keep[i]) { cs[nn + pre] = sv[i]; ci[nn + pre] = (unsigned short)iv[i]; } nn += __popcll(m); }
    tau_out = unmono_f(T);
    return nn;
}
__device__ __forceinline__ float relu_asm(float x) { return __int_as_float(max(__float_as_int(x), 0)); }
__device__ __forceinline__ void indexer_tile(const Params& P, int tile, LAS unsigned char* lds) {
    int tid_ = threadIdx.x; asm volatile("" : "+v"(tid_));
    const int tid = tid_, lane = tid & 63, wid = __builtin_amdgcn_readfirstlane(tid >> 6), l31 = lane & 31, hf = lane >> 5;
    LAS float* candS = (LAS float*)lds;
    LAS unsigned short* candI = (LAS unsigned short*)(lds + 32 * CAP * 4);
    LAS unsigned char* kbuf = lds + 32 * CAP * 6;
    LAS int* lflag = (LAS int*)(lds + LDS_BYTES - 1024 + 192);
    const f16* IQ = (const f16*)(P.ws + WS_IQ); const f16* IK = (const f16*)(P.ws + WS_IK); const float* IW = (const float*)(P.ws + WS_IW);
    unsigned short* SEL = (unsigned short*)(P.ws + WS_SEL);
    const int t0 = tile * 32, tw = t0 + wid * 4;
    half8 afr[4];
    { const int qi = 2 * (l31 >> 4) + ((l31 >> 2) & 1), hd = 4 * ((l31 >> 3) & 1) + (l31 & 3); int tq = tw + qi; if (tq > L - 1) tq = L - 1;
      const half8* ap = (const half8*)(IQ + (size_t)tq * 512 + hd * 64);
#pragma unroll
      for (int s = 0; s < 4; ++s) afr[s] = ap[2 * s + hf]; }
    float w0[8], w1[8];
    { int ta = tw + hf, tb = tw + 2 + hf; if (ta > L - 1) ta = L - 1; if (tb > L - 1) tb = L - 1;
#pragma unroll
      for (int h = 0; h < 8; ++h) { w0[h] = IW[(size_t)ta * 8 + h]; w1[h] = IW[(size_t)tb * 8 + h]; } }
    asm volatile("" :: "v"(afr[0]), "v"(afr[1]), "v"(afr[2]), "v"(afr[3]));
    asm volatile("" :: "v"(w0[0]), "v"(w0[1]), "v"(w0[2]), "v"(w0[3]), "v"(w0[4]), "v"(w0[5]), "v"(w0[6]), "v"(w0[7]));
    asm volatile("" :: "v"(w1[0]), "v"(w1[1]), "v"(w1[2]), "v"(w1[3]), "v"(w1[4]), "v"(w1[5]), "v"(w1[6]), "v"(w1[7]));
    const int tq0 = (tw + hf < L) ? tw + hf : -1, tq1 = (tw + 2 + hf < L) ? tw + 2 + hf : -1;
    float tau0 = -__builtin_inff(), tau1 = -__builtin_inff();
    int cq0 = 0, cq1 = 0, cq2 = 0, cq3 = 0;
    if (tid < 3) lflag[tid] = 0;
    const int nkeys = (t0 + 32 < L) ? t0 + 32 : L, nst = (nkeys + 127) >> 7;
    u32x4 stg[2];
    const u32x4* IKv = (const u32x4*)IK;
#pragma unroll
    for (int i = 0; i < 2; ++i) stg[i] = IKv[(size_t)0 * 1024 + tid + 512 * i];
#pragma unroll
    for (int i = 0; i < 2; ++i) { const int ci = tid + 512 * i, row = ci >> 3, ch = ci & 7; *(LAS u32x4*)(kbuf + row * 128 + ((ch ^ ((row >> 1) & 7)) << 4)) = stg[i]; }
    __syncthreads();
#pragma unroll 1
    for (int st = 0; st < nst; ++st) {
        LAS unsigned char* kb = kbuf + (st & 1) * 16384;
        if (st + 1 < nst) {
#pragma unroll
            for (int i = 0; i < 2; ++i) stg[i] = IKv[(size_t)(st + 1) * 1024 + tid + 512 * i];
        }
        if (st * 128 <= tw + 3) {
            f32x16 acc[4];
#pragma unroll
            for (int c = 0; c < 4; ++c) {
#pragma unroll
                for (int i = 0; i < 16; ++i) acc[c][i] = 0.f;
            }
#pragma unroll
            for (int s = 0; s < 4; ++s) {
#pragma unroll
                for (int c = 0; c < 4; ++c) { const int row = c * 32 + l31; const half8 bf = *(const LAS half8*)(kb + row * 128 + (((2 * s + hf) ^ ((row >> 1) & 7)) << 4)); acc[c] = __builtin_amdgcn_mfma_f32_32x32x16_f16(afr[s], bf, acc[c], 0, 0, 0); }
            }
            float sc[8]; bool ok[8]; int na = 0, nb = 0;
#pragma unroll
            for (int c = 0; c < 4; ++c) {
                float s0 = 0.f, s1 = 0.f;
#pragma unroll
                for (int h = 0; h < 8; ++h) { const float r0 = relu_asm(acc[c][h]), r1 = relu_asm(acc[c][8 + h]);
                    asm("v_fmac_f32 %0, %1, %2" : "+v"(s0) : "v"(w0[h]), "v"(r0)); asm("v_fmac_f32 %0, %1, %2" : "+v"(s1) : "v"(w1[h]), "v"(r1)); }
                const int key = st * 128 + c * 32 + l31;
                sc[2 * c] = s0; sc[2 * c + 1] = s1; ok[2 * c] = key <= tq0 && s0 > tau0; ok[2 * c + 1] = key <= tq1 && s1 > tau1;
                na += ok[2 * c] ? 1 : 0; nb += ok[2 * c + 1] ? 1 : 0;
            }
            const int ia = half_scan_incl(na), ib = half_scan_incl(nb);
            const int ta0 = __builtin_amdgcn_readlane(ia, 31), ta1 = __builtin_amdgcn_readlane(ia, 63), tb0 = __builtin_amdgcn_readlane(ib, 31), tb1 = __builtin_amdgcn_readlane(ib, 63);
            int pa = (hf ? cq1 : cq0) + ia - na, pb = (hf ? cq3 : cq2) + ib - nb;
            cq0 += ta0; cq1 += ta1; cq2 += tb0; cq3 += tb1;
            pa += (wid * 4 + hf) * CAP; pb += (wid * 4 + 2 + hf) * CAP;
            const int dmy = 32 * CAP * 6 / 4 + 2 * 16384 / 4 + 64 + lane;
#pragma unroll
            for (int c = 0; c < 4; ++c) {
                const unsigned short key = (unsigned short)(st * 128 + c * 32 + l31);
                { const bool k0 = ok[2 * c]; LAS float* ps = k0 ? candS + pa : candS + dmy; LAS unsigned short* pi = k0 ? candI + pa : (LAS unsigned short*)(candS + dmy + 64); *ps = sc[2 * c]; *pi = key; pa += k0 ? 1 : 0; }
                { const bool k1 = ok[2 * c + 1]; LAS float* ps = k1 ? candS + pb : candS + dmy; LAS unsigned short* pi = k1 ? candI + pb : (LAS unsigned short*)(candS + dmy + 64); *ps = sc[2 * c + 1]; *pi = key; pb += k1 ? 1 : 0; }
            }
        }
        if (st + 1 < nst) {
            LAS unsigned char* kn = kbuf + ((st + 1) & 1) * 16384;
#pragma unroll
            for (int i = 0; i < 2; ++i) { const int ci = tid + 512 * i, row = ci >> 3, ch = ci & 7; *(LAS u32x4*)(kn + row * 128 + ((ch ^ ((row >> 1) & 7)) << 4)) = stg[i]; }
        }
        const int mx = max(max(cq0, cq1), max(cq2, cq3));
        if (mx > CAP - 128 && lane == 0) lflag[st % 3] = 1;
        if (tid == 0) lflag[(st + 1) % 3] = 0;
        __syncthreads();
        const int any = lflag[st % 3];
        if (any) {
#pragma unroll 1
            for (int qq = 0; qq < 4; ++qq) { const int n = qq == 0 ? cq0 : (qq == 1 ? cq1 : (qq == 2 ? cq2 : cq3));
                if (n > 288) { float nt; const int nn = topk_compact(candS + (wid * 4 + qq) * CAP, candI + (wid * 4 + qq) * CAP, n, false, nt, lane);
                    if (qq == 0) cq0 = nn; else if (qq == 1) cq1 = nn; else if (qq == 2) cq2 = nn; else cq3 = nn;
                    if (hf == (qq & 1)) { if (qq < 2) tau0 = nt; else tau1 = nt; } } }
        }
    }
#pragma unroll 1
    for (int qq = 0; qq < 4; ++qq) {
        const int t = tw + qq; if (t >= L) break;
        int n = qq == 0 ? cq0 : (qq == 1 ? cq1 : (qq == 2 ? cq2 : cq3)); LAS float* cs = candS + (wid * 4 + qq) * CAP; LAS unsigned short* ci = candI + (wid * 4 + qq) * CAP;
        if (n > 256) { float nt; n = topk_compact(cs, ci, n, true, nt, lane); }
#pragma unroll
        for (int j = 0; j < 4; ++j) { const int p = lane + 64 * j; SEL[(size_t)t * 256 + (p & 15) * 16 + (p >> 4)] = p < n ? ci[p] : (unsigned short)0xffffu; }
    }
    __syncthreads();
}

__device__ __forceinline__ void sparse_attn(const Params& P, LAS unsigned char* lds, int vbid) {
    int tid_ = threadIdx.x; asm volatile("" : "+v"(tid_));
    const int tid = tid_, lane = tid & 63, wid = tid >> 6, grp = lane >> 2, c4 = lane & 3;
    const int head = vbid & 7, slot = (vbid >> 3) * 8 + wid, nslot = (gridDim.x >> 3) * 8;
    typedef _Float16 half2v __attribute__((ext_vector_type(2)));
    LAS float* red = (LAS float*)(lds + 4096 + wid * 4352);
    const unsigned short* SEL = (const unsigned short*)(P.ws + WS_SEL);
    const unsigned char* Q8 = P.ws + WS_DQ + head * 64 + c4 * 16; const float* QS = (const float*)(P.ws + WS_DQ + (size_t)LP * 512) + head;
    const unsigned char* kvh = P.ws + WS_KV + (size_t)head * LP * 128; f16* mix = (f16*)(P.ws + WS_ACTA);
    int t = NMETA + slot;
    u32x4 sela = {0u, 0u, 0u, 0u}, selb = {0u, 0u, 0u, 0u}, q8 = {0u, 0u, 0u, 0u}; float lscale = 0.f;
    if (t < L) { sela = *(const u32x4*)(SEL + (size_t)t * 256 + grp * 16); selb = *(const u32x4*)(SEL + (size_t)t * 256 + grp * 16 + 8); q8 = *(const u32x4*)(Q8 + (size_t)t * 512); lscale = QS[(size_t)t * 8]; }
#define ATTN_ITEM(ALLV) do { \
        unsigned keys[16]; u32x4 kreg[16], vreg[16]; \
        _Pragma("unroll") for (int it = 0; it < 16; ++it) { const unsigned w = it < 8 ? sela[it >> 1] : selb[(it - 8) >> 1]; keys[it] = (it & 1) ? (w >> 16) : (w & 0xffffu); } \
        _Pragma("unroll") for (int it = 0; it < 16; ++it) { const unsigned kk = (ALLV || keys[it] != 0xffffu) ? keys[it] : 0u; kreg[it] = *(const u32x4*)(kvh + (size_t)kk * 128 + c4 * 16); } \
        _Pragma("unroll") for (int it = 0; it < 16; ++it) { const unsigned kk = (ALLV || keys[it] != 0xffffu) ? keys[it] : 0u; vreg[it] = *(const u32x4*)(kvh + (size_t)kk * 128 + 64 + c4 * 16); } \
        const u32x4 qc = q8; const float ls = lscale; \
        { const int tn = t + nslot;     \
          if (tn < L) { sela = *(const u32x4*)(SEL + (size_t)tn * 256 + grp * 16); selb = *(const u32x4*)(SEL + (size_t)tn * 256 + grp * 16 + 8); q8 = *(const u32x4*)(Q8 + (size_t)tn * 512); lscale = QS[(size_t)tn * 8]; } } \
        float lg[16]; float mx = -__builtin_inff(); \
        _Pragma("unroll") for (int it = 0; it < 16; ++it) { \
            int ai = 0; \
            _Pragma("unroll") for (int w = 0; w < 4; ++w) ai = __builtin_amdgcn_sdot4((int)kreg[it][w], (int)qc[w], ai, false); \
            ai += __builtin_amdgcn_update_dpp(0, ai, 0xB1, 0xf, 0xf, true);     \
            ai += __builtin_amdgcn_update_dpp(0, ai, 0x4E, 0xf, 0xf, true);     \
            lg[it] = (ALLV || keys[it] != 0xffffu) ? (float)ai * ls : -__builtin_inff(); mx = fmaxf(mx, lg[it]); } \
        mx = fmaxf(mx, __shfl_xor(mx, 4)); mx = fmaxf(mx, __shfl_xor(mx, 8)); mx = fmaxf(mx, __shfl_xor(mx, 16)); mx = fmaxf(mx, __shfl_xor(mx, 32)); \
        half2v o2[8]; float lsum = 0.f; \
        _Pragma("unroll") for (int e = 0; e < 8; ++e) o2[e] = (half2v){(f16)0.f, (f16)0.f}; \
        _Pragma("unroll") for (int it = 0; it < 16; ++it) { \
            const float p = __expf(lg[it] - mx); lsum += p; const f16 ph = (f16)p; const half2v p2 = {ph, ph}; \
            _Pragma("unroll") for (int w = 0; w < 4; ++w) {     \
                const half2v v01 = __builtin_bit_cast(half2v, __builtin_amdgcn_perm(0u, vreg[it][w], 0x010c000cu)), v23 = __builtin_bit_cast(half2v, __builtin_amdgcn_perm(0u, vreg[it][w], 0x030c020cu)); \
                o2[2 * w] = p2 * v01 + o2[2 * w]; o2[2 * w + 1] = p2 * v23 + o2[2 * w + 1]; } } \
        lsum += __shfl_xor(lsum, 4); lsum += __shfl_xor(lsum, 8); lsum += __shfl_xor(lsum, 16); lsum += __shfl_xor(lsum, 32); \
          \
        _Pragma("unroll") for (int e = 0; e < 8; ++e) { red[lane * 17 + 2 * e] = (float)o2[e][0]; red[lane * 17 + 2 * e + 1] = (float)o2[e][1]; } \
        float acc = 0.f; \
        { const int cc = lane >> 4, e = lane & 15; \
          _Pragma("unroll") for (int g = 0; g < 16; ++g) acc += red[(g * 4 + cc) * 17 + e]; } \
        mix[(size_t)(t - NMETA) * D + 512 + head * 64 + lane] = (f16)(acc * __builtin_amdgcn_rcpf(lsum)); \
    } while (0)
#pragma unroll 1
    for (; t < L; t += nslot) {
        if (t >= 255) ATTN_ITEM(true);
        else ATTN_ITEM(false);
    }
#undef ATTN_ITEM
    __syncthreads();
}

__device__ __forceinline__ void final_norm(const Params& P) {
    const int tid = threadIdx.x, lane = tid & 63, gw = blockIdx.x * 8 + (tid >> 6), nw = gridDim.x * 8;
    const float* ss3 = (const float*)(P.ws + WS_SS3); const f16* h3 = (const f16*)(P.ws + WS_ACTA);
    for (int r = gw; r < SEQ; r += nw) { const float rs = row_rstd(ss3, 16, r);
#pragma unroll
        for (int i = 0; i < 2; ++i) { const int k = lane * 8 + 512 * i; const half8 v = *(const half8*)(h3 + (size_t)r * D + k); const f32x4 g0 = *(const f32x4*)(P.nf + k), g1 = *(const f32x4*)(P.nf + k + 4); f32x4 o0, o1;
#pragma unroll
            for (int j = 0; j < 4; ++j) { o0[j] = (float)v[j] * rs * g0[j]; o1[j] = (float)v[4 + j] * rs * g1[j]; }
            *(f32x4*)(P.out + (size_t)r * D + k) = o0; *(f32x4*)(P.out + (size_t)r * D + k + 4) = o1; } }
}

#define XB_TMO      128
#define XB_XCNT(j)  (256  + 64 * (j))
#define XB_XSUB(j)  (1280 + 64 * (j))
#define XB_XGEN(j)  (2304 + 64 * (j))
#define XB_TOP      3328
#define XB_TOPGEN   3392
#define XCD_BAR_WORDS 3456
#define XB_SPIN_CAP (1u << 22)
__device__ __forceinline__ unsigned xb_ld(unsigned* p)              { return __hip_atomic_load(p, __ATOMIC_RELAXED, __HIP_MEMORY_SCOPE_AGENT); }
__device__ __forceinline__ unsigned xb_add(unsigned* p, unsigned v) { return __hip_atomic_fetch_add(p, v, __ATOMIC_RELAXED, __HIP_MEMORY_SCOPE_AGENT); }
__device__ __forceinline__ unsigned xb_xcc_id() { return (unsigned)__builtin_amdgcn_s_getreg((3 << 11) | 20) & 0xFu; }
#define XB_SPIN(cond, bar) do { unsigned _sp = 0; while (cond) { __builtin_amdgcn_s_sleep(1); \
    if ((++_sp & 255u) == 0u) { if (xb_ld(&(bar)[XB_TMO])) break; if (_sp > XB_SPIN_CAP) { atomicAdd(&(bar)[XB_TMO], 1u); break; } } } } while (0)
struct XcdBarrier { unsigned* bar; unsigned x; volatile LAS unsigned* st; };
__device__ __forceinline__ XcdBarrier xcd_barrier_post(unsigned* bar, volatile LAS unsigned* st) {
    XcdBarrier b; b.bar = bar; b.x = xb_xcc_id(); b.st = st;
    if (threadIdx.x == 0) (void)xb_add(&bar[XB_XCNT(b.x)], 1u);
    return b;
}
__device__ __forceinline__ void xcd_barrier_complete(unsigned* bar, unsigned x, unsigned& nloc, unsigned& nx) {
    const unsigned G = gridDim.x * gridDim.y * gridDim.z;
    unsigned sum, cnt, mine, sp = 0u;
    for (;;) {
        sum = 0u; cnt = 0u; mine = 0u;
#pragma unroll
        for (unsigned j = 0; j < 16; ++j) { const unsigned c = xb_ld(&bar[XB_XCNT(j)]); sum += c; cnt += (c > 0u) ? 1u : 0u; mine = (j == x) ? c : mine; }
        if (sum == G) break;
        __builtin_amdgcn_s_sleep(1);
        if ((++sp & 255u) == 0u) { if (xb_ld(&bar[XB_TMO])) break; if (sp > XB_SPIN_CAP) { atomicAdd(&bar[XB_TMO], 1u); break; } }
    }
    nloc = mine > 0u ? mine : 1u; nx = cnt > 0u ? cnt : 1u;
}
__device__ __forceinline__ void xcd_barrier(const XcdBarrier& b) {
    asm volatile("s_waitcnt vmcnt(0)" ::: "memory");
    __syncthreads();
    if (threadIdx.x == 0) {
        unsigned* bar = b.bar;
        __builtin_amdgcn_s_waitcnt(0);
        unsigned nloc = b.st[0], nx = b.st[1];
        if (nloc == 0u) { xcd_barrier_complete(bar, b.x, nloc, nx); b.st[0] = nloc; b.st[1] = nx; }
        const unsigned old = xb_add(&bar[XB_XSUB(b.x)], 1u);
        const unsigned gen = old / nloc;
        if (old + 1u == (gen + 1u) * nloc) {
            __builtin_amdgcn_fence(__ATOMIC_RELEASE, "agent");
            asm volatile("s_waitcnt vmcnt(0)" ::: "memory");
            const unsigned og = xb_add(&bar[XB_TOP], 1u);
            const unsigned tg = og / nx;
            if (og + 1u == (tg + 1u) * nx) xb_add(&bar[XB_TOPGEN], 1u);
            else XB_SPIN(xb_ld(&bar[XB_TOPGEN]) == tg, bar);
            __builtin_amdgcn_fence(__ATOMIC_ACQUIRE, "agent");
            xb_add(&bar[XB_XGEN(b.x)], 1u);
            asm volatile("s_waitcnt vmcnt(0)" ::: "memory");
        } else {
            XB_SPIN(xb_ld(&bar[XB_XGEN(b.x)]) == gen, bar);
            __builtin_amdgcn_fence(__ATOMIC_ACQUIRE, "agent");
            asm volatile("s_waitcnt vmcnt(0)" ::: "memory");
        }
    }
    __syncthreads();
}

__global__ void __launch_bounds__(NTHREADS, 2) fwd_kernel(Params P) {
    __shared__ __attribute__((aligned(16))) unsigned char lds_raw[LDS_BYTES];
    LAS unsigned char* lds = (LAS unsigned char*)lds_raw;
    const int tid = threadIdx.x, bid = blockIdx.x, G = gridDim.x;
    unsigned char* ws = P.ws;
    const int lo = P.ph_lo, hi = P.ph_hi;
#ifndef ONLY_PHASE
#define ONLY_PHASE -1
#endif
#define IN(k) ((ONLY_PHASE < 0 || ONLY_PHASE == (k)) && lo <= (k) && (k) < hi)
#define SEAM(k) do { if (IN(k) && IN((k) + 1)) { xcd_barrier(xbar); } } while (0)
    XcdBarrier xbar; xbar.bar = (unsigned*)(ws + WS_BAR); xbar.x = 0; xbar.st = (volatile LAS unsigned*)(lds + LDS_BYTES - 1024 + 16);
    if (hi - lo > 1) {
        if (tid == 0) { xbar.st[0] = 0u; xbar.st[1] = 0u; }
        __syncthreads();
        xbar = xcd_barrier_post((unsigned*)(ws + WS_BAR), (volatile LAS unsigned*)(lds + LDS_BYTES - 1024 + 16));
    }
    LAS int* misc = (LAS int*)(lds + LDS_BYTES - 1024);
    if (hi - lo > 1) {
        if (tid == 0) { const unsigned xcc = xb_xcc_id() & 7u; misc[8] = (int)xcc; misc[9] = (int)xb_add((unsigned*)(ws + WS_CTL) + 32 + 32 * xcc, 1u); }
    }
    int vbid = bid;
    f16* acta = (f16*)(ws + WS_ACTA); f16* Gb = (f16*)(ws + WS_G);
    float* ss0 = (float*)(ws + WS_SS0); float* ss1 = (float*)(ws + WS_SS1); float* ss2 = (float*)(ws + WS_SS2); float* ss3 = (float*)(ws + WS_SS3);
    if (IN(0)) { p0_prologue(P, lds); }
    SEAM(0);
    if (hi - lo > 1 && (G & 7) == 0) {
        if (tid == 0) { bool ok = true; for (int j = 0; j < 8; ++j) ok = ok && (xb_ld((unsigned*)(ws + WS_CTL) + 32 + 32 * j) == (unsigned)(G >> 3)); misc[10] = ok ? misc[9] * 8 + misc[8] : bid; }
        __syncthreads();
        vbid = __builtin_amdgcn_readfirstlane(misc[10]);
        __syncthreads();
    }
    if (IN(1)) {
        pg8::Gemm g{(const f16*)(ws + WS_US), (const f16*)(ws + WS_WGU1), MP, 2 * DFF, D / 2}; pg8::StaticOrder S; S.init(MP, 2 * DFF, G, vbid);
        EpiSwiglu<true> E{Gb, ss0, 1, (const float*)(ws + WS_IQ), (const float*)(ws + WS_WGU1 + (size_t)2 * DFF * D)}; pg8::gemm_phase(lds, g, S, E);
    }
    SEAM(1);
    if (IN(2)) {
        meta_down(P, lds);
        pg8::Gemm g{Gb, (const f16*)(ws + WS_WD1), SEQ, D, DFF}; pg8::StaticOrder S; S.init(SEQ, D, G, vbid);
        EpiResid<true> E{acta, (f16*)P.out, ss1, 0.5f}; pg8::gemm_phase(lds, g, S, E);
    }
    SEAM(2);
    if (IN(3)) {
        pg8::Gemm g{(const f16*)P.out, (const f16*)(ws + WS_WIN), MP, NIN, D}; pg8::StaticOrder S; S.init(MP, NIN, G, vbid);
        EpiInProj E{ss1, (const f32x2*)(ws + WS_ROPE), ws};
        pg8::gemm_phase(lds, g, S, E);
    }
    SEAM(3);
    if (IN(4)) {
        for (int u = bid; u < (NCH - 1) * 4; u += G) gla_a_unit(P, u, lds);
        {
            constexpr int NI8 = 2 * DFF / 64; LAS f16* tl = (LAS f16*)lds;
            if (G > NI8 + 64) {
                if (bid >= G - NI8) prep_weight_i8(P, 4, 2 * DFF, ws + WS_WGU2, (float*)(ws + WS_WGU2 + (size_t)2 * DFF * D), bid - (G - NI8), NI8, lds);
                else { int tbase = 0, cursor = bid;
                    prep_weight(P, 3, D, D, (f16*)(ws + WS_WOUT), cursor, tbase, tl, G - NI8);
                    prep_weight(P, 5, D, DFF, (f16*)(ws + WS_WD2), cursor, tbase, tl, G - NI8); }
            } else { int tbase = 0, cursor = bid;
                prep_weight(P, 3, D, D, (f16*)(ws + WS_WOUT), cursor, tbase, tl, G);
                prep_weight(P, 5, D, DFF, (f16*)(ws + WS_WD2), cursor, tbase, tl, G);
                __syncthreads();
                prep_weight_i8(P, 4, 2 * DFF, ws + WS_WGU2, (float*)(ws + WS_WGU2 + (size_t)2 * DFF * D), bid, G, lds); }
        }
    }
    SEAM(4);
    if (IN(5)) {
        if (bid < 64) gla_scan(P);
        unsigned* ctr = (unsigned*)(ws + WS_CTL); LAS int* bc = (LAS int*)(lds + LDS_BYTES - 1024);
        for (;;) {
            if (tid == 0) bc[0] = (int)atomicAdd(ctr, 1u);
            __syncthreads();
            const int k = bc[0];
            __syncthreads();
            if (k >= 513) break;
            indexer_tile(P, 512 - k, lds);
        }
    }
    SEAM(5);
    if (IN(6)) { for (int u = 4 + bid; u < NCH * 4; u += G) gla_c_unit(P, u, lds); sparse_attn(P, lds, vbid); }
    SEAM(6);
    if (IN(7)) {
        pg8::Gemm g{acta, (const f16*)(ws + WS_WOUT), SEQ, D, D}; pg8::StaticOrder S; S.init(SEQ, D, G, vbid);
        EpiResid<true> E{P.out, (f16*)(ws + WS_US), ss2, 1.0f}; pg8::gemm_phase(lds, g, S, E);
    }
    SEAM(7);
    if (IN(8)) quant_rows_i8((const f16*)(ws + WS_US), ws + WS_DQ, (float*)(ws + WS_IQ), SEQ);
    SEAM(8);
    if (IN(9)) {
        pg8::Gemm g{(const f16*)(ws + WS_DQ), (const f16*)(ws + WS_WGU2), SEQ, 2 * DFF, D / 2}; pg8::StaticOrder S; S.init(SEQ, 2 * DFF, G, vbid);
        EpiSwiglu<true> E{Gb, ss2, 16, (const float*)(ws + WS_IQ), (const float*)(ws + WS_WGU2 + (size_t)2 * DFF * D)}; pg8::gemm_phase(lds, g, S, E);
    }
    SEAM(9);
    if (IN(10)) {
        pg8::Gemm g{Gb, (const f16*)(ws + WS_WD2), SEQ, D, DFF}; pg8::StaticOrder S; S.init(SEQ, D, G, vbid);
        EpiResid<true> E{ws + WS_US, acta, ss3, 0.5f}; pg8::gemm_phase(lds, g, S, E);
    }
    SEAM(10);
    if (IN(11)) final_norm(P);
#undef IN
#undef SEAM
}

extern "C" void kernel_launch(void* const* d_in, const int* in_sizes, int n_in, void* d_out, int out_size, void* d_ws, size_t ws_size, hipStream_t stream) {
    static int grid = 0;
    if (grid == 0) {
        if (n_in != 17 || in_sizes[0] != SEQ * D || out_size != SEQ * D || ws_size < WS_END) { fprintf(stderr, "kernel_launch: unexpected shapes (n_in %d, in0 %d, out %d, ws %zu, need %zu)\n", n_in, n_in > 0 ? in_sizes[0] : -1, out_size, ws_size, (size_t)WS_END); grid = -1; return; }
        int dev = 0, cus = 0, per_cu = 0;
        (void)hipGetDevice(&dev); (void)hipDeviceGetAttribute(&cus, hipDeviceAttributeMultiprocessorCount, dev);
        if (hipOccupancyMaxActiveBlocksPerMultiprocessor(&per_cu, (const void*)fwd_kernel, NTHREADS, 0) != hipSuccess || per_cu < 1) { fprintf(stderr, "kernel_launch: occupancy query says %d blocks per CU\n", per_cu); per_cu = 1; }
        (void)hipGetLastError();
        grid = cus;
        if (grid % 8 != 0 || grid < 64) { fprintf(stderr, "kernel_launch: unexpected CU count %d\n", cus); }
    }
    if (grid < 0) return;
    if (hipMemsetAsync((char*)d_ws + WS_CTL, 0, CTL_BYTES, stream) != hipSuccess) { fprintf(stderr, "kernel_launch: memset failed\n"); return; }
    Params p{};
    const float** pp = (const float**)&p;
    for (int i = 0; i < 17; ++i) pp[i] = (const float*)d_in[i];
    p.out = (float*)d_out; p.ws = (unsigned char*)d_ws;
#if MODE == 0
    for (int ph = 0; ph < NPHASE; ++ph) { p.ph_lo = ph; p.ph_hi = ph + 1; hipLaunchKernelGGL(fwd_kernel, dim3(grid), dim3(NTHREADS), 0, stream, p); }
#else
    p.ph_lo = 0; p.ph_hi = NPHASE;
    void* args[] = {&p};
    hipError_t e = hipLaunchCooperativeKernel((const void*)fwd_kernel, dim3(grid), dim3(NTHREADS), args, 0, stream);
    if (e != hipSuccess) fprintf(stderr, "cooperative launch failed: %s (grid %d)\n", hipGetErrorString(e), grid);
#endif
}
```

```cpp
#include <hip/hip_runtime.h>
#include <cstdio>
#include <cstdint>

#ifndef MODE
#define MODE 1
#endif

#define LAS __attribute__((address_space(3)))
typedef _Float16 f16;
typedef _Float16 half8 __attribute__((ext_vector_type(8)));
typedef _Float16 half4 __attribute__((ext_vector_type(4)));
typedef float f32x2 __attribute__((ext_vector_type(2)));
typedef float f32x4 __attribute__((ext_vector_type(4)));
typedef float f32x16 __attribute__((ext_vector_type(16)));
typedef unsigned u32x2 __attribute__((ext_vector_type(2)));
typedef unsigned u32x4 __attribute__((ext_vector_type(4)));
typedef int i32x4 __attribute__((ext_vector_type(4)));

constexpr int D = 1024, SEQ = 16384, NMETA = 16, L = SEQ + NMETA, DFF = 2816;
constexpr int MP = 16640;
constexpr int LP = 16512;
constexpr int NIN = 3840;
constexpr int NCH = 257;
constexpr float EPS = 1e-6f;
constexpr int NTHREADS = 512;
constexpr int LDS_BYTES = 155648 + 1024;
constexpr int NPHASE = 12;

constexpr size_t al256(size_t x) { return (x + 255) & ~(size_t)255; }
constexpr size_t WS_CTL = 0;
constexpr size_t CTL_BYTES = 32768;
constexpr size_t WS_BAR = 2048;
constexpr size_t WS_WGU1 = CTL_BYTES;
constexpr size_t WS_WD1 = WS_WGU1 + (size_t)2 * DFF * D * 2;
constexpr size_t WS_WIN = WS_WD1 + (size_t)D * DFF * 2;
constexpr size_t WS_WOUT = WS_WIN + (size_t)NIN * D * 2;
constexpr size_t WS_WGU2 = WS_WOUT + (size_t)D * D * 2;
constexpr size_t WS_WD2 = WS_WGU2 + (size_t)2 * DFF * D * 2;
constexpr size_t WS_ACTA = WS_WD2 + (size_t)D * DFF * 2;
constexpr size_t WS_G = WS_ACTA + (size_t)MP * D * 2;
constexpr size_t WS_US = WS_G + (size_t)MP * DFF * 2;
constexpr size_t WS_DQ = WS_US + (size_t)NCH * 4 * 64 * 128 * 4;
constexpr size_t WS_IQ = WS_DQ + (size_t)LP * 512 * 2;
constexpr size_t WS_SEL = WS_IQ + (size_t)LP * 512 * 2;
constexpr size_t WS_ROPE = WS_SEL + (size_t)LP * 256 * 2;
constexpr size_t WS_IW = WS_ROPE + al256((size_t)L * 32 * 8);
constexpr size_t WS_GA = WS_IW + (size_t)LP * 8 * 4;
constexpr size_t WS_DECAY = WS_GA + (size_t)LP * 16 * 4;
constexpr size_t WS_SS0 = WS_DECAY + al256((size_t)NCH * 256 * 4);
constexpr size_t WS_SS1 = WS_SS0 + (size_t)MP * 4;
constexpr size_t WS_SS2 = WS_SS1 + (size_t)MP * 64;
constexpr size_t WS_SS3 = WS_SS2 + (size_t)MP * 64;
constexpr size_t WS_END = WS_SS3 + (size_t)MP * 64;
constexpr size_t WS_KV = WS_G;
constexpr size_t WS_GQ = WS_KV + (size_t)8 * LP * 128 * 2;
constexpr size_t WS_GK = WS_GQ + (size_t)LP * 256 * 2;
constexpr size_t WS_GV = WS_GK + (size_t)LP * 256 * 2;
constexpr size_t WS_GR = WS_GV + (size_t)LP * 512 * 2;
constexpr size_t WS_IK = WS_GR + (size_t)LP * 512 * 2;
constexpr size_t WS_ALIAS_END = WS_IK + (size_t)LP * 64 * 2;
static_assert(WS_ALIAS_END <= WS_US, "aliased buffers exceed G");
static_assert(WS_END <= (size_t)256 * 1024 * 1024, "workspace exceeds 256 MiB");
static_assert((size_t)SEQ * D * 2 <= (size_t)NCH * 4 * 64 * 128 * 4, "h2_16 alias");

struct Params {
    const float* x; const float* meta; const float* n1; const float* wg1; const float* wu1; const float* wd1;
    const float* nmix; const float* win; const float* wa2; const float* ba; const float* hn; const float* wout;
    const float* n2; const float* wg2; const float* wu2; const float* wd2; const float* nf;
    float* out; unsigned char* ws; int ph_lo, ph_hi;
};

namespace pg8 {
constexpr int BM = 256, BK = 64, HALF = 128, HTB = HALF * BK * 2, STAGE_BYTES = 8 * HTB, NXCD = 8, WGM = 8;
__host__ __device__ __forceinline__ int lds_byte(int r, int c) { const int st = (r >> 4) * 2 + (c >> 5), rr = r & 15, cc = c & 31, ob = rr * 64 + cc * 2; return st * 1024 + (ob ^ (((ob >> 9) & 1) << 5)); }
__host__ __device__ __forceinline__ int perm32(int rho) { const int n = rho >> 4, i = rho & 15; return 8 * (i >> 2) + 4 * n + (i & 3); }
__host__ __device__ __forceinline__ void stage_rc(int b, int& R, int& C) { const int st = b / 1024, sb = b % 1024, swz = sb ^ (((sb >> 9) & 1) << 5); R = (st >> 1) * 16 + swz / 64; C = (st & 1) * 32 + (swz % 64) / 2; }
struct Unit { int pm, pn; };
struct Gemm { const f16* A; const f16* Bt; int M, N, K; };
struct StaticOrder {
    int nM, nN, nwg, G, c;
    __host__ __device__ void init(int M, int N, int G_, int c_) { nM = M / BM; nN = N / BM; nwg = nM * nN; G = G_; c = c_; }
    __host__ __device__ bool next(int i, Unit& u) const {
        const long Lx = (long)i * G + c; if (Lx >= nwg) return false;
        int wgid = (int)Lx; { const int q = nwg / NXCD, r = nwg % NXCD, xcd = wgid % NXCD, off = wgid / NXCD; wgid = (xcd < r ? xcd * (q + 1) : r * (q + 1) + (xcd - r) * q) + off; }
        const int nig = WGM * nN, gid = wgid / nig, fm = gid * WGM, gsz = (nM - fm) < WGM ? (nM - fm) : WGM;
        u.pm = fm + ((wgid % nig) % gsz); u.pn = (wgid % nig) / gsz; return true;
    }
};
template <class Epi>
__device__ __forceinline__ void gemm_phase(LAS unsigned char* lds, const Gemm g, const StaticOrder& S, const Epi& E) {
    int tid_ = threadIdx.x; asm volatile("" : "+v"(tid_));
    const int tid = tid_, wid = __builtin_amdgcn_readfirstlane(tid >> 6), lane = tid & 63, wr = wid >> 2, wc = wid & 3, fr = lane & 15, fq = lane >> 4;
    const int K = g.K, nt = K / BK;
    unsigned voffA[2], voffB[2];
#pragma unroll
    for (int i = 0; i < 2; ++i) { int R, C; stage_rc(tid * 16 + i * 8192, R, C); const int Rb = (R & ~31) + perm32(R & 31); voffA[i] = (unsigned)(R * K + C) * 2u; voffB[i] = (unsigned)(Rb * K + C) * 2u; }
    const size_t kstep = (size_t)(BK * 2);
    const size_t hstep = (size_t)HALF * K * 2;
    const size_t tstep = 2 * hstep;
    const unsigned ldsw = (unsigned)wid * 1024u;
    const int aoff = lds_byte(wr * 64 + fr, fq * 8), boff = lds_byte(wc * 32 + fr, fq * 8);
#define PG8_SA(b, h) (((b) * 2 + (h)) * HTB)
#define PG8_SB(b, h) ((4 + (b) * 2 + (h)) * HTB)
#define PG8_STAGE(bufoff, gbase, voff) do { _Pragma("unroll") for (int _i = 0; _i < 2; ++_i) \
        __builtin_amdgcn_global_load_lds((const unsigned*)((const char*)(gbase) + (voff)[_i]), (LAS unsigned*)(lds + (bufoff) + ldsw + _i * 8192), 16, 0, 0); } while (0)
#define PG8_LDA(dst, b, h) do { _Pragma("unroll") for (int m = 0; m < 4; ++m) _Pragma("unroll") for (int k = 0; k < 2; ++k) dst[m][k] = *(const LAS half8*)(lds + PG8_SA(b, h) + aoff + m * 2048 + k * 1024); } while (0)
#define PG8_LDB(dst, b, h) do { _Pragma("unroll") for (int n = 0; n < 2; ++n) _Pragma("unroll") for (int k = 0; k < 2; ++k) dst[n][k] = *(const LAS half8*)(lds + PG8_SB(b, h) + boff + n * 2048 + k * 1024); } while (0)
#define PG8_MMA(ai, bj, At, Bt) do { __builtin_amdgcn_s_setprio(1); _Pragma("unroll") for (int m = 0; m < 4; ++m) _Pragma("unroll") for (int n = 0; n < 2; ++n) _Pragma("unroll") for (int k = 0; k < 2; ++k) { \
        if constexpr (Epi::I8) acc[ai][bj][m][n] = __builtin_bit_cast(f32x4, __builtin_amdgcn_mfma_i32_16x16x64_i8(__builtin_bit_cast(i32x4, Bt[n][k]), __builtin_bit_cast(i32x4, At[m][k]), __builtin_bit_cast(i32x4, acc[ai][bj][m][n]), 0, 0, 0)); \
        else acc[ai][bj][m][n] = __builtin_amdgcn_mfma_f32_16x16x32_f16(Bt[n][k], At[m][k], acc[ai][bj][m][n], 0, 0, 0); } __builtin_amdgcn_s_setprio(0); } while (0)
#define PG8_WAIT_V(n) asm volatile("s_waitcnt vmcnt(" #n ")" ::: "memory")
#define PG8_WAIT_L(n) asm volatile("s_waitcnt lgkmcnt(" #n ")" ::: "memory")
#define PG8_BAR __builtin_amdgcn_s_barrier()
#define PG8_SCHED __builtin_amdgcn_sched_barrier(0)
    Unit cur, nxt; int ui = 0;
    if (!S.next(0, cur)) return;
    f32x4 acc[2][2][4][2];
#pragma unroll
    for (int a = 0; a < 2; ++a)
#pragma unroll
        for (int b = 0; b < 2; ++b)
#pragma unroll
            for (int m = 0; m < 4; ++m)
#pragma unroll
                for (int n = 0; n < 2; ++n) acc[a][b][m][n] = (f32x4){0.f, 0.f, 0.f, 0.f};
    half8 At[4][2], B0[2][2], B1[2][2];
    const char* cA = (const char*)g.A + (size_t)cur.pm * tstep; const char* cB = (const char*)g.Bt + (size_t)cur.pn * tstep;
    PG8_STAGE(PG8_SB(0, 0), cB, voffB); PG8_STAGE(PG8_SA(0, 0), cA, voffA); PG8_STAGE(PG8_SB(0, 1), cB + hstep, voffB); PG8_STAGE(PG8_SA(0, 1), cA + hstep, voffA);
    if (wr == 1) PG8_BAR;
    PG8_WAIT_V(4); PG8_BAR;
    PG8_STAGE(PG8_SB(1, 0), cB + kstep, voffB); PG8_STAGE(PG8_SA(1, 0), cA + kstep, voffA); PG8_STAGE(PG8_SB(1, 1), cB + hstep + kstep, voffB);
    PG8_WAIT_V(6); PG8_BAR;
    for (;;) {
        const bool has_next = S.next(ui + 1, nxt);
        const char* nA = has_next ? (const char*)g.A + (size_t)nxt.pm * tstep : cA; const char* nB = has_next ? (const char*)g.Bt + (size_t)nxt.pn * tstep : cB;
        for (int t = 0; t < nt; t += 2) {
            const bool last = (t == nt - 2);
            const char* a1 = cA + (size_t)(t + 1) * kstep;
            const char* a2 = last ? nA : cA + (size_t)(t + 2) * kstep; const char* b2 = last ? nB : cB + (size_t)(t + 2) * kstep;
            const char* a3 = a2 + kstep; const char* b3 = b2 + kstep;
            PG8_LDB(B0, 0, 0); PG8_SCHED; PG8_LDA(At, 0, 0); PG8_STAGE(PG8_SA(1, 1), a1 + hstep, voffA);
            PG8_WAIT_L(8); PG8_BAR; PG8_WAIT_L(0); PG8_MMA(0, 0, At, B0); PG8_BAR; PG8_SCHED;
            PG8_LDB(B1, 0, 1); PG8_STAGE(PG8_SB(0, 0), b2, voffB);
            PG8_BAR; PG8_WAIT_L(0); PG8_MMA(0, 1, At, B1); PG8_BAR;
            PG8_LDA(At, 0, 1); PG8_STAGE(PG8_SA(0, 0), a2, voffA);
            PG8_BAR; PG8_WAIT_L(0); PG8_MMA(1, 0, At, B0); PG8_BAR; PG8_SCHED;
            PG8_STAGE(PG8_SB(0, 1), b2 + hstep, voffB);
            PG8_WAIT_V(6); PG8_BAR; PG8_MMA(1, 1, At, B1); PG8_BAR;
            PG8_LDB(B0, 1, 0); PG8_SCHED; PG8_LDA(At, 1, 0); PG8_STAGE(PG8_SA(0, 1), a2 + hstep, voffA);
            PG8_WAIT_L(8); PG8_BAR; PG8_WAIT_L(0); PG8_MMA(0, 0, At, B0); PG8_BAR; PG8_SCHED;
            PG8_LDB(B1, 1, 1); PG8_STAGE(PG8_SB(1, 0), b3, voffB);
            PG8_BAR; PG8_WAIT_L(0); PG8_MMA(0, 1, At, B1); PG8_BAR;
            PG8_LDA(At, 1, 1); PG8_STAGE(PG8_SA(1, 0), a3, voffA);
            PG8_BAR; PG8_WAIT_L(0); PG8_MMA(1, 0, At, B0); PG8_BAR; PG8_SCHED;
            PG8_STAGE(PG8_SB(1, 1), b3 + hstep, voffB);
            PG8_WAIT_V(6); PG8_BAR; PG8_MMA(1, 1, At, B1); PG8_BAR;
        }
        if constexpr (Epi::I8) {
#pragma unroll
            for (int a = 0; a < 2; ++a)
#pragma unroll
                for (int b = 0; b < 2; ++b)
#pragma unroll
                    for (int m = 0; m < 4; ++m)
#pragma unroll
                        for (int n = 0; n < 2; ++n) { const i32x4 v = __builtin_bit_cast(i32x4, acc[a][b][m][n]); acc[a][b][m][n] = (f32x4){(float)v[0], (float)v[1], (float)v[2], (float)v[3]}; }
        }
        E(acc, cur, wr, wc, fr, fq);
        if (!has_next) break;
#pragma unroll
        for (int a = 0; a < 2; ++a)
#pragma unroll
            for (int b = 0; b < 2; ++b)
#pragma unroll
                for (int m = 0; m < 4; ++m)
#pragma unroll
                    for (int n = 0; n < 2; ++n) acc[a][b][m][n] = (f32x4){0.f, 0.f, 0.f, 0.f};
        cur = nxt; cA = nA; cB = nB; ++ui;
    }
    PG8_WAIT_V(0);
    if (wr == 0) PG8_BAR;
    PG8_BAR;
#undef PG8_SA
#undef PG8_SB
#undef PG8_STAGE
#undef PG8_LDA
#undef PG8_LDB
#undef PG8_MMA
#undef PG8_WAIT_V
#undef PG8_WAIT_L
#undef PG8_BAR
#undef PG8_SCHED
}
}

__device__ __forceinline__ float silu_f(float v) { return v * __builtin_amdgcn_rcpf(1.0f + __expf(-v)); }
__device__ __forceinline__ half4 to_half4(f32x4 v) { half4 h; h[0] = (f16)v[0]; h[1] = (f16)v[1]; h[2] = (f16)v[2]; h[3] = (f16)v[3]; return h; }

__device__ __forceinline__ float row_rstd(const float* ss, int np, int row) {
    float s;
    if (np == 1) s = ss[row];
    else { const f32x4* p = (const f32x4*)(ss + (size_t)row * 16); const f32x4 a = p[0], b = p[1], c = p[2], d = p[3];
        s = (((a[0] + a[1]) + (a[2] + a[3])) + ((b[0] + b[1]) + (b[2] + b[3]))) + (((c[0] + c[1]) + (c[2] + c[3])) + ((d[0] + d[1]) + (d[2] + d[3]))); }
    return rsqrtf(s * (1.0f / D) + EPS);
}
template <bool I8_> struct EpiSwiglu {
    static constexpr bool I8 = I8_;
    f16* G; const float* ss; int np; const float* sa; const float* sw;
    __device__ __forceinline__ void operator()(const f32x4 (&acc)[2][2][4][2], const pg8::Unit& u, int wr, int wc, int fr_, int fq_) const {
        int fr = fr_, fq = fq_; asm volatile("" : "+v"(fr), "+v"(fq));
        f32x4 swg[2], swu[2];
        if constexpr (I8) {
#pragma unroll
            for (int n = 0; n < 2; ++n) { swg[n] = *(const f32x4*)(sw + u.pn * 256 + wc * 32 + 8 * fq + 4 * n); swu[n] = *(const f32x4*)(sw + u.pn * 256 + 128 + wc * 32 + 8 * fq + 4 * n); }
        }
#pragma unroll
        for (int ai = 0; ai < 2; ++ai)
#pragma unroll
            for (int m = 0; m < 4; ++m) {
                const int row = u.pm * 256 + ai * 128 + wr * 64 + m * 16 + fr;
                float rs; if constexpr (I8) rs = sa[row]; else rs = row_rstd(ss, np, row);
                const float ce = -1.4426950408889634f * rs, rs2 = rs * rs; half8 o;
#pragma unroll
                for (int n = 0; n < 2; ++n) {
                    f32x4 g = acc[ai][0][m][n], u = acc[ai][1][m][n];
                    if constexpr (I8) { g = g * swg[n]; u = u * swu[n]; }
                    const f32x4 t = g * ce; f32x4 e, r;
#pragma unroll
                    for (int j = 0; j < 4; ++j) e[j] = __builtin_amdgcn_exp2f(t[j]);
                    const f32x4 d = e + 1.0f;
#pragma unroll
                    for (int j = 0; j < 4; ++j) r[j] = __builtin_amdgcn_rcpf(d[j]);
                    const f32x4 w = (g * u) * (r * rs2);
#pragma unroll
                    for (int j = 0; j < 4; ++j) o[4 * n + j] = (f16)w[j];
                }
                *(half8*)(G + (size_t)row * DFF + u.pn * 128 + wc * 32 + 8 * fq) = o;
            }
    }
};
template <bool SRC16, bool STATS = true> struct EpiResid {
    static constexpr bool I8 = false;
    const void* src; f16* h16; float* ss; float alpha;
    __device__ __forceinline__ void operator()(const f32x4 (&acc)[2][2][4][2], const pg8::Unit& u, int wr, int wc, int fr_, int fq_) const {
        int fr = fr_, fq = fq_; asm volatile("" : "+v"(fr), "+v"(fq));
#pragma unroll
        for (int ai = 0; ai < 2; ++ai)
#pragma unroll
            for (int m = 0; m < 4; ++m) {
                const int row = u.pm * 256 + ai * 128 + wr * 64 + m * 16 + fr; float part = 0.f;
#pragma unroll
                for (int bj = 0; bj < 2; ++bj) {
                    const size_t off = (size_t)row * D + u.pn * 256 + bj * 128 + wc * 32 + 8 * fq; half8 h; f32x4 sv[2];
                    if (SRC16) { const half8 s8 = *(const half8*)((const f16*)src + off);
#pragma unroll
                        for (int j = 0; j < 4; ++j) { sv[0][j] = (float)s8[j]; sv[1][j] = (float)s8[4 + j]; } }
                    else { sv[0] = *(const f32x4*)((const float*)src + off); sv[1] = *(const f32x4*)((const float*)src + off + 4); }
#pragma unroll
                    for (int n = 0; n < 2; ++n) {
                        const f32x4 o = sv[n] + alpha * acc[ai][bj][m][n];
#pragma unroll
                        for (int j = 0; j < 4; ++j) h[4 * n + j] = (f16)o[j];
                        if (STATS) part += (o[0] * o[0] + o[1] * o[1]) + (o[2] * o[2] + o[3] * o[3]);
                    }
                    *(half8*)(h16 + off) = h;
                }
                if (STATS) { part += __shfl_xor(part, 16); part += __shfl_xor(part, 32);
                    if (fq == 0) ss[(size_t)row * 16 + u.pn * 4 + wc] = part; }
            }
    }
};
constexpr float K_I8_SCALE = 127.0f / 8.0f;
__device__ __forceinline__ void rope8(const f32x4 (&x1)[2], const f32x4 (&x2)[2], const f32x2* rp, float sc, float (&o1)[8], float (&o2)[8]) {
#pragma unroll
    for (int n = 0; n < 2; ++n) {
        const f32x4 cs0 = *(const f32x4*)(rp + 4 * n), cs1 = *(const f32x4*)(rp + 4 * n + 2);
        o1[4 * n + 0] = (x1[n][0] * cs0[0] - x2[n][0] * cs0[1]) * sc; o2[4 * n + 0] = (x2[n][0] * cs0[0] + x1[n][0] * cs0[1]) * sc;
        o1[4 * n + 1] = (x1[n][1] * cs0[2] - x2[n][1] * cs0[3]) * sc; o2[4 * n + 1] = (x2[n][1] * cs0[2] + x1[n][1] * cs0[3]) * sc;
        o1[4 * n + 2] = (x1[n][2] * cs1[0] - x2[n][2] * cs1[1]) * sc; o2[4 * n + 2] = (x2[n][2] * cs1[0] + x1[n][2] * cs1[1]) * sc;
        o1[4 * n + 3] = (x1[n][3] * cs1[2] - x2[n][3] * cs1[3]) * sc; o2[4 * n + 3] = (x2[n][3] * cs1[2] + x1[n][3] * cs1[3]) * sc;
    }
}
__device__ __forceinline__ u32x2 pack_i8x8(const float (&v)[8]) {
    u32x2 r;
#pragma unroll
    for (int w = 0; w < 2; ++w) { unsigned word = 0u;
#pragma unroll
        for (int j = 0; j < 4; ++j) { const int q = (int)__builtin_rintf(fminf(fmaxf(v[4 * w + j] * K_I8_SCALE, -127.f), 127.f)); word |= ((unsigned)q & 0xffu) << (8 * j); }
        r[w] = word; }
    return r;
}
__device__ __forceinline__ u32x2 pack_bf8x8(const float (&v)[8]) {
    u32x2 r;
#pragma unroll
    for (int w = 0; w < 2; ++w) { int word = __builtin_amdgcn_cvt_pk_bf8_f32(v[4 * w], v[4 * w + 1], 0, false); word = __builtin_amdgcn_cvt_pk_bf8_f32(v[4 * w + 2], v[4 * w + 3], word, true); r[w] = (unsigned)word; }
    return r;
}
struct EpiInProj {
    static constexpr bool I8 = false;
    const float* ss; const f32x2* rope; unsigned char* ws;
    __device__ __forceinline__ void operator()(const f32x4 (&acc)[2][2][4][2], const pg8::Unit& u, int wr, int wc, int fr_, int fq_) const {
        int fr = fr_, fq = fq_; asm volatile("" : "+v"(fr), "+v"(fq));
        const int pn = u.pn;
        if (pn >= 8 && pn <= 11) {
            unsigned char* lb = (pn <= 9) ? ws + WS_KV + (size_t)((pn - 8) * 4 + wc) * LP * 128 + 8 * fq
                                          : ws + WS_KV + (size_t)((pn - 10) * 4 + (wc >> 1)) * LP * 128 + 64 + (wc & 1) * 32 + 8 * fq;
#pragma unroll
            for (int ai = 0; ai < 2; ++ai)
#pragma unroll
                for (int m = 0; m < 4; ++m) {
                    const int p = u.pm * 256 + ai * 128 + wr * 64 + m * 16 + fr;
                    const int t = p < SEQ ? p + NMETA : p - SEQ;
                    if (p < L) {
                        const float sc = row_rstd(ss, 16, p);
                        if (pn <= 9) {
                            float o1[8], o2[8]; rope8(acc[ai][0][m], acc[ai][1][m], rope + (size_t)t * 32 + 8 * fq, sc, o1, o2);
                            unsigned char* d8 = lb + (size_t)t * 128; *(u32x2*)d8 = pack_i8x8(o1); *(u32x2*)(d8 + 32) = pack_i8x8(o2);
                        } else {
#pragma unroll
                            for (int bj = 0; bj < 2; ++bj) { float v[8];
#pragma unroll
                                for (int j = 0; j < 4; ++j) { v[j] = acc[ai][bj][m][0][j] * sc; v[4 + j] = acc[ai][bj][m][1][j] * sc; }
                                *(u32x2*)(lb + (size_t)t * 128 + (size_t)bj * 2 * LP * 128) = pack_bf8x8(v); }
                        }
                    }
                    asm volatile("" ::: "memory");
                }
            return;
        }
        int mode = 0, stride = 256; float scale = 1.0f; f16* lanebase;
        if (pn == 0) lanebase = (f16*)(ws + WS_GQ) + wc * 32 + 8 * fq;
        else if (pn == 1) lanebase = (f16*)(ws + WS_GK) + wc * 32 + 8 * fq;
        else if (pn <= 3) { lanebase = (f16*)(ws + WS_GV) + (pn - 2) * 256 + wc * 32 + 8 * fq; stride = 512; }
        else if (pn <= 5) { lanebase = (f16*)(ws + WS_GR) + (pn - 4) * 256 + wc * 32 + 8 * fq; stride = 512; }
        else if (pn <= 7) { lanebase = (f16*)(ws + WS_DQ); mode = 6; scale = 0.125f; }
        else if (pn <= 13) { lanebase = (f16*)(ws + WS_IQ) + (pn - 12) * 256 + wc * 64 + 8 * fq; stride = 512; mode = 1; scale = 0.125f; }
        else { lanebase = (f16*)(ws + WS_IK) + 8 * fq; stride = 64; mode = wc == 0 ? 1 : (wc == 1 ? 2 : 3); }
#pragma unroll
        for (int ai = 0; ai < 2; ++ai)
#pragma unroll
            for (int m = 0; m < 4; ++m) {
                const int p = u.pm * 256 + ai * 128 + wr * 64 + m * 16 + fr;
                const int t = p < SEQ ? p + NMETA : p - SEQ;
                if (p < L && mode != 3) {
                    const float rs = row_rstd(ss, 16, p);
                    if (mode == 6) {
                        float o1[8], o2[8]; rope8(acc[ai][0][m], acc[ai][1][m], rope + (size_t)t * 32 + 8 * fq, rs * scale, o1, o2);
                        float qm = 1e-20f;
#pragma unroll
                        for (int j = 0; j < 8; ++j) qm = fmaxf(qm, fmaxf(fabsf(o1[j]), fabsf(o2[j])));
                        qm = fmaxf(qm, __shfl_xor(qm, 16)); qm = fmaxf(qm, __shfl_xor(qm, 32));
                        const float qsc = 127.0f * __builtin_amdgcn_rcpf(qm); u32x2 w1, w2;
#pragma unroll
                        for (int w = 0; w < 2; ++w) { unsigned a = 0u, b = 0u;
#pragma unroll
                            for (int j = 0; j < 4; ++j) { a |= ((unsigned)(int)__builtin_rintf(o1[4 * w + j] * qsc) & 0xffu) << (8 * j); b |= ((unsigned)(int)__builtin_rintf(o2[4 * w + j] * qsc) & 0xffu) << (8 * j); }
                            w1[w] = a; w2[w] = b; }
                        const int head = (pn - 6) * 4 + wc; unsigned char* qrow = ws + WS_DQ + (size_t)t * 512 + head * 64 + 8 * fq;
                        *(u32x2*)qrow = w1; *(u32x2*)(qrow + 32) = w2;
                        if (fq == 0) ((float*)(ws + WS_DQ + (size_t)LP * 512))[(size_t)t * 8 + head] = qm * (1.0f / (127.0f * K_I8_SCALE));
                    } else if (mode == 1) {
                        float o1[8], o2[8]; rope8(acc[ai][0][m], acc[ai][1][m], rope + (size_t)t * 32 + 8 * fq, rs * scale, o1, o2);
                        half8 h1, h2;
#pragma unroll
                        for (int j = 0; j < 8; ++j) { h1[j] = (f16)o1[j]; h2[j] = (f16)o2[j]; }
                        f16* dst = lanebase + (size_t)t * stride; *(half8*)dst = h1; *(half8*)(dst + 32) = h2;
                    } else if (mode == 2) {
                        if (fq < 2) { float* gp = (float*)(ws + WS_GA) + (size_t)t * 16 + 8 * fq; *(f32x4*)gp = acc[ai][0][m][0] * rs; *(f32x4*)(gp + 4) = acc[ai][0][m][1] * rs; }
                        else if (fq == 2) { float* ip = (float*)(ws + WS_IW) + (size_t)t * 8; const float r2 = rs * 0.35355339059327373f; *(f32x4*)ip = acc[ai][0][m][0] * r2; *(f32x4*)(ip + 4) = acc[ai][0][m][1] * r2; }
                    } else {
#pragma unroll
                        for (int bj = 0; bj < 2; ++bj) { half8 h;
#pragma unroll
                            for (int j = 0; j < 4; ++j) { h[j] = (f16)(acc[ai][bj][m][0][j] * rs); h[4 + j] = (f16)(acc[ai][bj][m][1][j] * rs); }
                            *(half8*)(lanebase + (size_t)t * stride + bj * 128) = h; }
                    }
                }
                asm volatile("" ::: "memory");
            }
    }
};

__device__ __forceinline__ const float* w_src(const Params& P, int kind, int n, int& ld, const float*& gain) {
    switch (kind) {
    case 0: case 4: { const int pn = n >> 8, bj = (n >> 7) & 1, cc = n & 127; ld = DFF; gain = kind == 0 ? P.n1 : P.n2;
        const float* w = kind == 0 ? (bj ? P.wu1 : P.wg1) : (bj ? P.wu2 : P.wg2); return w + pn * 128 + cc; }
    case 1: ld = D; gain = nullptr; return P.wd1 + n;
    case 5: ld = D; gain = nullptr; return P.wd2 + n;
    case 3: ld = D; gain = nullptr; return P.wout + n;
    default: { ld = 3672; gain = P.nmix; const int pn = n >> 8, c = n & 255, bj = c >> 7, hh = (c >> 5) & 3, dd = c & 31; int j;
        if (pn == 0) j = c; else if (pn == 1) j = 256 + c; else if (pn <= 3) j = 512 + (pn - 2) * 256 + c; else if (pn <= 5) j = 1024 + (pn - 4) * 256 + c;
        else if (pn <= 7) j = 1552 + (pn - 6) * 256 + hh * 64 + bj * 32 + dd;
        else if (pn <= 9) j = 2064 + (pn - 8) * 256 + hh * 64 + bj * 32 + dd;
        else if (pn <= 11) j = 2576 + (pn - 10) * 256 + c;
        else if (pn <= 13) j = 3088 + (pn - 12) * 256 + hh * 64 + bj * 32 + dd;
        else { if (c < 32) j = 3600 + c; else if (c < 48) j = 1536 + (c - 32); else if (c < 56) j = 3664 + (c - 48); else if (c >= 128 && c < 160) j = 3600 + 32 + (c - 128); else j = -1; }
        return j < 0 ? nullptr : P.win + j; }
    }
}
__device__ __forceinline__ void prep_weight(const Params& P, const int kind, const int N, const int K, f16* dst, int& cursor, int& tbase, LAS f16* tl, const int G) {
    const int tid = threadIdx.x, tn = N / 64, tk = K / 256, ntile = tn * tk;
    const int n = tid & 63, kk0 = tid >> 6;
    float v[32], vn[32];
#define PREP_LOAD(dstv, tI) do { const int n0_ = ((tI) % tn) * 64, k0_ = ((tI) / tn) * 256; int ld; const float* gain; const float* col = w_src(P, kind, n0_ + n, ld, gain); \
        _Pragma("unroll") for (int i = 0; i < 32; ++i) dstv[i] = col ? col[(size_t)(k0_ + kk0 + 8 * i) * ld] : 0.f; \
        if (gain) { _Pragma("unroll") for (int i = 0; i < 32; ++i) dstv[i] *= gain[k0_ + kk0 + 8 * i]; } } while (0)
    if (cursor < tbase + ntile) PREP_LOAD(v, cursor - tbase);
#pragma unroll 1
    for (; cursor < tbase + ntile; cursor += G) {
        const int tI = cursor - tbase, n0 = (tI % tn) * 64, k0 = (tI / tn) * 256;
        const bool more = cursor + G < tbase + ntile;
        if (more) PREP_LOAD(vn, tI + G);
#pragma unroll
        for (int i = 0; i < 32; ++i) tl[n * 264 + kk0 + 8 * i] = (f16)v[i];
        __syncthreads();
        { const int nr = tid >> 3, seg = tid & 7;
#pragma unroll
          for (int j = 0; j < 4; ++j) *(half8*)(dst + (size_t)(n0 + nr) * K + k0 + (seg + 8 * j) * 8) = *(const LAS half8*)(tl + nr * 264 + (seg + 8 * j) * 8); }
        __syncthreads();
        if (more) {
#pragma unroll
            for (int i = 0; i < 32; ++i) v[i] = vn[i];
        }
    }
#undef PREP_LOAD
    tbase += ntile;
}
__device__ __forceinline__ void prep_weight_i8(const Params& P, const int kind, const int N, unsigned char* dst, float* sw, int first, int step, LAS unsigned char* lds) {
    const int tid = threadIdx.x, n = tid & 63, kk0 = tid >> 6;
    LAS float* pmax = (LAS float*)lds; LAS unsigned* img = (LAS unsigned*)(lds + 2048);
#pragma unroll 1
    for (int task = first; task < N / 64; task += step) {
        const int n0 = task * 64; int ld; const float* gain; const float* col = w_src(P, kind, n0 + n, ld, gain);
        float v[128]; float mx = 0.f;
#pragma unroll
        for (int i = 0; i < 128; ++i) v[i] = col ? col[(size_t)(kk0 * 128 + i) * ld] : 0.f;
        if (gain) {
#pragma unroll
            for (int i = 0; i < 128; ++i) v[i] *= gain[kk0 * 128 + i];
        }
#pragma unroll
        for (int i = 0; i < 128; ++i) mx = fmaxf(mx, fabsf(v[i]));
        pmax[kk0 * 64 + n] = mx;
        __syncthreads();
#pragma unroll
        for (int q = 0; q < 8; ++q) mx = fmaxf(mx, pmax[q * 64 + n]);
        const float sc = mx > 0.f ? 127.0f / mx : 0.f;
        if (kk0 == 0) sw[n0 + n] = mx * (1.0f / 127.0f);
#pragma unroll
        for (int w = 0; w < 32; ++w) { unsigned word = 0u;
#pragma unroll
            for (int j = 0; j < 4; ++j) word |= ((unsigned)(int)__builtin_rintf(v[4 * w + j] * sc) & 0xffu) << (8 * j);
            img[n * 260 + kk0 * 32 + w] = word; }
        __syncthreads();
        { const int nr = tid >> 3, seg = tid & 7;
#pragma unroll
          for (int j = 0; j < 8; ++j) *(u32x4*)(dst + (size_t)(n0 + nr) * D + (seg + 8 * j) * 16) = *(const LAS u32x4*)(img + nr * 260 + (seg + 8 * j) * 4); }
        __syncthreads();
    }
}
__device__ __forceinline__ void quant_rows_i8(const f16* src, unsigned char* dst, float* sa, int rows) {
    const int tid = threadIdx.x, lane = tid & 63, gw = blockIdx.x * 8 + (tid >> 6), nw = gridDim.x * 8;
    for (int r = gw; r < rows; r += nw) {
        const half8 a = *(const half8*)(src + (size_t)r * D + lane * 16), b = *(const half8*)(src + (size_t)r * D + lane * 16 + 8);
        float v[16], mx = 0.f, sq = 0.f;
#pragma unroll
        for (int j = 0; j < 8; ++j) { v[j] = (float)a[j]; v[8 + j] = (float)b[j]; }
#pragma unroll
        for (int j = 0; j < 16; ++j) { mx = fmaxf(mx, fabsf(v[j])); sq = __builtin_fmaf(v[j], v[j], sq); }
#pragma unroll
        for (int o = 32; o >= 1; o >>= 1) { mx = fmaxf(mx, __shfl_xor(mx, o)); sq += __shfl_xor(sq, o); }
        const float sc = mx > 0.f ? 127.0f / mx : 0.f; u32x4 w;
#pragma unroll
        for (int q = 0; q < 4; ++q) { unsigned word = 0u;
#pragma unroll
            for (int j = 0; j < 4; ++j) word |= ((unsigned)(int)__builtin_rintf(v[4 * q + j] * sc) & 0xffu) << (8 * j);
            w[q] = word; }
        *(u32x4*)(dst + (size_t)r * D + lane * 16) = w;
        if (lane == 0) sa[r] = mx * (1.0f / 127.0f) * rsqrtf(sq * (1.0f / D) + EPS);
    }
}
__device__ __forceinline__ void p0_prologue(const Params& P, LAS unsigned char* lds) {
    const int tid = threadIdx.x, bid = blockIdx.x, G = gridDim.x, lane = tid & 63;
    unsigned char* ws = P.ws;
    LAS f16* tl = (LAS f16*)lds;
    {
        constexpr int NI8 = 2 * DFF / 64; const int nI = G > 2 * NI8 ? NI8 : 0;
        if (bid >= G - nI || nI == 0) prep_weight_i8(P, 0, 2 * DFF, ws + WS_WGU1, (float*)(ws + WS_WGU1 + (size_t)2 * DFF * D), nI ? bid - (G - nI) : bid, nI ? nI : G, lds);
        if (bid < G - nI) { int tbase = 0, cursor = bid; __syncthreads();
            prep_weight(P, 1, D, DFF, (f16*)(ws + WS_WD1), cursor, tbase, tl, G - nI);
            prep_weight(P, 2, NIN, D, (f16*)(ws + WS_WIN), cursor, tbase, tl, G - nI); }
    }
    f16* acta = (f16*)(ws + WS_ACTA);
    const int gw = bid * 8 + (tid >> 6), nw = G * 8;
    unsigned char* x8 = ws + WS_US; float* sa0 = (float*)(ws + WS_IQ);
    for (int p = gw; p < L; p += nw) {
        const float* src = p < SEQ ? P.x + (size_t)p * D : P.meta + (size_t)(p - SEQ) * D; float s = 0.f, mx = 0.f; f32x4 v[4];
#pragma unroll
        for (int i = 0; i < 4; ++i) { v[i] = *(const f32x4*)(src + lane * 4 + 256 * i); s += (v[i][0] * v[i][0] + v[i][1] * v[i][1]) + (v[i][2] * v[i][2] + v[i][3] * v[i][3]);
            mx = fmaxf(fmaxf(mx, fmaxf(fabsf(v[i][0]), fabsf(v[i][1]))), fmaxf(fabsf(v[i][2]), fabsf(v[i][3]))); *(half4*)(acta + (size_t)p * D + lane * 4 + 256 * i) = to_half4(v[i]); }
#pragma unroll
        for (int o = 32; o >= 1; o >>= 1) { s += __shfl_xor(s, o); mx = fmaxf(mx, __shfl_xor(mx, o)); }
        const float sc = mx > 0.f ? 127.0f / mx : 0.f;
#pragma unroll
        for (int i = 0; i < 4; ++i) { unsigned word = 0u;
#pragma unroll
            for (int j = 0; j < 4; ++j) word |= ((unsigned)(int)__builtin_rintf(v[i][j] * sc) & 0xffu) << (8 * j);
            *(unsigned*)(x8 + (size_t)p * D + lane * 4 + 256 * i) = word; }
        if (lane == 0) sa0[p] = mx * (1.0f / 127.0f) * rsqrtf(s * (1.0f / D) + EPS);
    }
    const int gt = bid * NTHREADS + tid, ngt = G * NTHREADS;
    for (int i = gt; i < MP; i += ngt) { if (i >= L) sa0[i] = 0.f; }
    f32x2* rope = (f32x2*)(ws + WS_ROPE);
    for (int i = gt; i < L * 32; i += ngt) { const int t = i >> 5, f = i & 31; const double inv = exp(-(double)f * (9.210340371976184 / 32.0)); double sn, cs; sincos((double)t * inv, &sn, &cs); rope[i] = (f32x2){(float)cs, (float)sn}; }
}

__device__ __forceinline__ void meta_down(const Params& P, LAS unsigned char* lds) {
    const int tid = threadIdx.x, lane = tid & 63, wid = tid >> 6;
    const f16* Gm = (const f16*)(P.ws + WS_G) + (size_t)SEQ * DFF; const f16* Wt = (const f16*)(P.ws + WS_WD1);
    f16* acta = (f16*)P.out; float* ss1 = (float*)(P.ws + WS_SS1); LAS float* slot = (LAS float*)lds;
    for (int task = blockIdx.x; task < NMETA * 16; task += gridDim.x) {
        const int r = task >> 4, cg = task & 15; float part = 0.f;
#pragma unroll 1
        for (int q = 0; q < 2; ++q) {
            const int n0 = cg * 64 + (2 * wid + q) * 4; float a[4] = {0.f, 0.f, 0.f, 0.f};
            for (int kc = lane; kc < DFF / 8; kc += 64) {
                const half8 gv = *(const half8*)(Gm + (size_t)r * DFF + kc * 8);
#pragma unroll
                for (int j = 0; j < 4; ++j) { const half8 wv = *(const half8*)(Wt + (size_t)(n0 + j) * DFF + kc * 8);
#pragma unroll
                    for (int e = 0; e < 8; ++e) a[j] += (float)gv[e] * (float)wv[e]; }
            }
#pragma unroll
            for (int o = 32; o >= 1; o >>= 1) { a[0] += __shfl_xor(a[0], o); a[1] += __shfl_xor(a[1], o); a[2] += __shfl_xor(a[2], o); a[3] += __shfl_xor(a[3], o); }
            f32x4 o;
#pragma unroll
            for (int j = 0; j < 4; ++j) { o[j] = P.meta[r * D + n0 + j] + 0.5f * a[j]; part += o[j] * o[j]; }
            if (lane == 0) *(half4*)(acta + (size_t)(SEQ + r) * D + n0) = to_half4(o);
        }
        if (lane == 0) slot[wid] = part;
        __syncthreads();
        if (tid == 0) { float s = 0.f; for (int w = 0; w < 8; ++w) s += slot[w]; ss1[(size_t)(SEQ + r) * 16 + cg] = s; }
        __syncthreads();
    }
}

__device__ __forceinline__ float logsigmoid_f(float z) { return fminf(z, 0.f) - __logf(1.0f + __expf(-fabsf(z))); }
__device__ __forceinline__ void gla_gates(const Params& P, int c, int h, LAS float* bl) {
    const int tid = threadIdx.x, ti = tid >> 3, d0 = (tid & 7) * 8, tt = 64 * c - 48 + ti; const float* GA = (const float*)(P.ws + WS_GA);
    {
        float z[8];
        if (tt >= 0 && tt < L) {
            const f32x4 b0 = *(const f32x4*)(P.ba + 64 * h + d0), b1 = *(const f32x4*)(P.ba + 64 * h + d0 + 4);
#pragma unroll
            for (int m = 0; m < 4; ++m) { z[m] = b0[m]; z[4 + m] = b1[m]; }
            f32x4 a4[4];
#pragma unroll
            for (int q = 0; q < 4; ++q) a4[q] = *(const f32x4*)(GA + (size_t)tt * 16 + 4 * q);
#pragma unroll
            for (int r = 0; r < 16; ++r) { const float ar = a4[r >> 2][r & 3]; const f32x4 w0 = *(const f32x4*)(P.wa2 + r * 256 + 64 * h + d0), w1 = *(const f32x4*)(P.wa2 + r * 256 + 64 * h + d0 + 4);
#pragma unroll
                for (int m = 0; m < 4; ++m) { z[m] += ar * w0[m]; z[4 + m] += ar * w1[m]; } }
#pragma unroll
            for (int m = 0; m < 8; ++m) z[m] = logsigmoid_f(z[m]) * (1.0f / 16.0f);
        } else {
#pragma unroll
            for (int m = 0; m < 8; ++m) z[m] = 0.f;
        }
#pragma unroll
        for (int m = 0; m < 8; ++m) bl[ti * 65 + d0 + m] = z[m];
    }
    __syncthreads();
    {
        const int d = tid & 63, seg = tid >> 6; float v[8], run = 0.f;
#pragma unroll
        for (int i = 0; i < 8; ++i) { run += bl[(seg * 8 + i) * 65 + d]; v[i] = run; }
#pragma unroll
        for (int i = 0; i < 8; ++i) bl[(seg * 8 + i) * 65 + d] = v[i];
        __syncthreads();
        float off = 0.f;
#pragma unroll
        for (int sg = 0; sg < 7; ++sg) off += (sg < seg) ? bl[(sg * 8 + 7) * 65 + d] : 0.f;
        __syncthreads();
#pragma unroll
        for (int i = 0; i < 8; ++i) bl[(seg * 8 + i) * 65 + d] = v[i] + off;
    }
    __syncthreads();
}
__device__ __forceinline__ void gla_a_unit(const Params& P, int unit, LAS unsigned char* lds) {
    int tid_ = threadIdx.x; asm volatile("" : "+v"(tid_));
    const int tid = tid_, lane = tid & 63, wid = tid >> 6, c = unit >> 2, h = unit & 3;
    LAS float* bl = (LAS float*)lds; LAS float* ks = bl + 4160; LAS float* vs = ks + 4096;
    const f16* GK = (const f16*)(P.ws + WS_GK); const f16* GV = (const f16*)(P.ws + WS_GV);
    float* U = (float*)(P.ws + WS_US); float* DEC = (float*)(P.ws + WS_DECAY);
    const int ti = tid >> 3, d0 = (tid & 7) * 8, tt = 64 * c - 48 + ti; const bool tv = tt >= 0 && tt < L;
    half8 k8, v8[2];
#pragma unroll
    for (int m = 0; m < 8; ++m) { k8[m] = (f16)0.f; v8[0][m] = (f16)0.f; v8[1][m] = (f16)0.f; }
    if (tv) k8 = *(const half8*)(GK + (size_t)tt * 256 + 64 * h + d0);
#pragma unroll
    for (int q = 0; q < 2; ++q) { const int ch = tid + 512 * q, j = ch >> 4, t = 64 * c - 48 + j; if (t >= 0 && t < L) v8[q] = *(const half8*)(GV + (size_t)t * 512 + 128 * h + (ch & 15) * 8); }
    gla_gates(P, c, h, bl);
    { f32x4 o0, o1;
#pragma unroll
      for (int m = 0; m < 4; ++m) { o0[m] = (float)k8[m] * __expf(bl[63 * 65 + d0 + m] - bl[ti * 65 + d0 + m]); o1[m] = (float)k8[4 + m] * __expf(bl[63 * 65 + d0 + 4 + m] - bl[ti * 65 + d0 + 4 + m]); }
      *(LAS f32x4*)(ks + ti * 64 + d0) = o0; *(LAS f32x4*)(ks + ti * 64 + d0 + 4) = o1; }
#pragma unroll
    for (int q = 0; q < 2; ++q) { const int ch = tid + 512 * q, j = ch >> 4, e0 = (ch & 15) * 8; f32x4 o0, o1;
#pragma unroll
        for (int m = 0; m < 4; ++m) { o0[m] = (float)v8[q][m]; o1[m] = (float)v8[q][4 + m]; }
        *(LAS f32x4*)(vs + j * 128 + e0) = o0; *(LAS f32x4*)(vs + j * 128 + e0 + 4) = o1; }
    if (tid < 64) DEC[(size_t)c * 256 + h * 64 + tid] = __expf(bl[63 * 65 + tid]);
    __syncthreads();
    { const int dd0 = (wid >> 2) * 32, e0 = (wid & 3) * 32, l31 = lane & 31, hf = lane >> 5; f32x16 acc;
#pragma unroll
      for (int i = 0; i < 16; ++i) acc[i] = 0.f;
#pragma unroll 8
      for (int s = 0; s < 32; ++s) acc = __builtin_amdgcn_mfma_f32_32x32x2f32(ks[(2 * s + hf) * 64 + dd0 + l31], vs[(2 * s + hf) * 128 + e0 + l31], acc, 0, 0, 0);
      float* up = U + ((size_t)unit * 64) * 128;
#pragma unroll
      for (int r = 0; r < 16; ++r) { const int row = (r & 3) + 8 * (r >> 2) + 4 * hf; up[(size_t)(dd0 + row) * 128 + e0 + l31] = acc[r]; } }
    __syncthreads();
}
__device__ __forceinline__ void gla_scan(const Params& P) {
    float* U = (float*)(P.ws + WS_US); const float* DEC = (const float*)(P.ws + WS_DECAY);
    const int idx = blockIdx.x * NTHREADS + threadIdx.x;
    if (idx >= 32768) return;
    float s = 0.f;
#pragma unroll 8
    for (int c = 0; c < NCH - 1; ++c) { const float u = U[(size_t)c * 32768 + idx], dc = DEC[(size_t)c * 256 + (idx >> 7)]; U[(size_t)c * 32768 + idx] = s; s = dc * s + u; }
    U[(size_t)(NCH - 1) * 32768 + idx] = s;
}
__device__ __forceinline__ void gla_c_unit(const Params& P, int unit, LAS unsigned char* lds) {
    int tid_ = threadIdx.x; asm volatile("" : "+v"(tid_));
    const int tid = tid_, lane = tid & 63, wid = tid >> 6, c = unit >> 2, h = unit & 3, l31 = lane & 31, hf = lane >> 5;
    LAS float* bl = (LAS float*)lds; LAS float* kk = bl + 4160; LAS float* qs = kk + 4160; LAS float* As = qs + 4160; LAS float* vs = As + 4160; LAS float* Ss = vs + 8192; LAS float* os = bl;
    const f16* GQ = (const f16*)(P.ws + WS_GQ); const f16* GK = (const f16*)(P.ws + WS_GK); const f16* GV = (const f16*)(P.ws + WS_GV); const f16* GR = (const f16*)(P.ws + WS_GR);
    const float* Sg = (const float*)(P.ws + WS_US) + (size_t)unit * 8192; f16* mix = (f16*)(P.ws + WS_ACTA);
    const int ti = tid >> 3, d0 = (tid & 7) * 8, tt = 64 * c - 48 + ti; const bool tv = tt >= 0 && tt < L;
    half8 q8, k8, v8[2], r8[2]; f32x4 sreg[4];
#pragma unroll
    for (int m = 0; m < 8; ++m) { q8[m] = (f16)0.f; k8[m] = (f16)0.f; v8[0][m] = (f16)0.f; v8[1][m] = (f16)0.f; r8[0][m] = (f16)0.f; r8[1][m] = (f16)0.f; }
    if (tv) { q8 = *(const half8*)(GQ + (size_t)tt * 256 + 64 * h + d0); k8 = *(const half8*)(GK + (size_t)tt * 256 + 64 * h + d0);
        r8[0] = *(const half8*)(GR + (size_t)tt * 512 + 128 * h + (tid & 7) * 16); r8[1] = *(const half8*)(GR + (size_t)tt * 512 + 128 * h + (tid & 7) * 16 + 8); }
#pragma unroll
    for (int q = 0; q < 2; ++q) { const int ch = tid + 512 * q, j = ch >> 4, t = 64 * c - 48 + j; if (t >= 0 && t < L) v8[q] = *(const half8*)(GV + (size_t)t * 512 + 128 * h + (ch & 15) * 8); }
#pragma unroll
    for (int q = 0; q < 4; ++q) sreg[q] = *(const f32x4*)(Sg + (size_t)(tid + 512 * q) * 4);
    gla_gates(P, c, h, bl);
#pragma unroll
    for (int m = 0; m < 8; ++m) { const float bv = bl[ti * 65 + d0 + m]; qs[ti * 65 + d0 + m] = (float)q8[m] * 0.125f * __expf(bv); kk[ti * 65 + d0 + m] = (float)k8[m] * __expf(-bv); }
#pragma unroll
    for (int q = 0; q < 2; ++q) { const int ch = tid + 512 * q, j = ch >> 4, e0 = (ch & 15) * 8; f32x4 o0, o1;
#pragma unroll
        for (int m = 0; m < 4; ++m) { o0[m] = (float)v8[q][m]; o1[m] = (float)v8[q][4 + m]; }
        *(LAS f32x4*)(vs + j * 128 + e0) = o0; *(LAS f32x4*)(vs + j * 128 + e0 + 4) = o1; }
#pragma unroll
    for (int q = 0; q < 4; ++q) *(LAS f32x4*)(Ss + (tid + 512 * q) * 4) = sreg[q];
    __syncthreads();
    if (wid < 4) { const int i0 = (wid >> 1) * 32, j0 = (wid & 1) * 32; f32x16 acc;
#pragma unroll
        for (int i = 0; i < 16; ++i) acc[i] = 0.f;
#pragma unroll 8
        for (int s = 0; s < 32; ++s) acc = __builtin_amdgcn_mfma_f32_32x32x2f32(qs[(i0 + l31) * 65 + 2 * s + hf], kk[(j0 + l31) * 65 + 2 * s + hf], acc, 0, 0, 0);
#pragma unroll
        for (int r = 0; r < 16; ++r) { const int i = i0 + (r & 3) + 8 * (r >> 2) + 4 * hf, j = j0 + l31; As[i * 65 + j] = (j <= i) ? acc[r] : 0.f; } }
    __syncthreads();
    { const int i0 = (wid >> 2) * 32, e0 = (wid & 3) * 32; f32x16 acc;
#pragma unroll
      for (int i = 0; i < 16; ++i) acc[i] = 0.f;
#pragma unroll 8
      for (int s = 0; s < 32; ++s) acc = __builtin_amdgcn_mfma_f32_32x32x2f32(qs[(i0 + l31) * 65 + 2 * s + hf], Ss[(2 * s + hf) * 128 + e0 + l31], acc, 0, 0, 0);
#pragma unroll 8
      for (int s = 0; s < 32; ++s) acc = __builtin_amdgcn_mfma_f32_32x32x2f32(As[(i0 + l31) * 65 + 2 * s + hf], vs[(2 * s + hf) * 128 + e0 + l31], acc, 0, 0, 0);
#pragma unroll
      for (int r = 0; r < 16; ++r) { const int i = i0 + (r & 3) + 8 * (r >> 2) + 4 * hf; os[i * 129 + e0 + l31] = acc[r]; } }
    __syncthreads();
    { const int e0 = (tid & 7) * 16; float o[16], sq = 0.f;
#pragma unroll
      for (int j = 0; j < 16; ++j) { o[j] = os[ti * 129 + e0 + j]; sq += o[j] * o[j]; }
      sq += __shfl_xor(sq, 1); sq += __shfl_xor(sq, 2); sq += __shfl_xor(sq, 4);
      const float rs = rsqrtf(sq * (1.0f / 128.0f) + EPS);
      if (tt >= NMETA && tt < L) { half8 w0, w1;
#pragma unroll
          for (int j = 0; j < 8; ++j) { w0[j] = (f16)(o[j] * rs * P.hn[e0 + j] * silu_f((float)r8[0][j])); w1[j] = (f16)(o[8 + j] * rs * P.hn[e0 + 8 + j] * silu_f((float)r8[1][j])); }
          f16* dst = mix + (size_t)(tt - NMETA) * D + 128 * h + e0; *(half8*)dst = w0; *(half8*)(dst + 8) = w1; } }
    __syncthreads();
}

__device__ __forceinline__ unsigned mono_u(float f) { const unsigned u = __float_as_uint(f); return (u & 0x80000000u) ? ~u : (u | 0x80000000u); }
__device__ __forceinline__ float unmono_f(unsigned m) { return __uint_as_float((m & 0x80000000u) ? (m & 0x7fffffffu) : ~m); }
__device__ __forceinline__ unsigned wave_umax(unsigned v) {
    v = max(v, (unsigned)__builtin_amdgcn_update_dpp(0, (int)v, 0x111, 0xf, 0xf, false));
    v = max(v, (unsigned)__builtin_amdgcn_update_dpp(0, (int)v, 0x112, 0xf, 0xf, false));
    v = max(v, (unsigned)__builtin_amdgcn_update_dpp(0, (int)v, 0x114, 0xf, 0xf, false));
    v = max(v, (unsigned)__builtin_amdgcn_update_dpp(0, (int)v, 0x118, 0xf, 0xf, false));
    v = max(v, (unsigned)__builtin_amdgcn_update_dpp(0, (int)v, 0x142, 0xa, 0xf, false));
    v = max(v, (unsigned)__builtin_amdgcn_update_dpp(0, (int)v, 0x143, 0xc, 0xf, false));
    return (unsigned)__builtin_amdgcn_readlane((int)v, 63);
}
__device__ __forceinline__ int half_scan_incl(int v) {
    v += __builtin_amdgcn_update_dpp(0, v, 0x111, 0xf, 0xf, true);
    v += __builtin_amdgcn_update_dpp(0, v, 0x112, 0xf, 0xf, true);
    v += __builtin_amdgcn_update_dpp(0, v, 0x114, 0xf, 0xf, true);
    v += __builtin_amdgcn_update_dpp(0, v, 0x118, 0xf, 0xf, true);
    v += __builtin_amdgcn_update_dpp(0, v, 0x142, 0xa, 0xf, true);
    return v;
}
constexpr int CAP = 640, NPL = CAP / 64;
__device__ __forceinline__ int topk_compact(LAS float* cs, LAS unsigned short* ci, int n, bool exact, float& tau_out, int lane) {
    float sv[NPL]; unsigned iv[NPL], u[NPL];
#pragma unroll
    for (int i = 0; i < NPL; ++i) { const int p = lane + 64 * i; const bool v = p < n; sv[i] = v ? cs[p] : 0.f; iv[i] = v ? (unsigned)ci[p] : 0xffffu; u[i] = v ? mono_u(sv[i]) : 0u; }
    unsigned T = 0u; bool full = true; int hb = 31;
    {
        unsigned umx = 0u, umn = 0xffffffffu;
#pragma unroll
        for (int i = 0; i < NPL; ++i) { umx = max(umx, u[i]); umn = min(umn, (lane + 64 * i < n) ? u[i] : 0xffffffffu); }
        umx = wave_umax(umx); umn = ~wave_umax(~umn);
        const unsigned df = umx ^ umn;
        if (df == 0u) { hb = -1; T = umx; } else { hb = 31 - __clz(df); T = (hb == 31) ? 0u : (umx & ~((2u << hb) - 1u)); }
    }
#pragma unroll 1
    for (int bit = hb; bit >= 0; --bit) {
        const unsigned cand = T | (1u << bit); int cgt = 0;
#pragma unroll
        for (int i = 0; i < NPL; ++i) cgt += __popcll(__ballot(u[i] >= cand));
        if (cgt >= 256) { T = cand; if (cgt <= (exact ? 256 : 272)) { full = false; break; } }
    }
    bool keep[NPL];
    if (full) {
        int cgt = 0;
#pragma unroll
        for (int i = 0; i < NPL; ++i) cgt += __popcll(__ballot(u[i] > T));
        const int need = 256 - cgt; unsigned I = 0xffffu; int nties = 0;
#pragma unroll
        for (int i = 0; i < NPL; ++i) nties += __popcll(__ballot(u[i] == T));
        if (nties != need) { I = 0u;
#pragma unroll 1
        for (int bit = 15; bit >= 0; --bit) { const unsigned cand = I | (1u << bit); int cl = 0;
#pragma unroll
            for (int i = 0; i < NPL; ++i) cl += __popcll(__ballot(u[i] == T && iv[i] < cand));
            if (cl < need) I = cand; } }
#pragma unroll
        for (int i = 0; i < NPL; ++i) keep[i] = (u[i] > T) || (u[i] == T && iv[i] <= I);
    } else {
#pragma unroll
        for (int i = 0; i < NPL; ++i) keep[i] = u[i] >= T;
    }
    int nn = 0;
#pragma unroll
    for (int i = 0; i < NPL; ++i) { const unsigned long long m = __ballot(keep[i]); const int pre = __builtin_amdgcn_mbcnt_hi((unsigned)(m >> 32), __builtin_amdgcn_mbcnt_lo((unsigned)m, 0u));
        if (keep[i]) { cs[nn + pre] = sv[i]; ci[nn + pre] = (unsigned short)iv[i]; } nn += __popcll(m); }
    tau_out = unmono_f(T);
    return nn;
}
__device__ __forceinline__ float relu_asm(float x) { return __int_as_float(max(__float_as_int(x), 0)); }
__device__ __forceinline__ void indexer_tile(const Params& P, int tile, LAS unsigned char* lds) {
    int tid_ = threadIdx.x; asm volatile("" : "+v"(tid_));
    const int tid = tid_, lane = tid & 63, wid = __builtin_amdgcn_readfirstlane(tid >> 6), l31 = lane & 31, hf = lane >> 5;
    LAS float* candS = (LAS float*)lds;
    LAS unsigned short* candI = (LAS unsigned short*)(lds + 32 * CAP * 4);
    LAS unsigned char* kbuf = lds + 32 * CAP * 6;
    LAS int* lflag = (LAS int*)(lds + LDS_BYTES - 1024 + 192);
    const f16* IQ = (const f16*)(P.ws + WS_IQ); const f16* IK = (const f16*)(P.ws + WS_IK); const float* IW = (const float*)(P.ws + WS_IW);
    unsigned short* SEL = (unsigned short*)(P.ws + WS_SEL);
    const int t0 = tile * 32, tw = t0 + wid * 4;
    half8 afr[4];
    { const int qi = 2 * (l31 >> 4) + ((l31 >> 2) & 1), hd = 4 * ((l31 >> 3) & 1) + (l31 & 3); int tq = tw + qi; if (tq > L - 1) tq = L - 1;
      const half8* ap = (const half8*)(IQ + (size_t)tq * 512 + hd * 64);
#pragma unroll
      for (int s = 0; s < 4; ++s) afr[s] = ap[2 * s + hf]; }
    float w0[8], w1[8];
    { int ta = tw + hf, tb = tw + 2 + hf; if (ta > L - 1) ta = L - 1; if (tb > L - 1) tb = L - 1;
#pragma unroll
      for (int h = 0; h < 8; ++h) { w0[h] = IW[(size_t)ta * 8 + h]; w1[h] = IW[(size_t)tb * 8 + h]; } }
    asm volatile("" :: "v"(afr[0]), "v"(afr[1]), "v"(afr[2]), "v"(afr[3]));
    asm volatile("" :: "v"(w0[0]), "v"(w0[1]), "v"(w0[2]), "v"(w0[3]), "v"(w0[4]), "v"(w0[5]), "v"(w0[6]), "v"(w0[7]));
    asm volatile("" :: "v"(w1[0]), "v"(w1[1]), "v"(w1[2]), "v"(w1[3]), "v"(w1[4]), "v"(w1[5]), "v"(w1[6]), "v"(w1[7]));
    const int tq0 = (tw + hf < L) ? tw + hf : -1, tq1 = (tw + 2 + hf < L) ? tw + 2 + hf : -1;
    float tau0 = -__builtin_inff(), tau1 = -__builtin_inff();
    int cq0 = 0, cq1 = 0, cq2 = 0, cq3 = 0;
    if (tid < 3) lflag[tid] = 0;
    const int nkeys = (t0 + 32 < L) ? t0 + 32 : L, nst = (nkeys + 127) >> 7;
    u32x4 stg[2];
    const u32x4* IKv = (const u32x4*)IK;
#pragma unroll
    for (int i = 0; i < 2; ++i) stg[i] = IKv[(size_t)0 * 1024 + tid + 512 * i];
#pragma unroll
    for (int i = 0; i < 2; ++i) { const int ci = tid + 512 * i, row = ci >> 3, ch = ci & 7; *(LAS u32x4*)(kbuf + row * 128 + ((ch ^ ((row >> 1) & 7)) << 4)) = stg[i]; }
    __syncthreads();
#pragma unroll 1
    for (int st = 0; st < nst; ++st) {
        LAS unsigned char* kb = kbuf + (st & 1) * 16384;
        if (st + 1 < nst) {
#pragma unroll
            for (int i = 0; i < 2; ++i) stg[i] = IKv[(size_t)(st + 1) * 1024 + tid + 512 * i];
        }
        if (st * 128 <= tw + 3) {
            f32x16 acc[4];
#pragma unroll
            for (int c = 0; c < 4; ++c) {
#pragma unroll
                for (int i = 0; i < 16; ++i) acc[c][i] = 0.f;
            }
#pragma unroll
            for (int s = 0; s < 4; ++s) {
#pragma unroll
                for (int c = 0; c < 4; ++c) { const int row = c * 32 + l31; const half8 bf = *(const LAS half8*)(kb + row * 128 + (((2 * s + hf) ^ ((row >> 1) & 7)) << 4)); acc[c] = __builtin_amdgcn_mfma_f32_32x32x16_f16(afr[s], bf, acc[c], 0, 0, 0); }
            }
            float sc[8]; bool ok[8]; int na = 0, nb = 0;
#pragma unroll
            for (int c = 0; c < 4; ++c) {
                float s0 = 0.f, s1 = 0.f;
#pragma unroll
                for (int h = 0; h < 8; ++h) { const float r0 = relu_asm(acc[c][h]), r1 = relu_asm(acc[c][8 + h]);
                    asm("v_fmac_f32 %0, %1, %2" : "+v"(s0) : "v"(w0[h]), "v"(r0)); asm("v_fmac_f32 %0, %1, %2" : "+v"(s1) : "v"(w1[h]), "v"(r1)); }
                const int key = st * 128 + c * 32 + l31;
                sc[2 * c] = s0; sc[2 * c + 1] = s1; ok[2 * c] = key <= tq0 && s0 > tau0; ok[2 * c + 1] = key <= tq1 && s1 > tau1;
                na += ok[2 * c] ? 1 : 0; nb += ok[2 * c + 1] ? 1 : 0;
            }
            const int ia = half_scan_incl(na), ib = half_scan_incl(nb);
            const int ta0 = __builtin_amdgcn_readlane(ia, 31), ta1 = __builtin_amdgcn_readlane(ia, 63), tb0 = __builtin_amdgcn_readlane(ib, 31), tb1 = __builtin_amdgcn_readlane(ib, 63);
            int pa = (hf ? cq1 : cq0) + ia - na, pb = (hf ? cq3 : cq2) + ib - nb;
            cq0 += ta0; cq1 += ta1; cq2 += tb0; cq3 += tb1;
            pa += (wid * 4 + hf) * CAP; pb += (wid * 4 + 2 + hf) * CAP;
            const int dmy = 32 * CAP * 6 / 4 + 2 * 16384 / 4 + 64 + lane;
#pragma unroll
            for (int c = 0; c < 4; ++c) {
                const unsigned short key = (unsigned short)(st * 128 + c * 32 + l31);
                { const bool k0 = ok[2 * c]; LAS float* ps = k0 ? candS + pa : candS + dmy; LAS unsigned short* pi = k0 ? candI + pa : (LAS unsigned short*)(candS + dmy + 64); *ps = sc[2 * c]; *pi = key; pa += k0 ? 1 : 0; }
                { const bool k1 = ok[2 * c + 1]; LAS float* ps = k1 ? candS + pb : candS + dmy; LAS unsigned short* pi = k1 ? candI + pb : (LAS unsigned short*)(candS + dmy + 64); *ps = sc[2 * c + 1]; *pi = key; pb += k1 ? 1 : 0; }
            }
        }
        if (st + 1 < nst) {
            LAS unsigned char* kn = kbuf + ((st + 1) & 1) * 16384;
#pragma unroll
            for (int i = 0; i < 2; ++i) { const int ci = tid + 512 * i, row = ci >> 3, ch = ci & 7; *(LAS u32x4*)(kn + row * 128 + ((ch ^ ((row >> 1) & 7)) << 4)) = stg[i]; }
        }
        const int mx = max(max(cq0, cq1), max(cq2, cq3));
        if (mx > CAP - 128 && lane == 0) lflag[st % 3] = 1;
        if (tid == 0) lflag[(st + 1) % 3] = 0;
        __syncthreads();
        const int any = lflag[st % 3];
        if (any) {
#pragma unroll 1
            for (int qq = 0; qq < 4; ++qq) { const int n = qq == 0 ? cq0 : (qq == 1 ? cq1 : (qq == 2 ? cq2 : cq3));
                if (n > 288) { float nt; const int nn = topk_compact(candS + (wid * 4 + qq) * CAP, candI + (wid * 4 + qq) * CAP, n, false, nt, lane);
                    if (qq == 0) cq0 = nn; else if (qq == 1) cq1 = nn; else if (qq == 2) cq2 = nn; else cq3 = nn;
                    if (hf == (qq & 1)) { if (qq < 2) tau0 = nt; else tau1 = nt; } } }
        }
    }
#pragma unroll 1
    for (int qq = 0; qq < 4; ++qq) {
        const int t = tw + qq; if (t >= L) break;
        int n = qq == 0 ? cq0 : (qq == 1 ? cq1 : (qq == 2 ? cq2 : cq3)); LAS float* cs = candS + (wid * 4 + qq) * CAP; LAS unsigned short* ci = candI + (wid * 4 + qq) * CAP;
        if (n > 256) { float nt; n = topk_compact(cs, ci, n, true, nt, lane); }
#pragma unroll
        for (int j = 0; j < 4; ++j) { const int p = lane + 64 * j; SEL[(size_t)t * 256 + (p & 15) * 16 + (p >> 4)] = p < n ? ci[p] : (unsigned short)0xffffu; }
    }
    __syncthreads();
}

__device__ __forceinline__ void sparse_attn(const Params& P, LAS unsigned char* lds, int vbid) {
    int tid_ = threadIdx.x; asm volatile("" : "+v"(tid_));
    const int tid = tid_, lane = tid & 63, wid = tid >> 6, grp = lane >> 2, c4 = lane & 3;
    const int head = vbid & 7, slot = (vbid >> 3) * 8 + wid, nslot = (gridDim.x >> 3) * 8;
    typedef _Float16 half2v __attribute__((ext_vector_type(2)));
    LAS float* red = (LAS float*)(lds + 4096 + wid * 4352);
    const unsigned short* SEL = (const unsigned short*)(P.ws + WS_SEL);
    const unsigned char* Q8 = P.ws + WS_DQ + head * 64 + c4 * 16; const float* QS = (const float*)(P.ws + WS_DQ + (size_t)LP * 512) + head;
    const unsigned char* kvh = P.ws + WS_KV + (size_t)head * LP * 128; f16* mix = (f16*)(P.ws + WS_ACTA);
    int t = NMETA + slot;
    u32x4 sela = {0u, 0u, 0u, 0u}, selb = {0u, 0u, 0u, 0u}, q8 = {0u, 0u, 0u, 0u}; float lscale = 0.f;
    if (t < L) { sela = *(const u32x4*)(SEL + (size_t)t * 256 + grp * 16); selb = *(const u32x4*)(SEL + (size_t)t * 256 + grp * 16 + 8); q8 = *(const u32x4*)(Q8 + (size_t)t * 512); lscale = QS[(size_t)t * 8]; }
#define ATTN_ITEM(ALLV) do { \
        unsigned keys[16]; u32x4 kreg[16], vreg[16]; \
        _Pragma("unroll") for (int it = 0; it < 16; ++it) { const unsigned w = it < 8 ? sela[it >> 1] : selb[(it - 8) >> 1]; keys[it] = (it & 1) ? (w >> 16) : (w & 0xffffu); } \
        _Pragma("unroll") for (int it = 0; it < 16; ++it) { const unsigned kk = (ALLV || keys[it] != 0xffffu) ? keys[it] : 0u; kreg[it] = *(const u32x4*)(kvh + (size_t)kk * 128 + c4 * 16); } \
        _Pragma("unroll") for (int it = 0; it < 16; ++it) { const unsigned kk = (ALLV || keys[it] != 0xffffu) ? keys[it] : 0u; vreg[it] = *(const u32x4*)(kvh + (size_t)kk * 128 + 64 + c4 * 16); } \
        const u32x4 qc = q8; const float ls = lscale; \
        { const int tn = t + nslot;     \
          if (tn < L) { sela = *(const u32x4*)(SEL + (size_t)tn * 256 + grp * 16); selb = *(const u32x4*)(SEL + (size_t)tn * 256 + grp * 16 + 8); q8 = *(const u32x4*)(Q8 + (size_t)tn * 512); lscale = QS[(size_t)tn * 8]; } } \
        float lg[16]; float mx = -__builtin_inff(); \
        _Pragma("unroll") for (int it = 0; it < 16; ++it) { \
            int ai = 0; \
            _Pragma("unroll") for (int w = 0; w < 4; ++w) ai = __builtin_amdgcn_sdot4((int)kreg[it][w], (int)qc[w], ai, false); \
            ai += __builtin_amdgcn_update_dpp(0, ai, 0xB1, 0xf, 0xf, true);     \
            ai += __builtin_amdgcn_update_dpp(0, ai, 0x4E, 0xf, 0xf, true);     \
            lg[it] = (ALLV || keys[it] != 0xffffu) ? (float)ai * ls : -__builtin_inff(); mx = fmaxf(mx, lg[it]); } \
        mx = fmaxf(mx, __shfl_xor(mx, 4)); mx = fmaxf(mx, __shfl_xor(mx, 8)); mx = fmaxf(mx, __shfl_xor(mx, 16)); mx = fmaxf(mx, __shfl_xor(mx, 32)); \
        half2v o2[8]; float lsum = 0.f; \
        _Pragma("unroll") for (int e = 0; e < 8; ++e) o2[e] = (half2v){(f16)0.f, (f16)0.f}; \
        _Pragma("unroll") for (int it = 0; it < 16; ++it) { \
            const float p = __expf(lg[it] - mx); lsum += p; const f16 ph = (f16)p; const half2v p2 = {ph, ph}; \
            _Pragma("unroll") for (int w = 0; w < 4; ++w) {     \
                const half2v v01 = __builtin_bit_cast(half2v, __builtin_amdgcn_perm(0u, vreg[it][w], 0x010c000cu)), v23 = __builtin_bit_cast(half2v, __builtin_amdgcn_perm(0u, vreg[it][w], 0x030c020cu)); \
                o2[2 * w] = p2 * v01 + o2[2 * w]; o2[2 * w + 1] = p2 * v23 + o2[2 * w + 1]; } } \
        lsum += __shfl_xor(lsum, 4); lsum += __shfl_xor(lsum, 8); lsum += __shfl_xor(lsum, 16); lsum += __shfl_xor(lsum, 32); \
          \
        _Pragma("unroll") for (int e = 0; e < 8; ++e) { red[lane * 17 + 2 * e] = (float)o2[e][0]; red[lane * 17 + 2 * e + 1] = (float)o2[e][1]; } \
        float acc = 0.f; \
        { const int cc = lane >> 4, e = lane & 15; \
          _Pragma("unroll") for (int g = 0; g < 16; ++g) acc += red[(g * 4 + cc) * 17 + e]; } \
        mix[(size_t)(t - NMETA) * D + 512 + head * 64 + lane] = (f16)(acc * __builtin_amdgcn_rcpf(lsum)); \
    } while (0)
#pragma unroll 1
    for (; t < L; t += nslot) {
        if (t >= 255) ATTN_ITEM(true);
        else ATTN_ITEM(false);
    }
#undef ATTN_ITEM
    __syncthreads();
}

__device__ __forceinline__ void final_norm(const Params& P) {
    const int tid = threadIdx.x, lane = tid & 63, gw = blockIdx.x * 8 + (tid >> 6), nw = gridDim.x * 8;
    const float* ss3 = (const float*)(P.ws + WS_SS3); const f16* h3 = (const f16*)(P.ws + WS_ACTA);
    for (int r = gw; r < SEQ; r += nw) { const float rs = row_rstd(ss3, 16, r);
#pragma unroll
        for (int i = 0; i < 2; ++i) { const int k = lane * 8 + 512 * i; const half8 v = *(const half8*)(h3 + (size_t)r * D + k); const f32x4 g0 = *(const f32x4*)(P.nf + k), g1 = *(const f32x4*)(P.nf + k + 4); f32x4 o0, o1;
#pragma unroll
            for (int j = 0; j < 4; ++j) { o0[j] = (float)v[j] * rs * g0[j]; o1[j] = (float)v[4 + j] * rs * g1[j]; }
            *(f32x4*)(P.out + (size_t)r * D + k) = o0; *(f32x4*)(P.out + (size_t)r * D + k + 4) = o1; } }
}

#define XB_TMO      128
#define XB_XCNT(j)  (256  + 64 * (j))
#define XB_XSUB(j)  (1280 + 64 * (j))
#define XB_XGEN(j)  (2304 + 64 * (j))
#define XB_TOP      3328
#define XB_TOPGEN   3392
#define XCD_BAR_WORDS 3456
#define XB_SPIN_CAP (1u << 22)
__device__ __forceinline__ unsigned xb_ld(unsigned* p)              { return __hip_atomic_load(p, __ATOMIC_RELAXED, __HIP_MEMORY_SCOPE_AGENT); }
__device__ __forceinline__ unsigned xb_add(unsigned* p, unsigned v) { return __hip_atomic_fetch_add(p, v, __ATOMIC_RELAXED, __HIP_MEMORY_SCOPE_AGENT); }
__device__ __forceinline__ unsigned xb_xcc_id() { return (unsigned)__builtin_amdgcn_s_getreg((3 << 11) | 20) & 0xFu; }
#define XB_SPIN(cond, bar) do { unsigned _sp = 0; while (cond) { __builtin_amdgcn_s_sleep(1); \
    if ((++_sp & 255u) == 0u) { if (xb_ld(&(bar)[XB_TMO])) break; if (_sp > XB_SPIN_CAP) { atomicAdd(&(bar)[XB_TMO], 1u); break; } } } } while (0)
struct XcdBarrier { unsigned* bar; unsigned x; volatile LAS unsigned* st; };
__device__ __forceinline__ XcdBarrier xcd_barrier_post(unsigned* bar, volatile LAS unsigned* st) {
    XcdBarrier b; b.bar = bar; b.x = xb_xcc_id(); b.st = st;
    if (threadIdx.x == 0) (void)xb_add(&bar[XB_XCNT(b.x)], 1u);
    return b;
}
__device__ __forceinline__ void xcd_barrier_complete(unsigned* bar, unsigned x, unsigned& nloc, unsigned& nx) {
    const unsigned G = gridDim.x * gridDim.y * gridDim.z;
    unsigned sum, cnt, mine, sp = 0u;
    for (;;) {
        sum = 0u; cnt = 0u; mine = 0u;
#pragma unroll
        for (unsigned j = 0; j < 16; ++j) { const unsigned c = xb_ld(&bar[XB_XCNT(j)]); sum += c; cnt += (c > 0u) ? 1u : 0u; mine = (j == x) ? c : mine; }
        if (sum == G) break;
        __builtin_amdgcn_s_sleep(1);
        if ((++sp & 255u) == 0u) { if (xb_ld(&bar[XB_TMO])) break; if (sp > XB_SPIN_CAP) { atomicAdd(&bar[XB_TMO], 1u); break; } }
    }
    nloc = mine > 0u ? mine : 1u; nx = cnt > 0u ? cnt : 1u;
}
__device__ __forceinline__ void xcd_barrier(const XcdBarrier& b) {
    asm volatile("s_waitcnt vmcnt(0)" ::: "memory");
    __syncthreads();
    if (threadIdx.x == 0) {
        unsigned* bar = b.bar;
        __builtin_amdgcn_s_waitcnt(0);
        unsigned nloc = b.st[0], nx = b.st[1];
        if (nloc == 0u) { xcd_barrier_complete(bar, b.x, nloc, nx); b.st[0] = nloc; b.st[1] = nx; }
        const unsigned old = xb_add(&bar[XB_XSUB(b.x)], 1u);
        const unsigned gen = old / nloc;
        if (old + 1u == (gen + 1u) * nloc) {
            __builtin_amdgcn_fence(__ATOMIC_RELEASE, "agent");
            asm volatile("s_waitcnt vmcnt(0)" ::: "memory");
            const unsigned og = xb_add(&bar[XB_TOP], 1u);
            const unsigned tg = og / nx;
            if (og + 1u == (tg + 1u) * nx) xb_add(&bar[XB_TOPGEN], 1u);
            else XB_SPIN(xb_ld(&bar[XB_TOPGEN]) == tg, bar);
            __builtin_amdgcn_fence(__ATOMIC_ACQUIRE, "agent");
            xb_add(&bar[XB_XGEN(b.x)], 1u);
            asm volatile("s_waitcnt vmcnt(0)" ::: "memory");
        } else {
            XB_SPIN(xb_ld(&bar[XB_XGEN(b.x)]) == gen, bar);
            __builtin_amdgcn_fence(__ATOMIC_ACQUIRE, "agent");
            asm volatile("s_waitcnt vmcnt(0)" ::: "memory");
        }
    }
    __syncthreads();
}

__global__ void __launch_bounds__(NTHREADS, 2) fwd_kernel(Params P) {
    __shared__ __attribute__((aligned(16))) unsigned char lds_raw[LDS_BYTES];
    LAS unsigned char* lds = (LAS unsigned char*)lds_raw;
    const int tid = threadIdx.x, bid = blockIdx.x, G = gridDim.x;
    unsigned char* ws = P.ws;
    const int lo = P.ph_lo, hi = P.ph_hi;
#ifndef ONLY_PHASE
#define ONLY_PHASE -1
#endif
#define IN(k) ((ONLY_PHASE < 0 || ONLY_PHASE == (k)) && lo <= (k) && (k) < hi)
#define SEAM(k) do { if (IN(k) && IN((k) + 1)) { xcd_barrier(xbar); } } while (0)
    XcdBarrier xbar; xbar.bar = (unsigned*)(ws + WS_BAR); xbar.x = 0; xbar.st = (volatile LAS unsigned*)(lds + LDS_BYTES - 1024 + 16);
    if (hi - lo > 1) {
        if (tid == 0) { xbar.st[0] = 0u; xbar.st[1] = 0u; }
        __syncthreads();
        xbar = xcd_barrier_post((unsigned*)(ws + WS_BAR), (volatile LAS unsigned*)(lds + LDS_BYTES - 1024 + 16));
    }
    LAS int* misc = (LAS int*)(lds + LDS_BYTES - 1024);
    if (hi - lo > 1) {
        if (tid == 0) { const unsigned xcc = xb_xcc_id() & 7u; misc[8] = (int)xcc; misc[9] = (int)xb_add((unsigned*)(ws + WS_CTL) + 32 + 32 * xcc, 1u); }
    }
    int vbid = bid;
    f16* acta = (f16*)(ws + WS_ACTA); f16* Gb = (f16*)(ws + WS_G);
    float* ss1 = (float*)(ws + WS_SS1); float* ss3 = (float*)(ws + WS_SS3);
    if (IN(0)) { p0_prologue(P, lds); }
    SEAM(0);
    if (hi - lo > 1 && (G & 7) == 0) {
        if (tid == 0) { bool ok = true; for (int j = 0; j < 8; ++j) ok = ok && (xb_ld((unsigned*)(ws + WS_CTL) + 32 + 32 * j) == (unsigned)(G >> 3)); misc[10] = ok ? misc[9] * 8 + misc[8] : bid; }
        __syncthreads();
        vbid = __builtin_amdgcn_readfirstlane(misc[10]);
        __syncthreads();
    }
    if (IN(1)) {
        pg8::Gemm g{(const f16*)(ws + WS_US), (const f16*)(ws + WS_WGU1), MP, 2 * DFF, D / 2}; pg8::StaticOrder S; S.init(MP, 2 * DFF, G, vbid);
        EpiSwiglu<true> E{Gb, nullptr, 1, (const float*)(ws + WS_IQ), (const float*)(ws + WS_WGU1 + (size_t)2 * DFF * D)}; pg8::gemm_phase(lds, g, S, E);
    }
    SEAM(1);
    if (IN(2)) {
        meta_down(P, lds);
        pg8::Gemm g{Gb, (const f16*)(ws + WS_WD1), SEQ, D, DFF}; pg8::StaticOrder S; S.init(SEQ, D, G, vbid);
        EpiResid<true> E{acta, (f16*)P.out, ss1, 0.5f}; pg8::gemm_phase(lds, g, S, E);
    }
    SEAM(2);
    if (IN(3)) {
        pg8::Gemm g{(const f16*)P.out, (const f16*)(ws + WS_WIN), MP, NIN, D}; pg8::StaticOrder S; S.init(MP, NIN, G, vbid);
        EpiInProj E{ss1, (const f32x2*)(ws + WS_ROPE), ws};
        pg8::gemm_phase(lds, g, S, E);
    }
    SEAM(3);
    if (IN(4)) {
        for (int u = bid; u < (NCH - 1) * 4; u += G) gla_a_unit(P, u, lds);
        {
            constexpr int NI8 = 2 * DFF / 64; LAS f16* tl = (LAS f16*)lds;
            if (G > NI8 + 64) {
                if (bid >= G - NI8) prep_weight_i8(P, 4, 2 * DFF, ws + WS_WGU2, (float*)(ws + WS_WGU2 + (size_t)2 * DFF * D), bid - (G - NI8), NI8, lds);
                else { int tbase = 0, cursor = bid;
                    prep_weight(P, 3, D, D, (f16*)(ws + WS_WOUT), cursor, tbase, tl, G - NI8);
                    prep_weight(P, 5, D, DFF, (f16*)(ws + WS_WD2), cursor, tbase, tl, G - NI8); }
            } else { int tbase = 0, cursor = bid;
                prep_weight(P, 3, D, D, (f16*)(ws + WS_WOUT), cursor, tbase, tl, G);
                prep_weight(P, 5, D, DFF, (f16*)(ws + WS_WD2), cursor, tbase, tl, G);
                __syncthreads();
                prep_weight_i8(P, 4, 2 * DFF, ws + WS_WGU2, (float*)(ws + WS_WGU2 + (size_t)2 * DFF * D), bid, G, lds); }
        }
    }
    SEAM(4);
    if (IN(5)) {
        if (bid < 64) gla_scan(P);
        unsigned* ctr = (unsigned*)(ws + WS_CTL); LAS int* bc = (LAS int*)(lds + LDS_BYTES - 1024);
        for (;;) {
            if (tid == 0) bc[0] = (int)atomicAdd(ctr, 1u);
            __syncthreads();
            const int k = bc[0];
            __syncthreads();
            if (k >= 513) break;
            indexer_tile(P, 512 - k, lds);
        }
    }
    SEAM(5);
    if (IN(6)) { for (int u = 4 + bid; u < NCH * 4; u += G) gla_c_unit(P, u, lds); sparse_attn(P, lds, vbid); }
    SEAM(6);
    if (IN(7)) {
        pg8::Gemm g{acta, (const f16*)(ws + WS_WOUT), SEQ, D, D}; pg8::StaticOrder S; S.init(SEQ, D, G, vbid);
        EpiResid<true, false> E{P.out, (f16*)(ws + WS_US), nullptr, 1.0f}; pg8::gemm_phase(lds, g, S, E);
    }
    SEAM(7);
    if (IN(8)) quant_rows_i8((const f16*)(ws + WS_US), ws + WS_DQ, (float*)(ws + WS_IQ), SEQ);
    SEAM(8);
    if (IN(9)) {
        pg8::Gemm g{(const f16*)(ws + WS_DQ), (const f16*)(ws + WS_WGU2), SEQ, 2 * DFF, D / 2}; pg8::StaticOrder S; S.init(SEQ, 2 * DFF, G, vbid);
        EpiSwiglu<true> E{Gb, nullptr, 16, (const float*)(ws + WS_IQ), (const float*)(ws + WS_WGU2 + (size_t)2 * DFF * D)}; pg8::gemm_phase(lds, g, S, E);
    }
    SEAM(9);
    if (IN(10)) {
        pg8::Gemm g{Gb, (const f16*)(ws + WS_WD2), SEQ, D, DFF}; pg8::StaticOrder S; S.init(SEQ, D, G, vbid);
        EpiResid<true> E{ws + WS_US, acta, ss3, 0.5f}; pg8::gemm_phase(lds, g, S, E);
    }
    SEAM(10);
    if (IN(11)) final_norm(P);
#undef IN
#undef SEAM
}

extern "C" void kernel_launch(void* const* d_in, const int* in_sizes, int n_in, void* d_out, int out_size, void* d_ws, size_t ws_size, hipStream_t stream) {
    static int grid = 0;
    if (grid == 0) {
        if (n_in != 17 || in_sizes[0] != SEQ * D || out_size != SEQ * D || ws_size < WS_END) { fprintf(stderr, "kernel_launch: unexpected shapes (n_in %d, in0 %d, out %d, ws %zu, need %zu)\n", n_in, n_in > 0 ? in_sizes[0] : -1, out_size, ws_size, (size_t)WS_END); grid = -1; return; }
        int dev = 0, cus = 0, per_cu = 0;
        (void)hipGetDevice(&dev); (void)hipDeviceGetAttribute(&cus, hipDeviceAttributeMultiprocessorCount, dev);
        if (hipOccupancyMaxActiveBlocksPerMultiprocessor(&per_cu, (const void*)fwd_kernel, NTHREADS, 0) != hipSuccess || per_cu < 1) { fprintf(stderr, "kernel_launch: occupancy query says %d blocks per CU\n", per_cu); per_cu = 1; }
        (void)hipGetLastError();
        grid = cus;
        if (grid % 8 != 0 || grid < 64) { fprintf(stderr, "kernel_launch: unexpected CU count %d\n", cus); }
    }
    if (grid < 0) return;
    if (hipMemsetAsync((char*)d_ws + WS_CTL, 0, CTL_BYTES, stream) != hipSuccess) { fprintf(stderr, "kernel_launch: memset failed\n"); return; }
    Params p{};
    const float** pp = (const float**)&p;
    for (int i = 0; i < 17; ++i) pp[i] = (const float*)d_in[i];
    p.out = (float*)d_out; p.ws = (unsigned char*)d_ws;
#if MODE == 0
    for (int ph = 0; ph < NPHASE; ++ph) { p.ph_lo = ph; p.ph_hi = ph + 1; hipLaunchKernelGGL(fwd_kernel, dim3(grid), dim3(NTHREADS), 0, stream, p); }
#else
    p.ph_lo = 0; p.ph_hi = NPHASE;
    void* args[] = {&p};
    hipError_t e = hipLaunchCooperativeKernel((const void*)fwd_kernel, dim3(grid), dim3(NTHREADS), args, 0, stream);
    if (e != hipSuccess) fprintf(stderr, "cooperative launch failed: %s (grid %d)\n", hipGetErrorString(e), grid);
#endif
}
```

```cpp
#include <hip/hip_runtime.h>
#include <cstdio>
#include <cstdint>

#ifndef MODE
#define MODE 1
#endif

#define LAS __attribute__((address_space(3)))
typedef _Float16 f16;
typedef _Float16 half8 __attribute__((ext_vector_type(8)));
typedef _Float16 half4 __attribute__((ext_vector_type(4)));
typedef float f32x2 __attribute__((ext_vector_type(2)));
typedef float f32x4 __attribute__((ext_vector_type(4)));
typedef float f32x16 __attribute__((ext_vector_type(16)));
typedef unsigned u32x2 __attribute__((ext_vector_type(2)));
typedef unsigned u32x4 __attribute__((ext_vector_type(4)));
typedef int i32x4 __attribute__((ext_vector_type(4)));

constexpr int D = 1024, SEQ = 16384, NMETA = 16, L = SEQ + NMETA, DFF = 2816;
constexpr int MP = 16640;
constexpr int LP = 16512;
constexpr int NIN = 3840;
constexpr int NCH = 257;
constexpr float EPS = 1e-6f;
constexpr int NTHREADS = 512;
constexpr int LDS_BYTES = 155648 + 1024;
constexpr int NPHASE = 12;

constexpr size_t al256(size_t x) { return (x + 255) & ~(size_t)255; }
constexpr size_t WS_CTL = 0;
constexpr size_t CTL_BYTES = 32768;
constexpr size_t WS_BAR = 2048;
constexpr size_t WS_WGU1 = CTL_BYTES;
constexpr size_t WS_WD1 = WS_WGU1 + (size_t)2 * DFF * D * 2;
constexpr size_t WS_WIN = WS_WD1 + (size_t)D * DFF * 2;
constexpr size_t WS_WOUT = WS_WIN + (size_t)NIN * D * 2;
constexpr size_t WS_WGU2 = WS_WOUT + (size_t)D * D * 2;
constexpr size_t WS_WD2 = WS_WGU2 + (size_t)2 * DFF * D * 2;
constexpr size_t WS_ACTA = WS_WD2 + (size_t)D * DFF * 2;
constexpr size_t WS_G = WS_ACTA + (size_t)MP * D * 2;
constexpr size_t WS_US = WS_G + (size_t)MP * DFF * 2;
constexpr size_t WS_DQ = WS_US + (size_t)NCH * 4 * 64 * 128 * 4;
constexpr size_t WS_IQ = WS_DQ + (size_t)LP * 512 * 2;
constexpr size_t WS_SEL = WS_IQ + (size_t)LP * 512 * 2;
constexpr size_t WS_ROPE = WS_SEL + (size_t)LP * 256 * 2;
constexpr size_t WS_IW = WS_ROPE + al256((size_t)L * 32 * 8);
constexpr size_t WS_GA = WS_IW + (size_t)LP * 8 * 4;
constexpr size_t WS_DECAY = WS_GA + (size_t)LP * 16 * 4;
constexpr size_t WS_SS0 = WS_DECAY + al256((size_t)NCH * 256 * 4);
constexpr size_t WS_SS1 = WS_SS0 + (size_t)MP * 4;
constexpr size_t WS_SS2 = WS_SS1 + (size_t)MP * 64;
constexpr size_t WS_SS3 = WS_SS2 + (size_t)MP * 64;
constexpr size_t WS_END = WS_SS3 + (size_t)MP * 64;
constexpr size_t WS_KV = WS_G;
constexpr size_t WS_GQ = WS_KV + (size_t)8 * LP * 128 * 2;
constexpr size_t WS_GK = WS_GQ + (size_t)LP * 256 * 2;
constexpr size_t WS_GV = WS_GK + (size_t)LP * 256 * 2;
constexpr size_t WS_GR = WS_GV + (size_t)LP * 512 * 2;
constexpr size_t WS_IK = WS_GR + (size_t)LP * 512 * 2;
constexpr size_t WS_ALIAS_END = WS_IK + (size_t)LP * 64 * 2;
static_assert(WS_ALIAS_END <= WS_US, "aliased buffers exceed G");
static_assert(WS_END <= (size_t)256 * 1024 * 1024, "workspace exceeds 256 MiB");
static_assert((size_t)SEQ * D * 2 <= (size_t)NCH * 4 * 64 * 128 * 4, "h2_16 alias");

struct Params {
    const float* x; const float* meta; const float* n1; const float* wg1; const float* wu1; const float* wd1;
    const float* nmix; const float* win; const float* wa2; const float* ba; const float* hn; const float* wout;
    const float* n2; const float* wg2; const float* wu2; const float* wd2; const float* nf;
    float* out; unsigned char* ws; int ph_lo, ph_hi;
};

namespace pg8 {
constexpr int BM = 256, BK = 64, HALF = 128, HTB = HALF * BK * 2, STAGE_BYTES = 8 * HTB, NXCD = 8, WGM = 8;
__host__ __device__ __forceinline__ int lds_byte(int r, int c) { const int st = (r >> 4) * 2 + (c >> 5), rr = r & 15, cc = c & 31, ob = rr * 64 + cc * 2; return st * 1024 + (ob ^ (((ob >> 9) & 1) << 5)); }
__host__ __device__ __forceinline__ int perm32(int rho) { const int n = rho >> 4, i = rho & 15; return 8 * (i >> 2) + 4 * n + (i & 3); }
__host__ __device__ __forceinline__ void stage_rc(int b, int& R, int& C) { const int st = b / 1024, sb = b % 1024, swz = sb ^ (((sb >> 9) & 1) << 5); R = (st >> 1) * 16 + swz / 64; C = (st & 1) * 32 + (swz % 64) / 2; }
struct Unit { int pm, pn; };
struct Gemm { const f16* A; const f16* Bt; int M, N, K; };
struct StaticOrder {
    int nM, nN, nwg, G, c;
    __host__ __device__ void init(int M, int N, int G_, int c_) { nM = M / BM; nN = N / BM; nwg = nM * nN; G = G_; c = c_; }
    __host__ __device__ bool next(int i, Unit& u) const {
        const long Lx = (long)i * G + c; if (Lx >= nwg) return false;
        int wgid = (int)Lx; { const int q = nwg / NXCD, r = nwg % NXCD, xcd = wgid % NXCD, off = wgid / NXCD; wgid = (xcd < r ? xcd * (q + 1) : r * (q + 1) + (xcd - r) * q) + off; }
        const int nig = WGM * nN, gid = wgid / nig, fm = gid * WGM, gsz = (nM - fm) < WGM ? (nM - fm) : WGM;
        u.pm = fm + ((wgid % nig) % gsz); u.pn = (wgid % nig) / gsz; return true;
    }
};
template <class Epi>
__device__ __forceinline__ void gemm_phase(LAS unsigned char* lds, const Gemm g, const StaticOrder& S, const Epi& E) {
    int tid_ = threadIdx.x; asm volatile("" : "+v"(tid_));
    const int tid = tid_, wid = __builtin_amdgcn_readfirstlane(tid >> 6), lane = tid & 63, wr = wid >> 2, wc = wid & 3, fr = lane & 15, fq = lane >> 4;
    const int K = g.K, nt = K / BK;
    unsigned voffA[2], voffB[2];
#pragma unroll
    for (int i = 0; i < 2; ++i) { int R, C; stage_rc(tid * 16 + i * 8192, R, C); const int Rb = (R & ~31) + perm32(R & 31); voffA[i] = (unsigned)(R * K + C) * 2u; voffB[i] = (unsigned)(Rb * K + C) * 2u; }
    const size_t kstep = (size_t)(BK * 2);
    const size_t hstep = (size_t)HALF * K * 2;
    const size_t tstep = 2 * hstep;
    const unsigned ldsw = (unsigned)wid * 1024u;
    const int aoff = lds_byte(wr * 64 + fr, fq * 8), boff = lds_byte(wc * 32 + fr, fq * 8);
#define PG8_SA(b, h) (((b) * 2 + (h)) * HTB)
#define PG8_SB(b, h) ((4 + (b) * 2 + (h)) * HTB)
#define PG8_STAGE(bufoff, gbase, voff) do { _Pragma("unroll") for (int _i = 0; _i < 2; ++_i) \
        __builtin_amdgcn_global_load_lds((const unsigned*)((const char*)(gbase) + (voff)[_i]), (LAS unsigned*)(lds + (bufoff) + ldsw + _i * 8192), 16, 0, 0); } while (0)
#define PG8_LDA(dst, b, h) do { _Pragma("unroll") for (int m = 0; m < 4; ++m) _Pragma("unroll") for (int k = 0; k < 2; ++k) dst[m][k] = *(const LAS half8*)(lds + PG8_SA(b, h) + aoff + m * 2048 + k * 1024); } while (0)
#define PG8_LDB(dst, b, h) do { _Pragma("unroll") for (int n = 0; n < 2; ++n) _Pragma("unroll") for (int k = 0; k < 2; ++k) dst[n][k] = *(const LAS half8*)(lds + PG8_SB(b, h) + boff + n * 2048 + k * 1024); } while (0)
#define PG8_MMA(ai, bj, At, Bt) do { __builtin_amdgcn_s_setprio(1); _Pragma("unroll") for (int m = 0; m < 4; ++m) _Pragma("unroll") for (int n = 0; n < 2; ++n) _Pragma("unroll") for (int k = 0; k < 2; ++k) { \
        if constexpr (Epi::I8) acc[ai][bj][m][n] = __builtin_bit_cast(f32x4, __builtin_amdgcn_mfma_i32_16x16x64_i8(__builtin_bit_cast(i32x4, Bt[n][k]), __builtin_bit_cast(i32x4, At[m][k]), __builtin_bit_cast(i32x4, acc[ai][bj][m][n]), 0, 0, 0)); \
        else acc[ai][bj][m][n] = __builtin_amdgcn_mfma_f32_16x16x32_f16(Bt[n][k], At[m][k], acc[ai][bj][m][n], 0, 0, 0); } __builtin_amdgcn_s_setprio(0); } while (0)
#define PG8_WAIT_V(n) asm volatile("s_waitcnt vmcnt(" #n ")" ::: "memory")
#define PG8_WAIT_L(n) asm volatile("s_waitcnt lgkmcnt(" #n ")" ::: "memory")
#define PG8_BAR __builtin_amdgcn_s_barrier()
#define PG8_SCHED __builtin_amdgcn_sched_barrier(0)
    Unit cur, nxt; int ui = 0;
    if (!S.next(0, cur)) return;
    LAS float* rowbuf = (LAS float*)(lds + 8 * HTB);
    if constexpr (Epi::ROWF) {
        Unit uu;
#pragma unroll 1
        for (int j = 0; j < 16 && S.next(j, uu); ++j) { if (tid < 256) rowbuf[j * 256 + tid] = E.rowf(uu.pm * 256 + tid); }
        __syncthreads();
    }
    f32x4 acc[2][2][4][2];
#pragma unroll
    for (int a = 0; a < 2; ++a)
#pragma unroll
        for (int b = 0; b < 2; ++b)
#pragma unroll
            for (int m = 0; m < 4; ++m)
#pragma unroll
                for (int n = 0; n < 2; ++n) acc[a][b][m][n] = (f32x4){0.f, 0.f, 0.f, 0.f};
    half8 At[4][2], B0[2][2], B1[2][2];
    const char* cA = (const char*)g.A + (size_t)cur.pm * tstep; const char* cB = (const char*)g.Bt + (size_t)cur.pn * tstep;
    PG8_STAGE(PG8_SB(0, 0), cB, voffB); PG8_STAGE(PG8_SA(0, 0), cA, voffA); PG8_STAGE(PG8_SB(0, 1), cB + hstep, voffB); PG8_STAGE(PG8_SA(0, 1), cA + hstep, voffA);
    if (wr == 1) PG8_BAR;
    PG8_WAIT_V(4); PG8_BAR;
    PG8_STAGE(PG8_SB(1, 0), cB + kstep, voffB); PG8_STAGE(PG8_SA(1, 0), cA + kstep, voffA); PG8_STAGE(PG8_SB(1, 1), cB + hstep + kstep, voffB);
    PG8_WAIT_V(6); PG8_BAR;
    for (;;) {
        const bool has_next = S.next(ui + 1, nxt);
        const char* nA = has_next ? (const char*)g.A + (size_t)nxt.pm * tstep : cA; const char* nB = has_next ? (const char*)g.Bt + (size_t)nxt.pn * tstep : cB;
        for (int t = 0; t < nt; t += 2) {
            const bool last = (t == nt - 2);
            const char* a1 = cA + (size_t)(t + 1) * kstep;
            const char* a2 = last ? nA : cA + (size_t)(t + 2) * kstep; const char* b2 = last ? nB : cB + (size_t)(t + 2) * kstep;
            const char* a3 = a2 + kstep; const char* b3 = b2 + kstep;
            PG8_LDB(B0, 0, 0); PG8_SCHED; PG8_LDA(At, 0, 0); PG8_STAGE(PG8_SA(1, 1), a1 + hstep, voffA);
            PG8_WAIT_L(8); PG8_BAR; PG8_WAIT_L(0); PG8_MMA(0, 0, At, B0); PG8_BAR; PG8_SCHED;
            PG8_LDB(B1, 0, 1); PG8_STAGE(PG8_SB(0, 0), b2, voffB);
            PG8_BAR; PG8_WAIT_L(0); PG8_MMA(0, 1, At, B1); PG8_BAR;
            PG8_LDA(At, 0, 1); PG8_STAGE(PG8_SA(0, 0), a2, voffA);
            PG8_BAR; PG8_WAIT_L(0); PG8_MMA(1, 0, At, B0); PG8_BAR; PG8_SCHED;
            PG8_STAGE(PG8_SB(0, 1), b2 + hstep, voffB);
            PG8_WAIT_V(6); PG8_BAR; PG8_MMA(1, 1, At, B1); PG8_BAR;
            PG8_LDB(B0, 1, 0); PG8_SCHED; PG8_LDA(At, 1, 0); PG8_STAGE(PG8_SA(0, 1), a2 + hstep, voffA);
            PG8_WAIT_L(8); PG8_BAR; PG8_WAIT_L(0); PG8_MMA(0, 0, At, B0); PG8_BAR; PG8_SCHED;
            PG8_LDB(B1, 1, 1); PG8_STAGE(PG8_SB(1, 0), b3, voffB);
            PG8_BAR; PG8_WAIT_L(0); PG8_MMA(0, 1, At, B1); PG8_BAR;
            PG8_LDA(At, 1, 1); PG8_STAGE(PG8_SA(1, 0), a3, voffA);
            PG8_BAR; PG8_WAIT_L(0); PG8_MMA(1, 0, At, B0); PG8_BAR; PG8_SCHED;
            PG8_STAGE(PG8_SB(1, 1), b3 + hstep, voffB);
            PG8_WAIT_V(6); PG8_BAR; PG8_MMA(1, 1, At, B1); PG8_BAR;
        }
        if constexpr (Epi::I8) {
#pragma unroll
            for (int a = 0; a < 2; ++a)
#pragma unroll
                for (int b = 0; b < 2; ++b)
#pragma unroll
                    for (int m = 0; m < 4; ++m)
#pragma unroll
                        for (int n = 0; n < 2; ++n) { const i32x4 v = __builtin_bit_cast(i32x4, acc[a][b][m][n]); acc[a][b][m][n] = (f32x4){(float)v[0], (float)v[1], (float)v[2], (float)v[3]}; }
        }
        E(acc, cur, wr, wc, fr, fq, rowbuf + ui * 256);
        if (!has_next) break;
#pragma unroll
        for (int a = 0; a < 2; ++a)
#pragma unroll
            for (int b = 0; b < 2; ++b)
#pragma unroll
                for (int m = 0; m < 4; ++m)
#pragma unroll
                    for (int n = 0; n < 2; ++n) acc[a][b][m][n] = (f32x4){0.f, 0.f, 0.f, 0.f};
        cur = nxt; cA = nA; cB = nB; ++ui;
    }
    PG8_WAIT_V(0);
    if (wr == 0) PG8_BAR;
    PG8_BAR;
#undef PG8_SA
#undef PG8_SB
#undef PG8_STAGE
#undef PG8_LDA
#undef PG8_LDB
#undef PG8_MMA
#undef PG8_WAIT_V
#undef PG8_WAIT_L
#undef PG8_BAR
#undef PG8_SCHED
}
}

__device__ __forceinline__ float silu_f(float v) { return v * __builtin_amdgcn_rcpf(1.0f + __expf(-v)); }
__device__ __forceinline__ half4 to_half4(f32x4 v) { half4 h; h[0] = (f16)v[0]; h[1] = (f16)v[1]; h[2] = (f16)v[2]; h[3] = (f16)v[3]; return h; }

__device__ __forceinline__ float row_rstd(const float* ss, int np, int row) {
    float s;
    if (np == 1) s = ss[row];
    else { const f32x4* p = (const f32x4*)(ss + (size_t)row * 16); const f32x4 a = p[0], b = p[1], c = p[2], d = p[3];
        s = (((a[0] + a[1]) + (a[2] + a[3])) + ((b[0] + b[1]) + (b[2] + b[3]))) + (((c[0] + c[1]) + (c[2] + c[3])) + ((d[0] + d[1]) + (d[2] + d[3]))); }
    return rsqrtf(s * (1.0f / D) + EPS);
}
template <bool I8_> struct EpiSwiglu {
    static constexpr bool I8 = I8_, ROWF = I8_;
    __device__ __forceinline__ float rowf(int row) const { return sa[row]; }
    f16* G; const float* ss; int np; const float* sa; const float* sw;
    __device__ __forceinline__ void operator()(const f32x4 (&acc)[2][2][4][2], const pg8::Unit& u, int wr, int wc, int fr_, int fq_, const LAS float* rf) const {
        int fr = fr_, fq = fq_; asm volatile("" : "+v"(fr), "+v"(fq));
        f32x4 swg[2], swu[2];
        if constexpr (I8) {
#pragma unroll
            for (int n = 0; n < 2; ++n) { swg[n] = *(const f32x4*)(sw + u.pn * 256 + wc * 32 + 8 * fq + 4 * n); swu[n] = *(const f32x4*)(sw + u.pn * 256 + 128 + wc * 32 + 8 * fq + 4 * n); }
        }
#pragma unroll
        for (int ai = 0; ai < 2; ++ai)
#pragma unroll
            for (int m = 0; m < 4; ++m) {
                const int row = u.pm * 256 + ai * 128 + wr * 64 + m * 16 + fr;
                float rs; if constexpr (I8) rs = rf[row - u.pm * 256]; else rs = row_rstd(ss, np, row);
                const float ce = -1.4426950408889634f * rs, rs2 = rs * rs; half8 o;
#pragma unroll
                for (int n = 0; n < 2; ++n) {
                    f32x4 g = acc[ai][0][m][n], u = acc[ai][1][m][n];
                    if constexpr (I8) { g = g * swg[n]; u = u * swu[n]; }
                    const f32x4 t = g * ce; f32x4 e, r;
#pragma unroll
                    for (int j = 0; j < 4; ++j) e[j] = __builtin_amdgcn_exp2f(t[j]);
                    const f32x4 d = e + 1.0f;
#pragma unroll
                    for (int j = 0; j < 4; ++j) r[j] = __builtin_amdgcn_rcpf(d[j]);
                    const f32x4 w = (g * u) * (r * rs2);
#pragma unroll
                    for (int j = 0; j < 4; ++j) o[4 * n + j] = (f16)w[j];
                }
                *(half8*)(G + (size_t)row * DFF + u.pn * 128 + wc * 32 + 8 * fq) = o;
            }
    }
};
template <bool SRC16, bool STATS = true> struct EpiResid {
    static constexpr bool I8 = false, ROWF = false;
    const void* src; f16* h16; float* ss; float alpha;
    __device__ __forceinline__ void operator()(const f32x4 (&acc)[2][2][4][2], const pg8::Unit& u, int wr, int wc, int fr_, int fq_, const LAS float* rf) const {
        int fr = fr_, fq = fq_; asm volatile("" : "+v"(fr), "+v"(fq));
#pragma unroll
        for (int ai = 0; ai < 2; ++ai)
#pragma unroll
            for (int m = 0; m < 4; ++m) {
                const int row = u.pm * 256 + ai * 128 + wr * 64 + m * 16 + fr; float part = 0.f;
#pragma unroll
                for (int bj = 0; bj < 2; ++bj) {
                    const size_t off = (size_t)row * D + u.pn * 256 + bj * 128 + wc * 32 + 8 * fq; half8 h; f32x4 sv[2];
                    if (SRC16) { const half8 s8 = *(const half8*)((const f16*)src + off);
#pragma unroll
                        for (int j = 0; j < 4; ++j) { sv[0][j] = (float)s8[j]; sv[1][j] = (float)s8[4 + j]; } }
                    else { sv[0] = *(const f32x4*)((const float*)src + off); sv[1] = *(const f32x4*)((const float*)src + off + 4); }
#pragma unroll
                    for (int n = 0; n < 2; ++n) {
                        const f32x4 o = sv[n] + alpha * acc[ai][bj][m][n];
#pragma unroll
                        for (int j = 0; j < 4; ++j) h[4 * n + j] = (f16)o[j];
                        if (STATS) part += (o[0] * o[0] + o[1] * o[1]) + (o[2] * o[2] + o[3] * o[3]);
                    }
                    *(half8*)(h16 + off) = h;
                }
                if (STATS) { part += __shfl_xor(part, 16); part += __shfl_xor(part, 32);
                    if (fq == 0) ss[(size_t)row * 16 + u.pn * 4 + wc] = part; }
            }
    }
};
constexpr float K_I8_SCALE = 127.0f / 8.0f;
__device__ __forceinline__ void rope8(const f32x4 (&x1)[2], const f32x4 (&x2)[2], const f32x2* rp, float sc, float (&o1)[8], float (&o2)[8]) {
#pragma unroll
    for (int n = 0; n < 2; ++n) {
        const f32x4 cs0 = *(const f32x4*)(rp + 4 * n), cs1 = *(const f32x4*)(rp + 4 * n + 2);
        o1[4 * n + 0] = (x1[n][0] * cs0[0] - x2[n][0] * cs0[1]) * sc; o2[4 * n + 0] = (x2[n][0] * cs0[0] + x1[n][0] * cs0[1]) * sc;
        o1[4 * n + 1] = (x1[n][1] * cs0[2] - x2[n][1] * cs0[3]) * sc; o2[4 * n + 1] = (x2[n][1] * cs0[2] + x1[n][1] * cs0[3]) * sc;
        o1[4 * n + 2] = (x1[n][2] * cs1[0] - x2[n][2] * cs1[1]) * sc; o2[4 * n + 2] = (x2[n][2] * cs1[0] + x1[n][2] * cs1[1]) * sc;
        o1[4 * n + 3] = (x1[n][3] * cs1[2] - x2[n][3] * cs1[3]) * sc; o2[4 * n + 3] = (x2[n][3] * cs1[2] + x1[n][3] * cs1[3]) * sc;
    }
}
__device__ __forceinline__ u32x2 pack_i8x8(const float (&v)[8]) {
    u32x2 r;
#pragma unroll
    for (int w = 0; w < 2; ++w) { unsigned word = 0u;
#pragma unroll
        for (int j = 0; j < 4; ++j) { const int q = (int)__builtin_rintf(fminf(fmaxf(v[4 * w + j] * K_I8_SCALE, -127.f), 127.f)); word |= ((unsigned)q & 0xffu) << (8 * j); }
        r[w] = word; }
    return r;
}
__device__ __forceinline__ u32x2 pack_bf8x8(const float (&v)[8]) {
    u32x2 r;
#pragma unroll
    for (int w = 0; w < 2; ++w) { int word = __builtin_amdgcn_cvt_pk_bf8_f32(v[4 * w], v[4 * w + 1], 0, false); word = __builtin_amdgcn_cvt_pk_bf8_f32(v[4 * w + 2], v[4 * w + 3], word, true); r[w] = (unsigned)word; }
    return r;
}
struct EpiInProj {
    static constexpr bool I8 = false, ROWF = false;
    const float* ss; const f32x2* rope; unsigned char* ws;
    __device__ __forceinline__ void operator()(const f32x4 (&acc)[2][2][4][2], const pg8::Unit& u, int wr, int wc, int fr_, int fq_, const LAS float* rf) const {
        int fr = fr_, fq = fq_; asm volatile("" : "+v"(fr), "+v"(fq));
        const int pn = u.pn;
        if (pn >= 8 && pn <= 11) {
            unsigned char* lb = (pn <= 9) ? ws + WS_KV + (size_t)((pn - 8) * 4 + wc) * LP * 128 + 8 * fq
                                          : ws + WS_KV + (size_t)((pn - 10) * 4 + (wc >> 1)) * LP * 128 + 64 + (wc & 1) * 32 + 8 * fq;
#pragma unroll
            for (int ai = 0; ai < 2; ++ai)
#pragma unroll
                for (int m = 0; m < 4; ++m) {
                    const int p = u.pm * 256 + ai * 128 + wr * 64 + m * 16 + fr;
                    const int t = p < SEQ ? p + NMETA : p - SEQ;
                    if (p < L) {
                        const float sc = row_rstd(ss, 16, p);
                        if (pn <= 9) {
                            float o1[8], o2[8]; rope8(acc[ai][0][m], acc[ai][1][m], rope + (size_t)t * 32 + 8 * fq, sc, o1, o2);
                            unsigned char* d8 = lb + (size_t)t * 128; *(u32x2*)d8 = pack_i8x8(o1); *(u32x2*)(d8 + 32) = pack_i8x8(o2);
                        } else {
#pragma unroll
                            for (int bj = 0; bj < 2; ++bj) { float v[8];
#pragma unroll
                                for (int j = 0; j < 4; ++j) { v[j] = acc[ai][bj][m][0][j] * sc; v[4 + j] = acc[ai][bj][m][1][j] * sc; }
                                *(u32x2*)(lb + (size_t)t * 128 + (size_t)bj * 2 * LP * 128) = pack_bf8x8(v); }
                        }
                    }
                    asm volatile("" ::: "memory");
                }
            return;
        }
        int mode = 0, stride = 256; float scale = 1.0f; f16* lanebase;
        if (pn == 0) lanebase = (f16*)(ws + WS_GQ) + wc * 32 + 8 * fq;
        else if (pn == 1) lanebase = (f16*)(ws + WS_GK) + wc * 32 + 8 * fq;
        else if (pn <= 3) { lanebase = (f16*)(ws + WS_GV) + (pn - 2) * 256 + wc * 32 + 8 * fq; stride = 512; }
        else if (pn <= 5) { lanebase = (f16*)(ws + WS_GR) + (pn - 4) * 256 + wc * 32 + 8 * fq; stride = 512; }
        else if (pn <= 7) { lanebase = (f16*)(ws + WS_DQ); mode = 6; scale = 0.125f; }
        else if (pn <= 13) { lanebase = (f16*)(ws + WS_IQ) + (pn - 12) * 256 + wc * 64 + 8 * fq; stride = 512; mode = 1; scale = 0.125f; }
        else { lanebase = (f16*)(ws + WS_IK) + 8 * fq; stride = 64; mode = wc == 0 ? 1 : (wc == 1 ? 2 : 3); }
#pragma unroll
        for (int ai = 0; ai < 2; ++ai)
#pragma unroll
            for (int m = 0; m < 4; ++m) {
                const int p = u.pm * 256 + ai * 128 + wr * 64 + m * 16 + fr;
                const int t = p < SEQ ? p + NMETA : p - SEQ;
                if (p < L && mode != 3) {
                    const float rs = row_rstd(ss, 16, p);
                    if (mode == 6) {
                        float o1[8], o2[8]; rope8(acc[ai][0][m], acc[ai][1][m], rope + (size_t)t * 32 + 8 * fq, rs * scale, o1, o2);
                        float qm = 1e-20f;
#pragma unroll
                        for (int j = 0; j < 8; ++j) qm = fmaxf(qm, fmaxf(fabsf(o1[j]), fabsf(o2[j])));
                        qm = fmaxf(qm, __shfl_xor(qm, 16)); qm = fmaxf(qm, __shfl_xor(qm, 32));
                        const float qsc = 127.0f * __builtin_amdgcn_rcpf(qm); u32x2 w1, w2;
#pragma unroll
                        for (int w = 0; w < 2; ++w) { unsigned a = 0u, b = 0u;
#pragma unroll
                            for (int j = 0; j < 4; ++j) { a |= ((unsigned)(int)__builtin_rintf(o1[4 * w + j] * qsc) & 0xffu) << (8 * j); b |= ((unsigned)(int)__builtin_rintf(o2[4 * w + j] * qsc) & 0xffu) << (8 * j); }
                            w1[w] = a; w2[w] = b; }
                        const int head = (pn - 6) * 4 + wc; unsigned char* qrow = ws + WS_DQ + (size_t)t * 512 + head * 64 + 8 * fq;
                        *(u32x2*)qrow = w1; *(u32x2*)(qrow + 32) = w2;
                        if (fq == 0) ((float*)(ws + WS_DQ + (size_t)LP * 512))[(size_t)t * 8 + head] = qm * (1.0f / (127.0f * K_I8_SCALE));
                    } else if (mode == 1) {
                        float o1[8], o2[8]; rope8(acc[ai][0][m], acc[ai][1][m], rope + (size_t)t * 32 + 8 * fq, rs * scale, o1, o2);
                        half8 h1, h2;
#pragma unroll
                        for (int j = 0; j < 8; ++j) { h1[j] = (f16)o1[j]; h2[j] = (f16)o2[j]; }
                        f16* dst = lanebase + (size_t)t * stride; *(half8*)dst = h1; *(half8*)(dst + 32) = h2;
                    } else if (mode == 2) {
                        if (fq < 2) { float* gp = (float*)(ws + WS_GA) + (size_t)t * 16 + 8 * fq; *(f32x4*)gp = acc[ai][0][m][0] * rs; *(f32x4*)(gp + 4) = acc[ai][0][m][1] * rs; }
                        else if (fq == 2) { float* ip = (float*)(ws + WS_IW) + (size_t)t * 8; const float r2 = rs * 0.35355339059327373f; *(f32x4*)ip = acc[ai][0][m][0] * r2; *(f32x4*)(ip + 4) = acc[ai][0][m][1] * r2; }
                    } else {
#pragma unroll
                        for (int bj = 0; bj < 2; ++bj) { half8 h;
#pragma unroll
                            for (int j = 0; j < 4; ++j) { h[j] = (f16)(acc[ai][bj][m][0][j] * rs); h[4 + j] = (f16)(acc[ai][bj][m][1][j] * rs); }
                            *(half8*)(lanebase + (size_t)t * stride + bj * 128) = h; }
                    }
                }
                asm volatile("" ::: "memory");
            }
    }
};

__device__ __forceinline__ const float* w_src(const Params& P, int kind, int n, int& ld, const float*& gain) {
    switch (kind) {
    case 0: case 4: { const int pn = n >> 8, bj = (n >> 7) & 1, cc = n & 127; ld = DFF; gain = kind == 0 ? P.n1 : P.n2;
        const float* w = kind == 0 ? (bj ? P.wu1 : P.wg1) : (bj ? P.wu2 : P.wg2); return w + pn * 128 + cc; }
    case 1: ld = D; gain = nullptr; return P.wd1 + n;
    case 5: ld = D; gain = nullptr; return P.wd2 + n;
    case 3: ld = D; gain = nullptr; return P.wout + n;
    default: { ld = 3672; gain = P.nmix; const int pn = n >> 8, c = n & 255, bj = c >> 7, hh = (c >> 5) & 3, dd = c & 31; int j;
        if (pn == 0) j = c; else if (pn == 1) j = 256 + c; else if (pn <= 3) j = 512 + (pn - 2) * 256 + c; else if (pn <= 5) j = 1024 + (pn - 4) * 256 + c;
        else if (pn <= 7) j = 1552 + (pn - 6) * 256 + hh * 64 + bj * 32 + dd;
        else if (pn <= 9) j = 2064 + (pn - 8) * 256 + hh * 64 + bj * 32 + dd;
        else if (pn <= 11) j = 2576 + (pn - 10) * 256 + c;
        else if (pn <= 13) j = 3088 + (pn - 12) * 256 + hh * 64 + bj * 32 + dd;
        else { if (c < 32) j = 3600 + c; else if (c < 48) j = 1536 + (c - 32); else if (c < 56) j = 3664 + (c - 48); else if (c >= 128 && c < 160) j = 3600 + 32 + (c - 128); else j = -1; }
        return j < 0 ? nullptr : P.win + j; }
    }
}
__device__ __forceinline__ void prep_weight(const Params& P, const int kind, const int N, const int K, f16* dst, int& cursor, int& tbase, LAS f16* tl, const int G) {
    const int tid = threadIdx.x, tn = N / 64, tk = K / 256, ntile = tn * tk;
    const int n = tid & 63, kk0 = tid >> 6;
    float v[32], vn[32];
#define PREP_LOAD(dstv, tI) do { const int n0_ = ((tI) % tn) * 64, k0_ = ((tI) / tn) * 256; int ld; const float* gain; const float* col = w_src(P, kind, n0_ + n, ld, gain); \
        _Pragma("unroll") for (int i = 0; i < 32; ++i) dstv[i] = col ? col[(size_t)(k0_ + kk0 + 8 * i) * ld] : 0.f; \
        if (gain) { _Pragma("unroll") for (int i = 0; i < 32; ++i) dstv[i] *= gain[k0_ + kk0 + 8 * i]; } } while (0)
    if (cursor < tbase + ntile) PREP_LOAD(v, cursor - tbase);
#pragma unroll 1
    for (; cursor < tbase + ntile; cursor += G) {
        const int tI = cursor - tbase, n0 = (tI % tn) * 64, k0 = (tI / tn) * 256;
        const bool more = cursor + G < tbase + ntile;
        if (more) PREP_LOAD(vn, tI + G);
#pragma unroll
        for (int i = 0; i < 32; ++i) tl[n * 264 + kk0 + 8 * i] = (f16)v[i];
        __syncthreads();
        { const int nr = tid >> 3, seg = tid & 7;
#pragma unroll
          for (int j = 0; j < 4; ++j) *(half8*)(dst + (size_t)(n0 + nr) * K + k0 + (seg + 8 * j) * 8) = *(const LAS half8*)(tl + nr * 264 + (seg + 8 * j) * 8); }
        __syncthreads();
        if (more) {
#pragma unroll
            for (int i = 0; i < 32; ++i) v[i] = vn[i];
        }
    }
#undef PREP_LOAD
    tbase += ntile;
}
__device__ __forceinline__ void prep_weight_i8(const Params& P, const int kind, const int N, unsigned char* dst, float* sw, int first, int step, LAS unsigned char* lds) {
    const int tid = threadIdx.x, n = tid & 63, kk0 = tid >> 6;
    LAS float* pmax = (LAS float*)lds; LAS unsigned* img = (LAS unsigned*)(lds + 2048);
#pragma unroll 1
    for (int task = first; task < N / 64; task += step) {
        const int n0 = task * 64; int ld; const float* gain; const float* col = w_src(P, kind, n0 + n, ld, gain);
        float v[128]; float mx = 0.f;
#pragma unroll
        for (int i = 0; i < 128; ++i) v[i] = col ? col[(size_t)(kk0 * 128 + i) * ld] : 0.f;
        if (gain) {
#pragma unroll
            for (int i = 0; i < 128; ++i) v[i] *= gain[kk0 * 128 + i];
        }
#pragma unroll
        for (int i = 0; i < 128; ++i) mx = fmaxf(mx, fabsf(v[i]));
        pmax[kk0 * 64 + n] = mx;
        __syncthreads();
#pragma unroll
        for (int q = 0; q < 8; ++q) mx = fmaxf(mx, pmax[q * 64 + n]);
        const float sc = mx > 0.f ? 127.0f / mx : 0.f;
        if (kk0 == 0) sw[n0 + n] = mx * (1.0f / 127.0f);
#pragma unroll
        for (int w = 0; w < 32; ++w) { unsigned word = 0u;
#pragma unroll
            for (int j = 0; j < 4; ++j) word |= ((unsigned)(int)__builtin_rintf(v[4 * w + j] * sc) & 0xffu) << (8 * j);
            img[n * 260 + kk0 * 32 + w] = word; }
        __syncthreads();
        { const int nr = tid >> 3, seg = tid & 7;
#pragma unroll
          for (int j = 0; j < 8; ++j) *(u32x4*)(dst + (size_t)(n0 + nr) * D + (seg + 8 * j) * 16) = *(const LAS u32x4*)(img + nr * 260 + (seg + 8 * j) * 4); }
        __syncthreads();
    }
}
__device__ __forceinline__ void quant_rows_i8(const f16* src, unsigned char* dst, float* sa, int rows) {
    const int tid = threadIdx.x, lane = tid & 63, gw = blockIdx.x * 8 + (tid >> 6), nw = gridDim.x * 8;
    for (int r = gw; r < rows; r += nw) {
        const half8 a = *(const half8*)(src + (size_t)r * D + lane * 16), b = *(const half8*)(src + (size_t)r * D + lane * 16 + 8);
        float v[16], mx = 0.f, sq = 0.f;
#pragma unroll
        for (int j = 0; j < 8; ++j) { v[j] = (float)a[j]; v[8 + j] = (float)b[j]; }
#pragma unroll
        for (int j = 0; j < 16; ++j) { mx = fmaxf(mx, fabsf(v[j])); sq = __builtin_fmaf(v[j], v[j], sq); }
#pragma unroll
        for (int o = 32; o >= 1; o >>= 1) { mx = fmaxf(mx, __shfl_xor(mx, o)); sq += __shfl_xor(sq, o); }
        const float sc = mx > 0.f ? 127.0f / mx : 0.f; u32x4 w;
#pragma unroll
        for (int q = 0; q < 4; ++q) { unsigned word = 0u;
#pragma unroll
            for (int j = 0; j < 4; ++j) word |= ((unsigned)(int)__builtin_rintf(v[4 * q + j] * sc) & 0xffu) << (8 * j);
            w[q] = word; }
        *(u32x4*)(dst + (size_t)r * D + lane * 16) = w;
        if (lane == 0) sa[r] = mx * (1.0f / 127.0f) * rsqrtf(sq * (1.0f / D) + EPS);
    }
}
__device__ __forceinline__ void p0_prologue(const Params& P, LAS unsigned char* lds) {
    const int tid = threadIdx.x, bid = blockIdx.x, G = gridDim.x, lane = tid & 63;
    unsigned char* ws = P.ws;
    LAS f16* tl = (LAS f16*)lds;
    {
        constexpr int NI8 = 2 * DFF / 64; const int nI = G > 2 * NI8 ? NI8 : 0;
        if (bid >= G - nI || nI == 0) prep_weight_i8(P, 0, 2 * DFF, ws + WS_WGU1, (float*)(ws + WS_WGU1 + (size_t)2 * DFF * D), nI ? bid - (G - nI) : bid, nI ? nI : G, lds);
        if (bid < G - nI) { int tbase = 0, cursor = bid; __syncthreads();
            prep_weight(P, 1, D, DFF, (f16*)(ws + WS_WD1), cursor, tbase, tl, G - nI);
            prep_weight(P, 2, NIN, D, (f16*)(ws + WS_WIN), cursor, tbase, tl, G - nI); }
    }
    f16* acta = (f16*)(ws + WS_ACTA);
    const int gw = bid * 8 + (tid >> 6), nw = G * 8;
    unsigned char* x8 = ws + WS_US; float* sa0 = (float*)(ws + WS_IQ);
    for (int p = gw; p < L; p += nw) {
        const float* src = p < SEQ ? P.x + (size_t)p * D : P.meta + (size_t)(p - SEQ) * D; float s = 0.f, mx = 0.f; f32x4 v[4];
#pragma unroll
        for (int i = 0; i < 4; ++i) { v[i] = *(const f32x4*)(src + lane * 4 + 256 * i); s += (v[i][0] * v[i][0] + v[i][1] * v[i][1]) + (v[i][2] * v[i][2] + v[i][3] * v[i][3]);
            mx = fmaxf(fmaxf(mx, fmaxf(fabsf(v[i][0]), fabsf(v[i][1]))), fmaxf(fabsf(v[i][2]), fabsf(v[i][3]))); *(half4*)(acta + (size_t)p * D + lane * 4 + 256 * i) = to_half4(v[i]); }
#pragma unroll
        for (int o = 32; o >= 1; o >>= 1) { s += __shfl_xor(s, o); mx = fmaxf(mx, __shfl_xor(mx, o)); }
        const float sc = mx > 0.f ? 127.0f / mx : 0.f;
#pragma unroll
        for (int i = 0; i < 4; ++i) { unsigned word = 0u;
#pragma unroll
            for (int j = 0; j < 4; ++j) word |= ((unsigned)(int)__builtin_rintf(v[i][j] * sc) & 0xffu) << (8 * j);
            *(unsigned*)(x8 + (size_t)p * D + lane * 4 + 256 * i) = word; }
        if (lane == 0) sa0[p] = mx * (1.0f / 127.0f) * rsqrtf(s * (1.0f / D) + EPS);
    }
    const int gt = bid * NTHREADS + tid, ngt = G * NTHREADS;
    for (int i = gt; i < MP; i += ngt) { if (i >= L) sa0[i] = 0.f; }
    f32x2* rope = (f32x2*)(ws + WS_ROPE);
    for (int i = gt; i < L * 32; i += ngt) { const int t = i >> 5, f = i & 31; const double inv = exp(-(double)f * (9.210340371976184 / 32.0)); double sn, cs; sincos((double)t * inv, &sn, &cs); rope[i] = (f32x2){(float)cs, (float)sn}; }
}

__device__ __forceinline__ void meta_down(const Params& P, LAS unsigned char* lds) {
    const int tid = threadIdx.x, lane = tid & 63, wid = tid >> 6;
    const f16* Gm = (const f16*)(P.ws + WS_G) + (size_t)SEQ * DFF; const f16* Wt = (const f16*)(P.ws + WS_WD1);
    f16* acta = (f16*)P.out; float* ss1 = (float*)(P.ws + WS_SS1); LAS float* slot = (LAS float*)lds;
    for (int task = blockIdx.x; task < NMETA * 16; task += gridDim.x) {
        const int r = task >> 4, cg = task & 15; float part = 0.f;
#pragma unroll 1
        for (int q = 0; q < 2; ++q) {
            const int n0 = cg * 64 + (2 * wid + q) * 4; float a[4] = {0.f, 0.f, 0.f, 0.f};
            for (int kc = lane; kc < DFF / 8; kc += 64) {
                const half8 gv = *(const half8*)(Gm + (size_t)r * DFF + kc * 8);
#pragma unroll
                for (int j = 0; j < 4; ++j) { const half8 wv = *(const half8*)(Wt + (size_t)(n0 + j) * DFF + kc * 8);
#pragma unroll
                    for (int e = 0; e < 8; ++e) a[j] += (float)gv[e] * (float)wv[e]; }
            }
#pragma unroll
            for (int o = 32; o >= 1; o >>= 1) { a[0] += __shfl_xor(a[0], o); a[1] += __shfl_xor(a[1], o); a[2] += __shfl_xor(a[2], o); a[3] += __shfl_xor(a[3], o); }
            f32x4 o;
#pragma unroll
            for (int j = 0; j < 4; ++j) { o[j] = P.meta[r * D + n0 + j] + 0.5f * a[j]; part += o[j] * o[j]; }
            if (lane == 0) *(half4*)(acta + (size_t)(SEQ + r) * D + n0) = to_half4(o);
        }
        if (lane == 0) slot[wid] = part;
        __syncthreads();
        if (tid == 0) { float s = 0.f; for (int w = 0; w < 8; ++w) s += slot[w]; ss1[(size_t)(SEQ + r) * 16 + cg] = s; }
        __syncthreads();
    }
}

__device__ __forceinline__ float logsigmoid_f(float z) { return fminf(z, 0.f) - __logf(1.0f + __expf(-fabsf(z))); }
__device__ __forceinline__ void gla_gates(const Params& P, int c, int h, LAS float* bl) {
    const int tid = threadIdx.x, ti = tid >> 3, d0 = (tid & 7) * 8, tt = 64 * c - 48 + ti; const float* GA = (const float*)(P.ws + WS_GA);
    {
        float z[8];
        if (tt >= 0 && tt < L) {
            const f32x4 b0 = *(const f32x4*)(P.ba + 64 * h + d0), b1 = *(const f32x4*)(P.ba + 64 * h + d0 + 4);
#pragma unroll
            for (int m = 0; m < 4; ++m) { z[m] = b0[m]; z[4 + m] = b1[m]; }
            f32x4 a4[4];
#pragma unroll
            for (int q = 0; q < 4; ++q) a4[q] = *(const f32x4*)(GA + (size_t)tt * 16 + 4 * q);
#pragma unroll
            for (int r = 0; r < 16; ++r) { const float ar = a4[r >> 2][r & 3]; const f32x4 w0 = *(const f32x4*)(P.wa2 + r * 256 + 64 * h + d0), w1 = *(const f32x4*)(P.wa2 + r * 256 + 64 * h + d0 + 4);
#pragma unroll
                for (int m = 0; m < 4; ++m) { z[m] += ar * w0[m]; z[4 + m] += ar * w1[m]; } }
#pragma unroll
            for (int m = 0; m < 8; ++m) z[m] = logsigmoid_f(z[m]) * (1.0f / 16.0f);
        } else {
#pragma unroll
            for (int m = 0; m < 8; ++m) z[m] = 0.f;
        }
#pragma unroll
        for (int m = 0; m < 8; ++m) bl[ti * 65 + d0 + m] = z[m];
    }
    __syncthreads();
    {
        const int d = tid & 63, seg = tid >> 6; float v[8], run = 0.f;
#pragma unroll
        for (int i = 0; i < 8; ++i) { run += bl[(seg * 8 + i) * 65 + d]; v[i] = run; }
#pragma unroll
        for (int i = 0; i < 8; ++i) bl[(seg * 8 + i) * 65 + d] = v[i];
        __syncthreads();
        float off = 0.f;
#pragma unroll
        for (int sg = 0; sg < 7; ++sg) off += (sg < seg) ? bl[(sg * 8 + 7) * 65 + d] : 0.f;
        __syncthreads();
#pragma unroll
        for (int i = 0; i < 8; ++i) bl[(seg * 8 + i) * 65 + d] = v[i] + off;
    }
    __syncthreads();
}
__device__ __forceinline__ void gla_a_unit(const Params& P, int unit, LAS unsigned char* lds) {
    int tid_ = threadIdx.x; asm volatile("" : "+v"(tid_));
    const int tid = tid_, lane = tid & 63, wid = tid >> 6, c = unit >> 2, h = unit & 3;
    LAS float* bl = (LAS float*)lds; LAS float* ks = bl + 4160; LAS float* vs = ks + 4096;
    const f16* GK = (const f16*)(P.ws + WS_GK); const f16* GV = (const f16*)(P.ws + WS_GV);
    float* U = (float*)(P.ws + WS_US); float* DEC = (float*)(P.ws + WS_DECAY);
    const int ti = tid >> 3, d0 = (tid & 7) * 8, tt = 64 * c - 48 + ti; const bool tv = tt >= 0 && tt < L;
    half8 k8, v8[2];
#pragma unroll
    for (int m = 0; m < 8; ++m) { k8[m] = (f16)0.f; v8[0][m] = (f16)0.f; v8[1][m] = (f16)0.f; }
    if (tv) k8 = *(const half8*)(GK + (size_t)tt * 256 + 64 * h + d0);
#pragma unroll
    for (int q = 0; q < 2; ++q) { const int ch = tid + 512 * q, j = ch >> 4, t = 64 * c - 48 + j; if (t >= 0 && t < L) v8[q] = *(const half8*)(GV + (size_t)t * 512 + 128 * h + (ch & 15) * 8); }
    gla_gates(P, c, h, bl);
    { f32x4 o0, o1;
#pragma unroll
      for (int m = 0; m < 4; ++m) { o0[m] = (float)k8[m] * __expf(bl[63 * 65 + d0 + m] - bl[ti * 65 + d0 + m]); o1[m] = (float)k8[4 + m] * __expf(bl[63 * 65 + d0 + 4 + m] - bl[ti * 65 + d0 + 4 + m]); }
      *(LAS f32x4*)(ks + ti * 64 + d0) = o0; *(LAS f32x4*)(ks + ti * 64 + d0 + 4) = o1; }
#pragma unroll
    for (int q = 0; q < 2; ++q) { const int ch = tid + 512 * q, j = ch >> 4, e0 = (ch & 15) * 8; f32x4 o0, o1;
#pragma unroll
        for (int m = 0; m < 4; ++m) { o0[m] = (float)v8[q][m]; o1[m] = (float)v8[q][4 + m]; }
        *(LAS f32x4*)(vs + j * 128 + e0) = o0; *(LAS f32x4*)(vs + j * 128 + e0 + 4) = o1; }
    if (tid < 64) DEC[(size_t)c * 256 + h * 64 + tid] = __expf(bl[63 * 65 + tid]);
    __syncthreads();
    { const int dd0 = (wid >> 2) * 32, e0 = (wid & 3) * 32, l31 = lane & 31, hf = lane >> 5; f32x16 acc;
#pragma unroll
      for (int i = 0; i < 16; ++i) acc[i] = 0.f;
#pragma unroll 8
      for (int s = 0; s < 32; ++s) acc = __builtin_amdgcn_mfma_f32_32x32x2f32(ks[(2 * s + hf) * 64 + dd0 + l31], vs[(2 * s + hf) * 128 + e0 + l31], acc, 0, 0, 0);
      float* up = U + ((size_t)unit * 64) * 128;
#pragma unroll
      for (int r = 0; r < 16; ++r) { const int row = (r & 3) + 8 * (r >> 2) + 4 * hf; up[(size_t)(dd0 + row) * 128 + e0 + l31] = acc[r]; } }
    __syncthreads();
}
__device__ __forceinline__ void gla_scan(const Params& P) {
    float* U = (float*)(P.ws + WS_US); const float* DEC = (const float*)(P.ws + WS_DECAY);
    const int idx = blockIdx.x * NTHREADS + threadIdx.x;
    if (idx >= 32768) return;
    float s = 0.f;
#pragma unroll 8
    for (int c = 0; c < NCH - 1; ++c) { const float u = U[(size_t)c * 32768 + idx], dc = DEC[(size_t)c * 256 + (idx >> 7)]; U[(size_t)c * 32768 + idx] = s; s = dc * s + u; }
    U[(size_t)(NCH - 1) * 32768 + idx] = s;
}
__device__ __forceinline__ void gla_c_unit(const Params& P, int unit, LAS unsigned char* lds) {
    int tid_ = threadIdx.x; asm volatile("" : "+v"(tid_));
    const int tid = tid_, lane = tid & 63, wid = tid >> 6, c = unit >> 2, h = unit & 3, l31 = lane & 31, hf = lane >> 5;
    LAS float* bl = (LAS float*)lds; LAS float* kk = bl + 4160; LAS float* qs = kk + 4160; LAS float* As = qs + 4160; LAS float* vs = As + 4160; LAS float* Ss = vs + 8192; LAS float* os = bl;
    const f16* GQ = (const f16*)(P.ws + WS_GQ); const f16* GK = (const f16*)(P.ws + WS_GK); const f16* GV = (const f16*)(P.ws + WS_GV); const f16* GR = (const f16*)(P.ws + WS_GR);
    const float* Sg = (const float*)(P.ws + WS_US) + (size_t)unit * 8192; f16* mix = (f16*)(P.ws + WS_ACTA);
    const int ti = tid >> 3, d0 = (tid & 7) * 8, tt = 64 * c - 48 + ti; const bool tv = tt >= 0 && tt < L;
    half8 q8, k8, v8[2], r8[2]; f32x4 sreg[4];
#pragma unroll
    for (int m = 0; m < 8; ++m) { q8[m] = (f16)0.f; k8[m] = (f16)0.f; v8[0][m] = (f16)0.f; v8[1][m] = (f16)0.f; r8[0][m] = (f16)0.f; r8[1][m] = (f16)0.f; }
    if (tv) { q8 = *(const half8*)(GQ + (size_t)tt * 256 + 64 * h + d0); k8 = *(const half8*)(GK + (size_t)tt * 256 + 64 * h + d0);
        r8[0] = *(const half8*)(GR + (size_t)tt * 512 + 128 * h + (tid & 7) * 16); r8[1] = *(const half8*)(GR + (size_t)tt * 512 + 128 * h + (tid & 7) * 16 + 8); }
#pragma unroll
    for (int q = 0; q < 2; ++q) { const int ch = tid + 512 * q, j = ch >> 4, t = 64 * c - 48 + j; if (t >= 0 && t < L) v8[q] = *(const half8*)(GV + (size_t)t * 512 + 128 * h + (ch & 15) * 8); }
#pragma unroll
    for (int q = 0; q < 4; ++q) sreg[q] = *(const f32x4*)(Sg + (size_t)(tid + 512 * q) * 4);
    gla_gates(P, c, h, bl);
#pragma unroll
    for (int m = 0; m < 8; ++m) { const float bv = bl[ti * 65 + d0 + m]; qs[ti * 65 + d0 + m] = (float)q8[m] * 0.125f * __expf(bv); kk[ti * 65 + d0 + m] = (float)k8[m] * __expf(-bv); }
#pragma unroll
    for (int q = 0; q < 2; ++q) { const int ch = tid + 512 * q, j = ch >> 4, e0 = (ch & 15) * 8; f32x4 o0, o1;
#pragma unroll
        for (int m = 0; m < 4; ++m) { o0[m] = (float)v8[q][m]; o1[m] = (float)v8[q][4 + m]; }
        *(LAS f32x4*)(vs + j * 128 + e0) = o0; *(LAS f32x4*)(vs + j * 128 + e0 + 4) = o1; }
#pragma unroll
    for (int q = 0; q < 4; ++q) *(LAS f32x4*)(Ss + (tid + 512 * q) * 4) = sreg[q];
    __syncthreads();
    if (wid < 4) { const int i0 = (wid >> 1) * 32, j0 = (wid & 1) * 32; f32x16 acc;
#pragma unroll
        for (int i = 0; i < 16; ++i) acc[i] = 0.f;
#pragma unroll 8
        for (int s = 0; s < 32; ++s) acc = __builtin_amdgcn_mfma_f32_32x32x2f32(qs[(i0 + l31) * 65 + 2 * s + hf], kk[(j0 + l31) * 65 + 2 * s + hf], acc, 0, 0, 0);
#pragma unroll
        for (int r = 0; r < 16; ++r) { const int i = i0 + (r & 3) + 8 * (r >> 2) + 4 * hf, j = j0 + l31; As[i * 65 + j] = (j <= i) ? acc[r] : 0.f; } }
    __syncthreads();
    { const int i0 = (wid >> 2) * 32, e0 = (wid & 3) * 32; f32x16 acc;
#pragma unroll
      for (int i = 0; i < 16; ++i) acc[i] = 0.f;
#pragma unroll 8
      for (int s = 0; s < 32; ++s) acc = __builtin_amdgcn_mfma_f32_32x32x2f32(qs[(i0 + l31) * 65 + 2 * s + hf], Ss[(2 * s + hf) * 128 + e0 + l31], acc, 0, 0, 0);
#pragma unroll 8
      for (int s = 0; s < 32; ++s) acc = __builtin_amdgcn_mfma_f32_32x32x2f32(As[(i0 + l31) * 65 + 2 * s + hf], vs[(2 * s + hf) * 128 + e0 + l31], acc, 0, 0, 0);
#pragma unroll
      for (int r = 0; r < 16; ++r) { const int i = i0 + (r & 3) + 8 * (r >> 2) + 4 * hf; os[i * 129 + e0 + l31] = acc[r]; } }
    __syncthreads();
    { const int e0 = (tid & 7) * 16; float o[16], sq = 0.f;
#pragma unroll
      for (int j = 0; j < 16; ++j) { o[j] = os[ti * 129 + e0 + j]; sq += o[j] * o[j]; }
      sq += __shfl_xor(sq, 1); sq += __shfl_xor(sq, 2); sq += __shfl_xor(sq, 4);
      const float rs = rsqrtf(sq * (1.0f / 128.0f) + EPS);
      if (tt >= NMETA && tt < L) { half8 w0, w1;
#pragma unroll
          for (int j = 0; j < 8; ++j) { w0[j] = (f16)(o[j] * rs * P.hn[e0 + j] * silu_f((float)r8[0][j])); w1[j] = (f16)(o[8 + j] * rs * P.hn[e0 + 8 + j] * silu_f((float)r8[1][j])); }
          f16* dst = mix + (size_t)(tt - NMETA) * D + 128 * h + e0; *(half8*)dst = w0; *(half8*)(dst + 8) = w1; } }
    __syncthreads();
}

__device__ __forceinline__ unsigned mono_u(float f) { const unsigned u = __float_as_uint(f); return (u & 0x80000000u) ? ~u : (u | 0x80000000u); }
__device__ __forceinline__ float unmono_f(unsigned m) { return __uint_as_float((m & 0x80000000u) ? (m & 0x7fffffffu) : ~m); }
__device__ __forceinline__ unsigned wave_umax(unsigned v) {
    v = max(v, (unsigned)__builtin_amdgcn_update_dpp(0, (int)v, 0x111, 0xf, 0xf, false));
    v = max(v, (unsigned)__builtin_amdgcn_update_dpp(0, (int)v, 0x112, 0xf, 0xf, false));
    v = max(v, (unsigned)__builtin_amdgcn_update_dpp(0, (int)v, 0x114, 0xf, 0xf, false));
    v = max(v, (unsigned)__builtin_amdgcn_update_dpp(0, (int)v, 0x118, 0xf, 0xf, false));
    v = max(v, (unsigned)__builtin_amdgcn_update_dpp(0, (int)v, 0x142, 0xa, 0xf, false));
    v = max(v, (unsigned)__builtin_amdgcn_update_dpp(0, (int)v, 0x143, 0xc, 0xf, false));
    return (unsigned)__builtin_amdgcn_readlane((int)v, 63);
}
__device__ __forceinline__ int half_scan_incl(int v) {
    v += __builtin_amdgcn_update_dpp(0, v, 0x111, 0xf, 0xf, true);
    v += __builtin_amdgcn_update_dpp(0, v, 0x112, 0xf, 0xf, true);
    v += __builtin_amdgcn_update_dpp(0, v, 0x114, 0xf, 0xf, true);
    v += __builtin_amdgcn_update_dpp(0, v, 0x118, 0xf, 0xf, true);
    v += __builtin_amdgcn_update_dpp(0, v, 0x142, 0xa, 0xf, true);
    return v;
}
constexpr int CAP = 640, NPL = CAP / 64;
__device__ __forceinline__ int topk_compact(LAS float* cs, LAS unsigned short* ci, int n, bool exact, float& tau_out, int lane) {
    float sv[NPL]; unsigned iv[NPL], u[NPL];
#pragma unroll
    for (int i = 0; i < NPL; ++i) { const int p = lane + 64 * i; const bool v = p < n; sv[i] = v ? cs[p] : 0.f; iv[i] = v ? (unsigned)ci[p] : 0xffffu; u[i] = v ? mono_u(sv[i]) : 0u; }
    unsigned T = 0u; bool full = true; int hb = 31;
    {
        unsigned umx = 0u, umn = 0xffffffffu;
#pragma unroll
        for (int i = 0; i < NPL; ++i) { umx = max(umx, u[i]); umn = min(umn, (lane + 64 * i < n) ? u[i] : 0xffffffffu); }
        umx = wave_umax(umx); umn = ~wave_umax(~umn);
        const unsigned df = umx ^ umn;
        if (df == 0u) { hb = -1; T = umx; } else { hb = 31 - __clz(df); T = (hb == 31) ? 0u : (umx & ~((2u << hb) - 1u)); }
    }
#pragma unroll 1
    for (int bit = hb; bit >= 0; --bit) {
        const unsigned cand = T | (1u << bit); int cgt = 0;
#pragma unroll
        for (int i = 0; i < NPL; ++i) cgt += __popcll(__ballot(u[i] >= cand));
        if (cgt >= 256) { T = cand; if (cgt <= (exact ? 256 : 272)) { full = false; break; } }
    }
    bool keep[NPL];
    if (full) {
        int cgt = 0;
#pragma unroll
        for (int i = 0; i < NPL; ++i) cgt += __popcll(__ballot(u[i] > T));
        const int need = 256 - cgt; unsigned I = 0xffffu; int nties = 0;
#pragma unroll
        for (int i = 0; i < NPL; ++i) nties += __popcll(__ballot(u[i] == T));
        if (nties != need) { I = 0u;
#pragma unroll 1
        for (int bit = 15; bit >= 0; --bit) { const unsigned cand = I | (1u << bit); int cl = 0;
#pragma unroll
            for (int i = 0; i < NPL; ++i) cl += __popcll(__ballot(u[i] == T && iv[i] < cand));
            if (cl < need) I = cand; } }
#pragma unroll
        for (int i = 0; i < NPL; ++i) keep[i] = (u[i] > T) || (u[i] == T && iv[i] <= I);
    } else {
#pragma unroll
        for (int i = 0; i < NPL; ++i) keep[i] = u[i] >= T;
    }
    int nn = 0;
#pragma unroll
    for (int i = 0; i < NPL; ++i) { const unsigned long long m = __ballot(keep[i]); const int pre = __builtin_amdgcn_mbcnt_hi((unsigned)(m >> 32), __builtin_amdgcn_mbcnt_lo((unsigned)m, 0u));
        if (keep[i]) { cs[nn + pre] = sv[i]; ci[nn + pre] = (unsigned short)iv[i]; } nn += __popcll(m); }
    tau_out = unmono_f(T);
    return nn;
}
__device__ __forceinline__ float relu_asm(float x) { return __int_as_float(max(__float_as_int(x), 0)); }
__device__ __forceinline__ void indexer_tile(const Params& P, int tile, LAS unsigned char* lds) {
    int tid_ = threadIdx.x; asm volatile("" : "+v"(tid_));
    const int tid = tid_, lane = tid & 63, wid = __builtin_amdgcn_readfirstlane(tid >> 6), l31 = lane & 31, hf = lane >> 5;
    LAS float* candS = (LAS float*)lds;
    LAS unsigned short* candI = (LAS unsigned short*)(lds + 32 * CAP * 4);
    LAS unsigned char* kbuf = lds + 32 * CAP * 6;
    LAS int* lflag = (LAS int*)(lds + LDS_BYTES - 1024 + 192);
    const f16* IQ = (const f16*)(P.ws + WS_IQ); const f16* IK = (const f16*)(P.ws + WS_IK); const float* IW = (const float*)(P.ws + WS_IW);
    unsigned short* SEL = (unsigned short*)(P.ws + WS_SEL);
    const int t0 = tile * 32, tw = t0 + wid * 4;
    half8 afr[4];
    { const int qi = 2 * (l31 >> 4) + ((l31 >> 2) & 1), hd = 4 * ((l31 >> 3) & 1) + (l31 & 3); int tq = tw + qi; if (tq > L - 1) tq = L - 1;
      const half8* ap = (const half8*)(IQ + (size_t)tq * 512 + hd * 64);
#pragma unroll
      for (int s = 0; s < 4; ++s) afr[s] = ap[2 * s + hf]; }
    float w0[8], w1[8];
    { int ta = tw + hf, tb = tw + 2 + hf; if (ta > L - 1) ta = L - 1; if (tb > L - 1) tb = L - 1;
#pragma unroll
      for (int h = 0; h < 8; ++h) { w0[h] = IW[(size_t)ta * 8 + h]; w1[h] = IW[(size_t)tb * 8 + h]; } }
    asm volatile("" :: "v"(afr[0]), "v"(afr[1]), "v"(afr[2]), "v"(afr[3]));
    asm volatile("" :: "v"(w0[0]), "v"(w0[1]), "v"(w0[2]), "v"(w0[3]), "v"(w0[4]), "v"(w0[5]), "v"(w0[6]), "v"(w0[7]));
    asm volatile("" :: "v"(w1[0]), "v"(w1[1]), "v"(w1[2]), "v"(w1[3]), "v"(w1[4]), "v"(w1[5]), "v"(w1[6]), "v"(w1[7]));
    const int tq0 = (tw + hf < L) ? tw + hf : -1, tq1 = (tw + 2 + hf < L) ? tw + 2 + hf : -1;
    float tau0 = -__builtin_inff(), tau1 = -__builtin_inff();
    int cq0 = 0, cq1 = 0, cq2 = 0, cq3 = 0;
    if (tid < 3) lflag[tid] = 0;
    const int nkeys = (t0 + 32 < L) ? t0 + 32 : L, nst = (nkeys + 127) >> 7;
    u32x4 stg[2];
    const u32x4* IKv = (const u32x4*)IK;
#pragma unroll
    for (int i = 0; i < 2; ++i) stg[i] = IKv[(size_t)0 * 1024 + tid + 512 * i];
#pragma unroll
    for (int i = 0; i < 2; ++i) { const int ci = tid + 512 * i, row = ci >> 3, ch = ci & 7; *(LAS u32x4*)(kbuf + row * 128 + ((ch ^ ((row >> 1) & 7)) << 4)) = stg[i]; }
    __syncthreads();
#pragma unroll 1
    for (int st = 0; st < nst; ++st) {
        LAS unsigned char* kb = kbuf + (st & 1) * 16384;
        if (st + 1 < nst) {
#pragma unroll
            for (int i = 0; i < 2; ++i) stg[i] = IKv[(size_t)(st + 1) * 1024 + tid + 512 * i];
        }
        if (st * 128 <= tw + 3) {
            f32x16 acc[4];
#pragma unroll
            for (int c = 0; c < 4; ++c) {
#pragma unroll
                for (int i = 0; i < 16; ++i) acc[c][i] = 0.f;
            }
#pragma unroll
            for (int s = 0; s < 4; ++s) {
#pragma unroll
                for (int c = 0; c < 4; ++c) { const int row = c * 32 + l31; const half8 bf = *(const LAS half8*)(kb + row * 128 + (((2 * s + hf) ^ ((row >> 1) & 7)) << 4)); acc[c] = __builtin_amdgcn_mfma_f32_32x32x16_f16(afr[s], bf, acc[c], 0, 0, 0); }
            }
            float sc[8]; bool ok[8]; int na = 0, nb = 0;
#pragma unroll
            for (int c = 0; c < 4; ++c) {
                float s0 = 0.f, s1 = 0.f;
#pragma unroll
                for (int h = 0; h < 8; ++h) { const float r0 = relu_asm(acc[c][h]), r1 = relu_asm(acc[c][8 + h]);
                    asm("v_fmac_f32 %0, %1, %2" : "+v"(s0) : "v"(w0[h]), "v"(r0)); asm("v_fmac_f32 %0, %1, %2" : "+v"(s1) : "v"(w1[h]), "v"(r1)); }
                const int key = st * 128 + c * 32 + l31;
                sc[2 * c] = s0; sc[2 * c + 1] = s1; ok[2 * c] = key <= tq0 && s0 > tau0; ok[2 * c + 1] = key <= tq1 && s1 > tau1;
                na += ok[2 * c] ? 1 : 0; nb += ok[2 * c + 1] ? 1 : 0;
            }
            const int ia = half_scan_incl(na), ib = half_scan_incl(nb);
            const int ta0 = __builtin_amdgcn_readlane(ia, 31), ta1 = __builtin_amdgcn_readlane(ia, 63), tb0 = __builtin_amdgcn_readlane(ib, 31), tb1 = __builtin_amdgcn_readlane(ib, 63);
            int pa = (hf ? cq1 : cq0) + ia - na, pb = (hf ? cq3 : cq2) + ib - nb;
            cq0 += ta0; cq1 += ta1; cq2 += tb0; cq3 += tb1;
            pa += (wid * 4 + hf) * CAP; pb += (wid * 4 + 2 + hf) * CAP;
            const int dmy = 32 * CAP * 6 / 4 + 2 * 16384 / 4 + 64 + lane;
#pragma unroll
            for (int c = 0; c < 4; ++c) {
                const unsigned short key = (unsigned short)(st * 128 + c * 32 + l31);
                { const bool k0 = ok[2 * c]; LAS float* ps = k0 ? candS + pa : candS + dmy; LAS unsigned short* pi = k0 ? candI + pa : (LAS unsigned short*)(candS + dmy + 64); *ps = sc[2 * c]; *pi = key; pa += k0 ? 1 : 0; }
                { const bool k1 = ok[2 * c + 1]; LAS float* ps = k1 ? candS + pb : candS + dmy; LAS unsigned short* pi = k1 ? candI + pb : (LAS unsigned short*)(candS + dmy + 64); *ps = sc[2 * c + 1]; *pi = key; pb += k1 ? 1 : 0; }
            }
        }
        if (st + 1 < nst) {
            LAS unsigned char* kn = kbuf + ((st + 1) & 1) * 16384;
#pragma unroll
            for (int i = 0; i < 2; ++i) { const int ci = tid + 512 * i, row = ci >> 3, ch = ci & 7; *(LAS u32x4*)(kn + row * 128 + ((ch ^ ((row >> 1) & 7)) << 4)) = stg[i]; }
        }
        const int mx = max(max(cq0, cq1), max(cq2, cq3));
        if (mx > CAP - 128 && lane == 0) lflag[st % 3] = 1;
        if (tid == 0) lflag[(st + 1) % 3] = 0;
        __syncthreads();
        const int any = lflag[st % 3];
        if (any) {
#pragma unroll 1
            for (int qq = 0; qq < 4; ++qq) { const int n = qq == 0 ? cq0 : (qq == 1 ? cq1 : (qq == 2 ? cq2 : cq3));
                if (n > 288) { float nt; const int nn = topk_compact(candS + (wid * 4 + qq) * CAP, candI + (wid * 4 + qq) * CAP, n, false, nt, lane);
                    if (qq == 0) cq0 = nn; else if (qq == 1) cq1 = nn; else if (qq == 2) cq2 = nn; else cq3 = nn;
                    if (hf == (qq & 1)) { if (qq < 2) tau0 = nt; else tau1 = nt; } } }
        }
    }
#pragma unroll 1
    for (int qq = 0; qq < 4; ++qq) {
        const int t = tw + qq; if (t >= L) break;
        int n = qq == 0 ? cq0 : (qq == 1 ? cq1 : (qq == 2 ? cq2 : cq3)); LAS float* cs = candS + (wid * 4 + qq) * CAP; LAS unsigned short* ci = candI + (wid * 4 + qq) * CAP;
        if (n > 256) { float nt; n = topk_compact(cs, ci, n, true, nt, lane); }
#pragma unroll
        for (int j = 0; j < 4; ++j) { const int p = lane + 64 * j; SEL[(size_t)t * 256 + (p & 15) * 16 + (p >> 4)] = p < n ? ci[p] : (unsigned short)0xffffu; }
    }
    __syncthreads();
}

__device__ __forceinline__ void sparse_attn(const Params& P, LAS unsigned char* lds, int vbid) {
    int tid_ = threadIdx.x; asm volatile("" : "+v"(tid_));
    const int tid = tid_, lane = tid & 63, wid = tid >> 6, grp = lane >> 2, c4 = lane & 3;
    const int head = vbid & 7, slot = (vbid >> 3) * 8 + wid, nslot = (gridDim.x >> 3) * 8;
    typedef _Float16 half2v __attribute__((ext_vector_type(2)));
    LAS float* red = (LAS float*)(lds + 4096 + wid * 4352);
    const unsigned short* SEL = (const unsigned short*)(P.ws + WS_SEL);
    const unsigned char* Q8 = P.ws + WS_DQ + head * 64 + c4 * 16; const float* QS = (const float*)(P.ws + WS_DQ + (size_t)LP * 512) + head;
    const unsigned char* kvh = P.ws + WS_KV + (size_t)head * LP * 128; f16* mix = (f16*)(P.ws + WS_ACTA);
    int t = NMETA + slot;
    u32x4 sela = {0u, 0u, 0u, 0u}, selb = {0u, 0u, 0u, 0u}, q8 = {0u, 0u, 0u, 0u}; float lscale = 0.f;
    if (t < L) { sela = *(const u32x4*)(SEL + (size_t)t * 256 + grp * 16); selb = *(const u32x4*)(SEL + (size_t)t * 256 + grp * 16 + 8); q8 = *(const u32x4*)(Q8 + (size_t)t * 512); lscale = QS[(size_t)t * 8]; }
#define ATTN_ITEM(ALLV) do { \
        unsigned keys[16]; u32x4 kreg[16], vreg[16]; \
        _Pragma("unroll") for (int it = 0; it < 16; ++it) { const unsigned w = it < 8 ? sela[it >> 1] : selb[(it - 8) >> 1]; keys[it] = (it & 1) ? (w >> 16) : (w & 0xffffu); } \
        _Pragma("unroll") for (int it = 0; it < 16; ++it) { const unsigned kk = (ALLV || keys[it] != 0xffffu) ? keys[it] : 0u; kreg[it] = *(const u32x4*)(kvh + (size_t)kk * 128 + c4 * 16); } \
        _Pragma("unroll") for (int it = 0; it < 16; ++it) { const unsigned kk = (ALLV || keys[it] != 0xffffu) ? keys[it] : 0u; vreg[it] = *(const u32x4*)(kvh + (size_t)kk * 128 + 64 + c4 * 16); } \
        const u32x4 qc = q8; const float ls = lscale; \
        { const int tn = t + nslot;     \
          if (tn < L) { sela = *(const u32x4*)(SEL + (size_t)tn * 256 + grp * 16); selb = *(const u32x4*)(SEL + (size_t)tn * 256 + grp * 16 + 8); q8 = *(const u32x4*)(Q8 + (size_t)tn * 512); lscale = QS[(size_t)tn * 8]; } } \
        float lg[16]; float mx = -__builtin_inff(); \
        _Pragma("unroll") for (int it = 0; it < 16; ++it) { \
            int ai = 0; \
            _Pragma("unroll") for (int w = 0; w < 4; ++w) ai = __builtin_amdgcn_sdot4((int)kreg[it][w], (int)qc[w], ai, false); \
            ai += __builtin_amdgcn_update_dpp(0, ai, 0xB1, 0xf, 0xf, true);     \
            ai += __builtin_amdgcn_update_dpp(0, ai, 0x4E, 0xf, 0xf, true);     \
            lg[it] = (ALLV || keys[it] != 0xffffu) ? (float)ai * ls : -__builtin_inff(); mx = fmaxf(mx, lg[it]); } \
        mx = fmaxf(mx, __shfl_xor(mx, 4)); mx = fmaxf(mx, __shfl_xor(mx, 8)); mx = fmaxf(mx, __shfl_xor(mx, 16)); mx = fmaxf(mx, __shfl_xor(mx, 32)); \
        half2v o2[8]; float lsum = 0.f; \
        _Pragma("unroll") for (int e = 0; e < 8; ++e) o2[e] = (half2v){(f16)0.f, (f16)0.f}; \
        _Pragma("unroll") for (int it = 0; it < 16; ++it) { \
            const float p = __expf(lg[it] - mx); lsum += p; const f16 ph = (f16)p; const half2v p2 = {ph, ph}; \
            _Pragma("unroll") for (int w = 0; w < 4; ++w) {     \
                const half2v v01 = __builtin_bit_cast(half2v, __builtin_amdgcn_perm(0u, vreg[it][w], 0x010c000cu)), v23 = __builtin_bit_cast(half2v, __builtin_amdgcn_perm(0u, vreg[it][w], 0x030c020cu)); \
                o2[2 * w] = p2 * v01 + o2[2 * w]; o2[2 * w + 1] = p2 * v23 + o2[2 * w + 1]; } } \
        lsum += __shfl_xor(lsum, 4); lsum += __shfl_xor(lsum, 8); lsum += __shfl_xor(lsum, 16); lsum += __shfl_xor(lsum, 32); \
          \
        _Pragma("unroll") for (int e = 0; e < 8; ++e) { red[lane * 17 + 2 * e] = (float)o2[e][0]; red[lane * 17 + 2 * e + 1] = (float)o2[e][1]; } \
        float acc = 0.f; \
        { const int cc = lane >> 4, e = lane & 15; \
          _Pragma("unroll") for (int g = 0; g < 16; ++g) acc += red[(g * 4 + cc) * 17 + e]; } \
        mix[(size_t)(t - NMETA) * D + 512 + head * 64 + lane] = (f16)(acc * __builtin_amdgcn_rcpf(lsum)); \
    } while (0)
#pragma unroll 1
    for (; t < L; t += nslot) {
        if (t >= 255) ATTN_ITEM(true);
        else ATTN_ITEM(false);
    }
#undef ATTN_ITEM
    __syncthreads();
}

__device__ __forceinline__ void final_norm(const Params& P) {
    const int tid = threadIdx.x, lane = tid & 63, gw = blockIdx.x * 8 + (tid >> 6), nw = gridDim.x * 8;
    const float* ss3 = (const float*)(P.ws + WS_SS3); const f16* h3 = (const f16*)(P.ws + WS_ACTA);
    for (int r = gw; r < SEQ; r += nw) { const float rs = row_rstd(ss3, 16, r);
#pragma unroll
        for (int i = 0; i < 2; ++i) { const int k = lane * 8 + 512 * i; const half8 v = *(const half8*)(h3 + (size_t)r * D + k); const f32x4 g0 = *(const f32x4*)(P.nf + k), g1 = *(const f32x4*)(P.nf + k + 4); f32x4 o0, o1;
#pragma unroll
            for (int j = 0; j < 4; ++j) { o0[j] = (float)v[j] * rs * g0[j]; o1[j] = (float)v[4 + j] * rs * g1[j]; }
            *(f32x4*)(P.out + (size_t)r * D + k) = o0; *(f32x4*)(P.out + (size_t)r * D + k + 4) = o1; } }
}

#define XB_TMO      128
#define XB_XCNT(j)  (256  + 64 * (j))
#define XB_XSUB(j)  (1280 + 64 * (j))
#define XB_XGEN(j)  (2304 + 64 * (j))
#define XB_TOP      3328
#define XB_TOPGEN   3392
#define XCD_BAR_WORDS 3456
#define XB_SPIN_CAP (1u << 22)
__device__ __forceinline__ unsigned xb_ld(unsigned* p)              { return __hip_atomic_load(p, __ATOMIC_RELAXED, __HIP_MEMORY_SCOPE_AGENT); }
__device__ __forceinline__ unsigned xb_add(unsigned* p, unsigned v) { return __hip_atomic_fetch_add(p, v, __ATOMIC_RELAXED, __HIP_MEMORY_SCOPE_AGENT); }
__device__ __forceinline__ unsigned xb_xcc_id() { return (unsigned)__builtin_amdgcn_s_getreg((3 << 11) | 20) & 0xFu; }
#define XB_SPIN(cond, bar) do { unsigned _sp = 0; while (cond) { __builtin_amdgcn_s_sleep(1); \
    if ((++_sp & 255u) == 0u) { if (xb_ld(&(bar)[XB_TMO])) break; if (_sp > XB_SPIN_CAP) { atomicAdd(&(bar)[XB_TMO], 1u); break; } } } } while (0)
struct XcdBarrier { unsigned* bar; unsigned x; volatile LAS unsigned* st; };
__device__ __forceinline__ XcdBarrier xcd_barrier_post(unsigned* bar, volatile LAS unsigned* st) {
    XcdBarrier b; b.bar = bar; b.x = xb_xcc_id(); b.st = st;
    if (threadIdx.x == 0) (void)xb_add(&bar[XB_XCNT(b.x)], 1u);
    return b;
}
__device__ __forceinline__ void xcd_barrier_complete(unsigned* bar, unsigned x, unsigned& nloc, unsigned& nx) {
    const unsigned G = gridDim.x * gridDim.y * gridDim.z;
    unsigned sum, cnt, mine, sp = 0u;
    for (;;) {
        sum = 0u; cnt = 0u; mine = 0u;
#pragma unroll
        for (unsigned j = 0; j < 16; ++j) { const unsigned c = xb_ld(&bar[XB_XCNT(j)]); sum += c; cnt += (c > 0u) ? 1u : 0u; mine = (j == x) ? c : mine; }
        if (sum == G) break;
        __builtin_amdgcn_s_sleep(1);
        if ((++sp & 255u) == 0u) { if (xb_ld(&bar[XB_TMO])) break; if (sp > XB_SPIN_CAP) { atomicAdd(&bar[XB_TMO], 1u); break; } }
    }
    nloc = mine > 0u ? mine : 1u; nx = cnt > 0u ? cnt : 1u;
}
__device__ __forceinline__ void xcd_barrier(const XcdBarrier& b) {
    asm volatile("s_waitcnt vmcnt(0)" ::: "memory");
    __syncthreads();
    if (threadIdx.x == 0) {
        unsigned* bar = b.bar;
        __builtin_amdgcn_s_waitcnt(0);
        unsigned nloc = b.st[0], nx = b.st[1];
        if (nloc == 0u) { xcd_barrier_complete(bar, b.x, nloc, nx); b.st[0] = nloc; b.st[1] = nx; }
        const unsigned old = xb_add(&bar[XB_XSUB(b.x)], 1u);
        const unsigned gen = old / nloc;
        if (old + 1u == (gen + 1u) * nloc) {
            __builtin_amdgcn_fence(__ATOMIC_RELEASE, "agent");
            asm volatile("s_waitcnt vmcnt(0)" ::: "memory");
            const unsigned og = xb_add(&bar[XB_TOP], 1u);
            const unsigned tg = og / nx;
            if (og + 1u == (tg + 1u) * nx) xb_add(&bar[XB_TOPGEN], 1u);
            else XB_SPIN(xb_ld(&bar[XB_TOPGEN]) == tg, bar);
            __builtin_amdgcn_fence(__ATOMIC_ACQUIRE, "agent");
            xb_add(&bar[XB_XGEN(b.x)], 1u);
            asm volatile("s_waitcnt vmcnt(0)" ::: "memory");
        } else {
            XB_SPIN(xb_ld(&bar[XB_XGEN(b.x)]) == gen, bar);
            __builtin_amdgcn_fence(__ATOMIC_ACQUIRE, "agent");
            asm volatile("s_waitcnt vmcnt(0)" ::: "memory");
        }
    }
    __syncthreads();
}

__global__ void __launch_bounds__(NTHREADS, 2) fwd_kernel(Params P) {
    __shared__ __attribute__((aligned(16))) unsigned char lds_raw[LDS_BYTES];
    LAS unsigned char* lds = (LAS unsigned char*)lds_raw;
    const int tid = threadIdx.x, bid = blockIdx.x, G = gridDim.x;
    unsigned char* ws = P.ws;
    const int lo = P.ph_lo, hi = P.ph_hi;
#ifndef ONLY_PHASE
#define ONLY_PHASE -1
#endif
#define IN(k) ((ONLY_PHASE < 0 || ONLY_PHASE == (k)) && lo <= (k) && (k) < hi)
#define SEAM(k) do { if (IN(k) && IN((k) + 1)) { xcd_barrier(xbar); } } while (0)
    XcdBarrier xbar; xbar.bar = (unsigned*)(ws + WS_BAR); xbar.x = 0; xbar.st = (volatile LAS unsigned*)(lds + LDS_BYTES - 1024 + 16);
    if (hi - lo > 1) {
        if (tid == 0) { xbar.st[0] = 0u; xbar.st[1] = 0u; }
        __syncthreads();
        xbar = xcd_barrier_post((unsigned*)(ws + WS_BAR), (volatile LAS unsigned*)(lds + LDS_BYTES - 1024 + 16));
    }
    LAS int* misc = (LAS int*)(lds + LDS_BYTES - 1024);
    if (hi - lo > 1) {
        if (tid == 0) { const unsigned xcc = xb_xcc_id() & 7u; misc[8] = (int)xcc; misc[9] = (int)xb_add((unsigned*)(ws + WS_CTL) + 32 + 32 * xcc, 1u); }
    }
    int vbid = bid;
    f16* acta = (f16*)(ws + WS_ACTA); f16* Gb = (f16*)(ws + WS_G);
    float* ss1 = (float*)(ws + WS_SS1); float* ss3 = (float*)(ws + WS_SS3);
    if (IN(0)) { p0_prologue(P, lds); }
    SEAM(0);
    if (hi - lo > 1 && (G & 7) == 0) {
        if (tid == 0) { bool ok = true; for (int j = 0; j < 8; ++j) ok = ok && (xb_ld((unsigned*)(ws + WS_CTL) + 32 + 32 * j) == (unsigned)(G >> 3)); misc[10] = ok ? misc[9] * 8 + misc[8] : bid; }
        __syncthreads();
        vbid = __builtin_amdgcn_readfirstlane(misc[10]);
        __syncthreads();
    }
    if (IN(1)) {
        pg8::Gemm g{(const f16*)(ws + WS_US), (const f16*)(ws + WS_WGU1), MP, 2 * DFF, D / 2}; pg8::StaticOrder S; S.init(MP, 2 * DFF, G, vbid);
        EpiSwiglu<true> E{Gb, nullptr, 1, (const float*)(ws + WS_IQ), (const float*)(ws + WS_WGU1 + (size_t)2 * DFF * D)}; pg8::gemm_phase(lds, g, S, E);
    }
    SEAM(1);
    if (IN(2)) {
        meta_down(P, lds);
        pg8::Gemm g{Gb, (const f16*)(ws + WS_WD1), SEQ, D, DFF}; pg8::StaticOrder S; S.init(SEQ, D, G, vbid);
        EpiResid<true> E{acta, (f16*)P.out, ss1, 0.5f}; pg8::gemm_phase(lds, g, S, E);
    }
    SEAM(2);
    if (IN(3)) {
        pg8::Gemm g{(const f16*)P.out, (const f16*)(ws + WS_WIN), MP, NIN, D}; pg8::StaticOrder S; S.init(MP, NIN, G, vbid);
        EpiInProj E{ss1, (const f32x2*)(ws + WS_ROPE), ws};
        pg8::gemm_phase(lds, g, S, E);
    }
    SEAM(3);
    if (IN(4)) {
        for (int u = bid; u < (NCH - 1) * 4; u += G) gla_a_unit(P, u, lds);
        {
            constexpr int NI8 = 2 * DFF / 64; LAS f16* tl = (LAS f16*)lds;
            if (G > NI8 + 64) {
                if (bid >= G - NI8) prep_weight_i8(P, 4, 2 * DFF, ws + WS_WGU2, (float*)(ws + WS_WGU2 + (size_t)2 * DFF * D), bid - (G - NI8), NI8, lds);
                else { int tbase = 0, cursor = bid;
                    prep_weight(P, 3, D, D, (f16*)(ws + WS_WOUT), cursor, tbase, tl, G - NI8);
                    prep_weight(P, 5, D, DFF, (f16*)(ws + WS_WD2), cursor, tbase, tl, G - NI8); }
            } else { int tbase = 0, cursor = bid;
                prep_weight(P, 3, D, D, (f16*)(ws + WS_WOUT), cursor, tbase, tl, G);
                prep_weight(P, 5, D, DFF, (f16*)(ws + WS_WD2), cursor, tbase, tl, G);
                __syncthreads();
                prep_weight_i8(P, 4, 2 * DFF, ws + WS_WGU2, (float*)(ws + WS_WGU2 + (size_t)2 * DFF * D), bid, G, lds); }
        }
    }
    SEAM(4);
    if (IN(5)) {
        if (bid < 64) gla_scan(P);
        unsigned* ctr = (unsigned*)(ws + WS_CTL); LAS int* bc = (LAS int*)(lds + LDS_BYTES - 1024);
        for (;;) {
            if (tid == 0) bc[0] = (int)atomicAdd(ctr, 1u);
            __syncthreads();
            const int k = bc[0];
            __syncthreads();
            if (k >= 513) break;
            indexer_tile(P, 512 - k, lds);
        }
    }
    SEAM(5);
    if (IN(6)) { for (int u = 4 + bid; u < NCH * 4; u += G) gla_c_unit(P, u, lds); sparse_attn(P, lds, vbid); }
    SEAM(6);
    if (IN(7)) {
        pg8::Gemm g{acta, (const f16*)(ws + WS_WOUT), SEQ, D, D}; pg8::StaticOrder S; S.init(SEQ, D, G, vbid);
        EpiResid<true, false> E{P.out, (f16*)(ws + WS_US), nullptr, 1.0f}; pg8::gemm_phase(lds, g, S, E);
    }
    SEAM(7);
    if (IN(8)) quant_rows_i8((const f16*)(ws + WS_US), ws + WS_DQ, (float*)(ws + WS_IQ), SEQ);
    SEAM(8);
    if (IN(9)) {
        pg8::Gemm g{(const f16*)(ws + WS_DQ), (const f16*)(ws + WS_WGU2), SEQ, 2 * DFF, D / 2}; pg8::StaticOrder S; S.init(SEQ, 2 * DFF, G, vbid);
        EpiSwiglu<true> E{Gb, nullptr, 16, (const float*)(ws + WS_IQ), (const float*)(ws + WS_WGU2 + (size_t)2 * DFF * D)}; pg8::gemm_phase(lds, g, S, E);
    }
    SEAM(9);
    if (IN(10)) {
        pg8::Gemm g{Gb, (const f16*)(ws + WS_WD2), SEQ, D, DFF}; pg8::StaticOrder S; S.init(SEQ, D, G, vbid);
        EpiResid<true> E{ws + WS_US, acta, ss3, 0.5f}; pg8::gemm_phase(lds, g, S, E);
    }
    SEAM(10);
    if (IN(11)) final_norm(P);
#undef IN
#undef SEAM
}

extern "C" void kernel_launch(void* const* d_in, const int* in_sizes, int n_in, void* d_out, int out_size, void* d_ws, size_t ws_size, hipStream_t stream) {
    static int grid = 0;
    if (grid == 0) {
        if (n_in != 17 || in_sizes[0] != SEQ * D || out_size != SEQ * D || ws_size < WS_END) { fprintf(stderr, "kernel_launch: unexpected shapes (n_in %d, in0 %d, out %d, ws %zu, need %zu)\n", n_in, n_in > 0 ? in_sizes[0] : -1, out_size, ws_size, (size_t)WS_END); grid = -1; return; }
        int dev = 0, cus = 0, per_cu = 0;
        (void)hipGetDevice(&dev); (void)hipDeviceGetAttribute(&cus, hipDeviceAttributeMultiprocessorCount, dev);
        if (hipOccupancyMaxActiveBlocksPerMultiprocessor(&per_cu, (const void*)fwd_kernel, NTHREADS, 0) != hipSuccess || per_cu < 1) { fprintf(stderr, "kernel_launch: occupancy query says %d blocks per CU\n", per_cu); per_cu = 1; }
        (void)hipGetLastError();
        grid = cus;
        if (grid % 8 != 0 || grid < 64) { fprintf(stderr, "kernel_launch: unexpected CU count %d\n", cus); }
    }
    if (grid < 0) return;
    if (hipMemsetAsync((char*)d_ws + WS_CTL, 0, CTL_BYTES, stream) != hipSuccess) { fprintf(stderr, "kernel_launch: memset failed\n"); return; }
    Params p{};
    const float** pp = (const float**)&p;
    for (int i = 0; i < 17; ++i) pp[i] = (const float*)d_in[i];
    p.out = (float*)d_out; p.ws = (unsigned char*)d_ws;
#if MODE == 0
    for (int ph = 0; ph < NPHASE; ++ph) { p.ph_lo = ph; p.ph_hi = ph + 1; hipLaunchKernelGGL(fwd_kernel, dim3(grid), dim3(NTHREADS), 0, stream, p); }
#else
    p.ph_lo = 0; p.ph_hi = NPHASE;
    void* args[] = {&p};
    hipError_t e = hipLaunchCooperativeKernel((const void*)fwd_kernel, dim3(grid), dim3(NTHREADS), args, 0, stream);
    if (e != hipSuccess) fprintf(stderr, "cooperative launch failed: %s (grid %d)\n", hipGetErrorString(e), grid);
#endif
}
```

```cpp
#include <hip/hip_runtime.h>
#include <cstdio>
#include <cstdint>

#ifndef MODE
#define MODE 1
#endif

#define LAS __attribute__((address_space(3)))
typedef _Float16 f16;
typedef _Float16 half8 __attribute__((ext_vector_type(8)));
typedef _Float16 half4 __attribute__((ext_vector_type(4)));
typedef float f32x2 __attribute__((ext_vector_type(2)));
typedef float f32x4 __attribute__((ext_vector_type(4)));
typedef float f32x16 __attribute__((ext_vector_type(16)));
typedef unsigned u32x2 __attribute__((ext_vector_type(2)));
typedef unsigned u32x4 __attribute__((ext_vector_type(4)));
typedef int i32x4 __attribute__((ext_vector_type(4)));
typedef __bf16 bf16x8 __attribute__((ext_vector_type(8)));

constexpr int D = 1024, SEQ = 16384, NMETA = 16, L = SEQ + NMETA, DFF = 2816;
constexpr int MP = 16640;
constexpr int LP = 16512;
constexpr int NIN = 3840;
constexpr int NCH = 257;
constexpr float EPS = 1e-6f;
constexpr int NTHREADS = 512;
constexpr int LDS_BYTES = 155648 + 1024;
constexpr int NPHASE = 12;

constexpr size_t al256(size_t x) { return (x + 255) & ~(size_t)255; }
constexpr size_t WS_CTL = 0;
constexpr size_t CTL_BYTES = 32768;
constexpr size_t WS_BAR = 2048;
constexpr size_t WS_WGU1 = CTL_BYTES;
constexpr size_t WS_WD1 = WS_WGU1 + (size_t)2 * DFF * D * 2;
constexpr size_t WS_WIN = WS_WD1 + (size_t)D * DFF * 2;
constexpr size_t WS_WOUT = WS_WIN + (size_t)NIN * D * 2;
constexpr size_t WS_WGU2 = WS_WOUT + (size_t)D * D * 2;
constexpr size_t WS_WD2 = WS_WGU2 + (size_t)2 * DFF * D * 2;
constexpr size_t WS_ACTA = WS_WD2 + (size_t)D * DFF * 2;
constexpr size_t WS_G = WS_ACTA + (size_t)MP * D * 2;
constexpr size_t WS_US = WS_G + (size_t)MP * DFF * 2;
constexpr size_t WS_DQ = WS_US + (size_t)NCH * 4 * 64 * 128 * 4;
constexpr size_t WS_IQ = WS_DQ + (size_t)LP * 512 * 2;
constexpr size_t WS_SEL = WS_IQ + (size_t)LP * 512 * 2;
constexpr size_t WS_ROPE = WS_SEL + (size_t)LP * 256 * 2;
constexpr size_t WS_IW = WS_ROPE + al256((size_t)L * 32 * 8);
constexpr size_t WS_GA = WS_IW + (size_t)LP * 8 * 4;
constexpr size_t WS_DECAY = WS_GA + (size_t)LP * 16 * 4;
constexpr size_t WS_SS0 = WS_DECAY + al256((size_t)NCH * 256 * 4);
constexpr size_t WS_SS1 = WS_SS0 + (size_t)MP * 4;
constexpr size_t WS_SS2 = WS_SS1 + (size_t)MP * 64;
constexpr size_t WS_SS3 = WS_SS2 + (size_t)MP * 64;
constexpr size_t WS_END = WS_SS3 + (size_t)MP * 64;
constexpr size_t WS_BL = WS_WGU1;
constexpr size_t WS_KV = WS_G;
constexpr size_t WS_GQ = WS_KV + (size_t)8 * LP * 128 * 2;
constexpr size_t WS_GK = WS_GQ + (size_t)LP * 256 * 2;
constexpr size_t WS_GV = WS_GK + (size_t)LP * 256 * 2;
constexpr size_t WS_GR = WS_GV + (size_t)LP * 512 * 2;
constexpr size_t WS_IK = WS_GR + (size_t)LP * 512 * 2;
constexpr size_t WS_ALIAS_END = WS_IK + (size_t)LP * 64 * 2;
static_assert(WS_ALIAS_END <= WS_US, "aliased buffers exceed G");
static_assert(WS_BL + (size_t)(NCH - 1) * 4 * 4096 * 4 <= WS_WOUT, "gate buffer exceeds the dead weight regions");
static_assert(WS_END <= (size_t)256 * 1024 * 1024, "workspace exceeds 256 MiB");
static_assert((size_t)SEQ * D * 2 <= (size_t)NCH * 4 * 64 * 128 * 4, "h2_16 alias");

struct Params {
    const float* x; const float* meta; const float* n1; const float* wg1; const float* wu1; const float* wd1;
    const float* nmix; const float* win; const float* wa2; const float* ba; const float* hn; const float* wout;
    const float* n2; const float* wg2; const float* wu2; const float* wd2; const float* nf;
    float* out; unsigned char* ws; int ph_lo, ph_hi;
};

namespace pg8 {
constexpr int BM = 256, BK = 64, HALF = 128, HTB = HALF * BK * 2, STAGE_BYTES = 8 * HTB, NXCD = 8, WGM = 8;
__host__ __device__ __forceinline__ int lds_byte(int r, int c) { const int st = (r >> 4) * 2 + (c >> 5), rr = r & 15, cc = c & 31, ob = rr * 64 + cc * 2; return st * 1024 + (ob ^ (((ob >> 9) & 1) << 5)); }
__host__ __device__ __forceinline__ int perm32(int rho) { const int n = rho >> 4, i = rho & 15; return 8 * (i >> 2) + 4 * n + (i & 3); }
__host__ __device__ __forceinline__ void stage_rc(int b, int& R, int& C) { const int st = b / 1024, sb = b % 1024, swz = sb ^ (((sb >> 9) & 1) << 5); R = (st >> 1) * 16 + swz / 64; C = (st & 1) * 32 + (swz % 64) / 2; }
struct Unit { int pm, pn; };
struct Gemm { const f16* A; const f16* Bt; int M, N, K; };
struct StaticOrder {
    int nM, nN, nwg, G, c;
    __host__ __device__ void init(int M, int N, int G_, int c_) { nM = M / BM; nN = N / BM; nwg = nM * nN; G = G_; c = c_; }
    __host__ __device__ bool next(int i, Unit& u) const {
        const long Lx = (long)i * G + c; if (Lx >= nwg) return false;
        int wgid = (int)Lx; { const int q = nwg / NXCD, r = nwg % NXCD, xcd = wgid % NXCD, off = wgid / NXCD; wgid = (xcd < r ? xcd * (q + 1) : r * (q + 1) + (xcd - r) * q) + off; }
        const int nig = WGM * nN, gid = wgid / nig, fm = gid * WGM, gsz = (nM - fm) < WGM ? (nM - fm) : WGM;
        u.pm = fm + ((wgid % nig) % gsz); u.pn = (wgid % nig) / gsz; return true;
    }
};
template <class Epi>
__device__ __forceinline__ void gemm_phase(LAS unsigned char* lds, const Gemm g, const StaticOrder& S, const Epi& E) {
    int tid_ = threadIdx.x; asm volatile("" : "+v"(tid_));
    const int tid = tid_, wid = __builtin_amdgcn_readfirstlane(tid >> 6), lane = tid & 63, wr = wid >> 2, wc = wid & 3, fr = lane & 15, fq = lane >> 4;
    const int K = g.K, nt = K / BK;
    unsigned voffA[2], voffB[2];
#pragma unroll
    for (int i = 0; i < 2; ++i) { int R, C; stage_rc(tid * 16 + i * 8192, R, C); const int Rb = (R & ~31) + perm32(R & 31); voffA[i] = (unsigned)(R * K + C) * 2u; voffB[i] = (unsigned)(Rb * K + C) * 2u; }
    const size_t kstep = (size_t)(BK * 2);
    const size_t hstep = (size_t)HALF * K * 2;
    const size_t tstep = 2 * hstep;
    const unsigned ldsw = (unsigned)wid * 1024u;
    const int aoff = lds_byte(wr * 64 + fr, fq * 8), boff = lds_byte(wc * 32 + fr, fq * 8);
#define PG8_SA(b, h) (((b) * 2 + (h)) * HTB)
#define PG8_SB(b, h) ((4 + (b) * 2 + (h)) * HTB)
#define PG8_STAGE(bufoff, gbase, voff) do { _Pragma("unroll") for (int _i = 0; _i < 2; ++_i) \
        __builtin_amdgcn_global_load_lds((const unsigned*)((const char*)(gbase) + (voff)[_i]), (LAS unsigned*)(lds + (bufoff) + ldsw + _i * 8192), 16, 0, 0); } while (0)
#define PG8_LDA(dst, b, h) do { _Pragma("unroll") for (int m = 0; m < 4; ++m) _Pragma("unroll") for (int k = 0; k < 2; ++k) dst[m][k] = *(const LAS half8*)(lds + PG8_SA(b, h) + aoff + m * 2048 + k * 1024); } while (0)
#define PG8_LDB(dst, b, h) do { _Pragma("unroll") for (int n = 0; n < 2; ++n) _Pragma("unroll") for (int k = 0; k < 2; ++k) dst[n][k] = *(const LAS half8*)(lds + PG8_SB(b, h) + boff + n * 2048 + k * 1024); } while (0)
#define PG8_MMA(ai, bj, At, Bt) do { __builtin_amdgcn_s_setprio(1); _Pragma("unroll") for (int m = 0; m < 4; ++m) _Pragma("unroll") for (int n = 0; n < 2; ++n) _Pragma("unroll") for (int k = 0; k < 2; ++k) { \
        if constexpr (Epi::I8) acc[ai][bj][m][n] = __builtin_bit_cast(f32x4, __builtin_amdgcn_mfma_i32_16x16x64_i8(__builtin_bit_cast(i32x4, Bt[n][k]), __builtin_bit_cast(i32x4, At[m][k]), __builtin_bit_cast(i32x4, acc[ai][bj][m][n]), 0, 0, 0)); \
        else acc[ai][bj][m][n] = __builtin_amdgcn_mfma_f32_16x16x32_f16(Bt[n][k], At[m][k], acc[ai][bj][m][n], 0, 0, 0); } __builtin_amdgcn_s_setprio(0); } while (0)
#define PG8_WAIT_V(n) asm volatile("s_waitcnt vmcnt(" #n ")" ::: "memory")
#define PG8_WAIT_L(n) asm volatile("s_waitcnt lgkmcnt(" #n ")" ::: "memory")
#define PG8_BAR __builtin_amdgcn_s_barrier()
#define PG8_SCHED __builtin_amdgcn_sched_barrier(0)
    Unit cur, nxt; int ui = 0;
    if (!S.next(0, cur)) return;
    LAS float* rowbuf = (LAS float*)(lds + 8 * HTB);
    if constexpr (Epi::ROWF) {
        Unit uu;
#pragma unroll 1
        for (int j = 0; j < 16 && S.next(j, uu); ++j) { if (tid < 256) rowbuf[j * 256 + tid] = E.rowf(uu.pm * 256 + tid); }
        __syncthreads();
    }
    f32x4 acc[2][2][4][2];
#pragma unroll
    for (int a = 0; a < 2; ++a)
#pragma unroll
        for (int b = 0; b < 2; ++b)
#pragma unroll
            for (int m = 0; m < 4; ++m)
#pragma unroll
                for (int n = 0; n < 2; ++n) acc[a][b][m][n] = (f32x4){0.f, 0.f, 0.f, 0.f};
    half8 At[4][2], B0[2][2], B1[2][2];
    const char* cA = (const char*)g.A + (size_t)cur.pm * tstep; const char* cB = (const char*)g.Bt + (size_t)cur.pn * tstep;
    PG8_STAGE(PG8_SB(0, 0), cB, voffB); PG8_STAGE(PG8_SA(0, 0), cA, voffA); PG8_STAGE(PG8_SB(0, 1), cB + hstep, voffB); PG8_STAGE(PG8_SA(0, 1), cA + hstep, voffA);
    if (wr == 1) PG8_BAR;
    PG8_WAIT_V(4); PG8_BAR;
    PG8_STAGE(PG8_SB(1, 0), cB + kstep, voffB); PG8_STAGE(PG8_SA(1, 0), cA + kstep, voffA); PG8_STAGE(PG8_SB(1, 1), cB + hstep + kstep, voffB);
    PG8_WAIT_V(6); PG8_BAR;
    for (;;) {
        const bool has_next = S.next(ui + 1, nxt);
        const char* nA = has_next ? (const char*)g.A + (size_t)nxt.pm * tstep : cA; const char* nB = has_next ? (const char*)g.Bt + (size_t)nxt.pn * tstep : cB;
        const int tw = nt > 2 ? nt - 2 : 0;
        const bool rstg = Epi::RSTG && !has_next;
        const int ntl = rstg ? nt - 2 : nt;
        for (int t = 0; t < ntl; t += 2) {
            const bool last = (t == nt - 2);
            if constexpr (Epi::WARM) {
                if (t == tw) {
#pragma unroll
                    for (int i = 0; i < 2; ++i) __builtin_amdgcn_global_load_lds((const unsigned*)E.warm_addr(cur, wid * 128 + i * 64 + lane), (LAS unsigned*)(lds + 8 * HTB + wid * 2048 + i * 1024), 16, 0, 0);
                }
            }
            const char* a1 = cA + (size_t)(t + 1) * kstep;
            const char* a2 = last ? nA : cA + (size_t)(t + 2) * kstep; const char* b2 = last ? nB : cB + (size_t)(t + 2) * kstep;
            const char* a3 = a2 + kstep; const char* b3 = b2 + kstep;
            PG8_LDB(B0, 0, 0); PG8_SCHED; PG8_LDA(At, 0, 0); PG8_STAGE(PG8_SA(1, 1), a1 + hstep, voffA);
            PG8_WAIT_L(8); PG8_BAR; PG8_WAIT_L(0); PG8_MMA(0, 0, At, B0); PG8_BAR; PG8_SCHED;
            PG8_LDB(B1, 0, 1); PG8_STAGE(PG8_SB(0, 0), b2, voffB);
            PG8_BAR; PG8_WAIT_L(0); PG8_MMA(0, 1, At, B1); PG8_BAR;
            PG8_LDA(At, 0, 1); PG8_STAGE(PG8_SA(0, 0), a2, voffA);
            PG8_BAR; PG8_WAIT_L(0); PG8_MMA(1, 0, At, B0); PG8_BAR; PG8_SCHED;
            PG8_STAGE(PG8_SB(0, 1), b2 + hstep, voffB);
            PG8_WAIT_V(6); PG8_BAR; PG8_MMA(1, 1, At, B1); PG8_BAR;
            PG8_LDB(B0, 1, 0); PG8_SCHED; PG8_LDA(At, 1, 0); PG8_STAGE(PG8_SA(0, 1), a2 + hstep, voffA);
            PG8_WAIT_L(8); PG8_BAR; PG8_WAIT_L(0); PG8_MMA(0, 0, At, B0); PG8_BAR; PG8_SCHED;
            PG8_LDB(B1, 1, 1); PG8_STAGE(PG8_SB(1, 0), b3, voffB);
            PG8_BAR; PG8_WAIT_L(0); PG8_MMA(0, 1, At, B1); PG8_BAR;
            PG8_LDA(At, 1, 1); PG8_STAGE(PG8_SA(1, 0), a3, voffA);
            PG8_BAR; PG8_WAIT_L(0); PG8_MMA(1, 0, At, B0); PG8_BAR; PG8_SCHED;
            PG8_STAGE(PG8_SB(1, 1), b3 + hstep, voffB);
            PG8_WAIT_V(6); PG8_BAR; PG8_MMA(1, 1, At, B1); PG8_BAR;
        }
        if constexpr (Epi::RSTG) { if (rstg) {
#define PG8_RSTAGE(bufoff, c) do { _Pragma("unroll") for (int _i = 0; _i < 2; ++_i) \
        __builtin_amdgcn_global_load_lds((const unsigned*)E.res_addr(cur, 2 * (c) + _i, wr, wc, fr, fq), (LAS unsigned*)(lds + (bufoff) + ldsw + _i * 8192), 16, 0, 0); } while (0)
            const char* a1 = cA + (size_t)(nt - 1) * kstep;
            PG8_LDB(B0, 0, 0); PG8_SCHED; PG8_LDA(At, 0, 0); PG8_STAGE(PG8_SA(1, 1), a1 + hstep, voffA);
            PG8_WAIT_L(8); PG8_BAR; PG8_WAIT_L(0); PG8_MMA(0, 0, At, B0); PG8_BAR; PG8_SCHED;
            PG8_LDB(B1, 0, 1); PG8_RSTAGE(PG8_SB(0, 0), 0);
            PG8_BAR; PG8_WAIT_L(0); PG8_MMA(0, 1, At, B1); PG8_BAR;
            PG8_LDA(At, 0, 1); PG8_RSTAGE(PG8_SA(0, 0), 1);
            PG8_BAR; PG8_WAIT_L(0); PG8_MMA(1, 0, At, B0); PG8_BAR; PG8_SCHED;
            PG8_RSTAGE(PG8_SB(0, 1), 2);
            PG8_WAIT_V(6); PG8_BAR; PG8_MMA(1, 1, At, B1); PG8_BAR;
            PG8_LDB(B0, 1, 0); PG8_SCHED; PG8_LDA(At, 1, 0); PG8_RSTAGE(PG8_SA(0, 1), 3);
            PG8_WAIT_L(8); PG8_BAR; PG8_WAIT_L(0); PG8_MMA(0, 0, At, B0); PG8_BAR; PG8_SCHED;
            PG8_LDB(B1, 1, 1); PG8_RSTAGE(PG8_SB(1, 0), 4);
            PG8_BAR; PG8_WAIT_L(0); PG8_MMA(0, 1, At, B1); PG8_BAR;
            PG8_LDA(At, 1, 1); PG8_RSTAGE(PG8_SA(1, 0), 5);
            PG8_BAR; PG8_WAIT_L(0); PG8_MMA(1, 0, At, B0); PG8_BAR; PG8_SCHED;
            PG8_RSTAGE(PG8_SB(1, 1), 6);
            PG8_WAIT_V(6); PG8_BAR; PG8_MMA(1, 1, At, B1); PG8_BAR;
            PG8_WAIT_V(0);
#undef PG8_RSTAGE
        } }
        if constexpr (Epi::I8) {
#pragma unroll
            for (int a = 0; a < 2; ++a)
#pragma unroll
                for (int b = 0; b < 2; ++b)
#pragma unroll
                    for (int m = 0; m < 4; ++m)
#pragma unroll
                        for (int n = 0; n < 2; ++n) { const i32x4 v = __builtin_bit_cast(i32x4, acc[a][b][m][n]); acc[a][b][m][n] = (f32x4){(float)v[0], (float)v[1], (float)v[2], (float)v[3]}; }
        }
        E(acc, cur, wr, wc, fr, fq, rowbuf + ui * 256, (Epi::RSTG && rstg) ? (const LAS unsigned char*)(lds + ldsw + lane * 16) : (const LAS unsigned char*)nullptr);
        if (!has_next) break;
#pragma unroll
        for (int a = 0; a < 2; ++a)
#pragma unroll
            for (int b = 0; b < 2; ++b)
#pragma unroll
                for (int m = 0; m < 4; ++m)
#pragma unroll
                    for (int n = 0; n < 2; ++n) acc[a][b][m][n] = (f32x4){0.f, 0.f, 0.f, 0.f};
        cur = nxt; cA = nA; cB = nB; ++ui;
    }
    PG8_WAIT_V(0);
    if (wr == 0) PG8_BAR;
    PG8_BAR;
#undef PG8_SA
#undef PG8_SB
#undef PG8_STAGE
#undef PG8_LDA
#undef PG8_LDB
#undef PG8_MMA
#undef PG8_WAIT_V
#undef PG8_WAIT_L
#undef PG8_BAR
#undef PG8_SCHED
}
}

__device__ __forceinline__ float silu_f(float v) { return v * __builtin_amdgcn_rcpf(1.0f + __expf(-v)); }
__device__ __forceinline__ half4 to_half4(f32x4 v) { half4 h; h[0] = (f16)v[0]; h[1] = (f16)v[1]; h[2] = (f16)v[2]; h[3] = (f16)v[3]; return h; }

__device__ __forceinline__ float row_rstd(const float* ss, int np, int row) {
    float s;
    if (np == 1) s = ss[row];
    else { const f32x4* p = (const f32x4*)(ss + (size_t)row * 16); const f32x4 a = p[0], b = p[1], c = p[2], d = p[3];
        s = (((a[0] + a[1]) + (a[2] + a[3])) + ((b[0] + b[1]) + (b[2] + b[3]))) + (((c[0] + c[1]) + (c[2] + c[3])) + ((d[0] + d[1]) + (d[2] + d[3]))); }
    return rsqrtf(s * (1.0f / D) + EPS);
}
template <bool I8_> struct EpiSwiglu {
    static constexpr bool I8 = I8_, ROWF = I8_, WARM = false, RSTG = false;
    __device__ __forceinline__ float rowf(int row) const { return sa[row]; }
    f16* G; const float* ss; int np; const float* sa; const float* sw;
    __device__ __forceinline__ void operator()(const f32x4 (&acc)[2][2][4][2], const pg8::Unit& u, int wr, int wc, int fr_, int fq_, const LAS float* rf, const LAS unsigned char* rl) const {
        int fr = fr_, fq = fq_; asm volatile("" : "+v"(fr), "+v"(fq));
        f32x4 swg[2], swu[2];
        if constexpr (I8) {
#pragma unroll
            for (int n = 0; n < 2; ++n) { swg[n] = *(const f32x4*)(sw + u.pn * 256 + wc * 32 + 8 * fq + 4 * n); swu[n] = *(const f32x4*)(sw + u.pn * 256 + 128 + wc * 32 + 8 * fq + 4 * n); }
        }
#pragma unroll
        for (int ai = 0; ai < 2; ++ai)
#pragma unroll
            for (int m = 0; m < 4; ++m) {
                const int row = u.pm * 256 + ai * 128 + wr * 64 + m * 16 + fr;
                float rs; if constexpr (I8) rs = rf[row - u.pm * 256]; else rs = row_rstd(ss, np, row);
                const float ce = -1.4426950408889634f * rs, rs2 = rs * rs; half8 o;
#pragma unroll
                for (int n = 0; n < 2; ++n) {
                    f32x4 g = acc[ai][0][m][n], u = acc[ai][1][m][n];
                    if constexpr (I8) { g = g * swg[n]; u = u * swu[n]; }
                    const f32x4 t = g * ce; f32x4 e, r;
#pragma unroll
                    for (int j = 0; j < 4; ++j) e[j] = __builtin_amdgcn_exp2f(t[j]);
                    const f32x4 d = e + 1.0f;
#pragma unroll
                    for (int j = 0; j < 4; ++j) r[j] = __builtin_amdgcn_rcpf(d[j]);
                    const f32x4 w = (g * u) * (r * rs2);
#pragma unroll
                    for (int j = 0; j < 4; ++j) o[4 * n + j] = (f16)w[j];
                }
                *(half8*)(G + (size_t)row * DFF + u.pn * 128 + wc * 32 + 8 * fq) = o;
            }
    }
};
template <bool SRC16, bool STATS = true> struct EpiResid {
    static constexpr bool I8 = false, ROWF = false, WARM = SRC16;
    static constexpr bool RSTG = SRC16;
    __device__ __forceinline__ const void* res_addr(const pg8::Unit& u, int k, int wr, int wc, int fr, int fq) const {
        return (const f16*)src + (size_t)(u.pm * 256 + (k >> 3) * 128 + wr * 64 + ((k >> 1) & 3) * 16 + fr) * D + u.pn * 256 + (k & 1) * 128 + wc * 32 + 8 * fq; }
    __device__ __forceinline__ const void* warm_addr(const pg8::Unit& u, int l) const { return (const f16*)src + (size_t)(u.pm * 256 + (l >> 2)) * D + u.pn * 256 + (l & 3) * 64; }
    const void* src; f16* h16; float* ss; float alpha;
    __device__ __forceinline__ void operator()(const f32x4 (&acc)[2][2][4][2], const pg8::Unit& u, int wr, int wc, int fr_, int fq_, const LAS float* rf, const LAS unsigned char* rl) const {
        int fr = fr_, fq = fq_; asm volatile("" : "+v"(fr), "+v"(fq));
#pragma unroll
        for (int ai = 0; ai < 2; ++ai)
#pragma unroll
            for (int m = 0; m < 4; ++m) {
                const int row = u.pm * 256 + ai * 128 + wr * 64 + m * 16 + fr; float part = 0.f;
#pragma unroll
                for (int bj = 0; bj < 2; ++bj) {
                    const size_t off = (size_t)row * D + u.pn * 256 + bj * 128 + wc * 32 + 8 * fq; half8 h; f32x4 sv[2];
                    if (SRC16) { const int k_ = (ai * 4 + m) * 2 + bj; constexpr int bo_[7] = {4, 0, 5, 1, 6, 2, 7};
                        const half8 s8 = (rl && k_ < 14) ? *(const LAS half8*)(rl + bo_[k_ >> 1 < 7 ? k_ >> 1 : 0] * pg8::HTB + (k_ & 1) * 8192) : *(const half8*)((const f16*)src + off);
#pragma unroll
                        for (int j = 0; j < 4; ++j) { sv[0][j] = (float)s8[j]; sv[1][j] = (float)s8[4 + j]; } }
                    else { sv[0] = *(const f32x4*)((const float*)src + off); sv[1] = *(const f32x4*)((const float*)src + off + 4); }
#pragma unroll
                    for (int n = 0; n < 2; ++n) {
                        const f32x4 o = sv[n] + alpha * acc[ai][bj][m][n];
#pragma unroll
                        for (int j = 0; j < 4; ++j) h[4 * n + j] = (f16)o[j];
                        if (STATS) part += (o[0] * o[0] + o[1] * o[1]) + (o[2] * o[2] + o[3] * o[3]);
                    }
                    *(half8*)(h16 + off) = h;
                }
                if (STATS) { part += __shfl_xor(part, 16); part += __shfl_xor(part, 32);
                    if (fq == 0) ss[(size_t)row * 16 + u.pn * 4 + wc] = part; }
            }
    }
};
constexpr float K_I8_SCALE = 127.0f / 8.0f;
__device__ __forceinline__ void rope8(const f32x4 (&x1)[2], const f32x4 (&x2)[2], const f32x2* rp, float sc, float (&o1)[8], float (&o2)[8]) {
#pragma unroll
    for (int n = 0; n < 2; ++n) {
        const f32x4 cs0 = *(const f32x4*)(rp + 4 * n), cs1 = *(const f32x4*)(rp + 4 * n + 2);
        o1[4 * n + 0] = (x1[n][0] * cs0[0] - x2[n][0] * cs0[1]) * sc; o2[4 * n + 0] = (x2[n][0] * cs0[0] + x1[n][0] * cs0[1]) * sc;
        o1[4 * n + 1] = (x1[n][1] * cs0[2] - x2[n][1] * cs0[3]) * sc; o2[4 * n + 1] = (x2[n][1] * cs0[2] + x1[n][1] * cs0[3]) * sc;
        o1[4 * n + 2] = (x1[n][2] * cs1[0] - x2[n][2] * cs1[1]) * sc; o2[4 * n + 2] = (x2[n][2] * cs1[0] + x1[n][2] * cs1[1]) * sc;
        o1[4 * n + 3] = (x1[n][3] * cs1[2] - x2[n][3] * cs1[3]) * sc; o2[4 * n + 3] = (x2[n][3] * cs1[2] + x1[n][3] * cs1[3]) * sc;
    }
}
__device__ __forceinline__ u32x2 pack_i8x8(const float (&v)[8]) {
    u32x2 r;
#pragma unroll
    for (int w = 0; w < 2; ++w) { unsigned word = 0u;
#pragma unroll
        for (int j = 0; j < 4; ++j) { const int q = (int)__builtin_rintf(fminf(fmaxf(v[4 * w + j] * K_I8_SCALE, -127.f), 127.f)); word |= ((unsigned)q & 0xffu) << (8 * j); }
        r[w] = word; }
    return r;
}
__device__ __forceinline__ u32x2 pack_bf8x8(const float (&v)[8]) {
    u32x2 r;
#pragma unroll
    for (int w = 0; w < 2; ++w) { int word = __builtin_amdgcn_cvt_pk_bf8_f32(v[4 * w], v[4 * w + 1], 0, false); word = __builtin_amdgcn_cvt_pk_bf8_f32(v[4 * w + 2], v[4 * w + 3], word, true); r[w] = (unsigned)word; }
    return r;
}
struct EpiInProj {
    static constexpr bool I8 = false, ROWF = true, WARM = false, RSTG = false;
    __device__ __forceinline__ float rowf(int row) const { return row_rstd(ss, 16, row); }
    const float* ss; const f32x2* rope; unsigned char* ws;
    __device__ __forceinline__ void operator()(const f32x4 (&acc)[2][2][4][2], const pg8::Unit& u, int wr, int wc, int fr_, int fq_, const LAS float* rf, const LAS unsigned char* rl) const {
        int fr = fr_, fq = fq_; asm volatile("" : "+v"(fr), "+v"(fq));
        const int pn = u.pn;
        if (pn >= 8 && pn <= 11) {
            unsigned char* lb = (pn <= 9) ? ws + WS_KV + (size_t)((pn - 8) * 4 + wc) * LP * 128 + 8 * fq
                                          : ws + WS_KV + (size_t)((pn - 10) * 4 + (wc >> 1)) * LP * 128 + 64 + (wc & 1) * 32 + 8 * fq;
#pragma unroll
            for (int ai = 0; ai < 2; ++ai)
#pragma unroll
                for (int m = 0; m < 4; ++m) {
                    const int p = u.pm * 256 + ai * 128 + wr * 64 + m * 16 + fr;
                    const int t = p < SEQ ? p + NMETA : p - SEQ;
                    if (p < L) {
                        const float sc = rf[p - u.pm * 256];
                        if (pn <= 9) {
                            float o1[8], o2[8]; rope8(acc[ai][0][m], acc[ai][1][m], rope + (size_t)t * 32 + 8 * fq, sc, o1, o2);
                            unsigned char* d8 = lb + (size_t)t * 128; *(u32x2*)d8 = pack_i8x8(o1); *(u32x2*)(d8 + 32) = pack_i8x8(o2);
                        } else {
#pragma unroll
                            for (int bj = 0; bj < 2; ++bj) { float v[8];
#pragma unroll
                                for (int j = 0; j < 4; ++j) { v[j] = acc[ai][bj][m][0][j] * sc; v[4 + j] = acc[ai][bj][m][1][j] * sc; }
                                *(u32x2*)(lb + (size_t)t * 128 + (size_t)bj * 2 * LP * 128) = pack_bf8x8(v); }
                        }
                    }
                    asm volatile("" ::: "memory");
                }
            return;
        }
        int mode = 0, stride = 256; float scale = 1.0f; f16* lanebase;
        if (pn == 0) lanebase = (f16*)(ws + WS_GQ) + wc * 32 + 8 * fq;
        else if (pn == 1) lanebase = (f16*)(ws + WS_GK) + wc * 32 + 8 * fq;
        else if (pn <= 3) { lanebase = (f16*)(ws + WS_GV) + (pn - 2) * 256 + wc * 32 + 8 * fq; stride = 512; }
        else if (pn <= 5) { lanebase = (f16*)(ws + WS_GR) + (pn - 4) * 256 + wc * 32 + 8 * fq; stride = 512; }
        else if (pn <= 7) { lanebase = (f16*)(ws + WS_DQ); mode = 6; scale = 0.125f; }
        else if (pn <= 13) { lanebase = (f16*)(ws + WS_IQ) + (pn - 12) * 256 + wc * 64 + 8 * fq; stride = 512; mode = 1; scale = 0.125f; }
        else { lanebase = (f16*)(ws + WS_IK) + 8 * fq; stride = 64; mode = wc == 0 ? 1 : (wc == 1 ? 2 : 3); }
#pragma unroll
        for (int ai = 0; ai < 2; ++ai)
#pragma unroll
            for (int m = 0; m < 4; ++m) {
                const int p = u.pm * 256 + ai * 128 + wr * 64 + m * 16 + fr;
                const int t = p < SEQ ? p + NMETA : p - SEQ;
                if (p < L && mode != 3) {
                    const float rs = rf[p - u.pm * 256];
                    if (mode == 6) {
                        float o1[8], o2[8]; rope8(acc[ai][0][m], acc[ai][1][m], rope + (size_t)t * 32 + 8 * fq, rs * scale, o1, o2);
                        float qm = 1e-20f;
#pragma unroll
                        for (int j = 0; j < 8; ++j) qm = fmaxf(qm, fmaxf(fabsf(o1[j]), fabsf(o2[j])));
                        qm = fmaxf(qm, __shfl_xor(qm, 16)); qm = fmaxf(qm, __shfl_xor(qm, 32));
                        const float qsc = 127.0f * __builtin_amdgcn_rcpf(qm); u32x2 w1, w2;
#pragma unroll
                        for (int w = 0; w < 2; ++w) { unsigned a = 0u, b = 0u;
#pragma unroll
                            for (int j = 0; j < 4; ++j) { a |= ((unsigned)(int)__builtin_rintf(o1[4 * w + j] * qsc) & 0xffu) << (8 * j); b |= ((unsigned)(int)__builtin_rintf(o2[4 * w + j] * qsc) & 0xffu) << (8 * j); }
                            w1[w] = a; w2[w] = b; }
                        const int head = (pn - 6) * 4 + wc; unsigned char* qrow = ws + WS_DQ + (size_t)t * 512 + head * 64 + 8 * fq;
                        *(u32x2*)qrow = w1; *(u32x2*)(qrow + 32) = w2;
                        if (fq == 0) ((float*)(ws + WS_DQ + (size_t)LP * 512))[(size_t)t * 8 + head] = qm * (1.0f / (127.0f * K_I8_SCALE));
                    } else if (mode == 1) {
                        float o1[8], o2[8]; rope8(acc[ai][0][m], acc[ai][1][m], rope + (size_t)t * 32 + 8 * fq, rs * scale, o1, o2);
                        half8 h1, h2;
#pragma unroll
                        for (int j = 0; j < 8; ++j) { h1[j] = (f16)o1[j]; h2[j] = (f16)o2[j]; }
                        f16* dst = lanebase + (size_t)t * stride; *(half8*)dst = h1; *(half8*)(dst + 32) = h2;
                    } else if (mode == 2) {
                        if (fq < 2) { float* gp = (float*)(ws + WS_GA) + (size_t)t * 16 + 8 * fq; *(f32x4*)gp = acc[ai][0][m][0] * rs; *(f32x4*)(gp + 4) = acc[ai][0][m][1] * rs; }
                        else if (fq == 2) { float* ip = (float*)(ws + WS_IW) + (size_t)t * 8; const float r2 = rs * 0.35355339059327373f; *(f32x4*)ip = acc[ai][0][m][0] * r2; *(f32x4*)(ip + 4) = acc[ai][0][m][1] * r2; }
                    } else {
#pragma unroll
                        for (int bj = 0; bj < 2; ++bj) { half8 h;
#pragma unroll
                            for (int j = 0; j < 4; ++j) { h[j] = (f16)(acc[ai][bj][m][0][j] * rs); h[4 + j] = (f16)(acc[ai][bj][m][1][j] * rs); }
                            *(half8*)(lanebase + (size_t)t * stride + bj * 128) = h; }
                    }
                }
                asm volatile("" ::: "memory");
            }
    }
};

__device__ __forceinline__ const float* w_src(const Params& P, int kind, int n, int& ld, const float*& gain) {
    switch (kind) {
    case 0: case 4: { const int pn = n >> 8, bj = (n >> 7) & 1, cc = n & 127; ld = DFF; gain = kind == 0 ? P.n1 : P.n2;
        const float* w = kind == 0 ? (bj ? P.wu1 : P.wg1) : (bj ? P.wu2 : P.wg2); return w + pn * 128 + cc; }
    case 1: ld = D; gain = nullptr; return P.wd1 + n;
    case 5: ld = D; gain = nullptr; return P.wd2 + n;
    case 3: ld = D; gain = nullptr; return P.wout + n;
    default: { ld = 3672; gain = P.nmix; const int pn = n >> 8, c = n & 255, bj = c >> 7, hh = (c >> 5) & 3, dd = c & 31; int j;
        if (pn == 0) j = c; else if (pn == 1) j = 256 + c; else if (pn <= 3) j = 512 + (pn - 2) * 256 + c; else if (pn <= 5) j = 1024 + (pn - 4) * 256 + c;
        else if (pn <= 7) j = 1552 + (pn - 6) * 256 + hh * 64 + bj * 32 + dd;
        else if (pn <= 9) j = 2064 + (pn - 8) * 256 + hh * 64 + bj * 32 + dd;
        else if (pn <= 11) j = 2576 + (pn - 10) * 256 + c;
        else if (pn <= 13) j = 3088 + (pn - 12) * 256 + hh * 64 + bj * 32 + dd;
        else { if (c < 32) j = 3600 + c; else if (c < 48) j = 1536 + (c - 32); else if (c < 56) j = 3664 + (c - 48); else if (c >= 128 && c < 160) j = 3600 + 32 + (c - 128); else j = -1; }
        return j < 0 ? nullptr : P.win + j; }
    }
}
__device__ __forceinline__ void prep_weight(const Params& P, const int kind, const int N, const int K, f16* dst, int& cursor, int& tbase, LAS f16* tl, const int G) {
    const int tid = threadIdx.x, tn = N / 64, tk = K / 256, ntile = tn * tk;
    const int n = tid & 63, kk0 = tid >> 6;
    float v[32], vn[32];
#define PREP_LOAD(dstv, tI) do { const int n0_ = ((tI) % tn) * 64, k0_ = ((tI) / tn) * 256; int ld; const float* gain; const float* col = w_src(P, kind, n0_ + n, ld, gain); \
        _Pragma("unroll") for (int i = 0; i < 32; ++i) dstv[i] = col ? col[(size_t)(k0_ + kk0 + 8 * i) * ld] : 0.f; \
        if (gain) { _Pragma("unroll") for (int i = 0; i < 32; ++i) dstv[i] *= gain[k0_ + kk0 + 8 * i]; } } while (0)
    if (cursor < tbase + ntile) PREP_LOAD(v, cursor - tbase);
#pragma unroll 1
    for (; cursor < tbase + ntile; cursor += G) {
        const int tI = cursor - tbase, n0 = (tI % tn) * 64, k0 = (tI / tn) * 256;
        const bool more = cursor + G < tbase + ntile;
        if (more) PREP_LOAD(vn, tI + G);
#pragma unroll
        for (int i = 0; i < 32; ++i) tl[n * 264 + kk0 + 8 * i] = (f16)v[i];
        __syncthreads();
        { const int nr = tid >> 3, seg = tid & 7;
#pragma unroll
          for (int j = 0; j < 4; ++j) *(half8*)(dst + (size_t)(n0 + nr) * K + k0 + (seg + 8 * j) * 8) = *(const LAS half8*)(tl + nr * 264 + (seg + 8 * j) * 8); }
        __syncthreads();
        if (more) {
#pragma unroll
            for (int i = 0; i < 32; ++i) v[i] = vn[i];
        }
    }
#undef PREP_LOAD
    tbase += ntile;
}
__device__ __forceinline__ void prep_weight_i8(const Params& P, const int kind, const int N, unsigned char* dst, float* sw, int first, int step, LAS unsigned char* lds) {
    const int tid = threadIdx.x, n = tid & 63, kk0 = tid >> 6;
    LAS float* pmax = (LAS float*)lds; LAS unsigned* img = (LAS unsigned*)(lds + 2048);
#pragma unroll 1
    for (int task = first; task < N / 64; task += step) {
        const int n0 = task * 64; int ld; const float* gain; const float* col = w_src(P, kind, n0 + n, ld, gain);
        float v[128]; float mx = 0.f;
#pragma unroll
        for (int i = 0; i < 128; ++i) v[i] = col ? col[(size_t)(kk0 * 128 + i) * ld] : 0.f;
        if (gain) {
#pragma unroll
            for (int i = 0; i < 128; ++i) v[i] *= gain[kk0 * 128 + i];
        }
#pragma unroll
        for (int i = 0; i < 128; ++i) mx = fmaxf(mx, fabsf(v[i]));
        pmax[kk0 * 64 + n] = mx;
        __syncthreads();
#pragma unroll
        for (int q = 0; q < 8; ++q) mx = fmaxf(mx, pmax[q * 64 + n]);
        const float sc = mx > 0.f ? 127.0f / mx : 0.f;
        if (kk0 == 0) sw[n0 + n] = mx * (1.0f / 127.0f);
#pragma unroll
        for (int w = 0; w < 32; ++w) { unsigned word = 0u;
#pragma unroll
            for (int j = 0; j < 4; ++j) word |= ((unsigned)(int)__builtin_rintf(v[4 * w + j] * sc) & 0xffu) << (8 * j);
            img[n * 260 + kk0 * 32 + w] = word; }
        __syncthreads();
        { const int nr = tid >> 3, seg = tid & 7;
#pragma unroll
          for (int j = 0; j < 8; ++j) *(u32x4*)(dst + (size_t)(n0 + nr) * D + (seg + 8 * j) * 16) = *(const LAS u32x4*)(img + nr * 260 + (seg + 8 * j) * 4); }
        __syncthreads();
    }
}
__device__ __forceinline__ void quant_rows_i8(const f16* src, unsigned char* dst, float* sa, int rows) {
    const int tid = threadIdx.x, lane = tid & 63, gw = blockIdx.x * 8 + (tid >> 6), nw = gridDim.x * 8;
    for (int r = gw; r < rows; r += nw) {
        const half8 a = *(const half8*)(src + (size_t)r * D + lane * 16), b = *(const half8*)(src + (size_t)r * D + lane * 16 + 8);
        float v[16], mx = 0.f, sq = 0.f;
#pragma unroll
        for (int j = 0; j < 8; ++j) { v[j] = (float)a[j]; v[8 + j] = (float)b[j]; }
#pragma unroll
        for (int j = 0; j < 16; ++j) { mx = fmaxf(mx, fabsf(v[j])); sq = __builtin_fmaf(v[j], v[j], sq); }
#pragma unroll
        for (int o = 32; o >= 1; o >>= 1) { mx = fmaxf(mx, __shfl_xor(mx, o)); sq += __shfl_xor(sq, o); }
        const float sc = mx > 0.f ? 127.0f / mx : 0.f; u32x4 w;
#pragma unroll
        for (int q = 0; q < 4; ++q) { unsigned word = 0u;
#pragma unroll
            for (int j = 0; j < 4; ++j) word |= ((unsigned)(int)__builtin_rintf(v[4 * q + j] * sc) & 0xffu) << (8 * j);
            w[q] = word; }
        *(u32x4*)(dst + (size_t)r * D + lane * 16) = w;
        if (lane == 0) sa[r] = mx * (1.0f / 127.0f) * rsqrtf(sq * (1.0f / D) + EPS);
    }
}
__device__ __forceinline__ void p0_prologue(const Params& P, LAS unsigned char* lds) {
    const int tid = threadIdx.x, bid = blockIdx.x, G = gridDim.x, lane = tid & 63;
    unsigned char* ws = P.ws;
    LAS f16* tl = (LAS f16*)lds;
    {
        constexpr int NI8 = 2 * DFF / 64; const int nI = G > 2 * NI8 ? NI8 : 0;
        if (bid >= G - nI || nI == 0) prep_weight_i8(P, 0, 2 * DFF, ws + WS_WGU1, (float*)(ws + WS_WGU1 + (size_t)2 * DFF * D), nI ? bid - (G - nI) : bid, nI ? nI : G, lds);
        if (bid < G - nI) { int tbase = 0, cursor = bid; __syncthreads();
            prep_weight(P, 1, D, DFF, (f16*)(ws + WS_WD1), cursor, tbase, tl, G - nI);
            prep_weight(P, 2, NIN, D, (f16*)(ws + WS_WIN), cursor, tbase, tl, G - nI); }
    }
    f16* acta = (f16*)(ws + WS_ACTA);
    const int gw = bid * 8 + (tid >> 6), nw = G * 8;
    unsigned char* x8 = ws + WS_US; float* sa0 = (float*)(ws + WS_IQ);
    for (int p = gw; p < L; p += nw) {
        const float* src = p < SEQ ? P.x + (size_t)p * D : P.meta + (size_t)(p - SEQ) * D; float s = 0.f, mx = 0.f; f32x4 v[4];
#pragma unroll
        for (int i = 0; i < 4; ++i) { v[i] = *(const f32x4*)(src + lane * 4 + 256 * i); s += (v[i][0] * v[i][0] + v[i][1] * v[i][1]) + (v[i][2] * v[i][2] + v[i][3] * v[i][3]);
            mx = fmaxf(fmaxf(mx, fmaxf(fabsf(v[i][0]), fabsf(v[i][1]))), fmaxf(fabsf(v[i][2]), fabsf(v[i][3]))); *(half4*)(acta + (size_t)p * D + lane * 4 + 256 * i) = to_half4(v[i]); }
#pragma unroll
        for (int o = 32; o >= 1; o >>= 1) { s += __shfl_xor(s, o); mx = fmaxf(mx, __shfl_xor(mx, o)); }
        const float sc = mx > 0.f ? 127.0f / mx : 0.f;
#pragma unroll
        for (int i = 0; i < 4; ++i) { unsigned word = 0u;
#pragma unroll
            for (int j = 0; j < 4; ++j) word |= ((unsigned)(int)__builtin_rintf(v[i][j] * sc) & 0xffu) << (8 * j);
            *(unsigned*)(x8 + (size_t)p * D + lane * 4 + 256 * i) = word; }
        if (lane == 0) sa0[p] = mx * (1.0f / 127.0f) * rsqrtf(s * (1.0f / D) + EPS);
    }
    const int gt = bid * NTHREADS + tid, ngt = G * NTHREADS;
    for (int i = gt; i < MP; i += ngt) { if (i >= L) sa0[i] = 0.f; }
    f32x2* rope = (f32x2*)(ws + WS_ROPE);
    for (int i = gt; i < L * 32; i += ngt) { const int t = i >> 5, f = i & 31; const double inv = exp(-(double)f * (9.210340371976184 / 32.0)); double sn, cs; sincos((double)t * inv, &sn, &cs); rope[i] = (f32x2){(float)cs, (float)sn}; }
}

__device__ __forceinline__ void meta_down(const Params& P, LAS unsigned char* lds) {
    const int tid = threadIdx.x, lane = tid & 63, wid = tid >> 6;
    const f16* Gm = (const f16*)(P.ws + WS_G) + (size_t)SEQ * DFF; const f16* Wt = (const f16*)(P.ws + WS_WD1);
    f16* acta = (f16*)P.out; float* ss1 = (float*)(P.ws + WS_SS1); LAS float* slot = (LAS float*)lds;
    for (int task = blockIdx.x; task < NMETA * 16; task += gridDim.x) {
        const int r = task >> 4, cg = task & 15; float part = 0.f;
#pragma unroll 1
        for (int q = 0; q < 2; ++q) {
            const int n0 = cg * 64 + (2 * wid + q) * 4; float a[4] = {0.f, 0.f, 0.f, 0.f};
            {
                constexpr int NI = (DFF / 8 + 63) / 64; half8 gv[NI], wv[4][NI];
#pragma unroll
                for (int i = 0; i < NI; ++i) { const int kc = lane + 64 * i; const bool v = kc < DFF / 8; const int kk = v ? kc : 0;
                    gv[i] = *(const half8*)(Gm + (size_t)r * DFF + kk * 8);
#pragma unroll
                    for (int j = 0; j < 4; ++j) wv[j][i] = *(const half8*)(Wt + (size_t)(n0 + j) * DFF + kk * 8);
                    if (!v) {
#pragma unroll
                        for (int e = 0; e < 8; ++e) gv[i][e] = (f16)0.f; } }
#pragma unroll
                for (int i = 0; i < NI; ++i)
#pragma unroll
                    for (int j = 0; j < 4; ++j)
#pragma unroll
                        for (int e = 0; e < 8; ++e) a[j] += (float)gv[i][e] * (float)wv[j][i][e];
            }
#pragma unroll
            for (int o = 32; o >= 1; o >>= 1) { a[0] += __shfl_xor(a[0], o); a[1] += __shfl_xor(a[1], o); a[2] += __shfl_xor(a[2], o); a[3] += __shfl_xor(a[3], o); }
            f32x4 o;
#pragma unroll
            for (int j = 0; j < 4; ++j) { o[j] = P.meta[r * D + n0 + j] + 0.5f * a[j]; part += o[j] * o[j]; }
            if (lane == 0) *(half4*)(acta + (size_t)(SEQ + r) * D + n0) = to_half4(o);
        }
        if (lane == 0) slot[wid] = part;
        __syncthreads();
        if (tid == 0) { float s = 0.f; for (int w = 0; w < 8; ++w) s += slot[w]; ss1[(size_t)(SEQ + r) * 16 + cg] = s; }
        __syncthreads();
    }
}

__device__ __forceinline__ float logsigmoid_f(float z) { return fminf(z, 0.f) - __logf(1.0f + __expf(-fabsf(z))); }
__device__ __forceinline__ void gla_gates(const Params& P, int c, int h, LAS float* bl) {
    const int tid = threadIdx.x, ti = tid >> 3, d0 = (tid & 7) * 8, tt = 64 * c - 48 + ti; const float* GA = (const float*)(P.ws + WS_GA);
    {
        float z[8];
        if (tt >= 0 && tt < L) {
            const f32x4 b0 = *(const f32x4*)(P.ba + 64 * h + d0), b1 = *(const f32x4*)(P.ba + 64 * h + d0 + 4);
#pragma unroll
            for (int m = 0; m < 4; ++m) { z[m] = b0[m]; z[4 + m] = b1[m]; }
            f32x4 a4[4];
#pragma unroll
            for (int q = 0; q < 4; ++q) a4[q] = *(const f32x4*)(GA + (size_t)tt * 16 + 4 * q);
#pragma unroll
            for (int r = 0; r < 16; ++r) { const float ar = a4[r >> 2][r & 3]; const f32x4 w0 = *(const f32x4*)(P.wa2 + r * 256 + 64 * h + d0), w1 = *(const f32x4*)(P.wa2 + r * 256 + 64 * h + d0 + 4);
#pragma unroll
                for (int m = 0; m < 4; ++m) { z[m] += ar * w0[m]; z[4 + m] += ar * w1[m]; } }
#pragma unroll
            for (int m = 0; m < 8; ++m) z[m] = logsigmoid_f(z[m]) * (1.0f / 16.0f);
        } else {
#pragma unroll
            for (int m = 0; m < 8; ++m) z[m] = 0.f;
        }
#pragma unroll
        for (int m = 0; m < 8; ++m) bl[ti * 65 + d0 + m] = z[m];
    }
    __syncthreads();
    {
        const int d = tid & 63, seg = tid >> 6; float v[8], run = 0.f;
#pragma unroll
        for (int i = 0; i < 8; ++i) { run += bl[(seg * 8 + i) * 65 + d]; v[i] = run; }
#pragma unroll
        for (int i = 0; i < 8; ++i) bl[(seg * 8 + i) * 65 + d] = v[i];
        __syncthreads();
        float off = 0.f;
#pragma unroll
        for (int sg = 0; sg < 7; ++sg) off += (sg < seg) ? bl[(sg * 8 + 7) * 65 + d] : 0.f;
        __syncthreads();
#pragma unroll
        for (int i = 0; i < 8; ++i) bl[(seg * 8 + i) * 65 + d] = v[i] + off;
    }
    __syncthreads();
}
__device__ __forceinline__ void gla_a_unit(const Params& P, int unit, LAS unsigned char* lds) {
    int tid_ = threadIdx.x; asm volatile("" : "+v"(tid_));
    const int tid = tid_, lane = tid & 63, wid = tid >> 6, c = unit >> 2, h = unit & 3;
    LAS float* bl = (LAS float*)lds; LAS f16* ksT = (LAS f16*)(bl + 4160); LAS f16* vsT = ksT + 64 * 64;
    const f16* GK = (const f16*)(P.ws + WS_GK); const f16* GV = (const f16*)(P.ws + WS_GV);
    float* U = (float*)(P.ws + WS_US); float* DEC = (float*)(P.ws + WS_DECAY);
    const int ti = tid >> 3, d0 = (tid & 7) * 8, tt = 64 * c - 48 + ti; const bool tv = tt >= 0 && tt < L;
    half8 k8, v8[2];
#pragma unroll
    for (int m = 0; m < 8; ++m) { k8[m] = (f16)0.f; v8[0][m] = (f16)0.f; v8[1][m] = (f16)0.f; }
    if (tv) k8 = *(const half8*)(GK + (size_t)tt * 256 + 64 * h + d0);
#pragma unroll
    for (int q = 0; q < 2; ++q) { const int ch = tid + 512 * q, j = ch >> 4, t = 64 * c - 48 + j; if (t >= 0 && t < L) v8[q] = *(const half8*)(GV + (size_t)t * 512 + 128 * h + (ch & 15) * 8); }
    gla_gates(P, c, h, bl);
    { float* blg = (float*)(P.ws + WS_BL) + (size_t)unit * 4096 + ti * 64 + d0; f32x4 g0, g1;
#pragma unroll
      for (int m = 0; m < 4; ++m) { g0[m] = bl[ti * 65 + d0 + m]; g1[m] = bl[ti * 65 + d0 + 4 + m]; }
      *(f32x4*)blg = g0; *(f32x4*)(blg + 4) = g1; }
#pragma unroll
    for (int m = 0; m < 8; ++m) { const int d = d0 + m; ksT[d * 64 + (((ti >> 3) ^ ((d >> 2) & 7)) << 3) + (ti & 7)] = (f16)((float)k8[m] * __expf(bl[63 * 65 + d] - bl[ti * 65 + d])); }
#pragma unroll
    for (int q = 0; q < 2; ++q) { const int ch = tid + 512 * q, j = ch >> 4, e0 = (ch & 15) * 8;
#pragma unroll
        for (int m = 0; m < 8; ++m) { const int e = e0 + m; vsT[e * 64 + (((j >> 3) ^ ((e >> 2) & 7)) << 3) + (j & 7)] = v8[q][m]; } }
    if (tid < 64) DEC[(size_t)c * 256 + h * 64 + tid] = __expf(bl[63 * 65 + tid]);
    __syncthreads();
    { const int dd0 = (wid >> 2) * 32, e0 = (wid & 3) * 32, l31 = lane & 31, hf = lane >> 5; f32x16 acc;
#pragma unroll
      for (int i = 0; i < 16; ++i) acc[i] = 0.f;
      const int dr = dd0 + l31, er = e0 + l31;
#pragma unroll
      for (int s = 0; s < 4; ++s) acc = __builtin_amdgcn_mfma_f32_32x32x16_f16(*(const LAS half8*)(ksT + dr * 64 + (((2 * s + hf) ^ ((dr >> 2) & 7)) << 3)), *(const LAS half8*)(vsT + er * 64 + (((2 * s + hf) ^ ((er >> 2) & 7)) << 3)), acc, 0, 0, 0);
      float* up = U + ((size_t)unit * 64) * 128;
#pragma unroll
      for (int r = 0; r < 16; ++r) { const int row = (r & 3) + 8 * (r >> 2) + 4 * hf; up[(size_t)(dd0 + row) * 128 + e0 + l31] = acc[r]; } }
    __syncthreads();
}
__device__ __forceinline__ void gla_scan(const Params& P) {
    float* U = (float*)(P.ws + WS_US); const float* DEC = (const float*)(P.ws + WS_DECAY);
    const int idx = blockIdx.x * NTHREADS + threadIdx.x;
    if (idx >= 32768) return;
    float s = 0.f;
#pragma unroll 8
    for (int c = 0; c < NCH - 1; ++c) { const float u = U[(size_t)c * 32768 + idx], dc = DEC[(size_t)c * 256 + (idx >> 7)]; U[(size_t)c * 32768 + idx] = s; s = dc * s + u; }
    U[(size_t)(NCH - 1) * 32768 + idx] = s;
}
__device__ __forceinline__ void gla_c_unit(const Params& P, int unit, LAS unsigned char* lds) {
    int tid_ = threadIdx.x; asm volatile("" : "+v"(tid_));
    const int tid = tid_, lane = tid & 63, wid = tid >> 6, c = unit >> 2, h = unit & 3, l31 = lane & 31, hf = lane >> 5;
    LAS float* bl = (LAS float*)lds; LAS __bf16* kkb = (LAS __bf16*)(lds + 16640); LAS __bf16* qsb = (LAS __bf16*)(lds + 33280); LAS float* os = bl;
    LAS f16* qs16 = (LAS f16*)(lds + 49920); LAS f16* As16 = qs16 + 64 * 72; LAS f16* vsT = As16 + 64 * 72; LAS f16* SsT = vsT + 128 * 64;
    const f16* GQ = (const f16*)(P.ws + WS_GQ); const f16* GK = (const f16*)(P.ws + WS_GK); const f16* GV = (const f16*)(P.ws + WS_GV); const f16* GR = (const f16*)(P.ws + WS_GR);
    const float* Sg = (const float*)(P.ws + WS_US) + (size_t)unit * 8192; f16* mix = (f16*)(P.ws + WS_ACTA);
    const int ti = tid >> 3, d0 = (tid & 7) * 8, tt = 64 * c - 48 + ti; const bool tv = tt >= 0 && tt < L;
    half8 q8, k8, v8[2], r8[2]; f32x4 sreg[4];
#pragma unroll
    for (int m = 0; m < 8; ++m) { q8[m] = (f16)0.f; k8[m] = (f16)0.f; v8[0][m] = (f16)0.f; v8[1][m] = (f16)0.f; r8[0][m] = (f16)0.f; r8[1][m] = (f16)0.f; }
    if (tv) { q8 = *(const half8*)(GQ + (size_t)tt * 256 + 64 * h + d0); k8 = *(const half8*)(GK + (size_t)tt * 256 + 64 * h + d0);
        r8[0] = *(const half8*)(GR + (size_t)tt * 512 + 128 * h + (tid & 7) * 16); r8[1] = *(const half8*)(GR + (size_t)tt * 512 + 128 * h + (tid & 7) * 16 + 8); }
#pragma unroll
    for (int q = 0; q < 2; ++q) { const int ch = tid + 512 * q, j = ch >> 4, t = 64 * c - 48 + j; if (t >= 0 && t < L) v8[q] = *(const half8*)(GV + (size_t)t * 512 + 128 * h + (ch & 15) * 8); }
#pragma unroll
    for (int q = 0; q < 4; ++q) sreg[q] = *(const f32x4*)(Sg + (size_t)(tid + 512 * q) * 4);
    float bvv[8];
    if (c < NCH - 1) { const float* blg = (const float*)(P.ws + WS_BL) + (size_t)unit * 4096 + ti * 64 + d0; const f32x4 g0 = *(const f32x4*)blg, g1 = *(const f32x4*)(blg + 4);
#pragma unroll
        for (int m = 0; m < 4; ++m) { bvv[m] = g0[m]; bvv[4 + m] = g1[m]; }
    } else { gla_gates(P, c, h, bl);
#pragma unroll
        for (int m = 0; m < 8; ++m) bvv[m] = bl[ti * 65 + d0 + m]; }
    { half8 qh; bf16x8 qb, kb;
#pragma unroll
    for (int m = 0; m < 8; ++m) { const float bv = bvv[m]; const float qv = (float)q8[m] * 0.125f * __expf(bv); qh[m] = (f16)qv; qb[m] = (__bf16)qv; kb[m] = (__bf16)((float)k8[m] * __expf(-bv)); }
      *(LAS half8*)(qs16 + ti * 72 + d0) = qh; *(LAS bf16x8*)(qsb + ti * 72 + d0) = qb; *(LAS bf16x8*)(kkb + ti * 72 + d0) = kb; }
#pragma unroll
    for (int q = 0; q < 2; ++q) { const int ch = tid + 512 * q, j = ch >> 4, e0 = (ch & 15) * 8;
#pragma unroll
        for (int m = 0; m < 8; ++m) { const int e = e0 + m; vsT[e * 64 + (((j >> 3) ^ ((e >> 2) & 7)) << 3) + (j & 7)] = v8[q][m]; } }
#pragma unroll
    for (int q = 0; q < 4; ++q) { const int d = (tid + 512 * q) >> 5, eb = (tid & 31) * 4;
#pragma unroll
        for (int m = 0; m < 4; ++m) { const int e = eb + m; SsT[e * 64 + (((d >> 3) ^ ((e >> 2) & 7)) << 3) + (d & 7)] = (f16)sreg[q][m]; } }
    __syncthreads();
    if (wid < 4) { const int i0 = (wid >> 1) * 32, j0 = (wid & 1) * 32; f32x16 acc;
#pragma unroll
        for (int i = 0; i < 16; ++i) acc[i] = 0.f;
#pragma unroll
        for (int s = 0; s < 4; ++s) acc = __builtin_amdgcn_mfma_f32_32x32x16_bf16(*(const LAS bf16x8*)(qsb + (i0 + l31) * 72 + 16 * s + 8 * hf), *(const LAS bf16x8*)(kkb + (j0 + l31) * 72 + 16 * s + 8 * hf), acc, 0, 0, 0);
#pragma unroll
        for (int r = 0; r < 16; ++r) { const int i = i0 + (r & 3) + 8 * (r >> 2) + 4 * hf, j = j0 + l31; As16[i * 72 + j] = (f16)((j <= i) ? acc[r] : 0.f); } }
    __syncthreads();
    { const int i0 = (wid >> 2) * 32, e0 = (wid & 3) * 32; f32x16 acc;
#pragma unroll
      for (int i = 0; i < 16; ++i) acc[i] = 0.f;
      const int er = e0 + l31, xs = (er >> 2) & 7;
#pragma unroll
      for (int s = 0; s < 4; ++s) acc = __builtin_amdgcn_mfma_f32_32x32x16_f16(*(const LAS half8*)(qs16 + (i0 + l31) * 72 + 16 * s + 8 * hf), *(const LAS half8*)(SsT + er * 64 + (((2 * s + hf) ^ xs) << 3)), acc, 0, 0, 0);
#pragma unroll
      for (int s = 0; s < 4; ++s) acc = __builtin_amdgcn_mfma_f32_32x32x16_f16(*(const LAS half8*)(As16 + (i0 + l31) * 72 + 16 * s + 8 * hf), *(const LAS half8*)(vsT + er * 64 + (((2 * s + hf) ^ xs) << 3)), acc, 0, 0, 0);
#pragma unroll
      for (int r = 0; r < 16; ++r) { const int i = i0 + (r & 3) + 8 * (r >> 2) + 4 * hf; os[i * 129 + e0 + l31] = acc[r]; } }
    __syncthreads();
    { const int e0 = (tid & 7) * 16; float o[16], sq = 0.f;
#pragma unroll
      for (int j = 0; j < 16; ++j) { o[j] = os[ti * 129 + e0 + j]; sq += o[j] * o[j]; }
      sq += __shfl_xor(sq, 1); sq += __shfl_xor(sq, 2); sq += __shfl_xor(sq, 4);
      const float rs = rsqrtf(sq * (1.0f / 128.0f) + EPS);
      if (tt >= NMETA && tt < L) { half8 w0, w1;
#pragma unroll
          for (int j = 0; j < 8; ++j) { w0[j] = (f16)(o[j] * rs * P.hn[e0 + j] * silu_f((float)r8[0][j])); w1[j] = (f16)(o[8 + j] * rs * P.hn[e0 + 8 + j] * silu_f((float)r8[1][j])); }
          f16* dst = mix + (size_t)(tt - NMETA) * D + 128 * h + e0; *(half8*)dst = w0; *(half8*)(dst + 8) = w1; } }
    __syncthreads();
}

__device__ __forceinline__ unsigned mono_u(float f) { const unsigned u = __float_as_uint(f); return (u & 0x80000000u) ? ~u : (u | 0x80000000u); }
__device__ __forceinline__ float unmono_f(unsigned m) { return __uint_as_float((m & 0x80000000u) ? (m & 0x7fffffffu) : ~m); }
__device__ __forceinline__ unsigned wave_umax(unsigned v) {
    v = max(v, (unsigned)__builtin_amdgcn_update_dpp(0, (int)v, 0x111, 0xf, 0xf, false));
    v = max(v, (unsigned)__builtin_amdgcn_update_dpp(0, (int)v, 0x112, 0xf, 0xf, false));
    v = max(v, (unsigned)__builtin_amdgcn_update_dpp(0, (int)v, 0x114, 0xf, 0xf, false));
    v = max(v, (unsigned)__builtin_amdgcn_update_dpp(0, (int)v, 0x118, 0xf, 0xf, false));
    v = max(v, (unsigned)__builtin_amdgcn_update_dpp(0, (int)v, 0x142, 0xa, 0xf, false));
    v = max(v, (unsigned)__builtin_amdgcn_update_dpp(0, (int)v, 0x143, 0xc, 0xf, false));
    return (unsigned)__builtin_amdgcn_readlane((int)v, 63);
}
__device__ __forceinline__ int half_scan_incl(int v) {
    v += __builtin_amdgcn_update_dpp(0, v, 0x111, 0xf, 0xf, true);
    v += __builtin_amdgcn_update_dpp(0, v, 0x112, 0xf, 0xf, true);
    v += __builtin_amdgcn_update_dpp(0, v, 0x114, 0xf, 0xf, true);
    v += __builtin_amdgcn_update_dpp(0, v, 0x118, 0xf, 0xf, true);
    v += __builtin_amdgcn_update_dpp(0, v, 0x142, 0xa, 0xf, true);
    return v;
}
constexpr int CAP = 640, NPL = CAP / 64;
template <int NS> __device__ __forceinline__ int topk_compact_n(LAS float* cs, LAS unsigned short* ci, int n, bool exact, float& tau_out, int lane) {
    float sv[NS]; unsigned iv[NS], u[NS];
#pragma unroll
    for (int i = 0; i < NS; ++i) { const int p = lane + 64 * i; const bool v = p < n; sv[i] = v ? cs[p] : 0.f; iv[i] = v ? (unsigned)ci[p] : 0xffffu; u[i] = v ? mono_u(sv[i]) : 0u; }
    unsigned T = 0u; bool full = true; int hb = 31;
    {
        unsigned umx = 0u, umn = 0xffffffffu;
#pragma unroll
        for (int i = 0; i < NS; ++i) { umx = max(umx, u[i]); umn = min(umn, (lane + 64 * i < n) ? u[i] : 0xffffffffu); }
        umx = wave_umax(umx); umn = ~wave_umax(~umn);
        const unsigned df = umx ^ umn;
        if (df == 0u) { hb = -1; T = umx; } else { hb = 31 - __clz(df); T = (hb == 31) ? 0u : (umx & ~((2u << hb) - 1u)); }
    }
#pragma unroll 1
    for (int bit = hb; bit >= 0; --bit) {
        const unsigned cand = T | (1u << bit); int cgt = 0;
#pragma unroll
        for (int i = 0; i < NS; ++i) cgt += __popcll(__ballot(u[i] >= cand));
        if (cgt >= 256) { T = cand; if (cgt <= (exact ? 256 : 272)) { full = false; break; } }
    }
    bool keep[NS];
    if (full) {
        int cgt = 0;
#pragma unroll
        for (int i = 0; i < NS; ++i) cgt += __popcll(__ballot(u[i] > T));
        const int need = 256 - cgt; unsigned I = 0xffffu; int nties = 0;
#pragma unroll
        for (int i = 0; i < NS; ++i) nties += __popcll(__ballot(u[i] == T));
        if (nties != need) { I = 0u;
#pragma unroll 1
        for (int bit = 15; bit >= 0; --bit) { const unsigned cand = I | (1u << bit); int cl = 0;
#pragma unroll
            for (int i = 0; i < NS; ++i) cl += __popcll(__ballot(u[i] == T && iv[i] < cand));
            if (cl < need) I = cand; } }
#pragma unroll
        for (int i = 0; i < NS; ++i) keep[i] = (u[i] > T) || (u[i] == T && iv[i] <= I);
    } else {
#pragma unroll
        for (int i = 0; i < NS; ++i) keep[i] = u[i] >= T;
    }
    int nn = 0;
#pragma unroll
    for (int i = 0; i < NS; ++i) { const unsigned long long m = __ballot(keep[i]); const int pre = __builtin_amdgcn_mbcnt_hi((unsigned)(m >> 32), __builtin_amdgcn_mbcnt_lo((unsigned)m, 0u));
        if (keep[i]) { cs[nn + pre] = sv[i]; ci[nn + pre] = (unsigned short)iv[i]; } nn += __popcll(m); }
    tau_out = unmono_f(T);
    return nn;
}
__device__ __forceinline__ int topk_compact(LAS float* cs, LAS unsigned short* ci, int n, bool exact, float& tau_out, int lane) {
    if (n <= 384) { if (n <= 320) return topk_compact_n<5>(cs, ci, n, exact, tau_out, lane); return topk_compact_n<6>(cs, ci, n, exact, tau_out, lane); }
    if (n <= 512) { if (n <= 448) return topk_compact_n<7>(cs, ci, n, exact, tau_out, lane); return topk_compact_n<8>(cs, ci, n, exact, tau_out, lane); }
    if (n <= 576) return topk_compact_n<9>(cs, ci, n, exact, tau_out, lane);
    return topk_compact_n<NPL>(cs, ci, n, exact, tau_out, lane);
}
__device__ __forceinline__ float relu_asm(float x) { return __int_as_float(max(__float_as_int(x), 0)); }
__device__ __forceinline__ void indexer_tile(const Params& P, int tile, LAS unsigned char* lds) {
    int tid_ = threadIdx.x; asm volatile("" : "+v"(tid_));
    const int tid = tid_, lane = tid & 63, wid = __builtin_amdgcn_readfirstlane(tid >> 6), l31 = lane & 31, hf = lane >> 5;
    LAS float* candS = (LAS float*)lds;
    LAS unsigned short* candI = (LAS unsigned short*)(lds + 32 * CAP * 4);
    LAS unsigned char* kbuf = lds + 32 * CAP * 6;
    LAS int* lflag = (LAS int*)(lds + LDS_BYTES - 1024 + 192);
    const f16* IQ = (const f16*)(P.ws + WS_IQ); const f16* IK = (const f16*)(P.ws + WS_IK); const float* IW = (const float*)(P.ws + WS_IW);
    unsigned short* SEL = (unsigned short*)(P.ws + WS_SEL);
    const int t0 = tile * 32, tw = t0 + wid * 4;
    half8 afr[4];
    { const int qi = 2 * (l31 >> 4) + ((l31 >> 2) & 1), hd = 4 * ((l31 >> 3) & 1) + (l31 & 3); int tq = tw + qi; if (tq > L - 1) tq = L - 1;
      const half8* ap = (const half8*)(IQ + (size_t)tq * 512 + hd * 64);
#pragma unroll
      for (int s = 0; s < 4; ++s) afr[s] = ap[2 * s + hf]; }
    float w0[8], w1[8];
    { int ta = tw + hf, tb = tw + 2 + hf; if (ta > L - 1) ta = L - 1; if (tb > L - 1) tb = L - 1;
#pragma unroll
      for (int h = 0; h < 8; ++h) { w0[h] = IW[(size_t)ta * 8 + h]; w1[h] = IW[(size_t)tb * 8 + h]; } }
    asm volatile("" :: "v"(afr[0]), "v"(afr[1]), "v"(afr[2]), "v"(afr[3]));
    asm volatile("" :: "v"(w0[0]), "v"(w0[1]), "v"(w0[2]), "v"(w0[3]), "v"(w0[4]), "v"(w0[5]), "v"(w0[6]), "v"(w0[7]));
    asm volatile("" :: "v"(w1[0]), "v"(w1[1]), "v"(w1[2]), "v"(w1[3]), "v"(w1[4]), "v"(w1[5]), "v"(w1[6]), "v"(w1[7]));
    const int tq0 = (tw + hf < L) ? tw + hf : -1, tq1 = (tw + 2 + hf < L) ? tw + 2 + hf : -1;
    float tau0 = -__builtin_inff(), tau1 = -__builtin_inff();
    int cq0 = 0, cq1 = 0, cq2 = 0, cq3 = 0;
    if (tid < 3) lflag[tid] = 0;
    const int nkeys = (t0 + 32 < L) ? t0 + 32 : L, nst = (nkeys + 127) >> 7;
    u32x4 stg[2];
    const u32x4* IKv = (const u32x4*)IK;
#pragma unroll
    for (int i = 0; i < 2; ++i) stg[i] = IKv[(size_t)0 * 1024 + tid + 512 * i];
#pragma unroll
    for (int i = 0; i < 2; ++i) { const int ci = tid + 512 * i, row = ci >> 3, ch = ci & 7; *(LAS u32x4*)(kbuf + row * 128 + ((ch ^ ((row >> 1) & 7)) << 4)) = stg[i]; }
    __syncthreads();
#pragma unroll 1
    for (int st = 0; st < nst; ++st) {
        LAS unsigned char* kb = kbuf + (st & 1) * 16384;
        if (st + 1 < nst) {
#pragma unroll
            for (int i = 0; i < 2; ++i) stg[i] = IKv[(size_t)(st + 1) * 1024 + tid + 512 * i];
        }
        if (st * 128 <= tw + 3) {
            f32x16 acc[4];
#pragma unroll
            for (int c = 0; c < 4; ++c) {
#pragma unroll
                for (int i = 0; i < 16; ++i) acc[c][i] = 0.f;
            }
#pragma unroll
            for (int s = 0; s < 4; ++s) {
#pragma unroll
                for (int c = 0; c < 4; ++c) { const int row = c * 32 + l31; const half8 bf = *(const LAS half8*)(kb + row * 128 + (((2 * s + hf) ^ ((row >> 1) & 7)) << 4)); acc[c] = __builtin_amdgcn_mfma_f32_32x32x16_f16(afr[s], bf, acc[c], 0, 0, 0); }
            }
            float sc[8]; bool ok[8]; int na = 0, nb = 0;
#pragma unroll
            for (int c = 0; c < 4; ++c) {
                float s0, s1;
                { const float r0 = relu_asm(acc[c][0]), r1 = relu_asm(acc[c][8]); asm("v_mul_f32 %0, %1, %2" : "=v"(s0) : "v"(w0[0]), "v"(r0)); asm("v_mul_f32 %0, %1, %2" : "=v"(s1) : "v"(w1[0]), "v"(r1)); }
#pragma unroll
                for (int h = 1; h < 8; ++h) { const float r0 = relu_asm(acc[c][h]), r1 = relu_asm(acc[c][8 + h]);
                    asm("v_fmac_f32 %0, %1, %2" : "+v"(s0) : "v"(w0[h]), "v"(r0)); asm("v_fmac_f32 %0, %1, %2" : "+v"(s1) : "v"(w1[h]), "v"(r1)); }
                const int key = st * 128 + c * 32 + l31;
                sc[2 * c] = s0; sc[2 * c + 1] = s1; ok[2 * c] = key <= tq0 && s0 > tau0; ok[2 * c + 1] = key <= tq1 && s1 > tau1;
                na += ok[2 * c] ? 1 : 0; nb += ok[2 * c + 1] ? 1 : 0;
            }
            const int ia = half_scan_incl(na), ib = half_scan_incl(nb);
            const int ta0 = __builtin_amdgcn_readlane(ia, 31), ta1 = __builtin_amdgcn_readlane(ia, 63), tb0 = __builtin_amdgcn_readlane(ib, 31), tb1 = __builtin_amdgcn_readlane(ib, 63);
            int pa = (hf ? cq1 : cq0) + ia - na, pb = (hf ? cq3 : cq2) + ib - nb;
            cq0 += ta0; cq1 += ta1; cq2 += tb0; cq3 += tb1;
            pa += (wid * 4 + hf) * CAP; pb += (wid * 4 + 2 + hf) * CAP;
            const int dmy = 32 * CAP * 6 / 4 + 2 * 16384 / 4 + 64 + lane;
#pragma unroll
            for (int c = 0; c < 4; ++c) {
                const unsigned short key = (unsigned short)(st * 128 + c * 32 + l31);
                { const bool k0 = ok[2 * c]; LAS float* ps = k0 ? candS + pa : candS + dmy; LAS unsigned short* pi = k0 ? candI + pa : (LAS unsigned short*)(candS + dmy + 64); *ps = sc[2 * c]; *pi = key; pa += k0 ? 1 : 0; }
                { const bool k1 = ok[2 * c + 1]; LAS float* ps = k1 ? candS + pb : candS + dmy; LAS unsigned short* pi = k1 ? candI + pb : (LAS unsigned short*)(candS + dmy + 64); *ps = sc[2 * c + 1]; *pi = key; pb += k1 ? 1 : 0; }
            }
        }
        if (st + 1 < nst) {
            LAS unsigned char* kn = kbuf + ((st + 1) & 1) * 16384;
#pragma unroll
            for (int i = 0; i < 2; ++i) { const int ci = tid + 512 * i, row = ci >> 3, ch = ci & 7; *(LAS u32x4*)(kn + row * 128 + ((ch ^ ((row >> 1) & 7)) << 4)) = stg[i]; }
        }
        const int mx = max(max(cq0, cq1), max(cq2, cq3));
        if (mx > CAP - 128 && lane == 0) lflag[st % 3] = 1;
        if (tid == 0) lflag[(st + 1) % 3] = 0;
        __syncthreads();
        const int any = lflag[st % 3];
        if (any) {
#pragma unroll 1
            for (int qq = 0; qq < 4; ++qq) { const int n = qq == 0 ? cq0 : (qq == 1 ? cq1 : (qq == 2 ? cq2 : cq3));
                if (n > 288) { float nt; const int nn = topk_compact(candS + (wid * 4 + qq) * CAP, candI + (wid * 4 + qq) * CAP, n, false, nt, lane);
                    if (qq == 0) cq0 = nn; else if (qq == 1) cq1 = nn; else if (qq == 2) cq2 = nn; else cq3 = nn;
                    if (hf == (qq & 1)) { if (qq < 2) tau0 = nt; else tau1 = nt; } } }
        }
    }
#pragma unroll 1
    for (int qq = 0; qq < 4; ++qq) {
        const int t = tw + qq; if (t >= L) break;
        int n = qq == 0 ? cq0 : (qq == 1 ? cq1 : (qq == 2 ? cq2 : cq3)); LAS float* cs = candS + (wid * 4 + qq) * CAP; LAS unsigned short* ci = candI + (wid * 4 + qq) * CAP;
        if (n > 256) { float nt; n = topk_compact(cs, ci, n, true, nt, lane); }
#pragma unroll
        for (int j = 0; j < 4; ++j) { const int p = lane + 64 * j; SEL[(size_t)t * 256 + (p & 15) * 16 + (p >> 4)] = p < n ? ci[p] : (unsigned short)0xffffu; }
    }
    __syncthreads();
}

__device__ __forceinline__ void sparse_attn(const Params& P, LAS unsigned char* lds, int vbid) {
    int tid_ = threadIdx.x; asm volatile("" : "+v"(tid_));
    const int tid = tid_, lane = tid & 63, wid = tid >> 6, grp = lane >> 2, c4 = lane & 3;
    const int head = vbid & 7, slot = (vbid >> 3) * 8 + wid, nslot = (gridDim.x >> 3) * 8;
    typedef _Float16 half2v __attribute__((ext_vector_type(2)));
    LAS float* red = (LAS float*)(lds + 4096 + wid * 4352);
    const unsigned short* SEL = (const unsigned short*)(P.ws + WS_SEL);
    const unsigned char* Q8 = P.ws + WS_DQ + head * 64 + c4 * 16; const float* QS = (const float*)(P.ws + WS_DQ + (size_t)LP * 512) + head;
    const unsigned char* kvh = P.ws + WS_KV + (size_t)head * LP * 128; f16* mix = (f16*)(P.ws + WS_ACTA);
    int t = NMETA + slot;
    u32x4 sela = {0u, 0u, 0u, 0u}, selb = {0u, 0u, 0u, 0u}, q8 = {0u, 0u, 0u, 0u}; float lscale = 0.f;
    if (t < L) { sela = *(const u32x4*)(SEL + (size_t)t * 256 + grp * 16); selb = *(const u32x4*)(SEL + (size_t)t * 256 + grp * 16 + 8); q8 = *(const u32x4*)(Q8 + (size_t)t * 512); lscale = QS[(size_t)t * 8]; }
#define ATTN_ITEM(ALLV) do { \
        unsigned keys[16]; u32x4 kreg[16], vreg[16]; \
        _Pragma("unroll") for (int it = 0; it < 16; ++it) { const unsigned w = it < 8 ? sela[it >> 1] : selb[(it - 8) >> 1]; keys[it] = (it & 1) ? (w >> 16) : (w & 0xffffu); } \
          \
        _Pragma("unroll") for (int it = 0; it < 16; ++it) { const unsigned kk = (ALLV || keys[it] != 0xffffu) ? keys[it] : 0u; kreg[it] = *(const u32x4*)(kvh + (size_t)kk * 128 + c4 * 16); vreg[it] = *(const u32x4*)(kvh + (size_t)kk * 128 + 64 + c4 * 16); } \
        const u32x4 qc = q8; const float ls = lscale; \
        { const int tn = t + nslot;     \
          if (tn < L) { sela = *(const u32x4*)(SEL + (size_t)tn * 256 + grp * 16); selb = *(const u32x4*)(SEL + (size_t)tn * 256 + grp * 16 + 8); q8 = *(const u32x4*)(Q8 + (size_t)tn * 512); lscale = QS[(size_t)tn * 8]; } } \
        float lg[16]; float mx = -__builtin_inff(); \
        _Pragma("unroll") for (int it = 0; it < 16; ++it) { \
            int ai = 0; \
            _Pragma("unroll") for (int w = 0; w < 4; ++w) ai = __builtin_amdgcn_sdot4((int)kreg[it][w], (int)qc[w], ai, false); \
            ai += __builtin_amdgcn_update_dpp(0, ai, 0xB1, 0xf, 0xf, true);     \
            ai += __builtin_amdgcn_update_dpp(0, ai, 0x4E, 0xf, 0xf, true);     \
            lg[it] = (ALLV || keys[it] != 0xffffu) ? (float)ai * ls : -__builtin_inff(); mx = fmaxf(mx, lg[it]); } \
        mx = fmaxf(mx, __shfl_xor(mx, 4)); mx = fmaxf(mx, __shfl_xor(mx, 8)); mx = fmaxf(mx, __shfl_xor(mx, 16)); mx = fmaxf(mx, __shfl_xor(mx, 32)); \
        half2v o2[8]; float lsum = 0.f; \
        _Pragma("unroll") for (int e = 0; e < 8; ++e) o2[e] = (half2v){(f16)0.f, (f16)0.f}; \
        _Pragma("unroll") for (int it = 0; it < 16; ++it) { \
            const float p = __expf(lg[it] - mx); lsum += p; const f16 ph = (f16)p; const half2v p2 = {ph, ph}; \
            _Pragma("unroll") for (int w = 0; w < 4; ++w) {     \
                const half2v v01 = __builtin_bit_cast(half2v, __builtin_amdgcn_perm(0u, vreg[it][w], 0x010c000cu)), v23 = __builtin_bit_cast(half2v, __builtin_amdgcn_perm(0u, vreg[it][w], 0x030c020cu)); \
                o2[2 * w] = p2 * v01 + o2[2 * w]; o2[2 * w + 1] = p2 * v23 + o2[2 * w + 1]; } } \
        lsum += __shfl_xor(lsum, 4); lsum += __shfl_xor(lsum, 8); lsum += __shfl_xor(lsum, 16); lsum += __shfl_xor(lsum, 32); \
          \
        _Pragma("unroll") for (int e = 0; e < 8; ++e) { red[lane * 17 + 2 * e] = (float)o2[e][0]; red[lane * 17 + 2 * e + 1] = (float)o2[e][1]; } \
        float acc = 0.f; \
        { const int cc = lane >> 4, e = lane & 15; \
          _Pragma("unroll") for (int g = 0; g < 16; ++g) acc += red[(g * 4 + cc) * 17 + e]; } \
        mix[(size_t)(t - NMETA) * D + 512 + head * 64 + lane] = (f16)(acc * __builtin_amdgcn_rcpf(lsum)); \
    } while (0)
    if (wid >= 4) __builtin_amdgcn_s_sleep(64);
#pragma unroll 1
    for (; t < L; t += nslot) {
        if (t >= 255) ATTN_ITEM(true);
        else ATTN_ITEM(false);
    }
#undef ATTN_ITEM
    __syncthreads();
}

__device__ __forceinline__ void final_norm(const Params& P) {
    const int tid = threadIdx.x, lane = tid & 63, gw = blockIdx.x * 8 + (tid >> 6), nw = gridDim.x * 8;
    const float* ss3 = (const float*)(P.ws + WS_SS3); const f16* h3 = (const f16*)(P.ws + WS_ACTA);
    for (int r = gw; r < SEQ; r += nw) { const float rs = row_rstd(ss3, 16, r);
#pragma unroll
        for (int i = 0; i < 2; ++i) { const int k = lane * 8 + 512 * i; const half8 v = *(const half8*)(h3 + (size_t)r * D + k); const f32x4 g0 = *(const f32x4*)(P.nf + k), g1 = *(const f32x4*)(P.nf + k + 4); f32x4 o0, o1;
#pragma unroll
            for (int j = 0; j < 4; ++j) { o0[j] = (float)v[j] * rs * g0[j]; o1[j] = (float)v[4 + j] * rs * g1[j]; }
            *(f32x4*)(P.out + (size_t)r * D + k) = o0; *(f32x4*)(P.out + (size_t)r * D + k + 4) = o1; } }
}

#define XB_TMO      128
#define XB_XCNT(j)  (256  + 64 * (j))
#define XB_XSUB(j)  (1280 + 64 * (j))
#define XB_XGEN(j)  (2304 + 64 * (j))
#define XB_TOP      3328
#define XB_TOPGEN   3392
#define XCD_BAR_WORDS 3456
#define XB_SPIN_CAP (1u << 22)
__device__ __forceinline__ unsigned xb_ld(unsigned* p)              { return __hip_atomic_load(p, __ATOMIC_RELAXED, __HIP_MEMORY_SCOPE_AGENT); }
__device__ __forceinline__ unsigned xb_add(unsigned* p, unsigned v) { return __hip_atomic_fetch_add(p, v, __ATOMIC_RELAXED, __HIP_MEMORY_SCOPE_AGENT); }
__device__ __forceinline__ unsigned xb_xcc_id() { return (unsigned)__builtin_amdgcn_s_getreg((3 << 11) | 20) & 0xFu; }
#define XB_SPIN(cond, bar) do { unsigned _sp = 0; while (cond) { __builtin_amdgcn_s_sleep(1); \
    if ((++_sp & 255u) == 0u) { if (xb_ld(&(bar)[XB_TMO])) break; if (_sp > XB_SPIN_CAP) { atomicAdd(&(bar)[XB_TMO], 1u); break; } } } } while (0)
struct XcdBarrier { unsigned* bar; unsigned x; volatile LAS unsigned* st; };
__device__ __forceinline__ XcdBarrier xcd_barrier_post(unsigned* bar, volatile LAS unsigned* st) {
    XcdBarrier b; b.bar = bar; b.x = xb_xcc_id(); b.st = st;
    if (threadIdx.x == 0) (void)xb_add(&bar[XB_XCNT(b.x)], 1u);
    return b;
}
__device__ __forceinline__ void xcd_barrier_complete(unsigned* bar, unsigned x, unsigned& nloc, unsigned& nx) {
    const unsigned G = gridDim.x * gridDim.y * gridDim.z;
    unsigned sum, cnt, mine, sp = 0u;
    for (;;) {
        sum = 0u; cnt = 0u; mine = 0u;
#pragma unroll
        for (unsigned j = 0; j < 16; ++j) { const unsigned c = xb_ld(&bar[XB_XCNT(j)]); sum += c; cnt += (c > 0u) ? 1u : 0u; mine = (j == x) ? c : mine; }
        if (sum == G) break;
        __builtin_amdgcn_s_sleep(1);
        if ((++sp & 255u) == 0u) { if (xb_ld(&bar[XB_TMO])) break; if (sp > XB_SPIN_CAP) { atomicAdd(&bar[XB_TMO], 1u); break; } }
    }
    nloc = mine > 0u ? mine : 1u; nx = cnt > 0u ? cnt : 1u;
}
__device__ __forceinline__ void xcd_barrier(const XcdBarrier& b) {
    asm volatile("s_waitcnt vmcnt(0)" ::: "memory");
    __syncthreads();
    if (threadIdx.x == 0) {
        unsigned* bar = b.bar;
        __builtin_amdgcn_s_waitcnt(0);
        unsigned nloc = b.st[0], nx = b.st[1];
        if (nloc == 0u) { xcd_barrier_complete(bar, b.x, nloc, nx); b.st[0] = nloc; b.st[1] = nx; }
        const unsigned old = xb_add(&bar[XB_XSUB(b.x)], 1u);
        const unsigned gen = old / nloc;
        if (old + 1u == (gen + 1u) * nloc) {
            __builtin_amdgcn_fence(__ATOMIC_RELEASE, "agent");
            asm volatile("s_waitcnt vmcnt(0)" ::: "memory");
            const unsigned og = xb_add(&bar[XB_TOP], 1u);
            const unsigned tg = og / nx;
            if (og + 1u == (tg + 1u) * nx) xb_add(&bar[XB_TOPGEN], 1u);
            else XB_SPIN(xb_ld(&bar[XB_TOPGEN]) == tg, bar);
            __builtin_amdgcn_fence(__ATOMIC_ACQUIRE, "agent");
            xb_add(&bar[XB_XGEN(b.x)], 1u);
            asm volatile("s_waitcnt vmcnt(0)" ::: "memory");
        } else {
            XB_SPIN(xb_ld(&bar[XB_XGEN(b.x)]) == gen, bar);
            __builtin_amdgcn_fence(__ATOMIC_ACQUIRE, "agent");
            asm volatile("s_waitcnt vmcnt(0)" ::: "memory");
        }
    }
    __syncthreads();
}

__global__ void __launch_bounds__(NTHREADS, 2) fwd_kernel(Params P) {
    __shared__ __attribute__((aligned(16))) unsigned char lds_raw[LDS_BYTES];
    LAS unsigned char* lds = (LAS unsigned char*)lds_raw;
    const int tid = threadIdx.x, bid = blockIdx.x, G = gridDim.x;
    unsigned char* ws = P.ws;
    const int lo = P.ph_lo, hi = P.ph_hi;
#ifndef ONLY_PHASE
#define ONLY_PHASE -1
#endif
#define IN(k) ((ONLY_PHASE < 0 || ONLY_PHASE == (k)) && lo <= (k) && (k) < hi)
#define SEAM(k) do { if (IN(k) && IN((k) + 1)) { xcd_barrier(xbar); } } while (0)
    XcdBarrier xbar; xbar.bar = (unsigned*)(ws + WS_BAR); xbar.x = 0; xbar.st = (volatile LAS unsigned*)(lds + LDS_BYTES - 1024 + 16);
    if (hi - lo > 1) {
        if (tid == 0) { xbar.st[0] = 0u; xbar.st[1] = 0u; }
        __syncthreads();
        xbar = xcd_barrier_post((unsigned*)(ws + WS_BAR), (volatile LAS unsigned*)(lds + LDS_BYTES - 1024 + 16));
    }
    LAS int* misc = (LAS int*)(lds + LDS_BYTES - 1024);
    if (hi - lo > 1) {
        if (tid == 0) { const unsigned xcc = xb_xcc_id() & 7u; misc[8] = (int)xcc; misc[9] = (int)xb_add((unsigned*)(ws + WS_CTL) + 32 + 32 * xcc, 1u); }
    }
    int vbid = bid;
    f16* acta = (f16*)(ws + WS_ACTA); f16* Gb = (f16*)(ws + WS_G);
    float* ss1 = (float*)(ws + WS_SS1); float* ss3 = (float*)(ws + WS_SS3);
    if (IN(0)) { p0_prologue(P, lds); }
    SEAM(0);
    if (hi - lo > 1 && (G & 7) == 0) {
        if (tid == 0) { bool ok = true; for (int j = 0; j < 8; ++j) ok = ok && (xb_ld((unsigned*)(ws + WS_CTL) + 32 + 32 * j) == (unsigned)(G >> 3)); misc[10] = ok ? misc[9] * 8 + misc[8] : bid; }
        __syncthreads();
        vbid = __builtin_amdgcn_readfirstlane(misc[10]);
        __syncthreads();
    }
    if (IN(1)) {
        pg8::Gemm g{(const f16*)(ws + WS_US), (const f16*)(ws + WS_WGU1), MP, 2 * DFF, D / 2}; pg8::StaticOrder S; S.init(MP, 2 * DFF, G, vbid);
        EpiSwiglu<true> E{Gb, nullptr, 1, (const float*)(ws + WS_IQ), (const float*)(ws + WS_WGU1 + (size_t)2 * DFF * D)}; pg8::gemm_phase(lds, g, S, E);
    }
    SEAM(1);
    if (IN(2)) {
        meta_down(P, lds);
        pg8::Gemm g{Gb, (const f16*)(ws + WS_WD1), SEQ, D, DFF}; pg8::StaticOrder S; S.init(SEQ, D, G, vbid);
        EpiResid<true> E{acta, (f16*)P.out, ss1, 0.5f}; pg8::gemm_phase(lds, g, S, E);
    }
    SEAM(2);
    if (IN(3)) {
        pg8::Gemm g{(const f16*)P.out, (const f16*)(ws + WS_WIN), MP, NIN, D}; pg8::StaticOrder S; S.init(MP, NIN, G, vbid);
        EpiInProj E{ss1, (const f32x2*)(ws + WS_ROPE), ws};
        pg8::gemm_phase(lds, g, S, E);
    }
    SEAM(3);
    if (IN(4)) {
        for (int u = bid; u < (NCH - 1) * 4; u += G) gla_a_unit(P, u, lds);
        {
            constexpr int NI8 = 2 * DFF / 64; LAS f16* tl = (LAS f16*)lds;
            if (G > NI8 + 64) {
                if (bid >= G - NI8) prep_weight_i8(P, 4, 2 * DFF, ws + WS_WGU2, (float*)(ws + WS_WGU2 + (size_t)2 * DFF * D), bid - (G - NI8), NI8, lds);
                else { int tbase = 0, cursor = bid;
                    prep_weight(P, 3, D, D, (f16*)(ws + WS_WOUT), cursor, tbase, tl, G - NI8);
                    prep_weight(P, 5, D, DFF, (f16*)(ws + WS_WD2), cursor, tbase, tl, G - NI8); }
            } else { int tbase = 0, cursor = bid;
                prep_weight(P, 3, D, D, (f16*)(ws + WS_WOUT), cursor, tbase, tl, G);
                prep_weight(P, 5, D, DFF, (f16*)(ws + WS_WD2), cursor, tbase, tl, G);
                __syncthreads();
                prep_weight_i8(P, 4, 2 * DFF, ws + WS_WGU2, (float*)(ws + WS_WGU2 + (size_t)2 * DFF * D), bid, G, lds); }
        }
    }
    SEAM(4);
    if (IN(5)) {
        if (bid < 64) gla_scan(P);
        unsigned* ctr = (unsigned*)(ws + WS_CTL); LAS int* bc = (LAS int*)(lds + LDS_BYTES - 1024);
        for (;;) {
            if (tid == 0) bc[0] = (int)atomicAdd(ctr, 1u);
            __syncthreads();
            const int k = bc[0];
            __syncthreads();
            if (k >= 513) break;
            indexer_tile(P, 512 - k, lds);
        }
    }
    SEAM(5);
    if (IN(6)) { for (int u = 4 + bid; u < NCH * 4; u += G) gla_c_unit(P, u, lds); sparse_attn(P, lds, vbid); }
    SEAM(6);
    if (IN(7)) {
        pg8::Gemm g{acta, (const f16*)(ws + WS_WOUT), SEQ, D, D}; pg8::StaticOrder S; S.init(SEQ, D, G, vbid);
        EpiResid<true, false> E{P.out, (f16*)(ws + WS_US), nullptr, 1.0f}; pg8::gemm_phase(lds, g, S, E);
    }
    SEAM(7);
    if (IN(8)) quant_rows_i8((const f16*)(ws + WS_US), ws + WS_DQ, (float*)(ws + WS_IQ), SEQ);
    SEAM(8);
    if (IN(9)) {
        pg8::Gemm g{(const f16*)(ws + WS_DQ), (const f16*)(ws + WS_WGU2), SEQ, 2 * DFF, D / 2}; pg8::StaticOrder S; S.init(SEQ, 2 * DFF, G, vbid);
        EpiSwiglu<true> E{Gb, nullptr, 16, (const float*)(ws + WS_IQ), (const float*)(ws + WS_WGU2 + (size_t)2 * DFF * D)}; pg8::gemm_phase(lds, g, S, E);
    }
    SEAM(9);
    if (IN(10)) {
        pg8::Gemm g{Gb, (const f16*)(ws + WS_WD2), SEQ, D, DFF}; pg8::StaticOrder S; S.init(SEQ, D, G, vbid);
        EpiResid<true> E{ws + WS_US, acta, ss3, 0.5f}; pg8::gemm_phase(lds, g, S, E);
    }
    SEAM(10);
    if (IN(11)) final_norm(P);
#undef IN
#undef SEAM
}

extern "C" void kernel_launch(void* const* d_in, const int* in_sizes, int n_in, void* d_out, int out_size, void* d_ws, size_t ws_size, hipStream_t stream) {
    static int grid = 0;
    if (grid == 0) {
        if (n_in != 17 || in_sizes[0] != SEQ * D || out_size != SEQ * D || ws_size < WS_END) { fprintf(stderr, "kernel_launch: unexpected shapes (n_in %d, in0 %d, out %d, ws %zu, need %zu)\n", n_in, n_in > 0 ? in_sizes[0] : -1, out_size, ws_size, (size_t)WS_END); grid = -1; return; }
        int dev = 0, cus = 0, per_cu = 0;
        (void)hipGetDevice(&dev); (void)hipDeviceGetAttribute(&cus, hipDeviceAttributeMultiprocessorCount, dev);
        if (hipOccupancyMaxActiveBlocksPerMultiprocessor(&per_cu, (const void*)fwd_kernel, NTHREADS, 0) != hipSuccess || per_cu < 1) { fprintf(stderr, "kernel_launch: occupancy query says %d blocks per CU\n", per_cu); per_cu = 1; }
        (void)hipGetLastError();
        grid = cus;
        if (grid % 8 != 0 || grid < 64) { fprintf(stderr, "kernel_launch: unexpected CU count %d\n", cus); }
    }
    if (grid < 0) return;
    if (hipMemsetAsync((char*)d_ws + WS_CTL, 0, CTL_BYTES, stream) != hipSuccess) { fprintf(stderr, "kernel_launch: memset failed\n"); return; }
    Params p{};
    const float** pp = (const float**)&p;
    for (int i = 0; i < 17; ++i) pp[i] = (const float*)d_in[i];
    p.out = (float*)d_out; p.ws = (unsigned char*)d_ws;
#if MODE == 0
    for (int ph = 0; ph < NPHASE; ++ph) { p.ph_lo = ph; p.ph_hi = ph + 1; hipLaunchKernelGGL(fwd_kernel, dim3(grid), dim3(NTHREADS), 0, stream, p); }
#else
    p.ph_lo = 0; p.ph_hi = NPHASE;
    void* args[] = {&p};
    hipError_t e = hipLaunchCooperativeKernel((const void*)fwd_kernel, dim3(grid), dim3(NTHREADS), args, 0, stream);
    if (e != hipSuccess) fprintf(stderr, "cooperative launch failed: %s (grid %d)\n", hipGetErrorString(e), grid);
#endif
}
```
